# Optimizing an MI355X kernel written in HIP

```python
import jax
import jax.numpy as jnp
from jax import lax
import numpy as np

D_MODEL = 1024
BATCH = 2
SEQ = 16384
DEPTH = 4

GRID_W = 64
CTX_LEN = 256
HEAD_DIM = 64
NA_HEADS = 6
NA_DIM = NA_HEADS * HEAD_DIM
NA_ROWS = 8
NA_COLS = 16
NA_QBLOCK = 16
NA_KSPAN = 32
HG_HEADS = 6
HG_DK = 64
HG_DV = 64
HG_DIM = HG_HEADS * HG_DV
HG_CHUNK = 64
CONV_DIM = 256
CONV_WIDTH = 3
MIX_DIM = NA_DIM + HG_DIM + CONV_DIM
N_EXPERTS = 16
EXPERT_DIM = 512
EC_CAPACITY_FACTOR = 2
ROPE_BASE = 10000.0
NORM_EPS = 1e-6
N_MOD = 6

kernel_name = 'hybrid_na_hgrn2_shortconv_ecmoe_dit'


def _in_sizes():
    return [NA_DIM] * 3 + [HG_HEADS * HG_DK] * 3 + [HG_HEADS * HG_DV] * 2 + [CONV_DIM] * 3


def _split_points():
    return [int(s) for s in np.cumsum(_in_sizes())[:-1]]


def _rmsnorm(x, w):
    xf = x.astype(jnp.float32)
    y = xf * lax.rsqrt(jnp.mean(xf * xf, axis=-1, keepdims=True) + NORM_EPS)
    return (y * w.astype(jnp.float32)).astype(x.dtype)


def _adaln(cond, w, b):
    return jnp.matmul(jax.nn.silu(cond), w) + b


def _modulate(h, shift, scale):
    return h * (1 + scale) + shift


def _rope_tables(n, dtype):
    t = jnp.arange(n, dtype=jnp.int32)
    row = (t // GRID_W).astype(jnp.float32)
    col = (t % GRID_W).astype(jnp.float32)
    n_freq = HEAD_DIM // 4
    inv = ROPE_BASE ** (-jnp.arange(n_freq, dtype=jnp.float32) / n_freq)
    ar = row[:, None] * inv
    ac = col[:, None] * inv
    ang = jnp.concatenate([ar, ar, ac, ac], axis=-1)
    return jnp.cos(ang).astype(dtype)[:, None, :], jnp.sin(ang).astype(dtype)[:, None, :]


def _rot(x):
    x0, x1, x2, x3 = jnp.split(x, 4, axis=-1)
    return jnp.concatenate([-x1, x0, -x3, x2], axis=-1)


def _rope(x, cos, sin):
    return x * cos + _rot(x) * sin


def _na_col_tables():
    cols = np.arange(GRID_W)
    win_start = np.clip(cols - NA_COLS // 2, 0, GRID_W - NA_COLS)
    n_cb = GRID_W // NA_QBLOCK
    blk_start = np.clip(win_start[::NA_QBLOCK], 0, GRID_W - NA_KSPAN)
    key_cols = blk_start[:, None] + np.arange(NA_KSPAN)[None, :]
    q_cols = cols.reshape(n_cb, NA_QBLOCK)
    q_start = win_start.reshape(n_cb, NA_QBLOCK)
    kc = key_cols[:, None, :]
    mask = (kc >= q_start[..., None]) & (kc < q_start[..., None] + NA_COLS)
    rel = np.clip(kc - q_cols[..., None] + NA_COLS - 1, 0, 2 * NA_COLS - 2)
    return key_cols, rel, mask


def _na_latent(q, k, v, k_ctx, v_ctx, rpb):
    b, n, h, d = q.shape
    rows = n // GRID_W
    kr = min(NA_ROWS, rows)
    n_cb = GRID_W // NA_QBLOCK
    key_cols_np, rel_col_np, col_mask_np = _na_col_tables()
    key_cols = jnp.asarray(key_cols_np)
    rel_col = jnp.asarray(rel_col_np)
    n_loc = kr * NA_KSPAN
    win_mask = jnp.asarray(np.broadcast_to(col_mask_np[:, :, None, :], (n_cb, NA_QBLOCK, kr, NA_KSPAN)).reshape(n_cb, NA_QBLOCK, n_loc))
    kg = k.reshape(b, rows, GRID_W, h, d)
    vg = v.reshape(b, rows, GRID_W, h, d)
    q_rows = q.reshape(b, rows, n_cb, NA_QBLOCK, h, d).transpose(1, 0, 2, 3, 4, 5)
    scale = d ** -0.5

    def gather_blocks(g, rs):
        blk = lax.dynamic_slice_in_dim(g, rs, kr, axis=1)[:, :, key_cols]
        return blk.transpose(0, 2, 1, 3, 4, 5).reshape(b, n_cb, n_loc, h, d)

    def row_fn(xs):
        r, q_r = xs
        rs = jnp.clip(r - kr // 2, 0, rows - kr)
        k_loc = gather_blocks(kg, rs)
        v_loc = gather_blocks(vg, rs)
        rel_row = rs + jnp.arange(kr) - r + (NA_ROWS - 1)
        bias = rpb[:, rel_row[:, None, None, None], rel_col[None]]
        bias = bias.transpose(0, 2, 3, 1, 4).reshape(h, n_cb, NA_QBLOCK, n_loc)
        s_loc = jnp.einsum('bjqhd,bjkhd->bhjqk', q_r, k_loc).astype(jnp.float32) * scale + bias.astype(jnp.float32)
        s_loc = jnp.where(win_mask, s_loc, -jnp.inf)
        s_ctx = jnp.einsum('bjqhd,bchd->bhjqc', q_r, k_ctx).astype(jnp.float32) * scale
        p = jax.nn.softmax(jnp.concatenate([s_loc, s_ctx], axis=-1), axis=-1).astype(v.dtype)
        o_loc = jnp.einsum('bhjqk,bjkhd->bjqhd', p[..., :n_loc], v_loc)
        o_ctx = jnp.einsum('bhjqc,bchd->bjqhd', p[..., n_loc:], v_ctx)
        return o_loc + o_ctx

    out = lax.map(row_fn, (jnp.arange(rows, dtype=jnp.int32), q_rows))
    return out.transpose(1, 0, 2, 3, 4, 5).reshape(b, n, h, d)


def _ctx_attn(q, k, v):
    s = jnp.einsum('bqhd,bkhd->bhqk', q, k).astype(jnp.float32) * (q.shape[-1] ** -0.5)
    p = jax.nn.softmax(s, axis=-1).astype(v.dtype)
    return jnp.einsum('bhqk,bkhd->bqhd', p, v)


def _hgrn_lower_bounds(logits):
    p = jax.nn.softmax(logits.astype(jnp.float32), axis=1)
    return jnp.concatenate([jnp.zeros_like(p[:, :1]), jnp.cumsum(p[:, 1:], axis=1)], axis=1)


def _hgrn_gates(f_logit, lb):
    z = f_logit.astype(jnp.float32)
    log_f = jnp.logaddexp(jnp.log(lb), jnp.log1p(-lb) + jax.nn.log_sigmoid(z))
    k = (1 - lb) * jax.nn.sigmoid(-z)
    return log_f, k


def _heads(a, dh):
    return a.reshape(a.shape[0], a.shape[1], -1, dh).astype(jnp.float32)


def _gla_scan(q, k, log_f, v, s0):
    b, t, h, _ = q.shape
    nc = t // HG_CHUNK

    def to_chunks(a):
        return a.reshape(b, nc, HG_CHUNK, h, a.shape[-1]).transpose(1, 0, 3, 2, 4)

    causal = jnp.tril(jnp.ones((HG_CHUNK, HG_CHUNK), dtype=bool))

    def step(s, xs):
        qc, kc, gc, vc = xs
        a = jnp.cumsum(gc, axis=2)
        diff = a[:, :, :, None, :] - a[:, :, None, :, :]
        decay = jnp.exp(jnp.where(causal[:, :, None], diff, -jnp.inf))
        scores = jnp.sum(qc[:, :, :, None, :] * kc[:, :, None, :, :] * decay, axis=-1)
        o = jnp.einsum('bhts,bhsv->bhtv', scores, vc) + jnp.einsum('bhtk,bhkv->bhtv', qc * jnp.exp(a), s)
        a_last = a[:, :, -1:, :]
        s_new = jnp.exp(a_last[:, :, 0, :, None]) * s + jnp.einsum('bhsk,bhsv->bhkv', kc * jnp.exp(a_last - a), vc)
        return s_new, o

    s_fin, o = lax.scan(step, s0, (to_chunks(q), to_chunks(k), to_chunks(log_f), to_chunks(v)))
    o = o.transpose(1, 0, 3, 2, 4).reshape(b, t, h, v.shape[-1])
    return o, s_fin


def _hgrn2_mixer(lat, cxt, lb_fwd, lb_bwd, norm_w, need_ctx):
    q_l, ff_l, fb_l, i_l, g_l = lat
    q_c, ff_c, fb_c, i_c, g_c = cxt
    dtype = q_l.dtype
    b = q_l.shape[0]
    scale = HG_DK ** -0.5
    ql = _heads(q_l, HG_DK) * scale
    qc = _heads(q_c, HG_DK) * scale
    vl = _heads(i_l, HG_DV)
    vc = _heads(i_c, HG_DV)
    o_l = jnp.zeros_like(vl)
    o_c = jnp.zeros_like(vc)
    for f_lat, f_ctx, lb, rev in ((ff_l, ff_c, lb_fwd, False), (fb_l, fb_c, lb_bwd, True)):
        lb = lb.astype(jnp.float32).reshape(HG_HEADS, HG_DK)
        lf_l, k_l = _hgrn_gates(_heads(f_lat, HG_DK), lb)
        lf_c, k_c = _hgrn_gates(_heads(f_ctx, HG_DK), lb)
        lat_seq = (ql, k_l, lf_l, vl)
        ctx_seq = (qc, k_c, lf_c, vc)
        if rev:
            lat_seq = tuple(jnp.flip(a, axis=1) for a in lat_seq)
            ctx_seq = tuple(jnp.flip(a, axis=1) for a in ctx_seq)
        s0 = jnp.zeros((b, HG_HEADS, HG_DK, HG_DV), jnp.float32)
        oc, s_ctx = _gla_scan(*ctx_seq, s0)
        ol, _ = _gla_scan(*lat_seq, s_ctx)
        if rev:
            oc = jnp.flip(oc, axis=1)
            ol = jnp.flip(ol, axis=1)
        o_l = o_l + ol
        o_c = o_c + oc
    y_l = (_rmsnorm(o_l, norm_w) * jax.nn.silu(_heads(g_l, HG_DV))).reshape(g_l.shape).astype(dtype)
    if not need_ctx:
        return y_l, None
    y_c = (_rmsnorm(o_c, norm_w) * jax.nn.silu(_heads(g_c, HG_DV))).reshape(g_c.shape).astype(dtype)
    return y_l, y_c


def _short_gated_conv(b_gate, c_gate, u, w):
    z = c_gate * u
    t = z.shape[1]
    zp = jnp.pad(z, ((0, 0), (CONV_WIDTH // 2, CONV_WIDTH // 2), (0, 0)))
    y = sum(w[j] * zp[:, j:j + t] for j in range(CONV_WIDTH))
    return b_gate * y


def _token_mixers(h, hc, w_in_l, q_norm, k_norm, rpb, lb_fwd, lb_bwd, hg_norm_l, conv_w_l, rope_cos, rope_sin, need_ctx):
    b, n, _ = h.shape
    ctx_len = hc.shape[1]
    pts = _split_points()
    p = jnp.split(jnp.einsum('btd,dk->btk', h, w_in_l), pts, axis=-1)
    pc = jnp.split(jnp.einsum('btd,dk->btk', hc, w_in_l), pts, axis=-1)

    def na_heads(a):
        return a.reshape(a.shape[0], a.shape[1], NA_HEADS, HEAD_DIM)

    q = _rope(_rmsnorm(na_heads(p[0]), q_norm), rope_cos, rope_sin)
    k = _rope(_rmsnorm(na_heads(p[1]), k_norm), rope_cos, rope_sin)
    v = na_heads(p[2])
    qc = _rmsnorm(na_heads(pc[0]), q_norm)
    kc = _rmsnorm(na_heads(pc[1]), k_norm)
    vc = na_heads(pc[2])
    na = _na_latent(q, k, v, kc, vc, rpb).reshape(b, n, NA_DIM)
    hg, hg_c = _hgrn2_mixer(p[3:8], pc[3:8], lb_fwd, lb_bwd, hg_norm_l, need_ctx)
    cv = _short_gated_conv(p[8], p[9], p[10], conv_w_l)
    mix = jnp.concatenate([na, hg, cv], axis=-1)
    if not need_ctx:
        return mix, None
    na_c = _ctx_attn(qc, kc, vc).reshape(b, ctx_len, NA_DIM)
    cv_c = _short_gated_conv(pc[8], pc[9], pc[10], conv_w_l)
    return mix, jnp.concatenate([na_c, hg_c, cv_c], axis=-1)


def _expert_choice_ffn(h, w_router, w_gate, w_up, w_down):
    b, t, d = h.shape
    cap = EC_CAPACITY_FACTOR * t // N_EXPERTS
    aff = jax.nn.softmax(jnp.einsum('btd,de->bte', h, w_router).astype(jnp.float32), axis=-1)
    vals, idx = lax.top_k(aff.transpose(0, 2, 1), cap)
    xg = jax.vmap(lambda hb, ib: hb[ib])(h, idx)
    hid = jax.nn.silu(jnp.einsum('becd,edf->becf', xg, w_gate)) * jnp.einsum('becd,edf->becf', xg, w_up)
    out = jnp.einsum('becf,efd->becd', hid, w_down) * vals[..., None].astype(h.dtype)
    return jax.vmap(lambda ob, ib: jnp.zeros((t, d), h.dtype).at[ib.reshape(-1)].add(ob.reshape(-1, d)))(out, idx)


def setup_inputs(seed: int = 0) -> dict:
    key = jax.random.key(seed)
    ks = jax.random.split(key, 20)
    nrm = jax.random.normal
    d = D_MODEL
    in_cols = sum(_in_sizes())
    return {
        'x': nrm(ks[0], (BATCH, SEQ, d), jnp.float32),
        'c': nrm(ks[1], (BATCH, d), jnp.float32),
        'ctx': nrm(ks[2], (BATCH, CTX_LEN, d), jnp.float32),
        'c_ctx': nrm(ks[3], (d,), jnp.float32),
        'w_mod': nrm(ks[4], (DEPTH, d, N_MOD * d), jnp.float32) * (0.5 * d ** -0.5),
        'b_mod': 0.02 * nrm(ks[5], (DEPTH, N_MOD * d), jnp.float32),
        'norm1_w': 1.0 + 0.1 * nrm(ks[6], (DEPTH, d), jnp.float32),
        'w_in': nrm(ks[7], (DEPTH, d, in_cols), jnp.float32) * d ** -0.5,
        'na_q_norm': 1.0 + 0.1 * nrm(ks[8], (DEPTH, HEAD_DIM), jnp.float32),
        'na_k_norm': 1.0 + 0.1 * nrm(ks[9], (DEPTH, HEAD_DIM), jnp.float32),
        'na_rpb': 0.5 * nrm(ks[10], (DEPTH, NA_HEADS, 2 * NA_ROWS - 1, 2 * NA_COLS - 1), jnp.float32),
        'hg_lb_logits': nrm(ks[11], (2, DEPTH, HG_HEADS * HG_DK), jnp.float32),
        'hg_norm': 1.0 + 0.1 * nrm(ks[12], (DEPTH, HG_DV), jnp.float32),
        'conv_w': nrm(ks[13], (DEPTH, CONV_WIDTH, CONV_DIM), jnp.float32) * CONV_WIDTH ** -0.5,
        'w_out': nrm(ks[14], (DEPTH, MIX_DIM, d), jnp.float32) * MIX_DIM ** -0.5,
        'norm2_w': 1.0 + 0.1 * nrm(ks[15], (DEPTH, d), jnp.float32),
        'w_router': nrm(ks[16], (DEPTH, d, N_EXPERTS), jnp.float32) * d ** -0.5,
        'w_exp_gate': nrm(ks[17], (DEPTH, N_EXPERTS, d, EXPERT_DIM), jnp.float32) * d ** -0.5,
        'w_exp_up': nrm(ks[18], (DEPTH, N_EXPERTS, d, EXPERT_DIM), jnp.float32) * d ** -0.5,
        'w_exp_down': nrm(ks[19], (DEPTH, N_EXPERTS, EXPERT_DIM, d), jnp.float32) * EXPERT_DIM ** -0.5,
    }


def reference(x, c, ctx, c_ctx, w_mod, b_mod, norm1_w, w_in, na_q_norm, na_k_norm, na_rpb, hg_lb_logits, hg_norm, conv_w, w_out, norm2_w, w_router, w_exp_gate, w_exp_up, w_exp_down):
    n = x.shape[1]
    rope_cos, rope_sin = _rope_tables(n, x.dtype)
    lb = _hgrn_lower_bounds(hg_lb_logits)
    cx = ctx
    for l in range(DEPTH):
        need_ctx = l < DEPTH - 1
        m_lat = jnp.split(_adaln(c, w_mod[l], b_mod[l])[:, None, :], N_MOD, axis=-1)
        m_ctx = jnp.split(_adaln(c_ctx, w_mod[l], b_mod[l]), N_MOD, axis=-1)
        h = _modulate(_rmsnorm(x, norm1_w[l]), m_lat[0], m_lat[1])
        hc = _modulate(_rmsnorm(cx, norm1_w[l]), m_ctx[0], m_ctx[1])
        mix, mix_c = _token_mixers(h, hc, w_in[l], na_q_norm[l], na_k_norm[l], na_rpb[l], lb[0, l], lb[1, l], hg_norm[l], conv_w[l], rope_cos, rope_sin, need_ctx)
        x = x + m_lat[2] * jnp.einsum('btm,md->btd', mix, w_out[l])
        h2 = _modulate(_rmsnorm(x, norm2_w[l]), m_lat[3], m_lat[4])
        x = x + m_lat[5] * _expert_choice_ffn(h2, w_router[l], w_exp_gate[l], w_exp_up[l], w_exp_down[l])
        if need_ctx:
            cx = cx + m_ctx[2] * jnp.einsum('btm,md->btd', mix_c, w_out[l])
            hc2 = _modulate(_rmsnorm(cx, norm2_w[l]), m_ctx[3], m_ctx[4])
            cx = cx + m_ctx[5] * _expert_choice_ffn(hc2, w_router[l], w_exp_gate[l], w_exp_up[l], w_exp_down[l])
    return x
```

```cpp
#ifndef CPU_SIM
#include <hip/hip_runtime.h>
#define BODY __device__ __forceinline__
#define FSIN(x) __sinf(x)
#define FCOS(x) __cosf(x)
#else
#include <cmath>
#include <cstdio>
#include <cstdlib>
#include <cstring>
#define BODY static inline
#define FSIN(x) sinf(x)
#define FCOS(x) cosf(x)
#endif
#include <stdint.h>
#include <stddef.h>

#ifndef CFG_D
#define CFG_D 1024
#define CFG_SEQ 16384
#define CFG_CTX 256
#define CFG_EDIM 512
#define CFG_DEPTH 4
#endif

typedef unsigned short bf16_t;

constexpr int D = CFG_D, NB = 2, SEQ = CFG_SEQ, DEPTH = CFG_DEPTH, GW = 64, ROWS = SEQ / GW, CTX = CFG_CTX;
constexpr int HD = 64, NAH = 6, HGH = 6, CVD = 256, MIXD = 1024, INC = 3840, NMOD = 6 * D;
constexpr int NE = 16, ED = CFG_EDIM, CAPL = 2 * SEQ / NE, CAPC = 2 * CTX / NE;
constexpr int NLAT = NB * SEQ, NCTX = NB * CTX, NTOK = NLAT + NCTX;
constexpr int NSLOT_L = NB * NE * CAPL, NSLOT_C = NB * NE * CAPC, NSLOT = NSLOT_L + NSLOT_C;
constexpr int OQ = 0, OK_ = 384, OV = 768, OHQ = 1152, OFF_ = 1536, OFB = 1920, OHI = 2304, OHG_ = 2688, OCB = 3072, OCC = 3328, OCU = 3584;
constexpr float EPS = 1e-6f;
constexpr int NCH = (CTX + SEQ) / 64, NCHC = CTX / 64, NBH = NB * HGH;

struct Params {
    const float *x, *c, *ctx, *c_ctx, *w_mod, *b_mod, *norm1_w, *w_in, *q_norm, *k_norm, *rpb, *lb_logits, *hg_norm, *conv_w, *w_out,
        *norm2_w, *w_router, *w_gate, *w_up, *w_down;
    float *XL, *XC, *MOD, *LB, *AFF, *SVAL, *FG, *OHG;
    bf16_t *H, *P, *MIX, *HID, *Y;
    int *STOK, *INV;
    bf16_t *WIN_T, *WOUT_T, *WGU_T, *WD_T;
    unsigned* CTL;
    bf16_t* SLOC;
    float* GDEC;
};

#ifndef CPU_SIM
#define AS4 __attribute__((address_space(4)))
typedef const AS4 Params& PRef;
#else
typedef const Params& PRef;
#endif
BODY float bf2f(bf16_t v) { return __builtin_bit_cast(float, (unsigned)v << 16); }
BODY bf16_t f2bf(float f) { unsigned u = __builtin_bit_cast(unsigned, f); u += 0x7fffu + ((u >> 16) & 1u); return (bf16_t)(u >> 16); }
BODY float silu_f(float x) { return x / (1.f + expf(-x)); }
BODY float sigmoid_f(float x) { return 1.f / (1.f + expf(-x)); }
BODY int modset(int r) { return r < NLAT ? r / SEQ : 2; }
BODY float* xrow(PRef p, int r) { return r < NLAT ? p.XL + (size_t)r * D : p.XC + (size_t)(r - NLAT) * D; }

BODY void b_adaln(long gid, PRef p, int) {
    const int n = (int)(gid % NMOD), s = (int)((gid / NMOD) % 3), l = (int)(gid / (3 * NMOD));
    const float* cv = s < 2 ? p.c + s * D : p.c_ctx;
    const float* w = p.w_mod + (size_t)l * D * NMOD + n;
    float acc = 0.f;
    for (int k = 0; k < D; ++k) acc += silu_f(cv[k]) * w[(size_t)k * NMOD];
    p.MOD[gid] = acc + p.b_mod[l * NMOD + n];
}
BODY void b_lb(long gid, PRef p, int) {
    const int dir = (int)(gid / 384), j = (int)(gid % 384);
    const float* lg = p.lb_logits + (size_t)dir * DEPTH * 384 + j;
    float m = -INFINITY;
    for (int l = 0; l < DEPTH; ++l) m = fmaxf(m, lg[l * 384]);
    float s = 0.f;
    for (int l = 0; l < DEPTH; ++l) s += expf(lg[l * 384] - m);
    float cum = 0.f;
    p.LB[(dir * DEPTH + 0) * 384 + j] = 0.f;
    for (int l = 1; l < DEPTH; ++l) { cum += expf(lg[l * 384] - m) / s; p.LB[(dir * DEPTH + l) * 384 + j] = cum; }
}
BODY void b_copyx(long gid, PRef p, int) {
    if (gid < (long)NLAT * D) p.XL[gid] = p.x[gid]; else p.XC[gid - (long)NLAT * D] = p.ctx[gid - (long)NLAT * D];
}
template <int WHICH> BODY void b_prenorm(long gid, PRef p, int l) {
    const int r = (int)gid;
    const float* xr = xrow(p, r);
    const float* nw = (WHICH ? p.norm2_w : p.norm1_w) + l * D;
    const float* mod = p.MOD + ((size_t)l * 3 + modset(r)) * NMOD;
    const float* shift = mod + (WHICH ? 3 : 0) * D;
    const float* scale = mod + (WHICH ? 4 : 1) * D;
    float ss = 0.f;
    for (int k = 0; k < D; ++k) ss += xr[k] * xr[k];
    const float rstd = 1.f / sqrtf(ss / D + EPS);
    float lg[NE];
#pragma unroll
    for (int e = 0; e < NE; ++e) lg[e] = 0.f;
    for (int k = 0; k < D; ++k) {
        const float h = xr[k] * rstd * nw[k] * (1.f + scale[k]) + shift[k];
        p.H[(size_t)r * D + k] = f2bf(h);
        if (WHICH) {
            const float* wr = p.w_router + ((size_t)l * D + k) * NE;
#pragma unroll
            for (int e = 0; e < NE; ++e) lg[e] += h * wr[e];
        }
    }
    if (WHICH) {
        float m = lg[0];
#pragma unroll
        for (int e = 1; e < NE; ++e) m = fmaxf(m, lg[e]);
        float s = 0.f;
#pragma unroll
        for (int e = 0; e < NE; ++e) { lg[e] = expf(lg[e] - m); s += lg[e]; }
#pragma unroll
        for (int e = 0; e < NE; ++e) p.AFF[(size_t)r * NE + e] = lg[e] / s;
    }
}
BODY void b_gemm_in(long gid, PRef p, int l) {
    const int r = (int)(gid / (INC / 4)), n = (int)(gid % (INC / 4)) * 4;
    const bf16_t* a = p.H + (size_t)r * D;
    const float* w = p.w_in + (size_t)l * D * INC + n;
    float a0 = 0.f, a1 = 0.f, a2 = 0.f, a3 = 0.f;
    for (int k = 0; k < D; ++k) { const float av = bf2f(a[k]); const float* wk = w + (size_t)k * INC; a0 += av * wk[0]; a1 += av * wk[1]; a2 += av * wk[2]; a3 += av * wk[3]; }
    bf16_t* o = p.P + (size_t)r * INC + n;
    o[0] = f2bf(a0); o[1] = f2bf(a1); o[2] = f2bf(a2); o[3] = f2bf(a3);
}
BODY void b_qkprep(long gid, PRef p, int l) {
    const int r = (int)(gid / 12), which = (int)(gid % 12) / 6, head = (int)(gid % 6);
    bf16_t* ptr = p.P + (size_t)r * INC + (which ? OK_ : OQ) + head * HD;
    const float* nw = (which ? p.k_norm : p.q_norm) + l * HD;
    float y[HD];
    float ss = 0.f;
#pragma unroll
    for (int d = 0; d < HD; ++d) { y[d] = bf2f(ptr[d]); ss += y[d] * y[d]; }
    const float rstd = 1.f / sqrtf(ss / HD + EPS);
#pragma unroll
    for (int d = 0; d < HD; ++d) y[d] = y[d] * rstd * nw[d];
    if (r < NLAT) {
        const int t = r % SEQ; const float row = (float)(t / GW), col = (float)(t % GW);
#pragma unroll
        for (int d = 0; d < 16; ++d) {
            const float inv = powf(10000.f, -(float)d / 16.f);
            const float ar = row * inv, ac = col * inv;
            const float cr = FCOS(ar), sr = FSIN(ar), cc = FCOS(ac), sc = FSIN(ac);
            const float x0 = y[d], x1 = y[d + 16], x2 = y[d + 32], x3 = y[d + 48];
            y[d] = x0 * cr - x1 * sr; y[d + 16] = x1 * cr + x0 * sr; y[d + 32] = x2 * cc - x3 * sc; y[d + 48] = x3 * cc + x2 * sc;
        }
    }
#pragma unroll
    for (int d = 0; d < HD; ++d) ptr[d] = f2bf(y[d]);
}
BODY void b_attn(long gid, PRef p, int l) {
    const int r = (int)(gid / NAH), head = (int)(gid % NAH);
    float q[HD], acc[HD];
    const bf16_t* qp = p.P + (size_t)r * INC + OQ + head * HD;
#pragma unroll
    for (int d = 0; d < HD; ++d) { q[d] = bf2f(qp[d]) * 0.125f; acc[d] = 0.f; }
    float m = -INFINITY, s = 0.f;
    const int b = r < NLAT ? r / SEQ : (r - NLAT) / CTX;
    const int nloc = r < NLAT ? 128 : 0;
    int row = 0, col = 0, rs = 0, ws = 0;
    if (r < NLAT) { const int t = r % SEQ; row = t / GW; col = t % GW; rs = row - 4; rs = rs < 0 ? 0 : (rs > ROWS - 8 ? ROWS - 8 : rs); ws = col - 8; ws = ws < 0 ? 0 : (ws > GW - 16 ? GW - 16 : ws); }
    for (int j = 0; j < nloc + CTX; ++j) {
        int kr; float bias = 0.f;
        if (j < nloc) { const int i = j / 16, jj = j % 16; kr = b * SEQ + (rs + i) * GW + ws + jj; bias = p.rpb[(((size_t)l * NAH + head) * 15 + (rs + i - row + 7)) * 31 + (ws + jj - col + 15)]; }
        else kr = NLAT + b * CTX + (j - nloc);
        const bf16_t* kp = p.P + (size_t)kr * INC + OK_ + head * HD;
        const bf16_t* vp = p.P + (size_t)kr * INC + OV + head * HD;
        float sc = 0.f;
#pragma unroll
        for (int d = 0; d < HD; ++d) sc += q[d] * bf2f(kp[d]);
        sc += bias;
        const float mn = fmaxf(m, sc), corr = expf(m - mn), pj = expf(sc - mn);
        s = s * corr + pj;
#pragma unroll
        for (int d = 0; d < HD; ++d) acc[d] = acc[d] * corr + pj * bf2f(vp[d]);
        m = mn;
    }
    const float inv = 1.f / s;
    bf16_t* o = p.MIX + (size_t)r * MIXD + head * HD;
#pragma unroll
    for (int d = 0; d < HD; ++d) o[d] = f2bf(acc[d] * inv);
}
BODY void b_gates(long gid, PRef p, int l) {
    const int j = (int)(gid % 384), dir = (int)((gid / 384) % 2), r = (int)(gid / 768);
    const float z = bf2f(p.P[(size_t)r * INC + (dir ? OFB : OFF_) + j]);
    const float lbv = p.LB[(dir * DEPTH + l) * 384 + j];
    p.FG[gid] = lbv + (1.f - lbv) * sigmoid_f(z);
}
template <int DIR> BODY void b_hgrn_seq(long gid, PRef p, int) {
    const int v = (int)(gid % 64), h = (int)((gid / 64) % HGH), b = (int)(gid / (64 * HGH));
    float S[64];
#pragma unroll
    for (int k = 0; k < 64; ++k) S[k] = 0.f;
    for (int step = 0; step < CTX + SEQ; ++step) {
        int r;
        if (step < CTX) r = NLAT + b * CTX + (DIR ? CTX - 1 - step : step);
        else r = b * SEQ + (DIR ? SEQ - 1 - (step - CTX) : (step - CTX));
        const float vv = bf2f(p.P[(size_t)r * INC + OHI + h * 64 + v]);
        const float* fr = p.FG + ((size_t)r * 2 + DIR) * 384 + h * 64;
        const bf16_t* qr = p.P + (size_t)r * INC + OHQ + h * 64;
        float o = 0.f;
#pragma unroll
        for (int k = 0; k < 64; ++k) { const float f = fr[k]; S[k] = f * S[k] + (1.f - f) * vv; o += S[k] * bf2f(qr[k]); }
        o *= 0.125f;
        p.OHG[((size_t)DIR * NTOK + r) * 384 + h * 64 + v] = o;
    }
}
BODY void b_hgfin(long gid, PRef p, int l) {
    const int r = (int)(gid / HGH), h = (int)(gid % HGH);
    const float* op = p.OHG + (size_t)r * 384 + h * 64;
    const float* op1 = op + (size_t)NTOK * 384;
    float o[64]; float ss = 0.f;
#pragma unroll
    for (int v = 0; v < 64; ++v) { o[v] = op[v] + op1[v]; ss += o[v] * o[v]; }
    const float rstd = 1.f / sqrtf(ss / 64.f + EPS);
    const bf16_t* g = p.P + (size_t)r * INC + OHG_ + h * 64;
    bf16_t* out = p.MIX + (size_t)r * MIXD + 384 + h * 64;
#pragma unroll
    for (int v = 0; v < 64; ++v) out[v] = f2bf(o[v] * rstd * p.hg_norm[l * 64 + v] * silu_f(bf2f(g[v])));
}
BODY void b_conv(long gid, PRef p, int l) {
    const int ch = (int)(gid % CVD), r = (int)(gid / CVD);
    int t, T;
    if (r < NLAT) { t = r % SEQ; T = SEQ; } else { t = (r - NLAT) % CTX; T = CTX; }
    const float* w = p.conv_w + (size_t)l * 3 * CVD + ch;
    float y = 0.f;
    for (int j = 0; j < 3; ++j) {
        const int tt = t + j - 1;
        if (tt < 0 || tt >= T) continue;
        const bf16_t* pr = p.P + (size_t)(r + j - 1) * INC;
        y += w[j * CVD] * bf2f(pr[OCC + ch]) * bf2f(pr[OCU + ch]);
    }
    p.MIX[(size_t)r * MIXD + 768 + ch] = f2bf(bf2f(p.P[(size_t)r * INC + OCB + ch]) * y);
}
BODY void b_gemm_out(long gid, PRef p, int l) {
    const int r = (int)(gid / (D / 4)), n = (int)(gid % (D / 4)) * 4;
    const bf16_t* a = p.MIX + (size_t)r * MIXD;
    const float* w = p.w_out + (size_t)l * MIXD * D + n;
    float a0 = 0.f, a1 = 0.f, a2 = 0.f, a3 = 0.f;
    for (int k = 0; k < MIXD; ++k) { const float av = bf2f(a[k]); const float* wk = w + (size_t)k * D; a0 += av * wk[0]; a1 += av * wk[1]; a2 += av * wk[2]; a3 += av * wk[3]; }
    const float* g = p.MOD + ((size_t)l * 3 + modset(r)) * NMOD + 2 * D + n;
    float* xr = xrow(p, r) + n;
    xr[0] += g[0] * a0; xr[1] += g[1] * a1; xr[2] += g[2] * a2; xr[3] += g[3] * a3;
}
BODY void b_rank(long gid, PRef p, int) {
    const int e = (int)(gid % NE), r = (int)(gid / NE);
    int t, T, row0, cap, base;
    if (r < NLAT) { const int b = r / SEQ; t = r % SEQ; T = SEQ; row0 = b * SEQ; cap = CAPL; base = (b * NE + e) * CAPL; }
    else { const int b = (r - NLAT) / CTX; t = (r - NLAT) % CTX; T = CTX; row0 = NLAT + b * CTX; cap = CAPC; base = NSLOT_L + (b * NE + e) * CAPC; }
    const float a = p.AFF[(size_t)r * NE + e];
    const float* col = p.AFF + (size_t)row0 * NE + e;
    int rank = 0;
    for (int tt = 0; tt < T; ++tt) { const float o = col[(size_t)tt * NE]; rank += (o > a || (o == a && tt < t)) ? 1 : 0; }
    if (rank < cap) { p.STOK[base + rank] = r; p.SVAL[base + rank] = a; p.INV[(size_t)r * NE + e] = base + rank; }
    else p.INV[(size_t)r * NE + e] = -1;
}
BODY int slot_expert(int s) { return s < NSLOT_L ? (s / CAPL) % NE : ((s - NSLOT_L) / CAPC) % NE; }
BODY void b_moe1(long gid, PRef p, int l) {
    const int s = (int)(gid / (ED / 4)), f = (int)(gid % (ED / 4)) * 4;
    const int e = slot_expert(s); int row = p.STOK[s]; row = row < 0 ? 0 : (row >= NTOK ? NTOK - 1 : row);
    const bf16_t* a = p.H + (size_t)row * D;
    const float* wg = p.w_gate + ((size_t)l * NE + e) * D * ED + f;
    const float* wu = p.w_up + ((size_t)l * NE + e) * D * ED + f;
    float g0 = 0.f, g1 = 0.f, g2 = 0.f, g3 = 0.f, u0 = 0.f, u1 = 0.f, u2 = 0.f, u3 = 0.f;
    for (int k = 0; k < D; ++k) {
        const float av = bf2f(a[k]); const float* gk = wg + (size_t)k * ED; const float* uk = wu + (size_t)k * ED;
        g0 += av * gk[0]; g1 += av * gk[1]; g2 += av * gk[2]; g3 += av * gk[3];
        u0 += av * uk[0]; u1 += av * uk[1]; u2 += av * uk[2]; u3 += av * uk[3];
    }
    bf16_t* o = p.HID + (size_t)s * ED + f;
    o[0] = f2bf(silu_f(g0) * u0); o[1] = f2bf(silu_f(g1) * u1); o[2] = f2bf(silu_f(g2) * u2); o[3] = f2bf(silu_f(g3) * u3);
}
BODY void b_moe2(long gid, PRef p, int l) {
    const int s = (int)(gid / (D / 4)), n = (int)(gid % (D / 4)) * 4;
    const int e = slot_expert(s);
    const bf16_t* a = p.HID + (size_t)s * ED;
    const float* w = p.w_down + ((size_t)l * NE + e) * ED * D + n;
    float a0 = 0.f, a1 = 0.f, a2 = 0.f, a3 = 0.f;
    for (int k = 0; k < ED; ++k) { const float av = bf2f(a[k]); const float* wk = w + (size_t)k * D; a0 += av * wk[0]; a1 += av * wk[1]; a2 += av * wk[2]; a3 += av * wk[3]; }
    const float val = p.SVAL[s];
    bf16_t* o = p.Y + (size_t)s * D + n;
    o[0] = f2bf(val * a0); o[1] = f2bf(val * a1); o[2] = f2bf(val * a2); o[3] = f2bf(val * a3);
}
BODY void b_combine(long gid, PRef p, int l) {
    const int r = (int)(gid / (D / 4)), n = (int)(gid % (D / 4)) * 4;
    float a0 = 0.f, a1 = 0.f, a2 = 0.f, a3 = 0.f;
    for (int e = 0; e < NE; ++e) {
        const int s = p.INV[(size_t)r * NE + e];
        if (s >= 0) { const bf16_t* y = p.Y + (size_t)s * D + n; a0 += bf2f(y[0]); a1 += bf2f(y[1]); a2 += bf2f(y[2]); a3 += bf2f(y[3]); }
    }
    const float* g = p.MOD + ((size_t)l * 3 + modset(r)) * NMOD + 5 * D + n;
    float* xr = xrow(p, r) + n;
    xr[0] += g[0] * a0; xr[1] += g[1] * a1; xr[2] += g[2] * a2; xr[3] += g[3] * a3;
}


#ifndef HGRN_DIAG
#define HGRN_DIAG 0
#endif
BODY void b_hgrn_chunkseq(long gid, PRef p, int l) {
    const int v = (int)(gid % 64), pc = (int)((gid / 64) % NCH), bh = (int)((gid / (64 * NCH)) % NBH), dir = (int)(gid / (64L * NCH * NBH));
    const int h = bh % HGH, b = bh / HGH, row0 = pc < NCHC ? NLAT + b * CTX + pc * 64 : b * SEQ + (pc - NCHC) * 64;
    const bf16_t* sin = p.SLOC + ((size_t)(dir * NBH + bh) * NCH + pc) * 4096 + v * 64;
    float S[64];
#pragma unroll
    for (int k = 0; k < 64; ++k) S[k] = bf2f(sin[k]);
    for (int i = 0; i < 64; ++i) {
        const int r = row0 + (dir ? 63 - i : i);
        const float vv = bf2f(p.P[(size_t)r * INC + OHI + h * 64 + v]);
        const bf16_t* zr = p.P + (size_t)r * INC + (dir ? OFB : OFF_) + h * 64;
        const bf16_t* qr = p.P + (size_t)r * INC + OHQ + h * 64;
        const float* lb = p.LB + (size_t)(dir * DEPTH + l) * 384 + h * 64;
        float o = 0.f;
#pragma unroll
        for (int k = 0; k < 64; ++k) { const float f = lb[k] + (1.f - lb[k]) * sigmoid_f(bf2f(zr[k])); S[k] = f * S[k] + (1.f - f) * vv; o += S[k] * bf2f(qr[k]); }
        p.OHG[((size_t)dir * NTOK + r) * 384 + h * 64 + v] = o * 0.125f;
    }
}

BODY void b_hgrn_scan_slow(long gid, PRef p, int) {
    const int e = (int)(gid % 4096), sq = (int)(gid / 4096), dir = sq / NBH, k = e & 63;
    bf16_t* S = p.SLOC + (size_t)sq * NCH * 4096 + e;
    const float* G = p.GDEC + (size_t)sq * NCH * 64 + k;
    float c = 0.f;
    for (int j = 0; j < NCH; ++j) {
        const int pc = dir ? (j < NCHC ? NCHC - 1 - j : NCH + NCHC - 1 - j) : j;
        const float x = bf2f(S[(size_t)pc * 4096]);
        S[(size_t)pc * 4096] = f2bf(c);
        c = G[(size_t)pc * 64] * c + x;
    }
}

BODY void b_hgrn_local_slow(long gid, PRef p, int l) {
    const int v = (int)(gid % 64), pc = (int)((gid / 64) % NCH), bh = (int)((gid / (64 * NCH)) % NBH), dir = (int)(gid / (64L * NCH * NBH));
    const int h = bh % HGH, b = bh / HGH, row0 = pc < NCHC ? NLAT + b * CTX + pc * 64 : b * SEQ + (pc - NCHC) * 64;
    float S[64], g[64];
#pragma unroll
    for (int k = 0; k < 64; ++k) { S[k] = 0.f; g[k] = 1.f; }
    for (int i = 0; i < 64; ++i) {
        const int r = row0 + (dir ? 63 - i : i);
        const float vv = bf2f(p.P[(size_t)r * INC + OHI + h * 64 + v]);
        const bf16_t* zr = p.P + (size_t)r * INC + (dir ? OFB : OFF_) + h * 64;
        const float* lb = p.LB + (size_t)(dir * DEPTH + l) * 384 + h * 64;
#pragma unroll
        for (int k = 0; k < 64; ++k) { const float f = lb[k] + (1.f - lb[k]) * sigmoid_f(bf2f(zr[k])); S[k] = f * S[k] + (1.f - f) * vv; g[k] *= f; }
    }
    bf16_t* dst = p.SLOC + ((size_t)(dir * NBH + bh) * NCH + pc) * 4096 + v * 64;
    if (HGRN_DIAG != 3 && HGRN_DIAG != 4) {
#pragma unroll
    for (int k = 0; k < 64; ++k) dst[k] = f2bf(S[k]);
    }
    if (v == 0) {
        float* gd = p.GDEC + ((size_t)(dir * NBH + bh) * NCH + pc) * 64;
#pragma unroll
        for (int k = 0; k < 64; ++k) gd[k] = g[k];
    }
}
#ifndef FAST_TOPK
#define FAST_TOPK 1
#endif
#ifndef FAST_HGRN
#define FAST_HGRN 1
#endif
#ifndef FAST_ATTN
#define FAST_ATTN 1
#endif
constexpr size_t al256(size_t x) { return (x + 255) & ~(size_t)255; }
constexpr size_t CTL_BYTES = 65536;
constexpr size_t WS_CTL = 0;
constexpr size_t WS_MOD = WS_CTL + CTL_BYTES;
constexpr size_t WS_LB = WS_MOD + al256((size_t)DEPTH * 3 * NMOD * 4);
constexpr size_t WS_XC = WS_LB + al256((size_t)2 * DEPTH * 384 * 4);
constexpr size_t WS_AFF = WS_XC + al256((size_t)NCTX * D * 4);
constexpr size_t WS_SVAL = WS_AFF + al256((size_t)NTOK * NE * 4);
constexpr size_t WS_STOK = WS_SVAL + al256((size_t)NSLOT * 4);
constexpr size_t WS_INV = WS_STOK + al256((size_t)NSLOT * 4);
constexpr size_t WS_H = WS_INV + al256((size_t)NTOK * NE * 4);
constexpr size_t WS_MIX = WS_H + al256((size_t)NTOK * D * 2);
constexpr size_t WS_P = WS_MIX + al256((size_t)NTOK * MIXD * 2);
constexpr size_t WS_HID = WS_P;
constexpr size_t WS_Y = WS_HID + al256((size_t)NSLOT * ED * 2);
constexpr size_t WS_P_END0 = WS_P + al256((size_t)NTOK * INC * 2);
constexpr size_t WS_P_END1 = WS_Y + al256((size_t)NSLOT * D * 2);
constexpr size_t WS_WB = WS_P_END0 > WS_P_END1 ? WS_P_END0 : WS_P_END1;
constexpr size_t WS_WIN_T = WS_WB;
constexpr size_t WS_WOUT_T = WS_WIN_T + al256((size_t)INC * D * 2);
constexpr size_t WS_WGU_T = WS_WOUT_T + al256((size_t)D * MIXD * 2);
constexpr size_t WS_WD_T = WS_WGU_T + al256((size_t)NE * 2 * ED * D * 2);
constexpr size_t WS_T = WS_WD_T + al256((size_t)NE * D * ED * 2);
#if FAST_HGRN
constexpr size_t WS_SLOC = WS_T;
constexpr size_t WS_GDEC = WS_SLOC + al256((size_t)2 * NBH * NCH * 4096 * 2);
constexpr size_t WS_OHG = WS_GDEC + al256((size_t)2 * NBH * NCH * 64 * 4);
constexpr size_t WS_END = WS_OHG + (HGRN_DIAG ? al256((size_t)2 * NTOK * 384 * 4) : 0);
constexpr size_t WS_FG = WS_T;
#else
constexpr size_t WS_FG = WS_T;
constexpr size_t WS_OHG = WS_FG + al256((size_t)NTOK * 768 * 4);
constexpr size_t WS_SLOC = WS_OHG + al256((size_t)2 * NTOK * 384 * 4);
constexpr size_t WS_GDEC = WS_SLOC;
constexpr size_t WS_END = WS_SLOC;
#endif

static inline Params make_params(void* const* d_in, void* d_out, void* d_ws) {
    Params p{};
    const float** f = (const float**)&p;
    for (int i = 0; i < 20; ++i) f[i] = (const float*)d_in[i];
    char* ws = (char*)d_ws;
    p.XL = (float*)d_out; p.XC = (float*)(ws + WS_XC); p.MOD = (float*)(ws + WS_MOD); p.LB = (float*)(ws + WS_LB); p.AFF = (float*)(ws + WS_AFF);
    p.SVAL = (float*)(ws + WS_SVAL); p.FG = (float*)(ws + WS_FG); p.OHG = (float*)(ws + WS_OHG);
    p.H = (bf16_t*)(ws + WS_H); p.P = (bf16_t*)(ws + WS_P); p.MIX = (bf16_t*)(ws + WS_MIX); p.HID = (bf16_t*)(ws + WS_HID); p.Y = (bf16_t*)(ws + WS_Y);
    p.STOK = (int*)(ws + WS_STOK); p.INV = (int*)(ws + WS_INV);
    p.WIN_T = (bf16_t*)(ws + WS_WIN_T); p.WOUT_T = (bf16_t*)(ws + WS_WOUT_T); p.WGU_T = (bf16_t*)(ws + WS_WGU_T); p.WD_T = (bf16_t*)(ws + WS_WD_T);
    p.CTL = (unsigned*)(ws + WS_CTL); p.SLOC = (bf16_t*)(ws + WS_SLOC); p.GDEC = (float*)(ws + WS_GDEC);
    return p;
}

#define FORWARD_STAGES(STAGE)                                                      \
    STAGE(b_adaln, (long)DEPTH * 3 * NMOD, 0)                                      \
    STAGE(b_lb, 2L * 384, 0)                                                       \
    STAGE(b_copyx, (long)NTOK * D, 0)                                              \
    for (int l = 0; l < DEPTH; ++l) {                                              \
        STAGE(b_prenorm<0>, (long)NTOK, l)                                         \
        STAGE(b_gemm_in, (long)NTOK * (INC / 4), l)                                \
        STAGE(b_qkprep, (long)NTOK * 12, l)                                        \
        STAGE(b_attn, (long)NTOK * NAH, l)                                         \
        STAGE(b_gates, (long)NTOK * 768, l)                                        \
        STAGE(b_hgrn_seq<0>, (long)NB * HGH * 64, l)                               \
        STAGE(b_hgrn_seq<1>, (long)NB * HGH * 64, l)                               \
        STAGE(b_hgfin, (long)NTOK * HGH, l)                                        \
        STAGE(b_conv, (long)NTOK * CVD, l)                                         \
        STAGE(b_gemm_out, (long)NTOK * (D / 4), l)                                 \
        STAGE(b_prenorm<1>, (long)NTOK, l)                                         \
        STAGE(b_rank, (long)NTOK * NE, l)                                          \
        STAGE(b_moe1, (long)NSLOT * (ED / 4), l)                                   \
        STAGE(b_moe2, (long)NSLOT * (D / 4), l)                                    \
        STAGE(b_combine, (long)NTOK * (D / 4), l)                                  \
    }

#ifndef CPU_SIM
#include <cstdio>
#define LAS __attribute__((address_space(3)))
#define GAS __attribute__((address_space(1)))
typedef short bf16x8 __attribute__((ext_vector_type(8)));
typedef float f32x4 __attribute__((ext_vector_type(4)));
typedef float f32x2 __attribute__((ext_vector_type(2)));
typedef unsigned u32x4 __attribute__((ext_vector_type(4)));
typedef unsigned u32x2 __attribute__((ext_vector_type(2)));
constexpr int NWAVES = 8, NTHR = 512;
constexpr int RING_BYTES = 131072, LDSCTL_OFF = RING_BYTES, MISC_OFF = LDSCTL_OFF + 320, TAB_OFF = LDSCTL_OFF + 1024  , LDS_BYTES = 147456;

typedef __bf16 bf16v2_t __attribute__((ext_vector_type(2)));
__device__ __forceinline__ unsigned cvt_pk_bf16_asm(float lo, float hi) { unsigned r; asm volatile("v_cvt_pk_bf16_f32 %0, %1, %2" : "=v"(r) : "v"(lo), "v"(hi)); return r; }
__device__ __forceinline__ unsigned cvt_pk_bf16(float lo, float hi) { bf16v2_t v = {(__bf16)lo, (__bf16)hi}; return __builtin_bit_cast(unsigned, v); }
__device__ __forceinline__ float wave_sum(float v, int lane) {
    v += __builtin_bit_cast(float, __builtin_amdgcn_ds_swizzle(__builtin_bit_cast(int, v), (1 << 10) | 0x1f));
    v += __builtin_bit_cast(float, __builtin_amdgcn_ds_swizzle(__builtin_bit_cast(int, v), (2 << 10) | 0x1f));
    v += __builtin_bit_cast(float, __builtin_amdgcn_ds_swizzle(__builtin_bit_cast(int, v), (4 << 10) | 0x1f));
    v += __builtin_bit_cast(float, __builtin_amdgcn_ds_swizzle(__builtin_bit_cast(int, v), (8 << 10) | 0x1f));
    v += __builtin_bit_cast(float, __builtin_amdgcn_ds_swizzle(__builtin_bit_cast(int, v), (16 << 10) | 0x1f));
    v += __builtin_bit_cast(float, __builtin_amdgcn_ds_bpermute((lane ^ 32) << 2, __builtin_bit_cast(int, v)));
    return v;
}

extern __shared__ __attribute__((aligned(16))) unsigned char lds_raw[];
#ifndef FUSE_QK
#define FUSE_QK 1
#endif
namespace pg8 {
constexpr int BM = 256, BK = 64, HALF = 128, HTB = HALF * BK * 2, STAGE_BYTES = 8 * HTB, NXCD = 8, WGM = 8;
__device__ __forceinline__ int lds_byte(int r, int c) { const int st = (r >> 4) * 2 + (c >> 5), rr = r & 15, cc = c & 31, ob = rr * 64 + cc * 2; return st * 1024 + (ob ^ (((ob >> 9) & 1) << 5)); }
__device__ __forceinline__ void stage_rc(int b, int& R, int& C) { const int st = b / 1024, sb = b % 1024, swz = sb ^ (((sb >> 9) & 1) << 5); R = (st >> 1) * 16 + swz / 64; C = (st & 1) * 32 + (swz % 64) / 2; }
__device__ __forceinline__ int perm32(int rho) { const int n = rho >> 4, i = rho & 15; return 8 * (i >> 2) + 4 * n + (i & 3); }
struct Unit { int pm, pn; };
struct Gemm {
    const bf16_t* A; const bf16_t* Bt; int M, N, K;
    const int* gather;
    int gt, ng; size_t gstride;
};
struct StaticOrder {
    int nM, nN, nwg, G, c;
    __device__ void init(int M, int N, int G_, int c_) { nM = M / BM; nN = N / BM; nwg = nM * nN; G = G_; c = c_; }
    __device__ bool next(int i, Unit& u) const {
        const long L = (long)i * G + c; if (L >= nwg) return false;
        int wgid = (int)L; { const int q = nwg / NXCD, r = nwg % NXCD, xcd = wgid % NXCD, off = wgid / NXCD; wgid = (xcd < r ? xcd * (q + 1) : r * (q + 1) + (xcd - r) * q) + off; }
        const int nig = WGM * nN, gid = wgid / nig, fm = gid * WGM, gsz = (nM - fm) < WGM ? (nM - fm) : WGM;
        u.pm = fm + ((wgid % nig) % gsz); u.pn = (wgid % nig) / gsz; return true;
    }
};
struct EpiBf16 {
    static constexpr bool PERM = true;
    bf16_t* O; int ldc; const float* rowscale; int skip;
    __device__ __forceinline__ void operator()(const f32x4 (&acc)[2][2][4][2], const Unit& u, int wr, int wc, int fr, int fq) const {
        const int row0 = u.pm * BM + wr * 64 + fr, col0 = u.pn * BM + wc * 32 + 8 * fq;
        if (skip) { asm volatile("" :: "v"(acc[0][0][0][0]), "v"(acc[1][1][3][1])); return; }
#pragma unroll
        for (int ai = 0; ai < 2; ++ai)
#pragma unroll
            for (int m = 0; m < 4; ++m) { const int row = row0 + ai * HALF + m * 16; bf16_t* rowp = O + (size_t)row * ldc + col0; const float sc = rowscale ? rowscale[row] : 1.f;
#pragma unroll
                for (int bj = 0; bj < 2; ++bj) { const f32x4 v0 = acc[ai][bj][m][0] * sc, v1 = acc[ai][bj][m][1] * sc;
                    u32x4 w; w.x = cvt_pk_bf16_asm(v0[0], v0[1]); w.y = cvt_pk_bf16_asm(v0[2], v0[3]); w.z = cvt_pk_bf16_asm(v1[0], v1[1]); w.w = cvt_pk_bf16_asm(v1[2], v1[3]);
                    *(u32x4*)(rowp + bj * HALF) = w; } }
    }
};
struct EpiP {
    static constexpr bool PERM = true;
    bf16_t* O; int ldc; const float* qn; const float* kn; int skip;
    __device__ __forceinline__ void operator()(const f32x4 (&acc)[2][2][4][2], const Unit& u, int wr, int wc, int fr, int fq) const {
        const int row0 = u.pm * BM + wr * 64 + fr, col0 = u.pn * BM + wc * 32 + 8 * fq;
        if (skip) { asm volatile("" :: "v"(acc[0][0][0][0]), "v"(acc[1][1][3][1])); return; }
        if (u.pn >= 3 || !FUSE_QK) {
#pragma unroll
            for (int ai = 0; ai < 2; ++ai)
#pragma unroll
                for (int m = 0; m < 4; ++m) { bf16_t* rowp = O + (size_t)(row0 + ai * HALF + m * 16) * ldc + col0;
#pragma unroll
                    for (int bj = 0; bj < 2; ++bj) { const f32x4 v0 = acc[ai][bj][m][0], v1 = acc[ai][bj][m][1];
                        u32x4 w; w.x = cvt_pk_bf16_asm(v0[0], v0[1]); w.y = cvt_pk_bf16_asm(v0[2], v0[3]); w.z = cvt_pk_bf16_asm(v1[0], v1[1]); w.w = cvt_pk_bf16_asm(v1[2], v1[3]);
                        *(u32x4*)(rowp + bj * HALF) = w; } }
            return;
        }
        LAS float* PS = (LAS float*)((LAS unsigned char*)lds_raw + LDSCTL_OFF + 4096);
        const int half = wc & 1, hw = wc >> 1;
        unsigned lm_ = ~0u; asm volatile("" : "+s"(lm_)); const int lane = (int)__builtin_amdgcn_mbcnt_hi(lm_, __builtin_amdgcn_mbcnt_lo(lm_, 0u));
#pragma unroll
        for (int ai = 0; ai < 2; ++ai)
#pragma unroll
            for (int m = 0; m < 4; ++m)
#pragma unroll
                for (int bj = 0; bj < 2; ++bj) { const f32x4 v0 = acc[ai][bj][m][0], v1 = acc[ai][bj][m][1];
                    float s = (v0[0] * v0[0] + v0[1] * v0[1]) + (v0[2] * v0[2] + v0[3] * v0[3]) + (v1[0] * v1[0] + v1[1] * v1[1]) + (v1[2] * v1[2] + v1[3] * v1[3]);
                    s += __builtin_bit_cast(float, __builtin_amdgcn_ds_swizzle(__builtin_bit_cast(int, s), (16 << 10) | 0x1f));
                    s += __builtin_bit_cast(float, __builtin_amdgcn_ds_bpermute((lane ^ 32) << 2, __builtin_bit_cast(int, s)));
                    if (fq == 0) PS[((ai * HALF + wr * 64 + m * 16 + fr) * 4 + 2 * bj + hw) * 2 + half] = s; }
        asm volatile("s_waitcnt lgkmcnt(0)" ::: "memory"); __builtin_amdgcn_s_barrier(); asm volatile("" ::: "memory");
        float invf[8];
#pragma unroll
        for (int j = 0; j < 8; ++j) invf[j] = __builtin_amdgcn_exp2f(-(float)(8 * (fq & 1) + j) * (13.287712379549449f / 16.f));
        const bool second = (fq & 2) != 0;
#pragma unroll
        for (int ai = 0; ai < 2; ++ai)
#pragma unroll
            for (int m = 0; m < 4; ++m) {
                const int grow = row0 + ai * HALF + m * 16; const bool lat = grow < NLAT; const int t = lat ? grow % SEQ : 0;
                int tp = half ? t % GW : t / GW; asm volatile("" : "+v"(tp));
                const float pos = (float)tp;
                float cs[8], sn[8];
#pragma unroll
                for (int j = 0; j < 8; ++j) { const float ang = pos * invf[j]; cs[j] = __cosf(ang); sn[j] = __sinf(ang); }
                bf16_t* rowp = O + (size_t)grow * ldc + col0;
#pragma unroll
                for (int bj = 0; bj < 2; ++bj) {
                    const int rl = ai * HALF + wr * 64 + m * 16 + fr, head = 2 * bj + hw;
                    const float ssq = PS[(rl * 4 + head) * 2] + PS[(rl * 4 + head) * 2 + 1];
                    const bool isk = (u.pn * BM + bj * HALF + wc * 32) >= 384;
                    const float rstd = (isk ? 1.f : 0.125f * 1.44269504089f) / sqrtf(ssq * (1.f / HD) + EPS);
                    const float* nw = (isk ? kn : qn) + 32 * half + 8 * fq;
                    const f32x4 n0 = *(const f32x4*)nw, n1 = *(const f32x4*)(nw + 4);
                    float y[8];
#pragma unroll
                    for (int j = 0; j < 4; ++j) { y[j] = acc[ai][bj][m][0][j] * rstd * n0[j]; y[4 + j] = acc[ai][bj][m][1][j] * rstd * n1[j]; }
#pragma unroll
                    for (int j = 0; j < 8; ++j) {
                        const unsigned yb = __builtin_bit_cast(unsigned, y[j]);
                        const auto sw = __builtin_amdgcn_permlane32_swap(yb, yb, false, false);
                        const float other = __builtin_bit_cast(float, lane < 32 ? sw[1] : sw[0]);
                        const float rot = second ? y[j] * cs[j] + other * sn[j] : y[j] * cs[j] - other * sn[j];
                        y[j] = lat ? rot : y[j];
                    }
                    u32x4 w; w.x = cvt_pk_bf16(y[0], y[1]); w.y = cvt_pk_bf16(y[2], y[3]); w.z = cvt_pk_bf16(y[4], y[5]); w.w = cvt_pk_bf16(y[6], y[7]);
                    *(u32x4*)(rowp + bj * HALF) = w;
                }
                asm volatile("" ::: "memory");
            }
    }
};
struct EpiRes {
    static constexpr bool PERM = false;
    float* X; const float* Xin; int ldc; const float* gate0; int rows_per_set; size_t set_stride;
    __device__ __forceinline__ void operator()(const f32x4 (&acc)[2][2][4][2], const Unit& u, int wr, int wc, int fr, int fq) const {
        const int row0 = u.pm * BM + wr * 64 + fr, col0 = u.pn * BM + wc * 32 + 4 * fq;
        const float* gate = gate0 + (size_t)((u.pm * BM) / rows_per_set) * set_stride;
        f32x4 gv[2][2];
#pragma unroll
        for (int bj = 0; bj < 2; ++bj)
#pragma unroll
            for (int n = 0; n < 2; ++n) gv[bj][n] = *(const f32x4*)(gate + col0 + bj * HALF + n * 16);
#pragma unroll
        for (int ai = 0; ai < 2; ++ai)
#pragma unroll
            for (int m = 0; m < 4; ++m) { const size_t ro = (size_t)(row0 + ai * HALF + m * 16) * ldc + col0; float* rowp = X + ro; const float* rowi = Xin + ro;
#pragma unroll
                for (int bj = 0; bj < 2; ++bj)
#pragma unroll
                    for (int n = 0; n < 2; ++n) { f32x4* q = (f32x4*)(rowp + bj * HALF + n * 16); *q = *(const f32x4*)(rowi + bj * HALF + n * 16) + gv[bj][n] * acc[ai][bj][m][n]; }
                if (m & 1) asm volatile("" ::: "memory"); }
    }
};
struct EpiHid {
    static constexpr bool PERM = false;
    bf16_t* O; int ldc;
    __device__ __forceinline__ void operator()(const f32x4 (&acc)[2][2][4][2], const Unit& u, int wr, int wc, int fr, int fq) const {
        const int row0 = u.pm * BM + wr * 64 + fr, col0 = (u.pn * BM + wc * 32) / 2 + 4 * fq;
#pragma unroll
        for (int ai = 0; ai < 2; ++ai)
#pragma unroll
            for (int m = 0; m < 4; ++m) { bf16_t* rowp = O + (size_t)(row0 + ai * HALF + m * 16) * ldc + col0;
#pragma unroll
                for (int bj = 0; bj < 2; ++bj) { const f32x4 g = acc[ai][bj][m][0], up = acc[ai][bj][m][1]; f32x4 h;
#pragma unroll
                    for (int j = 0; j < 4; ++j) h[j] = g[j] * __builtin_amdgcn_rcpf(1.f + __expf(-g[j])) * up[j];
                    u32x2 w; w.x = cvt_pk_bf16_asm(h[0], h[1]); w.y = cvt_pk_bf16_asm(h[2], h[3]);
                    *(u32x2*)(rowp + bj * (HALF / 2)) = w; } }
    }
};

template <class Epi, bool GATHER>
__device__ __forceinline__ void gemm_phase(const int tid, LAS unsigned char* lds, const Gemm g, const StaticOrder& S, const Epi& E) {
    const int wid = __builtin_amdgcn_readfirstlane(tid >> 6), lane = tid & 63, wr = wid >> 2, wc = wid & 3, fr = lane & 15, fq = lane >> 4;
    const int K = g.K, nt = K / BK;
    unsigned voffA[2], voffB[2];
#pragma unroll
    for (int i = 0; i < 2; ++i) { int R, C; stage_rc(tid * 16 + i * 8192, R, C); const int Rb = Epi::PERM ? ((R & ~31) + perm32(R & 31)) : R;
        voffB[i] = (unsigned)(Rb * K + C) * 2u; voffA[i] = GATHER ? (unsigned)(C * 2) : (Epi::PERM ? (unsigned)(R * K + C) * 2u : voffB[i]); }
    const size_t kstep = (size_t)(BK * 2);
    const size_t hstep = (size_t)HALF * K * 2;
    const size_t tstep = 2 * hstep;
    const unsigned ldsw = (unsigned)wid * 1024u;
    const int aoff = lds_byte(wr * 64 + fr, fq * 8), boff = lds_byte(wc * 32 + fr, fq * 8);
#define PG8_SA(b, h) (((b) * 2 + (h)) * HTB)
#define PG8_SB(b, h) ((4 + (b) * 2 + (h)) * HTB)
#define PG8_STAGE(bufoff, gbase, voff) do { const char* gb_ = (const char*)(gbase); asm volatile("" : "+s"(gb_)); _Pragma("unroll") for (int _i = 0; _i < 2; ++_i) \
        __builtin_amdgcn_global_load_lds((const unsigned*)(gb_ + (voff)[_i]), (LAS unsigned*)(lds + (bufoff) + ldsw + _i * 8192), 16, 0, 0); } while (0)
#define PG8_STAGE_A(bufoff, ubase, kt, h, tb) do { if constexpr (GATHER) { \
        if ((tb) < 0) { PG8_STAGE(bufoff, Ab + (size_t)(kt) * kstep, oAc[h]); } else { \
        unsigned m_ = ~0u; asm volatile("" : "+s"(m_)); const int tl_ = wid * 64 + (int)__builtin_amdgcn_mbcnt_hi(m_, __builtin_amdgcn_mbcnt_lo(m_, 0u)); \
        _Pragma("unroll") for (int _i = 0; _i < 2; ++_i) { int _R, _C; stage_rc(tl_ * 16 + _i * 8192, _R, _C); \
            const unsigned _o = *(const LAS unsigned*)(lds + TAB_OFF + (tb) * 1024 + ((h) * HALF + _R) * 4) + (unsigned)(_C * 2); \
            __builtin_amdgcn_global_load_lds((const unsigned*)(Ab + (size_t)(kt) * kstep + _o), (LAS unsigned*)(lds + (bufoff) + ldsw + _i * 8192), 16, 0, 0); } } } \
        else { PG8_STAGE(bufoff, (ubase) + (size_t)(kt) * kstep + (size_t)(h) * hstep, voffA); } } while (0)
#define PG8_LOADOFFS(tb) do { if constexpr (GATHER) { unsigned m_ = ~0u; asm volatile("" : "+s"(m_)); const int tl_ = wid * 64 + (int)__builtin_amdgcn_mbcnt_hi(m_, __builtin_amdgcn_mbcnt_lo(m_, 0u)); \
        _Pragma("unroll") for (int _h = 0; _h < 2; ++_h) _Pragma("unroll") for (int _i = 0; _i < 2; ++_i) { int _R, _C; stage_rc(tl_ * 16 + _i * 8192, _R, _C); \
            oAc[_h][_i] = *(const LAS unsigned*)(lds + TAB_OFF + (tb) * 1024 + (_h * HALF + _R) * 4) + (unsigned)(_C * 2); } } } while (0)
#define PG8_FILLTAB(u, tb) do { if constexpr (GATHER) { unsigned m_ = ~0u; asm volatile("" : "+s"(m_)); const int tl_ = wid * 64 + (int)__builtin_amdgcn_mbcnt_hi(m_, __builtin_amdgcn_mbcnt_lo(m_, 0u)); \
        if (tl_ < 256) *(LAS unsigned*)(lds + TAB_OFF + (tb) * 1024 + tl_ * 4) = min((unsigned)g.gather[(u).pm * BM + tl_], (unsigned)(NTOK - 1)) * (unsigned)(K * 2); } } while (0)
#define PG8_LDA(dst, b, h) do { _Pragma("unroll") for (int m = 0; m < 4; ++m) _Pragma("unroll") for (int k = 0; k < 2; ++k) dst[m][k] = *(const LAS bf16x8*)(lds + PG8_SA(b, h) + aoff + m * 2048 + k * 1024); } while (0)
#define PG8_LDB(dst, b, h) do { _Pragma("unroll") for (int n = 0; n < 2; ++n) _Pragma("unroll") for (int k = 0; k < 2; ++k) dst[n][k] = *(const LAS bf16x8*)(lds + PG8_SB(b, h) + boff + n * 2048 + k * 1024); } while (0)
#define PG8_MMA(ai, bj, At, Bt) do { __builtin_amdgcn_s_setprio(1); _Pragma("unroll") for (int m = 0; m < 4; ++m) _Pragma("unroll") for (int n = 0; n < 2; ++n) _Pragma("unroll") for (int k = 0; k < 2; ++k) \
        acc[ai][bj][m][n] = __builtin_amdgcn_mfma_f32_16x16x32_bf16(Bt[n][k], At[m][k], acc[ai][bj][m][n], 0, 0, 0); __builtin_amdgcn_s_setprio(0); } while (0)
#define PG8_WAIT_V(n) asm volatile("s_waitcnt vmcnt(" #n ")" ::: "memory")
#define PG8_WAIT_L(n) asm volatile("s_waitcnt lgkmcnt(" #n ")" ::: "memory")
#define PG8_BAR __builtin_amdgcn_s_barrier()
#define PG8_SCHED __builtin_amdgcn_sched_barrier(0)
#define PG8_KTILE2(u1, k1, o1, u2, k2, o2, b2p) do { \
        PG8_LDB(B0, 0, 0); PG8_LDB(B1, 0, 1); PG8_SCHED; PG8_LDA(At, 0, 0); PG8_STAGE_A(PG8_SA(1, 1), u1, k1, 1, o1); \
        PG8_WAIT_V(8); PG8_WAIT_L(0); PG8_BAR; PG8_MMA(0, 0, At, B0); PG8_MMA(0, 1, At, B1); PG8_BAR; PG8_SCHED; \
        PG8_LDA(At, 0, 1); PG8_STAGE(PG8_SB(0, 0), b2p, voffB); PG8_STAGE(PG8_SB(0, 1), (b2p) + hstep, voffB); PG8_STAGE_A(PG8_SA(0, 0), u2, k2, 0, o2); \
        PG8_WAIT_V(8); PG8_WAIT_L(0); PG8_BAR; PG8_MMA(1, 0, At, B0); PG8_MMA(1, 1, At, B1); PG8_BAR; PG8_SCHED; \
        PG8_LDB(B0, 1, 0); PG8_LDB(B1, 1, 1); PG8_SCHED; PG8_LDA(At, 1, 0); PG8_STAGE_A(PG8_SA(0, 1), u2, k2, 1, o2); \
        PG8_WAIT_V(8); PG8_WAIT_L(0); PG8_BAR; PG8_MMA(0, 0, At, B0); PG8_MMA(0, 1, At, B1); PG8_BAR; PG8_SCHED; \
        PG8_LDA(At, 1, 1); PG8_STAGE(PG8_SB(1, 0), (b2p) + kstep, voffB); PG8_STAGE(PG8_SB(1, 1), (b2p) + kstep + hstep, voffB); PG8_STAGE_A(PG8_SA(1, 0), u2, (k2) + 1, 0, o2); \
        PG8_WAIT_V(8); PG8_WAIT_L(0); PG8_BAR; PG8_MMA(1, 0, At, B0); PG8_MMA(1, 1, At, B1); PG8_BAR; PG8_SCHED; } while (0)
#define PG8_BPTR(u) ((const char*)g.Bt + (g.gt ? (size_t)(((u).pm / g.gt) % g.ng) * g.gstride : (size_t)0) + (size_t)(u).pn * tstep)
    Unit cur, nxt; int ui = 0;
    if (!S.next(0, cur)) return;
    f32x4 acc[2][2][4][2];
#pragma unroll
    for (int a = 0; a < 2; ++a)
#pragma unroll
        for (int b = 0; b < 2; ++b)
#pragma unroll
            for (int m = 0; m < 4; ++m)
#pragma unroll
                for (int n = 0; n < 2; ++n) acc[a][b][m][n] = (f32x4){0.f, 0.f, 0.f, 0.f};
    bf16x8 At[4][2], B0[2][2], B1[2][2];
    unsigned oAc[2][2] = {{0u, 0u}, {0u, 0u}};
    const char* const Ab = (const char*)g.A;
    const char* cA = Ab + (size_t)cur.pm * tstep;
    const char* cB = PG8_BPTR(cur);
    PG8_FILLTAB(cur, 0);
    if constexpr (GATHER) { PG8_WAIT_L(0); PG8_BAR; PG8_LOADOFFS(0); }
    PG8_STAGE(PG8_SB(0, 0), cB, voffB); PG8_STAGE(PG8_SB(0, 1), cB + hstep, voffB); PG8_STAGE_A(PG8_SA(0, 0), cA, 0, 0, -1); PG8_STAGE_A(PG8_SA(0, 1), cA, 0, 1, -1);
    if (wr == 1) PG8_BAR;
    PG8_WAIT_V(2); PG8_BAR;
    PG8_STAGE(PG8_SB(1, 0), cB + kstep, voffB); PG8_STAGE_A(PG8_SA(1, 0), cA, 1, 0, -1); PG8_STAGE(PG8_SB(1, 1), cB + hstep + kstep, voffB);
    PG8_WAIT_V(6); PG8_BAR;
    for (;;) {
        const bool has_next = S.next(ui + 1, nxt);
        const char* nA = has_next ? Ab + (size_t)nxt.pm * tstep : cA; const char* nB = has_next ? PG8_BPTR(nxt) : cB;
        const int tbc = ui & 1, tbn = has_next ? ((ui + 1) & 1) : (ui & 1);
        if (has_next) PG8_FILLTAB(nxt, tbn);
        for (int t = 0; t < nt - 2; t += 2) { const char* b2 = cB + (size_t)(t + 2) * kstep; PG8_KTILE2(cA, t + 1, -1, cA, t + 2, -1, b2); }
        PG8_KTILE2(cA, nt - 1, -1, nA, 0, tbn, nB);
        if (wr == 0) PG8_BAR;
        { unsigned m_ = ~0u; asm volatile("" : "+s"(m_)); int l2 = (int)__builtin_amdgcn_mbcnt_hi(m_, __builtin_amdgcn_mbcnt_lo(m_, 0u)); asm volatile("" : "+v"(l2)); E(acc, cur, wr, wc, l2 & 15, l2 >> 4); }
        if (!has_next) break;
#pragma unroll
        for (int a = 0; a < 2; ++a)
#pragma unroll
            for (int b = 0; b < 2; ++b)
#pragma unroll
                for (int m = 0; m < 4; ++m)
#pragma unroll
                    for (int n = 0; n < 2; ++n) acc[a][b][m][n] = (f32x4){0.f, 0.f, 0.f, 0.f};
        cur = nxt; cA = nA; cB = nB; ++ui;
        PG8_LOADOFFS(ui & 1);
        if (wr == 1) PG8_BAR;
    }
    PG8_WAIT_V(0);
    PG8_BAR;
#undef PG8_STAGE_A
#undef PG8_FILLTAB
#undef PG8_LOADOFFS
#undef PG8_SA
#undef PG8_SB
#undef PG8_STAGE
#undef PG8_LDA
#undef PG8_LDB
#undef PG8_MMA
#undef PG8_WAIT_V
#undef PG8_WAIT_L
#undef PG8_BAR
#undef PG8_SCHED
#undef PG8_KTILE2
#undef PG8_BPTR
}
}

#define XB_TMO      128
#define XB_XCNT(j)  (256  + 64 * (j))
#define XB_XSUB(j)  (1280 + 64 * (j))
#define XB_XGEN(j)  (2304 + 64 * (j))
#define XB_TOP      3328
#define XB_TOPGEN   3392
#define XCD_BAR_WORDS 3456
#define XB_SPIN_CAP (1u << 20)
__device__ __forceinline__ unsigned xb_ld(unsigned* p)              { return __hip_atomic_load(p, __ATOMIC_RELAXED, __HIP_MEMORY_SCOPE_AGENT); }
__device__ __forceinline__ unsigned xb_add(unsigned* p, unsigned v) { return __hip_atomic_fetch_add(p, v, __ATOMIC_RELAXED, __HIP_MEMORY_SCOPE_AGENT); }
__device__ __forceinline__ unsigned xb_xcc_id() { return (unsigned)__builtin_amdgcn_s_getreg((3 << 11) | 20) & 0xFu; }
#define XB_SPIN(cond, bar) do { unsigned _sp = 0; while (cond) { __builtin_amdgcn_s_sleep(1); \
    if ((++_sp & 255u) == 0u) { if (xb_ld(&(bar)[XB_TMO])) break; if (_sp > XB_SPIN_CAP) { atomicAdd(&(bar)[XB_TMO], 1u); break; } } } } while (0)
struct XcdBarrier { unsigned* bar; unsigned x; };
#define XB_ST(ldsbase) ((volatile LAS unsigned*)((LAS unsigned char*)(ldsbase) + MISC_OFF + 32))
__device__ __forceinline__ XcdBarrier xcd_barrier_post(unsigned* bar, bool leader) {
    XcdBarrier b; b.bar = bar; b.x = xb_xcc_id();
    if (leader) (void)xb_add(&bar[XB_XCNT(b.x)], 1u);
    return b;
}
__device__ __forceinline__ void xcd_barrier_complete(unsigned* bar, unsigned x, unsigned& nloc, unsigned& nx) {
    const unsigned G = gridDim.x * gridDim.y * gridDim.z;
    unsigned sum, cnt, mine, sp = 0u;
    for (;;) {
        sum = 0u; cnt = 0u; mine = 0u;
#pragma unroll
        for (unsigned j = 0; j < 16; ++j) { const unsigned c = xb_ld(&bar[XB_XCNT(j)]); sum += c; cnt += (c > 0u) ? 1u : 0u; mine = (j == x) ? c : mine; }
        if (sum == G) break;
        __builtin_amdgcn_s_sleep(1);
        if ((++sp & 255u) == 0u) { if (xb_ld(&bar[XB_TMO])) break; if (sp > XB_SPIN_CAP) { atomicAdd(&bar[XB_TMO], 1u); break; } }
    }
    nloc = mine > 0u ? mine : 1u; nx = cnt > 0u ? cnt : 1u;
}
__device__ __forceinline__ void xcd_barrier(const XcdBarrier& b, bool leader, volatile LAS unsigned* st) {
    asm volatile("s_waitcnt vmcnt(0)" ::: "memory");
    __syncthreads();
    if (leader) {
        unsigned* bar = b.bar;
        __builtin_amdgcn_s_waitcnt(0);
        unsigned nloc = st[0], nx = st[1];
        if (nloc == 0u) { xcd_barrier_complete(bar, b.x, nloc, nx); st[0] = nloc; st[1] = nx; }
        const unsigned old = xb_add(&bar[XB_XSUB(b.x)], 1u);
        const unsigned gen = old / nloc;
        if (old + 1u == (gen + 1u) * nloc) {
            __builtin_amdgcn_fence(__ATOMIC_RELEASE, "agent");
            asm volatile("s_waitcnt vmcnt(0)" ::: "memory");
            const unsigned og = xb_add(&bar[XB_TOP], 1u);
            const unsigned tg = og / nx;
            if (og + 1u == (tg + 1u) * nx) xb_add(&bar[XB_TOPGEN], 1u);
            else XB_SPIN(xb_ld(&bar[XB_TOPGEN]) == tg, bar);
            __builtin_amdgcn_fence(__ATOMIC_ACQUIRE, "agent");
            xb_add(&bar[XB_XGEN(b.x)], 1u);
            asm volatile("s_waitcnt vmcnt(0)" ::: "memory");
        } else {
            XB_SPIN(xb_ld(&bar[XB_XGEN(b.x)]) == gen, bar);
            __builtin_amdgcn_fence(__ATOMIC_ACQUIRE, "agent");
            asm volatile("s_waitcnt vmcnt(0)" ::: "memory");
        }
    }
    __syncthreads();
}

template <void (*F)(long, PRef, int)> __device__ __forceinline__ void run_items(const int tid, PRef p, int l, long n, long off) {
    for (long gid = (long)blockIdx.x * NTHR + tid; gid < n; gid += (long)gridDim.x * NTHR) F(gid + off, p, l);
}
BODY void b_hgrn_seq2(long gid, PRef p, int l) { const long n1 = (long)NB * HGH * 64; if (gid < n1) b_hgrn_seq<0>(gid, p, l); else b_hgrn_seq<1>(gid - n1, p, l); }

template <int MAP> __device__ __forceinline__ void transpose_item(const float* W, int K, int N, bf16_t* WT, int row_off, LAS float* scr, int item, int lane) {
    const int nblk = N / 32, kb = item / nblk, nb = item % nblk, k0 = 64 * kb, n0 = 32 * nb;
#pragma unroll 8
    for (int i = 0; i < 32; ++i) { const int kk = 2 * i + (lane >> 5); scr[kk * 33 + (lane & 31)] = W[(size_t)(k0 + kk) * N + n0 + (lane & 31)]; }
    asm volatile("s_waitcnt lgkmcnt(0)" ::: "memory");
    const int c = lane & 7;
#pragma unroll
    for (int j = 0; j < 4; ++j) { const int n = (lane >> 3) + 8 * j; const LAS float* s = scr + (8 * c) * 33 + n;
        u32x4 o; o.x = cvt_pk_bf16(s[0 * 33], s[1 * 33]); o.y = cvt_pk_bf16(s[2 * 33], s[3 * 33]); o.z = cvt_pk_bf16(s[4 * 33], s[5 * 33]); o.w = cvt_pk_bf16(s[6 * 33], s[7 * 33]);
        const int nn = n0 + n; const int drow = MAP == 0 ? row_off + nn : (32 * (nn >> 4) + (nn & 15) + (MAP == 2 ? 16 : 0));
        *(u32x4*)(WT + (size_t)drow * K + k0 + 8 * c) = o; }
    asm volatile("s_waitcnt lgkmcnt(0)" ::: "memory");
}
__device__ __forceinline__ void phase_convert(const int tid, PRef p, int l, LAS unsigned char* lds, int part = 0, int blk_lo = 0) {
    if ((int)blockIdx.x < blk_lo) return;
    const int lane = tid & 63, wave = tid >> 6;
    LAS float* scr = (LAS float*)(lds + wave * 16384);
    const int gw = ((int)blockIdx.x - blk_lo) * NWAVES + wave, NGW = ((int)gridDim.x - blk_lo) * NWAVES;
    constexpr int I_IN = (D / 64) * (INC / 32), I_OUT = (MIXD / 64) * (D / 32), I_G = (D / 64) * (ED / 32), I_D = (ED / 64) * (D / 32);
    constexpr int NITEMS = I_IN + I_OUT + NE * (2 * I_G + I_D);
    const int it_lo = part == 2 ? I_IN + I_OUT : 0, it_hi = part == 1 ? I_IN + I_OUT : NITEMS;
    for (int it = it_lo + gw; it < it_hi; it += NGW) {
        int r = it;
        if (r < I_IN) { transpose_item<0>(p.w_in + (size_t)l * D * INC, D, INC, p.WIN_T, 0, scr, r, lane); continue; } r -= I_IN;
        if (r < I_OUT) { transpose_item<0>(p.w_out + (size_t)l * MIXD * D, MIXD, D, p.WOUT_T, 0, scr, r, lane); continue; } r -= I_OUT;
        const int e = r / (2 * I_G + I_D); r -= e * (2 * I_G + I_D);
        if (r < I_G) { transpose_item<1>(p.w_gate + ((size_t)l * NE + e) * D * ED, D, ED, p.WGU_T + (size_t)e * 2 * ED * D, 0, scr, r, lane); continue; } r -= I_G;
        if (r < I_G) { transpose_item<2>(p.w_up + ((size_t)l * NE + e) * D * ED, D, ED, p.WGU_T + (size_t)e * 2 * ED * D, 0, scr, r, lane); continue; } r -= I_G;
        transpose_item<0>(p.w_down + ((size_t)l * NE + e) * ED * D, ED, D, p.WD_T + (size_t)e * D * ED, 0, scr, r, lane);
    }
}
template <int WHICH> __device__ __forceinline__ void phase_prenorm(const int tid, PRef p, int l) {
    static_assert(D == 1024, "wave-per-row kernels assume D = 1024");
    const int lane = tid & 63, wave = tid >> 6;
    const int gw = blockIdx.x * NWAVES + wave, NGW = gridDim.x * NWAVES;
    const float* nw = (WHICH ? p.norm2_w : p.norm1_w) + l * D;
    for (int r = gw; r < NTOK; r += NGW) {
        const float* xr = xrow(p, r);
        const float* mod = p.MOD + ((size_t)l * 3 + modset(r)) * NMOD;
        const float* shift = mod + (WHICH ? 3 : 0) * D; const float* scale = mod + (WHICH ? 4 : 1) * D;
        f32x4 v[4]; float ss = 0.f;
#pragma unroll
        for (int j = 0; j < 4; ++j) { v[j] = *(const f32x4*)(xr + 4 * lane + 256 * j); ss += (v[j][0] * v[j][0] + v[j][1] * v[j][1]) + (v[j][2] * v[j][2] + v[j][3] * v[j][3]); }
        const float rstd = 1.f / sqrtf(wave_sum(ss, lane) * (1.f / D) + EPS);
        float lg[NE];
#pragma unroll
        for (int e = 0; e < NE; ++e) lg[e] = 0.f;
#pragma unroll
        for (int j = 0; j < 4; ++j) {
            const int c = 4 * lane + 256 * j;
            const f32x4 w4 = *(const f32x4*)(nw + c), sc4 = *(const f32x4*)(scale + c), sh4 = *(const f32x4*)(shift + c);
            f32x4 h;
#pragma unroll
            for (int i = 0; i < 4; ++i) h[i] = v[j][i] * rstd * w4[i] * (1.f + sc4[i]) + sh4[i];
            u32x2 o; o.x = cvt_pk_bf16(h[0], h[1]); o.y = cvt_pk_bf16(h[2], h[3]);
            *(u32x2*)(p.H + (size_t)r * D + c) = o;
            if (WHICH) {
#pragma unroll
                for (int i = 0; i < 4; ++i) { const f32x4* wr = (const f32x4*)(p.w_router + ((size_t)l * D + c + i) * NE);
#pragma unroll
                    for (int q = 0; q < 4; ++q) { const f32x4 w = wr[q]; lg[4 * q + 0] += h[i] * w[0]; lg[4 * q + 1] += h[i] * w[1]; lg[4 * q + 2] += h[i] * w[2]; lg[4 * q + 3] += h[i] * w[3]; } }
            }
        }
        if (WHICH) {
#pragma unroll
            for (int e = 0; e < NE; ++e) lg[e] = wave_sum(lg[e], lane);
            float m = lg[0];
#pragma unroll
            for (int e = 1; e < NE; ++e) m = fmaxf(m, lg[e]);
            float s = 0.f, mine = 0.f;
#pragma unroll
            for (int e = 0; e < NE; ++e) { const float ex = expf(lg[e] - m); s += ex; mine = (lane == e) ? ex : mine; }
            if (lane < NE) p.AFF[(size_t)r * NE + lane] = mine / s;
        }
    }
}
__device__ __forceinline__ void phase_combine(const int tid, PRef p, int l) {
    const int lane = tid & 63, wave = tid >> 6;
    const int gw = blockIdx.x * NWAVES + wave, NGW = gridDim.x * NWAVES;
    for (int r = gw; r < NTOK; r += NGW) {
        float* xr = xrow(p, r);
        const float* g = p.MOD + ((size_t)l * 3 + modset(r)) * NMOD + 5 * D;
        f32x4 acc[4];
#pragma unroll
        for (int j = 0; j < 4; ++j) acc[j] = (f32x4){0.f, 0.f, 0.f, 0.f};
        const int myinv = lane < NE ? p.INV[(size_t)r * NE + lane] : -1;
#pragma unroll
        for (int e = 0; e < NE; ++e) {
            const int s = __builtin_amdgcn_readlane(myinv, e);
            if (s >= 0 && s < NSLOT) {
                const bf16_t* y = p.Y + (size_t)s * D;
#pragma unroll
                for (int j = 0; j < 4; ++j) { const u32x2 w = *(const u32x2*)(y + 4 * lane + 256 * j);
                    acc[j][0] += __builtin_bit_cast(float, w.x << 16); acc[j][1] += __builtin_bit_cast(float, w.x & 0xffff0000u);
                    acc[j][2] += __builtin_bit_cast(float, w.y << 16); acc[j][3] += __builtin_bit_cast(float, w.y & 0xffff0000u); }
            }
        }
#pragma unroll
        for (int j = 0; j < 4; ++j) { const int c = 4 * lane + 256 * j; f32x4* q = (f32x4*)(xr + c); *q = *q + *(const f32x4*)(g + c) * acc[j]; }
    }
}


__device__ __forceinline__ unsigned wave_excl_scan(unsigned x, int lane) {
    unsigned inc = x;
#pragma unroll
    for (int d = 1; d < 64; d <<= 1) { const unsigned y = (unsigned)__builtin_amdgcn_ds_bpermute(((lane - d) & 63) << 2, (int)inc); if (lane >= d) inc += y; }
    return inc - x;
}
__device__ __forceinline__ void phase_topk(const int tid, PRef p, LAS unsigned char* lds) {
    LAS unsigned* keys = (LAS unsigned*)lds;
    LAS unsigned* hist = (LAS unsigned*)(lds + 70000);
    LAS unsigned* cgt = (LAS unsigned*)(lds + 76000);
    LAS unsigned* ceq = (LAS unsigned*)(lds + 80000);
    LAS unsigned* sh = (LAS unsigned*)(lds + 84000);
    static_assert(SEQ % 512 == 0 && SEQ + SEQ / 32 <= 17400, "topk LDS layout");
    constexpr int PER = SEQ / 512;
    for (int pr = blockIdx.x; pr < 2 * NB * NE; pr += gridDim.x) {
        const int e = pr % NE, b = (pr / NE) % NB, isctx = pr / (NE * NB);
        if (!isctx) {
            const int row0 = b * SEQ, base = (b * NE + e) * CAPL;
            for (int i = 0; i < PER; ++i) { const int t = i * 512 + tid; keys[t + (t >> 5)] = __builtin_bit_cast(unsigned, p.AFF[(size_t)(row0 + t) * NE + e]); }
            if (tid == 0) { sh[0] = 0u; sh[1] = (unsigned)CAPL; }
            __syncthreads();
            for (int pass = 0; pass < 3; ++pass) {
                const int shift = 20 - 10 * pass;
                for (int i = tid; i < 1024; i += 512) hist[i] = 0u;
                __syncthreads();
                const unsigned prefix = sh[0]; const unsigned himask = pass == 0 ? 0u : (0xFFFFFFFFu << (shift + 10));
                for (int i = 0; i < PER; ++i) { const int t = tid * PER + i; const unsigned k = keys[t + (t >> 5)]; if ((k & himask) == prefix) atomicAdd((unsigned*)&hist[(k >> shift) & 1023u], 1u); }
                __syncthreads();
                if (tid < 64) {
                    const unsigned need = sh[1];
                    unsigned c[16]; unsigned tot = 0u;
#pragma unroll
                    for (int q = 0; q < 16; ++q) { c[q] = hist[1023 - 16 * tid - q]; tot += c[q]; }
                    unsigned above = wave_excl_scan(tot, tid);
                    int fbin = -1; unsigned fabove = 0u;
#pragma unroll
                    for (int q = 0; q < 16; ++q) { if (fbin < 0 && above < need && above + c[q] >= need) { fbin = 1023 - 16 * tid - q; fabove = above; } above += c[q]; }
                    if (fbin >= 0) { sh[0] = prefix | ((unsigned)fbin << shift); sh[1] = need - fabove; }
                }
                __syncthreads();
            }
            const unsigned thr = sh[0], keq = sh[1];
            unsigned ng = 0u, nq = 0u;
            for (int i = 0; i < PER; ++i) { const int t = tid * PER + i; const unsigned k = keys[t + (t >> 5)]; ng += k > thr ? 1u : 0u; nq += k == thr ? 1u : 0u; }
            cgt[tid] = ng; ceq[tid] = nq;
            __syncthreads();
            if (tid < 64) {
                unsigned g[8], q[8], sg = 0u, sq = 0u;
#pragma unroll
                for (int i = 0; i < 8; ++i) { g[i] = cgt[8 * tid + i]; q[i] = ceq[8 * tid + i]; sg += g[i]; sq += q[i]; }
                unsigned ag = wave_excl_scan(sg, tid), aq = wave_excl_scan(sq, tid);
#pragma unroll
                for (int i = 0; i < 8; ++i) { cgt[8 * tid + i] = ag; ceq[8 * tid + i] = aq; ag += g[i]; aq += q[i]; }
            }
            __syncthreads();
            unsigned rg = cgt[tid], rq = ceq[tid];
            for (int i = 0; i < PER; ++i) {
                const int t = tid * PER + i; const unsigned k = keys[t + (t >> 5)];
                int slot = -1;
                if (k > thr) { slot = (int)(rg + (rq < keq ? rq : keq)); ++rg; }
                else if (k == thr) { if (rq < keq) slot = (int)(rg + rq); ++rq; }
                const int row = row0 + t;
                if (slot >= 0) { p.STOK[base + slot] = row; p.SVAL[base + slot] = __builtin_bit_cast(float, k); p.INV[(size_t)row * NE + e] = base + slot; }
                else p.INV[(size_t)row * NE + e] = -1;
            }
            __syncthreads();
        } else {
            const int row0 = NLAT + b * CTX, base = NSLOT_L + (b * NE + e) * CAPC;
            LAS float* vals = (LAS float*)lds;
            for (int t = tid; t < CTX; t += 512) vals[t] = p.AFF[(size_t)(row0 + t) * NE + e];
            __syncthreads();
            for (int t = tid; t < CTX; t += 512) {
                const float a = vals[t]; int rank = 0;
                for (int tt = 0; tt < CTX; ++tt) { const float o = vals[tt]; rank += (o > a || (o == a && tt < t)) ? 1 : 0; }
                const int row = row0 + t;
                if (rank < CAPC) { p.STOK[base + rank] = row; p.SVAL[base + rank] = a; p.INV[(size_t)row * NE + e] = base + rank; }
                else p.INV[(size_t)row * NE + e] = -1;
            }
            __syncthreads();
        }
    }
}

#define LDS_BAR() do { asm volatile("s_waitcnt lgkmcnt(0)" ::: "memory"); __builtin_amdgcn_s_barrier(); asm volatile("" ::: "memory"); } while (0)
__device__ __forceinline__ float bfw(unsigned w, int hi) { return __builtin_bit_cast(float, hi ? (w & 0xffff0000u) : (w << 16)); }
__device__ __forceinline__ float bf8(const u32x4& v, int j) { return bfw(v[j >> 1], j & 1); }
__device__ __forceinline__ int hg_row0(int b, int pc) { return pc < NCHC ? NLAT + b * CTX + pc * 64 : b * SEQ + (pc - NCHC) * 64; }
constexpr int HG_FF = 0, HG_FB = 16640, HG_AF = 33280, HG_AB = 49920, HG_T0 = 66560, HG_TS = 9216, HG_VT = HG_T0 + 6 * HG_TS;
static_assert(HG_VT + HG_TS <= RING_BYTES, "hgrn LDS layout");
#define TSW_E(k, t) ((k) * 72 + ((((t) >> 3) ^ (((k) >> 3) & 7)) << 3) + ((t) & 7))
#define TSW_B(k, c) ((k) * 144 + (((c) ^ (((k) >> 3) & 7)) << 4))
__device__ __forceinline__ void hg_gates(const int tid, PRef p, int l, int h, const u32x4 zf, const u32x4 zb, LAS unsigned char* lds) {
    LAS float* FF = (LAS float*)(lds + HG_FF); LAS float* FB = (LAS float*)(lds + HG_FB); LAS float* AF = (LAS float*)(lds + HG_AF); LAS float* AB = (LAS float*)(lds + HG_AB);
    const int t = tid >> 3, cg = tid & 7;
    const float* lbf = p.LB + (size_t)(0 * DEPTH + l) * 384 + h * 64 + cg * 8; const float* lbb = p.LB + (size_t)(1 * DEPTH + l) * 384 + h * 64 + cg * 8;
#pragma unroll
    for (int j = 0; j < 8; ++j) {
        const float z0 = fminf(fmaxf(bf8(zf, j), -60.f), 60.f), z1 = fminf(fmaxf(bf8(zb, j), -60.f), 60.f);
        const float l0 = lbf[j], l1 = lbb[j];
        FF[t * 65 + cg * 8 + j] = l0 + (1.f - l0) * __builtin_amdgcn_rcpf(1.f + __expf(-z0));
        FB[t * 65 + cg * 8 + j] = l1 + (1.f - l1) * __builtin_amdgcn_rcpf(1.f + __expf(-z1));
    }
    LDS_BAR();
    {
        const int wave = tid >> 6, lane = tid & 63, cl = lane & 15, seg = lane >> 4, dir = wave >> 2, col = 16 * (wave & 3) + cl;
        const LAS float* F = dir ? FB : FF; LAS float* A = dir ? AB : AF;
        float pre[16]; float run = 0.f;
#pragma unroll
        for (int i = 0; i < 16; ++i) { const int tt = dir ? 16 * seg + 15 - i : 16 * seg + i; run += __logf(F[tt * 65 + col]); pre[i] = run; }
        const float T0 = __builtin_bit_cast(float, __builtin_amdgcn_ds_bpermute((cl + 0) << 2, __builtin_bit_cast(int, run)));
        const float T1 = __builtin_bit_cast(float, __builtin_amdgcn_ds_bpermute((cl + 16) << 2, __builtin_bit_cast(int, run)));
        const float T2 = __builtin_bit_cast(float, __builtin_amdgcn_ds_bpermute((cl + 32) << 2, __builtin_bit_cast(int, run)));
        const float T3 = __builtin_bit_cast(float, __builtin_amdgcn_ds_bpermute((cl + 48) << 2, __builtin_bit_cast(int, run)));
        const float off = dir ? ((seg < 1 ? T1 : 0.f) + (seg < 2 ? T2 : 0.f) + (seg < 3 ? T3 : 0.f)) : ((seg > 0 ? T0 : 0.f) + (seg > 1 ? T1 : 0.f) + (seg > 2 ? T2 : 0.f));
#pragma unroll
        for (int i = 0; i < 16; ++i) { const int tt = dir ? 16 * seg + 15 - i : 16 * seg + i; A[tt * 65 + col] = off + pre[i]; }
    }
    LDS_BAR();
}
__device__ __forceinline__ bf16x8 ld2x64(const LAS unsigned char* p0, const LAS unsigned char* p1) {
    const u32x2 a = *(const LAS u32x2*)p0, b = *(const LAS u32x2*)p1; u32x4 r; r.x = a.x; r.y = a.y; r.z = b.x; r.w = b.y; return __builtin_bit_cast(bf16x8, r);
}
__device__ __forceinline__ f32x4 mfma16(bf16x8 a, bf16x8 b, f32x4 c) { return __builtin_amdgcn_mfma_f32_16x16x32_bf16(a, b, c, 0, 0, 0); }
__device__ __forceinline__ void phase_hgrn_local(const int tid, PRef p, int l, LAS unsigned char* lds) {
    LAS float* FF = (LAS float*)(lds + HG_FF); LAS float* FB = (LAS float*)(lds + HG_FB); LAS float* AF = (LAS float*)(lds + HG_AF); LAS float* AB = (LAS float*)(lds + HG_AB);
    LAS bf16_t* KTf = (LAS bf16_t*)(lds + HG_T0); LAS bf16_t* KTb = (LAS bf16_t*)(lds + HG_T0 + HG_TS); LAS bf16_t* VT = (LAS bf16_t*)(lds + HG_VT);
    const int t = tid >> 3, cg = tid & 7, wave = tid >> 6, lane = tid & 63, fr = lane & 15, fq = lane >> 4;
    u32x4 nzf = (u32x4){0u, 0u, 0u, 0u}, nzb = nzf, nv8 = nzf;
    if ((int)blockIdx.x < NBH * NCH) { const int it = blockIdx.x, pc = it % NCH, bh = it / NCH, h = bh % HGH, b = bh / HGH;
        const bf16_t* pr = p.P + (size_t)(hg_row0(b, pc) + t) * INC + h * 64 + cg * 8; nzf = *(const u32x4*)(pr + OFF_); nzb = *(const u32x4*)(pr + OFB); nv8 = *(const u32x4*)(pr + OHI); }
    for (int it = blockIdx.x; it < NBH * NCH; it += gridDim.x) {
        const int pc = it % NCH, bh = it / NCH, h = bh % HGH, b = bh / HGH, row0 = hg_row0(b, pc);
        const u32x4 zf = nzf, zb = nzb, v8 = nv8;
        { const int it2 = it + gridDim.x; if (it2 < NBH * NCH) { const int pc2 = it2 % NCH, bh2 = it2 / NCH, h2 = bh2 % HGH, b2 = bh2 / HGH;
            const bf16_t* pr = p.P + (size_t)(hg_row0(b2, pc2) + t) * INC + h2 * 64 + cg * 8; nzf = *(const u32x4*)(pr + OFF_); nzb = *(const u32x4*)(pr + OFB); nv8 = *(const u32x4*)(pr + OHI); } }
        hg_gates(tid, p, l, h, zf, zb, lds);
#pragma unroll
        for (int j = 0; j < 8; ++j) {
            const int k = cg * 8 + j;
            VT[TSW_E(k, t)] = (bf16_t)(j & 1 ? v8[j >> 1] >> 16 : v8[j >> 1] & 0xffffu);
            KTf[TSW_E(k, t)] = f2bf((1.f - FF[t * 65 + k]) * __expf(AF[63 * 65 + k] - AF[t * 65 + k]));
            KTb[TSW_E(k, t)] = f2bf((1.f - FB[t * 65 + k]) * __expf(AB[k] - AB[t * 65 + k]));
        }
        if (tid < 64) p.GDEC[((size_t)(0 * NBH + bh) * NCH + pc) * 64 + tid] = __expf(AF[63 * 65 + tid]);
        else if (tid < 128) p.GDEC[((size_t)(1 * NBH + bh) * NCH + pc) * 64 + (tid - 64)] = __expf(AB[tid - 64]);
        LDS_BAR();
#if HGRN_DIAG == 4
        {
            const int v = tid >> 3, kg = tid & 7;
            for (int dir = 0; dir < 2; ++dir) {
                const LAS bf16_t* KT = (const LAS bf16_t*)(lds + HG_T0 + dir * HG_TS);
                float acc[8];
#pragma unroll
                for (int j = 0; j < 8; ++j) acc[j] = 0.f;
                for (int s_ = 0; s_ < 64; ++s_) { const float vv = bf2f(VT[v * 72 + s_]);
#pragma unroll
                    for (int j = 0; j < 8; ++j) acc[j] += bf2f(KT[(kg * 8 + j) * 72 + s_]) * vv; }
                bf16_t* dst = p.SLOC + ((size_t)(dir * NBH + bh) * NCH + pc) * 4096 + v * 64 + kg * 8;
#pragma unroll
                for (int j = 0; j < 8; ++j) dst[j] = f2bf(acc[j]);
            }
        }
#else
        {
            const int dir = wave >> 2, mt = wave & 3;
            const LAS unsigned char* KT = lds + HG_T0 + dir * HG_TS;
            bf16x8 a[2];
#pragma unroll
            for (int ks = 0; ks < 2; ++ks) a[ks] = *(const LAS bf16x8*)(KT + TSW_B(mt * 16 + fr, ks * 4 + fq));
            bf16_t* dst = p.SLOC + ((size_t)(dir * NBH + bh) * NCH + pc) * 4096;
#pragma unroll
            for (int nt = 0; nt < 4; ++nt) {
                f32x4 acc = (f32x4){0.f, 0.f, 0.f, 0.f};
#pragma unroll
                for (int ks = 0; ks < 2; ++ks) { const bf16x8 bb = *(const LAS bf16x8*)(lds + HG_VT + TSW_B(nt * 16 + fr, ks * 4 + fq)); acc = mfma16(a[ks], bb, acc); }
                u32x2 w; w.x = cvt_pk_bf16(acc[0], acc[1]); w.y = cvt_pk_bf16(acc[2], acc[3]);
                *(u32x2*)(dst + (nt * 16 + fr) * 64 + mt * 16 + 4 * fq) = w;
            }
        }
#endif
        LDS_BAR();
    }
}
__device__ __forceinline__ void phase_hgrn_scan(const int tid, PRef p) {
    static_assert(NCH % 20 == 0, "scan group size");
    constexpr int GS = 20;
    for (int blk = (int)gridDim.x - 1 - (int)blockIdx.x; blk < 2 * NBH * 4; blk += gridDim.x) {
        const int sq = blk >> 2, part = blk & 3, dir = sq / NBH, e0 = part * 1024 + tid * 2, k = e0 & 63;
        unsigned* S = (unsigned*)(p.SLOC + (size_t)sq * NCH * 4096 + e0);
        const float* G = p.GDEC + (size_t)sq * NCH * 64 + k;
        float c0 = 0.f, c1 = 0.f;
        unsigned nx[GS]; f32x2 gn[GS];
#define HG_PC(j) (dir ? ((j) < NCHC ? NCHC - 1 - (j) : NCH + NCHC - 1 - (j)) : (j))
#pragma unroll
        for (int u = 0; u < GS; ++u) { const int pc = HG_PC(u); nx[u] = S[(size_t)pc * 2048]; gn[u] = *(const f32x2*)(G + (size_t)pc * 64); }
        for (int j0 = 0; j0 < NCH; j0 += GS) {
            unsigned cu[GS]; f32x2 gc[GS];
#pragma unroll
            for (int u = 0; u < GS; ++u) { cu[u] = nx[u]; gc[u] = gn[u]; }
            if (j0 + GS < NCH) {
#pragma unroll
                for (int u = 0; u < GS; ++u) { const int pc = HG_PC(j0 + GS + u); nx[u] = S[(size_t)pc * 2048]; gn[u] = *(const f32x2*)(G + (size_t)pc * 64); }
            }
#pragma unroll
            for (int u = 0; u < GS; ++u) {
                const int pc = HG_PC(j0 + u);
                S[(size_t)pc * 2048] = cvt_pk_bf16(c0, c1);
                c0 = gc[u][0] * c0 + bfw(cu[u], 0); c1 = gc[u][1] * c1 + bfw(cu[u], 1);
            }
        }
#undef HG_PC
    }
}
__device__ __forceinline__ void phase_hgrn_out(const int tid, PRef p, int l, LAS unsigned char* lds) {
    LAS float* FF = (LAS float*)(lds + HG_FF); LAS float* FB = (LAS float*)(lds + HG_FB); LAS float* AF = (LAS float*)(lds + HG_AF); LAS float* AB = (LAS float*)(lds + HG_AB);
    LAS bf16_t* VT = (LAS bf16_t*)(lds + HG_VT);
    LAS float* OO = (LAS float*)(lds + HG_AF);
    const int t = tid >> 3, cg = tid & 7, wave = tid >> 6, lane = tid & 63, fr = lane & 15, fq = lane >> 4;
    u32x4 nzf = (u32x4){0u, 0u, 0u, 0u}, nzb = nzf, nv8 = nzf, nq8 = nzf, ng8 = nzf;
    if ((int)blockIdx.x < NBH * NCH) { const int it = blockIdx.x, pc = it % NCH, bh = it / NCH, h = bh % HGH, b = bh / HGH;
        const bf16_t* pr = p.P + (size_t)(hg_row0(b, pc) + t) * INC + h * 64 + cg * 8; nzf = *(const u32x4*)(pr + OFF_); nzb = *(const u32x4*)(pr + OFB); nv8 = *(const u32x4*)(pr + OHI); nq8 = *(const u32x4*)(pr + OHQ); ng8 = *(const u32x4*)(pr + OHG_); }
    for (int it = blockIdx.x; it < NBH * NCH; it += gridDim.x) {
        const int pc = it % NCH, bh = it / NCH, h = bh % HGH, b = bh / HGH, row0 = hg_row0(b, pc);
        const u32x4 zf = nzf, zb = nzb, v8 = nv8, q8 = nq8, g8 = ng8;
        { const int it2 = it + gridDim.x; if (it2 < NBH * NCH) { const int pc2 = it2 % NCH, bh2 = it2 / NCH, h2 = bh2 % HGH, b2 = bh2 / HGH;
            const bf16_t* pr = p.P + (size_t)(hg_row0(b2, pc2) + t) * INC + h2 * 64 + cg * 8; nzf = *(const u32x4*)(pr + OFF_); nzb = *(const u32x4*)(pr + OFB); nv8 = *(const u32x4*)(pr + OHI); nq8 = *(const u32x4*)(pr + OHQ); ng8 = *(const u32x4*)(pr + OHG_); } }
        bf16x8 bsin[4][2];
        { const bf16_t* SIN = p.SLOC + ((size_t)((wave >> 2) * NBH + bh) * NCH + pc) * 4096;
#pragma unroll
          for (int vt = 0; vt < 4; ++vt)
#pragma unroll
            for (int ks = 0; ks < 2; ++ks) bsin[vt][ks] = *(const bf16x8*)(SIN + (vt * 16 + fr) * 64 + ks * 32 + fq * 8); }
        hg_gates(tid, p, l, h, zf, zb, lds);
        {
            float w[6][8];
#pragma unroll
            for (int j = 0; j < 8; ++j) {
                const int k = cg * 8 + j;
                VT[TSW_E(k, t)] = (bf16_t)(j & 1 ? v8[j >> 1] >> 16 : v8[j >> 1] & 0xffffu);
                const float qv = bf8(q8, j) * 0.125f, af = AF[t * 65 + k], ab = AB[t * 65 + k], rf = AF[31 * 65 + k], rb = AB[32 * 65 + k];
                w[0][j] = qv * __expf(fminf(af - rf, 80.f)); w[1][j] = (1.f - FF[t * 65 + k]) * __expf(fminf(rf - af, 80.f)); w[2][j] = qv * __expf(af);
                w[3][j] = qv * __expf(fminf(ab - rb, 80.f)); w[4][j] = (1.f - FB[t * 65 + k]) * __expf(fminf(rb - ab, 80.f)); w[5][j] = qv * __expf(ab);
            }
#pragma unroll
            for (int a = 0; a < 6; ++a) { u32x4 o; o.x = cvt_pk_bf16(w[a][0], w[a][1]); o.y = cvt_pk_bf16(w[a][2], w[a][3]); o.z = cvt_pk_bf16(w[a][4], w[a][5]); o.w = cvt_pk_bf16(w[a][6], w[a][7]);
                *(LAS u32x4*)(lds + HG_T0 + a * HG_TS + t * 144 + cg * 16) = o; }
        }
        LDS_BAR();
        {
            const int dir = wave >> 2, tt = wave & 3;
            const LAS unsigned char* QT = lds + HG_T0 + (dir * 3 + 0) * HG_TS; const LAS unsigned char* KL = lds + HG_T0 + (dir * 3 + 1) * HG_TS; const LAS unsigned char* QH = lds + HG_T0 + (dir * 3 + 2) * HG_TS;
            bf16x8 bq[2], bh[2];
#pragma unroll
            for (int ks = 0; ks < 2; ++ks) { bq[ks] = *(const LAS bf16x8*)(QT + (tt * 16 + fr) * 144 + ks * 64 + fq * 16); bh[ks] = *(const LAS bf16x8*)(QH + (tt * 16 + fr) * 144 + ks * 64 + fq * 16); }
            f32x4 o[4];
#pragma unroll
            for (int vt = 0; vt < 4; ++vt) { o[vt] = (f32x4){0.f, 0.f, 0.f, 0.f};
#pragma unroll
                for (int ks = 0; ks < 2; ++ks) o[vt] = mfma16(bsin[vt][ks], bh[ks], o[vt]); }
            const int t_ = 16 * tt + fr;
#pragma unroll
            for (int kp = 0; kp < 2; ++kp) {
                f32x4 sc[2];
#pragma unroll
                for (int hf = 0; hf < 2; ++hf) { const int st = 2 * kp + hf;
                    sc[hf] = (f32x4){0.f, 0.f, 0.f, 0.f};
                    if (dir ? st >= tt : st <= tt) {
#pragma unroll
                        for (int ks = 0; ks < 2; ++ks) { const bf16x8 a = *(const LAS bf16x8*)(KL + (st * 16 + fr) * 144 + ks * 64 + fq * 16); sc[hf] = mfma16(a, bq[ks], sc[hf]); }
#pragma unroll
                        for (int r = 0; r < 4; ++r) { const int s_ = 16 * st + 4 * fq + r; const bool keep = dir ? (s_ >= t_) : (s_ <= t_); sc[hf][r] = keep ? sc[hf][r] : 0.f; }
                    } }
                if (dir ? (2 * kp + 1 >= tt) : (2 * kp <= tt)) {
                    u32x4 pw; pw.x = cvt_pk_bf16(sc[0][0], sc[0][1]); pw.y = cvt_pk_bf16(sc[0][2], sc[0][3]); pw.z = cvt_pk_bf16(sc[1][0], sc[1][1]); pw.w = cvt_pk_bf16(sc[1][2], sc[1][3]);
                    const bf16x8 pf = __builtin_bit_cast(bf16x8, pw);
                    const int s0 = 32 * kp + 4 * fq;
#pragma unroll
                    for (int vt = 0; vt < 4; ++vt) { const int v_ = 16 * vt + fr; const int sw = (v_ >> 3) & 7;
                        const LAS unsigned char* vr = lds + HG_VT + v_ * 144 + (s0 & 7) * 2;
                        const bf16x8 a = ld2x64(vr + (((s0 >> 3) ^ sw) << 4), vr + ((((s0 + 16) >> 3) ^ sw) << 4));
                        o[vt] = mfma16(a, pf, o[vt]); }
                }
            }
            LAS float* OOd = (LAS float*)(lds + (dir ? HG_FB : HG_FF));
#pragma unroll
            for (int vt = 0; vt < 4; ++vt)
#pragma unroll
                for (int r = 0; r < 4; ++r) OOd[t_ * 65 + 16 * vt + 4 * fq + r] = o[vt][r];
        }
        LDS_BAR();
        {
            float o[8]; float ss = 0.f;
#pragma unroll
            for (int j = 0; j < 8; ++j) { o[j] = FF[t * 65 + cg * 8 + j] + FB[t * 65 + cg * 8 + j]; ss += o[j] * o[j]; }
            ss += __builtin_bit_cast(float, __builtin_amdgcn_ds_swizzle(__builtin_bit_cast(int, ss), (1 << 10) | 0x1f));
            ss += __builtin_bit_cast(float, __builtin_amdgcn_ds_swizzle(__builtin_bit_cast(int, ss), (2 << 10) | 0x1f));
            ss += __builtin_bit_cast(float, __builtin_amdgcn_ds_swizzle(__builtin_bit_cast(int, ss), (4 << 10) | 0x1f));
            const float rstd = 1.f / sqrtf(ss * (1.f / 64.f) + EPS);
            const float* nw = p.hg_norm + l * 64 + cg * 8;
            float y[8];
#pragma unroll
            for (int j = 0; j < 8; ++j) { const float g = bf8(g8, j); y[j] = o[j] * rstd * nw[j] * g * __builtin_amdgcn_rcpf(1.f + __expf(-g)); }
            u32x4 ov; ov.x = cvt_pk_bf16(y[0], y[1]); ov.y = cvt_pk_bf16(y[2], y[3]); ov.z = cvt_pk_bf16(y[4], y[5]); ov.w = cvt_pk_bf16(y[6], y[7]);
            *(u32x4*)(p.MIX + (size_t)(row0 + t) * MIXD + 384 + h * 64 + cg * 8) = ov;
        }
        LDS_BAR();
    }
}


constexpr int AT_KC = 0, AT_VCT = 36864, AT_KL = AT_VCT + 64 * 528, AT_VL = AT_KL + 2 * 9216, AT_RPB = AT_VL + 2 * 9216, AT_END = AT_RPB + 1920;
static_assert(AT_END <= RING_BYTES && CTX == 256, "attention LDS layout (built for 256 context tokens)");
constexpr float ATHR = 6.f;
template <bool LOCAL, int NKB>
__device__ __forceinline__ void attn_step(const LAS unsigned char* Kb, const LAS unsigned char* Vb, int vstride, const bf16x8 (&qb)[2], f32x4 (&o)[4], float& m, float& lsum,
                                          int fr, int fq, int lane, const LAS float* rpb_row, const int (&boff)[8], const int (&voff)[4][2], int kbase) {
    f32x4 sc[2 * NKB];
#pragma unroll
    for (int mt = 0; mt < 2 * NKB; ++mt) { sc[mt] = (f32x4){0.f, 0.f, 0.f, 0.f};
#pragma unroll
        for (int ks = 0; ks < 2; ++ks) { const bf16x8 a = *(const LAS bf16x8*)(Kb + (16 * mt + fr) * 144 + ks * 64 + fq * 16); sc[mt] = mfma16(a, qb[ks], sc[mt]); } }
    float mx = -INFINITY;
#pragma unroll
    for (int mt = 0; mt < 2 * NKB; ++mt)
#pragma unroll
        for (int r = 0; r < 4; ++r) {
            float v = sc[mt][r];
            if (LOCAL) v += *(const LAS float*)((const LAS unsigned char*)rpb_row + boff[(4 * mt + r) & 7]);
            sc[mt][r] = v; mx = fmaxf(mx, v);
        }
    mx = fmaxf(mx, __builtin_bit_cast(float, __builtin_amdgcn_ds_swizzle(__builtin_bit_cast(int, mx), (16 << 10) | 0x1f)));
    mx = fmaxf(mx, __builtin_bit_cast(float, __builtin_amdgcn_ds_bpermute((lane ^ 32) << 2, __builtin_bit_cast(int, mx))));
    if (__builtin_amdgcn_ballot_w64(mx > m + ATHR) != 0ull) {
        const float mn = fmaxf(m, mx), corr = __builtin_amdgcn_exp2f(m - mn);
        m = mn; lsum *= corr;
#pragma unroll
        for (int dt = 0; dt < 4; ++dt) o[dt] = o[dt] * corr;
    }
    float ps = 0.f;
#pragma unroll
    for (int kb = 0; kb < NKB; ++kb) {
        float pv[8];
#pragma unroll
        for (int h2 = 0; h2 < 2; ++h2)
#pragma unroll
            for (int r = 0; r < 4; ++r) { const float e = __builtin_amdgcn_exp2f(sc[2 * kb + h2][r] - m); pv[4 * h2 + r] = e; ps += e; }
        u32x4 pw; pw.x = cvt_pk_bf16(pv[0], pv[1]); pw.y = cvt_pk_bf16(pv[2], pv[3]); pw.z = cvt_pk_bf16(pv[4], pv[5]); pw.w = cvt_pk_bf16(pv[6], pv[7]);
        const bf16x8 pf = __builtin_bit_cast(bf16x8, pw);
#pragma unroll
        for (int dt = 0; dt < 4; ++dt) {
            bf16x8 a;
            if (LOCAL) a = ld2x64(Vb + voff[dt][0], Vb + voff[dt][1]);
            else { const int d_ = 16 * dt + fr, sw_ = (d_ >> 3) & 7, c0_ = (kbase >> 3) + 4 * kb + (fq >> 1);
                const LAS unsigned char* vr = Vb + d_ * vstride + (fq & 1) * 8;
                a = ld2x64(vr + ((c0_ ^ sw_) << 4), vr + (((c0_ + 2) ^ sw_) << 4)); }
            o[dt] = mfma16(a, pf, o[dt]);
        }
    }
    lsum += ps;
}
__device__ __forceinline__ void phase_attn(const int tid, PRef p, int l, LAS unsigned char* lds) {
    const int wave = tid >> 6, lane = tid & 63, fr = lane & 15, fq = lane >> 4, skey = tid >> 3, sc8 = tid & 7;
    LAS float* RPB = (LAS float*)(lds + AT_RPB);
    constexpr int NPAIR = ROWS / 2, IPB = NPAIR + 2;
    const int G_ = gridDim.x, NIT = NB * NAH * IPB;
    const bool deal = (G_ == 256 && NIT <= 160 * 7 + 96 * 5);
    const int it_lo = deal ? ((int)blockIdx.x < 160 ? (int)blockIdx.x * 7 : 1120 + ((int)blockIdx.x - 160) * 5) : (int)blockIdx.x;
    const int it_n = deal ? ((int)blockIdx.x < 160 ? 7 : 5) : (NIT - (int)blockIdx.x + G_ - 1) / G_;
    int last_bh = -1;
    for (int ii = 0; ii < it_n; ++ii) {
        const int it = deal ? it_lo + ii : it_lo + ii * G_;
        if (it >= NIT) break;
        const int sub = it % IPB, bh = it / IPB, head = bh % NAH, b = bh / NAH;
        const bool islat = sub < NPAIR;
        const int r0 = 2 * sub, qr = r0 + (wave >> 2), jb = wave & 3;
        LDS_BAR();
        if (bh != last_bh) {
            last_bh = bh;
            for (int rnd = 0; rnd < 4; ++rnd) {
                const int key = skey + 64 * rnd; const bf16_t* src = p.P + (size_t)(NLAT + b * CTX + key) * INC + head * 64 + sc8 * 8;
                const u32x4 kv = *(const u32x4*)(src + OK_), vv = *(const u32x4*)(src + OV);
                *(LAS u32x4*)(lds + AT_KC + key * 144 + sc8 * 16) = kv;
#pragma unroll
                for (int j = 0; j < 8; ++j) *(LAS bf16_t*)(lds + AT_VCT + (sc8 * 8 + j) * 528 + ((((key >> 3) ^ sc8) << 4) + (key & 7) * 2)) = (bf16_t)(j & 1 ? vv[j >> 1] >> 16 : vv[j >> 1] & 0xffffu);
            }
            if (tid < 15 * 32) RPB[tid] = (tid & 31) < 31 ? p.rpb[((size_t)l * NAH + head) * 465 + (tid >> 5) * 31 + (tid & 31)] * 1.44269504089f : -INFINITY;
        }
        const int qtok = islat ? b * SEQ + qr * GW + 16 * jb + fr : NLAT + b * CTX + ((sub - NPAIR) * 128 + 16 * wave) + fr;
        bf16x8 qb[2];
#pragma unroll
        for (int ks = 0; ks < 2; ++ks) qb[ks] = *(const bf16x8*)(p.P + (size_t)qtok * INC + OQ + head * 64 + ks * 32 + fq * 8);
        int krlo = 0, krhi = -1, rs = 0;
        if (islat) { int a = r0 - 4; a = a < 0 ? 0 : (a > ROWS - 8 ? ROWS - 8 : a); int c = r0 + 1 - 4; c = c < 0 ? 0 : (c > ROWS - 8 ? ROWS - 8 : c); krlo = a; krhi = c + 7;
            rs = qr - 4; rs = rs < 0 ? 0 : (rs > ROWS - 8 ? ROWS - 8 : rs); }
        u32x4 kA = (u32x4){0u, 0u, 0u, 0u}, vA = kA, kB = kA, vB = kA;
#define AT_LOADROW(row, kd, vd) do { const bf16_t* src_ = p.P + (size_t)(b * SEQ + (row) * GW + skey) * INC + head * 64 + sc8 * 8; kd = *(const u32x4*)(src_ + OK_); vd = *(const u32x4*)(src_ + OV); } while (0)
#define AT_STAGEROW(bufi, kd, vd) do { *(LAS u32x4*)(lds + AT_KL + (bufi) * 9216 + skey * 144 + sc8 * 16) = kd; \
        _Pragma("unroll") for (int j = 0; j < 8; ++j) *(LAS bf16_t*)(lds + AT_VL + (bufi) * 9216 + (sc8 * 8 + j) * 144 + ((((skey >> 3) ^ sc8) << 4) + (skey & 7) * 2)) = (bf16_t)(j & 1 ? vd[j >> 1] >> 16 : vd[j >> 1] & 0xffffu); } while (0)
        if (islat) { AT_LOADROW(krlo, kA, vA); AT_LOADROW(krlo + 1, kB, vB); }
        f32x4 o[4]; float m = -1e30f, lsum = 0.f;
#pragma unroll
        for (int dt = 0; dt < 4; ++dt) o[dt] = (f32x4){0.f, 0.f, 0.f, 0.f};
        LDS_BAR();
        const int bs = jb == 0 ? 0 : (jb == 1 ? 8 : (jb == 2 ? 24 : 32)), qc = 16 * jb + fr;
        int boff[8], voff[4][2];
        { int ws = qc - 8; ws = ws < 0 ? 0 : (ws > 48 ? 48 : ws);
#pragma unroll
          for (int j_ = 0; j_ < 8; ++j_) { const int kc = bs + 16 * (j_ >> 2) + 4 * fq + (j_ & 3); const bool ok = kc >= ws && kc < ws + 16; boff[j_] = (ok ? kc - qc + 15 : 31) * 4; asm volatile("" : "+v"(boff[j_])); }
#pragma unroll
          for (int dt = 0; dt < 4; ++dt) { const int d_ = 16 * dt + fr, sw_ = (d_ >> 3) & 7, c0_ = (bs >> 3) + (fq >> 1);
              voff[dt][0] = d_ * 144 + (fq & 1) * 8 + ((c0_ ^ sw_) << 4); voff[dt][1] = d_ * 144 + (fq & 1) * 8 + (((c0_ + 2) ^ sw_) << 4); asm volatile("" : "+v"(voff[dt][0]), "+v"(voff[dt][1])); } }
        for (int st = 0; st < 4; ++st)
            attn_step<false, 2>(lds + AT_KC + st * 64 * 144, lds + AT_VCT, 528, qb, o, m, lsum, fr, fq, lane, RPB, boff, voff, st * 64);
        if (islat) { AT_STAGEROW(0, kA, vA); kA = kB; vA = vB; if (krlo + 2 <= krhi) AT_LOADROW(krlo + 2, kB, vB); }
        LDS_BAR();
        for (int kr = krlo; kr <= krhi; ++kr) {
            const int buf = (kr - krlo) & 1;
            if (kr >= rs && kr < rs + 8)
                attn_step<true, 1>(lds + AT_KL + buf * 9216 + bs * 144, lds + AT_VL + buf * 9216, 144, qb, o, m, lsum, fr, fq, lane, RPB + (kr - qr + 7) * 32, boff, voff, bs);
            if (kr < krhi) { AT_STAGEROW(buf ^ 1, kA, vA); kA = kB; vA = vB; if (kr + 3 <= krhi) AT_LOADROW(kr + 3, kB, vB); }
            LDS_BAR();
        }
#undef AT_LOADROW
#undef AT_STAGEROW
        lsum += __builtin_bit_cast(float, __builtin_amdgcn_ds_swizzle(__builtin_bit_cast(int, lsum), (16 << 10) | 0x1f));
        lsum += __builtin_bit_cast(float, __builtin_amdgcn_ds_bpermute((lane ^ 32) << 2, __builtin_bit_cast(int, lsum)));
        const float inv = 1.f / lsum;
        bf16_t* orow = p.MIX + (size_t)qtok * MIXD + head * 64;
#pragma unroll
        for (int dt = 0; dt < 4; ++dt) { u32x2 w; w.x = cvt_pk_bf16(o[dt][0] * inv, o[dt][1] * inv); w.y = cvt_pk_bf16(o[dt][2] * inv, o[dt][3] * inv); *(u32x2*)(orow + 16 * dt + 4 * fq) = w; }
    }
}


template <int MODE> __device__ __forceinline__ void mini_gemm(const int tid, PRef p, int l) {
    const int wave = tid >> 6, lane = tid & 63, fr = lane & 15, fq = lane >> 4;
    const int gw = blockIdx.x * NWAVES + wave, NGW = gridDim.x * NWAVES;
    constexpr int K = MODE == 3 ? ED : (MODE == 1 ? MIXD : D);
    constexpr int N = MODE == 0 ? INC : (MODE == 2 ? 2 * ED : D);
    constexpr int MROWS = MODE <= 1 ? NCTX : NSLOT_C;
    constexpr int NTC = MODE == 2 ? 2 : 1, TW = 16 * NTC;
    constexpr int NTN = N / TW, NT = (MROWS / 32) * NTN;
    for (int t = gw; t < NT; t += NGW) {
        const int rt = t / NTN, ct = t % NTN, c0 = ct * TW;
        const bf16_t* Bt; const bf16_t* arow[2];
        if (MODE == 0) { Bt = p.WIN_T; for (int mt = 0; mt < 2; ++mt) arow[mt] = p.H + (size_t)(NLAT + rt * 32 + 16 * mt + fr) * D; }
        else if (MODE == 1) { Bt = p.WOUT_T; for (int mt = 0; mt < 2; ++mt) arow[mt] = p.MIX + (size_t)(NLAT + rt * 32 + 16 * mt + fr) * MIXD; }
        else if (MODE == 2) { const int e = rt % NE; Bt = p.WGU_T + (size_t)e * 2 * ED * D;
            for (int mt = 0; mt < 2; ++mt) { int row = p.STOK[NSLOT_L + rt * 32 + 16 * mt + fr]; row = row < 0 ? 0 : (row >= NTOK ? NTOK - 1 : row); arow[mt] = p.H + (size_t)row * D; } }
        else { const int e = rt % NE; Bt = p.WD_T + (size_t)e * D * ED; for (int mt = 0; mt < 2; ++mt) arow[mt] = p.HID + (size_t)(NSLOT_L + rt * 32 + 16 * mt + fr) * ED; }
        const bf16_t* brow = Bt + (size_t)(c0 + fr) * K;
        f32x4 acc[2][NTC];
#pragma unroll
        for (int mt = 0; mt < 2; ++mt)
#pragma unroll
            for (int nt = 0; nt < NTC; ++nt) acc[mt][nt] = (f32x4){0.f, 0.f, 0.f, 0.f};
#pragma unroll 8
        for (int ks = 0; ks < K / 32; ++ks) {
            bf16x8 a[2], bfr[NTC];
#pragma unroll
            for (int mt = 0; mt < 2; ++mt) a[mt] = *(const bf16x8*)(arow[mt] + ks * 32 + fq * 8);
#pragma unroll
            for (int nt = 0; nt < NTC; ++nt) bfr[nt] = *(const bf16x8*)(brow + (size_t)(16 * nt) * K + ks * 32 + fq * 8);
#pragma unroll
            for (int mt = 0; mt < 2; ++mt)
#pragma unroll
                for (int nt = 0; nt < NTC; ++nt) acc[mt][nt] = mfma16(a[mt], bfr[nt], acc[mt][nt]);
        }
#pragma unroll
        for (int mt = 0; mt < 2; ++mt)
#pragma unroll
            for (int r = 0; r < 4; ++r) {
                const int lr = rt * 32 + 16 * mt + 4 * fq + r;
                if (MODE == 0) { bf16_t* o = p.P + (size_t)(NLAT + lr) * INC + c0 + fr;
#pragma unroll
                    for (int nt = 0; nt < NTC; ++nt) o[16 * nt] = f2bf(acc[mt][nt][r]); }
                else if (MODE == 1) { float* o = p.XC + (size_t)lr * D + c0 + fr; const float* g = p.MOD + ((size_t)l * 3 + 2) * NMOD + 2 * D + c0 + fr;
#pragma unroll
                    for (int nt = 0; nt < NTC; ++nt) o[16 * nt] += g[16 * nt] * acc[mt][nt][r]; }
                else if (MODE == 2) { bf16_t* o = p.HID + (size_t)(NSLOT_L + lr) * ED + c0 / 2 + fr;
#pragma unroll
                    for (int q = 0; q < NTC / 2; ++q) { const float g = acc[mt][2 * q][r], u = acc[mt][2 * q + 1][r]; o[16 * q] = f2bf(g / (1.f + __expf(-g)) * u); } }
                else { bf16_t* o = p.Y + (size_t)(NSLOT_L + lr) * D + c0 + fr; const float val = p.SVAL[NSLOT_L + lr];
#pragma unroll
                    for (int nt = 0; nt < NTC; ++nt) o[16 * nt] = f2bf(val * acc[mt][nt][r]); }
            }
    }
}


__device__ __forceinline__ void phase_conv(const int tid, PRef p, int l) {
    const float* w = p.conv_w + (size_t)l * 3 * CVD;
    for (long gid = (long)blockIdx.x * NTHR + tid; gid < (long)NTOK * (CVD / 8); gid += (long)gridDim.x * NTHR) {
        const int r = (int)(gid / (CVD / 8)), c8 = (int)(gid % (CVD / 8)) * 8;
        int t, T; if (r < NLAT) { t = r % SEQ; T = SEQ; } else { t = (r - NLAT) % CTX; T = CTX; }
        const bf16_t* pr = p.P + (size_t)r * INC + c8;
        float y[8];
#pragma unroll
        for (int j = 0; j < 8; ++j) y[j] = 0.f;
#pragma unroll
        for (int d = 0; d < 3; ++d) {
            const int tt = t + d - 1;
            if (tt >= 0 && tt < T) {
                const bf16_t* q = pr + (long)(d - 1) * INC; const u32x4 c = *(const u32x4*)(q + OCC), u = *(const u32x4*)(q + OCU);
                const f32x4 w0 = *(const f32x4*)(w + d * CVD + c8), w1 = *(const f32x4*)(w + d * CVD + c8 + 4);
#pragma unroll
                for (int j = 0; j < 8; ++j) y[j] += (j < 4 ? w0[j & 3] : w1[j & 3]) * bf8(c, j) * bf8(u, j);
            }
        }
        const u32x4 bg = *(const u32x4*)(pr + OCB);
        u32x4 o; o.x = cvt_pk_bf16(bf8(bg, 0) * y[0], bf8(bg, 1) * y[1]); o.y = cvt_pk_bf16(bf8(bg, 2) * y[2], bf8(bg, 3) * y[3]);
        o.z = cvt_pk_bf16(bf8(bg, 4) * y[4], bf8(bg, 5) * y[5]); o.w = cvt_pk_bf16(bf8(bg, 6) * y[6], bf8(bg, 7) * y[7]);
        *(u32x4*)(p.MIX + (size_t)r * MIXD + 768 + c8) = o;
    }
}
__device__ __forceinline__ void phase_qkprep(const int tid, PRef p, int l) {
    const int sub = tid & 7;
    constexpr int U = 4;
    const long ngroups = (long)NTOK * 12, gstride = ((long)gridDim.x * NTHR) >> 3;
    for (long g0 = ((long)blockIdx.x * NTHR + tid) >> 3; g0 < ngroups; g0 += gstride * U) {
        u32x4 raw[U]; bf16_t* ptr[U]; int rr[U]; int wh[U];
#pragma unroll
        for (int u = 0; u < U; ++u) { long g8 = g0 + u * gstride; const bool ok = g8 < ngroups; if (!ok) g8 = g0;
            rr[u] = ok ? (int)(g8 / 12) : -1; wh[u] = (int)(g8 % 12) / 6; const int head = (int)(g8 % 6);
            ptr[u] = p.P + (size_t)(g8 / 12) * INC + (wh[u] ? OK_ : OQ) + head * HD + sub * 8; raw[u] = *(const u32x4*)ptr[u]; }
#pragma unroll
        for (int u = 0; u < U; ++u) {
            const float* nw = (wh[u] ? p.k_norm : p.q_norm) + l * HD + sub * 8;
            float y[8]; float ss = 0.f;
#pragma unroll
            for (int j = 0; j < 8; ++j) { y[j] = bf8(raw[u], j); ss += y[j] * y[j]; }
            ss += __builtin_bit_cast(float, __builtin_amdgcn_ds_swizzle(__builtin_bit_cast(int, ss), (1 << 10) | 0x1f));
            ss += __builtin_bit_cast(float, __builtin_amdgcn_ds_swizzle(__builtin_bit_cast(int, ss), (2 << 10) | 0x1f));
            ss += __builtin_bit_cast(float, __builtin_amdgcn_ds_swizzle(__builtin_bit_cast(int, ss), (4 << 10) | 0x1f));
            const float rstd = 1.f / sqrtf(ss * (1.f / HD) + EPS);
#pragma unroll
            for (int j = 0; j < 8; ++j) y[j] = y[j] * rstd * nw[j];
            const int r = rr[u];
            const bool lat = r >= 0 && r < NLAT;
            const int t = lat ? r % SEQ : 0; const float pos = (sub & 4) ? (float)(t % GW) : (float)(t / GW);
            const bool second = (sub & 2) != 0;
#pragma unroll
            for (int j = 0; j < 8; ++j) {
                const float other = __builtin_bit_cast(float, __builtin_amdgcn_ds_swizzle(__builtin_bit_cast(int, y[j]), (2 << 10) | 0x1f));
                const int fi = (sub & 1) * 8 + j;
                const float ang = pos * __builtin_amdgcn_exp2f(-(float)fi * (13.287712379549449f / 16.f));
                const float cs = FCOS(ang), sn = FSIN(ang);
                const float rot = second ? y[j] * cs + other * sn : y[j] * cs - other * sn;
                y[j] = lat ? rot : y[j];
            }
            if (r >= 0) { u32x4 o; o.x = cvt_pk_bf16(y[0], y[1]); o.y = cvt_pk_bf16(y[2], y[3]); o.z = cvt_pk_bf16(y[4], y[5]); o.w = cvt_pk_bf16(y[6], y[7]); *(u32x4*)ptr[u] = o; }
        }
    }
}

__device__ __forceinline__ f32x4 bf4(const u32x2 w) { return (f32x4){bfw(w.x, 0), bfw(w.x, 1), bfw(w.y, 0), bfw(w.y, 1)}; }
template <int MODE> __device__ __forceinline__ void phase_rows(const int tid, PRef p, int l, LAS unsigned char* lds) {
    static_assert(D == 1024, "wave-per-row kernels assume D = 1024");
    const int lane = tid & 63, wave = tid >> 6;
    if (MODE == 1) {
        for (int k = tid; k < D; k += NTHR) { const f32x4* src = (const f32x4*)(p.w_router + ((size_t)l * D + k) * NE); LAS f32x4* dst = (LAS f32x4*)(lds + k * 64 + (k >> 2) * 16);
#pragma unroll
            for (int u = 0; u < 4; ++u) dst[u] = src[u]; }
        __syncthreads();
    }
    const int gw = blockIdx.x * NWAVES + wave, NGW = gridDim.x * NWAVES;
    const int rw = ((NTOK + NGW - 1) / NGW + 1) & ~1;
    const int r_lo = gw * rw, r_hi = min(NTOK, r_lo + rw);
    const bool doh = MODE != 2 || l + 1 < DEPTH;
    const int ln = (MODE == 2 && l + 1 < DEPTH) ? l + 1 : l;
    const float* nw = (MODE == 1 ? p.norm2_w : p.norm1_w) + (size_t)ln * D;
    int curset = -1; f32x4 Av[4], Sv[4], Gv[4];
#pragma unroll
    for (int j = 0; j < 4; ++j) { Av[j] = (f32x4){0.f, 0.f, 0.f, 0.f}; Sv[j] = Av[j]; Gv[j] = Av[j]; }
    f32x4 vn[2][4]; int invn[2] = {-1, -1};
#define ROWS_LOADPAIR(rb) do { _Pragma("unroll") for (int i_ = 0; i_ < 2; ++i_) { const int rr_ = ((rb) + i_ < r_hi) ? (rb) + i_ : (rb); \
        const float* src_ = MODE == 0 ? (rr_ < NLAT ? p.x + (size_t)rr_ * D : p.ctx + (size_t)(rr_ - NLAT) * D) : xrow(p, rr_); \
        _Pragma("unroll") for (int j_ = 0; j_ < 4; ++j_) vn[i_][j_] = *(const f32x4*)(src_ + 4 * lane + 256 * j_); \
        if (MODE == 2) invn[i_] = lane < NE ? p.INV[(size_t)rr_ * NE + lane] : -1; } } while (0)
#pragma unroll
    for (int i = 0; i < 2; ++i)
#pragma unroll
        for (int j = 0; j < 4; ++j) vn[i][j] = (f32x4){0.f, 0.f, 0.f, 0.f};
    if (r_lo < r_hi) ROWS_LOADPAIR(r_lo);
#pragma unroll 1
    for (int r = r_lo; r < r_hi; r += 2) {
        const bool two = r + 1 < r_hi;
        const int set = modset(r);
        if (set != curset) { curset = set;
            const float* mod = p.MOD + ((size_t)ln * 3 + set) * NMOD; const float* shift = mod + (MODE == 1 ? 3 : 0) * D; const float* scale = mod + (MODE == 1 ? 4 : 1) * D;
            int lane2 = lane; asm volatile("" : "+v"(lane2));
#pragma unroll
            for (int j = 0; j < 4; ++j) { const int c = 4 * lane2 + 256 * j; const f32x4 w4 = *(const f32x4*)(nw + c), sc4 = *(const f32x4*)(scale + c); Av[j] = w4 * (sc4 + 1.f); Sv[j] = *(const f32x4*)(shift + c);
                if (MODE == 2) Gv[j] = *(const f32x4*)(p.MOD + ((size_t)l * 3 + set) * NMOD + 5 * D + c); } }
        f32x4 v[2][4]; int inv2[2];
#pragma unroll
        for (int i = 0; i < 2; ++i) { inv2[i] = invn[i];
#pragma unroll
            for (int j = 0; j < 4; ++j) v[i][j] = vn[i][j]; }
        if (r + 2 < r_hi) ROWS_LOADPAIR(r + 2);
        if (MODE == 2) {
#pragma unroll
            for (int i = 0; i < 2; ++i) {
                const int myinv = inv2[i];
                unsigned long long mask = __ballot(myinv >= 0 && myinv < NSLOT);
                f32x4 acc[4];
#pragma unroll
                for (int j = 0; j < 4; ++j) acc[j] = (f32x4){0.f, 0.f, 0.f, 0.f};
                while (mask) {
                    const int e0 = __builtin_ctzll(mask); mask &= mask - 1; const int s0 = __builtin_amdgcn_readlane(myinv, e0);
                    int s1 = -1; if (mask) { const int e1 = __builtin_ctzll(mask); mask &= mask - 1; s1 = __builtin_amdgcn_readlane(myinv, e1); }
                    u32x2 y0[4], y1[4];
#pragma unroll
                    for (int j = 0; j < 4; ++j) y0[j] = *(const u32x2*)(p.Y + (size_t)s0 * D + 4 * lane + 256 * j);
                    if (s1 >= 0) {
#pragma unroll
                        for (int j = 0; j < 4; ++j) y1[j] = *(const u32x2*)(p.Y + (size_t)s1 * D + 4 * lane + 256 * j);
                    }
#pragma unroll
                    for (int j = 0; j < 4; ++j) acc[j] = acc[j] + bf4(y0[j]);
                    if (s1 >= 0) {
#pragma unroll
                        for (int j = 0; j < 4; ++j) acc[j] = acc[j] + bf4(y1[j]);
                    }
                }
#pragma unroll
                for (int j = 0; j < 4; ++j) v[i][j] = v[i][j] + Gv[j] * acc[j];
            }
        }
        if ((MODE == 0 && r >= NLAT) || MODE == 2) {
#pragma unroll
            for (int i = 0; i < 2; ++i) if (i == 0 || two) { float* dst = xrow(p, r + i);
#pragma unroll
                for (int j = 0; j < 4; ++j) *(f32x4*)(dst + 4 * lane + 256 * j) = v[i][j]; }
        }
        if (doh) {
            float ss[2];
#pragma unroll
            for (int i = 0; i < 2; ++i) { float a = 0.f;
#pragma unroll
                for (int j = 0; j < 4; ++j) a += (v[i][j][0] * v[i][j][0] + v[i][j][1] * v[i][j][1]) + (v[i][j][2] * v[i][j][2] + v[i][j][3] * v[i][j][3]);
                ss[i] = a; }
            ss[0] = wave_sum(ss[0], lane); ss[1] = wave_sum(ss[1], lane);
            const float rstd0 = 1.f / sqrtf(ss[0] * (1.f / D) + EPS), rstd1 = 1.f / sqrtf(ss[1] * (1.f / D) + EPS);
            f32x4 hh[2][4];
#pragma unroll
            for (int j = 0; j < 4; ++j) {
                const int c = 4 * lane + 256 * j;
                hh[0][j] = v[0][j] * rstd0 * Av[j] + Sv[j]; hh[1][j] = v[1][j] * rstd1 * Av[j] + Sv[j];
                u32x2 o; o.x = cvt_pk_bf16(hh[0][j][0], hh[0][j][1]); o.y = cvt_pk_bf16(hh[0][j][2], hh[0][j][3]);
                *(u32x2*)(p.H + (size_t)r * D + c) = o;
                if (two) { o.x = cvt_pk_bf16(hh[1][j][0], hh[1][j][1]); o.y = cvt_pk_bf16(hh[1][j][2], hh[1][j][3]); *(u32x2*)(p.H + (size_t)(r + 1) * D + c) = o; }
            }
            if (MODE == 1) {
                LAS float* red = (LAS float*)(lds + 70144 + wave * 4224);
#pragma unroll
                for (int i = 0; i < 2; ++i) {
                    float lg[NE];
#pragma unroll
                    for (int e = 0; e < NE; ++e) lg[e] = 0.f;
#pragma unroll
                    for (int j = 0; j < 4; ++j)
#pragma unroll
                        for (int q = 0; q < 4; ++q) { const int k = 4 * lane + 256 * j + q; const LAS f32x4* wr = (const LAS f32x4*)(lds + k * 64 + (k >> 2) * 16); const float hv = hh[i][j][q];
#pragma unroll
                            for (int u = 0; u < 4; ++u) { const f32x4 w = wr[u]; lg[4 * u + 0] += hv * w[0]; lg[4 * u + 1] += hv * w[1]; lg[4 * u + 2] += hv * w[2]; lg[4 * u + 3] += hv * w[3]; } }
#pragma unroll
                    for (int e = 0; e < NE; ++e) red[e * 65 + lane] = lg[e];
                    asm volatile("" ::: "memory");
                    const int e2 = lane & 15, part = lane >> 4;
                    float t = 0.f;
#pragma unroll
                    for (int x = 0; x < 16; ++x) t += red[e2 * 65 + part * 16 + x];
                    asm volatile("" ::: "memory");
                    t += __builtin_bit_cast(float, __builtin_amdgcn_ds_swizzle(__builtin_bit_cast(int, t), (16 << 10) | 0x1f));
                    t += __builtin_bit_cast(float, __builtin_amdgcn_ds_bpermute((lane ^ 32) << 2, __builtin_bit_cast(int, t)));
#define SWZF(x, d) __builtin_bit_cast(float, __builtin_amdgcn_ds_swizzle(__builtin_bit_cast(int, (x)), ((d) << 10) | 0x1f))
                    float m = t;
                    m = fmaxf(m, SWZF(m, 1)); m = fmaxf(m, SWZF(m, 2)); m = fmaxf(m, SWZF(m, 4)); m = fmaxf(m, SWZF(m, 8));
                    const float ex = expf(t - m); float sm = ex;
                    sm += SWZF(sm, 1); sm += SWZF(sm, 2); sm += SWZF(sm, 4); sm += SWZF(sm, 8);
#undef SWZF
                    if (lane < NE && (i == 0 || two)) p.AFF[(size_t)(r + i) * NE + lane] = ex / sm;
                }
            }
        }
    }
#undef ROWS_LOADPAIR
    if (MODE == 1) __syncthreads();
}


__device__ __forceinline__ void phase_adaln(const int tid, PRef p, LAS unsigned char* lds) {
    static_assert(D == 1024 && NMOD % 256 == 0, "adaln layout");
    const int lane = tid & 63, wave = tid >> 6;
    LAS float* SC = (LAS float*)lds;
    LAS float* RED = (LAS float*)(lds + 16384);
    for (int i = tid; i < 3 * D; i += NTHR) { const int st = i / D, k = i % D; const float cv = st < 2 ? p.c[st * D + k] : p.c_ctx[k]; SC[i] = cv / (1.f + __expf(-cv)); }
    __syncthreads();
    constexpr int NCG = NMOD / 256;
    for (int item = blockIdx.x; item < DEPTH * NCG * 2; item += gridDim.x) {
        const int l = item / (NCG * 2), rem = item % (NCG * 2), cgp = rem >> 1, kh = rem & 1;
        const int kbase = kh * 512 + wave * 64;
        const float* wp = p.w_mod + ((size_t)l * D + kbase) * NMOD + cgp * 256 + 4 * lane;
        f32x4 acc[3];
#pragma unroll
        for (int st = 0; st < 3; ++st) acc[st] = (f32x4){0.f, 0.f, 0.f, 0.f};
#pragma unroll 16
        for (int kk = 0; kk < 64; ++kk) { const f32x4 w = *(const f32x4*)(wp + (size_t)kk * NMOD);
#pragma unroll
            for (int st = 0; st < 3; ++st) acc[st] = acc[st] + w * SC[st * D + kbase + kk]; }
#pragma unroll
        for (int st = 0; st < 3; ++st) *(LAS f32x4*)(RED + (wave * 3 + st) * 256 + 4 * lane) = acc[st];
        __syncthreads();
        for (int o = tid; o < 3 * 256; o += NTHR) { const int st = o >> 8, n = o & 255; float v = 0.f;
#pragma unroll
            for (int w8 = 0; w8 < 8; ++w8) v += RED[(w8 * 3 + st) * 256 + n];
            if (kh == 0) v += p.b_mod[(size_t)l * NMOD + cgp * 256 + n];
            atomicAdd(p.MOD + ((size_t)l * 3 + st) * NMOD + cgp * 256 + n, v); }
        __syncthreads();
    }
}

constexpr int NPL = 11, NPH = 1 + DEPTH * NPL;
struct Args { Params p; int ph_lo, ph_hi; };
__global__ void __launch_bounds__(NTHR, 2) mega_fwd(Args args) {
    LAS unsigned char* lds = (LAS unsigned char*)lds_raw;
    {
        const int tid0 = threadIdx.x;
        for (int u = tid0; u < (LDS_BYTES - LDSCTL_OFF) / 4; u += NTHR) ((LAS unsigned*)(lds + LDSCTL_OFF))[u] = 0u;
        __syncthreads();
    }
    int wslot = 0;
    { unsigned m_ = ~0u; asm volatile("" : "+s"(m_));
      const int simd = (int)(__builtin_amdgcn_s_getreg((1 << 11) | (4 << 6) | 4) & 3u);
      if (__builtin_amdgcn_mbcnt_hi(m_, __builtin_amdgcn_mbcnt_lo(m_, 0u)) == 0) wslot = simd + 4 * (int)__hip_atomic_fetch_add(((unsigned*)(lds_raw + MISC_OFF + 64)) + simd, 1u, __ATOMIC_RELAXED, __HIP_MEMORY_SCOPE_WORKGROUP); }
    wslot = __builtin_amdgcn_readfirstlane(wslot) & 7;
#define MY_TID(var) int var; { unsigned m_ = ~0u; asm volatile("" : "+s"(m_)); var = wslot * 64 + (int)__builtin_amdgcn_mbcnt_hi(m_, __builtin_amdgcn_mbcnt_lo(m_, 0u)); } asm volatile("" : "+v"(var))
    XcdBarrier bar; bar.bar = args.p.CTL; bar.x = 0;
    const bool multi = args.ph_hi - args.ph_lo > 1;
    if (multi) { MY_TID(t0); bar = xcd_barrier_post(args.p.CTL, t0 == 0); }
    const int G = gridDim.x;
    const int ph_lo = args.ph_lo, ph_hi = args.ph_hi;
#ifndef PHMASK
#define PHMASK 0xFFFF
#endif
#define PH_ON(k) ((k) == 0 ? (PHMASK & 1) : ((PHMASK >> (1 + ((k) - 1) % NPL)) & 1))
#ifndef REPMASK
#define REPMASK 0
#endif
#ifndef REP_LOCAL
#define REP_LOCAL 0
#define REP_CONV 0
#define REP_ATTN 0
#endif
#ifndef REP_P0
#define REP_P0 0
#endif
#define REP_N(k) (((k) == 0 && REP_P0) ? 2 : (((k) > 0 && ((REPMASK >> (((k) - 1) % NPL)) & 1)) ? 2 : 1))
#define PH_BEGIN(k) if (PH_ON(k) && ph_lo <= (k) && (k) < ph_hi) { for (int rep_ = 0; rep_ < REP_N(k); ++rep_) { const AS4 Args* kp = (const AS4 Args*)__builtin_amdgcn_kernarg_segment_ptr(); asm volatile("" : "+s"(kp)); PRef p = kp->p; MY_TID(tid);
#define PH_END_IF(k, cond) } if ((cond) && (k) + 1 < ph_hi) { MY_TID(t1); xcd_barrier(bar, t1 == 0, XB_ST(lds_raw)); } }
#ifndef REP_CVT
#define REP_CVT 0
#endif
#ifndef REP_BAR
#define REP_BAR 0
#endif
#define PH_END(k) } if ((k) + 1 < ph_hi) { for (int rb_ = 0; rb_ < 1 + REP_BAR; ++rb_) { MY_TID(t1); xcd_barrier(bar, t1 == 0, XB_ST(lds_raw)); } } }
    PH_BEGIN(0)
        phase_adaln(tid, p, lds);
        run_items<b_lb>(tid, p, 0, 2L * 384, 0);
        phase_convert(tid, p, 0, lds, 1, 0);
    PH_END(0)
#define LAYER(l)                                                                                                                                     \
    PH_BEGIN(1 + (l) * NPL + 0) if ((l) == 0) { phase_rows<0>(tid, p, 0, lds); } PH_END_IF(1 + (l) * NPL + 0, (l) == 0)                                 \
    PH_BEGIN(1 + (l) * NPL + 1) {                                                                                                                    \
        pg8::Gemm g{p.H, p.WIN_T, NTOK, INC, D, nullptr, 0, 1, 0}; pg8::StaticOrder S; S.init(NTOK, INC, G, (int)blockIdx.x);                         \
        pg8::EpiP E{p.P, INC, p.q_norm + (l) * HD, p.k_norm + (l) * HD, rep_};                                                    \
        pg8::gemm_phase<pg8::EpiP, false>(tid, lds, g, S, E);                                                                                     \
        } PH_END(1 + (l) * NPL + 1)               \
    PH_BEGIN(1 + (l) * NPL + 2) if constexpr (!FUSE_QK) { phase_qkprep(tid, p, l); } if constexpr (FAST_HGRN && (HGRN_DIAG == 3 || HGRN_DIAG == 4)) { phase_hgrn_local(tid, p, l, lds); { MY_TID(t7); run_items<b_hgrn_local_slow>(t7, p, l, 2L * NBH * NCH * 64, 0); } } else if constexpr (FAST_HGRN && HGRN_DIAG >= 2) { run_items<b_hgrn_local_slow>(tid, p, l, 2L * NBH * NCH * 64, 0); } else if constexpr (FAST_HGRN) { for (int r2_ = 0; r2_ < 1 + REP_LOCAL; ++r2_) phase_hgrn_local(tid, p, l, lds); } else { run_items<b_gates>(tid, p, l, (long)NTOK * 768, 0); } phase_conv(tid, p, l); PH_END(1 + (l) * NPL + 2) \
    PH_BEGIN(1 + (l) * NPL + 3) if constexpr (FAST_HGRN && HGRN_DIAG) { run_items<b_hgrn_scan_slow>(tid, p, l, 2L * NBH * 4096, 0); } else if constexpr (FAST_HGRN) { phase_hgrn_scan(tid, p); } else { run_items<b_hgrn_seq2>(tid, p, l, 2L * NB * HGH * 64, 0); } if constexpr (FAST_ATTN) { for (int r4_ = 0; r4_ < 1 + REP_ATTN; ++r4_) { MY_TID(t6); phase_attn(t6, p, l, lds); } } else { run_items<b_attn>(tid, p, l, (long)NTOK * NAH, 0); } PH_END(1 + (l) * NPL + 3) \
    PH_BEGIN(1 + (l) * NPL + 4) if constexpr (FAST_HGRN && HGRN_DIAG) { run_items<b_hgrn_chunkseq>(tid, p, l, 2L * NBH * NCH * 64, 0); { MY_TID(t9); xcd_barrier(bar, t9 == 0, XB_ST(lds_raw)); } { MY_TID(t8); run_items<b_hgfin>(t8, p, l, (long)NTOK * HGH, 0); } } else if constexpr (FAST_HGRN) { phase_hgrn_out(tid, p, l, lds); } else { run_items<b_hgfin>(tid, p, l, (long)NTOK * HGH, 0); } PH_END(1 + (l) * NPL + 4)                                         \
    PH_BEGIN(1 + (l) * NPL + 5) {                                                                                                                    \
        pg8::Gemm g{p.MIX, p.WOUT_T, NLAT, D, MIXD, nullptr, 0, 1, 0}; pg8::StaticOrder S; S.init(NLAT, D, G, (int)blockIdx.x);                       \
        pg8::EpiRes E{p.XL, (l) == 0 ? p.x : p.XL, D, p.MOD + (size_t)(l) * 3 * NMOD + 2 * D, SEQ, (size_t)NMOD};                                                           \
        pg8::gemm_phase<pg8::EpiRes, false>(tid, lds, g, S, E);                                                                                      \
        if ((l) + 1 < DEPTH) { MY_TID(tid2); mini_gemm<1>(tid2, p, l); } } PH_END(1 + (l) * NPL + 5)                  \
    PH_BEGIN(1 + (l) * NPL + 6) phase_rows<1>(tid, p, l, lds); PH_END(1 + (l) * NPL + 6)                                                               \
    PH_BEGIN(1 + (l) * NPL + 7) if constexpr (FAST_TOPK) { phase_topk(tid, p, lds); if ((l) == 0 && gridDim.x > 2 * NB * NE + 32) { MY_TID(t4); phase_convert(t4, p, 0, lds, 2, 2 * NB * NE); } else if ((l) == 0) { MY_TID(t4); phase_convert(t4, p, 0, lds, 2, 0); } } else { run_items<b_rank>(tid, p, l, (long)NTOK * NE, 0); } PH_END(1 + (l) * NPL + 7)                                          \
    PH_BEGIN(1 + (l) * NPL + 8) {                                                                                                                    \
        pg8::Gemm g{p.H, p.WGU_T, NSLOT_L, 2 * ED, D, p.STOK, CAPL / 256, NE, (size_t)2 * ED * D * 2}; pg8::StaticOrder S; S.init(NSLOT_L, 2 * ED, G, (int)blockIdx.x); \
        pg8::EpiHid E{p.HID, ED};                                                                                                                    \
        pg8::gemm_phase<pg8::EpiHid, true>(tid, lds, g, S, E);                                                                                       \
        if ((l) + 1 < DEPTH) { MY_TID(tid2); mini_gemm<2>(tid2, p, l); } } PH_END(1 + (l) * NPL + 8)              \
    PH_BEGIN(1 + (l) * NPL + 9) {                                                                                                                    \
        pg8::Gemm g{p.HID, p.WD_T, NSLOT_L, D, ED, nullptr, CAPL / 256, NE, (size_t)D * ED * 2}; pg8::StaticOrder S; S.init(NSLOT_L, D, G, (int)blockIdx.x); \
        pg8::EpiBf16 E{p.Y, D, p.SVAL, 0};                                                                                                              \
        pg8::gemm_phase<pg8::EpiBf16, false>(tid, lds, g, S, E);                                                                                     \
        if ((l) + 1 < DEPTH) { MY_TID(tid2); mini_gemm<3>(tid2, p, l); } } PH_END(1 + (l) * NPL + 9)                \
    PH_BEGIN(1 + (l) * NPL + 10) phase_rows<2>(tid, p, l, lds); if ((l) + 1 < DEPTH) { for (int rc_ = 0; rc_ < 1 + REP_CVT; ++rc_) { MY_TID(t5); phase_convert(t5, p, (l) + 1, lds); } } PH_END(1 + (l) * NPL + 10)
#ifndef NLAYERS_BUILD
#define NLAYERS_BUILD DEPTH
#endif
    LAYER(0)
    if constexpr (NLAYERS_BUILD > 1) { LAYER(1) }
    if constexpr (NLAYERS_BUILD > 2) { LAYER(2) }
    if constexpr (NLAYERS_BUILD > 3) { LAYER(3) }
}

#ifndef MK_SPLIT
#define MK_SPLIT 0
#endif
extern "C" void kernel_launch(void* const* d_in, const int* in_sizes, int n_in, void* d_out, int out_size, void* d_ws, size_t ws_size,
                              hipStream_t stream) {
    static int grid = 0;
    if (grid == 0) {
        if (n_in != 20 || out_size != NLAT * D || ws_size < WS_END) { fprintf(stderr, "kernel_launch: unexpected problem (n_in %d out %d ws %zu need %zu)\n", n_in, out_size, ws_size, (size_t)WS_END); grid = -1; return; }
        int dev = 0, cus = 0;
        if (hipGetDevice(&dev) != hipSuccess || hipDeviceGetAttribute(&cus, hipDeviceAttributeMultiprocessorCount, dev) != hipSuccess) { grid = -1; return; }
        if (hipFuncSetAttribute((const void*)mega_fwd, hipFuncAttributeMaxDynamicSharedMemorySize, LDS_BYTES) != hipSuccess) { fprintf(stderr, "kernel_launch: hipFuncSetAttribute failed\n"); grid = -1; return; }
        int per_cu = 0;
        if (hipOccupancyMaxActiveBlocksPerMultiprocessor(&per_cu, (const void*)mega_fwd, NTHR, LDS_BYTES) != hipSuccess || per_cu < 1) { fprintf(stderr, "kernel_launch: occupancy query says %d\n", per_cu); }
        (void)hipGetLastError();
        grid = cus;
    }
    if (grid < 0) return;
    (void)hipMemsetAsync((char*)d_ws + WS_CTL, 0, WS_LB - WS_CTL, stream);
    Args a{};
    a.p = make_params(d_in, d_out, d_ws);
#if MK_SPLIT
    for (int ph = 0; ph < NPH; ++ph) { a.ph_lo = ph; a.ph_hi = ph + 1; hipLaunchKernelGGL(mega_fwd, dim3(grid), dim3(NTHR), LDS_BYTES, stream, a); }
#else
    a.ph_lo = 0; a.ph_hi = NPH;
    hipLaunchKernelGGL(mega_fwd, dim3(grid), dim3(NTHR), LDS_BYTES, stream, a);
#endif
}
#endif
```

```cpp
#ifndef CPU_SIM
#include <hip/hip_runtime.h>
#define BODY __device__ __forceinline__
#define FSIN(x) __sinf(x)
#define FCOS(x) __cosf(x)
#else
#include <cmath>
#include <cstdio>
#include <cstdlib>
#include <cstring>
#define BODY static inline
#define FSIN(x) sinf(x)
#define FCOS(x) cosf(x)
#endif
#include <stdint.h>
#include <stddef.h>

#ifndef CFG_D
#define CFG_D 1024
#define CFG_SEQ 16384
#define CFG_CTX 256
#define CFG_EDIM 512
#define CFG_DEPTH 4
#endif

typedef unsigned short bf16_t;

constexpr int D = CFG_D, NB = 2, SEQ = CFG_SEQ, DEPTH = CFG_DEPTH, GW = 64, ROWS = SEQ / GW, CTX = CFG_CTX;
constexpr int HD = 64, NAH = 6, HGH = 6, CVD = 256, MIXD = 1024, INC = 3840, NMOD = 6 * D;
constexpr int NE = 16, ED = CFG_EDIM, CAPL = 2 * SEQ / NE, CAPC = 2 * CTX / NE;
constexpr int NLAT = NB * SEQ, NCTX = NB * CTX, NTOK = NLAT + NCTX;
constexpr int NSLOT_L = NB * NE * CAPL, NSLOT_C = NB * NE * CAPC, NSLOT = NSLOT_L + NSLOT_C;
constexpr int OQ = 0, OK_ = 384, OV = 768, OHQ = 1152, OFF_ = 1536, OFB = 1920, OHI = 2304, OHG_ = 2688, OCB = 3072, OCC = 3328, OCU = 3584;
constexpr float EPS = 1e-6f;
constexpr int NCH = (CTX + SEQ) / 64, NCHC = CTX / 64, NBH = NB * HGH;

struct Params {
    const float *x, *c, *ctx, *c_ctx, *w_mod, *b_mod, *norm1_w, *w_in, *q_norm, *k_norm, *rpb, *lb_logits, *hg_norm, *conv_w, *w_out,
        *norm2_w, *w_router, *w_gate, *w_up, *w_down;
    float *XL, *XC, *MOD, *LB, *AFF, *SVAL, *FG, *OHG;
    bf16_t *H, *P, *MIX, *HID, *Y;
    int *STOK, *INV;
    bf16_t *WIN_T, *WOUT_T, *WGU_T, *WD_T;
    unsigned* CTL;
    bf16_t* SLOC;
    float* GDEC;
};

#ifndef CPU_SIM
#define AS4 __attribute__((address_space(4)))
typedef const AS4 Params& PRef;
#else
typedef const Params& PRef;
#endif
BODY float bf2f(bf16_t v) { return __builtin_bit_cast(float, (unsigned)v << 16); }
BODY bf16_t f2bf(float f) { unsigned u = __builtin_bit_cast(unsigned, f); u += 0x7fffu + ((u >> 16) & 1u); return (bf16_t)(u >> 16); }
BODY float silu_f(float x) { return x / (1.f + expf(-x)); }
BODY float sigmoid_f(float x) { return 1.f / (1.f + expf(-x)); }
BODY int modset(int r) { return r < NLAT ? r / SEQ : 2; }
BODY float* xrow(PRef p, int r) { return r < NLAT ? p.XL + (size_t)r * D : p.XC + (size_t)(r - NLAT) * D; }

BODY void b_adaln(long gid, PRef p, int) {
    const int n = (int)(gid % NMOD), s = (int)((gid / NMOD) % 3), l = (int)(gid / (3 * NMOD));
    const float* cv = s < 2 ? p.c + s * D : p.c_ctx;
    const float* w = p.w_mod + (size_t)l * D * NMOD + n;
    float acc = 0.f;
    for (int k = 0; k < D; ++k) acc += silu_f(cv[k]) * w[(size_t)k * NMOD];
    p.MOD[gid] = acc + p.b_mod[l * NMOD + n];
}
BODY void b_lb(long gid, PRef p, int) {
    const int dir = (int)(gid / 384), j = (int)(gid % 384);
    const float* lg = p.lb_logits + (size_t)dir * DEPTH * 384 + j;
    float m = -INFINITY;
    for (int l = 0; l < DEPTH; ++l) m = fmaxf(m, lg[l * 384]);
    float s = 0.f;
    for (int l = 0; l < DEPTH; ++l) s += expf(lg[l * 384] - m);
    float cum = 0.f;
    p.LB[(dir * DEPTH + 0) * 384 + j] = 0.f;
    for (int l = 1; l < DEPTH; ++l) { cum += expf(lg[l * 384] - m) / s; p.LB[(dir * DEPTH + l) * 384 + j] = cum; }
}
BODY void b_copyx(long gid, PRef p, int) {
    if (gid < (long)NLAT * D) p.XL[gid] = p.x[gid]; else p.XC[gid - (long)NLAT * D] = p.ctx[gid - (long)NLAT * D];
}
template <int WHICH> BODY void b_prenorm(long gid, PRef p, int l) {
    const int r = (int)gid;
    const float* xr = xrow(p, r);
    const float* nw = (WHICH ? p.norm2_w : p.norm1_w) + l * D;
    const float* mod = p.MOD + ((size_t)l * 3 + modset(r)) * NMOD;
    const float* shift = mod + (WHICH ? 3 : 0) * D;
    const float* scale = mod + (WHICH ? 4 : 1) * D;
    float ss = 0.f;
    for (int k = 0; k < D; ++k) ss += xr[k] * xr[k];
    const float rstd = 1.f / sqrtf(ss / D + EPS);
    float lg[NE];
#pragma unroll
    for (int e = 0; e < NE; ++e) lg[e] = 0.f;
    for (int k = 0; k < D; ++k) {
        const float h = xr[k] * rstd * nw[k] * (1.f + scale[k]) + shift[k];
        p.H[(size_t)r * D + k] = f2bf(h);
        if (WHICH) {
            const float* wr = p.w_router + ((size_t)l * D + k) * NE;
#pragma unroll
            for (int e = 0; e < NE; ++e) lg[e] += h * wr[e];
        }
    }
    if (WHICH) {
        float m = lg[0];
#pragma unroll
        for (int e = 1; e < NE; ++e) m = fmaxf(m, lg[e]);
        float s = 0.f;
#pragma unroll
        for (int e = 0; e < NE; ++e) { lg[e] = expf(lg[e] - m); s += lg[e]; }
#pragma unroll
        for (int e = 0; e < NE; ++e) p.AFF[(size_t)r * NE + e] = lg[e] / s;
    }
}
BODY void b_gemm_in(long gid, PRef p, int l) {
    const int r = (int)(gid / (INC / 4)), n = (int)(gid % (INC / 4)) * 4;
    const bf16_t* a = p.H + (size_t)r * D;
    const float* w = p.w_in + (size_t)l * D * INC + n;
    float a0 = 0.f, a1 = 0.f, a2 = 0.f, a3 = 0.f;
    for (int k = 0; k < D; ++k) { const float av = bf2f(a[k]); const float* wk = w + (size_t)k * INC; a0 += av * wk[0]; a1 += av * wk[1]; a2 += av * wk[2]; a3 += av * wk[3]; }
    bf16_t* o = p.P + (size_t)r * INC + n;
    o[0] = f2bf(a0); o[1] = f2bf(a1); o[2] = f2bf(a2); o[3] = f2bf(a3);
}
BODY void b_qkprep(long gid, PRef p, int l) {
    const int r = (int)(gid / 12), which = (int)(gid % 12) / 6, head = (int)(gid % 6);
    bf16_t* ptr = p.P + (size_t)r * INC + (which ? OK_ : OQ) + head * HD;
    const float* nw = (which ? p.k_norm : p.q_norm) + l * HD;
    float y[HD];
    float ss = 0.f;
#pragma unroll
    for (int d = 0; d < HD; ++d) { y[d] = bf2f(ptr[d]); ss += y[d] * y[d]; }
    const float rstd = 1.f / sqrtf(ss / HD + EPS);
#pragma unroll
    for (int d = 0; d < HD; ++d) y[d] = y[d] * rstd * nw[d];
    if (r < NLAT) {
        const int t = r % SEQ; const float row = (float)(t / GW), col = (float)(t % GW);
#pragma unroll
        for (int d = 0; d < 16; ++d) {
            const float inv = powf(10000.f, -(float)d / 16.f);
            const float ar = row * inv, ac = col * inv;
            const float cr = FCOS(ar), sr = FSIN(ar), cc = FCOS(ac), sc = FSIN(ac);
            const float x0 = y[d], x1 = y[d + 16], x2 = y[d + 32], x3 = y[d + 48];
            y[d] = x0 * cr - x1 * sr; y[d + 16] = x1 * cr + x0 * sr; y[d + 32] = x2 * cc - x3 * sc; y[d + 48] = x3 * cc + x2 * sc;
        }
    }
#pragma unroll
    for (int d = 0; d < HD; ++d) ptr[d] = f2bf(y[d]);
}
BODY void b_attn(long gid, PRef p, int l) {
    const int r = (int)(gid / NAH), head = (int)(gid % NAH);
    float q[HD], acc[HD];
    const bf16_t* qp = p.P + (size_t)r * INC + OQ + head * HD;
#pragma unroll
    for (int d = 0; d < HD; ++d) { q[d] = bf2f(qp[d]) * 0.125f; acc[d] = 0.f; }
    float m = -INFINITY, s = 0.f;
    const int b = r < NLAT ? r / SEQ : (r - NLAT) / CTX;
    const int nloc = r < NLAT ? 128 : 0;
    int row = 0, col = 0, rs = 0, ws = 0;
    if (r < NLAT) { const int t = r % SEQ; row = t / GW; col = t % GW; rs = row - 4; rs = rs < 0 ? 0 : (rs > ROWS - 8 ? ROWS - 8 : rs); ws = col - 8; ws = ws < 0 ? 0 : (ws > GW - 16 ? GW - 16 : ws); }
    for (int j = 0; j < nloc + CTX; ++j) {
        int kr; float bias = 0.f;
        if (j < nloc) { const int i = j / 16, jj = j % 16; kr = b * SEQ + (rs + i) * GW + ws + jj; bias = p.rpb[(((size_t)l * NAH + head) * 15 + (rs + i - row + 7)) * 31 + (ws + jj - col + 15)]; }
        else kr = NLAT + b * CTX + (j - nloc);
        const bf16_t* kp = p.P + (size_t)kr * INC + OK_ + head * HD;
        const bf16_t* vp = p.P + (size_t)kr * INC + OV + head * HD;
        float sc = 0.f;
#pragma unroll
        for (int d = 0; d < HD; ++d) sc += q[d] * bf2f(kp[d]);
        sc += bias;
        const float mn = fmaxf(m, sc), corr = expf(m - mn), pj = expf(sc - mn);
        s = s * corr + pj;
#pragma unroll
        for (int d = 0; d < HD; ++d) acc[d] = acc[d] * corr + pj * bf2f(vp[d]);
        m = mn;
    }
    const float inv = 1.f / s;
    bf16_t* o = p.MIX + (size_t)r * MIXD + head * HD;
#pragma unroll
    for (int d = 0; d < HD; ++d) o[d] = f2bf(acc[d] * inv);
}
BODY void b_gates(long gid, PRef p, int l) {
    const int j = (int)(gid % 384), dir = (int)((gid / 384) % 2), r = (int)(gid / 768);
    const float z = bf2f(p.P[(size_t)r * INC + (dir ? OFB : OFF_) + j]);
    const float lbv = p.LB[(dir * DEPTH + l) * 384 + j];
    p.FG[gid] = lbv + (1.f - lbv) * sigmoid_f(z);
}
template <int DIR> BODY void b_hgrn_seq(long gid, PRef p, int) {
    const int v = (int)(gid % 64), h = (int)((gid / 64) % HGH), b = (int)(gid / (64 * HGH));
    float S[64];
#pragma unroll
    for (int k = 0; k < 64; ++k) S[k] = 0.f;
    for (int step = 0; step < CTX + SEQ; ++step) {
        int r;
        if (step < CTX) r = NLAT + b * CTX + (DIR ? CTX - 1 - step : step);
        else r = b * SEQ + (DIR ? SEQ - 1 - (step - CTX) : (step - CTX));
        const float vv = bf2f(p.P[(size_t)r * INC + OHI + h * 64 + v]);
        const float* fr = p.FG + ((size_t)r * 2 + DIR) * 384 + h * 64;
        const bf16_t* qr = p.P + (size_t)r * INC + OHQ + h * 64;
        float o = 0.f;
#pragma unroll
        for (int k = 0; k < 64; ++k) { const float f = fr[k]; S[k] = f * S[k] + (1.f - f) * vv; o += S[k] * bf2f(qr[k]); }
        o *= 0.125f;
        p.OHG[((size_t)DIR * NTOK + r) * 384 + h * 64 + v] = o;
    }
}
BODY void b_hgfin(long gid, PRef p, int l) {
    const int r = (int)(gid / HGH), h = (int)(gid % HGH);
    const float* op = p.OHG + (size_t)r * 384 + h * 64;
    const float* op1 = op + (size_t)NTOK * 384;
    float o[64]; float ss = 0.f;
#pragma unroll
    for (int v = 0; v < 64; ++v) { o[v] = op[v] + op1[v]; ss += o[v] * o[v]; }
    const float rstd = 1.f / sqrtf(ss / 64.f + EPS);
    const bf16_t* g = p.P + (size_t)r * INC + OHG_ + h * 64;
    bf16_t* out = p.MIX + (size_t)r * MIXD + 384 + h * 64;
#pragma unroll
    for (int v = 0; v < 64; ++v) out[v] = f2bf(o[v] * rstd * p.hg_norm[l * 64 + v] * silu_f(bf2f(g[v])));
}
BODY void b_conv(long gid, PRef p, int l) {
    const int ch = (int)(gid % CVD), r = (int)(gid / CVD);
    int t, T;
    if (r < NLAT) { t = r % SEQ; T = SEQ; } else { t = (r - NLAT) % CTX; T = CTX; }
    const float* w = p.conv_w + (size_t)l * 3 * CVD + ch;
    float y = 0.f;
    for (int j = 0; j < 3; ++j) {
        const int tt = t + j - 1;
        if (tt < 0 || tt >= T) continue;
        const bf16_t* pr = p.P + (size_t)(r + j - 1) * INC;
        y += w[j * CVD] * bf2f(pr[OCC + ch]) * bf2f(pr[OCU + ch]);
    }
    p.MIX[(size_t)r * MIXD + 768 + ch] = f2bf(bf2f(p.P[(size_t)r * INC + OCB + ch]) * y);
}
BODY void b_gemm_out(long gid, PRef p, int l) {
    const int r = (int)(gid / (D / 4)), n = (int)(gid % (D / 4)) * 4;
    const bf16_t* a = p.MIX + (size_t)r * MIXD;
    const float* w = p.w_out + (size_t)l * MIXD * D + n;
    float a0 = 0.f, a1 = 0.f, a2 = 0.f, a3 = 0.f;
    for (int k = 0; k < MIXD; ++k) { const float av = bf2f(a[k]); const float* wk = w + (size_t)k * D; a0 += av * wk[0]; a1 += av * wk[1]; a2 += av * wk[2]; a3 += av * wk[3]; }
    const float* g = p.MOD + ((size_t)l * 3 + modset(r)) * NMOD + 2 * D + n;
    float* xr = xrow(p, r) + n;
    xr[0] += g[0] * a0; xr[1] += g[1] * a1; xr[2] += g[2] * a2; xr[3] += g[3] * a3;
}
BODY void b_rank(long gid, PRef p, int) {
    const int e = (int)(gid % NE), r = (int)(gid / NE);
    int t, T, row0, cap, base;
    if (r < NLAT) { const int b = r / SEQ; t = r % SEQ; T = SEQ; row0 = b * SEQ; cap = CAPL; base = (b * NE + e) * CAPL; }
    else { const int b = (r - NLAT) / CTX; t = (r - NLAT) % CTX; T = CTX; row0 = NLAT + b * CTX; cap = CAPC; base = NSLOT_L + (b * NE + e) * CAPC; }
    const float a = p.AFF[(size_t)r * NE + e];
    const float* col = p.AFF + (size_t)row0 * NE + e;
    int rank = 0;
    for (int tt = 0; tt < T; ++tt) { const float o = col[(size_t)tt * NE]; rank += (o > a || (o == a && tt < t)) ? 1 : 0; }
    if (rank < cap) { p.STOK[base + rank] = r; p.SVAL[base + rank] = a; p.INV[(size_t)r * NE + e] = base + rank; }
    else p.INV[(size_t)r * NE + e] = -1;
}
BODY int slot_expert(int s) { return s < NSLOT_L ? (s / CAPL) % NE : ((s - NSLOT_L) / CAPC) % NE; }
BODY void b_moe1(long gid, PRef p, int l) {
    const int s = (int)(gid / (ED / 4)), f = (int)(gid % (ED / 4)) * 4;
    const int e = slot_expert(s); int row = p.STOK[s]; row = row < 0 ? 0 : (row >= NTOK ? NTOK - 1 : row);
    const bf16_t* a = p.H + (size_t)row * D;
    const float* wg = p.w_gate + ((size_t)l * NE + e) * D * ED + f;
    const float* wu = p.w_up + ((size_t)l * NE + e) * D * ED + f;
    float g0 = 0.f, g1 = 0.f, g2 = 0.f, g3 = 0.f, u0 = 0.f, u1 = 0.f, u2 = 0.f, u3 = 0.f;
    for (int k = 0; k < D; ++k) {
        const float av = bf2f(a[k]); const float* gk = wg + (size_t)k * ED; const float* uk = wu + (size_t)k * ED;
        g0 += av * gk[0]; g1 += av * gk[1]; g2 += av * gk[2]; g3 += av * gk[3];
        u0 += av * uk[0]; u1 += av * uk[1]; u2 += av * uk[2]; u3 += av * uk[3];
    }
    bf16_t* o = p.HID + (size_t)s * ED + f;
    o[0] = f2bf(silu_f(g0) * u0); o[1] = f2bf(silu_f(g1) * u1); o[2] = f2bf(silu_f(g2) * u2); o[3] = f2bf(silu_f(g3) * u3);
}
BODY void b_moe2(long gid, PRef p, int l) {
    const int s = (int)(gid / (D / 4)), n = (int)(gid % (D / 4)) * 4;
    const int e = slot_expert(s);
    const bf16_t* a = p.HID + (size_t)s * ED;
    const float* w = p.w_down + ((size_t)l * NE + e) * ED * D + n;
    float a0 = 0.f, a1 = 0.f, a2 = 0.f, a3 = 0.f;
    for (int k = 0; k < ED; ++k) { const float av = bf2f(a[k]); const float* wk = w + (size_t)k * D; a0 += av * wk[0]; a1 += av * wk[1]; a2 += av * wk[2]; a3 += av * wk[3]; }
    const float val = p.SVAL[s];
    bf16_t* o = p.Y + (size_t)s * D + n;
    o[0] = f2bf(val * a0); o[1] = f2bf(val * a1); o[2] = f2bf(val * a2); o[3] = f2bf(val * a3);
}
BODY void b_combine(long gid, PRef p, int l) {
    const int r = (int)(gid / (D / 4)), n = (int)(gid % (D / 4)) * 4;
    float a0 = 0.f, a1 = 0.f, a2 = 0.f, a3 = 0.f;
    for (int e = 0; e < NE; ++e) {
        const int s = p.INV[(size_t)r * NE + e];
        if (s >= 0) { const bf16_t* y = p.Y + (size_t)s * D + n; a0 += bf2f(y[0]); a1 += bf2f(y[1]); a2 += bf2f(y[2]); a3 += bf2f(y[3]); }
    }
    const float* g = p.MOD + ((size_t)l * 3 + modset(r)) * NMOD + 5 * D + n;
    float* xr = xrow(p, r) + n;
    xr[0] += g[0] * a0; xr[1] += g[1] * a1; xr[2] += g[2] * a2; xr[3] += g[3] * a3;
}


#ifndef HGRN_DIAG
#define HGRN_DIAG 0
#endif
BODY void b_hgrn_chunkseq(long gid, PRef p, int l) {
    const int v = (int)(gid % 64), pc = (int)((gid / 64) % NCH), bh = (int)((gid / (64 * NCH)) % NBH), dir = (int)(gid / (64L * NCH * NBH));
    const int h = bh % HGH, b = bh / HGH, row0 = pc < NCHC ? NLAT + b * CTX + pc * 64 : b * SEQ + (pc - NCHC) * 64;
    const bf16_t* sin = p.SLOC + ((size_t)(dir * NBH + bh) * NCH + pc) * 4096 + v * 64;
    float S[64];
#pragma unroll
    for (int k = 0; k < 64; ++k) S[k] = bf2f(sin[k]);
    for (int i = 0; i < 64; ++i) {
        const int r = row0 + (dir ? 63 - i : i);
        const float vv = bf2f(p.P[(size_t)r * INC + OHI + h * 64 + v]);
        const bf16_t* zr = p.P + (size_t)r * INC + (dir ? OFB : OFF_) + h * 64;
        const bf16_t* qr = p.P + (size_t)r * INC + OHQ + h * 64;
        const float* lb = p.LB + (size_t)(dir * DEPTH + l) * 384 + h * 64;
        float o = 0.f;
#pragma unroll
        for (int k = 0; k < 64; ++k) { const float f = lb[k] + (1.f - lb[k]) * sigmoid_f(bf2f(zr[k])); S[k] = f * S[k] + (1.f - f) * vv; o += S[k] * bf2f(qr[k]); }
        p.OHG[((size_t)dir * NTOK + r) * 384 + h * 64 + v] = o * 0.125f;
    }
}

BODY void b_hgrn_scan_slow(long gid, PRef p, int) {
    const int e = (int)(gid % 4096), sq = (int)(gid / 4096), dir = sq / NBH, k = e & 63;
    bf16_t* S = p.SLOC + (size_t)sq * NCH * 4096 + e;
    const float* G = p.GDEC + (size_t)sq * NCH * 64 + k;
    float c = 0.f;
    for (int j = 0; j < NCH; ++j) {
        const int pc = dir ? (j < NCHC ? NCHC - 1 - j : NCH + NCHC - 1 - j) : j;
        const float x = bf2f(S[(size_t)pc * 4096]);
        S[(size_t)pc * 4096] = f2bf(c);
        c = G[(size_t)pc * 64] * c + x;
    }
}

BODY void b_hgrn_local_slow(long gid, PRef p, int l) {
    const int v = (int)(gid % 64), pc = (int)((gid / 64) % NCH), bh = (int)((gid / (64 * NCH)) % NBH), dir = (int)(gid / (64L * NCH * NBH));
    const int h = bh % HGH, b = bh / HGH, row0 = pc < NCHC ? NLAT + b * CTX + pc * 64 : b * SEQ + (pc - NCHC) * 64;
    float S[64], g[64];
#pragma unroll
    for (int k = 0; k < 64; ++k) { S[k] = 0.f; g[k] = 1.f; }
    for (int i = 0; i < 64; ++i) {
        const int r = row0 + (dir ? 63 - i : i);
        const float vv = bf2f(p.P[(size_t)r * INC + OHI + h * 64 + v]);
        const bf16_t* zr = p.P + (size_t)r * INC + (dir ? OFB : OFF_) + h * 64;
        const float* lb = p.LB + (size_t)(dir * DEPTH + l) * 384 + h * 64;
#pragma unroll
        for (int k = 0; k < 64; ++k) { const float f = lb[k] + (1.f - lb[k]) * sigmoid_f(bf2f(zr[k])); S[k] = f * S[k] + (1.f - f) * vv; g[k] *= f; }
    }
    bf16_t* dst = p.SLOC + ((size_t)(dir * NBH + bh) * NCH + pc) * 4096 + v * 64;
    if (HGRN_DIAG != 3 && HGRN_DIAG != 4) {
#pragma unroll
    for (int k = 0; k < 64; ++k) dst[k] = f2bf(S[k]);
    }
    if (v == 0) {
        float* gd = p.GDEC + ((size_t)(dir * NBH + bh) * NCH + pc) * 64;
#pragma unroll
        for (int k = 0; k < 64; ++k) gd[k] = g[k];
    }
}
#ifndef FAST_TOPK
#define FAST_TOPK 1
#endif
#ifndef FAST_HGRN
#define FAST_HGRN 1
#endif
#ifndef FAST_ATTN
#define FAST_ATTN 1
#endif
constexpr size_t al256(size_t x) { return (x + 255) & ~(size_t)255; }
constexpr size_t CTL_BYTES = 65536;
constexpr size_t WS_CTL = 0;
constexpr size_t WS_MOD = WS_CTL + CTL_BYTES;
constexpr size_t WS_LB = WS_MOD + al256((size_t)DEPTH * 3 * NMOD * 4);
constexpr size_t WS_XC = WS_LB + al256((size_t)2 * DEPTH * 384 * 4);
constexpr size_t WS_AFF = WS_XC + al256((size_t)NCTX * D * 4);
constexpr size_t WS_SVAL = WS_AFF + al256((size_t)NTOK * NE * 4);
constexpr size_t WS_STOK = WS_SVAL + al256((size_t)NSLOT * 4);
constexpr size_t WS_INV = WS_STOK + al256((size_t)NSLOT * 4);
constexpr size_t WS_H = WS_INV + al256((size_t)NTOK * NE * 4);
constexpr size_t WS_MIX = WS_H + al256((size_t)NTOK * D * 2);
constexpr size_t WS_P = WS_MIX + al256((size_t)NTOK * MIXD * 2);
constexpr size_t WS_HID = WS_P;
constexpr size_t WS_Y = WS_HID + al256((size_t)NSLOT * ED * 2);
constexpr size_t WS_P_END0 = WS_P + al256((size_t)NTOK * INC * 2);
constexpr size_t WS_P_END1 = WS_Y + al256((size_t)NSLOT * D * 2);
constexpr size_t WS_WB = WS_P_END0 > WS_P_END1 ? WS_P_END0 : WS_P_END1;
constexpr size_t WS_WIN_T = WS_WB;
constexpr size_t WS_WOUT_T = WS_WIN_T + al256((size_t)INC * D * 2);
constexpr size_t WS_WGU_T = WS_WOUT_T + al256((size_t)D * MIXD * 2);
constexpr size_t WS_WD_T = WS_WGU_T + al256((size_t)NE * 2 * ED * D * 2);
constexpr size_t WS_T = WS_WD_T + al256((size_t)NE * D * ED * 2);
#if FAST_HGRN
constexpr size_t WS_SLOC = WS_T;
constexpr size_t WS_GDEC = WS_SLOC + al256((size_t)2 * NBH * NCH * 4096 * 2);
constexpr size_t WS_OHG = WS_GDEC + al256((size_t)2 * NBH * NCH * 64 * 4);
constexpr size_t WS_END = WS_OHG + (HGRN_DIAG ? al256((size_t)2 * NTOK * 384 * 4) : 0);
constexpr size_t WS_FG = WS_T;
#else
constexpr size_t WS_FG = WS_T;
constexpr size_t WS_OHG = WS_FG + al256((size_t)NTOK * 768 * 4);
constexpr size_t WS_SLOC = WS_OHG + al256((size_t)2 * NTOK * 384 * 4);
constexpr size_t WS_GDEC = WS_SLOC;
constexpr size_t WS_END = WS_SLOC;
#endif

static inline Params make_params(void* const* d_in, void* d_out, void* d_ws) {
    Params p{};
    const float** f = (const float**)&p;
    for (int i = 0; i < 20; ++i) f[i] = (const float*)d_in[i];
    char* ws = (char*)d_ws;
    p.XL = (float*)d_out; p.XC = (float*)(ws + WS_XC); p.MOD = (float*)(ws + WS_MOD); p.LB = (float*)(ws + WS_LB); p.AFF = (float*)(ws + WS_AFF);
    p.SVAL = (float*)(ws + WS_SVAL); p.FG = (float*)(ws + WS_FG); p.OHG = (float*)(ws + WS_OHG);
    p.H = (bf16_t*)(ws + WS_H); p.P = (bf16_t*)(ws + WS_P); p.MIX = (bf16_t*)(ws + WS_MIX); p.HID = (bf16_t*)(ws + WS_HID); p.Y = (bf16_t*)(ws + WS_Y);
    p.STOK = (int*)(ws + WS_STOK); p.INV = (int*)(ws + WS_INV);
    p.WIN_T = (bf16_t*)(ws + WS_WIN_T); p.WOUT_T = (bf16_t*)(ws + WS_WOUT_T); p.WGU_T = (bf16_t*)(ws + WS_WGU_T); p.WD_T = (bf16_t*)(ws + WS_WD_T);
    p.CTL = (unsigned*)(ws + WS_CTL); p.SLOC = (bf16_t*)(ws + WS_SLOC); p.GDEC = (float*)(ws + WS_GDEC);
    return p;
}

#define FORWARD_STAGES(STAGE)                                                      \
    STAGE(b_adaln, (long)DEPTH * 3 * NMOD, 0)                                      \
    STAGE(b_lb, 2L * 384, 0)                                                       \
    STAGE(b_copyx, (long)NTOK * D, 0)                                              \
    for (int l = 0; l < DEPTH; ++l) {                                              \
        STAGE(b_prenorm<0>, (long)NTOK, l)                                         \
        STAGE(b_gemm_in, (long)NTOK * (INC / 4), l)                                \
        STAGE(b_qkprep, (long)NTOK * 12, l)                                        \
        STAGE(b_attn, (long)NTOK * NAH, l)                                         \
        STAGE(b_gates, (long)NTOK * 768, l)                                        \
        STAGE(b_hgrn_seq<0>, (long)NB * HGH * 64, l)                               \
        STAGE(b_hgrn_seq<1>, (long)NB * HGH * 64, l)                               \
        STAGE(b_hgfin, (long)NTOK * HGH, l)                                        \
        STAGE(b_conv, (long)NTOK * CVD, l)                                         \
        STAGE(b_gemm_out, (long)NTOK * (D / 4), l)                                 \
        STAGE(b_prenorm<1>, (long)NTOK, l)                                         \
        STAGE(b_rank, (long)NTOK * NE, l)                                          \
        STAGE(b_moe1, (long)NSLOT * (ED / 4), l)                                   \
        STAGE(b_moe2, (long)NSLOT * (D / 4), l)                                    \
        STAGE(b_combine, (long)NTOK * (D / 4), l)                                  \
    }

#ifndef CPU_SIM
#include <cstdio>
#define LAS __attribute__((address_space(3)))
#define GAS __attribute__((address_space(1)))
typedef short bf16x8 __attribute__((ext_vector_type(8)));
typedef float f32x4 __attribute__((ext_vector_type(4)));
typedef float f32x2 __attribute__((ext_vector_type(2)));
typedef unsigned u32x4 __attribute__((ext_vector_type(4)));
typedef unsigned u32x2 __attribute__((ext_vector_type(2)));
constexpr int NWAVES = 8, NTHR = 512;
constexpr int RING_BYTES = 131072, LDSCTL_OFF = RING_BYTES, MISC_OFF = LDSCTL_OFF + 320, TAB_OFF = LDSCTL_OFF + 1024  , LDS_BYTES = 147456;

typedef __bf16 bf16v2_t __attribute__((ext_vector_type(2)));
__device__ __forceinline__ unsigned cvt_pk_bf16_asm(float lo, float hi) { unsigned r; asm volatile("v_cvt_pk_bf16_f32 %0, %1, %2" : "=v"(r) : "v"(lo), "v"(hi)); return r; }
__device__ __forceinline__ unsigned cvt_pk_bf16(float lo, float hi) { bf16v2_t v = {(__bf16)lo, (__bf16)hi}; return __builtin_bit_cast(unsigned, v); }
__device__ __forceinline__ float wave_sum(float v, int lane) {
    v += __builtin_bit_cast(float, __builtin_amdgcn_ds_swizzle(__builtin_bit_cast(int, v), (1 << 10) | 0x1f));
    v += __builtin_bit_cast(float, __builtin_amdgcn_ds_swizzle(__builtin_bit_cast(int, v), (2 << 10) | 0x1f));
    v += __builtin_bit_cast(float, __builtin_amdgcn_ds_swizzle(__builtin_bit_cast(int, v), (4 << 10) | 0x1f));
    v += __builtin_bit_cast(float, __builtin_amdgcn_ds_swizzle(__builtin_bit_cast(int, v), (8 << 10) | 0x1f));
    v += __builtin_bit_cast(float, __builtin_amdgcn_ds_swizzle(__builtin_bit_cast(int, v), (16 << 10) | 0x1f));
    v += __builtin_bit_cast(float, __builtin_amdgcn_ds_bpermute((lane ^ 32) << 2, __builtin_bit_cast(int, v)));
    return v;
}

extern __shared__ __attribute__((aligned(16))) unsigned char lds_raw[];
#ifndef FUSE_QK
#define FUSE_QK 1
#endif
namespace pg8 {
constexpr int BM = 256, BK = 64, HALF = 128, HTB = HALF * BK * 2, STAGE_BYTES = 8 * HTB, NXCD = 8, WGM = 8;
__device__ __forceinline__ int lds_byte(int r, int c) { const int st = (r >> 4) * 2 + (c >> 5), rr = r & 15, cc = c & 31, ob = rr * 64 + cc * 2; return st * 1024 + (ob ^ (((ob >> 9) & 1) << 5)); }
__device__ __forceinline__ void stage_rc(int b, int& R, int& C) { const int st = b / 1024, sb = b % 1024, swz = sb ^ (((sb >> 9) & 1) << 5); R = (st >> 1) * 16 + swz / 64; C = (st & 1) * 32 + (swz % 64) / 2; }
__device__ __forceinline__ int perm32(int rho) { const int n = rho >> 4, i = rho & 15; return 8 * (i >> 2) + 4 * n + (i & 3); }
struct Unit { int pm, pn; };
struct Gemm {
    const bf16_t* A; const bf16_t* Bt; int M, N, K;
    const int* gather;
    int gt, ng; size_t gstride;
};
struct StaticOrder {
    int nM, nN, nwg, G, c;
    __device__ void init(int M, int N, int G_, int c_) { nM = M / BM; nN = N / BM; nwg = nM * nN; G = G_; c = c_; }
    __device__ bool next(int i, Unit& u) const {
        const long L = (long)i * G + c; if (L >= nwg) return false;
        int wgid = (int)L; { const int q = nwg / NXCD, r = nwg % NXCD, xcd = wgid % NXCD, off = wgid / NXCD; wgid = (xcd < r ? xcd * (q + 1) : r * (q + 1) + (xcd - r) * q) + off; }
        const int nig = WGM * nN, gid = wgid / nig, fm = gid * WGM, gsz = (nM - fm) < WGM ? (nM - fm) : WGM;
        u.pm = fm + ((wgid % nig) % gsz); u.pn = (wgid % nig) / gsz; return true;
    }
};
struct EpiBf16 {
    static constexpr bool PERM = true;
    bf16_t* O; int ldc; const float* rowscale; int skip;
    __device__ __forceinline__ void operator()(const f32x4 (&acc)[2][2][4][2], const Unit& u, int wr, int wc, int fr, int fq) const {
        const int row0 = u.pm * BM + wr * 64 + fr, col0 = u.pn * BM + wc * 32 + 8 * fq;
        if (skip) { asm volatile("" :: "v"(acc[0][0][0][0]), "v"(acc[1][1][3][1])); return; }
#pragma unroll
        for (int ai = 0; ai < 2; ++ai)
#pragma unroll
            for (int m = 0; m < 4; ++m) { const int row = row0 + ai * HALF + m * 16; bf16_t* rowp = O + (size_t)row * ldc + col0; const float sc = rowscale ? rowscale[row] : 1.f;
#pragma unroll
                for (int bj = 0; bj < 2; ++bj) { const f32x4 v0 = acc[ai][bj][m][0] * sc, v1 = acc[ai][bj][m][1] * sc;
                    u32x4 w; w.x = cvt_pk_bf16_asm(v0[0], v0[1]); w.y = cvt_pk_bf16_asm(v0[2], v0[3]); w.z = cvt_pk_bf16_asm(v1[0], v1[1]); w.w = cvt_pk_bf16_asm(v1[2], v1[3]);
                    *(u32x4*)(rowp + bj * HALF) = w; } }
    }
};
struct EpiP {
    static constexpr bool PERM = true;
    bf16_t* O; int ldc; const float* qn; const float* kn; int skip;
    __device__ __forceinline__ void operator()(const f32x4 (&acc)[2][2][4][2], const Unit& u, int wr, int wc, int fr, int fq) const {
        const int row0 = u.pm * BM + wr * 64 + fr, col0 = u.pn * BM + wc * 32 + 8 * fq;
        if (skip) { asm volatile("" :: "v"(acc[0][0][0][0]), "v"(acc[1][1][3][1])); return; }
        if (u.pn >= 3 || !FUSE_QK) {
#pragma unroll
            for (int ai = 0; ai < 2; ++ai)
#pragma unroll
                for (int m = 0; m < 4; ++m) { bf16_t* rowp = O + (size_t)(row0 + ai * HALF + m * 16) * ldc + col0;
#pragma unroll
                    for (int bj = 0; bj < 2; ++bj) { const f32x4 v0 = acc[ai][bj][m][0], v1 = acc[ai][bj][m][1];
                        u32x4 w; w.x = cvt_pk_bf16_asm(v0[0], v0[1]); w.y = cvt_pk_bf16_asm(v0[2], v0[3]); w.z = cvt_pk_bf16_asm(v1[0], v1[1]); w.w = cvt_pk_bf16_asm(v1[2], v1[3]);
                        *(u32x4*)(rowp + bj * HALF) = w; } }
            return;
        }
        LAS float* PS = (LAS float*)((LAS unsigned char*)lds_raw + LDSCTL_OFF + 4096);
        const int half = wc & 1, hw = wc >> 1;
        unsigned lm_ = ~0u; asm volatile("" : "+s"(lm_)); const int lane = (int)__builtin_amdgcn_mbcnt_hi(lm_, __builtin_amdgcn_mbcnt_lo(lm_, 0u));
#pragma unroll
        for (int ai = 0; ai < 2; ++ai)
#pragma unroll
            for (int m = 0; m < 4; ++m)
#pragma unroll
                for (int bj = 0; bj < 2; ++bj) { const f32x4 v0 = acc[ai][bj][m][0], v1 = acc[ai][bj][m][1];
                    float s = (v0[0] * v0[0] + v0[1] * v0[1]) + (v0[2] * v0[2] + v0[3] * v0[3]) + (v1[0] * v1[0] + v1[1] * v1[1]) + (v1[2] * v1[2] + v1[3] * v1[3]);
                    s += __builtin_bit_cast(float, __builtin_amdgcn_ds_swizzle(__builtin_bit_cast(int, s), (16 << 10) | 0x1f));
                    s += __builtin_bit_cast(float, __builtin_amdgcn_ds_bpermute((lane ^ 32) << 2, __builtin_bit_cast(int, s)));
                    if (fq == 0) PS[((ai * HALF + wr * 64 + m * 16 + fr) * 4 + 2 * bj + hw) * 2 + half] = s; }
        asm volatile("s_waitcnt lgkmcnt(0)" ::: "memory"); __builtin_amdgcn_s_barrier(); asm volatile("" ::: "memory");
        float invf[8];
#pragma unroll
        for (int j = 0; j < 8; ++j) invf[j] = __builtin_amdgcn_exp2f(-(float)(8 * (fq & 1) + j) * (13.287712379549449f / 16.f));
        const bool second = (fq & 2) != 0;
#pragma unroll
        for (int ai = 0; ai < 2; ++ai)
#pragma unroll
            for (int m = 0; m < 4; ++m) {
                const int grow = row0 + ai * HALF + m * 16; const bool lat = grow < NLAT; const int t = lat ? grow % SEQ : 0;
                int tp = half ? t % GW : t / GW; asm volatile("" : "+v"(tp));
                const float pos = (float)tp;
                float cs[8], sn[8];
#pragma unroll
                for (int j = 0; j < 8; ++j) { const float ang = pos * invf[j]; cs[j] = __cosf(ang); sn[j] = __sinf(ang); }
                bf16_t* rowp = O + (size_t)grow * ldc + col0;
#pragma unroll
                for (int bj = 0; bj < 2; ++bj) {
                    const int rl = ai * HALF + wr * 64 + m * 16 + fr, head = 2 * bj + hw;
                    const float ssq = PS[(rl * 4 + head) * 2] + PS[(rl * 4 + head) * 2 + 1];
                    const bool isk = (u.pn * BM + bj * HALF + wc * 32) >= 384;
                    const float rstd = (isk ? 1.f : 0.125f * 1.44269504089f) / sqrtf(ssq * (1.f / HD) + EPS);
                    const float* nw = (isk ? kn : qn) + 32 * half + 8 * fq;
                    const f32x4 n0 = *(const f32x4*)nw, n1 = *(const f32x4*)(nw + 4);
                    float y[8];
#pragma unroll
                    for (int j = 0; j < 4; ++j) { y[j] = acc[ai][bj][m][0][j] * rstd * n0[j]; y[4 + j] = acc[ai][bj][m][1][j] * rstd * n1[j]; }
#pragma unroll
                    for (int j = 0; j < 8; ++j) {
                        const unsigned yb = __builtin_bit_cast(unsigned, y[j]);
                        const auto sw = __builtin_amdgcn_permlane32_swap(yb, yb, false, false);
                        const float other = __builtin_bit_cast(float, lane < 32 ? sw[1] : sw[0]);
                        const float rot = second ? y[j] * cs[j] + other * sn[j] : y[j] * cs[j] - other * sn[j];
                        y[j] = lat ? rot : y[j];
                    }
                    u32x4 w; w.x = cvt_pk_bf16(y[0], y[1]); w.y = cvt_pk_bf16(y[2], y[3]); w.z = cvt_pk_bf16(y[4], y[5]); w.w = cvt_pk_bf16(y[6], y[7]);
                    *(u32x4*)(rowp + bj * HALF) = w;
                }
                asm volatile("" ::: "memory");
            }
    }
};
struct EpiRes {
    static constexpr bool PERM = false;
    float* X; const float* Xin; int ldc; const float* gate0; int rows_per_set; size_t set_stride;
    __device__ __forceinline__ void operator()(const f32x4 (&acc)[2][2][4][2], const Unit& u, int wr, int wc, int fr, int fq) const {
        const int row0 = u.pm * BM + wr * 64 + fr, col0 = u.pn * BM + wc * 32 + 4 * fq;
        const float* gate = gate0 + (size_t)((u.pm * BM) / rows_per_set) * set_stride;
        f32x4 gv[2][2];
#pragma unroll
        for (int bj = 0; bj < 2; ++bj)
#pragma unroll
            for (int n = 0; n < 2; ++n) gv[bj][n] = *(const f32x4*)(gate + col0 + bj * HALF + n * 16);
#pragma unroll
        for (int ai = 0; ai < 2; ++ai)
#pragma unroll
            for (int m = 0; m < 4; ++m) { const size_t ro = (size_t)(row0 + ai * HALF + m * 16) * ldc + col0; float* rowp = X + ro; const float* rowi = Xin + ro;
#pragma unroll
                for (int bj = 0; bj < 2; ++bj)
#pragma unroll
                    for (int n = 0; n < 2; ++n) { f32x4* q = (f32x4*)(rowp + bj * HALF + n * 16); *q = *(const f32x4*)(rowi + bj * HALF + n * 16) + gv[bj][n] * acc[ai][bj][m][n]; }
                if (m & 1) asm volatile("" ::: "memory"); }
    }
};
struct EpiHid {
    static constexpr bool PERM = false;
    bf16_t* O; int ldc;
    __device__ __forceinline__ void operator()(const f32x4 (&acc)[2][2][4][2], const Unit& u, int wr, int wc, int fr, int fq) const {
        const int row0 = u.pm * BM + wr * 64 + fr, col0 = (u.pn * BM + wc * 32) / 2 + 4 * fq;
#pragma unroll
        for (int ai = 0; ai < 2; ++ai)
#pragma unroll
            for (int m = 0; m < 4; ++m) { bf16_t* rowp = O + (size_t)(row0 + ai * HALF + m * 16) * ldc + col0;
#pragma unroll
                for (int bj = 0; bj < 2; ++bj) { const f32x4 g = acc[ai][bj][m][0], up = acc[ai][bj][m][1]; f32x4 h;
#pragma unroll
                    for (int j = 0; j < 4; ++j) h[j] = g[j] * __builtin_amdgcn_rcpf(1.f + __expf(-g[j])) * up[j];
                    u32x2 w; w.x = cvt_pk_bf16_asm(h[0], h[1]); w.y = cvt_pk_bf16_asm(h[2], h[3]);
                    *(u32x2*)(rowp + bj * (HALF / 2)) = w; } }
    }
};

template <class Epi, bool GATHER>
__device__ __forceinline__ void gemm_phase(const int tid, LAS unsigned char* lds, const Gemm g, const StaticOrder& S, const Epi& E) {
    const int wid = __builtin_amdgcn_readfirstlane(tid >> 6), lane = tid & 63, wr = wid >> 2, wc = wid & 3, fr = lane & 15, fq = lane >> 4;
    const int K = g.K, nt = K / BK;
    unsigned voffA[2], voffB[2];
#pragma unroll
    for (int i = 0; i < 2; ++i) { int R, C; stage_rc(tid * 16 + i * 8192, R, C); const int Rb = Epi::PERM ? ((R & ~31) + perm32(R & 31)) : R;
        voffB[i] = (unsigned)(Rb * K + C) * 2u; voffA[i] = GATHER ? (unsigned)(C * 2) : (Epi::PERM ? (unsigned)(R * K + C) * 2u : voffB[i]); }
    const size_t kstep = (size_t)(BK * 2);
    const size_t hstep = (size_t)HALF * K * 2;
    const size_t tstep = 2 * hstep;
    const unsigned ldsw = (unsigned)wid * 1024u;
    const int aoff = lds_byte(wr * 64 + fr, fq * 8), boff = lds_byte(wc * 32 + fr, fq * 8);
#define PG8_SA(b, h) (((b) * 2 + (h)) * HTB)
#define PG8_SB(b, h) ((4 + (b) * 2 + (h)) * HTB)
#define PG8_STAGE(bufoff, gbase, voff) do { const char* gb_ = (const char*)(gbase); asm volatile("" : "+s"(gb_)); _Pragma("unroll") for (int _i = 0; _i < 2; ++_i) \
        __builtin_amdgcn_global_load_lds((const unsigned*)(gb_ + (voff)[_i]), (LAS unsigned*)(lds + (bufoff) + ldsw + _i * 8192), 16, 0, 0); } while (0)
#define PG8_STAGE_A(bufoff, ubase, kt, h, tb) do { if constexpr (GATHER) { \
        if ((tb) < 0) { PG8_STAGE(bufoff, Ab + (size_t)(kt) * kstep, oAc[h]); } else { \
        unsigned m_ = ~0u; asm volatile("" : "+s"(m_)); const int tl_ = wid * 64 + (int)__builtin_amdgcn_mbcnt_hi(m_, __builtin_amdgcn_mbcnt_lo(m_, 0u)); \
        _Pragma("unroll") for (int _i = 0; _i < 2; ++_i) { int _R, _C; stage_rc(tl_ * 16 + _i * 8192, _R, _C); \
            const unsigned _o = *(const LAS unsigned*)(lds + TAB_OFF + (tb) * 1024 + ((h) * HALF + _R) * 4) + (unsigned)(_C * 2); \
            __builtin_amdgcn_global_load_lds((const unsigned*)(Ab + (size_t)(kt) * kstep + _o), (LAS unsigned*)(lds + (bufoff) + ldsw + _i * 8192), 16, 0, 0); } } } \
        else { PG8_STAGE(bufoff, (ubase) + (size_t)(kt) * kstep + (size_t)(h) * hstep, voffA); } } while (0)
#define PG8_LOADOFFS(tb) do { if constexpr (GATHER) { unsigned m_ = ~0u; asm volatile("" : "+s"(m_)); const int tl_ = wid * 64 + (int)__builtin_amdgcn_mbcnt_hi(m_, __builtin_amdgcn_mbcnt_lo(m_, 0u)); \
        _Pragma("unroll") for (int _h = 0; _h < 2; ++_h) _Pragma("unroll") for (int _i = 0; _i < 2; ++_i) { int _R, _C; stage_rc(tl_ * 16 + _i * 8192, _R, _C); \
            oAc[_h][_i] = *(const LAS unsigned*)(lds + TAB_OFF + (tb) * 1024 + (_h * HALF + _R) * 4) + (unsigned)(_C * 2); } } } while (0)
#define PG8_FILLTAB(u, tb) do { if constexpr (GATHER) { unsigned m_ = ~0u; asm volatile("" : "+s"(m_)); const int tl_ = wid * 64 + (int)__builtin_amdgcn_mbcnt_hi(m_, __builtin_amdgcn_mbcnt_lo(m_, 0u)); \
        if (tl_ < 256) *(LAS unsigned*)(lds + TAB_OFF + (tb) * 1024 + tl_ * 4) = min((unsigned)g.gather[(u).pm * BM + tl_], (unsigned)(NTOK - 1)) * (unsigned)(K * 2); } } while (0)
#define PG8_LDA(dst, b, h) do { _Pragma("unroll") for (int m = 0; m < 4; ++m) _Pragma("unroll") for (int k = 0; k < 2; ++k) dst[m][k] = *(const LAS bf16x8*)(lds + PG8_SA(b, h) + aoff + m * 2048 + k * 1024); } while (0)
#define PG8_LDB(dst, b, h) do { _Pragma("unroll") for (int n = 0; n < 2; ++n) _Pragma("unroll") for (int k = 0; k < 2; ++k) dst[n][k] = *(const LAS bf16x8*)(lds + PG8_SB(b, h) + boff + n * 2048 + k * 1024); } while (0)
#define PG8_MMA(ai, bj, At, Bt) do { __builtin_amdgcn_s_setprio(1); _Pragma("unroll") for (int m = 0; m < 4; ++m) _Pragma("unroll") for (int n = 0; n < 2; ++n) _Pragma("unroll") for (int k = 0; k < 2; ++k) \
        acc[ai][bj][m][n] = __builtin_amdgcn_mfma_f32_16x16x32_bf16(Bt[n][k], At[m][k], acc[ai][bj][m][n], 0, 0, 0); __builtin_amdgcn_s_setprio(0); } while (0)
#define PG8_WAIT_V(n) asm volatile("s_waitcnt vmcnt(" #n ")" ::: "memory")
#define PG8_WAIT_L(n) asm volatile("s_waitcnt lgkmcnt(" #n ")" ::: "memory")
#define PG8_BAR __builtin_amdgcn_s_barrier()
#define PG8_SCHED __builtin_amdgcn_sched_barrier(0)
#define PG8_KTILE2(u1, k1, o1, u2, k2, o2, b2p) do { \
        PG8_LDB(B0, 0, 0); PG8_LDB(B1, 0, 1); PG8_SCHED; PG8_LDA(At, 0, 0); PG8_STAGE_A(PG8_SA(1, 1), u1, k1, 1, o1); \
        PG8_WAIT_V(8); PG8_WAIT_L(0); PG8_BAR; PG8_MMA(0, 0, At, B0); PG8_MMA(0, 1, At, B1); PG8_BAR; PG8_SCHED; \
        PG8_LDA(At, 0, 1); PG8_STAGE(PG8_SB(0, 0), b2p, voffB); PG8_STAGE(PG8_SB(0, 1), (b2p) + hstep, voffB); PG8_STAGE_A(PG8_SA(0, 0), u2, k2, 0, o2); \
        PG8_WAIT_V(8); PG8_WAIT_L(0); PG8_BAR; PG8_MMA(1, 0, At, B0); PG8_MMA(1, 1, At, B1); PG8_BAR; PG8_SCHED; \
        PG8_LDB(B0, 1, 0); PG8_LDB(B1, 1, 1); PG8_SCHED; PG8_LDA(At, 1, 0); PG8_STAGE_A(PG8_SA(0, 1), u2, k2, 1, o2); \
        PG8_WAIT_V(8); PG8_WAIT_L(0); PG8_BAR; PG8_MMA(0, 0, At, B0); PG8_MMA(0, 1, At, B1); PG8_BAR; PG8_SCHED; \
        PG8_LDA(At, 1, 1); PG8_STAGE(PG8_SB(1, 0), (b2p) + kstep, voffB); PG8_STAGE(PG8_SB(1, 1), (b2p) + kstep + hstep, voffB); PG8_STAGE_A(PG8_SA(1, 0), u2, (k2) + 1, 0, o2); \
        PG8_WAIT_V(8); PG8_WAIT_L(0); PG8_BAR; PG8_MMA(1, 0, At, B0); PG8_MMA(1, 1, At, B1); PG8_BAR; PG8_SCHED; } while (0)
#define PG8_BPTR(u) ((const char*)g.Bt + (g.gt ? (size_t)(((u).pm / g.gt) % g.ng) * g.gstride : (size_t)0) + (size_t)(u).pn * tstep)
    Unit cur, nxt; int ui = 0;
    if (!S.next(0, cur)) return;
    f32x4 acc[2][2][4][2];
#pragma unroll
    for (int a = 0; a < 2; ++a)
#pragma unroll
        for (int b = 0; b < 2; ++b)
#pragma unroll
            for (int m = 0; m < 4; ++m)
#pragma unroll
                for (int n = 0; n < 2; ++n) acc[a][b][m][n] = (f32x4){0.f, 0.f, 0.f, 0.f};
    bf16x8 At[4][2], B0[2][2], B1[2][2];
    unsigned oAc[2][2] = {{0u, 0u}, {0u, 0u}};
    const char* const Ab = (const char*)g.A;
    const char* cA = Ab + (size_t)cur.pm * tstep;
    const char* cB = PG8_BPTR(cur);
    PG8_FILLTAB(cur, 0);
    if constexpr (GATHER) { PG8_WAIT_L(0); PG8_BAR; PG8_LOADOFFS(0); }
    PG8_STAGE(PG8_SB(0, 0), cB, voffB); PG8_STAGE(PG8_SB(0, 1), cB + hstep, voffB); PG8_STAGE_A(PG8_SA(0, 0), cA, 0, 0, -1); PG8_STAGE_A(PG8_SA(0, 1), cA, 0, 1, -1);
    if (wr == 1) PG8_BAR;
    PG8_WAIT_V(2); PG8_BAR;
    PG8_STAGE(PG8_SB(1, 0), cB + kstep, voffB); PG8_STAGE_A(PG8_SA(1, 0), cA, 1, 0, -1); PG8_STAGE(PG8_SB(1, 1), cB + hstep + kstep, voffB);
    PG8_WAIT_V(6); PG8_BAR;
    for (;;) {
        const bool has_next = S.next(ui + 1, nxt);
        const char* nA = has_next ? Ab + (size_t)nxt.pm * tstep : cA; const char* nB = has_next ? PG8_BPTR(nxt) : cB;
        const int tbc = ui & 1, tbn = has_next ? ((ui + 1) & 1) : (ui & 1);
        if (has_next) PG8_FILLTAB(nxt, tbn);
        for (int t = 0; t < nt - 2; t += 2) { const char* b2 = cB + (size_t)(t + 2) * kstep; PG8_KTILE2(cA, t + 1, -1, cA, t + 2, -1, b2); }
        PG8_KTILE2(cA, nt - 1, -1, nA, 0, tbn, nB);
        if (wr == 0) PG8_BAR;
        { unsigned m_ = ~0u; asm volatile("" : "+s"(m_)); int l2 = (int)__builtin_amdgcn_mbcnt_hi(m_, __builtin_amdgcn_mbcnt_lo(m_, 0u)); asm volatile("" : "+v"(l2)); E(acc, cur, wr, wc, l2 & 15, l2 >> 4); }
        if (!has_next) break;
#pragma unroll
        for (int a = 0; a < 2; ++a)
#pragma unroll
            for (int b = 0; b < 2; ++b)
#pragma unroll
                for (int m = 0; m < 4; ++m)
#pragma unroll
                    for (int n = 0; n < 2; ++n) acc[a][b][m][n] = (f32x4){0.f, 0.f, 0.f, 0.f};
        cur = nxt; cA = nA; cB = nB; ++ui;
        PG8_LOADOFFS(ui & 1);
        if (wr == 1) PG8_BAR;
    }
    PG8_WAIT_V(0);
    PG8_BAR;
#undef PG8_STAGE_A
#undef PG8_FILLTAB
#undef PG8_LOADOFFS
#undef PG8_SA
#undef PG8_SB
#undef PG8_STAGE
#undef PG8_LDA
#undef PG8_LDB
#undef PG8_MMA
#undef PG8_WAIT_V
#undef PG8_WAIT_L
#undef PG8_BAR
#undef PG8_SCHED
#undef PG8_KTILE2
#undef PG8_BPTR
}
}

#define XB_TMO      128
#define XB_XCNT(j)  (256  + 64 * (j))
#define XB_XSUB(j)  (1280 + 64 * (j))
#define XB_XGEN(j)  (2304 + 64 * (j))
#define XB_TOP      3328
#define XB_TOPGEN   3392
#define XCD_BAR_WORDS 3456
#define XB_SPIN_CAP (1u << 20)
__device__ __forceinline__ unsigned xb_ld(unsigned* p)              { return __hip_atomic_load(p, __ATOMIC_RELAXED, __HIP_MEMORY_SCOPE_AGENT); }
__device__ __forceinline__ unsigned xb_add(unsigned* p, unsigned v) { return __hip_atomic_fetch_add(p, v, __ATOMIC_RELAXED, __HIP_MEMORY_SCOPE_AGENT); }
__device__ __forceinline__ unsigned xb_xcc_id() { return (unsigned)__builtin_amdgcn_s_getreg((3 << 11) | 20) & 0xFu; }
#define XB_SPIN(cond, bar) do { unsigned _sp = 0; while (cond) { __builtin_amdgcn_s_sleep(1); \
    if ((++_sp & 255u) == 0u) { if (xb_ld(&(bar)[XB_TMO])) break; if (_sp > XB_SPIN_CAP) { atomicAdd(&(bar)[XB_TMO], 1u); break; } } } } while (0)
struct XcdBarrier { unsigned* bar; unsigned x; };
#define XB_ST(ldsbase) ((volatile LAS unsigned*)((LAS unsigned char*)(ldsbase) + MISC_OFF + 32))
__device__ __forceinline__ XcdBarrier xcd_barrier_post(unsigned* bar, bool leader) {
    XcdBarrier b; b.bar = bar; b.x = xb_xcc_id();
    if (leader) (void)xb_add(&bar[XB_XCNT(b.x)], 1u);
    return b;
}
__device__ __forceinline__ void xcd_barrier_complete(unsigned* bar, unsigned x, unsigned& nloc, unsigned& nx) {
    const unsigned G = gridDim.x * gridDim.y * gridDim.z;
    unsigned sum, cnt, mine, sp = 0u;
    for (;;) {
        sum = 0u; cnt = 0u; mine = 0u;
#pragma unroll
        for (unsigned j = 0; j < 16; ++j) { const unsigned c = xb_ld(&bar[XB_XCNT(j)]); sum += c; cnt += (c > 0u) ? 1u : 0u; mine = (j == x) ? c : mine; }
        if (sum == G) break;
        __builtin_amdgcn_s_sleep(1);
        if ((++sp & 255u) == 0u) { if (xb_ld(&bar[XB_TMO])) break; if (sp > XB_SPIN_CAP) { atomicAdd(&bar[XB_TMO], 1u); break; } }
    }
    nloc = mine > 0u ? mine : 1u; nx = cnt > 0u ? cnt : 1u;
}
__device__ __forceinline__ void xcd_barrier(const XcdBarrier& b, bool leader, volatile LAS unsigned* st) {
    asm volatile("s_waitcnt vmcnt(0)" ::: "memory");
    __syncthreads();
    if (leader) {
        unsigned* bar = b.bar;
        __builtin_amdgcn_s_waitcnt(0);
        unsigned nloc = st[0], nx = st[1];
        if (nloc == 0u) { xcd_barrier_complete(bar, b.x, nloc, nx); st[0] = nloc; st[1] = nx; }
        const unsigned old = xb_add(&bar[XB_XSUB(b.x)], 1u);
        const unsigned gen = old / nloc;
        if (old + 1u == (gen + 1u) * nloc) {
            __builtin_amdgcn_fence(__ATOMIC_RELEASE, "agent");
            asm volatile("s_waitcnt vmcnt(0)" ::: "memory");
            const unsigned og = xb_add(&bar[XB_TOP], 1u);
            const unsigned tg = og / nx;
            if (og + 1u == (tg + 1u) * nx) xb_add(&bar[XB_TOPGEN], 1u);
            else XB_SPIN(xb_ld(&bar[XB_TOPGEN]) == tg, bar);
            __builtin_amdgcn_fence(__ATOMIC_ACQUIRE, "agent");
            xb_add(&bar[XB_XGEN(b.x)], 1u);
            asm volatile("s_waitcnt vmcnt(0)" ::: "memory");
        } else {
            XB_SPIN(xb_ld(&bar[XB_XGEN(b.x)]) == gen, bar);
            __builtin_amdgcn_fence(__ATOMIC_ACQUIRE, "agent");
            asm volatile("s_waitcnt vmcnt(0)" ::: "memory");
        }
    }
    __syncthreads();
}

template <void (*F)(long, PRef, int)> __device__ __forceinline__ void run_items(const int tid, PRef p, int l, long n, long off) {
    for (long gid = (long)blockIdx.x * NTHR + tid; gid < n; gid += (long)gridDim.x * NTHR) F(gid + off, p, l);
}
BODY void b_hgrn_seq2(long gid, PRef p, int l) { const long n1 = (long)NB * HGH * 64; if (gid < n1) b_hgrn_seq<0>(gid, p, l); else b_hgrn_seq<1>(gid - n1, p, l); }

template <int MAP> __device__ __forceinline__ void transpose_item(const float* W, int K, int N, bf16_t* WT, int row_off, LAS float* scr, int item, int lane) {
    const int nblk = N / 32, kb = item / nblk, nb = item % nblk, k0 = 64 * kb, n0 = 32 * nb;
#pragma unroll 8
    for (int i = 0; i < 32; ++i) { const int kk = 2 * i + (lane >> 5); scr[kk * 33 + (lane & 31)] = W[(size_t)(k0 + kk) * N + n0 + (lane & 31)]; }
    asm volatile("s_waitcnt lgkmcnt(0)" ::: "memory");
    const int c = lane & 7;
#pragma unroll
    for (int j = 0; j < 4; ++j) { const int n = (lane >> 3) + 8 * j; const LAS float* s = scr + (8 * c) * 33 + n;
        u32x4 o; o.x = cvt_pk_bf16(s[0 * 33], s[1 * 33]); o.y = cvt_pk_bf16(s[2 * 33], s[3 * 33]); o.z = cvt_pk_bf16(s[4 * 33], s[5 * 33]); o.w = cvt_pk_bf16(s[6 * 33], s[7 * 33]);
        const int nn = n0 + n; const int drow = MAP == 0 ? row_off + nn : (32 * (nn >> 4) + (nn & 15) + (MAP == 2 ? 16 : 0));
        *(u32x4*)(WT + (size_t)drow * K + k0 + 8 * c) = o; }
    asm volatile("s_waitcnt lgkmcnt(0)" ::: "memory");
}
__device__ __forceinline__ void phase_convert(const int tid, PRef p, int l, LAS unsigned char* lds, int part = 0, int blk_lo = 0) {
    if ((int)blockIdx.x < blk_lo) return;
    const int lane = tid & 63, wave = tid >> 6;
    LAS float* scr = (LAS float*)(lds + wave * 16384);
    const int gw = ((int)blockIdx.x - blk_lo) * NWAVES + wave, NGW = ((int)gridDim.x - blk_lo) * NWAVES;
    constexpr int I_IN = (D / 64) * (INC / 32), I_OUT = (MIXD / 64) * (D / 32), I_G = (D / 64) * (ED / 32), I_D = (ED / 64) * (D / 32);
    constexpr int NITEMS = I_IN + I_OUT + NE * (2 * I_G + I_D);
    const int it_lo = part == 2 ? I_IN + I_OUT : 0, it_hi = part == 1 ? I_IN + I_OUT : NITEMS;
    for (int it = it_lo + gw; it < it_hi; it += NGW) {
        int r = it;
        if (r < I_IN) { transpose_item<0>(p.w_in + (size_t)l * D * INC, D, INC, p.WIN_T, 0, scr, r, lane); continue; } r -= I_IN;
        if (r < I_OUT) { transpose_item<0>(p.w_out + (size_t)l * MIXD * D, MIXD, D, p.WOUT_T, 0, scr, r, lane); continue; } r -= I_OUT;
        const int e = r / (2 * I_G + I_D); r -= e * (2 * I_G + I_D);
        if (r < I_G) { transpose_item<1>(p.w_gate + ((size_t)l * NE + e) * D * ED, D, ED, p.WGU_T + (size_t)e * 2 * ED * D, 0, scr, r, lane); continue; } r -= I_G;
        if (r < I_G) { transpose_item<2>(p.w_up + ((size_t)l * NE + e) * D * ED, D, ED, p.WGU_T + (size_t)e * 2 * ED * D, 0, scr, r, lane); continue; } r -= I_G;
        transpose_item<0>(p.w_down + ((size_t)l * NE + e) * ED * D, ED, D, p.WD_T + (size_t)e * D * ED, 0, scr, r, lane);
    }
}
template <int WHICH> __device__ __forceinline__ void phase_prenorm(const int tid, PRef p, int l) {
    static_assert(D == 1024, "wave-per-row kernels assume D = 1024");
    const int lane = tid & 63, wave = tid >> 6;
    const int gw = blockIdx.x * NWAVES + wave, NGW = gridDim.x * NWAVES;
    const float* nw = (WHICH ? p.norm2_w : p.norm1_w) + l * D;
    for (int r = gw; r < NTOK; r += NGW) {
        const float* xr = xrow(p, r);
        const float* mod = p.MOD + ((size_t)l * 3 + modset(r)) * NMOD;
        const float* shift = mod + (WHICH ? 3 : 0) * D; const float* scale = mod + (WHICH ? 4 : 1) * D;
        f32x4 v[4]; float ss = 0.f;
#pragma unroll
        for (int j = 0; j < 4; ++j) { v[j] = *(const f32x4*)(xr + 4 * lane + 256 * j); ss += (v[j][0] * v[j][0] + v[j][1] * v[j][1]) + (v[j][2] * v[j][2] + v[j][3] * v[j][3]); }
        const float rstd = 1.f / sqrtf(wave_sum(ss, lane) * (1.f / D) + EPS);
        float lg[NE];
#pragma unroll
        for (int e = 0; e < NE; ++e) lg[e] = 0.f;
#pragma unroll
        for (int j = 0; j < 4; ++j) {
            const int c = 4 * lane + 256 * j;
            const f32x4 w4 = *(const f32x4*)(nw + c), sc4 = *(const f32x4*)(scale + c), sh4 = *(const f32x4*)(shift + c);
            f32x4 h;
#pragma unroll
            for (int i = 0; i < 4; ++i) h[i] = v[j][i] * rstd * w4[i] * (1.f + sc4[i]) + sh4[i];
            u32x2 o; o.x = cvt_pk_bf16(h[0], h[1]); o.y = cvt_pk_bf16(h[2], h[3]);
            *(u32x2*)(p.H + (size_t)r * D + c) = o;
            if (WHICH) {
#pragma unroll
                for (int i = 0; i < 4; ++i) { const f32x4* wr = (const f32x4*)(p.w_router + ((size_t)l * D + c + i) * NE);
#pragma unroll
                    for (int q = 0; q < 4; ++q) { const f32x4 w = wr[q]; lg[4 * q + 0] += h[i] * w[0]; lg[4 * q + 1] += h[i] * w[1]; lg[4 * q + 2] += h[i] * w[2]; lg[4 * q + 3] += h[i] * w[3]; } }
            }
        }
        if (WHICH) {
#pragma unroll
            for (int e = 0; e < NE; ++e) lg[e] = wave_sum(lg[e], lane);
            float m = lg[0];
#pragma unroll
            for (int e = 1; e < NE; ++e) m = fmaxf(m, lg[e]);
            float s = 0.f, mine = 0.f;
#pragma unroll
            for (int e = 0; e < NE; ++e) { const float ex = expf(lg[e] - m); s += ex; mine = (lane == e) ? ex : mine; }
            if (lane < NE) p.AFF[(size_t)r * NE + lane] = mine / s;
        }
    }
}
__device__ __forceinline__ void phase_combine(const int tid, PRef p, int l) {
    const int lane = tid & 63, wave = tid >> 6;
    const int gw = blockIdx.x * NWAVES + wave, NGW = gridDim.x * NWAVES;
    for (int r = gw; r < NTOK; r += NGW) {
        float* xr = xrow(p, r);
        const float* g = p.MOD + ((size_t)l * 3 + modset(r)) * NMOD + 5 * D;
        f32x4 acc[4];
#pragma unroll
        for (int j = 0; j < 4; ++j) acc[j] = (f32x4){0.f, 0.f, 0.f, 0.f};
        const int myinv = lane < NE ? p.INV[(size_t)r * NE + lane] : -1;
#pragma unroll
        for (int e = 0; e < NE; ++e) {
            const int s = __builtin_amdgcn_readlane(myinv, e);
            if (s >= 0 && s < NSLOT) {
                const bf16_t* y = p.Y + (size_t)s * D;
#pragma unroll
                for (int j = 0; j < 4; ++j) { const u32x2 w = *(const u32x2*)(y + 4 * lane + 256 * j);
                    acc[j][0] += __builtin_bit_cast(float, w.x << 16); acc[j][1] += __builtin_bit_cast(float, w.x & 0xffff0000u);
                    acc[j][2] += __builtin_bit_cast(float, w.y << 16); acc[j][3] += __builtin_bit_cast(float, w.y & 0xffff0000u); }
            }
        }
#pragma unroll
        for (int j = 0; j < 4; ++j) { const int c = 4 * lane + 256 * j; f32x4* q = (f32x4*)(xr + c); *q = *q + *(const f32x4*)(g + c) * acc[j]; }
    }
}


__device__ __forceinline__ unsigned wave_excl_scan(unsigned x, int lane) {
    unsigned inc = x;
#pragma unroll
    for (int d = 1; d < 64; d <<= 1) { const unsigned y = (unsigned)__builtin_amdgcn_ds_bpermute(((lane - d) & 63) << 2, (int)inc); if (lane >= d) inc += y; }
    return inc - x;
}
__device__ __forceinline__ void phase_topk(const int tid, PRef p, LAS unsigned char* lds) {
    LAS unsigned* keys = (LAS unsigned*)lds;
    LAS unsigned* hist = (LAS unsigned*)(lds + 70000);
    LAS unsigned* cgt = (LAS unsigned*)(lds + 76000);
    LAS unsigned* ceq = (LAS unsigned*)(lds + 80000);
    LAS unsigned* sh = (LAS unsigned*)(lds + 84000);
    static_assert(SEQ % 512 == 0 && SEQ + SEQ / 32 <= 17400, "topk LDS layout");
    constexpr int PER = SEQ / 512;
    for (int pr = blockIdx.x; pr < 2 * NB * NE; pr += gridDim.x) {
        const int e = pr % NE, b = (pr / NE) % NB, isctx = pr / (NE * NB);
        if (!isctx) {
            const int row0 = b * SEQ, base = (b * NE + e) * CAPL;
            for (int i = 0; i < PER; ++i) { const int t = i * 512 + tid; keys[t + (t >> 5)] = __builtin_bit_cast(unsigned, p.AFF[(size_t)(row0 + t) * NE + e]); }
            if (tid == 0) { sh[0] = 0u; sh[1] = (unsigned)CAPL; }
            __syncthreads();
            for (int pass = 0; pass < 3; ++pass) {
                const int shift = 20 - 10 * pass;
                for (int i = tid; i < 1024; i += 512) hist[i] = 0u;
                __syncthreads();
                const unsigned prefix = sh[0]; const unsigned himask = pass == 0 ? 0u : (0xFFFFFFFFu << (shift + 10));
                for (int i = 0; i < PER; ++i) { const int t = tid * PER + i; const unsigned k = keys[t + (t >> 5)]; if ((k & himask) == prefix) atomicAdd((unsigned*)&hist[(k >> shift) & 1023u], 1u); }
                __syncthreads();
                if (tid < 64) {
                    const unsigned need = sh[1];
                    unsigned c[16]; unsigned tot = 0u;
#pragma unroll
                    for (int q = 0; q < 16; ++q) { c[q] = hist[1023 - 16 * tid - q]; tot += c[q]; }
                    unsigned above = wave_excl_scan(tot, tid);
                    int fbin = -1; unsigned fabove = 0u;
#pragma unroll
                    for (int q = 0; q < 16; ++q) { if (fbin < 0 && above < need && above + c[q] >= need) { fbin = 1023 - 16 * tid - q; fabove = above; } above += c[q]; }
                    if (fbin >= 0) { sh[0] = prefix | ((unsigned)fbin << shift); sh[1] = need - fabove; }
                }
                __syncthreads();
            }
            const unsigned thr = sh[0], keq = sh[1];
            unsigned ng = 0u, nq = 0u;
            for (int i = 0; i < PER; ++i) { const int t = tid * PER + i; const unsigned k = keys[t + (t >> 5)]; ng += k > thr ? 1u : 0u; nq += k == thr ? 1u : 0u; }
            cgt[tid] = ng; ceq[tid] = nq;
            __syncthreads();
            if (tid < 64) {
                unsigned g[8], q[8], sg = 0u, sq = 0u;
#pragma unroll
                for (int i = 0; i < 8; ++i) { g[i] = cgt[8 * tid + i]; q[i] = ceq[8 * tid + i]; sg += g[i]; sq += q[i]; }
                unsigned ag = wave_excl_scan(sg, tid), aq = wave_excl_scan(sq, tid);
#pragma unroll
                for (int i = 0; i < 8; ++i) { cgt[8 * tid + i] = ag; ceq[8 * tid + i] = aq; ag += g[i]; aq += q[i]; }
            }
            __syncthreads();
            unsigned rg = cgt[tid], rq = ceq[tid];
            for (int i = 0; i < PER; ++i) {
                const int t = tid * PER + i; const unsigned k = keys[t + (t >> 5)];
                int slot = -1;
                if (k > thr) { slot = (int)(rg + (rq < keq ? rq : keq)); ++rg; }
                else if (k == thr) { if (rq < keq) slot = (int)(rg + rq); ++rq; }
                const int row = row0 + t;
                if (slot >= 0) { p.STOK[base + slot] = row; p.SVAL[base + slot] = __builtin_bit_cast(float, k); p.INV[(size_t)row * NE + e] = base + slot; }
                else p.INV[(size_t)row * NE + e] = -1;
            }
            __syncthreads();
        } else {
            const int row0 = NLAT + b * CTX, base = NSLOT_L + (b * NE + e) * CAPC;
            LAS float* vals = (LAS float*)lds;
            for (int t = tid; t < CTX; t += 512) vals[t] = p.AFF[(size_t)(row0 + t) * NE + e];
            __syncthreads();
            for (int t = tid; t < CTX; t += 512) {
                const float a = vals[t]; int rank = 0;
                for (int tt = 0; tt < CTX; ++tt) { const float o = vals[tt]; rank += (o > a || (o == a && tt < t)) ? 1 : 0; }
                const int row = row0 + t;
                if (rank < CAPC) { p.STOK[base + rank] = row; p.SVAL[base + rank] = a; p.INV[(size_t)row * NE + e] = base + rank; }
                else p.INV[(size_t)row * NE + e] = -1;
            }
            __syncthreads();
        }
    }
}

#define LDS_BAR() do { asm volatile("s_waitcnt lgkmcnt(0)" ::: "memory"); __builtin_amdgcn_s_barrier(); asm volatile("" ::: "memory"); } while (0)
__device__ __forceinline__ float bfw(unsigned w, int hi) { return __builtin_bit_cast(float, hi ? (w & 0xffff0000u) : (w << 16)); }
__device__ __forceinline__ float bf8(const u32x4& v, int j) { return bfw(v[j >> 1], j & 1); }
__device__ __forceinline__ int hg_row0(int b, int pc) { return pc < NCHC ? NLAT + b * CTX + pc * 64 : b * SEQ + (pc - NCHC) * 64; }
constexpr int HG_FF = 0, HG_FB = 16640, HG_AF = 33280, HG_AB = 49920, HG_T0 = 66560, HG_TS = 9216, HG_VT = HG_T0 + 6 * HG_TS;
static_assert(HG_VT + HG_TS <= RING_BYTES, "hgrn LDS layout");
#define TSW_E(k, t) ((k) * 72 + ((((t) >> 3) ^ (((k) >> 3) & 7)) << 3) + ((t) & 7))
#define TSW_B(k, c) ((k) * 144 + (((c) ^ (((k) >> 3) & 7)) << 4))
__device__ __forceinline__ void hg_gates(const int tid, PRef p, int l, int h, const u32x4 zf, const u32x4 zb, LAS unsigned char* lds) {
    LAS float* FF = (LAS float*)(lds + HG_FF); LAS float* FB = (LAS float*)(lds + HG_FB); LAS float* AF = (LAS float*)(lds + HG_AF); LAS float* AB = (LAS float*)(lds + HG_AB);
    const int t = tid >> 3, cg = tid & 7;
    const float* lbf = p.LB + (size_t)(0 * DEPTH + l) * 384 + h * 64 + cg * 8; const float* lbb = p.LB + (size_t)(1 * DEPTH + l) * 384 + h * 64 + cg * 8;
#pragma unroll
    for (int j = 0; j < 8; ++j) {
        const float z0 = fminf(fmaxf(bf8(zf, j), -60.f), 60.f), z1 = fminf(fmaxf(bf8(zb, j), -60.f), 60.f);
        const float l0 = lbf[j], l1 = lbb[j];
        FF[t * 65 + cg * 8 + j] = l0 + (1.f - l0) * __builtin_amdgcn_rcpf(1.f + __expf(-z0));
        FB[t * 65 + cg * 8 + j] = l1 + (1.f - l1) * __builtin_amdgcn_rcpf(1.f + __expf(-z1));
    }
    LDS_BAR();
    {
        const int wave = tid >> 6, lane = tid & 63, cl = lane & 15, seg = lane >> 4, dir = wave >> 2, col = 16 * (wave & 3) + cl;
        const LAS float* F = dir ? FB : FF; LAS float* A = dir ? AB : AF;
        float pre[16]; float run = 0.f;
#pragma unroll
        for (int i = 0; i < 16; ++i) { const int tt = dir ? 16 * seg + 15 - i : 16 * seg + i; run += __logf(F[tt * 65 + col]); pre[i] = run; }
        const float T0 = __builtin_bit_cast(float, __builtin_amdgcn_ds_bpermute((cl + 0) << 2, __builtin_bit_cast(int, run)));
        const float T1 = __builtin_bit_cast(float, __builtin_amdgcn_ds_bpermute((cl + 16) << 2, __builtin_bit_cast(int, run)));
        const float T2 = __builtin_bit_cast(float, __builtin_amdgcn_ds_bpermute((cl + 32) << 2, __builtin_bit_cast(int, run)));
        const float T3 = __builtin_bit_cast(float, __builtin_amdgcn_ds_bpermute((cl + 48) << 2, __builtin_bit_cast(int, run)));
        const float off = dir ? ((seg < 1 ? T1 : 0.f) + (seg < 2 ? T2 : 0.f) + (seg < 3 ? T3 : 0.f)) : ((seg > 0 ? T0 : 0.f) + (seg > 1 ? T1 : 0.f) + (seg > 2 ? T2 : 0.f));
#pragma unroll
        for (int i = 0; i < 16; ++i) { const int tt = dir ? 16 * seg + 15 - i : 16 * seg + i; A[tt * 65 + col] = off + pre[i]; }
    }
    LDS_BAR();
}
__device__ __forceinline__ bf16x8 ld2x64(const LAS unsigned char* p0, const LAS unsigned char* p1) {
    const u32x2 a = *(const LAS u32x2*)p0, b = *(const LAS u32x2*)p1; u32x4 r; r.x = a.x; r.y = a.y; r.z = b.x; r.w = b.y; return __builtin_bit_cast(bf16x8, r);
}
__device__ __forceinline__ f32x4 mfma16(bf16x8 a, bf16x8 b, f32x4 c) { return __builtin_amdgcn_mfma_f32_16x16x32_bf16(a, b, c, 0, 0, 0); }
__device__ __forceinline__ void phase_hgrn_local(const int tid, PRef p, int l, LAS unsigned char* lds) {
    LAS float* FF = (LAS float*)(lds + HG_FF); LAS float* FB = (LAS float*)(lds + HG_FB); LAS float* AF = (LAS float*)(lds + HG_AF); LAS float* AB = (LAS float*)(lds + HG_AB);
    LAS bf16_t* KTf = (LAS bf16_t*)(lds + HG_T0); LAS bf16_t* KTb = (LAS bf16_t*)(lds + HG_T0 + HG_TS); LAS bf16_t* VT = (LAS bf16_t*)(lds + HG_VT);
    const int t = tid >> 3, cg = tid & 7, wave = tid >> 6, lane = tid & 63, fr = lane & 15, fq = lane >> 4;
    u32x4 nzf = (u32x4){0u, 0u, 0u, 0u}, nzb = nzf, nv8 = nzf;
    if ((int)blockIdx.x < NBH * NCH) { const int it = blockIdx.x, pc = it % NCH, bh = it / NCH, h = bh % HGH, b = bh / HGH;
        const bf16_t* pr = p.P + (size_t)(hg_row0(b, pc) + t) * INC + h * 64 + cg * 8; nzf = *(const u32x4*)(pr + OFF_); nzb = *(const u32x4*)(pr + OFB); nv8 = *(const u32x4*)(pr + OHI); }
    for (int it = blockIdx.x; it < NBH * NCH; it += gridDim.x) {
        const int pc = it % NCH, bh = it / NCH, h = bh % HGH, b = bh / HGH, row0 = hg_row0(b, pc);
        const u32x4 zf = nzf, zb = nzb, v8 = nv8;
        { const int it2 = it + gridDim.x; if (it2 < NBH * NCH) { const int pc2 = it2 % NCH, bh2 = it2 / NCH, h2 = bh2 % HGH, b2 = bh2 / HGH;
            const bf16_t* pr = p.P + (size_t)(hg_row0(b2, pc2) + t) * INC + h2 * 64 + cg * 8; nzf = *(const u32x4*)(pr + OFF_); nzb = *(const u32x4*)(pr + OFB); nv8 = *(const u32x4*)(pr + OHI); } }
        hg_gates(tid, p, l, h, zf, zb, lds);
#pragma unroll
        for (int j = 0; j < 8; ++j) {
            const int k = cg * 8 + j;
            VT[TSW_E(k, t)] = (bf16_t)(j & 1 ? v8[j >> 1] >> 16 : v8[j >> 1] & 0xffffu);
            KTf[TSW_E(k, t)] = f2bf((1.f - FF[t * 65 + k]) * __expf(AF[63 * 65 + k] - AF[t * 65 + k]));
            KTb[TSW_E(k, t)] = f2bf((1.f - FB[t * 65 + k]) * __expf(AB[k] - AB[t * 65 + k]));
        }
        if (tid < 64) p.GDEC[((size_t)(0 * NBH + bh) * NCH + pc) * 64 + tid] = __expf(AF[63 * 65 + tid]);
        else if (tid < 128) p.GDEC[((size_t)(1 * NBH + bh) * NCH + pc) * 64 + (tid - 64)] = __expf(AB[tid - 64]);
        LDS_BAR();
#if HGRN_DIAG == 4
        {
            const int v = tid >> 3, kg = tid & 7;
            for (int dir = 0; dir < 2; ++dir) {
                const LAS bf16_t* KT = (const LAS bf16_t*)(lds + HG_T0 + dir * HG_TS);
                float acc[8];
#pragma unroll
                for (int j = 0; j < 8; ++j) acc[j] = 0.f;
                for (int s_ = 0; s_ < 64; ++s_) { const float vv = bf2f(VT[v * 72 + s_]);
#pragma unroll
                    for (int j = 0; j < 8; ++j) acc[j] += bf2f(KT[(kg * 8 + j) * 72 + s_]) * vv; }
                bf16_t* dst = p.SLOC + ((size_t)(dir * NBH + bh) * NCH + pc) * 4096 + v * 64 + kg * 8;
#pragma unroll
                for (int j = 0; j < 8; ++j) dst[j] = f2bf(acc[j]);
            }
        }
#else
        {
            const int dir = wave >> 2, mt = wave & 3;
            const LAS unsigned char* KT = lds + HG_T0 + dir * HG_TS;
            bf16x8 a[2];
#pragma unroll
            for (int ks = 0; ks < 2; ++ks) a[ks] = *(const LAS bf16x8*)(KT + TSW_B(mt * 16 + fr, ks * 4 + fq));
            bf16_t* dst = p.SLOC + ((size_t)(dir * NBH + bh) * NCH + pc) * 4096;
#pragma unroll
            for (int nt = 0; nt < 4; ++nt) {
                f32x4 acc = (f32x4){0.f, 0.f, 0.f, 0.f};
#pragma unroll
                for (int ks = 0; ks < 2; ++ks) { const bf16x8 bb = *(const LAS bf16x8*)(lds + HG_VT + TSW_B(nt * 16 + fr, ks * 4 + fq)); acc = mfma16(a[ks], bb, acc); }
                u32x2 w; w.x = cvt_pk_bf16(acc[0], acc[1]); w.y = cvt_pk_bf16(acc[2], acc[3]);
                *(u32x2*)(dst + (nt * 16 + fr) * 64 + mt * 16 + 4 * fq) = w;
            }
        }
#endif
        LDS_BAR();
    }
}
__device__ __forceinline__ void phase_hgrn_scan(const int tid, PRef p) {
    static_assert(NCH % 20 == 0, "scan group size");
    constexpr int GS = 20;
    for (int blk = (int)gridDim.x - 1 - (int)blockIdx.x; blk < 2 * NBH * 4; blk += gridDim.x) {
        const int sq = blk >> 2, part = blk & 3, dir = sq / NBH, e0 = part * 1024 + tid * 2, k = e0 & 63;
        unsigned* S = (unsigned*)(p.SLOC + (size_t)sq * NCH * 4096 + e0);
        const float* G = p.GDEC + (size_t)sq * NCH * 64 + k;
        float c0 = 0.f, c1 = 0.f;
        unsigned nx[GS]; f32x2 gn[GS];
#define HG_PC(j) (dir ? ((j) < NCHC ? NCHC - 1 - (j) : NCH + NCHC - 1 - (j)) : (j))
#pragma unroll
        for (int u = 0; u < GS; ++u) { const int pc = HG_PC(u); nx[u] = S[(size_t)pc * 2048]; gn[u] = *(const f32x2*)(G + (size_t)pc * 64); }
        for (int j0 = 0; j0 < NCH; j0 += GS) {
            unsigned cu[GS]; f32x2 gc[GS];
#pragma unroll
            for (int u = 0; u < GS; ++u) { cu[u] = nx[u]; gc[u] = gn[u]; }
            if (j0 + GS < NCH) {
#pragma unroll
                for (int u = 0; u < GS; ++u) { const int pc = HG_PC(j0 + GS + u); nx[u] = S[(size_t)pc * 2048]; gn[u] = *(const f32x2*)(G + (size_t)pc * 64); }
            }
#pragma unroll
            for (int u = 0; u < GS; ++u) {
                const int pc = HG_PC(j0 + u);
                S[(size_t)pc * 2048] = cvt_pk_bf16(c0, c1);
                c0 = gc[u][0] * c0 + bfw(cu[u], 0); c1 = gc[u][1] * c1 + bfw(cu[u], 1);
            }
        }
#undef HG_PC
    }
}
__device__ __forceinline__ void phase_hgrn_out(const int tid, PRef p, int l, LAS unsigned char* lds) {
    const int NCHO = (l + 1 < DEPTH) ? NCH : NCH - NCHC, PC0 = NCH - NCHO;
    LAS float* FF = (LAS float*)(lds + HG_FF); LAS float* FB = (LAS float*)(lds + HG_FB); LAS float* AF = (LAS float*)(lds + HG_AF); LAS float* AB = (LAS float*)(lds + HG_AB);
    LAS bf16_t* VT = (LAS bf16_t*)(lds + HG_VT);
    LAS float* OO = (LAS float*)(lds + HG_AF);
    const int t = tid >> 3, cg = tid & 7, wave = tid >> 6, lane = tid & 63, fr = lane & 15, fq = lane >> 4;
    u32x4 nzf = (u32x4){0u, 0u, 0u, 0u}, nzb = nzf, nv8 = nzf, nq8 = nzf, ng8 = nzf;
    if ((int)blockIdx.x < NBH * NCHO) { const int it = blockIdx.x, pc = it % NCHO + PC0, bh = it / NCHO, h = bh % HGH, b = bh / HGH;
        const bf16_t* pr = p.P + (size_t)(hg_row0(b, pc) + t) * INC + h * 64 + cg * 8; nzf = *(const u32x4*)(pr + OFF_); nzb = *(const u32x4*)(pr + OFB); nv8 = *(const u32x4*)(pr + OHI); nq8 = *(const u32x4*)(pr + OHQ); ng8 = *(const u32x4*)(pr + OHG_); }
    for (int it = blockIdx.x; it < NBH * NCHO; it += gridDim.x) {
        const int pc = it % NCHO + PC0, bh = it / NCHO, h = bh % HGH, b = bh / HGH, row0 = hg_row0(b, pc);
        const u32x4 zf = nzf, zb = nzb, v8 = nv8, q8 = nq8, g8 = ng8;
        { const int it2 = it + gridDim.x; if (it2 < NBH * NCHO) { const int pc2 = it2 % NCHO + PC0, bh2 = it2 / NCHO, h2 = bh2 % HGH, b2 = bh2 / HGH;
            const bf16_t* pr = p.P + (size_t)(hg_row0(b2, pc2) + t) * INC + h2 * 64 + cg * 8; nzf = *(const u32x4*)(pr + OFF_); nzb = *(const u32x4*)(pr + OFB); nv8 = *(const u32x4*)(pr + OHI); nq8 = *(const u32x4*)(pr + OHQ); ng8 = *(const u32x4*)(pr + OHG_); } }
        bf16x8 bsin[4][2];
        { const bf16_t* SIN = p.SLOC + ((size_t)((wave >> 2) * NBH + bh) * NCH + pc) * 4096;
#pragma unroll
          for (int vt = 0; vt < 4; ++vt)
#pragma unroll
            for (int ks = 0; ks < 2; ++ks) bsin[vt][ks] = *(const bf16x8*)(SIN + (vt * 16 + fr) * 64 + ks * 32 + fq * 8); }
        hg_gates(tid, p, l, h, zf, zb, lds);
        {
            float w[6][8];
#pragma unroll
            for (int j = 0; j < 8; ++j) {
                const int k = cg * 8 + j;
                VT[TSW_E(k, t)] = (bf16_t)(j & 1 ? v8[j >> 1] >> 16 : v8[j >> 1] & 0xffffu);
                const float qv = bf8(q8, j) * 0.125f, af = AF[t * 65 + k], ab = AB[t * 65 + k], rf = AF[31 * 65 + k], rb = AB[32 * 65 + k];
                w[0][j] = qv * __expf(fminf(af - rf, 80.f)); w[1][j] = (1.f - FF[t * 65 + k]) * __expf(fminf(rf - af, 80.f)); w[2][j] = qv * __expf(af);
                w[3][j] = qv * __expf(fminf(ab - rb, 80.f)); w[4][j] = (1.f - FB[t * 65 + k]) * __expf(fminf(rb - ab, 80.f)); w[5][j] = qv * __expf(ab);
            }
#pragma unroll
            for (int a = 0; a < 6; ++a) { u32x4 o; o.x = cvt_pk_bf16(w[a][0], w[a][1]); o.y = cvt_pk_bf16(w[a][2], w[a][3]); o.z = cvt_pk_bf16(w[a][4], w[a][5]); o.w = cvt_pk_bf16(w[a][6], w[a][7]);
                *(LAS u32x4*)(lds + HG_T0 + a * HG_TS + t * 144 + cg * 16) = o; }
        }
        LDS_BAR();
        {
            const int dir = wave >> 2, tt = wave & 3;
            const LAS unsigned char* QT = lds + HG_T0 + (dir * 3 + 0) * HG_TS; const LAS unsigned char* KL = lds + HG_T0 + (dir * 3 + 1) * HG_TS; const LAS unsigned char* QH = lds + HG_T0 + (dir * 3 + 2) * HG_TS;
            bf16x8 bq[2], bh[2];
#pragma unroll
            for (int ks = 0; ks < 2; ++ks) { bq[ks] = *(const LAS bf16x8*)(QT + (tt * 16 + fr) * 144 + ks * 64 + fq * 16); bh[ks] = *(const LAS bf16x8*)(QH + (tt * 16 + fr) * 144 + ks * 64 + fq * 16); }
            f32x4 o[4];
#pragma unroll
            for (int vt = 0; vt < 4; ++vt) { o[vt] = (f32x4){0.f, 0.f, 0.f, 0.f};
#pragma unroll
                for (int ks = 0; ks < 2; ++ks) o[vt] = mfma16(bsin[vt][ks], bh[ks], o[vt]); }
            const int t_ = 16 * tt + fr;
#pragma unroll
            for (int kp = 0; kp < 2; ++kp) {
                f32x4 sc[2];
#pragma unroll
                for (int hf = 0; hf < 2; ++hf) { const int st = 2 * kp + hf;
                    sc[hf] = (f32x4){0.f, 0.f, 0.f, 0.f};
                    if (dir ? st >= tt : st <= tt) {
#pragma unroll
                        for (int ks = 0; ks < 2; ++ks) { const bf16x8 a = *(const LAS bf16x8*)(KL + (st * 16 + fr) * 144 + ks * 64 + fq * 16); sc[hf] = mfma16(a, bq[ks], sc[hf]); }
#pragma unroll
                        for (int r = 0; r < 4; ++r) { const int s_ = 16 * st + 4 * fq + r; const bool keep = dir ? (s_ >= t_) : (s_ <= t_); sc[hf][r] = keep ? sc[hf][r] : 0.f; }
                    } }
                if (dir ? (2 * kp + 1 >= tt) : (2 * kp <= tt)) {
                    u32x4 pw; pw.x = cvt_pk_bf16(sc[0][0], sc[0][1]); pw.y = cvt_pk_bf16(sc[0][2], sc[0][3]); pw.z = cvt_pk_bf16(sc[1][0], sc[1][1]); pw.w = cvt_pk_bf16(sc[1][2], sc[1][3]);
                    const bf16x8 pf = __builtin_bit_cast(bf16x8, pw);
                    const int s0 = 32 * kp + 4 * fq;
#pragma unroll
                    for (int vt = 0; vt < 4; ++vt) { const int v_ = 16 * vt + fr; const int sw = (v_ >> 3) & 7;
                        const LAS unsigned char* vr = lds + HG_VT + v_ * 144 + (s0 & 7) * 2;
                        const bf16x8 a = ld2x64(vr + (((s0 >> 3) ^ sw) << 4), vr + ((((s0 + 16) >> 3) ^ sw) << 4));
                        o[vt] = mfma16(a, pf, o[vt]); }
                }
            }
            LAS float* OOd = (LAS float*)(lds + (dir ? HG_FB : HG_FF));
#pragma unroll
            for (int vt = 0; vt < 4; ++vt)
#pragma unroll
                for (int r = 0; r < 4; ++r) OOd[t_ * 65 + 16 * vt + 4 * fq + r] = o[vt][r];
        }
        LDS_BAR();
        {
            float o[8]; float ss = 0.f;
#pragma unroll
            for (int j = 0; j < 8; ++j) { o[j] = FF[t * 65 + cg * 8 + j] + FB[t * 65 + cg * 8 + j]; ss += o[j] * o[j]; }
            ss += __builtin_bit_cast(float, __builtin_amdgcn_ds_swizzle(__builtin_bit_cast(int, ss), (1 << 10) | 0x1f));
            ss += __builtin_bit_cast(float, __builtin_amdgcn_ds_swizzle(__builtin_bit_cast(int, ss), (2 << 10) | 0x1f));
            ss += __builtin_bit_cast(float, __builtin_amdgcn_ds_swizzle(__builtin_bit_cast(int, ss), (4 << 10) | 0x1f));
            const float rstd = 1.f / sqrtf(ss * (1.f / 64.f) + EPS);
            const float* nw = p.hg_norm + l * 64 + cg * 8;
            float y[8];
#pragma unroll
            for (int j = 0; j < 8; ++j) { const float g = bf8(g8, j); y[j] = o[j] * rstd * nw[j] * g * __builtin_amdgcn_rcpf(1.f + __expf(-g)); }
            u32x4 ov; ov.x = cvt_pk_bf16(y[0], y[1]); ov.y = cvt_pk_bf16(y[2], y[3]); ov.z = cvt_pk_bf16(y[4], y[5]); ov.w = cvt_pk_bf16(y[6], y[7]);
            *(u32x4*)(p.MIX + (size_t)(row0 + t) * MIXD + 384 + h * 64 + cg * 8) = ov;
        }
        LDS_BAR();
    }
}


constexpr int AT_KC = 0, AT_VCT = 36864, AT_KL = AT_VCT + 64 * 528, AT_VL = AT_KL + 2 * 9216, AT_RPB = AT_VL + 2 * 9216, AT_END = AT_RPB + 1920;
static_assert(AT_END <= RING_BYTES && CTX == 256, "attention LDS layout (built for 256 context tokens)");
constexpr float ATHR = 6.f;
template <bool LOCAL, int NKB>
__device__ __forceinline__ void attn_step(const LAS unsigned char* Kb, const LAS unsigned char* Vb, int vstride, const bf16x8 (&qb)[2], f32x4 (&o)[4], float& m, float& lsum,
                                          int fr, int fq, int lane, const LAS float* rpb_row, const int (&boff)[8], const int (&voff)[4][2], int kbase) {
    f32x4 sc[2 * NKB];
#pragma unroll
    for (int mt = 0; mt < 2 * NKB; ++mt) { sc[mt] = (f32x4){0.f, 0.f, 0.f, 0.f};
#pragma unroll
        for (int ks = 0; ks < 2; ++ks) { const bf16x8 a = *(const LAS bf16x8*)(Kb + (16 * mt + fr) * 144 + ks * 64 + fq * 16); sc[mt] = mfma16(a, qb[ks], sc[mt]); } }
    float mx = -INFINITY;
#pragma unroll
    for (int mt = 0; mt < 2 * NKB; ++mt)
#pragma unroll
        for (int r = 0; r < 4; ++r) {
            float v = sc[mt][r];
            if (LOCAL) v += *(const LAS float*)((const LAS unsigned char*)rpb_row + boff[(4 * mt + r) & 7]);
            sc[mt][r] = v; mx = fmaxf(mx, v);
        }
    mx = fmaxf(mx, __builtin_bit_cast(float, __builtin_amdgcn_ds_swizzle(__builtin_bit_cast(int, mx), (16 << 10) | 0x1f)));
    mx = fmaxf(mx, __builtin_bit_cast(float, __builtin_amdgcn_ds_bpermute((lane ^ 32) << 2, __builtin_bit_cast(int, mx))));
    if (__builtin_amdgcn_ballot_w64(mx > m + ATHR) != 0ull) {
        const float mn = fmaxf(m, mx), corr = __builtin_amdgcn_exp2f(m - mn);
        m = mn; lsum *= corr;
#pragma unroll
        for (int dt = 0; dt < 4; ++dt) o[dt] = o[dt] * corr;
    }
    float ps = 0.f;
#pragma unroll
    for (int kb = 0; kb < NKB; ++kb) {
        float pv[8];
#pragma unroll
        for (int h2 = 0; h2 < 2; ++h2)
#pragma unroll
            for (int r = 0; r < 4; ++r) { const float e = __builtin_amdgcn_exp2f(sc[2 * kb + h2][r] - m); pv[4 * h2 + r] = e; ps += e; }
        u32x4 pw; pw.x = cvt_pk_bf16(pv[0], pv[1]); pw.y = cvt_pk_bf16(pv[2], pv[3]); pw.z = cvt_pk_bf16(pv[4], pv[5]); pw.w = cvt_pk_bf16(pv[6], pv[7]);
        const bf16x8 pf = __builtin_bit_cast(bf16x8, pw);
#pragma unroll
        for (int dt = 0; dt < 4; ++dt) {
            bf16x8 a;
            if (LOCAL) a = ld2x64(Vb + voff[dt][0], Vb + voff[dt][1]);
            else { const int d_ = 16 * dt + fr, sw_ = (d_ >> 3) & 7, c0_ = (kbase >> 3) + 4 * kb + (fq >> 1);
                const LAS unsigned char* vr = Vb + d_ * vstride + (fq & 1) * 8;
                a = ld2x64(vr + ((c0_ ^ sw_) << 4), vr + (((c0_ + 2) ^ sw_) << 4)); }
            o[dt] = mfma16(a, pf, o[dt]);
        }
    }
    lsum += ps;
}
__device__ __forceinline__ void phase_attn(const int tid, PRef p, int l, LAS unsigned char* lds) {
    const int wave = tid >> 6, lane = tid & 63, fr = lane & 15, fq = lane >> 4, skey = tid >> 3, sc8 = tid & 7;
    LAS float* RPB = (LAS float*)(lds + AT_RPB);
    constexpr int NPAIR = ROWS / 2; const int IPB = NPAIR + ((l + 1 < DEPTH) ? 2 : 0);
    const int G_ = gridDim.x, NIT = NB * NAH * IPB;
    const bool deal = (G_ == 256 && NIT <= 160 * 7 + 96 * 5);
    const int it_lo = deal ? ((int)blockIdx.x < 160 ? (int)blockIdx.x * 7 : 1120 + ((int)blockIdx.x - 160) * 5) : (int)blockIdx.x;
    const int it_n = deal ? ((int)blockIdx.x < 160 ? 7 : 5) : (NIT - (int)blockIdx.x + G_ - 1) / G_;
    int last_bh = -1;
    for (int ii = 0; ii < it_n; ++ii) {
        const int it = deal ? it_lo + ii : it_lo + ii * G_;
        if (it >= NIT) break;
        const int sub = it % IPB, bh = it / IPB, head = bh % NAH, b = bh / NAH;
        const bool islat = sub < NPAIR;
        const int r0 = 2 * sub, qr = r0 + (wave >> 2), jb = wave & 3;
        LDS_BAR();
        if (bh != last_bh) {
            last_bh = bh;
            for (int rnd = 0; rnd < 4; ++rnd) {
                const int key = skey + 64 * rnd; const bf16_t* src = p.P + (size_t)(NLAT + b * CTX + key) * INC + head * 64 + sc8 * 8;
                const u32x4 kv = *(const u32x4*)(src + OK_), vv = *(const u32x4*)(src + OV);
                *(LAS u32x4*)(lds + AT_KC + key * 144 + sc8 * 16) = kv;
#pragma unroll
                for (int j = 0; j < 8; ++j) *(LAS bf16_t*)(lds + AT_VCT + (sc8 * 8 + j) * 528 + ((((key >> 3) ^ sc8) << 4) + (key & 7) * 2)) = (bf16_t)(j & 1 ? vv[j >> 1] >> 16 : vv[j >> 1] & 0xffffu);
            }
            if (tid < 15 * 32) RPB[tid] = (tid & 31) < 31 ? p.rpb[((size_t)l * NAH + head) * 465 + (tid >> 5) * 31 + (tid & 31)] * 1.44269504089f : -INFINITY;
        }
        const int qtok = islat ? b * SEQ + qr * GW + 16 * jb + fr : NLAT + b * CTX + ((sub - NPAIR) * 128 + 16 * wave) + fr;
        bf16x8 qb[2];
#pragma unroll
        for (int ks = 0; ks < 2; ++ks) qb[ks] = *(const bf16x8*)(p.P + (size_t)qtok * INC + OQ + head * 64 + ks * 32 + fq * 8);
        int krlo = 0, krhi = -1, rs = 0;
        if (islat) { int a = r0 - 4; a = a < 0 ? 0 : (a > ROWS - 8 ? ROWS - 8 : a); int c = r0 + 1 - 4; c = c < 0 ? 0 : (c > ROWS - 8 ? ROWS - 8 : c); krlo = a; krhi = c + 7;
            rs = qr - 4; rs = rs < 0 ? 0 : (rs > ROWS - 8 ? ROWS - 8 : rs); }
        u32x4 kA = (u32x4){0u, 0u, 0u, 0u}, vA = kA, kB = kA, vB = kA;
#define AT_LOADROW(row, kd, vd) do { const bf16_t* src_ = p.P + (size_t)(b * SEQ + (row) * GW + skey) * INC + head * 64 + sc8 * 8; kd = *(const u32x4*)(src_ + OK_); vd = *(const u32x4*)(src_ + OV); } while (0)
#define AT_STAGEROW(bufi, kd, vd) do { *(LAS u32x4*)(lds + AT_KL + (bufi) * 9216 + skey * 144 + sc8 * 16) = kd; \
        _Pragma("unroll") for (int j = 0; j < 8; ++j) *(LAS bf16_t*)(lds + AT_VL + (bufi) * 9216 + (sc8 * 8 + j) * 144 + ((((skey >> 3) ^ sc8) << 4) + (skey & 7) * 2)) = (bf16_t)(j & 1 ? vd[j >> 1] >> 16 : vd[j >> 1] & 0xffffu); } while (0)
        if (islat) { AT_LOADROW(krlo, kA, vA); AT_LOADROW(krlo + 1, kB, vB); }
        f32x4 o[4]; float m = -1e30f, lsum = 0.f;
#pragma unroll
        for (int dt = 0; dt < 4; ++dt) o[dt] = (f32x4){0.f, 0.f, 0.f, 0.f};
        LDS_BAR();
        const int bs = jb == 0 ? 0 : (jb == 1 ? 8 : (jb == 2 ? 24 : 32)), qc = 16 * jb + fr;
        int boff[8], voff[4][2];
        { int ws = qc - 8; ws = ws < 0 ? 0 : (ws > 48 ? 48 : ws);
#pragma unroll
          for (int j_ = 0; j_ < 8; ++j_) { const int kc = bs + 16 * (j_ >> 2) + 4 * fq + (j_ & 3); const bool ok = kc >= ws && kc < ws + 16; boff[j_] = (ok ? kc - qc + 15 : 31) * 4; asm volatile("" : "+v"(boff[j_])); }
#pragma unroll
          for (int dt = 0; dt < 4; ++dt) { const int d_ = 16 * dt + fr, sw_ = (d_ >> 3) & 7, c0_ = (bs >> 3) + (fq >> 1);
              voff[dt][0] = d_ * 144 + (fq & 1) * 8 + ((c0_ ^ sw_) << 4); voff[dt][1] = d_ * 144 + (fq & 1) * 8 + (((c0_ + 2) ^ sw_) << 4); asm volatile("" : "+v"(voff[dt][0]), "+v"(voff[dt][1])); } }
        for (int st = 0; st < 4; ++st)
            attn_step<false, 2>(lds + AT_KC + st * 64 * 144, lds + AT_VCT, 528, qb, o, m, lsum, fr, fq, lane, RPB, boff, voff, st * 64);
        if (islat) { AT_STAGEROW(0, kA, vA); kA = kB; vA = vB; if (krlo + 2 <= krhi) AT_LOADROW(krlo + 2, kB, vB); }
        LDS_BAR();
        for (int kr = krlo; kr <= krhi; ++kr) {
            const int buf = (kr - krlo) & 1;
            if (kr >= rs && kr < rs + 8)
                attn_step<true, 1>(lds + AT_KL + buf * 9216 + bs * 144, lds + AT_VL + buf * 9216, 144, qb, o, m, lsum, fr, fq, lane, RPB + (kr - qr + 7) * 32, boff, voff, bs);
            if (kr < krhi) { AT_STAGEROW(buf ^ 1, kA, vA); kA = kB; vA = vB; if (kr + 3 <= krhi) AT_LOADROW(kr + 3, kB, vB); }
            LDS_BAR();
        }
#undef AT_LOADROW
#undef AT_STAGEROW
        lsum += __builtin_bit_cast(float, __builtin_amdgcn_ds_swizzle(__builtin_bit_cast(int, lsum), (16 << 10) | 0x1f));
        lsum += __builtin_bit_cast(float, __builtin_amdgcn_ds_bpermute((lane ^ 32) << 2, __builtin_bit_cast(int, lsum)));
        const float inv = 1.f / lsum;
        bf16_t* orow = p.MIX + (size_t)qtok * MIXD + head * 64;
#pragma unroll
        for (int dt = 0; dt < 4; ++dt) { u32x2 w; w.x = cvt_pk_bf16(o[dt][0] * inv, o[dt][1] * inv); w.y = cvt_pk_bf16(o[dt][2] * inv, o[dt][3] * inv); *(u32x2*)(orow + 16 * dt + 4 * fq) = w; }
    }
}


template <int MODE> __device__ __forceinline__ void mini_gemm(const int tid, PRef p, int l) {
    const int wave = tid >> 6, lane = tid & 63, fr = lane & 15, fq = lane >> 4;
    const int gw = blockIdx.x * NWAVES + wave, NGW = gridDim.x * NWAVES;
    constexpr int K = MODE == 3 ? ED : (MODE == 1 ? MIXD : D);
    constexpr int N = MODE == 0 ? INC : (MODE == 2 ? 2 * ED : D);
    constexpr int MROWS = MODE <= 1 ? NCTX : NSLOT_C;
    constexpr int NTC = MODE == 2 ? 2 : 1, TW = 16 * NTC;
    constexpr int NTN = N / TW, NT = (MROWS / 32) * NTN;
    for (int t = gw; t < NT; t += NGW) {
        const int rt = t / NTN, ct = t % NTN, c0 = ct * TW;
        const bf16_t* Bt; const bf16_t* arow[2];
        if (MODE == 0) { Bt = p.WIN_T; for (int mt = 0; mt < 2; ++mt) arow[mt] = p.H + (size_t)(NLAT + rt * 32 + 16 * mt + fr) * D; }
        else if (MODE == 1) { Bt = p.WOUT_T; for (int mt = 0; mt < 2; ++mt) arow[mt] = p.MIX + (size_t)(NLAT + rt * 32 + 16 * mt + fr) * MIXD; }
        else if (MODE == 2) { const int e = rt % NE; Bt = p.WGU_T + (size_t)e * 2 * ED * D;
            for (int mt = 0; mt < 2; ++mt) { int row = p.STOK[NSLOT_L + rt * 32 + 16 * mt + fr]; row = row < 0 ? 0 : (row >= NTOK ? NTOK - 1 : row); arow[mt] = p.H + (size_t)row * D; } }
        else { const int e = rt % NE; Bt = p.WD_T + (size_t)e * D * ED; for (int mt = 0; mt < 2; ++mt) arow[mt] = p.HID + (size_t)(NSLOT_L + rt * 32 + 16 * mt + fr) * ED; }
        const bf16_t* brow = Bt + (size_t)(c0 + fr) * K;
        f32x4 acc[2][NTC];
#pragma unroll
        for (int mt = 0; mt < 2; ++mt)
#pragma unroll
            for (int nt = 0; nt < NTC; ++nt) acc[mt][nt] = (f32x4){0.f, 0.f, 0.f, 0.f};
#pragma unroll 8
        for (int ks = 0; ks < K / 32; ++ks) {
            bf16x8 a[2], bfr[NTC];
#pragma unroll
            for (int mt = 0; mt < 2; ++mt) a[mt] = *(const bf16x8*)(arow[mt] + ks * 32 + fq * 8);
#pragma unroll
            for (int nt = 0; nt < NTC; ++nt) bfr[nt] = *(const bf16x8*)(brow + (size_t)(16 * nt) * K + ks * 32 + fq * 8);
#pragma unroll
            for (int mt = 0; mt < 2; ++mt)
#pragma unroll
                for (int nt = 0; nt < NTC; ++nt) acc[mt][nt] = mfma16(a[mt], bfr[nt], acc[mt][nt]);
        }
#pragma unroll
        for (int mt = 0; mt < 2; ++mt)
#pragma unroll
            for (int r = 0; r < 4; ++r) {
                const int lr = rt * 32 + 16 * mt + 4 * fq + r;
                if (MODE == 0) { bf16_t* o = p.P + (size_t)(NLAT + lr) * INC + c0 + fr;
#pragma unroll
                    for (int nt = 0; nt < NTC; ++nt) o[16 * nt] = f2bf(acc[mt][nt][r]); }
                else if (MODE == 1) { float* o = p.XC + (size_t)lr * D + c0 + fr; const float* g = p.MOD + ((size_t)l * 3 + 2) * NMOD + 2 * D + c0 + fr;
#pragma unroll
                    for (int nt = 0; nt < NTC; ++nt) o[16 * nt] += g[16 * nt] * acc[mt][nt][r]; }
                else if (MODE == 2) { bf16_t* o = p.HID + (size_t)(NSLOT_L + lr) * ED + c0 / 2 + fr;
#pragma unroll
                    for (int q = 0; q < NTC / 2; ++q) { const float g = acc[mt][2 * q][r], u = acc[mt][2 * q + 1][r]; o[16 * q] = f2bf(g / (1.f + __expf(-g)) * u); } }
                else { bf16_t* o = p.Y + (size_t)(NSLOT_L + lr) * D + c0 + fr; const float val = p.SVAL[NSLOT_L + lr];
#pragma unroll
                    for (int nt = 0; nt < NTC; ++nt) o[16 * nt] = f2bf(val * acc[mt][nt][r]); }
            }
    }
}


__device__ __forceinline__ void phase_conv(const int tid, PRef p, int l) {
    const float* w = p.conv_w + (size_t)l * 3 * CVD;
    for (long gid = (long)blockIdx.x * NTHR + tid; gid < (long)NTOK * (CVD / 8); gid += (long)gridDim.x * NTHR) {
        const int r = (int)(gid / (CVD / 8)), c8 = (int)(gid % (CVD / 8)) * 8;
        int t, T; if (r < NLAT) { t = r % SEQ; T = SEQ; } else { t = (r - NLAT) % CTX; T = CTX; }
        const bf16_t* pr = p.P + (size_t)r * INC + c8;
        float y[8];
#pragma unroll
        for (int j = 0; j < 8; ++j) y[j] = 0.f;
#pragma unroll
        for (int d = 0; d < 3; ++d) {
            const int tt = t + d - 1;
            if (tt >= 0 && tt < T) {
                const bf16_t* q = pr + (long)(d - 1) * INC; const u32x4 c = *(const u32x4*)(q + OCC), u = *(const u32x4*)(q + OCU);
                const f32x4 w0 = *(const f32x4*)(w + d * CVD + c8), w1 = *(const f32x4*)(w + d * CVD + c8 + 4);
#pragma unroll
                for (int j = 0; j < 8; ++j) y[j] += (j < 4 ? w0[j & 3] : w1[j & 3]) * bf8(c, j) * bf8(u, j);
            }
        }
        const u32x4 bg = *(const u32x4*)(pr + OCB);
        u32x4 o; o.x = cvt_pk_bf16(bf8(bg, 0) * y[0], bf8(bg, 1) * y[1]); o.y = cvt_pk_bf16(bf8(bg, 2) * y[2], bf8(bg, 3) * y[3]);
        o.z = cvt_pk_bf16(bf8(bg, 4) * y[4], bf8(bg, 5) * y[5]); o.w = cvt_pk_bf16(bf8(bg, 6) * y[6], bf8(bg, 7) * y[7]);
        *(u32x4*)(p.MIX + (size_t)r * MIXD + 768 + c8) = o;
    }
}
__device__ __forceinline__ void phase_qkprep(const int tid, PRef p, int l) {
    const int sub = tid & 7;
    constexpr int U = 4;
    const long ngroups = (long)NTOK * 12, gstride = ((long)gridDim.x * NTHR) >> 3;
    for (long g0 = ((long)blockIdx.x * NTHR + tid) >> 3; g0 < ngroups; g0 += gstride * U) {
        u32x4 raw[U]; bf16_t* ptr[U]; int rr[U]; int wh[U];
#pragma unroll
        for (int u = 0; u < U; ++u) { long g8 = g0 + u * gstride; const bool ok = g8 < ngroups; if (!ok) g8 = g0;
            rr[u] = ok ? (int)(g8 / 12) : -1; wh[u] = (int)(g8 % 12) / 6; const int head = (int)(g8 % 6);
            ptr[u] = p.P + (size_t)(g8 / 12) * INC + (wh[u] ? OK_ : OQ) + head * HD + sub * 8; raw[u] = *(const u32x4*)ptr[u]; }
#pragma unroll
        for (int u = 0; u < U; ++u) {
            const float* nw = (wh[u] ? p.k_norm : p.q_norm) + l * HD + sub * 8;
            float y[8]; float ss = 0.f;
#pragma unroll
            for (int j = 0; j < 8; ++j) { y[j] = bf8(raw[u], j); ss += y[j] * y[j]; }
            ss += __builtin_bit_cast(float, __builtin_amdgcn_ds_swizzle(__builtin_bit_cast(int, ss), (1 << 10) | 0x1f));
            ss += __builtin_bit_cast(float, __builtin_amdgcn_ds_swizzle(__builtin_bit_cast(int, ss), (2 << 10) | 0x1f));
            ss += __builtin_bit_cast(float, __builtin_amdgcn_ds_swizzle(__builtin_bit_cast(int, ss), (4 << 10) | 0x1f));
            const float rstd = 1.f / sqrtf(ss * (1.f / HD) + EPS);
#pragma unroll
            for (int j = 0; j < 8; ++j) y[j] = y[j] * rstd * nw[j];
            const int r = rr[u];
            const bool lat = r >= 0 && r < NLAT;
            const int t = lat ? r % SEQ : 0; const float pos = (sub & 4) ? (float)(t % GW) : (float)(t / GW);
            const bool second = (sub & 2) != 0;
#pragma unroll
            for (int j = 0; j < 8; ++j) {
                const float other = __builtin_bit_cast(float, __builtin_amdgcn_ds_swizzle(__builtin_bit_cast(int, y[j]), (2 << 10) | 0x1f));
                const int fi = (sub & 1) * 8 + j;
                const float ang = pos * __builtin_amdgcn_exp2f(-(float)fi * (13.287712379549449f / 16.f));
                const float cs = FCOS(ang), sn = FSIN(ang);
                const float rot = second ? y[j] * cs + other * sn : y[j] * cs - other * sn;
                y[j] = lat ? rot : y[j];
            }
            if (r >= 0) { u32x4 o; o.x = cvt_pk_bf16(y[0], y[1]); o.y = cvt_pk_bf16(y[2], y[3]); o.z = cvt_pk_bf16(y[4], y[5]); o.w = cvt_pk_bf16(y[6], y[7]); *(u32x4*)ptr[u] = o; }
        }
    }
}

__device__ __forceinline__ f32x4 bf4(const u32x2 w) { return (f32x4){bfw(w.x, 0), bfw(w.x, 1), bfw(w.y, 0), bfw(w.y, 1)}; }
template <int MODE> __device__ __forceinline__ void phase_rows(const int tid, PRef p, int l, LAS unsigned char* lds) {
    static_assert(D == 1024, "wave-per-row kernels assume D = 1024");
    const int lane = tid & 63, wave = tid >> 6;
    if (MODE == 1) {
        for (int k = tid; k < D; k += NTHR) { const f32x4* src = (const f32x4*)(p.w_router + ((size_t)l * D + k) * NE); LAS f32x4* dst = (LAS f32x4*)(lds + k * 64 + (k >> 2) * 16);
#pragma unroll
            for (int u = 0; u < 4; ++u) dst[u] = src[u]; }
        __syncthreads();
    }
    const int gw = blockIdx.x * NWAVES + wave, NGW = gridDim.x * NWAVES;
    const int rw = ((NTOK + NGW - 1) / NGW + 1) & ~1;
    const int r_lo = gw * rw, r_hi = min(NTOK, r_lo + rw);
    const bool doh = MODE != 2 || l + 1 < DEPTH;
    const int ln = (MODE == 2 && l + 1 < DEPTH) ? l + 1 : l;
    const float* nw = (MODE == 1 ? p.norm2_w : p.norm1_w) + (size_t)ln * D;
    int curset = -1; f32x4 Av[4], Sv[4], Gv[4];
#pragma unroll
    for (int j = 0; j < 4; ++j) { Av[j] = (f32x4){0.f, 0.f, 0.f, 0.f}; Sv[j] = Av[j]; Gv[j] = Av[j]; }
    f32x4 vn[2][4]; int invn[2] = {-1, -1};
#define ROWS_LOADPAIR(rb) do { _Pragma("unroll") for (int i_ = 0; i_ < 2; ++i_) { const int rr_ = ((rb) + i_ < r_hi) ? (rb) + i_ : (rb); \
        const float* src_ = MODE == 0 ? (rr_ < NLAT ? p.x + (size_t)rr_ * D : p.ctx + (size_t)(rr_ - NLAT) * D) : xrow(p, rr_); \
        _Pragma("unroll") for (int j_ = 0; j_ < 4; ++j_) vn[i_][j_] = *(const f32x4*)(src_ + 4 * lane + 256 * j_); \
        if (MODE == 2) invn[i_] = lane < NE ? p.INV[(size_t)rr_ * NE + lane] : -1; } } while (0)
#pragma unroll
    for (int i = 0; i < 2; ++i)
#pragma unroll
        for (int j = 0; j < 4; ++j) vn[i][j] = (f32x4){0.f, 0.f, 0.f, 0.f};
    if (r_lo < r_hi) ROWS_LOADPAIR(r_lo);
#pragma unroll 1
    for (int r = r_lo; r < r_hi; r += 2) {
        const bool two = r + 1 < r_hi;
        const int set = modset(r);
        if (set != curset) { curset = set;
            const float* mod = p.MOD + ((size_t)ln * 3 + set) * NMOD; const float* shift = mod + (MODE == 1 ? 3 : 0) * D; const float* scale = mod + (MODE == 1 ? 4 : 1) * D;
            int lane2 = lane; asm volatile("" : "+v"(lane2));
#pragma unroll
            for (int j = 0; j < 4; ++j) { const int c = 4 * lane2 + 256 * j; const f32x4 w4 = *(const f32x4*)(nw + c), sc4 = *(const f32x4*)(scale + c); Av[j] = w4 * (sc4 + 1.f); Sv[j] = *(const f32x4*)(shift + c);
                if (MODE == 2) Gv[j] = *(const f32x4*)(p.MOD + ((size_t)l * 3 + set) * NMOD + 5 * D + c); } }
        f32x4 v[2][4]; int inv2[2];
#pragma unroll
        for (int i = 0; i < 2; ++i) { inv2[i] = invn[i];
#pragma unroll
            for (int j = 0; j < 4; ++j) v[i][j] = vn[i][j]; }
        if (r + 2 < r_hi) ROWS_LOADPAIR(r + 2);
        if (MODE == 2) {
#pragma unroll
            for (int i = 0; i < 2; ++i) {
                const int myinv = inv2[i];
                unsigned long long mask = __ballot(myinv >= 0 && myinv < NSLOT);
                f32x4 acc[4];
#pragma unroll
                for (int j = 0; j < 4; ++j) acc[j] = (f32x4){0.f, 0.f, 0.f, 0.f};
                while (mask) {
                    const int e0 = __builtin_ctzll(mask); mask &= mask - 1; const int s0 = __builtin_amdgcn_readlane(myinv, e0);
                    int s1 = -1; if (mask) { const int e1 = __builtin_ctzll(mask); mask &= mask - 1; s1 = __builtin_amdgcn_readlane(myinv, e1); }
                    u32x2 y0[4], y1[4];
#pragma unroll
                    for (int j = 0; j < 4; ++j) y0[j] = *(const u32x2*)(p.Y + (size_t)s0 * D + 4 * lane + 256 * j);
                    if (s1 >= 0) {
#pragma unroll
                        for (int j = 0; j < 4; ++j) y1[j] = *(const u32x2*)(p.Y + (size_t)s1 * D + 4 * lane + 256 * j);
                    }
#pragma unroll
                    for (int j = 0; j < 4; ++j) acc[j] = acc[j] + bf4(y0[j]);
                    if (s1 >= 0) {
#pragma unroll
                        for (int j = 0; j < 4; ++j) acc[j] = acc[j] + bf4(y1[j]);
                    }
                }
#pragma unroll
                for (int j = 0; j < 4; ++j) v[i][j] = v[i][j] + Gv[j] * acc[j];
            }
        }
        if ((MODE == 0 && r >= NLAT) || MODE == 2) {
#pragma unroll
            for (int i = 0; i < 2; ++i) if (i == 0 || two) { float* dst = xrow(p, r + i);
#pragma unroll
                for (int j = 0; j < 4; ++j) *(f32x4*)(dst + 4 * lane + 256 * j) = v[i][j]; }
        }
        if (doh) {
            float ss[2];
#pragma unroll
            for (int i = 0; i < 2; ++i) { float a = 0.f;
#pragma unroll
                for (int j = 0; j < 4; ++j) a += (v[i][j][0] * v[i][j][0] + v[i][j][1] * v[i][j][1]) + (v[i][j][2] * v[i][j][2] + v[i][j][3] * v[i][j][3]);
                ss[i] = a; }
            ss[0] = wave_sum(ss[0], lane); ss[1] = wave_sum(ss[1], lane);
            const float rstd0 = 1.f / sqrtf(ss[0] * (1.f / D) + EPS), rstd1 = 1.f / sqrtf(ss[1] * (1.f / D) + EPS);
            f32x4 hh[2][4];
#pragma unroll
            for (int j = 0; j < 4; ++j) {
                const int c = 4 * lane + 256 * j;
                hh[0][j] = v[0][j] * rstd0 * Av[j] + Sv[j]; hh[1][j] = v[1][j] * rstd1 * Av[j] + Sv[j];
                u32x2 o; o.x = cvt_pk_bf16(hh[0][j][0], hh[0][j][1]); o.y = cvt_pk_bf16(hh[0][j][2], hh[0][j][3]);
                *(u32x2*)(p.H + (size_t)r * D + c) = o;
                if (two) { o.x = cvt_pk_bf16(hh[1][j][0], hh[1][j][1]); o.y = cvt_pk_bf16(hh[1][j][2], hh[1][j][3]); *(u32x2*)(p.H + (size_t)(r + 1) * D + c) = o; }
            }
            if (MODE == 1) {
                LAS float* red = (LAS float*)(lds + 70144 + wave * 4224);
#pragma unroll
                for (int i = 0; i < 2; ++i) {
                    float lg[NE];
#pragma unroll
                    for (int e = 0; e < NE; ++e) lg[e] = 0.f;
#pragma unroll
                    for (int j = 0; j < 4; ++j)
#pragma unroll
                        for (int q = 0; q < 4; ++q) { const int k = 4 * lane + 256 * j + q; const LAS f32x4* wr = (const LAS f32x4*)(lds + k * 64 + (k >> 2) * 16); const float hv = hh[i][j][q];
#pragma unroll
                            for (int u = 0; u < 4; ++u) { const f32x4 w = wr[u]; lg[4 * u + 0] += hv * w[0]; lg[4 * u + 1] += hv * w[1]; lg[4 * u + 2] += hv * w[2]; lg[4 * u + 3] += hv * w[3]; } }
#pragma unroll
                    for (int e = 0; e < NE; ++e) red[e * 65 + lane] = lg[e];
                    asm volatile("" ::: "memory");
                    const int e2 = lane & 15, part = lane >> 4;
                    float t = 0.f;
#pragma unroll
                    for (int x = 0; x < 16; ++x) t += red[e2 * 65 + part * 16 + x];
                    asm volatile("" ::: "memory");
                    t += __builtin_bit_cast(float, __builtin_amdgcn_ds_swizzle(__builtin_bit_cast(int, t), (16 << 10) | 0x1f));
                    t += __builtin_bit_cast(float, __builtin_amdgcn_ds_bpermute((lane ^ 32) << 2, __builtin_bit_cast(int, t)));
#define SWZF(x, d) __builtin_bit_cast(float, __builtin_amdgcn_ds_swizzle(__builtin_bit_cast(int, (x)), ((d) << 10) | 0x1f))
                    float m = t;
                    m = fmaxf(m, SWZF(m, 1)); m = fmaxf(m, SWZF(m, 2)); m = fmaxf(m, SWZF(m, 4)); m = fmaxf(m, SWZF(m, 8));
                    const float ex = expf(t - m); float sm = ex;
                    sm += SWZF(sm, 1); sm += SWZF(sm, 2); sm += SWZF(sm, 4); sm += SWZF(sm, 8);
#undef SWZF
                    if (lane < NE && (i == 0 || two)) p.AFF[(size_t)(r + i) * NE + lane] = ex / sm;
                }
            }
        }
    }
#undef ROWS_LOADPAIR
    if (MODE == 1) __syncthreads();
}


__device__ __forceinline__ void phase_adaln(const int tid, PRef p, LAS unsigned char* lds) {
    static_assert(D == 1024 && NMOD % 256 == 0, "adaln layout");
    const int lane = tid & 63, wave = tid >> 6;
    LAS float* SC = (LAS float*)lds;
    LAS float* RED = (LAS float*)(lds + 16384);
    for (int i = tid; i < 3 * D; i += NTHR) { const int st = i / D, k = i % D; const float cv = st < 2 ? p.c[st * D + k] : p.c_ctx[k]; SC[i] = cv / (1.f + __expf(-cv)); }
    __syncthreads();
    constexpr int NCG = NMOD / 256;
    for (int item = blockIdx.x; item < DEPTH * NCG * 2; item += gridDim.x) {
        const int l = item / (NCG * 2), rem = item % (NCG * 2), cgp = rem >> 1, kh = rem & 1;
        const int kbase = kh * 512 + wave * 64;
        const float* wp = p.w_mod + ((size_t)l * D + kbase) * NMOD + cgp * 256 + 4 * lane;
        f32x4 acc[3];
#pragma unroll
        for (int st = 0; st < 3; ++st) acc[st] = (f32x4){0.f, 0.f, 0.f, 0.f};
#pragma unroll 16
        for (int kk = 0; kk < 64; ++kk) { const f32x4 w = *(const f32x4*)(wp + (size_t)kk * NMOD);
#pragma unroll
            for (int st = 0; st < 3; ++st) acc[st] = acc[st] + w * SC[st * D + kbase + kk]; }
#pragma unroll
        for (int st = 0; st < 3; ++st) *(LAS f32x4*)(RED + (wave * 3 + st) * 256 + 4 * lane) = acc[st];
        __syncthreads();
        for (int o = tid; o < 3 * 256; o += NTHR) { const int st = o >> 8, n = o & 255; float v = 0.f;
#pragma unroll
            for (int w8 = 0; w8 < 8; ++w8) v += RED[(w8 * 3 + st) * 256 + n];
            if (kh == 0) v += p.b_mod[(size_t)l * NMOD + cgp * 256 + n];
            atomicAdd(p.MOD + ((size_t)l * 3 + st) * NMOD + cgp * 256 + n, v); }
        __syncthreads();
    }
}

constexpr int NPL = 11, NPH = 1 + DEPTH * NPL;
struct Args { Params p; int ph_lo, ph_hi; };
__global__ void __launch_bounds__(NTHR, 2) mega_fwd(Args args) {
    LAS unsigned char* lds = (LAS unsigned char*)lds_raw;
    {
        const int tid0 = threadIdx.x;
        for (int u = tid0; u < (LDS_BYTES - LDSCTL_OFF) / 4; u += NTHR) ((LAS unsigned*)(lds + LDSCTL_OFF))[u] = 0u;
        __syncthreads();
    }
    int wslot = 0;
    { unsigned m_ = ~0u; asm volatile("" : "+s"(m_));
      const int simd = (int)(__builtin_amdgcn_s_getreg((1 << 11) | (4 << 6) | 4) & 3u);
      if (__builtin_amdgcn_mbcnt_hi(m_, __builtin_amdgcn_mbcnt_lo(m_, 0u)) == 0) wslot = simd + 4 * (int)__hip_atomic_fetch_add(((unsigned*)(lds_raw + MISC_OFF + 64)) + simd, 1u, __ATOMIC_RELAXED, __HIP_MEMORY_SCOPE_WORKGROUP); }
    wslot = __builtin_amdgcn_readfirstlane(wslot) & 7;
#define MY_TID(var) int var; { unsigned m_ = ~0u; asm volatile("" : "+s"(m_)); var = wslot * 64 + (int)__builtin_amdgcn_mbcnt_hi(m_, __builtin_amdgcn_mbcnt_lo(m_, 0u)); } asm volatile("" : "+v"(var))
    XcdBarrier bar; bar.bar = args.p.CTL; bar.x = 0;
    const bool multi = args.ph_hi - args.ph_lo > 1;
    if (multi) { MY_TID(t0); bar = xcd_barrier_post(args.p.CTL, t0 == 0); }
    const int G = gridDim.x;
    const int ph_lo = args.ph_lo, ph_hi = args.ph_hi;
#ifndef PHMASK
#define PHMASK 0xFFFF
#endif
#define PH_ON(k) ((k) == 0 ? (PHMASK & 1) : ((PHMASK >> (1 + ((k) - 1) % NPL)) & 1))
#ifndef REPMASK
#define REPMASK 0
#endif
#ifndef REP_LOCAL
#define REP_LOCAL 0
#define REP_CONV 0
#define REP_ATTN 0
#endif
#ifndef REP_P0
#define REP_P0 0
#endif
#define REP_N(k) (((k) == 0 && REP_P0) ? 2 : (((k) > 0 && ((REPMASK >> (((k) - 1) % NPL)) & 1)) ? 2 : 1))
#define PH_BEGIN(k) if (PH_ON(k) && ph_lo <= (k) && (k) < ph_hi) { for (int rep_ = 0; rep_ < REP_N(k); ++rep_) { const AS4 Args* kp = (const AS4 Args*)__builtin_amdgcn_kernarg_segment_ptr(); asm volatile("" : "+s"(kp)); PRef p = kp->p; MY_TID(tid);
#define PH_END_IF(k, cond) } if ((cond) && (k) + 1 < ph_hi) { MY_TID(t1); xcd_barrier(bar, t1 == 0, XB_ST(lds_raw)); } }
#ifndef REP_CVT
#define REP_CVT 0
#endif
#ifndef REP_BAR
#define REP_BAR 0
#endif
#define PH_END(k) } if ((k) + 1 < ph_hi) { for (int rb_ = 0; rb_ < 1 + REP_BAR; ++rb_) { MY_TID(t1); xcd_barrier(bar, t1 == 0, XB_ST(lds_raw)); } } }
    PH_BEGIN(0)
        phase_adaln(tid, p, lds);
        run_items<b_lb>(tid, p, 0, 2L * 384, 0);
        phase_convert(tid, p, 0, lds, 1, 0);
    PH_END(0)
#define LAYER(l)                                                                                                                                     \
    PH_BEGIN(1 + (l) * NPL + 0) if ((l) == 0) { phase_rows<0>(tid, p, 0, lds); } PH_END_IF(1 + (l) * NPL + 0, (l) == 0)                                 \
    PH_BEGIN(1 + (l) * NPL + 1) {                                                                                                                    \
        pg8::Gemm g{p.H, p.WIN_T, NTOK, INC, D, nullptr, 0, 1, 0}; pg8::StaticOrder S; S.init(NTOK, INC, G, (int)blockIdx.x);                         \
        pg8::EpiP E{p.P, INC, p.q_norm + (l) * HD, p.k_norm + (l) * HD, rep_};                                                    \
        pg8::gemm_phase<pg8::EpiP, false>(tid, lds, g, S, E);                                                                                     \
        } PH_END(1 + (l) * NPL + 1)               \
    PH_BEGIN(1 + (l) * NPL + 2) if constexpr (!FUSE_QK) { phase_qkprep(tid, p, l); } if constexpr (FAST_HGRN && (HGRN_DIAG == 3 || HGRN_DIAG == 4)) { phase_hgrn_local(tid, p, l, lds); { MY_TID(t7); run_items<b_hgrn_local_slow>(t7, p, l, 2L * NBH * NCH * 64, 0); } } else if constexpr (FAST_HGRN && HGRN_DIAG >= 2) { run_items<b_hgrn_local_slow>(tid, p, l, 2L * NBH * NCH * 64, 0); } else if constexpr (FAST_HGRN) { for (int r2_ = 0; r2_ < 1 + REP_LOCAL; ++r2_) phase_hgrn_local(tid, p, l, lds); } else { run_items<b_gates>(tid, p, l, (long)NTOK * 768, 0); } phase_conv(tid, p, l); PH_END(1 + (l) * NPL + 2) \
    PH_BEGIN(1 + (l) * NPL + 3) if constexpr (FAST_HGRN && HGRN_DIAG) { run_items<b_hgrn_scan_slow>(tid, p, l, 2L * NBH * 4096, 0); } else if constexpr (FAST_HGRN) { phase_hgrn_scan(tid, p); } else { run_items<b_hgrn_seq2>(tid, p, l, 2L * NB * HGH * 64, 0); } if constexpr (FAST_ATTN) { for (int r4_ = 0; r4_ < 1 + REP_ATTN; ++r4_) { MY_TID(t6); phase_attn(t6, p, l, lds); } } else { run_items<b_attn>(tid, p, l, (long)NTOK * NAH, 0); } PH_END(1 + (l) * NPL + 3) \
    PH_BEGIN(1 + (l) * NPL + 4) if constexpr (FAST_HGRN && HGRN_DIAG) { run_items<b_hgrn_chunkseq>(tid, p, l, 2L * NBH * NCH * 64, 0); { MY_TID(t9); xcd_barrier(bar, t9 == 0, XB_ST(lds_raw)); } { MY_TID(t8); run_items<b_hgfin>(t8, p, l, (long)NTOK * HGH, 0); } } else if constexpr (FAST_HGRN) { phase_hgrn_out(tid, p, l, lds); } else { run_items<b_hgfin>(tid, p, l, (long)NTOK * HGH, 0); } PH_END(1 + (l) * NPL + 4)                                         \
    PH_BEGIN(1 + (l) * NPL + 5) {                                                                                                                    \
        pg8::Gemm g{p.MIX, p.WOUT_T, NLAT, D, MIXD, nullptr, 0, 1, 0}; pg8::StaticOrder S; S.init(NLAT, D, G, (int)blockIdx.x);                       \
        pg8::EpiRes E{p.XL, (l) == 0 ? p.x : p.XL, D, p.MOD + (size_t)(l) * 3 * NMOD + 2 * D, SEQ, (size_t)NMOD};                                                           \
        pg8::gemm_phase<pg8::EpiRes, false>(tid, lds, g, S, E);                                                                                      \
        if ((l) + 1 < DEPTH) { MY_TID(tid2); mini_gemm<1>(tid2, p, l); } } PH_END(1 + (l) * NPL + 5)                  \
    PH_BEGIN(1 + (l) * NPL + 6) phase_rows<1>(tid, p, l, lds); PH_END(1 + (l) * NPL + 6)                                                               \
    PH_BEGIN(1 + (l) * NPL + 7) if constexpr (FAST_TOPK) { phase_topk(tid, p, lds); if ((l) == 0 && gridDim.x > 2 * NB * NE + 32) { MY_TID(t4); phase_convert(t4, p, 0, lds, 2, 2 * NB * NE); } else if ((l) == 0) { MY_TID(t4); phase_convert(t4, p, 0, lds, 2, 0); } } else { run_items<b_rank>(tid, p, l, (long)NTOK * NE, 0); } PH_END(1 + (l) * NPL + 7)                                          \
    PH_BEGIN(1 + (l) * NPL + 8) {                                                                                                                    \
        pg8::Gemm g{p.H, p.WGU_T, NSLOT_L, 2 * ED, D, p.STOK, CAPL / 256, NE, (size_t)2 * ED * D * 2}; pg8::StaticOrder S; S.init(NSLOT_L, 2 * ED, G, (int)blockIdx.x); \
        pg8::EpiHid E{p.HID, ED};                                                                                                                    \
        pg8::gemm_phase<pg8::EpiHid, true>(tid, lds, g, S, E);                                                                                       \
        if ((l) + 1 < DEPTH) { MY_TID(tid2); mini_gemm<2>(tid2, p, l); } } PH_END(1 + (l) * NPL + 8)              \
    PH_BEGIN(1 + (l) * NPL + 9) {                                                                                                                    \
        pg8::Gemm g{p.HID, p.WD_T, NSLOT_L, D, ED, nullptr, CAPL / 256, NE, (size_t)D * ED * 2}; pg8::StaticOrder S; S.init(NSLOT_L, D, G, (int)blockIdx.x); \
        pg8::EpiBf16 E{p.Y, D, p.SVAL, 0};                                                                                                              \
        pg8::gemm_phase<pg8::EpiBf16, false>(tid, lds, g, S, E);                                                                                     \
        if ((l) + 1 < DEPTH) { MY_TID(tid2); mini_gemm<3>(tid2, p, l); } } PH_END(1 + (l) * NPL + 9)                \
    PH_BEGIN(1 + (l) * NPL + 10) phase_rows<2>(tid, p, l, lds); if ((l) + 1 < DEPTH) { for (int rc_ = 0; rc_ < 1 + REP_CVT; ++rc_) { MY_TID(t5); phase_convert(t5, p, (l) + 1, lds); } } PH_END(1 + (l) * NPL + 10)
#ifndef NLAYERS_BUILD
#define NLAYERS_BUILD DEPTH
#endif
    LAYER(0)
    if constexpr (NLAYERS_BUILD > 1) { LAYER(1) }
    if constexpr (NLAYERS_BUILD > 2) { LAYER(2) }
    if constexpr (NLAYERS_BUILD > 3) { LAYER(3) }
}

#ifndef MK_SPLIT
#define MK_SPLIT 0
#endif
extern "C" void kernel_launch(void* const* d_in, const int* in_sizes, int n_in, void* d_out, int out_size, void* d_ws, size_t ws_size,
                              hipStream_t stream) {
    static int grid = 0;
    if (grid == 0) {
        if (n_in != 20 || out_size != NLAT * D || ws_size < WS_END) { fprintf(stderr, "kernel_launch: unexpected problem (n_in %d out %d ws %zu need %zu)\n", n_in, out_size, ws_size, (size_t)WS_END); grid = -1; return; }
        int dev = 0, cus = 0;
        if (hipGetDevice(&dev) != hipSuccess || hipDeviceGetAttribute(&cus, hipDeviceAttributeMultiprocessorCount, dev) != hipSuccess) { grid = -1; return; }
        if (hipFuncSetAttribute((const void*)mega_fwd, hipFuncAttributeMaxDynamicSharedMemorySize, LDS_BYTES) != hipSuccess) { fprintf(stderr, "kernel_launch: hipFuncSetAttribute failed\n"); grid = -1; return; }
        int per_cu = 0;
        if (hipOccupancyMaxActiveBlocksPerMultiprocessor(&per_cu, (const void*)mega_fwd, NTHR, LDS_BYTES) != hipSuccess || per_cu < 1) { fprintf(stderr, "kernel_launch: occupancy query says %d\n", per_cu); }
        (void)hipGetLastError();
        grid = cus;
    }
    if (grid < 0) return;
    (void)hipMemsetAsync((char*)d_ws + WS_CTL, 0, WS_LB - WS_CTL, stream);
    Args a{};
    a.p = make_params(d_in, d_out, d_ws);
#if MK_SPLIT
    for (int ph = 0; ph < NPH; ++ph) { a.ph_lo = ph; a.ph_hi = ph + 1; hipLaunchKernelGGL(mega_fwd, dim3(grid), dim3(NTHR), LDS_BYTES, stream, a); }
#else
    a.ph_lo = 0; a.ph_hi = NPH;
    hipLaunchKernelGGL(mega_fwd, dim3(grid), dim3(NTHR), LDS_BYTES, stream, a);
#endif
}
#endif
```

```cpp
#ifndef CPU_SIM
#include <hip/hip_runtime.h>
#define BODY __device__ __forceinline__
#define FSIN(x) __sinf(x)
#define FCOS(x) __cosf(x)
#else
#include <cmath>
#include <cstdio>
#include <cstdlib>
#include <cstring>
#define BODY static inline
#define FSIN(x) sinf(x)
#define FCOS(x) cosf(x)
#endif
#include <stdint.h>
#include <stddef.h>

#ifndef CFG_D
#define CFG_D 1024
#define CFG_SEQ 16384
#define CFG_CTX 256
#define CFG_EDIM 512
#define CFG_DEPTH 4
#endif

typedef unsigned short bf16_t;

constexpr int D = CFG_D, NB = 2, SEQ = CFG_SEQ, DEPTH = CFG_DEPTH, GW = 64, ROWS = SEQ / GW, CTX = CFG_CTX;
constexpr int HD = 64, NAH = 6, HGH = 6, CVD = 256, MIXD = 1024, INC = 3840, NMOD = 6 * D;
constexpr int NE = 16, ED = CFG_EDIM, CAPL = 2 * SEQ / NE, CAPC = 2 * CTX / NE;
constexpr int NLAT = NB * SEQ, NCTX = NB * CTX, NTOK = NLAT + NCTX;
constexpr int NSLOT_L = NB * NE * CAPL, NSLOT_C = NB * NE * CAPC, NSLOT = NSLOT_L + NSLOT_C;
constexpr int OQ = 0, OK_ = 384, OV = 768, OHQ = 1152, OFF_ = 1536, OFB = 1920, OHI = 2304, OHG_ = 2688, OCB = 3072, OCC = 3328, OCU = 3584;
constexpr float EPS = 1e-6f;
constexpr int NCH = (CTX + SEQ) / 64, NCHC = CTX / 64, NBH = NB * HGH;

struct Params {
    const float *x, *c, *ctx, *c_ctx, *w_mod, *b_mod, *norm1_w, *w_in, *q_norm, *k_norm, *rpb, *lb_logits, *hg_norm, *conv_w, *w_out,
        *norm2_w, *w_router, *w_gate, *w_up, *w_down;
    float *XL, *XC, *MOD, *LB, *AFF, *SVAL, *FG, *OHG;
    bf16_t *H, *P, *MIX, *HID, *Y;
    int *STOK, *INV;
    bf16_t *WIN_T, *WOUT_T, *WGU_T, *WD_T;
    unsigned* CTL;
    bf16_t* SLOC;
    float* GDEC;
    bf16_t* XB;
};

#ifndef CPU_SIM
#define AS4 __attribute__((address_space(4)))
typedef const AS4 Params& PRef;
#else
typedef const Params& PRef;
#endif
BODY float bf2f(bf16_t v) { return __builtin_bit_cast(float, (unsigned)v << 16); }
BODY bf16_t f2bf(float f) { unsigned u = __builtin_bit_cast(unsigned, f); u += 0x7fffu + ((u >> 16) & 1u); return (bf16_t)(u >> 16); }
BODY float silu_f(float x) { return x / (1.f + expf(-x)); }
BODY float sigmoid_f(float x) { return 1.f / (1.f + expf(-x)); }
BODY int modset(int r) { return r < NLAT ? r / SEQ : 2; }
BODY float* xrow(PRef p, int r) { return r < NLAT ? p.XL + (size_t)r * D : p.XC + (size_t)(r - NLAT) * D; }

BODY void b_adaln(long gid, PRef p, int) {
    const int n = (int)(gid % NMOD), s = (int)((gid / NMOD) % 3), l = (int)(gid / (3 * NMOD));
    const float* cv = s < 2 ? p.c + s * D : p.c_ctx;
    const float* w = p.w_mod + (size_t)l * D * NMOD + n;
    float acc = 0.f;
    for (int k = 0; k < D; ++k) acc += silu_f(cv[k]) * w[(size_t)k * NMOD];
    p.MOD[gid] = acc + p.b_mod[l * NMOD + n];
}
BODY void b_lb(long gid, PRef p, int) {
    const int dir = (int)(gid / 384), j = (int)(gid % 384);
    const float* lg = p.lb_logits + (size_t)dir * DEPTH * 384 + j;
    float m = -INFINITY;
    for (int l = 0; l < DEPTH; ++l) m = fmaxf(m, lg[l * 384]);
    float s = 0.f;
    for (int l = 0; l < DEPTH; ++l) s += expf(lg[l * 384] - m);
    float cum = 0.f;
    p.LB[(dir * DEPTH + 0) * 384 + j] = 0.f;
    for (int l = 1; l < DEPTH; ++l) { cum += expf(lg[l * 384] - m) / s; p.LB[(dir * DEPTH + l) * 384 + j] = cum; }
}
BODY void b_copyx(long gid, PRef p, int) {
    if (gid < (long)NLAT * D) p.XL[gid] = p.x[gid]; else p.XC[gid - (long)NLAT * D] = p.ctx[gid - (long)NLAT * D];
}
template <int WHICH> BODY void b_prenorm(long gid, PRef p, int l) {
    const int r = (int)gid;
    const float* xr = xrow(p, r);
    const float* nw = (WHICH ? p.norm2_w : p.norm1_w) + l * D;
    const float* mod = p.MOD + ((size_t)l * 3 + modset(r)) * NMOD;
    const float* shift = mod + (WHICH ? 3 : 0) * D;
    const float* scale = mod + (WHICH ? 4 : 1) * D;
    float ss = 0.f;
    for (int k = 0; k < D; ++k) ss += xr[k] * xr[k];
    const float rstd = 1.f / sqrtf(ss / D + EPS);
    float lg[NE];
#pragma unroll
    for (int e = 0; e < NE; ++e) lg[e] = 0.f;
    for (int k = 0; k < D; ++k) {
        const float h = xr[k] * rstd * nw[k] * (1.f + scale[k]) + shift[k];
        p.H[(size_t)r * D + k] = f2bf(h);
        if (WHICH) {
            const float* wr = p.w_router + ((size_t)l * D + k) * NE;
#pragma unroll
            for (int e = 0; e < NE; ++e) lg[e] += h * wr[e];
        }
    }
    if (WHICH) {
        float m = lg[0];
#pragma unroll
        for (int e = 1; e < NE; ++e) m = fmaxf(m, lg[e]);
        float s = 0.f;
#pragma unroll
        for (int e = 0; e < NE; ++e) { lg[e] = expf(lg[e] - m); s += lg[e]; }
#pragma unroll
        for (int e = 0; e < NE; ++e) p.AFF[(size_t)r * NE + e] = lg[e] / s;
    }
}
BODY void b_gemm_in(long gid, PRef p, int l) {
    const int r = (int)(gid / (INC / 4)), n = (int)(gid % (INC / 4)) * 4;
    const bf16_t* a = p.H + (size_t)r * D;
    const float* w = p.w_in + (size_t)l * D * INC + n;
    float a0 = 0.f, a1 = 0.f, a2 = 0.f, a3 = 0.f;
    for (int k = 0; k < D; ++k) { const float av = bf2f(a[k]); const float* wk = w + (size_t)k * INC; a0 += av * wk[0]; a1 += av * wk[1]; a2 += av * wk[2]; a3 += av * wk[3]; }
    bf16_t* o = p.P + (size_t)r * INC + n;
    o[0] = f2bf(a0); o[1] = f2bf(a1); o[2] = f2bf(a2); o[3] = f2bf(a3);
}
BODY void b_qkprep(long gid, PRef p, int l) {
    const int r = (int)(gid / 12), which = (int)(gid % 12) / 6, head = (int)(gid % 6);
    bf16_t* ptr = p.P + (size_t)r * INC + (which ? OK_ : OQ) + head * HD;
    const float* nw = (which ? p.k_norm : p.q_norm) + l * HD;
    float y[HD];
    float ss = 0.f;
#pragma unroll
    for (int d = 0; d < HD; ++d) { y[d] = bf2f(ptr[d]); ss += y[d] * y[d]; }
    const float rstd = 1.f / sqrtf(ss / HD + EPS);
#pragma unroll
    for (int d = 0; d < HD; ++d) y[d] = y[d] * rstd * nw[d];
    if (r < NLAT) {
        const int t = r % SEQ; const float row = (float)(t / GW), col = (float)(t % GW);
#pragma unroll
        for (int d = 0; d < 16; ++d) {
            const float inv = powf(10000.f, -(float)d / 16.f);
            const float ar = row * inv, ac = col * inv;
            const float cr = FCOS(ar), sr = FSIN(ar), cc = FCOS(ac), sc = FSIN(ac);
            const float x0 = y[d], x1 = y[d + 16], x2 = y[d + 32], x3 = y[d + 48];
            y[d] = x0 * cr - x1 * sr; y[d + 16] = x1 * cr + x0 * sr; y[d + 32] = x2 * cc - x3 * sc; y[d + 48] = x3 * cc + x2 * sc;
        }
    }
#pragma unroll
    for (int d = 0; d < HD; ++d) ptr[d] = f2bf(y[d]);
}
BODY void b_attn(long gid, PRef p, int l) {
    const int r = (int)(gid / NAH), head = (int)(gid % NAH);
    float q[HD], acc[HD];
    const bf16_t* qp = p.P + (size_t)r * INC + OQ + head * HD;
#pragma unroll
    for (int d = 0; d < HD; ++d) { q[d] = bf2f(qp[d]) * 0.125f; acc[d] = 0.f; }
    float m = -INFINITY, s = 0.f;
    const int b = r < NLAT ? r / SEQ : (r - NLAT) / CTX;
    const int nloc = r < NLAT ? 128 : 0;
    int row = 0, col = 0, rs = 0, ws = 0;
    if (r < NLAT) { const int t = r % SEQ; row = t / GW; col = t % GW; rs = row - 4; rs = rs < 0 ? 0 : (rs > ROWS - 8 ? ROWS - 8 : rs); ws = col - 8; ws = ws < 0 ? 0 : (ws > GW - 16 ? GW - 16 : ws); }
    for (int j = 0; j < nloc + CTX; ++j) {
        int kr; float bias = 0.f;
        if (j < nloc) { const int i = j / 16, jj = j % 16; kr = b * SEQ + (rs + i) * GW + ws + jj; bias = p.rpb[(((size_t)l * NAH + head) * 15 + (rs + i - row + 7)) * 31 + (ws + jj - col + 15)]; }
        else kr = NLAT + b * CTX + (j - nloc);
        const bf16_t* kp = p.P + (size_t)kr * INC + OK_ + head * HD;
        const bf16_t* vp = p.P + (size_t)kr * INC + OV + head * HD;
        float sc = 0.f;
#pragma unroll
        for (int d = 0; d < HD; ++d) sc += q[d] * bf2f(kp[d]);
        sc += bias;
        const float mn = fmaxf(m, sc), corr = expf(m - mn), pj = expf(sc - mn);
        s = s * corr + pj;
#pragma unroll
        for (int d = 0; d < HD; ++d) acc[d] = acc[d] * corr + pj * bf2f(vp[d]);
        m = mn;
    }
    const float inv = 1.f / s;
    bf16_t* o = p.MIX + (size_t)r * MIXD + head * HD;
#pragma unroll
    for (int d = 0; d < HD; ++d) o[d] = f2bf(acc[d] * inv);
}
BODY void b_gates(long gid, PRef p, int l) {
    const int j = (int)(gid % 384), dir = (int)((gid / 384) % 2), r = (int)(gid / 768);
    const float z = bf2f(p.P[(size_t)r * INC + (dir ? OFB : OFF_) + j]);
    const float lbv = p.LB[(dir * DEPTH + l) * 384 + j];
    p.FG[gid] = lbv + (1.f - lbv) * sigmoid_f(z);
}
template <int DIR> BODY void b_hgrn_seq(long gid, PRef p, int) {
    const int v = (int)(gid % 64), h = (int)((gid / 64) % HGH), b = (int)(gid / (64 * HGH));
    float S[64];
#pragma unroll
    for (int k = 0; k < 64; ++k) S[k] = 0.f;
    for (int step = 0; step < CTX + SEQ; ++step) {
        int r;
        if (step < CTX) r = NLAT + b * CTX + (DIR ? CTX - 1 - step : step);
        else r = b * SEQ + (DIR ? SEQ - 1 - (step - CTX) : (step - CTX));
        const float vv = bf2f(p.P[(size_t)r * INC + OHI + h * 64 + v]);
        const float* fr = p.FG + ((size_t)r * 2 + DIR) * 384 + h * 64;
        const bf16_t* qr = p.P + (size_t)r * INC + OHQ + h * 64;
        float o = 0.f;
#pragma unroll
        for (int k = 0; k < 64; ++k) { const float f = fr[k]; S[k] = f * S[k] + (1.f - f) * vv; o += S[k] * bf2f(qr[k]); }
        o *= 0.125f;
        p.OHG[((size_t)DIR * NTOK + r) * 384 + h * 64 + v] = o;
    }
}
BODY void b_hgfin(long gid, PRef p, int l) {
    const int r = (int)(gid / HGH), h = (int)(gid % HGH);
    const float* op = p.OHG + (size_t)r * 384 + h * 64;
    const float* op1 = op + (size_t)NTOK * 384;
    float o[64]; float ss = 0.f;
#pragma unroll
    for (int v = 0; v < 64; ++v) { o[v] = op[v] + op1[v]; ss += o[v] * o[v]; }
    const float rstd = 1.f / sqrtf(ss / 64.f + EPS);
    const bf16_t* g = p.P + (size_t)r * INC + OHG_ + h * 64;
    bf16_t* out = p.MIX + (size_t)r * MIXD + 384 + h * 64;
#pragma unroll
    for (int v = 0; v < 64; ++v) out[v] = f2bf(o[v] * rstd * p.hg_norm[l * 64 + v] * silu_f(bf2f(g[v])));
}
BODY void b_conv(long gid, PRef p, int l) {
    const int ch = (int)(gid % CVD), r = (int)(gid / CVD);
    int t, T;
    if (r < NLAT) { t = r % SEQ; T = SEQ; } else { t = (r - NLAT) % CTX; T = CTX; }
    const float* w = p.conv_w + (size_t)l * 3 * CVD + ch;
    float y = 0.f;
    for (int j = 0; j < 3; ++j) {
        const int tt = t + j - 1;
        if (tt < 0 || tt >= T) continue;
        const bf16_t* pr = p.P + (size_t)(r + j - 1) * INC;
        y += w[j * CVD] * bf2f(pr[OCC + ch]) * bf2f(pr[OCU + ch]);
    }
    p.MIX[(size_t)r * MIXD + 768 + ch] = f2bf(bf2f(p.P[(size_t)r * INC + OCB + ch]) * y);
}
BODY void b_gemm_out(long gid, PRef p, int l) {
    const int r = (int)(gid / (D / 4)), n = (int)(gid % (D / 4)) * 4;
    const bf16_t* a = p.MIX + (size_t)r * MIXD;
    const float* w = p.w_out + (size_t)l * MIXD * D + n;
    float a0 = 0.f, a1 = 0.f, a2 = 0.f, a3 = 0.f;
    for (int k = 0; k < MIXD; ++k) { const float av = bf2f(a[k]); const float* wk = w + (size_t)k * D; a0 += av * wk[0]; a1 += av * wk[1]; a2 += av * wk[2]; a3 += av * wk[3]; }
    const float* g = p.MOD + ((size_t)l * 3 + modset(r)) * NMOD + 2 * D + n;
    float* xr = xrow(p, r) + n;
    xr[0] += g[0] * a0; xr[1] += g[1] * a1; xr[2] += g[2] * a2; xr[3] += g[3] * a3;
}
BODY void b_rank(long gid, PRef p, int) {
    const int e = (int)(gid % NE), r = (int)(gid / NE);
    int t, T, row0, cap, base;
    if (r < NLAT) { const int b = r / SEQ; t = r % SEQ; T = SEQ; row0 = b * SEQ; cap = CAPL; base = (b * NE + e) * CAPL; }
    else { const int b = (r - NLAT) / CTX; t = (r - NLAT) % CTX; T = CTX; row0 = NLAT + b * CTX; cap = CAPC; base = NSLOT_L + (b * NE + e) * CAPC; }
    const float a = p.AFF[(size_t)r * NE + e];
    const float* col = p.AFF + (size_t)row0 * NE + e;
    int rank = 0;
    for (int tt = 0; tt < T; ++tt) { const float o = col[(size_t)tt * NE]; rank += (o > a || (o == a && tt < t)) ? 1 : 0; }
    if (rank < cap) { p.STOK[base + rank] = r; p.SVAL[base + rank] = a; p.INV[(size_t)r * NE + e] = base + rank; }
    else p.INV[(size_t)r * NE + e] = -1;
}
BODY int slot_expert(int s) { return s < NSLOT_L ? (s / CAPL) % NE : ((s - NSLOT_L) / CAPC) % NE; }
BODY void b_moe1(long gid, PRef p, int l) {
    const int s = (int)(gid / (ED / 4)), f = (int)(gid % (ED / 4)) * 4;
    const int e = slot_expert(s); int row = p.STOK[s]; row = row < 0 ? 0 : (row >= NTOK ? NTOK - 1 : row);
    const bf16_t* a = p.H + (size_t)row * D;
    const float* wg = p.w_gate + ((size_t)l * NE + e) * D * ED + f;
    const float* wu = p.w_up + ((size_t)l * NE + e) * D * ED + f;
    float g0 = 0.f, g1 = 0.f, g2 = 0.f, g3 = 0.f, u0 = 0.f, u1 = 0.f, u2 = 0.f, u3 = 0.f;
    for (int k = 0; k < D; ++k) {
        const float av = bf2f(a[k]); const float* gk = wg + (size_t)k * ED; const float* uk = wu + (size_t)k * ED;
        g0 += av * gk[0]; g1 += av * gk[1]; g2 += av * gk[2]; g3 += av * gk[3];
        u0 += av * uk[0]; u1 += av * uk[1]; u2 += av * uk[2]; u3 += av * uk[3];
    }
    bf16_t* o = p.HID + (size_t)s * ED + f;
    o[0] = f2bf(silu_f(g0) * u0); o[1] = f2bf(silu_f(g1) * u1); o[2] = f2bf(silu_f(g2) * u2); o[3] = f2bf(silu_f(g3) * u3);
}
BODY void b_moe2(long gid, PRef p, int l) {
    const int s = (int)(gid / (D / 4)), n = (int)(gid % (D / 4)) * 4;
    const int e = slot_expert(s);
    const bf16_t* a = p.HID + (size_t)s * ED;
    const float* w = p.w_down + ((size_t)l * NE + e) * ED * D + n;
    float a0 = 0.f, a1 = 0.f, a2 = 0.f, a3 = 0.f;
    for (int k = 0; k < ED; ++k) { const float av = bf2f(a[k]); const float* wk = w + (size_t)k * D; a0 += av * wk[0]; a1 += av * wk[1]; a2 += av * wk[2]; a3 += av * wk[3]; }
    const float val = p.SVAL[s];
    bf16_t* o = p.Y + (size_t)s * D + n;
    o[0] = f2bf(val * a0); o[1] = f2bf(val * a1); o[2] = f2bf(val * a2); o[3] = f2bf(val * a3);
}
BODY void b_combine(long gid, PRef p, int l) {
    const int r = (int)(gid / (D / 4)), n = (int)(gid % (D / 4)) * 4;
    float a0 = 0.f, a1 = 0.f, a2 = 0.f, a3 = 0.f;
    for (int e = 0; e < NE; ++e) {
        const int s = p.INV[(size_t)r * NE + e];
        if (s >= 0) { const bf16_t* y = p.Y + (size_t)s * D + n; a0 += bf2f(y[0]); a1 += bf2f(y[1]); a2 += bf2f(y[2]); a3 += bf2f(y[3]); }
    }
    const float* g = p.MOD + ((size_t)l * 3 + modset(r)) * NMOD + 5 * D + n;
    float* xr = xrow(p, r) + n;
    xr[0] += g[0] * a0; xr[1] += g[1] * a1; xr[2] += g[2] * a2; xr[3] += g[3] * a3;
}


#ifndef HGRN_DIAG
#define HGRN_DIAG 0
#endif
BODY void b_hgrn_chunkseq(long gid, PRef p, int l) {
    const int v = (int)(gid % 64), pc = (int)((gid / 64) % NCH), bh = (int)((gid / (64 * NCH)) % NBH), dir = (int)(gid / (64L * NCH * NBH));
    const int h = bh % HGH, b = bh / HGH, row0 = pc < NCHC ? NLAT + b * CTX + pc * 64 : b * SEQ + (pc - NCHC) * 64;
    const bf16_t* sin = p.SLOC + ((size_t)(dir * NBH + bh) * NCH + pc) * 4096 + v * 64;
    float S[64];
#pragma unroll
    for (int k = 0; k < 64; ++k) S[k] = bf2f(sin[k]);
    for (int i = 0; i < 64; ++i) {
        const int r = row0 + (dir ? 63 - i : i);
        const float vv = bf2f(p.P[(size_t)r * INC + OHI + h * 64 + v]);
        const bf16_t* zr = p.P + (size_t)r * INC + (dir ? OFB : OFF_) + h * 64;
        const bf16_t* qr = p.P + (size_t)r * INC + OHQ + h * 64;
        const float* lb = p.LB + (size_t)(dir * DEPTH + l) * 384 + h * 64;
        float o = 0.f;
#pragma unroll
        for (int k = 0; k < 64; ++k) { const float f = lb[k] + (1.f - lb[k]) * sigmoid_f(bf2f(zr[k])); S[k] = f * S[k] + (1.f - f) * vv; o += S[k] * bf2f(qr[k]); }
        p.OHG[((size_t)dir * NTOK + r) * 384 + h * 64 + v] = o * 0.125f;
    }
}

BODY void b_hgrn_scan_slow(long gid, PRef p, int) {
    const int e = (int)(gid % 4096), sq = (int)(gid / 4096), dir = sq / NBH, k = e & 63;
    bf16_t* S = p.SLOC + (size_t)sq * NCH * 4096 + e;
    const float* G = p.GDEC + (size_t)sq * NCH * 64 + k;
    float c = 0.f;
    for (int j = 0; j < NCH; ++j) {
        const int pc = dir ? (j < NCHC ? NCHC - 1 - j : NCH + NCHC - 1 - j) : j;
        const float x = bf2f(S[(size_t)pc * 4096]);
        S[(size_t)pc * 4096] = f2bf(c);
        c = G[(size_t)pc * 64] * c + x;
    }
}

BODY void b_hgrn_local_slow(long gid, PRef p, int l) {
    const int v = (int)(gid % 64), pc = (int)((gid / 64) % NCH), bh = (int)((gid / (64 * NCH)) % NBH), dir = (int)(gid / (64L * NCH * NBH));
    const int h = bh % HGH, b = bh / HGH, row0 = pc < NCHC ? NLAT + b * CTX + pc * 64 : b * SEQ + (pc - NCHC) * 64;
    float S[64], g[64];
#pragma unroll
    for (int k = 0; k < 64; ++k) { S[k] = 0.f; g[k] = 1.f; }
    for (int i = 0; i < 64; ++i) {
        const int r = row0 + (dir ? 63 - i : i);
        const float vv = bf2f(p.P[(size_t)r * INC + OHI + h * 64 + v]);
        const bf16_t* zr = p.P + (size_t)r * INC + (dir ? OFB : OFF_) + h * 64;
        const float* lb = p.LB + (size_t)(dir * DEPTH + l) * 384 + h * 64;
#pragma unroll
        for (int k = 0; k < 64; ++k) { const float f = lb[k] + (1.f - lb[k]) * sigmoid_f(bf2f(zr[k])); S[k] = f * S[k] + (1.f - f) * vv; g[k] *= f; }
    }
    bf16_t* dst = p.SLOC + ((size_t)(dir * NBH + bh) * NCH + pc) * 4096 + v * 64;
    if (HGRN_DIAG != 3 && HGRN_DIAG != 4) {
#pragma unroll
    for (int k = 0; k < 64; ++k) dst[k] = f2bf(S[k]);
    }
    if (v == 0) {
        float* gd = p.GDEC + ((size_t)(dir * NBH + bh) * NCH + pc) * 64;
#pragma unroll
        for (int k = 0; k < 64; ++k) gd[k] = g[k];
    }
}
#ifndef FAST_TOPK
#define FAST_TOPK 1
#endif
#ifndef FAST_HGRN
#define FAST_HGRN 1
#endif
#ifndef FAST_ATTN
#define FAST_ATTN 1
#endif
constexpr size_t al256(size_t x) { return (x + 255) & ~(size_t)255; }
constexpr size_t CTL_BYTES = 65536;
constexpr size_t WS_CTL = 0;
constexpr size_t WS_MOD = WS_CTL + CTL_BYTES;
constexpr size_t WS_LB = WS_MOD + al256((size_t)DEPTH * 3 * NMOD * 4);
constexpr size_t WS_XC = WS_LB + al256((size_t)2 * DEPTH * 384 * 4);
constexpr size_t WS_AFF = WS_XC + al256((size_t)NCTX * D * 4);
constexpr size_t WS_SVAL = WS_AFF + al256((size_t)NTOK * NE * 4);
constexpr size_t WS_STOK = WS_SVAL + al256((size_t)NSLOT * 4);
constexpr size_t WS_INV = WS_STOK + al256((size_t)NSLOT * 4);
constexpr size_t WS_H = WS_INV + al256((size_t)NTOK * NE * 4);
constexpr size_t WS_MIX = WS_H + al256((size_t)NTOK * D * 2);
constexpr size_t WS_P = WS_MIX + al256((size_t)NTOK * MIXD * 2);
constexpr size_t WS_HID = WS_P;
constexpr size_t WS_Y = WS_HID + al256((size_t)NSLOT * ED * 2);
constexpr size_t WS_P_END0 = WS_P + al256((size_t)NTOK * INC * 2);
constexpr size_t WS_P_END1 = WS_Y + al256((size_t)NSLOT * D * 2);
constexpr size_t WS_WB = WS_P_END0 > WS_P_END1 ? WS_P_END0 : WS_P_END1;
constexpr size_t WS_WIN_T = WS_WB;
constexpr size_t WS_WOUT_T = WS_WIN_T + al256((size_t)INC * D * 2);
constexpr size_t WS_WGU_T = WS_WOUT_T + al256((size_t)D * MIXD * 2);
constexpr size_t WS_WD_T = WS_WGU_T + al256((size_t)NE * 2 * ED * D * 2);
constexpr size_t WS_T = WS_WD_T + al256((size_t)NE * D * ED * 2);
#if FAST_HGRN
constexpr size_t WS_SLOC = WS_T;
constexpr size_t WS_GDEC = WS_SLOC + al256((size_t)2 * NBH * NCH * 4096 * 2);
constexpr size_t WS_OHG = WS_GDEC + al256((size_t)2 * NBH * NCH * 64 * 4);
constexpr size_t WS_XB = WS_OHG + (HGRN_DIAG ? al256((size_t)2 * NTOK * 384 * 4) : 0);
constexpr size_t WS_END = WS_XB + al256((size_t)NLAT * D * 2);
constexpr size_t WS_FG = WS_T;
#else
constexpr size_t WS_FG = WS_T;
constexpr size_t WS_OHG = WS_FG + al256((size_t)NTOK * 768 * 4);
constexpr size_t WS_SLOC = WS_OHG + al256((size_t)2 * NTOK * 384 * 4);
constexpr size_t WS_GDEC = WS_SLOC;
constexpr size_t WS_XB = WS_SLOC;
constexpr size_t WS_END = WS_XB + al256((size_t)NLAT * D * 2);
#endif

static inline Params make_params(void* const* d_in, void* d_out, void* d_ws) {
    Params p{};
    const float** f = (const float**)&p;
    for (int i = 0; i < 20; ++i) f[i] = (const float*)d_in[i];
    char* ws = (char*)d_ws;
    p.XL = (float*)d_out; p.XC = (float*)(ws + WS_XC); p.MOD = (float*)(ws + WS_MOD); p.LB = (float*)(ws + WS_LB); p.AFF = (float*)(ws + WS_AFF);
    p.SVAL = (float*)(ws + WS_SVAL); p.FG = (float*)(ws + WS_FG); p.OHG = (float*)(ws + WS_OHG);
    p.H = (bf16_t*)(ws + WS_H); p.P = (bf16_t*)(ws + WS_P); p.MIX = (bf16_t*)(ws + WS_MIX); p.HID = (bf16_t*)(ws + WS_HID); p.Y = (bf16_t*)(ws + WS_Y);
    p.STOK = (int*)(ws + WS_STOK); p.INV = (int*)(ws + WS_INV);
    p.WIN_T = (bf16_t*)(ws + WS_WIN_T); p.WOUT_T = (bf16_t*)(ws + WS_WOUT_T); p.WGU_T = (bf16_t*)(ws + WS_WGU_T); p.WD_T = (bf16_t*)(ws + WS_WD_T);
    p.CTL = (unsigned*)(ws + WS_CTL); p.SLOC = (bf16_t*)(ws + WS_SLOC); p.GDEC = (float*)(ws + WS_GDEC); p.XB = (bf16_t*)(ws + WS_XB);
    return p;
}

#define FORWARD_STAGES(STAGE)                                                      \
    STAGE(b_adaln, (long)DEPTH * 3 * NMOD, 0)                                      \
    STAGE(b_lb, 2L * 384, 0)                                                       \
    STAGE(b_copyx, (long)NTOK * D, 0)                                              \
    for (int l = 0; l < DEPTH; ++l) {                                              \
        STAGE(b_prenorm<0>, (long)NTOK, l)                                         \
        STAGE(b_gemm_in, (long)NTOK * (INC / 4), l)                                \
        STAGE(b_qkprep, (long)NTOK * 12, l)                                        \
        STAGE(b_attn, (long)NTOK * NAH, l)                                         \
        STAGE(b_gates, (long)NTOK * 768, l)                                        \
        STAGE(b_hgrn_seq<0>, (long)NB * HGH * 64, l)                               \
        STAGE(b_hgrn_seq<1>, (long)NB * HGH * 64, l)                               \
        STAGE(b_hgfin, (long)NTOK * HGH, l)                                        \
        STAGE(b_conv, (long)NTOK * CVD, l)                                         \
        STAGE(b_gemm_out, (long)NTOK * (D / 4), l)                                 \
        STAGE(b_prenorm<1>, (long)NTOK, l)                                         \
        STAGE(b_rank, (long)NTOK * NE, l)                                          \
        STAGE(b_moe1, (long)NSLOT * (ED / 4), l)                                   \
        STAGE(b_moe2, (long)NSLOT * (D / 4), l)                                    \
        STAGE(b_combine, (long)NTOK * (D / 4), l)                                  \
    }

#ifndef CPU_SIM
#include <cstdio>
#define LAS __attribute__((address_space(3)))
#define GAS __attribute__((address_space(1)))
typedef short bf16x8 __attribute__((ext_vector_type(8)));
typedef float f32x4 __attribute__((ext_vector_type(4)));
typedef float f32x2 __attribute__((ext_vector_type(2)));
typedef unsigned u32x4 __attribute__((ext_vector_type(4)));
typedef unsigned u32x2 __attribute__((ext_vector_type(2)));
constexpr int NWAVES = 8, NTHR = 512;
constexpr int RING_BYTES = 131072, LDSCTL_OFF = RING_BYTES, MISC_OFF = LDSCTL_OFF + 320, TAB_OFF = LDSCTL_OFF + 1024  , LDS_BYTES = 147456;

typedef __bf16 bf16v2_t __attribute__((ext_vector_type(2)));
__device__ __forceinline__ unsigned cvt_pk_bf16_asm(float lo, float hi) { unsigned r; asm volatile("v_cvt_pk_bf16_f32 %0, %1, %2" : "=v"(r) : "v"(lo), "v"(hi)); return r; }
__device__ __forceinline__ unsigned cvt_pk_bf16(float lo, float hi) { bf16v2_t v = {(__bf16)lo, (__bf16)hi}; return __builtin_bit_cast(unsigned, v); }
__device__ __forceinline__ float wave_sum(float v, int lane) {
    v += __builtin_bit_cast(float, __builtin_amdgcn_ds_swizzle(__builtin_bit_cast(int, v), (1 << 10) | 0x1f));
    v += __builtin_bit_cast(float, __builtin_amdgcn_ds_swizzle(__builtin_bit_cast(int, v), (2 << 10) | 0x1f));
    v += __builtin_bit_cast(float, __builtin_amdgcn_ds_swizzle(__builtin_bit_cast(int, v), (4 << 10) | 0x1f));
    v += __builtin_bit_cast(float, __builtin_amdgcn_ds_swizzle(__builtin_bit_cast(int, v), (8 << 10) | 0x1f));
    v += __builtin_bit_cast(float, __builtin_amdgcn_ds_swizzle(__builtin_bit_cast(int, v), (16 << 10) | 0x1f));
    v += __builtin_bit_cast(float, __builtin_amdgcn_ds_bpermute((lane ^ 32) << 2, __builtin_bit_cast(int, v)));
    return v;
}

extern __shared__ __attribute__((aligned(16))) unsigned char lds_raw[];
#ifndef FUSE_QK
#define FUSE_QK 1
#endif
__device__ __forceinline__ float bfw(unsigned w, int hi) { return __builtin_bit_cast(float, hi ? (w & 0xffff0000u) : (w << 16)); }
__device__ __forceinline__ float bf8(const u32x4& v, int j) { return bfw(v[j >> 1], j & 1); }
namespace pg8 {
constexpr int BM = 256, BK = 64, HALF = 128, HTB = HALF * BK * 2, STAGE_BYTES = 8 * HTB, NXCD = 8, WGM = 8;
__device__ __forceinline__ int lds_byte(int r, int c) { const int st = (r >> 4) * 2 + (c >> 5), rr = r & 15, cc = c & 31, ob = rr * 64 + cc * 2; return st * 1024 + (ob ^ (((ob >> 9) & 1) << 5)); }
__device__ __forceinline__ void stage_rc(int b, int& R, int& C) { const int st = b / 1024, sb = b % 1024, swz = sb ^ (((sb >> 9) & 1) << 5); R = (st >> 1) * 16 + swz / 64; C = (st & 1) * 32 + (swz % 64) / 2; }
__device__ __forceinline__ int perm32(int rho) { const int n = rho >> 4, i = rho & 15; return 8 * (i >> 2) + 4 * n + (i & 3); }
struct Unit { int pm, pn; };
struct Gemm {
    const bf16_t* A; const bf16_t* Bt; int M, N, K;
    const int* gather;
    int gt, ng; size_t gstride;
};
struct StaticOrder {
    int nM, nN, nwg, G, c;
    __device__ void init(int M, int N, int G_, int c_) { nM = M / BM; nN = N / BM; nwg = nM * nN; G = G_; c = c_; }
    __device__ bool next(int i, Unit& u) const {
        const long L = (long)i * G + c; if (L >= nwg) return false;
        int wgid = (int)L; { const int q = nwg / NXCD, r = nwg % NXCD, xcd = wgid % NXCD, off = wgid / NXCD; wgid = (xcd < r ? xcd * (q + 1) : r * (q + 1) + (xcd - r) * q) + off; }
        const int nig = WGM * nN, gid = wgid / nig, fm = gid * WGM, gsz = (nM - fm) < WGM ? (nM - fm) : WGM;
        u.pm = fm + ((wgid % nig) % gsz); u.pn = (wgid % nig) / gsz; return true;
    }
};
struct EpiBf16 {
    static constexpr bool PERM = true;
    bf16_t* O; int ldc; const float* rowscale; int skip;
    __device__ __forceinline__ void operator()(const f32x4 (&acc)[2][2][4][2], const Unit& u, int wr, int wc, int fr, int fq) const {
        const int row0 = u.pm * BM + wr * 64 + fr, col0 = u.pn * BM + wc * 32 + 8 * fq;
        if (skip) { asm volatile("" :: "v"(acc[0][0][0][0]), "v"(acc[1][1][3][1])); return; }
        float scv[2][4];
#pragma unroll
        for (int ai = 0; ai < 2; ++ai)
#pragma unroll
            for (int m = 0; m < 4; ++m) scv[ai][m] = rowscale ? rowscale[row0 + ai * HALF + m * 16] : 1.f;
        asm volatile("" ::: "memory");
#pragma unroll
        for (int ai = 0; ai < 2; ++ai)
#pragma unroll
            for (int m = 0; m < 4; ++m) { const int row = row0 + ai * HALF + m * 16; bf16_t* rowp = O + (size_t)row * ldc + col0; const float sc = scv[ai][m];
#pragma unroll
                for (int bj = 0; bj < 2; ++bj) { const f32x4 v0 = acc[ai][bj][m][0] * sc, v1 = acc[ai][bj][m][1] * sc;
                    u32x4 w; w.x = cvt_pk_bf16_asm(v0[0], v0[1]); w.y = cvt_pk_bf16_asm(v0[2], v0[3]); w.z = cvt_pk_bf16_asm(v1[0], v1[1]); w.w = cvt_pk_bf16_asm(v1[2], v1[3]);
                    *(u32x4*)(rowp + bj * HALF) = w; } }
    }
};
struct EpiP {
    static constexpr bool PERM = true;
    bf16_t* O; int ldc; const float* qn; const float* kn; int skip;
    __device__ __forceinline__ void operator()(const f32x4 (&acc)[2][2][4][2], const Unit& u, int wr, int wc, int fr, int fq) const {
        const int row0 = u.pm * BM + wr * 64 + fr, col0 = u.pn * BM + wc * 32 + 8 * fq;
        if (skip) { asm volatile("" :: "v"(acc[0][0][0][0]), "v"(acc[1][1][3][1])); return; }
        if (u.pn >= 3 || !FUSE_QK) {
#pragma unroll
            for (int ai = 0; ai < 2; ++ai)
#pragma unroll
                for (int m = 0; m < 4; ++m) { bf16_t* rowp = O + (size_t)(row0 + ai * HALF + m * 16) * ldc + col0;
#pragma unroll
                    for (int bj = 0; bj < 2; ++bj) { const f32x4 v0 = acc[ai][bj][m][0], v1 = acc[ai][bj][m][1];
                        u32x4 w; w.x = cvt_pk_bf16_asm(v0[0], v0[1]); w.y = cvt_pk_bf16_asm(v0[2], v0[3]); w.z = cvt_pk_bf16_asm(v1[0], v1[1]); w.w = cvt_pk_bf16_asm(v1[2], v1[3]);
                        *(u32x4*)(rowp + bj * HALF) = w; } }
            return;
        }
        LAS float* PS = (LAS float*)((LAS unsigned char*)lds_raw + LDSCTL_OFF + 4096);
        const int half = wc & 1, hw = wc >> 1;
        unsigned lm_ = ~0u; asm volatile("" : "+s"(lm_)); const int lane = (int)__builtin_amdgcn_mbcnt_hi(lm_, __builtin_amdgcn_mbcnt_lo(lm_, 0u));
#pragma unroll
        for (int ai = 0; ai < 2; ++ai)
#pragma unroll
            for (int m = 0; m < 4; ++m)
#pragma unroll
                for (int bj = 0; bj < 2; ++bj) { const f32x4 v0 = acc[ai][bj][m][0], v1 = acc[ai][bj][m][1];
                    float s = (v0[0] * v0[0] + v0[1] * v0[1]) + (v0[2] * v0[2] + v0[3] * v0[3]) + (v1[0] * v1[0] + v1[1] * v1[1]) + (v1[2] * v1[2] + v1[3] * v1[3]);
                    s += __builtin_bit_cast(float, __builtin_amdgcn_ds_swizzle(__builtin_bit_cast(int, s), (16 << 10) | 0x1f));
                    s += __builtin_bit_cast(float, __builtin_amdgcn_ds_bpermute((lane ^ 32) << 2, __builtin_bit_cast(int, s)));
                    if (fq == 0) PS[((ai * HALF + wr * 64 + m * 16 + fr) * 4 + 2 * bj + hw) * 2 + half] = s; }
        asm volatile("s_waitcnt lgkmcnt(0)" ::: "memory"); __builtin_amdgcn_s_barrier(); asm volatile("" ::: "memory");
        float invf[8];
#pragma unroll
        for (int j = 0; j < 8; ++j) invf[j] = __builtin_amdgcn_exp2f(-(float)(8 * (fq & 1) + j) * (13.287712379549449f / 16.f));
        const bool second = (fq & 2) != 0;
        f32x4 nwv[2][2];
#pragma unroll
        for (int bj = 0; bj < 2; ++bj) { const bool isk = (u.pn * BM + bj * HALF + wc * 32) >= 384; const float* nw = (isk ? kn : qn) + 32 * half + 8 * fq; nwv[bj][0] = *(const f32x4*)nw; nwv[bj][1] = *(const f32x4*)(nw + 4); }
        asm volatile("" ::: "memory");
#pragma unroll
        for (int ai = 0; ai < 2; ++ai)
#pragma unroll
            for (int m = 0; m < 4; ++m) {
                const int grow = row0 + ai * HALF + m * 16; const bool lat = grow < NLAT; const int t = lat ? grow % SEQ : 0;
                int tp = half ? t % GW : t / GW; asm volatile("" : "+v"(tp));
                const float pos = (float)tp;
                float cs[8], sn[8];
#pragma unroll
                for (int j = 0; j < 8; ++j) { const float ang = pos * invf[j]; cs[j] = __cosf(ang); sn[j] = __sinf(ang); }
                bf16_t* rowp = O + (size_t)grow * ldc + col0;
#pragma unroll
                for (int bj = 0; bj < 2; ++bj) {
                    const int rl = ai * HALF + wr * 64 + m * 16 + fr, head = 2 * bj + hw;
                    const float ssq = PS[(rl * 4 + head) * 2] + PS[(rl * 4 + head) * 2 + 1];
                    const bool isk = (u.pn * BM + bj * HALF + wc * 32) >= 384;
                    const float rstd = (isk ? 1.f : 0.125f * 1.44269504089f) / sqrtf(ssq * (1.f / HD) + EPS);
                    const f32x4 n0 = nwv[bj][0], n1 = nwv[bj][1];
                    float y[8];
#pragma unroll
                    for (int j = 0; j < 4; ++j) { y[j] = acc[ai][bj][m][0][j] * rstd * n0[j]; y[4 + j] = acc[ai][bj][m][1][j] * rstd * n1[j]; }
#pragma unroll
                    for (int j = 0; j < 8; ++j) {
                        const unsigned yb = __builtin_bit_cast(unsigned, y[j]);
                        const auto sw = __builtin_amdgcn_permlane32_swap(yb, yb, false, false);
                        const float other = __builtin_bit_cast(float, lane < 32 ? sw[1] : sw[0]);
                        const float rot = second ? y[j] * cs[j] + other * sn[j] : y[j] * cs[j] - other * sn[j];
                        y[j] = lat ? rot : y[j];
                    }
                    u32x4 w; w.x = cvt_pk_bf16(y[0], y[1]); w.y = cvt_pk_bf16(y[2], y[3]); w.z = cvt_pk_bf16(y[4], y[5]); w.w = cvt_pk_bf16(y[6], y[7]);
                    *(u32x4*)(rowp + bj * HALF) = w;
                }
                asm volatile("" ::: "memory");
            }
    }
};
struct EpiRes {
    static constexpr bool PERM = true;
    bf16_t* X; int ldc; const float* gate0; int rows_per_set; size_t set_stride;
    __device__ __forceinline__ void operator()(const f32x4 (&acc)[2][2][4][2], const Unit& u, int wr, int wc, int fr, int fq) const {
        const int row0 = u.pm * BM + wr * 64 + fr, col0 = u.pn * BM + wc * 32 + 8 * fq;
        const float* gate = gate0 + (size_t)((u.pm * BM) / rows_per_set) * set_stride;
        f32x4 gv[2][2];
#pragma unroll
        for (int bj = 0; bj < 2; ++bj)
#pragma unroll
            for (int n = 0; n < 2; ++n) gv[bj][n] = *(const f32x4*)(gate + col0 + bj * HALF + n * 4);
        u32x4 rv[2][4][2];
#pragma unroll
        for (int ai = 0; ai < 2; ++ai)
#pragma unroll
            for (int m = 0; m < 4; ++m)
#pragma unroll
                for (int bj = 0; bj < 2; ++bj) rv[ai][m][bj] = *(const u32x4*)(X + (size_t)(row0 + ai * HALF + m * 16) * ldc + col0 + bj * HALF);
        asm volatile("" ::: "memory");
#pragma unroll
        for (int ai = 0; ai < 2; ++ai)
#pragma unroll
            for (int m = 0; m < 4; ++m) { bf16_t* rowp = X + (size_t)(row0 + ai * HALF + m * 16) * ldc + col0;
#pragma unroll
                for (int bj = 0; bj < 2; ++bj) { const u32x4 r = rv[ai][m][bj];
                    const f32x4 x0 = (f32x4){bfw(r.x, 0), bfw(r.x, 1), bfw(r.y, 0), bfw(r.y, 1)}, x1 = (f32x4){bfw(r.z, 0), bfw(r.z, 1), bfw(r.w, 0), bfw(r.w, 1)};
                    const f32x4 v0 = x0 + gv[bj][0] * acc[ai][bj][m][0], v1 = x1 + gv[bj][1] * acc[ai][bj][m][1];
                    u32x4 w; w.x = cvt_pk_bf16_asm(v0[0], v0[1]); w.y = cvt_pk_bf16_asm(v0[2], v0[3]); w.z = cvt_pk_bf16_asm(v1[0], v1[1]); w.w = cvt_pk_bf16_asm(v1[2], v1[3]);
                    *(u32x4*)(rowp + bj * HALF) = w; } }
    }
};
struct EpiHid {
    static constexpr bool PERM = false;
    bf16_t* O; int ldc;
    __device__ __forceinline__ void operator()(const f32x4 (&acc)[2][2][4][2], const Unit& u, int wr, int wc, int fr, int fq) const {
        const int row0 = u.pm * BM + wr * 64 + fr, col0 = (u.pn * BM + wc * 32) / 2 + 4 * fq;
#pragma unroll
        for (int ai = 0; ai < 2; ++ai)
#pragma unroll
            for (int m = 0; m < 4; ++m) { bf16_t* rowp = O + (size_t)(row0 + ai * HALF + m * 16) * ldc + col0;
#pragma unroll
                for (int bj = 0; bj < 2; ++bj) { const f32x4 g = acc[ai][bj][m][0], up = acc[ai][bj][m][1]; f32x4 h;
#pragma unroll
                    for (int j = 0; j < 4; ++j) h[j] = g[j] * __builtin_amdgcn_rcpf(1.f + __expf(-g[j])) * up[j];
                    u32x2 w; w.x = cvt_pk_bf16_asm(h[0], h[1]); w.y = cvt_pk_bf16_asm(h[2], h[3]);
                    *(u32x2*)(rowp + bj * (HALF / 2)) = w; } }
    }
};

template <class Epi, bool GATHER>
__device__ __forceinline__ void gemm_phase(const int tid, LAS unsigned char* lds, const Gemm g, const StaticOrder& S, const Epi& E) {
    const int wid = __builtin_amdgcn_readfirstlane(tid >> 6), lane = tid & 63, wr = wid >> 2, wc = wid & 3, fr = lane & 15, fq = lane >> 4;
    const int K = g.K, nt = K / BK;
    unsigned voffA[2], voffB[2];
#pragma unroll
    for (int i = 0; i < 2; ++i) { int R, C; stage_rc(tid * 16 + i * 8192, R, C); const int Rb = Epi::PERM ? ((R & ~31) + perm32(R & 31)) : R;
        voffB[i] = (unsigned)(Rb * K + C) * 2u; voffA[i] = GATHER ? (unsigned)(C * 2) : (Epi::PERM ? (unsigned)(R * K + C) * 2u : voffB[i]); }
    const size_t kstep = (size_t)(BK * 2);
    const size_t hstep = (size_t)HALF * K * 2;
    const size_t tstep = 2 * hstep;
    const unsigned ldsw = (unsigned)wid * 1024u;
    const int aoff = lds_byte(wr * 64 + fr, fq * 8), boff = lds_byte(wc * 32 + fr, fq * 8);
#define PG8_SA(b, h) (((b) * 2 + (h)) * HTB)
#define PG8_SB(b, h) ((4 + (b) * 2 + (h)) * HTB)
#define PG8_STAGE(bufoff, gbase, voff) do { const char* gb_ = (const char*)(gbase); asm volatile("" : "+s"(gb_)); _Pragma("unroll") for (int _i = 0; _i < 2; ++_i) \
        __builtin_amdgcn_global_load_lds((const unsigned*)(gb_ + (voff)[_i]), (LAS unsigned*)(lds + (bufoff) + ldsw + _i * 8192), 16, 0, 0); } while (0)
#define PG8_STAGE_A(bufoff, ubase, kt, h, tb) do { if constexpr (GATHER) { \
        if ((tb) < 0) { PG8_STAGE(bufoff, Ab + (size_t)(kt) * kstep, oAc[h]); } else { \
        unsigned m_ = ~0u; asm volatile("" : "+s"(m_)); const int tl_ = wid * 64 + (int)__builtin_amdgcn_mbcnt_hi(m_, __builtin_amdgcn_mbcnt_lo(m_, 0u)); \
        _Pragma("unroll") for (int _i = 0; _i < 2; ++_i) { int _R, _C; stage_rc(tl_ * 16 + _i * 8192, _R, _C); \
            const unsigned _o = *(const LAS unsigned*)(lds + TAB_OFF + (tb) * 1024 + ((h) * HALF + _R) * 4) + (unsigned)(_C * 2); \
            __builtin_amdgcn_global_load_lds((const unsigned*)(Ab + (size_t)(kt) * kstep + _o), (LAS unsigned*)(lds + (bufoff) + ldsw + _i * 8192), 16, 0, 0); } } } \
        else { PG8_STAGE(bufoff, (ubase) + (size_t)(kt) * kstep + (size_t)(h) * hstep, voffA); } } while (0)
#define PG8_LOADOFFS(tb) do { if constexpr (GATHER) { unsigned m_ = ~0u; asm volatile("" : "+s"(m_)); const int tl_ = wid * 64 + (int)__builtin_amdgcn_mbcnt_hi(m_, __builtin_amdgcn_mbcnt_lo(m_, 0u)); \
        _Pragma("unroll") for (int _h = 0; _h < 2; ++_h) _Pragma("unroll") for (int _i = 0; _i < 2; ++_i) { int _R, _C; stage_rc(tl_ * 16 + _i * 8192, _R, _C); \
            oAc[_h][_i] = *(const LAS unsigned*)(lds + TAB_OFF + (tb) * 1024 + (_h * HALF + _R) * 4) + (unsigned)(_C * 2); } } } while (0)
#define PG8_FILLTAB(u, tb) do { if constexpr (GATHER) { unsigned m_ = ~0u; asm volatile("" : "+s"(m_)); const int tl_ = wid * 64 + (int)__builtin_amdgcn_mbcnt_hi(m_, __builtin_amdgcn_mbcnt_lo(m_, 0u)); \
        if (tl_ < 256) *(LAS unsigned*)(lds + TAB_OFF + (tb) * 1024 + tl_ * 4) = min((unsigned)g.gather[(u).pm * BM + tl_], (unsigned)(NTOK - 1)) * (unsigned)(K * 2); } } while (0)
#define PG8_LDA(dst, b, h) do { _Pragma("unroll") for (int m = 0; m < 4; ++m) _Pragma("unroll") for (int k = 0; k < 2; ++k) dst[m][k] = *(const LAS bf16x8*)(lds + PG8_SA(b, h) + aoff + m * 2048 + k * 1024); } while (0)
#define PG8_LDB(dst, b, h) do { _Pragma("unroll") for (int n = 0; n < 2; ++n) _Pragma("unroll") for (int k = 0; k < 2; ++k) dst[n][k] = *(const LAS bf16x8*)(lds + PG8_SB(b, h) + boff + n * 2048 + k * 1024); } while (0)
#define PG8_MMA(ai, bj, At, Bt) do { __builtin_amdgcn_s_setprio(1); _Pragma("unroll") for (int m = 0; m < 4; ++m) _Pragma("unroll") for (int n = 0; n < 2; ++n) _Pragma("unroll") for (int k = 0; k < 2; ++k) \
        acc[ai][bj][m][n] = __builtin_amdgcn_mfma_f32_16x16x32_bf16(Bt[n][k], At[m][k], acc[ai][bj][m][n], 0, 0, 0); __builtin_amdgcn_s_setprio(0); } while (0)
#define PG8_WAIT_V(n) asm volatile("s_waitcnt vmcnt(" #n ")" ::: "memory")
#define PG8_WAIT_L(n) asm volatile("s_waitcnt lgkmcnt(" #n ")" ::: "memory")
#define PG8_BAR __builtin_amdgcn_s_barrier()
#define PG8_SCHED __builtin_amdgcn_sched_barrier(0)
#define PG8_KTILE2(u1, k1, o1, u2, k2, o2, b2p) do { \
        PG8_LDB(B0, 0, 0); PG8_LDB(B1, 0, 1); PG8_SCHED; PG8_LDA(At, 0, 0); PG8_STAGE_A(PG8_SA(1, 1), u1, k1, 1, o1); \
        PG8_WAIT_V(8); PG8_WAIT_L(0); PG8_BAR; PG8_MMA(0, 0, At, B0); PG8_MMA(0, 1, At, B1); PG8_BAR; PG8_SCHED; \
        PG8_LDA(At, 0, 1); PG8_STAGE(PG8_SB(0, 0), b2p, voffB); PG8_STAGE(PG8_SB(0, 1), (b2p) + hstep, voffB); PG8_STAGE_A(PG8_SA(0, 0), u2, k2, 0, o2); \
        PG8_WAIT_V(8); PG8_WAIT_L(0); PG8_BAR; PG8_MMA(1, 0, At, B0); PG8_MMA(1, 1, At, B1); PG8_BAR; PG8_SCHED; \
        PG8_LDB(B0, 1, 0); PG8_LDB(B1, 1, 1); PG8_SCHED; PG8_LDA(At, 1, 0); PG8_STAGE_A(PG8_SA(0, 1), u2, k2, 1, o2); \
        PG8_WAIT_V(8); PG8_WAIT_L(0); PG8_BAR; PG8_MMA(0, 0, At, B0); PG8_MMA(0, 1, At, B1); PG8_BAR; PG8_SCHED; \
        PG8_LDA(At, 1, 1); PG8_STAGE(PG8_SB(1, 0), (b2p) + kstep, voffB); PG8_STAGE(PG8_SB(1, 1), (b2p) + kstep + hstep, voffB); PG8_STAGE_A(PG8_SA(1, 0), u2, (k2) + 1, 0, o2); \
        PG8_WAIT_V(8); PG8_WAIT_L(0); PG8_BAR; PG8_MMA(1, 0, At, B0); PG8_MMA(1, 1, At, B1); PG8_BAR; PG8_SCHED; } while (0)
#define PG8_BPTR(u) ((const char*)g.Bt + (g.gt ? (size_t)(((u).pm / g.gt) % g.ng) * g.gstride : (size_t)0) + (size_t)(u).pn * tstep)
    Unit cur, nxt; int ui = 0;
    if (!S.next(0, cur)) return;
#ifndef GEMM_STAGGER
#define GEMM_STAGGER 0
#endif
    if (GEMM_STAGGER) { const int dg_ = ((int)blockIdx.x >> 3) & 3; for (int i_ = 0; i_ < dg_; ++i_) __builtin_amdgcn_s_sleep(GEMM_STAGGER); }
    f32x4 acc[2][2][4][2];
#pragma unroll
    for (int a = 0; a < 2; ++a)
#pragma unroll
        for (int b = 0; b < 2; ++b)
#pragma unroll
            for (int m = 0; m < 4; ++m)
#pragma unroll
                for (int n = 0; n < 2; ++n) acc[a][b][m][n] = (f32x4){0.f, 0.f, 0.f, 0.f};
    bf16x8 At[4][2], B0[2][2], B1[2][2];
    unsigned oAc[2][2] = {{0u, 0u}, {0u, 0u}};
    const char* const Ab = (const char*)g.A;
    const char* cA = Ab + (size_t)cur.pm * tstep;
    const char* cB = PG8_BPTR(cur);
    PG8_FILLTAB(cur, 0);
    if constexpr (GATHER) { PG8_WAIT_L(0); PG8_BAR; PG8_LOADOFFS(0); }
    PG8_STAGE(PG8_SB(0, 0), cB, voffB); PG8_STAGE(PG8_SB(0, 1), cB + hstep, voffB); PG8_STAGE_A(PG8_SA(0, 0), cA, 0, 0, -1); PG8_STAGE_A(PG8_SA(0, 1), cA, 0, 1, -1);
    if (wr == 1) PG8_BAR;
    PG8_WAIT_V(2); PG8_BAR;
    PG8_STAGE(PG8_SB(1, 0), cB + kstep, voffB); PG8_STAGE_A(PG8_SA(1, 0), cA, 1, 0, -1); PG8_STAGE(PG8_SB(1, 1), cB + hstep + kstep, voffB);
    PG8_WAIT_V(6); PG8_BAR;
    for (;;) {
        const bool has_next = S.next(ui + 1, nxt);
        const char* nA = has_next ? Ab + (size_t)nxt.pm * tstep : cA; const char* nB = has_next ? PG8_BPTR(nxt) : cB;
        const int tbc = ui & 1, tbn = has_next ? ((ui + 1) & 1) : (ui & 1);
        if (has_next) PG8_FILLTAB(nxt, tbn);
        for (int t = 0; t < nt - 2; t += 2) { const char* b2 = cB + (size_t)(t + 2) * kstep; PG8_KTILE2(cA, t + 1, -1, cA, t + 2, -1, b2); }
        PG8_KTILE2(cA, nt - 1, -1, nA, 0, tbn, nB);
        if (wr == 0) PG8_BAR;
        { unsigned m_ = ~0u; asm volatile("" : "+s"(m_)); int l2 = (int)__builtin_amdgcn_mbcnt_hi(m_, __builtin_amdgcn_mbcnt_lo(m_, 0u)); asm volatile("" : "+v"(l2)); E(acc, cur, wr, wc, l2 & 15, l2 >> 4); }
        if (!has_next) break;
#pragma unroll
        for (int a = 0; a < 2; ++a)
#pragma unroll
            for (int b = 0; b < 2; ++b)
#pragma unroll
                for (int m = 0; m < 4; ++m)
#pragma unroll
                    for (int n = 0; n < 2; ++n) acc[a][b][m][n] = (f32x4){0.f, 0.f, 0.f, 0.f};
        cur = nxt; cA = nA; cB = nB; ++ui;
        PG8_LOADOFFS(ui & 1);
        if (wr == 1) PG8_BAR;
    }
    PG8_WAIT_V(0);
    PG8_BAR;
#undef PG8_STAGE_A
#undef PG8_FILLTAB
#undef PG8_LOADOFFS
#undef PG8_SA
#undef PG8_SB
#undef PG8_STAGE
#undef PG8_LDA
#undef PG8_LDB
#undef PG8_MMA
#undef PG8_WAIT_V
#undef PG8_WAIT_L
#undef PG8_BAR
#undef PG8_SCHED
#undef PG8_KTILE2
#undef PG8_BPTR
}
}

#define XB_TMO      128
#define XB_XCNT(j)  (256  + 64 * (j))
#define XB_XSUB(j)  (1280 + 64 * (j))
#define XB_XGEN(j)  (2304 + 64 * (j))
#define XB_TOP      3328
#define XB_TOPGEN   3392
#define XCD_BAR_WORDS 3456
#define XB_SPIN_CAP (1u << 20)
__device__ __forceinline__ unsigned xb_ld(unsigned* p)              { return __hip_atomic_load(p, __ATOMIC_RELAXED, __HIP_MEMORY_SCOPE_AGENT); }
__device__ __forceinline__ unsigned xb_add(unsigned* p, unsigned v) { return __hip_atomic_fetch_add(p, v, __ATOMIC_RELAXED, __HIP_MEMORY_SCOPE_AGENT); }
__device__ __forceinline__ unsigned xb_xcc_id() { return (unsigned)__builtin_amdgcn_s_getreg((3 << 11) | 20) & 0xFu; }
#define XB_SPIN(cond, bar) do { unsigned _sp = 0; while (cond) { __builtin_amdgcn_s_sleep(1); \
    if ((++_sp & 255u) == 0u) { if (xb_ld(&(bar)[XB_TMO])) break; if (_sp > XB_SPIN_CAP) { atomicAdd(&(bar)[XB_TMO], 1u); break; } } } } while (0)
struct XcdBarrier { unsigned* bar; unsigned x; };
#define XB_ST(ldsbase) ((volatile LAS unsigned*)((LAS unsigned char*)(ldsbase) + MISC_OFF + 32))
__device__ __forceinline__ XcdBarrier xcd_barrier_post(unsigned* bar, bool leader) {
    XcdBarrier b; b.bar = bar; b.x = xb_xcc_id();
    if (leader) (void)xb_add(&bar[XB_XCNT(b.x)], 1u);
    return b;
}
__device__ __forceinline__ void xcd_barrier_complete(unsigned* bar, unsigned x, unsigned& nloc, unsigned& nx) {
    const unsigned G = gridDim.x * gridDim.y * gridDim.z;
    unsigned sum, cnt, mine, sp = 0u;
    for (;;) {
        sum = 0u; cnt = 0u; mine = 0u;
#pragma unroll
        for (unsigned j = 0; j < 16; ++j) { const unsigned c = xb_ld(&bar[XB_XCNT(j)]); sum += c; cnt += (c > 0u) ? 1u : 0u; mine = (j == x) ? c : mine; }
        if (sum == G) break;
        __builtin_amdgcn_s_sleep(1);
        if ((++sp & 255u) == 0u) { if (xb_ld(&bar[XB_TMO])) break; if (sp > XB_SPIN_CAP) { atomicAdd(&bar[XB_TMO], 1u); break; } }
    }
    nloc = mine > 0u ? mine : 1u; nx = cnt > 0u ? cnt : 1u;
}
__device__ __forceinline__ void xcd_barrier(const XcdBarrier& b, bool leader, volatile LAS unsigned* st) {
    asm volatile("s_waitcnt vmcnt(0)" ::: "memory");
    __syncthreads();
    if (leader) {
        unsigned* bar = b.bar;
        __builtin_amdgcn_s_waitcnt(0);
        unsigned nloc = st[0], nx = st[1];
        if (nloc == 0u) { xcd_barrier_complete(bar, b.x, nloc, nx); st[0] = nloc; st[1] = nx; }
        const unsigned old = xb_add(&bar[XB_XSUB(b.x)], 1u);
        const unsigned gen = old / nloc;
        if (old + 1u == (gen + 1u) * nloc) {
            __builtin_amdgcn_fence(__ATOMIC_RELEASE, "agent");
            asm volatile("s_waitcnt vmcnt(0)" ::: "memory");
            const unsigned og = xb_add(&bar[XB_TOP], 1u);
            const unsigned tg = og / nx;
            if (og + 1u == (tg + 1u) * nx) xb_add(&bar[XB_TOPGEN], 1u);
            else XB_SPIN(xb_ld(&bar[XB_TOPGEN]) == tg, bar);
            __builtin_amdgcn_fence(__ATOMIC_ACQUIRE, "agent");
            xb_add(&bar[XB_XGEN(b.x)], 1u);
            asm volatile("s_waitcnt vmcnt(0)" ::: "memory");
        } else {
            XB_SPIN(xb_ld(&bar[XB_XGEN(b.x)]) == gen, bar);
            __builtin_amdgcn_fence(__ATOMIC_ACQUIRE, "agent");
            asm volatile("s_waitcnt vmcnt(0)" ::: "memory");
        }
    }
    __syncthreads();
}

template <void (*F)(long, PRef, int)> __device__ __forceinline__ void run_items(const int tid, PRef p, int l, long n, long off) {
    for (long gid = (long)blockIdx.x * NTHR + tid; gid < n; gid += (long)gridDim.x * NTHR) F(gid + off, p, l);
}
BODY void b_hgrn_seq2(long gid, PRef p, int l) { const long n1 = (long)NB * HGH * 64; if (gid < n1) b_hgrn_seq<0>(gid, p, l); else b_hgrn_seq<1>(gid - n1, p, l); }

template <int MAP> __device__ __forceinline__ void transpose_item(const float* W, int K, int N, bf16_t* WT, int row_off, LAS float* scr, int item, int lane) {
    const int nblk = N / 32, kb = item / nblk, nb = item % nblk, k0 = 64 * kb, n0 = 32 * nb;
#pragma unroll 8
    for (int i = 0; i < 32; ++i) { const int kk = 2 * i + (lane >> 5); scr[kk * 33 + (lane & 31)] = W[(size_t)(k0 + kk) * N + n0 + (lane & 31)]; }
    asm volatile("s_waitcnt lgkmcnt(0)" ::: "memory");
    const int c = lane & 7;
#pragma unroll
    for (int j = 0; j < 4; ++j) { const int n = (lane >> 3) + 8 * j; const LAS float* s = scr + (8 * c) * 33 + n;
        u32x4 o; o.x = cvt_pk_bf16(s[0 * 33], s[1 * 33]); o.y = cvt_pk_bf16(s[2 * 33], s[3 * 33]); o.z = cvt_pk_bf16(s[4 * 33], s[5 * 33]); o.w = cvt_pk_bf16(s[6 * 33], s[7 * 33]);
        const int nn = n0 + n; const int drow = MAP == 0 ? row_off + nn : (32 * (nn >> 4) + (nn & 15) + (MAP == 2 ? 16 : 0));
        *(u32x4*)(WT + (size_t)drow * K + k0 + 8 * c) = o; }
    asm volatile("s_waitcnt lgkmcnt(0)" ::: "memory");
}
__device__ __forceinline__ void phase_convert(const int tid, PRef p, int l, LAS unsigned char* lds, int part = 0, int blk_lo = 0) {
    if ((int)blockIdx.x < blk_lo) return;
    const int lane = tid & 63, wave = tid >> 6;
    LAS float* scr = (LAS float*)(lds + wave * 16384);
    const int gw = ((int)blockIdx.x - blk_lo) * NWAVES + wave, NGW = ((int)gridDim.x - blk_lo) * NWAVES;
    constexpr int I_IN = (D / 64) * (INC / 32), I_OUT = (MIXD / 64) * (D / 32), I_G = (D / 64) * (ED / 32), I_D = (ED / 64) * (D / 32);
    constexpr int NITEMS = I_IN + I_OUT + NE * (2 * I_G + I_D);
    const int it_lo = part == 2 ? I_IN + I_OUT : 0, it_hi = part == 1 ? I_IN + I_OUT : NITEMS;
    for (int it = it_lo + gw; it < it_hi; it += NGW) {
        int r = it;
        if (r < I_IN) { transpose_item<0>(p.w_in + (size_t)l * D * INC, D, INC, p.WIN_T, 0, scr, r, lane); continue; } r -= I_IN;
        if (r < I_OUT) { transpose_item<0>(p.w_out + (size_t)l * MIXD * D, MIXD, D, p.WOUT_T, 0, scr, r, lane); continue; } r -= I_OUT;
        const int e = r / (2 * I_G + I_D); r -= e * (2 * I_G + I_D);
        if (r < I_G) { transpose_item<1>(p.w_gate + ((size_t)l * NE + e) * D * ED, D, ED, p.WGU_T + (size_t)e * 2 * ED * D, 0, scr, r, lane); continue; } r -= I_G;
        if (r < I_G) { transpose_item<2>(p.w_up + ((size_t)l * NE + e) * D * ED, D, ED, p.WGU_T + (size_t)e * 2 * ED * D, 0, scr, r, lane); continue; } r -= I_G;
        transpose_item<0>(p.w_down + ((size_t)l * NE + e) * ED * D, ED, D, p.WD_T + (size_t)e * D * ED, 0, scr, r, lane);
    }
}
template <int WHICH> __device__ __forceinline__ void phase_prenorm(const int tid, PRef p, int l) {
    static_assert(D == 1024, "wave-per-row kernels assume D = 1024");
    const int lane = tid & 63, wave = tid >> 6;
    const int gw = blockIdx.x * NWAVES + wave, NGW = gridDim.x * NWAVES;
    const float* nw = (WHICH ? p.norm2_w : p.norm1_w) + l * D;
    for (int r = gw; r < NTOK; r += NGW) {
        const float* xr = xrow(p, r);
        const float* mod = p.MOD + ((size_t)l * 3 + modset(r)) * NMOD;
        const float* shift = mod + (WHICH ? 3 : 0) * D; const float* scale = mod + (WHICH ? 4 : 1) * D;
        f32x4 v[4]; float ss = 0.f;
#pragma unroll
        for (int j = 0; j < 4; ++j) { v[j] = *(const f32x4*)(xr + 4 * lane + 256 * j); ss += (v[j][0] * v[j][0] + v[j][1] * v[j][1]) + (v[j][2] * v[j][2] + v[j][3] * v[j][3]); }
        const float rstd = 1.f / sqrtf(wave_sum(ss, lane) * (1.f / D) + EPS);
        float lg[NE];
#pragma unroll
        for (int e = 0; e < NE; ++e) lg[e] = 0.f;
#pragma unroll
        for (int j = 0; j < 4; ++j) {
            const int c = 4 * lane + 256 * j;
            const f32x4 w4 = *(const f32x4*)(nw + c), sc4 = *(const f32x4*)(scale + c), sh4 = *(const f32x4*)(shift + c);
            f32x4 h;
#pragma unroll
            for (int i = 0; i < 4; ++i) h[i] = v[j][i] * rstd * w4[i] * (1.f + sc4[i]) + sh4[i];
            u32x2 o; o.x = cvt_pk_bf16(h[0], h[1]); o.y = cvt_pk_bf16(h[2], h[3]);
            *(u32x2*)(p.H + (size_t)r * D + c) = o;
            if (WHICH) {
#pragma unroll
                for (int i = 0; i < 4; ++i) { const f32x4* wr = (const f32x4*)(p.w_router + ((size_t)l * D + c + i) * NE);
#pragma unroll
                    for (int q = 0; q < 4; ++q) { const f32x4 w = wr[q]; lg[4 * q + 0] += h[i] * w[0]; lg[4 * q + 1] += h[i] * w[1]; lg[4 * q + 2] += h[i] * w[2]; lg[4 * q + 3] += h[i] * w[3]; } }
            }
        }
        if (WHICH) {
#pragma unroll
            for (int e = 0; e < NE; ++e) lg[e] = wave_sum(lg[e], lane);
            float m = lg[0];
#pragma unroll
            for (int e = 1; e < NE; ++e) m = fmaxf(m, lg[e]);
            float s = 0.f, mine = 0.f;
#pragma unroll
            for (int e = 0; e < NE; ++e) { const float ex = expf(lg[e] - m); s += ex; mine = (lane == e) ? ex : mine; }
            if (lane < NE) p.AFF[(size_t)r * NE + lane] = mine / s;
        }
    }
}
__device__ __forceinline__ void phase_combine(const int tid, PRef p, int l) {
    const int lane = tid & 63, wave = tid >> 6;
    const int gw = blockIdx.x * NWAVES + wave, NGW = gridDim.x * NWAVES;
    for (int r = gw; r < NTOK; r += NGW) {
        float* xr = xrow(p, r);
        const float* g = p.MOD + ((size_t)l * 3 + modset(r)) * NMOD + 5 * D;
        f32x4 acc[4];
#pragma unroll
        for (int j = 0; j < 4; ++j) acc[j] = (f32x4){0.f, 0.f, 0.f, 0.f};
        const int myinv = lane < NE ? p.INV[(size_t)r * NE + lane] : -1;
#pragma unroll
        for (int e = 0; e < NE; ++e) {
            const int s = __builtin_amdgcn_readlane(myinv, e);
            if (s >= 0 && s < NSLOT) {
                const bf16_t* y = p.Y + (size_t)s * D;
#pragma unroll
                for (int j = 0; j < 4; ++j) { const u32x2 w = *(const u32x2*)(y + 4 * lane + 256 * j);
                    acc[j][0] += __builtin_bit_cast(float, w.x << 16); acc[j][1] += __builtin_bit_cast(float, w.x & 0xffff0000u);
                    acc[j][2] += __builtin_bit_cast(float, w.y << 16); acc[j][3] += __builtin_bit_cast(float, w.y & 0xffff0000u); }
            }
        }
#pragma unroll
        for (int j = 0; j < 4; ++j) { const int c = 4 * lane + 256 * j; f32x4* q = (f32x4*)(xr + c); *q = *q + *(const f32x4*)(g + c) * acc[j]; }
    }
}


__device__ __forceinline__ unsigned wave_excl_scan(unsigned x, int lane) {
    unsigned inc = x;
#pragma unroll
    for (int d = 1; d < 64; d <<= 1) { const unsigned y = (unsigned)__builtin_amdgcn_ds_bpermute(((lane - d) & 63) << 2, (int)inc); if (lane >= d) inc += y; }
    return inc - x;
}
__device__ __forceinline__ void phase_topk(const int tid, PRef p, LAS unsigned char* lds) {
    LAS unsigned* keys = (LAS unsigned*)lds;
    LAS unsigned* hist = (LAS unsigned*)(lds + 70000);
    LAS unsigned* cgt = (LAS unsigned*)(lds + 76000);
    LAS unsigned* ceq = (LAS unsigned*)(lds + 80000);
    LAS unsigned* sh = (LAS unsigned*)(lds + 84000);
    static_assert(SEQ % 512 == 0 && SEQ + SEQ / 32 <= 17400, "topk LDS layout");
    constexpr int PER = SEQ / 512;
    for (int pr = blockIdx.x; pr < 2 * NB * NE; pr += gridDim.x) {
        const int e = pr % NE, b = (pr / NE) % NB, isctx = pr / (NE * NB);
        if (!isctx) {
            const int row0 = b * SEQ, base = (b * NE + e) * CAPL;
            for (int i = 0; i < PER; ++i) { const int t = i * 512 + tid; keys[t + (t >> 5)] = __builtin_bit_cast(unsigned, p.AFF[(size_t)(row0 + t) * NE + e]); }
            if (tid == 0) { sh[0] = 0u; sh[1] = (unsigned)CAPL; }
            __syncthreads();
            for (int pass = 0; pass < 3; ++pass) {
                const int shift = 20 - 10 * pass;
                for (int i = tid; i < 1024; i += 512) hist[i] = 0u;
                __syncthreads();
                const unsigned prefix = sh[0]; const unsigned himask = pass == 0 ? 0u : (0xFFFFFFFFu << (shift + 10));
                for (int i = 0; i < PER; ++i) { const int t = tid * PER + i; const unsigned k = keys[t + (t >> 5)]; if ((k & himask) == prefix) atomicAdd((unsigned*)&hist[(k >> shift) & 1023u], 1u); }
                __syncthreads();
                if (tid < 64) {
                    const unsigned need = sh[1];
                    unsigned c[16]; unsigned tot = 0u;
#pragma unroll
                    for (int q = 0; q < 16; ++q) { c[q] = hist[1023 - 16 * tid - q]; tot += c[q]; }
                    unsigned above = wave_excl_scan(tot, tid);
                    int fbin = -1; unsigned fabove = 0u;
#pragma unroll
                    for (int q = 0; q < 16; ++q) { if (fbin < 0 && above < need && above + c[q] >= need) { fbin = 1023 - 16 * tid - q; fabove = above; } above += c[q]; }
                    if (fbin >= 0) { sh[0] = prefix | ((unsigned)fbin << shift); sh[1] = need - fabove; }
                }
                __syncthreads();
            }
            const unsigned thr = sh[0], keq = sh[1];
            unsigned ng = 0u, nq = 0u;
            for (int i = 0; i < PER; ++i) { const int t = tid * PER + i; const unsigned k = keys[t + (t >> 5)]; ng += k > thr ? 1u : 0u; nq += k == thr ? 1u : 0u; }
            cgt[tid] = ng; ceq[tid] = nq;
            __syncthreads();
            if (tid < 64) {
                unsigned g[8], q[8], sg = 0u, sq = 0u;
#pragma unroll
                for (int i = 0; i < 8; ++i) { g[i] = cgt[8 * tid + i]; q[i] = ceq[8 * tid + i]; sg += g[i]; sq += q[i]; }
                unsigned ag = wave_excl_scan(sg, tid), aq = wave_excl_scan(sq, tid);
#pragma unroll
                for (int i = 0; i < 8; ++i) { cgt[8 * tid + i] = ag; ceq[8 * tid + i] = aq; ag += g[i]; aq += q[i]; }
            }
            __syncthreads();
            unsigned rg = cgt[tid], rq = ceq[tid];
            for (int i = 0; i < PER; ++i) {
                const int t = tid * PER + i; const unsigned k = keys[t + (t >> 5)];
                int slot = -1;
                if (k > thr) { slot = (int)(rg + (rq < keq ? rq : keq)); ++rg; }
                else if (k == thr) { if (rq < keq) slot = (int)(rg + rq); ++rq; }
                const int row = row0 + t;
                if (slot >= 0) { p.STOK[base + slot] = row; p.SVAL[base + slot] = __builtin_bit_cast(float, k); p.INV[(size_t)row * NE + e] = base + slot; }
                else p.INV[(size_t)row * NE + e] = -1;
            }
            __syncthreads();
        } else {
            const int row0 = NLAT + b * CTX, base = NSLOT_L + (b * NE + e) * CAPC;
            LAS float* vals = (LAS float*)lds;
            for (int t = tid; t < CTX; t += 512) vals[t] = p.AFF[(size_t)(row0 + t) * NE + e];
            __syncthreads();
            for (int t = tid; t < CTX; t += 512) {
                const float a = vals[t]; int rank = 0;
                for (int tt = 0; tt < CTX; ++tt) { const float o = vals[tt]; rank += (o > a || (o == a && tt < t)) ? 1 : 0; }
                const int row = row0 + t;
                if (rank < CAPC) { p.STOK[base + rank] = row; p.SVAL[base + rank] = a; p.INV[(size_t)row * NE + e] = base + rank; }
                else p.INV[(size_t)row * NE + e] = -1;
            }
            __syncthreads();
        }
    }
}

#define LDS_BAR() do { asm volatile("s_waitcnt lgkmcnt(0)" ::: "memory"); __builtin_amdgcn_s_barrier(); asm volatile("" ::: "memory"); } while (0)
__device__ __forceinline__ int hg_row0(int b, int pc) { return pc < NCHC ? NLAT + b * CTX + pc * 64 : b * SEQ + (pc - NCHC) * 64; }
constexpr int HG_FF = 0, HG_FB = 16640, HG_AF = 33280, HG_AB = 49920, HG_T0 = 66560, HG_TS = 9216, HG_VT = HG_T0 + 6 * HG_TS;
static_assert(HG_VT + HG_TS <= RING_BYTES, "hgrn LDS layout");
#define TSW_E(k, t) ((k) * 72 + ((((t) >> 3) ^ (((k) >> 3) & 7)) << 3) + ((t) & 7))
#define TSW_B(k, c) ((k) * 144 + (((c) ^ (((k) >> 3) & 7)) << 4))
constexpr int HG_LBOFF = LDSCTL_OFF + 4096;
__device__ __forceinline__ void hg_stage_lb(const int tid, PRef p, int l) {
    LAS float* dst = (LAS float*)((LAS unsigned char*)lds_raw + HG_LBOFF);
    for (int i = tid; i < 768; i += NTHR) dst[i] = p.LB[(size_t)((i / 384) * DEPTH + l) * 384 + (i % 384)];
    LDS_BAR();
}
__device__ __forceinline__ void hg_gates(const int tid, PRef p, int l, int h, const u32x4 zf, const u32x4 zb, LAS unsigned char* lds) {
    LAS float* FF = (LAS float*)(lds + HG_FF); LAS float* FB = (LAS float*)(lds + HG_FB); LAS float* AF = (LAS float*)(lds + HG_AF); LAS float* AB = (LAS float*)(lds + HG_AB);
    const int t = tid >> 3, cg = tid & 7;
    const LAS float* lbf = (const LAS float*)((LAS unsigned char*)lds_raw + HG_LBOFF) + h * 64 + cg * 8; const LAS float* lbb = lbf + 384;
#pragma unroll
    for (int j = 0; j < 8; ++j) {
        const float z0 = fminf(fmaxf(bf8(zf, j), -60.f), 60.f), z1 = fminf(fmaxf(bf8(zb, j), -60.f), 60.f);
        const float l0 = lbf[j], l1 = lbb[j];
        FF[t * 65 + cg * 8 + j] = l0 + (1.f - l0) * __builtin_amdgcn_rcpf(1.f + __expf(-z0));
        FB[t * 65 + cg * 8 + j] = l1 + (1.f - l1) * __builtin_amdgcn_rcpf(1.f + __expf(-z1));
    }
    LDS_BAR();
    {
        const int wave = tid >> 6, lane = tid & 63, cl = lane & 15, seg = lane >> 4, dir = wave >> 2, col = 16 * (wave & 3) + cl;
        const LAS float* F = dir ? FB : FF; LAS float* A = dir ? AB : AF;
        float pre[16]; float run = 0.f;
#pragma unroll
        for (int i = 0; i < 16; ++i) { const int tt = dir ? 16 * seg + 15 - i : 16 * seg + i; run += __logf(F[tt * 65 + col]); pre[i] = run; }
        const float T0 = __builtin_bit_cast(float, __builtin_amdgcn_ds_bpermute((cl + 0) << 2, __builtin_bit_cast(int, run)));
        const float T1 = __builtin_bit_cast(float, __builtin_amdgcn_ds_bpermute((cl + 16) << 2, __builtin_bit_cast(int, run)));
        const float T2 = __builtin_bit_cast(float, __builtin_amdgcn_ds_bpermute((cl + 32) << 2, __builtin_bit_cast(int, run)));
        const float T3 = __builtin_bit_cast(float, __builtin_amdgcn_ds_bpermute((cl + 48) << 2, __builtin_bit_cast(int, run)));
        const float off = dir ? ((seg < 1 ? T1 : 0.f) + (seg < 2 ? T2 : 0.f) + (seg < 3 ? T3 : 0.f)) : ((seg > 0 ? T0 : 0.f) + (seg > 1 ? T1 : 0.f) + (seg > 2 ? T2 : 0.f));
#pragma unroll
        for (int i = 0; i < 16; ++i) { const int tt = dir ? 16 * seg + 15 - i : 16 * seg + i; A[tt * 65 + col] = off + pre[i]; }
    }
    LDS_BAR();
}
__device__ __forceinline__ bf16x8 ld2x64(const LAS unsigned char* p0, const LAS unsigned char* p1) {
    const u32x2 a = *(const LAS u32x2*)p0, b = *(const LAS u32x2*)p1; u32x4 r; r.x = a.x; r.y = a.y; r.z = b.x; r.w = b.y; return __builtin_bit_cast(bf16x8, r);
}
__device__ __forceinline__ f32x4 mfma16(bf16x8 a, bf16x8 b, f32x4 c) { return __builtin_amdgcn_mfma_f32_16x16x32_bf16(a, b, c, 0, 0, 0); }
__device__ __forceinline__ void phase_hgrn_local(const int tid, PRef p, int l, LAS unsigned char* lds) {
    LAS float* FF = (LAS float*)(lds + HG_FF); LAS float* FB = (LAS float*)(lds + HG_FB); LAS float* AF = (LAS float*)(lds + HG_AF); LAS float* AB = (LAS float*)(lds + HG_AB);
    LAS bf16_t* KTf = (LAS bf16_t*)(lds + HG_T0); LAS bf16_t* KTb = (LAS bf16_t*)(lds + HG_T0 + HG_TS); LAS bf16_t* VT = (LAS bf16_t*)(lds + HG_VT);
    const int t = tid >> 3, cg = tid & 7, wave = tid >> 6, lane = tid & 63, fr = lane & 15, fq = lane >> 4;
    u32x4 nzf = (u32x4){0u, 0u, 0u, 0u}, nzb = nzf, nv8 = nzf;
    if ((int)blockIdx.x < NBH * NCH) { const int it = blockIdx.x, pc = it % NCH, bh = it / NCH, h = bh % HGH, b = bh / HGH;
        const bf16_t* pr = p.P + (size_t)(hg_row0(b, pc) + t) * INC + h * 64 + cg * 8; nzf = *(const u32x4*)(pr + OFF_); nzb = *(const u32x4*)(pr + OFB); nv8 = *(const u32x4*)(pr + OHI); }
    hg_stage_lb(tid, p, l);
    for (int it = blockIdx.x; it < NBH * NCH; it += gridDim.x) {
        const int pc = it % NCH, bh = it / NCH, h = bh % HGH, b = bh / HGH, row0 = hg_row0(b, pc);
        const u32x4 zf = nzf, zb = nzb, v8 = nv8;
        { const int it2 = it + gridDim.x; if (it2 < NBH * NCH) { const int pc2 = it2 % NCH, bh2 = it2 / NCH, h2 = bh2 % HGH, b2 = bh2 / HGH;
            const bf16_t* pr = p.P + (size_t)(hg_row0(b2, pc2) + t) * INC + h2 * 64 + cg * 8; nzf = *(const u32x4*)(pr + OFF_); nzb = *(const u32x4*)(pr + OFB); nv8 = *(const u32x4*)(pr + OHI); } }
        hg_gates(tid, p, l, h, zf, zb, lds);
#pragma unroll
        for (int j = 0; j < 8; ++j) {
            const int k = cg * 8 + j;
            VT[TSW_E(k, t)] = (bf16_t)(j & 1 ? v8[j >> 1] >> 16 : v8[j >> 1] & 0xffffu);
            KTf[TSW_E(k, t)] = f2bf((1.f - FF[t * 65 + k]) * __expf(AF[63 * 65 + k] - AF[t * 65 + k]));
            KTb[TSW_E(k, t)] = f2bf((1.f - FB[t * 65 + k]) * __expf(AB[k] - AB[t * 65 + k]));
        }
        if (tid < 64) p.GDEC[((size_t)(0 * NBH + bh) * NCH + pc) * 64 + tid] = __expf(AF[63 * 65 + tid]);
        else if (tid < 128) p.GDEC[((size_t)(1 * NBH + bh) * NCH + pc) * 64 + (tid - 64)] = __expf(AB[tid - 64]);
        LDS_BAR();
#if HGRN_DIAG == 4
        {
            const int v = tid >> 3, kg = tid & 7;
            for (int dir = 0; dir < 2; ++dir) {
                const LAS bf16_t* KT = (const LAS bf16_t*)(lds + HG_T0 + dir * HG_TS);
                float acc[8];
#pragma unroll
                for (int j = 0; j < 8; ++j) acc[j] = 0.f;
                for (int s_ = 0; s_ < 64; ++s_) { const float vv = bf2f(VT[v * 72 + s_]);
#pragma unroll
                    for (int j = 0; j < 8; ++j) acc[j] += bf2f(KT[(kg * 8 + j) * 72 + s_]) * vv; }
                bf16_t* dst = p.SLOC + ((size_t)(dir * NBH + bh) * NCH + pc) * 4096 + v * 64 + kg * 8;
#pragma unroll
                for (int j = 0; j < 8; ++j) dst[j] = f2bf(acc[j]);
            }
        }
#else
        {
            const int dir = wave >> 2, mt = wave & 3;
            const LAS unsigned char* KT = lds + HG_T0 + dir * HG_TS;
            bf16x8 a[2];
#pragma unroll
            for (int ks = 0; ks < 2; ++ks) a[ks] = *(const LAS bf16x8*)(KT + TSW_B(mt * 16 + fr, ks * 4 + fq));
            bf16_t* dst = p.SLOC + ((size_t)(dir * NBH + bh) * NCH + pc) * 4096;
#pragma unroll
            for (int nt = 0; nt < 4; ++nt) {
                f32x4 acc = (f32x4){0.f, 0.f, 0.f, 0.f};
#pragma unroll
                for (int ks = 0; ks < 2; ++ks) { const bf16x8 bb = *(const LAS bf16x8*)(lds + HG_VT + TSW_B(nt * 16 + fr, ks * 4 + fq)); acc = mfma16(a[ks], bb, acc); }
                u32x2 w; w.x = cvt_pk_bf16(acc[0], acc[1]); w.y = cvt_pk_bf16(acc[2], acc[3]);
                *(u32x2*)(dst + (nt * 16 + fr) * 64 + mt * 16 + 4 * fq) = w;
            }
        }
#endif
        LDS_BAR();
    }
}
__device__ __forceinline__ void phase_hgrn_scan(const int tid, PRef p) {
    static_assert(NCH % 20 == 0, "scan group size");
    constexpr int GS = 20;
    for (int blk = (int)gridDim.x - 1 - (int)blockIdx.x; blk < 2 * NBH * 4; blk += gridDim.x) {
        const int sq = blk >> 2, part = blk & 3, dir = sq / NBH, e0 = part * 1024 + tid * 2, k = e0 & 63;
        unsigned* S = (unsigned*)(p.SLOC + (size_t)sq * NCH * 4096 + e0);
        const float* G = p.GDEC + (size_t)sq * NCH * 64 + k;
        float c0 = 0.f, c1 = 0.f;
        unsigned nx[GS]; f32x2 gn[GS];
#define HG_PC(j) (dir ? ((j) < NCHC ? NCHC - 1 - (j) : NCH + NCHC - 1 - (j)) : (j))
#pragma unroll
        for (int u = 0; u < GS; ++u) { const int pc = HG_PC(u); nx[u] = S[(size_t)pc * 2048]; gn[u] = *(const f32x2*)(G + (size_t)pc * 64); }
        for (int j0 = 0; j0 < NCH; j0 += GS) {
            unsigned cu[GS]; f32x2 gc[GS];
#pragma unroll
            for (int u = 0; u < GS; ++u) { cu[u] = nx[u]; gc[u] = gn[u]; }
            if (j0 + GS < NCH) {
#pragma unroll
                for (int u = 0; u < GS; ++u) { const int pc = HG_PC(j0 + GS + u); nx[u] = S[(size_t)pc * 2048]; gn[u] = *(const f32x2*)(G + (size_t)pc * 64); }
            }
#pragma unroll
            for (int u = 0; u < GS; ++u) {
                const int pc = HG_PC(j0 + u);
                S[(size_t)pc * 2048] = cvt_pk_bf16(c0, c1);
                c0 = gc[u][0] * c0 + bfw(cu[u], 0); c1 = gc[u][1] * c1 + bfw(cu[u], 1);
            }
        }
#undef HG_PC
    }
}
__device__ __forceinline__ void phase_hgrn_out(const int tid, PRef p, int l, LAS unsigned char* lds, int stop_after = 0) {
    const int NCHO = (l + 1 < DEPTH) ? NCH : NCH - NCHC, PC0 = NCH - NCHO;
    LAS float* FF = (LAS float*)(lds + HG_FF); LAS float* FB = (LAS float*)(lds + HG_FB); LAS float* AF = (LAS float*)(lds + HG_AF); LAS float* AB = (LAS float*)(lds + HG_AB);
    LAS bf16_t* VT = (LAS bf16_t*)(lds + HG_VT);
    LAS float* OO = (LAS float*)(lds + HG_AF);
    const int t = tid >> 3, cg = tid & 7, wave = tid >> 6, lane = tid & 63, fr = lane & 15, fq = lane >> 4;
    u32x4 nzf = (u32x4){0u, 0u, 0u, 0u}, nzb = nzf, nv8 = nzf, nq8 = nzf, ng8 = nzf;
    if ((int)blockIdx.x < NBH * NCHO) { const int it = blockIdx.x, pc = it % NCHO + PC0, bh = it / NCHO, h = bh % HGH, b = bh / HGH;
        const bf16_t* pr = p.P + (size_t)(hg_row0(b, pc) + t) * INC + h * 64 + cg * 8; nzf = *(const u32x4*)(pr + OFF_); nzb = *(const u32x4*)(pr + OFB); nv8 = *(const u32x4*)(pr + OHI); nq8 = *(const u32x4*)(pr + OHQ); ng8 = *(const u32x4*)(pr + OHG_); }
    hg_stage_lb(tid, p, l);
    f32x4 hn0, hn1; { const float* nwp = p.hg_norm + l * 64 + cg * 8; hn0 = *(const f32x4*)nwp; hn1 = *(const f32x4*)(nwp + 4); }
    bf16x8 nbsin[4][2];
#define HG_LOADSIN(bhx, pcx) do { const bf16_t* SIN_ = p.SLOC + ((size_t)((wave >> 2) * NBH + (bhx)) * NCH + (pcx)) * 4096; \
        _Pragma("unroll") for (int vt = 0; vt < 4; ++vt) _Pragma("unroll") for (int ks = 0; ks < 2; ++ks) nbsin[vt][ks] = *(const bf16x8*)(SIN_ + (vt * 16 + fr) * 64 + ks * 32 + fq * 8); } while (0)
#pragma unroll
    for (int vt = 0; vt < 4; ++vt) { nbsin[vt][0] = (bf16x8){0, 0, 0, 0, 0, 0, 0, 0}; nbsin[vt][1] = nbsin[vt][0]; }
    if ((int)blockIdx.x < NBH * NCHO) { const int it = blockIdx.x; HG_LOADSIN(it / NCHO, it % NCHO + PC0); }
    for (int it = blockIdx.x; it < NBH * NCHO; it += gridDim.x) {
        const int pc = it % NCHO + PC0, bh = it / NCHO, h = bh % HGH, b = bh / HGH, row0 = hg_row0(b, pc);
        const u32x4 zf = nzf, zb = nzb, v8 = nv8, q8 = nq8, g8 = ng8;
        { const int it2 = it + gridDim.x; if (it2 < NBH * NCHO) { const int pc2 = it2 % NCHO + PC0, bh2 = it2 / NCHO, h2 = bh2 % HGH, b2 = bh2 / HGH;
            const bf16_t* pr = p.P + (size_t)(hg_row0(b2, pc2) + t) * INC + h2 * 64 + cg * 8; nzf = *(const u32x4*)(pr + OFF_); nzb = *(const u32x4*)(pr + OFB); nv8 = *(const u32x4*)(pr + OHI); nq8 = *(const u32x4*)(pr + OHQ); ng8 = *(const u32x4*)(pr + OHG_); } }
        bf16x8 bsin[4][2];
#pragma unroll
        for (int vt = 0; vt < 4; ++vt) { bsin[vt][0] = nbsin[vt][0]; bsin[vt][1] = nbsin[vt][1]; }
        { const int it2 = it + gridDim.x; if (it2 < NBH * NCHO) { const int pc2 = it2 % NCHO + PC0, bh2 = it2 / NCHO; HG_LOADSIN(bh2, pc2); } }
        hg_gates(tid, p, l, h, zf, zb, lds);
        if (stop_after == 1) { LDS_BAR(); continue; }
        {
            float w[6][8];
#pragma unroll
            for (int j = 0; j < 8; ++j) {
                const int k = cg * 8 + j;
                VT[TSW_E(k, t)] = (bf16_t)(j & 1 ? v8[j >> 1] >> 16 : v8[j >> 1] & 0xffffu);
                const float qv = bf8(q8, j) * 0.125f, af = AF[t * 65 + k], ab = AB[t * 65 + k], rf = AF[31 * 65 + k], rb = AB[32 * 65 + k];
                w[0][j] = qv * __expf(fminf(af - rf, 80.f)); w[1][j] = (1.f - FF[t * 65 + k]) * __expf(fminf(rf - af, 80.f)); w[2][j] = qv * __expf(af);
                w[3][j] = qv * __expf(fminf(ab - rb, 80.f)); w[4][j] = (1.f - FB[t * 65 + k]) * __expf(fminf(rb - ab, 80.f)); w[5][j] = qv * __expf(ab);
            }
#pragma unroll
            for (int a = 0; a < 6; ++a) { u32x4 o; o.x = cvt_pk_bf16(w[a][0], w[a][1]); o.y = cvt_pk_bf16(w[a][2], w[a][3]); o.z = cvt_pk_bf16(w[a][4], w[a][5]); o.w = cvt_pk_bf16(w[a][6], w[a][7]);
                *(LAS u32x4*)(lds + HG_T0 + a * HG_TS + t * 144 + cg * 16) = o; }
        }
        LDS_BAR();
        if (stop_after == 2) { LDS_BAR(); continue; }
        {
            const int dir = wave >> 2, tt = wave & 3;
            const LAS unsigned char* QT = lds + HG_T0 + (dir * 3 + 0) * HG_TS; const LAS unsigned char* KL = lds + HG_T0 + (dir * 3 + 1) * HG_TS; const LAS unsigned char* QH = lds + HG_T0 + (dir * 3 + 2) * HG_TS;
            bf16x8 bq[2], bh[2];
#pragma unroll
            for (int ks = 0; ks < 2; ++ks) { bq[ks] = *(const LAS bf16x8*)(QT + (tt * 16 + fr) * 144 + ks * 64 + fq * 16); bh[ks] = *(const LAS bf16x8*)(QH + (tt * 16 + fr) * 144 + ks * 64 + fq * 16); }
            f32x4 o[4];
#pragma unroll
            for (int vt = 0; vt < 4; ++vt) { o[vt] = (f32x4){0.f, 0.f, 0.f, 0.f};
#pragma unroll
                for (int ks = 0; ks < 2; ++ks) o[vt] = mfma16(bsin[vt][ks], bh[ks], o[vt]); }
            const int t_ = 16 * tt + fr;
#pragma unroll
            for (int kp = 0; kp < 2; ++kp) {
                f32x4 sc[2];
#pragma unroll
                for (int hf = 0; hf < 2; ++hf) { const int st = 2 * kp + hf;
                    sc[hf] = (f32x4){0.f, 0.f, 0.f, 0.f};
                    if (dir ? st >= tt : st <= tt) {
#pragma unroll
                        for (int ks = 0; ks < 2; ++ks) { const bf16x8 a = *(const LAS bf16x8*)(KL + (st * 16 + fr) * 144 + ks * 64 + fq * 16); sc[hf] = mfma16(a, bq[ks], sc[hf]); }
#pragma unroll
                        for (int r = 0; r < 4; ++r) { const int s_ = 16 * st + 4 * fq + r; const bool keep = dir ? (s_ >= t_) : (s_ <= t_); sc[hf][r] = keep ? sc[hf][r] : 0.f; }
                    } }
                if (dir ? (2 * kp + 1 >= tt) : (2 * kp <= tt)) {
                    u32x4 pw; pw.x = cvt_pk_bf16(sc[0][0], sc[0][1]); pw.y = cvt_pk_bf16(sc[0][2], sc[0][3]); pw.z = cvt_pk_bf16(sc[1][0], sc[1][1]); pw.w = cvt_pk_bf16(sc[1][2], sc[1][3]);
                    const bf16x8 pf = __builtin_bit_cast(bf16x8, pw);
                    const int s0 = 32 * kp + 4 * fq;
#pragma unroll
                    for (int vt = 0; vt < 4; ++vt) { const int v_ = 16 * vt + fr; const int sw = (v_ >> 3) & 7;
                        const LAS unsigned char* vr = lds + HG_VT + v_ * 144 + (s0 & 7) * 2;
                        const bf16x8 a = ld2x64(vr + (((s0 >> 3) ^ sw) << 4), vr + ((((s0 + 16) >> 3) ^ sw) << 4));
                        o[vt] = mfma16(a, pf, o[vt]); }
                }
            }
            LAS float* OOd = (LAS float*)(lds + (dir ? HG_FB : HG_FF));
#pragma unroll
            for (int vt = 0; vt < 4; ++vt)
#pragma unroll
                for (int r = 0; r < 4; ++r) OOd[t_ * 65 + 16 * vt + 4 * fq + r] = o[vt][r];
        }
        LDS_BAR();
        if (stop_after == 3) { LDS_BAR(); continue; }
        {
            float o[8]; float ss = 0.f;
#pragma unroll
            for (int j = 0; j < 8; ++j) { o[j] = FF[t * 65 + cg * 8 + j] + FB[t * 65 + cg * 8 + j]; ss += o[j] * o[j]; }
            ss += __builtin_bit_cast(float, __builtin_amdgcn_ds_swizzle(__builtin_bit_cast(int, ss), (1 << 10) | 0x1f));
            ss += __builtin_bit_cast(float, __builtin_amdgcn_ds_swizzle(__builtin_bit_cast(int, ss), (2 << 10) | 0x1f));
            ss += __builtin_bit_cast(float, __builtin_amdgcn_ds_swizzle(__builtin_bit_cast(int, ss), (4 << 10) | 0x1f));
            const float rstd = 1.f / sqrtf(ss * (1.f / 64.f) + EPS);
            float y[8];
#pragma unroll
            for (int j = 0; j < 8; ++j) { const float g = bf8(g8, j); y[j] = o[j] * rstd * (j < 4 ? hn0[j & 3] : hn1[j & 3]) * g * __builtin_amdgcn_rcpf(1.f + __expf(-g)); }
            u32x4 ov; ov.x = cvt_pk_bf16(y[0], y[1]); ov.y = cvt_pk_bf16(y[2], y[3]); ov.z = cvt_pk_bf16(y[4], y[5]); ov.w = cvt_pk_bf16(y[6], y[7]);
            if (stop_after == 5) *(u32x4*)(p.H + ((size_t)it * 64 + t) * 64 + cg * 8) = ov; else if (stop_after != 4) *(u32x4*)(p.MIX + (size_t)(row0 + t) * MIXD + 384 + h * 64 + cg * 8) = ov; else asm volatile("" :: "v"(ov));
        }
        LDS_BAR();
    }
}


#undef HG_LOADSIN
constexpr int AT_KC = 0, AT_VCT = 36864, AT_KL = AT_VCT + 64 * 528, AT_VL = AT_KL + 2 * 9216, AT_RPB = AT_VL + 2 * 9216, AT_END = AT_RPB + 1920;
static_assert(AT_END <= RING_BYTES && CTX == 256, "attention LDS layout (built for 256 context tokens)");
constexpr float ATHR = 6.f;
template <bool LOCAL, int NKB>
__device__ __forceinline__ void attn_step(const LAS unsigned char* Kb, const LAS unsigned char* Vb, int vstride, const bf16x8 (&qb)[2], f32x4 (&o)[4], float& m, float& lsum,
                                          int fr, int fq, int lane, const LAS float* rpb_row, const int (&boff)[8], const int (&voff)[4][2], int kbase) {
    f32x4 sc[2 * NKB];
#pragma unroll
    for (int mt = 0; mt < 2 * NKB; ++mt) { sc[mt] = (f32x4){0.f, 0.f, 0.f, 0.f};
#pragma unroll
        for (int ks = 0; ks < 2; ++ks) { const bf16x8 a = *(const LAS bf16x8*)(Kb + (16 * mt + fr) * 144 + ks * 64 + fq * 16); sc[mt] = mfma16(a, qb[ks], sc[mt]); } }
    float mx = -INFINITY;
#pragma unroll
    for (int mt = 0; mt < 2 * NKB; ++mt)
#pragma unroll
        for (int r = 0; r < 4; ++r) {
            float v = sc[mt][r];
            if (LOCAL) v += *(const LAS float*)((const LAS unsigned char*)rpb_row + boff[(4 * mt + r) & 7]);
            sc[mt][r] = v; mx = fmaxf(mx, v);
        }
    mx = fmaxf(mx, __builtin_bit_cast(float, __builtin_amdgcn_ds_swizzle(__builtin_bit_cast(int, mx), (16 << 10) | 0x1f)));
    mx = fmaxf(mx, __builtin_bit_cast(float, __builtin_amdgcn_ds_bpermute((lane ^ 32) << 2, __builtin_bit_cast(int, mx))));
    if (__builtin_amdgcn_ballot_w64(mx > m + ATHR) != 0ull) {
        const float mn = fmaxf(m, mx), corr = __builtin_amdgcn_exp2f(m - mn);
        m = mn; lsum *= corr;
#pragma unroll
        for (int dt = 0; dt < 4; ++dt) o[dt] = o[dt] * corr;
    }
    float ps = 0.f;
#pragma unroll
    for (int kb = 0; kb < NKB; ++kb) {
        float pv[8];
#pragma unroll
        for (int h2 = 0; h2 < 2; ++h2)
#pragma unroll
            for (int r = 0; r < 4; ++r) { const float e = __builtin_amdgcn_exp2f(sc[2 * kb + h2][r] - m); pv[4 * h2 + r] = e; ps += e; }
        u32x4 pw; pw.x = cvt_pk_bf16(pv[0], pv[1]); pw.y = cvt_pk_bf16(pv[2], pv[3]); pw.z = cvt_pk_bf16(pv[4], pv[5]); pw.w = cvt_pk_bf16(pv[6], pv[7]);
        const bf16x8 pf = __builtin_bit_cast(bf16x8, pw);
#pragma unroll
        for (int dt = 0; dt < 4; ++dt) {
            bf16x8 a;
            if (LOCAL) a = ld2x64(Vb + voff[dt][0], Vb + voff[dt][1]);
            else { const int d_ = 16 * dt + fr, sw_ = (d_ >> 3) & 7, c0_ = (kbase >> 3) + 4 * kb + (fq >> 1);
                const LAS unsigned char* vr = Vb + d_ * vstride + (fq & 1) * 8;
                a = ld2x64(vr + ((c0_ ^ sw_) << 4), vr + (((c0_ + 2) ^ sw_) << 4)); }
            o[dt] = mfma16(a, pf, o[dt]);
        }
    }
    lsum += ps;
}
__device__ __forceinline__ void phase_attn(const int tid, PRef p, int l, LAS unsigned char* lds) {
    const int wave = tid >> 6, lane = tid & 63, fr = lane & 15, fq = lane >> 4, skey = tid >> 3, sc8 = tid & 7;
    LAS float* RPB = (LAS float*)(lds + AT_RPB);
    constexpr int NPAIR = ROWS / 2; const int IPB = NPAIR + ((l + 1 < DEPTH) ? 2 : 0);
    const int G_ = gridDim.x, NIT = NB * NAH * IPB;
    const bool deal = (G_ == 256 && NIT <= 160 * 7 + 96 * 5);
    const int it_lo = deal ? ((int)blockIdx.x < 160 ? (int)blockIdx.x * 7 : 1120 + ((int)blockIdx.x - 160) * 5) : (int)blockIdx.x;
    const int it_n = deal ? ((int)blockIdx.x < 160 ? 7 : 5) : (NIT - (int)blockIdx.x + G_ - 1) / G_;
    int last_bh = -1;
#define AT_QTOK(itx) (((itx) % IPB) < NPAIR ? (((itx) / IPB) / NAH) * SEQ + (2 * ((itx) % IPB) + (wave >> 2)) * GW + 16 * (wave & 3) + fr : NLAT + (((itx) / IPB) / NAH) * CTX + ((((itx) % IPB) - NPAIR) * 128 + 16 * wave) + fr)
#define AT_LOADQ(itx, dst) do { const bf16_t* qp_ = p.P + (size_t)AT_QTOK(itx) * INC + OQ + (((itx) / IPB) % NAH) * 64 + fq * 8; dst[0] = *(const bf16x8*)qp_; dst[1] = *(const bf16x8*)(qp_ + 32); } while (0)
    bf16x8 qnx[2] = {(bf16x8){0, 0, 0, 0, 0, 0, 0, 0}, (bf16x8){0, 0, 0, 0, 0, 0, 0, 0}};
    { const int it0 = it_lo; if (it_n > 0 && it0 < NIT) AT_LOADQ(it0, qnx); }
    for (int ii = 0; ii < it_n; ++ii) {
        const int it = deal ? it_lo + ii : it_lo + ii * G_;
        if (it >= NIT) break;
        const int sub = it % IPB, bh = it / IPB, head = bh % NAH, b = bh / NAH;
        const bool islat = sub < NPAIR;
        const int r0 = 2 * sub, qr = r0 + (wave >> 2), jb = wave & 3;
        LDS_BAR();
        if (bh != last_bh) {
            last_bh = bh;
            for (int rnd = 0; rnd < 4; ++rnd) {
                const int key = skey + 64 * rnd; const bf16_t* src = p.P + (size_t)(NLAT + b * CTX + key) * INC + head * 64 + sc8 * 8;
                const u32x4 kv = *(const u32x4*)(src + OK_), vv = *(const u32x4*)(src + OV);
                *(LAS u32x4*)(lds + AT_KC + key * 144 + sc8 * 16) = kv;
#pragma unroll
                for (int j = 0; j < 8; ++j) *(LAS bf16_t*)(lds + AT_VCT + (sc8 * 8 + j) * 528 + ((((key >> 3) ^ sc8) << 4) + (key & 7) * 2)) = (bf16_t)(j & 1 ? vv[j >> 1] >> 16 : vv[j >> 1] & 0xffffu);
            }
            if (tid < 15 * 32) RPB[tid] = (tid & 31) < 31 ? p.rpb[((size_t)l * NAH + head) * 465 + (tid >> 5) * 31 + (tid & 31)] * 1.44269504089f : -INFINITY;
        }
        const int qtok = islat ? b * SEQ + qr * GW + 16 * jb + fr : NLAT + b * CTX + ((sub - NPAIR) * 128 + 16 * wave) + fr;
        bf16x8 qb[2]; qb[0] = qnx[0]; qb[1] = qnx[1];
        { const int itn = deal ? it + 1 : it + G_; if (ii + 1 < it_n && itn < NIT) AT_LOADQ(itn, qnx); }
        int krlo = 0, krhi = -1, rs = 0;
        if (islat) { int a = r0 - 4; a = a < 0 ? 0 : (a > ROWS - 8 ? ROWS - 8 : a); int c = r0 + 1 - 4; c = c < 0 ? 0 : (c > ROWS - 8 ? ROWS - 8 : c); krlo = a; krhi = c + 7;
            rs = qr - 4; rs = rs < 0 ? 0 : (rs > ROWS - 8 ? ROWS - 8 : rs); }
        u32x4 kA = (u32x4){0u, 0u, 0u, 0u}, vA = kA, kB = kA, vB = kA;
#define AT_LOADROW(row, kd, vd) do { const bf16_t* src_ = p.P + (size_t)(b * SEQ + (row) * GW + skey) * INC + head * 64 + sc8 * 8; kd = *(const u32x4*)(src_ + OK_); vd = *(const u32x4*)(src_ + OV); } while (0)
#define AT_STAGEROW(bufi, kd, vd) do { *(LAS u32x4*)(lds + AT_KL + (bufi) * 9216 + skey * 144 + sc8 * 16) = kd; \
        _Pragma("unroll") for (int j = 0; j < 8; ++j) *(LAS bf16_t*)(lds + AT_VL + (bufi) * 9216 + (sc8 * 8 + j) * 144 + ((((skey >> 3) ^ sc8) << 4) + (skey & 7) * 2)) = (bf16_t)(j & 1 ? vd[j >> 1] >> 16 : vd[j >> 1] & 0xffffu); } while (0)
        if (islat) { AT_LOADROW(krlo, kA, vA); AT_LOADROW(krlo + 1, kB, vB); }
        f32x4 o[4]; float m = -1e30f, lsum = 0.f;
#pragma unroll
        for (int dt = 0; dt < 4; ++dt) o[dt] = (f32x4){0.f, 0.f, 0.f, 0.f};
        LDS_BAR();
        const int bs = jb == 0 ? 0 : (jb == 1 ? 8 : (jb == 2 ? 24 : 32)), qc = 16 * jb + fr;
        int boff[8], voff[4][2];
        { int ws = qc - 8; ws = ws < 0 ? 0 : (ws > 48 ? 48 : ws);
#pragma unroll
          for (int j_ = 0; j_ < 8; ++j_) { const int kc = bs + 16 * (j_ >> 2) + 4 * fq + (j_ & 3); const bool ok = kc >= ws && kc < ws + 16; boff[j_] = (ok ? kc - qc + 15 : 31) * 4; asm volatile("" : "+v"(boff[j_])); }
#pragma unroll
          for (int dt = 0; dt < 4; ++dt) { const int d_ = 16 * dt + fr, sw_ = (d_ >> 3) & 7, c0_ = (bs >> 3) + (fq >> 1);
              voff[dt][0] = d_ * 144 + (fq & 1) * 8 + ((c0_ ^ sw_) << 4); voff[dt][1] = d_ * 144 + (fq & 1) * 8 + (((c0_ + 2) ^ sw_) << 4); asm volatile("" : "+v"(voff[dt][0]), "+v"(voff[dt][1])); } }
        for (int st = 0; st < 4; ++st)
            attn_step<false, 2>(lds + AT_KC + st * 64 * 144, lds + AT_VCT, 528, qb, o, m, lsum, fr, fq, lane, RPB, boff, voff, st * 64);
        if (islat) { AT_STAGEROW(0, kA, vA); kA = kB; vA = vB; if (krlo + 2 <= krhi) AT_LOADROW(krlo + 2, kB, vB); }
        LDS_BAR();
        for (int kr = krlo; kr <= krhi; ++kr) {
            const int buf = (kr - krlo) & 1;
            if (kr >= rs && kr < rs + 8)
                attn_step<true, 1>(lds + AT_KL + buf * 9216 + bs * 144, lds + AT_VL + buf * 9216, 144, qb, o, m, lsum, fr, fq, lane, RPB + (kr - qr + 7) * 32, boff, voff, bs);
            if (kr < krhi) { AT_STAGEROW(buf ^ 1, kA, vA); kA = kB; vA = vB; if (kr + 3 <= krhi) AT_LOADROW(kr + 3, kB, vB); }
            LDS_BAR();
        }
#undef AT_LOADROW
#undef AT_STAGEROW
        lsum += __builtin_bit_cast(float, __builtin_amdgcn_ds_swizzle(__builtin_bit_cast(int, lsum), (16 << 10) | 0x1f));
        lsum += __builtin_bit_cast(float, __builtin_amdgcn_ds_bpermute((lane ^ 32) << 2, __builtin_bit_cast(int, lsum)));
        const float inv = 1.f / lsum;
        bf16_t* orow = p.MIX + (size_t)qtok * MIXD + head * 64;
#pragma unroll
        for (int dt = 0; dt < 4; ++dt) { u32x2 w; w.x = cvt_pk_bf16(o[dt][0] * inv, o[dt][1] * inv); w.y = cvt_pk_bf16(o[dt][2] * inv, o[dt][3] * inv); *(u32x2*)(orow + 16 * dt + 4 * fq) = w; }
    }
}


#undef AT_QTOK
#undef AT_LOADQ
template <int MODE> __device__ __forceinline__ void mini_gemm(const int tid, PRef p, int l) {
    const int wave = tid >> 6, lane = tid & 63, fr = lane & 15, fq = lane >> 4;
    const int gw = blockIdx.x * NWAVES + wave, NGW = gridDim.x * NWAVES;
    constexpr int K = MODE == 3 ? ED : (MODE == 1 ? MIXD : D);
    constexpr int N = MODE == 0 ? INC : (MODE == 2 ? 2 * ED : D);
    constexpr int MROWS = MODE <= 1 ? NCTX : NSLOT_C;
    constexpr int NTC = MODE == 2 ? 2 : 1, TW = 16 * NTC;
    constexpr int NTN = N / TW, NT = (MROWS / 32) * NTN;
    for (int t = gw; t < NT; t += NGW) {
        const int rt = t / NTN, ct = t % NTN, c0 = ct * TW;
        const bf16_t* Bt; const bf16_t* arow[2];
        if (MODE == 0) { Bt = p.WIN_T; for (int mt = 0; mt < 2; ++mt) arow[mt] = p.H + (size_t)(NLAT + rt * 32 + 16 * mt + fr) * D; }
        else if (MODE == 1) { Bt = p.WOUT_T; for (int mt = 0; mt < 2; ++mt) arow[mt] = p.MIX + (size_t)(NLAT + rt * 32 + 16 * mt + fr) * MIXD; }
        else if (MODE == 2) { const int e = rt % NE; Bt = p.WGU_T + (size_t)e * 2 * ED * D;
            for (int mt = 0; mt < 2; ++mt) { int row = p.STOK[NSLOT_L + rt * 32 + 16 * mt + fr]; row = row < 0 ? 0 : (row >= NTOK ? NTOK - 1 : row); arow[mt] = p.H + (size_t)row * D; } }
        else { const int e = rt % NE; Bt = p.WD_T + (size_t)e * D * ED; for (int mt = 0; mt < 2; ++mt) arow[mt] = p.HID + (size_t)(NSLOT_L + rt * 32 + 16 * mt + fr) * ED; }
        const bf16_t* brow = Bt + (size_t)(c0 + fr) * K;
        f32x4 acc[2][NTC];
#pragma unroll
        for (int mt = 0; mt < 2; ++mt)
#pragma unroll
            for (int nt = 0; nt < NTC; ++nt) acc[mt][nt] = (f32x4){0.f, 0.f, 0.f, 0.f};
#pragma unroll 8
        for (int ks = 0; ks < K / 32; ++ks) {
            bf16x8 a[2], bfr[NTC];
#pragma unroll
            for (int mt = 0; mt < 2; ++mt) a[mt] = *(const bf16x8*)(arow[mt] + ks * 32 + fq * 8);
#pragma unroll
            for (int nt = 0; nt < NTC; ++nt) bfr[nt] = *(const bf16x8*)(brow + (size_t)(16 * nt) * K + ks * 32 + fq * 8);
#pragma unroll
            for (int mt = 0; mt < 2; ++mt)
#pragma unroll
                for (int nt = 0; nt < NTC; ++nt) acc[mt][nt] = mfma16(a[mt], bfr[nt], acc[mt][nt]);
        }
#pragma unroll
        for (int mt = 0; mt < 2; ++mt)
#pragma unroll
            for (int r = 0; r < 4; ++r) {
                const int lr = rt * 32 + 16 * mt + 4 * fq + r;
                if (MODE == 0) { bf16_t* o = p.P + (size_t)(NLAT + lr) * INC + c0 + fr;
#pragma unroll
                    for (int nt = 0; nt < NTC; ++nt) o[16 * nt] = f2bf(acc[mt][nt][r]); }
                else if (MODE == 1) { float* o = p.XC + (size_t)lr * D + c0 + fr; const float* g = p.MOD + ((size_t)l * 3 + 2) * NMOD + 2 * D + c0 + fr;
#pragma unroll
                    for (int nt = 0; nt < NTC; ++nt) o[16 * nt] += g[16 * nt] * acc[mt][nt][r]; }
                else if (MODE == 2) { bf16_t* o = p.HID + (size_t)(NSLOT_L + lr) * ED + c0 / 2 + fr;
#pragma unroll
                    for (int q = 0; q < NTC / 2; ++q) { const float g = acc[mt][2 * q][r], u = acc[mt][2 * q + 1][r]; o[16 * q] = f2bf(g / (1.f + __expf(-g)) * u); } }
                else { bf16_t* o = p.Y + (size_t)(NSLOT_L + lr) * D + c0 + fr; const float val = p.SVAL[NSLOT_L + lr];
#pragma unroll
                    for (int nt = 0; nt < NTC; ++nt) o[16 * nt] = f2bf(val * acc[mt][nt][r]); }
            }
    }
}


__device__ __forceinline__ void phase_conv(const int tid, PRef p, int l) {
    const float* w = p.conv_w + (size_t)l * 3 * CVD;
    for (long gid = (long)blockIdx.x * NTHR + tid; gid < (long)NTOK * (CVD / 8); gid += (long)gridDim.x * NTHR) {
        const int r = (int)(gid / (CVD / 8)), c8 = (int)(gid % (CVD / 8)) * 8;
        int t, T; if (r < NLAT) { t = r % SEQ; T = SEQ; } else { t = (r - NLAT) % CTX; T = CTX; }
        const bf16_t* pr = p.P + (size_t)r * INC + c8;
        float y[8];
#pragma unroll
        for (int j = 0; j < 8; ++j) y[j] = 0.f;
#pragma unroll
        for (int d = 0; d < 3; ++d) {
            const int tt = t + d - 1;
            if (tt >= 0 && tt < T) {
                const bf16_t* q = pr + (long)(d - 1) * INC; const u32x4 c = *(const u32x4*)(q + OCC), u = *(const u32x4*)(q + OCU);
                const f32x4 w0 = *(const f32x4*)(w + d * CVD + c8), w1 = *(const f32x4*)(w + d * CVD + c8 + 4);
#pragma unroll
                for (int j = 0; j < 8; ++j) y[j] += (j < 4 ? w0[j & 3] : w1[j & 3]) * bf8(c, j) * bf8(u, j);
            }
        }
        const u32x4 bg = *(const u32x4*)(pr + OCB);
        u32x4 o; o.x = cvt_pk_bf16(bf8(bg, 0) * y[0], bf8(bg, 1) * y[1]); o.y = cvt_pk_bf16(bf8(bg, 2) * y[2], bf8(bg, 3) * y[3]);
        o.z = cvt_pk_bf16(bf8(bg, 4) * y[4], bf8(bg, 5) * y[5]); o.w = cvt_pk_bf16(bf8(bg, 6) * y[6], bf8(bg, 7) * y[7]);
        *(u32x4*)(p.MIX + (size_t)r * MIXD + 768 + c8) = o;
    }
}
__device__ __forceinline__ void phase_qkprep(const int tid, PRef p, int l) {
    const int sub = tid & 7;
    constexpr int U = 4;
    const long ngroups = (long)NTOK * 12, gstride = ((long)gridDim.x * NTHR) >> 3;
    for (long g0 = ((long)blockIdx.x * NTHR + tid) >> 3; g0 < ngroups; g0 += gstride * U) {
        u32x4 raw[U]; bf16_t* ptr[U]; int rr[U]; int wh[U];
#pragma unroll
        for (int u = 0; u < U; ++u) { long g8 = g0 + u * gstride; const bool ok = g8 < ngroups; if (!ok) g8 = g0;
            rr[u] = ok ? (int)(g8 / 12) : -1; wh[u] = (int)(g8 % 12) / 6; const int head = (int)(g8 % 6);
            ptr[u] = p.P + (size_t)(g8 / 12) * INC + (wh[u] ? OK_ : OQ) + head * HD + sub * 8; raw[u] = *(const u32x4*)ptr[u]; }
#pragma unroll
        for (int u = 0; u < U; ++u) {
            const float* nw = (wh[u] ? p.k_norm : p.q_norm) + l * HD + sub * 8;
            float y[8]; float ss = 0.f;
#pragma unroll
            for (int j = 0; j < 8; ++j) { y[j] = bf8(raw[u], j); ss += y[j] * y[j]; }
            ss += __builtin_bit_cast(float, __builtin_amdgcn_ds_swizzle(__builtin_bit_cast(int, ss), (1 << 10) | 0x1f));
            ss += __builtin_bit_cast(float, __builtin_amdgcn_ds_swizzle(__builtin_bit_cast(int, ss), (2 << 10) | 0x1f));
            ss += __builtin_bit_cast(float, __builtin_amdgcn_ds_swizzle(__builtin_bit_cast(int, ss), (4 << 10) | 0x1f));
            const float rstd = 1.f / sqrtf(ss * (1.f / HD) + EPS);
#pragma unroll
            for (int j = 0; j < 8; ++j) y[j] = y[j] * rstd * nw[j];
            const int r = rr[u];
            const bool lat = r >= 0 && r < NLAT;
            const int t = lat ? r % SEQ : 0; const float pos = (sub & 4) ? (float)(t % GW) : (float)(t / GW);
            const bool second = (sub & 2) != 0;
#pragma unroll
            for (int j = 0; j < 8; ++j) {
                const float other = __builtin_bit_cast(float, __builtin_amdgcn_ds_swizzle(__builtin_bit_cast(int, y[j]), (2 << 10) | 0x1f));
                const int fi = (sub & 1) * 8 + j;
                const float ang = pos * __builtin_amdgcn_exp2f(-(float)fi * (13.287712379549449f / 16.f));
                const float cs = FCOS(ang), sn = FSIN(ang);
                const float rot = second ? y[j] * cs + other * sn : y[j] * cs - other * sn;
                y[j] = lat ? rot : y[j];
            }
            if (r >= 0) { u32x4 o; o.x = cvt_pk_bf16(y[0], y[1]); o.y = cvt_pk_bf16(y[2], y[3]); o.z = cvt_pk_bf16(y[4], y[5]); o.w = cvt_pk_bf16(y[6], y[7]); *(u32x4*)ptr[u] = o; }
        }
    }
}

__device__ __forceinline__ f32x4 bf4(const u32x2 w) { return (f32x4){bfw(w.x, 0), bfw(w.x, 1), bfw(w.y, 0), bfw(w.y, 1)}; }
template <int MODE> __device__ __forceinline__ void phase_rows(const int tid, PRef p, int l, LAS unsigned char* lds) {
    static_assert(D == 1024, "wave-per-row kernels assume D = 1024");
    const int lane = tid & 63, wave = tid >> 6;
#define RC(j) (8 * lane + 512 * ((j) >> 1) + 4 * ((j) & 1))
    if (MODE == 1) {
        for (int k = tid; k < D; k += NTHR) { const f32x4* src = (const f32x4*)(p.w_router + ((size_t)l * D + k) * NE); LAS f32x4* dst = (LAS f32x4*)(lds + k * 64 + (k >> 3) * 16);
#pragma unroll
            for (int u = 0; u < 4; ++u) dst[u] = src[u]; }
        __syncthreads();
    }
    const int gw = blockIdx.x * NWAVES + wave, NGW = gridDim.x * NWAVES;
    const int rw = ((NTOK + NGW - 1) / NGW + 1) & ~1;
    const int r_lo = gw * rw, r_hi = min(NTOK, r_lo + rw);
    const bool doh = MODE != 2 || l + 1 < DEPTH;
    const int ln = (MODE == 2 && l + 1 < DEPTH) ? l + 1 : l;
    const float* nw = (MODE == 1 ? p.norm2_w : p.norm1_w) + (size_t)ln * D;
    int curset = -1; f32x4 Av[4], Sv[4], Gv[4];
#pragma unroll
    for (int j = 0; j < 4; ++j) { Av[j] = (f32x4){0.f, 0.f, 0.f, 0.f}; Sv[j] = Av[j]; Gv[j] = Av[j]; }
    u32x4 vn[2][4]; int invn[2] = {-1, -1};
#define ROWS_LOADPAIR(rb) do { _Pragma("unroll") for (int i_ = 0; i_ < 2; ++i_) { const int rr_ = ((rb) + i_ < r_hi) ? (rb) + i_ : (rb); \
        if (MODE != 0 && rr_ < NLAT) { const bf16_t* src_ = p.XB + (size_t)rr_ * D + 8 * lane; vn[i_][0] = *(const u32x4*)src_; vn[i_][1] = *(const u32x4*)(src_ + 512); } \
        else { const float* src_ = MODE == 0 ? (rr_ < NLAT ? p.x + (size_t)rr_ * D : p.ctx + (size_t)(rr_ - NLAT) * D) : p.XC + (size_t)(rr_ - NLAT) * D; \
            _Pragma("unroll") for (int j_ = 0; j_ < 4; ++j_) vn[i_][j_] = *(const u32x4*)(src_ + RC(j_)); } \
        if (MODE == 2) invn[i_] = lane < NE ? p.INV[(size_t)rr_ * NE + lane] : -1; } } while (0)
#pragma unroll
    for (int i = 0; i < 2; ++i)
#pragma unroll
        for (int j = 0; j < 4; ++j) vn[i][j] = (u32x4){0u, 0u, 0u, 0u};
    if (r_lo < r_hi) ROWS_LOADPAIR(r_lo);
#pragma unroll 1
    for (int r = r_lo; r < r_hi; r += 2) {
        const bool two = r + 1 < r_hi;
        const bool lat = r < NLAT;
        const int set = modset(r);
        if (set != curset) { curset = set;
            const float* mod = p.MOD + ((size_t)ln * 3 + set) * NMOD; const float* shift = mod + (MODE == 1 ? 3 : 0) * D; const float* scale = mod + (MODE == 1 ? 4 : 1) * D;
            int lane2 = lane; asm volatile("" : "+v"(lane2));
#pragma unroll
            for (int j = 0; j < 4; ++j) { const int c = 8 * lane2 + 512 * (j >> 1) + 4 * (j & 1); const f32x4 w4 = *(const f32x4*)(nw + c), sc4 = *(const f32x4*)(scale + c); Av[j] = w4 * (sc4 + 1.f); Sv[j] = *(const f32x4*)(shift + c);
                if (MODE == 2) Gv[j] = *(const f32x4*)(p.MOD + ((size_t)l * 3 + set) * NMOD + 5 * D + c); } }
        f32x4 v[2][4]; int inv2[2];
#pragma unroll
        for (int i = 0; i < 2; ++i) { inv2[i] = invn[i];
            if (MODE != 0 && lat) {
#pragma unroll
                for (int jj = 0; jj < 2; ++jj) { const u32x4 w = vn[i][jj]; v[i][2 * jj] = (f32x4){bfw(w.x, 0), bfw(w.x, 1), bfw(w.y, 0), bfw(w.y, 1)}; v[i][2 * jj + 1] = (f32x4){bfw(w.z, 0), bfw(w.z, 1), bfw(w.w, 0), bfw(w.w, 1)}; }
            } else {
#pragma unroll
                for (int j = 0; j < 4; ++j) v[i][j] = __builtin_bit_cast(f32x4, vn[i][j]);
            } }
        if (r + 2 < r_hi) ROWS_LOADPAIR(r + 2);
        if (MODE == 2) {
#pragma unroll
            for (int i = 0; i < 2; ++i) {
                const int myinv = inv2[i];
                unsigned long long mask = __ballot(myinv >= 0 && myinv < NSLOT);
                f32x4 acc[4];
#pragma unroll
                for (int j = 0; j < 4; ++j) acc[j] = (f32x4){0.f, 0.f, 0.f, 0.f};
                while (mask) {
                    const int e0 = __builtin_ctzll(mask); mask &= mask - 1; const int s0 = __builtin_amdgcn_readlane(myinv, e0);
                    int s1 = -1; if (mask) { const int e1 = __builtin_ctzll(mask); mask &= mask - 1; s1 = __builtin_amdgcn_readlane(myinv, e1); }
                    u32x4 y0[2], y1[2];
#pragma unroll
                    for (int jj = 0; jj < 2; ++jj) y0[jj] = *(const u32x4*)(p.Y + (size_t)s0 * D + 8 * lane + 512 * jj);
                    if (s1 >= 0) {
#pragma unroll
                        for (int jj = 0; jj < 2; ++jj) y1[jj] = *(const u32x4*)(p.Y + (size_t)s1 * D + 8 * lane + 512 * jj);
                    }
#pragma unroll
                    for (int jj = 0; jj < 2; ++jj) { acc[2 * jj] = acc[2 * jj] + (f32x4){bfw(y0[jj].x, 0), bfw(y0[jj].x, 1), bfw(y0[jj].y, 0), bfw(y0[jj].y, 1)}; acc[2 * jj + 1] = acc[2 * jj + 1] + (f32x4){bfw(y0[jj].z, 0), bfw(y0[jj].z, 1), bfw(y0[jj].w, 0), bfw(y0[jj].w, 1)}; }
                    if (s1 >= 0) {
#pragma unroll
                        for (int jj = 0; jj < 2; ++jj) { acc[2 * jj] = acc[2 * jj] + (f32x4){bfw(y1[jj].x, 0), bfw(y1[jj].x, 1), bfw(y1[jj].y, 0), bfw(y1[jj].y, 1)}; acc[2 * jj + 1] = acc[2 * jj + 1] + (f32x4){bfw(y1[jj].z, 0), bfw(y1[jj].z, 1), bfw(y1[jj].w, 0), bfw(y1[jj].w, 1)}; }
                    }
                }
#pragma unroll
                for (int j = 0; j < 4; ++j) v[i][j] = v[i][j] + Gv[j] * acc[j];
            }
        }
        if (MODE == 0 || MODE == 2) {
            const bool fin = MODE == 2 && l + 1 == DEPTH;
#pragma unroll
            for (int i = 0; i < 2; ++i) if (i == 0 || two) {
                if (lat && !fin) {
#pragma unroll
                    for (int jj = 0; jj < 2; ++jj) { u32x4 o; o.x = cvt_pk_bf16(v[i][2 * jj][0], v[i][2 * jj][1]); o.y = cvt_pk_bf16(v[i][2 * jj][2], v[i][2 * jj][3]); o.z = cvt_pk_bf16(v[i][2 * jj + 1][0], v[i][2 * jj + 1][1]); o.w = cvt_pk_bf16(v[i][2 * jj + 1][2], v[i][2 * jj + 1][3]);
                        *(u32x4*)(p.XB + (size_t)(r + i) * D + 8 * lane + 512 * jj) = o; }
                } else if (lat || !fin) { float* dst = lat ? p.XL + (size_t)(r + i) * D : p.XC + (size_t)(r + i - NLAT) * D;
#pragma unroll
                    for (int j = 0; j < 4; ++j) *(f32x4*)(dst + RC(j)) = v[i][j]; }
            }
        }
        if (doh) {
            float ss[2];
#pragma unroll
            for (int i = 0; i < 2; ++i) { float a = 0.f;
#pragma unroll
                for (int j = 0; j < 4; ++j) a += (v[i][j][0] * v[i][j][0] + v[i][j][1] * v[i][j][1]) + (v[i][j][2] * v[i][j][2] + v[i][j][3] * v[i][j][3]);
                ss[i] = a; }
            ss[0] = wave_sum(ss[0], lane); ss[1] = wave_sum(ss[1], lane);
            const float rstd0 = 1.f / sqrtf(ss[0] * (1.f / D) + EPS), rstd1 = 1.f / sqrtf(ss[1] * (1.f / D) + EPS);
            f32x4 hh[2][4];
#pragma unroll
            for (int j = 0; j < 4; ++j) { hh[0][j] = v[0][j] * rstd0 * Av[j] + Sv[j]; hh[1][j] = v[1][j] * rstd1 * Av[j] + Sv[j]; }
#pragma unroll
            for (int i = 0; i < 2; ++i) if (i == 0 || two) {
#pragma unroll
                for (int jj = 0; jj < 2; ++jj) { u32x4 o; o.x = cvt_pk_bf16(hh[i][2 * jj][0], hh[i][2 * jj][1]); o.y = cvt_pk_bf16(hh[i][2 * jj][2], hh[i][2 * jj][3]); o.z = cvt_pk_bf16(hh[i][2 * jj + 1][0], hh[i][2 * jj + 1][1]); o.w = cvt_pk_bf16(hh[i][2 * jj + 1][2], hh[i][2 * jj + 1][3]);
                    *(u32x4*)(p.H + (size_t)(r + i) * D + 8 * lane + 512 * jj) = o; } }
            if (MODE == 1) {
                LAS float* red = (LAS float*)(lds + 70144 + wave * 4224);
#pragma unroll
                for (int i = 0; i < 2; ++i) {
                    float lg[NE];
#pragma unroll
                    for (int e = 0; e < NE; ++e) lg[e] = 0.f;
#pragma unroll
                    for (int j = 0; j < 4; ++j)
#pragma unroll
                        for (int q = 0; q < 4; ++q) { const int k = RC(j) + q; const LAS f32x4* wr = (const LAS f32x4*)(lds + k * 64 + (k >> 3) * 16); const float hv = hh[i][j][q];
#pragma unroll
                            for (int u = 0; u < 4; ++u) { const f32x4 w = wr[u]; lg[4 * u + 0] += hv * w[0]; lg[4 * u + 1] += hv * w[1]; lg[4 * u + 2] += hv * w[2]; lg[4 * u + 3] += hv * w[3]; } }
#pragma unroll
                    for (int e = 0; e < NE; ++e) red[e * 65 + lane] = lg[e];
                    asm volatile("" ::: "memory");
                    const int e2 = lane & 15, part = lane >> 4;
                    float t = 0.f;
#pragma unroll
                    for (int x = 0; x < 16; ++x) t += red[e2 * 65 + part * 16 + x];
                    asm volatile("" ::: "memory");
                    t += __builtin_bit_cast(float, __builtin_amdgcn_ds_swizzle(__builtin_bit_cast(int, t), (16 << 10) | 0x1f));
                    t += __builtin_bit_cast(float, __builtin_amdgcn_ds_bpermute((lane ^ 32) << 2, __builtin_bit_cast(int, t)));
#define SWZF(x, d) __builtin_bit_cast(float, __builtin_amdgcn_ds_swizzle(__builtin_bit_cast(int, (x)), ((d) << 10) | 0x1f))
                    float m = t;
                    m = fmaxf(m, SWZF(m, 1)); m = fmaxf(m, SWZF(m, 2)); m = fmaxf(m, SWZF(m, 4)); m = fmaxf(m, SWZF(m, 8));
                    const float ex = expf(t - m); float sm = ex;
                    sm += SWZF(sm, 1); sm += SWZF(sm, 2); sm += SWZF(sm, 4); sm += SWZF(sm, 8);
#undef SWZF
                    if (lane < NE && (i == 0 || two)) p.AFF[(size_t)(r + i) * NE + lane] = ex / sm;
                }
            }
        }
    }
#undef ROWS_LOADPAIR
#undef RC
    if (MODE == 1) __syncthreads();
}


__device__ __forceinline__ void phase_adaln(const int tid, PRef p, LAS unsigned char* lds) {
    static_assert(D == 1024 && NMOD % 256 == 0, "adaln layout");
    const int lane = tid & 63, wave = tid >> 6;
    LAS float* SC = (LAS float*)lds;
    LAS float* RED = (LAS float*)(lds + 16384);
    for (int i = tid; i < 3 * D; i += NTHR) { const int st = i / D, k = i % D; const float cv = st < 2 ? p.c[st * D + k] : p.c_ctx[k]; SC[i] = cv / (1.f + __expf(-cv)); }
    __syncthreads();
    constexpr int NCG = NMOD / 256;
    for (int item = blockIdx.x; item < DEPTH * NCG * 2; item += gridDim.x) {
        const int l = item / (NCG * 2), rem = item % (NCG * 2), cgp = rem >> 1, kh = rem & 1;
        const int kbase = kh * 512 + wave * 64;
        const float* wp = p.w_mod + ((size_t)l * D + kbase) * NMOD + cgp * 256 + 4 * lane;
        f32x4 acc[3];
#pragma unroll
        for (int st = 0; st < 3; ++st) acc[st] = (f32x4){0.f, 0.f, 0.f, 0.f};
#pragma unroll 16
        for (int kk = 0; kk < 64; ++kk) { const f32x4 w = *(const f32x4*)(wp + (size_t)kk * NMOD);
#pragma unroll
            for (int st = 0; st < 3; ++st) acc[st] = acc[st] + w * SC[st * D + kbase + kk]; }
#pragma unroll
        for (int st = 0; st < 3; ++st) *(LAS f32x4*)(RED + (wave * 3 + st) * 256 + 4 * lane) = acc[st];
        __syncthreads();
        for (int o = tid; o < 3 * 256; o += NTHR) { const int st = o >> 8, n = o & 255; float v = 0.f;
#pragma unroll
            for (int w8 = 0; w8 < 8; ++w8) v += RED[(w8 * 3 + st) * 256 + n];
            if (kh == 0) v += p.b_mod[(size_t)l * NMOD + cgp * 256 + n];
            atomicAdd(p.MOD + ((size_t)l * 3 + st) * NMOD + cgp * 256 + n, v); }
        __syncthreads();
    }
}

constexpr int NPL = 11, NPH = 1 + DEPTH * NPL;
struct Args { Params p; int ph_lo, ph_hi; };
__global__ void __launch_bounds__(NTHR, 2) mega_fwd(Args args) {
    LAS unsigned char* lds = (LAS unsigned char*)lds_raw;
    {
        const int tid0 = threadIdx.x;
        for (int u = tid0; u < (LDS_BYTES - LDSCTL_OFF) / 4; u += NTHR) ((LAS unsigned*)(lds + LDSCTL_OFF))[u] = 0u;
        __syncthreads();
    }
    int wslot = 0;
    { unsigned m_ = ~0u; asm volatile("" : "+s"(m_));
      const int simd = (int)(__builtin_amdgcn_s_getreg((1 << 11) | (4 << 6) | 4) & 3u);
      if (__builtin_amdgcn_mbcnt_hi(m_, __builtin_amdgcn_mbcnt_lo(m_, 0u)) == 0) wslot = simd + 4 * (int)__hip_atomic_fetch_add(((unsigned*)(lds_raw + MISC_OFF + 64)) + simd, 1u, __ATOMIC_RELAXED, __HIP_MEMORY_SCOPE_WORKGROUP); }
    wslot = __builtin_amdgcn_readfirstlane(wslot) & 7;
#define MY_TID(var) int var; { unsigned m_ = ~0u; asm volatile("" : "+s"(m_)); var = wslot * 64 + (int)__builtin_amdgcn_mbcnt_hi(m_, __builtin_amdgcn_mbcnt_lo(m_, 0u)); } asm volatile("" : "+v"(var))
    XcdBarrier bar; bar.bar = args.p.CTL; bar.x = 0;
    const bool multi = args.ph_hi - args.ph_lo > 1;
    if (multi) { MY_TID(t0); bar = xcd_barrier_post(args.p.CTL, t0 == 0); }
    const int G = gridDim.x;
    const int ph_lo = args.ph_lo, ph_hi = args.ph_hi;
#ifndef PHMASK
#define PHMASK 0xFFFF
#endif
#define PH_ON(k) ((k) == 0 ? (PHMASK & 1) : ((PHMASK >> (1 + ((k) - 1) % NPL)) & 1))
#ifndef REPMASK
#define REPMASK 0
#endif
#ifndef REP_LOCAL
#define REP_LOCAL 0
#define REP_CONV 0
#define REP_ATTN 0
#endif
#ifndef HG_STOP
#define HG_STOP 0
#endif
#ifndef REP_P0
#define REP_P0 0
#endif
#define REP_N(k) (((k) == 0 && REP_P0) ? 2 : (((k) > 0 && ((REPMASK >> (((k) - 1) % NPL)) & 1)) ? 2 : 1))
#define PH_BEGIN(k) if (PH_ON(k) && ph_lo <= (k) && (k) < ph_hi) { for (int rep_ = 0; rep_ < REP_N(k); ++rep_) { const AS4 Args* kp = (const AS4 Args*)__builtin_amdgcn_kernarg_segment_ptr(); asm volatile("" : "+s"(kp)); PRef p = kp->p; MY_TID(tid);
#define PH_END_IF(k, cond) } if ((cond) && (k) + 1 < ph_hi) { MY_TID(t1); xcd_barrier(bar, t1 == 0, XB_ST(lds_raw)); } }
#ifndef REP_CVT
#define REP_CVT 0
#endif
#ifndef REP_BAR
#define REP_BAR 0
#endif
#define PH_END(k) } if ((k) + 1 < ph_hi) { for (int rb_ = 0; rb_ < 1 + REP_BAR; ++rb_) { MY_TID(t1); xcd_barrier(bar, t1 == 0, XB_ST(lds_raw)); } } }
    PH_BEGIN(0)
        phase_adaln(tid, p, lds);
        run_items<b_lb>(tid, p, 0, 2L * 384, 0);
        phase_convert(tid, p, 0, lds, 1, 0);
    PH_END(0)
#define LAYER(l)                                                                                                                                     \
    PH_BEGIN(1 + (l) * NPL + 0) if ((l) == 0) { phase_rows<0>(tid, p, 0, lds); } PH_END_IF(1 + (l) * NPL + 0, (l) == 0)                                 \
    PH_BEGIN(1 + (l) * NPL + 1) {                                                                                                                    \
        pg8::Gemm g{p.H, p.WIN_T, NTOK, INC, D, nullptr, 0, 1, 0}; pg8::StaticOrder S; S.init(NTOK, INC, G, (int)blockIdx.x);                         \
        pg8::EpiP E{p.P, INC, p.q_norm + (l) * HD, p.k_norm + (l) * HD, rep_};                                                    \
        pg8::gemm_phase<pg8::EpiP, false>(tid, lds, g, S, E);                                                                                     \
        } PH_END(1 + (l) * NPL + 1)               \
    PH_BEGIN(1 + (l) * NPL + 2) if constexpr (!FUSE_QK) { phase_qkprep(tid, p, l); } if constexpr (FAST_HGRN && (HGRN_DIAG == 3 || HGRN_DIAG == 4)) { phase_hgrn_local(tid, p, l, lds); { MY_TID(t7); run_items<b_hgrn_local_slow>(t7, p, l, 2L * NBH * NCH * 64, 0); } } else if constexpr (FAST_HGRN && HGRN_DIAG >= 2) { run_items<b_hgrn_local_slow>(tid, p, l, 2L * NBH * NCH * 64, 0); } else if constexpr (FAST_HGRN) { for (int r2_ = 0; r2_ < 1 + REP_LOCAL; ++r2_) phase_hgrn_local(tid, p, l, lds); } else { run_items<b_gates>(tid, p, l, (long)NTOK * 768, 0); } phase_conv(tid, p, l); PH_END(1 + (l) * NPL + 2) \
    PH_BEGIN(1 + (l) * NPL + 3) if constexpr (FAST_HGRN && HGRN_DIAG) { run_items<b_hgrn_scan_slow>(tid, p, l, 2L * NBH * 4096, 0); } else if constexpr (FAST_HGRN) { phase_hgrn_scan(tid, p); } else { run_items<b_hgrn_seq2>(tid, p, l, 2L * NB * HGH * 64, 0); } if constexpr (FAST_ATTN) { for (int r4_ = 0; r4_ < 1 + REP_ATTN; ++r4_) { MY_TID(t6); phase_attn(t6, p, l, lds); } } else { run_items<b_attn>(tid, p, l, (long)NTOK * NAH, 0); } PH_END(1 + (l) * NPL + 3) \
    PH_BEGIN(1 + (l) * NPL + 4) if constexpr (FAST_HGRN && HGRN_DIAG) { run_items<b_hgrn_chunkseq>(tid, p, l, 2L * NBH * NCH * 64, 0); { MY_TID(t9); xcd_barrier(bar, t9 == 0, XB_ST(lds_raw)); } { MY_TID(t8); run_items<b_hgfin>(t8, p, l, (long)NTOK * HGH, 0); } } else if constexpr (FAST_HGRN) { phase_hgrn_out(tid, p, l, lds, rep_ ? HG_STOP : 0); } else { run_items<b_hgfin>(tid, p, l, (long)NTOK * HGH, 0); } PH_END(1 + (l) * NPL + 4)                                         \
    PH_BEGIN(1 + (l) * NPL + 5) {                                                                                                                    \
        pg8::Gemm g{p.MIX, p.WOUT_T, NLAT, D, MIXD, nullptr, 0, 1, 0}; pg8::StaticOrder S; S.init(NLAT, D, G, (int)blockIdx.x);                       \
        pg8::EpiRes E{p.XB, D, p.MOD + (size_t)(l) * 3 * NMOD + 2 * D, SEQ, (size_t)NMOD};                                                           \
        pg8::gemm_phase<pg8::EpiRes, false>(tid, lds, g, S, E);                                                                                      \
        if ((l) + 1 < DEPTH) { MY_TID(tid2); mini_gemm<1>(tid2, p, l); } } PH_END(1 + (l) * NPL + 5)                  \
    PH_BEGIN(1 + (l) * NPL + 6) phase_rows<1>(tid, p, l, lds); PH_END(1 + (l) * NPL + 6)                                                               \
    PH_BEGIN(1 + (l) * NPL + 7) if constexpr (FAST_TOPK) { phase_topk(tid, p, lds); if ((l) == 0 && gridDim.x > 2 * NB * NE + 32) { MY_TID(t4); phase_convert(t4, p, 0, lds, 2, 2 * NB * NE); } else if ((l) == 0) { MY_TID(t4); phase_convert(t4, p, 0, lds, 2, 0); } } else { run_items<b_rank>(tid, p, l, (long)NTOK * NE, 0); } PH_END(1 + (l) * NPL + 7)                                          \
    PH_BEGIN(1 + (l) * NPL + 8) {                                                                                                                    \
        pg8::Gemm g{p.H, p.WGU_T, NSLOT_L, 2 * ED, D, p.STOK, CAPL / 256, NE, (size_t)2 * ED * D * 2}; pg8::StaticOrder S; S.init(NSLOT_L, 2 * ED, G, (int)blockIdx.x); \
        pg8::EpiHid E{p.HID, ED};                                                                                                                    \
        pg8::gemm_phase<pg8::EpiHid, true>(tid, lds, g, S, E);                                                                                       \
        if ((l) + 1 < DEPTH) { MY_TID(tid2); mini_gemm<2>(tid2, p, l); } } PH_END(1 + (l) * NPL + 8)              \
    PH_BEGIN(1 + (l) * NPL + 9) {                                                                                                                    \
        pg8::Gemm g{p.HID, p.WD_T, NSLOT_L, D, ED, nullptr, CAPL / 256, NE, (size_t)D * ED * 2}; pg8::StaticOrder S; S.init(NSLOT_L, D, G, (int)blockIdx.x); \
        pg8::EpiBf16 E{p.Y, D, p.SVAL, 0};                                                                                                              \
        pg8::gemm_phase<pg8::EpiBf16, false>(tid, lds, g, S, E);                                                                                     \
        if ((l) + 1 < DEPTH) { MY_TID(tid2); mini_gemm<3>(tid2, p, l); } } PH_END(1 + (l) * NPL + 9)                \
    PH_BEGIN(1 + (l) * NPL + 10) phase_rows<2>(tid, p, l, lds); if ((l) + 1 < DEPTH) { for (int rc_ = 0; rc_ < 1 + REP_CVT; ++rc_) { MY_TID(t5); phase_convert(t5, p, (l) + 1, lds); } } PH_END(1 + (l) * NPL + 10)
#ifndef NLAYERS_BUILD
#define NLAYERS_BUILD DEPTH
#endif
    LAYER(0)
    if constexpr (NLAYERS_BUILD > 1) { LAYER(1) }
    if constexpr (NLAYERS_BUILD > 2) { LAYER(2) }
    if constexpr (NLAYERS_BUILD > 3) { LAYER(3) }
}

#ifndef MK_SPLIT
#define MK_SPLIT 0
#endif
extern "C" void kernel_launch(void* const* d_in, const int* in_sizes, int n_in, void* d_out, int out_size, void* d_ws, size_t ws_size,
                              hipStream_t stream) {
    static int grid = 0;
    if (grid == 0) {
        if (n_in != 20 || out_size != NLAT * D || ws_size < WS_END) { fprintf(stderr, "kernel_launch: unexpected problem (n_in %d out %d ws %zu need %zu)\n", n_in, out_size, ws_size, (size_t)WS_END); grid = -1; return; }
        int dev = 0, cus = 0;
        if (hipGetDevice(&dev) != hipSuccess || hipDeviceGetAttribute(&cus, hipDeviceAttributeMultiprocessorCount, dev) != hipSuccess) { grid = -1; return; }
        if (hipFuncSetAttribute((const void*)mega_fwd, hipFuncAttributeMaxDynamicSharedMemorySize, LDS_BYTES) != hipSuccess) { fprintf(stderr, "kernel_launch: hipFuncSetAttribute failed\n"); grid = -1; return; }
        int per_cu = 0;
        if (hipOccupancyMaxActiveBlocksPerMultiprocessor(&per_cu, (const void*)mega_fwd, NTHR, LDS_BYTES) != hipSuccess || per_cu < 1) { fprintf(stderr, "kernel_launch: occupancy query says %d\n", per_cu); }
        (void)hipGetLastError();
        grid = cus;
    }
    if (grid < 0) return;
    (void)hipMemsetAsync((char*)d_ws + WS_CTL, 0, WS_LB - WS_CTL, stream);
    Args a{};
    a.p = make_params(d_in, d_out, d_ws);
#if MK_SPLIT
    for (int ph = 0; ph < NPH; ++ph) { a.ph_lo = ph; a.ph_hi = ph + 1; hipLaunchKernelGGL(mega_fwd, dim3(grid), dim3(NTHR), LDS_BYTES, stream, a); }
#else
    a.ph_lo = 0; a.ph_hi = NPH;
    hipLaunchKernelGGL(mega_fwd, dim3(grid), dim3(NTHR), LDS_BYTES, stream, a);
#endif
}
#endif
```

```cpp
#ifndef CPU_SIM
#include <hip/hip_runtime.h>
#define BODY __device__ __forceinline__
#define FSIN(x) __sinf(x)
#define FCOS(x) __cosf(x)
#else
#include <cmath>
#include <cstdio>
#include <cstdlib>
#include <cstring>
#define BODY static inline
#define FSIN(x) sinf(x)
#define FCOS(x) cosf(x)
#endif
#include <stdint.h>
#include <stddef.h>

#ifndef CFG_D
#define CFG_D 1024
#define CFG_SEQ 16384
#define CFG_CTX 256
#define CFG_EDIM 512
#define CFG_DEPTH 4
#endif

typedef unsigned short bf16_t;

constexpr int D = CFG_D, NB = 2, SEQ = CFG_SEQ, DEPTH = CFG_DEPTH, GW = 64, ROWS = SEQ / GW, CTX = CFG_CTX;
constexpr int HD = 64, NAH = 6, HGH = 6, CVD = 256, MIXD = 1024, INC = 3840, NMOD = 6 * D;
constexpr int NE = 16, ED = CFG_EDIM, CAPL = 2 * SEQ / NE, CAPC = 2 * CTX / NE;
constexpr int NLAT = NB * SEQ, NCTX = NB * CTX, NTOK = NLAT + NCTX;
constexpr int NSLOT_L = NB * NE * CAPL, NSLOT_C = NB * NE * CAPC, NSLOT = NSLOT_L + NSLOT_C;
constexpr int OQ = 0, OK_ = 384, OV = 768, OHQ = 1152, OFF_ = 1536, OFB = 1920, OHI = 2304, OHG_ = 2688, OCB = 3072, OCC = 3328, OCU = 3584;
constexpr float EPS = 1e-6f;
constexpr int NCH = (CTX + SEQ) / 64, NCHC = CTX / 64, NBH = NB * HGH;

struct Params {
    const float *x, *c, *ctx, *c_ctx, *w_mod, *b_mod, *norm1_w, *w_in, *q_norm, *k_norm, *rpb, *lb_logits, *hg_norm, *conv_w, *w_out,
        *norm2_w, *w_router, *w_gate, *w_up, *w_down;
    float *XL, *XC, *MOD, *LB, *AFF, *SVAL, *FG, *OHG;
    bf16_t *H, *P, *MIX, *HID, *Y;
    int *STOK, *INV;
    bf16_t *WIN_T, *WOUT_T, *WGU_T, *WD_T;
    unsigned* CTL;
    bf16_t* SLOC;
    float* GDEC;
    bf16_t* XB;
};

#ifndef CPU_SIM
#define AS4 __attribute__((address_space(4)))
typedef const AS4 Params& PRef;
#else
typedef const Params& PRef;
#endif
BODY float bf2f(bf16_t v) { return __builtin_bit_cast(float, (unsigned)v << 16); }
BODY bf16_t f2bf(float f) { unsigned u = __builtin_bit_cast(unsigned, f); u += 0x7fffu + ((u >> 16) & 1u); return (bf16_t)(u >> 16); }
BODY float silu_f(float x) { return x / (1.f + expf(-x)); }
BODY float sigmoid_f(float x) { return 1.f / (1.f + expf(-x)); }
BODY int modset(int r) { return r < NLAT ? r / SEQ : 2; }
BODY float* xrow(PRef p, int r) { return r < NLAT ? p.XL + (size_t)r * D : p.XC + (size_t)(r - NLAT) * D; }

BODY void b_adaln(long gid, PRef p, int) {
    const int n = (int)(gid % NMOD), s = (int)((gid / NMOD) % 3), l = (int)(gid / (3 * NMOD));
    const float* cv = s < 2 ? p.c + s * D : p.c_ctx;
    const float* w = p.w_mod + (size_t)l * D * NMOD + n;
    float acc = 0.f;
    for (int k = 0; k < D; ++k) acc += silu_f(cv[k]) * w[(size_t)k * NMOD];
    p.MOD[gid] = acc + p.b_mod[l * NMOD + n];
}
BODY void b_lb(long gid, PRef p, int) {
    const int dir = (int)(gid / 384), j = (int)(gid % 384);
    const float* lg = p.lb_logits + (size_t)dir * DEPTH * 384 + j;
    float m = -INFINITY;
    for (int l = 0; l < DEPTH; ++l) m = fmaxf(m, lg[l * 384]);
    float s = 0.f;
    for (int l = 0; l < DEPTH; ++l) s += expf(lg[l * 384] - m);
    float cum = 0.f;
    p.LB[(dir * DEPTH + 0) * 384 + j] = 0.f;
    for (int l = 1; l < DEPTH; ++l) { cum += expf(lg[l * 384] - m) / s; p.LB[(dir * DEPTH + l) * 384 + j] = cum; }
}
BODY void b_copyx(long gid, PRef p, int) {
    if (gid < (long)NLAT * D) p.XL[gid] = p.x[gid]; else p.XC[gid - (long)NLAT * D] = p.ctx[gid - (long)NLAT * D];
}
template <int WHICH> BODY void b_prenorm(long gid, PRef p, int l) {
    const int r = (int)gid;
    const float* xr = xrow(p, r);
    const float* nw = (WHICH ? p.norm2_w : p.norm1_w) + l * D;
    const float* mod = p.MOD + ((size_t)l * 3 + modset(r)) * NMOD;
    const float* shift = mod + (WHICH ? 3 : 0) * D;
    const float* scale = mod + (WHICH ? 4 : 1) * D;
    float ss = 0.f;
    for (int k = 0; k < D; ++k) ss += xr[k] * xr[k];
    const float rstd = 1.f / sqrtf(ss / D + EPS);
    float lg[NE];
#pragma unroll
    for (int e = 0; e < NE; ++e) lg[e] = 0.f;
    for (int k = 0; k < D; ++k) {
        const float h = xr[k] * rstd * nw[k] * (1.f + scale[k]) + shift[k];
        p.H[(size_t)r * D + k] = f2bf(h);
        if (WHICH) {
            const float* wr = p.w_router + ((size_t)l * D + k) * NE;
#pragma unroll
            for (int e = 0; e < NE; ++e) lg[e] += h * wr[e];
        }
    }
    if (WHICH) {
        float m = lg[0];
#pragma unroll
        for (int e = 1; e < NE; ++e) m = fmaxf(m, lg[e]);
        float s = 0.f;
#pragma unroll
        for (int e = 0; e < NE; ++e) { lg[e] = expf(lg[e] - m); s += lg[e]; }
#pragma unroll
        for (int e = 0; e < NE; ++e) p.AFF[(size_t)r * NE + e] = lg[e] / s;
    }
}
BODY void b_gemm_in(long gid, PRef p, int l) {
    const int r = (int)(gid / (INC / 4)), n = (int)(gid % (INC / 4)) * 4;
    const bf16_t* a = p.H + (size_t)r * D;
    const float* w = p.w_in + (size_t)l * D * INC + n;
    float a0 = 0.f, a1 = 0.f, a2 = 0.f, a3 = 0.f;
    for (int k = 0; k < D; ++k) { const float av = bf2f(a[k]); const float* wk = w + (size_t)k * INC; a0 += av * wk[0]; a1 += av * wk[1]; a2 += av * wk[2]; a3 += av * wk[3]; }
    bf16_t* o = p.P + (size_t)r * INC + n;
    o[0] = f2bf(a0); o[1] = f2bf(a1); o[2] = f2bf(a2); o[3] = f2bf(a3);
}
BODY void b_qkprep(long gid, PRef p, int l) {
    const int r = (int)(gid / 12), which = (int)(gid % 12) / 6, head = (int)(gid % 6);
    bf16_t* ptr = p.P + (size_t)r * INC + (which ? OK_ : OQ) + head * HD;
    const float* nw = (which ? p.k_norm : p.q_norm) + l * HD;
    float y[HD];
    float ss = 0.f;
#pragma unroll
    for (int d = 0; d < HD; ++d) { y[d] = bf2f(ptr[d]); ss += y[d] * y[d]; }
    const float rstd = 1.f / sqrtf(ss / HD + EPS);
#pragma unroll
    for (int d = 0; d < HD; ++d) y[d] = y[d] * rstd * nw[d];
    if (r < NLAT) {
        const int t = r % SEQ; const float row = (float)(t / GW), col = (float)(t % GW);
#pragma unroll
        for (int d = 0; d < 16; ++d) {
            const float inv = powf(10000.f, -(float)d / 16.f);
            const float ar = row * inv, ac = col * inv;
            const float cr = FCOS(ar), sr = FSIN(ar), cc = FCOS(ac), sc = FSIN(ac);
            const float x0 = y[d], x1 = y[d + 16], x2 = y[d + 32], x3 = y[d + 48];
            y[d] = x0 * cr - x1 * sr; y[d + 16] = x1 * cr + x0 * sr; y[d + 32] = x2 * cc - x3 * sc; y[d + 48] = x3 * cc + x2 * sc;
        }
    }
#pragma unroll
    for (int d = 0; d < HD; ++d) ptr[d] = f2bf(y[d]);
}
BODY void b_attn(long gid, PRef p, int l) {
    const int r = (int)(gid / NAH), head = (int)(gid % NAH);
    float q[HD], acc[HD];
    const bf16_t* qp = p.P + (size_t)r * INC + OQ + head * HD;
#pragma unroll
    for (int d = 0; d < HD; ++d) { q[d] = bf2f(qp[d]) * 0.125f; acc[d] = 0.f; }
    float m = -INFINITY, s = 0.f;
    const int b = r < NLAT ? r / SEQ : (r - NLAT) / CTX;
    const int nloc = r < NLAT ? 128 : 0;
    int row = 0, col = 0, rs = 0, ws = 0;
    if (r < NLAT) { const int t = r % SEQ; row = t / GW; col = t % GW; rs = row - 4; rs = rs < 0 ? 0 : (rs > ROWS - 8 ? ROWS - 8 : rs); ws = col - 8; ws = ws < 0 ? 0 : (ws > GW - 16 ? GW - 16 : ws); }
    for (int j = 0; j < nloc + CTX; ++j) {
        int kr; float bias = 0.f;
        if (j < nloc) { const int i = j / 16, jj = j % 16; kr = b * SEQ + (rs + i) * GW + ws + jj; bias = p.rpb[(((size_t)l * NAH + head) * 15 + (rs + i - row + 7)) * 31 + (ws + jj - col + 15)]; }
        else kr = NLAT + b * CTX + (j - nloc);
        const bf16_t* kp = p.P + (size_t)kr * INC + OK_ + head * HD;
        const bf16_t* vp = p.P + (size_t)kr * INC + OV + head * HD;
        float sc = 0.f;
#pragma unroll
        for (int d = 0; d < HD; ++d) sc += q[d] * bf2f(kp[d]);
        sc += bias;
        const float mn = fmaxf(m, sc), corr = expf(m - mn), pj = expf(sc - mn);
        s = s * corr + pj;
#pragma unroll
        for (int d = 0; d < HD; ++d) acc[d] = acc[d] * corr + pj * bf2f(vp[d]);
        m = mn;
    }
    const float inv = 1.f / s;
    bf16_t* o = p.MIX + (size_t)r * MIXD + head * HD;
#pragma unroll
    for (int d = 0; d < HD; ++d) o[d] = f2bf(acc[d] * inv);
}
BODY void b_gates(long gid, PRef p, int l) {
    const int j = (int)(gid % 384), dir = (int)((gid / 384) % 2), r = (int)(gid / 768);
    const float z = bf2f(p.P[(size_t)r * INC + (dir ? OFB : OFF_) + j]);
    const float lbv = p.LB[(dir * DEPTH + l) * 384 + j];
    p.FG[gid] = lbv + (1.f - lbv) * sigmoid_f(z);
}
template <int DIR> BODY void b_hgrn_seq(long gid, PRef p, int) {
    const int v = (int)(gid % 64), h = (int)((gid / 64) % HGH), b = (int)(gid / (64 * HGH));
    float S[64];
#pragma unroll
    for (int k = 0; k < 64; ++k) S[k] = 0.f;
    for (int step = 0; step < CTX + SEQ; ++step) {
        int r;
        if (step < CTX) r = NLAT + b * CTX + (DIR ? CTX - 1 - step : step);
        else r = b * SEQ + (DIR ? SEQ - 1 - (step - CTX) : (step - CTX));
        const float vv = bf2f(p.P[(size_t)r * INC + OHI + h * 64 + v]);
        const float* fr = p.FG + ((size_t)r * 2 + DIR) * 384 + h * 64;
        const bf16_t* qr = p.P + (size_t)r * INC + OHQ + h * 64;
        float o = 0.f;
#pragma unroll
        for (int k = 0; k < 64; ++k) { const float f = fr[k]; S[k] = f * S[k] + (1.f - f) * vv; o += S[k] * bf2f(qr[k]); }
        o *= 0.125f;
        p.OHG[((size_t)DIR * NTOK + r) * 384 + h * 64 + v] = o;
    }
}
BODY void b_hgfin(long gid, PRef p, int l) {
    const int r = (int)(gid / HGH), h = (int)(gid % HGH);
    const float* op = p.OHG + (size_t)r * 384 + h * 64;
    const float* op1 = op + (size_t)NTOK * 384;
    float o[64]; float ss = 0.f;
#pragma unroll
    for (int v = 0; v < 64; ++v) { o[v] = op[v] + op1[v]; ss += o[v] * o[v]; }
    const float rstd = 1.f / sqrtf(ss / 64.f + EPS);
    const bf16_t* g = p.P + (size_t)r * INC + OHG_ + h * 64;
    bf16_t* out = p.MIX + (size_t)r * MIXD + 384 + h * 64;
#pragma unroll
    for (int v = 0; v < 64; ++v) out[v] = f2bf(o[v] * rstd * p.hg_norm[l * 64 + v] * silu_f(bf2f(g[v])));
}
BODY void b_conv(long gid, PRef p, int l) {
    const int ch = (int)(gid % CVD), r = (int)(gid / CVD);
    int t, T;
    if (r < NLAT) { t = r % SEQ; T = SEQ; } else { t = (r - NLAT) % CTX; T = CTX; }
    const float* w = p.conv_w + (size_t)l * 3 * CVD + ch;
    float y = 0.f;
    for (int j = 0; j < 3; ++j) {
        const int tt = t + j - 1;
        if (tt < 0 || tt >= T) continue;
        const bf16_t* pr = p.P + (size_t)(r + j - 1) * INC;
        y += w[j * CVD] * bf2f(pr[OCC + ch]) * bf2f(pr[OCU + ch]);
    }
    p.MIX[(size_t)r * MIXD + 768 + ch] = f2bf(bf2f(p.P[(size_t)r * INC + OCB + ch]) * y);
}
BODY void b_gemm_out(long gid, PRef p, int l) {
    const int r = (int)(gid / (D / 4)), n = (int)(gid % (D / 4)) * 4;
    const bf16_t* a = p.MIX + (size_t)r * MIXD;
    const float* w = p.w_out + (size_t)l * MIXD * D + n;
    float a0 = 0.f, a1 = 0.f, a2 = 0.f, a3 = 0.f;
    for (int k = 0; k < MIXD; ++k) { const float av = bf2f(a[k]); const float* wk = w + (size_t)k * D; a0 += av * wk[0]; a1 += av * wk[1]; a2 += av * wk[2]; a3 += av * wk[3]; }
    const float* g = p.MOD + ((size_t)l * 3 + modset(r)) * NMOD + 2 * D + n;
    float* xr = xrow(p, r) + n;
    xr[0] += g[0] * a0; xr[1] += g[1] * a1; xr[2] += g[2] * a2; xr[3] += g[3] * a3;
}
BODY void b_rank(long gid, PRef p, int) {
    const int e = (int)(gid % NE), r = (int)(gid / NE);
    int t, T, row0, cap, base;
    if (r < NLAT) { const int b = r / SEQ; t = r % SEQ; T = SEQ; row0 = b * SEQ; cap = CAPL; base = (b * NE + e) * CAPL; }
    else { const int b = (r - NLAT) / CTX; t = (r - NLAT) % CTX; T = CTX; row0 = NLAT + b * CTX; cap = CAPC; base = NSLOT_L + (b * NE + e) * CAPC; }
    const float a = p.AFF[(size_t)r * NE + e];
    const float* col = p.AFF + (size_t)row0 * NE + e;
    int rank = 0;
    for (int tt = 0; tt < T; ++tt) { const float o = col[(size_t)tt * NE]; rank += (o > a || (o == a && tt < t)) ? 1 : 0; }
    if (rank < cap) { p.STOK[base + rank] = r; p.SVAL[base + rank] = a; p.INV[(size_t)r * NE + e] = base + rank; }
    else p.INV[(size_t)r * NE + e] = -1;
}
BODY int slot_expert(int s) { return s < NSLOT_L ? (s / CAPL) % NE : ((s - NSLOT_L) / CAPC) % NE; }
BODY void b_moe1(long gid, PRef p, int l) {
    const int s = (int)(gid / (ED / 4)), f = (int)(gid % (ED / 4)) * 4;
    const int e = slot_expert(s); int row = p.STOK[s]; row = row < 0 ? 0 : (row >= NTOK ? NTOK - 1 : row);
    const bf16_t* a = p.H + (size_t)row * D;
    const float* wg = p.w_gate + ((size_t)l * NE + e) * D * ED + f;
    const float* wu = p.w_up + ((size_t)l * NE + e) * D * ED + f;
    float g0 = 0.f, g1 = 0.f, g2 = 0.f, g3 = 0.f, u0 = 0.f, u1 = 0.f, u2 = 0.f, u3 = 0.f;
    for (int k = 0; k < D; ++k) {
        const float av = bf2f(a[k]); const float* gk = wg + (size_t)k * ED; const float* uk = wu + (size_t)k * ED;
        g0 += av * gk[0]; g1 += av * gk[1]; g2 += av * gk[2]; g3 += av * gk[3];
        u0 += av * uk[0]; u1 += av * uk[1]; u2 += av * uk[2]; u3 += av * uk[3];
    }
    bf16_t* o = p.HID + (size_t)s * ED + f;
    o[0] = f2bf(silu_f(g0) * u0); o[1] = f2bf(silu_f(g1) * u1); o[2] = f2bf(silu_f(g2) * u2); o[3] = f2bf(silu_f(g3) * u3);
}
BODY void b_moe2(long gid, PRef p, int l) {
    const int s = (int)(gid / (D / 4)), n = (int)(gid % (D / 4)) * 4;
    const int e = slot_expert(s);
    const bf16_t* a = p.HID + (size_t)s * ED;
    const float* w = p.w_down + ((size_t)l * NE + e) * ED * D + n;
    float a0 = 0.f, a1 = 0.f, a2 = 0.f, a3 = 0.f;
    for (int k = 0; k < ED; ++k) { const float av = bf2f(a[k]); const float* wk = w + (size_t)k * D; a0 += av * wk[0]; a1 += av * wk[1]; a2 += av * wk[2]; a3 += av * wk[3]; }
    const float val = p.SVAL[s];
    bf16_t* o = p.Y + (size_t)s * D + n;
    o[0] = f2bf(val * a0); o[1] = f2bf(val * a1); o[2] = f2bf(val * a2); o[3] = f2bf(val * a3);
}
BODY void b_combine(long gid, PRef p, int l) {
    const int r = (int)(gid / (D / 4)), n = (int)(gid % (D / 4)) * 4;
    float a0 = 0.f, a1 = 0.f, a2 = 0.f, a3 = 0.f;
    for (int e = 0; e < NE; ++e) {
        const int s = p.INV[(size_t)r * NE + e];
        if (s >= 0) { const bf16_t* y = p.Y + (size_t)s * D + n; a0 += bf2f(y[0]); a1 += bf2f(y[1]); a2 += bf2f(y[2]); a3 += bf2f(y[3]); }
    }
    const float* g = p.MOD + ((size_t)l * 3 + modset(r)) * NMOD + 5 * D + n;
    float* xr = xrow(p, r) + n;
    xr[0] += g[0] * a0; xr[1] += g[1] * a1; xr[2] += g[2] * a2; xr[3] += g[3] * a3;
}


#ifndef HGRN_DIAG
#define HGRN_DIAG 0
#endif
BODY void b_hgrn_chunkseq(long gid, PRef p, int l) {
    const int v = (int)(gid % 64), pc = (int)((gid / 64) % NCH), bh = (int)((gid / (64 * NCH)) % NBH), dir = (int)(gid / (64L * NCH * NBH));
    const int h = bh % HGH, b = bh / HGH, row0 = pc < NCHC ? NLAT + b * CTX + pc * 64 : b * SEQ + (pc - NCHC) * 64;
    const bf16_t* sin = p.SLOC + ((size_t)(dir * NBH + bh) * NCH + pc) * 4096 + v * 64;
    float S[64];
#pragma unroll
    for (int k = 0; k < 64; ++k) S[k] = bf2f(sin[k]);
    for (int i = 0; i < 64; ++i) {
        const int r = row0 + (dir ? 63 - i : i);
        const float vv = bf2f(p.P[(size_t)r * INC + OHI + h * 64 + v]);
        const bf16_t* zr = p.P + (size_t)r * INC + (dir ? OFB : OFF_) + h * 64;
        const bf16_t* qr = p.P + (size_t)r * INC + OHQ + h * 64;
        const float* lb = p.LB + (size_t)(dir * DEPTH + l) * 384 + h * 64;
        float o = 0.f;
#pragma unroll
        for (int k = 0; k < 64; ++k) { const float f = lb[k] + (1.f - lb[k]) * sigmoid_f(bf2f(zr[k])); S[k] = f * S[k] + (1.f - f) * vv; o += S[k] * bf2f(qr[k]); }
        p.OHG[((size_t)dir * NTOK + r) * 384 + h * 64 + v] = o * 0.125f;
    }
}

BODY void b_hgrn_scan_slow(long gid, PRef p, int) {
    const int e = (int)(gid % 4096), sq = (int)(gid / 4096), dir = sq / NBH, k = e & 63;
    bf16_t* S = p.SLOC + (size_t)sq * NCH * 4096 + e;
    const float* G = p.GDEC + (size_t)sq * NCH * 64 + k;
    float c = 0.f;
    for (int j = 0; j < NCH; ++j) {
        const int pc = dir ? (j < NCHC ? NCHC - 1 - j : NCH + NCHC - 1 - j) : j;
        const float x = bf2f(S[(size_t)pc * 4096]);
        S[(size_t)pc * 4096] = f2bf(c);
        c = G[(size_t)pc * 64] * c + x;
    }
}

BODY void b_hgrn_local_slow(long gid, PRef p, int l) {
    const int v = (int)(gid % 64), pc = (int)((gid / 64) % NCH), bh = (int)((gid / (64 * NCH)) % NBH), dir = (int)(gid / (64L * NCH * NBH));
    const int h = bh % HGH, b = bh / HGH, row0 = pc < NCHC ? NLAT + b * CTX + pc * 64 : b * SEQ + (pc - NCHC) * 64;
    float S[64], g[64];
#pragma unroll
    for (int k = 0; k < 64; ++k) { S[k] = 0.f; g[k] = 1.f; }
    for (int i = 0; i < 64; ++i) {
        const int r = row0 + (dir ? 63 - i : i);
        const float vv = bf2f(p.P[(size_t)r * INC + OHI + h * 64 + v]);
        const bf16_t* zr = p.P + (size_t)r * INC + (dir ? OFB : OFF_) + h * 64;
        const float* lb = p.LB + (size_t)(dir * DEPTH + l) * 384 + h * 64;
#pragma unroll
        for (int k = 0; k < 64; ++k) { const float f = lb[k] + (1.f - lb[k]) * sigmoid_f(bf2f(zr[k])); S[k] = f * S[k] + (1.f - f) * vv; g[k] *= f; }
    }
    bf16_t* dst = p.SLOC + ((size_t)(dir * NBH + bh) * NCH + pc) * 4096 + v * 64;
    if (HGRN_DIAG != 3 && HGRN_DIAG != 4) {
#pragma unroll
    for (int k = 0; k < 64; ++k) dst[k] = f2bf(S[k]);
    }
    if (v == 0) {
        float* gd = p.GDEC + ((size_t)(dir * NBH + bh) * NCH + pc) * 64;
#pragma unroll
        for (int k = 0; k < 64; ++k) gd[k] = g[k];
    }
}
#ifndef FAST_TOPK
#define FAST_TOPK 1
#endif
#ifndef FAST_HGRN
#define FAST_HGRN 1
#endif
#ifndef FAST_ATTN
#define FAST_ATTN 1
#endif
constexpr size_t al256(size_t x) { return (x + 255) & ~(size_t)255; }
constexpr size_t CTL_BYTES = 65536;
constexpr size_t WS_CTL = 0;
constexpr size_t WS_MOD = WS_CTL + CTL_BYTES;
constexpr size_t WS_LB = WS_MOD + al256((size_t)DEPTH * 3 * NMOD * 4);
constexpr size_t WS_XC = WS_LB + al256((size_t)2 * DEPTH * 384 * 4);
constexpr size_t WS_AFF = WS_XC + al256((size_t)NCTX * D * 4);
constexpr size_t WS_SVAL = WS_AFF + al256((size_t)NTOK * NE * 4);
constexpr size_t WS_STOK = WS_SVAL + al256((size_t)NSLOT * 4);
constexpr size_t WS_INV = WS_STOK + al256((size_t)NSLOT * 4);
constexpr size_t WS_H = WS_INV + al256((size_t)NTOK * NE * 4);
constexpr size_t WS_MIX = WS_H + al256((size_t)NTOK * D * 2);
constexpr size_t WS_P = WS_MIX + al256((size_t)NTOK * MIXD * 2);
constexpr size_t WS_HID = WS_P;
constexpr size_t WS_Y = WS_HID + al256((size_t)NSLOT * ED * 2);
constexpr size_t WS_P_END0 = WS_P + al256((size_t)NTOK * INC * 2);
constexpr size_t WS_P_END1 = WS_Y + al256((size_t)NSLOT * D * 2);
constexpr size_t WS_WB = WS_P_END0 > WS_P_END1 ? WS_P_END0 : WS_P_END1;
constexpr size_t WS_WIN_T = WS_WB;
constexpr size_t WS_WOUT_T = WS_WIN_T + al256((size_t)INC * D * 2);
constexpr size_t WS_WGU_T = WS_WOUT_T + al256((size_t)D * MIXD * 2);
constexpr size_t WS_WD_T = WS_WGU_T + al256((size_t)NE * 2 * ED * D * 2);
constexpr size_t WS_T = WS_WD_T + al256((size_t)NE * D * ED * 2);
#if FAST_HGRN
constexpr size_t WS_SLOC = WS_T;
constexpr size_t WS_GDEC = WS_SLOC + al256((size_t)2 * NBH * NCH * 4096 * 2);
constexpr size_t WS_OHG = WS_GDEC + al256((size_t)2 * NBH * NCH * 64 * 4);
constexpr size_t WS_XB = WS_OHG + (HGRN_DIAG ? al256((size_t)2 * NTOK * 384 * 4) : 0);
constexpr size_t WS_END = WS_XB + al256((size_t)NLAT * D * 2);
constexpr size_t WS_FG = WS_T;
#else
constexpr size_t WS_FG = WS_T;
constexpr size_t WS_OHG = WS_FG + al256((size_t)NTOK * 768 * 4);
constexpr size_t WS_SLOC = WS_OHG + al256((size_t)2 * NTOK * 384 * 4);
constexpr size_t WS_GDEC = WS_SLOC;
constexpr size_t WS_XB = WS_SLOC;
constexpr size_t WS_END = WS_XB + al256((size_t)NLAT * D * 2);
#endif

static inline Params make_params(void* const* d_in, void* d_out, void* d_ws) {
    Params p{};
    const float** f = (const float**)&p;
    for (int i = 0; i < 20; ++i) f[i] = (const float*)d_in[i];
    char* ws = (char*)d_ws;
    p.XL = (float*)d_out; p.XC = (float*)(ws + WS_XC); p.MOD = (float*)(ws + WS_MOD); p.LB = (float*)(ws + WS_LB); p.AFF = (float*)(ws + WS_AFF);
    p.SVAL = (float*)(ws + WS_SVAL); p.FG = (float*)(ws + WS_FG); p.OHG = (float*)(ws + WS_OHG);
    p.H = (bf16_t*)(ws + WS_H); p.P = (bf16_t*)(ws + WS_P); p.MIX = (bf16_t*)(ws + WS_MIX); p.HID = (bf16_t*)(ws + WS_HID); p.Y = (bf16_t*)(ws + WS_Y);
    p.STOK = (int*)(ws + WS_STOK); p.INV = (int*)(ws + WS_INV);
    p.WIN_T = (bf16_t*)(ws + WS_WIN_T); p.WOUT_T = (bf16_t*)(ws + WS_WOUT_T); p.WGU_T = (bf16_t*)(ws + WS_WGU_T); p.WD_T = (bf16_t*)(ws + WS_WD_T);
    p.CTL = (unsigned*)(ws + WS_CTL); p.SLOC = (bf16_t*)(ws + WS_SLOC); p.GDEC = (float*)(ws + WS_GDEC); p.XB = (bf16_t*)(ws + WS_XB);
    return p;
}

#define FORWARD_STAGES(STAGE)                                                      \
    STAGE(b_adaln, (long)DEPTH * 3 * NMOD, 0)                                      \
    STAGE(b_lb, 2L * 384, 0)                                                       \
    STAGE(b_copyx, (long)NTOK * D, 0)                                              \
    for (int l = 0; l < DEPTH; ++l) {                                              \
        STAGE(b_prenorm<0>, (long)NTOK, l)                                         \
        STAGE(b_gemm_in, (long)NTOK * (INC / 4), l)                                \
        STAGE(b_qkprep, (long)NTOK * 12, l)                                        \
        STAGE(b_attn, (long)NTOK * NAH, l)                                         \
        STAGE(b_gates, (long)NTOK * 768, l)                                        \
        STAGE(b_hgrn_seq<0>, (long)NB * HGH * 64, l)                               \
        STAGE(b_hgrn_seq<1>, (long)NB * HGH * 64, l)                               \
        STAGE(b_hgfin, (long)NTOK * HGH, l)                                        \
        STAGE(b_conv, (long)NTOK * CVD, l)                                         \
        STAGE(b_gemm_out, (long)NTOK * (D / 4), l)                                 \
        STAGE(b_prenorm<1>, (long)NTOK, l)                                         \
        STAGE(b_rank, (long)NTOK * NE, l)                                          \
        STAGE(b_moe1, (long)NSLOT * (ED / 4), l)                                   \
        STAGE(b_moe2, (long)NSLOT * (D / 4), l)                                    \
        STAGE(b_combine, (long)NTOK * (D / 4), l)                                  \
    }

#ifndef CPU_SIM
#include <cstdio>
#define LAS __attribute__((address_space(3)))
#define GAS __attribute__((address_space(1)))
typedef short bf16x8 __attribute__((ext_vector_type(8)));
typedef float f32x4 __attribute__((ext_vector_type(4)));
typedef float f32x2 __attribute__((ext_vector_type(2)));
typedef unsigned u32x4 __attribute__((ext_vector_type(4)));
typedef unsigned u32x2 __attribute__((ext_vector_type(2)));
constexpr int NWAVES = 8, NTHR = 512;
constexpr int RING_BYTES = 131072, LDSCTL_OFF = RING_BYTES, MISC_OFF = LDSCTL_OFF + 320, TAB_OFF = LDSCTL_OFF + 1024  , LDS_BYTES = 147456;

typedef __bf16 bf16v2_t __attribute__((ext_vector_type(2)));
__device__ __forceinline__ unsigned cvt_pk_bf16_asm(float lo, float hi) { unsigned r; asm volatile("v_cvt_pk_bf16_f32 %0, %1, %2" : "=v"(r) : "v"(lo), "v"(hi)); return r; }
__device__ __forceinline__ unsigned cvt_pk_bf16(float lo, float hi) { bf16v2_t v = {(__bf16)lo, (__bf16)hi}; return __builtin_bit_cast(unsigned, v); }
__device__ __forceinline__ float wave_sum(float v, int lane) {
    v += __builtin_bit_cast(float, __builtin_amdgcn_ds_swizzle(__builtin_bit_cast(int, v), (1 << 10) | 0x1f));
    v += __builtin_bit_cast(float, __builtin_amdgcn_ds_swizzle(__builtin_bit_cast(int, v), (2 << 10) | 0x1f));
    v += __builtin_bit_cast(float, __builtin_amdgcn_ds_swizzle(__builtin_bit_cast(int, v), (4 << 10) | 0x1f));
    v += __builtin_bit_cast(float, __builtin_amdgcn_ds_swizzle(__builtin_bit_cast(int, v), (8 << 10) | 0x1f));
    v += __builtin_bit_cast(float, __builtin_amdgcn_ds_swizzle(__builtin_bit_cast(int, v), (16 << 10) | 0x1f));
    v += __builtin_bit_cast(float, __builtin_amdgcn_ds_bpermute((lane ^ 32) << 2, __builtin_bit_cast(int, v)));
    return v;
}

extern __shared__ __attribute__((aligned(16))) unsigned char lds_raw[];
#ifndef FUSE_QK
#define FUSE_QK 1
#endif
__device__ __forceinline__ float bfw(unsigned w, int hi) { return __builtin_bit_cast(float, hi ? (w & 0xffff0000u) : (w << 16)); }
__device__ __forceinline__ float bf8(const u32x4& v, int j) { return bfw(v[j >> 1], j & 1); }
namespace pg8 {
constexpr int BM = 256, BK = 64, HALF = 128, HTB = HALF * BK * 2, STAGE_BYTES = 8 * HTB, NXCD = 8, WGM = 8;
__device__ __forceinline__ int lds_byte(int r, int c) { const int st = (r >> 4) * 2 + (c >> 5), rr = r & 15, cc = c & 31, ob = rr * 64 + cc * 2; return st * 1024 + (ob ^ (((ob >> 9) & 1) << 5)); }
__device__ __forceinline__ void stage_rc(int b, int& R, int& C) { const int st = b / 1024, sb = b % 1024, swz = sb ^ (((sb >> 9) & 1) << 5); R = (st >> 1) * 16 + swz / 64; C = (st & 1) * 32 + (swz % 64) / 2; }
__device__ __forceinline__ int perm32(int rho) { const int n = rho >> 4, i = rho & 15; return 8 * (i >> 2) + 4 * n + (i & 3); }
struct Unit { int pm, pn; };
struct Gemm {
    const bf16_t* A; const bf16_t* Bt; int M, N, K;
    const int* gather;
    int gt, ng; size_t gstride;
};
struct StaticOrder {
    int nM, nN, nwg, G, c;
    __device__ void init(int M, int N, int G_, int c_) { nM = M / BM; nN = N / BM; nwg = nM * nN; G = G_; c = c_; }
    __device__ bool next(int i, Unit& u) const {
        const long L = (long)i * G + c; if (L >= nwg) return false;
        int wgid = (int)L; { const int q = nwg / NXCD, r = nwg % NXCD, xcd = wgid % NXCD, off = wgid / NXCD; wgid = (xcd < r ? xcd * (q + 1) : r * (q + 1) + (xcd - r) * q) + off; }
        const int nig = WGM * nN, gid = wgid / nig, fm = gid * WGM, gsz = (nM - fm) < WGM ? (nM - fm) : WGM;
        u.pm = fm + ((wgid % nig) % gsz); u.pn = (wgid % nig) / gsz; return true;
    }
};
struct EpiBf16 {
    static constexpr bool PERM = true;
    bf16_t* O; int ldc; const float* rowscale; int skip;
    __device__ __forceinline__ void operator()(const f32x4 (&acc)[2][2][4][2], const Unit& u, int wr, int wc, int fr, int fq) const {
        const int row0 = u.pm * BM + wr * 64 + fr, col0 = u.pn * BM + wc * 32 + 8 * fq;
        if (skip) { asm volatile("" :: "v"(acc[0][0][0][0]), "v"(acc[1][1][3][1])); return; }
        float scv[2][4];
#pragma unroll
        for (int ai = 0; ai < 2; ++ai)
#pragma unroll
            for (int m = 0; m < 4; ++m) scv[ai][m] = rowscale ? rowscale[row0 + ai * HALF + m * 16] : 1.f;
        asm volatile("" ::: "memory");
#pragma unroll
        for (int ai = 0; ai < 2; ++ai)
#pragma unroll
            for (int m = 0; m < 4; ++m) { const int row = row0 + ai * HALF + m * 16; bf16_t* rowp = O + (size_t)row * ldc + col0; const float sc = scv[ai][m];
#pragma unroll
                for (int bj = 0; bj < 2; ++bj) { const f32x4 v0 = acc[ai][bj][m][0] * sc, v1 = acc[ai][bj][m][1] * sc;
                    u32x4 w; w.x = cvt_pk_bf16_asm(v0[0], v0[1]); w.y = cvt_pk_bf16_asm(v0[2], v0[3]); w.z = cvt_pk_bf16_asm(v1[0], v1[1]); w.w = cvt_pk_bf16_asm(v1[2], v1[3]);
                    *(u32x4*)(rowp + bj * HALF) = w; } }
    }
};
struct EpiP {
    static constexpr bool PERM = true;
    bf16_t* O; int ldc; const float* qn; const float* kn; int skip;
    __device__ __forceinline__ void operator()(const f32x4 (&acc)[2][2][4][2], const Unit& u, int wr, int wc, int fr, int fq) const {
        const int row0 = u.pm * BM + wr * 64 + fr, col0 = u.pn * BM + wc * 32 + 8 * fq;
        if (skip) { asm volatile("" :: "v"(acc[0][0][0][0]), "v"(acc[1][1][3][1])); return; }
        if (u.pn >= 3 || !FUSE_QK) {
#pragma unroll
            for (int ai = 0; ai < 2; ++ai)
#pragma unroll
                for (int m = 0; m < 4; ++m) { bf16_t* rowp = O + (size_t)(row0 + ai * HALF + m * 16) * ldc + col0;
#pragma unroll
                    for (int bj = 0; bj < 2; ++bj) { const f32x4 v0 = acc[ai][bj][m][0], v1 = acc[ai][bj][m][1];
                        u32x4 w; w.x = cvt_pk_bf16_asm(v0[0], v0[1]); w.y = cvt_pk_bf16_asm(v0[2], v0[3]); w.z = cvt_pk_bf16_asm(v1[0], v1[1]); w.w = cvt_pk_bf16_asm(v1[2], v1[3]);
                        *(u32x4*)(rowp + bj * HALF) = w; } }
            return;
        }
        LAS float* PS = (LAS float*)((LAS unsigned char*)lds_raw + LDSCTL_OFF + 4096);
        const int half = wc & 1, hw = wc >> 1;
        unsigned lm_ = ~0u; asm volatile("" : "+s"(lm_)); const int lane = (int)__builtin_amdgcn_mbcnt_hi(lm_, __builtin_amdgcn_mbcnt_lo(lm_, 0u));
#pragma unroll
        for (int ai = 0; ai < 2; ++ai)
#pragma unroll
            for (int m = 0; m < 4; ++m)
#pragma unroll
                for (int bj = 0; bj < 2; ++bj) { const f32x4 v0 = acc[ai][bj][m][0], v1 = acc[ai][bj][m][1];
                    float s = (v0[0] * v0[0] + v0[1] * v0[1]) + (v0[2] * v0[2] + v0[3] * v0[3]) + (v1[0] * v1[0] + v1[1] * v1[1]) + (v1[2] * v1[2] + v1[3] * v1[3]);
                    s += __builtin_bit_cast(float, __builtin_amdgcn_ds_swizzle(__builtin_bit_cast(int, s), (16 << 10) | 0x1f));
                    s += __builtin_bit_cast(float, __builtin_amdgcn_ds_bpermute((lane ^ 32) << 2, __builtin_bit_cast(int, s)));
                    if (fq == 0) PS[((ai * HALF + wr * 64 + m * 16 + fr) * 4 + 2 * bj + hw) * 2 + half] = s; }
        asm volatile("s_waitcnt lgkmcnt(0)" ::: "memory"); __builtin_amdgcn_s_barrier(); asm volatile("" ::: "memory");
        float invf[8];
#pragma unroll
        for (int j = 0; j < 8; ++j) invf[j] = __builtin_amdgcn_exp2f(-(float)(8 * (fq & 1) + j) * (13.287712379549449f / 16.f));
        const bool second = (fq & 2) != 0;
        f32x4 nwv[2][2];
#pragma unroll
        for (int bj = 0; bj < 2; ++bj) { const bool isk = (u.pn * BM + bj * HALF + wc * 32) >= 384; const float* nw = (isk ? kn : qn) + 32 * half + 8 * fq; nwv[bj][0] = *(const f32x4*)nw; nwv[bj][1] = *(const f32x4*)(nw + 4); }
        asm volatile("" ::: "memory");
#pragma unroll
        for (int ai = 0; ai < 2; ++ai)
#pragma unroll
            for (int m = 0; m < 4; ++m) {
                const int grow = row0 + ai * HALF + m * 16; const bool lat = grow < NLAT; const int t = lat ? grow % SEQ : 0;
                int tp = half ? t % GW : t / GW; asm volatile("" : "+v"(tp));
                const float pos = (float)tp;
                float cs[8], sn[8];
#pragma unroll
                for (int j = 0; j < 8; ++j) { const float ang = pos * invf[j]; cs[j] = __cosf(ang); sn[j] = __sinf(ang); }
                bf16_t* rowp = O + (size_t)grow * ldc + col0;
#pragma unroll
                for (int bj = 0; bj < 2; ++bj) {
                    const int rl = ai * HALF + wr * 64 + m * 16 + fr, head = 2 * bj + hw;
                    const float ssq = PS[(rl * 4 + head) * 2] + PS[(rl * 4 + head) * 2 + 1];
                    const bool isk = (u.pn * BM + bj * HALF + wc * 32) >= 384;
                    const float rstd = (isk ? 1.f : 0.125f * 1.44269504089f) / sqrtf(ssq * (1.f / HD) + EPS);
                    const f32x4 n0 = nwv[bj][0], n1 = nwv[bj][1];
                    float y[8];
#pragma unroll
                    for (int j = 0; j < 4; ++j) { y[j] = acc[ai][bj][m][0][j] * rstd * n0[j]; y[4 + j] = acc[ai][bj][m][1][j] * rstd * n1[j]; }
#pragma unroll
                    for (int j = 0; j < 8; ++j) {
                        const unsigned yb = __builtin_bit_cast(unsigned, y[j]);
                        const auto sw = __builtin_amdgcn_permlane32_swap(yb, yb, false, false);
                        const float other = __builtin_bit_cast(float, lane < 32 ? sw[1] : sw[0]);
                        const float rot = second ? y[j] * cs[j] + other * sn[j] : y[j] * cs[j] - other * sn[j];
                        y[j] = lat ? rot : y[j];
                    }
                    u32x4 w; w.x = cvt_pk_bf16(y[0], y[1]); w.y = cvt_pk_bf16(y[2], y[3]); w.z = cvt_pk_bf16(y[4], y[5]); w.w = cvt_pk_bf16(y[6], y[7]);
                    *(u32x4*)(rowp + bj * HALF) = w;
                }
                asm volatile("" ::: "memory");
            }
    }
};
struct EpiRes {
    static constexpr bool PERM = true;
    bf16_t* X; int ldc; const float* gate0; int rows_per_set; size_t set_stride;
    __device__ __forceinline__ void operator()(const f32x4 (&acc)[2][2][4][2], const Unit& u, int wr, int wc, int fr, int fq) const {
        const int row0 = u.pm * BM + wr * 64 + fr, col0 = u.pn * BM + wc * 32 + 8 * fq;
        const float* gate = gate0 + (size_t)((u.pm * BM) / rows_per_set) * set_stride;
        f32x4 gv[2][2];
#pragma unroll
        for (int bj = 0; bj < 2; ++bj)
#pragma unroll
            for (int n = 0; n < 2; ++n) gv[bj][n] = *(const f32x4*)(gate + col0 + bj * HALF + n * 4);
        u32x4 rv[2][4][2];
#pragma unroll
        for (int ai = 0; ai < 2; ++ai)
#pragma unroll
            for (int m = 0; m < 4; ++m)
#pragma unroll
                for (int bj = 0; bj < 2; ++bj) rv[ai][m][bj] = *(const u32x4*)(X + (size_t)(row0 + ai * HALF + m * 16) * ldc + col0 + bj * HALF);
        asm volatile("" ::: "memory");
#pragma unroll
        for (int ai = 0; ai < 2; ++ai)
#pragma unroll
            for (int m = 0; m < 4; ++m) { bf16_t* rowp = X + (size_t)(row0 + ai * HALF + m * 16) * ldc + col0;
#pragma unroll
                for (int bj = 0; bj < 2; ++bj) { const u32x4 r = rv[ai][m][bj];
                    const f32x4 x0 = (f32x4){bfw(r.x, 0), bfw(r.x, 1), bfw(r.y, 0), bfw(r.y, 1)}, x1 = (f32x4){bfw(r.z, 0), bfw(r.z, 1), bfw(r.w, 0), bfw(r.w, 1)};
                    const f32x4 v0 = x0 + gv[bj][0] * acc[ai][bj][m][0], v1 = x1 + gv[bj][1] * acc[ai][bj][m][1];
                    u32x4 w; w.x = cvt_pk_bf16_asm(v0[0], v0[1]); w.y = cvt_pk_bf16_asm(v0[2], v0[3]); w.z = cvt_pk_bf16_asm(v1[0], v1[1]); w.w = cvt_pk_bf16_asm(v1[2], v1[3]);
                    *(u32x4*)(rowp + bj * HALF) = w; } }
    }
};
struct EpiHid {
    static constexpr bool PERM = false;
    bf16_t* O; int ldc;
    __device__ __forceinline__ void operator()(const f32x4 (&acc)[2][2][4][2], const Unit& u, int wr, int wc, int fr, int fq) const {
        const int row0 = u.pm * BM + wr * 64 + fr, col0 = (u.pn * BM + wc * 32) / 2 + 4 * fq;
#pragma unroll
        for (int ai = 0; ai < 2; ++ai)
#pragma unroll
            for (int m = 0; m < 4; ++m) { bf16_t* rowp = O + (size_t)(row0 + ai * HALF + m * 16) * ldc + col0;
#pragma unroll
                for (int bj = 0; bj < 2; ++bj) { const f32x4 g = acc[ai][bj][m][0], up = acc[ai][bj][m][1]; f32x4 h;
#pragma unroll
                    for (int j = 0; j < 4; ++j) h[j] = g[j] * __builtin_amdgcn_rcpf(1.f + __expf(-g[j])) * up[j];
                    u32x2 w; w.x = cvt_pk_bf16_asm(h[0], h[1]); w.y = cvt_pk_bf16_asm(h[2], h[3]);
                    *(u32x2*)(rowp + bj * (HALF / 2)) = w; } }
    }
};

template <class Epi, bool GATHER>
__device__ __forceinline__ void gemm_phase(const int tid, LAS unsigned char* lds, const Gemm g, const StaticOrder& S, const Epi& E) {
    const int wid = __builtin_amdgcn_readfirstlane(tid >> 6), lane = tid & 63, wr = wid >> 2, wc = wid & 3, fr = lane & 15, fq = lane >> 4;
    const int K = g.K, nt = K / BK;
    unsigned voffA[2], voffB[2];
#pragma unroll
    for (int i = 0; i < 2; ++i) { int R, C; stage_rc(tid * 16 + i * 8192, R, C); const int Rb = Epi::PERM ? ((R & ~31) + perm32(R & 31)) : R;
        voffB[i] = (unsigned)(Rb * K + C) * 2u; voffA[i] = GATHER ? (unsigned)(C * 2) : (Epi::PERM ? (unsigned)(R * K + C) * 2u : voffB[i]); }
    const size_t kstep = (size_t)(BK * 2);
    const size_t hstep = (size_t)HALF * K * 2;
    const size_t tstep = 2 * hstep;
    const unsigned ldsw = (unsigned)wid * 1024u;
    const int aoff = lds_byte(wr * 64 + fr, fq * 8), boff = lds_byte(wc * 32 + fr, fq * 8);
#define PG8_SA(b, h) (((b) * 2 + (h)) * HTB)
#define PG8_SB(b, h) ((4 + (b) * 2 + (h)) * HTB)
#define PG8_STAGE(bufoff, gbase, voff) do { const char* gb_ = (const char*)(gbase); asm volatile("" : "+s"(gb_)); _Pragma("unroll") for (int _i = 0; _i < 2; ++_i) \
        __builtin_amdgcn_global_load_lds((const unsigned*)(gb_ + (voff)[_i]), (LAS unsigned*)(lds + (bufoff) + ldsw + _i * 8192), 16, 0, 0); } while (0)
#define PG8_STAGE_A(bufoff, ubase, kt, h, tb) do { if constexpr (GATHER) { \
        if ((tb) < 0) { PG8_STAGE(bufoff, Ab + (size_t)(kt) * kstep, oAc[h]); } else { \
        unsigned m_ = ~0u; asm volatile("" : "+s"(m_)); const int tl_ = wid * 64 + (int)__builtin_amdgcn_mbcnt_hi(m_, __builtin_amdgcn_mbcnt_lo(m_, 0u)); \
        _Pragma("unroll") for (int _i = 0; _i < 2; ++_i) { int _R, _C; stage_rc(tl_ * 16 + _i * 8192, _R, _C); \
            const unsigned _o = *(const LAS unsigned*)(lds + TAB_OFF + (tb) * 1024 + ((h) * HALF + _R) * 4) + (unsigned)(_C * 2); \
            __builtin_amdgcn_global_load_lds((const unsigned*)(Ab + (size_t)(kt) * kstep + _o), (LAS unsigned*)(lds + (bufoff) + ldsw + _i * 8192), 16, 0, 0); } } } \
        else { PG8_STAGE(bufoff, (ubase) + (size_t)(kt) * kstep + (size_t)(h) * hstep, voffA); } } while (0)
#define PG8_LOADOFFS(tb) do { if constexpr (GATHER) { unsigned m_ = ~0u; asm volatile("" : "+s"(m_)); const int tl_ = wid * 64 + (int)__builtin_amdgcn_mbcnt_hi(m_, __builtin_amdgcn_mbcnt_lo(m_, 0u)); \
        _Pragma("unroll") for (int _h = 0; _h < 2; ++_h) _Pragma("unroll") for (int _i = 0; _i < 2; ++_i) { int _R, _C; stage_rc(tl_ * 16 + _i * 8192, _R, _C); \
            oAc[_h][_i] = *(const LAS unsigned*)(lds + TAB_OFF + (tb) * 1024 + (_h * HALF + _R) * 4) + (unsigned)(_C * 2); } } } while (0)
#define PG8_FILLTAB(u, tb) do { if constexpr (GATHER) { unsigned m_ = ~0u; asm volatile("" : "+s"(m_)); const int tl_ = wid * 64 + (int)__builtin_amdgcn_mbcnt_hi(m_, __builtin_amdgcn_mbcnt_lo(m_, 0u)); \
        if (tl_ < 256) *(LAS unsigned*)(lds + TAB_OFF + (tb) * 1024 + tl_ * 4) = min((unsigned)g.gather[(u).pm * BM + tl_], (unsigned)(NTOK - 1)) * (unsigned)(K * 2); } } while (0)
#define PG8_LDA(dst, b, h) do { _Pragma("unroll") for (int m = 0; m < 4; ++m) _Pragma("unroll") for (int k = 0; k < 2; ++k) dst[m][k] = *(const LAS bf16x8*)(lds + PG8_SA(b, h) + aoff + m * 2048 + k * 1024); } while (0)
#define PG8_LDB(dst, b, h) do { _Pragma("unroll") for (int n = 0; n < 2; ++n) _Pragma("unroll") for (int k = 0; k < 2; ++k) dst[n][k] = *(const LAS bf16x8*)(lds + PG8_SB(b, h) + boff + n * 2048 + k * 1024); } while (0)
#define PG8_MMA(ai, bj, At, Bt) do { __builtin_amdgcn_s_setprio(1); _Pragma("unroll") for (int m = 0; m < 4; ++m) _Pragma("unroll") for (int n = 0; n < 2; ++n) _Pragma("unroll") for (int k = 0; k < 2; ++k) \
        acc[ai][bj][m][n] = __builtin_amdgcn_mfma_f32_16x16x32_bf16(Bt[n][k], At[m][k], acc[ai][bj][m][n], 0, 0, 0); __builtin_amdgcn_s_setprio(0); } while (0)
#define PG8_WAIT_V(n) asm volatile("s_waitcnt vmcnt(" #n ")" ::: "memory")
#define PG8_WAIT_L(n) asm volatile("s_waitcnt lgkmcnt(" #n ")" ::: "memory")
#define PG8_BAR __builtin_amdgcn_s_barrier()
#define PG8_SCHED __builtin_amdgcn_sched_barrier(0)
#define PG8_KTILE2(u1, k1, o1, u2, k2, o2, b2p) do { \
        PG8_LDB(B0, 0, 0); PG8_LDB(B1, 0, 1); PG8_SCHED; PG8_LDA(At, 0, 0); PG8_STAGE_A(PG8_SA(1, 1), u1, k1, 1, o1); \
        PG8_WAIT_V(8); PG8_WAIT_L(0); PG8_BAR; PG8_MMA(0, 0, At, B0); PG8_MMA(0, 1, At, B1); PG8_BAR; PG8_SCHED; \
        PG8_LDA(At, 0, 1); PG8_STAGE(PG8_SB(0, 0), b2p, voffB); PG8_STAGE(PG8_SB(0, 1), (b2p) + hstep, voffB); PG8_STAGE_A(PG8_SA(0, 0), u2, k2, 0, o2); \
        PG8_WAIT_V(8); PG8_WAIT_L(0); PG8_BAR; PG8_MMA(1, 0, At, B0); PG8_MMA(1, 1, At, B1); PG8_BAR; PG8_SCHED; \
        PG8_LDB(B0, 1, 0); PG8_LDB(B1, 1, 1); PG8_SCHED; PG8_LDA(At, 1, 0); PG8_STAGE_A(PG8_SA(0, 1), u2, k2, 1, o2); \
        PG8_WAIT_V(8); PG8_WAIT_L(0); PG8_BAR; PG8_MMA(0, 0, At, B0); PG8_MMA(0, 1, At, B1); PG8_BAR; PG8_SCHED; \
        PG8_LDA(At, 1, 1); PG8_STAGE(PG8_SB(1, 0), (b2p) + kstep, voffB); PG8_STAGE(PG8_SB(1, 1), (b2p) + kstep + hstep, voffB); PG8_STAGE_A(PG8_SA(1, 0), u2, (k2) + 1, 0, o2); \
        PG8_WAIT_V(8); PG8_WAIT_L(0); PG8_BAR; PG8_MMA(1, 0, At, B0); PG8_MMA(1, 1, At, B1); PG8_BAR; PG8_SCHED; } while (0)
#define PG8_BPTR(u) ((const char*)g.Bt + (g.gt ? (size_t)(((u).pm / g.gt) % g.ng) * g.gstride : (size_t)0) + (size_t)(u).pn * tstep)
    Unit cur, nxt; int ui = 0;
    if (!S.next(0, cur)) return;
#ifndef LATE_START
#define LATE_START 4
#endif
#ifndef GEMM_STAGGER
#define GEMM_STAGGER 0
#endif
    if (GEMM_STAGGER) { const int dg_ = ((int)blockIdx.x >> 3) & 3; for (int i_ = 0; i_ < dg_; ++i_) __builtin_amdgcn_s_sleep(GEMM_STAGGER); }
    if (S.nwg % S.G != 0 && S.c >= S.nwg % S.G) { for (int i_ = 0; i_ < LATE_START; ++i_) __builtin_amdgcn_s_sleep(127); }
    f32x4 acc[2][2][4][2];
#pragma unroll
    for (int a = 0; a < 2; ++a)
#pragma unroll
        for (int b = 0; b < 2; ++b)
#pragma unroll
            for (int m = 0; m < 4; ++m)
#pragma unroll
                for (int n = 0; n < 2; ++n) acc[a][b][m][n] = (f32x4){0.f, 0.f, 0.f, 0.f};
    bf16x8 At[4][2], B0[2][2], B1[2][2];
    unsigned oAc[2][2] = {{0u, 0u}, {0u, 0u}};
    const char* const Ab = (const char*)g.A;
    const char* cA = Ab + (size_t)cur.pm * tstep;
    const char* cB = PG8_BPTR(cur);
    PG8_FILLTAB(cur, 0);
    if constexpr (GATHER) { PG8_WAIT_L(0); PG8_BAR; PG8_LOADOFFS(0); }
    PG8_STAGE(PG8_SB(0, 0), cB, voffB); PG8_STAGE(PG8_SB(0, 1), cB + hstep, voffB); PG8_STAGE_A(PG8_SA(0, 0), cA, 0, 0, -1); PG8_STAGE_A(PG8_SA(0, 1), cA, 0, 1, -1);
    if (wr == 1) PG8_BAR;
    PG8_WAIT_V(2); PG8_BAR;
    PG8_STAGE(PG8_SB(1, 0), cB + kstep, voffB); PG8_STAGE_A(PG8_SA(1, 0), cA, 1, 0, -1); PG8_STAGE(PG8_SB(1, 1), cB + hstep + kstep, voffB);
    PG8_WAIT_V(6); PG8_BAR;
    for (;;) {
        const bool has_next = S.next(ui + 1, nxt);
        const char* nA = has_next ? Ab + (size_t)nxt.pm * tstep : cA; const char* nB = has_next ? PG8_BPTR(nxt) : cB;
        const int tbc = ui & 1, tbn = has_next ? ((ui + 1) & 1) : (ui & 1);
        if (has_next) PG8_FILLTAB(nxt, tbn);
        for (int t = 0; t < nt - 2; t += 2) { const char* b2 = cB + (size_t)(t + 2) * kstep; PG8_KTILE2(cA, t + 1, -1, cA, t + 2, -1, b2); }
        PG8_KTILE2(cA, nt - 1, -1, nA, 0, tbn, nB);
        if (wr == 0) PG8_BAR;
        { unsigned m_ = ~0u; asm volatile("" : "+s"(m_)); int l2 = (int)__builtin_amdgcn_mbcnt_hi(m_, __builtin_amdgcn_mbcnt_lo(m_, 0u)); asm volatile("" : "+v"(l2)); E(acc, cur, wr, wc, l2 & 15, l2 >> 4); }
        if (!has_next) break;
#pragma unroll
        for (int a = 0; a < 2; ++a)
#pragma unroll
            for (int b = 0; b < 2; ++b)
#pragma unroll
                for (int m = 0; m < 4; ++m)
#pragma unroll
                    for (int n = 0; n < 2; ++n) acc[a][b][m][n] = (f32x4){0.f, 0.f, 0.f, 0.f};
        cur = nxt; cA = nA; cB = nB; ++ui;
        PG8_LOADOFFS(ui & 1);
        if (wr == 1) PG8_BAR;
    }
    PG8_WAIT_V(0);
    PG8_BAR;
#undef PG8_STAGE_A
#undef PG8_FILLTAB
#undef PG8_LOADOFFS
#undef PG8_SA
#undef PG8_SB
#undef PG8_STAGE
#undef PG8_LDA
#undef PG8_LDB
#undef PG8_MMA
#undef PG8_WAIT_V
#undef PG8_WAIT_L
#undef PG8_BAR
#undef PG8_SCHED
#undef PG8_KTILE2
#undef PG8_BPTR
}
}

#define XB_TMO      128
#define XB_XCNT(j)  (256  + 64 * (j))
#define XB_XSUB(j)  (1280 + 64 * (j))
#define XB_XGEN(j)  (2304 + 64 * (j))
#define XB_TOP      3328
#define XB_TOPGEN   3392
#define XCD_BAR_WORDS 3456
#define XB_SPIN_CAP (1u << 20)
__device__ __forceinline__ unsigned xb_ld(unsigned* p)              { return __hip_atomic_load(p, __ATOMIC_RELAXED, __HIP_MEMORY_SCOPE_AGENT); }
__device__ __forceinline__ unsigned xb_add(unsigned* p, unsigned v) { return __hip_atomic_fetch_add(p, v, __ATOMIC_RELAXED, __HIP_MEMORY_SCOPE_AGENT); }
__device__ __forceinline__ unsigned xb_xcc_id() { return (unsigned)__builtin_amdgcn_s_getreg((3 << 11) | 20) & 0xFu; }
#define XB_SPIN(cond, bar) do { unsigned _sp = 0; while (cond) { __builtin_amdgcn_s_sleep(1); \
    if ((++_sp & 255u) == 0u) { if (xb_ld(&(bar)[XB_TMO])) break; if (_sp > XB_SPIN_CAP) { atomicAdd(&(bar)[XB_TMO], 1u); break; } } } } while (0)
struct XcdBarrier { unsigned* bar; unsigned x; };
#define XB_ST(ldsbase) ((volatile LAS unsigned*)((LAS unsigned char*)(ldsbase) + MISC_OFF + 32))
__device__ __forceinline__ XcdBarrier xcd_barrier_post(unsigned* bar, bool leader) {
    XcdBarrier b; b.bar = bar; b.x = xb_xcc_id();
    if (leader) (void)xb_add(&bar[XB_XCNT(b.x)], 1u);
    return b;
}
__device__ __forceinline__ void xcd_barrier_complete(unsigned* bar, unsigned x, unsigned& nloc, unsigned& nx) {
    const unsigned G = gridDim.x * gridDim.y * gridDim.z;
    unsigned sum, cnt, mine, sp = 0u;
    for (;;) {
        sum = 0u; cnt = 0u; mine = 0u;
#pragma unroll
        for (unsigned j = 0; j < 16; ++j) { const unsigned c = xb_ld(&bar[XB_XCNT(j)]); sum += c; cnt += (c > 0u) ? 1u : 0u; mine = (j == x) ? c : mine; }
        if (sum == G) break;
        __builtin_amdgcn_s_sleep(1);
        if ((++sp & 255u) == 0u) { if (xb_ld(&bar[XB_TMO])) break; if (sp > XB_SPIN_CAP) { atomicAdd(&bar[XB_TMO], 1u); break; } }
    }
    nloc = mine > 0u ? mine : 1u; nx = cnt > 0u ? cnt : 1u;
}
__device__ __forceinline__ void xcd_barrier(const XcdBarrier& b, bool leader, volatile LAS unsigned* st) {
    asm volatile("s_waitcnt vmcnt(0)" ::: "memory");
    __syncthreads();
    if (leader) {
        unsigned* bar = b.bar;
        __builtin_amdgcn_s_waitcnt(0);
        unsigned nloc = st[0], nx = st[1];
        if (nloc == 0u) { xcd_barrier_complete(bar, b.x, nloc, nx); st[0] = nloc; st[1] = nx; }
        const unsigned old = xb_add(&bar[XB_XSUB(b.x)], 1u);
        const unsigned gen = old / nloc;
        if (old + 1u == (gen + 1u) * nloc) {
            __builtin_amdgcn_fence(__ATOMIC_RELEASE, "agent");
            asm volatile("s_waitcnt vmcnt(0)" ::: "memory");
            const unsigned og = xb_add(&bar[XB_TOP], 1u);
            const unsigned tg = og / nx;
            if (og + 1u == (tg + 1u) * nx) xb_add(&bar[XB_TOPGEN], 1u);
            else XB_SPIN(xb_ld(&bar[XB_TOPGEN]) == tg, bar);
            __builtin_amdgcn_fence(__ATOMIC_ACQUIRE, "agent");
            xb_add(&bar[XB_XGEN(b.x)], 1u);
            asm volatile("s_waitcnt vmcnt(0)" ::: "memory");
        } else {
            XB_SPIN(xb_ld(&bar[XB_XGEN(b.x)]) == gen, bar);
            __builtin_amdgcn_fence(__ATOMIC_ACQUIRE, "agent");
            asm volatile("s_waitcnt vmcnt(0)" ::: "memory");
        }
    }
    __syncthreads();
}

template <void (*F)(long, PRef, int)> __device__ __forceinline__ void run_items(const int tid, PRef p, int l, long n, long off) {
    for (long gid = (long)blockIdx.x * NTHR + tid; gid < n; gid += (long)gridDim.x * NTHR) F(gid + off, p, l);
}
BODY void b_hgrn_seq2(long gid, PRef p, int l) { const long n1 = (long)NB * HGH * 64; if (gid < n1) b_hgrn_seq<0>(gid, p, l); else b_hgrn_seq<1>(gid - n1, p, l); }

template <int MAP> __device__ __forceinline__ void transpose_item(const float* W, int K, int N, bf16_t* WT, int row_off, LAS float* scr, int item, int lane) {
    const int nblk = N / 32, kb = item / nblk, nb = item % nblk, k0 = 64 * kb, n0 = 32 * nb;
#pragma unroll 8
    for (int i = 0; i < 32; ++i) { const int kk = 2 * i + (lane >> 5); scr[kk * 33 + (lane & 31)] = W[(size_t)(k0 + kk) * N + n0 + (lane & 31)]; }
    asm volatile("s_waitcnt lgkmcnt(0)" ::: "memory");
    const int c = lane & 7;
#pragma unroll
    for (int j = 0; j < 4; ++j) { const int n = (lane >> 3) + 8 * j; const LAS float* s = scr + (8 * c) * 33 + n;
        u32x4 o; o.x = cvt_pk_bf16(s[0 * 33], s[1 * 33]); o.y = cvt_pk_bf16(s[2 * 33], s[3 * 33]); o.z = cvt_pk_bf16(s[4 * 33], s[5 * 33]); o.w = cvt_pk_bf16(s[6 * 33], s[7 * 33]);
        const int nn = n0 + n; const int drow = MAP == 0 ? row_off + nn : (32 * (nn >> 4) + (nn & 15) + (MAP == 2 ? 16 : 0));
        *(u32x4*)(WT + (size_t)drow * K + k0 + 8 * c) = o; }
    asm volatile("s_waitcnt lgkmcnt(0)" ::: "memory");
}
__device__ __forceinline__ void phase_convert(const int tid, PRef p, int l, LAS unsigned char* lds, int part = 0, int blk_lo = 0) {
    if ((int)blockIdx.x < blk_lo) return;
    const int lane = tid & 63, wave = tid >> 6;
    LAS float* scr = (LAS float*)(lds + wave * 16384);
    const int gw = ((int)blockIdx.x - blk_lo) * NWAVES + wave, NGW = ((int)gridDim.x - blk_lo) * NWAVES;
    constexpr int I_IN = (D / 64) * (INC / 32), I_OUT = (MIXD / 64) * (D / 32), I_G = (D / 64) * (ED / 32), I_D = (ED / 64) * (D / 32);
    constexpr int NITEMS = I_IN + I_OUT + NE * (2 * I_G + I_D);
    const int it_lo = part == 2 ? I_IN + I_OUT : 0, it_hi = part == 1 ? I_IN + I_OUT : NITEMS;
    for (int it = it_lo + gw; it < it_hi; it += NGW) {
        int r = it;
        if (r < I_IN) { transpose_item<0>(p.w_in + (size_t)l * D * INC, D, INC, p.WIN_T, 0, scr, r, lane); continue; } r -= I_IN;
        if (r < I_OUT) { transpose_item<0>(p.w_out + (size_t)l * MIXD * D, MIXD, D, p.WOUT_T, 0, scr, r, lane); continue; } r -= I_OUT;
        const int e = r / (2 * I_G + I_D); r -= e * (2 * I_G + I_D);
        if (r < I_G) { transpose_item<1>(p.w_gate + ((size_t)l * NE + e) * D * ED, D, ED, p.WGU_T + (size_t)e * 2 * ED * D, 0, scr, r, lane); continue; } r -= I_G;
        if (r < I_G) { transpose_item<2>(p.w_up + ((size_t)l * NE + e) * D * ED, D, ED, p.WGU_T + (size_t)e * 2 * ED * D, 0, scr, r, lane); continue; } r -= I_G;
        transpose_item<0>(p.w_down + ((size_t)l * NE + e) * ED * D, ED, D, p.WD_T + (size_t)e * D * ED, 0, scr, r, lane);
    }
}
template <int WHICH> __device__ __forceinline__ void phase_prenorm(const int tid, PRef p, int l) {
    static_assert(D == 1024, "wave-per-row kernels assume D = 1024");
    const int lane = tid & 63, wave = tid >> 6;
    const int gw = blockIdx.x * NWAVES + wave, NGW = gridDim.x * NWAVES;
    const float* nw = (WHICH ? p.norm2_w : p.norm1_w) + l * D;
    for (int r = gw; r < NTOK; r += NGW) {
        const float* xr = xrow(p, r);
        const float* mod = p.MOD + ((size_t)l * 3 + modset(r)) * NMOD;
        const float* shift = mod + (WHICH ? 3 : 0) * D; const float* scale = mod + (WHICH ? 4 : 1) * D;
        f32x4 v[4]; float ss = 0.f;
#pragma unroll
        for (int j = 0; j < 4; ++j) { v[j] = *(const f32x4*)(xr + 4 * lane + 256 * j); ss += (v[j][0] * v[j][0] + v[j][1] * v[j][1]) + (v[j][2] * v[j][2] + v[j][3] * v[j][3]); }
        const float rstd = 1.f / sqrtf(wave_sum(ss, lane) * (1.f / D) + EPS);
        float lg[NE];
#pragma unroll
        for (int e = 0; e < NE; ++e) lg[e] = 0.f;
#pragma unroll
        for (int j = 0; j < 4; ++j) {
            const int c = 4 * lane + 256 * j;
            const f32x4 w4 = *(const f32x4*)(nw + c), sc4 = *(const f32x4*)(scale + c), sh4 = *(const f32x4*)(shift + c);
            f32x4 h;
#pragma unroll
            for (int i = 0; i < 4; ++i) h[i] = v[j][i] * rstd * w4[i] * (1.f + sc4[i]) + sh4[i];
            u32x2 o; o.x = cvt_pk_bf16(h[0], h[1]); o.y = cvt_pk_bf16(h[2], h[3]);
            *(u32x2*)(p.H + (size_t)r * D + c) = o;
            if (WHICH) {
#pragma unroll
                for (int i = 0; i < 4; ++i) { const f32x4* wr = (const f32x4*)(p.w_router + ((size_t)l * D + c + i) * NE);
#pragma unroll
                    for (int q = 0; q < 4; ++q) { const f32x4 w = wr[q]; lg[4 * q + 0] += h[i] * w[0]; lg[4 * q + 1] += h[i] * w[1]; lg[4 * q + 2] += h[i] * w[2]; lg[4 * q + 3] += h[i] * w[3]; } }
            }
        }
        if (WHICH) {
#pragma unroll
            for (int e = 0; e < NE; ++e) lg[e] = wave_sum(lg[e], lane);
            float m = lg[0];
#pragma unroll
            for (int e = 1; e < NE; ++e) m = fmaxf(m, lg[e]);
            float s = 0.f, mine = 0.f;
#pragma unroll
            for (int e = 0; e < NE; ++e) { const float ex = expf(lg[e] - m); s += ex; mine = (lane == e) ? ex : mine; }
            if (lane < NE) p.AFF[(size_t)r * NE + lane] = mine / s;
        }
    }
}
__device__ __forceinline__ void phase_combine(const int tid, PRef p, int l) {
    const int lane = tid & 63, wave = tid >> 6;
    const int gw = blockIdx.x * NWAVES + wave, NGW = gridDim.x * NWAVES;
    for (int r = gw; r < NTOK; r += NGW) {
        float* xr = xrow(p, r);
        const float* g = p.MOD + ((size_t)l * 3 + modset(r)) * NMOD + 5 * D;
        f32x4 acc[4];
#pragma unroll
        for (int j = 0; j < 4; ++j) acc[j] = (f32x4){0.f, 0.f, 0.f, 0.f};
        const int myinv = lane < NE ? p.INV[(size_t)r * NE + lane] : -1;
#pragma unroll
        for (int e = 0; e < NE; ++e) {
            const int s = __builtin_amdgcn_readlane(myinv, e);
            if (s >= 0 && s < NSLOT) {
                const bf16_t* y = p.Y + (size_t)s * D;
#pragma unroll
                for (int j = 0; j < 4; ++j) { const u32x2 w = *(const u32x2*)(y + 4 * lane + 256 * j);
                    acc[j][0] += __builtin_bit_cast(float, w.x << 16); acc[j][1] += __builtin_bit_cast(float, w.x & 0xffff0000u);
                    acc[j][2] += __builtin_bit_cast(float, w.y << 16); acc[j][3] += __builtin_bit_cast(float, w.y & 0xffff0000u); }
            }
        }
#pragma unroll
        for (int j = 0; j < 4; ++j) { const int c = 4 * lane + 256 * j; f32x4* q = (f32x4*)(xr + c); *q = *q + *(const f32x4*)(g + c) * acc[j]; }
    }
}


__device__ __forceinline__ unsigned wave_excl_scan(unsigned x, int lane) {
    unsigned inc = x;
#pragma unroll
    for (int d = 1; d < 64; d <<= 1) { const unsigned y = (unsigned)__builtin_amdgcn_ds_bpermute(((lane - d) & 63) << 2, (int)inc); if (lane >= d) inc += y; }
    return inc - x;
}
__device__ __forceinline__ void phase_topk(const int tid, PRef p, LAS unsigned char* lds) {
    LAS unsigned* keys = (LAS unsigned*)lds;
    LAS unsigned* hist = (LAS unsigned*)(lds + 70000);
    LAS unsigned* cgt = (LAS unsigned*)(lds + 76000);
    LAS unsigned* ceq = (LAS unsigned*)(lds + 80000);
    LAS unsigned* sh = (LAS unsigned*)(lds + 84000);
    static_assert(SEQ % 512 == 0 && SEQ + SEQ / 32 <= 17400, "topk LDS layout");
    constexpr int PER = SEQ / 512;
    for (int pr = blockIdx.x; pr < 2 * NB * NE; pr += gridDim.x) {
        const int e = pr % NE, b = (pr / NE) % NB, isctx = pr / (NE * NB);
        if (!isctx) {
            const int row0 = b * SEQ, base = (b * NE + e) * CAPL;
            for (int i = 0; i < PER; ++i) { const int t = i * 512 + tid; keys[t + (t >> 5)] = __builtin_bit_cast(unsigned, p.AFF[(size_t)(row0 + t) * NE + e]); }
            if (tid == 0) { sh[0] = 0u; sh[1] = (unsigned)CAPL; }
            __syncthreads();
            for (int pass = 0; pass < 3; ++pass) {
                const int shift = 20 - 10 * pass;
                for (int i = tid; i < 1024; i += 512) hist[i] = 0u;
                __syncthreads();
                const unsigned prefix = sh[0]; const unsigned himask = pass == 0 ? 0u : (0xFFFFFFFFu << (shift + 10));
                for (int i = 0; i < PER; ++i) { const int t = tid * PER + i; const unsigned k = keys[t + (t >> 5)]; if ((k & himask) == prefix) atomicAdd((unsigned*)&hist[(k >> shift) & 1023u], 1u); }
                __syncthreads();
                if (tid < 64) {
                    const unsigned need = sh[1];
                    unsigned c[16]; unsigned tot = 0u;
#pragma unroll
                    for (int q = 0; q < 16; ++q) { c[q] = hist[1023 - 16 * tid - q]; tot += c[q]; }
                    unsigned above = wave_excl_scan(tot, tid);
                    int fbin = -1; unsigned fabove = 0u;
#pragma unroll
                    for (int q = 0; q < 16; ++q) { if (fbin < 0 && above < need && above + c[q] >= need) { fbin = 1023 - 16 * tid - q; fabove = above; } above += c[q]; }
                    if (fbin >= 0) { sh[0] = prefix | ((unsigned)fbin << shift); sh[1] = need - fabove; }
                }
                __syncthreads();
            }
            const unsigned thr = sh[0], keq = sh[1];
            unsigned ng = 0u, nq = 0u;
            for (int i = 0; i < PER; ++i) { const int t = tid * PER + i; const unsigned k = keys[t + (t >> 5)]; ng += k > thr ? 1u : 0u; nq += k == thr ? 1u : 0u; }
            cgt[tid] = ng; ceq[tid] = nq;
            __syncthreads();
            if (tid < 64) {
                unsigned g[8], q[8], sg = 0u, sq = 0u;
#pragma unroll
                for (int i = 0; i < 8; ++i) { g[i] = cgt[8 * tid + i]; q[i] = ceq[8 * tid + i]; sg += g[i]; sq += q[i]; }
                unsigned ag = wave_excl_scan(sg, tid), aq = wave_excl_scan(sq, tid);
#pragma unroll
                for (int i = 0; i < 8; ++i) { cgt[8 * tid + i] = ag; ceq[8 * tid + i] = aq; ag += g[i]; aq += q[i]; }
            }
            __syncthreads();
            unsigned rg = cgt[tid], rq = ceq[tid];
            for (int i = 0; i < PER; ++i) {
                const int t = tid * PER + i; const unsigned k = keys[t + (t >> 5)];
                int slot = -1;
                if (k > thr) { slot = (int)(rg + (rq < keq ? rq : keq)); ++rg; }
                else if (k == thr) { if (rq < keq) slot = (int)(rg + rq); ++rq; }
                const int row = row0 + t;
                if (slot >= 0) { p.STOK[base + slot] = row; p.SVAL[base + slot] = __builtin_bit_cast(float, k); p.INV[(size_t)row * NE + e] = base + slot; }
                else p.INV[(size_t)row * NE + e] = -1;
            }
            __syncthreads();
        } else {
            const int row0 = NLAT + b * CTX, base = NSLOT_L + (b * NE + e) * CAPC;
            LAS float* vals = (LAS float*)lds;
            for (int t = tid; t < CTX; t += 512) vals[t] = p.AFF[(size_t)(row0 + t) * NE + e];
            __syncthreads();
            for (int t = tid; t < CTX; t += 512) {
                const float a = vals[t]; int rank = 0;
                for (int tt = 0; tt < CTX; ++tt) { const float o = vals[tt]; rank += (o > a || (o == a && tt < t)) ? 1 : 0; }
                const int row = row0 + t;
                if (rank < CAPC) { p.STOK[base + rank] = row; p.SVAL[base + rank] = a; p.INV[(size_t)row * NE + e] = base + rank; }
                else p.INV[(size_t)row * NE + e] = -1;
            }
            __syncthreads();
        }
    }
}

#define LDS_BAR() do { asm volatile("s_waitcnt lgkmcnt(0)" ::: "memory"); __builtin_amdgcn_s_barrier(); asm volatile("" ::: "memory"); } while (0)
__device__ __forceinline__ int hg_row0(int b, int pc) { return pc < NCHC ? NLAT + b * CTX + pc * 64 : b * SEQ + (pc - NCHC) * 64; }
constexpr int HG_FF = 0, HG_FB = 16640, HG_AF = 33280, HG_AB = 49920, HG_T0 = 66560, HG_TS = 9216, HG_VT = HG_T0 + 6 * HG_TS;
static_assert(HG_VT + HG_TS <= RING_BYTES, "hgrn LDS layout");
#define TSW_E(k, t) ((k) * 72 + ((((t) >> 3) ^ (((k) >> 3) & 7)) << 3) + ((t) & 7))
#define TSW_B(k, c) ((k) * 144 + (((c) ^ (((k) >> 3) & 7)) << 4))
constexpr int HG_LBOFF = LDSCTL_OFF + 4096;
__device__ __forceinline__ void hg_stage_lb(const int tid, PRef p, int l) {
    LAS float* dst = (LAS float*)((LAS unsigned char*)lds_raw + HG_LBOFF);
    for (int i = tid; i < 768; i += NTHR) dst[i] = p.LB[(size_t)((i / 384) * DEPTH + l) * 384 + (i % 384)];
    LDS_BAR();
}
__device__ __forceinline__ void hg_gates(const int tid, PRef p, int l, int h, const u32x4 zf, const u32x4 zb, LAS unsigned char* lds) {
    LAS float* FF = (LAS float*)(lds + HG_FF); LAS float* FB = (LAS float*)(lds + HG_FB); LAS float* AF = (LAS float*)(lds + HG_AF); LAS float* AB = (LAS float*)(lds + HG_AB);
    const int t = tid >> 3, cg = tid & 7;
    const LAS float* lbf = (const LAS float*)((LAS unsigned char*)lds_raw + HG_LBOFF) + h * 64 + cg * 8; const LAS float* lbb = lbf + 384;
#pragma unroll
    for (int j = 0; j < 8; ++j) {
        const float z0 = fminf(fmaxf(bf8(zf, j), -60.f), 60.f), z1 = fminf(fmaxf(bf8(zb, j), -60.f), 60.f);
        const float l0 = lbf[j], l1 = lbb[j];
        FF[t * 65 + cg * 8 + j] = l0 + (1.f - l0) * __builtin_amdgcn_rcpf(1.f + __expf(-z0));
        FB[t * 65 + cg * 8 + j] = l1 + (1.f - l1) * __builtin_amdgcn_rcpf(1.f + __expf(-z1));
    }
    LDS_BAR();
    {
        const int wave = tid >> 6, lane = tid & 63, cl = lane & 15, seg = lane >> 4, dir = wave >> 2, col = 16 * (wave & 3) + cl;
        const LAS float* F = dir ? FB : FF; LAS float* A = dir ? AB : AF;
        float pre[16]; float run = 0.f;
#pragma unroll
        for (int i = 0; i < 16; ++i) { const int tt = dir ? 16 * seg + 15 - i : 16 * seg + i; run += __logf(F[tt * 65 + col]); pre[i] = run; }
        const float T0 = __builtin_bit_cast(float, __builtin_amdgcn_ds_bpermute((cl + 0) << 2, __builtin_bit_cast(int, run)));
        const float T1 = __builtin_bit_cast(float, __builtin_amdgcn_ds_bpermute((cl + 16) << 2, __builtin_bit_cast(int, run)));
        const float T2 = __builtin_bit_cast(float, __builtin_amdgcn_ds_bpermute((cl + 32) << 2, __builtin_bit_cast(int, run)));
        const float T3 = __builtin_bit_cast(float, __builtin_amdgcn_ds_bpermute((cl + 48) << 2, __builtin_bit_cast(int, run)));
        const float off = dir ? ((seg < 1 ? T1 : 0.f) + (seg < 2 ? T2 : 0.f) + (seg < 3 ? T3 : 0.f)) : ((seg > 0 ? T0 : 0.f) + (seg > 1 ? T1 : 0.f) + (seg > 2 ? T2 : 0.f));
#pragma unroll
        for (int i = 0; i < 16; ++i) { const int tt = dir ? 16 * seg + 15 - i : 16 * seg + i; A[tt * 65 + col] = off + pre[i]; }
    }
    LDS_BAR();
}
__device__ __forceinline__ bf16x8 ld2x64(const LAS unsigned char* p0, const LAS unsigned char* p1) {
    const u32x2 a = *(const LAS u32x2*)p0, b = *(const LAS u32x2*)p1; u32x4 r; r.x = a.x; r.y = a.y; r.z = b.x; r.w = b.y; return __builtin_bit_cast(bf16x8, r);
}
__device__ __forceinline__ f32x4 mfma16(bf16x8 a, bf16x8 b, f32x4 c) { return __builtin_amdgcn_mfma_f32_16x16x32_bf16(a, b, c, 0, 0, 0); }
__device__ __forceinline__ void phase_hgrn_local(const int tid, PRef p, int l, LAS unsigned char* lds) {
    LAS float* FF = (LAS float*)(lds + HG_FF); LAS float* FB = (LAS float*)(lds + HG_FB); LAS float* AF = (LAS float*)(lds + HG_AF); LAS float* AB = (LAS float*)(lds + HG_AB);
    LAS bf16_t* KTf = (LAS bf16_t*)(lds + HG_T0); LAS bf16_t* KTb = (LAS bf16_t*)(lds + HG_T0 + HG_TS); LAS bf16_t* VT = (LAS bf16_t*)(lds + HG_VT);
    const int t = tid >> 3, cg = tid & 7, wave = tid >> 6, lane = tid & 63, fr = lane & 15, fq = lane >> 4;
    u32x4 zf = (u32x4){0u, 0u, 0u, 0u}, zb = zf, v8 = zf, nzf = zf, nzb = zf, nv8 = zf;
    if ((int)blockIdx.x < NBH * NCH) { const int it = blockIdx.x, pc = it % NCH, bh = it / NCH, h = bh % HGH, b = bh / HGH;
        const bf16_t* pr = p.P + (size_t)(hg_row0(b, pc) + t) * INC + h * 64 + cg * 8; zf = *(const u32x4*)(pr + OFF_); zb = *(const u32x4*)(pr + OFB); v8 = *(const u32x4*)(pr + OHI); }
    hg_stage_lb(tid, p, l);
    for (int it = blockIdx.x; it < NBH * NCH; it += gridDim.x) {
        const int pc = it % NCH, bh = it / NCH, h = bh % HGH, b = bh / HGH, row0 = hg_row0(b, pc);
        { const int it2 = min(it + (int)gridDim.x, NBH * NCH - 1); const int pc2 = it2 % NCH, bh2 = it2 / NCH, h2 = bh2 % HGH, b2 = bh2 / HGH;
            const bf16_t* pr = p.P + (size_t)(hg_row0(b2, pc2) + t) * INC + h2 * 64 + cg * 8; nzf = *(const u32x4*)(pr + OFF_); nzb = *(const u32x4*)(pr + OFB); nv8 = *(const u32x4*)(pr + OHI); }
        hg_gates(tid, p, l, h, zf, zb, lds);
#pragma unroll
        for (int j = 0; j < 8; ++j) {
            const int k = cg * 8 + j;
            VT[TSW_E(k, t)] = (bf16_t)(j & 1 ? v8[j >> 1] >> 16 : v8[j >> 1] & 0xffffu);
            KTf[TSW_E(k, t)] = f2bf((1.f - FF[t * 65 + k]) * __expf(AF[63 * 65 + k] - AF[t * 65 + k]));
            KTb[TSW_E(k, t)] = f2bf((1.f - FB[t * 65 + k]) * __expf(AB[k] - AB[t * 65 + k]));
        }
        if (tid < 64) p.GDEC[((size_t)(0 * NBH + bh) * NCH + pc) * 64 + tid] = __expf(AF[63 * 65 + tid]);
        else if (tid < 128) p.GDEC[((size_t)(1 * NBH + bh) * NCH + pc) * 64 + (tid - 64)] = __expf(AB[tid - 64]);
        LDS_BAR();
#if HGRN_DIAG == 4
        {
            const int v = tid >> 3, kg = tid & 7;
            for (int dir = 0; dir < 2; ++dir) {
                const LAS bf16_t* KT = (const LAS bf16_t*)(lds + HG_T0 + dir * HG_TS);
                float acc[8];
#pragma unroll
                for (int j = 0; j < 8; ++j) acc[j] = 0.f;
                for (int s_ = 0; s_ < 64; ++s_) { const float vv = bf2f(VT[v * 72 + s_]);
#pragma unroll
                    for (int j = 0; j < 8; ++j) acc[j] += bf2f(KT[(kg * 8 + j) * 72 + s_]) * vv; }
                bf16_t* dst = p.SLOC + ((size_t)(dir * NBH + bh) * NCH + pc) * 4096 + v * 64 + kg * 8;
#pragma unroll
                for (int j = 0; j < 8; ++j) dst[j] = f2bf(acc[j]);
            }
        }
#else
        {
            const int dir = wave >> 2, mt = wave & 3;
            const LAS unsigned char* KT = lds + HG_T0 + dir * HG_TS;
            bf16x8 a[2];
#pragma unroll
            for (int ks = 0; ks < 2; ++ks) a[ks] = *(const LAS bf16x8*)(KT + TSW_B(mt * 16 + fr, ks * 4 + fq));
            bf16_t* dst = p.SLOC + ((size_t)(dir * NBH + bh) * NCH + pc) * 4096;
            u32x2 w[4];
#pragma unroll
            for (int nt = 0; nt < 4; ++nt) {
                f32x4 acc = (f32x4){0.f, 0.f, 0.f, 0.f};
#pragma unroll
                for (int ks = 0; ks < 2; ++ks) { const bf16x8 bb = *(const LAS bf16x8*)(lds + HG_VT + TSW_B(nt * 16 + fr, ks * 4 + fq)); acc = mfma16(a[ks], bb, acc); }
                w[nt].x = cvt_pk_bf16(acc[0], acc[1]); w[nt].y = cvt_pk_bf16(acc[2], acc[3]);
            }
            zf = nzf; zb = nzb; v8 = nv8;
            asm volatile("" ::: "memory");
#pragma unroll
            for (int nt = 0; nt < 4; ++nt) *(u32x2*)(dst + (nt * 16 + fr) * 64 + mt * 16 + 4 * fq) = w[nt];
        }
#endif
        LDS_BAR();
    }
}
__device__ __forceinline__ void phase_hgrn_scan(const int tid, PRef p) {
    static_assert(NCH % 20 == 0, "scan group size");
    constexpr int GS = 20;
    for (int blk = (int)gridDim.x - 1 - (int)blockIdx.x; blk < 2 * NBH * 4; blk += gridDim.x) {
        const int sq = blk >> 2, part = blk & 3, dir = sq / NBH, e0 = part * 1024 + tid * 2, k = e0 & 63;
        unsigned* S = (unsigned*)(p.SLOC + (size_t)sq * NCH * 4096 + e0);
        const float* G = p.GDEC + (size_t)sq * NCH * 64 + k;
        float c0 = 0.f, c1 = 0.f;
        unsigned nx[GS]; f32x2 gn[GS];
#define HG_PC(j) (dir ? ((j) < NCHC ? NCHC - 1 - (j) : NCH + NCHC - 1 - (j)) : (j))
#pragma unroll
        for (int u = 0; u < GS; ++u) { const int pc = HG_PC(u); nx[u] = S[(size_t)pc * 2048]; gn[u] = *(const f32x2*)(G + (size_t)pc * 64); }
        for (int j0 = 0; j0 < NCH; j0 += GS) {
            unsigned cu[GS]; f32x2 gc[GS];
#pragma unroll
            for (int u = 0; u < GS; ++u) { cu[u] = nx[u]; gc[u] = gn[u]; }
            if (j0 + GS < NCH) {
#pragma unroll
                for (int u = 0; u < GS; ++u) { const int pc = HG_PC(j0 + GS + u); nx[u] = S[(size_t)pc * 2048]; gn[u] = *(const f32x2*)(G + (size_t)pc * 64); }
            }
#pragma unroll
            for (int u = 0; u < GS; ++u) {
                const int pc = HG_PC(j0 + u);
                S[(size_t)pc * 2048] = cvt_pk_bf16(c0, c1);
                c0 = gc[u][0] * c0 + bfw(cu[u], 0); c1 = gc[u][1] * c1 + bfw(cu[u], 1);
            }
        }
#undef HG_PC
    }
}
__device__ __forceinline__ void phase_hgrn_out(const int tid, PRef p, int l, LAS unsigned char* lds) {
    const int NCHO = (l + 1 < DEPTH) ? NCH : NCH - NCHC, PC0 = NCH - NCHO;
    LAS float* FF = (LAS float*)(lds + HG_FF); LAS float* FB = (LAS float*)(lds + HG_FB); LAS float* AF = (LAS float*)(lds + HG_AF); LAS float* AB = (LAS float*)(lds + HG_AB);
    LAS bf16_t* VT = (LAS bf16_t*)(lds + HG_VT);
    LAS float* OO = (LAS float*)(lds + HG_AF);
    const int t = tid >> 3, cg = tid & 7, wave = tid >> 6, lane = tid & 63, fr = lane & 15, fq = lane >> 4;
    u32x4 zf = (u32x4){0u, 0u, 0u, 0u}, zb = zf, v8 = zf, q8 = zf, g8 = zf, nzf = zf, nzb = zf, nv8 = zf, nq8 = zf, ng8 = zf;
    bf16x8 bsin[4][2], nbsin[4][2];
#define HG_LOADSIN(dst, bhx, pcx) do { const bf16_t* SIN_ = p.SLOC + ((size_t)((wave >> 2) * NBH + (bhx)) * NCH + (pcx)) * 4096; \
        _Pragma("unroll") for (int vt = 0; vt < 4; ++vt) _Pragma("unroll") for (int ks = 0; ks < 2; ++ks) dst[vt][ks] = *(const bf16x8*)(SIN_ + (vt * 16 + fr) * 64 + ks * 32 + fq * 8); } while (0)
#pragma unroll
    for (int vt = 0; vt < 4; ++vt) { bsin[vt][0] = (bf16x8){0, 0, 0, 0, 0, 0, 0, 0}; bsin[vt][1] = bsin[vt][0]; nbsin[vt][0] = bsin[vt][0]; nbsin[vt][1] = bsin[vt][0]; }
    if ((int)blockIdx.x < NBH * NCHO) { const int it = blockIdx.x, pc = it % NCHO + PC0, bh = it / NCHO, h = bh % HGH, b = bh / HGH;
        const bf16_t* pr = p.P + (size_t)(hg_row0(b, pc) + t) * INC + h * 64 + cg * 8; zf = *(const u32x4*)(pr + OFF_); zb = *(const u32x4*)(pr + OFB); v8 = *(const u32x4*)(pr + OHI); q8 = *(const u32x4*)(pr + OHQ); g8 = *(const u32x4*)(pr + OHG_);
        HG_LOADSIN(bsin, bh, pc); }
    hg_stage_lb(tid, p, l);
    f32x4 hn0, hn1; { const float* nwp = p.hg_norm + l * 64 + cg * 8; hn0 = *(const f32x4*)nwp; hn1 = *(const f32x4*)(nwp + 4); }
    for (int it = blockIdx.x; it < NBH * NCHO; it += gridDim.x) {
        const int pc = it % NCHO + PC0, bh = it / NCHO, h = bh % HGH, b = bh / HGH, row0 = hg_row0(b, pc);
        { const int it2 = min(it + (int)gridDim.x, NBH * NCHO - 1); const int pc2 = it2 % NCHO + PC0, bh2 = it2 / NCHO, h2 = bh2 % HGH, b2 = bh2 / HGH;
            const bf16_t* pr = p.P + (size_t)(hg_row0(b2, pc2) + t) * INC + h2 * 64 + cg * 8; nzf = *(const u32x4*)(pr + OFF_); nzb = *(const u32x4*)(pr + OFB); nv8 = *(const u32x4*)(pr + OHI); nq8 = *(const u32x4*)(pr + OHQ); ng8 = *(const u32x4*)(pr + OHG_);
            HG_LOADSIN(nbsin, bh2, pc2); }
        hg_gates(tid, p, l, h, zf, zb, lds);
        {
            float w[6][8];
#pragma unroll
            for (int j = 0; j < 8; ++j) {
                const int k = cg * 8 + j;
                VT[TSW_E(k, t)] = (bf16_t)(j & 1 ? v8[j >> 1] >> 16 : v8[j >> 1] & 0xffffu);
                const float qv = bf8(q8, j) * 0.125f, af = AF[t * 65 + k], ab = AB[t * 65 + k], rf = AF[31 * 65 + k], rb = AB[32 * 65 + k];
                w[0][j] = qv * __expf(fminf(af - rf, 80.f)); w[1][j] = (1.f - FF[t * 65 + k]) * __expf(fminf(rf - af, 80.f)); w[2][j] = qv * __expf(af);
                w[3][j] = qv * __expf(fminf(ab - rb, 80.f)); w[4][j] = (1.f - FB[t * 65 + k]) * __expf(fminf(rb - ab, 80.f)); w[5][j] = qv * __expf(ab);
            }
#pragma unroll
            for (int a = 0; a < 6; ++a) { u32x4 o; o.x = cvt_pk_bf16(w[a][0], w[a][1]); o.y = cvt_pk_bf16(w[a][2], w[a][3]); o.z = cvt_pk_bf16(w[a][4], w[a][5]); o.w = cvt_pk_bf16(w[a][6], w[a][7]);
                *(LAS u32x4*)(lds + HG_T0 + a * HG_TS + t * 144 + cg * 16) = o; }
        }
        LDS_BAR();
        {
            const int dir = wave >> 2, tt = wave & 3;
            const LAS unsigned char* QT = lds + HG_T0 + (dir * 3 + 0) * HG_TS; const LAS unsigned char* KL = lds + HG_T0 + (dir * 3 + 1) * HG_TS; const LAS unsigned char* QH = lds + HG_T0 + (dir * 3 + 2) * HG_TS;
            bf16x8 bq[2], bh[2];
#pragma unroll
            for (int ks = 0; ks < 2; ++ks) { bq[ks] = *(const LAS bf16x8*)(QT + (tt * 16 + fr) * 144 + ks * 64 + fq * 16); bh[ks] = *(const LAS bf16x8*)(QH + (tt * 16 + fr) * 144 + ks * 64 + fq * 16); }
            f32x4 o[4];
#pragma unroll
            for (int vt = 0; vt < 4; ++vt) { o[vt] = (f32x4){0.f, 0.f, 0.f, 0.f};
#pragma unroll
                for (int ks = 0; ks < 2; ++ks) o[vt] = mfma16(bsin[vt][ks], bh[ks], o[vt]); }
            const int t_ = 16 * tt + fr;
#pragma unroll
            for (int kp = 0; kp < 2; ++kp) {
                f32x4 sc[2];
#pragma unroll
                for (int hf = 0; hf < 2; ++hf) { const int st = 2 * kp + hf;
                    sc[hf] = (f32x4){0.f, 0.f, 0.f, 0.f};
                    if (dir ? st >= tt : st <= tt) {
#pragma unroll
                        for (int ks = 0; ks < 2; ++ks) { const bf16x8 a = *(const LAS bf16x8*)(KL + (st * 16 + fr) * 144 + ks * 64 + fq * 16); sc[hf] = mfma16(a, bq[ks], sc[hf]); }
#pragma unroll
                        for (int r = 0; r < 4; ++r) { const int s_ = 16 * st + 4 * fq + r; const bool keep = dir ? (s_ >= t_) : (s_ <= t_); sc[hf][r] = keep ? sc[hf][r] : 0.f; }
                    } }
                if (dir ? (2 * kp + 1 >= tt) : (2 * kp <= tt)) {
                    u32x4 pw; pw.x = cvt_pk_bf16(sc[0][0], sc[0][1]); pw.y = cvt_pk_bf16(sc[0][2], sc[0][3]); pw.z = cvt_pk_bf16(sc[1][0], sc[1][1]); pw.w = cvt_pk_bf16(sc[1][2], sc[1][3]);
                    const bf16x8 pf = __builtin_bit_cast(bf16x8, pw);
                    const int s0 = 32 * kp + 4 * fq;
#pragma unroll
                    for (int vt = 0; vt < 4; ++vt) { const int v_ = 16 * vt + fr; const int sw = (v_ >> 3) & 7;
                        const LAS unsigned char* vr = lds + HG_VT + v_ * 144 + (s0 & 7) * 2;
                        const bf16x8 a = ld2x64(vr + (((s0 >> 3) ^ sw) << 4), vr + ((((s0 + 16) >> 3) ^ sw) << 4));
                        o[vt] = mfma16(a, pf, o[vt]); }
                }
            }
            LAS float* OOd = (LAS float*)(lds + (dir ? HG_FB : HG_FF));
#pragma unroll
            for (int vt = 0; vt < 4; ++vt)
#pragma unroll
                for (int r = 0; r < 4; ++r) OOd[t_ * 65 + 16 * vt + 4 * fq + r] = o[vt][r];
        }
        LDS_BAR();
        {
            float o[8]; float ss = 0.f;
#pragma unroll
            for (int j = 0; j < 8; ++j) { o[j] = FF[t * 65 + cg * 8 + j] + FB[t * 65 + cg * 8 + j]; ss += o[j] * o[j]; }
            ss += __builtin_bit_cast(float, __builtin_amdgcn_ds_swizzle(__builtin_bit_cast(int, ss), (1 << 10) | 0x1f));
            ss += __builtin_bit_cast(float, __builtin_amdgcn_ds_swizzle(__builtin_bit_cast(int, ss), (2 << 10) | 0x1f));
            ss += __builtin_bit_cast(float, __builtin_amdgcn_ds_swizzle(__builtin_bit_cast(int, ss), (4 << 10) | 0x1f));
            const float rstd = 1.f / sqrtf(ss * (1.f / 64.f) + EPS);
            float y[8];
#pragma unroll
            for (int j = 0; j < 8; ++j) { const float g = bf8(g8, j); y[j] = o[j] * rstd * (j < 4 ? hn0[j & 3] : hn1[j & 3]) * g * __builtin_amdgcn_rcpf(1.f + __expf(-g)); }
            u32x4 ov; ov.x = cvt_pk_bf16(y[0], y[1]); ov.y = cvt_pk_bf16(y[2], y[3]); ov.z = cvt_pk_bf16(y[4], y[5]); ov.w = cvt_pk_bf16(y[6], y[7]);
            zf = nzf; zb = nzb; v8 = nv8; q8 = nq8; g8 = ng8;
#pragma unroll
            for (int vt = 0; vt < 4; ++vt) { bsin[vt][0] = nbsin[vt][0]; bsin[vt][1] = nbsin[vt][1]; }
            asm volatile("" ::: "memory");
            *(u32x4*)(p.MIX + (size_t)(row0 + t) * MIXD + 384 + h * 64 + cg * 8) = ov;
        }
        LDS_BAR();
    }
}


#undef HG_LOADSIN
constexpr int AT_KC = 0, AT_VCT = 36864, AT_KL = AT_VCT + 64 * 528, AT_VL = AT_KL + 2 * 9216, AT_RPB = AT_VL + 2 * 9216, AT_END = AT_RPB + 1920;
static_assert(AT_END <= RING_BYTES && CTX == 256, "attention LDS layout (built for 256 context tokens)");
constexpr float ATHR = 6.f;
template <bool LOCAL, int NKB>
__device__ __forceinline__ void attn_step(const LAS unsigned char* Kb, const LAS unsigned char* Vb, int vstride, const bf16x8 (&qb)[2], f32x4 (&o)[4], float& m, float& lsum,
                                          int fr, int fq, int lane, const LAS float* rpb_row, const int (&boff)[8], const int (&voff)[4][2], int kbase) {
    f32x4 sc[2 * NKB];
#pragma unroll
    for (int mt = 0; mt < 2 * NKB; ++mt) { sc[mt] = (f32x4){0.f, 0.f, 0.f, 0.f};
#pragma unroll
        for (int ks = 0; ks < 2; ++ks) { const bf16x8 a = *(const LAS bf16x8*)(Kb + (16 * mt + fr) * 144 + ks * 64 + fq * 16); sc[mt] = mfma16(a, qb[ks], sc[mt]); } }
    float mx = -INFINITY;
#pragma unroll
    for (int mt = 0; mt < 2 * NKB; ++mt)
#pragma unroll
        for (int r = 0; r < 4; ++r) {
            float v = sc[mt][r];
            if (LOCAL) v += *(const LAS float*)((const LAS unsigned char*)rpb_row + boff[(4 * mt + r) & 7]);
            sc[mt][r] = v; mx = fmaxf(mx, v);
        }
    mx = fmaxf(mx, __builtin_bit_cast(float, __builtin_amdgcn_ds_swizzle(__builtin_bit_cast(int, mx), (16 << 10) | 0x1f)));
    mx = fmaxf(mx, __builtin_bit_cast(float, __builtin_amdgcn_ds_bpermute((lane ^ 32) << 2, __builtin_bit_cast(int, mx))));
    if (__builtin_amdgcn_ballot_w64(mx > m + ATHR) != 0ull) {
        const float mn = fmaxf(m, mx), corr = __builtin_amdgcn_exp2f(m - mn);
        m = mn; lsum *= corr;
#pragma unroll
        for (int dt = 0; dt < 4; ++dt) o[dt] = o[dt] * corr;
    }
    float ps = 0.f;
#pragma unroll
    for (int kb = 0; kb < NKB; ++kb) {
        float pv[8];
#pragma unroll
        for (int h2 = 0; h2 < 2; ++h2)
#pragma unroll
            for (int r = 0; r < 4; ++r) { const float e = __builtin_amdgcn_exp2f(sc[2 * kb + h2][r] - m); pv[4 * h2 + r] = e; ps += e; }
        u32x4 pw; pw.x = cvt_pk_bf16(pv[0], pv[1]); pw.y = cvt_pk_bf16(pv[2], pv[3]); pw.z = cvt_pk_bf16(pv[4], pv[5]); pw.w = cvt_pk_bf16(pv[6], pv[7]);
        const bf16x8 pf = __builtin_bit_cast(bf16x8, pw);
#pragma unroll
        for (int dt = 0; dt < 4; ++dt) {
            bf16x8 a;
            if (LOCAL) a = ld2x64(Vb + voff[dt][0], Vb + voff[dt][1]);
            else { const int d_ = 16 * dt + fr, sw_ = (d_ >> 3) & 7, c0_ = (kbase >> 3) + 4 * kb + (fq >> 1);
                const LAS unsigned char* vr = Vb + d_ * vstride + (fq & 1) * 8;
                a = ld2x64(vr + ((c0_ ^ sw_) << 4), vr + (((c0_ + 2) ^ sw_) << 4)); }
            o[dt] = mfma16(a, pf, o[dt]);
        }
    }
    lsum += ps;
}
__device__ __forceinline__ void phase_attn(const int tid, PRef p, int l, LAS unsigned char* lds) {
    const int wave = tid >> 6, lane = tid & 63, fr = lane & 15, fq = lane >> 4, skey = tid >> 3, sc8 = tid & 7;
    LAS float* RPB = (LAS float*)(lds + AT_RPB);
    constexpr int NPAIR = ROWS / 2; const int IPB = NPAIR + ((l + 1 < DEPTH) ? 2 : 0);
    const int G_ = gridDim.x, NIT = NB * NAH * IPB;
    const bool deal = (G_ == 256 && NIT <= 160 * 7 + 96 * 5);
    const int it_lo = deal ? ((int)blockIdx.x < 160 ? (int)blockIdx.x * 7 : 1120 + ((int)blockIdx.x - 160) * 5) : (int)blockIdx.x;
    const int it_n = deal ? ((int)blockIdx.x < 160 ? 7 : 5) : (NIT - (int)blockIdx.x + G_ - 1) / G_;
    int last_bh = -1;
#define AT_QTOK(itx) (((itx) % IPB) < NPAIR ? (((itx) / IPB) / NAH) * SEQ + (2 * ((itx) % IPB) + (wave >> 2)) * GW + 16 * (wave & 3) + fr : NLAT + (((itx) / IPB) / NAH) * CTX + ((((itx) % IPB) - NPAIR) * 128 + 16 * wave) + fr)
#define AT_LOADQ(itx, dst) do { const bf16_t* qp_ = p.P + (size_t)AT_QTOK(itx) * INC + OQ + (((itx) / IPB) % NAH) * 64 + fq * 8; dst[0] = *(const bf16x8*)qp_; dst[1] = *(const bf16x8*)(qp_ + 32); } while (0)
    bf16x8 qnx[2] = {(bf16x8){0, 0, 0, 0, 0, 0, 0, 0}, (bf16x8){0, 0, 0, 0, 0, 0, 0, 0}};
    { const int it0 = it_lo; if (it_n > 0 && it0 < NIT) AT_LOADQ(it0, qnx); }
    for (int ii = 0; ii < it_n; ++ii) {
        const int it = deal ? it_lo + ii : it_lo + ii * G_;
        if (it >= NIT) break;
        const int sub = it % IPB, bh = it / IPB, head = bh % NAH, b = bh / NAH;
        const bool islat = sub < NPAIR;
        const int r0 = 2 * sub, qr = r0 + (wave >> 2), jb = wave & 3;
        LDS_BAR();
        if (bh != last_bh) {
            last_bh = bh;
            for (int rnd = 0; rnd < 4; ++rnd) {
                const int key = skey + 64 * rnd; const bf16_t* src = p.P + (size_t)(NLAT + b * CTX + key) * INC + head * 64 + sc8 * 8;
                const u32x4 kv = *(const u32x4*)(src + OK_), vv = *(const u32x4*)(src + OV);
                *(LAS u32x4*)(lds + AT_KC + key * 144 + sc8 * 16) = kv;
#pragma unroll
                for (int j = 0; j < 8; ++j) *(LAS bf16_t*)(lds + AT_VCT + (sc8 * 8 + j) * 528 + ((((key >> 3) ^ sc8) << 4) + (key & 7) * 2)) = (bf16_t)(j & 1 ? vv[j >> 1] >> 16 : vv[j >> 1] & 0xffffu);
            }
            if (tid < 15 * 32) RPB[tid] = (tid & 31) < 31 ? p.rpb[((size_t)l * NAH + head) * 465 + (tid >> 5) * 31 + (tid & 31)] * 1.44269504089f : -INFINITY;
        }
        const int qtok = islat ? b * SEQ + qr * GW + 16 * jb + fr : NLAT + b * CTX + ((sub - NPAIR) * 128 + 16 * wave) + fr;
        bf16x8 qb[2]; qb[0] = qnx[0]; qb[1] = qnx[1];
        { const int itn = deal ? it + 1 : it + G_; if (ii + 1 < it_n && itn < NIT) AT_LOADQ(itn, qnx); }
        int krlo = 0, krhi = -1, rs = 0;
        if (islat) { int a = r0 - 4; a = a < 0 ? 0 : (a > ROWS - 8 ? ROWS - 8 : a); int c = r0 + 1 - 4; c = c < 0 ? 0 : (c > ROWS - 8 ? ROWS - 8 : c); krlo = a; krhi = c + 7;
            rs = qr - 4; rs = rs < 0 ? 0 : (rs > ROWS - 8 ? ROWS - 8 : rs); }
        u32x4 kA = (u32x4){0u, 0u, 0u, 0u}, vA = kA, kB = kA, vB = kA, kC = kA, vC = kA, kD = kA, vD = kA;
#define AT_LOADROW(row, kd, vd) do { const bf16_t* src_ = p.P + (size_t)(b * SEQ + (row) * GW + skey) * INC + head * 64 + sc8 * 8; kd = *(const u32x4*)(src_ + OK_); vd = *(const u32x4*)(src_ + OV); } while (0)
#define AT_STAGEROW(bufi, kd, vd) do { *(LAS u32x4*)(lds + AT_KL + (bufi) * 9216 + skey * 144 + sc8 * 16) = kd; \
        _Pragma("unroll") for (int j = 0; j < 8; ++j) *(LAS bf16_t*)(lds + AT_VL + (bufi) * 9216 + (sc8 * 8 + j) * 144 + ((((skey >> 3) ^ sc8) << 4) + (skey & 7) * 2)) = (bf16_t)(j & 1 ? vd[j >> 1] >> 16 : vd[j >> 1] & 0xffffu); } while (0)
        if (islat) { AT_LOADROW(krlo, kA, vA); AT_LOADROW(krlo + 1, kB, vB); AT_LOADROW(krlo + 2, kC, vC); AT_LOADROW(krlo + 3, kD, vD); }
        f32x4 o[4]; float m = -1e30f, lsum = 0.f;
#pragma unroll
        for (int dt = 0; dt < 4; ++dt) o[dt] = (f32x4){0.f, 0.f, 0.f, 0.f};
        LDS_BAR();
        const int bs = jb == 0 ? 0 : (jb == 1 ? 8 : (jb == 2 ? 24 : 32)), qc = 16 * jb + fr;
        int boff[8], voff[4][2];
        { int ws = qc - 8; ws = ws < 0 ? 0 : (ws > 48 ? 48 : ws);
#pragma unroll
          for (int j_ = 0; j_ < 8; ++j_) { const int kc = bs + 16 * (j_ >> 2) + 4 * fq + (j_ & 3); const bool ok = kc >= ws && kc < ws + 16; boff[j_] = (ok ? kc - qc + 15 : 31) * 4; asm volatile("" : "+v"(boff[j_])); }
#pragma unroll
          for (int dt = 0; dt < 4; ++dt) { const int d_ = 16 * dt + fr, sw_ = (d_ >> 3) & 7, c0_ = (bs >> 3) + (fq >> 1);
              voff[dt][0] = d_ * 144 + (fq & 1) * 8 + ((c0_ ^ sw_) << 4); voff[dt][1] = d_ * 144 + (fq & 1) * 8 + (((c0_ + 2) ^ sw_) << 4); asm volatile("" : "+v"(voff[dt][0]), "+v"(voff[dt][1])); } }
        for (int st = 0; st < 4; ++st)
            attn_step<false, 2>(lds + AT_KC + st * 64 * 144, lds + AT_VCT, 528, qb, o, m, lsum, fr, fq, lane, RPB, boff, voff, st * 64);
        if (islat) { AT_STAGEROW(0, kA, vA); AT_LOADROW(krlo + 4, kA, vA); }
        LDS_BAR();
#define AT_ROWSTEP(jj, BUF, NK, NV, DOSTAGE, DOLOAD) { const int kr = krlo + (jj); \
            if (kr >= rs && kr < rs + 8) \
                attn_step<true, 1>(lds + AT_KL + (BUF) * 9216 + bs * 144, lds + AT_VL + (BUF) * 9216, 144, qb, o, m, lsum, fr, fq, lane, RPB + (kr - qr + 7) * 32, boff, voff, bs); \
            if (DOSTAGE) { AT_STAGEROW((BUF) ^ 1, NK, NV); } if (DOLOAD) { AT_LOADROW(min(kr + 5, krhi), NK, NV); } \
            LDS_BAR(); }
        if (islat) {
            AT_ROWSTEP(0, 0, kB, vB, 1, 1) AT_ROWSTEP(1, 1, kC, vC, 1, 1) AT_ROWSTEP(2, 0, kD, vD, 1, 1) AT_ROWSTEP(3, 1, kA, vA, 1, 1)
            AT_ROWSTEP(4, 0, kB, vB, 1, 0) AT_ROWSTEP(5, 1, kC, vC, 1, 0) AT_ROWSTEP(6, 0, kD, vD, 1, 0) AT_ROWSTEP(7, 1, kA, vA, 1, 0)
            if (krlo + 8 <= krhi) { AT_ROWSTEP(8, 0, kB, vB, 0, 0) }
        }
#undef AT_ROWSTEP
#undef AT_LOADROW
#undef AT_STAGEROW
        lsum += __builtin_bit_cast(float, __builtin_amdgcn_ds_swizzle(__builtin_bit_cast(int, lsum), (16 << 10) | 0x1f));
        lsum += __builtin_bit_cast(float, __builtin_amdgcn_ds_bpermute((lane ^ 32) << 2, __builtin_bit_cast(int, lsum)));
        const float inv = 1.f / lsum;
        bf16_t* orow = p.MIX + (size_t)qtok * MIXD + head * 64;
#pragma unroll
        for (int dt = 0; dt < 4; ++dt) { u32x2 w; w.x = cvt_pk_bf16(o[dt][0] * inv, o[dt][1] * inv); w.y = cvt_pk_bf16(o[dt][2] * inv, o[dt][3] * inv); *(u32x2*)(orow + 16 * dt + 4 * fq) = w; }
    }
}


#undef AT_QTOK
#undef AT_LOADQ
template <int MODE> __device__ __forceinline__ void mini_gemm(const int tid, PRef p, int l) {
    const int wave = tid >> 6, lane = tid & 63, fr = lane & 15, fq = lane >> 4;
    const int gw = blockIdx.x * NWAVES + wave, NGW = gridDim.x * NWAVES;
    constexpr int K = MODE == 3 ? ED : (MODE == 1 ? MIXD : D);
    constexpr int N = MODE == 0 ? INC : (MODE == 2 ? 2 * ED : D);
    constexpr int MROWS = MODE <= 1 ? NCTX : NSLOT_C;
    constexpr int NTC = MODE == 2 ? 2 : 1, TW = 16 * NTC;
    constexpr int NTN = N / TW, NT = (MROWS / 32) * NTN;
    for (int t = gw; t < NT; t += NGW) {
        const int rt = t / NTN, ct = t % NTN, c0 = ct * TW;
        const bf16_t* Bt; const bf16_t* arow[2];
        if (MODE == 0) { Bt = p.WIN_T; for (int mt = 0; mt < 2; ++mt) arow[mt] = p.H + (size_t)(NLAT + rt * 32 + 16 * mt + fr) * D; }
        else if (MODE == 1) { Bt = p.WOUT_T; for (int mt = 0; mt < 2; ++mt) arow[mt] = p.MIX + (size_t)(NLAT + rt * 32 + 16 * mt + fr) * MIXD; }
        else if (MODE == 2) { const int e = rt % NE; Bt = p.WGU_T + (size_t)e * 2 * ED * D;
            for (int mt = 0; mt < 2; ++mt) { int row = p.STOK[NSLOT_L + rt * 32 + 16 * mt + fr]; row = row < 0 ? 0 : (row >= NTOK ? NTOK - 1 : row); arow[mt] = p.H + (size_t)row * D; } }
        else { const int e = rt % NE; Bt = p.WD_T + (size_t)e * D * ED; for (int mt = 0; mt < 2; ++mt) arow[mt] = p.HID + (size_t)(NSLOT_L + rt * 32 + 16 * mt + fr) * ED; }
        const bf16_t* brow = Bt + (size_t)(c0 + fr) * K;
        f32x4 acc[2][NTC];
#pragma unroll
        for (int mt = 0; mt < 2; ++mt)
#pragma unroll
            for (int nt = 0; nt < NTC; ++nt) acc[mt][nt] = (f32x4){0.f, 0.f, 0.f, 0.f};
#pragma unroll 8
        for (int ks = 0; ks < K / 32; ++ks) {
            bf16x8 a[2], bfr[NTC];
#pragma unroll
            for (int mt = 0; mt < 2; ++mt) a[mt] = *(const bf16x8*)(arow[mt] + ks * 32 + fq * 8);
#pragma unroll
            for (int nt = 0; nt < NTC; ++nt) bfr[nt] = *(const bf16x8*)(brow + (size_t)(16 * nt) * K + ks * 32 + fq * 8);
#pragma unroll
            for (int mt = 0; mt < 2; ++mt)
#pragma unroll
                for (int nt = 0; nt < NTC; ++nt) acc[mt][nt] = mfma16(a[mt], bfr[nt], acc[mt][nt]);
        }
#pragma unroll
        for (int mt = 0; mt < 2; ++mt)
#pragma unroll
            for (int r = 0; r < 4; ++r) {
                const int lr = rt * 32 + 16 * mt + 4 * fq + r;
                if (MODE == 0) { bf16_t* o = p.P + (size_t)(NLAT + lr) * INC + c0 + fr;
#pragma unroll
                    for (int nt = 0; nt < NTC; ++nt) o[16 * nt] = f2bf(acc[mt][nt][r]); }
                else if (MODE == 1) { float* o = p.XC + (size_t)lr * D + c0 + fr; const float* g = p.MOD + ((size_t)l * 3 + 2) * NMOD + 2 * D + c0 + fr;
#pragma unroll
                    for (int nt = 0; nt < NTC; ++nt) o[16 * nt] += g[16 * nt] * acc[mt][nt][r]; }
                else if (MODE == 2) { bf16_t* o = p.HID + (size_t)(NSLOT_L + lr) * ED + c0 / 2 + fr;
#pragma unroll
                    for (int q = 0; q < NTC / 2; ++q) { const float g = acc[mt][2 * q][r], u = acc[mt][2 * q + 1][r]; o[16 * q] = f2bf(g / (1.f + __expf(-g)) * u); } }
                else { bf16_t* o = p.Y + (size_t)(NSLOT_L + lr) * D + c0 + fr; const float val = p.SVAL[NSLOT_L + lr];
#pragma unroll
                    for (int nt = 0; nt < NTC; ++nt) o[16 * nt] = f2bf(val * acc[mt][nt][r]); }
            }
    }
}


__device__ __forceinline__ void phase_conv(const int tid, PRef p, int l) {
    const float* w = p.conv_w + (size_t)l * 3 * CVD;
    constexpr int U = 2;
    const long nitem = (long)NTOK * (CVD / 8), gstr = (long)gridDim.x * NTHR;
    for (long g0 = (long)blockIdx.x * NTHR + tid; g0 < nitem; g0 += gstr * U) {
        u32x4 cc[U][3], uu[U][3], bg[U]; float vz[U][3]; int rr[U], c8v[U]; bool ok[U];
#pragma unroll
        for (int u = 0; u < U; ++u) {
            long gid = g0 + u * gstr; ok[u] = gid < nitem; if (!ok[u]) gid = g0;
            const int r = (int)(gid / (CVD / 8)), c8 = (int)(gid % (CVD / 8)) * 8; rr[u] = r; c8v[u] = c8;
            int t, T; if (r < NLAT) { t = r % SEQ; T = SEQ; } else { t = (r - NLAT) % CTX; T = CTX; }
            const bf16_t* pr = p.P + (size_t)r * INC + c8;
#pragma unroll
            for (int d = 0; d < 3; ++d) { const int tt = t + d - 1; const bool in = tt >= 0 && tt < T; vz[u][d] = in ? 1.f : 0.f;
                const bf16_t* q = pr + (in ? (long)(d - 1) * INC : 0L); cc[u][d] = *(const u32x4*)(q + OCC); uu[u][d] = *(const u32x4*)(q + OCU); }
            bg[u] = *(const u32x4*)(pr + OCB);
        }
        asm volatile("" ::: "memory");
#pragma unroll
        for (int u = 0; u < U; ++u) {
            float y[8];
#pragma unroll
            for (int j = 0; j < 8; ++j) y[j] = 0.f;
#pragma unroll
            for (int d = 0; d < 3; ++d) {
                const f32x4 w0 = *(const f32x4*)(w + d * CVD + c8v[u]) * vz[u][d], w1 = *(const f32x4*)(w + d * CVD + c8v[u] + 4) * vz[u][d];
#pragma unroll
                for (int j = 0; j < 8; ++j) y[j] += (j < 4 ? w0[j & 3] : w1[j & 3]) * bf8(cc[u][d], j) * bf8(uu[u][d], j);
            }
            u32x4 o; o.x = cvt_pk_bf16(bf8(bg[u], 0) * y[0], bf8(bg[u], 1) * y[1]); o.y = cvt_pk_bf16(bf8(bg[u], 2) * y[2], bf8(bg[u], 3) * y[3]);
            o.z = cvt_pk_bf16(bf8(bg[u], 4) * y[4], bf8(bg[u], 5) * y[5]); o.w = cvt_pk_bf16(bf8(bg[u], 6) * y[6], bf8(bg[u], 7) * y[7]);
            if (ok[u]) *(u32x4*)(p.MIX + (size_t)rr[u] * MIXD + 768 + c8v[u]) = o;
        }
    }
}
__device__ __forceinline__ void phase_qkprep(const int tid, PRef p, int l) {
    const int sub = tid & 7;
    constexpr int U = 4;
    const long ngroups = (long)NTOK * 12, gstride = ((long)gridDim.x * NTHR) >> 3;
    for (long g0 = ((long)blockIdx.x * NTHR + tid) >> 3; g0 < ngroups; g0 += gstride * U) {
        u32x4 raw[U]; bf16_t* ptr[U]; int rr[U]; int wh[U];
#pragma unroll
        for (int u = 0; u < U; ++u) { long g8 = g0 + u * gstride; const bool ok = g8 < ngroups; if (!ok) g8 = g0;
            rr[u] = ok ? (int)(g8 / 12) : -1; wh[u] = (int)(g8 % 12) / 6; const int head = (int)(g8 % 6);
            ptr[u] = p.P + (size_t)(g8 / 12) * INC + (wh[u] ? OK_ : OQ) + head * HD + sub * 8; raw[u] = *(const u32x4*)ptr[u]; }
#pragma unroll
        for (int u = 0; u < U; ++u) {
            const float* nw = (wh[u] ? p.k_norm : p.q_norm) + l * HD + sub * 8;
            float y[8]; float ss = 0.f;
#pragma unroll
            for (int j = 0; j < 8; ++j) { y[j] = bf8(raw[u], j); ss += y[j] * y[j]; }
            ss += __builtin_bit_cast(float, __builtin_amdgcn_ds_swizzle(__builtin_bit_cast(int, ss), (1 << 10) | 0x1f));
            ss += __builtin_bit_cast(float, __builtin_amdgcn_ds_swizzle(__builtin_bit_cast(int, ss), (2 << 10) | 0x1f));
            ss += __builtin_bit_cast(float, __builtin_amdgcn_ds_swizzle(__builtin_bit_cast(int, ss), (4 << 10) | 0x1f));
            const float rstd = 1.f / sqrtf(ss * (1.f / HD) + EPS);
#pragma unroll
            for (int j = 0; j < 8; ++j) y[j] = y[j] * rstd * nw[j];
            const int r = rr[u];
            const bool lat = r >= 0 && r < NLAT;
            const int t = lat ? r % SEQ : 0; const float pos = (sub & 4) ? (float)(t % GW) : (float)(t / GW);
            const bool second = (sub & 2) != 0;
#pragma unroll
            for (int j = 0; j < 8; ++j) {
                const float other = __builtin_bit_cast(float, __builtin_amdgcn_ds_swizzle(__builtin_bit_cast(int, y[j]), (2 << 10) | 0x1f));
                const int fi = (sub & 1) * 8 + j;
                const float ang = pos * __builtin_amdgcn_exp2f(-(float)fi * (13.287712379549449f / 16.f));
                const float cs = FCOS(ang), sn = FSIN(ang);
                const float rot = second ? y[j] * cs + other * sn : y[j] * cs - other * sn;
                y[j] = lat ? rot : y[j];
            }
            if (r >= 0) { u32x4 o; o.x = cvt_pk_bf16(y[0], y[1]); o.y = cvt_pk_bf16(y[2], y[3]); o.z = cvt_pk_bf16(y[4], y[5]); o.w = cvt_pk_bf16(y[6], y[7]); *(u32x4*)ptr[u] = o; }
        }
    }
}

__device__ __forceinline__ f32x4 bf4(const u32x2 w) { return (f32x4){bfw(w.x, 0), bfw(w.x, 1), bfw(w.y, 0), bfw(w.y, 1)}; }
template <int MODE> __device__ __forceinline__ void phase_rows(const int tid, PRef p, int l, LAS unsigned char* lds) {
    static_assert(D == 1024, "wave-per-row kernels assume D = 1024");
    const int lane = tid & 63, wave = tid >> 6;
#define RC(j) (8 * lane + 512 * ((j) >> 1) + 4 * ((j) & 1))
    if (MODE == 1) {
        for (int k = tid; k < D; k += NTHR) { const f32x4* src = (const f32x4*)(p.w_router + ((size_t)l * D + k) * NE); LAS f32x4* dst = (LAS f32x4*)(lds + k * 64 + (k >> 3) * 16);
#pragma unroll
            for (int u = 0; u < 4; ++u) dst[u] = src[u]; }
        __syncthreads();
    }
    const int gw = blockIdx.x * NWAVES + wave, NGW = gridDim.x * NWAVES;
    const int rw = ((NTOK + NGW - 1) / NGW + 1) & ~1;
    const int r_lo = gw * rw, r_hi = min(NTOK, r_lo + rw);
    const bool doh = MODE != 2 || l + 1 < DEPTH;
    const int ln = (MODE == 2 && l + 1 < DEPTH) ? l + 1 : l;
    const float* nw = (MODE == 1 ? p.norm2_w : p.norm1_w) + (size_t)ln * D;
    int curset = -1; f32x4 Av[4], Sv[4], Gv[4];
#pragma unroll
    for (int j = 0; j < 4; ++j) { Av[j] = (f32x4){0.f, 0.f, 0.f, 0.f}; Sv[j] = Av[j]; Gv[j] = Av[j]; }
    u32x4 vn[2][4]; int invn[2] = {-1, -1};
#define ROWS_LOADPAIR(rb) do { _Pragma("unroll") for (int i_ = 0; i_ < 2; ++i_) { const int rr_ = ((rb) + i_ < r_hi) ? (rb) + i_ : (rb); \
        if (MODE != 0 && rr_ < NLAT) { const bf16_t* src_ = p.XB + (size_t)rr_ * D + 8 * lane; vn[i_][0] = *(const u32x4*)src_; vn[i_][1] = *(const u32x4*)(src_ + 512); } \
        else { const float* src_ = MODE == 0 ? (rr_ < NLAT ? p.x + (size_t)rr_ * D : p.ctx + (size_t)(rr_ - NLAT) * D) : p.XC + (size_t)(rr_ - NLAT) * D; \
            _Pragma("unroll") for (int j_ = 0; j_ < 4; ++j_) vn[i_][j_] = *(const u32x4*)(src_ + RC(j_)); } \
        if (MODE == 2) invn[i_] = lane < NE ? p.INV[(size_t)rr_ * NE + lane] : -1; } } while (0)
#pragma unroll
    for (int i = 0; i < 2; ++i)
#pragma unroll
        for (int j = 0; j < 4; ++j) vn[i][j] = (u32x4){0u, 0u, 0u, 0u};
    if (r_lo < r_hi) ROWS_LOADPAIR(r_lo);
#pragma unroll 1
    for (int r = r_lo; r < r_hi; r += 2) {
        const bool two = r + 1 < r_hi;
        const bool lat = r < NLAT;
        const int set = modset(r);
        if (set != curset) { curset = set;
            const float* mod = p.MOD + ((size_t)ln * 3 + set) * NMOD; const float* shift = mod + (MODE == 1 ? 3 : 0) * D; const float* scale = mod + (MODE == 1 ? 4 : 1) * D;
            int lane2 = lane; asm volatile("" : "+v"(lane2));
#pragma unroll
            for (int j = 0; j < 4; ++j) { const int c = 8 * lane2 + 512 * (j >> 1) + 4 * (j & 1); const f32x4 w4 = *(const f32x4*)(nw + c), sc4 = *(const f32x4*)(scale + c); Av[j] = w4 * (sc4 + 1.f); Sv[j] = *(const f32x4*)(shift + c);
                if (MODE == 2) Gv[j] = *(const f32x4*)(p.MOD + ((size_t)l * 3 + set) * NMOD + 5 * D + c); } }
        f32x4 v[2][4]; int inv2[2];
#pragma unroll
        for (int i = 0; i < 2; ++i) { inv2[i] = invn[i];
            if (MODE != 0 && lat) {
#pragma unroll
                for (int jj = 0; jj < 2; ++jj) { const u32x4 w = vn[i][jj]; v[i][2 * jj] = (f32x4){bfw(w.x, 0), bfw(w.x, 1), bfw(w.y, 0), bfw(w.y, 1)}; v[i][2 * jj + 1] = (f32x4){bfw(w.z, 0), bfw(w.z, 1), bfw(w.w, 0), bfw(w.w, 1)}; }
            } else {
#pragma unroll
                for (int j = 0; j < 4; ++j) v[i][j] = __builtin_bit_cast(f32x4, vn[i][j]);
            } }
        if (r + 2 < r_hi) ROWS_LOADPAIR(r + 2);
        if (MODE == 2) {
#pragma unroll
            for (int i = 0; i < 2; ++i) {
                const int myinv = inv2[i];
                unsigned long long mask = __ballot(myinv >= 0 && myinv < NSLOT);
                f32x4 acc[4];
#pragma unroll
                for (int j = 0; j < 4; ++j) acc[j] = (f32x4){0.f, 0.f, 0.f, 0.f};
                while (mask) {
                    const int e0 = __builtin_ctzll(mask); mask &= mask - 1; const int s0 = __builtin_amdgcn_readlane(myinv, e0);
                    int s1 = -1; if (mask) { const int e1 = __builtin_ctzll(mask); mask &= mask - 1; s1 = __builtin_amdgcn_readlane(myinv, e1); }
                    u32x4 y0[2], y1[2];
#pragma unroll
                    for (int jj = 0; jj < 2; ++jj) y0[jj] = *(const u32x4*)(p.Y + (size_t)s0 * D + 8 * lane + 512 * jj);
                    if (s1 >= 0) {
#pragma unroll
                        for (int jj = 0; jj < 2; ++jj) y1[jj] = *(const u32x4*)(p.Y + (size_t)s1 * D + 8 * lane + 512 * jj);
                    }
#pragma unroll
                    for (int jj = 0; jj < 2; ++jj) { acc[2 * jj] = acc[2 * jj] + (f32x4){bfw(y0[jj].x, 0), bfw(y0[jj].x, 1), bfw(y0[jj].y, 0), bfw(y0[jj].y, 1)}; acc[2 * jj + 1] = acc[2 * jj + 1] + (f32x4){bfw(y0[jj].z, 0), bfw(y0[jj].z, 1), bfw(y0[jj].w, 0), bfw(y0[jj].w, 1)}; }
                    if (s1 >= 0) {
#pragma unroll
                        for (int jj = 0; jj < 2; ++jj) { acc[2 * jj] = acc[2 * jj] + (f32x4){bfw(y1[jj].x, 0), bfw(y1[jj].x, 1), bfw(y1[jj].y, 0), bfw(y1[jj].y, 1)}; acc[2 * jj + 1] = acc[2 * jj + 1] + (f32x4){bfw(y1[jj].z, 0), bfw(y1[jj].z, 1), bfw(y1[jj].w, 0), bfw(y1[jj].w, 1)}; }
                    }
                }
#pragma unroll
                for (int j = 0; j < 4; ++j) v[i][j] = v[i][j] + Gv[j] * acc[j];
            }
        }
        if (MODE == 0 || MODE == 2) {
            const bool fin = MODE == 2 && l + 1 == DEPTH;
#pragma unroll
            for (int i = 0; i < 2; ++i) if (i == 0 || two) {
                if (lat && !fin) {
#pragma unroll
                    for (int jj = 0; jj < 2; ++jj) { u32x4 o; o.x = cvt_pk_bf16(v[i][2 * jj][0], v[i][2 * jj][1]); o.y = cvt_pk_bf16(v[i][2 * jj][2], v[i][2 * jj][3]); o.z = cvt_pk_bf16(v[i][2 * jj + 1][0], v[i][2 * jj + 1][1]); o.w = cvt_pk_bf16(v[i][2 * jj + 1][2], v[i][2 * jj + 1][3]);
                        *(u32x4*)(p.XB + (size_t)(r + i) * D + 8 * lane + 512 * jj) = o; }
                } else if (lat || !fin) { float* dst = lat ? p.XL + (size_t)(r + i) * D : p.XC + (size_t)(r + i - NLAT) * D;
#pragma unroll
                    for (int j = 0; j < 4; ++j) *(f32x4*)(dst + RC(j)) = v[i][j]; }
            }
        }
        if (doh) {
            float ss[2];
#pragma unroll
            for (int i = 0; i < 2; ++i) { float a = 0.f;
#pragma unroll
                for (int j = 0; j < 4; ++j) a += (v[i][j][0] * v[i][j][0] + v[i][j][1] * v[i][j][1]) + (v[i][j][2] * v[i][j][2] + v[i][j][3] * v[i][j][3]);
                ss[i] = a; }
            ss[0] = wave_sum(ss[0], lane); ss[1] = wave_sum(ss[1], lane);
            const float rstd0 = 1.f / sqrtf(ss[0] * (1.f / D) + EPS), rstd1 = 1.f / sqrtf(ss[1] * (1.f / D) + EPS);
            f32x4 hh[2][4];
#pragma unroll
            for (int j = 0; j < 4; ++j) { hh[0][j] = v[0][j] * rstd0 * Av[j] + Sv[j]; hh[1][j] = v[1][j] * rstd1 * Av[j] + Sv[j]; }
#pragma unroll
            for (int i = 0; i < 2; ++i) if (i == 0 || two) {
#pragma unroll
                for (int jj = 0; jj < 2; ++jj) { u32x4 o; o.x = cvt_pk_bf16(hh[i][2 * jj][0], hh[i][2 * jj][1]); o.y = cvt_pk_bf16(hh[i][2 * jj][2], hh[i][2 * jj][3]); o.z = cvt_pk_bf16(hh[i][2 * jj + 1][0], hh[i][2 * jj + 1][1]); o.w = cvt_pk_bf16(hh[i][2 * jj + 1][2], hh[i][2 * jj + 1][3]);
                    *(u32x4*)(p.H + (size_t)(r + i) * D + 8 * lane + 512 * jj) = o; } }
            if (MODE == 1) {
                LAS float* red = (LAS float*)(lds + 70144 + wave * 4224);
#pragma unroll
                for (int i = 0; i < 2; ++i) {
                    float lg[NE];
#pragma unroll
                    for (int e = 0; e < NE; ++e) lg[e] = 0.f;
#pragma unroll
                    for (int j = 0; j < 4; ++j)
#pragma unroll
                        for (int q = 0; q < 4; ++q) { const int k = RC(j) + q; const LAS f32x4* wr = (const LAS f32x4*)(lds + k * 64 + (k >> 3) * 16); const float hv = hh[i][j][q];
#pragma unroll
                            for (int u = 0; u < 4; ++u) { const f32x4 w = wr[u]; lg[4 * u + 0] += hv * w[0]; lg[4 * u + 1] += hv * w[1]; lg[4 * u + 2] += hv * w[2]; lg[4 * u + 3] += hv * w[3]; } }
#pragma unroll
                    for (int e = 0; e < NE; ++e) red[e * 65 + lane] = lg[e];
                    asm volatile("" ::: "memory");
                    const int e2 = lane & 15, part = lane >> 4;
                    float t = 0.f;
#pragma unroll
                    for (int x = 0; x < 16; ++x) t += red[e2 * 65 + part * 16 + x];
                    asm volatile("" ::: "memory");
                    t += __builtin_bit_cast(float, __builtin_amdgcn_ds_swizzle(__builtin_bit_cast(int, t), (16 << 10) | 0x1f));
                    t += __builtin_bit_cast(float, __builtin_amdgcn_ds_bpermute((lane ^ 32) << 2, __builtin_bit_cast(int, t)));
#define SWZF(x, d) __builtin_bit_cast(float, __builtin_amdgcn_ds_swizzle(__builtin_bit_cast(int, (x)), ((d) << 10) | 0x1f))
                    float m = t;
                    m = fmaxf(m, SWZF(m, 1)); m = fmaxf(m, SWZF(m, 2)); m = fmaxf(m, SWZF(m, 4)); m = fmaxf(m, SWZF(m, 8));
                    const float ex = expf(t - m); float sm = ex;
                    sm += SWZF(sm, 1); sm += SWZF(sm, 2); sm += SWZF(sm, 4); sm += SWZF(sm, 8);
#undef SWZF
                    if (lane < NE && (i == 0 || two)) p.AFF[(size_t)(r + i) * NE + lane] = ex / sm;
                }
            }
        }
    }
#undef ROWS_LOADPAIR
#undef RC
    if (MODE == 1) __syncthreads();
}


__device__ __forceinline__ void phase_adaln(const int tid, PRef p, LAS unsigned char* lds) {
    static_assert(D == 1024 && NMOD % 256 == 0, "adaln layout");
    const int lane = tid & 63, wave = tid >> 6;
    LAS float* SC = (LAS float*)lds;
    LAS float* RED = (LAS float*)(lds + 16384);
    for (int i = tid; i < 3 * D; i += NTHR) { const int st = i / D, k = i % D; const float cv = st < 2 ? p.c[st * D + k] : p.c_ctx[k]; SC[i] = cv / (1.f + __expf(-cv)); }
    __syncthreads();
    constexpr int NCG = NMOD / 256;
    for (int item = blockIdx.x; item < DEPTH * NCG * 2; item += gridDim.x) {
        const int l = item / (NCG * 2), rem = item % (NCG * 2), cgp = rem >> 1, kh = rem & 1;
        const int kbase = kh * 512 + wave * 64;
        const float* wp = p.w_mod + ((size_t)l * D + kbase) * NMOD + cgp * 256 + 4 * lane;
        f32x4 acc[3];
#pragma unroll
        for (int st = 0; st < 3; ++st) acc[st] = (f32x4){0.f, 0.f, 0.f, 0.f};
#pragma unroll 16
        for (int kk = 0; kk < 64; ++kk) { const f32x4 w = *(const f32x4*)(wp + (size_t)kk * NMOD);
#pragma unroll
            for (int st = 0; st < 3; ++st) acc[st] = acc[st] + w * SC[st * D + kbase + kk]; }
#pragma unroll
        for (int st = 0; st < 3; ++st) *(LAS f32x4*)(RED + (wave * 3 + st) * 256 + 4 * lane) = acc[st];
        __syncthreads();
        for (int o = tid; o < 3 * 256; o += NTHR) { const int st = o >> 8, n = o & 255; float v = 0.f;
#pragma unroll
            for (int w8 = 0; w8 < 8; ++w8) v += RED[(w8 * 3 + st) * 256 + n];
            if (kh == 0) v += p.b_mod[(size_t)l * NMOD + cgp * 256 + n];
            atomicAdd(p.MOD + ((size_t)l * 3 + st) * NMOD + cgp * 256 + n, v); }
        __syncthreads();
    }
}

constexpr int NPL = 11, NPH = 1 + DEPTH * NPL;
struct Args { Params p; int ph_lo, ph_hi; };
__global__ void __launch_bounds__(NTHR, 2) mega_fwd(Args args) {
    LAS unsigned char* lds = (LAS unsigned char*)lds_raw;
    {
        const int tid0 = threadIdx.x;
        for (int u = tid0; u < (LDS_BYTES - LDSCTL_OFF) / 4; u += NTHR) ((LAS unsigned*)(lds + LDSCTL_OFF))[u] = 0u;
        __syncthreads();
    }
    int wslot = 0;
    { unsigned m_ = ~0u; asm volatile("" : "+s"(m_));
      const int simd = (int)(__builtin_amdgcn_s_getreg((1 << 11) | (4 << 6) | 4) & 3u);
      if (__builtin_amdgcn_mbcnt_hi(m_, __builtin_amdgcn_mbcnt_lo(m_, 0u)) == 0) wslot = simd + 4 * (int)__hip_atomic_fetch_add(((unsigned*)(lds_raw + MISC_OFF + 64)) + simd, 1u, __ATOMIC_RELAXED, __HIP_MEMORY_SCOPE_WORKGROUP); }
    wslot = __builtin_amdgcn_readfirstlane(wslot) & 7;
#define MY_TID(var) int var; { unsigned m_ = ~0u; asm volatile("" : "+s"(m_)); var = wslot * 64 + (int)__builtin_amdgcn_mbcnt_hi(m_, __builtin_amdgcn_mbcnt_lo(m_, 0u)); } asm volatile("" : "+v"(var))
    XcdBarrier bar; bar.bar = args.p.CTL; bar.x = 0;
    const bool multi = args.ph_hi - args.ph_lo > 1;
    if (multi) { MY_TID(t0); bar = xcd_barrier_post(args.p.CTL, t0 == 0); }
    const int G = gridDim.x;
    const int ph_lo = args.ph_lo, ph_hi = args.ph_hi;
#ifndef PHMASK
#define PHMASK 0xFFFF
#endif
#define PH_ON(k) ((k) == 0 ? (PHMASK & 1) : ((PHMASK >> (1 + ((k) - 1) % NPL)) & 1))
#ifndef REPMASK
#define REPMASK 0
#endif
#ifndef REP_LOCAL
#define REP_LOCAL 0
#define REP_CONV 0
#define REP_ATTN 0
#endif
#ifndef HG_STOP
#define HG_STOP 0
#endif
#ifndef REP_P0
#define REP_P0 0
#endif
#define REP_N(k) (((k) == 0 && REP_P0) ? 2 : (((k) > 0 && ((REPMASK >> (((k) - 1) % NPL)) & 1)) ? 2 : 1))
#define PH_BEGIN(k) if (PH_ON(k) && ph_lo <= (k) && (k) < ph_hi) { for (int rep_ = 0; rep_ < REP_N(k); ++rep_) { const AS4 Args* kp = (const AS4 Args*)__builtin_amdgcn_kernarg_segment_ptr(); asm volatile("" : "+s"(kp)); PRef p = kp->p; MY_TID(tid);
#define PH_END_IF(k, cond) } if ((cond) && (k) + 1 < ph_hi) { MY_TID(t1); xcd_barrier(bar, t1 == 0, XB_ST(lds_raw)); } }
#ifndef REP_CVT
#define REP_CVT 0
#endif
#ifndef REP_BAR
#define REP_BAR 0
#endif
#define PH_END(k) } if ((k) + 1 < ph_hi) { for (int rb_ = 0; rb_ < 1 + REP_BAR; ++rb_) { MY_TID(t1); xcd_barrier(bar, t1 == 0, XB_ST(lds_raw)); } } }
    PH_BEGIN(0)
        phase_adaln(tid, p, lds);
        run_items<b_lb>(tid, p, 0, 2L * 384, 0);
        phase_convert(tid, p, 0, lds, 1, 0);
    PH_END(0)
#define LAYER(l)                                                                                                                                     \
    PH_BEGIN(1 + (l) * NPL + 0) if ((l) == 0) { phase_rows<0>(tid, p, 0, lds); } PH_END_IF(1 + (l) * NPL + 0, (l) == 0)                                 \
    PH_BEGIN(1 + (l) * NPL + 1) {                                                                                                                    \
        pg8::Gemm g{p.H, p.WIN_T, NTOK, INC, D, nullptr, 0, 1, 0}; pg8::StaticOrder S; S.init(NTOK, INC, G, (int)blockIdx.x);                         \
        pg8::EpiP E{p.P, INC, p.q_norm + (l) * HD, p.k_norm + (l) * HD, rep_};                                                    \
        pg8::gemm_phase<pg8::EpiP, false>(tid, lds, g, S, E);                                                                                     \
        } PH_END(1 + (l) * NPL + 1)               \
    PH_BEGIN(1 + (l) * NPL + 2) if constexpr (!FUSE_QK) { phase_qkprep(tid, p, l); } if constexpr (FAST_HGRN && (HGRN_DIAG == 3 || HGRN_DIAG == 4)) { phase_hgrn_local(tid, p, l, lds); { MY_TID(t7); run_items<b_hgrn_local_slow>(t7, p, l, 2L * NBH * NCH * 64, 0); } } else if constexpr (FAST_HGRN && HGRN_DIAG >= 2) { run_items<b_hgrn_local_slow>(tid, p, l, 2L * NBH * NCH * 64, 0); } else if constexpr (FAST_HGRN) { for (int r2_ = 0; r2_ < 1 + REP_LOCAL; ++r2_) phase_hgrn_local(tid, p, l, lds); } else { run_items<b_gates>(tid, p, l, (long)NTOK * 768, 0); } phase_conv(tid, p, l); PH_END(1 + (l) * NPL + 2) \
    PH_BEGIN(1 + (l) * NPL + 3) if constexpr (FAST_HGRN && HGRN_DIAG) { run_items<b_hgrn_scan_slow>(tid, p, l, 2L * NBH * 4096, 0); } else if constexpr (FAST_HGRN) { phase_hgrn_scan(tid, p); } else { run_items<b_hgrn_seq2>(tid, p, l, 2L * NB * HGH * 64, 0); } if constexpr (FAST_ATTN) { for (int r4_ = 0; r4_ < 1 + REP_ATTN; ++r4_) { MY_TID(t6); phase_attn(t6, p, l, lds); } } else { run_items<b_attn>(tid, p, l, (long)NTOK * NAH, 0); } PH_END(1 + (l) * NPL + 3) \
    PH_BEGIN(1 + (l) * NPL + 4) if constexpr (FAST_HGRN && HGRN_DIAG) { run_items<b_hgrn_chunkseq>(tid, p, l, 2L * NBH * NCH * 64, 0); { MY_TID(t9); xcd_barrier(bar, t9 == 0, XB_ST(lds_raw)); } { MY_TID(t8); run_items<b_hgfin>(t8, p, l, (long)NTOK * HGH, 0); } } else if constexpr (FAST_HGRN) { phase_hgrn_out(tid, p, l, lds); } else { run_items<b_hgfin>(tid, p, l, (long)NTOK * HGH, 0); } PH_END(1 + (l) * NPL + 4)                                         \
    PH_BEGIN(1 + (l) * NPL + 5) {                                                                                                                    \
        pg8::Gemm g{p.MIX, p.WOUT_T, NLAT, D, MIXD, nullptr, 0, 1, 0}; pg8::StaticOrder S; S.init(NLAT, D, G, (int)blockIdx.x);                       \
        pg8::EpiRes E{p.XB, D, p.MOD + (size_t)(l) * 3 * NMOD + 2 * D, SEQ, (size_t)NMOD};                                                           \
        pg8::gemm_phase<pg8::EpiRes, false>(tid, lds, g, S, E);                                                                                      \
        if ((l) + 1 < DEPTH) { MY_TID(tid2); mini_gemm<1>(tid2, p, l); } } PH_END(1 + (l) * NPL + 5)                  \
    PH_BEGIN(1 + (l) * NPL + 6) phase_rows<1>(tid, p, l, lds); PH_END(1 + (l) * NPL + 6)                                                               \
    PH_BEGIN(1 + (l) * NPL + 7) if constexpr (FAST_TOPK) { phase_topk(tid, p, lds); if ((l) == 0 && gridDim.x > 2 * NB * NE + 32) { MY_TID(t4); phase_convert(t4, p, 0, lds, 2, 2 * NB * NE); } else if ((l) == 0) { MY_TID(t4); phase_convert(t4, p, 0, lds, 2, 0); } } else { run_items<b_rank>(tid, p, l, (long)NTOK * NE, 0); } PH_END(1 + (l) * NPL + 7)                                          \
    PH_BEGIN(1 + (l) * NPL + 8) {                                                                                                                    \
        pg8::Gemm g{p.H, p.WGU_T, NSLOT_L, 2 * ED, D, p.STOK, CAPL / 256, NE, (size_t)2 * ED * D * 2}; pg8::StaticOrder S; S.init(NSLOT_L, 2 * ED, G, (int)blockIdx.x); \
        pg8::EpiHid E{p.HID, ED};                                                                                                                    \
        pg8::gemm_phase<pg8::EpiHid, true>(tid, lds, g, S, E);                                                                                       \
        if ((l) + 1 < DEPTH) { MY_TID(tid2); mini_gemm<2>(tid2, p, l); } } PH_END(1 + (l) * NPL + 8)              \
    PH_BEGIN(1 + (l) * NPL + 9) {                                                                                                                    \
        pg8::Gemm g{p.HID, p.WD_T, NSLOT_L, D, ED, nullptr, CAPL / 256, NE, (size_t)D * ED * 2}; pg8::StaticOrder S; S.init(NSLOT_L, D, G, (int)blockIdx.x); \
        pg8::EpiBf16 E{p.Y, D, p.SVAL, 0};                                                                                                              \
        pg8::gemm_phase<pg8::EpiBf16, false>(tid, lds, g, S, E);                                                                                     \
        if ((l) + 1 < DEPTH) { MY_TID(tid2); mini_gemm<3>(tid2, p, l); } } PH_END(1 + (l) * NPL + 9)                \
    PH_BEGIN(1 + (l) * NPL + 10) phase_rows<2>(tid, p, l, lds); if ((l) + 1 < DEPTH) { for (int rc_ = 0; rc_ < 1 + REP_CVT; ++rc_) { MY_TID(t5); phase_convert(t5, p, (l) + 1, lds); } } PH_END(1 + (l) * NPL + 10)
#ifndef NLAYERS_BUILD
#define NLAYERS_BUILD DEPTH
#endif
    LAYER(0)
    if constexpr (NLAYERS_BUILD > 1) { LAYER(1) }
    if constexpr (NLAYERS_BUILD > 2) { LAYER(2) }
    if constexpr (NLAYERS_BUILD > 3) { LAYER(3) }
}

#ifndef MK_SPLIT
#define MK_SPLIT 0
#endif
extern "C" void kernel_launch(void* const* d_in, const int* in_sizes, int n_in, void* d_out, int out_size, void* d_ws, size_t ws_size,
                              hipStream_t stream) {
    static int grid = 0;
    if (grid == 0) {
        if (n_in != 20 || out_size != NLAT * D || ws_size < WS_END) { fprintf(stderr, "kernel_launch: unexpected problem (n_in %d out %d ws %zu need %zu)\n", n_in, out_size, ws_size, (size_t)WS_END); grid = -1; return; }
        int dev = 0, cus = 0;
        if (hipGetDevice(&dev) != hipSuccess || hipDeviceGetAttribute(&cus, hipDeviceAttributeMultiprocessorCount, dev) != hipSuccess) { grid = -1; return; }
        if (hipFuncSetAttribute((const void*)mega_fwd, hipFuncAttributeMaxDynamicSharedMemorySize, LDS_BYTES) != hipSuccess) { fprintf(stderr, "kernel_launch: hipFuncSetAttribute failed\n"); grid = -1; return; }
        int per_cu = 0;
        if (hipOccupancyMaxActiveBlocksPerMultiprocessor(&per_cu, (const void*)mega_fwd, NTHR, LDS_BYTES) != hipSuccess || per_cu < 1) { fprintf(stderr, "kernel_launch: occupancy query says %d\n", per_cu); }
        (void)hipGetLastError();
        grid = cus;
    }
    if (grid < 0) return;
    (void)hipMemsetAsync((char*)d_ws + WS_CTL, 0, WS_LB - WS_CTL, stream);
    Args a{};
    a.p = make_params(d_in, d_out, d_ws);
#if MK_SPLIT
    for (int ph = 0; ph < NPH; ++ph) { a.ph_lo = ph; a.ph_hi = ph + 1; hipLaunchKernelGGL(mega_fwd, dim3(grid), dim3(NTHR), LDS_BYTES, stream, a); }
#else
    a.ph_lo = 0; a.ph_hi = NPH;
    hipLaunchKernelGGL(mega_fwd, dim3(grid), dim3(NTHR), LDS_BYTES, stream, a);
#endif
}
#endif
```

```cpp
#ifndef CPU_SIM
#include <hip/hip_runtime.h>
#define BODY __device__ __forceinline__
#define FSIN(x) __sinf(x)
#define FCOS(x) __cosf(x)
#else
#include <cmath>
#include <cstdio>
#include <cstdlib>
#include <cstring>
#define BODY static inline
#define FSIN(x) sinf(x)
#define FCOS(x) cosf(x)
#endif
#include <stdint.h>
#include <stddef.h>

#ifndef CFG_D
#define CFG_D 1024
#define CFG_SEQ 16384
#define CFG_CTX 256
#define CFG_EDIM 512
#define CFG_DEPTH 4
#endif

typedef unsigned short bf16_t;

constexpr int D = CFG_D, NB = 2, SEQ = CFG_SEQ, DEPTH = CFG_DEPTH, GW = 64, ROWS = SEQ / GW, CTX = CFG_CTX;
constexpr int HD = 64, NAH = 6, HGH = 6, CVD = 256, MIXD = 1024, INC = 3840, NMOD = 6 * D;
constexpr int NE = 16, ED = CFG_EDIM, CAPL = 2 * SEQ / NE, CAPC = 2 * CTX / NE;
constexpr int NLAT = NB * SEQ, NCTX = NB * CTX, NTOK = NLAT + NCTX;
constexpr int NSLOT_L = NB * NE * CAPL, NSLOT_C = NB * NE * CAPC, NSLOT = NSLOT_L + NSLOT_C;
constexpr int OQ = 0, OK_ = 384, OV = 768, OHQ = 1152, OFF_ = 1536, OFB = 1920, OHI = 2304, OHG_ = 2688, OCB = 3072, OCC = 3328, OCU = 3584;
constexpr float EPS = 1e-6f;
constexpr int NCH = (CTX + SEQ) / 64, NCHC = CTX / 64, NBH = NB * HGH;

struct Params {
    const float *x, *c, *ctx, *c_ctx, *w_mod, *b_mod, *norm1_w, *w_in, *q_norm, *k_norm, *rpb, *lb_logits, *hg_norm, *conv_w, *w_out,
        *norm2_w, *w_router, *w_gate, *w_up, *w_down;
    float *XL, *XC, *MOD, *LB, *AFF, *SVAL, *FG, *OHG;
    bf16_t *H, *P, *MIX, *HID, *Y;
    int *STOK, *INV;
    bf16_t *WIN_T, *WOUT_T, *WGU_T, *WD_T;
    unsigned* CTL;
    bf16_t* SLOC;
    float* GDEC;
    bf16_t* XB;
};

#ifndef CPU_SIM
#define AS4 __attribute__((address_space(4)))
typedef const AS4 Params& PRef;
#else
typedef const Params& PRef;
#endif
BODY float bf2f(bf16_t v) { return __builtin_bit_cast(float, (unsigned)v << 16); }
BODY bf16_t f2bf(float f) { unsigned u = __builtin_bit_cast(unsigned, f); u += 0x7fffu + ((u >> 16) & 1u); return (bf16_t)(u >> 16); }
BODY float silu_f(float x) { return x / (1.f + expf(-x)); }
BODY float sigmoid_f(float x) { return 1.f / (1.f + expf(-x)); }
BODY int modset(int r) { return r < NLAT ? r / SEQ : 2; }
BODY float* xrow(PRef p, int r) { return r < NLAT ? p.XL + (size_t)r * D : p.XC + (size_t)(r - NLAT) * D; }

BODY void b_adaln(long gid, PRef p, int) {
    const int n = (int)(gid % NMOD), s = (int)((gid / NMOD) % 3), l = (int)(gid / (3 * NMOD));
    const float* cv = s < 2 ? p.c + s * D : p.c_ctx;
    const float* w = p.w_mod + (size_t)l * D * NMOD + n;
    float acc = 0.f;
    for (int k = 0; k < D; ++k) acc += silu_f(cv[k]) * w[(size_t)k * NMOD];
    p.MOD[gid] = acc + p.b_mod[l * NMOD + n];
}
BODY void b_lb(long gid, PRef p, int) {
    const int dir = (int)(gid / 384), j = (int)(gid % 384);
    const float* lg = p.lb_logits + (size_t)dir * DEPTH * 384 + j;
    float m = -INFINITY;
    for (int l = 0; l < DEPTH; ++l) m = fmaxf(m, lg[l * 384]);
    float s = 0.f;
    for (int l = 0; l < DEPTH; ++l) s += expf(lg[l * 384] - m);
    float cum = 0.f;
    p.LB[(dir * DEPTH + 0) * 384 + j] = 0.f;
    for (int l = 1; l < DEPTH; ++l) { cum += expf(lg[l * 384] - m) / s; p.LB[(dir * DEPTH + l) * 384 + j] = cum; }
}
BODY void b_copyx(long gid, PRef p, int) {
    if (gid < (long)NLAT * D) p.XL[gid] = p.x[gid]; else p.XC[gid - (long)NLAT * D] = p.ctx[gid - (long)NLAT * D];
}
template <int WHICH> BODY void b_prenorm(long gid, PRef p, int l) {
    const int r = (int)gid;
    const float* xr = xrow(p, r);
    const float* nw = (WHICH ? p.norm2_w : p.norm1_w) + l * D;
    const float* mod = p.MOD + ((size_t)l * 3 + modset(r)) * NMOD;
    const float* shift = mod + (WHICH ? 3 : 0) * D;
    const float* scale = mod + (WHICH ? 4 : 1) * D;
    float ss = 0.f;
    for (int k = 0; k < D; ++k) ss += xr[k] * xr[k];
    const float rstd = 1.f / sqrtf(ss / D + EPS);
    float lg[NE];
#pragma unroll
    for (int e = 0; e < NE; ++e) lg[e] = 0.f;
    for (int k = 0; k < D; ++k) {
        const float h = xr[k] * rstd * nw[k] * (1.f + scale[k]) + shift[k];
        p.H[(size_t)r * D + k] = f2bf(h);
        if (WHICH) {
            const float* wr = p.w_router + ((size_t)l * D + k) * NE;
#pragma unroll
            for (int e = 0; e < NE; ++e) lg[e] += h * wr[e];
        }
    }
    if (WHICH) {
        float m = lg[0];
#pragma unroll
        for (int e = 1; e < NE; ++e) m = fmaxf(m, lg[e]);
        float s = 0.f;
#pragma unroll
        for (int e = 0; e < NE; ++e) { lg[e] = expf(lg[e] - m); s += lg[e]; }
#pragma unroll
        for (int e = 0; e < NE; ++e) p.AFF[(size_t)r * NE + e] = lg[e] / s;
    }
}
BODY void b_gemm_in(long gid, PRef p, int l) {
    const int r = (int)(gid / (INC / 4)), n = (int)(gid % (INC / 4)) * 4;
    const bf16_t* a = p.H + (size_t)r * D;
    const float* w = p.w_in + (size_t)l * D * INC + n;
    float a0 = 0.f, a1 = 0.f, a2 = 0.f, a3 = 0.f;
    for (int k = 0; k < D; ++k) { const float av = bf2f(a[k]); const float* wk = w + (size_t)k * INC; a0 += av * wk[0]; a1 += av * wk[1]; a2 += av * wk[2]; a3 += av * wk[3]; }
    bf16_t* o = p.P + (size_t)r * INC + n;
    o[0] = f2bf(a0); o[1] = f2bf(a1); o[2] = f2bf(a2); o[3] = f2bf(a3);
}
BODY void b_qkprep(long gid, PRef p, int l) {
    const int r = (int)(gid / 12), which = (int)(gid % 12) / 6, head = (int)(gid % 6);
    bf16_t* ptr = p.P + (size_t)r * INC + (which ? OK_ : OQ) + head * HD;
    const float* nw = (which ? p.k_norm : p.q_norm) + l * HD;
    float y[HD];
    float ss = 0.f;
#pragma unroll
    for (int d = 0; d < HD; ++d) { y[d] = bf2f(ptr[d]); ss += y[d] * y[d]; }
    const float rstd = 1.f / sqrtf(ss / HD + EPS);
#pragma unroll
    for (int d = 0; d < HD; ++d) y[d] = y[d] * rstd * nw[d];
    if (r < NLAT) {
        const int t = r % SEQ; const float row = (float)(t / GW), col = (float)(t % GW);
#pragma unroll
        for (int d = 0; d < 16; ++d) {
            const float inv = powf(10000.f, -(float)d / 16.f);
            const float ar = row * inv, ac = col * inv;
            const float cr = FCOS(ar), sr = FSIN(ar), cc = FCOS(ac), sc = FSIN(ac);
            const float x0 = y[d], x1 = y[d + 16], x2 = y[d + 32], x3 = y[d + 48];
            y[d] = x0 * cr - x1 * sr; y[d + 16] = x1 * cr + x0 * sr; y[d + 32] = x2 * cc - x3 * sc; y[d + 48] = x3 * cc + x2 * sc;
        }
    }
#pragma unroll
    for (int d = 0; d < HD; ++d) ptr[d] = f2bf(y[d]);
}
BODY void b_attn(long gid, PRef p, int l) {
    const int r = (int)(gid / NAH), head = (int)(gid % NAH);
    float q[HD], acc[HD];
    const bf16_t* qp = p.P + (size_t)r * INC + OQ + head * HD;
#pragma unroll
    for (int d = 0; d < HD; ++d) { q[d] = bf2f(qp[d]) * 0.125f; acc[d] = 0.f; }
    float m = -INFINITY, s = 0.f;
    const int b = r < NLAT ? r / SEQ : (r - NLAT) / CTX;
    const int nloc = r < NLAT ? 128 : 0;
    int row = 0, col = 0, rs = 0, ws = 0;
    if (r < NLAT) { const int t = r % SEQ; row = t / GW; col = t % GW; rs = row - 4; rs = rs < 0 ? 0 : (rs > ROWS - 8 ? ROWS - 8 : rs); ws = col - 8; ws = ws < 0 ? 0 : (ws > GW - 16 ? GW - 16 : ws); }
    for (int j = 0; j < nloc + CTX; ++j) {
        int kr; float bias = 0.f;
        if (j < nloc) { const int i = j / 16, jj = j % 16; kr = b * SEQ + (rs + i) * GW + ws + jj; bias = p.rpb[(((size_t)l * NAH + head) * 15 + (rs + i - row + 7)) * 31 + (ws + jj - col + 15)]; }
        else kr = NLAT + b * CTX + (j - nloc);
        const bf16_t* kp = p.P + (size_t)kr * INC + OK_ + head * HD;
        const bf16_t* vp = p.P + (size_t)kr * INC + OV + head * HD;
        float sc = 0.f;
#pragma unroll
        for (int d = 0; d < HD; ++d) sc += q[d] * bf2f(kp[d]);
        sc += bias;
        const float mn = fmaxf(m, sc), corr = expf(m - mn), pj = expf(sc - mn);
        s = s * corr + pj;
#pragma unroll
        for (int d = 0; d < HD; ++d) acc[d] = acc[d] * corr + pj * bf2f(vp[d]);
        m = mn;
    }
    const float inv = 1.f / s;
    bf16_t* o = p.MIX + (size_t)r * MIXD + head * HD;
#pragma unroll
    for (int d = 0; d < HD; ++d) o[d] = f2bf(acc[d] * inv);
}
BODY void b_gates(long gid, PRef p, int l) {
    const int j = (int)(gid % 384), dir = (int)((gid / 384) % 2), r = (int)(gid / 768);
    const float z = bf2f(p.P[(size_t)r * INC + (dir ? OFB : OFF_) + j]);
    const float lbv = p.LB[(dir * DEPTH + l) * 384 + j];
    p.FG[gid] = lbv + (1.f - lbv) * sigmoid_f(z);
}
template <int DIR> BODY void b_hgrn_seq(long gid, PRef p, int) {
    const int v = (int)(gid % 64), h = (int)((gid / 64) % HGH), b = (int)(gid / (64 * HGH));
    float S[64];
#pragma unroll
    for (int k = 0; k < 64; ++k) S[k] = 0.f;
    for (int step = 0; step < CTX + SEQ; ++step) {
        int r;
        if (step < CTX) r = NLAT + b * CTX + (DIR ? CTX - 1 - step : step);
        else r = b * SEQ + (DIR ? SEQ - 1 - (step - CTX) : (step - CTX));
        const float vv = bf2f(p.P[(size_t)r * INC + OHI + h * 64 + v]);
        const float* fr = p.FG + ((size_t)r * 2 + DIR) * 384 + h * 64;
        const bf16_t* qr = p.P + (size_t)r * INC + OHQ + h * 64;
        float o = 0.f;
#pragma unroll
        for (int k = 0; k < 64; ++k) { const float f = fr[k]; S[k] = f * S[k] + (1.f - f) * vv; o += S[k] * bf2f(qr[k]); }
        o *= 0.125f;
        p.OHG[((size_t)DIR * NTOK + r) * 384 + h * 64 + v] = o;
    }
}
BODY void b_hgfin(long gid, PRef p, int l) {
    const int r = (int)(gid / HGH), h = (int)(gid % HGH);
    const float* op = p.OHG + (size_t)r * 384 + h * 64;
    const float* op1 = op + (size_t)NTOK * 384;
    float o[64]; float ss = 0.f;
#pragma unroll
    for (int v = 0; v < 64; ++v) { o[v] = op[v] + op1[v]; ss += o[v] * o[v]; }
    const float rstd = 1.f / sqrtf(ss / 64.f + EPS);
    const bf16_t* g = p.P + (size_t)r * INC + OHG_ + h * 64;
    bf16_t* out = p.MIX + (size_t)r * MIXD + 384 + h * 64;
#pragma unroll
    for (int v = 0; v < 64; ++v) out[v] = f2bf(o[v] * rstd * p.hg_norm[l * 64 + v] * silu_f(bf2f(g[v])));
}
BODY void b_conv(long gid, PRef p, int l) {
    const int ch = (int)(gid % CVD), r = (int)(gid / CVD);
    int t, T;
    if (r < NLAT) { t = r % SEQ; T = SEQ; } else { t = (r - NLAT) % CTX; T = CTX; }
    const float* w = p.conv_w + (size_t)l * 3 * CVD + ch;
    float y = 0.f;
    for (int j = 0; j < 3; ++j) {
        const int tt = t + j - 1;
        if (tt < 0 || tt >= T) continue;
        const bf16_t* pr = p.P + (size_t)(r + j - 1) * INC;
        y += w[j * CVD] * bf2f(pr[OCC + ch]) * bf2f(pr[OCU + ch]);
    }
    p.MIX[(size_t)r * MIXD + 768 + ch] = f2bf(bf2f(p.P[(size_t)r * INC + OCB + ch]) * y);
}
BODY void b_gemm_out(long gid, PRef p, int l) {
    const int r = (int)(gid / (D / 4)), n = (int)(gid % (D / 4)) * 4;
    const bf16_t* a = p.MIX + (size_t)r * MIXD;
    const float* w = p.w_out + (size_t)l * MIXD * D + n;
    float a0 = 0.f, a1 = 0.f, a2 = 0.f, a3 = 0.f;
    for (int k = 0; k < MIXD; ++k) { const float av = bf2f(a[k]); const float* wk = w + (size_t)k * D; a0 += av * wk[0]; a1 += av * wk[1]; a2 += av * wk[2]; a3 += av * wk[3]; }
    const float* g = p.MOD + ((size_t)l * 3 + modset(r)) * NMOD + 2 * D + n;
    float* xr = xrow(p, r) + n;
    xr[0] += g[0] * a0; xr[1] += g[1] * a1; xr[2] += g[2] * a2; xr[3] += g[3] * a3;
}
BODY void b_rank(long gid, PRef p, int) {
    const int e = (int)(gid % NE), r = (int)(gid / NE);
    int t, T, row0, cap, base;
    if (r < NLAT) { const int b = r / SEQ; t = r % SEQ; T = SEQ; row0 = b * SEQ; cap = CAPL; base = (b * NE + e) * CAPL; }
    else { const int b = (r - NLAT) / CTX; t = (r - NLAT) % CTX; T = CTX; row0 = NLAT + b * CTX; cap = CAPC; base = NSLOT_L + (b * NE + e) * CAPC; }
    const float a = p.AFF[(size_t)r * NE + e];
    const float* col = p.AFF + (size_t)row0 * NE + e;
    int rank = 0;
    for (int tt = 0; tt < T; ++tt) { const float o = col[(size_t)tt * NE]; rank += (o > a || (o == a && tt < t)) ? 1 : 0; }
    if (rank < cap) { p.STOK[base + rank] = r; p.SVAL[base + rank] = a; p.INV[(size_t)r * NE + e] = base + rank; }
    else p.INV[(size_t)r * NE + e] = -1;
}
BODY int slot_expert(int s) { return s < NSLOT_L ? (s / CAPL) % NE : ((s - NSLOT_L) / CAPC) % NE; }
BODY void b_moe1(long gid, PRef p, int l) {
    const int s = (int)(gid / (ED / 4)), f = (int)(gid % (ED / 4)) * 4;
    const int e = slot_expert(s); int row = p.STOK[s]; row = row < 0 ? 0 : (row >= NTOK ? NTOK - 1 : row);
    const bf16_t* a = p.H + (size_t)row * D;
    const float* wg = p.w_gate + ((size_t)l * NE + e) * D * ED + f;
    const float* wu = p.w_up + ((size_t)l * NE + e) * D * ED + f;
    float g0 = 0.f, g1 = 0.f, g2 = 0.f, g3 = 0.f, u0 = 0.f, u1 = 0.f, u2 = 0.f, u3 = 0.f;
    for (int k = 0; k < D; ++k) {
        const float av = bf2f(a[k]); const float* gk = wg + (size_t)k * ED; const float* uk = wu + (size_t)k * ED;
        g0 += av * gk[0]; g1 += av * gk[1]; g2 += av * gk[2]; g3 += av * gk[3];
        u0 += av * uk[0]; u1 += av * uk[1]; u2 += av * uk[2]; u3 += av * uk[3];
    }
    bf16_t* o = p.HID + (size_t)s * ED + f;
    o[0] = f2bf(silu_f(g0) * u0); o[1] = f2bf(silu_f(g1) * u1); o[2] = f2bf(silu_f(g2) * u2); o[3] = f2bf(silu_f(g3) * u3);
}
BODY void b_moe2(long gid, PRef p, int l) {
    const int s = (int)(gid / (D / 4)), n = (int)(gid % (D / 4)) * 4;
    const int e = slot_expert(s);
    const bf16_t* a = p.HID + (size_t)s * ED;
    const float* w = p.w_down + ((size_t)l * NE + e) * ED * D + n;
    float a0 = 0.f, a1 = 0.f, a2 = 0.f, a3 = 0.f;
    for (int k = 0; k < ED; ++k) { const float av = bf2f(a[k]); const float* wk = w + (size_t)k * D; a0 += av * wk[0]; a1 += av * wk[1]; a2 += av * wk[2]; a3 += av * wk[3]; }
    const float val = p.SVAL[s];
    bf16_t* o = p.Y + (size_t)s * D + n;
    o[0] = f2bf(val * a0); o[1] = f2bf(val * a1); o[2] = f2bf(val * a2); o[3] = f2bf(val * a3);
}
BODY void b_combine(long gid, PRef p, int l) {
    const int r = (int)(gid / (D / 4)), n = (int)(gid % (D / 4)) * 4;
    float a0 = 0.f, a1 = 0.f, a2 = 0.f, a3 = 0.f;
    for (int e = 0; e < NE; ++e) {
        const int s = p.INV[(size_t)r * NE + e];
        if (s >= 0) { const bf16_t* y = p.Y + (size_t)s * D + n; a0 += bf2f(y[0]); a1 += bf2f(y[1]); a2 += bf2f(y[2]); a3 += bf2f(y[3]); }
    }
    const float* g = p.MOD + ((size_t)l * 3 + modset(r)) * NMOD + 5 * D + n;
    float* xr = xrow(p, r) + n;
    xr[0] += g[0] * a0; xr[1] += g[1] * a1; xr[2] += g[2] * a2; xr[3] += g[3] * a3;
}


#ifndef HGRN_DIAG
#define HGRN_DIAG 0
#endif
BODY void b_hgrn_chunkseq(long gid, PRef p, int l) {
    const int v = (int)(gid % 64), pc = (int)((gid / 64) % NCH), bh = (int)((gid / (64 * NCH)) % NBH), dir = (int)(gid / (64L * NCH * NBH));
    const int h = bh % HGH, b = bh / HGH, row0 = pc < NCHC ? NLAT + b * CTX + pc * 64 : b * SEQ + (pc - NCHC) * 64;
    const bf16_t* sin = p.SLOC + ((size_t)(dir * NBH + bh) * NCH + pc) * 4096 + v * 64;
    float S[64];
#pragma unroll
    for (int k = 0; k < 64; ++k) S[k] = bf2f(sin[k]);
    for (int i = 0; i < 64; ++i) {
        const int r = row0 + (dir ? 63 - i : i);
        const float vv = bf2f(p.P[(size_t)r * INC + OHI + h * 64 + v]);
        const bf16_t* zr = p.P + (size_t)r * INC + (dir ? OFB : OFF_) + h * 64;
        const bf16_t* qr = p.P + (size_t)r * INC + OHQ + h * 64;
        const float* lb = p.LB + (size_t)(dir * DEPTH + l) * 384 + h * 64;
        float o = 0.f;
#pragma unroll
        for (int k = 0; k < 64; ++k) { const float f = lb[k] + (1.f - lb[k]) * sigmoid_f(bf2f(zr[k])); S[k] = f * S[k] + (1.f - f) * vv; o += S[k] * bf2f(qr[k]); }
        p.OHG[((size_t)dir * NTOK + r) * 384 + h * 64 + v] = o * 0.125f;
    }
}

BODY void b_hgrn_scan_slow(long gid, PRef p, int) {
    const int e = (int)(gid % 4096), sq = (int)(gid / 4096), dir = sq / NBH, k = e & 63;
    bf16_t* S = p.SLOC + (size_t)sq * NCH * 4096 + e;
    const float* G = p.GDEC + (size_t)sq * NCH * 64 + k;
    float c = 0.f;
    for (int j = 0; j < NCH; ++j) {
        const int pc = dir ? (j < NCHC ? NCHC - 1 - j : NCH + NCHC - 1 - j) : j;
        const float x = bf2f(S[(size_t)pc * 4096]);
        S[(size_t)pc * 4096] = f2bf(c);
        c = G[(size_t)pc * 64] * c + x;
    }
}

BODY void b_hgrn_local_slow(long gid, PRef p, int l) {
    const int v = (int)(gid % 64), pc = (int)((gid / 64) % NCH), bh = (int)((gid / (64 * NCH)) % NBH), dir = (int)(gid / (64L * NCH * NBH));
    const int h = bh % HGH, b = bh / HGH, row0 = pc < NCHC ? NLAT + b * CTX + pc * 64 : b * SEQ + (pc - NCHC) * 64;
    float S[64], g[64];
#pragma unroll
    for (int k = 0; k < 64; ++k) { S[k] = 0.f; g[k] = 1.f; }
    for (int i = 0; i < 64; ++i) {
        const int r = row0 + (dir ? 63 - i : i);
        const float vv = bf2f(p.P[(size_t)r * INC + OHI + h * 64 + v]);
        const bf16_t* zr = p.P + (size_t)r * INC + (dir ? OFB : OFF_) + h * 64;
        const float* lb = p.LB + (size_t)(dir * DEPTH + l) * 384 + h * 64;
#pragma unroll
        for (int k = 0; k < 64; ++k) { const float f = lb[k] + (1.f - lb[k]) * sigmoid_f(bf2f(zr[k])); S[k] = f * S[k] + (1.f - f) * vv; g[k] *= f; }
    }
    bf16_t* dst = p.SLOC + ((size_t)(dir * NBH + bh) * NCH + pc) * 4096 + v * 64;
    if (HGRN_DIAG != 3 && HGRN_DIAG != 4) {
#pragma unroll
    for (int k = 0; k < 64; ++k) dst[k] = f2bf(S[k]);
    }
    if (v == 0) {
        float* gd = p.GDEC + ((size_t)(dir * NBH + bh) * NCH + pc) * 64;
#pragma unroll
        for (int k = 0; k < 64; ++k) gd[k] = g[k];
    }
}
#ifndef FAST_TOPK
#define FAST_TOPK 1
#endif
#ifndef FAST_HGRN
#define FAST_HGRN 1
#endif
#ifndef FAST_ATTN
#define FAST_ATTN 1
#endif
constexpr size_t al256(size_t x) { return (x + 255) & ~(size_t)255; }
constexpr size_t CTL_BYTES = 65536;
constexpr size_t WS_CTL = 0;
constexpr size_t WS_MOD = WS_CTL + CTL_BYTES;
constexpr size_t WS_LB = WS_MOD + al256((size_t)DEPTH * 3 * NMOD * 4);
constexpr size_t WS_XC = WS_LB + al256((size_t)2 * DEPTH * 384 * 4);
constexpr size_t WS_AFF = WS_XC + al256((size_t)NCTX * D * 4);
constexpr size_t WS_SVAL = WS_AFF + al256((size_t)NTOK * NE * 4);
constexpr size_t WS_STOK = WS_SVAL + al256((size_t)NSLOT * 4);
constexpr size_t WS_INV = WS_STOK + al256((size_t)NSLOT * 4);
constexpr size_t WS_H = WS_INV + al256((size_t)NTOK * NE * 4);
constexpr size_t WS_MIX = WS_H + al256((size_t)NTOK * D * 2);
constexpr size_t WS_P = WS_MIX + al256((size_t)NTOK * MIXD * 2);
constexpr size_t WS_HID = WS_P;
constexpr size_t WS_Y = WS_HID + al256((size_t)NSLOT * ED * 2);
constexpr size_t WS_P_END0 = WS_P + al256((size_t)NTOK * INC * 2);
constexpr size_t WS_P_END1 = WS_Y + al256((size_t)NSLOT * D * 2);
constexpr size_t WS_WB = WS_P_END0 > WS_P_END1 ? WS_P_END0 : WS_P_END1;
constexpr size_t WS_WIN_T = WS_WB;
constexpr size_t WS_WOUT_T = WS_WIN_T + al256((size_t)INC * D * 2);
constexpr size_t WS_WGU_T = WS_WOUT_T + al256((size_t)D * MIXD * 2);
constexpr size_t WS_WD_T = WS_WGU_T + al256((size_t)NE * 2 * ED * D * 2);
constexpr size_t WB_BYTES = WS_WD_T + al256((size_t)NE * D * ED * 2) - WS_WB;
constexpr size_t WS_T = WS_WB + 2 * WB_BYTES;
#if FAST_HGRN
constexpr size_t WS_SLOC = WS_T;
constexpr size_t WS_GDEC = WS_SLOC + al256((size_t)2 * NBH * NCH * 4096 * 2);
constexpr size_t WS_OHG = WS_GDEC + al256((size_t)2 * NBH * NCH * 64 * 4);
constexpr size_t WS_XB = WS_OHG + (HGRN_DIAG ? al256((size_t)2 * NTOK * 384 * 4) : 0);
constexpr size_t WS_END = WS_XB + al256((size_t)NLAT * D * 2);
constexpr size_t WS_FG = WS_T;
#else
constexpr size_t WS_FG = WS_T;
constexpr size_t WS_OHG = WS_FG + al256((size_t)NTOK * 768 * 4);
constexpr size_t WS_SLOC = WS_OHG + al256((size_t)2 * NTOK * 384 * 4);
constexpr size_t WS_GDEC = WS_SLOC;
constexpr size_t WS_XB = WS_SLOC;
constexpr size_t WS_END = WS_XB + al256((size_t)NLAT * D * 2);
#endif

static inline Params make_params(void* const* d_in, void* d_out, void* d_ws) {
    Params p{};
    const float** f = (const float**)&p;
    for (int i = 0; i < 20; ++i) f[i] = (const float*)d_in[i];
    char* ws = (char*)d_ws;
    p.XL = (float*)d_out; p.XC = (float*)(ws + WS_XC); p.MOD = (float*)(ws + WS_MOD); p.LB = (float*)(ws + WS_LB); p.AFF = (float*)(ws + WS_AFF);
    p.SVAL = (float*)(ws + WS_SVAL); p.FG = (float*)(ws + WS_FG); p.OHG = (float*)(ws + WS_OHG);
    p.H = (bf16_t*)(ws + WS_H); p.P = (bf16_t*)(ws + WS_P); p.MIX = (bf16_t*)(ws + WS_MIX); p.HID = (bf16_t*)(ws + WS_HID); p.Y = (bf16_t*)(ws + WS_Y);
    p.STOK = (int*)(ws + WS_STOK); p.INV = (int*)(ws + WS_INV);
    p.WIN_T = (bf16_t*)(ws + WS_WIN_T); p.WOUT_T = (bf16_t*)(ws + WS_WOUT_T); p.WGU_T = (bf16_t*)(ws + WS_WGU_T); p.WD_T = (bf16_t*)(ws + WS_WD_T);
    p.CTL = (unsigned*)(ws + WS_CTL); p.SLOC = (bf16_t*)(ws + WS_SLOC); p.GDEC = (float*)(ws + WS_GDEC); p.XB = (bf16_t*)(ws + WS_XB);
    return p;
}

#define FORWARD_STAGES(STAGE)                                                      \
    STAGE(b_adaln, (long)DEPTH * 3 * NMOD, 0)                                      \
    STAGE(b_lb, 2L * 384, 0)                                                       \
    STAGE(b_copyx, (long)NTOK * D, 0)                                              \
    for (int l = 0; l < DEPTH; ++l) {                                              \
        STAGE(b_prenorm<0>, (long)NTOK, l)                                         \
        STAGE(b_gemm_in, (long)NTOK * (INC / 4), l)                                \
        STAGE(b_qkprep, (long)NTOK * 12, l)                                        \
        STAGE(b_attn, (long)NTOK * NAH, l)                                         \
        STAGE(b_gates, (long)NTOK * 768, l)                                        \
        STAGE(b_hgrn_seq<0>, (long)NB * HGH * 64, l)                               \
        STAGE(b_hgrn_seq<1>, (long)NB * HGH * 64, l)                               \
        STAGE(b_hgfin, (long)NTOK * HGH, l)                                        \
        STAGE(b_conv, (long)NTOK * CVD, l)                                         \
        STAGE(b_gemm_out, (long)NTOK * (D / 4), l)                                 \
        STAGE(b_prenorm<1>, (long)NTOK, l)                                         \
        STAGE(b_rank, (long)NTOK * NE, l)                                          \
        STAGE(b_moe1, (long)NSLOT * (ED / 4), l)                                   \
        STAGE(b_moe2, (long)NSLOT * (D / 4), l)                                    \
        STAGE(b_combine, (long)NTOK * (D / 4), l)                                  \
    }

#ifndef CPU_SIM
#include <cstdio>
#define LAS __attribute__((address_space(3)))
#define GAS __attribute__((address_space(1)))
typedef short bf16x8 __attribute__((ext_vector_type(8)));
typedef float f32x4 __attribute__((ext_vector_type(4)));
typedef float f32x2 __attribute__((ext_vector_type(2)));
typedef unsigned u32x4 __attribute__((ext_vector_type(4)));
typedef unsigned u32x2 __attribute__((ext_vector_type(2)));
constexpr int NWAVES = 8, NTHR = 512;
constexpr int RING_BYTES = 131072, LDSCTL_OFF = RING_BYTES, MISC_OFF = LDSCTL_OFF + 320, TAB_OFF = LDSCTL_OFF + 1024  , LDS_BYTES = 147456;

typedef __bf16 bf16v2_t __attribute__((ext_vector_type(2)));
__device__ __forceinline__ unsigned cvt_pk_bf16_asm(float lo, float hi) { unsigned r; asm volatile("v_cvt_pk_bf16_f32 %0, %1, %2" : "=v"(r) : "v"(lo), "v"(hi)); return r; }
__device__ __forceinline__ unsigned cvt_pk_bf16(float lo, float hi) { bf16v2_t v = {(__bf16)lo, (__bf16)hi}; return __builtin_bit_cast(unsigned, v); }
__device__ __forceinline__ float wave_sum(float v, int lane) {
    v += __builtin_bit_cast(float, __builtin_amdgcn_ds_swizzle(__builtin_bit_cast(int, v), (1 << 10) | 0x1f));
    v += __builtin_bit_cast(float, __builtin_amdgcn_ds_swizzle(__builtin_bit_cast(int, v), (2 << 10) | 0x1f));
    v += __builtin_bit_cast(float, __builtin_amdgcn_ds_swizzle(__builtin_bit_cast(int, v), (4 << 10) | 0x1f));
    v += __builtin_bit_cast(float, __builtin_amdgcn_ds_swizzle(__builtin_bit_cast(int, v), (8 << 10) | 0x1f));
    v += __builtin_bit_cast(float, __builtin_amdgcn_ds_swizzle(__builtin_bit_cast(int, v), (16 << 10) | 0x1f));
    v += __builtin_bit_cast(float, __builtin_amdgcn_ds_bpermute((lane ^ 32) << 2, __builtin_bit_cast(int, v)));
    return v;
}

extern __shared__ __attribute__((aligned(16))) unsigned char lds_raw[];
#ifndef FUSE_QK
#define FUSE_QK 1
#endif
__device__ __forceinline__ float bfw(unsigned w, int hi) { return __builtin_bit_cast(float, hi ? (w & 0xffff0000u) : (w << 16)); }
__device__ __forceinline__ float bf8(const u32x4& v, int j) { return bfw(v[j >> 1], j & 1); }
namespace pg8 {
constexpr int BM = 256, BK = 64, HALF = 128, HTB = HALF * BK * 2, STAGE_BYTES = 8 * HTB, NXCD = 8, WGM = 8;
__device__ __forceinline__ int lds_byte(int r, int c) { const int st = (r >> 4) * 2 + (c >> 5), rr = r & 15, cc = c & 31, ob = rr * 64 + cc * 2; return st * 1024 + (ob ^ (((ob >> 9) & 1) << 5)); }
__device__ __forceinline__ void stage_rc(int b, int& R, int& C) { const int st = b / 1024, sb = b % 1024, swz = sb ^ (((sb >> 9) & 1) << 5); R = (st >> 1) * 16 + swz / 64; C = (st & 1) * 32 + (swz % 64) / 2; }
__device__ __forceinline__ int perm32(int rho) { const int n = rho >> 4, i = rho & 15; return 8 * (i >> 2) + 4 * n + (i & 3); }
struct Unit { int pm, pn; };
struct Gemm {
    const bf16_t* A; const bf16_t* Bt; int M, N, K;
    const int* gather;
    int gt, ng; size_t gstride;
};
struct StaticOrder {
    int nM, nN, nwg, G, c;
    __device__ void init(int M, int N, int G_, int c_) { nM = M / BM; nN = N / BM; nwg = nM * nN; G = G_; c = c_; }
    __device__ bool next(int i, Unit& u) const {
        const long L = (long)i * G + c; if (L >= nwg) return false;
        int wgid = (int)L; { const int q = nwg / NXCD, r = nwg % NXCD, xcd = wgid % NXCD, off = wgid / NXCD; wgid = (xcd < r ? xcd * (q + 1) : r * (q + 1) + (xcd - r) * q) + off; }
        const int nig = WGM * nN, gid = wgid / nig, fm = gid * WGM, gsz = (nM - fm) < WGM ? (nM - fm) : WGM;
        u.pm = fm + ((wgid % nig) % gsz); u.pn = (wgid % nig) / gsz; return true;
    }
};
struct EpiBf16 {
    static constexpr bool PERM = true;
    bf16_t* O; int ldc; const float* rowscale; int skip;
    __device__ __forceinline__ void operator()(const f32x4 (&acc)[2][2][4][2], const Unit& u, int wr, int wc, int fr, int fq) const {
        const int row0 = u.pm * BM + wr * 64 + fr, col0 = u.pn * BM + wc * 32 + 8 * fq;
        if (skip) { asm volatile("" :: "v"(acc[0][0][0][0]), "v"(acc[1][1][3][1])); return; }
        float scv[2][4];
#pragma unroll
        for (int ai = 0; ai < 2; ++ai)
#pragma unroll
            for (int m = 0; m < 4; ++m) scv[ai][m] = rowscale ? rowscale[row0 + ai * HALF + m * 16] : 1.f;
        asm volatile("" ::: "memory");
#pragma unroll
        for (int ai = 0; ai < 2; ++ai)
#pragma unroll
            for (int m = 0; m < 4; ++m) { const int row = row0 + ai * HALF + m * 16; bf16_t* rowp = O + (size_t)row * ldc + col0; const float sc = scv[ai][m];
#pragma unroll
                for (int bj = 0; bj < 2; ++bj) { const f32x4 v0 = acc[ai][bj][m][0] * sc, v1 = acc[ai][bj][m][1] * sc;
                    u32x4 w; w.x = cvt_pk_bf16_asm(v0[0], v0[1]); w.y = cvt_pk_bf16_asm(v0[2], v0[3]); w.z = cvt_pk_bf16_asm(v1[0], v1[1]); w.w = cvt_pk_bf16_asm(v1[2], v1[3]);
                    *(u32x4*)(rowp + bj * HALF) = w; } }
    }
};
struct EpiP {
    static constexpr bool PERM = true;
    bf16_t* O; int ldc; const float* qn; const float* kn; int skip;
    __device__ __forceinline__ void operator()(const f32x4 (&acc)[2][2][4][2], const Unit& u, int wr, int wc, int fr, int fq) const {
        const int row0 = u.pm * BM + wr * 64 + fr, col0 = u.pn * BM + wc * 32 + 8 * fq;
        if (skip) { asm volatile("" :: "v"(acc[0][0][0][0]), "v"(acc[1][1][3][1])); return; }
        if (u.pn >= 3 || !FUSE_QK) {
#pragma unroll
            for (int ai = 0; ai < 2; ++ai)
#pragma unroll
                for (int m = 0; m < 4; ++m) { bf16_t* rowp = O + (size_t)(row0 + ai * HALF + m * 16) * ldc + col0;
#pragma unroll
                    for (int bj = 0; bj < 2; ++bj) { const f32x4 v0 = acc[ai][bj][m][0], v1 = acc[ai][bj][m][1];
                        u32x4 w; w.x = cvt_pk_bf16_asm(v0[0], v0[1]); w.y = cvt_pk_bf16_asm(v0[2], v0[3]); w.z = cvt_pk_bf16_asm(v1[0], v1[1]); w.w = cvt_pk_bf16_asm(v1[2], v1[3]);
                        *(u32x4*)(rowp + bj * HALF) = w; } }
            return;
        }
        LAS float* PS = (LAS float*)((LAS unsigned char*)lds_raw + LDSCTL_OFF + 4096);
        const int half = wc & 1, hw = wc >> 1;
        unsigned lm_ = ~0u; asm volatile("" : "+s"(lm_)); const int lane = (int)__builtin_amdgcn_mbcnt_hi(lm_, __builtin_amdgcn_mbcnt_lo(lm_, 0u));
#pragma unroll
        for (int ai = 0; ai < 2; ++ai)
#pragma unroll
            for (int m = 0; m < 4; ++m)
#pragma unroll
                for (int bj = 0; bj < 2; ++bj) { const f32x4 v0 = acc[ai][bj][m][0], v1 = acc[ai][bj][m][1];
                    float s = (v0[0] * v0[0] + v0[1] * v0[1]) + (v0[2] * v0[2] + v0[3] * v0[3]) + (v1[0] * v1[0] + v1[1] * v1[1]) + (v1[2] * v1[2] + v1[3] * v1[3]);
                    s += __builtin_bit_cast(float, __builtin_amdgcn_ds_swizzle(__builtin_bit_cast(int, s), (16 << 10) | 0x1f));
                    s += __builtin_bit_cast(float, __builtin_amdgcn_ds_bpermute((lane ^ 32) << 2, __builtin_bit_cast(int, s)));
                    if (fq == 0) PS[((ai * HALF + wr * 64 + m * 16 + fr) * 4 + 2 * bj + hw) * 2 + half] = s; }
        asm volatile("s_waitcnt lgkmcnt(0)" ::: "memory"); __builtin_amdgcn_s_barrier(); asm volatile("" ::: "memory");
        float invf[8];
#pragma unroll
        for (int j = 0; j < 8; ++j) invf[j] = __builtin_amdgcn_exp2f(-(float)(8 * (fq & 1) + j) * (13.287712379549449f / 16.f));
        const bool second = (fq & 2) != 0;
        f32x4 nwv[2][2];
#pragma unroll
        for (int bj = 0; bj < 2; ++bj) { const bool isk = (u.pn * BM + bj * HALF + wc * 32) >= 384; const float* nw = (isk ? kn : qn) + 32 * half + 8 * fq; nwv[bj][0] = *(const f32x4*)nw; nwv[bj][1] = *(const f32x4*)(nw + 4); }
        asm volatile("" ::: "memory");
#pragma unroll
        for (int ai = 0; ai < 2; ++ai)
#pragma unroll
            for (int m = 0; m < 4; ++m) {
                const int grow = row0 + ai * HALF + m * 16; const bool lat = grow < NLAT; const int t = lat ? grow % SEQ : 0;
                int tp = half ? t % GW : t / GW; asm volatile("" : "+v"(tp));
                const float pos = (float)tp;
                float cs[8], sn[8];
#pragma unroll
                for (int j = 0; j < 8; ++j) { const float ang = pos * invf[j]; cs[j] = __cosf(ang); sn[j] = __sinf(ang); }
                bf16_t* rowp = O + (size_t)grow * ldc + col0;
#pragma unroll
                for (int bj = 0; bj < 2; ++bj) {
                    const int rl = ai * HALF + wr * 64 + m * 16 + fr, head = 2 * bj + hw;
                    const float ssq = PS[(rl * 4 + head) * 2] + PS[(rl * 4 + head) * 2 + 1];
                    const bool isk = (u.pn * BM + bj * HALF + wc * 32) >= 384;
                    const float rstd = (isk ? 1.f : 0.125f * 1.44269504089f) / sqrtf(ssq * (1.f / HD) + EPS);
                    const f32x4 n0 = nwv[bj][0], n1 = nwv[bj][1];
                    float y[8];
#pragma unroll
                    for (int j = 0; j < 4; ++j) { y[j] = acc[ai][bj][m][0][j] * rstd * n0[j]; y[4 + j] = acc[ai][bj][m][1][j] * rstd * n1[j]; }
#pragma unroll
                    for (int j = 0; j < 8; ++j) {
                        const unsigned yb = __builtin_bit_cast(unsigned, y[j]);
                        const auto sw = __builtin_amdgcn_permlane32_swap(yb, yb, false, false);
                        const float other = __builtin_bit_cast(float, lane < 32 ? sw[1] : sw[0]);
                        const float rot = second ? y[j] * cs[j] + other * sn[j] : y[j] * cs[j] - other * sn[j];
                        y[j] = lat ? rot : y[j];
                    }
                    u32x4 w; w.x = cvt_pk_bf16(y[0], y[1]); w.y = cvt_pk_bf16(y[2], y[3]); w.z = cvt_pk_bf16(y[4], y[5]); w.w = cvt_pk_bf16(y[6], y[7]);
                    *(u32x4*)(rowp + bj * HALF) = w;
                }
                asm volatile("" ::: "memory");
            }
    }
};
struct EpiRes {
    static constexpr bool PERM = true;
    bf16_t* X; int ldc; const float* gate0; int rows_per_set; size_t set_stride;
    __device__ __forceinline__ void operator()(const f32x4 (&acc)[2][2][4][2], const Unit& u, int wr, int wc, int fr, int fq) const {
        const int row0 = u.pm * BM + wr * 64 + fr, col0 = u.pn * BM + wc * 32 + 8 * fq;
        const float* gate = gate0 + (size_t)((u.pm * BM) / rows_per_set) * set_stride;
        f32x4 gv[2][2];
#pragma unroll
        for (int bj = 0; bj < 2; ++bj)
#pragma unroll
            for (int n = 0; n < 2; ++n) gv[bj][n] = *(const f32x4*)(gate + col0 + bj * HALF + n * 4);
        u32x4 rv[2][4][2];
#pragma unroll
        for (int ai = 0; ai < 2; ++ai)
#pragma unroll
            for (int m = 0; m < 4; ++m)
#pragma unroll
                for (int bj = 0; bj < 2; ++bj) rv[ai][m][bj] = *(const u32x4*)(X + (size_t)(row0 + ai * HALF + m * 16) * ldc + col0 + bj * HALF);
        asm volatile("" ::: "memory");
#pragma unroll
        for (int ai = 0; ai < 2; ++ai)
#pragma unroll
            for (int m = 0; m < 4; ++m) { bf16_t* rowp = X + (size_t)(row0 + ai * HALF + m * 16) * ldc + col0;
#pragma unroll
                for (int bj = 0; bj < 2; ++bj) { const u32x4 r = rv[ai][m][bj];
                    const f32x4 x0 = (f32x4){bfw(r.x, 0), bfw(r.x, 1), bfw(r.y, 0), bfw(r.y, 1)}, x1 = (f32x4){bfw(r.z, 0), bfw(r.z, 1), bfw(r.w, 0), bfw(r.w, 1)};
                    const f32x4 v0 = x0 + gv[bj][0] * acc[ai][bj][m][0], v1 = x1 + gv[bj][1] * acc[ai][bj][m][1];
                    u32x4 w; w.x = cvt_pk_bf16_asm(v0[0], v0[1]); w.y = cvt_pk_bf16_asm(v0[2], v0[3]); w.z = cvt_pk_bf16_asm(v1[0], v1[1]); w.w = cvt_pk_bf16_asm(v1[2], v1[3]);
                    *(u32x4*)(rowp + bj * HALF) = w; } }
    }
};
struct EpiHid {
    static constexpr bool PERM = false;
    bf16_t* O; int ldc;
    __device__ __forceinline__ void operator()(const f32x4 (&acc)[2][2][4][2], const Unit& u, int wr, int wc, int fr, int fq) const {
        const int row0 = u.pm * BM + wr * 64 + fr, col0 = (u.pn * BM + wc * 32) / 2 + 4 * fq;
#pragma unroll
        for (int ai = 0; ai < 2; ++ai)
#pragma unroll
            for (int m = 0; m < 4; ++m) { bf16_t* rowp = O + (size_t)(row0 + ai * HALF + m * 16) * ldc + col0;
#pragma unroll
                for (int bj = 0; bj < 2; ++bj) { const f32x4 g = acc[ai][bj][m][0], up = acc[ai][bj][m][1]; f32x4 h;
#pragma unroll
                    for (int j = 0; j < 4; ++j) h[j] = g[j] * __builtin_amdgcn_rcpf(1.f + __expf(-g[j])) * up[j];
                    u32x2 w; w.x = cvt_pk_bf16_asm(h[0], h[1]); w.y = cvt_pk_bf16_asm(h[2], h[3]);
                    *(u32x2*)(rowp + bj * (HALF / 2)) = w; } }
    }
};

template <class Epi, bool GATHER>
__device__ __forceinline__ void gemm_phase(const int tid, LAS unsigned char* lds, const Gemm g, const StaticOrder& S, const Epi& E) {
    const int wid = __builtin_amdgcn_readfirstlane(tid >> 6), lane = tid & 63, wr = wid >> 2, wc = wid & 3, fr = lane & 15, fq = lane >> 4;
    const int K = g.K, nt = K / BK;
    unsigned voffA[2], voffB[2];
#pragma unroll
    for (int i = 0; i < 2; ++i) { int R, C; stage_rc(tid * 16 + i * 8192, R, C); const int Rb = Epi::PERM ? ((R & ~31) + perm32(R & 31)) : R;
        voffB[i] = (unsigned)(Rb * K + C) * 2u; voffA[i] = GATHER ? (unsigned)(C * 2) : (Epi::PERM ? (unsigned)(R * K + C) * 2u : voffB[i]); }
    const size_t kstep = (size_t)(BK * 2);
    const size_t hstep = (size_t)HALF * K * 2;
    const size_t tstep = 2 * hstep;
    const unsigned ldsw = (unsigned)wid * 1024u;
    const int aoff = lds_byte(wr * 64 + fr, fq * 8), boff = lds_byte(wc * 32 + fr, fq * 8);
#define PG8_SA(b, h) (((b) * 2 + (h)) * HTB)
#define PG8_SB(b, h) ((4 + (b) * 2 + (h)) * HTB)
#define PG8_STAGE(bufoff, gbase, voff) do { const char* gb_ = (const char*)(gbase); asm volatile("" : "+s"(gb_)); _Pragma("unroll") for (int _i = 0; _i < 2; ++_i) \
        __builtin_amdgcn_global_load_lds((const unsigned*)(gb_ + (voff)[_i]), (LAS unsigned*)(lds + (bufoff) + ldsw + _i * 8192), 16, 0, 0); } while (0)
#define PG8_STAGE_A(bufoff, ubase, kt, h, tb) do { if constexpr (GATHER) { \
        if ((tb) < 0) { PG8_STAGE(bufoff, Ab + (size_t)(kt) * kstep, oAc[h]); } else { \
        unsigned m_ = ~0u; asm volatile("" : "+s"(m_)); const int tl_ = wid * 64 + (int)__builtin_amdgcn_mbcnt_hi(m_, __builtin_amdgcn_mbcnt_lo(m_, 0u)); \
        _Pragma("unroll") for (int _i = 0; _i < 2; ++_i) { int _R, _C; stage_rc(tl_ * 16 + _i * 8192, _R, _C); \
            const unsigned _o = *(const LAS unsigned*)(lds + TAB_OFF + (tb) * 1024 + ((h) * HALF + _R) * 4) + (unsigned)(_C * 2); \
            __builtin_amdgcn_global_load_lds((const unsigned*)(Ab + (size_t)(kt) * kstep + _o), (LAS unsigned*)(lds + (bufoff) + ldsw + _i * 8192), 16, 0, 0); } } } \
        else { PG8_STAGE(bufoff, (ubase) + (size_t)(kt) * kstep + (size_t)(h) * hstep, voffA); } } while (0)
#define PG8_LOADOFFS(tb) do { if constexpr (GATHER) { unsigned m_ = ~0u; asm volatile("" : "+s"(m_)); const int tl_ = wid * 64 + (int)__builtin_amdgcn_mbcnt_hi(m_, __builtin_amdgcn_mbcnt_lo(m_, 0u)); \
        _Pragma("unroll") for (int _h = 0; _h < 2; ++_h) _Pragma("unroll") for (int _i = 0; _i < 2; ++_i) { int _R, _C; stage_rc(tl_ * 16 + _i * 8192, _R, _C); \
            oAc[_h][_i] = *(const LAS unsigned*)(lds + TAB_OFF + (tb) * 1024 + (_h * HALF + _R) * 4) + (unsigned)(_C * 2); } } } while (0)
#define PG8_FILLTAB(u, tb) do { if constexpr (GATHER) { unsigned m_ = ~0u; asm volatile("" : "+s"(m_)); const int tl_ = wid * 64 + (int)__builtin_amdgcn_mbcnt_hi(m_, __builtin_amdgcn_mbcnt_lo(m_, 0u)); \
        if (tl_ < 256) *(LAS unsigned*)(lds + TAB_OFF + (tb) * 1024 + tl_ * 4) = min((unsigned)g.gather[(u).pm * BM + tl_], (unsigned)(NTOK - 1)) * (unsigned)(K * 2); } } while (0)
#define PG8_LDA(dst, b, h) do { _Pragma("unroll") for (int m = 0; m < 4; ++m) _Pragma("unroll") for (int k = 0; k < 2; ++k) dst[m][k] = *(const LAS bf16x8*)(lds + PG8_SA(b, h) + aoff + m * 2048 + k * 1024); } while (0)
#define PG8_LDB(dst, b, h) do { _Pragma("unroll") for (int n = 0; n < 2; ++n) _Pragma("unroll") for (int k = 0; k < 2; ++k) dst[n][k] = *(const LAS bf16x8*)(lds + PG8_SB(b, h) + boff + n * 2048 + k * 1024); } while (0)
#define PG8_MMA(ai, bj, At, Bt) do { __builtin_amdgcn_s_setprio(1); _Pragma("unroll") for (int m = 0; m < 4; ++m) _Pragma("unroll") for (int n = 0; n < 2; ++n) _Pragma("unroll") for (int k = 0; k < 2; ++k) \
        acc[ai][bj][m][n] = __builtin_amdgcn_mfma_f32_16x16x32_bf16(Bt[n][k], At[m][k], acc[ai][bj][m][n], 0, 0, 0); __builtin_amdgcn_s_setprio(0); } while (0)
#define PG8_WAIT_V(n) asm volatile("s_waitcnt vmcnt(" #n ")" ::: "memory")
#define PG8_WAIT_L(n) asm volatile("s_waitcnt lgkmcnt(" #n ")" ::: "memory")
#define PG8_BAR __builtin_amdgcn_s_barrier()
#define PG8_SCHED __builtin_amdgcn_sched_barrier(0)
#define PG8_KTILE2(u1, k1, o1, u2, k2, o2, b2p) do { \
        PG8_LDB(B0, 0, 0); PG8_LDB(B1, 0, 1); PG8_SCHED; PG8_LDA(At, 0, 0); PG8_STAGE_A(PG8_SA(1, 1), u1, k1, 1, o1); \
        PG8_WAIT_V(8); PG8_WAIT_L(0); PG8_BAR; PG8_MMA(0, 0, At, B0); PG8_MMA(0, 1, At, B1); PG8_BAR; PG8_SCHED; \
        PG8_LDA(At, 0, 1); PG8_STAGE(PG8_SB(0, 0), b2p, voffB); PG8_STAGE(PG8_SB(0, 1), (b2p) + hstep, voffB); PG8_STAGE_A(PG8_SA(0, 0), u2, k2, 0, o2); \
        PG8_WAIT_V(8); PG8_WAIT_L(0); PG8_BAR; PG8_MMA(1, 0, At, B0); PG8_MMA(1, 1, At, B1); PG8_BAR; PG8_SCHED; \
        PG8_LDB(B0, 1, 0); PG8_LDB(B1, 1, 1); PG8_SCHED; PG8_LDA(At, 1, 0); PG8_STAGE_A(PG8_SA(0, 1), u2, k2, 1, o2); \
        PG8_WAIT_V(8); PG8_WAIT_L(0); PG8_BAR; PG8_MMA(0, 0, At, B0); PG8_MMA(0, 1, At, B1); PG8_BAR; PG8_SCHED; \
        PG8_LDA(At, 1, 1); PG8_STAGE(PG8_SB(1, 0), (b2p) + kstep, voffB); PG8_STAGE(PG8_SB(1, 1), (b2p) + kstep + hstep, voffB); PG8_STAGE_A(PG8_SA(1, 0), u2, (k2) + 1, 0, o2); \
        PG8_WAIT_V(8); PG8_WAIT_L(0); PG8_BAR; PG8_MMA(1, 0, At, B0); PG8_MMA(1, 1, At, B1); PG8_BAR; PG8_SCHED; } while (0)
#define PG8_BPTR(u) ((const char*)g.Bt + (g.gt ? (size_t)(((u).pm / g.gt) % g.ng) * g.gstride : (size_t)0) + (size_t)(u).pn * tstep)
    Unit cur, nxt; int ui = 0;
    if (!S.next(0, cur)) return;
#ifndef LATE_START
#define LATE_START 4
#endif
#ifndef GEMM_STAGGER
#define GEMM_STAGGER 0
#endif
    if (GEMM_STAGGER) { const int dg_ = ((int)blockIdx.x >> 3) & 3; for (int i_ = 0; i_ < dg_; ++i_) __builtin_amdgcn_s_sleep(GEMM_STAGGER); }
    if (S.nwg % S.G != 0 && S.c >= S.nwg % S.G) { for (int i_ = 0; i_ < LATE_START; ++i_) __builtin_amdgcn_s_sleep(127); }
    f32x4 acc[2][2][4][2];
#pragma unroll
    for (int a = 0; a < 2; ++a)
#pragma unroll
        for (int b = 0; b < 2; ++b)
#pragma unroll
            for (int m = 0; m < 4; ++m)
#pragma unroll
                for (int n = 0; n < 2; ++n) acc[a][b][m][n] = (f32x4){0.f, 0.f, 0.f, 0.f};
    bf16x8 At[4][2], B0[2][2], B1[2][2];
    unsigned oAc[2][2] = {{0u, 0u}, {0u, 0u}};
    const char* const Ab = (const char*)g.A;
    const char* cA = Ab + (size_t)cur.pm * tstep;
    const char* cB = PG8_BPTR(cur);
    PG8_FILLTAB(cur, 0);
    if constexpr (GATHER) { PG8_WAIT_L(0); PG8_BAR; PG8_LOADOFFS(0); }
    PG8_STAGE(PG8_SB(0, 0), cB, voffB); PG8_STAGE(PG8_SB(0, 1), cB + hstep, voffB); PG8_STAGE_A(PG8_SA(0, 0), cA, 0, 0, -1); PG8_STAGE_A(PG8_SA(0, 1), cA, 0, 1, -1);
    if (wr == 1) PG8_BAR;
    PG8_WAIT_V(2); PG8_BAR;
    PG8_STAGE(PG8_SB(1, 0), cB + kstep, voffB); PG8_STAGE_A(PG8_SA(1, 0), cA, 1, 0, -1); PG8_STAGE(PG8_SB(1, 1), cB + hstep + kstep, voffB);
    PG8_WAIT_V(6); PG8_BAR;
    for (;;) {
        const bool has_next = S.next(ui + 1, nxt);
        const char* nA = has_next ? Ab + (size_t)nxt.pm * tstep : cA; const char* nB = has_next ? PG8_BPTR(nxt) : cB;
        const int tbc = ui & 1, tbn = has_next ? ((ui + 1) & 1) : (ui & 1);
        if (has_next) PG8_FILLTAB(nxt, tbn);
        for (int t = 0; t < nt - 2; t += 2) { const char* b2 = cB + (size_t)(t + 2) * kstep; PG8_KTILE2(cA, t + 1, -1, cA, t + 2, -1, b2); }
        PG8_KTILE2(cA, nt - 1, -1, nA, 0, tbn, nB);
        if (wr == 0) PG8_BAR;
        { unsigned m_ = ~0u; asm volatile("" : "+s"(m_)); int l2 = (int)__builtin_amdgcn_mbcnt_hi(m_, __builtin_amdgcn_mbcnt_lo(m_, 0u)); asm volatile("" : "+v"(l2)); E(acc, cur, wr, wc, l2 & 15, l2 >> 4); }
        if (!has_next) break;
#pragma unroll
        for (int a = 0; a < 2; ++a)
#pragma unroll
            for (int b = 0; b < 2; ++b)
#pragma unroll
                for (int m = 0; m < 4; ++m)
#pragma unroll
                    for (int n = 0; n < 2; ++n) acc[a][b][m][n] = (f32x4){0.f, 0.f, 0.f, 0.f};
        cur = nxt; cA = nA; cB = nB; ++ui;
        PG8_LOADOFFS(ui & 1);
        if (wr == 1) PG8_BAR;
    }
    PG8_WAIT_V(0);
    PG8_BAR;
#undef PG8_STAGE_A
#undef PG8_FILLTAB
#undef PG8_LOADOFFS
#undef PG8_SA
#undef PG8_SB
#undef PG8_STAGE
#undef PG8_LDA
#undef PG8_LDB
#undef PG8_MMA
#undef PG8_WAIT_V
#undef PG8_WAIT_L
#undef PG8_BAR
#undef PG8_SCHED
#undef PG8_KTILE2
#undef PG8_BPTR
}
}

#define XB_TMO      128
#define XB_XCNT(j)  (256  + 64 * (j))
#define XB_XSUB(j)  (1280 + 64 * (j))
#define XB_XGEN(j)  (2304 + 64 * (j))
#define XB_TOP      3328
#define XB_TOPGEN   3392
#define XCD_BAR_WORDS 3456
#define XB_SPIN_CAP (1u << 20)
__device__ __forceinline__ unsigned xb_ld(unsigned* p)              { return __hip_atomic_load(p, __ATOMIC_RELAXED, __HIP_MEMORY_SCOPE_AGENT); }
__device__ __forceinline__ unsigned xb_add(unsigned* p, unsigned v) { return __hip_atomic_fetch_add(p, v, __ATOMIC_RELAXED, __HIP_MEMORY_SCOPE_AGENT); }
__device__ __forceinline__ unsigned xb_xcc_id() { return (unsigned)__builtin_amdgcn_s_getreg((3 << 11) | 20) & 0xFu; }
#define XB_SPIN(cond, bar) do { unsigned _sp = 0; while (cond) { __builtin_amdgcn_s_sleep(1); \
    if ((++_sp & 255u) == 0u) { if (xb_ld(&(bar)[XB_TMO])) break; if (_sp > XB_SPIN_CAP) { atomicAdd(&(bar)[XB_TMO], 1u); break; } } } } while (0)
struct XcdBarrier { unsigned* bar; unsigned x; };
#define XB_ST(ldsbase) ((volatile LAS unsigned*)((LAS unsigned char*)(ldsbase) + MISC_OFF + 32))
__device__ __forceinline__ XcdBarrier xcd_barrier_post(unsigned* bar, bool leader) {
    XcdBarrier b; b.bar = bar; b.x = xb_xcc_id();
    if (leader) (void)xb_add(&bar[XB_XCNT(b.x)], 1u);
    return b;
}
__device__ __forceinline__ void xcd_barrier_complete(unsigned* bar, unsigned x, unsigned& nloc, unsigned& nx) {
    const unsigned G = gridDim.x * gridDim.y * gridDim.z;
    unsigned sum, cnt, mine, sp = 0u;
    for (;;) {
        sum = 0u; cnt = 0u; mine = 0u;
#pragma unroll
        for (unsigned j = 0; j < 16; ++j) { const unsigned c = xb_ld(&bar[XB_XCNT(j)]); sum += c; cnt += (c > 0u) ? 1u : 0u; mine = (j == x) ? c : mine; }
        if (sum == G) break;
        __builtin_amdgcn_s_sleep(1);
        if ((++sp & 255u) == 0u) { if (xb_ld(&bar[XB_TMO])) break; if (sp > XB_SPIN_CAP) { atomicAdd(&bar[XB_TMO], 1u); break; } }
    }
    nloc = mine > 0u ? mine : 1u; nx = cnt > 0u ? cnt : 1u;
}
__device__ __forceinline__ void xcd_barrier(const XcdBarrier& b, bool leader, volatile LAS unsigned* st) {
    asm volatile("s_waitcnt vmcnt(0)" ::: "memory");
    __syncthreads();
    if (leader) {
        unsigned* bar = b.bar;
        __builtin_amdgcn_s_waitcnt(0);
        unsigned nloc = st[0], nx = st[1];
        if (nloc == 0u) { xcd_barrier_complete(bar, b.x, nloc, nx); st[0] = nloc; st[1] = nx; }
        const unsigned old = xb_add(&bar[XB_XSUB(b.x)], 1u);
        const unsigned gen = old / nloc;
        if (old + 1u == (gen + 1u) * nloc) {
            __builtin_amdgcn_fence(__ATOMIC_RELEASE, "agent");
            asm volatile("s_waitcnt vmcnt(0)" ::: "memory");
            const unsigned og = xb_add(&bar[XB_TOP], 1u);
            const unsigned tg = og / nx;
            if (og + 1u == (tg + 1u) * nx) xb_add(&bar[XB_TOPGEN], 1u);
            else XB_SPIN(xb_ld(&bar[XB_TOPGEN]) == tg, bar);
            __builtin_amdgcn_fence(__ATOMIC_ACQUIRE, "agent");
            xb_add(&bar[XB_XGEN(b.x)], 1u);
            asm volatile("s_waitcnt vmcnt(0)" ::: "memory");
        } else {
            XB_SPIN(xb_ld(&bar[XB_XGEN(b.x)]) == gen, bar);
            __builtin_amdgcn_fence(__ATOMIC_ACQUIRE, "agent");
            asm volatile("s_waitcnt vmcnt(0)" ::: "memory");
        }
    }
    __syncthreads();
}

template <void (*F)(long, PRef, int)> __device__ __forceinline__ void run_items(const int tid, PRef p, int l, long n, long off) {
    for (long gid = (long)blockIdx.x * NTHR + tid; gid < n; gid += (long)gridDim.x * NTHR) F(gid + off, p, l);
}
BODY void b_hgrn_seq2(long gid, PRef p, int l) { const long n1 = (long)NB * HGH * 64; if (gid < n1) b_hgrn_seq<0>(gid, p, l); else b_hgrn_seq<1>(gid - n1, p, l); }

template <int MAP> __device__ __forceinline__ void transpose_item(const float* W, int K, int N, bf16_t* WT, int row_off, LAS float* scr, int item, int lane) {
    const int nblk = N / 32, kb = item / nblk, nb = item % nblk, k0 = 64 * kb, n0 = 32 * nb;
#pragma unroll 8
    for (int i = 0; i < 32; ++i) { const int kk = 2 * i + (lane >> 5); scr[kk * 33 + (lane & 31)] = W[(size_t)(k0 + kk) * N + n0 + (lane & 31)]; }
    asm volatile("s_waitcnt lgkmcnt(0)" ::: "memory");
    const int c = lane & 7;
#pragma unroll
    for (int j = 0; j < 4; ++j) { const int n = (lane >> 3) + 8 * j; const LAS float* s = scr + (8 * c) * 33 + n;
        u32x4 o; o.x = cvt_pk_bf16(s[0 * 33], s[1 * 33]); o.y = cvt_pk_bf16(s[2 * 33], s[3 * 33]); o.z = cvt_pk_bf16(s[4 * 33], s[5 * 33]); o.w = cvt_pk_bf16(s[6 * 33], s[7 * 33]);
        const int nn = n0 + n; const int drow = MAP == 0 ? row_off + nn : (32 * (nn >> 4) + (nn & 15) + (MAP == 2 ? 16 : 0));
        *(u32x4*)(WT + (size_t)drow * K + k0 + 8 * c) = o; }
    asm volatile("s_waitcnt lgkmcnt(0)" ::: "memory");
}
#define WBOFF(l) ((size_t)((l) & 1) * (WB_BYTES / 2))
__device__ __forceinline__ void phase_convert(const int tid, PRef p, int l, LAS unsigned char* lds, int part = 0, int blk_lo = 0) {
    if ((int)blockIdx.x < blk_lo) return;
    const int lane = tid & 63, wave = tid >> 6;
    LAS float* scr = (LAS float*)(lds + wave * 16384);
    const int gw = ((int)blockIdx.x - blk_lo) * NWAVES + wave, NGW = ((int)gridDim.x - blk_lo) * NWAVES;
    constexpr int I_IN = (D / 64) * (INC / 32), I_OUT = (MIXD / 64) * (D / 32), I_G = (D / 64) * (ED / 32), I_D = (ED / 64) * (D / 32);
    constexpr int NITEMS = I_IN + I_OUT + NE * (2 * I_G + I_D);
    const int it_lo = part == 2 ? I_IN + I_OUT : 0, it_hi = part == 1 ? I_IN + I_OUT : NITEMS;
    for (int it = it_lo + gw; it < it_hi; it += NGW) {
        int r = it;
        if (r < I_IN) { transpose_item<0>(p.w_in + (size_t)l * D * INC, D, INC, p.WIN_T + WBOFF(l), 0, scr, r, lane); continue; } r -= I_IN;
        if (r < I_OUT) { transpose_item<0>(p.w_out + (size_t)l * MIXD * D, MIXD, D, p.WOUT_T + WBOFF(l), 0, scr, r, lane); continue; } r -= I_OUT;
        const int e = r / (2 * I_G + I_D); r -= e * (2 * I_G + I_D);
        if (r < I_G) { transpose_item<1>(p.w_gate + ((size_t)l * NE + e) * D * ED, D, ED, p.WGU_T + WBOFF(l) + (size_t)e * 2 * ED * D, 0, scr, r, lane); continue; } r -= I_G;
        if (r < I_G) { transpose_item<2>(p.w_up + ((size_t)l * NE + e) * D * ED, D, ED, p.WGU_T + WBOFF(l) + (size_t)e * 2 * ED * D, 0, scr, r, lane); continue; } r -= I_G;
        transpose_item<0>(p.w_down + ((size_t)l * NE + e) * ED * D, ED, D, p.WD_T + WBOFF(l) + (size_t)e * D * ED, 0, scr, r, lane);
    }
}
template <int WHICH> __device__ __forceinline__ void phase_prenorm(const int tid, PRef p, int l) {
    static_assert(D == 1024, "wave-per-row kernels assume D = 1024");
    const int lane = tid & 63, wave = tid >> 6;
    const int gw = blockIdx.x * NWAVES + wave, NGW = gridDim.x * NWAVES;
    const float* nw = (WHICH ? p.norm2_w : p.norm1_w) + l * D;
    for (int r = gw; r < NTOK; r += NGW) {
        const float* xr = xrow(p, r);
        const float* mod = p.MOD + ((size_t)l * 3 + modset(r)) * NMOD;
        const float* shift = mod + (WHICH ? 3 : 0) * D; const float* scale = mod + (WHICH ? 4 : 1) * D;
        f32x4 v[4]; float ss = 0.f;
#pragma unroll
        for (int j = 0; j < 4; ++j) { v[j] = *(const f32x4*)(xr + 4 * lane + 256 * j); ss += (v[j][0] * v[j][0] + v[j][1] * v[j][1]) + (v[j][2] * v[j][2] + v[j][3] * v[j][3]); }
        const float rstd = 1.f / sqrtf(wave_sum(ss, lane) * (1.f / D) + EPS);
        float lg[NE];
#pragma unroll
        for (int e = 0; e < NE; ++e) lg[e] = 0.f;
#pragma unroll
        for (int j = 0; j < 4; ++j) {
            const int c = 4 * lane + 256 * j;
            const f32x4 w4 = *(const f32x4*)(nw + c), sc4 = *(const f32x4*)(scale + c), sh4 = *(const f32x4*)(shift + c);
            f32x4 h;
#pragma unroll
            for (int i = 0; i < 4; ++i) h[i] = v[j][i] * rstd * w4[i] * (1.f + sc4[i]) + sh4[i];
            u32x2 o; o.x = cvt_pk_bf16(h[0], h[1]); o.y = cvt_pk_bf16(h[2], h[3]);
            *(u32x2*)(p.H + (size_t)r * D + c) = o;
            if (WHICH) {
#pragma unroll
                for (int i = 0; i < 4; ++i) { const f32x4* wr = (const f32x4*)(p.w_router + ((size_t)l * D + c + i) * NE);
#pragma unroll
                    for (int q = 0; q < 4; ++q) { const f32x4 w = wr[q]; lg[4 * q + 0] += h[i] * w[0]; lg[4 * q + 1] += h[i] * w[1]; lg[4 * q + 2] += h[i] * w[2]; lg[4 * q + 3] += h[i] * w[3]; } }
            }
        }
        if (WHICH) {
#pragma unroll
            for (int e = 0; e < NE; ++e) lg[e] = wave_sum(lg[e], lane);
            float m = lg[0];
#pragma unroll
            for (int e = 1; e < NE; ++e) m = fmaxf(m, lg[e]);
            float s = 0.f, mine = 0.f;
#pragma unroll
            for (int e = 0; e < NE; ++e) { const float ex = expf(lg[e] - m); s += ex; mine = (lane == e) ? ex : mine; }
            if (lane < NE) p.AFF[(size_t)r * NE + lane] = mine / s;
        }
    }
}
__device__ __forceinline__ void phase_combine(const int tid, PRef p, int l) {
    const int lane = tid & 63, wave = tid >> 6;
    const int gw = blockIdx.x * NWAVES + wave, NGW = gridDim.x * NWAVES;
    for (int r = gw; r < NTOK; r += NGW) {
        float* xr = xrow(p, r);
        const float* g = p.MOD + ((size_t)l * 3 + modset(r)) * NMOD + 5 * D;
        f32x4 acc[4];
#pragma unroll
        for (int j = 0; j < 4; ++j) acc[j] = (f32x4){0.f, 0.f, 0.f, 0.f};
        const int myinv = lane < NE ? p.INV[(size_t)r * NE + lane] : -1;
#pragma unroll
        for (int e = 0; e < NE; ++e) {
            const int s = __builtin_amdgcn_readlane(myinv, e);
            if (s >= 0 && s < NSLOT) {
                const bf16_t* y = p.Y + (size_t)s * D;
#pragma unroll
                for (int j = 0; j < 4; ++j) { const u32x2 w = *(const u32x2*)(y + 4 * lane + 256 * j);
                    acc[j][0] += __builtin_bit_cast(float, w.x << 16); acc[j][1] += __builtin_bit_cast(float, w.x & 0xffff0000u);
                    acc[j][2] += __builtin_bit_cast(float, w.y << 16); acc[j][3] += __builtin_bit_cast(float, w.y & 0xffff0000u); }
            }
        }
#pragma unroll
        for (int j = 0; j < 4; ++j) { const int c = 4 * lane + 256 * j; f32x4* q = (f32x4*)(xr + c); *q = *q + *(const f32x4*)(g + c) * acc[j]; }
    }
}


__device__ __forceinline__ unsigned wave_excl_scan(unsigned x, int lane) {
    unsigned inc = x;
#pragma unroll
    for (int d = 1; d < 64; d <<= 1) { const unsigned y = (unsigned)__builtin_amdgcn_ds_bpermute(((lane - d) & 63) << 2, (int)inc); if (lane >= d) inc += y; }
    return inc - x;
}
__device__ __forceinline__ void phase_topk(const int tid, PRef p, LAS unsigned char* lds) {
    LAS unsigned* keys = (LAS unsigned*)lds;
    LAS unsigned* hist = (LAS unsigned*)(lds + 70000);
    LAS unsigned* cgt = (LAS unsigned*)(lds + 76000);
    LAS unsigned* ceq = (LAS unsigned*)(lds + 80000);
    LAS unsigned* sh = (LAS unsigned*)(lds + 84000);
    static_assert(SEQ % 512 == 0 && SEQ + SEQ / 32 <= 17400, "topk LDS layout");
    constexpr int PER = SEQ / 512;
    for (int pr = blockIdx.x; pr < 2 * NB * NE; pr += gridDim.x) {
        const int e = pr % NE, b = (pr / NE) % NB, isctx = pr / (NE * NB);
        if (!isctx) {
            const int row0 = b * SEQ, base = (b * NE + e) * CAPL;
            for (int i = 0; i < PER; ++i) { const int t = i * 512 + tid; keys[t + (t >> 5)] = __builtin_bit_cast(unsigned, p.AFF[(size_t)(row0 + t) * NE + e]); }
            if (tid == 0) { sh[0] = 0u; sh[1] = (unsigned)CAPL; }
            __syncthreads();
            for (int pass = 0; pass < 3; ++pass) {
                const int shift = 20 - 10 * pass;
                for (int i = tid; i < 1024; i += 512) hist[i] = 0u;
                __syncthreads();
                const unsigned prefix = sh[0]; const unsigned himask = pass == 0 ? 0u : (0xFFFFFFFFu << (shift + 10));
                for (int i = 0; i < PER; ++i) { const int t = tid * PER + i; const unsigned k = keys[t + (t >> 5)]; if ((k & himask) == prefix) atomicAdd((unsigned*)&hist[(k >> shift) & 1023u], 1u); }
                __syncthreads();
                if (tid < 64) {
                    const unsigned need = sh[1];
                    unsigned c[16]; unsigned tot = 0u;
#pragma unroll
                    for (int q = 0; q < 16; ++q) { c[q] = hist[1023 - 16 * tid - q]; tot += c[q]; }
                    unsigned above = wave_excl_scan(tot, tid);
                    int fbin = -1; unsigned fabove = 0u;
#pragma unroll
                    for (int q = 0; q < 16; ++q) { if (fbin < 0 && above < need && above + c[q] >= need) { fbin = 1023 - 16 * tid - q; fabove = above; } above += c[q]; }
                    if (fbin >= 0) { sh[0] = prefix | ((unsigned)fbin << shift); sh[1] = need - fabove; }
                }
                __syncthreads();
            }
            const unsigned thr = sh[0], keq = sh[1];
            unsigned ng = 0u, nq = 0u;
            for (int i = 0; i < PER; ++i) { const int t = tid * PER + i; const unsigned k = keys[t + (t >> 5)]; ng += k > thr ? 1u : 0u; nq += k == thr ? 1u : 0u; }
            cgt[tid] = ng; ceq[tid] = nq;
            __syncthreads();
            if (tid < 64) {
                unsigned g[8], q[8], sg = 0u, sq = 0u;
#pragma unroll
                for (int i = 0; i < 8; ++i) { g[i] = cgt[8 * tid + i]; q[i] = ceq[8 * tid + i]; sg += g[i]; sq += q[i]; }
                unsigned ag = wave_excl_scan(sg, tid), aq = wave_excl_scan(sq, tid);
#pragma unroll
                for (int i = 0; i < 8; ++i) { cgt[8 * tid + i] = ag; ceq[8 * tid + i] = aq; ag += g[i]; aq += q[i]; }
            }
            __syncthreads();
            unsigned rg = cgt[tid], rq = ceq[tid];
            for (int i = 0; i < PER; ++i) {
                const int t = tid * PER + i; const unsigned k = keys[t + (t >> 5)];
                int slot = -1;
                if (k > thr) { slot = (int)(rg + (rq < keq ? rq : keq)); ++rg; }
                else if (k == thr) { if (rq < keq) slot = (int)(rg + rq); ++rq; }
                const int row = row0 + t;
                if (slot >= 0) { p.STOK[base + slot] = row; p.SVAL[base + slot] = __builtin_bit_cast(float, k); p.INV[(size_t)row * NE + e] = base + slot; }
                else p.INV[(size_t)row * NE + e] = -1;
            }
            __syncthreads();
        } else {
            const int row0 = NLAT + b * CTX, base = NSLOT_L + (b * NE + e) * CAPC;
            LAS float* vals = (LAS float*)lds;
            for (int t = tid; t < CTX; t += 512) vals[t] = p.AFF[(size_t)(row0 + t) * NE + e];
            __syncthreads();
            for (int t = tid; t < CTX; t += 512) {
                const float a = vals[t]; int rank = 0;
                for (int tt = 0; tt < CTX; ++tt) { const float o = vals[tt]; rank += (o > a || (o == a && tt < t)) ? 1 : 0; }
                const int row = row0 + t;
                if (rank < CAPC) { p.STOK[base + rank] = row; p.SVAL[base + rank] = a; p.INV[(size_t)row * NE + e] = base + rank; }
                else p.INV[(size_t)row * NE + e] = -1;
            }
            __syncthreads();
        }
    }
}

#define LDS_BAR() do { asm volatile("s_waitcnt lgkmcnt(0)" ::: "memory"); __builtin_amdgcn_s_barrier(); asm volatile("" ::: "memory"); } while (0)
__device__ __forceinline__ int hg_row0(int b, int pc) { return pc < NCHC ? NLAT + b * CTX + pc * 64 : b * SEQ + (pc - NCHC) * 64; }
constexpr int HG_FF = 0, HG_FB = 16640, HG_AF = 33280, HG_AB = 49920, HG_T0 = 66560, HG_TS = 9216, HG_VT = HG_T0 + 6 * HG_TS;
static_assert(HG_VT + HG_TS <= RING_BYTES, "hgrn LDS layout");
#define TSW_E(k, t) ((k) * 72 + ((((t) >> 3) ^ (((k) >> 3) & 7)) << 3) + ((t) & 7))
#define TSW_B(k, c) ((k) * 144 + (((c) ^ (((k) >> 3) & 7)) << 4))
constexpr int HG_LBOFF = LDSCTL_OFF + 4096;
__device__ __forceinline__ void hg_stage_lb(const int tid, PRef p, int l) {
    LAS float* dst = (LAS float*)((LAS unsigned char*)lds_raw + HG_LBOFF);
    for (int i = tid; i < 768; i += NTHR) dst[i] = p.LB[(size_t)((i / 384) * DEPTH + l) * 384 + (i % 384)];
    LDS_BAR();
}
__device__ __forceinline__ void hg_gates(const int tid, PRef p, int l, int h, const u32x4 zf, const u32x4 zb, LAS unsigned char* lds) {
    LAS float* FF = (LAS float*)(lds + HG_FF); LAS float* FB = (LAS float*)(lds + HG_FB); LAS float* AF = (LAS float*)(lds + HG_AF); LAS float* AB = (LAS float*)(lds + HG_AB);
    const int t = tid >> 3, cg = tid & 7;
    const LAS float* lbf = (const LAS float*)((LAS unsigned char*)lds_raw + HG_LBOFF) + h * 64 + cg * 8; const LAS float* lbb = lbf + 384;
#pragma unroll
    for (int j = 0; j < 8; ++j) {
        const float z0 = fminf(fmaxf(bf8(zf, j), -60.f), 60.f), z1 = fminf(fmaxf(bf8(zb, j), -60.f), 60.f);
        const float l0 = lbf[j], l1 = lbb[j];
        FF[t * 65 + cg * 8 + j] = l0 + (1.f - l0) * __builtin_amdgcn_rcpf(1.f + __expf(-z0));
        FB[t * 65 + cg * 8 + j] = l1 + (1.f - l1) * __builtin_amdgcn_rcpf(1.f + __expf(-z1));
    }
    LDS_BAR();
    {
        const int wave = tid >> 6, lane = tid & 63, cl = lane & 15, seg = lane >> 4, dir = wave >> 2, col = 16 * (wave & 3) + cl;
        const LAS float* F = dir ? FB : FF; LAS float* A = dir ? AB : AF;
        float pre[16]; float run = 0.f;
#pragma unroll
        for (int i = 0; i < 16; ++i) { const int tt = dir ? 16 * seg + 15 - i : 16 * seg + i; run += __logf(F[tt * 65 + col]); pre[i] = run; }
        const float T0 = __builtin_bit_cast(float, __builtin_amdgcn_ds_bpermute((cl + 0) << 2, __builtin_bit_cast(int, run)));
        const float T1 = __builtin_bit_cast(float, __builtin_amdgcn_ds_bpermute((cl + 16) << 2, __builtin_bit_cast(int, run)));
        const float T2 = __builtin_bit_cast(float, __builtin_amdgcn_ds_bpermute((cl + 32) << 2, __builtin_bit_cast(int, run)));
        const float T3 = __builtin_bit_cast(float, __builtin_amdgcn_ds_bpermute((cl + 48) << 2, __builtin_bit_cast(int, run)));
        const float off = dir ? ((seg < 1 ? T1 : 0.f) + (seg < 2 ? T2 : 0.f) + (seg < 3 ? T3 : 0.f)) : ((seg > 0 ? T0 : 0.f) + (seg > 1 ? T1 : 0.f) + (seg > 2 ? T2 : 0.f));
#pragma unroll
        for (int i = 0; i < 16; ++i) { const int tt = dir ? 16 * seg + 15 - i : 16 * seg + i; A[tt * 65 + col] = off + pre[i]; }
    }
    LDS_BAR();
}
__device__ __forceinline__ bf16x8 ld2x64(const LAS unsigned char* p0, const LAS unsigned char* p1) {
    const u32x2 a = *(const LAS u32x2*)p0, b = *(const LAS u32x2*)p1; u32x4 r; r.x = a.x; r.y = a.y; r.z = b.x; r.w = b.y; return __builtin_bit_cast(bf16x8, r);
}
__device__ __forceinline__ f32x4 mfma16(bf16x8 a, bf16x8 b, f32x4 c) { return __builtin_amdgcn_mfma_f32_16x16x32_bf16(a, b, c, 0, 0, 0); }
__device__ __forceinline__ void phase_hgrn_local(const int tid, PRef p, int l, LAS unsigned char* lds) {
    LAS float* FF = (LAS float*)(lds + HG_FF); LAS float* FB = (LAS float*)(lds + HG_FB); LAS float* AF = (LAS float*)(lds + HG_AF); LAS float* AB = (LAS float*)(lds + HG_AB);
    LAS bf16_t* KTf = (LAS bf16_t*)(lds + HG_T0); LAS bf16_t* KTb = (LAS bf16_t*)(lds + HG_T0 + HG_TS); LAS bf16_t* VT = (LAS bf16_t*)(lds + HG_VT);
    const int t = tid >> 3, cg = tid & 7, wave = tid >> 6, lane = tid & 63, fr = lane & 15, fq = lane >> 4;
    u32x4 zf = (u32x4){0u, 0u, 0u, 0u}, zb = zf, v8 = zf, nzf = zf, nzb = zf, nv8 = zf;
    if ((int)blockIdx.x < NBH * NCH) { const int it = blockIdx.x, pc = it % NCH, bh = it / NCH, h = bh % HGH, b = bh / HGH;
        const bf16_t* pr = p.P + (size_t)(hg_row0(b, pc) + t) * INC + h * 64 + cg * 8; zf = *(const u32x4*)(pr + OFF_); zb = *(const u32x4*)(pr + OFB); v8 = *(const u32x4*)(pr + OHI); }
    hg_stage_lb(tid, p, l);
    for (int it = blockIdx.x; it < NBH * NCH; it += gridDim.x) {
        const int pc = it % NCH, bh = it / NCH, h = bh % HGH, b = bh / HGH, row0 = hg_row0(b, pc);
        { const int it2 = min(it + (int)gridDim.x, NBH * NCH - 1); const int pc2 = it2 % NCH, bh2 = it2 / NCH, h2 = bh2 % HGH, b2 = bh2 / HGH;
            const bf16_t* pr = p.P + (size_t)(hg_row0(b2, pc2) + t) * INC + h2 * 64 + cg * 8; nzf = *(const u32x4*)(pr + OFF_); nzb = *(const u32x4*)(pr + OFB); nv8 = *(const u32x4*)(pr + OHI); }
        hg_gates(tid, p, l, h, zf, zb, lds);
#pragma unroll
        for (int j = 0; j < 8; ++j) {
            const int k = cg * 8 + j;
            VT[TSW_E(k, t)] = (bf16_t)(j & 1 ? v8[j >> 1] >> 16 : v8[j >> 1] & 0xffffu);
            KTf[TSW_E(k, t)] = f2bf((1.f - FF[t * 65 + k]) * __expf(AF[63 * 65 + k] - AF[t * 65 + k]));
            KTb[TSW_E(k, t)] = f2bf((1.f - FB[t * 65 + k]) * __expf(AB[k] - AB[t * 65 + k]));
        }
        if (tid < 64) p.GDEC[((size_t)(0 * NBH + bh) * NCH + pc) * 64 + tid] = __expf(AF[63 * 65 + tid]);
        else if (tid < 128) p.GDEC[((size_t)(1 * NBH + bh) * NCH + pc) * 64 + (tid - 64)] = __expf(AB[tid - 64]);
        LDS_BAR();
#if HGRN_DIAG == 4
        {
            const int v = tid >> 3, kg = tid & 7;
            for (int dir = 0; dir < 2; ++dir) {
                const LAS bf16_t* KT = (const LAS bf16_t*)(lds + HG_T0 + dir * HG_TS);
                float acc[8];
#pragma unroll
                for (int j = 0; j < 8; ++j) acc[j] = 0.f;
                for (int s_ = 0; s_ < 64; ++s_) { const float vv = bf2f(VT[v * 72 + s_]);
#pragma unroll
                    for (int j = 0; j < 8; ++j) acc[j] += bf2f(KT[(kg * 8 + j) * 72 + s_]) * vv; }
                bf16_t* dst = p.SLOC + ((size_t)(dir * NBH + bh) * NCH + pc) * 4096 + v * 64 + kg * 8;
#pragma unroll
                for (int j = 0; j < 8; ++j) dst[j] = f2bf(acc[j]);
            }
        }
#else
        {
            const int dir = wave >> 2, mt = wave & 3;
            const LAS unsigned char* KT = lds + HG_T0 + dir * HG_TS;
            bf16x8 a[2];
#pragma unroll
            for (int ks = 0; ks < 2; ++ks) a[ks] = *(const LAS bf16x8*)(KT + TSW_B(mt * 16 + fr, ks * 4 + fq));
            bf16_t* dst = p.SLOC + ((size_t)(dir * NBH + bh) * NCH + pc) * 4096;
            u32x2 w[4];
#pragma unroll
            for (int nt = 0; nt < 4; ++nt) {
                f32x4 acc = (f32x4){0.f, 0.f, 0.f, 0.f};
#pragma unroll
                for (int ks = 0; ks < 2; ++ks) { const bf16x8 bb = *(const LAS bf16x8*)(lds + HG_VT + TSW_B(nt * 16 + fr, ks * 4 + fq)); acc = mfma16(a[ks], bb, acc); }
                w[nt].x = cvt_pk_bf16(acc[0], acc[1]); w[nt].y = cvt_pk_bf16(acc[2], acc[3]);
            }
            zf = nzf; zb = nzb; v8 = nv8;
            asm volatile("" ::: "memory");
#pragma unroll
            for (int nt = 0; nt < 4; ++nt) *(u32x2*)(dst + (nt * 16 + fr) * 64 + mt * 16 + 4 * fq) = w[nt];
        }
#endif
        LDS_BAR();
    }
}
__device__ __forceinline__ void phase_hgrn_scan(const int tid, PRef p) {
    static_assert(NCH % 20 == 0, "scan group size");
    constexpr int GS = 20;
    for (int blk = (int)gridDim.x - 1 - (int)blockIdx.x; blk < 2 * NBH * 4; blk += gridDim.x) {
        const int sq = blk >> 2, part = blk & 3, dir = sq / NBH, e0 = part * 1024 + tid * 2, k = e0 & 63;
        unsigned* S = (unsigned*)(p.SLOC + (size_t)sq * NCH * 4096 + e0);
        const float* G = p.GDEC + (size_t)sq * NCH * 64 + k;
        float c0 = 0.f, c1 = 0.f;
        unsigned nx[GS]; f32x2 gn[GS];
#define HG_PC(j) (dir ? ((j) < NCHC ? NCHC - 1 - (j) : NCH + NCHC - 1 - (j)) : (j))
#pragma unroll
        for (int u = 0; u < GS; ++u) { const int pc = HG_PC(u); nx[u] = S[(size_t)pc * 2048]; gn[u] = *(const f32x2*)(G + (size_t)pc * 64); }
        for (int j0 = 0; j0 < NCH; j0 += GS) {
            unsigned cu[GS]; f32x2 gc[GS];
#pragma unroll
            for (int u = 0; u < GS; ++u) { cu[u] = nx[u]; gc[u] = gn[u]; }
            if (j0 + GS < NCH) {
#pragma unroll
                for (int u = 0; u < GS; ++u) { const int pc = HG_PC(j0 + GS + u); nx[u] = S[(size_t)pc * 2048]; gn[u] = *(const f32x2*)(G + (size_t)pc * 64); }
            }
#pragma unroll
            for (int u = 0; u < GS; ++u) {
                const int pc = HG_PC(j0 + u);
                S[(size_t)pc * 2048] = cvt_pk_bf16(c0, c1);
                c0 = gc[u][0] * c0 + bfw(cu[u], 0); c1 = gc[u][1] * c1 + bfw(cu[u], 1);
            }
        }
#undef HG_PC
    }
}
__device__ __forceinline__ void phase_hgrn_out(const int tid, PRef p, int l, LAS unsigned char* lds) {
    const int NCHO = (l + 1 < DEPTH) ? NCH : NCH - NCHC, PC0 = NCH - NCHO;
    LAS float* FF = (LAS float*)(lds + HG_FF); LAS float* FB = (LAS float*)(lds + HG_FB); LAS float* AF = (LAS float*)(lds + HG_AF); LAS float* AB = (LAS float*)(lds + HG_AB);
    LAS bf16_t* VT = (LAS bf16_t*)(lds + HG_VT);
    LAS float* OO = (LAS float*)(lds + HG_AF);
    const int t = tid >> 3, cg = tid & 7, wave = tid >> 6, lane = tid & 63, fr = lane & 15, fq = lane >> 4;
    u32x4 zf = (u32x4){0u, 0u, 0u, 0u}, zb = zf, v8 = zf, q8 = zf, g8 = zf, nzf = zf, nzb = zf, nv8 = zf, nq8 = zf, ng8 = zf;
    bf16x8 bsin[4][2], nbsin[4][2];
#define HG_LOADSIN(dst, bhx, pcx) do { const bf16_t* SIN_ = p.SLOC + ((size_t)((wave >> 2) * NBH + (bhx)) * NCH + (pcx)) * 4096; \
        _Pragma("unroll") for (int vt = 0; vt < 4; ++vt) _Pragma("unroll") for (int ks = 0; ks < 2; ++ks) dst[vt][ks] = *(const bf16x8*)(SIN_ + (vt * 16 + fr) * 64 + ks * 32 + fq * 8); } while (0)
#pragma unroll
    for (int vt = 0; vt < 4; ++vt) { bsin[vt][0] = (bf16x8){0, 0, 0, 0, 0, 0, 0, 0}; bsin[vt][1] = bsin[vt][0]; nbsin[vt][0] = bsin[vt][0]; nbsin[vt][1] = bsin[vt][0]; }
    if ((int)blockIdx.x < NBH * NCHO) { const int it = blockIdx.x, pc = it % NCHO + PC0, bh = it / NCHO, h = bh % HGH, b = bh / HGH;
        const bf16_t* pr = p.P + (size_t)(hg_row0(b, pc) + t) * INC + h * 64 + cg * 8; zf = *(const u32x4*)(pr + OFF_); zb = *(const u32x4*)(pr + OFB); v8 = *(const u32x4*)(pr + OHI); q8 = *(const u32x4*)(pr + OHQ); g8 = *(const u32x4*)(pr + OHG_);
        HG_LOADSIN(bsin, bh, pc); }
    hg_stage_lb(tid, p, l);
    f32x4 hn0, hn1; { const float* nwp = p.hg_norm + l * 64 + cg * 8; hn0 = *(const f32x4*)nwp; hn1 = *(const f32x4*)(nwp + 4); }
    for (int it = blockIdx.x; it < NBH * NCHO; it += gridDim.x) {
        const int pc = it % NCHO + PC0, bh = it / NCHO, h = bh % HGH, b = bh / HGH, row0 = hg_row0(b, pc);
        { const int it2 = min(it + (int)gridDim.x, NBH * NCHO - 1); const int pc2 = it2 % NCHO + PC0, bh2 = it2 / NCHO, h2 = bh2 % HGH, b2 = bh2 / HGH;
            const bf16_t* pr = p.P + (size_t)(hg_row0(b2, pc2) + t) * INC + h2 * 64 + cg * 8; nzf = *(const u32x4*)(pr + OFF_); nzb = *(const u32x4*)(pr + OFB); nv8 = *(const u32x4*)(pr + OHI); nq8 = *(const u32x4*)(pr + OHQ); ng8 = *(const u32x4*)(pr + OHG_);
            HG_LOADSIN(nbsin, bh2, pc2); }
        hg_gates(tid, p, l, h, zf, zb, lds);
        {
            float w[6][8];
#pragma unroll
            for (int j = 0; j < 8; ++j) {
                const int k = cg * 8 + j;
                VT[TSW_E(k, t)] = (bf16_t)(j & 1 ? v8[j >> 1] >> 16 : v8[j >> 1] & 0xffffu);
                const float qv = bf8(q8, j) * 0.125f, af = AF[t * 65 + k], ab = AB[t * 65 + k], rf = AF[31 * 65 + k], rb = AB[32 * 65 + k];
                w[0][j] = qv * __expf(fminf(af - rf, 80.f)); w[1][j] = (1.f - FF[t * 65 + k]) * __expf(fminf(rf - af, 80.f)); w[2][j] = qv * __expf(af);
                w[3][j] = qv * __expf(fminf(ab - rb, 80.f)); w[4][j] = (1.f - FB[t * 65 + k]) * __expf(fminf(rb - ab, 80.f)); w[5][j] = qv * __expf(ab);
            }
#pragma unroll
            for (int a = 0; a < 6; ++a) { u32x4 o; o.x = cvt_pk_bf16(w[a][0], w[a][1]); o.y = cvt_pk_bf16(w[a][2], w[a][3]); o.z = cvt_pk_bf16(w[a][4], w[a][5]); o.w = cvt_pk_bf16(w[a][6], w[a][7]);
                *(LAS u32x4*)(lds + HG_T0 + a * HG_TS + t * 144 + cg * 16) = o; }
        }
        LDS_BAR();
        {
            const int dir = wave >> 2, tt = wave & 3;
            const LAS unsigned char* QT = lds + HG_T0 + (dir * 3 + 0) * HG_TS; const LAS unsigned char* KL = lds + HG_T0 + (dir * 3 + 1) * HG_TS; const LAS unsigned char* QH = lds + HG_T0 + (dir * 3 + 2) * HG_TS;
            bf16x8 bq[2], bh[2];
#pragma unroll
            for (int ks = 0; ks < 2; ++ks) { bq[ks] = *(const LAS bf16x8*)(QT + (tt * 16 + fr) * 144 + ks * 64 + fq * 16); bh[ks] = *(const LAS bf16x8*)(QH + (tt * 16 + fr) * 144 + ks * 64 + fq * 16); }
            f32x4 o[4];
#pragma unroll
            for (int vt = 0; vt < 4; ++vt) { o[vt] = (f32x4){0.f, 0.f, 0.f, 0.f};
#pragma unroll
                for (int ks = 0; ks < 2; ++ks) o[vt] = mfma16(bsin[vt][ks], bh[ks], o[vt]); }
            const int t_ = 16 * tt + fr;
#pragma unroll
            for (int kp = 0; kp < 2; ++kp) {
                f32x4 sc[2];
#pragma unroll
                for (int hf = 0; hf < 2; ++hf) { const int st = 2 * kp + hf;
                    sc[hf] = (f32x4){0.f, 0.f, 0.f, 0.f};
                    if (dir ? st >= tt : st <= tt) {
#pragma unroll
                        for (int ks = 0; ks < 2; ++ks) { const bf16x8 a = *(const LAS bf16x8*)(KL + (st * 16 + fr) * 144 + ks * 64 + fq * 16); sc[hf] = mfma16(a, bq[ks], sc[hf]); }
#pragma unroll
                        for (int r = 0; r < 4; ++r) { const int s_ = 16 * st + 4 * fq + r; const bool keep = dir ? (s_ >= t_) : (s_ <= t_); sc[hf][r] = keep ? sc[hf][r] : 0.f; }
                    } }
                if (dir ? (2 * kp + 1 >= tt) : (2 * kp <= tt)) {
                    u32x4 pw; pw.x = cvt_pk_bf16(sc[0][0], sc[0][1]); pw.y = cvt_pk_bf16(sc[0][2], sc[0][3]); pw.z = cvt_pk_bf16(sc[1][0], sc[1][1]); pw.w = cvt_pk_bf16(sc[1][2], sc[1][3]);
                    const bf16x8 pf = __builtin_bit_cast(bf16x8, pw);
                    const int s0 = 32 * kp + 4 * fq;
#pragma unroll
                    for (int vt = 0; vt < 4; ++vt) { const int v_ = 16 * vt + fr; const int sw = (v_ >> 3) & 7;
                        const LAS unsigned char* vr = lds + HG_VT + v_ * 144 + (s0 & 7) * 2;
                        const bf16x8 a = ld2x64(vr + (((s0 >> 3) ^ sw) << 4), vr + ((((s0 + 16) >> 3) ^ sw) << 4));
                        o[vt] = mfma16(a, pf, o[vt]); }
                }
            }
            LAS float* OOd = (LAS float*)(lds + (dir ? HG_FB : HG_FF));
#pragma unroll
            for (int vt = 0; vt < 4; ++vt)
#pragma unroll
                for (int r = 0; r < 4; ++r) OOd[t_ * 65 + 16 * vt + 4 * fq + r] = o[vt][r];
        }
        LDS_BAR();
        {
            float o[8]; float ss = 0.f;
#pragma unroll
            for (int j = 0; j < 8; ++j) { o[j] = FF[t * 65 + cg * 8 + j] + FB[t * 65 + cg * 8 + j]; ss += o[j] * o[j]; }
            ss += __builtin_bit_cast(float, __builtin_amdgcn_ds_swizzle(__builtin_bit_cast(int, ss), (1 << 10) | 0x1f));
            ss += __builtin_bit_cast(float, __builtin_amdgcn_ds_swizzle(__builtin_bit_cast(int, ss), (2 << 10) | 0x1f));
            ss += __builtin_bit_cast(float, __builtin_amdgcn_ds_swizzle(__builtin_bit_cast(int, ss), (4 << 10) | 0x1f));
            const float rstd = 1.f / sqrtf(ss * (1.f / 64.f) + EPS);
            float y[8];
#pragma unroll
            for (int j = 0; j < 8; ++j) { const float g = bf8(g8, j); y[j] = o[j] * rstd * (j < 4 ? hn0[j & 3] : hn1[j & 3]) * g * __builtin_amdgcn_rcpf(1.f + __expf(-g)); }
            u32x4 ov; ov.x = cvt_pk_bf16(y[0], y[1]); ov.y = cvt_pk_bf16(y[2], y[3]); ov.z = cvt_pk_bf16(y[4], y[5]); ov.w = cvt_pk_bf16(y[6], y[7]);
            zf = nzf; zb = nzb; v8 = nv8; q8 = nq8; g8 = ng8;
#pragma unroll
            for (int vt = 0; vt < 4; ++vt) { bsin[vt][0] = nbsin[vt][0]; bsin[vt][1] = nbsin[vt][1]; }
            asm volatile("" ::: "memory");
            *(u32x4*)(p.MIX + (size_t)(row0 + t) * MIXD + 384 + h * 64 + cg * 8) = ov;
        }
        LDS_BAR();
    }
}


#undef HG_LOADSIN
constexpr int AT_KC = 0, AT_VCT = 36864, AT_KL = AT_VCT + 64 * 528, AT_VL = AT_KL + 2 * 9216, AT_RPB = AT_VL + 2 * 9216, AT_END = AT_RPB + 1920;
static_assert(AT_END <= RING_BYTES && CTX == 256, "attention LDS layout (built for 256 context tokens)");
constexpr float ATHR = 6.f;
template <bool LOCAL, int NKB>
__device__ __forceinline__ void attn_step(const LAS unsigned char* Kb, const LAS unsigned char* Vb, int vstride, const bf16x8 (&qb)[2], f32x4 (&o)[4], float& m, float& lsum,
                                          int fr, int fq, int lane, const LAS float* rpb_row, const int (&boff)[8], const int (&voff)[4][2], int kbase) {
    f32x4 sc[2 * NKB];
#pragma unroll
    for (int mt = 0; mt < 2 * NKB; ++mt) { sc[mt] = (f32x4){0.f, 0.f, 0.f, 0.f};
#pragma unroll
        for (int ks = 0; ks < 2; ++ks) { const bf16x8 a = *(const LAS bf16x8*)(Kb + (16 * mt + fr) * 144 + ks * 64 + fq * 16); sc[mt] = mfma16(a, qb[ks], sc[mt]); } }
    float mx = -INFINITY;
#pragma unroll
    for (int mt = 0; mt < 2 * NKB; ++mt)
#pragma unroll
        for (int r = 0; r < 4; ++r) {
            float v = sc[mt][r];
            if (LOCAL) v += *(const LAS float*)((const LAS unsigned char*)rpb_row + boff[(4 * mt + r) & 7]);
            sc[mt][r] = v; mx = fmaxf(mx, v);
        }
    mx = fmaxf(mx, __builtin_bit_cast(float, __builtin_amdgcn_ds_swizzle(__builtin_bit_cast(int, mx), (16 << 10) | 0x1f)));
    mx = fmaxf(mx, __builtin_bit_cast(float, __builtin_amdgcn_ds_bpermute((lane ^ 32) << 2, __builtin_bit_cast(int, mx))));
    if (__builtin_amdgcn_ballot_w64(mx > m + ATHR) != 0ull) {
        const float mn = fmaxf(m, mx), corr = __builtin_amdgcn_exp2f(m - mn);
        m = mn; lsum *= corr;
#pragma unroll
        for (int dt = 0; dt < 4; ++dt) o[dt] = o[dt] * corr;
    }
    float ps = 0.f;
#pragma unroll
    for (int kb = 0; kb < NKB; ++kb) {
        float pv[8];
#pragma unroll
        for (int h2 = 0; h2 < 2; ++h2)
#pragma unroll
            for (int r = 0; r < 4; ++r) { const float e = __builtin_amdgcn_exp2f(sc[2 * kb + h2][r] - m); pv[4 * h2 + r] = e; ps += e; }
        u32x4 pw; pw.x = cvt_pk_bf16(pv[0], pv[1]); pw.y = cvt_pk_bf16(pv[2], pv[3]); pw.z = cvt_pk_bf16(pv[4], pv[5]); pw.w = cvt_pk_bf16(pv[6], pv[7]);
        const bf16x8 pf = __builtin_bit_cast(bf16x8, pw);
#pragma unroll
        for (int dt = 0; dt < 4; ++dt) {
            bf16x8 a;
            if (LOCAL) a = ld2x64(Vb + voff[dt][0], Vb + voff[dt][1]);
            else { const int d_ = 16 * dt + fr, sw_ = (d_ >> 3) & 7, c0_ = (kbase >> 3) + 4 * kb + (fq >> 1);
                const LAS unsigned char* vr = Vb + d_ * vstride + (fq & 1) * 8;
                a = ld2x64(vr + ((c0_ ^ sw_) << 4), vr + (((c0_ + 2) ^ sw_) << 4)); }
            o[dt] = mfma16(a, pf, o[dt]);
        }
    }
    lsum += ps;
}
__device__ __forceinline__ void phase_attn(const int tid, PRef p, int l, LAS unsigned char* lds) {
    const int wave = tid >> 6, lane = tid & 63, fr = lane & 15, fq = lane >> 4, skey = tid >> 3, sc8 = tid & 7;
    LAS float* RPB = (LAS float*)(lds + AT_RPB);
    constexpr int NPAIR = ROWS / 2; const int IPB = NPAIR + ((l + 1 < DEPTH) ? 2 : 0);
    const int G_ = gridDim.x, NIT = NB * NAH * IPB;
    const bool deal = (G_ == 256 && NIT <= 160 * 7 + 96 * 5);
    const int it_lo = deal ? ((int)blockIdx.x < 160 ? (int)blockIdx.x * 7 : 1120 + ((int)blockIdx.x - 160) * 5) : (int)blockIdx.x;
    const int it_n = deal ? ((int)blockIdx.x < 160 ? 7 : 5) : (NIT - (int)blockIdx.x + G_ - 1) / G_;
    int last_bh = -1;
#define AT_QTOK(itx) (((itx) % IPB) < NPAIR ? (((itx) / IPB) / NAH) * SEQ + (2 * ((itx) % IPB) + (wave >> 2)) * GW + 16 * (wave & 3) + fr : NLAT + (((itx) / IPB) / NAH) * CTX + ((((itx) % IPB) - NPAIR) * 128 + 16 * wave) + fr)
#define AT_LOADQ(itx, dst) do { const bf16_t* qp_ = p.P + (size_t)AT_QTOK(itx) * INC + OQ + (((itx) / IPB) % NAH) * 64 + fq * 8; dst[0] = *(const bf16x8*)qp_; dst[1] = *(const bf16x8*)(qp_ + 32); } while (0)
    bf16x8 qnx[2] = {(bf16x8){0, 0, 0, 0, 0, 0, 0, 0}, (bf16x8){0, 0, 0, 0, 0, 0, 0, 0}};
    { const int it0 = it_lo; if (it_n > 0 && it0 < NIT) AT_LOADQ(it0, qnx); }
    for (int ii = 0; ii < it_n; ++ii) {
        const int it = deal ? it_lo + ii : it_lo + ii * G_;
        if (it >= NIT) break;
        const int sub = it % IPB, bh = it / IPB, head = bh % NAH, b = bh / NAH;
        const bool islat = sub < NPAIR;
        const int r0 = 2 * sub, qr = r0 + (wave >> 2), jb = wave & 3;
        LDS_BAR();
        if (bh != last_bh) {
            last_bh = bh;
            for (int rnd = 0; rnd < 4; ++rnd) {
                const int key = skey + 64 * rnd; const bf16_t* src = p.P + (size_t)(NLAT + b * CTX + key) * INC + head * 64 + sc8 * 8;
                const u32x4 kv = *(const u32x4*)(src + OK_), vv = *(const u32x4*)(src + OV);
                *(LAS u32x4*)(lds + AT_KC + key * 144 + sc8 * 16) = kv;
#pragma unroll
                for (int j = 0; j < 8; ++j) *(LAS bf16_t*)(lds + AT_VCT + (sc8 * 8 + j) * 528 + ((((key >> 3) ^ sc8) << 4) + (key & 7) * 2)) = (bf16_t)(j & 1 ? vv[j >> 1] >> 16 : vv[j >> 1] & 0xffffu);
            }
            if (tid < 15 * 32) RPB[tid] = (tid & 31) < 31 ? p.rpb[((size_t)l * NAH + head) * 465 + (tid >> 5) * 31 + (tid & 31)] * 1.44269504089f : -INFINITY;
        }
        const int qtok = islat ? b * SEQ + qr * GW + 16 * jb + fr : NLAT + b * CTX + ((sub - NPAIR) * 128 + 16 * wave) + fr;
        bf16x8 qb[2]; qb[0] = qnx[0]; qb[1] = qnx[1];
        { const int itn = deal ? it + 1 : it + G_; if (ii + 1 < it_n && itn < NIT) AT_LOADQ(itn, qnx); }
        int krlo = 0, krhi = -1, rs = 0;
        if (islat) { int a = r0 - 4; a = a < 0 ? 0 : (a > ROWS - 8 ? ROWS - 8 : a); int c = r0 + 1 - 4; c = c < 0 ? 0 : (c > ROWS - 8 ? ROWS - 8 : c); krlo = a; krhi = c + 7;
            rs = qr - 4; rs = rs < 0 ? 0 : (rs > ROWS - 8 ? ROWS - 8 : rs); }
        u32x4 kA = (u32x4){0u, 0u, 0u, 0u}, vA = kA, kB = kA, vB = kA, kC = kA, vC = kA, kD = kA, vD = kA;
#define AT_LOADROW(row, kd, vd) do { const bf16_t* src_ = p.P + (size_t)(b * SEQ + (row) * GW + skey) * INC + head * 64 + sc8 * 8; kd = *(const u32x4*)(src_ + OK_); vd = *(const u32x4*)(src_ + OV); } while (0)
#define AT_STAGEROW(bufi, kd, vd) do { *(LAS u32x4*)(lds + AT_KL + (bufi) * 9216 + skey * 144 + sc8 * 16) = kd; \
        _Pragma("unroll") for (int j = 0; j < 8; ++j) *(LAS bf16_t*)(lds + AT_VL + (bufi) * 9216 + (sc8 * 8 + j) * 144 + ((((skey >> 3) ^ sc8) << 4) + (skey & 7) * 2)) = (bf16_t)(j & 1 ? vd[j >> 1] >> 16 : vd[j >> 1] & 0xffffu); } while (0)
        if (islat) { AT_LOADROW(krlo, kA, vA); AT_LOADROW(krlo + 1, kB, vB); AT_LOADROW(krlo + 2, kC, vC); AT_LOADROW(krlo + 3, kD, vD); }
        f32x4 o[4]; float m = -1e30f, lsum = 0.f;
#pragma unroll
        for (int dt = 0; dt < 4; ++dt) o[dt] = (f32x4){0.f, 0.f, 0.f, 0.f};
        LDS_BAR();
        const int bs = jb == 0 ? 0 : (jb == 1 ? 8 : (jb == 2 ? 24 : 32)), qc = 16 * jb + fr;
        int boff[8], voff[4][2];
        { int ws = qc - 8; ws = ws < 0 ? 0 : (ws > 48 ? 48 : ws);
#pragma unroll
          for (int j_ = 0; j_ < 8; ++j_) { const int kc = bs + 16 * (j_ >> 2) + 4 * fq + (j_ & 3); const bool ok = kc >= ws && kc < ws + 16; boff[j_] = (ok ? kc - qc + 15 : 31) * 4; asm volatile("" : "+v"(boff[j_])); }
#pragma unroll
          for (int dt = 0; dt < 4; ++dt) { const int d_ = 16 * dt + fr, sw_ = (d_ >> 3) & 7, c0_ = (bs >> 3) + (fq >> 1);
              voff[dt][0] = d_ * 144 + (fq & 1) * 8 + ((c0_ ^ sw_) << 4); voff[dt][1] = d_ * 144 + (fq & 1) * 8 + (((c0_ + 2) ^ sw_) << 4); asm volatile("" : "+v"(voff[dt][0]), "+v"(voff[dt][1])); } }
        for (int st = 0; st < 4; ++st)
            attn_step<false, 2>(lds + AT_KC + st * 64 * 144, lds + AT_VCT, 528, qb, o, m, lsum, fr, fq, lane, RPB, boff, voff, st * 64);
        if (islat) { AT_STAGEROW(0, kA, vA); AT_LOADROW(krlo + 4, kA, vA); }
        LDS_BAR();
#define AT_ROWSTEP(jj, BUF, NK, NV, DOSTAGE, DOLOAD) { const int kr = krlo + (jj); \
            if (kr >= rs && kr < rs + 8) \
                attn_step<true, 1>(lds + AT_KL + (BUF) * 9216 + bs * 144, lds + AT_VL + (BUF) * 9216, 144, qb, o, m, lsum, fr, fq, lane, RPB + (kr - qr + 7) * 32, boff, voff, bs); \
            if (DOSTAGE) { AT_STAGEROW((BUF) ^ 1, NK, NV); } if (DOLOAD) { AT_LOADROW(min(kr + 5, krhi), NK, NV); } \
            LDS_BAR(); }
        if (islat) {
            AT_ROWSTEP(0, 0, kB, vB, 1, 1) AT_ROWSTEP(1, 1, kC, vC, 1, 1) AT_ROWSTEP(2, 0, kD, vD, 1, 1) AT_ROWSTEP(3, 1, kA, vA, 1, 1)
            AT_ROWSTEP(4, 0, kB, vB, 1, 0) AT_ROWSTEP(5, 1, kC, vC, 1, 0) AT_ROWSTEP(6, 0, kD, vD, 1, 0) AT_ROWSTEP(7, 1, kA, vA, 1, 0)
            if (krlo + 8 <= krhi) { AT_ROWSTEP(8, 0, kB, vB, 0, 0) }
        }
#undef AT_ROWSTEP
#undef AT_LOADROW
#undef AT_STAGEROW
        lsum += __builtin_bit_cast(float, __builtin_amdgcn_ds_swizzle(__builtin_bit_cast(int, lsum), (16 << 10) | 0x1f));
        lsum += __builtin_bit_cast(float, __builtin_amdgcn_ds_bpermute((lane ^ 32) << 2, __builtin_bit_cast(int, lsum)));
        const float inv = 1.f / lsum;
        bf16_t* orow = p.MIX + (size_t)qtok * MIXD + head * 64;
#pragma unroll
        for (int dt = 0; dt < 4; ++dt) { u32x2 w; w.x = cvt_pk_bf16(o[dt][0] * inv, o[dt][1] * inv); w.y = cvt_pk_bf16(o[dt][2] * inv, o[dt][3] * inv); *(u32x2*)(orow + 16 * dt + 4 * fq) = w; }
    }
}


#undef AT_QTOK
#undef AT_LOADQ
template <int MODE> __device__ __forceinline__ void mini_gemm(const int tid, PRef p, int l) {
    const int wave = tid >> 6, lane = tid & 63, fr = lane & 15, fq = lane >> 4;
    const int gw = blockIdx.x * NWAVES + wave, NGW = gridDim.x * NWAVES;
    constexpr int K = MODE == 3 ? ED : (MODE == 1 ? MIXD : D);
    constexpr int N = MODE == 0 ? INC : (MODE == 2 ? 2 * ED : D);
    constexpr int MROWS = MODE <= 1 ? NCTX : NSLOT_C;
    constexpr int NTC = MODE == 2 ? 2 : 1, TW = 16 * NTC;
    constexpr int NTN = N / TW, NT = (MROWS / 32) * NTN;
    for (int t = gw; t < NT; t += NGW) {
        const int rt = t / NTN, ct = t % NTN, c0 = ct * TW;
        const bf16_t* Bt; const bf16_t* arow[2];
        if (MODE == 0) { Bt = p.WIN_T + WBOFF(l); for (int mt = 0; mt < 2; ++mt) arow[mt] = p.H + (size_t)(NLAT + rt * 32 + 16 * mt + fr) * D; }
        else if (MODE == 1) { Bt = p.WOUT_T + WBOFF(l); for (int mt = 0; mt < 2; ++mt) arow[mt] = p.MIX + (size_t)(NLAT + rt * 32 + 16 * mt + fr) * MIXD; }
        else if (MODE == 2) { const int e = rt % NE; Bt = p.WGU_T + WBOFF(l) + (size_t)e * 2 * ED * D;
            for (int mt = 0; mt < 2; ++mt) { int row = p.STOK[NSLOT_L + rt * 32 + 16 * mt + fr]; row = row < 0 ? 0 : (row >= NTOK ? NTOK - 1 : row); arow[mt] = p.H + (size_t)row * D; } }
        else { const int e = rt % NE; Bt = p.WD_T + WBOFF(l) + (size_t)e * D * ED; for (int mt = 0; mt < 2; ++mt) arow[mt] = p.HID + (size_t)(NSLOT_L + rt * 32 + 16 * mt + fr) * ED; }
        const bf16_t* brow = Bt + (size_t)(c0 + fr) * K;
        f32x4 acc[2][NTC];
#pragma unroll
        for (int mt = 0; mt < 2; ++mt)
#pragma unroll
            for (int nt = 0; nt < NTC; ++nt) acc[mt][nt] = (f32x4){0.f, 0.f, 0.f, 0.f};
#pragma unroll 8
        for (int ks = 0; ks < K / 32; ++ks) {
            bf16x8 a[2], bfr[NTC];
#pragma unroll
            for (int mt = 0; mt < 2; ++mt) a[mt] = *(const bf16x8*)(arow[mt] + ks * 32 + fq * 8);
#pragma unroll
            for (int nt = 0; nt < NTC; ++nt) bfr[nt] = *(const bf16x8*)(brow + (size_t)(16 * nt) * K + ks * 32 + fq * 8);
#pragma unroll
            for (int mt = 0; mt < 2; ++mt)
#pragma unroll
                for (int nt = 0; nt < NTC; ++nt) acc[mt][nt] = mfma16(a[mt], bfr[nt], acc[mt][nt]);
        }
#pragma unroll
        for (int mt = 0; mt < 2; ++mt)
#pragma unroll
            for (int r = 0; r < 4; ++r) {
                const int lr = rt * 32 + 16 * mt + 4 * fq + r;
                if (MODE == 0) { bf16_t* o = p.P + (size_t)(NLAT + lr) * INC + c0 + fr;
#pragma unroll
                    for (int nt = 0; nt < NTC; ++nt) o[16 * nt] = f2bf(acc[mt][nt][r]); }
                else if (MODE == 1) { float* o = p.XC + (size_t)lr * D + c0 + fr; const float* g = p.MOD + ((size_t)l * 3 + 2) * NMOD + 2 * D + c0 + fr;
#pragma unroll
                    for (int nt = 0; nt < NTC; ++nt) o[16 * nt] += g[16 * nt] * acc[mt][nt][r]; }
                else if (MODE == 2) { bf16_t* o = p.HID + (size_t)(NSLOT_L + lr) * ED + c0 / 2 + fr;
#pragma unroll
                    for (int q = 0; q < NTC / 2; ++q) { const float g = acc[mt][2 * q][r], u = acc[mt][2 * q + 1][r]; o[16 * q] = f2bf(g / (1.f + __expf(-g)) * u); } }
                else { bf16_t* o = p.Y + (size_t)(NSLOT_L + lr) * D + c0 + fr; const float val = p.SVAL[NSLOT_L + lr];
#pragma unroll
                    for (int nt = 0; nt < NTC; ++nt) o[16 * nt] = f2bf(val * acc[mt][nt][r]); }
            }
    }
}


__device__ __forceinline__ void phase_conv(const int tid, PRef p, int l) {
    const float* w = p.conv_w + (size_t)l * 3 * CVD;
    constexpr int U = 2;
    const long nitem = (long)NTOK * (CVD / 8), gstr = (long)gridDim.x * NTHR;
    for (long g0 = (long)blockIdx.x * NTHR + tid; g0 < nitem; g0 += gstr * U) {
        u32x4 cc[U][3], uu[U][3], bg[U]; float vz[U][3]; int rr[U], c8v[U]; bool ok[U];
#pragma unroll
        for (int u = 0; u < U; ++u) {
            long gid = g0 + u * gstr; ok[u] = gid < nitem; if (!ok[u]) gid = g0;
            const int r = (int)(gid / (CVD / 8)), c8 = (int)(gid % (CVD / 8)) * 8; rr[u] = r; c8v[u] = c8;
            int t, T; if (r < NLAT) { t = r % SEQ; T = SEQ; } else { t = (r - NLAT) % CTX; T = CTX; }
            const bf16_t* pr = p.P + (size_t)r * INC + c8;
#pragma unroll
            for (int d = 0; d < 3; ++d) { const int tt = t + d - 1; const bool in = tt >= 0 && tt < T; vz[u][d] = in ? 1.f : 0.f;
                const bf16_t* q = pr + (in ? (long)(d - 1) * INC : 0L); cc[u][d] = *(const u32x4*)(q + OCC); uu[u][d] = *(const u32x4*)(q + OCU); }
            bg[u] = *(const u32x4*)(pr + OCB);
        }
        asm volatile("" ::: "memory");
#pragma unroll
        for (int u = 0; u < U; ++u) {
            float y[8];
#pragma unroll
            for (int j = 0; j < 8; ++j) y[j] = 0.f;
#pragma unroll
            for (int d = 0; d < 3; ++d) {
                const f32x4 w0 = *(const f32x4*)(w + d * CVD + c8v[u]) * vz[u][d], w1 = *(const f32x4*)(w + d * CVD + c8v[u] + 4) * vz[u][d];
#pragma unroll
                for (int j = 0; j < 8; ++j) y[j] += (j < 4 ? w0[j & 3] : w1[j & 3]) * bf8(cc[u][d], j) * bf8(uu[u][d], j);
            }
            u32x4 o; o.x = cvt_pk_bf16(bf8(bg[u], 0) * y[0], bf8(bg[u], 1) * y[1]); o.y = cvt_pk_bf16(bf8(bg[u], 2) * y[2], bf8(bg[u], 3) * y[3]);
            o.z = cvt_pk_bf16(bf8(bg[u], 4) * y[4], bf8(bg[u], 5) * y[5]); o.w = cvt_pk_bf16(bf8(bg[u], 6) * y[6], bf8(bg[u], 7) * y[7]);
            if (ok[u]) *(u32x4*)(p.MIX + (size_t)rr[u] * MIXD + 768 + c8v[u]) = o;
        }
    }
}
__device__ __forceinline__ void phase_qkprep(const int tid, PRef p, int l) {
    const int sub = tid & 7;
    constexpr int U = 4;
    const long ngroups = (long)NTOK * 12, gstride = ((long)gridDim.x * NTHR) >> 3;
    for (long g0 = ((long)blockIdx.x * NTHR + tid) >> 3; g0 < ngroups; g0 += gstride * U) {
        u32x4 raw[U]; bf16_t* ptr[U]; int rr[U]; int wh[U];
#pragma unroll
        for (int u = 0; u < U; ++u) { long g8 = g0 + u * gstride; const bool ok = g8 < ngroups; if (!ok) g8 = g0;
            rr[u] = ok ? (int)(g8 / 12) : -1; wh[u] = (int)(g8 % 12) / 6; const int head = (int)(g8 % 6);
            ptr[u] = p.P + (size_t)(g8 / 12) * INC + (wh[u] ? OK_ : OQ) + head * HD + sub * 8; raw[u] = *(const u32x4*)ptr[u]; }
#pragma unroll
        for (int u = 0; u < U; ++u) {
            const float* nw = (wh[u] ? p.k_norm : p.q_norm) + l * HD + sub * 8;
            float y[8]; float ss = 0.f;
#pragma unroll
            for (int j = 0; j < 8; ++j) { y[j] = bf8(raw[u], j); ss += y[j] * y[j]; }
            ss += __builtin_bit_cast(float, __builtin_amdgcn_ds_swizzle(__builtin_bit_cast(int, ss), (1 << 10) | 0x1f));
            ss += __builtin_bit_cast(float, __builtin_amdgcn_ds_swizzle(__builtin_bit_cast(int, ss), (2 << 10) | 0x1f));
            ss += __builtin_bit_cast(float, __builtin_amdgcn_ds_swizzle(__builtin_bit_cast(int, ss), (4 << 10) | 0x1f));
            const float rstd = 1.f / sqrtf(ss * (1.f / HD) + EPS);
#pragma unroll
            for (int j = 0; j < 8; ++j) y[j] = y[j] * rstd * nw[j];
            const int r = rr[u];
            const bool lat = r >= 0 && r < NLAT;
            const int t = lat ? r % SEQ : 0; const float pos = (sub & 4) ? (float)(t % GW) : (float)(t / GW);
            const bool second = (sub & 2) != 0;
#pragma unroll
            for (int j = 0; j < 8; ++j) {
                const float other = __builtin_bit_cast(float, __builtin_amdgcn_ds_swizzle(__builtin_bit_cast(int, y[j]), (2 << 10) | 0x1f));
                const int fi = (sub & 1) * 8 + j;
                const float ang = pos * __builtin_amdgcn_exp2f(-(float)fi * (13.287712379549449f / 16.f));
                const float cs = FCOS(ang), sn = FSIN(ang);
                const float rot = second ? y[j] * cs + other * sn : y[j] * cs - other * sn;
                y[j] = lat ? rot : y[j];
            }
            if (r >= 0) { u32x4 o; o.x = cvt_pk_bf16(y[0], y[1]); o.y = cvt_pk_bf16(y[2], y[3]); o.z = cvt_pk_bf16(y[4], y[5]); o.w = cvt_pk_bf16(y[6], y[7]); *(u32x4*)ptr[u] = o; }
        }
    }
}

__device__ __forceinline__ f32x4 bf4(const u32x2 w) { return (f32x4){bfw(w.x, 0), bfw(w.x, 1), bfw(w.y, 0), bfw(w.y, 1)}; }
template <int MODE> __device__ __forceinline__ void phase_rows(const int tid, PRef p, int l, LAS unsigned char* lds) {
    static_assert(D == 1024, "wave-per-row kernels assume D = 1024");
    const int lane = tid & 63, wave = tid >> 6;
#define RC(j) (8 * lane + 512 * ((j) >> 1) + 4 * ((j) & 1))
    if (MODE == 1) {
        for (int k = tid; k < D; k += NTHR) { const f32x4* src = (const f32x4*)(p.w_router + ((size_t)l * D + k) * NE); LAS f32x4* dst = (LAS f32x4*)(lds + k * 64 + (k >> 3) * 16);
#pragma unroll
            for (int u = 0; u < 4; ++u) dst[u] = src[u]; }
        __syncthreads();
    }
    const int gw = blockIdx.x * NWAVES + wave, NGW = gridDim.x * NWAVES;
    const int rw = ((NTOK + NGW - 1) / NGW + 1) & ~1;
    const int r_lo = gw * rw, r_hi = min(NTOK, r_lo + rw);
    const bool doh = MODE != 2 || l + 1 < DEPTH;
    const int ln = (MODE == 2 && l + 1 < DEPTH) ? l + 1 : l;
    const float* nw = (MODE == 1 ? p.norm2_w : p.norm1_w) + (size_t)ln * D;
    int curset = -1; f32x4 Av[4], Sv[4], Gv[4];
#pragma unroll
    for (int j = 0; j < 4; ++j) { Av[j] = (f32x4){0.f, 0.f, 0.f, 0.f}; Sv[j] = Av[j]; Gv[j] = Av[j]; }
    u32x4 vn[2][4]; int invn[2] = {-1, -1};
#define ROWS_LOADPAIR(rb) do { _Pragma("unroll") for (int i_ = 0; i_ < 2; ++i_) { const int rr_ = ((rb) + i_ < r_hi) ? (rb) + i_ : (rb); \
        if (MODE != 0 && rr_ < NLAT) { const bf16_t* src_ = p.XB + (size_t)rr_ * D + 8 * lane; vn[i_][0] = *(const u32x4*)src_; vn[i_][1] = *(const u32x4*)(src_ + 512); } \
        else { const float* src_ = MODE == 0 ? (rr_ < NLAT ? p.x + (size_t)rr_ * D : p.ctx + (size_t)(rr_ - NLAT) * D) : p.XC + (size_t)(rr_ - NLAT) * D; \
            _Pragma("unroll") for (int j_ = 0; j_ < 4; ++j_) vn[i_][j_] = *(const u32x4*)(src_ + RC(j_)); } \
        if (MODE == 2) invn[i_] = lane < NE ? p.INV[(size_t)rr_ * NE + lane] : -1; } } while (0)
#pragma unroll
    for (int i = 0; i < 2; ++i)
#pragma unroll
        for (int j = 0; j < 4; ++j) vn[i][j] = (u32x4){0u, 0u, 0u, 0u};
    if (r_lo < r_hi) ROWS_LOADPAIR(r_lo);
#pragma unroll 1
    for (int r = r_lo; r < r_hi; r += 2) {
        const bool two = r + 1 < r_hi;
        const bool lat = r < NLAT;
        const int set = modset(r);
        if (set != curset) { curset = set;
            const float* mod = p.MOD + ((size_t)ln * 3 + set) * NMOD; const float* shift = mod + (MODE == 1 ? 3 : 0) * D; const float* scale = mod + (MODE == 1 ? 4 : 1) * D;
            int lane2 = lane; asm volatile("" : "+v"(lane2));
#pragma unroll
            for (int j = 0; j < 4; ++j) { const int c = 8 * lane2 + 512 * (j >> 1) + 4 * (j & 1); const f32x4 w4 = *(const f32x4*)(nw + c), sc4 = *(const f32x4*)(scale + c); Av[j] = w4 * (sc4 + 1.f); Sv[j] = *(const f32x4*)(shift + c);
                if (MODE == 2) Gv[j] = *(const f32x4*)(p.MOD + ((size_t)l * 3 + set) * NMOD + 5 * D + c); } }
        f32x4 v[2][4]; int inv2[2];
#pragma unroll
        for (int i = 0; i < 2; ++i) { inv2[i] = invn[i];
            if (MODE != 0 && lat) {
#pragma unroll
                for (int jj = 0; jj < 2; ++jj) { const u32x4 w = vn[i][jj]; v[i][2 * jj] = (f32x4){bfw(w.x, 0), bfw(w.x, 1), bfw(w.y, 0), bfw(w.y, 1)}; v[i][2 * jj + 1] = (f32x4){bfw(w.z, 0), bfw(w.z, 1), bfw(w.w, 0), bfw(w.w, 1)}; }
            } else {
#pragma unroll
                for (int j = 0; j < 4; ++j) v[i][j] = __builtin_bit_cast(f32x4, vn[i][j]);
            } }
        if (r + 2 < r_hi) ROWS_LOADPAIR(r + 2);
        if (MODE == 2) {
#pragma unroll
            for (int i = 0; i < 2; ++i) {
                const int myinv = inv2[i];
                unsigned long long mask = __ballot(myinv >= 0 && myinv < NSLOT);
                f32x4 acc[4];
#pragma unroll
                for (int j = 0; j < 4; ++j) acc[j] = (f32x4){0.f, 0.f, 0.f, 0.f};
                while (mask) {
                    const int e0 = __builtin_ctzll(mask); mask &= mask - 1; const int s0 = __builtin_amdgcn_readlane(myinv, e0);
                    int s1 = -1; if (mask) { const int e1 = __builtin_ctzll(mask); mask &= mask - 1; s1 = __builtin_amdgcn_readlane(myinv, e1); }
                    u32x4 y0[2], y1[2];
#pragma unroll
                    for (int jj = 0; jj < 2; ++jj) y0[jj] = *(const u32x4*)(p.Y + (size_t)s0 * D + 8 * lane + 512 * jj);
                    if (s1 >= 0) {
#pragma unroll
                        for (int jj = 0; jj < 2; ++jj) y1[jj] = *(const u32x4*)(p.Y + (size_t)s1 * D + 8 * lane + 512 * jj);
                    }
#pragma unroll
                    for (int jj = 0; jj < 2; ++jj) { acc[2 * jj] = acc[2 * jj] + (f32x4){bfw(y0[jj].x, 0), bfw(y0[jj].x, 1), bfw(y0[jj].y, 0), bfw(y0[jj].y, 1)}; acc[2 * jj + 1] = acc[2 * jj + 1] + (f32x4){bfw(y0[jj].z, 0), bfw(y0[jj].z, 1), bfw(y0[jj].w, 0), bfw(y0[jj].w, 1)}; }
                    if (s1 >= 0) {
#pragma unroll
                        for (int jj = 0; jj < 2; ++jj) { acc[2 * jj] = acc[2 * jj] + (f32x4){bfw(y1[jj].x, 0), bfw(y1[jj].x, 1), bfw(y1[jj].y, 0), bfw(y1[jj].y, 1)}; acc[2 * jj + 1] = acc[2 * jj + 1] + (f32x4){bfw(y1[jj].z, 0), bfw(y1[jj].z, 1), bfw(y1[jj].w, 0), bfw(y1[jj].w, 1)}; }
                    }
                }
#pragma unroll
                for (int j = 0; j < 4; ++j) v[i][j] = v[i][j] + Gv[j] * acc[j];
            }
        }
        if (MODE == 0 || MODE == 2) {
            const bool fin = MODE == 2 && l + 1 == DEPTH;
#pragma unroll
            for (int i = 0; i < 2; ++i) if (i == 0 || two) {
                if (lat && !fin) {
#pragma unroll
                    for (int jj = 0; jj < 2; ++jj) { u32x4 o; o.x = cvt_pk_bf16(v[i][2 * jj][0], v[i][2 * jj][1]); o.y = cvt_pk_bf16(v[i][2 * jj][2], v[i][2 * jj][3]); o.z = cvt_pk_bf16(v[i][2 * jj + 1][0], v[i][2 * jj + 1][1]); o.w = cvt_pk_bf16(v[i][2 * jj + 1][2], v[i][2 * jj + 1][3]);
                        *(u32x4*)(p.XB + (size_t)(r + i) * D + 8 * lane + 512 * jj) = o; }
                } else if (lat || !fin) { float* dst = lat ? p.XL + (size_t)(r + i) * D : p.XC + (size_t)(r + i - NLAT) * D;
#pragma unroll
                    for (int j = 0; j < 4; ++j) *(f32x4*)(dst + RC(j)) = v[i][j]; }
            }
        }
        if (doh) {
            float ss[2];
#pragma unroll
            for (int i = 0; i < 2; ++i) { float a = 0.f;
#pragma unroll
                for (int j = 0; j < 4; ++j) a += (v[i][j][0] * v[i][j][0] + v[i][j][1] * v[i][j][1]) + (v[i][j][2] * v[i][j][2] + v[i][j][3] * v[i][j][3]);
                ss[i] = a; }
            ss[0] = wave_sum(ss[0], lane); ss[1] = wave_sum(ss[1], lane);
            const float rstd0 = 1.f / sqrtf(ss[0] * (1.f / D) + EPS), rstd1 = 1.f / sqrtf(ss[1] * (1.f / D) + EPS);
            f32x4 hh[2][4];
#pragma unroll
            for (int j = 0; j < 4; ++j) { hh[0][j] = v[0][j] * rstd0 * Av[j] + Sv[j]; hh[1][j] = v[1][j] * rstd1 * Av[j] + Sv[j]; }
#pragma unroll
            for (int i = 0; i < 2; ++i) if (i == 0 || two) {
#pragma unroll
                for (int jj = 0; jj < 2; ++jj) { u32x4 o; o.x = cvt_pk_bf16(hh[i][2 * jj][0], hh[i][2 * jj][1]); o.y = cvt_pk_bf16(hh[i][2 * jj][2], hh[i][2 * jj][3]); o.z = cvt_pk_bf16(hh[i][2 * jj + 1][0], hh[i][2 * jj + 1][1]); o.w = cvt_pk_bf16(hh[i][2 * jj + 1][2], hh[i][2 * jj + 1][3]);
                    *(u32x4*)(p.H + (size_t)(r + i) * D + 8 * lane + 512 * jj) = o; } }
            if (MODE == 1) {
                LAS float* red = (LAS float*)(lds + 70144 + wave * 4224);
#pragma unroll
                for (int i = 0; i < 2; ++i) {
                    float lg[NE];
#pragma unroll
                    for (int e = 0; e < NE; ++e) lg[e] = 0.f;
#pragma unroll
                    for (int j = 0; j < 4; ++j)
#pragma unroll
                        for (int q = 0; q < 4; ++q) { const int k = RC(j) + q; const LAS f32x4* wr = (const LAS f32x4*)(lds + k * 64 + (k >> 3) * 16); const float hv = hh[i][j][q];
#pragma unroll
                            for (int u = 0; u < 4; ++u) { const f32x4 w = wr[u]; lg[4 * u + 0] += hv * w[0]; lg[4 * u + 1] += hv * w[1]; lg[4 * u + 2] += hv * w[2]; lg[4 * u + 3] += hv * w[3]; } }
#pragma unroll
                    for (int e = 0; e < NE; ++e) red[e * 65 + lane] = lg[e];
                    asm volatile("" ::: "memory");
                    const int e2 = lane & 15, part = lane >> 4;
                    float t = 0.f;
#pragma unroll
                    for (int x = 0; x < 16; ++x) t += red[e2 * 65 + part * 16 + x];
                    asm volatile("" ::: "memory");
                    t += __builtin_bit_cast(float, __builtin_amdgcn_ds_swizzle(__builtin_bit_cast(int, t), (16 << 10) | 0x1f));
                    t += __builtin_bit_cast(float, __builtin_amdgcn_ds_bpermute((lane ^ 32) << 2, __builtin_bit_cast(int, t)));
#define SWZF(x, d) __builtin_bit_cast(float, __builtin_amdgcn_ds_swizzle(__builtin_bit_cast(int, (x)), ((d) << 10) | 0x1f))
                    float m = t;
                    m = fmaxf(m, SWZF(m, 1)); m = fmaxf(m, SWZF(m, 2)); m = fmaxf(m, SWZF(m, 4)); m = fmaxf(m, SWZF(m, 8));
                    const float ex = expf(t - m); float sm = ex;
                    sm += SWZF(sm, 1); sm += SWZF(sm, 2); sm += SWZF(sm, 4); sm += SWZF(sm, 8);
#undef SWZF
                    if (lane < NE && (i == 0 || two)) p.AFF[(size_t)(r + i) * NE + lane] = ex / sm;
                }
            }
        }
    }
#undef ROWS_LOADPAIR
#undef RC
    if (MODE == 1) __syncthreads();
}


__device__ __forceinline__ void phase_adaln(const int tid, PRef p, LAS unsigned char* lds) {
    static_assert(D == 1024 && NMOD % 256 == 0, "adaln layout");
    const int lane = tid & 63, wave = tid >> 6;
    LAS float* SC = (LAS float*)lds;
    LAS float* RED = (LAS float*)(lds + 16384);
    for (int i = tid; i < 3 * D; i += NTHR) { const int st = i / D, k = i % D; const float cv = st < 2 ? p.c[st * D + k] : p.c_ctx[k]; SC[i] = cv / (1.f + __expf(-cv)); }
    __syncthreads();
    constexpr int NCG = NMOD / 256;
    for (int item = blockIdx.x; item < DEPTH * NCG * 2; item += gridDim.x) {
        const int l = item / (NCG * 2), rem = item % (NCG * 2), cgp = rem >> 1, kh = rem & 1;
        const int kbase = kh * 512 + wave * 64;
        const float* wp = p.w_mod + ((size_t)l * D + kbase) * NMOD + cgp * 256 + 4 * lane;
        f32x4 acc[3];
#pragma unroll
        for (int st = 0; st < 3; ++st) acc[st] = (f32x4){0.f, 0.f, 0.f, 0.f};
#pragma unroll 16
        for (int kk = 0; kk < 64; ++kk) { const f32x4 w = *(const f32x4*)(wp + (size_t)kk * NMOD);
#pragma unroll
            for (int st = 0; st < 3; ++st) acc[st] = acc[st] + w * SC[st * D + kbase + kk]; }
#pragma unroll
        for (int st = 0; st < 3; ++st) *(LAS f32x4*)(RED + (wave * 3 + st) * 256 + 4 * lane) = acc[st];
        __syncthreads();
        for (int o = tid; o < 3 * 256; o += NTHR) { const int st = o >> 8, n = o & 255; float v = 0.f;
#pragma unroll
            for (int w8 = 0; w8 < 8; ++w8) v += RED[(w8 * 3 + st) * 256 + n];
            if (kh == 0) v += p.b_mod[(size_t)l * NMOD + cgp * 256 + n];
            atomicAdd(p.MOD + ((size_t)l * 3 + st) * NMOD + cgp * 256 + n, v); }
        __syncthreads();
    }
}

constexpr int NPL = 11, NPH = 1 + DEPTH * NPL;
struct Args { Params p; int ph_lo, ph_hi; };
__global__ void __launch_bounds__(NTHR, 2) mega_fwd(Args args) {
    LAS unsigned char* lds = (LAS unsigned char*)lds_raw;
    {
        const int tid0 = threadIdx.x;
        for (int u = tid0; u < (LDS_BYTES - LDSCTL_OFF) / 4; u += NTHR) ((LAS unsigned*)(lds + LDSCTL_OFF))[u] = 0u;
        __syncthreads();
    }
    int wslot = 0;
    { unsigned m_ = ~0u; asm volatile("" : "+s"(m_));
      const int simd = (int)(__builtin_amdgcn_s_getreg((1 << 11) | (4 << 6) | 4) & 3u);
      if (__builtin_amdgcn_mbcnt_hi(m_, __builtin_amdgcn_mbcnt_lo(m_, 0u)) == 0) wslot = simd + 4 * (int)__hip_atomic_fetch_add(((unsigned*)(lds_raw + MISC_OFF + 64)) + simd, 1u, __ATOMIC_RELAXED, __HIP_MEMORY_SCOPE_WORKGROUP); }
    wslot = __builtin_amdgcn_readfirstlane(wslot) & 7;
#define MY_TID(var) int var; { unsigned m_ = ~0u; asm volatile("" : "+s"(m_)); var = wslot * 64 + (int)__builtin_amdgcn_mbcnt_hi(m_, __builtin_amdgcn_mbcnt_lo(m_, 0u)); } asm volatile("" : "+v"(var))
    XcdBarrier bar; bar.bar = args.p.CTL; bar.x = 0;
    const bool multi = args.ph_hi - args.ph_lo > 1;
    if (multi) { MY_TID(t0); bar = xcd_barrier_post(args.p.CTL, t0 == 0); }
    const int G = gridDim.x;
    const int ph_lo = args.ph_lo, ph_hi = args.ph_hi;
#ifndef PHMASK
#define PHMASK 0xFFFF
#endif
#define PH_ON(k) ((k) == 0 ? (PHMASK & 1) : ((PHMASK >> (1 + ((k) - 1) % NPL)) & 1))
#ifndef REPMASK
#define REPMASK 0
#endif
#ifndef REP_LOCAL
#define REP_LOCAL 0
#define REP_CONV 0
#define REP_ATTN 0
#endif
#ifndef HG_STOP
#define HG_STOP 0
#endif
#ifndef REP_P0
#define REP_P0 0
#endif
#define REP_N(k) (((k) == 0 && REP_P0) ? 2 : (((k) > 0 && ((REPMASK >> (((k) - 1) % NPL)) & 1)) ? 2 : 1))
#define PH_BEGIN(k) if (PH_ON(k) && ph_lo <= (k) && (k) < ph_hi) { for (int rep_ = 0; rep_ < REP_N(k); ++rep_) { const AS4 Args* kp = (const AS4 Args*)__builtin_amdgcn_kernarg_segment_ptr(); asm volatile("" : "+s"(kp)); PRef p = kp->p; MY_TID(tid);
#define PH_END_IF(k, cond) } if ((cond) && (k) + 1 < ph_hi) { MY_TID(t1); xcd_barrier(bar, t1 == 0, XB_ST(lds_raw)); } }
#ifndef REP_CVT
#define REP_CVT 0
#endif
#ifndef REP_BAR
#define REP_BAR 0
#endif
#define PH_END(k) } if ((k) + 1 < ph_hi) { for (int rb_ = 0; rb_ < 1 + REP_BAR; ++rb_) { MY_TID(t1); xcd_barrier(bar, t1 == 0, XB_ST(lds_raw)); } } }
    PH_BEGIN(0)
        phase_adaln(tid, p, lds);
        run_items<b_lb>(tid, p, 0, 2L * 384, 0);
        phase_convert(tid, p, 0, lds, 1, 0);
    PH_END(0)
#define LAYER(l)                                                                                                                                     \
    PH_BEGIN(1 + (l) * NPL + 0) if ((l) == 0) { phase_rows<0>(tid, p, 0, lds); } PH_END_IF(1 + (l) * NPL + 0, (l) == 0)                                 \
    PH_BEGIN(1 + (l) * NPL + 1) {                                                                                                                    \
        pg8::Gemm g{p.H, p.WIN_T + WBOFF(l), NTOK, INC, D, nullptr, 0, 1, 0}; pg8::StaticOrder S; S.init(NTOK, INC, G, (int)blockIdx.x);                         \
        pg8::EpiP E{p.P, INC, p.q_norm + (l) * HD, p.k_norm + (l) * HD, rep_};                                                    \
        pg8::gemm_phase<pg8::EpiP, false>(tid, lds, g, S, E);                                                                                     \
        } PH_END(1 + (l) * NPL + 1)               \
    PH_BEGIN(1 + (l) * NPL + 2) if constexpr (!FUSE_QK) { phase_qkprep(tid, p, l); } if constexpr (FAST_HGRN && (HGRN_DIAG == 3 || HGRN_DIAG == 4)) { phase_hgrn_local(tid, p, l, lds); { MY_TID(t7); run_items<b_hgrn_local_slow>(t7, p, l, 2L * NBH * NCH * 64, 0); } } else if constexpr (FAST_HGRN && HGRN_DIAG >= 2) { run_items<b_hgrn_local_slow>(tid, p, l, 2L * NBH * NCH * 64, 0); } else if constexpr (FAST_HGRN) { for (int r2_ = 0; r2_ < 1 + REP_LOCAL; ++r2_) phase_hgrn_local(tid, p, l, lds); } else { run_items<b_gates>(tid, p, l, (long)NTOK * 768, 0); } phase_conv(tid, p, l); PH_END(1 + (l) * NPL + 2) \
    PH_BEGIN(1 + (l) * NPL + 3) if constexpr (FAST_HGRN && HGRN_DIAG) { run_items<b_hgrn_scan_slow>(tid, p, l, 2L * NBH * 4096, 0); } else if constexpr (FAST_HGRN) { phase_hgrn_scan(tid, p); } else { run_items<b_hgrn_seq2>(tid, p, l, 2L * NB * HGH * 64, 0); } if constexpr (FAST_ATTN) { for (int r4_ = 0; r4_ < 1 + REP_ATTN; ++r4_) { MY_TID(t6); phase_attn(t6, p, l, lds); } } else { run_items<b_attn>(tid, p, l, (long)NTOK * NAH, 0); } PH_END(1 + (l) * NPL + 3) \
    PH_BEGIN(1 + (l) * NPL + 4) if constexpr (FAST_HGRN && HGRN_DIAG) { run_items<b_hgrn_chunkseq>(tid, p, l, 2L * NBH * NCH * 64, 0); { MY_TID(t9); xcd_barrier(bar, t9 == 0, XB_ST(lds_raw)); } { MY_TID(t8); run_items<b_hgfin>(t8, p, l, (long)NTOK * HGH, 0); } } else if constexpr (FAST_HGRN) { phase_hgrn_out(tid, p, l, lds); } else { run_items<b_hgfin>(tid, p, l, (long)NTOK * HGH, 0); } PH_END(1 + (l) * NPL + 4)                                         \
    PH_BEGIN(1 + (l) * NPL + 5) {                                                                                                                    \
        pg8::Gemm g{p.MIX, p.WOUT_T + WBOFF(l), NLAT, D, MIXD, nullptr, 0, 1, 0}; pg8::StaticOrder S; S.init(NLAT, D, G, (int)blockIdx.x);                       \
        pg8::EpiRes E{p.XB, D, p.MOD + (size_t)(l) * 3 * NMOD + 2 * D, SEQ, (size_t)NMOD};                                                           \
        pg8::gemm_phase<pg8::EpiRes, false>(tid, lds, g, S, E);                                                                                      \
        if ((l) + 1 < DEPTH) { MY_TID(tid2); mini_gemm<1>(tid2, p, l); } } PH_END(1 + (l) * NPL + 5)                  \
    PH_BEGIN(1 + (l) * NPL + 6) phase_rows<1>(tid, p, l, lds); PH_END(1 + (l) * NPL + 6)                                                               \
    PH_BEGIN(1 + (l) * NPL + 7) if constexpr (FAST_TOPK) { phase_topk(tid, p, lds); if ((l) == 0 && gridDim.x > 2 * NB * NE + 32) { MY_TID(t4); phase_convert(t4, p, 0, lds, 2, 2 * NB * NE); } else if ((l) == 0) { MY_TID(t4); phase_convert(t4, p, 0, lds, 2, 0); } else if ((l) + 1 < DEPTH) { MY_TID(t4); phase_convert(t4, p, (l) + 1, lds, 0, gridDim.x > 2 * NB * NE + 32 ? 2 * NB * NE : 0); } } else { run_items<b_rank>(tid, p, l, (long)NTOK * NE, 0); } PH_END(1 + (l) * NPL + 7)                                          \
    PH_BEGIN(1 + (l) * NPL + 8) {                                                                                                                    \
        pg8::Gemm g{p.H, p.WGU_T + WBOFF(l), NSLOT_L, 2 * ED, D, p.STOK, CAPL / 256, NE, (size_t)2 * ED * D * 2}; pg8::StaticOrder S; S.init(NSLOT_L, 2 * ED, G, (int)blockIdx.x); \
        pg8::EpiHid E{p.HID, ED};                                                                                                                    \
        pg8::gemm_phase<pg8::EpiHid, true>(tid, lds, g, S, E);                                                                                       \
        if ((l) + 1 < DEPTH) { MY_TID(tid2); mini_gemm<2>(tid2, p, l); } } PH_END(1 + (l) * NPL + 8)              \
    PH_BEGIN(1 + (l) * NPL + 9) {                                                                                                                    \
        pg8::Gemm g{p.HID, p.WD_T + WBOFF(l), NSLOT_L, D, ED, nullptr, CAPL / 256, NE, (size_t)D * ED * 2}; pg8::StaticOrder S; S.init(NSLOT_L, D, G, (int)blockIdx.x); \
        pg8::EpiBf16 E{p.Y, D, p.SVAL, 0};                                                                                                              \
        pg8::gemm_phase<pg8::EpiBf16, false>(tid, lds, g, S, E);                                                                                     \
        if ((l) + 1 < DEPTH) { MY_TID(tid2); mini_gemm<3>(tid2, p, l); } } PH_END(1 + (l) * NPL + 9)                \
    PH_BEGIN(1 + (l) * NPL + 10) phase_rows<2>(tid, p, l, lds); if ((l) == 0) { for (int rc_ = 0; rc_ < 1 + REP_CVT; ++rc_) { MY_TID(t5); phase_convert(t5, p, (l) + 1, lds); } }        PH_END(1 + (l) * NPL + 10)
#ifndef NLAYERS_BUILD
#define NLAYERS_BUILD DEPTH
#endif
    LAYER(0)
    if constexpr (NLAYERS_BUILD > 1) { LAYER(1) }
    if constexpr (NLAYERS_BUILD > 2) { LAYER(2) }
    if constexpr (NLAYERS_BUILD > 3) { LAYER(3) }
}

#ifndef MK_SPLIT
#define MK_SPLIT 0
#endif
extern "C" void kernel_launch(void* const* d_in, const int* in_sizes, int n_in, void* d_out, int out_size, void* d_ws, size_t ws_size,
                              hipStream_t stream) {
    static int grid = 0;
    if (grid == 0) {
        if (n_in != 20 || out_size != NLAT * D || ws_size < WS_END) { fprintf(stderr, "kernel_launch: unexpected problem (n_in %d out %d ws %zu need %zu)\n", n_in, out_size, ws_size, (size_t)WS_END); grid = -1; return; }
        int dev = 0, cus = 0;
        if (hipGetDevice(&dev) != hipSuccess || hipDeviceGetAttribute(&cus, hipDeviceAttributeMultiprocessorCount, dev) != hipSuccess) { grid = -1; return; }
        if (hipFuncSetAttribute((const void*)mega_fwd, hipFuncAttributeMaxDynamicSharedMemorySize, LDS_BYTES) != hipSuccess) { fprintf(stderr, "kernel_launch: hipFuncSetAttribute failed\n"); grid = -1; return; }
        int per_cu = 0;
        if (hipOccupancyMaxActiveBlocksPerMultiprocessor(&per_cu, (const void*)mega_fwd, NTHR, LDS_BYTES) != hipSuccess || per_cu < 1) { fprintf(stderr, "kernel_launch: occupancy query says %d\n", per_cu); }
        (void)hipGetLastError();
        grid = cus;
    }
    if (grid < 0) return;
    (void)hipMemsetAsync((char*)d_ws + WS_CTL, 0, WS_LB - WS_CTL, stream);
    Args a{};
    a.p = make_params(d_in, d_out, d_ws);
#if MK_SPLIT
    for (int ph = 0; ph < NPH; ++ph) { a.ph_lo = ph; a.ph_hi = ph + 1; hipLaunchKernelGGL(mega_fwd, dim3(grid), dim3(NTHR), LDS_BYTES, stream, a); }
#else
    a.ph_lo = 0; a.ph_hi = NPH;
    hipLaunchKernelGGL(mega_fwd, dim3(grid), dim3(NTHR), LDS_BYTES, stream, a);
#endif
}
#endif
```

```cpp
#ifndef CPU_SIM
#include <hip/hip_runtime.h>
#define BODY __device__ __forceinline__
#define FSIN(x) __sinf(x)
#define FCOS(x) __cosf(x)
#else
#include <cmath>
#include <cstdio>
#include <cstdlib>
#include <cstring>
#define BODY static inline
#define FSIN(x) sinf(x)
#define FCOS(x) cosf(x)
#endif
#include <stdint.h>
#include <stddef.h>

#ifndef CFG_D
#define CFG_D 1024
#define CFG_SEQ 16384
#define CFG_CTX 256
#define CFG_EDIM 512
#define CFG_DEPTH 4
#endif

typedef unsigned short bf16_t;

constexpr int D = CFG_D, NB = 2, SEQ = CFG_SEQ, DEPTH = CFG_DEPTH, GW = 64, ROWS = SEQ / GW, CTX = CFG_CTX;
constexpr int HD = 64, NAH = 6, HGH = 6, CVD = 256, MIXD = 1024, INC = 3840, NMOD = 6 * D;
constexpr int NE = 16, ED = CFG_EDIM, CAPL = 2 * SEQ / NE, CAPC = 2 * CTX / NE;
constexpr int NLAT = NB * SEQ, NCTX = NB * CTX, NTOK = NLAT + NCTX;
constexpr int NSLOT_L = NB * NE * CAPL, NSLOT_C = NB * NE * CAPC, NSLOT = NSLOT_L + NSLOT_C;
constexpr int OQ = 0, OK_ = 384, OV = 768, OHQ = 1152, OFF_ = 1536, OFB = 1920, OHI = 2304, OHG_ = 2688, OCB = 3072, OCC = 3328, OCU = 3584;
constexpr float EPS = 1e-6f;
constexpr int NCH = (CTX + SEQ) / 64, NCHC = CTX / 64, NBH = NB * HGH;

struct Params {
    const float *x, *c, *ctx, *c_ctx, *w_mod, *b_mod, *norm1_w, *w_in, *q_norm, *k_norm, *rpb, *lb_logits, *hg_norm, *conv_w, *w_out,
        *norm2_w, *w_router, *w_gate, *w_up, *w_down;
    float *XL, *XC, *MOD, *LB, *AFF, *SVAL, *FG, *OHG;
    bf16_t *H, *P, *MIX, *HID, *Y;
    int *STOK, *INV;
    bf16_t *WIN_T, *WOUT_T, *WGU_T, *WD_T;
    unsigned* CTL;
    bf16_t* SLOC;
    float* GDEC;
    bf16_t* XB;
};

#ifndef CPU_SIM
#define AS4 __attribute__((address_space(4)))
typedef const AS4 Params& PRef;
#else
typedef const Params& PRef;
#endif
BODY float bf2f(bf16_t v) { return __builtin_bit_cast(float, (unsigned)v << 16); }
BODY bf16_t f2bf(float f) { unsigned u = __builtin_bit_cast(unsigned, f); u += 0x7fffu + ((u >> 16) & 1u); return (bf16_t)(u >> 16); }
BODY float silu_f(float x) { return x / (1.f + expf(-x)); }
BODY float sigmoid_f(float x) { return 1.f / (1.f + expf(-x)); }
BODY int modset(int r) { return r < NLAT ? r / SEQ : 2; }
BODY float* xrow(PRef p, int r) { return r < NLAT ? p.XL + (size_t)r * D : p.XC + (size_t)(r - NLAT) * D; }

BODY void b_adaln(long gid, PRef p, int) {
    const int n = (int)(gid % NMOD), s = (int)((gid / NMOD) % 3), l = (int)(gid / (3 * NMOD));
    const float* cv = s < 2 ? p.c + s * D : p.c_ctx;
    const float* w = p.w_mod + (size_t)l * D * NMOD + n;
    float acc = 0.f;
    for (int k = 0; k < D; ++k) acc += silu_f(cv[k]) * w[(size_t)k * NMOD];
    p.MOD[gid] = acc + p.b_mod[l * NMOD + n];
}
BODY void b_lb(long gid, PRef p, int) {
    const int dir = (int)(gid / 384), j = (int)(gid % 384);
    const float* lg = p.lb_logits + (size_t)dir * DEPTH * 384 + j;
    float m = -INFINITY;
    for (int l = 0; l < DEPTH; ++l) m = fmaxf(m, lg[l * 384]);
    float s = 0.f;
    for (int l = 0; l < DEPTH; ++l) s += expf(lg[l * 384] - m);
    float cum = 0.f;
    p.LB[(dir * DEPTH + 0) * 384 + j] = 0.f;
    for (int l = 1; l < DEPTH; ++l) { cum += expf(lg[l * 384] - m) / s; p.LB[(dir * DEPTH + l) * 384 + j] = cum; }
}
BODY void b_copyx(long gid, PRef p, int) {
    if (gid < (long)NLAT * D) p.XL[gid] = p.x[gid]; else p.XC[gid - (long)NLAT * D] = p.ctx[gid - (long)NLAT * D];
}
template <int WHICH> BODY void b_prenorm(long gid, PRef p, int l) {
    const int r = (int)gid;
    const float* xr = xrow(p, r);
    const float* nw = (WHICH ? p.norm2_w : p.norm1_w) + l * D;
    const float* mod = p.MOD + ((size_t)l * 3 + modset(r)) * NMOD;
    const float* shift = mod + (WHICH ? 3 : 0) * D;
    const float* scale = mod + (WHICH ? 4 : 1) * D;
    float ss = 0.f;
    for (int k = 0; k < D; ++k) ss += xr[k] * xr[k];
    const float rstd = 1.f / sqrtf(ss / D + EPS);
    float lg[NE];
#pragma unroll
    for (int e = 0; e < NE; ++e) lg[e] = 0.f;
    for (int k = 0; k < D; ++k) {
        const float h = xr[k] * rstd * nw[k] * (1.f + scale[k]) + shift[k];
        p.H[(size_t)r * D + k] = f2bf(h);
        if (WHICH) {
            const float* wr = p.w_router + ((size_t)l * D + k) * NE;
#pragma unroll
            for (int e = 0; e < NE; ++e) lg[e] += h * wr[e];
        }
    }
    if (WHICH) {
        float m = lg[0];
#pragma unroll
        for (int e = 1; e < NE; ++e) m = fmaxf(m, lg[e]);
        float s = 0.f;
#pragma unroll
        for (int e = 0; e < NE; ++e) { lg[e] = expf(lg[e] - m); s += lg[e]; }
#pragma unroll
        for (int e = 0; e < NE; ++e) p.AFF[(size_t)r * NE + e] = lg[e] / s;
    }
}
BODY void b_gemm_in(long gid, PRef p, int l) {
    const int r = (int)(gid / (INC / 4)), n = (int)(gid % (INC / 4)) * 4;
    const bf16_t* a = p.H + (size_t)r * D;
    const float* w = p.w_in + (size_t)l * D * INC + n;
    float a0 = 0.f, a1 = 0.f, a2 = 0.f, a3 = 0.f;
    for (int k = 0; k < D; ++k) { const float av = bf2f(a[k]); const float* wk = w + (size_t)k * INC; a0 += av * wk[0]; a1 += av * wk[1]; a2 += av * wk[2]; a3 += av * wk[3]; }
    bf16_t* o = p.P + (size_t)r * INC + n;
    o[0] = f2bf(a0); o[1] = f2bf(a1); o[2] = f2bf(a2); o[3] = f2bf(a3);
}
BODY void b_qkprep(long gid, PRef p, int l) {
    const int r = (int)(gid / 12), which = (int)(gid % 12) / 6, head = (int)(gid % 6);
    bf16_t* ptr = p.P + (size_t)r * INC + (which ? OK_ : OQ) + head * HD;
    const float* nw = (which ? p.k_norm : p.q_norm) + l * HD;
    float y[HD];
    float ss = 0.f;
#pragma unroll
    for (int d = 0; d < HD; ++d) { y[d] = bf2f(ptr[d]); ss += y[d] * y[d]; }
    const float rstd = 1.f / sqrtf(ss / HD + EPS);
#pragma unroll
    for (int d = 0; d < HD; ++d) y[d] = y[d] * rstd * nw[d];
    if (r < NLAT) {
        const int t = r % SEQ; const float row = (float)(t / GW), col = (float)(t % GW);
#pragma unroll
        for (int d = 0; d < 16; ++d) {
            const float inv = powf(10000.f, -(float)d / 16.f);
            const float ar = row * inv, ac = col * inv;
            const float cr = FCOS(ar), sr = FSIN(ar), cc = FCOS(ac), sc = FSIN(ac);
            const float x0 = y[d], x1 = y[d + 16], x2 = y[d + 32], x3 = y[d + 48];
            y[d] = x0 * cr - x1 * sr; y[d + 16] = x1 * cr + x0 * sr; y[d + 32] = x2 * cc - x3 * sc; y[d + 48] = x3 * cc + x2 * sc;
        }
    }
#pragma unroll
    for (int d = 0; d < HD; ++d) ptr[d] = f2bf(y[d]);
}
BODY void b_attn(long gid, PRef p, int l) {
    const int r = (int)(gid / NAH), head = (int)(gid % NAH);
    float q[HD], acc[HD];
    const bf16_t* qp = p.P + (size_t)r * INC + OQ + head * HD;
#pragma unroll
    for (int d = 0; d < HD; ++d) { q[d] = bf2f(qp[d]) * 0.125f; acc[d] = 0.f; }
    float m = -INFINITY, s = 0.f;
    const int b = r < NLAT ? r / SEQ : (r - NLAT) / CTX;
    const int nloc = r < NLAT ? 128 : 0;
    int row = 0, col = 0, rs = 0, ws = 0;
    if (r < NLAT) { const int t = r % SEQ; row = t / GW; col = t % GW; rs = row - 4; rs = rs < 0 ? 0 : (rs > ROWS - 8 ? ROWS - 8 : rs); ws = col - 8; ws = ws < 0 ? 0 : (ws > GW - 16 ? GW - 16 : ws); }
    for (int j = 0; j < nloc + CTX; ++j) {
        int kr; float bias = 0.f;
        if (j < nloc) { const int i = j / 16, jj = j % 16; kr = b * SEQ + (rs + i) * GW + ws + jj; bias = p.rpb[(((size_t)l * NAH + head) * 15 + (rs + i - row + 7)) * 31 + (ws + jj - col + 15)]; }
        else kr = NLAT + b * CTX + (j - nloc);
        const bf16_t* kp = p.P + (size_t)kr * INC + OK_ + head * HD;
        const bf16_t* vp = p.P + (size_t)kr * INC + OV + head * HD;
        float sc = 0.f;
#pragma unroll
        for (int d = 0; d < HD; ++d) sc += q[d] * bf2f(kp[d]);
        sc += bias;
        const float mn = fmaxf(m, sc), corr = expf(m - mn), pj = expf(sc - mn);
        s = s * corr + pj;
#pragma unroll
        for (int d = 0; d < HD; ++d) acc[d] = acc[d] * corr + pj * bf2f(vp[d]);
        m = mn;
    }
    const float inv = 1.f / s;
    bf16_t* o = p.MIX + (size_t)r * MIXD + head * HD;
#pragma unroll
    for (int d = 0; d < HD; ++d) o[d] = f2bf(acc[d] * inv);
}
BODY void b_gates(long gid, PRef p, int l) {
    const int j = (int)(gid % 384), dir = (int)((gid / 384) % 2), r = (int)(gid / 768);
    const float z = bf2f(p.P[(size_t)r * INC + (dir ? OFB : OFF_) + j]);
    const float lbv = p.LB[(dir * DEPTH + l) * 384 + j];
    p.FG[gid] = lbv + (1.f - lbv) * sigmoid_f(z);
}
template <int DIR> BODY void b_hgrn_seq(long gid, PRef p, int) {
    const int v = (int)(gid % 64), h = (int)((gid / 64) % HGH), b = (int)(gid / (64 * HGH));
    float S[64];
#pragma unroll
    for (int k = 0; k < 64; ++k) S[k] = 0.f;
    for (int step = 0; step < CTX + SEQ; ++step) {
        int r;
        if (step < CTX) r = NLAT + b * CTX + (DIR ? CTX - 1 - step : step);
        else r = b * SEQ + (DIR ? SEQ - 1 - (step - CTX) : (step - CTX));
        const float vv = bf2f(p.P[(size_t)r * INC + OHI + h * 64 + v]);
        const float* fr = p.FG + ((size_t)r * 2 + DIR) * 384 + h * 64;
        const bf16_t* qr = p.P + (size_t)r * INC + OHQ + h * 64;
        float o = 0.f;
#pragma unroll
        for (int k = 0; k < 64; ++k) { const float f = fr[k]; S[k] = f * S[k] + (1.f - f) * vv; o += S[k] * bf2f(qr[k]); }
        o *= 0.125f;
        p.OHG[((size_t)DIR * NTOK + r) * 384 + h * 64 + v] = o;
    }
}
BODY void b_hgfin(long gid, PRef p, int l) {
    const int r = (int)(gid / HGH), h = (int)(gid % HGH);
    const float* op = p.OHG + (size_t)r * 384 + h * 64;
    const float* op1 = op + (size_t)NTOK * 384;
    float o[64]; float ss = 0.f;
#pragma unroll
    for (int v = 0; v < 64; ++v) { o[v] = op[v] + op1[v]; ss += o[v] * o[v]; }
    const float rstd = 1.f / sqrtf(ss / 64.f + EPS);
    const bf16_t* g = p.P + (size_t)r * INC + OHG_ + h * 64;
    bf16_t* out = p.MIX + (size_t)r * MIXD + 384 + h * 64;
#pragma unroll
    for (int v = 0; v < 64; ++v) out[v] = f2bf(o[v] * rstd * p.hg_norm[l * 64 + v] * silu_f(bf2f(g[v])));
}
BODY void b_conv(long gid, PRef p, int l) {
    const int ch = (int)(gid % CVD), r = (int)(gid / CVD);
    int t, T;
    if (r < NLAT) { t = r % SEQ; T = SEQ; } else { t = (r - NLAT) % CTX; T = CTX; }
    const float* w = p.conv_w + (size_t)l * 3 * CVD + ch;
    float y = 0.f;
    for (int j = 0; j < 3; ++j) {
        const int tt = t + j - 1;
        if (tt < 0 || tt >= T) continue;
        const bf16_t* pr = p.P + (size_t)(r + j - 1) * INC;
        y += w[j * CVD] * bf2f(pr[OCC + ch]) * bf2f(pr[OCU + ch]);
    }
    p.MIX[(size_t)r * MIXD + 768 + ch] = f2bf(bf2f(p.P[(size_t)r * INC + OCB + ch]) * y);
}
BODY void b_gemm_out(long gid, PRef p, int l) {
    const int r = (int)(gid / (D / 4)), n = (int)(gid % (D / 4)) * 4;
    const bf16_t* a = p.MIX + (size_t)r * MIXD;
    const float* w = p.w_out + (size_t)l * MIXD * D + n;
    float a0 = 0.f, a1 = 0.f, a2 = 0.f, a3 = 0.f;
    for (int k = 0; k < MIXD; ++k) { const float av = bf2f(a[k]); const float* wk = w + (size_t)k * D; a0 += av * wk[0]; a1 += av * wk[1]; a2 += av * wk[2]; a3 += av * wk[3]; }
    const float* g = p.MOD + ((size_t)l * 3 + modset(r)) * NMOD + 2 * D + n;
    float* xr = xrow(p, r) + n;
    xr[0] += g[0] * a0; xr[1] += g[1] * a1; xr[2] += g[2] * a2; xr[3] += g[3] * a3;
}
BODY void b_rank(long gid, PRef p, int) {
    const int e = (int)(gid % NE), r = (int)(gid / NE);
    int t, T, row0, cap, base;
    if (r < NLAT) { const int b = r / SEQ; t = r % SEQ; T = SEQ; row0 = b * SEQ; cap = CAPL; base = (b * NE + e) * CAPL; }
    else { const int b = (r - NLAT) / CTX; t = (r - NLAT) % CTX; T = CTX; row0 = NLAT + b * CTX; cap = CAPC; base = NSLOT_L + (b * NE + e) * CAPC; }
    const float a = p.AFF[(size_t)r * NE + e];
    const float* col = p.AFF + (size_t)row0 * NE + e;
    int rank = 0;
    for (int tt = 0; tt < T; ++tt) { const float o = col[(size_t)tt * NE]; rank += (o > a || (o == a && tt < t)) ? 1 : 0; }
    if (rank < cap) { p.STOK[base + rank] = r; p.SVAL[base + rank] = a; p.INV[(size_t)r * NE + e] = base + rank; }
    else p.INV[(size_t)r * NE + e] = -1;
}
BODY int slot_expert(int s) { return s < NSLOT_L ? (s / CAPL) % NE : ((s - NSLOT_L) / CAPC) % NE; }
BODY void b_moe1(long gid, PRef p, int l) {
    const int s = (int)(gid / (ED / 4)), f = (int)(gid % (ED / 4)) * 4;
    const int e = slot_expert(s); int row = p.STOK[s]; row = row < 0 ? 0 : (row >= NTOK ? NTOK - 1 : row);
    const bf16_t* a = p.H + (size_t)row * D;
    const float* wg = p.w_gate + ((size_t)l * NE + e) * D * ED + f;
    const float* wu = p.w_up + ((size_t)l * NE + e) * D * ED + f;
    float g0 = 0.f, g1 = 0.f, g2 = 0.f, g3 = 0.f, u0 = 0.f, u1 = 0.f, u2 = 0.f, u3 = 0.f;
    for (int k = 0; k < D; ++k) {
        const float av = bf2f(a[k]); const float* gk = wg + (size_t)k * ED; const float* uk = wu + (size_t)k * ED;
        g0 += av * gk[0]; g1 += av * gk[1]; g2 += av * gk[2]; g3 += av * gk[3];
        u0 += av * uk[0]; u1 += av * uk[1]; u2 += av * uk[2]; u3 += av * uk[3];
    }
    bf16_t* o = p.HID + (size_t)s * ED + f;
    o[0] = f2bf(silu_f(g0) * u0); o[1] = f2bf(silu_f(g1) * u1); o[2] = f2bf(silu_f(g2) * u2); o[3] = f2bf(silu_f(g3) * u3);
}
BODY void b_moe2(long gid, PRef p, int l) {
    const int s = (int)(gid / (D / 4)), n = (int)(gid % (D / 4)) * 4;
    const int e = slot_expert(s);
    const bf16_t* a = p.HID + (size_t)s * ED;
    const float* w = p.w_down + ((size_t)l * NE + e) * ED * D + n;
    float a0 = 0.f, a1 = 0.f, a2 = 0.f, a3 = 0.f;
    for (int k = 0; k < ED; ++k) { const float av = bf2f(a[k]); const float* wk = w + (size_t)k * D; a0 += av * wk[0]; a1 += av * wk[1]; a2 += av * wk[2]; a3 += av * wk[3]; }
    const float val = p.SVAL[s];
    bf16_t* o = p.Y + (size_t)s * D + n;
    o[0] = f2bf(val * a0); o[1] = f2bf(val * a1); o[2] = f2bf(val * a2); o[3] = f2bf(val * a3);
}
BODY void b_combine(long gid, PRef p, int l) {
    const int r = (int)(gid / (D / 4)), n = (int)(gid % (D / 4)) * 4;
    float a0 = 0.f, a1 = 0.f, a2 = 0.f, a3 = 0.f;
    for (int e = 0; e < NE; ++e) {
        const int s = p.INV[(size_t)r * NE + e];
        if (s >= 0) { const bf16_t* y = p.Y + (size_t)s * D + n; a0 += bf2f(y[0]); a1 += bf2f(y[1]); a2 += bf2f(y[2]); a3 += bf2f(y[3]); }
    }
    const float* g = p.MOD + ((size_t)l * 3 + modset(r)) * NMOD + 5 * D + n;
    float* xr = xrow(p, r) + n;
    xr[0] += g[0] * a0; xr[1] += g[1] * a1; xr[2] += g[2] * a2; xr[3] += g[3] * a3;
}


#ifndef HGRN_DIAG
#define HGRN_DIAG 0
#endif
BODY void b_hgrn_chunkseq(long gid, PRef p, int l) {
    const int v = (int)(gid % 64), pc = (int)((gid / 64) % NCH), bh = (int)((gid / (64 * NCH)) % NBH), dir = (int)(gid / (64L * NCH * NBH));
    const int h = bh % HGH, b = bh / HGH, row0 = pc < NCHC ? NLAT + b * CTX + pc * 64 : b * SEQ + (pc - NCHC) * 64;
    const bf16_t* sin = p.SLOC + ((size_t)(dir * NBH + bh) * NCH + pc) * 4096 + v * 64;
    float S[64];
#pragma unroll
    for (int k = 0; k < 64; ++k) S[k] = bf2f(sin[k]);
    for (int i = 0; i < 64; ++i) {
        const int r = row0 + (dir ? 63 - i : i);
        const float vv = bf2f(p.P[(size_t)r * INC + OHI + h * 64 + v]);
        const bf16_t* zr = p.P + (size_t)r * INC + (dir ? OFB : OFF_) + h * 64;
        const bf16_t* qr = p.P + (size_t)r * INC + OHQ + h * 64;
        const float* lb = p.LB + (size_t)(dir * DEPTH + l) * 384 + h * 64;
        float o = 0.f;
#pragma unroll
        for (int k = 0; k < 64; ++k) { const float f = lb[k] + (1.f - lb[k]) * sigmoid_f(bf2f(zr[k])); S[k] = f * S[k] + (1.f - f) * vv; o += S[k] * bf2f(qr[k]); }
        p.OHG[((size_t)dir * NTOK + r) * 384 + h * 64 + v] = o * 0.125f;
    }
}

BODY void b_hgrn_scan_slow(long gid, PRef p, int) {
    const int e = (int)(gid % 4096), sq = (int)(gid / 4096), dir = sq / NBH, k = e & 63;
    bf16_t* S = p.SLOC + (size_t)sq * NCH * 4096 + e;
    const float* G = p.GDEC + (size_t)sq * NCH * 64 + k;
    float c = 0.f;
    for (int j = 0; j < NCH; ++j) {
        const int pc = dir ? (j < NCHC ? NCHC - 1 - j : NCH + NCHC - 1 - j) : j;
        const float x = bf2f(S[(size_t)pc * 4096]);
        S[(size_t)pc * 4096] = f2bf(c);
        c = G[(size_t)pc * 64] * c + x;
    }
}

BODY void b_hgrn_local_slow(long gid, PRef p, int l) {
    const int v = (int)(gid % 64), pc = (int)((gid / 64) % NCH), bh = (int)((gid / (64 * NCH)) % NBH), dir = (int)(gid / (64L * NCH * NBH));
    const int h = bh % HGH, b = bh / HGH, row0 = pc < NCHC ? NLAT + b * CTX + pc * 64 : b * SEQ + (pc - NCHC) * 64;
    float S[64], g[64];
#pragma unroll
    for (int k = 0; k < 64; ++k) { S[k] = 0.f; g[k] = 1.f; }
    for (int i = 0; i < 64; ++i) {
        const int r = row0 + (dir ? 63 - i : i);
        const float vv = bf2f(p.P[(size_t)r * INC + OHI + h * 64 + v]);
        const bf16_t* zr = p.P + (size_t)r * INC + (dir ? OFB : OFF_) + h * 64;
        const float* lb = p.LB + (size_t)(dir * DEPTH + l) * 384 + h * 64;
#pragma unroll
        for (int k = 0; k < 64; ++k) { const float f = lb[k] + (1.f - lb[k]) * sigmoid_f(bf2f(zr[k])); S[k] = f * S[k] + (1.f - f) * vv; g[k] *= f; }
    }
    bf16_t* dst = p.SLOC + ((size_t)(dir * NBH + bh) * NCH + pc) * 4096 + v * 64;
    if (HGRN_DIAG != 3 && HGRN_DIAG != 4) {
#pragma unroll
    for (int k = 0; k < 64; ++k) dst[k] = f2bf(S[k]);
    }
    if (v == 0) {
        float* gd = p.GDEC + ((size_t)(dir * NBH + bh) * NCH + pc) * 64;
#pragma unroll
        for (int k = 0; k < 64; ++k) gd[k] = g[k];
    }
}
#ifndef FAST_TOPK
#define FAST_TOPK 1
#endif
#ifndef FAST_HGRN
#define FAST_HGRN 1
#endif
#ifndef FAST_ATTN
#define FAST_ATTN 1
#endif
constexpr size_t al256(size_t x) { return (x + 255) & ~(size_t)255; }
constexpr size_t CTL_BYTES = 65536;
constexpr size_t WS_CTL = 0;
constexpr size_t WS_MOD = WS_CTL + CTL_BYTES;
constexpr size_t WS_LB = WS_MOD + al256((size_t)DEPTH * 3 * NMOD * 4);
constexpr size_t WS_XC = WS_LB + al256((size_t)2 * DEPTH * 384 * 4);
constexpr size_t WS_AFF = WS_XC + al256((size_t)NCTX * D * 4);
constexpr size_t WS_SVAL = WS_AFF + al256((size_t)NTOK * NE * 4);
constexpr size_t WS_STOK = WS_SVAL + al256((size_t)NSLOT * 4);
constexpr size_t WS_INV = WS_STOK + al256((size_t)NSLOT * 4);
constexpr size_t WS_H = WS_INV + al256((size_t)NTOK * NE * 4);
constexpr size_t WS_MIX = WS_H + al256((size_t)NTOK * D * 2);
constexpr size_t WS_P = WS_MIX + al256((size_t)NTOK * MIXD * 2);
constexpr size_t WS_HID = WS_P;
constexpr size_t WS_Y = WS_HID + al256((size_t)NSLOT * ED * 2);
constexpr size_t WS_P_END0 = WS_P + al256((size_t)NTOK * INC * 2);
constexpr size_t WS_P_END1 = WS_Y + al256((size_t)NSLOT * D * 2);
constexpr size_t WS_WB = WS_P_END0 > WS_P_END1 ? WS_P_END0 : WS_P_END1;
constexpr size_t WS_WIN_T = WS_WB;
constexpr size_t WS_WOUT_T = WS_WIN_T + al256((size_t)INC * D * 2);
constexpr size_t WS_WGU_T = WS_WOUT_T + al256((size_t)D * MIXD * 2);
constexpr size_t WS_WD_T = WS_WGU_T + al256((size_t)NE * 2 * ED * D * 2);
constexpr size_t WB_BYTES = WS_WD_T + al256((size_t)NE * D * ED * 2) - WS_WB;
constexpr size_t WS_T = WS_WB + 2 * WB_BYTES;
#if FAST_HGRN
constexpr size_t WS_SLOC = WS_T;
constexpr size_t WS_GDEC = WS_SLOC + al256((size_t)2 * NBH * NCH * 4096 * 2);
constexpr size_t WS_OHG = WS_GDEC + al256((size_t)2 * NBH * NCH * 64 * 4);
constexpr size_t WS_XB = WS_OHG + (HGRN_DIAG ? al256((size_t)2 * NTOK * 384 * 4) : 0);
constexpr size_t WS_END = WS_XB + al256((size_t)NLAT * D * 2);
constexpr size_t WS_FG = WS_T;
#else
constexpr size_t WS_FG = WS_T;
constexpr size_t WS_OHG = WS_FG + al256((size_t)NTOK * 768 * 4);
constexpr size_t WS_SLOC = WS_OHG + al256((size_t)2 * NTOK * 384 * 4);
constexpr size_t WS_GDEC = WS_SLOC;
constexpr size_t WS_XB = WS_SLOC;
constexpr size_t WS_END = WS_XB + al256((size_t)NLAT * D * 2);
#endif

static inline Params make_params(void* const* d_in, void* d_out, void* d_ws) {
    Params p{};
    const float** f = (const float**)&p;
    for (int i = 0; i < 20; ++i) f[i] = (const float*)d_in[i];
    char* ws = (char*)d_ws;
    p.XL = (float*)d_out; p.XC = (float*)(ws + WS_XC); p.MOD = (float*)(ws + WS_MOD); p.LB = (float*)(ws + WS_LB); p.AFF = (float*)(ws + WS_AFF);
    p.SVAL = (float*)(ws + WS_SVAL); p.FG = (float*)(ws + WS_FG); p.OHG = (float*)(ws + WS_OHG);
    p.H = (bf16_t*)(ws + WS_H); p.P = (bf16_t*)(ws + WS_P); p.MIX = (bf16_t*)(ws + WS_MIX); p.HID = (bf16_t*)(ws + WS_HID); p.Y = (bf16_t*)(ws + WS_Y);
    p.STOK = (int*)(ws + WS_STOK); p.INV = (int*)(ws + WS_INV);
    p.WIN_T = (bf16_t*)(ws + WS_WIN_T); p.WOUT_T = (bf16_t*)(ws + WS_WOUT_T); p.WGU_T = (bf16_t*)(ws + WS_WGU_T); p.WD_T = (bf16_t*)(ws + WS_WD_T);
    p.CTL = (unsigned*)(ws + WS_CTL); p.SLOC = (bf16_t*)(ws + WS_SLOC); p.GDEC = (float*)(ws + WS_GDEC); p.XB = (bf16_t*)(ws + WS_XB);
    return p;
}

#define FORWARD_STAGES(STAGE)                                                      \
    STAGE(b_adaln, (long)DEPTH * 3 * NMOD, 0)                                      \
    STAGE(b_lb, 2L * 384, 0)                                                       \
    STAGE(b_copyx, (long)NTOK * D, 0)                                              \
    for (int l = 0; l < DEPTH; ++l) {                                              \
        STAGE(b_prenorm<0>, (long)NTOK, l)                                         \
        STAGE(b_gemm_in, (long)NTOK * (INC / 4), l)                                \
        STAGE(b_qkprep, (long)NTOK * 12, l)                                        \
        STAGE(b_attn, (long)NTOK * NAH, l)                                         \
        STAGE(b_gates, (long)NTOK * 768, l)                                        \
        STAGE(b_hgrn_seq<0>, (long)NB * HGH * 64, l)                               \
        STAGE(b_hgrn_seq<1>, (long)NB * HGH * 64, l)                               \
        STAGE(b_hgfin, (long)NTOK * HGH, l)                                        \
        STAGE(b_conv, (long)NTOK * CVD, l)                                         \
        STAGE(b_gemm_out, (long)NTOK * (D / 4), l)                                 \
        STAGE(b_prenorm<1>, (long)NTOK, l)                                         \
        STAGE(b_rank, (long)NTOK * NE, l)                                          \
        STAGE(b_moe1, (long)NSLOT * (ED / 4), l)                                   \
        STAGE(b_moe2, (long)NSLOT * (D / 4), l)                                    \
        STAGE(b_combine, (long)NTOK * (D / 4), l)                                  \
    }

#ifndef CPU_SIM
#include <cstdio>
#define LAS __attribute__((address_space(3)))
#define GAS __attribute__((address_space(1)))
typedef short bf16x8 __attribute__((ext_vector_type(8)));
typedef float f32x4 __attribute__((ext_vector_type(4)));
typedef float f32x2 __attribute__((ext_vector_type(2)));
typedef unsigned u32x4 __attribute__((ext_vector_type(4)));
typedef unsigned u32x2 __attribute__((ext_vector_type(2)));
constexpr int NWAVES = 8, NTHR = 512;
constexpr int RING_BYTES = 131072, LDSCTL_OFF = RING_BYTES, MISC_OFF = LDSCTL_OFF + 320, TAB_OFF = LDSCTL_OFF + 1024  , LDS_BYTES = 147456;

typedef __bf16 bf16v2_t __attribute__((ext_vector_type(2)));
__device__ __forceinline__ unsigned cvt_pk_bf16_asm(float lo, float hi) { unsigned r; asm volatile("v_cvt_pk_bf16_f32 %0, %1, %2" : "=v"(r) : "v"(lo), "v"(hi)); return r; }
__device__ __forceinline__ unsigned cvt_pk_bf16(float lo, float hi) { bf16v2_t v = {(__bf16)lo, (__bf16)hi}; return __builtin_bit_cast(unsigned, v); }
__device__ __forceinline__ float wave_sum(float v, int lane) {
    v += __builtin_bit_cast(float, __builtin_amdgcn_ds_swizzle(__builtin_bit_cast(int, v), (1 << 10) | 0x1f));
    v += __builtin_bit_cast(float, __builtin_amdgcn_ds_swizzle(__builtin_bit_cast(int, v), (2 << 10) | 0x1f));
    v += __builtin_bit_cast(float, __builtin_amdgcn_ds_swizzle(__builtin_bit_cast(int, v), (4 << 10) | 0x1f));
    v += __builtin_bit_cast(float, __builtin_amdgcn_ds_swizzle(__builtin_bit_cast(int, v), (8 << 10) | 0x1f));
    v += __builtin_bit_cast(float, __builtin_amdgcn_ds_swizzle(__builtin_bit_cast(int, v), (16 << 10) | 0x1f));
    v += __builtin_bit_cast(float, __builtin_amdgcn_ds_bpermute((lane ^ 32) << 2, __builtin_bit_cast(int, v)));
    return v;
}

extern __shared__ __attribute__((aligned(16))) unsigned char lds_raw[];
#ifndef FUSE_QK
#define FUSE_QK 1
#endif
__device__ __forceinline__ float bfw(unsigned w, int hi) { return __builtin_bit_cast(float, hi ? (w & 0xffff0000u) : (w << 16)); }
__device__ __forceinline__ float bf8(const u32x4& v, int j) { return bfw(v[j >> 1], j & 1); }
namespace pg8 {
constexpr int BM = 256, BK = 64, HALF = 128, HTB = HALF * BK * 2, STAGE_BYTES = 8 * HTB, NXCD = 8, WGM = 8;
__device__ __forceinline__ int lds_byte(int r, int c) { const int st = (r >> 4) * 2 + (c >> 5), rr = r & 15, cc = c & 31, ob = rr * 64 + cc * 2; return st * 1024 + (ob ^ (((ob >> 9) & 1) << 5)); }
__device__ __forceinline__ void stage_rc(int b, int& R, int& C) { const int st = b / 1024, sb = b % 1024, swz = sb ^ (((sb >> 9) & 1) << 5); R = (st >> 1) * 16 + swz / 64; C = (st & 1) * 32 + (swz % 64) / 2; }
__device__ __forceinline__ int perm32(int rho) { const int n = rho >> 4, i = rho & 15; return 8 * (i >> 2) + 4 * n + (i & 3); }
struct Unit { int pm, pn; };
struct Gemm {
    const bf16_t* A; const bf16_t* Bt; int M, N, K;
    const int* gather;
    int gt, ng; size_t gstride;
};
struct StaticOrder {
    int nM, nN, nwg, G, c;
    __device__ void init(int M, int N, int G_, int c_) { nM = M / BM; nN = N / BM; nwg = nM * nN; G = G_; c = c_; }
    __device__ bool next(int i, Unit& u) const {
        const long L = (long)i * G + c; if (L >= nwg) return false;
        int wgid = (int)L; { const int q = nwg / NXCD, r = nwg % NXCD, xcd = wgid % NXCD, off = wgid / NXCD; wgid = (xcd < r ? xcd * (q + 1) : r * (q + 1) + (xcd - r) * q) + off; }
        const int nig = WGM * nN, gid = wgid / nig, fm = gid * WGM, gsz = (nM - fm) < WGM ? (nM - fm) : WGM;
        u.pm = fm + ((wgid % nig) % gsz); u.pn = (wgid % nig) / gsz; return true;
    }
};
struct EpiBf16 {
    static constexpr bool PERM = true;
    bf16_t* O; int ldc; const float* rowscale; int skip;
    __device__ __forceinline__ void operator()(const f32x4 (&acc)[2][2][4][2], const Unit& u, int wr, int wc, int fr, int fq) const {
        const int row0 = u.pm * BM + wr * 64 + fr, col0 = u.pn * BM + wc * 32 + 8 * fq;
        if (skip) { asm volatile("" :: "v"(acc[0][0][0][0]), "v"(acc[1][1][3][1])); return; }
        float scv[2][4];
#pragma unroll
        for (int ai = 0; ai < 2; ++ai)
#pragma unroll
            for (int m = 0; m < 4; ++m) scv[ai][m] = rowscale ? rowscale[row0 + ai * HALF + m * 16] : 1.f;
        asm volatile("" ::: "memory");
#pragma unroll
        for (int ai = 0; ai < 2; ++ai)
#pragma unroll
            for (int m = 0; m < 4; ++m) { const int row = row0 + ai * HALF + m * 16; bf16_t* rowp = O + (size_t)row * ldc + col0; const float sc = scv[ai][m];
#pragma unroll
                for (int bj = 0; bj < 2; ++bj) { const f32x4 v0 = acc[ai][bj][m][0] * sc, v1 = acc[ai][bj][m][1] * sc;
                    u32x4 w; w.x = cvt_pk_bf16_asm(v0[0], v0[1]); w.y = cvt_pk_bf16_asm(v0[2], v0[3]); w.z = cvt_pk_bf16_asm(v1[0], v1[1]); w.w = cvt_pk_bf16_asm(v1[2], v1[3]);
                    *(u32x4*)(rowp + bj * HALF) = w; } }
    }
};
struct EpiP {
    static constexpr bool PERM = true;
    bf16_t* O; int ldc; const float* qn; const float* kn; int skip;
    __device__ __forceinline__ void operator()(const f32x4 (&acc)[2][2][4][2], const Unit& u, int wr, int wc, int fr, int fq) const {
        const int row0 = u.pm * BM + wr * 64 + fr, col0 = u.pn * BM + wc * 32 + 8 * fq;
        if (skip) { asm volatile("" :: "v"(acc[0][0][0][0]), "v"(acc[1][1][3][1])); return; }
        if (u.pn >= 3 || !FUSE_QK) {
#pragma unroll
            for (int ai = 0; ai < 2; ++ai)
#pragma unroll
                for (int m = 0; m < 4; ++m) { bf16_t* rowp = O + (size_t)(row0 + ai * HALF + m * 16) * ldc + col0;
#pragma unroll
                    for (int bj = 0; bj < 2; ++bj) { const f32x4 v0 = acc[ai][bj][m][0], v1 = acc[ai][bj][m][1];
                        u32x4 w; w.x = cvt_pk_bf16_asm(v0[0], v0[1]); w.y = cvt_pk_bf16_asm(v0[2], v0[3]); w.z = cvt_pk_bf16_asm(v1[0], v1[1]); w.w = cvt_pk_bf16_asm(v1[2], v1[3]);
                        *(u32x4*)(rowp + bj * HALF) = w; } }
            return;
        }
        LAS float* PS = (LAS float*)((LAS unsigned char*)lds_raw + LDSCTL_OFF + 4096);
        const int half = wc & 1, hw = wc >> 1;
        unsigned lm_ = ~0u; asm volatile("" : "+s"(lm_)); const int lane = (int)__builtin_amdgcn_mbcnt_hi(lm_, __builtin_amdgcn_mbcnt_lo(lm_, 0u));
#pragma unroll
        for (int ai = 0; ai < 2; ++ai)
#pragma unroll
            for (int m = 0; m < 4; ++m)
#pragma unroll
                for (int bj = 0; bj < 2; ++bj) { const f32x4 v0 = acc[ai][bj][m][0], v1 = acc[ai][bj][m][1];
                    float s = (v0[0] * v0[0] + v0[1] * v0[1]) + (v0[2] * v0[2] + v0[3] * v0[3]) + (v1[0] * v1[0] + v1[1] * v1[1]) + (v1[2] * v1[2] + v1[3] * v1[3]);
                    s += __builtin_bit_cast(float, __builtin_amdgcn_ds_swizzle(__builtin_bit_cast(int, s), (16 << 10) | 0x1f));
                    s += __builtin_bit_cast(float, __builtin_amdgcn_ds_bpermute((lane ^ 32) << 2, __builtin_bit_cast(int, s)));
                    if (fq == 0) PS[((ai * HALF + wr * 64 + m * 16 + fr) * 4 + 2 * bj + hw) * 2 + half] = s; }
        asm volatile("s_waitcnt lgkmcnt(0)" ::: "memory"); __builtin_amdgcn_s_barrier(); asm volatile("" ::: "memory");
        float invf[8];
#pragma unroll
        for (int j = 0; j < 8; ++j) invf[j] = __builtin_amdgcn_exp2f(-(float)(8 * (fq & 1) + j) * (13.287712379549449f / 16.f));
        const bool second = (fq & 2) != 0;
        f32x4 nwv[2][2];
#pragma unroll
        for (int bj = 0; bj < 2; ++bj) { const bool isk = (u.pn * BM + bj * HALF + wc * 32) >= 384; const float* nw = (isk ? kn : qn) + 32 * half + 8 * fq; nwv[bj][0] = *(const f32x4*)nw; nwv[bj][1] = *(const f32x4*)(nw + 4); }
        asm volatile("" ::: "memory");
#pragma unroll
        for (int ai = 0; ai < 2; ++ai)
#pragma unroll
            for (int m = 0; m < 4; ++m) {
                const int grow = row0 + ai * HALF + m * 16; const bool lat = grow < NLAT; const int t = lat ? grow % SEQ : 0;
                int tp = half ? t % GW : t / GW; asm volatile("" : "+v"(tp));
                const float pos = (float)tp;
                float cs[8], sn[8];
#pragma unroll
                for (int j = 0; j < 8; ++j) { const float ang = pos * invf[j]; cs[j] = __cosf(ang); sn[j] = __sinf(ang); }
                bf16_t* rowp = O + (size_t)grow * ldc + col0;
#pragma unroll
                for (int bj = 0; bj < 2; ++bj) {
                    const int rl = ai * HALF + wr * 64 + m * 16 + fr, head = 2 * bj + hw;
                    const float ssq = PS[(rl * 4 + head) * 2] + PS[(rl * 4 + head) * 2 + 1];
                    const bool isk = (u.pn * BM + bj * HALF + wc * 32) >= 384;
                    const float rstd = (isk ? 1.f : 0.125f * 1.44269504089f) / sqrtf(ssq * (1.f / HD) + EPS);
                    const f32x4 n0 = nwv[bj][0], n1 = nwv[bj][1];
                    float y[8];
#pragma unroll
                    for (int j = 0; j < 4; ++j) { y[j] = acc[ai][bj][m][0][j] * rstd * n0[j]; y[4 + j] = acc[ai][bj][m][1][j] * rstd * n1[j]; }
#pragma unroll
                    for (int j = 0; j < 8; ++j) {
                        const unsigned yb = __builtin_bit_cast(unsigned, y[j]);
                        const auto sw = __builtin_amdgcn_permlane32_swap(yb, yb, false, false);
                        const float other = __builtin_bit_cast(float, lane < 32 ? sw[1] : sw[0]);
                        const float rot = second ? y[j] * cs[j] + other * sn[j] : y[j] * cs[j] - other * sn[j];
                        y[j] = lat ? rot : y[j];
                    }
                    u32x4 w; w.x = cvt_pk_bf16(y[0], y[1]); w.y = cvt_pk_bf16(y[2], y[3]); w.z = cvt_pk_bf16(y[4], y[5]); w.w = cvt_pk_bf16(y[6], y[7]);
                    *(u32x4*)(rowp + bj * HALF) = w;
                }
                asm volatile("" ::: "memory");
            }
    }
};
struct EpiRes {
    static constexpr bool PERM = true;
    bf16_t* X; int ldc; const float* gate0; int rows_per_set; size_t set_stride;
    __device__ __forceinline__ void operator()(const f32x4 (&acc)[2][2][4][2], const Unit& u, int wr, int wc, int fr, int fq) const {
        const int row0 = u.pm * BM + wr * 64 + fr, col0 = u.pn * BM + wc * 32 + 8 * fq;
        const float* gate = gate0 + (size_t)((u.pm * BM) / rows_per_set) * set_stride;
        f32x4 gv[2][2];
#pragma unroll
        for (int bj = 0; bj < 2; ++bj)
#pragma unroll
            for (int n = 0; n < 2; ++n) gv[bj][n] = *(const f32x4*)(gate + col0 + bj * HALF + n * 4);
        u32x4 rv[2][4][2];
#pragma unroll
        for (int ai = 0; ai < 2; ++ai)
#pragma unroll
            for (int m = 0; m < 4; ++m)
#pragma unroll
                for (int bj = 0; bj < 2; ++bj) rv[ai][m][bj] = *(const u32x4*)(X + (size_t)(row0 + ai * HALF + m * 16) * ldc + col0 + bj * HALF);
        asm volatile("" ::: "memory");
#pragma unroll
        for (int ai = 0; ai < 2; ++ai)
#pragma unroll
            for (int m = 0; m < 4; ++m) { bf16_t* rowp = X + (size_t)(row0 + ai * HALF + m * 16) * ldc + col0;
#pragma unroll
                for (int bj = 0; bj < 2; ++bj) { const u32x4 r = rv[ai][m][bj];
                    const f32x4 x0 = (f32x4){bfw(r.x, 0), bfw(r.x, 1), bfw(r.y, 0), bfw(r.y, 1)}, x1 = (f32x4){bfw(r.z, 0), bfw(r.z, 1), bfw(r.w, 0), bfw(r.w, 1)};
                    const f32x4 v0 = x0 + gv[bj][0] * acc[ai][bj][m][0], v1 = x1 + gv[bj][1] * acc[ai][bj][m][1];
                    u32x4 w; w.x = cvt_pk_bf16_asm(v0[0], v0[1]); w.y = cvt_pk_bf16_asm(v0[2], v0[3]); w.z = cvt_pk_bf16_asm(v1[0], v1[1]); w.w = cvt_pk_bf16_asm(v1[2], v1[3]);
                    *(u32x4*)(rowp + bj * HALF) = w; } }
    }
};
struct EpiHid {
    static constexpr bool PERM = false;
    bf16_t* O; int ldc;
    __device__ __forceinline__ void operator()(const f32x4 (&acc)[2][2][4][2], const Unit& u, int wr, int wc, int fr, int fq) const {
        const int row0 = u.pm * BM + wr * 64 + fr, col0 = (u.pn * BM + wc * 32) / 2 + 4 * fq;
#pragma unroll
        for (int ai = 0; ai < 2; ++ai)
#pragma unroll
            for (int m = 0; m < 4; ++m) { bf16_t* rowp = O + (size_t)(row0 + ai * HALF + m * 16) * ldc + col0;
#pragma unroll
                for (int bj = 0; bj < 2; ++bj) { const f32x4 g = acc[ai][bj][m][0], up = acc[ai][bj][m][1]; f32x4 h;
#pragma unroll
                    for (int j = 0; j < 4; ++j) h[j] = g[j] * __builtin_amdgcn_rcpf(1.f + __expf(-g[j])) * up[j];
                    u32x2 w; w.x = cvt_pk_bf16_asm(h[0], h[1]); w.y = cvt_pk_bf16_asm(h[2], h[3]);
                    *(u32x2*)(rowp + bj * (HALF / 2)) = w; } }
    }
};

template <class Epi, bool GATHER>
__device__ __forceinline__ void gemm_phase(const int tid, LAS unsigned char* lds, const Gemm g, const StaticOrder& S, const Epi& E) {
    const int wid = __builtin_amdgcn_readfirstlane(tid >> 6), lane = tid & 63, wr = wid >> 2, wc = wid & 3, fr = lane & 15, fq = lane >> 4;
    const int K = g.K, nt = K / BK;
    unsigned voffA[2], voffB[2];
#pragma unroll
    for (int i = 0; i < 2; ++i) { int R, C; stage_rc(tid * 16 + i * 8192, R, C); const int Rb = Epi::PERM ? ((R & ~31) + perm32(R & 31)) : R;
        voffB[i] = (unsigned)(Rb * K + C) * 2u; voffA[i] = GATHER ? (unsigned)(C * 2) : (Epi::PERM ? (unsigned)(R * K + C) * 2u : voffB[i]); }
    const size_t kstep = (size_t)(BK * 2);
    const size_t hstep = (size_t)HALF * K * 2;
    const size_t tstep = 2 * hstep;
    const unsigned ldsw = (unsigned)wid * 1024u;
    const int aoff = lds_byte(wr * 64 + fr, fq * 8), boff = lds_byte(wc * 32 + fr, fq * 8);
#define PG8_SA(b, h) (((b) * 2 + (h)) * HTB)
#define PG8_SB(b, h) ((4 + (b) * 2 + (h)) * HTB)
#define PG8_STAGE(bufoff, gbase, voff) do { const char* gb_ = (const char*)(gbase); asm volatile("" : "+s"(gb_)); _Pragma("unroll") for (int _i = 0; _i < 2; ++_i) \
        __builtin_amdgcn_global_load_lds((const unsigned*)(gb_ + (voff)[_i]), (LAS unsigned*)(lds + (bufoff) + ldsw + _i * 8192), 16, 0, 0); } while (0)
#define PG8_STAGE_A(bufoff, ubase, kt, h, tb) do { if constexpr (GATHER) { \
        if ((tb) < 0) { PG8_STAGE(bufoff, Ab + (size_t)(kt) * kstep, oAc[h]); } else { \
        unsigned m_ = ~0u; asm volatile("" : "+s"(m_)); const int tl_ = wid * 64 + (int)__builtin_amdgcn_mbcnt_hi(m_, __builtin_amdgcn_mbcnt_lo(m_, 0u)); \
        _Pragma("unroll") for (int _i = 0; _i < 2; ++_i) { int _R, _C; stage_rc(tl_ * 16 + _i * 8192, _R, _C); \
            const unsigned _o = *(const LAS unsigned*)(lds + TAB_OFF + (tb) * 1024 + ((h) * HALF + _R) * 4) + (unsigned)(_C * 2); \
            __builtin_amdgcn_global_load_lds((const unsigned*)(Ab + (size_t)(kt) * kstep + _o), (LAS unsigned*)(lds + (bufoff) + ldsw + _i * 8192), 16, 0, 0); } } } \
        else { PG8_STAGE(bufoff, (ubase) + (size_t)(kt) * kstep + (size_t)(h) * hstep, voffA); } } while (0)
#define PG8_LOADOFFS(tb) do { if constexpr (GATHER) { unsigned m_ = ~0u; asm volatile("" : "+s"(m_)); const int tl_ = wid * 64 + (int)__builtin_amdgcn_mbcnt_hi(m_, __builtin_amdgcn_mbcnt_lo(m_, 0u)); \
        _Pragma("unroll") for (int _h = 0; _h < 2; ++_h) _Pragma("unroll") for (int _i = 0; _i < 2; ++_i) { int _R, _C; stage_rc(tl_ * 16 + _i * 8192, _R, _C); \
            oAc[_h][_i] = *(const LAS unsigned*)(lds + TAB_OFF + (tb) * 1024 + (_h * HALF + _R) * 4) + (unsigned)(_C * 2); } } } while (0)
#define PG8_FILLTAB(u, tb) do { if constexpr (GATHER) { unsigned m_ = ~0u; asm volatile("" : "+s"(m_)); const int tl_ = wid * 64 + (int)__builtin_amdgcn_mbcnt_hi(m_, __builtin_amdgcn_mbcnt_lo(m_, 0u)); \
        if (tl_ < 256) *(LAS unsigned*)(lds + TAB_OFF + (tb) * 1024 + tl_ * 4) = min((unsigned)g.gather[(u).pm * BM + tl_], (unsigned)(NTOK - 1)) * (unsigned)(K * 2); } } while (0)
#define PG8_LDA(dst, b, h) do { _Pragma("unroll") for (int m = 0; m < 4; ++m) _Pragma("unroll") for (int k = 0; k < 2; ++k) dst[m][k] = *(const LAS bf16x8*)(lds + PG8_SA(b, h) + aoff + m * 2048 + k * 1024); } while (0)
#define PG8_LDB(dst, b, h) do { _Pragma("unroll") for (int n = 0; n < 2; ++n) _Pragma("unroll") for (int k = 0; k < 2; ++k) dst[n][k] = *(const LAS bf16x8*)(lds + PG8_SB(b, h) + boff + n * 2048 + k * 1024); } while (0)
#define PG8_MMA(ai, bj, At, Bt) do { __builtin_amdgcn_s_setprio(1); _Pragma("unroll") for (int m = 0; m < 4; ++m) _Pragma("unroll") for (int n = 0; n < 2; ++n) _Pragma("unroll") for (int k = 0; k < 2; ++k) \
        acc[ai][bj][m][n] = __builtin_amdgcn_mfma_f32_16x16x32_bf16(Bt[n][k], At[m][k], acc[ai][bj][m][n], 0, 0, 0); __builtin_amdgcn_s_setprio(0); } while (0)
#define PG8_WAIT_V(n) asm volatile("s_waitcnt vmcnt(" #n ")" ::: "memory")
#define PG8_WAIT_L(n) asm volatile("s_waitcnt lgkmcnt(" #n ")" ::: "memory")
#define PG8_BAR __builtin_amdgcn_s_barrier()
#define PG8_SCHED __builtin_amdgcn_sched_barrier(0)
#define PG8_KTILE2(u1, k1, o1, u2, k2, o2, b2p) do { \
        PG8_LDB(B0, 0, 0); PG8_LDB(B1, 0, 1); PG8_SCHED; PG8_LDA(At, 0, 0); PG8_STAGE_A(PG8_SA(1, 1), u1, k1, 1, o1); \
        PG8_WAIT_V(8); PG8_WAIT_L(0); PG8_BAR; PG8_MMA(0, 0, At, B0); PG8_MMA(0, 1, At, B1); PG8_BAR; PG8_SCHED; \
        PG8_LDA(At, 0, 1); PG8_STAGE(PG8_SB(0, 0), b2p, voffB); PG8_STAGE(PG8_SB(0, 1), (b2p) + hstep, voffB); PG8_STAGE_A(PG8_SA(0, 0), u2, k2, 0, o2); \
        PG8_WAIT_V(8); PG8_WAIT_L(0); PG8_BAR; PG8_MMA(1, 0, At, B0); PG8_MMA(1, 1, At, B1); PG8_BAR; PG8_SCHED; \
        PG8_LDB(B0, 1, 0); PG8_LDB(B1, 1, 1); PG8_SCHED; PG8_LDA(At, 1, 0); PG8_STAGE_A(PG8_SA(0, 1), u2, k2, 1, o2); \
        PG8_WAIT_V(8); PG8_WAIT_L(0); PG8_BAR; PG8_MMA(0, 0, At, B0); PG8_MMA(0, 1, At, B1); PG8_BAR; PG8_SCHED; \
        PG8_LDA(At, 1, 1); PG8_STAGE(PG8_SB(1, 0), (b2p) + kstep, voffB); PG8_STAGE(PG8_SB(1, 1), (b2p) + kstep + hstep, voffB); PG8_STAGE_A(PG8_SA(1, 0), u2, (k2) + 1, 0, o2); \
        PG8_WAIT_V(8); PG8_WAIT_L(0); PG8_BAR; PG8_MMA(1, 0, At, B0); PG8_MMA(1, 1, At, B1); PG8_BAR; PG8_SCHED; } while (0)
#define PG8_BPTR(u) ((const char*)g.Bt + (g.gt ? (size_t)(((u).pm / g.gt) % g.ng) * g.gstride : (size_t)0) + (size_t)(u).pn * tstep)
    Unit cur, nxt; int ui = 0;
    if (!S.next(0, cur)) return;
#ifndef LATE_START
#define LATE_START 4
#endif
#ifndef GEMM_STAGGER
#define GEMM_STAGGER 0
#endif
    if (GEMM_STAGGER) { const int dg_ = ((int)blockIdx.x >> 3) & 3; for (int i_ = 0; i_ < dg_; ++i_) __builtin_amdgcn_s_sleep(GEMM_STAGGER); }
    if (S.nwg % S.G != 0 && S.c >= S.nwg % S.G) { for (int i_ = 0; i_ < LATE_START; ++i_) __builtin_amdgcn_s_sleep(127); }
    f32x4 acc[2][2][4][2];
#pragma unroll
    for (int a = 0; a < 2; ++a)
#pragma unroll
        for (int b = 0; b < 2; ++b)
#pragma unroll
            for (int m = 0; m < 4; ++m)
#pragma unroll
                for (int n = 0; n < 2; ++n) acc[a][b][m][n] = (f32x4){0.f, 0.f, 0.f, 0.f};
    bf16x8 At[4][2], B0[2][2], B1[2][2];
    unsigned oAc[2][2] = {{0u, 0u}, {0u, 0u}};
    const char* const Ab = (const char*)g.A;
    const char* cA = Ab + (size_t)cur.pm * tstep;
    const char* cB = PG8_BPTR(cur);
    PG8_FILLTAB(cur, 0);
    if constexpr (GATHER) { PG8_WAIT_L(0); PG8_BAR; PG8_LOADOFFS(0); }
    PG8_STAGE(PG8_SB(0, 0), cB, voffB); PG8_STAGE(PG8_SB(0, 1), cB + hstep, voffB); PG8_STAGE_A(PG8_SA(0, 0), cA, 0, 0, -1); PG8_STAGE_A(PG8_SA(0, 1), cA, 0, 1, -1);
    if (wr == 1) PG8_BAR;
    PG8_WAIT_V(2); PG8_BAR;
    PG8_STAGE(PG8_SB(1, 0), cB + kstep, voffB); PG8_STAGE_A(PG8_SA(1, 0), cA, 1, 0, -1); PG8_STAGE(PG8_SB(1, 1), cB + hstep + kstep, voffB);
    PG8_WAIT_V(6); PG8_BAR;
    for (;;) {
        const bool has_next = S.next(ui + 1, nxt);
        const char* nA = has_next ? Ab + (size_t)nxt.pm * tstep : cA; const char* nB = has_next ? PG8_BPTR(nxt) : cB;
        const int tbc = ui & 1, tbn = has_next ? ((ui + 1) & 1) : (ui & 1);
        if (has_next) PG8_FILLTAB(nxt, tbn);
        for (int t = 0; t < nt - 2; t += 2) { const char* b2 = cB + (size_t)(t + 2) * kstep; PG8_KTILE2(cA, t + 1, -1, cA, t + 2, -1, b2); }
        PG8_KTILE2(cA, nt - 1, -1, nA, 0, tbn, nB);
        if (wr == 0) PG8_BAR;
        { unsigned m_ = ~0u; asm volatile("" : "+s"(m_)); int l2 = (int)__builtin_amdgcn_mbcnt_hi(m_, __builtin_amdgcn_mbcnt_lo(m_, 0u)); asm volatile("" : "+v"(l2)); E(acc, cur, wr, wc, l2 & 15, l2 >> 4); }
        if (!has_next) break;
#pragma unroll
        for (int a = 0; a < 2; ++a)
#pragma unroll
            for (int b = 0; b < 2; ++b)
#pragma unroll
                for (int m = 0; m < 4; ++m)
#pragma unroll
                    for (int n = 0; n < 2; ++n) acc[a][b][m][n] = (f32x4){0.f, 0.f, 0.f, 0.f};
        cur = nxt; cA = nA; cB = nB; ++ui;
        PG8_LOADOFFS(ui & 1);
        if (wr == 1) PG8_BAR;
    }
    PG8_WAIT_V(0);
    PG8_BAR;
#undef PG8_STAGE_A
#undef PG8_FILLTAB
#undef PG8_LOADOFFS
#undef PG8_SA
#undef PG8_SB
#undef PG8_STAGE
#undef PG8_LDA
#undef PG8_LDB
#undef PG8_MMA
#undef PG8_WAIT_V
#undef PG8_WAIT_L
#undef PG8_BAR
#undef PG8_SCHED
#undef PG8_KTILE2
#undef PG8_BPTR
}
}

#define XB_TMO      128
#define XB_XCNT(j)  (256  + 64 * (j))
#define XB_XSUB(j)  (1280 + 64 * (j))
#define XB_XGEN(j)  (2304 + 64 * (j))
#define XB_TOP      3328
#define XB_TOPGEN   3392
#define XCD_BAR_WORDS 3456
#define XB_SPIN_CAP (1u << 20)
__device__ __forceinline__ unsigned xb_ld(unsigned* p)              { return __hip_atomic_load(p, __ATOMIC_RELAXED, __HIP_MEMORY_SCOPE_AGENT); }
__device__ __forceinline__ unsigned xb_add(unsigned* p, unsigned v) { return __hip_atomic_fetch_add(p, v, __ATOMIC_RELAXED, __HIP_MEMORY_SCOPE_AGENT); }
__device__ __forceinline__ unsigned xb_xcc_id() { return (unsigned)__builtin_amdgcn_s_getreg((3 << 11) | 20) & 0xFu; }
#define XB_SPIN(cond, bar) do { unsigned _sp = 0; while (cond) { __builtin_amdgcn_s_sleep(1); \
    if ((++_sp & 255u) == 0u) { if (xb_ld(&(bar)[XB_TMO])) break; if (_sp > XB_SPIN_CAP) { atomicAdd(&(bar)[XB_TMO], 1u); break; } } } } while (0)
struct XcdBarrier { unsigned* bar; unsigned x; };
#define XB_ST(ldsbase) ((volatile LAS unsigned*)((LAS unsigned char*)(ldsbase) + MISC_OFF + 32))
__device__ __forceinline__ XcdBarrier xcd_barrier_post(unsigned* bar, bool leader) {
    XcdBarrier b; b.bar = bar; b.x = xb_xcc_id();
    if (leader) (void)xb_add(&bar[XB_XCNT(b.x)], 1u);
    return b;
}
__device__ __forceinline__ void xcd_barrier_complete(unsigned* bar, unsigned x, unsigned& nloc, unsigned& nx) {
    const unsigned G = gridDim.x * gridDim.y * gridDim.z;
    unsigned sum, cnt, mine, sp = 0u;
    for (;;) {
        sum = 0u; cnt = 0u; mine = 0u;
#pragma unroll
        for (unsigned j = 0; j < 16; ++j) { const unsigned c = xb_ld(&bar[XB_XCNT(j)]); sum += c; cnt += (c > 0u) ? 1u : 0u; mine = (j == x) ? c : mine; }
        if (sum == G) break;
        __builtin_amdgcn_s_sleep(1);
        if ((++sp & 255u) == 0u) { if (xb_ld(&bar[XB_TMO])) break; if (sp > XB_SPIN_CAP) { atomicAdd(&bar[XB_TMO], 1u); break; } }
    }
    nloc = mine > 0u ? mine : 1u; nx = cnt > 0u ? cnt : 1u;
}
__device__ __forceinline__ void xcd_barrier(const XcdBarrier& b, bool leader, volatile LAS unsigned* st) {
    asm volatile("s_waitcnt vmcnt(0)" ::: "memory");
    __syncthreads();
    if (leader) {
        unsigned* bar = b.bar;
        __builtin_amdgcn_s_waitcnt(0);
        unsigned nloc = st[0], nx = st[1];
        if (nloc == 0u) { xcd_barrier_complete(bar, b.x, nloc, nx); st[0] = nloc; st[1] = nx; }
        const unsigned old = xb_add(&bar[XB_XSUB(b.x)], 1u);
        const unsigned gen = old / nloc;
        if (old + 1u == (gen + 1u) * nloc) {
            __builtin_amdgcn_fence(__ATOMIC_RELEASE, "agent");
            asm volatile("s_waitcnt vmcnt(0)" ::: "memory");
            const unsigned og = xb_add(&bar[XB_TOP], 1u);
            const unsigned tg = og / nx;
            if (og + 1u == (tg + 1u) * nx) xb_add(&bar[XB_TOPGEN], 1u);
            else XB_SPIN(xb_ld(&bar[XB_TOPGEN]) == tg, bar);
            __builtin_amdgcn_fence(__ATOMIC_ACQUIRE, "agent");
            xb_add(&bar[XB_XGEN(b.x)], 1u);
            asm volatile("s_waitcnt vmcnt(0)" ::: "memory");
        } else {
            XB_SPIN(xb_ld(&bar[XB_XGEN(b.x)]) == gen, bar);
            __builtin_amdgcn_fence(__ATOMIC_ACQUIRE, "agent");
            asm volatile("s_waitcnt vmcnt(0)" ::: "memory");
        }
    }
    __syncthreads();
}

template <void (*F)(long, PRef, int)> __device__ __forceinline__ void run_items(const int tid, PRef p, int l, long n, long off) {
    for (long gid = (long)blockIdx.x * NTHR + tid; gid < n; gid += (long)gridDim.x * NTHR) F(gid + off, p, l);
}
BODY void b_hgrn_seq2(long gid, PRef p, int l) { const long n1 = (long)NB * HGH * 64; if (gid < n1) b_hgrn_seq<0>(gid, p, l); else b_hgrn_seq<1>(gid - n1, p, l); }

template <int MAP> __device__ __forceinline__ void transpose_item(const float* W, int K, int N, bf16_t* WT, int row_off, LAS float* scr, int item, int lane) {
    const int nblk = N / 32, kb = item / nblk, nb = item % nblk, k0 = 64 * kb, n0 = 32 * nb;
#pragma unroll 8
    for (int i = 0; i < 32; ++i) { const int kk = 2 * i + (lane >> 5); scr[kk * 33 + (lane & 31)] = W[(size_t)(k0 + kk) * N + n0 + (lane & 31)]; }
    asm volatile("s_waitcnt lgkmcnt(0)" ::: "memory");
    const int c = lane & 7;
#pragma unroll
    for (int j = 0; j < 4; ++j) { const int n = (lane >> 3) + 8 * j; const LAS float* s = scr + (8 * c) * 33 + n;
        u32x4 o; o.x = cvt_pk_bf16(s[0 * 33], s[1 * 33]); o.y = cvt_pk_bf16(s[2 * 33], s[3 * 33]); o.z = cvt_pk_bf16(s[4 * 33], s[5 * 33]); o.w = cvt_pk_bf16(s[6 * 33], s[7 * 33]);
        const int nn = n0 + n; const int drow = MAP == 0 ? row_off + nn : (32 * (nn >> 4) + (nn & 15) + (MAP == 2 ? 16 : 0));
        *(u32x4*)(WT + (size_t)drow * K + k0 + 8 * c) = o; }
    asm volatile("s_waitcnt lgkmcnt(0)" ::: "memory");
}
#define WBOFF(l) ((size_t)((l) & 1) * (WB_BYTES / 2))
__device__ __forceinline__ void phase_convert(const int tid, PRef p, int l, LAS unsigned char* lds, int part = 0, int blk_lo = 0) {
    if ((int)blockIdx.x < blk_lo) return;
    const int lane = tid & 63, wave = tid >> 6;
    LAS float* scr = (LAS float*)(lds + wave * 16384);
    const int gw = ((int)blockIdx.x - blk_lo) * NWAVES + wave, NGW = ((int)gridDim.x - blk_lo) * NWAVES;
    constexpr int I_IN = (D / 64) * (INC / 32), I_OUT = (MIXD / 64) * (D / 32), I_G = (D / 64) * (ED / 32), I_D = (ED / 64) * (D / 32);
    constexpr int NITEMS = I_IN + I_OUT + NE * (2 * I_G + I_D);
    const int it_lo = part == 2 ? I_IN + I_OUT : 0, it_hi = part == 1 ? I_IN + I_OUT : NITEMS;
    for (int it = it_lo + gw; it < it_hi; it += NGW) {
        int r = it;
        if (r < I_IN) { transpose_item<0>(p.w_in + (size_t)l * D * INC, D, INC, p.WIN_T + WBOFF(l), 0, scr, r, lane); continue; } r -= I_IN;
        if (r < I_OUT) { transpose_item<0>(p.w_out + (size_t)l * MIXD * D, MIXD, D, p.WOUT_T + WBOFF(l), 0, scr, r, lane); continue; } r -= I_OUT;
        const int e = r / (2 * I_G + I_D); r -= e * (2 * I_G + I_D);
        if (r < I_G) { transpose_item<1>(p.w_gate + ((size_t)l * NE + e) * D * ED, D, ED, p.WGU_T + WBOFF(l) + (size_t)e * 2 * ED * D, 0, scr, r, lane); continue; } r -= I_G;
        if (r < I_G) { transpose_item<2>(p.w_up + ((size_t)l * NE + e) * D * ED, D, ED, p.WGU_T + WBOFF(l) + (size_t)e * 2 * ED * D, 0, scr, r, lane); continue; } r -= I_G;
        transpose_item<0>(p.w_down + ((size_t)l * NE + e) * ED * D, ED, D, p.WD_T + WBOFF(l) + (size_t)e * D * ED, 0, scr, r, lane);
    }
}
template <int WHICH> __device__ __forceinline__ void phase_prenorm(const int tid, PRef p, int l) {
    static_assert(D == 1024, "wave-per-row kernels assume D = 1024");
    const int lane = tid & 63, wave = tid >> 6;
    const int gw = blockIdx.x * NWAVES + wave, NGW = gridDim.x * NWAVES;
    const float* nw = (WHICH ? p.norm2_w : p.norm1_w) + l * D;
    for (int r = gw; r < NTOK; r += NGW) {
        const float* xr = xrow(p, r);
        const float* mod = p.MOD + ((size_t)l * 3 + modset(r)) * NMOD;
        const float* shift = mod + (WHICH ? 3 : 0) * D; const float* scale = mod + (WHICH ? 4 : 1) * D;
        f32x4 v[4]; float ss = 0.f;
#pragma unroll
        for (int j = 0; j < 4; ++j) { v[j] = *(const f32x4*)(xr + 4 * lane + 256 * j); ss += (v[j][0] * v[j][0] + v[j][1] * v[j][1]) + (v[j][2] * v[j][2] + v[j][3] * v[j][3]); }
        const float rstd = 1.f / sqrtf(wave_sum(ss, lane) * (1.f / D) + EPS);
        float lg[NE];
#pragma unroll
        for (int e = 0; e < NE; ++e) lg[e] = 0.f;
#pragma unroll
        for (int j = 0; j < 4; ++j) {
            const int c = 4 * lane + 256 * j;
            const f32x4 w4 = *(const f32x4*)(nw + c), sc4 = *(const f32x4*)(scale + c), sh4 = *(const f32x4*)(shift + c);
            f32x4 h;
#pragma unroll
            for (int i = 0; i < 4; ++i) h[i] = v[j][i] * rstd * w4[i] * (1.f + sc4[i]) + sh4[i];
            u32x2 o; o.x = cvt_pk_bf16(h[0], h[1]); o.y = cvt_pk_bf16(h[2], h[3]);
            *(u32x2*)(p.H + (size_t)r * D + c) = o;
            if (WHICH) {
#pragma unroll
                for (int i = 0; i < 4; ++i) { const f32x4* wr = (const f32x4*)(p.w_router + ((size_t)l * D + c + i) * NE);
#pragma unroll
                    for (int q = 0; q < 4; ++q) { const f32x4 w = wr[q]; lg[4 * q + 0] += h[i] * w[0]; lg[4 * q + 1] += h[i] * w[1]; lg[4 * q + 2] += h[i] * w[2]; lg[4 * q + 3] += h[i] * w[3]; } }
            }
        }
        if (WHICH) {
#pragma unroll
            for (int e = 0; e < NE; ++e) lg[e] = wave_sum(lg[e], lane);
            float m = lg[0];
#pragma unroll
            for (int e = 1; e < NE; ++e) m = fmaxf(m, lg[e]);
            float s = 0.f, mine = 0.f;
#pragma unroll
            for (int e = 0; e < NE; ++e) { const float ex = expf(lg[e] - m); s += ex; mine = (lane == e) ? ex : mine; }
            if (lane < NE) p.AFF[(size_t)r * NE + lane] = mine / s;
        }
    }
}
__device__ __forceinline__ void phase_combine(const int tid, PRef p, int l) {
    const int lane = tid & 63, wave = tid >> 6;
    const int gw = blockIdx.x * NWAVES + wave, NGW = gridDim.x * NWAVES;
    for (int r = gw; r < NTOK; r += NGW) {
        float* xr = xrow(p, r);
        const float* g = p.MOD + ((size_t)l * 3 + modset(r)) * NMOD + 5 * D;
        f32x4 acc[4];
#pragma unroll
        for (int j = 0; j < 4; ++j) acc[j] = (f32x4){0.f, 0.f, 0.f, 0.f};
        const int myinv = lane < NE ? p.INV[(size_t)r * NE + lane] : -1;
#pragma unroll
        for (int e = 0; e < NE; ++e) {
            const int s = __builtin_amdgcn_readlane(myinv, e);
            if (s >= 0 && s < NSLOT) {
                const bf16_t* y = p.Y + (size_t)s * D;
#pragma unroll
                for (int j = 0; j < 4; ++j) { const u32x2 w = *(const u32x2*)(y + 4 * lane + 256 * j);
                    acc[j][0] += __builtin_bit_cast(float, w.x << 16); acc[j][1] += __builtin_bit_cast(float, w.x & 0xffff0000u);
                    acc[j][2] += __builtin_bit_cast(float, w.y << 16); acc[j][3] += __builtin_bit_cast(float, w.y & 0xffff0000u); }
            }
        }
#pragma unroll
        for (int j = 0; j < 4; ++j) { const int c = 4 * lane + 256 * j; f32x4* q = (f32x4*)(xr + c); *q = *q + *(const f32x4*)(g + c) * acc[j]; }
    }
}


__device__ __forceinline__ unsigned wave_excl_scan(unsigned x, int lane) {
    unsigned inc = x;
#pragma unroll
    for (int d = 1; d < 64; d <<= 1) { const unsigned y = (unsigned)__builtin_amdgcn_ds_bpermute(((lane - d) & 63) << 2, (int)inc); if (lane >= d) inc += y; }
    return inc - x;
}
__device__ __forceinline__ void phase_topk(const int tid, PRef p, LAS unsigned char* lds) {
    LAS unsigned* keys = (LAS unsigned*)lds;
    LAS unsigned* hist = (LAS unsigned*)(lds + 70000);
    LAS unsigned* cgt = (LAS unsigned*)(lds + 76000);
    LAS unsigned* ceq = (LAS unsigned*)(lds + 80000);
    LAS unsigned* sh = (LAS unsigned*)(lds + 84000);
    static_assert(SEQ % 512 == 0 && SEQ + SEQ / 32 <= 17400, "topk LDS layout");
    constexpr int PER = SEQ / 512;
    for (int pr = blockIdx.x; pr < 2 * NB * NE; pr += gridDim.x) {
        const int e = pr % NE, b = (pr / NE) % NB, isctx = pr / (NE * NB);
        if (!isctx) {
            const int row0 = b * SEQ, base = (b * NE + e) * CAPL;
            for (int i = 0; i < PER; ++i) { const int t = i * 512 + tid; keys[t + (t >> 5)] = __builtin_bit_cast(unsigned, p.AFF[(size_t)(row0 + t) * NE + e]); }
            if (tid == 0) { sh[0] = 0u; sh[1] = (unsigned)CAPL; }
            __syncthreads();
            for (int pass = 0; pass < 3; ++pass) {
                const int shift = 20 - 10 * pass;
                for (int i = tid; i < 1024; i += 512) hist[i] = 0u;
                __syncthreads();
                const unsigned prefix = sh[0]; const unsigned himask = pass == 0 ? 0u : (0xFFFFFFFFu << (shift + 10));
                for (int i = 0; i < PER; ++i) { const int t = tid * PER + i; const unsigned k = keys[t + (t >> 5)]; if ((k & himask) == prefix) atomicAdd((unsigned*)&hist[(k >> shift) & 1023u], 1u); }
                __syncthreads();
                if (tid < 64) {
                    const unsigned need = sh[1];
                    unsigned c[16]; unsigned tot = 0u;
#pragma unroll
                    for (int q = 0; q < 16; ++q) { c[q] = hist[1023 - 16 * tid - q]; tot += c[q]; }
                    unsigned above = wave_excl_scan(tot, tid);
                    int fbin = -1; unsigned fabove = 0u;
#pragma unroll
                    for (int q = 0; q < 16; ++q) { if (fbin < 0 && above < need && above + c[q] >= need) { fbin = 1023 - 16 * tid - q; fabove = above; } above += c[q]; }
                    if (fbin >= 0) { sh[0] = prefix | ((unsigned)fbin << shift); sh[1] = need - fabove; }
                }
                __syncthreads();
            }
            const unsigned thr = sh[0], keq = sh[1];
            unsigned ng = 0u, nq = 0u;
            for (int i = 0; i < PER; ++i) { const int t = tid * PER + i; const unsigned k = keys[t + (t >> 5)]; ng += k > thr ? 1u : 0u; nq += k == thr ? 1u : 0u; }
            cgt[tid] = ng; ceq[tid] = nq;
            __syncthreads();
            if (tid < 64) {
                unsigned g[8], q[8], sg = 0u, sq = 0u;
#pragma unroll
                for (int i = 0; i < 8; ++i) { g[i] = cgt[8 * tid + i]; q[i] = ceq[8 * tid + i]; sg += g[i]; sq += q[i]; }
                unsigned ag = wave_excl_scan(sg, tid), aq = wave_excl_scan(sq, tid);
#pragma unroll
                for (int i = 0; i < 8; ++i) { cgt[8 * tid + i] = ag; ceq[8 * tid + i] = aq; ag += g[i]; aq += q[i]; }
            }
            __syncthreads();
            unsigned rg = cgt[tid], rq = ceq[tid];
            for (int i = 0; i < PER; ++i) {
                const int t = tid * PER + i; const unsigned k = keys[t + (t >> 5)];
                int slot = -1;
                if (k > thr) { slot = (int)(rg + (rq < keq ? rq : keq)); ++rg; }
                else if (k == thr) { if (rq < keq) slot = (int)(rg + rq); ++rq; }
                const int row = row0 + t;
                if (slot >= 0) { p.STOK[base + slot] = row; p.SVAL[base + slot] = __builtin_bit_cast(float, k); p.INV[(size_t)row * NE + e] = base + slot; }
                else p.INV[(size_t)row * NE + e] = -1;
            }
            __syncthreads();
        } else {
            const int row0 = NLAT + b * CTX, base = NSLOT_L + (b * NE + e) * CAPC;
            LAS float* vals = (LAS float*)lds;
            for (int t = tid; t < CTX; t += 512) vals[t] = p.AFF[(size_t)(row0 + t) * NE + e];
            __syncthreads();
            for (int t = tid; t < CTX; t += 512) {
                const float a = vals[t]; int rank = 0;
                for (int tt = 0; tt < CTX; ++tt) { const float o = vals[tt]; rank += (o > a || (o == a && tt < t)) ? 1 : 0; }
                const int row = row0 + t;
                if (rank < CAPC) { p.STOK[base + rank] = row; p.SVAL[base + rank] = a; p.INV[(size_t)row * NE + e] = base + rank; }
                else p.INV[(size_t)row * NE + e] = -1;
            }
            __syncthreads();
        }
    }
}

#define LDS_BAR() do { asm volatile("s_waitcnt lgkmcnt(0)" ::: "memory"); __builtin_amdgcn_s_barrier(); asm volatile("" ::: "memory"); } while (0)
__device__ __forceinline__ int hg_row0(int b, int pc) { return pc < NCHC ? NLAT + b * CTX + pc * 64 : b * SEQ + (pc - NCHC) * 64; }
constexpr int HG_FF = 0, HG_FB = 16640, HG_AF = 33280, HG_AB = 49920, HG_T0 = 66560, HG_TS = 9216, HG_VT = HG_T0 + 6 * HG_TS;
static_assert(HG_VT + HG_TS <= RING_BYTES, "hgrn LDS layout");
#define TSW_E(k, t) ((k) * 72 + ((((t) >> 3) ^ (((k) >> 3) & 7)) << 3) + ((t) & 7))
#define TSW_B(k, c) ((k) * 144 + (((c) ^ (((k) >> 3) & 7)) << 4))
constexpr int HG_LBOFF = LDSCTL_OFF + 4096;
__device__ __forceinline__ void hg_stage_lb(const int tid, PRef p, int l) {
    LAS float* dst = (LAS float*)((LAS unsigned char*)lds_raw + HG_LBOFF);
    for (int i = tid; i < 768; i += NTHR) dst[i] = p.LB[(size_t)((i / 384) * DEPTH + l) * 384 + (i % 384)];
    LDS_BAR();
}
__device__ __forceinline__ void hg_gates(const int tid, PRef p, int l, int h, const u32x4 zf, const u32x4 zb, LAS unsigned char* lds) {
    LAS float* FF = (LAS float*)(lds + HG_FF); LAS float* FB = (LAS float*)(lds + HG_FB); LAS float* AF = (LAS float*)(lds + HG_AF); LAS float* AB = (LAS float*)(lds + HG_AB);
    const int t = tid >> 3, cg = tid & 7;
    const LAS float* lbf = (const LAS float*)((LAS unsigned char*)lds_raw + HG_LBOFF) + h * 64 + cg * 8; const LAS float* lbb = lbf + 384;
#pragma unroll
    for (int j = 0; j < 8; ++j) {
        const float z0 = fminf(fmaxf(bf8(zf, j), -60.f), 60.f), z1 = fminf(fmaxf(bf8(zb, j), -60.f), 60.f);
        const float l0 = lbf[j], l1 = lbb[j];
        FF[t * 65 + cg * 8 + j] = l0 + (1.f - l0) * __builtin_amdgcn_rcpf(1.f + __expf(-z0));
        FB[t * 65 + cg * 8 + j] = l1 + (1.f - l1) * __builtin_amdgcn_rcpf(1.f + __expf(-z1));
    }
    LDS_BAR();
    {
        const int wave = tid >> 6, lane = tid & 63, cl = lane & 15, seg = lane >> 4, dir = wave >> 2, col = 16 * (wave & 3) + cl;
        const LAS float* F = dir ? FB : FF; LAS float* A = dir ? AB : AF;
        float pre[16]; float run = 0.f;
#pragma unroll
        for (int i = 0; i < 16; ++i) { const int tt = dir ? 16 * seg + 15 - i : 16 * seg + i; run += __logf(F[tt * 65 + col]); pre[i] = run; }
        const float T0 = __builtin_bit_cast(float, __builtin_amdgcn_ds_bpermute((cl + 0) << 2, __builtin_bit_cast(int, run)));
        const float T1 = __builtin_bit_cast(float, __builtin_amdgcn_ds_bpermute((cl + 16) << 2, __builtin_bit_cast(int, run)));
        const float T2 = __builtin_bit_cast(float, __builtin_amdgcn_ds_bpermute((cl + 32) << 2, __builtin_bit_cast(int, run)));
        const float T3 = __builtin_bit_cast(float, __builtin_amdgcn_ds_bpermute((cl + 48) << 2, __builtin_bit_cast(int, run)));
        const float off = dir ? ((seg < 1 ? T1 : 0.f) + (seg < 2 ? T2 : 0.f) + (seg < 3 ? T3 : 0.f)) : ((seg > 0 ? T0 : 0.f) + (seg > 1 ? T1 : 0.f) + (seg > 2 ? T2 : 0.f));
#pragma unroll
        for (int i = 0; i < 16; ++i) { const int tt = dir ? 16 * seg + 15 - i : 16 * seg + i; A[tt * 65 + col] = off + pre[i]; }
    }
    LDS_BAR();
}
__device__ __forceinline__ bf16x8 ld2x64(const LAS unsigned char* p0, const LAS unsigned char* p1) {
    const u32x2 a = *(const LAS u32x2*)p0, b = *(const LAS u32x2*)p1; u32x4 r; r.x = a.x; r.y = a.y; r.z = b.x; r.w = b.y; return __builtin_bit_cast(bf16x8, r);
}
__device__ __forceinline__ f32x4 mfma16(bf16x8 a, bf16x8 b, f32x4 c) { return __builtin_amdgcn_mfma_f32_16x16x32_bf16(a, b, c, 0, 0, 0); }
__device__ __forceinline__ void phase_hgrn_local(const int tid, PRef p, int l, LAS unsigned char* lds) {
    LAS float* FF = (LAS float*)(lds + HG_FF); LAS float* FB = (LAS float*)(lds + HG_FB); LAS float* AF = (LAS float*)(lds + HG_AF); LAS float* AB = (LAS float*)(lds + HG_AB);
    LAS bf16_t* KTf = (LAS bf16_t*)(lds + HG_T0); LAS bf16_t* KTb = (LAS bf16_t*)(lds + HG_T0 + HG_TS); LAS bf16_t* VT = (LAS bf16_t*)(lds + HG_VT);
    const int t = tid >> 3, cg = tid & 7, wave = tid >> 6, lane = tid & 63, fr = lane & 15, fq = lane >> 4;
    u32x4 zf = (u32x4){0u, 0u, 0u, 0u}, zb = zf, v8 = zf, nzf = zf, nzb = zf, nv8 = zf;
    if ((int)blockIdx.x < NBH * NCH) { const int it = blockIdx.x, pc = it % NCH, bh = it / NCH, h = bh % HGH, b = bh / HGH;
        const bf16_t* pr = p.P + (size_t)(hg_row0(b, pc) + t) * INC + h * 64 + cg * 8; zf = *(const u32x4*)(pr + OFF_); zb = *(const u32x4*)(pr + OFB); v8 = *(const u32x4*)(pr + OHI); }
    hg_stage_lb(tid, p, l);
    for (int it = blockIdx.x; it < NBH * NCH; it += gridDim.x) {
        const int pc = it % NCH, bh = it / NCH, h = bh % HGH, b = bh / HGH, row0 = hg_row0(b, pc);
        { const int it2 = min(it + (int)gridDim.x, NBH * NCH - 1); const int pc2 = it2 % NCH, bh2 = it2 / NCH, h2 = bh2 % HGH, b2 = bh2 / HGH;
            const bf16_t* pr = p.P + (size_t)(hg_row0(b2, pc2) + t) * INC + h2 * 64 + cg * 8; nzf = *(const u32x4*)(pr + OFF_); nzb = *(const u32x4*)(pr + OFB); nv8 = *(const u32x4*)(pr + OHI); }
        hg_gates(tid, p, l, h, zf, zb, lds);
#pragma unroll
        for (int j = 0; j < 8; ++j) {
            const int k = cg * 8 + j;
            VT[TSW_E(k, t)] = (bf16_t)(j & 1 ? v8[j >> 1] >> 16 : v8[j >> 1] & 0xffffu);
            KTf[TSW_E(k, t)] = f2bf((1.f - FF[t * 65 + k]) * __expf(AF[63 * 65 + k] - AF[t * 65 + k]));
            KTb[TSW_E(k, t)] = f2bf((1.f - FB[t * 65 + k]) * __expf(AB[k] - AB[t * 65 + k]));
        }
        if (tid < 64) p.GDEC[((size_t)(0 * NBH + bh) * NCH + pc) * 64 + tid] = __expf(AF[63 * 65 + tid]);
        else if (tid < 128) p.GDEC[((size_t)(1 * NBH + bh) * NCH + pc) * 64 + (tid - 64)] = __expf(AB[tid - 64]);
        LDS_BAR();
#if HGRN_DIAG == 4
        {
            const int v = tid >> 3, kg = tid & 7;
            for (int dir = 0; dir < 2; ++dir) {
                const LAS bf16_t* KT = (const LAS bf16_t*)(lds + HG_T0 + dir * HG_TS);
                float acc[8];
#pragma unroll
                for (int j = 0; j < 8; ++j) acc[j] = 0.f;
                for (int s_ = 0; s_ < 64; ++s_) { const float vv = bf2f(VT[v * 72 + s_]);
#pragma unroll
                    for (int j = 0; j < 8; ++j) acc[j] += bf2f(KT[(kg * 8 + j) * 72 + s_]) * vv; }
                bf16_t* dst = p.SLOC + ((size_t)(dir * NBH + bh) * NCH + pc) * 4096 + v * 64 + kg * 8;
#pragma unroll
                for (int j = 0; j < 8; ++j) dst[j] = f2bf(acc[j]);
            }
        }
#else
        {
            const int dir = wave >> 2, mt = wave & 3;
            const LAS unsigned char* KT = lds + HG_T0 + dir * HG_TS;
            bf16x8 a[2];
#pragma unroll
            for (int ks = 0; ks < 2; ++ks) a[ks] = *(const LAS bf16x8*)(KT + TSW_B(mt * 16 + fr, ks * 4 + fq));
            bf16_t* dst = p.SLOC + ((size_t)(dir * NBH + bh) * NCH + pc) * 4096;
            u32x2 w[4];
#pragma unroll
            for (int nt = 0; nt < 4; ++nt) {
                f32x4 acc = (f32x4){0.f, 0.f, 0.f, 0.f};
#pragma unroll
                for (int ks = 0; ks < 2; ++ks) { const bf16x8 bb = *(const LAS bf16x8*)(lds + HG_VT + TSW_B(nt * 16 + fr, ks * 4 + fq)); acc = mfma16(a[ks], bb, acc); }
                w[nt].x = cvt_pk_bf16(acc[0], acc[1]); w[nt].y = cvt_pk_bf16(acc[2], acc[3]);
            }
            zf = nzf; zb = nzb; v8 = nv8;
            asm volatile("" ::: "memory");
#pragma unroll
            for (int nt = 0; nt < 4; ++nt) *(u32x2*)(dst + (nt * 16 + fr) * 64 + mt * 16 + 4 * fq) = w[nt];
        }
#endif
        LDS_BAR();
    }
}
__device__ __forceinline__ void phase_hgrn_scan(const int tid, PRef p) {
    static_assert(NCH % 20 == 0, "scan group size");
    constexpr int GS = 20;
    for (int blk = (int)gridDim.x - 1 - (int)blockIdx.x; blk < 2 * NBH * 4; blk += gridDim.x) {
        const int sq = blk >> 2, part = blk & 3, dir = sq / NBH, e0 = part * 1024 + tid * 2, k = e0 & 63;
        unsigned* S = (unsigned*)(p.SLOC + (size_t)sq * NCH * 4096 + e0);
        const float* G = p.GDEC + (size_t)sq * NCH * 64 + k;
        float c0 = 0.f, c1 = 0.f;
        unsigned nx[GS]; f32x2 gn[GS];
#define HG_PC(j) (dir ? ((j) < NCHC ? NCHC - 1 - (j) : NCH + NCHC - 1 - (j)) : (j))
#pragma unroll
        for (int u = 0; u < GS; ++u) { const int pc = HG_PC(u); nx[u] = S[(size_t)pc * 2048]; gn[u] = *(const f32x2*)(G + (size_t)pc * 64); }
        for (int j0 = 0; j0 < NCH; j0 += GS) {
            unsigned cu[GS]; f32x2 gc[GS];
#pragma unroll
            for (int u = 0; u < GS; ++u) { cu[u] = nx[u]; gc[u] = gn[u]; }
            if (j0 + GS < NCH) {
#pragma unroll
                for (int u = 0; u < GS; ++u) { const int pc = HG_PC(j0 + GS + u); nx[u] = S[(size_t)pc * 2048]; gn[u] = *(const f32x2*)(G + (size_t)pc * 64); }
            }
#pragma unroll
            for (int u = 0; u < GS; ++u) {
                const int pc = HG_PC(j0 + u);
                S[(size_t)pc * 2048] = cvt_pk_bf16(c0, c1);
                c0 = gc[u][0] * c0 + bfw(cu[u], 0); c1 = gc[u][1] * c1 + bfw(cu[u], 1);
            }
        }
#undef HG_PC
    }
}
__device__ __forceinline__ void phase_hgrn_out(const int tid, PRef p, int l, LAS unsigned char* lds) {
    const int NCHO = (l + 1 < DEPTH) ? NCH : NCH - NCHC, PC0 = NCH - NCHO;
    LAS float* FF = (LAS float*)(lds + HG_FF); LAS float* FB = (LAS float*)(lds + HG_FB); LAS float* AF = (LAS float*)(lds + HG_AF); LAS float* AB = (LAS float*)(lds + HG_AB);
    LAS bf16_t* VT = (LAS bf16_t*)(lds + HG_VT);
    LAS float* OO = (LAS float*)(lds + HG_AF);
    const int t = tid >> 3, cg = tid & 7, wave = tid >> 6, lane = tid & 63, fr = lane & 15, fq = lane >> 4;
    u32x4 zf = (u32x4){0u, 0u, 0u, 0u}, zb = zf, v8 = zf, q8 = zf, g8 = zf, nzf = zf, nzb = zf, nv8 = zf, nq8 = zf, ng8 = zf;
    bf16x8 bsin[4][2], nbsin[4][2];
#define HG_LOADSIN(dst, bhx, pcx) do { const bf16_t* SIN_ = p.SLOC + ((size_t)((wave >> 2) * NBH + (bhx)) * NCH + (pcx)) * 4096; \
        _Pragma("unroll") for (int vt = 0; vt < 4; ++vt) _Pragma("unroll") for (int ks = 0; ks < 2; ++ks) dst[vt][ks] = *(const bf16x8*)(SIN_ + (vt * 16 + fr) * 64 + ks * 32 + fq * 8); } while (0)
#pragma unroll
    for (int vt = 0; vt < 4; ++vt) { bsin[vt][0] = (bf16x8){0, 0, 0, 0, 0, 0, 0, 0}; bsin[vt][1] = bsin[vt][0]; nbsin[vt][0] = bsin[vt][0]; nbsin[vt][1] = bsin[vt][0]; }
    if ((int)blockIdx.x < NBH * NCHO) { const int it = blockIdx.x, pc = it % NCHO + PC0, bh = it / NCHO, h = bh % HGH, b = bh / HGH;
        const bf16_t* pr = p.P + (size_t)(hg_row0(b, pc) + t) * INC + h * 64 + cg * 8; zf = *(const u32x4*)(pr + OFF_); zb = *(const u32x4*)(pr + OFB); v8 = *(const u32x4*)(pr + OHI); q8 = *(const u32x4*)(pr + OHQ); g8 = *(const u32x4*)(pr + OHG_);
        HG_LOADSIN(bsin, bh, pc); }
    hg_stage_lb(tid, p, l);
    f32x4 hn0, hn1; { const float* nwp = p.hg_norm + l * 64 + cg * 8; hn0 = *(const f32x4*)nwp; hn1 = *(const f32x4*)(nwp + 4); }
    for (int it = blockIdx.x; it < NBH * NCHO; it += gridDim.x) {
        const int pc = it % NCHO + PC0, bh = it / NCHO, h = bh % HGH, b = bh / HGH, row0 = hg_row0(b, pc);
        { const int it2 = min(it + (int)gridDim.x, NBH * NCHO - 1); const int pc2 = it2 % NCHO + PC0, bh2 = it2 / NCHO, h2 = bh2 % HGH, b2 = bh2 / HGH;
            const bf16_t* pr = p.P + (size_t)(hg_row0(b2, pc2) + t) * INC + h2 * 64 + cg * 8; nzf = *(const u32x4*)(pr + OFF_); nzb = *(const u32x4*)(pr + OFB); nv8 = *(const u32x4*)(pr + OHI); nq8 = *(const u32x4*)(pr + OHQ); ng8 = *(const u32x4*)(pr + OHG_);
            HG_LOADSIN(nbsin, bh2, pc2); }
        hg_gates(tid, p, l, h, zf, zb, lds);
        {
            float w[6][8];
#pragma unroll
            for (int j = 0; j < 8; ++j) {
                const int k = cg * 8 + j;
                VT[TSW_E(k, t)] = (bf16_t)(j & 1 ? v8[j >> 1] >> 16 : v8[j >> 1] & 0xffffu);
                const float qv = bf8(q8, j) * 0.125f, af = AF[t * 65 + k], ab = AB[t * 65 + k], rf = AF[31 * 65 + k], rb = AB[32 * 65 + k];
                w[0][j] = qv * __expf(fminf(af - rf, 80.f)); w[1][j] = (1.f - FF[t * 65 + k]) * __expf(fminf(rf - af, 80.f)); w[2][j] = qv * __expf(af);
                w[3][j] = qv * __expf(fminf(ab - rb, 80.f)); w[4][j] = (1.f - FB[t * 65 + k]) * __expf(fminf(rb - ab, 80.f)); w[5][j] = qv * __expf(ab);
            }
#pragma unroll
            for (int a = 0; a < 6; ++a) { u32x4 o; o.x = cvt_pk_bf16(w[a][0], w[a][1]); o.y = cvt_pk_bf16(w[a][2], w[a][3]); o.z = cvt_pk_bf16(w[a][4], w[a][5]); o.w = cvt_pk_bf16(w[a][6], w[a][7]);
                *(LAS u32x4*)(lds + HG_T0 + a * HG_TS + t * 144 + cg * 16) = o; }
        }
        LDS_BAR();
        {
            const int dir = wave >> 2, tt = wave & 3;
            const LAS unsigned char* QT = lds + HG_T0 + (dir * 3 + 0) * HG_TS; const LAS unsigned char* KL = lds + HG_T0 + (dir * 3 + 1) * HG_TS; const LAS unsigned char* QH = lds + HG_T0 + (dir * 3 + 2) * HG_TS;
            bf16x8 bq[2], bh[2];
#pragma unroll
            for (int ks = 0; ks < 2; ++ks) { bq[ks] = *(const LAS bf16x8*)(QT + (tt * 16 + fr) * 144 + ks * 64 + fq * 16); bh[ks] = *(const LAS bf16x8*)(QH + (tt * 16 + fr) * 144 + ks * 64 + fq * 16); }
            f32x4 o[4];
#pragma unroll
            for (int vt = 0; vt < 4; ++vt) { o[vt] = (f32x4){0.f, 0.f, 0.f, 0.f};
#pragma unroll
                for (int ks = 0; ks < 2; ++ks) o[vt] = mfma16(bsin[vt][ks], bh[ks], o[vt]); }
            const int t_ = 16 * tt + fr;
#pragma unroll
            for (int kp = 0; kp < 2; ++kp) {
                f32x4 sc[2];
#pragma unroll
                for (int hf = 0; hf < 2; ++hf) { const int st = 2 * kp + hf;
                    sc[hf] = (f32x4){0.f, 0.f, 0.f, 0.f};
                    if (dir ? st >= tt : st <= tt) {
#pragma unroll
                        for (int ks = 0; ks < 2; ++ks) { const bf16x8 a = *(const LAS bf16x8*)(KL + (st * 16 + fr) * 144 + ks * 64 + fq * 16); sc[hf] = mfma16(a, bq[ks], sc[hf]); }
#pragma unroll
                        for (int r = 0; r < 4; ++r) { const int s_ = 16 * st + 4 * fq + r; const bool keep = dir ? (s_ >= t_) : (s_ <= t_); sc[hf][r] = keep ? sc[hf][r] : 0.f; }
                    } }
                if (dir ? (2 * kp + 1 >= tt) : (2 * kp <= tt)) {
                    u32x4 pw; pw.x = cvt_pk_bf16(sc[0][0], sc[0][1]); pw.y = cvt_pk_bf16(sc[0][2], sc[0][3]); pw.z = cvt_pk_bf16(sc[1][0], sc[1][1]); pw.w = cvt_pk_bf16(sc[1][2], sc[1][3]);
                    const bf16x8 pf = __builtin_bit_cast(bf16x8, pw);
                    const int s0 = 32 * kp + 4 * fq;
#pragma unroll
                    for (int vt = 0; vt < 4; ++vt) { const int v_ = 16 * vt + fr; const int sw = (v_ >> 3) & 7;
                        const LAS unsigned char* vr = lds + HG_VT + v_ * 144 + (s0 & 7) * 2;
                        const bf16x8 a = ld2x64(vr + (((s0 >> 3) ^ sw) << 4), vr + ((((s0 + 16) >> 3) ^ sw) << 4));
                        o[vt] = mfma16(a, pf, o[vt]); }
                }
            }
            LAS float* OOd = (LAS float*)(lds + (dir ? HG_FB : HG_FF));
#pragma unroll
            for (int vt = 0; vt < 4; ++vt)
#pragma unroll
                for (int r = 0; r < 4; ++r) OOd[t_ * 65 + 16 * vt + 4 * fq + r] = o[vt][r];
        }
        LDS_BAR();
        {
            float o[8]; float ss = 0.f;
#pragma unroll
            for (int j = 0; j < 8; ++j) { o[j] = FF[t * 65 + cg * 8 + j] + FB[t * 65 + cg * 8 + j]; ss += o[j] * o[j]; }
            ss += __builtin_bit_cast(float, __builtin_amdgcn_ds_swizzle(__builtin_bit_cast(int, ss), (1 << 10) | 0x1f));
            ss += __builtin_bit_cast(float, __builtin_amdgcn_ds_swizzle(__builtin_bit_cast(int, ss), (2 << 10) | 0x1f));
            ss += __builtin_bit_cast(float, __builtin_amdgcn_ds_swizzle(__builtin_bit_cast(int, ss), (4 << 10) | 0x1f));
            const float rstd = 1.f / sqrtf(ss * (1.f / 64.f) + EPS);
            float y[8];
#pragma unroll
            for (int j = 0; j < 8; ++j) { const float g = bf8(g8, j); y[j] = o[j] * rstd * (j < 4 ? hn0[j & 3] : hn1[j & 3]) * g * __builtin_amdgcn_rcpf(1.f + __expf(-g)); }
            u32x4 ov; ov.x = cvt_pk_bf16(y[0], y[1]); ov.y = cvt_pk_bf16(y[2], y[3]); ov.z = cvt_pk_bf16(y[4], y[5]); ov.w = cvt_pk_bf16(y[6], y[7]);
            zf = nzf; zb = nzb; v8 = nv8; q8 = nq8; g8 = ng8;
#pragma unroll
            for (int vt = 0; vt < 4; ++vt) { bsin[vt][0] = nbsin[vt][0]; bsin[vt][1] = nbsin[vt][1]; }
            asm volatile("" ::: "memory");
            *(u32x4*)(p.MIX + (size_t)(row0 + t) * MIXD + 384 + h * 64 + cg * 8) = ov;
        }
        LDS_BAR();
    }
}


#undef HG_LOADSIN
constexpr int AT_KC = 0, AT_VCT = 36864, AT_KL = AT_VCT + 64 * 528, AT_VL = AT_KL + 3 * 9216, AT_RPB = AT_VL + 3 * 9216, AT_END = AT_RPB + 1920;
static_assert(AT_END <= RING_BYTES && CTX == 256, "attention LDS layout (built for 256 context tokens)");
constexpr float ATHR = 6.f;
template <bool LOCAL, int NKB>
__device__ __forceinline__ void attn_scores(const LAS unsigned char* Kb, const bf16x8 (&qb)[2], f32x4 (&sc)[2 * NKB], int fr, int fq, const LAS float* rpb_row, const int (&boff)[8]) {
#pragma unroll
    for (int mt = 0; mt < 2 * NKB; ++mt) { sc[mt] = (f32x4){0.f, 0.f, 0.f, 0.f};
#pragma unroll
        for (int ks = 0; ks < 2; ++ks) { const bf16x8 a = *(const LAS bf16x8*)(Kb + (16 * mt + fr) * 144 + ks * 64 + fq * 16); sc[mt] = mfma16(a, qb[ks], sc[mt]); } }
    if (LOCAL) {
#pragma unroll
        for (int mt = 0; mt < 2 * NKB; ++mt)
#pragma unroll
            for (int r = 0; r < 4; ++r) sc[mt][r] += *(const LAS float*)((const LAS unsigned char*)rpb_row + boff[(4 * mt + r) & 7]);
    }
}
template <bool LOCAL, int NKB>
__device__ __forceinline__ void attn_spv(const f32x4 (&sc)[2 * NKB], const LAS unsigned char* Vb, int vstride, f32x4 (&o)[4], float& m, float& lsum,
                                         int fr, int fq, int lane, const int (&voff)[4][2], int kbase) {
    float mx = -INFINITY;
#pragma unroll
    for (int mt = 0; mt < 2 * NKB; ++mt)
#pragma unroll
        for (int r = 0; r < 4; ++r) mx = fmaxf(mx, sc[mt][r]);
    mx = fmaxf(mx, __builtin_bit_cast(float, __builtin_amdgcn_ds_swizzle(__builtin_bit_cast(int, mx), (16 << 10) | 0x1f)));
    mx = fmaxf(mx, __builtin_bit_cast(float, __builtin_amdgcn_ds_bpermute((lane ^ 32) << 2, __builtin_bit_cast(int, mx))));
    if (__builtin_amdgcn_ballot_w64(mx > m + ATHR) != 0ull) {
        const float mn = fmaxf(m, mx), corr = __builtin_amdgcn_exp2f(m - mn);
        m = mn; lsum *= corr;
#pragma unroll
        for (int dt = 0; dt < 4; ++dt) o[dt] = o[dt] * corr;
    }
    float ps = 0.f;
#pragma unroll
    for (int kb = 0; kb < NKB; ++kb) {
        float pv[8];
#pragma unroll
        for (int h2 = 0; h2 < 2; ++h2)
#pragma unroll
            for (int r = 0; r < 4; ++r) { const float e = __builtin_amdgcn_exp2f(sc[2 * kb + h2][r] - m); pv[4 * h2 + r] = e; ps += e; }
        u32x4 pw; pw.x = cvt_pk_bf16(pv[0], pv[1]); pw.y = cvt_pk_bf16(pv[2], pv[3]); pw.z = cvt_pk_bf16(pv[4], pv[5]); pw.w = cvt_pk_bf16(pv[6], pv[7]);
        const bf16x8 pf = __builtin_bit_cast(bf16x8, pw);
#pragma unroll
        for (int dt = 0; dt < 4; ++dt) {
            bf16x8 a;
            if (LOCAL) a = ld2x64(Vb + voff[dt][0], Vb + voff[dt][1]);
            else { const int d_ = 16 * dt + fr, sw_ = (d_ >> 3) & 7, c0_ = (kbase >> 3) + 4 * kb + (fq >> 1);
                const LAS unsigned char* vr = Vb + d_ * vstride + (fq & 1) * 8;
                a = ld2x64(vr + ((c0_ ^ sw_) << 4), vr + (((c0_ + 2) ^ sw_) << 4)); }
            o[dt] = mfma16(a, pf, o[dt]);
        }
    }
    lsum += ps;
}
__device__ __forceinline__ void phase_attn(const int tid, PRef p, int l, LAS unsigned char* lds) {
    const int wave = tid >> 6, lane = tid & 63, fr = lane & 15, fq = lane >> 4, skey = tid >> 3, sc8 = tid & 7;
    LAS float* RPB = (LAS float*)(lds + AT_RPB);
    constexpr int NPAIR = ROWS / 2; const int IPB = NPAIR + ((l + 1 < DEPTH) ? 2 : 0);
    const int G_ = gridDim.x, NIT = NB * NAH * IPB;
    const bool deal = (G_ == 256 && NIT <= 160 * 7 + 96 * 5);
    const int it_lo = deal ? ((int)blockIdx.x < 160 ? (int)blockIdx.x * 7 : 1120 + ((int)blockIdx.x - 160) * 5) : (int)blockIdx.x;
    const int it_n = deal ? ((int)blockIdx.x < 160 ? 7 : 5) : (NIT - (int)blockIdx.x + G_ - 1) / G_;
    int last_bh = -1;
#define AT_QTOK(itx) (((itx) % IPB) < NPAIR ? (((itx) / IPB) / NAH) * SEQ + (2 * ((itx) % IPB) + (wave >> 2)) * GW + 16 * (wave & 3) + fr : NLAT + (((itx) / IPB) / NAH) * CTX + ((((itx) % IPB) - NPAIR) * 128 + 16 * wave) + fr)
#define AT_LOADQ(itx, dst) do { const bf16_t* qp_ = p.P + (size_t)AT_QTOK(itx) * INC + OQ + (((itx) / IPB) % NAH) * 64 + fq * 8; dst[0] = *(const bf16x8*)qp_; dst[1] = *(const bf16x8*)(qp_ + 32); } while (0)
    bf16x8 qnx[2] = {(bf16x8){0, 0, 0, 0, 0, 0, 0, 0}, (bf16x8){0, 0, 0, 0, 0, 0, 0, 0}};
    { const int it0 = it_lo; if (it_n > 0 && it0 < NIT) AT_LOADQ(it0, qnx); }
    for (int ii = 0; ii < it_n; ++ii) {
        const int it = deal ? it_lo + ii : it_lo + ii * G_;
        if (it >= NIT) break;
        const int sub = it % IPB, bh = it / IPB, head = bh % NAH, b = bh / NAH;
        const bool islat = sub < NPAIR;
        const int r0 = 2 * sub, qr = r0 + (wave >> 2), jb = wave & 3;
        LDS_BAR();
        if (bh != last_bh) {
            last_bh = bh;
            for (int rnd = 0; rnd < 4; ++rnd) {
                const int key = skey + 64 * rnd; const bf16_t* src = p.P + (size_t)(NLAT + b * CTX + key) * INC + head * 64 + sc8 * 8;
                const u32x4 kv = *(const u32x4*)(src + OK_), vv = *(const u32x4*)(src + OV);
                *(LAS u32x4*)(lds + AT_KC + key * 144 + sc8 * 16) = kv;
#pragma unroll
                for (int j = 0; j < 8; ++j) *(LAS bf16_t*)(lds + AT_VCT + (sc8 * 8 + j) * 528 + ((((key >> 3) ^ sc8) << 4) + (key & 7) * 2)) = (bf16_t)(j & 1 ? vv[j >> 1] >> 16 : vv[j >> 1] & 0xffffu);
            }
            { int t2 = tid; asm volatile("" : "+v"(t2));
              if (t2 < 15 * 32) RPB[t2] = (t2 & 31) < 31 ? p.rpb[((size_t)l * NAH + head) * 465 + (t2 >> 5) * 31 + (t2 & 31)] * 1.44269504089f : -INFINITY; }
        }
        const int qtok = islat ? b * SEQ + qr * GW + 16 * jb + fr : NLAT + b * CTX + ((sub - NPAIR) * 128 + 16 * wave) + fr;
        bf16x8 qb[2]; qb[0] = qnx[0]; qb[1] = qnx[1];
        { const int itn = deal ? it + 1 : it + G_; if (ii + 1 < it_n && itn < NIT) AT_LOADQ(itn, qnx); }
        int krlo = 0, krhi = -1, rs = 0;
        if (islat) { int a = r0 - 4; a = a < 0 ? 0 : (a > ROWS - 8 ? ROWS - 8 : a); int c = r0 + 1 - 4; c = c < 0 ? 0 : (c > ROWS - 8 ? ROWS - 8 : c); krlo = a; krhi = c + 7;
            rs = qr - 4; rs = rs < 0 ? 0 : (rs > ROWS - 8 ? ROWS - 8 : rs); }
        u32x4 kA = (u32x4){0u, 0u, 0u, 0u}, vA = kA, kB = kA, vB = kA, kC = kA, vC = kA;
#define AT_LOADROW(row, kd, vd) do { const bf16_t* src_ = p.P + (size_t)(b * SEQ + (row) * GW + skey) * INC + head * 64 + sc8 * 8; kd = *(const u32x4*)(src_ + OK_); vd = *(const u32x4*)(src_ + OV); } while (0)
#define AT_STAGEROW(bufi, kd, vd) do { *(LAS u32x4*)(lds + AT_KL + (bufi) * 9216 + skey * 144 + sc8 * 16) = kd; \
        _Pragma("unroll") for (int j = 0; j < 8; ++j) *(LAS bf16_t*)(lds + AT_VL + (bufi) * 9216 + (sc8 * 8 + j) * 144 + ((((skey >> 3) ^ sc8) << 4) + (skey & 7) * 2)) = (bf16_t)(j & 1 ? vd[j >> 1] >> 16 : vd[j >> 1] & 0xffffu); } while (0)
        if (islat) { AT_LOADROW(krlo, kA, vA); AT_LOADROW(krlo + 1, kB, vB); AT_LOADROW(krlo + 2, kC, vC); }
        f32x4 o[4]; float m = -1e30f, lsum = 0.f;
#pragma unroll
        for (int dt = 0; dt < 4; ++dt) o[dt] = (f32x4){0.f, 0.f, 0.f, 0.f};
        LDS_BAR();
        const int bs = jb == 0 ? 0 : (jb == 1 ? 8 : (jb == 2 ? 24 : 32)), qc = 16 * jb + fr;
        int boff[8], voff[4][2];
        { int ws = qc - 8; ws = ws < 0 ? 0 : (ws > 48 ? 48 : ws);
#pragma unroll
          for (int j_ = 0; j_ < 8; ++j_) { const int kc = bs + 16 * (j_ >> 2) + 4 * fq + (j_ & 3); const bool ok = kc >= ws && kc < ws + 16; boff[j_] = (ok ? kc - qc + 15 : 31) * 4; asm volatile("" : "+v"(boff[j_])); }
#pragma unroll
          for (int dt = 0; dt < 4; ++dt) { const int d_ = 16 * dt + fr, sw_ = (d_ >> 3) & 7, c0_ = (bs >> 3) + (fq >> 1);
              voff[dt][0] = d_ * 144 + (fq & 1) * 8 + ((c0_ ^ sw_) << 4); voff[dt][1] = d_ * 144 + (fq & 1) * 8 + (((c0_ + 2) ^ sw_) << 4); asm volatile("" : "+v"(voff[dt][0]), "+v"(voff[dt][1])); } }
        {
            f32x4 sa[4], sb[4];
#define AT_CS(st, dst) attn_scores<false, 2>(lds + AT_KC + (st) * 64 * 144, qb, dst, fr, fq, RPB, boff)
#define AT_CP(st, src) attn_spv<false, 2>(src, lds + AT_VCT, 528, o, m, lsum, fr, fq, lane, voff, (st) * 64)
            AT_CS(0, sa); AT_CS(1, sb); AT_CP(0, sa); AT_CS(2, sa); AT_CP(1, sb); AT_CS(3, sb); AT_CP(2, sa); AT_CP(3, sb);
#undef AT_CS
#undef AT_CP
        }
        if (islat) { AT_STAGEROW(0, kA, vA); AT_LOADROW(krlo + 3, kA, vA); AT_STAGEROW(1, kB, vB); AT_LOADROW(krlo + 4, kB, vB); }
        LDS_BAR();
        if (islat) {
            const bool first0 = rs == krlo, last8 = !first0;
            const LAS float* rp = RPB + (krlo - qr + 7) * 32;
            f32x4 sa[2], sb[2];
#define AT_S(j, dst) attn_scores<true, 1>(lds + AT_KL + ((j) % 3) * 9216 + bs * 144, qb, dst, fr, fq, rp + 32 * (j), boff)
#define AT_P(j, src) attn_spv<true, 1>(src, lds + AT_VL + ((j) % 3) * 9216, 144, o, m, lsum, fr, fq, lane, voff, bs)
#define AT_MID(j, NK, NV, LOADROWX, SCUR, SNXT) { AT_STAGEROW(((j) + 2) % 3, NK, NV); if ((LOADROWX) >= 0) { AT_LOADROW(min(krlo + (LOADROWX), krhi), NK, NV); } \
            AT_S((j) + 1, SNXT); AT_P(j, SCUR); LDS_BAR(); }
            sa[0] = (f32x4){0.f, 0.f, 0.f, 0.f}; sa[1] = sa[0];
            if (first0) AT_S(0, sa);
            { AT_STAGEROW(2, kC, vC); AT_LOADROW(krlo + 5, kC, vC); AT_S(1, sb); if (first0) AT_P(0, sa); LDS_BAR(); }
            AT_MID(1, kA, vA, 6, sb, sa) AT_MID(2, kB, vB, 7, sa, sb) AT_MID(3, kC, vC, 8, sb, sa) AT_MID(4, kA, vA, -1, sa, sb) AT_MID(5, kB, vB, -1, sb, sa) AT_MID(6, kC, vC, -1, sa, sb)
            if (last8) { AT_S(8, sa); AT_P(7, sb); AT_P(8, sa); } else { AT_P(7, sb); }
#undef AT_S
#undef AT_P
#undef AT_MID
        }
#undef AT_LOADROW
#undef AT_STAGEROW
        lsum += __builtin_bit_cast(float, __builtin_amdgcn_ds_swizzle(__builtin_bit_cast(int, lsum), (16 << 10) | 0x1f));
        lsum += __builtin_bit_cast(float, __builtin_amdgcn_ds_bpermute((lane ^ 32) << 2, __builtin_bit_cast(int, lsum)));
        const float inv = 1.f / lsum;
        bf16_t* orow = p.MIX + (size_t)qtok * MIXD + head * 64;
#pragma unroll
        for (int dt = 0; dt < 4; ++dt) { u32x2 w; w.x = cvt_pk_bf16(o[dt][0] * inv, o[dt][1] * inv); w.y = cvt_pk_bf16(o[dt][2] * inv, o[dt][3] * inv); *(u32x2*)(orow + 16 * dt + 4 * fq) = w; }
    }
}


#undef AT_QTOK
#undef AT_LOADQ
template <int MODE> __device__ __forceinline__ void mini_gemm(const int tid, PRef p, int l) {
    const int wave = tid >> 6, lane = tid & 63, fr = lane & 15, fq = lane >> 4;
    const int gw = blockIdx.x * NWAVES + wave, NGW = gridDim.x * NWAVES;
    constexpr int K = MODE == 3 ? ED : (MODE == 1 ? MIXD : D);
    constexpr int N = MODE == 0 ? INC : (MODE == 2 ? 2 * ED : D);
    constexpr int MROWS = MODE <= 1 ? NCTX : NSLOT_C;
    constexpr int NTC = MODE == 2 ? 2 : 1, TW = 16 * NTC;
    constexpr int NTN = N / TW, NT = (MROWS / 32) * NTN;
    for (int t = gw; t < NT; t += NGW) {
        const int rt = t / NTN, ct = t % NTN, c0 = ct * TW;
        const bf16_t* Bt; const bf16_t* arow[2];
        if (MODE == 0) { Bt = p.WIN_T + WBOFF(l); for (int mt = 0; mt < 2; ++mt) arow[mt] = p.H + (size_t)(NLAT + rt * 32 + 16 * mt + fr) * D; }
        else if (MODE == 1) { Bt = p.WOUT_T + WBOFF(l); for (int mt = 0; mt < 2; ++mt) arow[mt] = p.MIX + (size_t)(NLAT + rt * 32 + 16 * mt + fr) * MIXD; }
        else if (MODE == 2) { const int e = rt % NE; Bt = p.WGU_T + WBOFF(l) + (size_t)e * 2 * ED * D;
            for (int mt = 0; mt < 2; ++mt) { int row = p.STOK[NSLOT_L + rt * 32 + 16 * mt + fr]; row = row < 0 ? 0 : (row >= NTOK ? NTOK - 1 : row); arow[mt] = p.H + (size_t)row * D; } }
        else { const int e = rt % NE; Bt = p.WD_T + WBOFF(l) + (size_t)e * D * ED; for (int mt = 0; mt < 2; ++mt) arow[mt] = p.HID + (size_t)(NSLOT_L + rt * 32 + 16 * mt + fr) * ED; }
        const bf16_t* brow = Bt + (size_t)(c0 + fr) * K;
        f32x4 acc[2][NTC];
#pragma unroll
        for (int mt = 0; mt < 2; ++mt)
#pragma unroll
            for (int nt = 0; nt < NTC; ++nt) acc[mt][nt] = (f32x4){0.f, 0.f, 0.f, 0.f};
#pragma unroll 8
        for (int ks = 0; ks < K / 32; ++ks) {
            bf16x8 a[2], bfr[NTC];
#pragma unroll
            for (int mt = 0; mt < 2; ++mt) a[mt] = *(const bf16x8*)(arow[mt] + ks * 32 + fq * 8);
#pragma unroll
            for (int nt = 0; nt < NTC; ++nt) bfr[nt] = *(const bf16x8*)(brow + (size_t)(16 * nt) * K + ks * 32 + fq * 8);
#pragma unroll
            for (int mt = 0; mt < 2; ++mt)
#pragma unroll
                for (int nt = 0; nt < NTC; ++nt) acc[mt][nt] = mfma16(a[mt], bfr[nt], acc[mt][nt]);
        }
#pragma unroll
        for (int mt = 0; mt < 2; ++mt)
#pragma unroll
            for (int r = 0; r < 4; ++r) {
                const int lr = rt * 32 + 16 * mt + 4 * fq + r;
                if (MODE == 0) { bf16_t* o = p.P + (size_t)(NLAT + lr) * INC + c0 + fr;
#pragma unroll
                    for (int nt = 0; nt < NTC; ++nt) o[16 * nt] = f2bf(acc[mt][nt][r]); }
                else if (MODE == 1) { float* o = p.XC + (size_t)lr * D + c0 + fr; const float* g = p.MOD + ((size_t)l * 3 + 2) * NMOD + 2 * D + c0 + fr;
#pragma unroll
                    for (int nt = 0; nt < NTC; ++nt) o[16 * nt] += g[16 * nt] * acc[mt][nt][r]; }
                else if (MODE == 2) { bf16_t* o = p.HID + (size_t)(NSLOT_L + lr) * ED + c0 / 2 + fr;
#pragma unroll
                    for (int q = 0; q < NTC / 2; ++q) { const float g = acc[mt][2 * q][r], u = acc[mt][2 * q + 1][r]; o[16 * q] = f2bf(g / (1.f + __expf(-g)) * u); } }
                else { bf16_t* o = p.Y + (size_t)(NSLOT_L + lr) * D + c0 + fr; const float val = p.SVAL[NSLOT_L + lr];
#pragma unroll
                    for (int nt = 0; nt < NTC; ++nt) o[16 * nt] = f2bf(val * acc[mt][nt][r]); }
            }
    }
}


__device__ __forceinline__ void phase_conv(const int tid, PRef p, int l) {
    const float* w = p.conv_w + (size_t)l * 3 * CVD;
    constexpr int U = 2;
    const long nitem = (long)NTOK * (CVD / 8), gstr = (long)gridDim.x * NTHR;
    for (long g0 = (long)blockIdx.x * NTHR + tid; g0 < nitem; g0 += gstr * U) {
        u32x4 cc[U][3], uu[U][3], bg[U]; float vz[U][3]; int rr[U], c8v[U]; bool ok[U];
#pragma unroll
        for (int u = 0; u < U; ++u) {
            long gid = g0 + u * gstr; ok[u] = gid < nitem; if (!ok[u]) gid = g0;
            const int r = (int)(gid / (CVD / 8)), c8 = (int)(gid % (CVD / 8)) * 8; rr[u] = r; c8v[u] = c8;
            int t, T; if (r < NLAT) { t = r % SEQ; T = SEQ; } else { t = (r - NLAT) % CTX; T = CTX; }
            const bf16_t* pr = p.P + (size_t)r * INC + c8;
#pragma unroll
            for (int d = 0; d < 3; ++d) { const int tt = t + d - 1; const bool in = tt >= 0 && tt < T; vz[u][d] = in ? 1.f : 0.f;
                const bf16_t* q = pr + (in ? (long)(d - 1) * INC : 0L); cc[u][d] = *(const u32x4*)(q + OCC); uu[u][d] = *(const u32x4*)(q + OCU); }
            bg[u] = *(const u32x4*)(pr + OCB);
        }
        asm volatile("" ::: "memory");
#pragma unroll
        for (int u = 0; u < U; ++u) {
            float y[8];
#pragma unroll
            for (int j = 0; j < 8; ++j) y[j] = 0.f;
#pragma unroll
            for (int d = 0; d < 3; ++d) {
                const f32x4 w0 = *(const f32x4*)(w + d * CVD + c8v[u]) * vz[u][d], w1 = *(const f32x4*)(w + d * CVD + c8v[u] + 4) * vz[u][d];
#pragma unroll
                for (int j = 0; j < 8; ++j) y[j] += (j < 4 ? w0[j & 3] : w1[j & 3]) * bf8(cc[u][d], j) * bf8(uu[u][d], j);
            }
            u32x4 o; o.x = cvt_pk_bf16(bf8(bg[u], 0) * y[0], bf8(bg[u], 1) * y[1]); o.y = cvt_pk_bf16(bf8(bg[u], 2) * y[2], bf8(bg[u], 3) * y[3]);
            o.z = cvt_pk_bf16(bf8(bg[u], 4) * y[4], bf8(bg[u], 5) * y[5]); o.w = cvt_pk_bf16(bf8(bg[u], 6) * y[6], bf8(bg[u], 7) * y[7]);
            if (ok[u]) *(u32x4*)(p.MIX + (size_t)rr[u] * MIXD + 768 + c8v[u]) = o;
        }
    }
}
__device__ __forceinline__ void phase_qkprep(const int tid, PRef p, int l) {
    const int sub = tid & 7;
    constexpr int U = 4;
    const long ngroups = (long)NTOK * 12, gstride = ((long)gridDim.x * NTHR) >> 3;
    for (long g0 = ((long)blockIdx.x * NTHR + tid) >> 3; g0 < ngroups; g0 += gstride * U) {
        u32x4 raw[U]; bf16_t* ptr[U]; int rr[U]; int wh[U];
#pragma unroll
        for (int u = 0; u < U; ++u) { long g8 = g0 + u * gstride; const bool ok = g8 < ngroups; if (!ok) g8 = g0;
            rr[u] = ok ? (int)(g8 / 12) : -1; wh[u] = (int)(g8 % 12) / 6; const int head = (int)(g8 % 6);
            ptr[u] = p.P + (size_t)(g8 / 12) * INC + (wh[u] ? OK_ : OQ) + head * HD + sub * 8; raw[u] = *(const u32x4*)ptr[u]; }
#pragma unroll
        for (int u = 0; u < U; ++u) {
            const float* nw = (wh[u] ? p.k_norm : p.q_norm) + l * HD + sub * 8;
            float y[8]; float ss = 0.f;
#pragma unroll
            for (int j = 0; j < 8; ++j) { y[j] = bf8(raw[u], j); ss += y[j] * y[j]; }
            ss += __builtin_bit_cast(float, __builtin_amdgcn_ds_swizzle(__builtin_bit_cast(int, ss), (1 << 10) | 0x1f));
            ss += __builtin_bit_cast(float, __builtin_amdgcn_ds_swizzle(__builtin_bit_cast(int, ss), (2 << 10) | 0x1f));
            ss += __builtin_bit_cast(float, __builtin_amdgcn_ds_swizzle(__builtin_bit_cast(int, ss), (4 << 10) | 0x1f));
            const float rstd = 1.f / sqrtf(ss * (1.f / HD) + EPS);
#pragma unroll
            for (int j = 0; j < 8; ++j) y[j] = y[j] * rstd * nw[j];
            const int r = rr[u];
            const bool lat = r >= 0 && r < NLAT;
            const int t = lat ? r % SEQ : 0; const float pos = (sub & 4) ? (float)(t % GW) : (float)(t / GW);
            const bool second = (sub & 2) != 0;
#pragma unroll
            for (int j = 0; j < 8; ++j) {
                const float other = __builtin_bit_cast(float, __builtin_amdgcn_ds_swizzle(__builtin_bit_cast(int, y[j]), (2 << 10) | 0x1f));
                const int fi = (sub & 1) * 8 + j;
                const float ang = pos * __builtin_amdgcn_exp2f(-(float)fi * (13.287712379549449f / 16.f));
                const float cs = FCOS(ang), sn = FSIN(ang);
                const float rot = second ? y[j] * cs + other * sn : y[j] * cs - other * sn;
                y[j] = lat ? rot : y[j];
            }
            if (r >= 0) { u32x4 o; o.x = cvt_pk_bf16(y[0], y[1]); o.y = cvt_pk_bf16(y[2], y[3]); o.z = cvt_pk_bf16(y[4], y[5]); o.w = cvt_pk_bf16(y[6], y[7]); *(u32x4*)ptr[u] = o; }
        }
    }
}

__device__ __forceinline__ f32x4 bf4(const u32x2 w) { return (f32x4){bfw(w.x, 0), bfw(w.x, 1), bfw(w.y, 0), bfw(w.y, 1)}; }
template <int MODE> __device__ __forceinline__ void phase_rows(const int tid, PRef p, int l, LAS unsigned char* lds) {
    static_assert(D == 1024, "wave-per-row kernels assume D = 1024");
    const int lane = tid & 63, wave = tid >> 6;
#define RC(j) (8 * lane + 512 * ((j) >> 1) + 4 * ((j) & 1))
    if (MODE == 1) {
        for (int k = tid; k < D; k += NTHR) { const f32x4* src = (const f32x4*)(p.w_router + ((size_t)l * D + k) * NE); LAS f32x4* dst = (LAS f32x4*)(lds + k * 64 + (k >> 3) * 16);
#pragma unroll
            for (int u = 0; u < 4; ++u) dst[u] = src[u]; }
        __syncthreads();
    }
    const int gw = blockIdx.x * NWAVES + wave, NGW = gridDim.x * NWAVES;
    const int rw = ((NTOK + NGW - 1) / NGW + 1) & ~1;
    const int r_lo = gw * rw, r_hi = min(NTOK, r_lo + rw);
    const bool doh = MODE != 2 || l + 1 < DEPTH;
    const int ln = (MODE == 2 && l + 1 < DEPTH) ? l + 1 : l;
    const float* nw = (MODE == 1 ? p.norm2_w : p.norm1_w) + (size_t)ln * D;
    int curset = -1; f32x4 Av[4], Sv[4], Gv[4];
#pragma unroll
    for (int j = 0; j < 4; ++j) { Av[j] = (f32x4){0.f, 0.f, 0.f, 0.f}; Sv[j] = Av[j]; Gv[j] = Av[j]; }
    u32x4 vn[2][4]; int invn[2] = {-1, -1};
#define ROWS_LOADPAIR(rb) do { _Pragma("unroll") for (int i_ = 0; i_ < 2; ++i_) { const int rr_ = ((rb) + i_ < r_hi) ? (rb) + i_ : (rb); \
        if (MODE != 0 && rr_ < NLAT) { const bf16_t* src_ = p.XB + (size_t)rr_ * D + 8 * lane; vn[i_][0] = *(const u32x4*)src_; vn[i_][1] = *(const u32x4*)(src_ + 512); } \
        else { const float* src_ = MODE == 0 ? (rr_ < NLAT ? p.x + (size_t)rr_ * D : p.ctx + (size_t)(rr_ - NLAT) * D) : p.XC + (size_t)(rr_ - NLAT) * D; \
            _Pragma("unroll") for (int j_ = 0; j_ < 4; ++j_) vn[i_][j_] = *(const u32x4*)(src_ + RC(j_)); } \
        if (MODE == 2) invn[i_] = lane < NE ? p.INV[(size_t)rr_ * NE + lane] : -1; } } while (0)
#pragma unroll
    for (int i = 0; i < 2; ++i)
#pragma unroll
        for (int j = 0; j < 4; ++j) vn[i][j] = (u32x4){0u, 0u, 0u, 0u};
    if (r_lo < r_hi) ROWS_LOADPAIR(r_lo);
#pragma unroll 1
    for (int r = r_lo; r < r_hi; r += 2) {
        const bool two = r + 1 < r_hi;
        const bool lat = r < NLAT;
        const int set = modset(r);
        if (set != curset) { curset = set;
            const float* mod = p.MOD + ((size_t)ln * 3 + set) * NMOD; const float* shift = mod + (MODE == 1 ? 3 : 0) * D; const float* scale = mod + (MODE == 1 ? 4 : 1) * D;
            int lane2 = lane; asm volatile("" : "+v"(lane2));
#pragma unroll
            for (int j = 0; j < 4; ++j) { const int c = 8 * lane2 + 512 * (j >> 1) + 4 * (j & 1); const f32x4 w4 = *(const f32x4*)(nw + c), sc4 = *(const f32x4*)(scale + c); Av[j] = w4 * (sc4 + 1.f); Sv[j] = *(const f32x4*)(shift + c);
                if (MODE == 2) Gv[j] = *(const f32x4*)(p.MOD + ((size_t)l * 3 + set) * NMOD + 5 * D + c); } }
        f32x4 v[2][4]; int inv2[2];
#pragma unroll
        for (int i = 0; i < 2; ++i) { inv2[i] = invn[i];
            if (MODE != 0 && lat) {
#pragma unroll
                for (int jj = 0; jj < 2; ++jj) { const u32x4 w = vn[i][jj]; v[i][2 * jj] = (f32x4){bfw(w.x, 0), bfw(w.x, 1), bfw(w.y, 0), bfw(w.y, 1)}; v[i][2 * jj + 1] = (f32x4){bfw(w.z, 0), bfw(w.z, 1), bfw(w.w, 0), bfw(w.w, 1)}; }
            } else {
#pragma unroll
                for (int j = 0; j < 4; ++j) v[i][j] = __builtin_bit_cast(f32x4, vn[i][j]);
            } }
        if (r + 2 < r_hi) ROWS_LOADPAIR(r + 2);
        if (MODE == 2) {
#pragma unroll
            for (int i = 0; i < 2; ++i) {
                const int myinv = inv2[i];
                unsigned long long mask = __ballot(myinv >= 0 && myinv < NSLOT);
                f32x4 acc[4];
#pragma unroll
                for (int j = 0; j < 4; ++j) acc[j] = (f32x4){0.f, 0.f, 0.f, 0.f};
                while (mask) {
                    const int e0 = __builtin_ctzll(mask); mask &= mask - 1; const int s0 = __builtin_amdgcn_readlane(myinv, e0);
                    int s1 = -1; if (mask) { const int e1 = __builtin_ctzll(mask); mask &= mask - 1; s1 = __builtin_amdgcn_readlane(myinv, e1); }
                    u32x4 y0[2], y1[2];
#pragma unroll
                    for (int jj = 0; jj < 2; ++jj) y0[jj] = *(const u32x4*)(p.Y + (size_t)s0 * D + 8 * lane + 512 * jj);
                    if (s1 >= 0) {
#pragma unroll
                        for (int jj = 0; jj < 2; ++jj) y1[jj] = *(const u32x4*)(p.Y + (size_t)s1 * D + 8 * lane + 512 * jj);
                    }
#pragma unroll
                    for (int jj = 0; jj < 2; ++jj) { acc[2 * jj] = acc[2 * jj] + (f32x4){bfw(y0[jj].x, 0), bfw(y0[jj].x, 1), bfw(y0[jj].y, 0), bfw(y0[jj].y, 1)}; acc[2 * jj + 1] = acc[2 * jj + 1] + (f32x4){bfw(y0[jj].z, 0), bfw(y0[jj].z, 1), bfw(y0[jj].w, 0), bfw(y0[jj].w, 1)}; }
                    if (s1 >= 0) {
#pragma unroll
                        for (int jj = 0; jj < 2; ++jj) { acc[2 * jj] = acc[2 * jj] + (f32x4){bfw(y1[jj].x, 0), bfw(y1[jj].x, 1), bfw(y1[jj].y, 0), bfw(y1[jj].y, 1)}; acc[2 * jj + 1] = acc[2 * jj + 1] + (f32x4){bfw(y1[jj].z, 0), bfw(y1[jj].z, 1), bfw(y1[jj].w, 0), bfw(y1[jj].w, 1)}; }
                    }
                }
#pragma unroll
                for (int j = 0; j < 4; ++j) v[i][j] = v[i][j] + Gv[j] * acc[j];
            }
        }
        if (MODE == 0 || MODE == 2) {
            const bool fin = MODE == 2 && l + 1 == DEPTH;
#pragma unroll
            for (int i = 0; i < 2; ++i) if (i == 0 || two) {
                if (lat && !fin) {
#pragma unroll
                    for (int jj = 0; jj < 2; ++jj) { u32x4 o; o.x = cvt_pk_bf16(v[i][2 * jj][0], v[i][2 * jj][1]); o.y = cvt_pk_bf16(v[i][2 * jj][2], v[i][2 * jj][3]); o.z = cvt_pk_bf16(v[i][2 * jj + 1][0], v[i][2 * jj + 1][1]); o.w = cvt_pk_bf16(v[i][2 * jj + 1][2], v[i][2 * jj + 1][3]);
                        *(u32x4*)(p.XB + (size_t)(r + i) * D + 8 * lane + 512 * jj) = o; }
                } else if (lat || !fin) { float* dst = lat ? p.XL + (size_t)(r + i) * D : p.XC + (size_t)(r + i - NLAT) * D;
#pragma unroll
                    for (int j = 0; j < 4; ++j) *(f32x4*)(dst + RC(j)) = v[i][j]; }
            }
        }
        if (doh) {
            float ss[2];
#pragma unroll
            for (int i = 0; i < 2; ++i) { float a = 0.f;
#pragma unroll
                for (int j = 0; j < 4; ++j) a += (v[i][j][0] * v[i][j][0] + v[i][j][1] * v[i][j][1]) + (v[i][j][2] * v[i][j][2] + v[i][j][3] * v[i][j][3]);
                ss[i] = a; }
            ss[0] = wave_sum(ss[0], lane); ss[1] = wave_sum(ss[1], lane);
            const float rstd0 = 1.f / sqrtf(ss[0] * (1.f / D) + EPS), rstd1 = 1.f / sqrtf(ss[1] * (1.f / D) + EPS);
            f32x4 hh[2][4];
#pragma unroll
            for (int j = 0; j < 4; ++j) { hh[0][j] = v[0][j] * rstd0 * Av[j] + Sv[j]; hh[1][j] = v[1][j] * rstd1 * Av[j] + Sv[j]; }
#pragma unroll
            for (int i = 0; i < 2; ++i) if (i == 0 || two) {
#pragma unroll
                for (int jj = 0; jj < 2; ++jj) { u32x4 o; o.x = cvt_pk_bf16(hh[i][2 * jj][0], hh[i][2 * jj][1]); o.y = cvt_pk_bf16(hh[i][2 * jj][2], hh[i][2 * jj][3]); o.z = cvt_pk_bf16(hh[i][2 * jj + 1][0], hh[i][2 * jj + 1][1]); o.w = cvt_pk_bf16(hh[i][2 * jj + 1][2], hh[i][2 * jj + 1][3]);
                    *(u32x4*)(p.H + (size_t)(r + i) * D + 8 * lane + 512 * jj) = o; } }
            if (MODE == 1) {
                LAS float* red = (LAS float*)(lds + 70144 + wave * 4224);
#pragma unroll
                for (int i = 0; i < 2; ++i) {
                    float lg[NE];
#pragma unroll
                    for (int e = 0; e < NE; ++e) lg[e] = 0.f;
#pragma unroll
                    for (int j = 0; j < 4; ++j)
#pragma unroll
                        for (int q = 0; q < 4; ++q) { const int k = RC(j) + q; const LAS f32x4* wr = (const LAS f32x4*)(lds + k * 64 + (k >> 3) * 16); const float hv = hh[i][j][q];
#pragma unroll
                            for (int u = 0; u < 4; ++u) { const f32x4 w = wr[u]; lg[4 * u + 0] += hv * w[0]; lg[4 * u + 1] += hv * w[1]; lg[4 * u + 2] += hv * w[2]; lg[4 * u + 3] += hv * w[3]; } }
#pragma unroll
                    for (int e = 0; e < NE; ++e) red[e * 65 + lane] = lg[e];
                    asm volatile("" ::: "memory");
                    const int e2 = lane & 15, part = lane >> 4;
                    float t = 0.f;
#pragma unroll
                    for (int x = 0; x < 16; ++x) t += red[e2 * 65 + part * 16 + x];
                    asm volatile("" ::: "memory");
                    t += __builtin_bit_cast(float, __builtin_amdgcn_ds_swizzle(__builtin_bit_cast(int, t), (16 << 10) | 0x1f));
                    t += __builtin_bit_cast(float, __builtin_amdgcn_ds_bpermute((lane ^ 32) << 2, __builtin_bit_cast(int, t)));
#define SWZF(x, d) __builtin_bit_cast(float, __builtin_amdgcn_ds_swizzle(__builtin_bit_cast(int, (x)), ((d) << 10) | 0x1f))
                    float m = t;
                    m = fmaxf(m, SWZF(m, 1)); m = fmaxf(m, SWZF(m, 2)); m = fmaxf(m, SWZF(m, 4)); m = fmaxf(m, SWZF(m, 8));
                    const float ex = expf(t - m); float sm = ex;
                    sm += SWZF(sm, 1); sm += SWZF(sm, 2); sm += SWZF(sm, 4); sm += SWZF(sm, 8);
#undef SWZF
                    if (lane < NE && (i == 0 || two)) p.AFF[(size_t)(r + i) * NE + lane] = ex / sm;
                }
            }
        }
    }
#undef ROWS_LOADPAIR
#undef RC
    if (MODE == 1) __syncthreads();
}


__device__ __forceinline__ void phase_adaln(const int tid, PRef p, LAS unsigned char* lds) {
    static_assert(D == 1024 && NMOD % 256 == 0, "adaln layout");
    const int lane = tid & 63, wave = tid >> 6;
    LAS float* SC = (LAS float*)lds;
    LAS float* RED = (LAS float*)(lds + 16384);
    for (int i = tid; i < 3 * D; i += NTHR) { const int st = i / D, k = i % D; const float cv = st < 2 ? p.c[st * D + k] : p.c_ctx[k]; SC[i] = cv / (1.f + __expf(-cv)); }
    __syncthreads();
    constexpr int NCG = NMOD / 256;
    for (int item = blockIdx.x; item < DEPTH * NCG * 2; item += gridDim.x) {
        const int l = item / (NCG * 2), rem = item % (NCG * 2), cgp = rem >> 1, kh = rem & 1;
        const int kbase = kh * 512 + wave * 64;
        const float* wp = p.w_mod + ((size_t)l * D + kbase) * NMOD + cgp * 256 + 4 * lane;
        f32x4 acc[3];
#pragma unroll
        for (int st = 0; st < 3; ++st) acc[st] = (f32x4){0.f, 0.f, 0.f, 0.f};
#pragma unroll 16
        for (int kk = 0; kk < 64; ++kk) { const f32x4 w = *(const f32x4*)(wp + (size_t)kk * NMOD);
#pragma unroll
            for (int st = 0; st < 3; ++st) acc[st] = acc[st] + w * SC[st * D + kbase + kk]; }
#pragma unroll
        for (int st = 0; st < 3; ++st) *(LAS f32x4*)(RED + (wave * 3 + st) * 256 + 4 * lane) = acc[st];
        __syncthreads();
        for (int o = tid; o < 3 * 256; o += NTHR) { const int st = o >> 8, n = o & 255; float v = 0.f;
#pragma unroll
            for (int w8 = 0; w8 < 8; ++w8) v += RED[(w8 * 3 + st) * 256 + n];
            if (kh == 0) v += p.b_mod[(size_t)l * NMOD + cgp * 256 + n];
            atomicAdd(p.MOD + ((size_t)l * 3 + st) * NMOD + cgp * 256 + n, v); }
        __syncthreads();
    }
}

constexpr int NPL = 11, NPH = 1 + DEPTH * NPL;
struct Args { Params p; int ph_lo, ph_hi; };
__global__ void __launch_bounds__(NTHR, 2) mega_fwd(Args args) {
    LAS unsigned char* lds = (LAS unsigned char*)lds_raw;
    {
        const int tid0 = threadIdx.x;
        for (int u = tid0; u < (LDS_BYTES - LDSCTL_OFF) / 4; u += NTHR) ((LAS unsigned*)(lds + LDSCTL_OFF))[u] = 0u;
        __syncthreads();
    }
    int wslot = 0;
    { unsigned m_ = ~0u; asm volatile("" : "+s"(m_));
      const int simd = (int)(__builtin_amdgcn_s_getreg((1 << 11) | (4 << 6) | 4) & 3u);
      if (__builtin_amdgcn_mbcnt_hi(m_, __builtin_amdgcn_mbcnt_lo(m_, 0u)) == 0) wslot = simd + 4 * (int)__hip_atomic_fetch_add(((unsigned*)(lds_raw + MISC_OFF + 64)) + simd, 1u, __ATOMIC_RELAXED, __HIP_MEMORY_SCOPE_WORKGROUP); }
    wslot = __builtin_amdgcn_readfirstlane(wslot) & 7;
#define MY_TID(var) int var; { unsigned m_ = ~0u; asm volatile("" : "+s"(m_)); var = wslot * 64 + (int)__builtin_amdgcn_mbcnt_hi(m_, __builtin_amdgcn_mbcnt_lo(m_, 0u)); } asm volatile("" : "+v"(var))
    XcdBarrier bar; bar.bar = args.p.CTL; bar.x = 0;
    const bool multi = args.ph_hi - args.ph_lo > 1;
    if (multi) { MY_TID(t0); bar = xcd_barrier_post(args.p.CTL, t0 == 0); }
    const int G = gridDim.x;
    const int ph_lo = args.ph_lo, ph_hi = args.ph_hi;
#ifndef PHMASK
#define PHMASK 0xFFFF
#endif
#define PH_ON(k) ((k) == 0 ? (PHMASK & 1) : ((PHMASK >> (1 + ((k) - 1) % NPL)) & 1))
#ifndef REPMASK
#define REPMASK 0
#endif
#ifndef REP_LOCAL
#define REP_LOCAL 0
#define REP_CONV 0
#define REP_ATTN 0
#endif
#ifndef HG_STOP
#define HG_STOP 0
#endif
#ifndef REP_P0
#define REP_P0 0
#endif
#define REP_N(k) (((k) == 0 && REP_P0) ? 2 : (((k) > 0 && ((REPMASK >> (((k) - 1) % NPL)) & 1)) ? 2 : 1))
#define PH_BEGIN(k) if (PH_ON(k) && ph_lo <= (k) && (k) < ph_hi) { for (int rep_ = 0; rep_ < REP_N(k); ++rep_) { const AS4 Args* kp = (const AS4 Args*)__builtin_amdgcn_kernarg_segment_ptr(); asm volatile("" : "+s"(kp)); PRef p = kp->p; MY_TID(tid);
#define PH_END_IF(k, cond) } if ((cond) && (k) + 1 < ph_hi) { MY_TID(t1); xcd_barrier(bar, t1 == 0, XB_ST(lds_raw)); } }
#ifndef REP_CVT
#define REP_CVT 0
#endif
#ifndef REP_BAR
#define REP_BAR 0
#endif
#define PH_END(k) } if ((k) + 1 < ph_hi) { for (int rb_ = 0; rb_ < 1 + REP_BAR; ++rb_) { MY_TID(t1); xcd_barrier(bar, t1 == 0, XB_ST(lds_raw)); } } }
    PH_BEGIN(0)
        phase_adaln(tid, p, lds);
        run_items<b_lb>(tid, p, 0, 2L * 384, 0);
        phase_convert(tid, p, 0, lds, 1, 0);
    PH_END(0)
#define LAYER(l)                                                                                                                                     \
    PH_BEGIN(1 + (l) * NPL + 0) if ((l) == 0) { phase_rows<0>(tid, p, 0, lds); } PH_END_IF(1 + (l) * NPL + 0, (l) == 0)                                 \
    PH_BEGIN(1 + (l) * NPL + 1) {                                                                                                                    \
        pg8::Gemm g{p.H, p.WIN_T + WBOFF(l), NTOK, INC, D, nullptr, 0, 1, 0}; pg8::StaticOrder S; S.init(NTOK, INC, G, (int)blockIdx.x);                         \
        pg8::EpiP E{p.P, INC, p.q_norm + (l) * HD, p.k_norm + (l) * HD, rep_};                                                    \
        pg8::gemm_phase<pg8::EpiP, false>(tid, lds, g, S, E);                                                                                     \
        } PH_END(1 + (l) * NPL + 1)               \
    PH_BEGIN(1 + (l) * NPL + 2) if constexpr (!FUSE_QK) { phase_qkprep(tid, p, l); } if constexpr (FAST_HGRN && (HGRN_DIAG == 3 || HGRN_DIAG == 4)) { phase_hgrn_local(tid, p, l, lds); { MY_TID(t7); run_items<b_hgrn_local_slow>(t7, p, l, 2L * NBH * NCH * 64, 0); } } else if constexpr (FAST_HGRN && HGRN_DIAG >= 2) { run_items<b_hgrn_local_slow>(tid, p, l, 2L * NBH * NCH * 64, 0); } else if constexpr (FAST_HGRN) { for (int r2_ = 0; r2_ < 1 + REP_LOCAL; ++r2_) phase_hgrn_local(tid, p, l, lds); } else { run_items<b_gates>(tid, p, l, (long)NTOK * 768, 0); } phase_conv(tid, p, l); PH_END(1 + (l) * NPL + 2) \
    PH_BEGIN(1 + (l) * NPL + 3) if constexpr (FAST_HGRN && HGRN_DIAG) { run_items<b_hgrn_scan_slow>(tid, p, l, 2L * NBH * 4096, 0); } else if constexpr (FAST_HGRN) { phase_hgrn_scan(tid, p); } else { run_items<b_hgrn_seq2>(tid, p, l, 2L * NB * HGH * 64, 0); } if constexpr (FAST_ATTN) { for (int r4_ = 0; r4_ < 1 + REP_ATTN; ++r4_) { MY_TID(t6); phase_attn(t6, p, l, lds); } } else { run_items<b_attn>(tid, p, l, (long)NTOK * NAH, 0); } PH_END(1 + (l) * NPL + 3) \
    PH_BEGIN(1 + (l) * NPL + 4) if constexpr (FAST_HGRN && HGRN_DIAG) { run_items<b_hgrn_chunkseq>(tid, p, l, 2L * NBH * NCH * 64, 0); { MY_TID(t9); xcd_barrier(bar, t9 == 0, XB_ST(lds_raw)); } { MY_TID(t8); run_items<b_hgfin>(t8, p, l, (long)NTOK * HGH, 0); } } else if constexpr (FAST_HGRN) { phase_hgrn_out(tid, p, l, lds); } else { run_items<b_hgfin>(tid, p, l, (long)NTOK * HGH, 0); } PH_END(1 + (l) * NPL + 4)                                         \
    PH_BEGIN(1 + (l) * NPL + 5) {                                                                                                                    \
        pg8::Gemm g{p.MIX, p.WOUT_T + WBOFF(l), NLAT, D, MIXD, nullptr, 0, 1, 0}; pg8::StaticOrder S; S.init(NLAT, D, G, (int)blockIdx.x);                       \
        pg8::EpiRes E{p.XB, D, p.MOD + (size_t)(l) * 3 * NMOD + 2 * D, SEQ, (size_t)NMOD};                                                           \
        pg8::gemm_phase<pg8::EpiRes, false>(tid, lds, g, S, E);                                                                                      \
        if ((l) + 1 < DEPTH) { MY_TID(tid2); mini_gemm<1>(tid2, p, l); } } PH_END(1 + (l) * NPL + 5)                  \
    PH_BEGIN(1 + (l) * NPL + 6) phase_rows<1>(tid, p, l, lds); PH_END(1 + (l) * NPL + 6)                                                               \
    PH_BEGIN(1 + (l) * NPL + 7) if constexpr (FAST_TOPK) { phase_topk(tid, p, lds); if ((l) == 0 && gridDim.x > 2 * NB * NE + 32) { MY_TID(t4); phase_convert(t4, p, 0, lds, 2, 2 * NB * NE); } else if ((l) == 0) { MY_TID(t4); phase_convert(t4, p, 0, lds, 2, 0); } else if ((l) + 1 < DEPTH) { MY_TID(t4); phase_convert(t4, p, (l) + 1, lds, 0, gridDim.x > 2 * NB * NE + 32 ? 2 * NB * NE : 0); } } else { run_items<b_rank>(tid, p, l, (long)NTOK * NE, 0); } PH_END(1 + (l) * NPL + 7)                                          \
    PH_BEGIN(1 + (l) * NPL + 8) {                                                                                                                    \
        pg8::Gemm g{p.H, p.WGU_T + WBOFF(l), NSLOT_L, 2 * ED, D, p.STOK, CAPL / 256, NE, (size_t)2 * ED * D * 2}; pg8::StaticOrder S; S.init(NSLOT_L, 2 * ED, G, (int)blockIdx.x); \
        pg8::EpiHid E{p.HID, ED};                                                                                                                    \
        pg8::gemm_phase<pg8::EpiHid, true>(tid, lds, g, S, E);                                                                                       \
        if ((l) + 1 < DEPTH) { MY_TID(tid2); mini_gemm<2>(tid2, p, l); } } PH_END(1 + (l) * NPL + 8)              \
    PH_BEGIN(1 + (l) * NPL + 9) {                                                                                                                    \
        pg8::Gemm g{p.HID, p.WD_T + WBOFF(l), NSLOT_L, D, ED, nullptr, CAPL / 256, NE, (size_t)D * ED * 2}; pg8::StaticOrder S; S.init(NSLOT_L, D, G, (int)blockIdx.x); \
        pg8::EpiBf16 E{p.Y, D, p.SVAL, 0};                                                                                                              \
        pg8::gemm_phase<pg8::EpiBf16, false>(tid, lds, g, S, E);                                                                                     \
        if ((l) + 1 < DEPTH) { MY_TID(tid2); mini_gemm<3>(tid2, p, l); } } PH_END(1 + (l) * NPL + 9)                \
    PH_BEGIN(1 + (l) * NPL + 10) phase_rows<2>(tid, p, l, lds); if ((l) == 0) { for (int rc_ = 0; rc_ < 1 + REP_CVT; ++rc_) { MY_TID(t5); phase_convert(t5, p, (l) + 1, lds); } }        PH_END(1 + (l) * NPL + 10)
#ifndef NLAYERS_BUILD
#define NLAYERS_BUILD DEPTH
#endif
    LAYER(0)
    if constexpr (NLAYERS_BUILD > 1) { LAYER(1) }
    if constexpr (NLAYERS_BUILD > 2) { LAYER(2) }
    if constexpr (NLAYERS_BUILD > 3) { LAYER(3) }
}

#ifndef MK_SPLIT
#define MK_SPLIT 0
#endif
extern "C" void kernel_launch(void* const* d_in, const int* in_sizes, int n_in, void* d_out, int out_size, void* d_ws, size_t ws_size,
                              hipStream_t stream) {
    static int grid = 0;
    if (grid == 0) {
        if (n_in != 20 || out_size != NLAT * D || ws_size < WS_END) { fprintf(stderr, "kernel_launch: unexpected problem (n_in %d out %d ws %zu need %zu)\n", n_in, out_size, ws_size, (size_t)WS_END); grid = -1; return; }
        int dev = 0, cus = 0;
        if (hipGetDevice(&dev) != hipSuccess || hipDeviceGetAttribute(&cus, hipDeviceAttributeMultiprocessorCount, dev) != hipSuccess) { grid = -1; return; }
        if (hipFuncSetAttribute((const void*)mega_fwd, hipFuncAttributeMaxDynamicSharedMemorySize, LDS_BYTES) != hipSuccess) { fprintf(stderr, "kernel_launch: hipFuncSetAttribute failed\n"); grid = -1; return; }
        int per_cu = 0;
        if (hipOccupancyMaxActiveBlocksPerMultiprocessor(&per_cu, (const void*)mega_fwd, NTHR, LDS_BYTES) != hipSuccess || per_cu < 1) { fprintf(stderr, "kernel_launch: occupancy query says %d\n", per_cu); }
        (void)hipGetLastError();
        grid = cus;
    }
    if (grid < 0) return;
    (void)hipMemsetAsync((char*)d_ws + WS_CTL, 0, WS_LB - WS_CTL, stream);
    Args a{};
    a.p = make_params(d_in, d_out, d_ws);
#if MK_SPLIT
    for (int ph = 0; ph < NPH; ++ph) { a.ph_lo = ph; a.ph_hi = ph + 1; hipLaunchKernelGGL(mega_fwd, dim3(grid), dim3(NTHR), LDS_BYTES, stream, a); }
#else
    a.ph_lo = 0; a.ph_hi = NPH;
    hipLaunchKernelGGL(mega_fwd, dim3(grid), dim3(NTHR), LDS_BYTES, stream, a);
#endif
}
#endif
```

```cpp
#ifndef CPU_SIM
#include <hip/hip_runtime.h>
#define BODY __device__ __forceinline__
#define FSIN(x) __sinf(x)
#define FCOS(x) __cosf(x)
#else
#include <cmath>
#include <cstdio>
#include <cstdlib>
#include <cstring>
#define BODY static inline
#define FSIN(x) sinf(x)
#define FCOS(x) cosf(x)
#endif
#include <stdint.h>
#include <stddef.h>

#ifndef CFG_D
#define CFG_D 1024
#define CFG_SEQ 16384
#define CFG_CTX 256
#define CFG_EDIM 512
#define CFG_DEPTH 4
#endif

typedef unsigned short bf16_t;

constexpr int D = CFG_D, NB = 2, SEQ = CFG_SEQ, DEPTH = CFG_DEPTH, GW = 64, ROWS = SEQ / GW, CTX = CFG_CTX;
constexpr int HD = 64, NAH = 6, HGH = 6, CVD = 256, MIXD = 1024, INC = 3840, NMOD = 6 * D;
constexpr int NE = 16, ED = CFG_EDIM, CAPL = 2 * SEQ / NE, CAPC = 2 * CTX / NE;
constexpr int NLAT = NB * SEQ, NCTX = NB * CTX, NTOK = NLAT + NCTX;
constexpr int NSLOT_L = NB * NE * CAPL, NSLOT_C = NB * NE * CAPC, NSLOT = NSLOT_L + NSLOT_C;
constexpr int OQ = 0, OK_ = 384, OV = 768, OHQ = 1152, OFF_ = 1536, OFB = 1920, OHI = 2304, OHG_ = 2688, OCB = 3072, OCC = 3328, OCU = 3584;
constexpr float EPS = 1e-6f;
constexpr int NCH = (CTX + SEQ) / 64, NCHC = CTX / 64, NBH = NB * HGH;

struct Params {
    const float *x, *c, *ctx, *c_ctx, *w_mod, *b_mod, *norm1_w, *w_in, *q_norm, *k_norm, *rpb, *lb_logits, *hg_norm, *conv_w, *w_out,
        *norm2_w, *w_router, *w_gate, *w_up, *w_down;
    float *XL, *XC, *MOD, *LB, *AFF, *SVAL, *FG, *OHG;
    bf16_t *H, *P, *MIX, *HID, *Y;
    int *STOK, *INV;
    bf16_t *WIN_T, *WOUT_T, *WGU_T, *WD_T;
    unsigned* CTL;
    bf16_t* SLOC;
    float* GDEC;
    bf16_t* XB;
};

#ifndef CPU_SIM
#define AS4 __attribute__((address_space(4)))
typedef const AS4 Params& PRef;
#else
typedef const Params& PRef;
#endif
BODY float bf2f(bf16_t v) { return __builtin_bit_cast(float, (unsigned)v << 16); }
BODY bf16_t f2bf(float f) { unsigned u = __builtin_bit_cast(unsigned, f); u += 0x7fffu + ((u >> 16) & 1u); return (bf16_t)(u >> 16); }
BODY float silu_f(float x) { return x / (1.f + expf(-x)); }
BODY float sigmoid_f(float x) { return 1.f / (1.f + expf(-x)); }
BODY int modset(int r) { return r < NLAT ? r / SEQ : 2; }
BODY float* xrow(PRef p, int r) { return r < NLAT ? p.XL + (size_t)r * D : p.XC + (size_t)(r - NLAT) * D; }

BODY void b_adaln(long gid, PRef p, int) {
    const int n = (int)(gid % NMOD), s = (int)((gid / NMOD) % 3), l = (int)(gid / (3 * NMOD));
    const float* cv = s < 2 ? p.c + s * D : p.c_ctx;
    const float* w = p.w_mod + (size_t)l * D * NMOD + n;
    float acc = 0.f;
    for (int k = 0; k < D; ++k) acc += silu_f(cv[k]) * w[(size_t)k * NMOD];
    p.MOD[gid] = acc + p.b_mod[l * NMOD + n];
}
BODY void b_lb(long gid, PRef p, int) {
    const int dir = (int)(gid / 384), j = (int)(gid % 384);
    const float* lg = p.lb_logits + (size_t)dir * DEPTH * 384 + j;
    float m = -INFINITY;
    for (int l = 0; l < DEPTH; ++l) m = fmaxf(m, lg[l * 384]);
    float s = 0.f;
    for (int l = 0; l < DEPTH; ++l) s += expf(lg[l * 384] - m);
    float cum = 0.f;
    p.LB[(dir * DEPTH + 0) * 384 + j] = 0.f;
    for (int l = 1; l < DEPTH; ++l) { cum += expf(lg[l * 384] - m) / s; p.LB[(dir * DEPTH + l) * 384 + j] = cum; }
}
BODY void b_copyx(long gid, PRef p, int) {
    if (gid < (long)NLAT * D) p.XL[gid] = p.x[gid]; else p.XC[gid - (long)NLAT * D] = p.ctx[gid - (long)NLAT * D];
}
template <int WHICH> BODY void b_prenorm(long gid, PRef p, int l) {
    const int r = (int)gid;
    const float* xr = xrow(p, r);
    const float* nw = (WHICH ? p.norm2_w : p.norm1_w) + l * D;
    const float* mod = p.MOD + ((size_t)l * 3 + modset(r)) * NMOD;
    const float* shift = mod + (WHICH ? 3 : 0) * D;
    const float* scale = mod + (WHICH ? 4 : 1) * D;
    float ss = 0.f;
    for (int k = 0; k < D; ++k) ss += xr[k] * xr[k];
    const float rstd = 1.f / sqrtf(ss / D + EPS);
    float lg[NE];
#pragma unroll
    for (int e = 0; e < NE; ++e) lg[e] = 0.f;
    for (int k = 0; k < D; ++k) {
        const float h = xr[k] * rstd * nw[k] * (1.f + scale[k]) + shift[k];
        p.H[(size_t)r * D + k] = f2bf(h);
        if (WHICH) {
            const float* wr = p.w_router + ((size_t)l * D + k) * NE;
#pragma unroll
            for (int e = 0; e < NE; ++e) lg[e] += h * wr[e];
        }
    }
    if (WHICH) {
        float m = lg[0];
#pragma unroll
        for (int e = 1; e < NE; ++e) m = fmaxf(m, lg[e]);
        float s = 0.f;
#pragma unroll
        for (int e = 0; e < NE; ++e) { lg[e] = expf(lg[e] - m); s += lg[e]; }
#pragma unroll
        for (int e = 0; e < NE; ++e) p.AFF[(size_t)r * NE + e] = lg[e] / s;
    }
}
BODY void b_gemm_in(long gid, PRef p, int l) {
    const int r = (int)(gid / (INC / 4)), n = (int)(gid % (INC / 4)) * 4;
    const bf16_t* a = p.H + (size_t)r * D;
    const float* w = p.w_in + (size_t)l * D * INC + n;
    float a0 = 0.f, a1 = 0.f, a2 = 0.f, a3 = 0.f;
    for (int k = 0; k < D; ++k) { const float av = bf2f(a[k]); const float* wk = w + (size_t)k * INC; a0 += av * wk[0]; a1 += av * wk[1]; a2 += av * wk[2]; a3 += av * wk[3]; }
    bf16_t* o = p.P + (size_t)r * INC + n;
    o[0] = f2bf(a0); o[1] = f2bf(a1); o[2] = f2bf(a2); o[3] = f2bf(a3);
}
BODY void b_qkprep(long gid, PRef p, int l) {
    const int r = (int)(gid / 12), which = (int)(gid % 12) / 6, head = (int)(gid % 6);
    bf16_t* ptr = p.P + (size_t)r * INC + (which ? OK_ : OQ) + head * HD;
    const float* nw = (which ? p.k_norm : p.q_norm) + l * HD;
    float y[HD];
    float ss = 0.f;
#pragma unroll
    for (int d = 0; d < HD; ++d) { y[d] = bf2f(ptr[d]); ss += y[d] * y[d]; }
    const float rstd = 1.f / sqrtf(ss / HD + EPS);
#pragma unroll
    for (int d = 0; d < HD; ++d) y[d] = y[d] * rstd * nw[d];
    if (r < NLAT) {
        const int t = r % SEQ; const float row = (float)(t / GW), col = (float)(t % GW);
#pragma unroll
        for (int d = 0; d < 16; ++d) {
            const float inv = powf(10000.f, -(float)d / 16.f);
            const float ar = row * inv, ac = col * inv;
            const float cr = FCOS(ar), sr = FSIN(ar), cc = FCOS(ac), sc = FSIN(ac);
            const float x0 = y[d], x1 = y[d + 16], x2 = y[d + 32], x3 = y[d + 48];
            y[d] = x0 * cr - x1 * sr; y[d + 16] = x1 * cr + x0 * sr; y[d + 32] = x2 * cc - x3 * sc; y[d + 48] = x3 * cc + x2 * sc;
        }
    }
#pragma unroll
    for (int d = 0; d < HD; ++d) ptr[d] = f2bf(y[d]);
}
BODY void b_attn(long gid, PRef p, int l) {
    const int r = (int)(gid / NAH), head = (int)(gid % NAH);
    float q[HD], acc[HD];
    const bf16_t* qp = p.P + (size_t)r * INC + OQ + head * HD;
#pragma unroll
    for (int d = 0; d < HD; ++d) { q[d] = bf2f(qp[d]) * 0.125f; acc[d] = 0.f; }
    float m = -INFINITY, s = 0.f;
    const int b = r < NLAT ? r / SEQ : (r - NLAT) / CTX;
    const int nloc = r < NLAT ? 128 : 0;
    int row = 0, col = 0, rs = 0, ws = 0;
    if (r < NLAT) { const int t = r % SEQ; row = t / GW; col = t % GW; rs = row - 4; rs = rs < 0 ? 0 : (rs > ROWS - 8 ? ROWS - 8 : rs); ws = col - 8; ws = ws < 0 ? 0 : (ws > GW - 16 ? GW - 16 : ws); }
    for (int j = 0; j < nloc + CTX; ++j) {
        int kr; float bias = 0.f;
        if (j < nloc) { const int i = j / 16, jj = j % 16; kr = b * SEQ + (rs + i) * GW + ws + jj; bias = p.rpb[(((size_t)l * NAH + head) * 15 + (rs + i - row + 7)) * 31 + (ws + jj - col + 15)]; }
        else kr = NLAT + b * CTX + (j - nloc);
        const bf16_t* kp = p.P + (size_t)kr * INC + OK_ + head * HD;
        const bf16_t* vp = p.P + (size_t)kr * INC + OV + head * HD;
        float sc = 0.f;
#pragma unroll
        for (int d = 0; d < HD; ++d) sc += q[d] * bf2f(kp[d]);
        sc += bias;
        const float mn = fmaxf(m, sc), corr = expf(m - mn), pj = expf(sc - mn);
        s = s * corr + pj;
#pragma unroll
        for (int d = 0; d < HD; ++d) acc[d] = acc[d] * corr + pj * bf2f(vp[d]);
        m = mn;
    }
    const float inv = 1.f / s;
    bf16_t* o = p.MIX + (size_t)r * MIXD + head * HD;
#pragma unroll
    for (int d = 0; d < HD; ++d) o[d] = f2bf(acc[d] * inv);
}
BODY void b_gates(long gid, PRef p, int l) {
    const int j = (int)(gid % 384), dir = (int)((gid / 384) % 2), r = (int)(gid / 768);
    const float z = bf2f(p.P[(size_t)r * INC + (dir ? OFB : OFF_) + j]);
    const float lbv = p.LB[(dir * DEPTH + l) * 384 + j];
    p.FG[gid] = lbv + (1.f - lbv) * sigmoid_f(z);
}
template <int DIR> BODY void b_hgrn_seq(long gid, PRef p, int) {
    const int v = (int)(gid % 64), h = (int)((gid / 64) % HGH), b = (int)(gid / (64 * HGH));
    float S[64];
#pragma unroll
    for (int k = 0; k < 64; ++k) S[k] = 0.f;
    for (int step = 0; step < CTX + SEQ; ++step) {
        int r;
        if (step < CTX) r = NLAT + b * CTX + (DIR ? CTX - 1 - step : step);
        else r = b * SEQ + (DIR ? SEQ - 1 - (step - CTX) : (step - CTX));
        const float vv = bf2f(p.P[(size_t)r * INC + OHI + h * 64 + v]);
        const float* fr = p.FG + ((size_t)r * 2 + DIR) * 384 + h * 64;
        const bf16_t* qr = p.P + (size_t)r * INC + OHQ + h * 64;
        float o = 0.f;
#pragma unroll
        for (int k = 0; k < 64; ++k) { const float f = fr[k]; S[k] = f * S[k] + (1.f - f) * vv; o += S[k] * bf2f(qr[k]); }
        o *= 0.125f;
        p.OHG[((size_t)DIR * NTOK + r) * 384 + h * 64 + v] = o;
    }
}
BODY void b_hgfin(long gid, PRef p, int l) {
    const int r = (int)(gid / HGH), h = (int)(gid % HGH);
    const float* op = p.OHG + (size_t)r * 384 + h * 64;
    const float* op1 = op + (size_t)NTOK * 384;
    float o[64]; float ss = 0.f;
#pragma unroll
    for (int v = 0; v < 64; ++v) { o[v] = op[v] + op1[v]; ss += o[v] * o[v]; }
    const float rstd = 1.f / sqrtf(ss / 64.f + EPS);
    const bf16_t* g = p.P + (size_t)r * INC + OHG_ + h * 64;
    bf16_t* out = p.MIX + (size_t)r * MIXD + 384 + h * 64;
#pragma unroll
    for (int v = 0; v < 64; ++v) out[v] = f2bf(o[v] * rstd * p.hg_norm[l * 64 + v] * silu_f(bf2f(g[v])));
}
BODY void b_conv(long gid, PRef p, int l) {
    const int ch = (int)(gid % CVD), r = (int)(gid / CVD);
    int t, T;
    if (r < NLAT) { t = r % SEQ; T = SEQ; } else { t = (r - NLAT) % CTX; T = CTX; }
    const float* w = p.conv_w + (size_t)l * 3 * CVD + ch;
    float y = 0.f;
    for (int j = 0; j < 3; ++j) {
        const int tt = t + j - 1;
        if (tt < 0 || tt >= T) continue;
        const bf16_t* pr = p.P + (size_t)(r + j - 1) * INC;
        y += w[j * CVD] * bf2f(pr[OCC + ch]) * bf2f(pr[OCU + ch]);
    }
    p.MIX[(size_t)r * MIXD + 768 + ch] = f2bf(bf2f(p.P[(size_t)r * INC + OCB + ch]) * y);
}
BODY void b_gemm_out(long gid, PRef p, int l) {
    const int r = (int)(gid / (D / 4)), n = (int)(gid % (D / 4)) * 4;
    const bf16_t* a = p.MIX + (size_t)r * MIXD;
    const float* w = p.w_out + (size_t)l * MIXD * D + n;
    float a0 = 0.f, a1 = 0.f, a2 = 0.f, a3 = 0.f;
    for (int k = 0; k < MIXD; ++k) { const float av = bf2f(a[k]); const float* wk = w + (size_t)k * D; a0 += av * wk[0]; a1 += av * wk[1]; a2 += av * wk[2]; a3 += av * wk[3]; }
    const float* g = p.MOD + ((size_t)l * 3 + modset(r)) * NMOD + 2 * D + n;
    float* xr = xrow(p, r) + n;
    xr[0] += g[0] * a0; xr[1] += g[1] * a1; xr[2] += g[2] * a2; xr[3] += g[3] * a3;
}
BODY void b_rank(long gid, PRef p, int) {
    const int e = (int)(gid % NE), r = (int)(gid / NE);
    int t, T, row0, cap, base;
    if (r < NLAT) { const int b = r / SEQ; t = r % SEQ; T = SEQ; row0 = b * SEQ; cap = CAPL; base = (b * NE + e) * CAPL; }
    else { const int b = (r - NLAT) / CTX; t = (r - NLAT) % CTX; T = CTX; row0 = NLAT + b * CTX; cap = CAPC; base = NSLOT_L + (b * NE + e) * CAPC; }
    const float a = p.AFF[(size_t)r * NE + e];
    const float* col = p.AFF + (size_t)row0 * NE + e;
    int rank = 0;
    for (int tt = 0; tt < T; ++tt) { const float o = col[(size_t)tt * NE]; rank += (o > a || (o == a && tt < t)) ? 1 : 0; }
    if (rank < cap) { p.STOK[base + rank] = r; p.SVAL[base + rank] = a; p.INV[(size_t)r * NE + e] = base + rank; }
    else p.INV[(size_t)r * NE + e] = -1;
}
BODY int slot_expert(int s) { return s < NSLOT_L ? (s / CAPL) % NE : ((s - NSLOT_L) / CAPC) % NE; }
BODY void b_moe1(long gid, PRef p, int l) {
    const int s = (int)(gid / (ED / 4)), f = (int)(gid % (ED / 4)) * 4;
    const int e = slot_expert(s); int row = p.STOK[s]; row = row < 0 ? 0 : (row >= NTOK ? NTOK - 1 : row);
    const bf16_t* a = p.H + (size_t)row * D;
    const float* wg = p.w_gate + ((size_t)l * NE + e) * D * ED + f;
    const float* wu = p.w_up + ((size_t)l * NE + e) * D * ED + f;
    float g0 = 0.f, g1 = 0.f, g2 = 0.f, g3 = 0.f, u0 = 0.f, u1 = 0.f, u2 = 0.f, u3 = 0.f;
    for (int k = 0; k < D; ++k) {
        const float av = bf2f(a[k]); const float* gk = wg + (size_t)k * ED; const float* uk = wu + (size_t)k * ED;
        g0 += av * gk[0]; g1 += av * gk[1]; g2 += av * gk[2]; g3 += av * gk[3];
        u0 += av * uk[0]; u1 += av * uk[1]; u2 += av * uk[2]; u3 += av * uk[3];
    }
    bf16_t* o = p.HID + (size_t)s * ED + f;
    o[0] = f2bf(silu_f(g0) * u0); o[1] = f2bf(silu_f(g1) * u1); o[2] = f2bf(silu_f(g2) * u2); o[3] = f2bf(silu_f(g3) * u3);
}
BODY void b_moe2(long gid, PRef p, int l) {
    const int s = (int)(gid / (D / 4)), n = (int)(gid % (D / 4)) * 4;
    const int e = slot_expert(s);
    const bf16_t* a = p.HID + (size_t)s * ED;
    const float* w = p.w_down + ((size_t)l * NE + e) * ED * D + n;
    float a0 = 0.f, a1 = 0.f, a2 = 0.f, a3 = 0.f;
    for (int k = 0; k < ED; ++k) { const float av = bf2f(a[k]); const float* wk = w + (size_t)k * D; a0 += av * wk[0]; a1 += av * wk[1]; a2 += av * wk[2]; a3 += av * wk[3]; }
    const float val = p.SVAL[s];
    bf16_t* o = p.Y + (size_t)s * D + n;
    o[0] = f2bf(val * a0); o[1] = f2bf(val * a1); o[2] = f2bf(val * a2); o[3] = f2bf(val * a3);
}
BODY void b_combine(long gid, PRef p, int l) {
    const int r = (int)(gid / (D / 4)), n = (int)(gid % (D / 4)) * 4;
    float a0 = 0.f, a1 = 0.f, a2 = 0.f, a3 = 0.f;
    for (int e = 0; e < NE; ++e) {
        const int s = p.INV[(size_t)r * NE + e];
        if (s >= 0) { const bf16_t* y = p.Y + (size_t)s * D + n; a0 += bf2f(y[0]); a1 += bf2f(y[1]); a2 += bf2f(y[2]); a3 += bf2f(y[3]); }
    }
    const float* g = p.MOD + ((size_t)l * 3 + modset(r)) * NMOD + 5 * D + n;
    float* xr = xrow(p, r) + n;
    xr[0] += g[0] * a0; xr[1] += g[1] * a1; xr[2] += g[2] * a2; xr[3] += g[3] * a3;
}


#ifndef HGRN_DIAG
#define HGRN_DIAG 0
#endif
BODY void b_hgrn_chunkseq(long gid, PRef p, int l) {
    const int v = (int)(gid % 64), pc = (int)((gid / 64) % NCH), bh = (int)((gid / (64 * NCH)) % NBH), dir = (int)(gid / (64L * NCH * NBH));
    const int h = bh % HGH, b = bh / HGH, row0 = pc < NCHC ? NLAT + b * CTX + pc * 64 : b * SEQ + (pc - NCHC) * 64;
    const bf16_t* sin = p.SLOC + ((size_t)(dir * NBH + bh) * NCH + pc) * 4096 + v * 64;
    float S[64];
#pragma unroll
    for (int k = 0; k < 64; ++k) S[k] = bf2f(sin[k]);
    for (int i = 0; i < 64; ++i) {
        const int r = row0 + (dir ? 63 - i : i);
        const float vv = bf2f(p.P[(size_t)r * INC + OHI + h * 64 + v]);
        const bf16_t* zr = p.P + (size_t)r * INC + (dir ? OFB : OFF_) + h * 64;
        const bf16_t* qr = p.P + (size_t)r * INC + OHQ + h * 64;
        const float* lb = p.LB + (size_t)(dir * DEPTH + l) * 384 + h * 64;
        float o = 0.f;
#pragma unroll
        for (int k = 0; k < 64; ++k) { const float f = lb[k] + (1.f - lb[k]) * sigmoid_f(bf2f(zr[k])); S[k] = f * S[k] + (1.f - f) * vv; o += S[k] * bf2f(qr[k]); }
        p.OHG[((size_t)dir * NTOK + r) * 384 + h * 64 + v] = o * 0.125f;
    }
}

BODY void b_hgrn_scan_slow(long gid, PRef p, int) {
    const int e = (int)(gid % 4096), sq = (int)(gid / 4096), dir = sq / NBH, k = e & 63;
    bf16_t* S = p.SLOC + (size_t)sq * NCH * 4096 + e;
    const float* G = p.GDEC + (size_t)sq * NCH * 64 + k;
    float c = 0.f;
    for (int j = 0; j < NCH; ++j) {
        const int pc = dir ? (j < NCHC ? NCHC - 1 - j : NCH + NCHC - 1 - j) : j;
        const float x = bf2f(S[(size_t)pc * 4096]);
        S[(size_t)pc * 4096] = f2bf(c);
        c = G[(size_t)pc * 64] * c + x;
    }
}

BODY void b_hgrn_local_slow(long gid, PRef p, int l) {
    const int v = (int)(gid % 64), pc = (int)((gid / 64) % NCH), bh = (int)((gid / (64 * NCH)) % NBH), dir = (int)(gid / (64L * NCH * NBH));
    const int h = bh % HGH, b = bh / HGH, row0 = pc < NCHC ? NLAT + b * CTX + pc * 64 : b * SEQ + (pc - NCHC) * 64;
    float S[64], g[64];
#pragma unroll
    for (int k = 0; k < 64; ++k) { S[k] = 0.f; g[k] = 1.f; }
    for (int i = 0; i < 64; ++i) {
        const int r = row0 + (dir ? 63 - i : i);
        const float vv = bf2f(p.P[(size_t)r * INC + OHI + h * 64 + v]);
        const bf16_t* zr = p.P + (size_t)r * INC + (dir ? OFB : OFF_) + h * 64;
        const float* lb = p.LB + (size_t)(dir * DEPTH + l) * 384 + h * 64;
#pragma unroll
        for (int k = 0; k < 64; ++k) { const float f = lb[k] + (1.f - lb[k]) * sigmoid_f(bf2f(zr[k])); S[k] = f * S[k] + (1.f - f) * vv; g[k] *= f; }
    }
    bf16_t* dst = p.SLOC + ((size_t)(dir * NBH + bh) * NCH + pc) * 4096 + v * 64;
    if (HGRN_DIAG != 3 && HGRN_DIAG != 4) {
#pragma unroll
    for (int k = 0; k < 64; ++k) dst[k] = f2bf(S[k]);
    }
    if (v == 0) {
        float* gd = p.GDEC + ((size_t)(dir * NBH + bh) * NCH + pc) * 64;
#pragma unroll
        for (int k = 0; k < 64; ++k) gd[k] = g[k];
    }
}
#ifndef FAST_TOPK
#define FAST_TOPK 1
#endif
#ifndef FAST_HGRN
#define FAST_HGRN 1
#endif
#ifndef FAST_ATTN
#define FAST_ATTN 1
#endif
constexpr size_t al256(size_t x) { return (x + 255) & ~(size_t)255; }
constexpr size_t CTL_BYTES = 65536;
constexpr size_t WS_CTL = 0;
constexpr size_t WS_MOD = WS_CTL + CTL_BYTES;
constexpr size_t WS_LB = WS_MOD + al256((size_t)DEPTH * 3 * NMOD * 4);
constexpr size_t WS_XC = WS_LB + al256((size_t)2 * DEPTH * 384 * 4);
constexpr size_t WS_AFF = WS_XC + al256((size_t)NCTX * D * 4);
constexpr size_t WS_SVAL = WS_AFF + al256((size_t)NTOK * NE * 4);
constexpr size_t WS_STOK = WS_SVAL + al256((size_t)NSLOT * 4);
constexpr size_t WS_INV = WS_STOK + al256((size_t)NSLOT * 4);
constexpr size_t WS_H = WS_INV + al256((size_t)NTOK * NE * 4);
constexpr size_t WS_MIX = WS_H + al256((size_t)NTOK * D * 2);
constexpr size_t WS_P = WS_MIX + al256((size_t)NTOK * MIXD * 2);
constexpr size_t WS_HID = WS_P;
constexpr size_t WS_Y = WS_HID + al256((size_t)NSLOT * ED * 2);
constexpr size_t WS_P_END0 = WS_P + al256((size_t)NTOK * INC * 2);
constexpr size_t WS_P_END1 = WS_Y + al256((size_t)NSLOT * D * 2);
constexpr size_t WS_WB = WS_P_END0 > WS_P_END1 ? WS_P_END0 : WS_P_END1;
constexpr size_t WS_WIN_T = WS_WB;
constexpr size_t WS_WOUT_T = WS_WIN_T + al256((size_t)INC * D * 2);
constexpr size_t WS_WGU_T = WS_WOUT_T + al256((size_t)D * MIXD * 2);
constexpr size_t WS_WD_T = WS_WGU_T + al256((size_t)NE * 2 * ED * D * 2);
constexpr size_t WB_BYTES = WS_WD_T + al256((size_t)NE * D * ED * 2) - WS_WB;
constexpr size_t WS_T = WS_WB + 2 * WB_BYTES;
#if FAST_HGRN
constexpr size_t WS_SLOC = WS_T;
constexpr size_t WS_GDEC = WS_SLOC + al256((size_t)2 * NBH * NCH * 4096 * 2);
constexpr size_t WS_OHG = WS_GDEC + al256((size_t)2 * NBH * NCH * 64 * 4);
constexpr size_t WS_XB = WS_OHG + (HGRN_DIAG ? al256((size_t)2 * NTOK * 384 * 4) : 0);
constexpr size_t WS_END = WS_XB + al256((size_t)NLAT * D * 2);
constexpr size_t WS_FG = WS_T;
#else
constexpr size_t WS_FG = WS_T;
constexpr size_t WS_OHG = WS_FG + al256((size_t)NTOK * 768 * 4);
constexpr size_t WS_SLOC = WS_OHG + al256((size_t)2 * NTOK * 384 * 4);
constexpr size_t WS_GDEC = WS_SLOC;
constexpr size_t WS_XB = WS_SLOC;
constexpr size_t WS_END = WS_XB + al256((size_t)NLAT * D * 2);
#endif

static inline Params make_params(void* const* d_in, void* d_out, void* d_ws) {
    Params p{};
    const float** f = (const float**)&p;
    for (int i = 0; i < 20; ++i) f[i] = (const float*)d_in[i];
    char* ws = (char*)d_ws;
    p.XL = (float*)d_out; p.XC = (float*)(ws + WS_XC); p.MOD = (float*)(ws + WS_MOD); p.LB = (float*)(ws + WS_LB); p.AFF = (float*)(ws + WS_AFF);
    p.SVAL = (float*)(ws + WS_SVAL); p.FG = (float*)(ws + WS_FG); p.OHG = (float*)(ws + WS_OHG);
    p.H = (bf16_t*)(ws + WS_H); p.P = (bf16_t*)(ws + WS_P); p.MIX = (bf16_t*)(ws + WS_MIX); p.HID = (bf16_t*)(ws + WS_HID); p.Y = (bf16_t*)(ws + WS_Y);
    p.STOK = (int*)(ws + WS_STOK); p.INV = (int*)(ws + WS_INV);
    p.WIN_T = (bf16_t*)(ws + WS_WIN_T); p.WOUT_T = (bf16_t*)(ws + WS_WOUT_T); p.WGU_T = (bf16_t*)(ws + WS_WGU_T); p.WD_T = (bf16_t*)(ws + WS_WD_T);
    p.CTL = (unsigned*)(ws + WS_CTL); p.SLOC = (bf16_t*)(ws + WS_SLOC); p.GDEC = (float*)(ws + WS_GDEC); p.XB = (bf16_t*)(ws + WS_XB);
    return p;
}

#define FORWARD_STAGES(STAGE)                                                      \
    STAGE(b_adaln, (long)DEPTH * 3 * NMOD, 0)                                      \
    STAGE(b_lb, 2L * 384, 0)                                                       \
    STAGE(b_copyx, (long)NTOK * D, 0)                                              \
    for (int l = 0; l < DEPTH; ++l) {                                              \
        STAGE(b_prenorm<0>, (long)NTOK, l)                                         \
        STAGE(b_gemm_in, (long)NTOK * (INC / 4), l)                                \
        STAGE(b_qkprep, (long)NTOK * 12, l)                                        \
        STAGE(b_attn, (long)NTOK * NAH, l)                                         \
        STAGE(b_gates, (long)NTOK * 768, l)                                        \
        STAGE(b_hgrn_seq<0>, (long)NB * HGH * 64, l)                               \
        STAGE(b_hgrn_seq<1>, (long)NB * HGH * 64, l)                               \
        STAGE(b_hgfin, (long)NTOK * HGH, l)                                        \
        STAGE(b_conv, (long)NTOK * CVD, l)                                         \
        STAGE(b_gemm_out, (long)NTOK * (D / 4), l)                                 \
        STAGE(b_prenorm<1>, (long)NTOK, l)                                         \
        STAGE(b_rank, (long)NTOK * NE, l)                                          \
        STAGE(b_moe1, (long)NSLOT * (ED / 4), l)                                   \
        STAGE(b_moe2, (long)NSLOT * (D / 4), l)                                    \
        STAGE(b_combine, (long)NTOK * (D / 4), l)                                  \
    }

#ifndef CPU_SIM
#include <cstdio>
#define LAS __attribute__((address_space(3)))
#define GAS __attribute__((address_space(1)))
typedef short bf16x8 __attribute__((ext_vector_type(8)));
typedef float f32x4 __attribute__((ext_vector_type(4)));
typedef float f32x2 __attribute__((ext_vector_type(2)));
typedef unsigned u32x4 __attribute__((ext_vector_type(4)));
typedef unsigned u32x2 __attribute__((ext_vector_type(2)));
constexpr int NWAVES = 8, NTHR = 512;
constexpr int RING_BYTES = 131072, LDSCTL_OFF = RING_BYTES, MISC_OFF = LDSCTL_OFF + 320, TAB_OFF = LDSCTL_OFF + 1024  , LDS_BYTES = 147456;

typedef __bf16 bf16v2_t __attribute__((ext_vector_type(2)));
__device__ __forceinline__ unsigned cvt_pk_bf16_asm(float lo, float hi) { unsigned r; asm volatile("v_cvt_pk_bf16_f32 %0, %1, %2" : "=v"(r) : "v"(lo), "v"(hi)); return r; }
__device__ __forceinline__ unsigned cvt_pk_bf16(float lo, float hi) { bf16v2_t v = {(__bf16)lo, (__bf16)hi}; return __builtin_bit_cast(unsigned, v); }
#define DPPF(x, ctrl) __builtin_bit_cast(float, __builtin_amdgcn_update_dpp(0, __builtin_bit_cast(int, (x)), (ctrl), 0xF, 0xF, true))
#define DPP_X1 0xB1
#define DPP_X2 0x4E
#define DPP_HM 0x141
#define DPP_RM 0x140
__device__ __forceinline__ float x16_other(float x, int lane) { const unsigned u = __builtin_bit_cast(unsigned, x); const auto r = __builtin_amdgcn_permlane16_swap(u, u, false, false); return __builtin_bit_cast(float, (lane & 16) ? r[0] : r[1]); }
__device__ __forceinline__ float x32_other(float x, int lane) { const unsigned u = __builtin_bit_cast(unsigned, x); const auto r = __builtin_amdgcn_permlane32_swap(u, u, false, false); return __builtin_bit_cast(float, (lane & 32) ? r[0] : r[1]); }
__device__ __forceinline__ float x16_sum(float x, int lane) { return x + x16_other(x, lane); }
__device__ __forceinline__ float x32_sum(float x, int lane) { return x + x32_other(x, lane); }
__device__ __forceinline__ float x16_max(float x, int lane) { return fmaxf(x, x16_other(x, lane)); }
__device__ __forceinline__ float x32_max(float x, int lane) { return fmaxf(x, x32_other(x, lane)); }
__device__ __forceinline__ float row16_sum(float v) { v += DPPF(v, DPP_X1); v += DPPF(v, DPP_X2); v += DPPF(v, DPP_HM); v += DPPF(v, DPP_RM); return v; }
__device__ __forceinline__ float row16_max(float v) { v = fmaxf(v, DPPF(v, DPP_X1)); v = fmaxf(v, DPPF(v, DPP_X2)); v = fmaxf(v, DPPF(v, DPP_HM)); v = fmaxf(v, DPPF(v, DPP_RM)); return v; }
__device__ __forceinline__ float oct_sum(float v) { v += DPPF(v, DPP_X1); v += DPPF(v, DPP_X2); v += DPPF(v, DPP_HM); return v; }
__device__ __forceinline__ float wave_sum(float v, int lane) { return x32_sum(x16_sum(row16_sum(v), lane), lane); }

extern __shared__ __attribute__((aligned(16))) unsigned char lds_raw[];
#ifndef FUSE_QK
#define FUSE_QK 1
#endif
__device__ __forceinline__ float bfw(unsigned w, int hi) { return __builtin_bit_cast(float, hi ? (w & 0xffff0000u) : (w << 16)); }
__device__ __forceinline__ float bf8(const u32x4& v, int j) { return bfw(v[j >> 1], j & 1); }
namespace pg8 {
constexpr int BM = 256, BK = 64, HALF = 128, HTB = HALF * BK * 2, STAGE_BYTES = 8 * HTB, NXCD = 8, WGM = 8;
__device__ __forceinline__ int lds_byte(int r, int c) { const int st = (r >> 4) * 2 + (c >> 5), rr = r & 15, cc = c & 31, ob = rr * 64 + cc * 2; return st * 1024 + (ob ^ (((ob >> 9) & 1) << 5)); }
__device__ __forceinline__ void stage_rc(int b, int& R, int& C) { const int st = b / 1024, sb = b % 1024, swz = sb ^ (((sb >> 9) & 1) << 5); R = (st >> 1) * 16 + swz / 64; C = (st & 1) * 32 + (swz % 64) / 2; }
__device__ __forceinline__ int perm32(int rho) { const int n = rho >> 4, i = rho & 15; return 8 * (i >> 2) + 4 * n + (i & 3); }
struct Unit { int pm, pn; };
struct Gemm {
    const bf16_t* A; const bf16_t* Bt; int M, N, K;
    const int* gather;
    int gt, ng; size_t gstride;
};
struct StaticOrder {
    int nM, nN, nwg, G, c;
    __device__ void init(int M, int N, int G_, int c_) { nM = M / BM; nN = N / BM; nwg = nM * nN; G = G_; c = c_; }
    __device__ bool next(int i, Unit& u) const {
        const long L = (long)i * G + c; if (L >= nwg) return false;
        int wgid = (int)L; { const int q = nwg / NXCD, r = nwg % NXCD, xcd = wgid % NXCD, off = wgid / NXCD; wgid = (xcd < r ? xcd * (q + 1) : r * (q + 1) + (xcd - r) * q) + off; }
        const int nig = WGM * nN, gid = wgid / nig, fm = gid * WGM, gsz = (nM - fm) < WGM ? (nM - fm) : WGM;
        u.pm = fm + ((wgid % nig) % gsz); u.pn = (wgid % nig) / gsz; return true;
    }
};
struct EpiBf16 {
    static constexpr bool PERM = true;
    bf16_t* O; int ldc; const float* rowscale; int skip;
    __device__ __forceinline__ void operator()(const f32x4 (&acc)[2][2][4][2], const Unit& u, int wr, int wc, int fr, int fq) const {
        const int row0 = u.pm * BM + wr * 64 + fr, col0 = u.pn * BM + wc * 32 + 8 * fq;
        if (skip) { asm volatile("" :: "v"(acc[0][0][0][0]), "v"(acc[1][1][3][1])); return; }
        float scv[2][4];
#pragma unroll
        for (int ai = 0; ai < 2; ++ai)
#pragma unroll
            for (int m = 0; m < 4; ++m) scv[ai][m] = rowscale ? rowscale[row0 + ai * HALF + m * 16] : 1.f;
        asm volatile("" ::: "memory");
#pragma unroll
        for (int ai = 0; ai < 2; ++ai)
#pragma unroll
            for (int m = 0; m < 4; ++m) { const int row = row0 + ai * HALF + m * 16; bf16_t* rowp = O + (size_t)row * ldc + col0; const float sc = scv[ai][m];
#pragma unroll
                for (int bj = 0; bj < 2; ++bj) { const f32x4 v0 = acc[ai][bj][m][0] * sc, v1 = acc[ai][bj][m][1] * sc;
                    u32x4 w; w.x = cvt_pk_bf16_asm(v0[0], v0[1]); w.y = cvt_pk_bf16_asm(v0[2], v0[3]); w.z = cvt_pk_bf16_asm(v1[0], v1[1]); w.w = cvt_pk_bf16_asm(v1[2], v1[3]);
                    *(u32x4*)(rowp + bj * HALF) = w; } }
    }
};
struct EpiP {
    static constexpr bool PERM = true;
    bf16_t* O; int ldc; const float* qn; const float* kn; int skip;
    __device__ __forceinline__ void operator()(const f32x4 (&acc)[2][2][4][2], const Unit& u, int wr, int wc, int fr, int fq) const {
        const int row0 = u.pm * BM + wr * 64 + fr, col0 = u.pn * BM + wc * 32 + 8 * fq;
        if (skip) { asm volatile("" :: "v"(acc[0][0][0][0]), "v"(acc[1][1][3][1])); return; }
        if (u.pn >= 3 || !FUSE_QK) {
#pragma unroll
            for (int ai = 0; ai < 2; ++ai)
#pragma unroll
                for (int m = 0; m < 4; ++m) { bf16_t* rowp = O + (size_t)(row0 + ai * HALF + m * 16) * ldc + col0;
#pragma unroll
                    for (int bj = 0; bj < 2; ++bj) { const f32x4 v0 = acc[ai][bj][m][0], v1 = acc[ai][bj][m][1];
                        u32x4 w; w.x = cvt_pk_bf16_asm(v0[0], v0[1]); w.y = cvt_pk_bf16_asm(v0[2], v0[3]); w.z = cvt_pk_bf16_asm(v1[0], v1[1]); w.w = cvt_pk_bf16_asm(v1[2], v1[3]);
                        *(u32x4*)(rowp + bj * HALF) = w; } }
            return;
        }
        LAS float* PS = (LAS float*)((LAS unsigned char*)lds_raw + LDSCTL_OFF + 4096);
        const int half = wc & 1, hw = wc >> 1;
        unsigned lm_ = ~0u; asm volatile("" : "+s"(lm_)); const int lane = (int)__builtin_amdgcn_mbcnt_hi(lm_, __builtin_amdgcn_mbcnt_lo(lm_, 0u));
#pragma unroll
        for (int ai = 0; ai < 2; ++ai)
#pragma unroll
            for (int m = 0; m < 4; ++m)
#pragma unroll
                for (int bj = 0; bj < 2; ++bj) { const f32x4 v0 = acc[ai][bj][m][0], v1 = acc[ai][bj][m][1];
                    float s = (v0[0] * v0[0] + v0[1] * v0[1]) + (v0[2] * v0[2] + v0[3] * v0[3]) + (v1[0] * v1[0] + v1[1] * v1[1]) + (v1[2] * v1[2] + v1[3] * v1[3]);
                    s = x32_sum(x16_sum(s, lane), lane);
                    if (fq == 0) PS[((ai * HALF + wr * 64 + m * 16 + fr) * 4 + 2 * bj + hw) * 2 + half] = s; }
        asm volatile("s_waitcnt lgkmcnt(0)" ::: "memory"); __builtin_amdgcn_s_barrier(); asm volatile("" ::: "memory");
        float invf[8];
#pragma unroll
        for (int j = 0; j < 8; ++j) invf[j] = __builtin_amdgcn_exp2f(-(float)(8 * (fq & 1) + j) * (13.287712379549449f / 16.f));
        const bool second = (fq & 2) != 0;
        f32x4 nwv[2][2];
#pragma unroll
        for (int bj = 0; bj < 2; ++bj) { const bool isk = (u.pn * BM + bj * HALF + wc * 32) >= 384; const float* nw = (isk ? kn : qn) + 32 * half + 8 * fq; nwv[bj][0] = *(const f32x4*)nw; nwv[bj][1] = *(const f32x4*)(nw + 4); }
        asm volatile("" ::: "memory");
#pragma unroll
        for (int ai = 0; ai < 2; ++ai)
#pragma unroll
            for (int m = 0; m < 4; ++m) {
                const int grow = row0 + ai * HALF + m * 16; const bool lat = grow < NLAT; const int t = lat ? grow % SEQ : 0;
                int tp = half ? t % GW : t / GW; asm volatile("" : "+v"(tp));
                const float pos = (float)tp;
                float cs[8], sn[8];
#pragma unroll
                for (int j = 0; j < 8; ++j) { const float ang = pos * invf[j]; cs[j] = __cosf(ang); sn[j] = __sinf(ang); }
                bf16_t* rowp = O + (size_t)grow * ldc + col0;
#pragma unroll
                for (int bj = 0; bj < 2; ++bj) {
                    const int rl = ai * HALF + wr * 64 + m * 16 + fr, head = 2 * bj + hw;
                    const float ssq = PS[(rl * 4 + head) * 2] + PS[(rl * 4 + head) * 2 + 1];
                    const bool isk = (u.pn * BM + bj * HALF + wc * 32) >= 384;
                    const float rstd = (isk ? 1.f : 0.125f * 1.44269504089f) / sqrtf(ssq * (1.f / HD) + EPS);
                    const f32x4 n0 = nwv[bj][0], n1 = nwv[bj][1];
                    float y[8];
#pragma unroll
                    for (int j = 0; j < 4; ++j) { y[j] = acc[ai][bj][m][0][j] * rstd * n0[j]; y[4 + j] = acc[ai][bj][m][1][j] * rstd * n1[j]; }
#pragma unroll
                    for (int j = 0; j < 8; ++j) {
                        const unsigned yb = __builtin_bit_cast(unsigned, y[j]);
                        const auto sw = __builtin_amdgcn_permlane32_swap(yb, yb, false, false);
                        const float other = __builtin_bit_cast(float, lane < 32 ? sw[1] : sw[0]);
                        const float rot = second ? y[j] * cs[j] + other * sn[j] : y[j] * cs[j] - other * sn[j];
                        y[j] = lat ? rot : y[j];
                    }
                    u32x4 w; w.x = cvt_pk_bf16(y[0], y[1]); w.y = cvt_pk_bf16(y[2], y[3]); w.z = cvt_pk_bf16(y[4], y[5]); w.w = cvt_pk_bf16(y[6], y[7]);
                    *(u32x4*)(rowp + bj * HALF) = w;
                }
                asm volatile("" ::: "memory");
            }
    }
};
struct EpiRes {
    static constexpr bool PERM = true;
    bf16_t* X; int ldc; const float* gate0; int rows_per_set; size_t set_stride;
    __device__ __forceinline__ void operator()(const f32x4 (&acc)[2][2][4][2], const Unit& u, int wr, int wc, int fr, int fq) const {
        const int row0 = u.pm * BM + wr * 64 + fr, col0 = u.pn * BM + wc * 32 + 8 * fq;
        const float* gate = gate0 + (size_t)((u.pm * BM) / rows_per_set) * set_stride;
        f32x4 gv[2][2];
#pragma unroll
        for (int bj = 0; bj < 2; ++bj)
#pragma unroll
            for (int n = 0; n < 2; ++n) gv[bj][n] = *(const f32x4*)(gate + col0 + bj * HALF + n * 4);
        u32x4 rv[2][4][2];
#pragma unroll
        for (int ai = 0; ai < 2; ++ai)
#pragma unroll
            for (int m = 0; m < 4; ++m)
#pragma unroll
                for (int bj = 0; bj < 2; ++bj) rv[ai][m][bj] = *(const u32x4*)(X + (size_t)(row0 + ai * HALF + m * 16) * ldc + col0 + bj * HALF);
        asm volatile("" ::: "memory");
#pragma unroll
        for (int ai = 0; ai < 2; ++ai)
#pragma unroll
            for (int m = 0; m < 4; ++m) { bf16_t* rowp = X + (size_t)(row0 + ai * HALF + m * 16) * ldc + col0;
#pragma unroll
                for (int bj = 0; bj < 2; ++bj) { const u32x4 r = rv[ai][m][bj];
                    const f32x4 x0 = (f32x4){bfw(r.x, 0), bfw(r.x, 1), bfw(r.y, 0), bfw(r.y, 1)}, x1 = (f32x4){bfw(r.z, 0), bfw(r.z, 1), bfw(r.w, 0), bfw(r.w, 1)};
                    const f32x4 v0 = x0 + gv[bj][0] * acc[ai][bj][m][0], v1 = x1 + gv[bj][1] * acc[ai][bj][m][1];
                    u32x4 w; w.x = cvt_pk_bf16_asm(v0[0], v0[1]); w.y = cvt_pk_bf16_asm(v0[2], v0[3]); w.z = cvt_pk_bf16_asm(v1[0], v1[1]); w.w = cvt_pk_bf16_asm(v1[2], v1[3]);
                    *(u32x4*)(rowp + bj * HALF) = w; } }
    }
};
struct EpiHid {
    static constexpr bool PERM = false;
    bf16_t* O; int ldc;
    __device__ __forceinline__ void operator()(const f32x4 (&acc)[2][2][4][2], const Unit& u, int wr, int wc, int fr, int fq) const {
        const int row0 = u.pm * BM + wr * 64 + fr, col0 = (u.pn * BM + wc * 32) / 2 + 4 * fq;
#pragma unroll
        for (int ai = 0; ai < 2; ++ai)
#pragma unroll
            for (int m = 0; m < 4; ++m) { bf16_t* rowp = O + (size_t)(row0 + ai * HALF + m * 16) * ldc + col0;
#pragma unroll
                for (int bj = 0; bj < 2; ++bj) { const f32x4 g = acc[ai][bj][m][0], up = acc[ai][bj][m][1]; f32x4 h;
#pragma unroll
                    for (int j = 0; j < 4; ++j) h[j] = g[j] * __builtin_amdgcn_rcpf(1.f + __expf(-g[j])) * up[j];
                    u32x2 w; w.x = cvt_pk_bf16_asm(h[0], h[1]); w.y = cvt_pk_bf16_asm(h[2], h[3]);
                    *(u32x2*)(rowp + bj * (HALF / 2)) = w; } }
    }
};

template <class Epi, bool GATHER>
__device__ __forceinline__ void gemm_phase(const int tid, LAS unsigned char* lds, const Gemm g, const StaticOrder& S, const Epi& E) {
    const int wid = __builtin_amdgcn_readfirstlane(tid >> 6), lane = tid & 63, wr = wid >> 2, wc = wid & 3, fr = lane & 15, fq = lane >> 4;
    const int K = g.K, nt = K / BK;
    unsigned voffA[2], voffB[2];
#pragma unroll
    for (int i = 0; i < 2; ++i) { int R, C; stage_rc(tid * 16 + i * 8192, R, C); const int Rb = Epi::PERM ? ((R & ~31) + perm32(R & 31)) : R;
        voffB[i] = (unsigned)(Rb * K + C) * 2u; voffA[i] = GATHER ? (unsigned)(C * 2) : (Epi::PERM ? (unsigned)(R * K + C) * 2u : voffB[i]); }
    const size_t kstep = (size_t)(BK * 2);
    const size_t hstep = (size_t)HALF * K * 2;
    const size_t tstep = 2 * hstep;
    const unsigned ldsw = (unsigned)wid * 1024u;
    const int aoff = lds_byte(wr * 64 + fr, fq * 8), boff = lds_byte(wc * 32 + fr, fq * 8);
#define PG8_SA(b, h) (((b) * 2 + (h)) * HTB)
#define PG8_SB(b, h) ((4 + (b) * 2 + (h)) * HTB)
#define PG8_STAGE(bufoff, gbase, voff) do { const char* gb_ = (const char*)(gbase); asm volatile("" : "+s"(gb_)); _Pragma("unroll") for (int _i = 0; _i < 2; ++_i) \
        __builtin_amdgcn_global_load_lds((const unsigned*)(gb_ + (voff)[_i]), (LAS unsigned*)(lds + (bufoff) + ldsw + _i * 8192), 16, 0, 0); } while (0)
#define PG8_STAGE_A(bufoff, ubase, kt, h, tb) do { if constexpr (GATHER) { \
        if ((tb) < 0) { PG8_STAGE(bufoff, Ab + (size_t)(kt) * kstep, oAc[h]); } else { \
        unsigned m_ = ~0u; asm volatile("" : "+s"(m_)); const int tl_ = wid * 64 + (int)__builtin_amdgcn_mbcnt_hi(m_, __builtin_amdgcn_mbcnt_lo(m_, 0u)); \
        _Pragma("unroll") for (int _i = 0; _i < 2; ++_i) { int _R, _C; stage_rc(tl_ * 16 + _i * 8192, _R, _C); \
            const unsigned _o = min(*(const LAS unsigned*)(lds + TAB_OFF + (tb) * 1024 + ((h) * HALF + _R) * 4), (unsigned)(NTOK - 1)) * (unsigned)(K * 2) + (unsigned)(_C * 2); \
            __builtin_amdgcn_global_load_lds((const unsigned*)(Ab + (size_t)(kt) * kstep + _o), (LAS unsigned*)(lds + (bufoff) + ldsw + _i * 8192), 16, 0, 0); } } } \
        else { PG8_STAGE(bufoff, (ubase) + (size_t)(kt) * kstep + (size_t)(h) * hstep, voffA); } } while (0)
#define PG8_LOADOFFS(tb) do { if constexpr (GATHER) { unsigned m_ = ~0u; asm volatile("" : "+s"(m_)); const int tl_ = wid * 64 + (int)__builtin_amdgcn_mbcnt_hi(m_, __builtin_amdgcn_mbcnt_lo(m_, 0u)); \
        _Pragma("unroll") for (int _h = 0; _h < 2; ++_h) _Pragma("unroll") for (int _i = 0; _i < 2; ++_i) { int _R, _C; stage_rc(tl_ * 16 + _i * 8192, _R, _C); \
            oAc[_h][_i] = min(*(const LAS unsigned*)(lds + TAB_OFF + (tb) * 1024 + (_h * HALF + _R) * 4), (unsigned)(NTOK - 1)) * (unsigned)(K * 2) + (unsigned)(_C * 2); } } } while (0)
#define PG8_FILLTAB(u, tb) do { if constexpr (GATHER) { unsigned m_ = ~0u; asm volatile("" : "+s"(m_)); const int tl_ = wid * 64 + (int)__builtin_amdgcn_mbcnt_hi(m_, __builtin_amdgcn_mbcnt_lo(m_, 0u)); \
        if (tl_ < 256) *(LAS unsigned*)(lds + TAB_OFF + (tb) * 1024 + tl_ * 4) = (unsigned)g.gather[(u).pm * BM + tl_]; } } while (0)
#define PG8_LDA(dst, b, h) do { _Pragma("unroll") for (int m = 0; m < 4; ++m) _Pragma("unroll") for (int k = 0; k < 2; ++k) dst[m][k] = *(const LAS bf16x8*)(lds + PG8_SA(b, h) + aoff + m * 2048 + k * 1024); } while (0)
#define PG8_LDB(dst, b, h) do { _Pragma("unroll") for (int n = 0; n < 2; ++n) _Pragma("unroll") for (int k = 0; k < 2; ++k) dst[n][k] = *(const LAS bf16x8*)(lds + PG8_SB(b, h) + boff + n * 2048 + k * 1024); } while (0)
#define PG8_MMA(ai, bj, At, Bt) do { __builtin_amdgcn_s_setprio(1); _Pragma("unroll") for (int m = 0; m < 4; ++m) _Pragma("unroll") for (int n = 0; n < 2; ++n) _Pragma("unroll") for (int k = 0; k < 2; ++k) \
        acc[ai][bj][m][n] = __builtin_amdgcn_mfma_f32_16x16x32_bf16(Bt[n][k], At[m][k], acc[ai][bj][m][n], 0, 0, 0); __builtin_amdgcn_s_setprio(0); } while (0)
#define PG8_WAIT_V(n) asm volatile("s_waitcnt vmcnt(" #n ")" ::: "memory")
#define PG8_WAIT_L(n) asm volatile("s_waitcnt lgkmcnt(" #n ")" ::: "memory")
#define PG8_BAR __builtin_amdgcn_s_barrier()
#define PG8_SCHED __builtin_amdgcn_sched_barrier(0)
#define PG8_KTILE2(u1, k1, o1, u2, k2, o2, b2p) do { \
        PG8_LDB(B0, 0, 0); PG8_LDB(B1, 0, 1); PG8_SCHED; PG8_LDA(At, 0, 0); PG8_STAGE_A(PG8_SA(1, 1), u1, k1, 1, o1); \
        PG8_WAIT_V(8); PG8_WAIT_L(0); PG8_BAR; PG8_MMA(0, 0, At, B0); PG8_MMA(0, 1, At, B1); PG8_BAR; PG8_SCHED; \
        PG8_LDA(At, 0, 1); PG8_STAGE(PG8_SB(0, 0), b2p, voffB); PG8_STAGE(PG8_SB(0, 1), (b2p) + hstep, voffB); PG8_STAGE_A(PG8_SA(0, 0), u2, k2, 0, o2); \
        PG8_WAIT_V(8); PG8_WAIT_L(0); PG8_BAR; PG8_MMA(1, 0, At, B0); PG8_MMA(1, 1, At, B1); PG8_BAR; PG8_SCHED; \
        PG8_LDB(B0, 1, 0); PG8_LDB(B1, 1, 1); PG8_SCHED; PG8_LDA(At, 1, 0); PG8_STAGE_A(PG8_SA(0, 1), u2, k2, 1, o2); \
        PG8_WAIT_V(8); PG8_WAIT_L(0); PG8_BAR; PG8_MMA(0, 0, At, B0); PG8_MMA(0, 1, At, B1); PG8_BAR; PG8_SCHED; \
        PG8_LDA(At, 1, 1); PG8_STAGE(PG8_SB(1, 0), (b2p) + kstep, voffB); PG8_STAGE(PG8_SB(1, 1), (b2p) + kstep + hstep, voffB); PG8_STAGE_A(PG8_SA(1, 0), u2, (k2) + 1, 0, o2); \
        PG8_WAIT_V(8); PG8_WAIT_L(0); PG8_BAR; PG8_MMA(1, 0, At, B0); PG8_MMA(1, 1, At, B1); PG8_BAR; PG8_SCHED; } while (0)
#define PG8_BPTR(u) ((const char*)g.Bt + (g.gt ? (size_t)(((u).pm / g.gt) % g.ng) * g.gstride : (size_t)0) + (size_t)(u).pn * tstep)
    Unit cur, nxt; int ui = 0;
    if (!S.next(0, cur)) return;
#ifndef LATE_START
#define LATE_START 4
#endif
#ifndef GEMM_STAGGER
#define GEMM_STAGGER 0
#endif
    if (GEMM_STAGGER) { const int dg_ = ((int)blockIdx.x >> 3) & 3; for (int i_ = 0; i_ < dg_; ++i_) __builtin_amdgcn_s_sleep(GEMM_STAGGER); }
    if (S.nwg % S.G != 0 && S.c >= S.nwg % S.G) { for (int i_ = 0; i_ < LATE_START; ++i_) __builtin_amdgcn_s_sleep(127); }
    f32x4 acc[2][2][4][2];
#pragma unroll
    for (int a = 0; a < 2; ++a)
#pragma unroll
        for (int b = 0; b < 2; ++b)
#pragma unroll
            for (int m = 0; m < 4; ++m)
#pragma unroll
                for (int n = 0; n < 2; ++n) acc[a][b][m][n] = (f32x4){0.f, 0.f, 0.f, 0.f};
    bf16x8 At[4][2], B0[2][2], B1[2][2];
    unsigned oAc[2][2] = {{0u, 0u}, {0u, 0u}};
    const char* const Ab = (const char*)g.A;
    const char* cA = Ab + (size_t)cur.pm * tstep;
    const char* cB = PG8_BPTR(cur);
    PG8_FILLTAB(cur, 0);
    if constexpr (GATHER) { PG8_WAIT_L(0); PG8_BAR; PG8_LOADOFFS(0); }
    PG8_STAGE(PG8_SB(0, 0), cB, voffB); PG8_STAGE(PG8_SB(0, 1), cB + hstep, voffB); PG8_STAGE_A(PG8_SA(0, 0), cA, 0, 0, -1); PG8_STAGE_A(PG8_SA(0, 1), cA, 0, 1, -1);
    if (wr == 1) PG8_BAR;
    PG8_WAIT_V(2); PG8_BAR;
    PG8_STAGE(PG8_SB(1, 0), cB + kstep, voffB); PG8_STAGE_A(PG8_SA(1, 0), cA, 1, 0, -1); PG8_STAGE(PG8_SB(1, 1), cB + hstep + kstep, voffB);
    PG8_WAIT_V(6); PG8_BAR;
    for (;;) {
        const bool has_next = S.next(ui + 1, nxt);
        const char* nA = has_next ? Ab + (size_t)nxt.pm * tstep : cA; const char* nB = has_next ? PG8_BPTR(nxt) : cB;
        const int tbc = ui & 1, tbn = has_next ? ((ui + 1) & 1) : (ui & 1);
        if constexpr (GATHER) { if (has_next && wid < 4) { unsigned m_ = ~0u; asm volatile("" : "+s"(m_)); const int tl_ = wid * 64 + (int)__builtin_amdgcn_mbcnt_hi(m_, __builtin_amdgcn_mbcnt_lo(m_, 0u));
            __builtin_amdgcn_global_load_lds((const unsigned*)(g.gather + nxt.pm * BM + tl_), (LAS unsigned*)(lds + TAB_OFF + tbn * 1024 + wid * 256), 4, 0, 0); } }
        for (int t = 0; t < nt - 2; t += 2) { const char* b2 = cB + (size_t)(t + 2) * kstep; PG8_KTILE2(cA, t + 1, -1, cA, t + 2, -1, b2); }
        PG8_KTILE2(cA, nt - 1, -1, nA, 0, tbn, nB);
        if (wr == 0) PG8_BAR;
        { unsigned m_ = ~0u; asm volatile("" : "+s"(m_)); int l2 = (int)__builtin_amdgcn_mbcnt_hi(m_, __builtin_amdgcn_mbcnt_lo(m_, 0u)); asm volatile("" : "+v"(l2)); E(acc, cur, wr, wc, l2 & 15, l2 >> 4); }
        if (!has_next) break;
#pragma unroll
        for (int a = 0; a < 2; ++a)
#pragma unroll
            for (int b = 0; b < 2; ++b)
#pragma unroll
                for (int m = 0; m < 4; ++m)
#pragma unroll
                    for (int n = 0; n < 2; ++n) acc[a][b][m][n] = (f32x4){0.f, 0.f, 0.f, 0.f};
        cur = nxt; cA = nA; cB = nB; ++ui;
        PG8_LOADOFFS(ui & 1);
        if (wr == 1) PG8_BAR;
    }
    PG8_WAIT_V(0);
    PG8_BAR;
#undef PG8_STAGE_A
#undef PG8_FILLTAB
#undef PG8_LOADOFFS
#undef PG8_SA
#undef PG8_SB
#undef PG8_STAGE
#undef PG8_LDA
#undef PG8_LDB
#undef PG8_MMA
#undef PG8_WAIT_V
#undef PG8_WAIT_L
#undef PG8_BAR
#undef PG8_SCHED
#undef PG8_KTILE2
#undef PG8_BPTR
}
}

#define XB_TMO      128
#define XB_XCNT(j)  (256  + 64 * (j))
#define XB_XSUB(j)  (1280 + 64 * (j))
#define XB_XGEN(j)  (2304 + 64 * (j))
#define XB_TOP      3328
#define XB_TOPGEN   3392
#define XCD_BAR_WORDS 3456
#define XB_SPIN_CAP (1u << 20)
__device__ __forceinline__ unsigned xb_ld(unsigned* p)              { return __hip_atomic_load(p, __ATOMIC_RELAXED, __HIP_MEMORY_SCOPE_AGENT); }
__device__ __forceinline__ unsigned xb_add(unsigned* p, unsigned v) { return __hip_atomic_fetch_add(p, v, __ATOMIC_RELAXED, __HIP_MEMORY_SCOPE_AGENT); }
__device__ __forceinline__ unsigned xb_xcc_id() { return (unsigned)__builtin_amdgcn_s_getreg((3 << 11) | 20) & 0xFu; }
#define XB_SPIN(cond, bar) do { unsigned _sp = 0; while (cond) { __builtin_amdgcn_s_sleep(1); \
    if ((++_sp & 255u) == 0u) { if (xb_ld(&(bar)[XB_TMO])) break; if (_sp > XB_SPIN_CAP) { atomicAdd(&(bar)[XB_TMO], 1u); break; } } } } while (0)
struct XcdBarrier { unsigned* bar; unsigned x; };
#define XB_ST(ldsbase) ((volatile LAS unsigned*)((LAS unsigned char*)(ldsbase) + MISC_OFF + 32))
__device__ __forceinline__ XcdBarrier xcd_barrier_post(unsigned* bar, bool leader) {
    XcdBarrier b; b.bar = bar; b.x = xb_xcc_id();
    if (leader) (void)xb_add(&bar[XB_XCNT(b.x)], 1u);
    return b;
}
__device__ __forceinline__ void xcd_barrier_complete(unsigned* bar, unsigned x, unsigned& nloc, unsigned& nx) {
    const unsigned G = gridDim.x * gridDim.y * gridDim.z;
    unsigned sum, cnt, mine, sp = 0u;
    for (;;) {
        sum = 0u; cnt = 0u; mine = 0u;
#pragma unroll
        for (unsigned j = 0; j < 16; ++j) { const unsigned c = xb_ld(&bar[XB_XCNT(j)]); sum += c; cnt += (c > 0u) ? 1u : 0u; mine = (j == x) ? c : mine; }
        if (sum == G) break;
        __builtin_amdgcn_s_sleep(1);
        if ((++sp & 255u) == 0u) { if (xb_ld(&bar[XB_TMO])) break; if (sp > XB_SPIN_CAP) { atomicAdd(&bar[XB_TMO], 1u); break; } }
    }
    nloc = mine > 0u ? mine : 1u; nx = cnt > 0u ? cnt : 1u;
}
__device__ __forceinline__ void xcd_barrier(const XcdBarrier& b, bool leader, volatile LAS unsigned* st) {
    asm volatile("s_waitcnt vmcnt(0)" ::: "memory");
    __syncthreads();
    if (leader) {
        unsigned* bar = b.bar;
        __builtin_amdgcn_s_waitcnt(0);
        unsigned nloc = st[0], nx = st[1];
        if (nloc == 0u) { xcd_barrier_complete(bar, b.x, nloc, nx); st[0] = nloc; st[1] = nx; }
        const unsigned old = xb_add(&bar[XB_XSUB(b.x)], 1u);
        const unsigned gen = old / nloc;
        if (old + 1u == (gen + 1u) * nloc) {
            __builtin_amdgcn_fence(__ATOMIC_RELEASE, "agent");
            asm volatile("s_waitcnt vmcnt(0)" ::: "memory");
            const unsigned og = xb_add(&bar[XB_TOP], 1u);
            const unsigned tg = og / nx;
            if (og + 1u == (tg + 1u) * nx) xb_add(&bar[XB_TOPGEN], 1u);
            else XB_SPIN(xb_ld(&bar[XB_TOPGEN]) == tg, bar);
            __builtin_amdgcn_fence(__ATOMIC_ACQUIRE, "agent");
            xb_add(&bar[XB_XGEN(b.x)], 1u);
            asm volatile("s_waitcnt vmcnt(0)" ::: "memory");
        } else {
            XB_SPIN(xb_ld(&bar[XB_XGEN(b.x)]) == gen, bar);
            __builtin_amdgcn_fence(__ATOMIC_ACQUIRE, "agent");
            asm volatile("s_waitcnt vmcnt(0)" ::: "memory");
        }
    }
    __syncthreads();
}

template <void (*F)(long, PRef, int)> __device__ __forceinline__ void run_items(const int tid, PRef p, int l, long n, long off) {
    for (long gid = (long)blockIdx.x * NTHR + tid; gid < n; gid += (long)gridDim.x * NTHR) F(gid + off, p, l);
}
BODY void b_hgrn_seq2(long gid, PRef p, int l) { const long n1 = (long)NB * HGH * 64; if (gid < n1) b_hgrn_seq<0>(gid, p, l); else b_hgrn_seq<1>(gid - n1, p, l); }

template <int MAP> __device__ __forceinline__ void transpose_item(const float* W, int K, int N, bf16_t* WT, int row_off, LAS float* scr, int item, int lane) {
    const int nblk = N / 32, kb = item / nblk, nb = item % nblk, k0 = 64 * kb, n0 = 32 * nb;
#pragma unroll 8
    for (int i = 0; i < 32; ++i) { const int kk = 2 * i + (lane >> 5); scr[kk * 33 + (lane & 31)] = W[(size_t)(k0 + kk) * N + n0 + (lane & 31)]; }
    asm volatile("s_waitcnt lgkmcnt(0)" ::: "memory");
    const int c = lane & 7;
#pragma unroll
    for (int j = 0; j < 4; ++j) { const int n = (lane >> 3) + 8 * j; const LAS float* s = scr + (8 * c) * 33 + n;
        u32x4 o; o.x = cvt_pk_bf16(s[0 * 33], s[1 * 33]); o.y = cvt_pk_bf16(s[2 * 33], s[3 * 33]); o.z = cvt_pk_bf16(s[4 * 33], s[5 * 33]); o.w = cvt_pk_bf16(s[6 * 33], s[7 * 33]);
        const int nn = n0 + n; const int drow = MAP == 0 ? row_off + nn : (32 * (nn >> 4) + (nn & 15) + (MAP == 2 ? 16 : 0));
        *(u32x4*)(WT + (size_t)drow * K + k0 + 8 * c) = o; }
    asm volatile("s_waitcnt lgkmcnt(0)" ::: "memory");
}
#define WBOFF(l) ((size_t)((l) & 1) * (WB_BYTES / 2))
__device__ __forceinline__ void phase_convert(const int tid, PRef p, int l, LAS unsigned char* lds, int part = 0, int blk_lo = 0) {
    if ((int)blockIdx.x < blk_lo) return;
    const int lane = tid & 63, wave = tid >> 6;
    LAS float* scr = (LAS float*)(lds + wave * 16384);
    const int gw = ((int)blockIdx.x - blk_lo) * NWAVES + wave, NGW = ((int)gridDim.x - blk_lo) * NWAVES;
    constexpr int I_IN = (D / 64) * (INC / 32), I_OUT = (MIXD / 64) * (D / 32), I_G = (D / 64) * (ED / 32), I_D = (ED / 64) * (D / 32);
    constexpr int NITEMS = I_IN + I_OUT + NE * (2 * I_G + I_D);
    const int it_lo = part == 2 ? I_IN + I_OUT : 0, it_hi = part == 1 ? I_IN + I_OUT : NITEMS;
    for (int it = it_lo + gw; it < it_hi; it += NGW) {
        int r = it;
        if (r < I_IN) { transpose_item<0>(p.w_in + (size_t)l * D * INC, D, INC, p.WIN_T + WBOFF(l), 0, scr, r, lane); continue; } r -= I_IN;
        if (r < I_OUT) { transpose_item<0>(p.w_out + (size_t)l * MIXD * D, MIXD, D, p.WOUT_T + WBOFF(l), 0, scr, r, lane); continue; } r -= I_OUT;
        const int e = r / (2 * I_G + I_D); r -= e * (2 * I_G + I_D);
        if (r < I_G) { transpose_item<1>(p.w_gate + ((size_t)l * NE + e) * D * ED, D, ED, p.WGU_T + WBOFF(l) + (size_t)e * 2 * ED * D, 0, scr, r, lane); continue; } r -= I_G;
        if (r < I_G) { transpose_item<2>(p.w_up + ((size_t)l * NE + e) * D * ED, D, ED, p.WGU_T + WBOFF(l) + (size_t)e * 2 * ED * D, 0, scr, r, lane); continue; } r -= I_G;
        transpose_item<0>(p.w_down + ((size_t)l * NE + e) * ED * D, ED, D, p.WD_T + WBOFF(l) + (size_t)e * D * ED, 0, scr, r, lane);
    }
}
template <int WHICH> __device__ __forceinline__ void phase_prenorm(const int tid, PRef p, int l) {
    static_assert(D == 1024, "wave-per-row kernels assume D = 1024");
    const int lane = tid & 63, wave = tid >> 6;
    const int gw = blockIdx.x * NWAVES + wave, NGW = gridDim.x * NWAVES;
    const float* nw = (WHICH ? p.norm2_w : p.norm1_w) + l * D;
    for (int r = gw; r < NTOK; r += NGW) {
        const float* xr = xrow(p, r);
        const float* mod = p.MOD + ((size_t)l * 3 + modset(r)) * NMOD;
        const float* shift = mod + (WHICH ? 3 : 0) * D; const float* scale = mod + (WHICH ? 4 : 1) * D;
        f32x4 v[4]; float ss = 0.f;
#pragma unroll
        for (int j = 0; j < 4; ++j) { v[j] = *(const f32x4*)(xr + 4 * lane + 256 * j); ss += (v[j][0] * v[j][0] + v[j][1] * v[j][1]) + (v[j][2] * v[j][2] + v[j][3] * v[j][3]); }
        const float rstd = 1.f / sqrtf(wave_sum(ss, lane) * (1.f / D) + EPS);
        float lg[NE];
#pragma unroll
        for (int e = 0; e < NE; ++e) lg[e] = 0.f;
#pragma unroll
        for (int j = 0; j < 4; ++j) {
            const int c = 4 * lane + 256 * j;
            const f32x4 w4 = *(const f32x4*)(nw + c), sc4 = *(const f32x4*)(scale + c), sh4 = *(const f32x4*)(shift + c);
            f32x4 h;
#pragma unroll
            for (int i = 0; i < 4; ++i) h[i] = v[j][i] * rstd * w4[i] * (1.f + sc4[i]) + sh4[i];
            u32x2 o; o.x = cvt_pk_bf16(h[0], h[1]); o.y = cvt_pk_bf16(h[2], h[3]);
            *(u32x2*)(p.H + (size_t)r * D + c) = o;
            if (WHICH) {
#pragma unroll
                for (int i = 0; i < 4; ++i) { const f32x4* wr = (const f32x4*)(p.w_router + ((size_t)l * D + c + i) * NE);
#pragma unroll
                    for (int q = 0; q < 4; ++q) { const f32x4 w = wr[q]; lg[4 * q + 0] += h[i] * w[0]; lg[4 * q + 1] += h[i] * w[1]; lg[4 * q + 2] += h[i] * w[2]; lg[4 * q + 3] += h[i] * w[3]; } }
            }
        }
        if (WHICH) {
#pragma unroll
            for (int e = 0; e < NE; ++e) lg[e] = wave_sum(lg[e], lane);
            float m = lg[0];
#pragma unroll
            for (int e = 1; e < NE; ++e) m = fmaxf(m, lg[e]);
            float s = 0.f, mine = 0.f;
#pragma unroll
            for (int e = 0; e < NE; ++e) { const float ex = expf(lg[e] - m); s += ex; mine = (lane == e) ? ex : mine; }
            if (lane < NE) p.AFF[(size_t)r * NE + lane] = mine / s;
        }
    }
}
__device__ __forceinline__ void phase_combine(const int tid, PRef p, int l) {
    const int lane = tid & 63, wave = tid >> 6;
    const int gw = blockIdx.x * NWAVES + wave, NGW = gridDim.x * NWAVES;
    for (int r = gw; r < NTOK; r += NGW) {
        float* xr = xrow(p, r);
        const float* g = p.MOD + ((size_t)l * 3 + modset(r)) * NMOD + 5 * D;
        f32x4 acc[4];
#pragma unroll
        for (int j = 0; j < 4; ++j) acc[j] = (f32x4){0.f, 0.f, 0.f, 0.f};
        const int myinv = lane < NE ? p.INV[(size_t)r * NE + lane] : -1;
#pragma unroll
        for (int e = 0; e < NE; ++e) {
            const int s = __builtin_amdgcn_readlane(myinv, e);
            if (s >= 0 && s < NSLOT) {
                const bf16_t* y = p.Y + (size_t)s * D;
#pragma unroll
                for (int j = 0; j < 4; ++j) { const u32x2 w = *(const u32x2*)(y + 4 * lane + 256 * j);
                    acc[j][0] += __builtin_bit_cast(float, w.x << 16); acc[j][1] += __builtin_bit_cast(float, w.x & 0xffff0000u);
                    acc[j][2] += __builtin_bit_cast(float, w.y << 16); acc[j][3] += __builtin_bit_cast(float, w.y & 0xffff0000u); }
            }
        }
#pragma unroll
        for (int j = 0; j < 4; ++j) { const int c = 4 * lane + 256 * j; f32x4* q = (f32x4*)(xr + c); *q = *q + *(const f32x4*)(g + c) * acc[j]; }
    }
}


__device__ __forceinline__ unsigned wave_excl_scan(unsigned x, int lane) {
    unsigned inc = x;
#pragma unroll
    for (int d = 1; d < 64; d <<= 1) { const unsigned y = (unsigned)__builtin_amdgcn_ds_bpermute(((lane - d) & 63) << 2, (int)inc); if (lane >= d) inc += y; }
    return inc - x;
}
__device__ __forceinline__ void phase_topk(const int tid, PRef p, LAS unsigned char* lds) {
    LAS unsigned* keys = (LAS unsigned*)lds;
    LAS unsigned* hist = (LAS unsigned*)(lds + 70000);
    LAS unsigned* cgt = (LAS unsigned*)(lds + 76000);
    LAS unsigned* ceq = (LAS unsigned*)(lds + 80000);
    LAS unsigned* sh = (LAS unsigned*)(lds + 84000);
    static_assert(SEQ % 512 == 0 && SEQ + SEQ / 32 <= 17400, "topk LDS layout");
    constexpr int PER = SEQ / 512;
    for (int pr = blockIdx.x; pr < 2 * NB * NE; pr += gridDim.x) {
        const int e = pr % NE, b = (pr / NE) % NB, isctx = pr / (NE * NB);
        if (!isctx) {
            const int row0 = b * SEQ, base = (b * NE + e) * CAPL;
            for (int i = 0; i < PER; ++i) { const int t = i * 512 + tid; keys[t + (t >> 5)] = __builtin_bit_cast(unsigned, p.AFF[(size_t)(row0 + t) * NE + e]); }
            if (tid == 0) { sh[0] = 0u; sh[1] = (unsigned)CAPL; }
            __syncthreads();
            for (int pass = 0; pass < 3; ++pass) {
                const int shift = 20 - 10 * pass;
                for (int i = tid; i < 1024; i += 512) hist[i] = 0u;
                __syncthreads();
                const unsigned prefix = sh[0]; const unsigned himask = pass == 0 ? 0u : (0xFFFFFFFFu << (shift + 10));
                for (int i = 0; i < PER; ++i) { const int t = tid * PER + i; const unsigned k = keys[t + (t >> 5)]; if ((k & himask) == prefix) atomicAdd((unsigned*)&hist[(k >> shift) & 1023u], 1u); }
                __syncthreads();
                if (tid < 64) {
                    const unsigned need = sh[1];
                    unsigned c[16]; unsigned tot = 0u;
#pragma unroll
                    for (int q = 0; q < 16; ++q) { c[q] = hist[1023 - 16 * tid - q]; tot += c[q]; }
                    unsigned above = wave_excl_scan(tot, tid);
                    int fbin = -1; unsigned fabove = 0u;
#pragma unroll
                    for (int q = 0; q < 16; ++q) { if (fbin < 0 && above < need && above + c[q] >= need) { fbin = 1023 - 16 * tid - q; fabove = above; } above += c[q]; }
                    if (fbin >= 0) { sh[0] = prefix | ((unsigned)fbin << shift); sh[1] = need - fabove; }
                }
                __syncthreads();
            }
            const unsigned thr = sh[0], keq = sh[1];
            unsigned ng = 0u, nq = 0u;
            for (int i = 0; i < PER; ++i) { const int t = tid * PER + i; const unsigned k = keys[t + (t >> 5)]; ng += k > thr ? 1u : 0u; nq += k == thr ? 1u : 0u; }
            cgt[tid] = ng; ceq[tid] = nq;
            __syncthreads();
            if (tid < 64) {
                unsigned g[8], q[8], sg = 0u, sq = 0u;
#pragma unroll
                for (int i = 0; i < 8; ++i) { g[i] = cgt[8 * tid + i]; q[i] = ceq[8 * tid + i]; sg += g[i]; sq += q[i]; }
                unsigned ag = wave_excl_scan(sg, tid), aq = wave_excl_scan(sq, tid);
#pragma unroll
                for (int i = 0; i < 8; ++i) { cgt[8 * tid + i] = ag; ceq[8 * tid + i] = aq; ag += g[i]; aq += q[i]; }
            }
            __syncthreads();
            unsigned rg = cgt[tid], rq = ceq[tid];
            for (int i = 0; i < PER; ++i) {
                const int t = tid * PER + i; const unsigned k = keys[t + (t >> 5)];
                int slot = -1;
                if (k > thr) { slot = (int)(rg + (rq < keq ? rq : keq)); ++rg; }
                else if (k == thr) { if (rq < keq) slot = (int)(rg + rq); ++rq; }
                const int row = row0 + t;
                if (slot >= 0) { p.STOK[base + slot] = row; p.SVAL[base + slot] = __builtin_bit_cast(float, k); p.INV[(size_t)row * NE + e] = base + slot; }
                else p.INV[(size_t)row * NE + e] = -1;
            }
            __syncthreads();
        } else {
            const int row0 = NLAT + b * CTX, base = NSLOT_L + (b * NE + e) * CAPC;
            LAS float* vals = (LAS float*)lds;
            for (int t = tid; t < CTX; t += 512) vals[t] = p.AFF[(size_t)(row0 + t) * NE + e];
            __syncthreads();
            for (int t = tid; t < CTX; t += 512) {
                const float a = vals[t]; int rank = 0;
                for (int tt = 0; tt < CTX; ++tt) { const float o = vals[tt]; rank += (o > a || (o == a && tt < t)) ? 1 : 0; }
                const int row = row0 + t;
                if (rank < CAPC) { p.STOK[base + rank] = row; p.SVAL[base + rank] = a; p.INV[(size_t)row * NE + e] = base + rank; }
                else p.INV[(size_t)row * NE + e] = -1;
            }
            __syncthreads();
        }
    }
}

#define LDS_BAR() do { asm volatile("s_waitcnt lgkmcnt(0)" ::: "memory"); __builtin_amdgcn_s_barrier(); asm volatile("" ::: "memory"); } while (0)
__device__ __forceinline__ int hg_row0(int b, int pc) { return pc < NCHC ? NLAT + b * CTX + pc * 64 : b * SEQ + (pc - NCHC) * 64; }
constexpr int HG_FF = 0, HG_FB = 16640, HG_AF = 33280, HG_AB = 49920, HG_T0 = 66560, HG_TS = 9216, HG_VT = HG_T0 + 6 * HG_TS;
static_assert(HG_VT + HG_TS <= RING_BYTES, "hgrn LDS layout");
#define TSW_E(k, t) ((k) * 72 + ((((t) >> 3) ^ (((k) >> 3) & 7)) << 3) + ((t) & 7))
#define TSW_B(k, c) ((k) * 144 + (((c) ^ (((k) >> 3) & 7)) << 4))
constexpr int HG_LBOFF = LDSCTL_OFF + 4096;
__device__ __forceinline__ void hg_stage_lb(const int tid, PRef p, int l) {
    LAS float* dst = (LAS float*)((LAS unsigned char*)lds_raw + HG_LBOFF);
    for (int i = tid; i < 768; i += NTHR) dst[i] = p.LB[(size_t)((i / 384) * DEPTH + l) * 384 + (i % 384)];
    LDS_BAR();
}
__device__ __forceinline__ void hg_gates(const int tid, PRef p, int l, int h, const u32x4 zf, const u32x4 zb, LAS unsigned char* lds) {
    LAS float* FF = (LAS float*)(lds + HG_FF); LAS float* FB = (LAS float*)(lds + HG_FB); LAS float* AF = (LAS float*)(lds + HG_AF); LAS float* AB = (LAS float*)(lds + HG_AB);
    const int t = tid >> 3, cg = tid & 7;
    const LAS float* lbf = (const LAS float*)((LAS unsigned char*)lds_raw + HG_LBOFF) + h * 64 + cg * 8; const LAS float* lbb = lbf + 384;
#pragma unroll
    for (int j = 0; j < 8; ++j) {
        const float z0 = fminf(fmaxf(bf8(zf, j), -60.f), 60.f), z1 = fminf(fmaxf(bf8(zb, j), -60.f), 60.f);
        const float l0 = lbf[j], l1 = lbb[j];
        FF[t * 65 + cg * 8 + j] = l0 + (1.f - l0) * __builtin_amdgcn_rcpf(1.f + __expf(-z0));
        FB[t * 65 + cg * 8 + j] = l1 + (1.f - l1) * __builtin_amdgcn_rcpf(1.f + __expf(-z1));
    }
    LDS_BAR();
    {
        const int wave = tid >> 6, lane = tid & 63, cl = lane & 15, seg = lane >> 4, dir = wave >> 2, col = 16 * (wave & 3) + cl;
        const LAS float* F = dir ? FB : FF; LAS float* A = dir ? AB : AF;
        float pre[16]; float run = 0.f;
#pragma unroll
        for (int i = 0; i < 16; ++i) { const int tt = dir ? 16 * seg + 15 - i : 16 * seg + i; run += __logf(F[tt * 65 + col]); pre[i] = run; }
        const float T0 = __builtin_bit_cast(float, __builtin_amdgcn_ds_bpermute((cl + 0) << 2, __builtin_bit_cast(int, run)));
        const float T1 = __builtin_bit_cast(float, __builtin_amdgcn_ds_bpermute((cl + 16) << 2, __builtin_bit_cast(int, run)));
        const float T2 = __builtin_bit_cast(float, __builtin_amdgcn_ds_bpermute((cl + 32) << 2, __builtin_bit_cast(int, run)));
        const float T3 = __builtin_bit_cast(float, __builtin_amdgcn_ds_bpermute((cl + 48) << 2, __builtin_bit_cast(int, run)));
        const float off = dir ? ((seg < 1 ? T1 : 0.f) + (seg < 2 ? T2 : 0.f) + (seg < 3 ? T3 : 0.f)) : ((seg > 0 ? T0 : 0.f) + (seg > 1 ? T1 : 0.f) + (seg > 2 ? T2 : 0.f));
#pragma unroll
        for (int i = 0; i < 16; ++i) { const int tt = dir ? 16 * seg + 15 - i : 16 * seg + i; A[tt * 65 + col] = off + pre[i]; }
    }
    LDS_BAR();
}
__device__ __forceinline__ bf16x8 ld2x64(const LAS unsigned char* p0, const LAS unsigned char* p1) {
    const u32x2 a = *(const LAS u32x2*)p0, b = *(const LAS u32x2*)p1; u32x4 r; r.x = a.x; r.y = a.y; r.z = b.x; r.w = b.y; return __builtin_bit_cast(bf16x8, r);
}
__device__ __forceinline__ f32x4 mfma16(bf16x8 a, bf16x8 b, f32x4 c) { return __builtin_amdgcn_mfma_f32_16x16x32_bf16(a, b, c, 0, 0, 0); }
__device__ __forceinline__ void phase_hgrn_local(const int tid, PRef p, int l, LAS unsigned char* lds) {
    LAS float* FF = (LAS float*)(lds + HG_FF); LAS float* FB = (LAS float*)(lds + HG_FB); LAS float* AF = (LAS float*)(lds + HG_AF); LAS float* AB = (LAS float*)(lds + HG_AB);
    LAS bf16_t* KTf = (LAS bf16_t*)(lds + HG_T0); LAS bf16_t* KTb = (LAS bf16_t*)(lds + HG_T0 + HG_TS); LAS bf16_t* VT = (LAS bf16_t*)(lds + HG_VT);
    const int t = tid >> 3, cg = tid & 7, wave = tid >> 6, lane = tid & 63, fr = lane & 15, fq = lane >> 4;
    u32x4 zf = (u32x4){0u, 0u, 0u, 0u}, zb = zf, v8 = zf, nzf = zf, nzb = zf, nv8 = zf;
    if ((int)blockIdx.x < NBH * NCH) { const int it = blockIdx.x, pc = it % NCH, bh = it / NCH, h = bh % HGH, b = bh / HGH;
        const bf16_t* pr = p.P + (size_t)(hg_row0(b, pc) + t) * INC + h * 64 + cg * 8; zf = *(const u32x4*)(pr + OFF_); zb = *(const u32x4*)(pr + OFB); v8 = *(const u32x4*)(pr + OHI); }
    hg_stage_lb(tid, p, l);
    for (int it = blockIdx.x; it < NBH * NCH; it += gridDim.x) {
        const int pc = it % NCH, bh = it / NCH, h = bh % HGH, b = bh / HGH, row0 = hg_row0(b, pc);
        { const int it2 = min(it + (int)gridDim.x, NBH * NCH - 1); const int pc2 = it2 % NCH, bh2 = it2 / NCH, h2 = bh2 % HGH, b2 = bh2 / HGH;
            const bf16_t* pr = p.P + (size_t)(hg_row0(b2, pc2) + t) * INC + h2 * 64 + cg * 8; nzf = *(const u32x4*)(pr + OFF_); nzb = *(const u32x4*)(pr + OFB); nv8 = *(const u32x4*)(pr + OHI); }
        hg_gates(tid, p, l, h, zf, zb, lds);
#pragma unroll
        for (int j = 0; j < 8; ++j) {
            const int k = cg * 8 + j;
            VT[TSW_E(k, t)] = (bf16_t)(j & 1 ? v8[j >> 1] >> 16 : v8[j >> 1] & 0xffffu);
            KTf[TSW_E(k, t)] = f2bf((1.f - FF[t * 65 + k]) * __expf(AF[63 * 65 + k] - AF[t * 65 + k]));
            KTb[TSW_E(k, t)] = f2bf((1.f - FB[t * 65 + k]) * __expf(AB[k] - AB[t * 65 + k]));
        }
        if (tid < 64) p.GDEC[((size_t)(0 * NBH + bh) * NCH + pc) * 64 + tid] = __expf(AF[63 * 65 + tid]);
        else if (tid < 128) p.GDEC[((size_t)(1 * NBH + bh) * NCH + pc) * 64 + (tid - 64)] = __expf(AB[tid - 64]);
        LDS_BAR();
#if HGRN_DIAG == 4
        {
            const int v = tid >> 3, kg = tid & 7;
            for (int dir = 0; dir < 2; ++dir) {
                const LAS bf16_t* KT = (const LAS bf16_t*)(lds + HG_T0 + dir * HG_TS);
                float acc[8];
#pragma unroll
                for (int j = 0; j < 8; ++j) acc[j] = 0.f;
                for (int s_ = 0; s_ < 64; ++s_) { const float vv = bf2f(VT[v * 72 + s_]);
#pragma unroll
                    for (int j = 0; j < 8; ++j) acc[j] += bf2f(KT[(kg * 8 + j) * 72 + s_]) * vv; }
                bf16_t* dst = p.SLOC + ((size_t)(dir * NBH + bh) * NCH + pc) * 4096 + v * 64 + kg * 8;
#pragma unroll
                for (int j = 0; j < 8; ++j) dst[j] = f2bf(acc[j]);
            }
        }
#else
        {
            const int dir = wave >> 2, mt = wave & 3;
            const LAS unsigned char* KT = lds + HG_T0 + dir * HG_TS;
            bf16x8 a[2];
#pragma unroll
            for (int ks = 0; ks < 2; ++ks) a[ks] = *(const LAS bf16x8*)(KT + TSW_B(mt * 16 + fr, ks * 4 + fq));
            bf16_t* dst = p.SLOC + ((size_t)(dir * NBH + bh) * NCH + pc) * 4096;
            u32x2 w[4];
#pragma unroll
            for (int nt = 0; nt < 4; ++nt) {
                f32x4 acc = (f32x4){0.f, 0.f, 0.f, 0.f};
#pragma unroll
                for (int ks = 0; ks < 2; ++ks) { const bf16x8 bb = *(const LAS bf16x8*)(lds + HG_VT + TSW_B(nt * 16 + fr, ks * 4 + fq)); acc = mfma16(a[ks], bb, acc); }
                w[nt].x = cvt_pk_bf16(acc[0], acc[1]); w[nt].y = cvt_pk_bf16(acc[2], acc[3]);
            }
            zf = nzf; zb = nzb; v8 = nv8;
            asm volatile("" ::: "memory");
#pragma unroll
            for (int nt = 0; nt < 4; ++nt) *(u32x2*)(dst + (nt * 16 + fr) * 64 + mt * 16 + 4 * fq) = w[nt];
        }
#endif
        LDS_BAR();
    }
}
__device__ __forceinline__ void phase_hgrn_scan(const int tid, PRef p) {
    static_assert(NCH % 20 == 0, "scan group size");
    constexpr int GS = 20;
    for (int blk = (int)gridDim.x - 1 - (int)blockIdx.x; blk < 2 * NBH * 4; blk += gridDim.x) {
        const int sq = blk >> 2, part = blk & 3, dir = sq / NBH, e0 = part * 1024 + tid * 2, k = e0 & 63;
        unsigned* S = (unsigned*)(p.SLOC + (size_t)sq * NCH * 4096 + e0);
        const float* G = p.GDEC + (size_t)sq * NCH * 64 + k;
        float c0 = 0.f, c1 = 0.f;
        unsigned nx[GS]; f32x2 gn[GS];
#define HG_PC(j) (dir ? ((j) < NCHC ? NCHC - 1 - (j) : NCH + NCHC - 1 - (j)) : (j))
#pragma unroll
        for (int u = 0; u < GS; ++u) { const int pc = HG_PC(u); nx[u] = S[(size_t)pc * 2048]; gn[u] = *(const f32x2*)(G + (size_t)pc * 64); }
        for (int j0 = 0; j0 < NCH; j0 += GS) {
            unsigned cu[GS]; f32x2 gc[GS];
#pragma unroll
            for (int u = 0; u < GS; ++u) { cu[u] = nx[u]; gc[u] = gn[u]; }
            if (j0 + GS < NCH) {
#pragma unroll
                for (int u = 0; u < GS; ++u) { const int pc = HG_PC(j0 + GS + u); nx[u] = S[(size_t)pc * 2048]; gn[u] = *(const f32x2*)(G + (size_t)pc * 64); }
            }
#pragma unroll
            for (int u = 0; u < GS; ++u) {
                const int pc = HG_PC(j0 + u);
                S[(size_t)pc * 2048] = cvt_pk_bf16(c0, c1);
                c0 = gc[u][0] * c0 + bfw(cu[u], 0); c1 = gc[u][1] * c1 + bfw(cu[u], 1);
            }
        }
#undef HG_PC
    }
}
__device__ __forceinline__ void phase_hgrn_out(const int tid, PRef p, int l, LAS unsigned char* lds) {
    const int NCHO = (l + 1 < DEPTH) ? NCH : NCH - NCHC, PC0 = NCH - NCHO;
    LAS float* FF = (LAS float*)(lds + HG_FF); LAS float* FB = (LAS float*)(lds + HG_FB); LAS float* AF = (LAS float*)(lds + HG_AF); LAS float* AB = (LAS float*)(lds + HG_AB);
    LAS bf16_t* VT = (LAS bf16_t*)(lds + HG_VT);
    LAS float* OO = (LAS float*)(lds + HG_AF);
    const int t = tid >> 3, cg = tid & 7, wave = tid >> 6, lane = tid & 63, fr = lane & 15, fq = lane >> 4;
    u32x4 zf = (u32x4){0u, 0u, 0u, 0u}, zb = zf, v8 = zf, q8 = zf, g8 = zf, nzf = zf, nzb = zf, nv8 = zf, nq8 = zf, ng8 = zf;
    bf16x8 bsin[4][2], nbsin[4][2];
#define HG_LOADSIN(dst, bhx, pcx) do { const bf16_t* SIN_ = p.SLOC + ((size_t)((wave >> 2) * NBH + (bhx)) * NCH + (pcx)) * 4096; \
        _Pragma("unroll") for (int vt = 0; vt < 4; ++vt) _Pragma("unroll") for (int ks = 0; ks < 2; ++ks) dst[vt][ks] = *(const bf16x8*)(SIN_ + (vt * 16 + fr) * 64 + ks * 32 + fq * 8); } while (0)
#pragma unroll
    for (int vt = 0; vt < 4; ++vt) { bsin[vt][0] = (bf16x8){0, 0, 0, 0, 0, 0, 0, 0}; bsin[vt][1] = bsin[vt][0]; nbsin[vt][0] = bsin[vt][0]; nbsin[vt][1] = bsin[vt][0]; }
    if ((int)blockIdx.x < NBH * NCHO) { const int it = blockIdx.x, pc = it % NCHO + PC0, bh = it / NCHO, h = bh % HGH, b = bh / HGH;
        const bf16_t* pr = p.P + (size_t)(hg_row0(b, pc) + t) * INC + h * 64 + cg * 8; zf = *(const u32x4*)(pr + OFF_); zb = *(const u32x4*)(pr + OFB); v8 = *(const u32x4*)(pr + OHI); q8 = *(const u32x4*)(pr + OHQ); g8 = *(const u32x4*)(pr + OHG_);
        HG_LOADSIN(bsin, bh, pc); }
    hg_stage_lb(tid, p, l);
    f32x4 hn0, hn1; { const float* nwp = p.hg_norm + l * 64 + cg * 8; hn0 = *(const f32x4*)nwp; hn1 = *(const f32x4*)(nwp + 4); }
    for (int it = blockIdx.x; it < NBH * NCHO; it += gridDim.x) {
        const int pc = it % NCHO + PC0, bh = it / NCHO, h = bh % HGH, b = bh / HGH, row0 = hg_row0(b, pc);
        { const int it2 = min(it + (int)gridDim.x, NBH * NCHO - 1); const int pc2 = it2 % NCHO + PC0, bh2 = it2 / NCHO, h2 = bh2 % HGH, b2 = bh2 / HGH;
            const bf16_t* pr = p.P + (size_t)(hg_row0(b2, pc2) + t) * INC + h2 * 64 + cg * 8; nzf = *(const u32x4*)(pr + OFF_); nzb = *(const u32x4*)(pr + OFB); nv8 = *(const u32x4*)(pr + OHI); nq8 = *(const u32x4*)(pr + OHQ); ng8 = *(const u32x4*)(pr + OHG_);
            HG_LOADSIN(nbsin, bh2, pc2); }
        hg_gates(tid, p, l, h, zf, zb, lds);
        {
            float w[6][8];
#pragma unroll
            for (int j = 0; j < 8; ++j) {
                const int k = cg * 8 + j;
                VT[TSW_E(k, t)] = (bf16_t)(j & 1 ? v8[j >> 1] >> 16 : v8[j >> 1] & 0xffffu);
                const float qv = bf8(q8, j) * 0.125f, af = AF[t * 65 + k], ab = AB[t * 65 + k], rf = AF[31 * 65 + k], rb = AB[32 * 65 + k];
                w[0][j] = qv * __expf(fminf(af - rf, 80.f)); w[1][j] = (1.f - FF[t * 65 + k]) * __expf(fminf(rf - af, 80.f)); w[2][j] = qv * __expf(af);
                w[3][j] = qv * __expf(fminf(ab - rb, 80.f)); w[4][j] = (1.f - FB[t * 65 + k]) * __expf(fminf(rb - ab, 80.f)); w[5][j] = qv * __expf(ab);
            }
#pragma unroll
            for (int a = 0; a < 6; ++a) { u32x4 o; o.x = cvt_pk_bf16(w[a][0], w[a][1]); o.y = cvt_pk_bf16(w[a][2], w[a][3]); o.z = cvt_pk_bf16(w[a][4], w[a][5]); o.w = cvt_pk_bf16(w[a][6], w[a][7]);
                *(LAS u32x4*)(lds + HG_T0 + a * HG_TS + t * 144 + cg * 16) = o; }
        }
        LDS_BAR();
        {
            const int dir = wave >> 2, tt = wave & 3;
            const LAS unsigned char* QT = lds + HG_T0 + (dir * 3 + 0) * HG_TS; const LAS unsigned char* KL = lds + HG_T0 + (dir * 3 + 1) * HG_TS; const LAS unsigned char* QH = lds + HG_T0 + (dir * 3 + 2) * HG_TS;
            bf16x8 bq[2], bh[2];
#pragma unroll
            for (int ks = 0; ks < 2; ++ks) { bq[ks] = *(const LAS bf16x8*)(QT + (tt * 16 + fr) * 144 + ks * 64 + fq * 16); bh[ks] = *(const LAS bf16x8*)(QH + (tt * 16 + fr) * 144 + ks * 64 + fq * 16); }
            f32x4 o[4];
#pragma unroll
            for (int vt = 0; vt < 4; ++vt) { o[vt] = (f32x4){0.f, 0.f, 0.f, 0.f};
#pragma unroll
                for (int ks = 0; ks < 2; ++ks) o[vt] = mfma16(bsin[vt][ks], bh[ks], o[vt]); }
            const int t_ = 16 * tt + fr;
#pragma unroll
            for (int kp = 0; kp < 2; ++kp) {
                f32x4 sc[2];
#pragma unroll
                for (int hf = 0; hf < 2; ++hf) { const int st = 2 * kp + hf;
                    sc[hf] = (f32x4){0.f, 0.f, 0.f, 0.f};
                    if (dir ? st >= tt : st <= tt) {
#pragma unroll
                        for (int ks = 0; ks < 2; ++ks) { const bf16x8 a = *(const LAS bf16x8*)(KL + (st * 16 + fr) * 144 + ks * 64 + fq * 16); sc[hf] = mfma16(a, bq[ks], sc[hf]); }
#pragma unroll
                        for (int r = 0; r < 4; ++r) { const int s_ = 16 * st + 4 * fq + r; const bool keep = dir ? (s_ >= t_) : (s_ <= t_); sc[hf][r] = keep ? sc[hf][r] : 0.f; }
                    } }
                if (dir ? (2 * kp + 1 >= tt) : (2 * kp <= tt)) {
                    u32x4 pw; pw.x = cvt_pk_bf16(sc[0][0], sc[0][1]); pw.y = cvt_pk_bf16(sc[0][2], sc[0][3]); pw.z = cvt_pk_bf16(sc[1][0], sc[1][1]); pw.w = cvt_pk_bf16(sc[1][2], sc[1][3]);
                    const bf16x8 pf = __builtin_bit_cast(bf16x8, pw);
                    const int s0 = 32 * kp + 4 * fq;
#pragma unroll
                    for (int vt = 0; vt < 4; ++vt) { const int v_ = 16 * vt + fr; const int sw = (v_ >> 3) & 7;
                        const LAS unsigned char* vr = lds + HG_VT + v_ * 144 + (s0 & 7) * 2;
                        const bf16x8 a = ld2x64(vr + (((s0 >> 3) ^ sw) << 4), vr + ((((s0 + 16) >> 3) ^ sw) << 4));
                        o[vt] = mfma16(a, pf, o[vt]); }
                }
            }
            LAS float* OOd = (LAS float*)(lds + (dir ? HG_FB : HG_FF));
#pragma unroll
            for (int vt = 0; vt < 4; ++vt)
#pragma unroll
                for (int r = 0; r < 4; ++r) OOd[t_ * 65 + 16 * vt + 4 * fq + r] = o[vt][r];
        }
        LDS_BAR();
        {
            float o[8]; float ss = 0.f;
#pragma unroll
            for (int j = 0; j < 8; ++j) { o[j] = FF[t * 65 + cg * 8 + j] + FB[t * 65 + cg * 8 + j]; ss += o[j] * o[j]; }
            ss = oct_sum(ss);
            const float rstd = 1.f / sqrtf(ss * (1.f / 64.f) + EPS);
            float y[8];
#pragma unroll
            for (int j = 0; j < 8; ++j) { const float g = bf8(g8, j); y[j] = o[j] * rstd * (j < 4 ? hn0[j & 3] : hn1[j & 3]) * g * __builtin_amdgcn_rcpf(1.f + __expf(-g)); }
            u32x4 ov; ov.x = cvt_pk_bf16(y[0], y[1]); ov.y = cvt_pk_bf16(y[2], y[3]); ov.z = cvt_pk_bf16(y[4], y[5]); ov.w = cvt_pk_bf16(y[6], y[7]);
            zf = nzf; zb = nzb; v8 = nv8; q8 = nq8; g8 = ng8;
#pragma unroll
            for (int vt = 0; vt < 4; ++vt) { bsin[vt][0] = nbsin[vt][0]; bsin[vt][1] = nbsin[vt][1]; }
            asm volatile("" ::: "memory");
            *(u32x4*)(p.MIX + (size_t)(row0 + t) * MIXD + 384 + h * 64 + cg * 8) = ov;
        }
        LDS_BAR();
    }
}


#undef HG_LOADSIN
constexpr int AT_KC = 0, AT_VCT = 36864, AT_KL = AT_VCT + 64 * 528, AT_VL = AT_KL + 3 * 9216, AT_RPB = AT_VL + 3 * 9216, AT_END = AT_RPB + 1920;
static_assert(AT_END <= RING_BYTES && CTX == 256, "attention LDS layout (built for 256 context tokens)");
constexpr float ATHR = 6.f;
template <bool LOCAL, int NKB>
__device__ __forceinline__ void attn_scores(const LAS unsigned char* Kb, const bf16x8 (&qb)[2], f32x4 (&sc)[2 * NKB], int fr, int fq, const LAS float* rpb_row, const int (&boff)[8]) {
#pragma unroll
    for (int mt = 0; mt < 2 * NKB; ++mt) { sc[mt] = (f32x4){0.f, 0.f, 0.f, 0.f};
#pragma unroll
        for (int ks = 0; ks < 2; ++ks) { const bf16x8 a = *(const LAS bf16x8*)(Kb + (16 * mt + fr) * 144 + ks * 64 + fq * 16); sc[mt] = mfma16(a, qb[ks], sc[mt]); } }
    if (LOCAL) {
#pragma unroll
        for (int mt = 0; mt < 2 * NKB; ++mt)
#pragma unroll
            for (int r = 0; r < 4; ++r) sc[mt][r] += *(const LAS float*)((const LAS unsigned char*)rpb_row + boff[(4 * mt + r) & 7]);
    }
}
template <bool LOCAL, int NKB>
__device__ __forceinline__ void attn_spv(const f32x4 (&sc)[2 * NKB], const LAS unsigned char* Vb, int vstride, f32x4 (&o)[4], float& m, float& lsum,
                                         int fr, int fq, int lane, const int (&voff)[4][2], int kbase) {
    float mx = -INFINITY;
#pragma unroll
    for (int mt = 0; mt < 2 * NKB; ++mt)
#pragma unroll
        for (int r = 0; r < 4; ++r) mx = fmaxf(mx, sc[mt][r]);
    mx = fmaxf(mx, __builtin_bit_cast(float, __builtin_amdgcn_ds_swizzle(__builtin_bit_cast(int, mx), (16 << 10) | 0x1f)));
    mx = fmaxf(mx, __builtin_bit_cast(float, __builtin_amdgcn_ds_bpermute((lane ^ 32) << 2, __builtin_bit_cast(int, mx))));
    if (__builtin_amdgcn_ballot_w64(mx > m + ATHR) != 0ull) {
        const float mn = fmaxf(m, mx), corr = __builtin_amdgcn_exp2f(m - mn);
        m = mn; lsum *= corr;
#pragma unroll
        for (int dt = 0; dt < 4; ++dt) o[dt] = o[dt] * corr;
    }
    float ps = 0.f;
#pragma unroll
    for (int kb = 0; kb < NKB; ++kb) {
        float pv[8];
#pragma unroll
        for (int h2 = 0; h2 < 2; ++h2)
#pragma unroll
            for (int r = 0; r < 4; ++r) { const float e = __builtin_amdgcn_exp2f(sc[2 * kb + h2][r] - m); pv[4 * h2 + r] = e; ps += e; }
        u32x4 pw; pw.x = cvt_pk_bf16(pv[0], pv[1]); pw.y = cvt_pk_bf16(pv[2], pv[3]); pw.z = cvt_pk_bf16(pv[4], pv[5]); pw.w = cvt_pk_bf16(pv[6], pv[7]);
        const bf16x8 pf = __builtin_bit_cast(bf16x8, pw);
#pragma unroll
        for (int dt = 0; dt < 4; ++dt) {
            bf16x8 a;
            if (LOCAL) a = ld2x64(Vb + voff[dt][0], Vb + voff[dt][1]);
            else { const int d_ = 16 * dt + fr, sw_ = (d_ >> 3) & 7, c0_ = (kbase >> 3) + 4 * kb + (fq >> 1);
                const LAS unsigned char* vr = Vb + d_ * vstride + (fq & 1) * 8;
                a = ld2x64(vr + ((c0_ ^ sw_) << 4), vr + (((c0_ + 2) ^ sw_) << 4)); }
            o[dt] = mfma16(a, pf, o[dt]);
        }
    }
    lsum += ps;
}
__device__ __forceinline__ void phase_attn(const int tid, PRef p, int l, LAS unsigned char* lds) {
    const int wave = tid >> 6, lane = tid & 63, fr = lane & 15, fq = lane >> 4, skey = tid >> 3, sc8 = tid & 7;
    LAS float* RPB = (LAS float*)(lds + AT_RPB);
    constexpr int NPAIR = ROWS / 2; const int IPB = NPAIR + ((l + 1 < DEPTH) ? 2 : 0);
    const int G_ = gridDim.x, NIT = NB * NAH * IPB;
    const bool deal = (G_ == 256 && NIT <= 160 * 7 + 96 * 5);
    const int it_lo = deal ? ((int)blockIdx.x < 160 ? (int)blockIdx.x * 7 : 1120 + ((int)blockIdx.x - 160) * 5) : (int)blockIdx.x;
    const int it_n = deal ? ((int)blockIdx.x < 160 ? 7 : 5) : (NIT - (int)blockIdx.x + G_ - 1) / G_;
    int last_bh = -1;
#define AT_QTOK(itx) (((itx) % IPB) < NPAIR ? (((itx) / IPB) / NAH) * SEQ + (2 * ((itx) % IPB) + (wave >> 2)) * GW + 16 * (wave & 3) + fr : NLAT + (((itx) / IPB) / NAH) * CTX + ((((itx) % IPB) - NPAIR) * 128 + 16 * wave) + fr)
#define AT_LOADQ(itx, dst) do { const bf16_t* qp_ = p.P + (size_t)AT_QTOK(itx) * INC + OQ + (((itx) / IPB) % NAH) * 64 + fq * 8; dst[0] = *(const bf16x8*)qp_; dst[1] = *(const bf16x8*)(qp_ + 32); } while (0)
    bf16x8 qnx[2] = {(bf16x8){0, 0, 0, 0, 0, 0, 0, 0}, (bf16x8){0, 0, 0, 0, 0, 0, 0, 0}};
    { const int it0 = it_lo; if (it_n > 0 && it0 < NIT) AT_LOADQ(it0, qnx); }
    for (int ii = 0; ii < it_n; ++ii) {
        const int it = deal ? it_lo + ii : it_lo + ii * G_;
        if (it >= NIT) break;
        const int sub = it % IPB, bh = it / IPB, head = bh % NAH, b = bh / NAH;
        const bool islat = sub < NPAIR;
        const int r0 = 2 * sub, qr = r0 + (wave >> 2), jb = wave & 3;
        LDS_BAR();
        if (bh != last_bh) {
            last_bh = bh;
            int sc8l = sc8; asm volatile("" : "+v"(sc8l));
            for (int rnd = 0; rnd < 4; ++rnd) {
                const int key = skey + 64 * rnd; const bf16_t* src = p.P + (size_t)(NLAT + b * CTX + key) * INC + head * 64 + sc8l * 8;
                const u32x4 kv = *(const u32x4*)(src + OK_), vv = *(const u32x4*)(src + OV);
                *(LAS u32x4*)(lds + AT_KC + key * 144 + sc8 * 16) = kv;
#pragma unroll
                for (int j = 0; j < 8; ++j) *(LAS bf16_t*)(lds + AT_VCT + (sc8 * 8 + j) * 528 + ((((key >> 3) ^ sc8) << 4) + (key & 7) * 2)) = (bf16_t)(j & 1 ? vv[j >> 1] >> 16 : vv[j >> 1] & 0xffffu);
            }
            { int t2 = tid; asm volatile("" : "+v"(t2));
              if (t2 < 15 * 32) RPB[t2] = (t2 & 31) < 31 ? p.rpb[((size_t)l * NAH + head) * 465 + (t2 >> 5) * 31 + (t2 & 31)] * 1.44269504089f : -INFINITY; }
        }
        const int qtok = islat ? b * SEQ + qr * GW + 16 * jb + fr : NLAT + b * CTX + ((sub - NPAIR) * 128 + 16 * wave) + fr;
        bf16x8 qb[2]; qb[0] = qnx[0]; qb[1] = qnx[1];
        { const int itn = deal ? it + 1 : it + G_; if (ii + 1 < it_n && itn < NIT) { int fr = (tid & 15); asm volatile("" : "+v"(fr)); AT_LOADQ(itn, qnx); } }
        int krlo = 0, krhi = -1, rs = 0;
        if (islat) { int a = r0 - 4; a = a < 0 ? 0 : (a > ROWS - 8 ? ROWS - 8 : a); int c = r0 + 1 - 4; c = c < 0 ? 0 : (c > ROWS - 8 ? ROWS - 8 : c); krlo = a; krhi = c + 7;
            rs = qr - 4; rs = rs < 0 ? 0 : (rs > ROWS - 8 ? ROWS - 8 : rs); }
        u32x4 kA = (u32x4){0u, 0u, 0u, 0u}, vA = kA, kB = kA, vB = kA, kC = kA, vC = kA;
        int skl = skey; asm volatile("" : "+v"(skl));
#define AT_LOADROW(row, kd, vd) do { const bf16_t* src_ = p.P + (size_t)(b * SEQ + (row) * GW + skl) * INC + head * 64 + sc8 * 8; kd = *(const u32x4*)(src_ + OK_); vd = *(const u32x4*)(src_ + OV); } while (0)
#define AT_STAGEROW(bufi, kd, vd) do { *(LAS u32x4*)(lds + AT_KL + (bufi) * 9216 + skey * 144 + sc8 * 16) = kd; \
        _Pragma("unroll") for (int j = 0; j < 8; ++j) *(LAS bf16_t*)(lds + AT_VL + (bufi) * 9216 + (sc8 * 8 + j) * 144 + ((((skey >> 3) ^ sc8) << 4) + (skey & 7) * 2)) = (bf16_t)(j & 1 ? vd[j >> 1] >> 16 : vd[j >> 1] & 0xffffu); } while (0)
        if (islat) { AT_LOADROW(krlo, kA, vA); AT_LOADROW(krlo + 1, kB, vB); AT_LOADROW(krlo + 2, kC, vC); }
        f32x4 o[4]; float m = -1e30f, lsum = 0.f;
#pragma unroll
        for (int dt = 0; dt < 4; ++dt) o[dt] = (f32x4){0.f, 0.f, 0.f, 0.f};
        LDS_BAR();
        const int bs = jb == 0 ? 0 : (jb == 1 ? 8 : (jb == 2 ? 24 : 32)), qc = 16 * jb + fr;
        int boff[8], voff[4][2];
        { int ws = qc - 8; ws = ws < 0 ? 0 : (ws > 48 ? 48 : ws);
#pragma unroll
          for (int j_ = 0; j_ < 8; ++j_) { const int kc = bs + 16 * (j_ >> 2) + 4 * fq + (j_ & 3); const bool ok = kc >= ws && kc < ws + 16; boff[j_] = (ok ? kc - qc + 15 : 31) * 4; asm volatile("" : "+v"(boff[j_])); }
#pragma unroll
          for (int dt = 0; dt < 4; ++dt) { const int d_ = 16 * dt + fr, sw_ = (d_ >> 3) & 7, c0_ = (bs >> 3) + (fq >> 1);
              voff[dt][0] = d_ * 144 + (fq & 1) * 8 + ((c0_ ^ sw_) << 4); voff[dt][1] = d_ * 144 + (fq & 1) * 8 + (((c0_ + 2) ^ sw_) << 4); asm volatile("" : "+v"(voff[dt][0]), "+v"(voff[dt][1])); } }
        {
            f32x4 sa[4], sb[4];
#define AT_CS(st, dst) attn_scores<false, 2>(lds + AT_KC + (st) * 64 * 144, qb, dst, fr, fq, RPB, boff)
#define AT_CP(st, src) attn_spv<false, 2>(src, lds + AT_VCT, 528, o, m, lsum, fr, fq, lane, voff, (st) * 64)
            AT_CS(0, sa); AT_CS(1, sb); AT_CP(0, sa); AT_CS(2, sa); AT_CP(1, sb); AT_CS(3, sb); AT_CP(2, sa); AT_CP(3, sb);
#undef AT_CS
#undef AT_CP
        }
        if (islat) { AT_STAGEROW(0, kA, vA); AT_LOADROW(krlo + 3, kA, vA); AT_STAGEROW(1, kB, vB); AT_LOADROW(krlo + 4, kB, vB); }
        LDS_BAR();
        if (islat) {
            const bool first0 = rs == krlo, last8 = !first0;
            const LAS float* rp = RPB + (krlo - qr + 7) * 32;
            f32x4 sa[2], sb[2];
#define AT_S(j, dst) attn_scores<true, 1>(lds + AT_KL + ((j) % 3) * 9216 + bs * 144, qb, dst, fr, fq, rp + 32 * (j), boff)
#define AT_P(j, src) attn_spv<true, 1>(src, lds + AT_VL + ((j) % 3) * 9216, 144, o, m, lsum, fr, fq, lane, voff, bs)
#define AT_MID(j, NK, NV, LOADROWX, SCUR, SNXT) { AT_STAGEROW(((j) + 2) % 3, NK, NV); if ((LOADROWX) >= 0) { AT_LOADROW(min(krlo + (LOADROWX), krhi), NK, NV); } \
            AT_S((j) + 1, SNXT); AT_P(j, SCUR); LDS_BAR(); }
            sa[0] = (f32x4){0.f, 0.f, 0.f, 0.f}; sa[1] = sa[0];
            if (first0) AT_S(0, sa);
            { AT_STAGEROW(2, kC, vC); AT_LOADROW(krlo + 5, kC, vC); AT_S(1, sb); if (first0) AT_P(0, sa); LDS_BAR(); }
            AT_MID(1, kA, vA, 6, sb, sa) AT_MID(2, kB, vB, 7, sa, sb) AT_MID(3, kC, vC, 8, sb, sa) AT_MID(4, kA, vA, -1, sa, sb) AT_MID(5, kB, vB, -1, sb, sa) AT_MID(6, kC, vC, -1, sa, sb)
            if (last8) { AT_S(8, sa); AT_P(7, sb); AT_P(8, sa); } else { AT_P(7, sb); }
#undef AT_S
#undef AT_P
#undef AT_MID
        }
#undef AT_LOADROW
#undef AT_STAGEROW
        lsum = x32_sum(x16_sum(lsum, lane), lane);
        const float inv = 1.f / lsum;
        bf16_t* orow = p.MIX + (size_t)qtok * MIXD + head * 64;
#pragma unroll
        for (int dt = 0; dt < 4; ++dt) { u32x2 w; w.x = cvt_pk_bf16(o[dt][0] * inv, o[dt][1] * inv); w.y = cvt_pk_bf16(o[dt][2] * inv, o[dt][3] * inv); *(u32x2*)(orow + 16 * dt + 4 * fq) = w; }
    }
}


#undef AT_QTOK
#undef AT_LOADQ
template <int MODE> __device__ __forceinline__ void mini_gemm(const int tid, PRef p, int l) {
    const int wave = tid >> 6, lane = tid & 63, fr = lane & 15, fq = lane >> 4;
    const int gw = blockIdx.x * NWAVES + wave, NGW = gridDim.x * NWAVES;
    constexpr int K = MODE == 3 ? ED : (MODE == 1 ? MIXD : D);
    constexpr int N = MODE == 0 ? INC : (MODE == 2 ? 2 * ED : D);
    constexpr int MROWS = MODE <= 1 ? NCTX : NSLOT_C;
    constexpr int NTC = MODE == 2 ? 2 : 1, TW = 16 * NTC;
    constexpr int NTN = N / TW, NT = (MROWS / 32) * NTN;
    for (int t = gw; t < NT; t += NGW) {
        const int rt = t / NTN, ct = t % NTN, c0 = ct * TW;
        const bf16_t* Bt; const bf16_t* arow[2];
        if (MODE == 0) { Bt = p.WIN_T + WBOFF(l); for (int mt = 0; mt < 2; ++mt) arow[mt] = p.H + (size_t)(NLAT + rt * 32 + 16 * mt + fr) * D; }
        else if (MODE == 1) { Bt = p.WOUT_T + WBOFF(l); for (int mt = 0; mt < 2; ++mt) arow[mt] = p.MIX + (size_t)(NLAT + rt * 32 + 16 * mt + fr) * MIXD; }
        else if (MODE == 2) { const int e = rt % NE; Bt = p.WGU_T + WBOFF(l) + (size_t)e * 2 * ED * D;
            for (int mt = 0; mt < 2; ++mt) { int row = p.STOK[NSLOT_L + rt * 32 + 16 * mt + fr]; row = row < 0 ? 0 : (row >= NTOK ? NTOK - 1 : row); arow[mt] = p.H + (size_t)row * D; } }
        else { const int e = rt % NE; Bt = p.WD_T + WBOFF(l) + (size_t)e * D * ED; for (int mt = 0; mt < 2; ++mt) arow[mt] = p.HID + (size_t)(NSLOT_L + rt * 32 + 16 * mt + fr) * ED; }
        const bf16_t* brow = Bt + (size_t)(c0 + fr) * K;
        f32x4 acc[2][NTC];
#pragma unroll
        for (int mt = 0; mt < 2; ++mt)
#pragma unroll
            for (int nt = 0; nt < NTC; ++nt) acc[mt][nt] = (f32x4){0.f, 0.f, 0.f, 0.f};
#pragma unroll 8
        for (int ks = 0; ks < K / 32; ++ks) {
            bf16x8 a[2], bfr[NTC];
#pragma unroll
            for (int mt = 0; mt < 2; ++mt) a[mt] = *(const bf16x8*)(arow[mt] + ks * 32 + fq * 8);
#pragma unroll
            for (int nt = 0; nt < NTC; ++nt) bfr[nt] = *(const bf16x8*)(brow + (size_t)(16 * nt) * K + ks * 32 + fq * 8);
#pragma unroll
            for (int mt = 0; mt < 2; ++mt)
#pragma unroll
                for (int nt = 0; nt < NTC; ++nt) acc[mt][nt] = mfma16(a[mt], bfr[nt], acc[mt][nt]);
        }
#pragma unroll
        for (int mt = 0; mt < 2; ++mt)
#pragma unroll
            for (int r = 0; r < 4; ++r) {
                const int lr = rt * 32 + 16 * mt + 4 * fq + r;
                if (MODE == 0) { bf16_t* o = p.P + (size_t)(NLAT + lr) * INC + c0 + fr;
#pragma unroll
                    for (int nt = 0; nt < NTC; ++nt) o[16 * nt] = f2bf(acc[mt][nt][r]); }
                else if (MODE == 1) { float* o = p.XC + (size_t)lr * D + c0 + fr; const float* g = p.MOD + ((size_t)l * 3 + 2) * NMOD + 2 * D + c0 + fr;
#pragma unroll
                    for (int nt = 0; nt < NTC; ++nt) o[16 * nt] += g[16 * nt] * acc[mt][nt][r]; }
                else if (MODE == 2) { bf16_t* o = p.HID + (size_t)(NSLOT_L + lr) * ED + c0 / 2 + fr;
#pragma unroll
                    for (int q = 0; q < NTC / 2; ++q) { const float g = acc[mt][2 * q][r], u = acc[mt][2 * q + 1][r]; o[16 * q] = f2bf(g / (1.f + __expf(-g)) * u); } }
                else { bf16_t* o = p.Y + (size_t)(NSLOT_L + lr) * D + c0 + fr; const float val = p.SVAL[NSLOT_L + lr];
#pragma unroll
                    for (int nt = 0; nt < NTC; ++nt) o[16 * nt] = f2bf(val * acc[mt][nt][r]); }
            }
    }
}


__device__ __forceinline__ void phase_conv(const int tid, PRef p, int l) {
    const float* w = p.conv_w + (size_t)l * 3 * CVD;
    constexpr int U = 2;
    const long nitem = (long)NTOK * (CVD / 8), gstr = (long)gridDim.x * NTHR;
    for (long g0 = (long)blockIdx.x * NTHR + tid; g0 < nitem; g0 += gstr * U) {
        u32x4 cc[U][3], uu[U][3], bg[U]; float vz[U][3]; int rr[U], c8v[U]; bool ok[U];
#pragma unroll
        for (int u = 0; u < U; ++u) {
            long gid = g0 + u * gstr; ok[u] = gid < nitem; if (!ok[u]) gid = g0;
            const int r = (int)(gid / (CVD / 8)), c8 = (int)(gid % (CVD / 8)) * 8; rr[u] = r; c8v[u] = c8;
            int t, T; if (r < NLAT) { t = r % SEQ; T = SEQ; } else { t = (r - NLAT) % CTX; T = CTX; }
            const bf16_t* pr = p.P + (size_t)r * INC + c8;
#pragma unroll
            for (int d = 0; d < 3; ++d) { const int tt = t + d - 1; const bool in = tt >= 0 && tt < T; vz[u][d] = in ? 1.f : 0.f;
                const bf16_t* q = pr + (in ? (long)(d - 1) * INC : 0L); cc[u][d] = *(const u32x4*)(q + OCC); uu[u][d] = *(const u32x4*)(q + OCU); }
            bg[u] = *(const u32x4*)(pr + OCB);
        }
        asm volatile("" ::: "memory");
#pragma unroll
        for (int u = 0; u < U; ++u) {
            float y[8];
#pragma unroll
            for (int j = 0; j < 8; ++j) y[j] = 0.f;
#pragma unroll
            for (int d = 0; d < 3; ++d) {
                const f32x4 w0 = *(const f32x4*)(w + d * CVD + c8v[u]) * vz[u][d], w1 = *(const f32x4*)(w + d * CVD + c8v[u] + 4) * vz[u][d];
#pragma unroll
                for (int j = 0; j < 8; ++j) y[j] += (j < 4 ? w0[j & 3] : w1[j & 3]) * bf8(cc[u][d], j) * bf8(uu[u][d], j);
            }
            u32x4 o; o.x = cvt_pk_bf16(bf8(bg[u], 0) * y[0], bf8(bg[u], 1) * y[1]); o.y = cvt_pk_bf16(bf8(bg[u], 2) * y[2], bf8(bg[u], 3) * y[3]);
            o.z = cvt_pk_bf16(bf8(bg[u], 4) * y[4], bf8(bg[u], 5) * y[5]); o.w = cvt_pk_bf16(bf8(bg[u], 6) * y[6], bf8(bg[u], 7) * y[7]);
            if (ok[u]) *(u32x4*)(p.MIX + (size_t)rr[u] * MIXD + 768 + c8v[u]) = o;
        }
    }
}
__device__ __forceinline__ void phase_qkprep(const int tid, PRef p, int l) {
    const int sub = tid & 7;
    constexpr int U = 4;
    const long ngroups = (long)NTOK * 12, gstride = ((long)gridDim.x * NTHR) >> 3;
    for (long g0 = ((long)blockIdx.x * NTHR + tid) >> 3; g0 < ngroups; g0 += gstride * U) {
        u32x4 raw[U]; bf16_t* ptr[U]; int rr[U]; int wh[U];
#pragma unroll
        for (int u = 0; u < U; ++u) { long g8 = g0 + u * gstride; const bool ok = g8 < ngroups; if (!ok) g8 = g0;
            rr[u] = ok ? (int)(g8 / 12) : -1; wh[u] = (int)(g8 % 12) / 6; const int head = (int)(g8 % 6);
            ptr[u] = p.P + (size_t)(g8 / 12) * INC + (wh[u] ? OK_ : OQ) + head * HD + sub * 8; raw[u] = *(const u32x4*)ptr[u]; }
#pragma unroll
        for (int u = 0; u < U; ++u) {
            const float* nw = (wh[u] ? p.k_norm : p.q_norm) + l * HD + sub * 8;
            float y[8]; float ss = 0.f;
#pragma unroll
            for (int j = 0; j < 8; ++j) { y[j] = bf8(raw[u], j); ss += y[j] * y[j]; }
            ss = oct_sum(ss);
            const float rstd = 1.f / sqrtf(ss * (1.f / HD) + EPS);
#pragma unroll
            for (int j = 0; j < 8; ++j) y[j] = y[j] * rstd * nw[j];
            const int r = rr[u];
            const bool lat = r >= 0 && r < NLAT;
            const int t = lat ? r % SEQ : 0; const float pos = (sub & 4) ? (float)(t % GW) : (float)(t / GW);
            const bool second = (sub & 2) != 0;
#pragma unroll
            for (int j = 0; j < 8; ++j) {
                const float other = __builtin_bit_cast(float, __builtin_amdgcn_ds_swizzle(__builtin_bit_cast(int, y[j]), (2 << 10) | 0x1f));
                const int fi = (sub & 1) * 8 + j;
                const float ang = pos * __builtin_amdgcn_exp2f(-(float)fi * (13.287712379549449f / 16.f));
                const float cs = FCOS(ang), sn = FSIN(ang);
                const float rot = second ? y[j] * cs + other * sn : y[j] * cs - other * sn;
                y[j] = lat ? rot : y[j];
            }
            if (r >= 0) { u32x4 o; o.x = cvt_pk_bf16(y[0], y[1]); o.y = cvt_pk_bf16(y[2], y[3]); o.z = cvt_pk_bf16(y[4], y[5]); o.w = cvt_pk_bf16(y[6], y[7]); *(u32x4*)ptr[u] = o; }
        }
    }
}

__device__ __forceinline__ f32x4 bf4(const u32x2 w) { return (f32x4){bfw(w.x, 0), bfw(w.x, 1), bfw(w.y, 0), bfw(w.y, 1)}; }
template <int MODE> __device__ __forceinline__ void phase_rows(const int tid, PRef p, int l, LAS unsigned char* lds) {
    static_assert(D == 1024, "wave-per-row kernels assume D = 1024");
    const int lane = tid & 63, wave = tid >> 6;
#define RC(j) (8 * lane + 512 * ((j) >> 1) + 4 * ((j) & 1))
    if (MODE == 1) {
        for (int k = tid; k < D; k += NTHR) { const f32x4* src = (const f32x4*)(p.w_router + ((size_t)l * D + k) * NE); LAS f32x4* dst = (LAS f32x4*)(lds + k * 64 + (k >> 3) * 16);
#pragma unroll
            for (int u = 0; u < 4; ++u) dst[u] = src[u]; }
        __syncthreads();
    }
    const int gw = blockIdx.x * NWAVES + wave, NGW = gridDim.x * NWAVES;
    const int rw = ((NTOK + NGW - 1) / NGW + 1) & ~1;
    const int r_lo = gw * rw, r_hi = min(NTOK, r_lo + rw);
    const bool doh = MODE != 2 || l + 1 < DEPTH;
    const int ln = (MODE == 2 && l + 1 < DEPTH) ? l + 1 : l;
    const float* nw = (MODE == 1 ? p.norm2_w : p.norm1_w) + (size_t)ln * D;
    int curset = -1; f32x4 Av[4], Sv[4], Gv[4];
#pragma unroll
    for (int j = 0; j < 4; ++j) { Av[j] = (f32x4){0.f, 0.f, 0.f, 0.f}; Sv[j] = Av[j]; Gv[j] = Av[j]; }
    constexpr int NVN = MODE == 0 ? 4 : 2;
    u32x4 vn[2][NVN]; int invn[2] = {-1, -1};
#define ROWS_LOADPAIR(rb) do { _Pragma("unroll") for (int i_ = 0; i_ < 2; ++i_) { const int rr_ = ((rb) + i_ < r_hi) ? (rb) + i_ : (rb); \
        if (MODE == 0) { const float* src_ = rr_ < NLAT ? p.x + (size_t)rr_ * D : p.ctx + (size_t)(rr_ - NLAT) * D; \
            _Pragma("unroll") for (int j_ = 0; j_ < NVN; ++j_) vn[i_][j_] = *(const u32x4*)(src_ + RC(j_)); } \
        else if (rr_ < NLAT) { const bf16_t* src_ = p.XB + (size_t)rr_ * D + 8 * lane; vn[i_][0] = *(const u32x4*)src_; vn[i_][1] = *(const u32x4*)(src_ + 512); } \
        if (MODE == 2) invn[i_] = lane < NE ? p.INV[(size_t)rr_ * NE + lane] : -1; } } while (0)
#pragma unroll
    for (int i = 0; i < 2; ++i)
#pragma unroll
        for (int j = 0; j < NVN; ++j) vn[i][j] = (u32x4){0u, 0u, 0u, 0u};
    if (r_lo < r_hi) ROWS_LOADPAIR(r_lo);
#pragma unroll 1
    for (int r = r_lo; r < r_hi; r += 2) {
        const bool two = r + 1 < r_hi;
        const bool lat = r < NLAT;
        const int set = modset(r);
        if (set != curset) { curset = set;
            const float* mod = p.MOD + ((size_t)ln * 3 + set) * NMOD; const float* shift = mod + (MODE == 1 ? 3 : 0) * D; const float* scale = mod + (MODE == 1 ? 4 : 1) * D;
            int lane2 = lane; asm volatile("" : "+v"(lane2));
#pragma unroll
            for (int j = 0; j < 4; ++j) { const int c = 8 * lane2 + 512 * (j >> 1) + 4 * (j & 1); const f32x4 w4 = *(const f32x4*)(nw + c), sc4 = *(const f32x4*)(scale + c); Av[j] = w4 * (sc4 + 1.f); Sv[j] = *(const f32x4*)(shift + c);
                if (MODE == 2) Gv[j] = *(const f32x4*)(p.MOD + ((size_t)l * 3 + set) * NMOD + 5 * D + c); } }
        f32x4 v[2][4]; int inv2[2];
#pragma unroll
        for (int i = 0; i < 2; ++i) { inv2[i] = invn[i];
            if (MODE == 0) {
#pragma unroll
                for (int j = 0; j < 4; ++j) v[i][j] = __builtin_bit_cast(f32x4, vn[i][j < NVN ? j : 0]);
            } else if (lat) {
#pragma unroll
                for (int jj = 0; jj < 2; ++jj) { const u32x4 w = vn[i][jj]; v[i][2 * jj] = (f32x4){bfw(w.x, 0), bfw(w.x, 1), bfw(w.y, 0), bfw(w.y, 1)}; v[i][2 * jj + 1] = (f32x4){bfw(w.z, 0), bfw(w.z, 1), bfw(w.w, 0), bfw(w.w, 1)}; }
            } else { const float* src = p.XC + (size_t)(r + ((i == 0 || two) ? i : 0) - NLAT) * D;
#pragma unroll
                for (int j = 0; j < 4; ++j) v[i][j] = *(const f32x4*)(src + RC(j));
            } }
        if (r + 2 < r_hi) ROWS_LOADPAIR(r + 2);
        if (MODE == 2) {
#pragma unroll
            for (int i = 0; i < 2; ++i) {
                const int myinv = inv2[i];
                unsigned long long mask = __ballot(myinv >= 0 && myinv < NSLOT);
                f32x4 acc[4];
#pragma unroll
                for (int j = 0; j < 4; ++j) acc[j] = (f32x4){0.f, 0.f, 0.f, 0.f};
                while (mask) {
                    const int e0 = __builtin_ctzll(mask); mask &= mask - 1; const int s0 = __builtin_amdgcn_readlane(myinv, e0);
                    int s1 = -1; if (mask) { const int e1 = __builtin_ctzll(mask); mask &= mask - 1; s1 = __builtin_amdgcn_readlane(myinv, e1); }
                    u32x4 y0[2], y1[2];
#pragma unroll
                    for (int jj = 0; jj < 2; ++jj) y0[jj] = *(const u32x4*)(p.Y + (size_t)s0 * D + 8 * lane + 512 * jj);
                    if (s1 >= 0) {
#pragma unroll
                        for (int jj = 0; jj < 2; ++jj) y1[jj] = *(const u32x4*)(p.Y + (size_t)s1 * D + 8 * lane + 512 * jj);
                    }
#pragma unroll
                    for (int jj = 0; jj < 2; ++jj) { acc[2 * jj] = acc[2 * jj] + (f32x4){bfw(y0[jj].x, 0), bfw(y0[jj].x, 1), bfw(y0[jj].y, 0), bfw(y0[jj].y, 1)}; acc[2 * jj + 1] = acc[2 * jj + 1] + (f32x4){bfw(y0[jj].z, 0), bfw(y0[jj].z, 1), bfw(y0[jj].w, 0), bfw(y0[jj].w, 1)}; }
                    if (s1 >= 0) {
#pragma unroll
                        for (int jj = 0; jj < 2; ++jj) { acc[2 * jj] = acc[2 * jj] + (f32x4){bfw(y1[jj].x, 0), bfw(y1[jj].x, 1), bfw(y1[jj].y, 0), bfw(y1[jj].y, 1)}; acc[2 * jj + 1] = acc[2 * jj + 1] + (f32x4){bfw(y1[jj].z, 0), bfw(y1[jj].z, 1), bfw(y1[jj].w, 0), bfw(y1[jj].w, 1)}; }
                    }
                }
#pragma unroll
                for (int j = 0; j < 4; ++j) v[i][j] = v[i][j] + Gv[j] * acc[j];
            }
        }
        if (MODE == 0 || MODE == 2) {
            const bool fin = MODE == 2 && l + 1 == DEPTH;
#pragma unroll
            for (int i = 0; i < 2; ++i) if (i == 0 || two) {
                if (lat && !fin) {
#pragma unroll
                    for (int jj = 0; jj < 2; ++jj) { u32x4 o; o.x = cvt_pk_bf16(v[i][2 * jj][0], v[i][2 * jj][1]); o.y = cvt_pk_bf16(v[i][2 * jj][2], v[i][2 * jj][3]); o.z = cvt_pk_bf16(v[i][2 * jj + 1][0], v[i][2 * jj + 1][1]); o.w = cvt_pk_bf16(v[i][2 * jj + 1][2], v[i][2 * jj + 1][3]);
                        *(u32x4*)(p.XB + (size_t)(r + i) * D + 8 * lane + 512 * jj) = o; }
                } else if (lat || !fin) { float* dst = lat ? p.XL + (size_t)(r + i) * D : p.XC + (size_t)(r + i - NLAT) * D;
#pragma unroll
                    for (int j = 0; j < 4; ++j) *(f32x4*)(dst + RC(j)) = v[i][j]; }
            }
        }
        if (doh) {
            float ss[2];
#pragma unroll
            for (int i = 0; i < 2; ++i) { float a = 0.f;
#pragma unroll
                for (int j = 0; j < 4; ++j) a += (v[i][j][0] * v[i][j][0] + v[i][j][1] * v[i][j][1]) + (v[i][j][2] * v[i][j][2] + v[i][j][3] * v[i][j][3]);
                ss[i] = a; }
            ss[0] = wave_sum(ss[0], lane); ss[1] = wave_sum(ss[1], lane);
            const float rstd0 = 1.f / sqrtf(ss[0] * (1.f / D) + EPS), rstd1 = 1.f / sqrtf(ss[1] * (1.f / D) + EPS);
            f32x4 hh[2][4];
#pragma unroll
            for (int j = 0; j < 4; ++j) { hh[0][j] = v[0][j] * rstd0 * Av[j] + Sv[j]; hh[1][j] = v[1][j] * rstd1 * Av[j] + Sv[j]; }
#pragma unroll
            for (int i = 0; i < 2; ++i) if (i == 0 || two) {
#pragma unroll
                for (int jj = 0; jj < 2; ++jj) { u32x4 o; o.x = cvt_pk_bf16(hh[i][2 * jj][0], hh[i][2 * jj][1]); o.y = cvt_pk_bf16(hh[i][2 * jj][2], hh[i][2 * jj][3]); o.z = cvt_pk_bf16(hh[i][2 * jj + 1][0], hh[i][2 * jj + 1][1]); o.w = cvt_pk_bf16(hh[i][2 * jj + 1][2], hh[i][2 * jj + 1][3]);
                    *(u32x4*)(p.H + (size_t)(r + i) * D + 8 * lane + 512 * jj) = o; } }
            if (MODE == 1) {
                LAS float* red = (LAS float*)(lds + 70144 + wave * 4224);
                LAS float* red1 = (LAS float*)(wave < 6 ? lds + 103936 + wave * 4224 : lds + LDSCTL_OFF + 1024 + (wave - 6) * 4224);
                const LAS unsigned char* wb = lds + lane * 528;
#pragma unroll
                for (int u = 0; u < 4; ++u) {
                    f32x4 a0 = (f32x4){0.f, 0.f, 0.f, 0.f}, a1 = a0;
#pragma unroll
                    for (int j = 0; j < 4; ++j)
#pragma unroll
                        for (int q = 0; q < 4; ++q) { const f32x4 w = *(const LAS f32x4*)(wb + (j >> 1) * 33792 + (4 * (j & 1) + q) * 64 + u * 16); const float h0 = hh[0][j][q], h1 = hh[1][j][q];
                            a0[0] += h0 * w[0]; a0[1] += h0 * w[1]; a0[2] += h0 * w[2]; a0[3] += h0 * w[3]; a1[0] += h1 * w[0]; a1[1] += h1 * w[1]; a1[2] += h1 * w[2]; a1[3] += h1 * w[3]; }
#pragma unroll
                    for (int c = 0; c < 4; ++c) { red[(4 * u + c) * 65 + lane] = a0[c]; red1[(4 * u + c) * 65 + lane] = a1[c]; }
                    asm volatile("" ::: "memory");
                }
#pragma unroll
                for (int i = 0; i < 2; ++i) {
                    const LAS float* rd = i ? red1 : red;
                    const int e2 = lane & 15, part = lane >> 4;
                    float t = 0.f;
#pragma unroll
                    for (int x = 0; x < 16; ++x) t += rd[e2 * 65 + part * 16 + x];
                    asm volatile("" ::: "memory");
                    t = x32_sum(x16_sum(t, lane), lane);
#define SWZF(x, d) __builtin_bit_cast(float, __builtin_amdgcn_ds_swizzle(__builtin_bit_cast(int, (x)), ((d) << 10) | 0x1f))
                    float m = t;
                    m = row16_max(m);
                    const float ex = expf(t - m); float sm = ex;
                    sm = row16_sum(sm);
#undef SWZF
                    if (lane < NE && (i == 0 || two)) p.AFF[(size_t)(r + i) * NE + lane] = ex / sm;
                }
            }
        }
    }
#undef ROWS_LOADPAIR
#undef RC
    if (MODE == 1) __syncthreads();
}


__device__ __forceinline__ void phase_adaln(const int tid, PRef p, LAS unsigned char* lds) {
    static_assert(D == 1024 && NMOD % 256 == 0, "adaln layout");
    const int lane = tid & 63, wave = tid >> 6;
    LAS float* SC = (LAS float*)lds;
    LAS float* RED = (LAS float*)(lds + 16384);
    for (int i = tid; i < 3 * D; i += NTHR) { const int st = i / D, k = i % D; const float cv = st < 2 ? p.c[st * D + k] : p.c_ctx[k]; SC[i] = cv / (1.f + __expf(-cv)); }
    __syncthreads();
    constexpr int NCG = NMOD / 256;
    for (int item = blockIdx.x; item < DEPTH * NCG * 2; item += gridDim.x) {
        const int l = item / (NCG * 2), rem = item % (NCG * 2), cgp = rem >> 1, kh = rem & 1;
        const int kbase = kh * 512 + wave * 64;
        const float* wp = p.w_mod + ((size_t)l * D + kbase) * NMOD + cgp * 256 + 4 * lane;
        f32x4 acc[3];
#pragma unroll
        for (int st = 0; st < 3; ++st) acc[st] = (f32x4){0.f, 0.f, 0.f, 0.f};
#pragma unroll 16
        for (int kk = 0; kk < 64; ++kk) { const f32x4 w = *(const f32x4*)(wp + (size_t)kk * NMOD);
#pragma unroll
            for (int st = 0; st < 3; ++st) acc[st] = acc[st] + w * SC[st * D + kbase + kk]; }
#pragma unroll
        for (int st = 0; st < 3; ++st) *(LAS f32x4*)(RED + (wave * 3 + st) * 256 + 4 * lane) = acc[st];
        __syncthreads();
        for (int o = tid; o < 3 * 256; o += NTHR) { const int st = o >> 8, n = o & 255; float v = 0.f;
#pragma unroll
            for (int w8 = 0; w8 < 8; ++w8) v += RED[(w8 * 3 + st) * 256 + n];
            if (kh == 0) v += p.b_mod[(size_t)l * NMOD + cgp * 256 + n];
            atomicAdd(p.MOD + ((size_t)l * 3 + st) * NMOD + cgp * 256 + n, v); }
        __syncthreads();
    }
}

constexpr int NPL = 11, NPH = 1 + DEPTH * NPL;
struct Args { Params p; int ph_lo, ph_hi; };
__global__ void __launch_bounds__(NTHR, 2) mega_fwd(Args args) {
    LAS unsigned char* lds = (LAS unsigned char*)lds_raw;
    {
        const int tid0 = threadIdx.x;
        for (int u = tid0; u < (LDS_BYTES - LDSCTL_OFF) / 4; u += NTHR) ((LAS unsigned*)(lds + LDSCTL_OFF))[u] = 0u;
        __syncthreads();
    }
    int wslot = 0;
    { unsigned m_ = ~0u; asm volatile("" : "+s"(m_));
      const int simd = (int)(__builtin_amdgcn_s_getreg((1 << 11) | (4 << 6) | 4) & 3u);
      if (__builtin_amdgcn_mbcnt_hi(m_, __builtin_amdgcn_mbcnt_lo(m_, 0u)) == 0) wslot = simd + 4 * (int)__hip_atomic_fetch_add(((unsigned*)(lds_raw + MISC_OFF + 64)) + simd, 1u, __ATOMIC_RELAXED, __HIP_MEMORY_SCOPE_WORKGROUP); }
    wslot = __builtin_amdgcn_readfirstlane(wslot) & 7;
#define MY_TID(var) int var; { unsigned m_ = ~0u; asm volatile("" : "+s"(m_)); var = wslot * 64 + (int)__builtin_amdgcn_mbcnt_hi(m_, __builtin_amdgcn_mbcnt_lo(m_, 0u)); } asm volatile("" : "+v"(var))
    XcdBarrier bar; bar.bar = args.p.CTL; bar.x = 0;
    const bool multi = args.ph_hi - args.ph_lo > 1;
    if (multi) { MY_TID(t0); bar = xcd_barrier_post(args.p.CTL, t0 == 0); }
    const int G = gridDim.x;
    const int ph_lo = args.ph_lo, ph_hi = args.ph_hi;
#ifndef PHMASK
#define PHMASK 0xFFFF
#endif
#define PH_ON(k) ((k) == 0 ? (PHMASK & 1) : ((PHMASK >> (1 + ((k) - 1) % NPL)) & 1))
#ifndef REPMASK
#define REPMASK 0
#endif
#ifndef REP_LOCAL
#define REP_LOCAL 0
#define REP_CONV 0
#define REP_ATTN 0
#endif
#ifndef HG_STOP
#define HG_STOP 0
#endif
#ifndef REP_P0
#define REP_P0 0
#endif
#define REP_N(k) (((k) == 0 && REP_P0) ? 2 : (((k) > 0 && ((REPMASK >> (((k) - 1) % NPL)) & 1)) ? 2 : 1))
#define PH_BEGIN(k) if (PH_ON(k) && ph_lo <= (k) && (k) < ph_hi) { for (int rep_ = 0; rep_ < REP_N(k); ++rep_) { const AS4 Args* kp = (const AS4 Args*)__builtin_amdgcn_kernarg_segment_ptr(); asm volatile("" : "+s"(kp)); PRef p = kp->p; MY_TID(tid);
#define PH_END_IF(k, cond) } if ((cond) && (k) + 1 < ph_hi) { MY_TID(t1); xcd_barrier(bar, t1 == 0, XB_ST(lds_raw)); } }
#ifndef REP_CVT
#define REP_CVT 0
#endif
#ifndef REP_BAR
#define REP_BAR 0
#endif
#define PH_END(k) } if ((k) + 1 < ph_hi) { for (int rb_ = 0; rb_ < 1 + REP_BAR; ++rb_) { MY_TID(t1); xcd_barrier(bar, t1 == 0, XB_ST(lds_raw)); } } }
    PH_BEGIN(0)
        phase_adaln(tid, p, lds);
        run_items<b_lb>(tid, p, 0, 2L * 384, 0);
        phase_convert(tid, p, 0, lds, 1, 0);
    PH_END(0)
#define LAYER(l)                                                                                                                                     \
    PH_BEGIN(1 + (l) * NPL + 0) if ((l) == 0) { phase_rows<0>(tid, p, 0, lds); } PH_END_IF(1 + (l) * NPL + 0, (l) == 0)                                 \
    PH_BEGIN(1 + (l) * NPL + 1) {                                                                                                                    \
        pg8::Gemm g{p.H, p.WIN_T + WBOFF(l), NTOK, INC, D, nullptr, 0, 1, 0}; pg8::StaticOrder S; S.init(NTOK, INC, G, (int)blockIdx.x);                         \
        pg8::EpiP E{p.P, INC, p.q_norm + (l) * HD, p.k_norm + (l) * HD, rep_};                                                    \
        pg8::gemm_phase<pg8::EpiP, false>(tid, lds, g, S, E);                                                                                     \
        } PH_END(1 + (l) * NPL + 1)               \
    PH_BEGIN(1 + (l) * NPL + 2) if constexpr (!FUSE_QK) { phase_qkprep(tid, p, l); } if constexpr (FAST_HGRN && (HGRN_DIAG == 3 || HGRN_DIAG == 4)) { phase_hgrn_local(tid, p, l, lds); { MY_TID(t7); run_items<b_hgrn_local_slow>(t7, p, l, 2L * NBH * NCH * 64, 0); } } else if constexpr (FAST_HGRN && HGRN_DIAG >= 2) { run_items<b_hgrn_local_slow>(tid, p, l, 2L * NBH * NCH * 64, 0); } else if constexpr (FAST_HGRN) { for (int r2_ = 0; r2_ < 1 + REP_LOCAL; ++r2_) phase_hgrn_local(tid, p, l, lds); } else { run_items<b_gates>(tid, p, l, (long)NTOK * 768, 0); } phase_conv(tid, p, l); PH_END(1 + (l) * NPL + 2) \
    PH_BEGIN(1 + (l) * NPL + 3) if constexpr (FAST_HGRN && HGRN_DIAG) { run_items<b_hgrn_scan_slow>(tid, p, l, 2L * NBH * 4096, 0); } else if constexpr (FAST_HGRN) { phase_hgrn_scan(tid, p); } else { run_items<b_hgrn_seq2>(tid, p, l, 2L * NB * HGH * 64, 0); } if constexpr (FAST_ATTN) { for (int r4_ = 0; r4_ < 1 + REP_ATTN; ++r4_) { MY_TID(t6); phase_attn(t6, p, l, lds); } } else { run_items<b_attn>(tid, p, l, (long)NTOK * NAH, 0); } PH_END(1 + (l) * NPL + 3) \
    PH_BEGIN(1 + (l) * NPL + 4) if constexpr (FAST_HGRN && HGRN_DIAG) { run_items<b_hgrn_chunkseq>(tid, p, l, 2L * NBH * NCH * 64, 0); { MY_TID(t9); xcd_barrier(bar, t9 == 0, XB_ST(lds_raw)); } { MY_TID(t8); run_items<b_hgfin>(t8, p, l, (long)NTOK * HGH, 0); } } else if constexpr (FAST_HGRN) { phase_hgrn_out(tid, p, l, lds); } else { run_items<b_hgfin>(tid, p, l, (long)NTOK * HGH, 0); } PH_END(1 + (l) * NPL + 4)                                         \
    PH_BEGIN(1 + (l) * NPL + 5) {                                                                                                                    \
        pg8::Gemm g{p.MIX, p.WOUT_T + WBOFF(l), NLAT, D, MIXD, nullptr, 0, 1, 0}; pg8::StaticOrder S; S.init(NLAT, D, G, (int)blockIdx.x);                       \
        pg8::EpiRes E{p.XB, D, p.MOD + (size_t)(l) * 3 * NMOD + 2 * D, SEQ, (size_t)NMOD};                                                           \
        pg8::gemm_phase<pg8::EpiRes, false>(tid, lds, g, S, E);                                                                                      \
        if ((l) + 1 < DEPTH) { MY_TID(tid2); mini_gemm<1>(tid2, p, l); } } PH_END(1 + (l) * NPL + 5)                  \
    PH_BEGIN(1 + (l) * NPL + 6) phase_rows<1>(tid, p, l, lds); PH_END(1 + (l) * NPL + 6)                                                               \
    PH_BEGIN(1 + (l) * NPL + 7) if constexpr (FAST_TOPK) { phase_topk(tid, p, lds); if ((l) == 0 && gridDim.x > 2 * NB * NE + 32) { MY_TID(t4); phase_convert(t4, p, 0, lds, 2, 2 * NB * NE); } else if ((l) == 0) { MY_TID(t4); phase_convert(t4, p, 0, lds, 2, 0); } else if ((l) + 1 < DEPTH) { MY_TID(t4); phase_convert(t4, p, (l) + 1, lds, 0, gridDim.x > 2 * NB * NE + 32 ? 2 * NB * NE : 0); } } else { run_items<b_rank>(tid, p, l, (long)NTOK * NE, 0); } PH_END(1 + (l) * NPL + 7)                                          \
    PH_BEGIN(1 + (l) * NPL + 8) {                                                                                                                    \
        pg8::Gemm g{p.H, p.WGU_T + WBOFF(l), NSLOT_L, 2 * ED, D, p.STOK, CAPL / 256, NE, (size_t)2 * ED * D * 2}; pg8::StaticOrder S; S.init(NSLOT_L, 2 * ED, G, (int)blockIdx.x); \
        pg8::EpiHid E{p.HID, ED};                                                                                                                    \
        pg8::gemm_phase<pg8::EpiHid, true>(tid, lds, g, S, E);                                                                                       \
        if ((l) + 1 < DEPTH) { MY_TID(tid2); mini_gemm<2>(tid2, p, l); } } PH_END(1 + (l) * NPL + 8)              \
    PH_BEGIN(1 + (l) * NPL + 9) {                                                                                                                    \
        pg8::Gemm g{p.HID, p.WD_T + WBOFF(l), NSLOT_L, D, ED, nullptr, CAPL / 256, NE, (size_t)D * ED * 2}; pg8::StaticOrder S; S.init(NSLOT_L, D, G, (int)blockIdx.x); \
        pg8::EpiBf16 E{p.Y, D, p.SVAL, 0};                                                                                                              \
        pg8::gemm_phase<pg8::EpiBf16, false>(tid, lds, g, S, E);                                                                                     \
        if ((l) + 1 < DEPTH) { MY_TID(tid2); mini_gemm<3>(tid2, p, l); } } PH_END(1 + (l) * NPL + 9)                \
    PH_BEGIN(1 + (l) * NPL + 10) phase_rows<2>(tid, p, l, lds); if ((l) == 0) { for (int rc_ = 0; rc_ < 1 + REP_CVT; ++rc_) { MY_TID(t5); phase_convert(t5, p, (l) + 1, lds); } }        PH_END(1 + (l) * NPL + 10)
#ifndef NLAYERS_BUILD
#define NLAYERS_BUILD DEPTH
#endif
    LAYER(0)
    if constexpr (NLAYERS_BUILD > 1) { LAYER(1) }
    if constexpr (NLAYERS_BUILD > 2) { LAYER(2) }
    if constexpr (NLAYERS_BUILD > 3) { LAYER(3) }
}

#ifndef MK_SPLIT
#define MK_SPLIT 0
#endif
extern "C" void kernel_launch(void* const* d_in, const int* in_sizes, int n_in, void* d_out, int out_size, void* d_ws, size_t ws_size,
                              hipStream_t stream) {
    static int grid = 0;
    if (grid == 0) {
        if (n_in != 20 || out_size != NLAT * D || ws_size < WS_END) { fprintf(stderr, "kernel_launch: unexpected problem (n_in %d out %d ws %zu need %zu)\n", n_in, out_size, ws_size, (size_t)WS_END); grid = -1; return; }
        int dev = 0, cus = 0;
        if (hipGetDevice(&dev) != hipSuccess || hipDeviceGetAttribute(&cus, hipDeviceAttributeMultiprocessorCount, dev) != hipSuccess) { grid = -1; return; }
        if (hipFuncSetAttribute((const void*)mega_fwd, hipFuncAttributeMaxDynamicSharedMemorySize, LDS_BYTES) != hipSuccess) { fprintf(stderr, "kernel_launch: hipFuncSetAttribute failed\n"); grid = -1; return; }
        int per_cu = 0;
        if (hipOccupancyMaxActiveBlocksPerMultiprocessor(&per_cu, (const void*)mega_fwd, NTHR, LDS_BYTES) != hipSuccess || per_cu < 1) { fprintf(stderr, "kernel_launch: occupancy query says %d\n", per_cu); }
        (void)hipGetLastError();
        grid = cus;
    }
    if (grid < 0) return;
    (void)hipMemsetAsync((char*)d_ws + WS_CTL, 0, WS_LB - WS_CTL, stream);
    Args a{};
    a.p = make_params(d_in, d_out, d_ws);
#if MK_SPLIT
    for (int ph = 0; ph < NPH; ++ph) { a.ph_lo = ph; a.ph_hi = ph + 1; hipLaunchKernelGGL(mega_fwd, dim3(grid), dim3(NTHR), LDS_BYTES, stream, a); }
#else
    a.ph_lo = 0; a.ph_hi = NPH;
    hipLaunchKernelGGL(mega_fwd, dim3(grid), dim3(NTHR), LDS_BYTES, stream, a);
#endif
}
#endif
```

```cpp
#ifndef CPU_SIM
#include <hip/hip_runtime.h>
#define BODY __device__ __forceinline__
#define FSIN(x) __sinf(x)
#define FCOS(x) __cosf(x)
#else
#include <cmath>
#include <cstdio>
#include <cstdlib>
#include <cstring>
#define BODY static inline
#define FSIN(x) sinf(x)
#define FCOS(x) cosf(x)
#endif
#include <stdint.h>
#include <stddef.h>

#ifndef CFG_D
#define CFG_D 1024
#define CFG_SEQ 16384
#define CFG_CTX 256
#define CFG_EDIM 512
#define CFG_DEPTH 4
#endif

typedef unsigned short bf16_t;

constexpr int D = CFG_D, NB = 2, SEQ = CFG_SEQ, DEPTH = CFG_DEPTH, GW = 64, ROWS = SEQ / GW, CTX = CFG_CTX;
constexpr int HD = 64, NAH = 6, HGH = 6, CVD = 256, MIXD = 1024, INC = 3840, NMOD = 6 * D;
constexpr int NE = 16, ED = CFG_EDIM, CAPL = 2 * SEQ / NE, CAPC = 2 * CTX / NE;
constexpr int NLAT = NB * SEQ, NCTX = NB * CTX, NTOK = NLAT + NCTX;
constexpr int NSLOT_L = NB * NE * CAPL, NSLOT_C = NB * NE * CAPC, NSLOT = NSLOT_L + NSLOT_C;
constexpr int OQ = 0, OK_ = 384, OV = 768, OHQ = 1152, OFF_ = 1536, OFB = 1920, OHI = 2304, OHG_ = 2688, OCB = 3072, OCC = 3328, OCU = 3584;
constexpr float EPS = 1e-6f;
constexpr int NCH = (CTX + SEQ) / 64, NCHC = CTX / 64, NBH = NB * HGH;

struct Params {
    const float *x, *c, *ctx, *c_ctx, *w_mod, *b_mod, *norm1_w, *w_in, *q_norm, *k_norm, *rpb, *lb_logits, *hg_norm, *conv_w, *w_out,
        *norm2_w, *w_router, *w_gate, *w_up, *w_down;
    float *XL, *XC, *MOD, *LB, *AFF, *SVAL, *FG, *OHG;
    bf16_t *H, *P, *MIX, *HID, *Y;
    int *STOK, *INV;
    bf16_t *WIN_T, *WOUT_T, *WGU_T, *WD_T;
    unsigned* CTL;
    bf16_t* SLOC;
    float* GDEC;
    bf16_t* XB;
};

#ifndef CPU_SIM
#define AS4 __attribute__((address_space(4)))
typedef const AS4 Params& PRef;
#else
typedef const Params& PRef;
#endif
BODY float bf2f(bf16_t v) { return __builtin_bit_cast(float, (unsigned)v << 16); }
BODY bf16_t f2bf(float f) { unsigned u = __builtin_bit_cast(unsigned, f); u += 0x7fffu + ((u >> 16) & 1u); return (bf16_t)(u >> 16); }
BODY float silu_f(float x) { return x / (1.f + expf(-x)); }
BODY float sigmoid_f(float x) { return 1.f / (1.f + expf(-x)); }
BODY int modset(int r) { return r < NLAT ? r / SEQ : 2; }
BODY float* xrow(PRef p, int r) { return r < NLAT ? p.XL + (size_t)r * D : p.XC + (size_t)(r - NLAT) * D; }

BODY void b_adaln(long gid, PRef p, int) {
    const int n = (int)(gid % NMOD), s = (int)((gid / NMOD) % 3), l = (int)(gid / (3 * NMOD));
    const float* cv = s < 2 ? p.c + s * D : p.c_ctx;
    const float* w = p.w_mod + (size_t)l * D * NMOD + n;
    float acc = 0.f;
    for (int k = 0; k < D; ++k) acc += silu_f(cv[k]) * w[(size_t)k * NMOD];
    p.MOD[gid] = acc + p.b_mod[l * NMOD + n];
}
BODY void b_lb(long gid, PRef p, int) {
    const int dir = (int)(gid / 384), j = (int)(gid % 384);
    const float* lg = p.lb_logits + (size_t)dir * DEPTH * 384 + j;
    float m = -INFINITY;
    for (int l = 0; l < DEPTH; ++l) m = fmaxf(m, lg[l * 384]);
    float s = 0.f;
    for (int l = 0; l < DEPTH; ++l) s += expf(lg[l * 384] - m);
    float cum = 0.f;
    p.LB[(dir * DEPTH + 0) * 384 + j] = 0.f;
    for (int l = 1; l < DEPTH; ++l) { cum += expf(lg[l * 384] - m) / s; p.LB[(dir * DEPTH + l) * 384 + j] = cum; }
}
BODY void b_copyx(long gid, PRef p, int) {
    if (gid < (long)NLAT * D) p.XL[gid] = p.x[gid]; else p.XC[gid - (long)NLAT * D] = p.ctx[gid - (long)NLAT * D];
}
template <int WHICH> BODY void b_prenorm(long gid, PRef p, int l) {
    const int r = (int)gid;
    const float* xr = xrow(p, r);
    const float* nw = (WHICH ? p.norm2_w : p.norm1_w) + l * D;
    const float* mod = p.MOD + ((size_t)l * 3 + modset(r)) * NMOD;
    const float* shift = mod + (WHICH ? 3 : 0) * D;
    const float* scale = mod + (WHICH ? 4 : 1) * D;
    float ss = 0.f;
    for (int k = 0; k < D; ++k) ss += xr[k] * xr[k];
    const float rstd = 1.f / sqrtf(ss / D + EPS);
    float lg[NE];
#pragma unroll
    for (int e = 0; e < NE; ++e) lg[e] = 0.f;
    for (int k = 0; k < D; ++k) {
        const float h = xr[k] * rstd * nw[k] * (1.f + scale[k]) + shift[k];
        p.H[(size_t)r * D + k] = f2bf(h);
        if (WHICH) {
            const float* wr = p.w_router + ((size_t)l * D + k) * NE;
#pragma unroll
            for (int e = 0; e < NE; ++e) lg[e] += h * wr[e];
        }
    }
    if (WHICH) {
        float m = lg[0];
#pragma unroll
        for (int e = 1; e < NE; ++e) m = fmaxf(m, lg[e]);
        float s = 0.f;
#pragma unroll
        for (int e = 0; e < NE; ++e) { lg[e] = expf(lg[e] - m); s += lg[e]; }
#pragma unroll
        for (int e = 0; e < NE; ++e) p.AFF[(size_t)r * NE + e] = lg[e] / s;
    }
}
BODY void b_gemm_in(long gid, PRef p, int l) {
    const int r = (int)(gid / (INC / 4)), n = (int)(gid % (INC / 4)) * 4;
    const bf16_t* a = p.H + (size_t)r * D;
    const float* w = p.w_in + (size_t)l * D * INC + n;
    float a0 = 0.f, a1 = 0.f, a2 = 0.f, a3 = 0.f;
    for (int k = 0; k < D; ++k) { const float av = bf2f(a[k]); const float* wk = w + (size_t)k * INC; a0 += av * wk[0]; a1 += av * wk[1]; a2 += av * wk[2]; a3 += av * wk[3]; }
    bf16_t* o = p.P + (size_t)r * INC + n;
    o[0] = f2bf(a0); o[1] = f2bf(a1); o[2] = f2bf(a2); o[3] = f2bf(a3);
}
BODY void b_qkprep(long gid, PRef p, int l) {
    const int r = (int)(gid / 12), which = (int)(gid % 12) / 6, head = (int)(gid % 6);
    bf16_t* ptr = p.P + (size_t)r * INC + (which ? OK_ : OQ) + head * HD;
    const float* nw = (which ? p.k_norm : p.q_norm) + l * HD;
    float y[HD];
    float ss = 0.f;
#pragma unroll
    for (int d = 0; d < HD; ++d) { y[d] = bf2f(ptr[d]); ss += y[d] * y[d]; }
    const float rstd = 1.f / sqrtf(ss / HD + EPS);
#pragma unroll
    for (int d = 0; d < HD; ++d) y[d] = y[d] * rstd * nw[d];
    if (r < NLAT) {
        const int t = r % SEQ; const float row = (float)(t / GW), col = (float)(t % GW);
#pragma unroll
        for (int d = 0; d < 16; ++d) {
            const float inv = powf(10000.f, -(float)d / 16.f);
            const float ar = row * inv, ac = col * inv;
            const float cr = FCOS(ar), sr = FSIN(ar), cc = FCOS(ac), sc = FSIN(ac);
            const float x0 = y[d], x1 = y[d + 16], x2 = y[d + 32], x3 = y[d + 48];
            y[d] = x0 * cr - x1 * sr; y[d + 16] = x1 * cr + x0 * sr; y[d + 32] = x2 * cc - x3 * sc; y[d + 48] = x3 * cc + x2 * sc;
        }
    }
#pragma unroll
    for (int d = 0; d < HD; ++d) ptr[d] = f2bf(y[d]);
}
BODY void b_attn(long gid, PRef p, int l) {
    const int r = (int)(gid / NAH), head = (int)(gid % NAH);
    float q[HD], acc[HD];
    const bf16_t* qp = p.P + (size_t)r * INC + OQ + head * HD;
#pragma unroll
    for (int d = 0; d < HD; ++d) { q[d] = bf2f(qp[d]) * 0.125f; acc[d] = 0.f; }
    float m = -INFINITY, s = 0.f;
    const int b = r < NLAT ? r / SEQ : (r - NLAT) / CTX;
    const int nloc = r < NLAT ? 128 : 0;
    int row = 0, col = 0, rs = 0, ws = 0;
    if (r < NLAT) { const int t = r % SEQ; row = t / GW; col = t % GW; rs = row - 4; rs = rs < 0 ? 0 : (rs > ROWS - 8 ? ROWS - 8 : rs); ws = col - 8; ws = ws < 0 ? 0 : (ws > GW - 16 ? GW - 16 : ws); }
    for (int j = 0; j < nloc + CTX; ++j) {
        int kr; float bias = 0.f;
        if (j < nloc) { const int i = j / 16, jj = j % 16; kr = b * SEQ + (rs + i) * GW + ws + jj; bias = p.rpb[(((size_t)l * NAH + head) * 15 + (rs + i - row + 7)) * 31 + (ws + jj - col + 15)]; }
        else kr = NLAT + b * CTX + (j - nloc);
        const bf16_t* kp = p.P + (size_t)kr * INC + OK_ + head * HD;
        const bf16_t* vp = p.P + (size_t)kr * INC + OV + head * HD;
        float sc = 0.f;
#pragma unroll
        for (int d = 0; d < HD; ++d) sc += q[d] * bf2f(kp[d]);
        sc += bias;
        const float mn = fmaxf(m, sc), corr = expf(m - mn), pj = expf(sc - mn);
        s = s * corr + pj;
#pragma unroll
        for (int d = 0; d < HD; ++d) acc[d] = acc[d] * corr + pj * bf2f(vp[d]);
        m = mn;
    }
    const float inv = 1.f / s;
    bf16_t* o = p.MIX + (size_t)r * MIXD + head * HD;
#pragma unroll
    for (int d = 0; d < HD; ++d) o[d] = f2bf(acc[d] * inv);
}
BODY void b_gates(long gid, PRef p, int l) {
    const int j = (int)(gid % 384), dir = (int)((gid / 384) % 2), r = (int)(gid / 768);
    const float z = bf2f(p.P[(size_t)r * INC + (dir ? OFB : OFF_) + j]);
    const float lbv = p.LB[(dir * DEPTH + l) * 384 + j];
    p.FG[gid] = lbv + (1.f - lbv) * sigmoid_f(z);
}
template <int DIR> BODY void b_hgrn_seq(long gid, PRef p, int) {
    const int v = (int)(gid % 64), h = (int)((gid / 64) % HGH), b = (int)(gid / (64 * HGH));
    float S[64];
#pragma unroll
    for (int k = 0; k < 64; ++k) S[k] = 0.f;
    for (int step = 0; step < CTX + SEQ; ++step) {
        int r;
        if (step < CTX) r = NLAT + b * CTX + (DIR ? CTX - 1 - step : step);
        else r = b * SEQ + (DIR ? SEQ - 1 - (step - CTX) : (step - CTX));
        const float vv = bf2f(p.P[(size_t)r * INC + OHI + h * 64 + v]);
        const float* fr = p.FG + ((size_t)r * 2 + DIR) * 384 + h * 64;
        const bf16_t* qr = p.P + (size_t)r * INC + OHQ + h * 64;
        float o = 0.f;
#pragma unroll
        for (int k = 0; k < 64; ++k) { const float f = fr[k]; S[k] = f * S[k] + (1.f - f) * vv; o += S[k] * bf2f(qr[k]); }
        o *= 0.125f;
        p.OHG[((size_t)DIR * NTOK + r) * 384 + h * 64 + v] = o;
    }
}
BODY void b_hgfin(long gid, PRef p, int l) {
    const int r = (int)(gid / HGH), h = (int)(gid % HGH);
    const float* op = p.OHG + (size_t)r * 384 + h * 64;
    const float* op1 = op + (size_t)NTOK * 384;
    float o[64]; float ss = 0.f;
#pragma unroll
    for (int v = 0; v < 64; ++v) { o[v] = op[v] + op1[v]; ss += o[v] * o[v]; }
    const float rstd = 1.f / sqrtf(ss / 64.f + EPS);
    const bf16_t* g = p.P + (size_t)r * INC + OHG_ + h * 64;
    bf16_t* out = p.MIX + (size_t)r * MIXD + 384 + h * 64;
#pragma unroll
    for (int v = 0; v < 64; ++v) out[v] = f2bf(o[v] * rstd * p.hg_norm[l * 64 + v] * silu_f(bf2f(g[v])));
}
BODY void b_conv(long gid, PRef p, int l) {
    const int ch = (int)(gid % CVD), r = (int)(gid / CVD);
    int t, T;
    if (r < NLAT) { t = r % SEQ; T = SEQ; } else { t = (r - NLAT) % CTX; T = CTX; }
    const float* w = p.conv_w + (size_t)l * 3 * CVD + ch;
    float y = 0.f;
    for (int j = 0; j < 3; ++j) {
        const int tt = t + j - 1;
        if (tt < 0 || tt >= T) continue;
        const bf16_t* pr = p.P + (size_t)(r + j - 1) * INC;
        y += w[j * CVD] * bf2f(pr[OCC + ch]) * bf2f(pr[OCU + ch]);
    }
    p.MIX[(size_t)r * MIXD + 768 + ch] = f2bf(bf2f(p.P[(size_t)r * INC + OCB + ch]) * y);
}
BODY void b_gemm_out(long gid, PRef p, int l) {
    const int r = (int)(gid / (D / 4)), n = (int)(gid % (D / 4)) * 4;
    const bf16_t* a = p.MIX + (size_t)r * MIXD;
    const float* w = p.w_out + (size_t)l * MIXD * D + n;
    float a0 = 0.f, a1 = 0.f, a2 = 0.f, a3 = 0.f;
    for (int k = 0; k < MIXD; ++k) { const float av = bf2f(a[k]); const float* wk = w + (size_t)k * D; a0 += av * wk[0]; a1 += av * wk[1]; a2 += av * wk[2]; a3 += av * wk[3]; }
    const float* g = p.MOD + ((size_t)l * 3 + modset(r)) * NMOD + 2 * D + n;
    float* xr = xrow(p, r) + n;
    xr[0] += g[0] * a0; xr[1] += g[1] * a1; xr[2] += g[2] * a2; xr[3] += g[3] * a3;
}
BODY void b_rank(long gid, PRef p, int) {
    const int e = (int)(gid % NE), r = (int)(gid / NE);
    int t, T, row0, cap, base;
    if (r < NLAT) { const int b = r / SEQ; t = r % SEQ; T = SEQ; row0 = b * SEQ; cap = CAPL; base = (b * NE + e) * CAPL; }
    else { const int b = (r - NLAT) / CTX; t = (r - NLAT) % CTX; T = CTX; row0 = NLAT + b * CTX; cap = CAPC; base = NSLOT_L + (b * NE + e) * CAPC; }
    const float a = p.AFF[(size_t)r * NE + e];
    const float* col = p.AFF + (size_t)row0 * NE + e;
    int rank = 0;
    for (int tt = 0; tt < T; ++tt) { const float o = col[(size_t)tt * NE]; rank += (o > a || (o == a && tt < t)) ? 1 : 0; }
    if (rank < cap) { p.STOK[base + rank] = r; p.SVAL[base + rank] = a; p.INV[(size_t)r * NE + e] = base + rank; }
    else p.INV[(size_t)r * NE + e] = -1;
}
BODY int slot_expert(int s) { return s < NSLOT_L ? (s / CAPL) % NE : ((s - NSLOT_L) / CAPC) % NE; }
BODY void b_moe1(long gid, PRef p, int l) {
    const int s = (int)(gid / (ED / 4)), f = (int)(gid % (ED / 4)) * 4;
    const int e = slot_expert(s); int row = p.STOK[s]; row = row < 0 ? 0 : (row >= NTOK ? NTOK - 1 : row);
    const bf16_t* a = p.H + (size_t)row * D;
    const float* wg = p.w_gate + ((size_t)l * NE + e) * D * ED + f;
    const float* wu = p.w_up + ((size_t)l * NE + e) * D * ED + f;
    float g0 = 0.f, g1 = 0.f, g2 = 0.f, g3 = 0.f, u0 = 0.f, u1 = 0.f, u2 = 0.f, u3 = 0.f;
    for (int k = 0; k < D; ++k) {
        const float av = bf2f(a[k]); const float* gk = wg + (size_t)k * ED; const float* uk = wu + (size_t)k * ED;
        g0 += av * gk[0]; g1 += av * gk[1]; g2 += av * gk[2]; g3 += av * gk[3];
        u0 += av * uk[0]; u1 += av * uk[1]; u2 += av * uk[2]; u3 += av * uk[3];
    }
    bf16_t* o = p.HID + (size_t)s * ED + f;
    o[0] = f2bf(silu_f(g0) * u0); o[1] = f2bf(silu_f(g1) * u1); o[2] = f2bf(silu_f(g2) * u2); o[3] = f2bf(silu_f(g3) * u3);
}
BODY void b_moe2(long gid, PRef p, int l) {
    const int s = (int)(gid / (D / 4)), n = (int)(gid % (D / 4)) * 4;
    const int e = slot_expert(s);
    const bf16_t* a = p.HID + (size_t)s * ED;
    const float* w = p.w_down + ((size_t)l * NE + e) * ED * D + n;
    float a0 = 0.f, a1 = 0.f, a2 = 0.f, a3 = 0.f;
    for (int k = 0; k < ED; ++k) { const float av = bf2f(a[k]); const float* wk = w + (size_t)k * D; a0 += av * wk[0]; a1 += av * wk[1]; a2 += av * wk[2]; a3 += av * wk[3]; }
    const float val = p.SVAL[s];
    bf16_t* o = p.Y + (size_t)s * D + n;
    o[0] = f2bf(val * a0); o[1] = f2bf(val * a1); o[2] = f2bf(val * a2); o[3] = f2bf(val * a3);
}
BODY void b_combine(long gid, PRef p, int l) {
    const int r = (int)(gid / (D / 4)), n = (int)(gid % (D / 4)) * 4;
    float a0 = 0.f, a1 = 0.f, a2 = 0.f, a3 = 0.f;
    for (int e = 0; e < NE; ++e) {
        const int s = p.INV[(size_t)r * NE + e];
        if (s >= 0) { const bf16_t* y = p.Y + (size_t)s * D + n; a0 += bf2f(y[0]); a1 += bf2f(y[1]); a2 += bf2f(y[2]); a3 += bf2f(y[3]); }
    }
    const float* g = p.MOD + ((size_t)l * 3 + modset(r)) * NMOD + 5 * D + n;
    float* xr = xrow(p, r) + n;
    xr[0] += g[0] * a0; xr[1] += g[1] * a1; xr[2] += g[2] * a2; xr[3] += g[3] * a3;
}


#ifndef HGRN_DIAG
#define HGRN_DIAG 0
#endif
BODY void b_hgrn_chunkseq(long gid, PRef p, int l) {
    const int v = (int)(gid % 64), pc = (int)((gid / 64) % NCH), bh = (int)((gid / (64 * NCH)) % NBH), dir = (int)(gid / (64L * NCH * NBH));
    const int h = bh % HGH, b = bh / HGH, row0 = pc < NCHC ? NLAT + b * CTX + pc * 64 : b * SEQ + (pc - NCHC) * 64;
    const bf16_t* sin = p.SLOC + ((size_t)(dir * NBH + bh) * NCH + pc) * 4096 + v * 64;
    float S[64];
#pragma unroll
    for (int k = 0; k < 64; ++k) S[k] = bf2f(sin[k]);
    for (int i = 0; i < 64; ++i) {
        const int r = row0 + (dir ? 63 - i : i);
        const float vv = bf2f(p.P[(size_t)r * INC + OHI + h * 64 + v]);
        const bf16_t* zr = p.P + (size_t)r * INC + (dir ? OFB : OFF_) + h * 64;
        const bf16_t* qr = p.P + (size_t)r * INC + OHQ + h * 64;
        const float* lb = p.LB + (size_t)(dir * DEPTH + l) * 384 + h * 64;
        float o = 0.f;
#pragma unroll
        for (int k = 0; k < 64; ++k) { const float f = lb[k] + (1.f - lb[k]) * sigmoid_f(bf2f(zr[k])); S[k] = f * S[k] + (1.f - f) * vv; o += S[k] * bf2f(qr[k]); }
        p.OHG[((size_t)dir * NTOK + r) * 384 + h * 64 + v] = o * 0.125f;
    }
}

BODY void b_hgrn_scan_slow(long gid, PRef p, int) {
    const int e = (int)(gid % 4096), sq = (int)(gid / 4096), dir = sq / NBH, k = e & 63;
    bf16_t* S = p.SLOC + (size_t)sq * NCH * 4096 + e;
    const float* G = p.GDEC + (size_t)sq * NCH * 64 + k;
    float c = 0.f;
    for (int j = 0; j < NCH; ++j) {
        const int pc = dir ? (j < NCHC ? NCHC - 1 - j : NCH + NCHC - 1 - j) : j;
        const float x = bf2f(S[(size_t)pc * 4096]);
        S[(size_t)pc * 4096] = f2bf(c);
        c = G[(size_t)pc * 64] * c + x;
    }
}

BODY void b_hgrn_local_slow(long gid, PRef p, int l) {
    const int v = (int)(gid % 64), pc = (int)((gid / 64) % NCH), bh = (int)((gid / (64 * NCH)) % NBH), dir = (int)(gid / (64L * NCH * NBH));
    const int h = bh % HGH, b = bh / HGH, row0 = pc < NCHC ? NLAT + b * CTX + pc * 64 : b * SEQ + (pc - NCHC) * 64;
    float S[64], g[64];
#pragma unroll
    for (int k = 0; k < 64; ++k) { S[k] = 0.f; g[k] = 1.f; }
    for (int i = 0; i < 64; ++i) {
        const int r = row0 + (dir ? 63 - i : i);
        const float vv = bf2f(p.P[(size_t)r * INC + OHI + h * 64 + v]);
        const bf16_t* zr = p.P + (size_t)r * INC + (dir ? OFB : OFF_) + h * 64;
        const float* lb = p.LB + (size_t)(dir * DEPTH + l) * 384 + h * 64;
#pragma unroll
        for (int k = 0; k < 64; ++k) { const float f = lb[k] + (1.f - lb[k]) * sigmoid_f(bf2f(zr[k])); S[k] = f * S[k] + (1.f - f) * vv; g[k] *= f; }
    }
    bf16_t* dst = p.SLOC + ((size_t)(dir * NBH + bh) * NCH + pc) * 4096 + v * 64;
    if (HGRN_DIAG != 3 && HGRN_DIAG != 4) {
#pragma unroll
    for (int k = 0; k < 64; ++k) dst[k] = f2bf(S[k]);
    }
    if (v == 0) {
        float* gd = p.GDEC + ((size_t)(dir * NBH + bh) * NCH + pc) * 64;
#pragma unroll
        for (int k = 0; k < 64; ++k) gd[k] = g[k];
    }
}
#ifndef FAST_TOPK
#define FAST_TOPK 1
#endif
#ifndef FAST_HGRN
#define FAST_HGRN 1
#endif
#ifndef FAST_ATTN
#define FAST_ATTN 1
#endif
constexpr size_t al256(size_t x) { return (x + 255) & ~(size_t)255; }
constexpr size_t CTL_BYTES = 65536;
constexpr size_t WS_CTL = 0;
constexpr size_t WS_MOD = WS_CTL + CTL_BYTES;
constexpr size_t WS_LB = WS_MOD + al256((size_t)DEPTH * 3 * NMOD * 4);
constexpr size_t WS_XC = WS_LB + al256((size_t)2 * DEPTH * 384 * 4);
constexpr size_t WS_AFF = WS_XC + al256((size_t)NCTX * D * 4);
constexpr size_t WS_SVAL = WS_AFF + al256((size_t)NTOK * NE * 4);
constexpr size_t WS_STOK = WS_SVAL + al256((size_t)NSLOT * 4);
constexpr size_t WS_INV = WS_STOK + al256((size_t)NSLOT * 4);
constexpr size_t WS_H = WS_INV + al256((size_t)NTOK * NE * 4);
constexpr size_t WS_MIX = WS_H + al256((size_t)NTOK * D * 2);
constexpr size_t WS_P = WS_MIX + al256((size_t)NTOK * MIXD * 2);
constexpr size_t WS_HID = WS_P;
constexpr size_t WS_Y = WS_HID + al256((size_t)NSLOT * ED * 2);
constexpr size_t WS_P_END0 = WS_P + al256((size_t)NTOK * INC * 2);
constexpr size_t WS_P_END1 = WS_Y + al256((size_t)NSLOT * D * 2);
constexpr size_t WS_WB = WS_P_END0 > WS_P_END1 ? WS_P_END0 : WS_P_END1;
constexpr size_t WS_WIN_T = WS_WB;
constexpr size_t WS_WOUT_T = WS_WIN_T + al256((size_t)INC * D * 2);
constexpr size_t WS_WGU_T = WS_WOUT_T + al256((size_t)D * MIXD * 2);
constexpr size_t WS_WD_T = WS_WGU_T + al256((size_t)NE * 2 * ED * D * 2);
constexpr size_t WB_BYTES = WS_WD_T + al256((size_t)NE * D * ED * 2) - WS_WB;
constexpr size_t WS_T = WS_WB + 2 * WB_BYTES;
#if FAST_HGRN
constexpr size_t WS_SLOC = WS_T;
constexpr size_t WS_GDEC = WS_SLOC + al256((size_t)2 * NBH * NCH * 4096 * 2);
constexpr size_t WS_OHG = WS_GDEC + al256((size_t)2 * NBH * NCH * 64 * 4);
constexpr size_t WS_XB = WS_OHG + (HGRN_DIAG ? al256((size_t)2 * NTOK * 384 * 4) : 0);
constexpr size_t WS_END = WS_XB + al256((size_t)NLAT * D * 2);
constexpr size_t WS_FG = WS_T;
#else
constexpr size_t WS_FG = WS_T;
constexpr size_t WS_OHG = WS_FG + al256((size_t)NTOK * 768 * 4);
constexpr size_t WS_SLOC = WS_OHG + al256((size_t)2 * NTOK * 384 * 4);
constexpr size_t WS_GDEC = WS_SLOC;
constexpr size_t WS_XB = WS_SLOC;
constexpr size_t WS_END = WS_XB + al256((size_t)NLAT * D * 2);
#endif

static inline Params make_params(void* const* d_in, void* d_out, void* d_ws) {
    Params p{};
    const float** f = (const float**)&p;
    for (int i = 0; i < 20; ++i) f[i] = (const float*)d_in[i];
    char* ws = (char*)d_ws;
    p.XL = (float*)d_out; p.XC = (float*)(ws + WS_XC); p.MOD = (float*)(ws + WS_MOD); p.LB = (float*)(ws + WS_LB); p.AFF = (float*)(ws + WS_AFF);
    p.SVAL = (float*)(ws + WS_SVAL); p.FG = (float*)(ws + WS_FG); p.OHG = (float*)(ws + WS_OHG);
    p.H = (bf16_t*)(ws + WS_H); p.P = (bf16_t*)(ws + WS_P); p.MIX = (bf16_t*)(ws + WS_MIX); p.HID = (bf16_t*)(ws + WS_HID); p.Y = (bf16_t*)(ws + WS_Y);
    p.STOK = (int*)(ws + WS_STOK); p.INV = (int*)(ws + WS_INV);
    p.WIN_T = (bf16_t*)(ws + WS_WIN_T); p.WOUT_T = (bf16_t*)(ws + WS_WOUT_T); p.WGU_T = (bf16_t*)(ws + WS_WGU_T); p.WD_T = (bf16_t*)(ws + WS_WD_T);
    p.CTL = (unsigned*)(ws + WS_CTL); p.SLOC = (bf16_t*)(ws + WS_SLOC); p.GDEC = (float*)(ws + WS_GDEC); p.XB = (bf16_t*)(ws + WS_XB);
    return p;
}

#define FORWARD_STAGES(STAGE)                                                      \
    STAGE(b_adaln, (long)DEPTH * 3 * NMOD, 0)                                      \
    STAGE(b_lb, 2L * 384, 0)                                                       \
    STAGE(b_copyx, (long)NTOK * D, 0)                                              \
    for (int l = 0; l < DEPTH; ++l) {                                              \
        STAGE(b_prenorm<0>, (long)NTOK, l)                                         \
        STAGE(b_gemm_in, (long)NTOK * (INC / 4), l)                                \
        STAGE(b_qkprep, (long)NTOK * 12, l)                                        \
        STAGE(b_attn, (long)NTOK * NAH, l)                                         \
        STAGE(b_gates, (long)NTOK * 768, l)                                        \
        STAGE(b_hgrn_seq<0>, (long)NB * HGH * 64, l)                               \
        STAGE(b_hgrn_seq<1>, (long)NB * HGH * 64, l)                               \
        STAGE(b_hgfin, (long)NTOK * HGH, l)                                        \
        STAGE(b_conv, (long)NTOK * CVD, l)                                         \
        STAGE(b_gemm_out, (long)NTOK * (D / 4), l)                                 \
        STAGE(b_prenorm<1>, (long)NTOK, l)                                         \
        STAGE(b_rank, (long)NTOK * NE, l)                                          \
        STAGE(b_moe1, (long)NSLOT * (ED / 4), l)                                   \
        STAGE(b_moe2, (long)NSLOT * (D / 4), l)                                    \
        STAGE(b_combine, (long)NTOK * (D / 4), l)                                  \
    }

#ifndef CPU_SIM
#include <cstdio>
#define LAS __attribute__((address_space(3)))
#define GAS __attribute__((address_space(1)))
typedef short bf16x8 __attribute__((ext_vector_type(8)));
typedef float f32x4 __attribute__((ext_vector_type(4)));
typedef float f32x2 __attribute__((ext_vector_type(2)));
typedef unsigned u32x4 __attribute__((ext_vector_type(4)));
typedef unsigned u32x2 __attribute__((ext_vector_type(2)));
constexpr int NWAVES = 8, NTHR = 512;
constexpr int RING_BYTES = 131072, LDSCTL_OFF = RING_BYTES, MISC_OFF = LDSCTL_OFF + 320, TAB_OFF = LDSCTL_OFF + 1024  , LDS_BYTES = 147456;

typedef __bf16 bf16v2_t __attribute__((ext_vector_type(2)));
__device__ __forceinline__ unsigned cvt_pk_bf16_asm(float lo, float hi) { unsigned r; asm volatile("v_cvt_pk_bf16_f32 %0, %1, %2" : "=v"(r) : "v"(lo), "v"(hi)); return r; }
__device__ __forceinline__ unsigned cvt_pk_bf16(float lo, float hi) { bf16v2_t v = {(__bf16)lo, (__bf16)hi}; return __builtin_bit_cast(unsigned, v); }
#define DPPF(x, ctrl) __builtin_bit_cast(float, __builtin_amdgcn_update_dpp(0, __builtin_bit_cast(int, (x)), (ctrl), 0xF, 0xF, true))
#define DPP_X1 0xB1
#define DPP_X2 0x4E
#define DPP_HM 0x141
#define DPP_RM 0x140
__device__ __forceinline__ float x16_other(float x, int lane) { const unsigned u = __builtin_bit_cast(unsigned, x); const auto r = __builtin_amdgcn_permlane16_swap(u, u, false, false); return __builtin_bit_cast(float, (lane & 16) ? r[0] : r[1]); }
__device__ __forceinline__ float x32_other(float x, int lane) { const unsigned u = __builtin_bit_cast(unsigned, x); const auto r = __builtin_amdgcn_permlane32_swap(u, u, false, false); return __builtin_bit_cast(float, (lane & 32) ? r[0] : r[1]); }
__device__ __forceinline__ float x16_sum(float x, int lane) { return x + x16_other(x, lane); }
__device__ __forceinline__ float x32_sum(float x, int lane) { return x + x32_other(x, lane); }
__device__ __forceinline__ float x16_max(float x, int lane) { return fmaxf(x, x16_other(x, lane)); }
__device__ __forceinline__ float x32_max(float x, int lane) { return fmaxf(x, x32_other(x, lane)); }
__device__ __forceinline__ float row16_sum(float v) { v += DPPF(v, DPP_X1); v += DPPF(v, DPP_X2); v += DPPF(v, DPP_HM); v += DPPF(v, DPP_RM); return v; }
__device__ __forceinline__ float row16_max(float v) { v = fmaxf(v, DPPF(v, DPP_X1)); v = fmaxf(v, DPPF(v, DPP_X2)); v = fmaxf(v, DPPF(v, DPP_HM)); v = fmaxf(v, DPPF(v, DPP_RM)); return v; }
__device__ __forceinline__ float oct_sum(float v) { v += DPPF(v, DPP_X1); v += DPPF(v, DPP_X2); v += DPPF(v, DPP_HM); return v; }
__device__ __forceinline__ float wave_sum(float v, int lane) { return x32_sum(x16_sum(row16_sum(v), lane), lane); }

extern __shared__ __attribute__((aligned(16))) unsigned char lds_raw[];
#ifndef FUSE_QK
#define FUSE_QK 1
#endif
__device__ __forceinline__ float bfw(unsigned w, int hi) { return __builtin_bit_cast(float, hi ? (w & 0xffff0000u) : (w << 16)); }
__device__ __forceinline__ float bf8(const u32x4& v, int j) { return bfw(v[j >> 1], j & 1); }
namespace pg8 {
constexpr int BM = 256, BK = 64, HALF = 128, HTB = HALF * BK * 2, STAGE_BYTES = 8 * HTB, NXCD = 8, WGM = 8;
__device__ __forceinline__ int lds_byte(int r, int c) { const int st = (r >> 4) * 2 + (c >> 5), rr = r & 15, cc = c & 31, ob = rr * 64 + cc * 2; return st * 1024 + (ob ^ (((ob >> 9) & 1) << 5)); }
__device__ __forceinline__ void stage_rc(int b, int& R, int& C) { const int st = b / 1024, sb = b % 1024, swz = sb ^ (((sb >> 9) & 1) << 5); R = (st >> 1) * 16 + swz / 64; C = (st & 1) * 32 + (swz % 64) / 2; }
__device__ __forceinline__ int perm32(int rho) { const int n = rho >> 4, i = rho & 15; return 8 * (i >> 2) + 4 * n + (i & 3); }
struct Unit { int pm, pn; };
struct Gemm {
    const bf16_t* A; const bf16_t* Bt; int M, N, K;
    const int* gather;
    int gt, ng; size_t gstride;
};
struct StaticOrder {
    int nM, nN, nwg, G, c;
    __device__ void init(int M, int N, int G_, int c_) { nM = M / BM; nN = N / BM; nwg = nM * nN; G = G_; c = c_; }
    __device__ bool next(int i, Unit& u) const {
        const long L = (long)i * G + c; if (L >= nwg) return false;
        int wgid = (int)L; { const int q = nwg / NXCD, r = nwg % NXCD, xcd = wgid % NXCD, off = wgid / NXCD; wgid = (xcd < r ? xcd * (q + 1) : r * (q + 1) + (xcd - r) * q) + off; }
        const int nig = WGM * nN, gid = wgid / nig, fm = gid * WGM, gsz = (nM - fm) < WGM ? (nM - fm) : WGM;
        u.pm = fm + ((wgid % nig) % gsz); u.pn = (wgid % nig) / gsz; return true;
    }
};
struct EpiBf16 {
    static constexpr bool PERM = true;
    bf16_t* O; int ldc; const float* rowscale; int skip;
    __device__ __forceinline__ void operator()(const f32x4 (&acc)[2][2][4][2], const Unit& u, int wr, int wc, int fr, int fq) const {
        const int row0 = u.pm * BM + wr * 64 + fr, col0 = u.pn * BM + wc * 32 + 8 * fq;
        if (skip) { asm volatile("" :: "v"(acc[0][0][0][0]), "v"(acc[1][1][3][1])); return; }
        float scv[2][4];
#pragma unroll
        for (int ai = 0; ai < 2; ++ai)
#pragma unroll
            for (int m = 0; m < 4; ++m) scv[ai][m] = rowscale ? rowscale[row0 + ai * HALF + m * 16] : 1.f;
        asm volatile("" ::: "memory");
#pragma unroll
        for (int ai = 0; ai < 2; ++ai)
#pragma unroll
            for (int m = 0; m < 4; ++m) { const int row = row0 + ai * HALF + m * 16; bf16_t* rowp = O + (size_t)row * ldc + col0; const float sc = scv[ai][m];
#pragma unroll
                for (int bj = 0; bj < 2; ++bj) { const f32x4 v0 = acc[ai][bj][m][0] * sc, v1 = acc[ai][bj][m][1] * sc;
                    u32x4 w; w.x = cvt_pk_bf16_asm(v0[0], v0[1]); w.y = cvt_pk_bf16_asm(v0[2], v0[3]); w.z = cvt_pk_bf16_asm(v1[0], v1[1]); w.w = cvt_pk_bf16_asm(v1[2], v1[3]);
                    *(u32x4*)(rowp + bj * HALF) = w; } }
    }
};
struct EpiP {
    static constexpr bool PERM = true;
    bf16_t* O; int ldc; const float* qn; const float* kn; int skip;
    __device__ __forceinline__ void operator()(const f32x4 (&acc)[2][2][4][2], const Unit& u, int wr, int wc, int fr, int fq) const {
        const int row0 = u.pm * BM + wr * 64 + fr, col0 = u.pn * BM + wc * 32 + 8 * fq;
        if (skip) { asm volatile("" :: "v"(acc[0][0][0][0]), "v"(acc[1][1][3][1])); return; }
        if (u.pn >= 3 || !FUSE_QK) {
#pragma unroll
            for (int ai = 0; ai < 2; ++ai)
#pragma unroll
                for (int m = 0; m < 4; ++m) { bf16_t* rowp = O + (size_t)(row0 + ai * HALF + m * 16) * ldc + col0;
#pragma unroll
                    for (int bj = 0; bj < 2; ++bj) { const f32x4 v0 = acc[ai][bj][m][0], v1 = acc[ai][bj][m][1];
                        u32x4 w; w.x = cvt_pk_bf16_asm(v0[0], v0[1]); w.y = cvt_pk_bf16_asm(v0[2], v0[3]); w.z = cvt_pk_bf16_asm(v1[0], v1[1]); w.w = cvt_pk_bf16_asm(v1[2], v1[3]);
                        *(u32x4*)(rowp + bj * HALF) = w; } }
            return;
        }
        LAS float* PS = (LAS float*)((LAS unsigned char*)lds_raw + LDSCTL_OFF + 4096);
        const int half = wc & 1, hw = wc >> 1;
        unsigned lm_ = ~0u; asm volatile("" : "+s"(lm_)); const int lane = (int)__builtin_amdgcn_mbcnt_hi(lm_, __builtin_amdgcn_mbcnt_lo(lm_, 0u));
#pragma unroll
        for (int ai = 0; ai < 2; ++ai)
#pragma unroll
            for (int m = 0; m < 4; ++m)
#pragma unroll
                for (int bj = 0; bj < 2; ++bj) { const f32x4 v0 = acc[ai][bj][m][0], v1 = acc[ai][bj][m][1];
                    float s = (v0[0] * v0[0] + v0[1] * v0[1]) + (v0[2] * v0[2] + v0[3] * v0[3]) + (v1[0] * v1[0] + v1[1] * v1[1]) + (v1[2] * v1[2] + v1[3] * v1[3]);
                    s = x32_sum(x16_sum(s, lane), lane);
                    if (fq == 0) PS[((ai * HALF + wr * 64 + m * 16 + fr) * 4 + 2 * bj + hw) * 2 + half] = s; }
        asm volatile("s_waitcnt lgkmcnt(0)" ::: "memory"); __builtin_amdgcn_s_barrier(); asm volatile("" ::: "memory");
        float invf[8];
#pragma unroll
        for (int j = 0; j < 8; ++j) invf[j] = __builtin_amdgcn_exp2f(-(float)(8 * (fq & 1) + j) * (13.287712379549449f / 16.f));
        const bool second = (fq & 2) != 0;
        f32x4 nwv[2][2];
#pragma unroll
        for (int bj = 0; bj < 2; ++bj) { const bool isk = (u.pn * BM + bj * HALF + wc * 32) >= 384; const float* nw = (isk ? kn : qn) + 32 * half + 8 * fq; nwv[bj][0] = *(const f32x4*)nw; nwv[bj][1] = *(const f32x4*)(nw + 4); }
        asm volatile("" ::: "memory");
#pragma unroll
        for (int ai = 0; ai < 2; ++ai)
#pragma unroll
            for (int m = 0; m < 4; ++m) {
                const int grow = row0 + ai * HALF + m * 16; const bool lat = grow < NLAT; const int t = lat ? grow % SEQ : 0;
                int tp = half ? t % GW : t / GW; asm volatile("" : "+v"(tp));
                const float pos = (float)tp;
                float cs[8], sn[8];
#pragma unroll
                for (int j = 0; j < 8; ++j) { const float ang = pos * invf[j]; cs[j] = __cosf(ang); sn[j] = __sinf(ang); }
                bf16_t* rowp = O + (size_t)grow * ldc + col0;
#pragma unroll
                for (int bj = 0; bj < 2; ++bj) {
                    const int rl = ai * HALF + wr * 64 + m * 16 + fr, head = 2 * bj + hw;
                    const float ssq = PS[(rl * 4 + head) * 2] + PS[(rl * 4 + head) * 2 + 1];
                    const bool isk = (u.pn * BM + bj * HALF + wc * 32) >= 384;
                    const float rstd = (isk ? 1.f : 0.125f * 1.44269504089f) / sqrtf(ssq * (1.f / HD) + EPS);
                    const f32x4 n0 = nwv[bj][0], n1 = nwv[bj][1];
                    float y[8];
#pragma unroll
                    for (int j = 0; j < 4; ++j) { y[j] = acc[ai][bj][m][0][j] * rstd * n0[j]; y[4 + j] = acc[ai][bj][m][1][j] * rstd * n1[j]; }
#pragma unroll
                    for (int j = 0; j < 8; ++j) {
                        const unsigned yb = __builtin_bit_cast(unsigned, y[j]);
                        const auto sw = __builtin_amdgcn_permlane32_swap(yb, yb, false, false);
                        const float other = __builtin_bit_cast(float, lane < 32 ? sw[1] : sw[0]);
                        const float rot = second ? y[j] * cs[j] + other * sn[j] : y[j] * cs[j] - other * sn[j];
                        y[j] = lat ? rot : y[j];
                    }
                    u32x4 w; w.x = cvt_pk_bf16(y[0], y[1]); w.y = cvt_pk_bf16(y[2], y[3]); w.z = cvt_pk_bf16(y[4], y[5]); w.w = cvt_pk_bf16(y[6], y[7]);
                    *(u32x4*)(rowp + bj * HALF) = w;
                }
                asm volatile("" ::: "memory");
            }
    }
};
struct EpiRes {
    static constexpr bool PERM = true;
    bf16_t* X; int ldc; const float* gate0; int rows_per_set; size_t set_stride;
    __device__ __forceinline__ void operator()(const f32x4 (&acc)[2][2][4][2], const Unit& u, int wr, int wc, int fr, int fq) const {
        const int row0 = u.pm * BM + wr * 64 + fr, col0 = u.pn * BM + wc * 32 + 8 * fq;
        const float* gate = gate0 + (size_t)((u.pm * BM) / rows_per_set) * set_stride;
        f32x4 gv[2][2];
#pragma unroll
        for (int bj = 0; bj < 2; ++bj)
#pragma unroll
            for (int n = 0; n < 2; ++n) gv[bj][n] = *(const f32x4*)(gate + col0 + bj * HALF + n * 4);
        u32x4 rv[2][4][2];
#pragma unroll
        for (int ai = 0; ai < 2; ++ai)
#pragma unroll
            for (int m = 0; m < 4; ++m)
#pragma unroll
                for (int bj = 0; bj < 2; ++bj) rv[ai][m][bj] = *(const u32x4*)(X + (size_t)(row0 + ai * HALF + m * 16) * ldc + col0 + bj * HALF);
        asm volatile("" ::: "memory");
#pragma unroll
        for (int ai = 0; ai < 2; ++ai)
#pragma unroll
            for (int m = 0; m < 4; ++m) { bf16_t* rowp = X + (size_t)(row0 + ai * HALF + m * 16) * ldc + col0;
#pragma unroll
                for (int bj = 0; bj < 2; ++bj) { const u32x4 r = rv[ai][m][bj];
                    const f32x4 x0 = (f32x4){bfw(r.x, 0), bfw(r.x, 1), bfw(r.y, 0), bfw(r.y, 1)}, x1 = (f32x4){bfw(r.z, 0), bfw(r.z, 1), bfw(r.w, 0), bfw(r.w, 1)};
                    const f32x4 v0 = x0 + gv[bj][0] * acc[ai][bj][m][0], v1 = x1 + gv[bj][1] * acc[ai][bj][m][1];
                    u32x4 w; w.x = cvt_pk_bf16_asm(v0[0], v0[1]); w.y = cvt_pk_bf16_asm(v0[2], v0[3]); w.z = cvt_pk_bf16_asm(v1[0], v1[1]); w.w = cvt_pk_bf16_asm(v1[2], v1[3]);
                    *(u32x4*)(rowp + bj * HALF) = w; } }
    }
};
struct EpiHid {
    static constexpr bool PERM = false;
    bf16_t* O; int ldc;
    __device__ __forceinline__ void operator()(const f32x4 (&acc)[2][2][4][2], const Unit& u, int wr, int wc, int fr, int fq) const {
        const int row0 = u.pm * BM + wr * 64 + fr, col0 = (u.pn * BM + wc * 32) / 2 + 4 * fq;
#pragma unroll
        for (int ai = 0; ai < 2; ++ai)
#pragma unroll
            for (int m = 0; m < 4; ++m) { bf16_t* rowp = O + (size_t)(row0 + ai * HALF + m * 16) * ldc + col0;
#pragma unroll
                for (int bj = 0; bj < 2; ++bj) { const f32x4 g = acc[ai][bj][m][0], up = acc[ai][bj][m][1]; f32x4 h;
#pragma unroll
                    for (int j = 0; j < 4; ++j) h[j] = g[j] * __builtin_amdgcn_rcpf(1.f + __expf(-g[j])) * up[j];
                    u32x2 w; w.x = cvt_pk_bf16_asm(h[0], h[1]); w.y = cvt_pk_bf16_asm(h[2], h[3]);
                    *(u32x2*)(rowp + bj * (HALF / 2)) = w; } }
    }
};

template <class Epi, bool GATHER>
__device__ __forceinline__ void gemm_phase(const int tid, LAS unsigned char* lds, const Gemm g, const StaticOrder& S, const Epi& E) {
    const int wid = __builtin_amdgcn_readfirstlane(tid >> 6), lane = tid & 63, wr = wid >> 2, wc = wid & 3, fr = lane & 15, fq = lane >> 4;
    const int K = g.K, nt = K / BK;
    unsigned voffA[2], voffB[2];
#pragma unroll
    for (int i = 0; i < 2; ++i) { int R, C; stage_rc(tid * 16 + i * 8192, R, C); const int Rb = Epi::PERM ? ((R & ~31) + perm32(R & 31)) : R;
        voffB[i] = (unsigned)(Rb * K + C) * 2u; voffA[i] = GATHER ? (unsigned)(C * 2) : (Epi::PERM ? (unsigned)(R * K + C) * 2u : voffB[i]); }
    const size_t kstep = (size_t)(BK * 2);
    const size_t hstep = (size_t)HALF * K * 2;
    const size_t tstep = 2 * hstep;
    const unsigned ldsw = (unsigned)wid * 1024u;
    const int aoff = lds_byte(wr * 64 + fr, fq * 8), boff = lds_byte(wc * 32 + fr, fq * 8);
#define PG8_SA(b, h) (((b) * 2 + (h)) * HTB)
#define PG8_SB(b, h) ((4 + (b) * 2 + (h)) * HTB)
#define PG8_STAGE(bufoff, gbase, voff) do { const char* gb_ = (const char*)(gbase); asm volatile("" : "+s"(gb_)); _Pragma("unroll") for (int _i = 0; _i < 2; ++_i) \
        __builtin_amdgcn_global_load_lds((const unsigned*)(gb_ + (voff)[_i]), (LAS unsigned*)(lds + (bufoff) + ldsw + _i * 8192), 16, 0, 0); } while (0)
#define PG8_STAGE_A(bufoff, ubase, kt, h, tb) do { if constexpr (GATHER) { \
        if ((tb) < 0) { PG8_STAGE(bufoff, Ab + (size_t)(kt) * kstep, oAc[h]); } else { \
        unsigned m_ = ~0u; asm volatile("" : "+s"(m_)); const int tl_ = wid * 64 + (int)__builtin_amdgcn_mbcnt_hi(m_, __builtin_amdgcn_mbcnt_lo(m_, 0u)); \
        _Pragma("unroll") for (int _i = 0; _i < 2; ++_i) { int _R, _C; stage_rc(tl_ * 16 + _i * 8192, _R, _C); \
            const unsigned _o = min(*(const LAS unsigned*)(lds + TAB_OFF + (tb) * 1024 + ((h) * HALF + _R) * 4), (unsigned)(NTOK - 1)) * (unsigned)(K * 2) + (unsigned)(_C * 2); \
            __builtin_amdgcn_global_load_lds((const unsigned*)(Ab + (size_t)(kt) * kstep + _o), (LAS unsigned*)(lds + (bufoff) + ldsw + _i * 8192), 16, 0, 0); } } } \
        else { PG8_STAGE(bufoff, (ubase) + (size_t)(kt) * kstep + (size_t)(h) * hstep, voffA); } } while (0)
#define PG8_LOADOFFS(tb) do { if constexpr (GATHER) { unsigned m_ = ~0u; asm volatile("" : "+s"(m_)); const int tl_ = wid * 64 + (int)__builtin_amdgcn_mbcnt_hi(m_, __builtin_amdgcn_mbcnt_lo(m_, 0u)); \
        _Pragma("unroll") for (int _h = 0; _h < 2; ++_h) _Pragma("unroll") for (int _i = 0; _i < 2; ++_i) { int _R, _C; stage_rc(tl_ * 16 + _i * 8192, _R, _C); \
            oAc[_h][_i] = min(*(const LAS unsigned*)(lds + TAB_OFF + (tb) * 1024 + (_h * HALF + _R) * 4), (unsigned)(NTOK - 1)) * (unsigned)(K * 2) + (unsigned)(_C * 2); } } } while (0)
#define PG8_FILLTAB(u, tb) do { if constexpr (GATHER) { unsigned m_ = ~0u; asm volatile("" : "+s"(m_)); const int tl_ = wid * 64 + (int)__builtin_amdgcn_mbcnt_hi(m_, __builtin_amdgcn_mbcnt_lo(m_, 0u)); \
        if (tl_ < 256) *(LAS unsigned*)(lds + TAB_OFF + (tb) * 1024 + tl_ * 4) = (unsigned)g.gather[(u).pm * BM + tl_]; } } while (0)
#define PG8_LDA(dst, b, h) do { _Pragma("unroll") for (int m = 0; m < 4; ++m) _Pragma("unroll") for (int k = 0; k < 2; ++k) dst[m][k] = *(const LAS bf16x8*)(lds + PG8_SA(b, h) + aoff + m * 2048 + k * 1024); } while (0)
#define PG8_LDB(dst, b, h) do { _Pragma("unroll") for (int n = 0; n < 2; ++n) _Pragma("unroll") for (int k = 0; k < 2; ++k) dst[n][k] = *(const LAS bf16x8*)(lds + PG8_SB(b, h) + boff + n * 2048 + k * 1024); } while (0)
#define PG8_MMA(ai, bj, At, Bt) do { __builtin_amdgcn_s_setprio(1); _Pragma("unroll") for (int m = 0; m < 4; ++m) _Pragma("unroll") for (int n = 0; n < 2; ++n) _Pragma("unroll") for (int k = 0; k < 2; ++k) \
        acc[ai][bj][m][n] = __builtin_amdgcn_mfma_f32_16x16x32_bf16(Bt[n][k], At[m][k], acc[ai][bj][m][n], 0, 0, 0); __builtin_amdgcn_s_setprio(0); } while (0)
#define PG8_WAIT_V(n) asm volatile("s_waitcnt vmcnt(" #n ")" ::: "memory")
#define PG8_WAIT_L(n) asm volatile("s_waitcnt lgkmcnt(" #n ")" ::: "memory")
#define PG8_BAR __builtin_amdgcn_s_barrier()
#define PG8_SCHED __builtin_amdgcn_sched_barrier(0)
#define PG8_KTILE2(u1, k1, o1, u2, k2, o2, b2p) do { \
        PG8_LDB(B0, 0, 0); PG8_LDB(B1, 0, 1); PG8_SCHED; PG8_LDA(At, 0, 0); PG8_STAGE_A(PG8_SA(1, 1), u1, k1, 1, o1); \
        PG8_WAIT_V(8); PG8_WAIT_L(0); PG8_BAR; PG8_MMA(0, 0, At, B0); PG8_MMA(0, 1, At, B1); PG8_BAR; PG8_SCHED; \
        PG8_LDA(At, 0, 1); PG8_STAGE(PG8_SB(0, 0), b2p, voffB); PG8_STAGE(PG8_SB(0, 1), (b2p) + hstep, voffB); PG8_STAGE_A(PG8_SA(0, 0), u2, k2, 0, o2); \
        PG8_WAIT_V(8); PG8_WAIT_L(0); PG8_BAR; PG8_MMA(1, 0, At, B0); PG8_MMA(1, 1, At, B1); PG8_BAR; PG8_SCHED; \
        PG8_LDB(B0, 1, 0); PG8_LDB(B1, 1, 1); PG8_SCHED; PG8_LDA(At, 1, 0); PG8_STAGE_A(PG8_SA(0, 1), u2, k2, 1, o2); \
        PG8_WAIT_V(8); PG8_WAIT_L(0); PG8_BAR; PG8_MMA(0, 0, At, B0); PG8_MMA(0, 1, At, B1); PG8_BAR; PG8_SCHED; \
        PG8_LDA(At, 1, 1); PG8_STAGE(PG8_SB(1, 0), (b2p) + kstep, voffB); PG8_STAGE(PG8_SB(1, 1), (b2p) + kstep + hstep, voffB); PG8_STAGE_A(PG8_SA(1, 0), u2, (k2) + 1, 0, o2); \
        PG8_WAIT_V(8); PG8_WAIT_L(0); PG8_BAR; PG8_MMA(1, 0, At, B0); PG8_MMA(1, 1, At, B1); PG8_BAR; PG8_SCHED; } while (0)
#define PG8_BPTR(u) ((const char*)g.Bt + (g.gt ? (size_t)(((u).pm / g.gt) % g.ng) * g.gstride : (size_t)0) + (size_t)(u).pn * tstep)
    Unit cur, nxt; int ui = 0;
    if (!S.next(0, cur)) return;
#ifndef LATE_START
#define LATE_START 4
#endif
#ifndef GEMM_STAGGER
#define GEMM_STAGGER 0
#endif
    if (GEMM_STAGGER) { const int dg_ = ((int)blockIdx.x >> 3) & 3; for (int i_ = 0; i_ < dg_; ++i_) __builtin_amdgcn_s_sleep(GEMM_STAGGER); }
    if (S.nwg % S.G != 0 && S.c >= S.nwg % S.G) { for (int i_ = 0; i_ < LATE_START; ++i_) __builtin_amdgcn_s_sleep(127); }
    f32x4 acc[2][2][4][2];
#pragma unroll
    for (int a = 0; a < 2; ++a)
#pragma unroll
        for (int b = 0; b < 2; ++b)
#pragma unroll
            for (int m = 0; m < 4; ++m)
#pragma unroll
                for (int n = 0; n < 2; ++n) acc[a][b][m][n] = (f32x4){0.f, 0.f, 0.f, 0.f};
    bf16x8 At[4][2], B0[2][2], B1[2][2];
    unsigned oAc[2][2] = {{0u, 0u}, {0u, 0u}};
    const char* const Ab = (const char*)g.A;
    const char* cA = Ab + (size_t)cur.pm * tstep;
    const char* cB = PG8_BPTR(cur);
    PG8_FILLTAB(cur, 0);
    if constexpr (GATHER) { PG8_WAIT_L(0); PG8_BAR; PG8_LOADOFFS(0); }
    PG8_STAGE(PG8_SB(0, 0), cB, voffB); PG8_STAGE(PG8_SB(0, 1), cB + hstep, voffB); PG8_STAGE_A(PG8_SA(0, 0), cA, 0, 0, -1); PG8_STAGE_A(PG8_SA(0, 1), cA, 0, 1, -1);
    if (wr == 1) PG8_BAR;
    PG8_WAIT_V(2); PG8_BAR;
    PG8_STAGE(PG8_SB(1, 0), cB + kstep, voffB); PG8_STAGE_A(PG8_SA(1, 0), cA, 1, 0, -1); PG8_STAGE(PG8_SB(1, 1), cB + hstep + kstep, voffB);
    PG8_WAIT_V(6); PG8_BAR;
    for (;;) {
        const bool has_next = S.next(ui + 1, nxt);
        const char* nA = has_next ? Ab + (size_t)nxt.pm * tstep : cA; const char* nB = has_next ? PG8_BPTR(nxt) : cB;
        const int tbc = ui & 1, tbn = has_next ? ((ui + 1) & 1) : (ui & 1);
        if constexpr (GATHER) { if (has_next && wid < 4) { unsigned m_ = ~0u; asm volatile("" : "+s"(m_)); const int tl_ = wid * 64 + (int)__builtin_amdgcn_mbcnt_hi(m_, __builtin_amdgcn_mbcnt_lo(m_, 0u));
            __builtin_amdgcn_global_load_lds((const unsigned*)(g.gather + nxt.pm * BM + tl_), (LAS unsigned*)(lds + TAB_OFF + tbn * 1024 + wid * 256), 4, 0, 0); } }
        for (int t = 0; t < nt - 2; t += 2) { const char* b2 = cB + (size_t)(t + 2) * kstep; PG8_KTILE2(cA, t + 1, -1, cA, t + 2, -1, b2); }
        PG8_KTILE2(cA, nt - 1, -1, nA, 0, tbn, nB);
        if (wr == 0) PG8_BAR;
        { unsigned m_ = ~0u; asm volatile("" : "+s"(m_)); int l2 = (int)__builtin_amdgcn_mbcnt_hi(m_, __builtin_amdgcn_mbcnt_lo(m_, 0u)); asm volatile("" : "+v"(l2)); E(acc, cur, wr, wc, l2 & 15, l2 >> 4); }
        if (!has_next) break;
#pragma unroll
        for (int a = 0; a < 2; ++a)
#pragma unroll
            for (int b = 0; b < 2; ++b)
#pragma unroll
                for (int m = 0; m < 4; ++m)
#pragma unroll
                    for (int n = 0; n < 2; ++n) acc[a][b][m][n] = (f32x4){0.f, 0.f, 0.f, 0.f};
        cur = nxt; cA = nA; cB = nB; ++ui;
        PG8_LOADOFFS(ui & 1);
        if (wr == 1) PG8_BAR;
    }
    PG8_WAIT_V(0);
    PG8_BAR;
#undef PG8_STAGE_A
#undef PG8_FILLTAB
#undef PG8_LOADOFFS
#undef PG8_SA
#undef PG8_SB
#undef PG8_STAGE
#undef PG8_LDA
#undef PG8_LDB
#undef PG8_MMA
#undef PG8_WAIT_V
#undef PG8_WAIT_L
#undef PG8_BAR
#undef PG8_SCHED
#undef PG8_KTILE2
#undef PG8_BPTR
}
}

#define XB_TMO      128
#define XB_XCNT(j)  (256  + 64 * (j))
#define XB_XSUB(j)  (1280 + 64 * (j))
#define XB_XGEN(j)  (2304 + 64 * (j))
#define XB_TOP      3328
#define XB_TOPGEN   3392
#define XCD_BAR_WORDS 3456
#define XB_SPIN_CAP (1u << 20)
__device__ __forceinline__ unsigned xb_ld(unsigned* p)              { return __hip_atomic_load(p, __ATOMIC_RELAXED, __HIP_MEMORY_SCOPE_AGENT); }
__device__ __forceinline__ unsigned xb_add(unsigned* p, unsigned v) { return __hip_atomic_fetch_add(p, v, __ATOMIC_RELAXED, __HIP_MEMORY_SCOPE_AGENT); }
__device__ __forceinline__ unsigned xb_xcc_id() { return (unsigned)__builtin_amdgcn_s_getreg((3 << 11) | 20) & 0xFu; }
#define XB_SPIN(cond, bar) do { unsigned _sp = 0; while (cond) { __builtin_amdgcn_s_sleep(1); \
    if ((++_sp & 255u) == 0u) { if (xb_ld(&(bar)[XB_TMO])) break; if (_sp > XB_SPIN_CAP) { atomicAdd(&(bar)[XB_TMO], 1u); break; } } } } while (0)
struct XcdBarrier { unsigned* bar; unsigned x; };
#define XB_ST(ldsbase) ((volatile LAS unsigned*)((LAS unsigned char*)(ldsbase) + MISC_OFF + 32))
__device__ __forceinline__ XcdBarrier xcd_barrier_post(unsigned* bar, bool leader) {
    XcdBarrier b; b.bar = bar; b.x = xb_xcc_id();
    if (leader) (void)xb_add(&bar[XB_XCNT(b.x)], 1u);
    return b;
}
__device__ __forceinline__ void xcd_barrier_complete(unsigned* bar, unsigned x, unsigned& nloc, unsigned& nx) {
    const unsigned G = gridDim.x * gridDim.y * gridDim.z;
    unsigned sum, cnt, mine, sp = 0u;
    for (;;) {
        sum = 0u; cnt = 0u; mine = 0u;
#pragma unroll
        for (unsigned j = 0; j < 16; ++j) { const unsigned c = xb_ld(&bar[XB_XCNT(j)]); sum += c; cnt += (c > 0u) ? 1u : 0u; mine = (j == x) ? c : mine; }
        if (sum == G) break;
        __builtin_amdgcn_s_sleep(1);
        if ((++sp & 255u) == 0u) { if (xb_ld(&bar[XB_TMO])) break; if (sp > XB_SPIN_CAP) { atomicAdd(&bar[XB_TMO], 1u); break; } }
    }
    nloc = mine > 0u ? mine : 1u; nx = cnt > 0u ? cnt : 1u;
}
__device__ __forceinline__ void xcd_barrier(const XcdBarrier& b, bool leader, volatile LAS unsigned* st) {
    asm volatile("s_waitcnt vmcnt(0)" ::: "memory");
    __syncthreads();
    if (leader) {
        unsigned* bar = b.bar;
        __builtin_amdgcn_s_waitcnt(0);
        unsigned nloc = st[0], nx = st[1];
        if (nloc == 0u) { xcd_barrier_complete(bar, b.x, nloc, nx); st[0] = nloc; st[1] = nx; }
        const unsigned old = xb_add(&bar[XB_XSUB(b.x)], 1u);
        const unsigned gen = old / nloc;
        if (old + 1u == (gen + 1u) * nloc) {
            __builtin_amdgcn_fence(__ATOMIC_RELEASE, "agent");
            asm volatile("s_waitcnt vmcnt(0)" ::: "memory");
            const unsigned og = xb_add(&bar[XB_TOP], 1u);
            const unsigned tg = og / nx;
            if (og + 1u == (tg + 1u) * nx) xb_add(&bar[XB_TOPGEN], 1u);
            else XB_SPIN(xb_ld(&bar[XB_TOPGEN]) == tg, bar);
            __builtin_amdgcn_fence(__ATOMIC_ACQUIRE, "agent");
            xb_add(&bar[XB_XGEN(b.x)], 1u);
            asm volatile("s_waitcnt vmcnt(0)" ::: "memory");
        } else {
            XB_SPIN(xb_ld(&bar[XB_XGEN(b.x)]) == gen, bar);
            __builtin_amdgcn_fence(__ATOMIC_ACQUIRE, "agent");
            asm volatile("s_waitcnt vmcnt(0)" ::: "memory");
        }
    }
    __syncthreads();
}

template <void (*F)(long, PRef, int)> __device__ __forceinline__ void run_items(const int tid, PRef p, int l, long n, long off) {
    for (long gid = (long)blockIdx.x * NTHR + tid; gid < n; gid += (long)gridDim.x * NTHR) F(gid + off, p, l);
}
BODY void b_hgrn_seq2(long gid, PRef p, int l) { const long n1 = (long)NB * HGH * 64; if (gid < n1) b_hgrn_seq<0>(gid, p, l); else b_hgrn_seq<1>(gid - n1, p, l); }

template <int MAP> __device__ __forceinline__ void transpose_item(const float* W, int K, int N, bf16_t* WT, int row_off, LAS float* scr, int item, int lane) {
    const int nblk = N / 32, kb = item / nblk, nb = item % nblk, k0 = 64 * kb, n0 = 32 * nb;
#pragma unroll 8
    for (int i = 0; i < 32; ++i) { const int kk = 2 * i + (lane >> 5); scr[kk * 33 + (lane & 31)] = W[(size_t)(k0 + kk) * N + n0 + (lane & 31)]; }
    asm volatile("s_waitcnt lgkmcnt(0)" ::: "memory");
    const int c = lane & 7;
#pragma unroll
    for (int j = 0; j < 4; ++j) { const int n = (lane >> 3) + 8 * j; const LAS float* s = scr + (8 * c) * 33 + n;
        u32x4 o; o.x = cvt_pk_bf16(s[0 * 33], s[1 * 33]); o.y = cvt_pk_bf16(s[2 * 33], s[3 * 33]); o.z = cvt_pk_bf16(s[4 * 33], s[5 * 33]); o.w = cvt_pk_bf16(s[6 * 33], s[7 * 33]);
        const int nn = n0 + n; const int drow = MAP == 0 ? row_off + nn : (32 * (nn >> 4) + (nn & 15) + (MAP == 2 ? 16 : 0));
        *(u32x4*)(WT + (size_t)drow * K + k0 + 8 * c) = o; }
    asm volatile("s_waitcnt lgkmcnt(0)" ::: "memory");
}
#define WBOFF(l) ((size_t)((l) & 1) * (WB_BYTES / 2))
__device__ __forceinline__ void phase_convert(const int tid, PRef p, int l, LAS unsigned char* lds, int part = 0, int blk_lo = 0) {
    if ((int)blockIdx.x < blk_lo) return;
    const int lane = tid & 63, wave = tid >> 6;
    LAS float* scr = (LAS float*)(lds + wave * 16384);
    const int gw = ((int)blockIdx.x - blk_lo) * NWAVES + wave, NGW = ((int)gridDim.x - blk_lo) * NWAVES;
    constexpr int I_IN = (D / 64) * (INC / 32), I_OUT = (MIXD / 64) * (D / 32), I_G = (D / 64) * (ED / 32), I_D = (ED / 64) * (D / 32);
    constexpr int NITEMS = I_IN + I_OUT + NE * (2 * I_G + I_D);
    const int it_lo = part == 2 ? I_IN + I_OUT : 0, it_hi = part == 1 ? I_IN + I_OUT : NITEMS;
    for (int it = it_lo + gw; it < it_hi; it += NGW) {
        int r = it;
        if (r < I_IN) { transpose_item<0>(p.w_in + (size_t)l * D * INC, D, INC, p.WIN_T + WBOFF(l), 0, scr, r, lane); continue; } r -= I_IN;
        if (r < I_OUT) { transpose_item<0>(p.w_out + (size_t)l * MIXD * D, MIXD, D, p.WOUT_T + WBOFF(l), 0, scr, r, lane); continue; } r -= I_OUT;
        const int e = r / (2 * I_G + I_D); r -= e * (2 * I_G + I_D);
        if (r < I_G) { transpose_item<1>(p.w_gate + ((size_t)l * NE + e) * D * ED, D, ED, p.WGU_T + WBOFF(l) + (size_t)e * 2 * ED * D, 0, scr, r, lane); continue; } r -= I_G;
        if (r < I_G) { transpose_item<2>(p.w_up + ((size_t)l * NE + e) * D * ED, D, ED, p.WGU_T + WBOFF(l) + (size_t)e * 2 * ED * D, 0, scr, r, lane); continue; } r -= I_G;
        transpose_item<0>(p.w_down + ((size_t)l * NE + e) * ED * D, ED, D, p.WD_T + WBOFF(l) + (size_t)e * D * ED, 0, scr, r, lane);
    }
}
template <int WHICH> __device__ __forceinline__ void phase_prenorm(const int tid, PRef p, int l) {
    static_assert(D == 1024, "wave-per-row kernels assume D = 1024");
    const int lane = tid & 63, wave = tid >> 6;
    const int gw = blockIdx.x * NWAVES + wave, NGW = gridDim.x * NWAVES;
    const float* nw = (WHICH ? p.norm2_w : p.norm1_w) + l * D;
    for (int r = gw; r < NTOK; r += NGW) {
        const float* xr = xrow(p, r);
        const float* mod = p.MOD + ((size_t)l * 3 + modset(r)) * NMOD;
        const float* shift = mod + (WHICH ? 3 : 0) * D; const float* scale = mod + (WHICH ? 4 : 1) * D;
        f32x4 v[4]; float ss = 0.f;
#pragma unroll
        for (int j = 0; j < 4; ++j) { v[j] = *(const f32x4*)(xr + 4 * lane + 256 * j); ss += (v[j][0] * v[j][0] + v[j][1] * v[j][1]) + (v[j][2] * v[j][2] + v[j][3] * v[j][3]); }
        const float rstd = 1.f / sqrtf(wave_sum(ss, lane) * (1.f / D) + EPS);
        float lg[NE];
#pragma unroll
        for (int e = 0; e < NE; ++e) lg[e] = 0.f;
#pragma unroll
        for (int j = 0; j < 4; ++j) {
            const int c = 4 * lane + 256 * j;
            const f32x4 w4 = *(const f32x4*)(nw + c), sc4 = *(const f32x4*)(scale + c), sh4 = *(const f32x4*)(shift + c);
            f32x4 h;
#pragma unroll
            for (int i = 0; i < 4; ++i) h[i] = v[j][i] * rstd * w4[i] * (1.f + sc4[i]) + sh4[i];
            u32x2 o; o.x = cvt_pk_bf16(h[0], h[1]); o.y = cvt_pk_bf16(h[2], h[3]);
            *(u32x2*)(p.H + (size_t)r * D + c) = o;
            if (WHICH) {
#pragma unroll
                for (int i = 0; i < 4; ++i) { const f32x4* wr = (const f32x4*)(p.w_router + ((size_t)l * D + c + i) * NE);
#pragma unroll
                    for (int q = 0; q < 4; ++q) { const f32x4 w = wr[q]; lg[4 * q + 0] += h[i] * w[0]; lg[4 * q + 1] += h[i] * w[1]; lg[4 * q + 2] += h[i] * w[2]; lg[4 * q + 3] += h[i] * w[3]; } }
            }
        }
        if (WHICH) {
#pragma unroll
            for (int e = 0; e < NE; ++e) lg[e] = wave_sum(lg[e], lane);
            float m = lg[0];
#pragma unroll
            for (int e = 1; e < NE; ++e) m = fmaxf(m, lg[e]);
            float s = 0.f, mine = 0.f;
#pragma unroll
            for (int e = 0; e < NE; ++e) { const float ex = expf(lg[e] - m); s += ex; mine = (lane == e) ? ex : mine; }
            if (lane < NE) p.AFF[(size_t)r * NE + lane] = mine / s;
        }
    }
}
__device__ __forceinline__ void phase_combine(const int tid, PRef p, int l) {
    const int lane = tid & 63, wave = tid >> 6;
    const int gw = blockIdx.x * NWAVES + wave, NGW = gridDim.x * NWAVES;
    for (int r = gw; r < NTOK; r += NGW) {
        float* xr = xrow(p, r);
        const float* g = p.MOD + ((size_t)l * 3 + modset(r)) * NMOD + 5 * D;
        f32x4 acc[4];
#pragma unroll
        for (int j = 0; j < 4; ++j) acc[j] = (f32x4){0.f, 0.f, 0.f, 0.f};
        const int myinv = lane < NE ? p.INV[(size_t)r * NE + lane] : -1;
#pragma unroll
        for (int e = 0; e < NE; ++e) {
            const int s = __builtin_amdgcn_readlane(myinv, e);
            if (s >= 0 && s < NSLOT) {
                const bf16_t* y = p.Y + (size_t)s * D;
#pragma unroll
                for (int j = 0; j < 4; ++j) { const u32x2 w = *(const u32x2*)(y + 4 * lane + 256 * j);
                    acc[j][0] += __builtin_bit_cast(float, w.x << 16); acc[j][1] += __builtin_bit_cast(float, w.x & 0xffff0000u);
                    acc[j][2] += __builtin_bit_cast(float, w.y << 16); acc[j][3] += __builtin_bit_cast(float, w.y & 0xffff0000u); }
            }
        }
#pragma unroll
        for (int j = 0; j < 4; ++j) { const int c = 4 * lane + 256 * j; f32x4* q = (f32x4*)(xr + c); *q = *q + *(const f32x4*)(g + c) * acc[j]; }
    }
}


__device__ __forceinline__ unsigned wave_excl_scan(unsigned x, int lane) {
    unsigned inc = x;
#pragma unroll
    for (int d = 1; d < 64; d <<= 1) { const unsigned y = (unsigned)__builtin_amdgcn_ds_bpermute(((lane - d) & 63) << 2, (int)inc); if (lane >= d) inc += y; }
    return inc - x;
}
__device__ __forceinline__ void phase_topk(const int tid, PRef p, LAS unsigned char* lds) {
    LAS unsigned* keys = (LAS unsigned*)lds;
    LAS unsigned* hist = (LAS unsigned*)(lds + 70000);
    LAS unsigned* cgt = (LAS unsigned*)(lds + 76000);
    LAS unsigned* ceq = (LAS unsigned*)(lds + 80000);
    LAS unsigned* sh = (LAS unsigned*)(lds + 84000);
    static_assert(SEQ % 512 == 0 && SEQ + SEQ / 32 <= 17400, "topk LDS layout");
    constexpr int PER = SEQ / 512;
    for (int pr = blockIdx.x; pr < 2 * NB * NE; pr += gridDim.x) {
        const int e = pr % NE, b = (pr / NE) % NB, isctx = pr / (NE * NB);
        if (!isctx) {
            const int row0 = b * SEQ, base = (b * NE + e) * CAPL;
            for (int i = 0; i < PER; ++i) { const int t = i * 512 + tid; keys[t + (t >> 5)] = __builtin_bit_cast(unsigned, p.AFF[(size_t)(row0 + t) * NE + e]); }
            if (tid == 0) { sh[0] = 0u; sh[1] = (unsigned)CAPL; }
            __syncthreads();
            for (int pass = 0; pass < 3; ++pass) {
                const int shift = 20 - 10 * pass;
                for (int i = tid; i < 1024; i += 512) hist[i] = 0u;
                __syncthreads();
                const unsigned prefix = sh[0]; const unsigned himask = pass == 0 ? 0u : (0xFFFFFFFFu << (shift + 10));
                for (int i = 0; i < PER; ++i) { const int t = tid * PER + i; const unsigned k = keys[t + (t >> 5)]; if ((k & himask) == prefix) atomicAdd((unsigned*)&hist[(k >> shift) & 1023u], 1u); }
                __syncthreads();
                if (tid < 64) {
                    const unsigned need = sh[1];
                    unsigned c[16]; unsigned tot = 0u;
#pragma unroll
                    for (int q = 0; q < 16; ++q) { c[q] = hist[1023 - 16 * tid - q]; tot += c[q]; }
                    unsigned above = wave_excl_scan(tot, tid);
                    int fbin = -1; unsigned fabove = 0u;
#pragma unroll
                    for (int q = 0; q < 16; ++q) { if (fbin < 0 && above < need && above + c[q] >= need) { fbin = 1023 - 16 * tid - q; fabove = above; } above += c[q]; }
                    if (fbin >= 0) { sh[0] = prefix | ((unsigned)fbin << shift); sh[1] = need - fabove; }
                }
                __syncthreads();
            }
            const unsigned thr = sh[0], keq = sh[1];
            unsigned ng = 0u, nq = 0u;
            for (int i = 0; i < PER; ++i) { const int t = tid * PER + i; const unsigned k = keys[t + (t >> 5)]; ng += k > thr ? 1u : 0u; nq += k == thr ? 1u : 0u; }
            cgt[tid] = ng; ceq[tid] = nq;
            __syncthreads();
            if (tid < 64) {
                unsigned g[8], q[8], sg = 0u, sq = 0u;
#pragma unroll
                for (int i = 0; i < 8; ++i) { g[i] = cgt[8 * tid + i]; q[i] = ceq[8 * tid + i]; sg += g[i]; sq += q[i]; }
                unsigned ag = wave_excl_scan(sg, tid), aq = wave_excl_scan(sq, tid);
#pragma unroll
                for (int i = 0; i < 8; ++i) { cgt[8 * tid + i] = ag; ceq[8 * tid + i] = aq; ag += g[i]; aq += q[i]; }
            }
            __syncthreads();
            unsigned rg = cgt[tid], rq = ceq[tid];
            for (int i = 0; i < PER; ++i) {
                const int t = tid * PER + i; const unsigned k = keys[t + (t >> 5)];
                int slot = -1;
                if (k > thr) { slot = (int)(rg + (rq < keq ? rq : keq)); ++rg; }
                else if (k == thr) { if (rq < keq) slot = (int)(rg + rq); ++rq; }
                const int row = row0 + t;
                if (slot >= 0) { p.STOK[base + slot] = row; p.SVAL[base + slot] = __builtin_bit_cast(float, k); p.INV[(size_t)row * NE + e] = base + slot; }
                else p.INV[(size_t)row * NE + e] = -1;
            }
            __syncthreads();
        } else {
            const int row0 = NLAT + b * CTX, base = NSLOT_L + (b * NE + e) * CAPC;
            LAS float* vals = (LAS float*)lds;
            for (int t = tid; t < CTX; t += 512) vals[t] = p.AFF[(size_t)(row0 + t) * NE + e];
            __syncthreads();
            for (int t = tid; t < CTX; t += 512) {
                const float a = vals[t]; int rank = 0;
                for (int tt = 0; tt < CTX; ++tt) { const float o = vals[tt]; rank += (o > a || (o == a && tt < t)) ? 1 : 0; }
                const int row = row0 + t;
                if (rank < CAPC) { p.STOK[base + rank] = row; p.SVAL[base + rank] = a; p.INV[(size_t)row * NE + e] = base + rank; }
                else p.INV[(size_t)row * NE + e] = -1;
            }
            __syncthreads();
        }
    }
}

#define LDS_BAR() do { asm volatile("s_waitcnt lgkmcnt(0)" ::: "memory"); __builtin_amdgcn_s_barrier(); asm volatile("" ::: "memory"); } while (0)
__device__ __forceinline__ int hg_row0(int b, int pc) { return pc < NCHC ? NLAT + b * CTX + pc * 64 : b * SEQ + (pc - NCHC) * 64; }
constexpr int HG_FF = 0, HG_FB = 16640, HG_AF = 33280, HG_AB = 49920, HG_T0 = 66560, HG_TS = 9216, HG_VT = HG_T0 + 6 * HG_TS;
static_assert(HG_VT + HG_TS <= RING_BYTES, "hgrn LDS layout");
#define TSW_E(k, t) ((k) * 72 + ((((t) >> 3) ^ (((k) >> 3) & 7)) << 3) + ((t) & 7))
#define TSW_B(k, c) ((k) * 144 + (((c) ^ (((k) >> 3) & 7)) << 4))
constexpr int HG_LBOFF = LDSCTL_OFF + 4096;
__device__ __forceinline__ void hg_stage_lb(const int tid, PRef p, int l) {
    LAS float* dst = (LAS float*)((LAS unsigned char*)lds_raw + HG_LBOFF);
    for (int i = tid; i < 768; i += NTHR) dst[i] = p.LB[(size_t)((i / 384) * DEPTH + l) * 384 + (i % 384)];
    LDS_BAR();
}
__device__ __forceinline__ void hg_gates(const int tid, PRef p, int l, int h, const u32x4 zf, const u32x4 zb, LAS unsigned char* lds) {
    LAS float* FF = (LAS float*)(lds + HG_FF); LAS float* FB = (LAS float*)(lds + HG_FB); LAS float* AF = (LAS float*)(lds + HG_AF); LAS float* AB = (LAS float*)(lds + HG_AB);
    const int t = tid >> 3, cg = tid & 7;
    const LAS float* lbf = (const LAS float*)((LAS unsigned char*)lds_raw + HG_LBOFF) + h * 64 + cg * 8; const LAS float* lbb = lbf + 384;
#pragma unroll
    for (int j = 0; j < 8; ++j) {
        const float z0 = fminf(fmaxf(bf8(zf, j), -60.f), 60.f), z1 = fminf(fmaxf(bf8(zb, j), -60.f), 60.f);
        const float l0 = lbf[j], l1 = lbb[j];
        FF[t * 65 + cg * 8 + j] = l0 + (1.f - l0) * __builtin_amdgcn_rcpf(1.f + __expf(-z0));
        FB[t * 65 + cg * 8 + j] = l1 + (1.f - l1) * __builtin_amdgcn_rcpf(1.f + __expf(-z1));
    }
    LDS_BAR();
    {
        const int wave = tid >> 6, lane = tid & 63, cl = lane & 15, seg = lane >> 4, dir = wave >> 2, col = 16 * (wave & 3) + cl;
        const LAS float* F = dir ? FB : FF; LAS float* A = dir ? AB : AF;
        float pre[16]; float run = 0.f;
#pragma unroll
        for (int i = 0; i < 16; ++i) { const int tt = dir ? 16 * seg + 15 - i : 16 * seg + i; run += __logf(F[tt * 65 + col]); pre[i] = run; }
        const float T0 = __builtin_bit_cast(float, __builtin_amdgcn_ds_bpermute((cl + 0) << 2, __builtin_bit_cast(int, run)));
        const float T1 = __builtin_bit_cast(float, __builtin_amdgcn_ds_bpermute((cl + 16) << 2, __builtin_bit_cast(int, run)));
        const float T2 = __builtin_bit_cast(float, __builtin_amdgcn_ds_bpermute((cl + 32) << 2, __builtin_bit_cast(int, run)));
        const float T3 = __builtin_bit_cast(float, __builtin_amdgcn_ds_bpermute((cl + 48) << 2, __builtin_bit_cast(int, run)));
        const float off = dir ? ((seg < 1 ? T1 : 0.f) + (seg < 2 ? T2 : 0.f) + (seg < 3 ? T3 : 0.f)) : ((seg > 0 ? T0 : 0.f) + (seg > 1 ? T1 : 0.f) + (seg > 2 ? T2 : 0.f));
#pragma unroll
        for (int i = 0; i < 16; ++i) { const int tt = dir ? 16 * seg + 15 - i : 16 * seg + i; A[tt * 65 + col] = off + pre[i]; }
    }
    LDS_BAR();
}
__device__ __forceinline__ bf16x8 ld2x64(const LAS unsigned char* p0, const LAS unsigned char* p1) {
    const u32x2 a = *(const LAS u32x2*)p0, b = *(const LAS u32x2*)p1; u32x4 r; r.x = a.x; r.y = a.y; r.z = b.x; r.w = b.y; return __builtin_bit_cast(bf16x8, r);
}
typedef short s16x4 __attribute__((ext_vector_type(4)));
__device__ __forceinline__ bf16x8 ld2tr(const LAS unsigned char* p0, const LAS unsigned char* p1) {
    const s16x4 a = __builtin_amdgcn_ds_read_tr16_b64_v4i16((LAS s16x4*)p0), b = __builtin_amdgcn_ds_read_tr16_b64_v4i16((LAS s16x4*)p1);
    return __builtin_shufflevector(a, b, 0, 1, 2, 3, 4, 5, 6, 7);
}
__device__ __forceinline__ f32x4 mfma16(bf16x8 a, bf16x8 b, f32x4 c) { return __builtin_amdgcn_mfma_f32_16x16x32_bf16(a, b, c, 0, 0, 0); }
__device__ __forceinline__ void phase_hgrn_local(const int tid, PRef p, int l, LAS unsigned char* lds) {
    LAS float* FF = (LAS float*)(lds + HG_FF); LAS float* FB = (LAS float*)(lds + HG_FB); LAS float* AF = (LAS float*)(lds + HG_AF); LAS float* AB = (LAS float*)(lds + HG_AB);
    LAS bf16_t* KTf = (LAS bf16_t*)(lds + HG_T0); LAS bf16_t* KTb = (LAS bf16_t*)(lds + HG_T0 + HG_TS); LAS bf16_t* VT = (LAS bf16_t*)(lds + HG_VT);
    const int t = tid >> 3, cg = tid & 7, wave = tid >> 6, lane = tid & 63, fr = lane & 15, fq = lane >> 4;
    u32x4 zf = (u32x4){0u, 0u, 0u, 0u}, zb = zf, v8 = zf, nzf = zf, nzb = zf, nv8 = zf;
    if ((int)blockIdx.x < NBH * NCH) { const int it = blockIdx.x, pc = it % NCH, bh = it / NCH, h = bh % HGH, b = bh / HGH;
        const bf16_t* pr = p.P + (size_t)(hg_row0(b, pc) + t) * INC + h * 64 + cg * 8; zf = *(const u32x4*)(pr + OFF_); zb = *(const u32x4*)(pr + OFB); v8 = *(const u32x4*)(pr + OHI); }
    hg_stage_lb(tid, p, l);
    for (int it = blockIdx.x; it < NBH * NCH; it += gridDim.x) {
        const int pc = it % NCH, bh = it / NCH, h = bh % HGH, b = bh / HGH, row0 = hg_row0(b, pc);
        { const int it2 = min(it + (int)gridDim.x, NBH * NCH - 1); const int pc2 = it2 % NCH, bh2 = it2 / NCH, h2 = bh2 % HGH, b2 = bh2 / HGH;
            const bf16_t* pr = p.P + (size_t)(hg_row0(b2, pc2) + t) * INC + h2 * 64 + cg * 8; nzf = *(const u32x4*)(pr + OFF_); nzb = *(const u32x4*)(pr + OFB); nv8 = *(const u32x4*)(pr + OHI); }
        hg_gates(tid, p, l, h, zf, zb, lds);
#pragma unroll
        for (int j = 0; j < 8; ++j) {
            const int k = cg * 8 + j;
            VT[TSW_E(k, t)] = (bf16_t)(j & 1 ? v8[j >> 1] >> 16 : v8[j >> 1] & 0xffffu);
            KTf[TSW_E(k, t)] = f2bf((1.f - FF[t * 65 + k]) * __expf(AF[63 * 65 + k] - AF[t * 65 + k]));
            KTb[TSW_E(k, t)] = f2bf((1.f - FB[t * 65 + k]) * __expf(AB[k] - AB[t * 65 + k]));
        }
        if (tid < 64) p.GDEC[((size_t)(0 * NBH + bh) * NCH + pc) * 64 + tid] = __expf(AF[63 * 65 + tid]);
        else if (tid < 128) p.GDEC[((size_t)(1 * NBH + bh) * NCH + pc) * 64 + (tid - 64)] = __expf(AB[tid - 64]);
        LDS_BAR();
#if HGRN_DIAG == 4
        {
            const int v = tid >> 3, kg = tid & 7;
            for (int dir = 0; dir < 2; ++dir) {
                const LAS bf16_t* KT = (const LAS bf16_t*)(lds + HG_T0 + dir * HG_TS);
                float acc[8];
#pragma unroll
                for (int j = 0; j < 8; ++j) acc[j] = 0.f;
                for (int s_ = 0; s_ < 64; ++s_) { const float vv = bf2f(VT[v * 72 + s_]);
#pragma unroll
                    for (int j = 0; j < 8; ++j) acc[j] += bf2f(KT[(kg * 8 + j) * 72 + s_]) * vv; }
                bf16_t* dst = p.SLOC + ((size_t)(dir * NBH + bh) * NCH + pc) * 4096 + v * 64 + kg * 8;
#pragma unroll
                for (int j = 0; j < 8; ++j) dst[j] = f2bf(acc[j]);
            }
        }
#else
        {
            const int dir = wave >> 2, mt = wave & 3;
            const LAS unsigned char* KT = lds + HG_T0 + dir * HG_TS;
            bf16x8 a[2];
#pragma unroll
            for (int ks = 0; ks < 2; ++ks) a[ks] = *(const LAS bf16x8*)(KT + TSW_B(mt * 16 + fr, ks * 4 + fq));
            bf16_t* dst = p.SLOC + ((size_t)(dir * NBH + bh) * NCH + pc) * 4096;
            u32x2 w[4];
#pragma unroll
            for (int nt = 0; nt < 4; ++nt) {
                f32x4 acc = (f32x4){0.f, 0.f, 0.f, 0.f};
#pragma unroll
                for (int ks = 0; ks < 2; ++ks) { const bf16x8 bb = *(const LAS bf16x8*)(lds + HG_VT + TSW_B(nt * 16 + fr, ks * 4 + fq)); acc = mfma16(a[ks], bb, acc); }
                w[nt].x = cvt_pk_bf16(acc[0], acc[1]); w[nt].y = cvt_pk_bf16(acc[2], acc[3]);
            }
            zf = nzf; zb = nzb; v8 = nv8;
            asm volatile("" ::: "memory");
#pragma unroll
            for (int nt = 0; nt < 4; ++nt) *(u32x2*)(dst + (nt * 16 + fr) * 64 + mt * 16 + 4 * fq) = w[nt];
        }
#endif
        LDS_BAR();
    }
}
__device__ __forceinline__ void phase_hgrn_scan(const int tid, PRef p) {
    static_assert(NCH % 20 == 0, "scan group size");
    constexpr int GS = 20;
    for (int blk = (int)gridDim.x - 1 - (int)blockIdx.x; blk < 2 * NBH * 4; blk += gridDim.x) {
        const int sq = blk >> 2, part = blk & 3, dir = sq / NBH, e0 = part * 1024 + tid * 2, k = e0 & 63;
        unsigned* S = (unsigned*)(p.SLOC + (size_t)sq * NCH * 4096 + e0);
        const float* G = p.GDEC + (size_t)sq * NCH * 64 + k;
        float c0 = 0.f, c1 = 0.f;
        unsigned nx[GS]; f32x2 gn[GS];
#define HG_PC(j) (dir ? ((j) < NCHC ? NCHC - 1 - (j) : NCH + NCHC - 1 - (j)) : (j))
#pragma unroll
        for (int u = 0; u < GS; ++u) { const int pc = HG_PC(u); nx[u] = S[(size_t)pc * 2048]; gn[u] = *(const f32x2*)(G + (size_t)pc * 64); }
        for (int j0 = 0; j0 < NCH; j0 += GS) {
            unsigned cu[GS]; f32x2 gc[GS];
#pragma unroll
            for (int u = 0; u < GS; ++u) { cu[u] = nx[u]; gc[u] = gn[u]; }
            if (j0 + GS < NCH) {
#pragma unroll
                for (int u = 0; u < GS; ++u) { const int pc = HG_PC(j0 + GS + u); nx[u] = S[(size_t)pc * 2048]; gn[u] = *(const f32x2*)(G + (size_t)pc * 64); }
            }
#pragma unroll
            for (int u = 0; u < GS; ++u) {
                const int pc = HG_PC(j0 + u);
                S[(size_t)pc * 2048] = cvt_pk_bf16(c0, c1);
                c0 = gc[u][0] * c0 + bfw(cu[u], 0); c1 = gc[u][1] * c1 + bfw(cu[u], 1);
            }
        }
#undef HG_PC
    }
}
__device__ __forceinline__ void phase_hgrn_out(const int tid, PRef p, int l, LAS unsigned char* lds) {
    const int NCHO = (l + 1 < DEPTH) ? NCH : NCH - NCHC, PC0 = NCH - NCHO;
    LAS float* FF = (LAS float*)(lds + HG_FF); LAS float* FB = (LAS float*)(lds + HG_FB); LAS float* AF = (LAS float*)(lds + HG_AF); LAS float* AB = (LAS float*)(lds + HG_AB);
    LAS bf16_t* VT = (LAS bf16_t*)(lds + HG_VT);
    LAS float* OO = (LAS float*)(lds + HG_AF);
    const int t = tid >> 3, cg = tid & 7, wave = tid >> 6, lane = tid & 63, fr = lane & 15, fq = lane >> 4;
    u32x4 zf = (u32x4){0u, 0u, 0u, 0u}, zb = zf, v8 = zf, q8 = zf, g8 = zf, nzf = zf, nzb = zf, nv8 = zf, nq8 = zf, ng8 = zf;
    bf16x8 bsin[4][2], nbsin[4][2];
#define HG_LOADSIN(dst, bhx, pcx) do { const bf16_t* SIN_ = p.SLOC + ((size_t)((wave >> 2) * NBH + (bhx)) * NCH + (pcx)) * 4096; \
        _Pragma("unroll") for (int vt = 0; vt < 4; ++vt) _Pragma("unroll") for (int ks = 0; ks < 2; ++ks) dst[vt][ks] = *(const bf16x8*)(SIN_ + (vt * 16 + fr) * 64 + ks * 32 + fq * 8); } while (0)
#pragma unroll
    for (int vt = 0; vt < 4; ++vt) { bsin[vt][0] = (bf16x8){0, 0, 0, 0, 0, 0, 0, 0}; bsin[vt][1] = bsin[vt][0]; nbsin[vt][0] = bsin[vt][0]; nbsin[vt][1] = bsin[vt][0]; }
    if ((int)blockIdx.x < NBH * NCHO) { const int it = blockIdx.x, pc = it % NCHO + PC0, bh = it / NCHO, h = bh % HGH, b = bh / HGH;
        const bf16_t* pr = p.P + (size_t)(hg_row0(b, pc) + t) * INC + h * 64 + cg * 8; zf = *(const u32x4*)(pr + OFF_); zb = *(const u32x4*)(pr + OFB); v8 = *(const u32x4*)(pr + OHI); q8 = *(const u32x4*)(pr + OHQ); g8 = *(const u32x4*)(pr + OHG_);
        HG_LOADSIN(bsin, bh, pc); }
    hg_stage_lb(tid, p, l);
    f32x4 hn0, hn1; { const float* nwp = p.hg_norm + l * 64 + cg * 8; hn0 = *(const f32x4*)nwp; hn1 = *(const f32x4*)(nwp + 4); }
    for (int it = blockIdx.x; it < NBH * NCHO; it += gridDim.x) {
        const int pc = it % NCHO + PC0, bh = it / NCHO, h = bh % HGH, b = bh / HGH, row0 = hg_row0(b, pc);
        { const int it2 = min(it + (int)gridDim.x, NBH * NCHO - 1); const int pc2 = it2 % NCHO + PC0, bh2 = it2 / NCHO, h2 = bh2 % HGH, b2 = bh2 / HGH;
            const bf16_t* pr = p.P + (size_t)(hg_row0(b2, pc2) + t) * INC + h2 * 64 + cg * 8; nzf = *(const u32x4*)(pr + OFF_); nzb = *(const u32x4*)(pr + OFB); nv8 = *(const u32x4*)(pr + OHI); nq8 = *(const u32x4*)(pr + OHQ); ng8 = *(const u32x4*)(pr + OHG_);
            HG_LOADSIN(nbsin, bh2, pc2); }
        hg_gates(tid, p, l, h, zf, zb, lds);
        {
            float w[6][8];
#pragma unroll
            for (int j = 0; j < 8; ++j) {
                const int k = cg * 8 + j;
                VT[TSW_E(k, t)] = (bf16_t)(j & 1 ? v8[j >> 1] >> 16 : v8[j >> 1] & 0xffffu);
                const float qv = bf8(q8, j) * 0.125f, af = AF[t * 65 + k], ab = AB[t * 65 + k], rf = AF[31 * 65 + k], rb = AB[32 * 65 + k];
                w[0][j] = qv * __expf(fminf(af - rf, 80.f)); w[1][j] = (1.f - FF[t * 65 + k]) * __expf(fminf(rf - af, 80.f)); w[2][j] = qv * __expf(af);
                w[3][j] = qv * __expf(fminf(ab - rb, 80.f)); w[4][j] = (1.f - FB[t * 65 + k]) * __expf(fminf(rb - ab, 80.f)); w[5][j] = qv * __expf(ab);
            }
#pragma unroll
            for (int a = 0; a < 6; ++a) { u32x4 o; o.x = cvt_pk_bf16(w[a][0], w[a][1]); o.y = cvt_pk_bf16(w[a][2], w[a][3]); o.z = cvt_pk_bf16(w[a][4], w[a][5]); o.w = cvt_pk_bf16(w[a][6], w[a][7]);
                *(LAS u32x4*)(lds + HG_T0 + a * HG_TS + t * 144 + cg * 16) = o; }
        }
        LDS_BAR();
        {
            const int dir = wave >> 2, tt = wave & 3;
            const LAS unsigned char* QT = lds + HG_T0 + (dir * 3 + 0) * HG_TS; const LAS unsigned char* KL = lds + HG_T0 + (dir * 3 + 1) * HG_TS; const LAS unsigned char* QH = lds + HG_T0 + (dir * 3 + 2) * HG_TS;
            bf16x8 bq[2], bh[2];
#pragma unroll
            for (int ks = 0; ks < 2; ++ks) { bq[ks] = *(const LAS bf16x8*)(QT + (tt * 16 + fr) * 144 + ks * 64 + fq * 16); bh[ks] = *(const LAS bf16x8*)(QH + (tt * 16 + fr) * 144 + ks * 64 + fq * 16); }
            f32x4 o[4];
#pragma unroll
            for (int vt = 0; vt < 4; ++vt) { o[vt] = (f32x4){0.f, 0.f, 0.f, 0.f};
#pragma unroll
                for (int ks = 0; ks < 2; ++ks) o[vt] = mfma16(bsin[vt][ks], bh[ks], o[vt]); }
            const int t_ = 16 * tt + fr;
#pragma unroll
            for (int kp = 0; kp < 2; ++kp) {
                f32x4 sc[2];
#pragma unroll
                for (int hf = 0; hf < 2; ++hf) { const int st = 2 * kp + hf;
                    sc[hf] = (f32x4){0.f, 0.f, 0.f, 0.f};
                    if (dir ? st >= tt : st <= tt) {
#pragma unroll
                        for (int ks = 0; ks < 2; ++ks) { const bf16x8 a = *(const LAS bf16x8*)(KL + (st * 16 + fr) * 144 + ks * 64 + fq * 16); sc[hf] = mfma16(a, bq[ks], sc[hf]); }
#pragma unroll
                        for (int r = 0; r < 4; ++r) { const int s_ = 16 * st + 4 * fq + r; const bool keep = dir ? (s_ >= t_) : (s_ <= t_); sc[hf][r] = keep ? sc[hf][r] : 0.f; }
                    } }
                if (dir ? (2 * kp + 1 >= tt) : (2 * kp <= tt)) {
                    u32x4 pw; pw.x = cvt_pk_bf16(sc[0][0], sc[0][1]); pw.y = cvt_pk_bf16(sc[0][2], sc[0][3]); pw.z = cvt_pk_bf16(sc[1][0], sc[1][1]); pw.w = cvt_pk_bf16(sc[1][2], sc[1][3]);
                    const bf16x8 pf = __builtin_bit_cast(bf16x8, pw);
                    const int s0 = 32 * kp + 4 * fq;
#pragma unroll
                    for (int vt = 0; vt < 4; ++vt) { const int v_ = 16 * vt + fr; const int sw = (v_ >> 3) & 7;
                        const LAS unsigned char* vr = lds + HG_VT + v_ * 144 + (s0 & 7) * 2;
                        const bf16x8 a = ld2x64(vr + (((s0 >> 3) ^ sw) << 4), vr + ((((s0 + 16) >> 3) ^ sw) << 4));
                        o[vt] = mfma16(a, pf, o[vt]); }
                }
            }
            LAS float* OOd = (LAS float*)(lds + (dir ? HG_FB : HG_FF));
#pragma unroll
            for (int vt = 0; vt < 4; ++vt)
#pragma unroll
                for (int r = 0; r < 4; ++r) OOd[t_ * 65 + 16 * vt + 4 * fq + r] = o[vt][r];
        }
        LDS_BAR();
        {
            float o[8]; float ss = 0.f;
#pragma unroll
            for (int j = 0; j < 8; ++j) { o[j] = FF[t * 65 + cg * 8 + j] + FB[t * 65 + cg * 8 + j]; ss += o[j] * o[j]; }
            ss = oct_sum(ss);
            const float rstd = 1.f / sqrtf(ss * (1.f / 64.f) + EPS);
            float y[8];
#pragma unroll
            for (int j = 0; j < 8; ++j) { const float g = bf8(g8, j); y[j] = o[j] * rstd * (j < 4 ? hn0[j & 3] : hn1[j & 3]) * g * __builtin_amdgcn_rcpf(1.f + __expf(-g)); }
            u32x4 ov; ov.x = cvt_pk_bf16(y[0], y[1]); ov.y = cvt_pk_bf16(y[2], y[3]); ov.z = cvt_pk_bf16(y[4], y[5]); ov.w = cvt_pk_bf16(y[6], y[7]);
            zf = nzf; zb = nzb; v8 = nv8; q8 = nq8; g8 = ng8;
#pragma unroll
            for (int vt = 0; vt < 4; ++vt) { bsin[vt][0] = nbsin[vt][0]; bsin[vt][1] = nbsin[vt][1]; }
            asm volatile("" ::: "memory");
            *(u32x4*)(p.MIX + (size_t)(row0 + t) * MIXD + 384 + h * 64 + cg * 8) = ov;
        }
        LDS_BAR();
    }
}


#undef HG_LOADSIN
constexpr int AT_KC = 0, AT_VCT = 36864, AT_KL = AT_VCT + 256 * 144, AT_VL = AT_KL + 3 * 9216, AT_RPB = AT_VL + 3 * 9216, AT_END = AT_RPB + 1920;
static_assert(AT_END <= RING_BYTES && CTX == 256, "attention LDS layout (built for 256 context tokens)");
constexpr float ATHR = 6.f;
template <bool LOCAL, int NKB>
__device__ __forceinline__ void attn_scores(const LAS unsigned char* Kb, const bf16x8 (&qb)[2], f32x4 (&sc)[2 * NKB], int fr, int fq, const LAS float* rpb_row, const int (&boff)[8]) {
#pragma unroll
    for (int mt = 0; mt < 2 * NKB; ++mt) { sc[mt] = (f32x4){0.f, 0.f, 0.f, 0.f};
#pragma unroll
        for (int ks = 0; ks < 2; ++ks) { const bf16x8 a = *(const LAS bf16x8*)(Kb + (16 * mt + fr) * 144 + ks * 64 + fq * 16); sc[mt] = mfma16(a, qb[ks], sc[mt]); } }
    if (LOCAL) {
#pragma unroll
        for (int mt = 0; mt < 2 * NKB; ++mt)
#pragma unroll
            for (int r = 0; r < 4; ++r) sc[mt][r] += *(const LAS float*)((const LAS unsigned char*)rpb_row + boff[(4 * mt + r) & 7]);
    }
}
template <bool LOCAL, int NKB>
__device__ __forceinline__ void attn_spv(const f32x4 (&sc)[2 * NKB], const LAS unsigned char* Vb, f32x4 (&o)[4], float& m, float& lsum, int lane, int vtr) {
    float mx = -INFINITY;
#pragma unroll
    for (int mt = 0; mt < 2 * NKB; ++mt)
#pragma unroll
        for (int r = 0; r < 4; ++r) mx = fmaxf(mx, sc[mt][r]);
    if (__builtin_amdgcn_ballot_w64(mx > m + ATHR) != 0ull) {
        mx = fmaxf(mx, __builtin_bit_cast(float, __builtin_amdgcn_ds_swizzle(__builtin_bit_cast(int, mx), (16 << 10) | 0x1f)));
        mx = fmaxf(mx, __builtin_bit_cast(float, __builtin_amdgcn_ds_bpermute((lane ^ 32) << 2, __builtin_bit_cast(int, mx))));
        const float mn = fmaxf(m, mx), corr = __builtin_amdgcn_exp2f(m - mn);
        m = mn; lsum *= corr;
#pragma unroll
        for (int dt = 0; dt < 4; ++dt) o[dt] = o[dt] * corr;
    }
    float ps = 0.f;
#pragma unroll
    for (int kb = 0; kb < NKB; ++kb) {
        float pv[8];
#pragma unroll
        for (int h2 = 0; h2 < 2; ++h2)
#pragma unroll
            for (int r = 0; r < 4; ++r) { const float e = __builtin_amdgcn_exp2f(sc[2 * kb + h2][r] - m); pv[4 * h2 + r] = e; ps += e; }
        u32x4 pw; pw.x = cvt_pk_bf16(pv[0], pv[1]); pw.y = cvt_pk_bf16(pv[2], pv[3]); pw.z = cvt_pk_bf16(pv[4], pv[5]); pw.w = cvt_pk_bf16(pv[6], pv[7]);
        const bf16x8 pf = __builtin_bit_cast(bf16x8, pw);
#pragma unroll
        for (int dt = 0; dt < 4; ++dt) {
            const LAS unsigned char* vr = Vb + vtr + kb * (32 * 144) + dt * 32;
            o[dt] = mfma16(ld2tr(vr, vr + 16 * 144), pf, o[dt]);
        }
    }
    lsum += ps;
}
__device__ __forceinline__ void phase_attn(const int tid, PRef p, int l, LAS unsigned char* lds) {
    const int wave = tid >> 6, lane = tid & 63, fr = lane & 15, fq = lane >> 4, skey = tid >> 3, sc8 = tid & 7;
    LAS float* RPB = (LAS float*)(lds + AT_RPB);
    constexpr int NPAIR = ROWS / 2; const int IPB = NPAIR + ((l + 1 < DEPTH) ? 2 : 0);
    const int G_ = gridDim.x, NIT = NB * NAH * IPB;
#ifndef AT_DEAL_A
#define AT_DEAL_A 9
#define AT_DEAL_B 2
#endif
    const bool deal = (G_ == 256 && NIT <= 160 * AT_DEAL_A + 96 * AT_DEAL_B);
    const int it_lo = deal ? ((int)blockIdx.x < 160 ? (int)blockIdx.x * AT_DEAL_A : 160 * AT_DEAL_A + ((int)blockIdx.x - 160) * AT_DEAL_B) : (int)blockIdx.x;
    const int it_n = deal ? ((int)blockIdx.x < 160 ? AT_DEAL_A : AT_DEAL_B) : (NIT - (int)blockIdx.x + G_ - 1) / G_;
    int last_bh = -1;
#define AT_QTOK(itx) (((itx) % IPB) < NPAIR ? (((itx) / IPB) / NAH) * SEQ + (2 * ((itx) % IPB) + (wave >> 2)) * GW + 16 * (wave & 3) + fr : NLAT + (((itx) / IPB) / NAH) * CTX + ((((itx) % IPB) - NPAIR) * 128 + 16 * wave) + fr)
#define AT_LOADQ(itx, dst) do { const bf16_t* qp_ = p.P + (size_t)AT_QTOK(itx) * INC + OQ + (((itx) / IPB) % NAH) * 64 + fq * 8; dst[0] = *(const bf16x8*)qp_; dst[1] = *(const bf16x8*)(qp_ + 32); } while (0)
    bf16x8 qnx[2] = {(bf16x8){0, 0, 0, 0, 0, 0, 0, 0}, (bf16x8){0, 0, 0, 0, 0, 0, 0, 0}};
    { const int it0 = it_lo; if (it_n > 0 && it0 < NIT) AT_LOADQ(it0, qnx); }
    for (int ii = 0; ii < it_n; ++ii) {
        const int it = deal ? it_lo + ii : it_lo + ii * G_;
        if (it >= NIT) break;
        const int sub = it % IPB, bh = it / IPB, head = bh % NAH, b = bh / NAH;
        const bool islat = sub < NPAIR;
        const int r0 = 2 * sub, qr = r0 + (wave >> 2), jb = wave & 3;
        LDS_BAR();
        if (bh != last_bh) {
            last_bh = bh;
            int sc8l = sc8; asm volatile("" : "+v"(sc8l));
            for (int rnd = 0; rnd < 4; ++rnd) {
                const int key = skey + 64 * rnd; const bf16_t* src = p.P + (size_t)(NLAT + b * CTX + key) * INC + head * 64 + sc8l * 8;
                const u32x4 kv = *(const u32x4*)(src + OK_), vv = *(const u32x4*)(src + OV);
                *(LAS u32x4*)(lds + AT_KC + key * 144 + sc8 * 16) = kv; *(LAS u32x4*)(lds + AT_VCT + key * 144 + sc8 * 16) = vv;
            }
            { int t2 = tid; asm volatile("" : "+v"(t2));
              if (t2 < 15 * 32) RPB[t2] = (t2 & 31) < 31 ? p.rpb[((size_t)l * NAH + head) * 465 + (t2 >> 5) * 31 + (t2 & 31)] * 1.44269504089f : -INFINITY; }
        }
        const int qtok = islat ? b * SEQ + qr * GW + 16 * jb + fr : NLAT + b * CTX + ((sub - NPAIR) * 128 + 16 * wave) + fr;
        bf16x8 qb[2]; qb[0] = qnx[0]; qb[1] = qnx[1];
        { const int itn = deal ? it + 1 : it + G_; if (ii + 1 < it_n && itn < NIT) { int fr = (tid & 15); asm volatile("" : "+v"(fr)); AT_LOADQ(itn, qnx); } }
        int krlo = 0, krhi = -1, rs = 0;
        if (islat) { int a = r0 - 4; a = a < 0 ? 0 : (a > ROWS - 8 ? ROWS - 8 : a); int c = r0 + 1 - 4; c = c < 0 ? 0 : (c > ROWS - 8 ? ROWS - 8 : c); krlo = a; krhi = c + 7;
            rs = qr - 4; rs = rs < 0 ? 0 : (rs > ROWS - 8 ? ROWS - 8 : rs); }
        u32x4 kA = (u32x4){0u, 0u, 0u, 0u}, vA = kA, kB = kA, vB = kA, kC = kA, vC = kA;
        int skl = skey; asm volatile("" : "+v"(skl));
#define AT_LOADROW(row, kd, vd) do { const bf16_t* src_ = p.P + (size_t)(b * SEQ + (row) * GW + skl) * INC + head * 64 + sc8 * 8; kd = *(const u32x4*)(src_ + OK_); vd = *(const u32x4*)(src_ + OV); } while (0)
#define AT_STAGEROW(bufi, kd, vd) do { *(LAS u32x4*)(lds + AT_KL + (bufi) * 9216 + skey * 144 + sc8 * 16) = kd; *(LAS u32x4*)(lds + AT_VL + (bufi) * 9216 + skey * 144 + sc8 * 16) = vd; } while (0)
        if (islat) { AT_LOADROW(krlo, kA, vA); AT_LOADROW(krlo + 1, kB, vB); AT_LOADROW(krlo + 2, kC, vC); }
        f32x4 o[4]; float m = -1e30f, lsum = 0.f;
#pragma unroll
        for (int dt = 0; dt < 4; ++dt) o[dt] = (f32x4){0.f, 0.f, 0.f, 0.f};
        LDS_BAR();
        const int bs = jb == 0 ? 0 : (jb == 1 ? 8 : (jb == 2 ? 24 : 32)), qc = 16 * jb + fr;
        int boff[8];
        { int ws = qc - 8; ws = ws < 0 ? 0 : (ws > 48 ? 48 : ws);
#pragma unroll
          for (int j_ = 0; j_ < 8; ++j_) { const int kc = bs + 16 * (j_ >> 2) + 4 * fq + (j_ & 3); const bool ok = kc >= ws && kc < ws + 16; boff[j_] = (ok ? kc - qc + 15 : 31) * 4; asm volatile("" : "+v"(boff[j_])); } }
        int vtr = (4 * fq + (fr >> 2)) * 144 + 8 * (fr & 3); asm volatile("" : "+v"(vtr));
        const int vtrl = vtr + bs * 144;
        {
            f32x4 sa[4], sb[4];
#define AT_CS(st, dst) attn_scores<false, 2>(lds + AT_KC + (st) * 64 * 144, qb, dst, fr, fq, RPB, boff)
#define AT_CP(st, src) attn_spv<false, 2>(src, lds + AT_VCT + (st) * 64 * 144, o, m, lsum, lane, vtr)
            AT_CS(0, sa); AT_CS(1, sb); AT_CP(0, sa); AT_CS(2, sa); AT_CP(1, sb); AT_CS(3, sb); AT_CP(2, sa); AT_CP(3, sb);
#undef AT_CS
#undef AT_CP
        }
        if (islat) { AT_STAGEROW(0, kA, vA); AT_LOADROW(krlo + 3, kA, vA); AT_STAGEROW(1, kB, vB); AT_LOADROW(krlo + 4, kB, vB); }
        LDS_BAR();
        if (islat) {
            const bool first0 = rs == krlo, last8 = !first0;
            const LAS float* rp = RPB + (krlo - qr + 7) * 32;
            f32x4 sa[2], sb[2];
#define AT_S(j, dst) attn_scores<true, 1>(lds + AT_KL + ((j) % 3) * 9216 + bs * 144, qb, dst, fr, fq, rp + 32 * (j), boff)
#define AT_P(j, src) attn_spv<true, 1>(src, lds + AT_VL + ((j) % 3) * 9216, o, m, lsum, lane, vtrl)
#define AT_MID(j, NK, NV, LOADROWX, SCUR, SNXT) { AT_STAGEROW(((j) + 2) % 3, NK, NV); if ((LOADROWX) >= 0) { AT_LOADROW(min(krlo + (LOADROWX), krhi), NK, NV); } \
            AT_S((j) + 1, SNXT); AT_P(j, SCUR); LDS_BAR(); }
            sa[0] = (f32x4){0.f, 0.f, 0.f, 0.f}; sa[1] = sa[0];
            if (first0) AT_S(0, sa);
            { AT_STAGEROW(2, kC, vC); AT_LOADROW(krlo + 5, kC, vC); AT_S(1, sb); if (first0) AT_P(0, sa); LDS_BAR(); }
            AT_MID(1, kA, vA, 6, sb, sa) AT_MID(2, kB, vB, 7, sa, sb) AT_MID(3, kC, vC, 8, sb, sa) AT_MID(4, kA, vA, -1, sa, sb) AT_MID(5, kB, vB, -1, sb, sa) AT_MID(6, kC, vC, -1, sa, sb)
            if (last8) { AT_S(8, sa); AT_P(7, sb); AT_P(8, sa); } else { AT_P(7, sb); }
#undef AT_S
#undef AT_P
#undef AT_MID
        }
#undef AT_LOADROW
#undef AT_STAGEROW
        lsum = x32_sum(x16_sum(lsum, lane), lane);
        const float inv = 1.f / lsum;
        bf16_t* orow = p.MIX + (size_t)qtok * MIXD + head * 64;
#pragma unroll
        for (int dt = 0; dt < 4; ++dt) { u32x2 w; w.x = cvt_pk_bf16(o[dt][0] * inv, o[dt][1] * inv); w.y = cvt_pk_bf16(o[dt][2] * inv, o[dt][3] * inv); *(u32x2*)(orow + 16 * dt + 4 * fq) = w; }
    }
}


#undef AT_QTOK
#undef AT_LOADQ
template <int MODE> __device__ __forceinline__ void mini_gemm(const int tid, PRef p, int l) {
    const int wave = tid >> 6, lane = tid & 63, fr = lane & 15, fq = lane >> 4;
    const int gw = blockIdx.x * NWAVES + wave, NGW = gridDim.x * NWAVES;
    constexpr int K = MODE == 3 ? ED : (MODE == 1 ? MIXD : D);
    constexpr int N = MODE == 0 ? INC : (MODE == 2 ? 2 * ED : D);
    constexpr int MROWS = MODE <= 1 ? NCTX : NSLOT_C;
    constexpr int NTC = MODE == 2 ? 2 : 1, TW = 16 * NTC;
    constexpr int NTN = N / TW, NT = (MROWS / 32) * NTN;
    for (int t = gw; t < NT; t += NGW) {
        const int rt = t / NTN, ct = t % NTN, c0 = ct * TW;
        const bf16_t* Bt; const bf16_t* arow[2];
        if (MODE == 0) { Bt = p.WIN_T + WBOFF(l); for (int mt = 0; mt < 2; ++mt) arow[mt] = p.H + (size_t)(NLAT + rt * 32 + 16 * mt + fr) * D; }
        else if (MODE == 1) { Bt = p.WOUT_T + WBOFF(l); for (int mt = 0; mt < 2; ++mt) arow[mt] = p.MIX + (size_t)(NLAT + rt * 32 + 16 * mt + fr) * MIXD; }
        else if (MODE == 2) { const int e = rt % NE; Bt = p.WGU_T + WBOFF(l) + (size_t)e * 2 * ED * D;
            for (int mt = 0; mt < 2; ++mt) { int row = p.STOK[NSLOT_L + rt * 32 + 16 * mt + fr]; row = row < 0 ? 0 : (row >= NTOK ? NTOK - 1 : row); arow[mt] = p.H + (size_t)row * D; } }
        else { const int e = rt % NE; Bt = p.WD_T + WBOFF(l) + (size_t)e * D * ED; for (int mt = 0; mt < 2; ++mt) arow[mt] = p.HID + (size_t)(NSLOT_L + rt * 32 + 16 * mt + fr) * ED; }
        const bf16_t* brow = Bt + (size_t)(c0 + fr) * K;
        f32x4 acc[2][NTC];
#pragma unroll
        for (int mt = 0; mt < 2; ++mt)
#pragma unroll
            for (int nt = 0; nt < NTC; ++nt) acc[mt][nt] = (f32x4){0.f, 0.f, 0.f, 0.f};
#pragma unroll 8
        for (int ks = 0; ks < K / 32; ++ks) {
            bf16x8 a[2], bfr[NTC];
#pragma unroll
            for (int mt = 0; mt < 2; ++mt) a[mt] = *(const bf16x8*)(arow[mt] + ks * 32 + fq * 8);
#pragma unroll
            for (int nt = 0; nt < NTC; ++nt) bfr[nt] = *(const bf16x8*)(brow + (size_t)(16 * nt) * K + ks * 32 + fq * 8);
#pragma unroll
            for (int mt = 0; mt < 2; ++mt)
#pragma unroll
                for (int nt = 0; nt < NTC; ++nt) acc[mt][nt] = mfma16(a[mt], bfr[nt], acc[mt][nt]);
        }
#pragma unroll
        for (int mt = 0; mt < 2; ++mt)
#pragma unroll
            for (int r = 0; r < 4; ++r) {
                const int lr = rt * 32 + 16 * mt + 4 * fq + r;
                if (MODE == 0) { bf16_t* o = p.P + (size_t)(NLAT + lr) * INC + c0 + fr;
#pragma unroll
                    for (int nt = 0; nt < NTC; ++nt) o[16 * nt] = f2bf(acc[mt][nt][r]); }
                else if (MODE == 1) { float* o = p.XC + (size_t)lr * D + c0 + fr; const float* g = p.MOD + ((size_t)l * 3 + 2) * NMOD + 2 * D + c0 + fr;
#pragma unroll
                    for (int nt = 0; nt < NTC; ++nt) o[16 * nt] += g[16 * nt] * acc[mt][nt][r]; }
                else if (MODE == 2) { bf16_t* o = p.HID + (size_t)(NSLOT_L + lr) * ED + c0 / 2 + fr;
#pragma unroll
                    for (int q = 0; q < NTC / 2; ++q) { const float g = acc[mt][2 * q][r], u = acc[mt][2 * q + 1][r]; o[16 * q] = f2bf(g / (1.f + __expf(-g)) * u); } }
                else { bf16_t* o = p.Y + (size_t)(NSLOT_L + lr) * D + c0 + fr; const float val = p.SVAL[NSLOT_L + lr];
#pragma unroll
                    for (int nt = 0; nt < NTC; ++nt) o[16 * nt] = f2bf(val * acc[mt][nt][r]); }
            }
    }
}


__device__ __forceinline__ void phase_conv(const int tid, PRef p, int l) {
    const float* w = p.conv_w + (size_t)l * 3 * CVD;
    constexpr int U = 2;
    const long nitem = (long)NTOK * (CVD / 8), gstr = (long)gridDim.x * NTHR;
    for (long g0 = (long)blockIdx.x * NTHR + tid; g0 < nitem; g0 += gstr * U) {
        u32x4 cc[U][3], uu[U][3], bg[U]; float vz[U][3]; int rr[U], c8v[U]; bool ok[U];
#pragma unroll
        for (int u = 0; u < U; ++u) {
            long gid = g0 + u * gstr; ok[u] = gid < nitem; if (!ok[u]) gid = g0;
            const int r = (int)(gid / (CVD / 8)), c8 = (int)(gid % (CVD / 8)) * 8; rr[u] = r; c8v[u] = c8;
            int t, T; if (r < NLAT) { t = r % SEQ; T = SEQ; } else { t = (r - NLAT) % CTX; T = CTX; }
            const bf16_t* pr = p.P + (size_t)r * INC + c8;
#pragma unroll
            for (int d = 0; d < 3; ++d) { const int tt = t + d - 1; const bool in = tt >= 0 && tt < T; vz[u][d] = in ? 1.f : 0.f;
                const bf16_t* q = pr + (in ? (long)(d - 1) * INC : 0L); cc[u][d] = *(const u32x4*)(q + OCC); uu[u][d] = *(const u32x4*)(q + OCU); }
            bg[u] = *(const u32x4*)(pr + OCB);
        }
        asm volatile("" ::: "memory");
#pragma unroll
        for (int u = 0; u < U; ++u) {
            float y[8];
#pragma unroll
            for (int j = 0; j < 8; ++j) y[j] = 0.f;
#pragma unroll
            for (int d = 0; d < 3; ++d) {
                const f32x4 w0 = *(const f32x4*)(w + d * CVD + c8v[u]) * vz[u][d], w1 = *(const f32x4*)(w + d * CVD + c8v[u] + 4) * vz[u][d];
#pragma unroll
                for (int j = 0; j < 8; ++j) y[j] += (j < 4 ? w0[j & 3] : w1[j & 3]) * bf8(cc[u][d], j) * bf8(uu[u][d], j);
            }
            u32x4 o; o.x = cvt_pk_bf16(bf8(bg[u], 0) * y[0], bf8(bg[u], 1) * y[1]); o.y = cvt_pk_bf16(bf8(bg[u], 2) * y[2], bf8(bg[u], 3) * y[3]);
            o.z = cvt_pk_bf16(bf8(bg[u], 4) * y[4], bf8(bg[u], 5) * y[5]); o.w = cvt_pk_bf16(bf8(bg[u], 6) * y[6], bf8(bg[u], 7) * y[7]);
            if (ok[u]) *(u32x4*)(p.MIX + (size_t)rr[u] * MIXD + 768 + c8v[u]) = o;
        }
    }
}
__device__ __forceinline__ void phase_qkprep(const int tid, PRef p, int l) {
    const int sub = tid & 7;
    constexpr int U = 4;
    const long ngroups = (long)NTOK * 12, gstride = ((long)gridDim.x * NTHR) >> 3;
    for (long g0 = ((long)blockIdx.x * NTHR + tid) >> 3; g0 < ngroups; g0 += gstride * U) {
        u32x4 raw[U]; bf16_t* ptr[U]; int rr[U]; int wh[U];
#pragma unroll
        for (int u = 0; u < U; ++u) { long g8 = g0 + u * gstride; const bool ok = g8 < ngroups; if (!ok) g8 = g0;
            rr[u] = ok ? (int)(g8 / 12) : -1; wh[u] = (int)(g8 % 12) / 6; const int head = (int)(g8 % 6);
            ptr[u] = p.P + (size_t)(g8 / 12) * INC + (wh[u] ? OK_ : OQ) + head * HD + sub * 8; raw[u] = *(const u32x4*)ptr[u]; }
#pragma unroll
        for (int u = 0; u < U; ++u) {
            const float* nw = (wh[u] ? p.k_norm : p.q_norm) + l * HD + sub * 8;
            float y[8]; float ss = 0.f;
#pragma unroll
            for (int j = 0; j < 8; ++j) { y[j] = bf8(raw[u], j); ss += y[j] * y[j]; }
            ss = oct_sum(ss);
            const float rstd = 1.f / sqrtf(ss * (1.f / HD) + EPS);
#pragma unroll
            for (int j = 0; j < 8; ++j) y[j] = y[j] * rstd * nw[j];
            const int r = rr[u];
            const bool lat = r >= 0 && r < NLAT;
            const int t = lat ? r % SEQ : 0; const float pos = (sub & 4) ? (float)(t % GW) : (float)(t / GW);
            const bool second = (sub & 2) != 0;
#pragma unroll
            for (int j = 0; j < 8; ++j) {
                const float other = __builtin_bit_cast(float, __builtin_amdgcn_ds_swizzle(__builtin_bit_cast(int, y[j]), (2 << 10) | 0x1f));
                const int fi = (sub & 1) * 8 + j;
                const float ang = pos * __builtin_amdgcn_exp2f(-(float)fi * (13.287712379549449f / 16.f));
                const float cs = FCOS(ang), sn = FSIN(ang);
                const float rot = second ? y[j] * cs + other * sn : y[j] * cs - other * sn;
                y[j] = lat ? rot : y[j];
            }
            if (r >= 0) { u32x4 o; o.x = cvt_pk_bf16(y[0], y[1]); o.y = cvt_pk_bf16(y[2], y[3]); o.z = cvt_pk_bf16(y[4], y[5]); o.w = cvt_pk_bf16(y[6], y[7]); *(u32x4*)ptr[u] = o; }
        }
    }
}

__device__ __forceinline__ f32x4 bf4(const u32x2 w) { return (f32x4){bfw(w.x, 0), bfw(w.x, 1), bfw(w.y, 0), bfw(w.y, 1)}; }
template <int MODE> __device__ __forceinline__ void phase_rows(const int tid, PRef p, int l, LAS unsigned char* lds) {
    static_assert(D == 1024, "wave-per-row kernels assume D = 1024");
    const int lane = tid & 63, wave = tid >> 6;
#define RC(j) (8 * lane + 512 * ((j) >> 1) + 4 * ((j) & 1))
    if (MODE == 1) {
        for (int k = tid; k < D; k += NTHR) { const f32x4* src = (const f32x4*)(p.w_router + ((size_t)l * D + k) * NE); LAS f32x4* dst = (LAS f32x4*)(lds + k * 64 + (k >> 3) * 16);
#pragma unroll
            for (int u = 0; u < 4; ++u) dst[u] = src[u]; }
        __syncthreads();
    }
    const int gw = blockIdx.x * NWAVES + wave, NGW = gridDim.x * NWAVES;
    const int rw = ((NTOK + NGW - 1) / NGW + 1) & ~1;
    const int r_lo = gw * rw, r_hi = min(NTOK, r_lo + rw);
    const bool doh = MODE != 2 || l + 1 < DEPTH;
    const int ln = (MODE == 2 && l + 1 < DEPTH) ? l + 1 : l;
    const float* nw = (MODE == 1 ? p.norm2_w : p.norm1_w) + (size_t)ln * D;
    int curset = -1; f32x4 Av[4], Sv[4], Gv[4];
#pragma unroll
    for (int j = 0; j < 4; ++j) { Av[j] = (f32x4){0.f, 0.f, 0.f, 0.f}; Sv[j] = Av[j]; Gv[j] = Av[j]; }
    constexpr int NVN = MODE == 0 ? 4 : 2;
    u32x4 vn[2][NVN]; int invn[2] = {-1, -1};
#define ROWS_LOADPAIR(rb) do { _Pragma("unroll") for (int i_ = 0; i_ < 2; ++i_) { const int rr_ = ((rb) + i_ < r_hi) ? (rb) + i_ : (rb); \
        if (MODE == 0) { const float* src_ = rr_ < NLAT ? p.x + (size_t)rr_ * D : p.ctx + (size_t)(rr_ - NLAT) * D; \
            _Pragma("unroll") for (int j_ = 0; j_ < NVN; ++j_) vn[i_][j_] = *(const u32x4*)(src_ + RC(j_)); } \
        else if (rr_ < NLAT) { const bf16_t* src_ = p.XB + (size_t)rr_ * D + 8 * lane; vn[i_][0] = *(const u32x4*)src_; vn[i_][1] = *(const u32x4*)(src_ + 512); } \
        if (MODE == 2) invn[i_] = lane < NE ? p.INV[(size_t)rr_ * NE + lane] : -1; } } while (0)
#pragma unroll
    for (int i = 0; i < 2; ++i)
#pragma unroll
        for (int j = 0; j < NVN; ++j) vn[i][j] = (u32x4){0u, 0u, 0u, 0u};
    if (r_lo < r_hi) ROWS_LOADPAIR(r_lo);
#pragma unroll 1
    for (int r = r_lo; r < r_hi; r += 2) {
        const bool two = r + 1 < r_hi;
        const bool lat = r < NLAT;
        const int set = modset(r);
        if (set != curset) { curset = set;
            const float* mod = p.MOD + ((size_t)ln * 3 + set) * NMOD; const float* shift = mod + (MODE == 1 ? 3 : 0) * D; const float* scale = mod + (MODE == 1 ? 4 : 1) * D;
            int lane2 = lane; asm volatile("" : "+v"(lane2));
#pragma unroll
            for (int j = 0; j < 4; ++j) { const int c = 8 * lane2 + 512 * (j >> 1) + 4 * (j & 1); const f32x4 w4 = *(const f32x4*)(nw + c), sc4 = *(const f32x4*)(scale + c); Av[j] = w4 * (sc4 + 1.f); Sv[j] = *(const f32x4*)(shift + c);
                if (MODE == 2) Gv[j] = *(const f32x4*)(p.MOD + ((size_t)l * 3 + set) * NMOD + 5 * D + c); } }
        f32x4 v[2][4]; int inv2[2];
#pragma unroll
        for (int i = 0; i < 2; ++i) { inv2[i] = invn[i];
            if (MODE == 0) {
#pragma unroll
                for (int j = 0; j < 4; ++j) v[i][j] = __builtin_bit_cast(f32x4, vn[i][j < NVN ? j : 0]);
            } else if (lat) {
#pragma unroll
                for (int jj = 0; jj < 2; ++jj) { const u32x4 w = vn[i][jj]; v[i][2 * jj] = (f32x4){bfw(w.x, 0), bfw(w.x, 1), bfw(w.y, 0), bfw(w.y, 1)}; v[i][2 * jj + 1] = (f32x4){bfw(w.z, 0), bfw(w.z, 1), bfw(w.w, 0), bfw(w.w, 1)}; }
            } else { const float* src = p.XC + (size_t)(r + ((i == 0 || two) ? i : 0) - NLAT) * D;
#pragma unroll
                for (int j = 0; j < 4; ++j) v[i][j] = *(const f32x4*)(src + RC(j));
            } }
        if (r + 2 < r_hi) ROWS_LOADPAIR(r + 2);
        if (MODE == 2) {
#pragma unroll
            for (int i = 0; i < 2; ++i) {
                const int myinv = inv2[i];
                unsigned long long mask = __ballot(myinv >= 0 && myinv < NSLOT);
                f32x4 acc[4];
#pragma unroll
                for (int j = 0; j < 4; ++j) acc[j] = (f32x4){0.f, 0.f, 0.f, 0.f};
                while (mask) {
                    const int e0 = __builtin_ctzll(mask); mask &= mask - 1; const int s0 = __builtin_amdgcn_readlane(myinv, e0);
                    int s1 = -1; if (mask) { const int e1 = __builtin_ctzll(mask); mask &= mask - 1; s1 = __builtin_amdgcn_readlane(myinv, e1); }
                    u32x4 y0[2], y1[2];
#pragma unroll
                    for (int jj = 0; jj < 2; ++jj) y0[jj] = *(const u32x4*)(p.Y + (size_t)s0 * D + 8 * lane + 512 * jj);
                    if (s1 >= 0) {
#pragma unroll
                        for (int jj = 0; jj < 2; ++jj) y1[jj] = *(const u32x4*)(p.Y + (size_t)s1 * D + 8 * lane + 512 * jj);
                    }
#pragma unroll
                    for (int jj = 0; jj < 2; ++jj) { acc[2 * jj] = acc[2 * jj] + (f32x4){bfw(y0[jj].x, 0), bfw(y0[jj].x, 1), bfw(y0[jj].y, 0), bfw(y0[jj].y, 1)}; acc[2 * jj + 1] = acc[2 * jj + 1] + (f32x4){bfw(y0[jj].z, 0), bfw(y0[jj].z, 1), bfw(y0[jj].w, 0), bfw(y0[jj].w, 1)}; }
                    if (s1 >= 0) {
#pragma unroll
                        for (int jj = 0; jj < 2; ++jj) { acc[2 * jj] = acc[2 * jj] + (f32x4){bfw(y1[jj].x, 0), bfw(y1[jj].x, 1), bfw(y1[jj].y, 0), bfw(y1[jj].y, 1)}; acc[2 * jj + 1] = acc[2 * jj + 1] + (f32x4){bfw(y1[jj].z, 0), bfw(y1[jj].z, 1), bfw(y1[jj].w, 0), bfw(y1[jj].w, 1)}; }
                    }
                }
#pragma unroll
                for (int j = 0; j < 4; ++j) v[i][j] = v[i][j] + Gv[j] * acc[j];
            }
        }
        if (MODE == 0 || MODE == 2) {
            const bool fin = MODE == 2 && l + 1 == DEPTH;
#pragma unroll
            for (int i = 0; i < 2; ++i) if (i == 0 || two) {
                if (lat && !fin) {
#pragma unroll
                    for (int jj = 0; jj < 2; ++jj) { u32x4 o; o.x = cvt_pk_bf16(v[i][2 * jj][0], v[i][2 * jj][1]); o.y = cvt_pk_bf16(v[i][2 * jj][2], v[i][2 * jj][3]); o.z = cvt_pk_bf16(v[i][2 * jj + 1][0], v[i][2 * jj + 1][1]); o.w = cvt_pk_bf16(v[i][2 * jj + 1][2], v[i][2 * jj + 1][3]);
                        *(u32x4*)(p.XB + (size_t)(r + i) * D + 8 * lane + 512 * jj) = o; }
                } else if (lat || !fin) { float* dst = lat ? p.XL + (size_t)(r + i) * D : p.XC + (size_t)(r + i - NLAT) * D;
#pragma unroll
                    for (int j = 0; j < 4; ++j) *(f32x4*)(dst + RC(j)) = v[i][j]; }
            }
        }
        if (doh) {
            float ss[2];
#pragma unroll
            for (int i = 0; i < 2; ++i) { float a = 0.f;
#pragma unroll
                for (int j = 0; j < 4; ++j) a += (v[i][j][0] * v[i][j][0] + v[i][j][1] * v[i][j][1]) + (v[i][j][2] * v[i][j][2] + v[i][j][3] * v[i][j][3]);
                ss[i] = a; }
            ss[0] = wave_sum(ss[0], lane); ss[1] = wave_sum(ss[1], lane);
            const float rstd0 = 1.f / sqrtf(ss[0] * (1.f / D) + EPS), rstd1 = 1.f / sqrtf(ss[1] * (1.f / D) + EPS);
            f32x4 hh[2][4];
#pragma unroll
            for (int j = 0; j < 4; ++j) { hh[0][j] = v[0][j] * rstd0 * Av[j] + Sv[j]; hh[1][j] = v[1][j] * rstd1 * Av[j] + Sv[j]; }
#pragma unroll
            for (int i = 0; i < 2; ++i) if (i == 0 || two) {
#pragma unroll
                for (int jj = 0; jj < 2; ++jj) { u32x4 o; o.x = cvt_pk_bf16(hh[i][2 * jj][0], hh[i][2 * jj][1]); o.y = cvt_pk_bf16(hh[i][2 * jj][2], hh[i][2 * jj][3]); o.z = cvt_pk_bf16(hh[i][2 * jj + 1][0], hh[i][2 * jj + 1][1]); o.w = cvt_pk_bf16(hh[i][2 * jj + 1][2], hh[i][2 * jj + 1][3]);
                    *(u32x4*)(p.H + (size_t)(r + i) * D + 8 * lane + 512 * jj) = o; } }
            if (MODE == 1) {
                LAS float* red = (LAS float*)(lds + 70144 + wave * 4224);
                LAS float* red1 = (LAS float*)(wave < 6 ? lds + 103936 + wave * 4224 : lds + LDSCTL_OFF + 1024 + (wave - 6) * 4224);
                const LAS unsigned char* wb = lds + lane * 528;
#pragma unroll
                for (int u = 0; u < 4; ++u) {
                    f32x4 a0 = (f32x4){0.f, 0.f, 0.f, 0.f}, a1 = a0;
#pragma unroll
                    for (int j = 0; j < 4; ++j)
#pragma unroll
                        for (int q = 0; q < 4; ++q) { const f32x4 w = *(const LAS f32x4*)(wb + (j >> 1) * 33792 + (4 * (j & 1) + q) * 64 + u * 16); const float h0 = hh[0][j][q], h1 = hh[1][j][q];
                            a0[0] += h0 * w[0]; a0[1] += h0 * w[1]; a0[2] += h0 * w[2]; a0[3] += h0 * w[3]; a1[0] += h1 * w[0]; a1[1] += h1 * w[1]; a1[2] += h1 * w[2]; a1[3] += h1 * w[3]; }
#pragma unroll
                    for (int c = 0; c < 4; ++c) { red[(4 * u + c) * 65 + lane] = a0[c]; red1[(4 * u + c) * 65 + lane] = a1[c]; }
                    asm volatile("" ::: "memory");
                }
#pragma unroll
                for (int i = 0; i < 2; ++i) {
                    const LAS float* rd = i ? red1 : red;
                    const int e2 = lane & 15, part = lane >> 4;
                    float t = 0.f;
#pragma unroll
                    for (int x = 0; x < 16; ++x) t += rd[e2 * 65 + part * 16 + x];
                    asm volatile("" ::: "memory");
                    t = x32_sum(x16_sum(t, lane), lane);
#define SWZF(x, d) __builtin_bit_cast(float, __builtin_amdgcn_ds_swizzle(__builtin_bit_cast(int, (x)), ((d) << 10) | 0x1f))
                    float m = t;
                    m = row16_max(m);
                    const float ex = expf(t - m); float sm = ex;
                    sm = row16_sum(sm);
#undef SWZF
                    if (lane < NE && (i == 0 || two)) p.AFF[(size_t)(r + i) * NE + lane] = ex / sm;
                }
            }
        }
    }
#undef ROWS_LOADPAIR
#undef RC
    if (MODE == 1) __syncthreads();
}


__device__ __forceinline__ void phase_adaln(const int tid, PRef p, LAS unsigned char* lds) {
    static_assert(D == 1024 && NMOD % 256 == 0, "adaln layout");
    const int lane = tid & 63, wave = tid >> 6;
    LAS float* SC = (LAS float*)lds;
    LAS float* RED = (LAS float*)(lds + 16384);
    for (int i = tid; i < 3 * D; i += NTHR) { const int st = i / D, k = i % D; const float cv = st < 2 ? p.c[st * D + k] : p.c_ctx[k]; SC[i] = cv / (1.f + __expf(-cv)); }
    __syncthreads();
    constexpr int NCG = NMOD / 256;
    for (int item = blockIdx.x; item < DEPTH * NCG * 2; item += gridDim.x) {
        const int l = item / (NCG * 2), rem = item % (NCG * 2), cgp = rem >> 1, kh = rem & 1;
        const int kbase = kh * 512 + wave * 64;
        const float* wp = p.w_mod + ((size_t)l * D + kbase) * NMOD + cgp * 256 + 4 * lane;
        f32x4 acc[3];
#pragma unroll
        for (int st = 0; st < 3; ++st) acc[st] = (f32x4){0.f, 0.f, 0.f, 0.f};
#pragma unroll 16
        for (int kk = 0; kk < 64; ++kk) { const f32x4 w = *(const f32x4*)(wp + (size_t)kk * NMOD);
#pragma unroll
            for (int st = 0; st < 3; ++st) acc[st] = acc[st] + w * SC[st * D + kbase + kk]; }
#pragma unroll
        for (int st = 0; st < 3; ++st) *(LAS f32x4*)(RED + (wave * 3 + st) * 256 + 4 * lane) = acc[st];
        __syncthreads();
        for (int o = tid; o < 3 * 256; o += NTHR) { const int st = o >> 8, n = o & 255; float v = 0.f;
#pragma unroll
            for (int w8 = 0; w8 < 8; ++w8) v += RED[(w8 * 3 + st) * 256 + n];
            if (kh == 0) v += p.b_mod[(size_t)l * NMOD + cgp * 256 + n];
            atomicAdd(p.MOD + ((size_t)l * 3 + st) * NMOD + cgp * 256 + n, v); }
        __syncthreads();
    }
}

constexpr int NPL = 11, NPH = 1 + DEPTH * NPL;
struct Args { Params p; int ph_lo, ph_hi; };
__global__ void __launch_bounds__(NTHR, 2) mega_fwd(Args args) {
    LAS unsigned char* lds = (LAS unsigned char*)lds_raw;
    {
        const int tid0 = threadIdx.x;
        for (int u = tid0; u < (LDS_BYTES - LDSCTL_OFF) / 4; u += NTHR) ((LAS unsigned*)(lds + LDSCTL_OFF))[u] = 0u;
        __syncthreads();
    }
    int wslot = 0;
    { unsigned m_ = ~0u; asm volatile("" : "+s"(m_));
      const int simd = (int)(__builtin_amdgcn_s_getreg((1 << 11) | (4 << 6) | 4) & 3u);
      if (__builtin_amdgcn_mbcnt_hi(m_, __builtin_amdgcn_mbcnt_lo(m_, 0u)) == 0) wslot = simd + 4 * (int)__hip_atomic_fetch_add(((unsigned*)(lds_raw + MISC_OFF + 64)) + simd, 1u, __ATOMIC_RELAXED, __HIP_MEMORY_SCOPE_WORKGROUP); }
    wslot = __builtin_amdgcn_readfirstlane(wslot) & 7;
#define MY_TID(var) int var; { unsigned m_ = ~0u; asm volatile("" : "+s"(m_)); var = wslot * 64 + (int)__builtin_amdgcn_mbcnt_hi(m_, __builtin_amdgcn_mbcnt_lo(m_, 0u)); } asm volatile("" : "+v"(var))
    XcdBarrier bar; bar.bar = args.p.CTL; bar.x = 0;
    const bool multi = args.ph_hi - args.ph_lo > 1;
    if (multi) { MY_TID(t0); bar = xcd_barrier_post(args.p.CTL, t0 == 0); }
    const int G = gridDim.x;
    const int ph_lo = args.ph_lo, ph_hi = args.ph_hi;
#ifndef PHMASK
#define PHMASK 0xFFFF
#endif
#define PH_ON(k) ((k) == 0 ? (PHMASK & 1) : ((PHMASK >> (1 + ((k) - 1) % NPL)) & 1))
#ifndef REPMASK
#define REPMASK 0
#endif
#ifndef REP_LOCAL
#define REP_LOCAL 0
#define REP_CONV 0
#define REP_ATTN 0
#endif
#ifndef HG_STOP
#define HG_STOP 0
#endif
#ifndef REP_P0
#define REP_P0 0
#endif
#define REP_N(k) (((k) == 0 && REP_P0) ? 2 : (((k) > 0 && ((REPMASK >> (((k) - 1) % NPL)) & 1)) ? 2 : 1))
#define PH_BEGIN(k) if (PH_ON(k) && ph_lo <= (k) && (k) < ph_hi) { for (int rep_ = 0; rep_ < REP_N(k); ++rep_) { const AS4 Args* kp = (const AS4 Args*)__builtin_amdgcn_kernarg_segment_ptr(); asm volatile("" : "+s"(kp)); PRef p = kp->p; MY_TID(tid);
#define PH_END_IF(k, cond) } if ((cond) && (k) + 1 < ph_hi) { MY_TID(t1); xcd_barrier(bar, t1 == 0, XB_ST(lds_raw)); } }
#ifndef REP_CVT
#define REP_CVT 0
#endif
#ifndef REP_BAR
#define REP_BAR 0
#endif
#define PH_END(k) } if ((k) + 1 < ph_hi) { for (int rb_ = 0; rb_ < 1 + REP_BAR; ++rb_) { MY_TID(t1); xcd_barrier(bar, t1 == 0, XB_ST(lds_raw)); } } }
    PH_BEGIN(0)
        phase_adaln(tid, p, lds);
        run_items<b_lb>(tid, p, 0, 2L * 384, 0);
        phase_convert(tid, p, 0, lds, 1, 0);
    PH_END(0)
#define LAYER(l)                                                                                                                                     \
    PH_BEGIN(1 + (l) * NPL + 0) if ((l) == 0) { phase_rows<0>(tid, p, 0, lds); } PH_END_IF(1 + (l) * NPL + 0, (l) == 0)                                 \
    PH_BEGIN(1 + (l) * NPL + 1) {                                                                                                                    \
        pg8::Gemm g{p.H, p.WIN_T + WBOFF(l), NTOK, INC, D, nullptr, 0, 1, 0}; pg8::StaticOrder S; S.init(NTOK, INC, G, (int)blockIdx.x);                         \
        pg8::EpiP E{p.P, INC, p.q_norm + (l) * HD, p.k_norm + (l) * HD, rep_};                                                    \
        pg8::gemm_phase<pg8::EpiP, false>(tid, lds, g, S, E);                                                                                     \
        } PH_END(1 + (l) * NPL + 1)               \
    PH_BEGIN(1 + (l) * NPL + 2) if constexpr (!FUSE_QK) { phase_qkprep(tid, p, l); } if constexpr (FAST_HGRN && (HGRN_DIAG == 3 || HGRN_DIAG == 4)) { phase_hgrn_local(tid, p, l, lds); { MY_TID(t7); run_items<b_hgrn_local_slow>(t7, p, l, 2L * NBH * NCH * 64, 0); } } else if constexpr (FAST_HGRN && HGRN_DIAG >= 2) { run_items<b_hgrn_local_slow>(tid, p, l, 2L * NBH * NCH * 64, 0); } else if constexpr (FAST_HGRN) { for (int r2_ = 0; r2_ < 1 + REP_LOCAL; ++r2_) phase_hgrn_local(tid, p, l, lds); } else { run_items<b_gates>(tid, p, l, (long)NTOK * 768, 0); } phase_conv(tid, p, l); PH_END(1 + (l) * NPL + 2) \
    PH_BEGIN(1 + (l) * NPL + 3) if constexpr (FAST_HGRN && HGRN_DIAG) { run_items<b_hgrn_scan_slow>(tid, p, l, 2L * NBH * 4096, 0); } else if constexpr (FAST_HGRN) { phase_hgrn_scan(tid, p); } else { run_items<b_hgrn_seq2>(tid, p, l, 2L * NB * HGH * 64, 0); } if constexpr (FAST_ATTN) { for (int r4_ = 0; r4_ < 1 + REP_ATTN; ++r4_) { MY_TID(t6); phase_attn(t6, p, l, lds); } } else { run_items<b_attn>(tid, p, l, (long)NTOK * NAH, 0); } PH_END(1 + (l) * NPL + 3) \
    PH_BEGIN(1 + (l) * NPL + 4) if constexpr (FAST_HGRN && HGRN_DIAG) { run_items<b_hgrn_chunkseq>(tid, p, l, 2L * NBH * NCH * 64, 0); { MY_TID(t9); xcd_barrier(bar, t9 == 0, XB_ST(lds_raw)); } { MY_TID(t8); run_items<b_hgfin>(t8, p, l, (long)NTOK * HGH, 0); } } else if constexpr (FAST_HGRN) { phase_hgrn_out(tid, p, l, lds); } else { run_items<b_hgfin>(tid, p, l, (long)NTOK * HGH, 0); } PH_END(1 + (l) * NPL + 4)                                         \
    PH_BEGIN(1 + (l) * NPL + 5) {                                                                                                                    \
        pg8::Gemm g{p.MIX, p.WOUT_T + WBOFF(l), NLAT, D, MIXD, nullptr, 0, 1, 0}; pg8::StaticOrder S; S.init(NLAT, D, G, (int)blockIdx.x);                       \
        pg8::EpiRes E{p.XB, D, p.MOD + (size_t)(l) * 3 * NMOD + 2 * D, SEQ, (size_t)NMOD};                                                           \
        pg8::gemm_phase<pg8::EpiRes, false>(tid, lds, g, S, E);                                                                                      \
        if ((l) + 1 < DEPTH) { MY_TID(tid2); mini_gemm<1>(tid2, p, l); } } PH_END(1 + (l) * NPL + 5)                  \
    PH_BEGIN(1 + (l) * NPL + 6) phase_rows<1>(tid, p, l, lds); PH_END(1 + (l) * NPL + 6)                                                               \
    PH_BEGIN(1 + (l) * NPL + 7) if constexpr (FAST_TOPK) { phase_topk(tid, p, lds); if ((l) == 0 && gridDim.x > 2 * NB * NE + 32) { MY_TID(t4); phase_convert(t4, p, 0, lds, 2, 2 * NB * NE); } else if ((l) == 0) { MY_TID(t4); phase_convert(t4, p, 0, lds, 2, 0); } else if ((l) + 1 < DEPTH) { MY_TID(t4); phase_convert(t4, p, (l) + 1, lds, 0, gridDim.x > 2 * NB * NE + 32 ? 2 * NB * NE : 0); } } else { run_items<b_rank>(tid, p, l, (long)NTOK * NE, 0); } PH_END(1 + (l) * NPL + 7)                                          \
    PH_BEGIN(1 + (l) * NPL + 8) {                                                                                                                    \
        pg8::Gemm g{p.H, p.WGU_T + WBOFF(l), NSLOT_L, 2 * ED, D, p.STOK, CAPL / 256, NE, (size_t)2 * ED * D * 2}; pg8::StaticOrder S; S.init(NSLOT_L, 2 * ED, G, (int)blockIdx.x); \
        pg8::EpiHid E{p.HID, ED};                                                                                                                    \
        pg8::gemm_phase<pg8::EpiHid, true>(tid, lds, g, S, E);                                                                                       \
        if ((l) + 1 < DEPTH) { MY_TID(tid2); mini_gemm<2>(tid2, p, l); } } PH_END(1 + (l) * NPL + 8)              \
    PH_BEGIN(1 + (l) * NPL + 9) {                                                                                                                    \
        pg8::Gemm g{p.HID, p.WD_T + WBOFF(l), NSLOT_L, D, ED, nullptr, CAPL / 256, NE, (size_t)D * ED * 2}; pg8::StaticOrder S; S.init(NSLOT_L, D, G, (int)blockIdx.x); \
        pg8::EpiBf16 E{p.Y, D, p.SVAL, 0};                                                                                                              \
        pg8::gemm_phase<pg8::EpiBf16, false>(tid, lds, g, S, E);                                                                                     \
        if ((l) + 1 < DEPTH) { MY_TID(tid2); mini_gemm<3>(tid2, p, l); } } PH_END(1 + (l) * NPL + 9)                \
    PH_BEGIN(1 + (l) * NPL + 10) phase_rows<2>(tid, p, l, lds); if ((l) == 0) { for (int rc_ = 0; rc_ < 1 + REP_CVT; ++rc_) { MY_TID(t5); phase_convert(t5, p, (l) + 1, lds); } }        PH_END(1 + (l) * NPL + 10)
#ifndef NLAYERS_BUILD
#define NLAYERS_BUILD DEPTH
#endif
    LAYER(0)
    if constexpr (NLAYERS_BUILD > 1) { LAYER(1) }
    if constexpr (NLAYERS_BUILD > 2) { LAYER(2) }
    if constexpr (NLAYERS_BUILD > 3) { LAYER(3) }
}

#ifndef MK_SPLIT
#define MK_SPLIT 0
#endif
extern "C" void kernel_launch(void* const* d_in, const int* in_sizes, int n_in, void* d_out, int out_size, void* d_ws, size_t ws_size,
                              hipStream_t stream) {
    static int grid = 0;
    if (grid == 0) {
        if (n_in != 20 || out_size != NLAT * D || ws_size < WS_END) { fprintf(stderr, "kernel_launch: unexpected problem (n_in %d out %d ws %zu need %zu)\n", n_in, out_size, ws_size, (size_t)WS_END); grid = -1; return; }
        int dev = 0, cus = 0;
        if (hipGetDevice(&dev) != hipSuccess || hipDeviceGetAttribute(&cus, hipDeviceAttributeMultiprocessorCount, dev) != hipSuccess) { grid = -1; return; }
        if (hipFuncSetAttribute((const void*)mega_fwd, hipFuncAttributeMaxDynamicSharedMemorySize, LDS_BYTES) != hipSuccess) { fprintf(stderr, "kernel_launch: hipFuncSetAttribute failed\n"); grid = -1; return; }
        int per_cu = 0;
        if (hipOccupancyMaxActiveBlocksPerMultiprocessor(&per_cu, (const void*)mega_fwd, NTHR, LDS_BYTES) != hipSuccess || per_cu < 1) { fprintf(stderr, "kernel_launch: occupancy query says %d\n", per_cu); }
        (void)hipGetLastError();
        grid = cus;
    }
    if (grid < 0) return;
    (void)hipMemsetAsync((char*)d_ws + WS_CTL, 0, WS_LB - WS_CTL, stream);
    Args a{};
    a.p = make_params(d_in, d_out, d_ws);
#if MK_SPLIT
    for (int ph = 0; ph < NPH; ++ph) { a.ph_lo = ph; a.ph_hi = ph + 1; hipLaunchKernelGGL(mega_fwd, dim3(grid), dim3(NTHR), LDS_BYTES, stream, a); }
#else
    a.ph_lo = 0; a.ph_hi = NPH;
    hipLaunchKernelGGL(mega_fwd, dim3(grid), dim3(NTHR), LDS_BYTES, stream, a);
#endif
}
#endif
```

```cpp
#ifndef CPU_SIM
#include <hip/hip_runtime.h>
#define BODY __device__ __forceinline__
#define FSIN(x) __sinf(x)
#define FCOS(x) __cosf(x)
#else
#include <cmath>
#include <cstdio>
#include <cstdlib>
#include <cstring>
#define BODY static inline
#define FSIN(x) sinf(x)
#define FCOS(x) cosf(x)
#endif
#include <stdint.h>
#include <stddef.h>

#ifndef CFG_D
#define CFG_D 1024
#define CFG_SEQ 16384
#define CFG_CTX 256
#define CFG_EDIM 512
#define CFG_DEPTH 4
#endif

typedef unsigned short bf16_t;

constexpr int D = CFG_D, NB = 2, SEQ = CFG_SEQ, DEPTH = CFG_DEPTH, GW = 64, ROWS = SEQ / GW, CTX = CFG_CTX;
constexpr int HD = 64, NAH = 6, HGH = 6, CVD = 256, MIXD = 1024, INC = 3840, NMOD = 6 * D;
constexpr int NE = 16, ED = CFG_EDIM, CAPL = 2 * SEQ / NE, CAPC = 2 * CTX / NE;
constexpr int NLAT = NB * SEQ, NCTX = NB * CTX, NTOK = NLAT + NCTX;
constexpr int NSLOT_L = NB * NE * CAPL, NSLOT_C = NB * NE * CAPC, NSLOT = NSLOT_L + NSLOT_C;
constexpr int OQ = 0, OK_ = 384, OV = 768, OHQ = 1152, OFF_ = 1536, OFB = 1920, OHI = 2304, OHG_ = 2688, OCB = 3072, OCC = 3328, OCU = 3584;
constexpr float EPS = 1e-6f;
constexpr int NCH = (CTX + SEQ) / 64, NCHC = CTX / 64, NBH = NB * HGH;

struct Params {
    const float *x, *c, *ctx, *c_ctx, *w_mod, *b_mod, *norm1_w, *w_in, *q_norm, *k_norm, *rpb, *lb_logits, *hg_norm, *conv_w, *w_out,
        *norm2_w, *w_router, *w_gate, *w_up, *w_down;
    float *XL, *XC, *MOD, *LB, *AFF, *SVAL, *FG, *OHG;
    bf16_t *H, *P, *MIX, *HID, *Y;
    int *STOK, *INV;
    bf16_t *WIN_T, *WOUT_T, *WGU_T, *WD_T;
    unsigned* CTL;
    bf16_t* SLOC;
    float* GDEC;
    bf16_t* XB;
};

#ifndef CPU_SIM
#define AS4 __attribute__((address_space(4)))
typedef const AS4 Params& PRef;
#else
typedef const Params& PRef;
#endif
BODY float bf2f(bf16_t v) { return __builtin_bit_cast(float, (unsigned)v << 16); }
BODY bf16_t f2bf(float f) { unsigned u = __builtin_bit_cast(unsigned, f); u += 0x7fffu + ((u >> 16) & 1u); return (bf16_t)(u >> 16); }
BODY float silu_f(float x) { return x / (1.f + expf(-x)); }
BODY float sigmoid_f(float x) { return 1.f / (1.f + expf(-x)); }
BODY int modset(int r) { return r < NLAT ? r / SEQ : 2; }
BODY float* xrow(PRef p, int r) { return r < NLAT ? p.XL + (size_t)r * D : p.XC + (size_t)(r - NLAT) * D; }

BODY void b_adaln(long gid, PRef p, int) {
    const int n = (int)(gid % NMOD), s = (int)((gid / NMOD) % 3), l = (int)(gid / (3 * NMOD));
    const float* cv = s < 2 ? p.c + s * D : p.c_ctx;
    const float* w = p.w_mod + (size_t)l * D * NMOD + n;
    float acc = 0.f;
    for (int k = 0; k < D; ++k) acc += silu_f(cv[k]) * w[(size_t)k * NMOD];
    p.MOD[gid] = acc + p.b_mod[l * NMOD + n];
}
BODY void b_lb(long gid, PRef p, int) {
    const int dir = (int)(gid / 384), j = (int)(gid % 384);
    const float* lg = p.lb_logits + (size_t)dir * DEPTH * 384 + j;
    float m = -INFINITY;
    for (int l = 0; l < DEPTH; ++l) m = fmaxf(m, lg[l * 384]);
    float s = 0.f;
    for (int l = 0; l < DEPTH; ++l) s += expf(lg[l * 384] - m);
    float cum = 0.f;
    p.LB[(dir * DEPTH + 0) * 384 + j] = 0.f;
    for (int l = 1; l < DEPTH; ++l) { cum += expf(lg[l * 384] - m) / s; p.LB[(dir * DEPTH + l) * 384 + j] = cum; }
}
BODY void b_copyx(long gid, PRef p, int) {
    if (gid < (long)NLAT * D) p.XL[gid] = p.x[gid]; else p.XC[gid - (long)NLAT * D] = p.ctx[gid - (long)NLAT * D];
}
template <int WHICH> BODY void b_prenorm(long gid, PRef p, int l) {
    const int r = (int)gid;
    const float* xr = xrow(p, r);
    const float* nw = (WHICH ? p.norm2_w : p.norm1_w) + l * D;
    const float* mod = p.MOD + ((size_t)l * 3 + modset(r)) * NMOD;
    const float* shift = mod + (WHICH ? 3 : 0) * D;
    const float* scale = mod + (WHICH ? 4 : 1) * D;
    float ss = 0.f;
    for (int k = 0; k < D; ++k) ss += xr[k] * xr[k];
    const float rstd = 1.f / sqrtf(ss / D + EPS);
    float lg[NE];
#pragma unroll
    for (int e = 0; e < NE; ++e) lg[e] = 0.f;
    for (int k = 0; k < D; ++k) {
        const float h = xr[k] * rstd * nw[k] * (1.f + scale[k]) + shift[k];
        p.H[(size_t)r * D + k] = f2bf(h);
        if (WHICH) {
            const float* wr = p.w_router + ((size_t)l * D + k) * NE;
#pragma unroll
            for (int e = 0; e < NE; ++e) lg[e] += h * wr[e];
        }
    }
    if (WHICH) {
        float m = lg[0];
#pragma unroll
        for (int e = 1; e < NE; ++e) m = fmaxf(m, lg[e]);
        float s = 0.f;
#pragma unroll
        for (int e = 0; e < NE; ++e) { lg[e] = expf(lg[e] - m); s += lg[e]; }
#pragma unroll
        for (int e = 0; e < NE; ++e) p.AFF[(size_t)r * NE + e] = lg[e] / s;
    }
}
BODY void b_gemm_in(long gid, PRef p, int l) {
    const int r = (int)(gid / (INC / 4)), n = (int)(gid % (INC / 4)) * 4;
    const bf16_t* a = p.H + (size_t)r * D;
    const float* w = p.w_in + (size_t)l * D * INC + n;
    float a0 = 0.f, a1 = 0.f, a2 = 0.f, a3 = 0.f;
    for (int k = 0; k < D; ++k) { const float av = bf2f(a[k]); const float* wk = w + (size_t)k * INC; a0 += av * wk[0]; a1 += av * wk[1]; a2 += av * wk[2]; a3 += av * wk[3]; }
    bf16_t* o = p.P + (size_t)r * INC + n;
    o[0] = f2bf(a0); o[1] = f2bf(a1); o[2] = f2bf(a2); o[3] = f2bf(a3);
}
BODY void b_qkprep(long gid, PRef p, int l) {
    const int r = (int)(gid / 12), which = (int)(gid % 12) / 6, head = (int)(gid % 6);
    bf16_t* ptr = p.P + (size_t)r * INC + (which ? OK_ : OQ) + head * HD;
    const float* nw = (which ? p.k_norm : p.q_norm) + l * HD;
    float y[HD];
    float ss = 0.f;
#pragma unroll
    for (int d = 0; d < HD; ++d) { y[d] = bf2f(ptr[d]); ss += y[d] * y[d]; }
    const float rstd = 1.f / sqrtf(ss / HD + EPS);
#pragma unroll
    for (int d = 0; d < HD; ++d) y[d] = y[d] * rstd * nw[d];
    if (r < NLAT) {
        const int t = r % SEQ; const float row = (float)(t / GW), col = (float)(t % GW);
#pragma unroll
        for (int d = 0; d < 16; ++d) {
            const float inv = powf(10000.f, -(float)d / 16.f);
            const float ar = row * inv, ac = col * inv;
            const float cr = FCOS(ar), sr = FSIN(ar), cc = FCOS(ac), sc = FSIN(ac);
            const float x0 = y[d], x1 = y[d + 16], x2 = y[d + 32], x3 = y[d + 48];
            y[d] = x0 * cr - x1 * sr; y[d + 16] = x1 * cr + x0 * sr; y[d + 32] = x2 * cc - x3 * sc; y[d + 48] = x3 * cc + x2 * sc;
        }
    }
#pragma unroll
    for (int d = 0; d < HD; ++d) ptr[d] = f2bf(y[d]);
}
BODY void b_attn(long gid, PRef p, int l) {
    const int r = (int)(gid / NAH), head = (int)(gid % NAH);
    float q[HD], acc[HD];
    const bf16_t* qp = p.P + (size_t)r * INC + OQ + head * HD;
#pragma unroll
    for (int d = 0; d < HD; ++d) { q[d] = bf2f(qp[d]) * 0.125f; acc[d] = 0.f; }
    float m = -INFINITY, s = 0.f;
    const int b = r < NLAT ? r / SEQ : (r - NLAT) / CTX;
    const int nloc = r < NLAT ? 128 : 0;
    int row = 0, col = 0, rs = 0, ws = 0;
    if (r < NLAT) { const int t = r % SEQ; row = t / GW; col = t % GW; rs = row - 4; rs = rs < 0 ? 0 : (rs > ROWS - 8 ? ROWS - 8 : rs); ws = col - 8; ws = ws < 0 ? 0 : (ws > GW - 16 ? GW - 16 : ws); }
    for (int j = 0; j < nloc + CTX; ++j) {
        int kr; float bias = 0.f;
        if (j < nloc) { const int i = j / 16, jj = j % 16; kr = b * SEQ + (rs + i) * GW + ws + jj; bias = p.rpb[(((size_t)l * NAH + head) * 15 + (rs + i - row + 7)) * 31 + (ws + jj - col + 15)]; }
        else kr = NLAT + b * CTX + (j - nloc);
        const bf16_t* kp = p.P + (size_t)kr * INC + OK_ + head * HD;
        const bf16_t* vp = p.P + (size_t)kr * INC + OV + head * HD;
        float sc = 0.f;
#pragma unroll
        for (int d = 0; d < HD; ++d) sc += q[d] * bf2f(kp[d]);
        sc += bias;
        const float mn = fmaxf(m, sc), corr = expf(m - mn), pj = expf(sc - mn);
        s = s * corr + pj;
#pragma unroll
        for (int d = 0; d < HD; ++d) acc[d] = acc[d] * corr + pj * bf2f(vp[d]);
        m = mn;
    }
    const float inv = 1.f / s;
    bf16_t* o = p.MIX + (size_t)r * MIXD + head * HD;
#pragma unroll
    for (int d = 0; d < HD; ++d) o[d] = f2bf(acc[d] * inv);
}
BODY void b_gates(long gid, PRef p, int l) {
    const int j = (int)(gid % 384), dir = (int)((gid / 384) % 2), r = (int)(gid / 768);
    const float z = bf2f(p.P[(size_t)r * INC + (dir ? OFB : OFF_) + j]);
    const float lbv = p.LB[(dir * DEPTH + l) * 384 + j];
    p.FG[gid] = lbv + (1.f - lbv) * sigmoid_f(z);
}
template <int DIR> BODY void b_hgrn_seq(long gid, PRef p, int) {
    const int v = (int)(gid % 64), h = (int)((gid / 64) % HGH), b = (int)(gid / (64 * HGH));
    float S[64];
#pragma unroll
    for (int k = 0; k < 64; ++k) S[k] = 0.f;
    for (int step = 0; step < CTX + SEQ; ++step) {
        int r;
        if (step < CTX) r = NLAT + b * CTX + (DIR ? CTX - 1 - step : step);
        else r = b * SEQ + (DIR ? SEQ - 1 - (step - CTX) : (step - CTX));
        const float vv = bf2f(p.P[(size_t)r * INC + OHI + h * 64 + v]);
        const float* fr = p.FG + ((size_t)r * 2 + DIR) * 384 + h * 64;
        const bf16_t* qr = p.P + (size_t)r * INC + OHQ + h * 64;
        float o = 0.f;
#pragma unroll
        for (int k = 0; k < 64; ++k) { const float f = fr[k]; S[k] = f * S[k] + (1.f - f) * vv; o += S[k] * bf2f(qr[k]); }
        o *= 0.125f;
        p.OHG[((size_t)DIR * NTOK + r) * 384 + h * 64 + v] = o;
    }
}
BODY void b_hgfin(long gid, PRef p, int l) {
    const int r = (int)(gid / HGH), h = (int)(gid % HGH);
    const float* op = p.OHG + (size_t)r * 384 + h * 64;
    const float* op1 = op + (size_t)NTOK * 384;
    float o[64]; float ss = 0.f;
#pragma unroll
    for (int v = 0; v < 64; ++v) { o[v] = op[v] + op1[v]; ss += o[v] * o[v]; }
    const float rstd = 1.f / sqrtf(ss / 64.f + EPS);
    const bf16_t* g = p.P + (size_t)r * INC + OHG_ + h * 64;
    bf16_t* out = p.MIX + (size_t)r * MIXD + 384 + h * 64;
#pragma unroll
    for (int v = 0; v < 64; ++v) out[v] = f2bf(o[v] * rstd * p.hg_norm[l * 64 + v] * silu_f(bf2f(g[v])));
}
BODY void b_conv(long gid, PRef p, int l) {
    const int ch = (int)(gid % CVD), r = (int)(gid / CVD);
    int t, T;
    if (r < NLAT) { t = r % SEQ; T = SEQ; } else { t = (r - NLAT) % CTX; T = CTX; }
    const float* w = p.conv_w + (size_t)l * 3 * CVD + ch;
    float y = 0.f;
    for (int j = 0; j < 3; ++j) {
        const int tt = t + j - 1;
        if (tt < 0 || tt >= T) continue;
        const bf16_t* pr = p.P + (size_t)(r + j - 1) * INC;
        y += w[j * CVD] * bf2f(pr[OCC + ch]) * bf2f(pr[OCU + ch]);
    }
    p.MIX[(size_t)r * MIXD + 768 + ch] = f2bf(bf2f(p.P[(size_t)r * INC + OCB + ch]) * y);
}
BODY void b_gemm_out(long gid, PRef p, int l) {
    const int r = (int)(gid / (D / 4)), n = (int)(gid % (D / 4)) * 4;
    const bf16_t* a = p.MIX + (size_t)r * MIXD;
    const float* w = p.w_out + (size_t)l * MIXD * D + n;
    float a0 = 0.f, a1 = 0.f, a2 = 0.f, a3 = 0.f;
    for (int k = 0; k < MIXD; ++k) { const float av = bf2f(a[k]); const float* wk = w + (size_t)k * D; a0 += av * wk[0]; a1 += av * wk[1]; a2 += av * wk[2]; a3 += av * wk[3]; }
    const float* g = p.MOD + ((size_t)l * 3 + modset(r)) * NMOD + 2 * D + n;
    float* xr = xrow(p, r) + n;
    xr[0] += g[0] * a0; xr[1] += g[1] * a1; xr[2] += g[2] * a2; xr[3] += g[3] * a3;
}
BODY void b_rank(long gid, PRef p, int) {
    const int e = (int)(gid % NE), r = (int)(gid / NE);
    int t, T, row0, cap, base;
    if (r < NLAT) { const int b = r / SEQ; t = r % SEQ; T = SEQ; row0 = b * SEQ; cap = CAPL; base = (b * NE + e) * CAPL; }
    else { const int b = (r - NLAT) / CTX; t = (r - NLAT) % CTX; T = CTX; row0 = NLAT + b * CTX; cap = CAPC; base = NSLOT_L + (b * NE + e) * CAPC; }
    const float a = p.AFF[(size_t)r * NE + e];
    const float* col = p.AFF + (size_t)row0 * NE + e;
    int rank = 0;
    for (int tt = 0; tt < T; ++tt) { const float o = col[(size_t)tt * NE]; rank += (o > a || (o == a && tt < t)) ? 1 : 0; }
    if (rank < cap) { p.STOK[base + rank] = r; p.SVAL[base + rank] = a; p.INV[(size_t)r * NE + e] = base + rank; }
    else p.INV[(size_t)r * NE + e] = -1;
}
BODY int slot_expert(int s) { return s < NSLOT_L ? (s / CAPL) % NE : ((s - NSLOT_L) / CAPC) % NE; }
BODY void b_moe1(long gid, PRef p, int l) {
    const int s = (int)(gid / (ED / 4)), f = (int)(gid % (ED / 4)) * 4;
    const int e = slot_expert(s); int row = p.STOK[s]; row = row < 0 ? 0 : (row >= NTOK ? NTOK - 1 : row);
    const bf16_t* a = p.H + (size_t)row * D;
    const float* wg = p.w_gate + ((size_t)l * NE + e) * D * ED + f;
    const float* wu = p.w_up + ((size_t)l * NE + e) * D * ED + f;
    float g0 = 0.f, g1 = 0.f, g2 = 0.f, g3 = 0.f, u0 = 0.f, u1 = 0.f, u2 = 0.f, u3 = 0.f;
    for (int k = 0; k < D; ++k) {
        const float av = bf2f(a[k]); const float* gk = wg + (size_t)k * ED; const float* uk = wu + (size_t)k * ED;
        g0 += av * gk[0]; g1 += av * gk[1]; g2 += av * gk[2]; g3 += av * gk[3];
        u0 += av * uk[0]; u1 += av * uk[1]; u2 += av * uk[2]; u3 += av * uk[3];
    }
    bf16_t* o = p.HID + (size_t)s * ED + f;
    o[0] = f2bf(silu_f(g0) * u0); o[1] = f2bf(silu_f(g1) * u1); o[2] = f2bf(silu_f(g2) * u2); o[3] = f2bf(silu_f(g3) * u3);
}
BODY void b_moe2(long gid, PRef p, int l) {
    const int s = (int)(gid / (D / 4)), n = (int)(gid % (D / 4)) * 4;
    const int e = slot_expert(s);
    const bf16_t* a = p.HID + (size_t)s * ED;
    const float* w = p.w_down + ((size_t)l * NE + e) * ED * D + n;
    float a0 = 0.f, a1 = 0.f, a2 = 0.f, a3 = 0.f;
    for (int k = 0; k < ED; ++k) { const float av = bf2f(a[k]); const float* wk = w + (size_t)k * D; a0 += av * wk[0]; a1 += av * wk[1]; a2 += av * wk[2]; a3 += av * wk[3]; }
    const float val = p.SVAL[s];
    bf16_t* o = p.Y + (size_t)s * D + n;
    o[0] = f2bf(val * a0); o[1] = f2bf(val * a1); o[2] = f2bf(val * a2); o[3] = f2bf(val * a3);
}
BODY void b_combine(long gid, PRef p, int l) {
    const int r = (int)(gid / (D / 4)), n = (int)(gid % (D / 4)) * 4;
    float a0 = 0.f, a1 = 0.f, a2 = 0.f, a3 = 0.f;
    for (int e = 0; e < NE; ++e) {
        const int s = p.INV[(size_t)r * NE + e];
        if (s >= 0) { const bf16_t* y = p.Y + (size_t)s * D + n; a0 += bf2f(y[0]); a1 += bf2f(y[1]); a2 += bf2f(y[2]); a3 += bf2f(y[3]); }
    }
    const float* g = p.MOD + ((size_t)l * 3 + modset(r)) * NMOD + 5 * D + n;
    float* xr = xrow(p, r) + n;
    xr[0] += g[0] * a0; xr[1] += g[1] * a1; xr[2] += g[2] * a2; xr[3] += g[3] * a3;
}


#ifndef HGRN_DIAG
#define HGRN_DIAG 0
#endif
BODY void b_hgrn_chunkseq(long gid, PRef p, int l) {
    const int v = (int)(gid % 64), pc = (int)((gid / 64) % NCH), bh = (int)((gid / (64 * NCH)) % NBH), dir = (int)(gid / (64L * NCH * NBH));
    const int h = bh % HGH, b = bh / HGH, row0 = pc < NCHC ? NLAT + b * CTX + pc * 64 : b * SEQ + (pc - NCHC) * 64;
    const bf16_t* sin = p.SLOC + ((size_t)(dir * NBH + bh) * NCH + pc) * 4096 + v * 64;
    float S[64];
#pragma unroll
    for (int k = 0; k < 64; ++k) S[k] = bf2f(sin[k]);
    for (int i = 0; i < 64; ++i) {
        const int r = row0 + (dir ? 63 - i : i);
        const float vv = bf2f(p.P[(size_t)r * INC + OHI + h * 64 + v]);
        const bf16_t* zr = p.P + (size_t)r * INC + (dir ? OFB : OFF_) + h * 64;
        const bf16_t* qr = p.P + (size_t)r * INC + OHQ + h * 64;
        const float* lb = p.LB + (size_t)(dir * DEPTH + l) * 384 + h * 64;
        float o = 0.f;
#pragma unroll
        for (int k = 0; k < 64; ++k) { const float f = lb[k] + (1.f - lb[k]) * sigmoid_f(bf2f(zr[k])); S[k] = f * S[k] + (1.f - f) * vv; o += S[k] * bf2f(qr[k]); }
        p.OHG[((size_t)dir * NTOK + r) * 384 + h * 64 + v] = o * 0.125f;
    }
}

BODY void b_hgrn_scan_slow(long gid, PRef p, int) {
    const int e = (int)(gid % 4096), sq = (int)(gid / 4096), dir = sq / NBH, k = e & 63;
    bf16_t* S = p.SLOC + (size_t)sq * NCH * 4096 + e;
    const float* G = p.GDEC + (size_t)sq * NCH * 64 + k;
    float c = 0.f;
    for (int j = 0; j < NCH; ++j) {
        const int pc = dir ? (j < NCHC ? NCHC - 1 - j : NCH + NCHC - 1 - j) : j;
        const float x = bf2f(S[(size_t)pc * 4096]);
        S[(size_t)pc * 4096] = f2bf(c);
        c = G[(size_t)pc * 64] * c + x;
    }
}

BODY void b_hgrn_local_slow(long gid, PRef p, int l) {
    const int v = (int)(gid % 64), pc = (int)((gid / 64) % NCH), bh = (int)((gid / (64 * NCH)) % NBH), dir = (int)(gid / (64L * NCH * NBH));
    const int h = bh % HGH, b = bh / HGH, row0 = pc < NCHC ? NLAT + b * CTX + pc * 64 : b * SEQ + (pc - NCHC) * 64;
    float S[64], g[64];
#pragma unroll
    for (int k = 0; k < 64; ++k) { S[k] = 0.f; g[k] = 1.f; }
    for (int i = 0; i < 64; ++i) {
        const int r = row0 + (dir ? 63 - i : i);
        const float vv = bf2f(p.P[(size_t)r * INC + OHI + h * 64 + v]);
        const bf16_t* zr = p.P + (size_t)r * INC + (dir ? OFB : OFF_) + h * 64;
        const float* lb = p.LB + (size_t)(dir * DEPTH + l) * 384 + h * 64;
#pragma unroll
        for (int k = 0; k < 64; ++k) { const float f = lb[k] + (1.f - lb[k]) * sigmoid_f(bf2f(zr[k])); S[k] = f * S[k] + (1.f - f) * vv; g[k] *= f; }
    }
    bf16_t* dst = p.SLOC + ((size_t)(dir * NBH + bh) * NCH + pc) * 4096 + v * 64;
    if (HGRN_DIAG != 3 && HGRN_DIAG != 4) {
#pragma unroll
    for (int k = 0; k < 64; ++k) dst[k] = f2bf(S[k]);
    }
    if (v == 0) {
        float* gd = p.GDEC + ((size_t)(dir * NBH + bh) * NCH + pc) * 64;
#pragma unroll
        for (int k = 0; k < 64; ++k) gd[k] = g[k];
    }
}
#ifndef FAST_TOPK
#define FAST_TOPK 1
#endif
#ifndef FAST_HGRN
#define FAST_HGRN 1
#endif
#ifndef FAST_ATTN
#define FAST_ATTN 1
#endif
constexpr size_t al256(size_t x) { return (x + 255) & ~(size_t)255; }
constexpr size_t CTL_BYTES = 65536;
constexpr size_t WS_CTL = 0;
constexpr size_t WS_MOD = WS_CTL + CTL_BYTES;
constexpr size_t WS_LB = WS_MOD + al256((size_t)DEPTH * 3 * NMOD * 4);
constexpr size_t WS_XC = WS_LB + al256((size_t)2 * DEPTH * 384 * 4);
constexpr size_t WS_AFF = WS_XC + al256((size_t)NCTX * D * 4);
constexpr size_t WS_SVAL = WS_AFF + al256((size_t)NTOK * NE * 4);
constexpr size_t WS_STOK = WS_SVAL + al256((size_t)NSLOT * 4);
constexpr size_t WS_INV = WS_STOK + al256((size_t)NSLOT * 4);
constexpr size_t WS_H = WS_INV + al256((size_t)NTOK * NE * 4);
constexpr size_t WS_MIX = WS_H + al256((size_t)NTOK * D * 2);
constexpr size_t WS_P = WS_MIX + al256((size_t)NTOK * MIXD * 2);
constexpr size_t WS_HID = WS_P;
constexpr size_t WS_Y = WS_HID + al256((size_t)NSLOT * ED * 2);
constexpr size_t WS_P_END0 = WS_P + al256((size_t)NTOK * INC * 2);
constexpr size_t WS_P_END1 = WS_Y + al256((size_t)NSLOT * D * 2);
constexpr size_t WS_WB = WS_P_END0 > WS_P_END1 ? WS_P_END0 : WS_P_END1;
constexpr size_t WS_WIN_T = WS_WB;
constexpr size_t WS_WOUT_T = WS_WIN_T + al256((size_t)INC * D * 2);
constexpr size_t WS_WGU_T = WS_WOUT_T + al256((size_t)D * MIXD * 2);
constexpr size_t WS_WD_T = WS_WGU_T + al256((size_t)NE * 2 * ED * D * 2);
constexpr size_t WB_BYTES = WS_WD_T + al256((size_t)NE * D * ED * 2) - WS_WB;
constexpr size_t WS_T = WS_WB + 2 * WB_BYTES;
#if FAST_HGRN
constexpr size_t WS_SLOC = WS_T;
constexpr size_t WS_GDEC = WS_SLOC + al256((size_t)2 * NBH * NCH * 4096 * 2);
constexpr size_t WS_OHG = WS_GDEC + al256((size_t)2 * NBH * NCH * 64 * 4);
constexpr size_t WS_XB = WS_OHG + (HGRN_DIAG ? al256((size_t)2 * NTOK * 384 * 4) : 0);
constexpr size_t WS_END = WS_XB + al256((size_t)NLAT * D * 2);
constexpr size_t WS_FG = WS_T;
#else
constexpr size_t WS_FG = WS_T;
constexpr size_t WS_OHG = WS_FG + al256((size_t)NTOK * 768 * 4);
constexpr size_t WS_SLOC = WS_OHG + al256((size_t)2 * NTOK * 384 * 4);
constexpr size_t WS_GDEC = WS_SLOC;
constexpr size_t WS_XB = WS_SLOC;
constexpr size_t WS_END = WS_XB + al256((size_t)NLAT * D * 2);
#endif

static inline Params make_params(void* const* d_in, void* d_out, void* d_ws) {
    Params p{};
    const float** f = (const float**)&p;
    for (int i = 0; i < 20; ++i) f[i] = (const float*)d_in[i];
    char* ws = (char*)d_ws;
    p.XL = (float*)d_out; p.XC = (float*)(ws + WS_XC); p.MOD = (float*)(ws + WS_MOD); p.LB = (float*)(ws + WS_LB); p.AFF = (float*)(ws + WS_AFF);
    p.SVAL = (float*)(ws + WS_SVAL); p.FG = (float*)(ws + WS_FG); p.OHG = (float*)(ws + WS_OHG);
    p.H = (bf16_t*)(ws + WS_H); p.P = (bf16_t*)(ws + WS_P); p.MIX = (bf16_t*)(ws + WS_MIX); p.HID = (bf16_t*)(ws + WS_HID); p.Y = (bf16_t*)(ws + WS_Y);
    p.STOK = (int*)(ws + WS_STOK); p.INV = (int*)(ws + WS_INV);
    p.WIN_T = (bf16_t*)(ws + WS_WIN_T); p.WOUT_T = (bf16_t*)(ws + WS_WOUT_T); p.WGU_T = (bf16_t*)(ws + WS_WGU_T); p.WD_T = (bf16_t*)(ws + WS_WD_T);
    p.CTL = (unsigned*)(ws + WS_CTL); p.SLOC = (bf16_t*)(ws + WS_SLOC); p.GDEC = (float*)(ws + WS_GDEC); p.XB = (bf16_t*)(ws + WS_XB);
    return p;
}

#define FORWARD_STAGES(STAGE)                                                      \
    STAGE(b_adaln, (long)DEPTH * 3 * NMOD, 0)                                      \
    STAGE(b_lb, 2L * 384, 0)                                                       \
    STAGE(b_copyx, (long)NTOK * D, 0)                                              \
    for (int l = 0; l < DEPTH; ++l) {                                              \
        STAGE(b_prenorm<0>, (long)NTOK, l)                                         \
        STAGE(b_gemm_in, (long)NTOK * (INC / 4), l)                                \
        STAGE(b_qkprep, (long)NTOK * 12, l)                                        \
        STAGE(b_attn, (long)NTOK * NAH, l)                                         \
        STAGE(b_gates, (long)NTOK * 768, l)                                        \
        STAGE(b_hgrn_seq<0>, (long)NB * HGH * 64, l)                               \
        STAGE(b_hgrn_seq<1>, (long)NB * HGH * 64, l)                               \
        STAGE(b_hgfin, (long)NTOK * HGH, l)                                        \
        STAGE(b_conv, (long)NTOK * CVD, l)                                         \
        STAGE(b_gemm_out, (long)NTOK * (D / 4), l)                                 \
        STAGE(b_prenorm<1>, (long)NTOK, l)                                         \
        STAGE(b_rank, (long)NTOK * NE, l)                                          \
        STAGE(b_moe1, (long)NSLOT * (ED / 4), l)                                   \
        STAGE(b_moe2, (long)NSLOT * (D / 4), l)                                    \
        STAGE(b_combine, (long)NTOK * (D / 4), l)                                  \
    }

#ifndef CPU_SIM
#include <cstdio>
#define LAS __attribute__((address_space(3)))
#define GAS __attribute__((address_space(1)))
typedef short bf16x8 __attribute__((ext_vector_type(8)));
typedef float f32x4 __attribute__((ext_vector_type(4)));
typedef float f32x2 __attribute__((ext_vector_type(2)));
typedef unsigned u32x4 __attribute__((ext_vector_type(4)));
typedef unsigned u32x2 __attribute__((ext_vector_type(2)));
constexpr int NWAVES = 8, NTHR = 512;
constexpr int RING_BYTES = 131072, LDSCTL_OFF = RING_BYTES, MISC_OFF = LDSCTL_OFF + 320, TAB_OFF = LDSCTL_OFF + 1024  , LDS_BYTES = 147456;

typedef __bf16 bf16v2_t __attribute__((ext_vector_type(2)));
__device__ __forceinline__ unsigned cvt_pk_bf16_asm(float lo, float hi) { unsigned r; asm volatile("v_cvt_pk_bf16_f32 %0, %1, %2" : "=v"(r) : "v"(lo), "v"(hi)); return r; }
__device__ __forceinline__ unsigned cvt_pk_bf16(float lo, float hi) { bf16v2_t v = {(__bf16)lo, (__bf16)hi}; return __builtin_bit_cast(unsigned, v); }
#define DPPF(x, ctrl) __builtin_bit_cast(float, __builtin_amdgcn_update_dpp(0, __builtin_bit_cast(int, (x)), (ctrl), 0xF, 0xF, true))
#define DPP_X1 0xB1
#define DPP_X2 0x4E
#define DPP_HM 0x141
#define DPP_RM 0x140
__device__ __forceinline__ float x16_other(float x, int lane) { const unsigned u = __builtin_bit_cast(unsigned, x); const auto r = __builtin_amdgcn_permlane16_swap(u, u, false, false); return __builtin_bit_cast(float, (lane & 16) ? r[0] : r[1]); }
__device__ __forceinline__ float x32_other(float x, int lane) { const unsigned u = __builtin_bit_cast(unsigned, x); const auto r = __builtin_amdgcn_permlane32_swap(u, u, false, false); return __builtin_bit_cast(float, (lane & 32) ? r[0] : r[1]); }
__device__ __forceinline__ float x16_sum(float x, int lane) { return x + x16_other(x, lane); }
__device__ __forceinline__ float x32_sum(float x, int lane) { return x + x32_other(x, lane); }
__device__ __forceinline__ float x16_max(float x, int lane) { return fmaxf(x, x16_other(x, lane)); }
__device__ __forceinline__ float x32_max(float x, int lane) { return fmaxf(x, x32_other(x, lane)); }
__device__ __forceinline__ float row16_sum(float v) { v += DPPF(v, DPP_X1); v += DPPF(v, DPP_X2); v += DPPF(v, DPP_HM); v += DPPF(v, DPP_RM); return v; }
__device__ __forceinline__ float row16_max(float v) { v = fmaxf(v, DPPF(v, DPP_X1)); v = fmaxf(v, DPPF(v, DPP_X2)); v = fmaxf(v, DPPF(v, DPP_HM)); v = fmaxf(v, DPPF(v, DPP_RM)); return v; }
__device__ __forceinline__ float oct_sum(float v) { v += DPPF(v, DPP_X1); v += DPPF(v, DPP_X2); v += DPPF(v, DPP_HM); return v; }
__device__ __forceinline__ float wave_sum(float v, int lane) { return x32_sum(x16_sum(row16_sum(v), lane), lane); }

extern __shared__ __attribute__((aligned(16))) unsigned char lds_raw[];
#ifndef FUSE_QK
#define FUSE_QK 1
#endif
__device__ __forceinline__ float bfw(unsigned w, int hi) { return __builtin_bit_cast(float, hi ? (w & 0xffff0000u) : (w << 16)); }
__device__ __forceinline__ float bf8(const u32x4& v, int j) { return bfw(v[j >> 1], j & 1); }
namespace pg8 {
constexpr int BM = 256, BK = 64, HALF = 128, HTB = HALF * BK * 2, STAGE_BYTES = 8 * HTB, NXCD = 8, WGM = 8;
__device__ __forceinline__ int lds_byte(int r, int c) { const int st = (r >> 4) * 2 + (c >> 5), rr = r & 15, cc = c & 31, ob = rr * 64 + cc * 2; return st * 1024 + (ob ^ (((ob >> 9) & 1) << 5)); }
__device__ __forceinline__ void stage_rc(int b, int& R, int& C) { const int st = b / 1024, sb = b % 1024, swz = sb ^ (((sb >> 9) & 1) << 5); R = (st >> 1) * 16 + swz / 64; C = (st & 1) * 32 + (swz % 64) / 2; }
__device__ __forceinline__ int perm32(int rho) { const int n = rho >> 4, i = rho & 15; return 8 * (i >> 2) + 4 * n + (i & 3); }
struct Unit { int pm, pn; };
struct Gemm {
    const bf16_t* A; const bf16_t* Bt; int M, N, K;
    const int* gather;
    int gt, ng; size_t gstride;
};
struct StaticOrder {
    int nM, nN, nwg, G, c;
    __device__ void init(int M, int N, int G_, int c_) { nM = M / BM; nN = N / BM; nwg = nM * nN; G = G_; c = c_; }
    __device__ bool next(int i, Unit& u) const {
        const long L = (long)i * G + c; if (L >= nwg) return false;
        int wgid = (int)L; { const int q = nwg / NXCD, r = nwg % NXCD, xcd = wgid % NXCD, off = wgid / NXCD; wgid = (xcd < r ? xcd * (q + 1) : r * (q + 1) + (xcd - r) * q) + off; }
        const int nig = WGM * nN, gid = wgid / nig, fm = gid * WGM, gsz = (nM - fm) < WGM ? (nM - fm) : WGM;
        u.pm = fm + ((wgid % nig) % gsz); u.pn = (wgid % nig) / gsz; return true;
    }
};
struct EpiBf16 {
    static constexpr bool PERM = true;
    bf16_t* O; int ldc; const float* rowscale; int skip;
    __device__ __forceinline__ void operator()(const f32x4 (&acc)[2][2][4][2], const Unit& u, int wr, int wc, int fr, int fq) const {
        const int row0 = u.pm * BM + wr * 64 + fr, col0 = u.pn * BM + wc * 32 + 8 * fq;
        if (skip) { asm volatile("" :: "v"(acc[0][0][0][0]), "v"(acc[1][1][3][1])); return; }
        float scv[2][4];
#pragma unroll
        for (int ai = 0; ai < 2; ++ai)
#pragma unroll
            for (int m = 0; m < 4; ++m) scv[ai][m] = rowscale ? rowscale[row0 + ai * HALF + m * 16] : 1.f;
        asm volatile("" ::: "memory");
#pragma unroll
        for (int ai = 0; ai < 2; ++ai)
#pragma unroll
            for (int m = 0; m < 4; ++m) { const int row = row0 + ai * HALF + m * 16; bf16_t* rowp = O + (size_t)row * ldc + col0; const float sc = scv[ai][m];
#pragma unroll
                for (int bj = 0; bj < 2; ++bj) { const f32x4 v0 = acc[ai][bj][m][0] * sc, v1 = acc[ai][bj][m][1] * sc;
                    u32x4 w; w.x = cvt_pk_bf16_asm(v0[0], v0[1]); w.y = cvt_pk_bf16_asm(v0[2], v0[3]); w.z = cvt_pk_bf16_asm(v1[0], v1[1]); w.w = cvt_pk_bf16_asm(v1[2], v1[3]);
                    *(u32x4*)(rowp + bj * HALF) = w; } }
    }
};
struct EpiP {
    static constexpr bool PERM = true;
    bf16_t* O; int ldc; const float* qn; const float* kn; int skip;
    __device__ __forceinline__ void operator()(const f32x4 (&acc)[2][2][4][2], const Unit& u, int wr, int wc, int fr, int fq) const {
        const int row0 = u.pm * BM + wr * 64 + fr, col0 = u.pn * BM + wc * 32 + 8 * fq;
        if (skip) { asm volatile("" :: "v"(acc[0][0][0][0]), "v"(acc[1][1][3][1])); return; }
        if (u.pn >= 3 || !FUSE_QK) {
#pragma unroll
            for (int ai = 0; ai < 2; ++ai)
#pragma unroll
                for (int m = 0; m < 4; ++m) { bf16_t* rowp = O + (size_t)(row0 + ai * HALF + m * 16) * ldc + col0;
#pragma unroll
                    for (int bj = 0; bj < 2; ++bj) { const f32x4 v0 = acc[ai][bj][m][0], v1 = acc[ai][bj][m][1];
                        u32x4 w; w.x = cvt_pk_bf16_asm(v0[0], v0[1]); w.y = cvt_pk_bf16_asm(v0[2], v0[3]); w.z = cvt_pk_bf16_asm(v1[0], v1[1]); w.w = cvt_pk_bf16_asm(v1[2], v1[3]);
                        *(u32x4*)(rowp + bj * HALF) = w; } }
            return;
        }
        LAS float* PS = (LAS float*)((LAS unsigned char*)lds_raw + LDSCTL_OFF + 4096);
        const int half = wc & 1, hw = wc >> 1;
        unsigned lm_ = ~0u; asm volatile("" : "+s"(lm_)); const int lane = (int)__builtin_amdgcn_mbcnt_hi(lm_, __builtin_amdgcn_mbcnt_lo(lm_, 0u));
#pragma unroll
        for (int ai = 0; ai < 2; ++ai)
#pragma unroll
            for (int m = 0; m < 4; ++m)
#pragma unroll
                for (int bj = 0; bj < 2; ++bj) { const f32x4 v0 = acc[ai][bj][m][0], v1 = acc[ai][bj][m][1];
                    float s = (v0[0] * v0[0] + v0[1] * v0[1]) + (v0[2] * v0[2] + v0[3] * v0[3]) + (v1[0] * v1[0] + v1[1] * v1[1]) + (v1[2] * v1[2] + v1[3] * v1[3]);
                    s = x32_sum(x16_sum(s, lane), lane);
                    if (fq == 0) PS[((ai * HALF + wr * 64 + m * 16 + fr) * 4 + 2 * bj + hw) * 2 + half] = s; }
        asm volatile("s_waitcnt lgkmcnt(0)" ::: "memory"); __builtin_amdgcn_s_barrier(); asm volatile("" ::: "memory");
        float invf[8];
#pragma unroll
        for (int j = 0; j < 8; ++j) invf[j] = __builtin_amdgcn_exp2f(-(float)(8 * (fq & 1) + j) * (13.287712379549449f / 16.f));
        const bool second = (fq & 2) != 0;
        f32x4 nwv[2][2];
#pragma unroll
        for (int bj = 0; bj < 2; ++bj) { const bool isk = (u.pn * BM + bj * HALF + wc * 32) >= 384; const float* nw = (isk ? kn : qn) + 32 * half + 8 * fq; nwv[bj][0] = *(const f32x4*)nw; nwv[bj][1] = *(const f32x4*)(nw + 4); }
        asm volatile("" ::: "memory");
#pragma unroll
        for (int ai = 0; ai < 2; ++ai)
#pragma unroll
            for (int m = 0; m < 4; ++m) {
                const int grow = row0 + ai * HALF + m * 16; const bool lat = grow < NLAT; const int t = lat ? grow % SEQ : 0;
                int tp = half ? t % GW : t / GW; asm volatile("" : "+v"(tp));
                const float pos = (float)tp;
                float cs[8], sn[8];
#pragma unroll
                for (int j = 0; j < 8; ++j) { const float ang = pos * invf[j]; cs[j] = __cosf(ang); sn[j] = __sinf(ang); }
                bf16_t* rowp = O + (size_t)grow * ldc + col0;
#pragma unroll
                for (int bj = 0; bj < 2; ++bj) {
                    const int rl = ai * HALF + wr * 64 + m * 16 + fr, head = 2 * bj + hw;
                    const float ssq = PS[(rl * 4 + head) * 2] + PS[(rl * 4 + head) * 2 + 1];
                    const bool isk = (u.pn * BM + bj * HALF + wc * 32) >= 384;
                    const float rstd = (isk ? 1.f : 0.125f * 1.44269504089f) / sqrtf(ssq * (1.f / HD) + EPS);
                    const f32x4 n0 = nwv[bj][0], n1 = nwv[bj][1];
                    float y[8];
#pragma unroll
                    for (int j = 0; j < 4; ++j) { y[j] = acc[ai][bj][m][0][j] * rstd * n0[j]; y[4 + j] = acc[ai][bj][m][1][j] * rstd * n1[j]; }
#pragma unroll
                    for (int j = 0; j < 8; ++j) {
                        const unsigned yb = __builtin_bit_cast(unsigned, y[j]);
                        const auto sw = __builtin_amdgcn_permlane32_swap(yb, yb, false, false);
                        const float other = __builtin_bit_cast(float, lane < 32 ? sw[1] : sw[0]);
                        const float rot = second ? y[j] * cs[j] + other * sn[j] : y[j] * cs[j] - other * sn[j];
                        y[j] = lat ? rot : y[j];
                    }
                    u32x4 w; w.x = cvt_pk_bf16(y[0], y[1]); w.y = cvt_pk_bf16(y[2], y[3]); w.z = cvt_pk_bf16(y[4], y[5]); w.w = cvt_pk_bf16(y[6], y[7]);
                    *(u32x4*)(rowp + bj * HALF) = w;
                }
                asm volatile("" ::: "memory");
            }
    }
};
struct EpiRes {
    static constexpr bool PERM = true;
    bf16_t* X; int ldc; const float* gate0; int rows_per_set; size_t set_stride;
    __device__ __forceinline__ void operator()(const f32x4 (&acc)[2][2][4][2], const Unit& u, int wr, int wc, int fr, int fq) const {
        const int row0 = u.pm * BM + wr * 64 + fr, col0 = u.pn * BM + wc * 32 + 8 * fq;
        const float* gate = gate0 + (size_t)((u.pm * BM) / rows_per_set) * set_stride;
        f32x4 gv[2][2];
#pragma unroll
        for (int bj = 0; bj < 2; ++bj)
#pragma unroll
            for (int n = 0; n < 2; ++n) gv[bj][n] = *(const f32x4*)(gate + col0 + bj * HALF + n * 4);
        u32x4 rv[2][4][2];
#pragma unroll
        for (int ai = 0; ai < 2; ++ai)
#pragma unroll
            for (int m = 0; m < 4; ++m)
#pragma unroll
                for (int bj = 0; bj < 2; ++bj) rv[ai][m][bj] = *(const u32x4*)(X + (size_t)(row0 + ai * HALF + m * 16) * ldc + col0 + bj * HALF);
        asm volatile("" ::: "memory");
#pragma unroll
        for (int ai = 0; ai < 2; ++ai)
#pragma unroll
            for (int m = 0; m < 4; ++m) { bf16_t* rowp = X + (size_t)(row0 + ai * HALF + m * 16) * ldc + col0;
#pragma unroll
                for (int bj = 0; bj < 2; ++bj) { const u32x4 r = rv[ai][m][bj];
                    const f32x4 x0 = (f32x4){bfw(r.x, 0), bfw(r.x, 1), bfw(r.y, 0), bfw(r.y, 1)}, x1 = (f32x4){bfw(r.z, 0), bfw(r.z, 1), bfw(r.w, 0), bfw(r.w, 1)};
                    const f32x4 v0 = x0 + gv[bj][0] * acc[ai][bj][m][0], v1 = x1 + gv[bj][1] * acc[ai][bj][m][1];
                    u32x4 w; w.x = cvt_pk_bf16_asm(v0[0], v0[1]); w.y = cvt_pk_bf16_asm(v0[2], v0[3]); w.z = cvt_pk_bf16_asm(v1[0], v1[1]); w.w = cvt_pk_bf16_asm(v1[2], v1[3]);
                    *(u32x4*)(rowp + bj * HALF) = w; } }
    }
};
struct EpiHid {
    static constexpr bool PERM = false;
    bf16_t* O; int ldc;
    __device__ __forceinline__ void operator()(const f32x4 (&acc)[2][2][4][2], const Unit& u, int wr, int wc, int fr, int fq) const {
        const int row0 = u.pm * BM + wr * 64 + fr, col0 = (u.pn * BM + wc * 32) / 2 + 4 * fq;
#pragma unroll
        for (int ai = 0; ai < 2; ++ai)
#pragma unroll
            for (int m = 0; m < 4; ++m) { bf16_t* rowp = O + (size_t)(row0 + ai * HALF + m * 16) * ldc + col0;
#pragma unroll
                for (int bj = 0; bj < 2; ++bj) { const f32x4 g = acc[ai][bj][m][0], up = acc[ai][bj][m][1]; f32x4 h;
#pragma unroll
                    for (int j = 0; j < 4; ++j) h[j] = g[j] * __builtin_amdgcn_rcpf(1.f + __expf(-g[j])) * up[j];
                    u32x2 w; w.x = cvt_pk_bf16_asm(h[0], h[1]); w.y = cvt_pk_bf16_asm(h[2], h[3]);
                    *(u32x2*)(rowp + bj * (HALF / 2)) = w; } }
    }
};

template <class Epi, bool GATHER>
__device__ __forceinline__ void gemm_phase(const int tid, LAS unsigned char* lds, const Gemm g, const StaticOrder& S, const Epi& E) {
    const int wid = __builtin_amdgcn_readfirstlane(tid >> 6), lane = tid & 63, wr = wid >> 2, wc = wid & 3, fr = lane & 15, fq = lane >> 4;
    const int K = g.K, nt = K / BK;
    unsigned voffA[2], voffB[2];
#pragma unroll
    for (int i = 0; i < 2; ++i) { int R, C; stage_rc(tid * 16 + i * 8192, R, C); const int Rb = Epi::PERM ? ((R & ~31) + perm32(R & 31)) : R;
        voffB[i] = (unsigned)(Rb * K + C) * 2u; voffA[i] = GATHER ? (unsigned)(C * 2) : (Epi::PERM ? (unsigned)(R * K + C) * 2u : voffB[i]); }
    const size_t kstep = (size_t)(BK * 2);
    const size_t hstep = (size_t)HALF * K * 2;
    const size_t tstep = 2 * hstep;
    const unsigned ldsw = (unsigned)wid * 1024u;
    const int aoff = lds_byte(wr * 64 + fr, fq * 8), boff = lds_byte(wc * 32 + fr, fq * 8);
#define PG8_SA(b, h) (((b) * 2 + (h)) * HTB)
#define PG8_SB(b, h) ((4 + (b) * 2 + (h)) * HTB)
#define PG8_STAGE(bufoff, gbase, voff) do { const char* gb_ = (const char*)(gbase); asm volatile("" : "+s"(gb_)); _Pragma("unroll") for (int _i = 0; _i < 2; ++_i) \
        __builtin_amdgcn_global_load_lds((const unsigned*)(gb_ + (voff)[_i]), (LAS unsigned*)(lds + (bufoff) + ldsw + _i * 8192), 16, 0, 0); } while (0)
#define PG8_STAGE_A(bufoff, ubase, kt, h, tb) do { if constexpr (GATHER) { \
        if ((tb) < 0) { PG8_STAGE(bufoff, Ab + (size_t)(kt) * kstep, oAc[h]); } else { \
        unsigned m_ = ~0u; asm volatile("" : "+s"(m_)); const int tl_ = wid * 64 + (int)__builtin_amdgcn_mbcnt_hi(m_, __builtin_amdgcn_mbcnt_lo(m_, 0u)); \
        _Pragma("unroll") for (int _i = 0; _i < 2; ++_i) { int _R, _C; stage_rc(tl_ * 16 + _i * 8192, _R, _C); \
            const unsigned _o = min(*(const LAS unsigned*)(lds + TAB_OFF + (tb) * 1024 + ((h) * HALF + _R) * 4), (unsigned)(NTOK - 1)) * (unsigned)(K * 2) + (unsigned)(_C * 2); \
            __builtin_amdgcn_global_load_lds((const unsigned*)(Ab + (size_t)(kt) * kstep + _o), (LAS unsigned*)(lds + (bufoff) + ldsw + _i * 8192), 16, 0, 0); } } } \
        else { PG8_STAGE(bufoff, (ubase) + (size_t)(kt) * kstep + (size_t)(h) * hstep, voffA); } } while (0)
#define PG8_LOADOFFS(tb) do { if constexpr (GATHER) { unsigned m_ = ~0u; asm volatile("" : "+s"(m_)); const int tl_ = wid * 64 + (int)__builtin_amdgcn_mbcnt_hi(m_, __builtin_amdgcn_mbcnt_lo(m_, 0u)); \
        _Pragma("unroll") for (int _h = 0; _h < 2; ++_h) _Pragma("unroll") for (int _i = 0; _i < 2; ++_i) { int _R, _C; stage_rc(tl_ * 16 + _i * 8192, _R, _C); \
            oAc[_h][_i] = min(*(const LAS unsigned*)(lds + TAB_OFF + (tb) * 1024 + (_h * HALF + _R) * 4), (unsigned)(NTOK - 1)) * (unsigned)(K * 2) + (unsigned)(_C * 2); } } } while (0)
#define PG8_FILLTAB(u, tb) do { if constexpr (GATHER) { unsigned m_ = ~0u; asm volatile("" : "+s"(m_)); const int tl_ = wid * 64 + (int)__builtin_amdgcn_mbcnt_hi(m_, __builtin_amdgcn_mbcnt_lo(m_, 0u)); \
        if (tl_ < 256) *(LAS unsigned*)(lds + TAB_OFF + (tb) * 1024 + tl_ * 4) = (unsigned)g.gather[(u).pm * BM + tl_]; } } while (0)
#define PG8_LDA(dst, b, h) do { _Pragma("unroll") for (int m = 0; m < 4; ++m) _Pragma("unroll") for (int k = 0; k < 2; ++k) dst[m][k] = *(const LAS bf16x8*)(lds + PG8_SA(b, h) + aoff + m * 2048 + k * 1024); } while (0)
#define PG8_LDB(dst, b, h) do { _Pragma("unroll") for (int n = 0; n < 2; ++n) _Pragma("unroll") for (int k = 0; k < 2; ++k) dst[n][k] = *(const LAS bf16x8*)(lds + PG8_SB(b, h) + boff + n * 2048 + k * 1024); } while (0)
#define PG8_MMA(ai, bj, At, Bt) do { __builtin_amdgcn_s_setprio(1); _Pragma("unroll") for (int m = 0; m < 4; ++m) _Pragma("unroll") for (int n = 0; n < 2; ++n) _Pragma("unroll") for (int k = 0; k < 2; ++k) \
        acc[ai][bj][m][n] = __builtin_amdgcn_mfma_f32_16x16x32_bf16(Bt[n][k], At[m][k], acc[ai][bj][m][n], 0, 0, 0); __builtin_amdgcn_s_setprio(0); } while (0)
#define PG8_WAIT_V(n) asm volatile("s_waitcnt vmcnt(" #n ")" ::: "memory")
#define PG8_WAIT_L(n) asm volatile("s_waitcnt lgkmcnt(" #n ")" ::: "memory")
#define PG8_BAR __builtin_amdgcn_s_barrier()
#define PG8_SCHED __builtin_amdgcn_sched_barrier(0)
#define PG8_KTILE2(u1, k1, o1, u2, k2, o2, b2p) do { \
        PG8_LDB(B0, 0, 0); PG8_LDB(B1, 0, 1); PG8_SCHED; PG8_LDA(At, 0, 0); PG8_STAGE_A(PG8_SA(1, 1), u1, k1, 1, o1); \
        PG8_WAIT_V(8); PG8_WAIT_L(0); PG8_BAR; PG8_MMA(0, 0, At, B0); PG8_MMA(0, 1, At, B1); PG8_BAR; PG8_SCHED; \
        PG8_LDA(At, 0, 1); PG8_STAGE(PG8_SB(0, 0), b2p, voffB); PG8_STAGE(PG8_SB(0, 1), (b2p) + hstep, voffB); PG8_STAGE_A(PG8_SA(0, 0), u2, k2, 0, o2); \
        PG8_WAIT_V(8); PG8_WAIT_L(0); PG8_BAR; PG8_MMA(1, 0, At, B0); PG8_MMA(1, 1, At, B1); PG8_BAR; PG8_SCHED; \
        PG8_LDB(B0, 1, 0); PG8_LDB(B1, 1, 1); PG8_SCHED; PG8_LDA(At, 1, 0); PG8_STAGE_A(PG8_SA(0, 1), u2, k2, 1, o2); \
        PG8_WAIT_V(8); PG8_WAIT_L(0); PG8_BAR; PG8_MMA(0, 0, At, B0); PG8_MMA(0, 1, At, B1); PG8_BAR; PG8_SCHED; \
        PG8_LDA(At, 1, 1); PG8_STAGE(PG8_SB(1, 0), (b2p) + kstep, voffB); PG8_STAGE(PG8_SB(1, 1), (b2p) + kstep + hstep, voffB); PG8_STAGE_A(PG8_SA(1, 0), u2, (k2) + 1, 0, o2); \
        PG8_WAIT_V(8); PG8_WAIT_L(0); PG8_BAR; PG8_MMA(1, 0, At, B0); PG8_MMA(1, 1, At, B1); PG8_BAR; PG8_SCHED; } while (0)
#define PG8_BPTR(u) ((const char*)g.Bt + (g.gt ? (size_t)(((u).pm / g.gt) % g.ng) * g.gstride : (size_t)0) + (size_t)(u).pn * tstep)
    Unit cur, nxt; int ui = 0;
    if (!S.next(0, cur)) return;
#ifndef LATE_START
#define LATE_START 4
#endif
#ifndef GEMM_STAGGER
#define GEMM_STAGGER 0
#endif
    if (GEMM_STAGGER) { const int dg_ = ((int)blockIdx.x >> 3) & 3; for (int i_ = 0; i_ < dg_; ++i_) __builtin_amdgcn_s_sleep(GEMM_STAGGER); }
    if (S.nwg % S.G != 0 && S.c >= S.nwg % S.G) { for (int i_ = 0; i_ < LATE_START; ++i_) __builtin_amdgcn_s_sleep(127); }
    f32x4 acc[2][2][4][2];
#pragma unroll
    for (int a = 0; a < 2; ++a)
#pragma unroll
        for (int b = 0; b < 2; ++b)
#pragma unroll
            for (int m = 0; m < 4; ++m)
#pragma unroll
                for (int n = 0; n < 2; ++n) acc[a][b][m][n] = (f32x4){0.f, 0.f, 0.f, 0.f};
    bf16x8 At[4][2], B0[2][2], B1[2][2];
    unsigned oAc[2][2] = {{0u, 0u}, {0u, 0u}};
    const char* const Ab = (const char*)g.A;
    const char* cA = Ab + (size_t)cur.pm * tstep;
    const char* cB = PG8_BPTR(cur);
    PG8_FILLTAB(cur, 0);
    if constexpr (GATHER) { PG8_WAIT_L(0); PG8_BAR; PG8_LOADOFFS(0); }
    PG8_STAGE(PG8_SB(0, 0), cB, voffB); PG8_STAGE(PG8_SB(0, 1), cB + hstep, voffB); PG8_STAGE_A(PG8_SA(0, 0), cA, 0, 0, -1); PG8_STAGE_A(PG8_SA(0, 1), cA, 0, 1, -1);
    if (wr == 1) PG8_BAR;
    PG8_WAIT_V(2); PG8_BAR;
    PG8_STAGE(PG8_SB(1, 0), cB + kstep, voffB); PG8_STAGE_A(PG8_SA(1, 0), cA, 1, 0, -1); PG8_STAGE(PG8_SB(1, 1), cB + hstep + kstep, voffB);
    PG8_WAIT_V(6); PG8_BAR;
    for (;;) {
        const bool has_next = S.next(ui + 1, nxt);
        const char* nA = has_next ? Ab + (size_t)nxt.pm * tstep : cA; const char* nB = has_next ? PG8_BPTR(nxt) : cB;
        const int tbc = ui & 1, tbn = has_next ? ((ui + 1) & 1) : (ui & 1);
        if constexpr (GATHER) { if (has_next && wid < 4) { unsigned m_ = ~0u; asm volatile("" : "+s"(m_)); const int tl_ = wid * 64 + (int)__builtin_amdgcn_mbcnt_hi(m_, __builtin_amdgcn_mbcnt_lo(m_, 0u));
            __builtin_amdgcn_global_load_lds((const unsigned*)(g.gather + nxt.pm * BM + tl_), (LAS unsigned*)(lds + TAB_OFF + tbn * 1024 + wid * 256), 4, 0, 0); } }
        for (int t = 0; t < nt - 2; t += 2) { const char* b2 = cB + (size_t)(t + 2) * kstep; PG8_KTILE2(cA, t + 1, -1, cA, t + 2, -1, b2); }
        PG8_KTILE2(cA, nt - 1, -1, nA, 0, tbn, nB);
        if (wr == 0) PG8_BAR;
        { unsigned m_ = ~0u; asm volatile("" : "+s"(m_)); int l2 = (int)__builtin_amdgcn_mbcnt_hi(m_, __builtin_amdgcn_mbcnt_lo(m_, 0u)); asm volatile("" : "+v"(l2)); E(acc, cur, wr, wc, l2 & 15, l2 >> 4); }
        if (!has_next) break;
#pragma unroll
        for (int a = 0; a < 2; ++a)
#pragma unroll
            for (int b = 0; b < 2; ++b)
#pragma unroll
                for (int m = 0; m < 4; ++m)
#pragma unroll
                    for (int n = 0; n < 2; ++n) acc[a][b][m][n] = (f32x4){0.f, 0.f, 0.f, 0.f};
        cur = nxt; cA = nA; cB = nB; ++ui;
        PG8_LOADOFFS(ui & 1);
        if (wr == 1) PG8_BAR;
    }
    PG8_WAIT_V(0);
    PG8_BAR;
#undef PG8_STAGE_A
#undef PG8_FILLTAB
#undef PG8_LOADOFFS
#undef PG8_SA
#undef PG8_SB
#undef PG8_STAGE
#undef PG8_LDA
#undef PG8_LDB
#undef PG8_MMA
#undef PG8_WAIT_V
#undef PG8_WAIT_L
#undef PG8_BAR
#undef PG8_SCHED
#undef PG8_KTILE2
#undef PG8_BPTR
}
}

#define XB_TMO      128
#define XB_XCNT(j)  (256  + 64 * (j))
#define XB_XSUB(j)  (1280 + 64 * (j))
#define XB_XGEN(j)  (2304 + 64 * (j))
#define XB_TOP      3328
#define XB_TOPGEN   3392
#define XCD_BAR_WORDS 3456
#define XB_SPIN_CAP (1u << 20)
__device__ __forceinline__ unsigned xb_ld(unsigned* p)              { return __hip_atomic_load(p, __ATOMIC_RELAXED, __HIP_MEMORY_SCOPE_AGENT); }
__device__ __forceinline__ unsigned xb_add(unsigned* p, unsigned v) { return __hip_atomic_fetch_add(p, v, __ATOMIC_RELAXED, __HIP_MEMORY_SCOPE_AGENT); }
__device__ __forceinline__ unsigned xb_xcc_id() { return (unsigned)__builtin_amdgcn_s_getreg((3 << 11) | 20) & 0xFu; }
#define XB_SPIN(cond, bar) do { unsigned _sp = 0; while (cond) { __builtin_amdgcn_s_sleep(1); \
    if ((++_sp & 255u) == 0u) { if (xb_ld(&(bar)[XB_TMO])) break; if (_sp > XB_SPIN_CAP) { atomicAdd(&(bar)[XB_TMO], 1u); break; } } } } while (0)
struct XcdBarrier { unsigned* bar; unsigned x; };
#define XB_ST(ldsbase) ((volatile LAS unsigned*)((LAS unsigned char*)(ldsbase) + MISC_OFF + 32))
__device__ __forceinline__ XcdBarrier xcd_barrier_post(unsigned* bar, bool leader) {
    XcdBarrier b; b.bar = bar; b.x = xb_xcc_id();
    if (leader) (void)xb_add(&bar[XB_XCNT(b.x)], 1u);
    return b;
}
__device__ __forceinline__ void xcd_barrier_complete(unsigned* bar, unsigned x, unsigned& nloc, unsigned& nx) {
    const unsigned G = gridDim.x * gridDim.y * gridDim.z;
    unsigned sum, cnt, mine, sp = 0u;
    for (;;) {
        sum = 0u; cnt = 0u; mine = 0u;
#pragma unroll
        for (unsigned j = 0; j < 16; ++j) { const unsigned c = xb_ld(&bar[XB_XCNT(j)]); sum += c; cnt += (c > 0u) ? 1u : 0u; mine = (j == x) ? c : mine; }
        if (sum == G) break;
        __builtin_amdgcn_s_sleep(1);
        if ((++sp & 255u) == 0u) { if (xb_ld(&bar[XB_TMO])) break; if (sp > XB_SPIN_CAP) { atomicAdd(&bar[XB_TMO], 1u); break; } }
    }
    nloc = mine > 0u ? mine : 1u; nx = cnt > 0u ? cnt : 1u;
}
__device__ __forceinline__ void xcd_barrier(const XcdBarrier& b, bool leader, volatile LAS unsigned* st) {
    asm volatile("s_waitcnt vmcnt(0)" ::: "memory");
    __syncthreads();
    if (leader) {
        unsigned* bar = b.bar;
        __builtin_amdgcn_s_waitcnt(0);
        unsigned nloc = st[0], nx = st[1];
        if (nloc == 0u) { xcd_barrier_complete(bar, b.x, nloc, nx); st[0] = nloc; st[1] = nx; }
        const unsigned old = xb_add(&bar[XB_XSUB(b.x)], 1u);
        const unsigned gen = old / nloc;
        if (old + 1u == (gen + 1u) * nloc) {
            __builtin_amdgcn_fence(__ATOMIC_RELEASE, "agent");
            asm volatile("s_waitcnt vmcnt(0)" ::: "memory");
            const unsigned og = xb_add(&bar[XB_TOP], 1u);
            const unsigned tg = og / nx;
            if (og + 1u == (tg + 1u) * nx) xb_add(&bar[XB_TOPGEN], 1u);
            else XB_SPIN(xb_ld(&bar[XB_TOPGEN]) == tg, bar);
            __builtin_amdgcn_fence(__ATOMIC_ACQUIRE, "agent");
            xb_add(&bar[XB_XGEN(b.x)], 1u);
            asm volatile("s_waitcnt vmcnt(0)" ::: "memory");
        } else {
            XB_SPIN(xb_ld(&bar[XB_XGEN(b.x)]) == gen, bar);
            __builtin_amdgcn_fence(__ATOMIC_ACQUIRE, "agent");
            asm volatile("s_waitcnt vmcnt(0)" ::: "memory");
        }
    }
    __syncthreads();
}

template <void (*F)(long, PRef, int)> __device__ __forceinline__ void run_items(const int tid, PRef p, int l, long n, long off) {
    for (long gid = (long)blockIdx.x * NTHR + tid; gid < n; gid += (long)gridDim.x * NTHR) F(gid + off, p, l);
}
BODY void b_hgrn_seq2(long gid, PRef p, int l) { const long n1 = (long)NB * HGH * 64; if (gid < n1) b_hgrn_seq<0>(gid, p, l); else b_hgrn_seq<1>(gid - n1, p, l); }

template <int MAP> __device__ __forceinline__ void transpose_item(const float* W, int K, int N, bf16_t* WT, int row_off, LAS float* scr, int item, int lane) {
    const int nblk = N / 32, kb = item / nblk, nb = item % nblk, k0 = 64 * kb, n0 = 32 * nb;
#pragma unroll 8
    for (int i = 0; i < 32; ++i) { const int kk = 2 * i + (lane >> 5); scr[kk * 33 + (lane & 31)] = W[(size_t)(k0 + kk) * N + n0 + (lane & 31)]; }
    asm volatile("s_waitcnt lgkmcnt(0)" ::: "memory");
    const int c = lane & 7;
#pragma unroll
    for (int j = 0; j < 4; ++j) { const int n = (lane >> 3) + 8 * j; const LAS float* s = scr + (8 * c) * 33 + n;
        u32x4 o; o.x = cvt_pk_bf16(s[0 * 33], s[1 * 33]); o.y = cvt_pk_bf16(s[2 * 33], s[3 * 33]); o.z = cvt_pk_bf16(s[4 * 33], s[5 * 33]); o.w = cvt_pk_bf16(s[6 * 33], s[7 * 33]);
        const int nn = n0 + n; const int drow = MAP == 0 ? row_off + nn : (32 * (nn >> 4) + (nn & 15) + (MAP == 2 ? 16 : 0));
        *(u32x4*)(WT + (size_t)drow * K + k0 + 8 * c) = o; }
    asm volatile("s_waitcnt lgkmcnt(0)" ::: "memory");
}
#define WBOFF(l) ((size_t)((l) & 1) * (WB_BYTES / 2))
__device__ __forceinline__ void phase_convert(const int tid, PRef p, int l, LAS unsigned char* lds, int part = 0, int blk_lo = 0) {
    if ((int)blockIdx.x < blk_lo) return;
    const int lane = tid & 63, wave = tid >> 6;
    LAS float* scr = (LAS float*)(lds + wave * 16384);
    const int gw = ((int)blockIdx.x - blk_lo) * NWAVES + wave, NGW = ((int)gridDim.x - blk_lo) * NWAVES;
    constexpr int I_IN = (D / 64) * (INC / 32), I_OUT = (MIXD / 64) * (D / 32), I_G = (D / 64) * (ED / 32), I_D = (ED / 64) * (D / 32);
    constexpr int NITEMS = I_IN + I_OUT + NE * (2 * I_G + I_D);
    const int it_lo = part == 2 ? I_IN + I_OUT : 0, it_hi = part == 1 ? I_IN + I_OUT : NITEMS;
    for (int it = it_lo + gw; it < it_hi; it += NGW) {
        int r = it;
        if (r < I_IN) { transpose_item<0>(p.w_in + (size_t)l * D * INC, D, INC, p.WIN_T + WBOFF(l), 0, scr, r, lane); continue; } r -= I_IN;
        if (r < I_OUT) { transpose_item<0>(p.w_out + (size_t)l * MIXD * D, MIXD, D, p.WOUT_T + WBOFF(l), 0, scr, r, lane); continue; } r -= I_OUT;
        const int e = r / (2 * I_G + I_D); r -= e * (2 * I_G + I_D);
        if (r < I_G) { transpose_item<1>(p.w_gate + ((size_t)l * NE + e) * D * ED, D, ED, p.WGU_T + WBOFF(l) + (size_t)e * 2 * ED * D, 0, scr, r, lane); continue; } r -= I_G;
        if (r < I_G) { transpose_item<2>(p.w_up + ((size_t)l * NE + e) * D * ED, D, ED, p.WGU_T + WBOFF(l) + (size_t)e * 2 * ED * D, 0, scr, r, lane); continue; } r -= I_G;
        transpose_item<0>(p.w_down + ((size_t)l * NE + e) * ED * D, ED, D, p.WD_T + WBOFF(l) + (size_t)e * D * ED, 0, scr, r, lane);
    }
}
template <int WHICH> __device__ __forceinline__ void phase_prenorm(const int tid, PRef p, int l) {
    static_assert(D == 1024, "wave-per-row kernels assume D = 1024");
    const int lane = tid & 63, wave = tid >> 6;
    const int gw = blockIdx.x * NWAVES + wave, NGW = gridDim.x * NWAVES;
    const float* nw = (WHICH ? p.norm2_w : p.norm1_w) + l * D;
    for (int r = gw; r < NTOK; r += NGW) {
        const float* xr = xrow(p, r);
        const float* mod = p.MOD + ((size_t)l * 3 + modset(r)) * NMOD;
        const float* shift = mod + (WHICH ? 3 : 0) * D; const float* scale = mod + (WHICH ? 4 : 1) * D;
        f32x4 v[4]; float ss = 0.f;
#pragma unroll
        for (int j = 0; j < 4; ++j) { v[j] = *(const f32x4*)(xr + 4 * lane + 256 * j); ss += (v[j][0] * v[j][0] + v[j][1] * v[j][1]) + (v[j][2] * v[j][2] + v[j][3] * v[j][3]); }
        const float rstd = 1.f / sqrtf(wave_sum(ss, lane) * (1.f / D) + EPS);
        float lg[NE];
#pragma unroll
        for (int e = 0; e < NE; ++e) lg[e] = 0.f;
#pragma unroll
        for (int j = 0; j < 4; ++j) {
            const int c = 4 * lane + 256 * j;
            const f32x4 w4 = *(const f32x4*)(nw + c), sc4 = *(const f32x4*)(scale + c), sh4 = *(const f32x4*)(shift + c);
            f32x4 h;
#pragma unroll
            for (int i = 0; i < 4; ++i) h[i] = v[j][i] * rstd * w4[i] * (1.f + sc4[i]) + sh4[i];
            u32x2 o; o.x = cvt_pk_bf16(h[0], h[1]); o.y = cvt_pk_bf16(h[2], h[3]);
            *(u32x2*)(p.H + (size_t)r * D + c) = o;
            if (WHICH) {
#pragma unroll
                for (int i = 0; i < 4; ++i) { const f32x4* wr = (const f32x4*)(p.w_router + ((size_t)l * D + c + i) * NE);
#pragma unroll
                    for (int q = 0; q < 4; ++q) { const f32x4 w = wr[q]; lg[4 * q + 0] += h[i] * w[0]; lg[4 * q + 1] += h[i] * w[1]; lg[4 * q + 2] += h[i] * w[2]; lg[4 * q + 3] += h[i] * w[3]; } }
            }
        }
        if (WHICH) {
#pragma unroll
            for (int e = 0; e < NE; ++e) lg[e] = wave_sum(lg[e], lane);
            float m = lg[0];
#pragma unroll
            for (int e = 1; e < NE; ++e) m = fmaxf(m, lg[e]);
            float s = 0.f, mine = 0.f;
#pragma unroll
            for (int e = 0; e < NE; ++e) { const float ex = expf(lg[e] - m); s += ex; mine = (lane == e) ? ex : mine; }
            if (lane < NE) p.AFF[(size_t)r * NE + lane] = mine / s;
        }
    }
}
__device__ __forceinline__ void phase_combine(const int tid, PRef p, int l) {
    const int lane = tid & 63, wave = tid >> 6;
    const int gw = blockIdx.x * NWAVES + wave, NGW = gridDim.x * NWAVES;
    for (int r = gw; r < NTOK; r += NGW) {
        float* xr = xrow(p, r);
        const float* g = p.MOD + ((size_t)l * 3 + modset(r)) * NMOD + 5 * D;
        f32x4 acc[4];
#pragma unroll
        for (int j = 0; j < 4; ++j) acc[j] = (f32x4){0.f, 0.f, 0.f, 0.f};
        const int myinv = lane < NE ? p.INV[(size_t)r * NE + lane] : -1;
#pragma unroll
        for (int e = 0; e < NE; ++e) {
            const int s = __builtin_amdgcn_readlane(myinv, e);
            if (s >= 0 && s < NSLOT) {
                const bf16_t* y = p.Y + (size_t)s * D;
#pragma unroll
                for (int j = 0; j < 4; ++j) { const u32x2 w = *(const u32x2*)(y + 4 * lane + 256 * j);
                    acc[j][0] += __builtin_bit_cast(float, w.x << 16); acc[j][1] += __builtin_bit_cast(float, w.x & 0xffff0000u);
                    acc[j][2] += __builtin_bit_cast(float, w.y << 16); acc[j][3] += __builtin_bit_cast(float, w.y & 0xffff0000u); }
            }
        }
#pragma unroll
        for (int j = 0; j < 4; ++j) { const int c = 4 * lane + 256 * j; f32x4* q = (f32x4*)(xr + c); *q = *q + *(const f32x4*)(g + c) * acc[j]; }
    }
}


__device__ __forceinline__ unsigned wave_excl_scan(unsigned x, int lane) {
    unsigned inc = x;
#pragma unroll
    for (int d = 1; d < 64; d <<= 1) { const unsigned y = (unsigned)__builtin_amdgcn_ds_bpermute(((lane - d) & 63) << 2, (int)inc); if (lane >= d) inc += y; }
    return inc - x;
}
__device__ __forceinline__ void phase_topk(const int tid, PRef p, LAS unsigned char* lds) {
    LAS unsigned* keys = (LAS unsigned*)lds;
    LAS unsigned* hist = (LAS unsigned*)(lds + 70000);
    LAS unsigned* cgt = (LAS unsigned*)(lds + 76000);
    LAS unsigned* ceq = (LAS unsigned*)(lds + 80000);
    LAS unsigned* sh = (LAS unsigned*)(lds + 84000);
    static_assert(SEQ % 512 == 0 && SEQ + SEQ / 32 <= 17400, "topk LDS layout");
    constexpr int PER = SEQ / 512;
    for (int pr = blockIdx.x; pr < 2 * NB * NE; pr += gridDim.x) {
        const int e = pr % NE, b = (pr / NE) % NB, isctx = pr / (NE * NB);
        if (!isctx) {
            const int row0 = b * SEQ, base = (b * NE + e) * CAPL;
            for (int i = 0; i < PER; ++i) { const int t = i * 512 + tid; keys[t + (t >> 5)] = __builtin_bit_cast(unsigned, p.AFF[(size_t)(row0 + t) * NE + e]); }
            if (tid == 0) { sh[0] = 0u; sh[1] = (unsigned)CAPL; }
            __syncthreads();
            for (int pass = 0; pass < 3; ++pass) {
                const int shift = 20 - 10 * pass;
                for (int i = tid; i < 1024; i += 512) hist[i] = 0u;
                __syncthreads();
                const unsigned prefix = sh[0]; const unsigned himask = pass == 0 ? 0u : (0xFFFFFFFFu << (shift + 10));
                for (int i = 0; i < PER; ++i) { const int t = tid * PER + i; const unsigned k = keys[t + (t >> 5)]; if ((k & himask) == prefix) atomicAdd((unsigned*)&hist[(k >> shift) & 1023u], 1u); }
                __syncthreads();
                if (tid < 64) {
                    const unsigned need = sh[1];
                    unsigned c[16]; unsigned tot = 0u;
#pragma unroll
                    for (int q = 0; q < 16; ++q) { c[q] = hist[1023 - 16 * tid - q]; tot += c[q]; }
                    unsigned above = wave_excl_scan(tot, tid);
                    int fbin = -1; unsigned fabove = 0u;
#pragma unroll
                    for (int q = 0; q < 16; ++q) { if (fbin < 0 && above < need && above + c[q] >= need) { fbin = 1023 - 16 * tid - q; fabove = above; } above += c[q]; }
                    if (fbin >= 0) { sh[0] = prefix | ((unsigned)fbin << shift); sh[1] = need - fabove; }
                }
                __syncthreads();
            }
            const unsigned thr = sh[0], keq = sh[1];
            unsigned ng = 0u, nq = 0u;
            for (int i = 0; i < PER; ++i) { const int t = tid * PER + i; const unsigned k = keys[t + (t >> 5)]; ng += k > thr ? 1u : 0u; nq += k == thr ? 1u : 0u; }
            cgt[tid] = ng; ceq[tid] = nq;
            __syncthreads();
            if (tid < 64) {
                unsigned g[8], q[8], sg = 0u, sq = 0u;
#pragma unroll
                for (int i = 0; i < 8; ++i) { g[i] = cgt[8 * tid + i]; q[i] = ceq[8 * tid + i]; sg += g[i]; sq += q[i]; }
                unsigned ag = wave_excl_scan(sg, tid), aq = wave_excl_scan(sq, tid);
#pragma unroll
                for (int i = 0; i < 8; ++i) { cgt[8 * tid + i] = ag; ceq[8 * tid + i] = aq; ag += g[i]; aq += q[i]; }
            }
            __syncthreads();
            unsigned rg = cgt[tid], rq = ceq[tid];
            for (int i = 0; i < PER; ++i) {
                const int t = tid * PER + i; const unsigned k = keys[t + (t >> 5)];
                int slot = -1;
                if (k > thr) { slot = (int)(rg + (rq < keq ? rq : keq)); ++rg; }
                else if (k == thr) { if (rq < keq) slot = (int)(rg + rq); ++rq; }
                const int row = row0 + t;
                if (slot >= 0) { p.STOK[base + slot] = row; p.SVAL[base + slot] = __builtin_bit_cast(float, k); p.INV[(size_t)row * NE + e] = base + slot; }
                else p.INV[(size_t)row * NE + e] = -1;
            }
            __syncthreads();
        } else {
            const int row0 = NLAT + b * CTX, base = NSLOT_L + (b * NE + e) * CAPC;
            LAS float* vals = (LAS float*)lds;
            for (int t = tid; t < CTX; t += 512) vals[t] = p.AFF[(size_t)(row0 + t) * NE + e];
            __syncthreads();
            for (int t = tid; t < CTX; t += 512) {
                const float a = vals[t]; int rank = 0;
                for (int tt = 0; tt < CTX; ++tt) { const float o = vals[tt]; rank += (o > a || (o == a && tt < t)) ? 1 : 0; }
                const int row = row0 + t;
                if (rank < CAPC) { p.STOK[base + rank] = row; p.SVAL[base + rank] = a; p.INV[(size_t)row * NE + e] = base + rank; }
                else p.INV[(size_t)row * NE + e] = -1;
            }
            __syncthreads();
        }
    }
}

#define LDS_BAR() do { asm volatile("s_waitcnt lgkmcnt(0)" ::: "memory"); __builtin_amdgcn_s_barrier(); asm volatile("" ::: "memory"); } while (0)
__device__ __forceinline__ int hg_row0(int b, int pc) { return pc < NCHC ? NLAT + b * CTX + pc * 64 : b * SEQ + (pc - NCHC) * 64; }
constexpr int HG_FF = 0, HG_FB = 16640, HG_AF = 33280, HG_AB = 49920, HG_T0 = 66560, HG_TS = 9216, HG_VT = HG_T0 + 6 * HG_TS;
static_assert(HG_VT + HG_TS <= RING_BYTES, "hgrn LDS layout");
#define TSW_E(k, t) ((k) * 72 + ((((t) >> 3) ^ (((k) >> 3) & 7)) << 3) + ((t) & 7))
#define TSW_B(k, c) ((k) * 144 + (((c) ^ (((k) >> 3) & 7)) << 4))
constexpr int HG_LBOFF = LDSCTL_OFF + 4096;
__device__ __forceinline__ void hg_stage_lb(const int tid, PRef p, int l) {
    LAS float* dst = (LAS float*)((LAS unsigned char*)lds_raw + HG_LBOFF);
    for (int i = tid; i < 768; i += NTHR) dst[i] = p.LB[(size_t)((i / 384) * DEPTH + l) * 384 + (i % 384)];
    LDS_BAR();
}
__device__ __forceinline__ void hg_gates(const int tid, PRef p, int l, int h, const u32x4 zf, const u32x4 zb, LAS unsigned char* lds) {
    LAS float* FF = (LAS float*)(lds + HG_FF); LAS float* FB = (LAS float*)(lds + HG_FB); LAS float* AF = (LAS float*)(lds + HG_AF); LAS float* AB = (LAS float*)(lds + HG_AB);
    const int t = tid >> 3, cg = tid & 7;
    const LAS float* lbf = (const LAS float*)((LAS unsigned char*)lds_raw + HG_LBOFF) + h * 64 + cg * 8; const LAS float* lbb = lbf + 384;
#pragma unroll
    for (int j = 0; j < 8; ++j) {
        const float z0 = fminf(fmaxf(bf8(zf, j), -60.f), 60.f), z1 = fminf(fmaxf(bf8(zb, j), -60.f), 60.f);
        const float l0 = lbf[j], l1 = lbb[j];
        FF[t * 65 + cg * 8 + j] = l0 + (1.f - l0) * __builtin_amdgcn_rcpf(1.f + __expf(-z0));
        FB[t * 65 + cg * 8 + j] = l1 + (1.f - l1) * __builtin_amdgcn_rcpf(1.f + __expf(-z1));
    }
    LDS_BAR();
    {
        const int wave = tid >> 6, lane = tid & 63, cl = lane & 15, seg = lane >> 4, dir = wave >> 2, col = 16 * (wave & 3) + cl;
        const LAS float* F = dir ? FB : FF; LAS float* A = dir ? AB : AF;
        float pre[16]; float run = 0.f;
#pragma unroll
        for (int i = 0; i < 16; ++i) { const int tt = dir ? 16 * seg + 15 - i : 16 * seg + i; run += __logf(F[tt * 65 + col]); pre[i] = run; }
        const float T0 = __builtin_bit_cast(float, __builtin_amdgcn_ds_bpermute((cl + 0) << 2, __builtin_bit_cast(int, run)));
        const float T1 = __builtin_bit_cast(float, __builtin_amdgcn_ds_bpermute((cl + 16) << 2, __builtin_bit_cast(int, run)));
        const float T2 = __builtin_bit_cast(float, __builtin_amdgcn_ds_bpermute((cl + 32) << 2, __builtin_bit_cast(int, run)));
        const float T3 = __builtin_bit_cast(float, __builtin_amdgcn_ds_bpermute((cl + 48) << 2, __builtin_bit_cast(int, run)));
        const float off = dir ? ((seg < 1 ? T1 : 0.f) + (seg < 2 ? T2 : 0.f) + (seg < 3 ? T3 : 0.f)) : ((seg > 0 ? T0 : 0.f) + (seg > 1 ? T1 : 0.f) + (seg > 2 ? T2 : 0.f));
#pragma unroll
        for (int i = 0; i < 16; ++i) { const int tt = dir ? 16 * seg + 15 - i : 16 * seg + i; A[tt * 65 + col] = off + pre[i]; }
    }
    LDS_BAR();
}
__device__ __forceinline__ bf16x8 ld2x64(const LAS unsigned char* p0, const LAS unsigned char* p1) {
    const u32x2 a = *(const LAS u32x2*)p0, b = *(const LAS u32x2*)p1; u32x4 r; r.x = a.x; r.y = a.y; r.z = b.x; r.w = b.y; return __builtin_bit_cast(bf16x8, r);
}
typedef short s16x4 __attribute__((ext_vector_type(4)));
__device__ __forceinline__ bf16x8 ld2tr(const LAS unsigned char* p0, const LAS unsigned char* p1) {
    const s16x4 a = __builtin_amdgcn_ds_read_tr16_b64_v4i16((LAS s16x4*)p0), b = __builtin_amdgcn_ds_read_tr16_b64_v4i16((LAS s16x4*)p1);
    return __builtin_shufflevector(a, b, 0, 1, 2, 3, 4, 5, 6, 7);
}
__device__ __forceinline__ f32x4 mfma16(bf16x8 a, bf16x8 b, f32x4 c) { return __builtin_amdgcn_mfma_f32_16x16x32_bf16(a, b, c, 0, 0, 0); }
__device__ __forceinline__ void phase_hgrn_local(const int tid, PRef p, int l, LAS unsigned char* lds) {
    LAS float* FF = (LAS float*)(lds + HG_FF); LAS float* FB = (LAS float*)(lds + HG_FB); LAS float* AF = (LAS float*)(lds + HG_AF); LAS float* AB = (LAS float*)(lds + HG_AB);
    LAS bf16_t* KTf = (LAS bf16_t*)(lds + HG_T0); LAS bf16_t* KTb = (LAS bf16_t*)(lds + HG_T0 + HG_TS); LAS bf16_t* VT = (LAS bf16_t*)(lds + HG_VT);
    const int t = tid >> 3, cg = tid & 7, wave = tid >> 6, lane = tid & 63, fr = lane & 15, fq = lane >> 4;
    u32x4 zf = (u32x4){0u, 0u, 0u, 0u}, zb = zf, v8 = zf, nzf = zf, nzb = zf, nv8 = zf;
    if ((int)blockIdx.x < NBH * NCH) { const int it = blockIdx.x, pc = it % NCH, bh = it / NCH, h = bh % HGH, b = bh / HGH;
        const bf16_t* pr = p.P + (size_t)(hg_row0(b, pc) + t) * INC + h * 64 + cg * 8; zf = *(const u32x4*)(pr + OFF_); zb = *(const u32x4*)(pr + OFB); v8 = *(const u32x4*)(pr + OHI); }
    hg_stage_lb(tid, p, l);
    for (int it = blockIdx.x; it < NBH * NCH; it += gridDim.x) {
        const int pc = it % NCH, bh = it / NCH, h = bh % HGH, b = bh / HGH, row0 = hg_row0(b, pc);
        { const int it2 = min(it + (int)gridDim.x, NBH * NCH - 1); const int pc2 = it2 % NCH, bh2 = it2 / NCH, h2 = bh2 % HGH, b2 = bh2 / HGH;
            const bf16_t* pr = p.P + (size_t)(hg_row0(b2, pc2) + t) * INC + h2 * 64 + cg * 8; nzf = *(const u32x4*)(pr + OFF_); nzb = *(const u32x4*)(pr + OFB); nv8 = *(const u32x4*)(pr + OHI); }
        hg_gates(tid, p, l, h, zf, zb, lds);
#pragma unroll
        for (int j = 0; j < 8; ++j) {
            const int k = cg * 8 + j;
            VT[TSW_E(k, t)] = (bf16_t)(j & 1 ? v8[j >> 1] >> 16 : v8[j >> 1] & 0xffffu);
            KTf[TSW_E(k, t)] = f2bf((1.f - FF[t * 65 + k]) * __expf(AF[63 * 65 + k] - AF[t * 65 + k]));
            KTb[TSW_E(k, t)] = f2bf((1.f - FB[t * 65 + k]) * __expf(AB[k] - AB[t * 65 + k]));
        }
        if (tid < 64) p.GDEC[((size_t)(0 * NBH + bh) * NCH + pc) * 64 + tid] = __expf(AF[63 * 65 + tid]);
        else if (tid < 128) p.GDEC[((size_t)(1 * NBH + bh) * NCH + pc) * 64 + (tid - 64)] = __expf(AB[tid - 64]);
        LDS_BAR();
#if HGRN_DIAG == 4
        {
            const int v = tid >> 3, kg = tid & 7;
            for (int dir = 0; dir < 2; ++dir) {
                const LAS bf16_t* KT = (const LAS bf16_t*)(lds + HG_T0 + dir * HG_TS);
                float acc[8];
#pragma unroll
                for (int j = 0; j < 8; ++j) acc[j] = 0.f;
                for (int s_ = 0; s_ < 64; ++s_) { const float vv = bf2f(VT[v * 72 + s_]);
#pragma unroll
                    for (int j = 0; j < 8; ++j) acc[j] += bf2f(KT[(kg * 8 + j) * 72 + s_]) * vv; }
                bf16_t* dst = p.SLOC + ((size_t)(dir * NBH + bh) * NCH + pc) * 4096 + v * 64 + kg * 8;
#pragma unroll
                for (int j = 0; j < 8; ++j) dst[j] = f2bf(acc[j]);
            }
        }
#else
        {
            const int dir = wave >> 2, mt = wave & 3;
            const LAS unsigned char* KT = lds + HG_T0 + dir * HG_TS;
            bf16x8 a[2];
#pragma unroll
            for (int ks = 0; ks < 2; ++ks) a[ks] = *(const LAS bf16x8*)(KT + TSW_B(mt * 16 + fr, ks * 4 + fq));
            bf16_t* dst = p.SLOC + ((size_t)(dir * NBH + bh) * NCH + pc) * 4096;
            u32x2 w[4];
#pragma unroll
            for (int nt = 0; nt < 4; ++nt) {
                f32x4 acc = (f32x4){0.f, 0.f, 0.f, 0.f};
#pragma unroll
                for (int ks = 0; ks < 2; ++ks) { const bf16x8 bb = *(const LAS bf16x8*)(lds + HG_VT + TSW_B(nt * 16 + fr, ks * 4 + fq)); acc = mfma16(a[ks], bb, acc); }
                w[nt].x = cvt_pk_bf16(acc[0], acc[1]); w[nt].y = cvt_pk_bf16(acc[2], acc[3]);
            }
            zf = nzf; zb = nzb; v8 = nv8;
            asm volatile("" ::: "memory");
#pragma unroll
            for (int nt = 0; nt < 4; ++nt) *(u32x2*)(dst + (nt * 16 + fr) * 64 + mt * 16 + 4 * fq) = w[nt];
        }
#endif
        LDS_BAR();
    }
}
__device__ __forceinline__ void phase_hgrn_scan(const int tid, PRef p) {
    static_assert(NCH % 20 == 0, "scan group size");
    constexpr int GS = 20;
    for (int blk = (int)gridDim.x - 1 - (int)blockIdx.x; blk < 2 * NBH * 4; blk += gridDim.x) {
        const int sq = blk >> 2, part = blk & 3, dir = sq / NBH, e0 = part * 1024 + tid * 2, k = e0 & 63;
        unsigned* S = (unsigned*)(p.SLOC + (size_t)sq * NCH * 4096 + e0);
        const float* G = p.GDEC + (size_t)sq * NCH * 64 + k;
        float c0 = 0.f, c1 = 0.f;
        unsigned nx[GS]; f32x2 gn[GS];
#define HG_PC(j) (dir ? ((j) < NCHC ? NCHC - 1 - (j) : NCH + NCHC - 1 - (j)) : (j))
#pragma unroll
        for (int u = 0; u < GS; ++u) { const int pc = HG_PC(u); nx[u] = S[(size_t)pc * 2048]; gn[u] = *(const f32x2*)(G + (size_t)pc * 64); }
        for (int j0 = 0; j0 < NCH; j0 += GS) {
            unsigned cu[GS]; f32x2 gc[GS];
#pragma unroll
            for (int u = 0; u < GS; ++u) { cu[u] = nx[u]; gc[u] = gn[u]; }
            if (j0 + GS < NCH) {
#pragma unroll
                for (int u = 0; u < GS; ++u) { const int pc = HG_PC(j0 + GS + u); nx[u] = S[(size_t)pc * 2048]; gn[u] = *(const f32x2*)(G + (size_t)pc * 64); }
            }
#pragma unroll
            for (int u = 0; u < GS; ++u) {
                const int pc = HG_PC(j0 + u);
                S[(size_t)pc * 2048] = cvt_pk_bf16(c0, c1);
                c0 = gc[u][0] * c0 + bfw(cu[u], 0); c1 = gc[u][1] * c1 + bfw(cu[u], 1);
            }
        }
#undef HG_PC
    }
}
__device__ __forceinline__ void phase_hgrn_out(const int tid, PRef p, int l, LAS unsigned char* lds) {
    const int NCHO = (l + 1 < DEPTH) ? NCH : NCH - NCHC, PC0 = NCH - NCHO;
    LAS float* FF = (LAS float*)(lds + HG_FF); LAS float* FB = (LAS float*)(lds + HG_FB); LAS float* AF = (LAS float*)(lds + HG_AF); LAS float* AB = (LAS float*)(lds + HG_AB);
    LAS bf16_t* VT = (LAS bf16_t*)(lds + HG_VT);
    LAS float* OO = (LAS float*)(lds + HG_AF);
    const int t = tid >> 3, cg = tid & 7, wave = tid >> 6, lane = tid & 63, fr = lane & 15, fq = lane >> 4;
    u32x4 zf = (u32x4){0u, 0u, 0u, 0u}, zb = zf, v8 = zf, q8 = zf, g8 = zf, nzf = zf, nzb = zf, nv8 = zf, nq8 = zf, ng8 = zf;
    bf16x8 bsin[4][2], nbsin[4][2];
#define HG_LOADSIN(dst, bhx, pcx) do { const bf16_t* SIN_ = p.SLOC + ((size_t)((wave >> 2) * NBH + (bhx)) * NCH + (pcx)) * 4096; \
        _Pragma("unroll") for (int vt = 0; vt < 4; ++vt) _Pragma("unroll") for (int ks = 0; ks < 2; ++ks) dst[vt][ks] = *(const bf16x8*)(SIN_ + (vt * 16 + fr) * 64 + ks * 32 + fq * 8); } while (0)
#pragma unroll
    for (int vt = 0; vt < 4; ++vt) { bsin[vt][0] = (bf16x8){0, 0, 0, 0, 0, 0, 0, 0}; bsin[vt][1] = bsin[vt][0]; nbsin[vt][0] = bsin[vt][0]; nbsin[vt][1] = bsin[vt][0]; }
    if ((int)blockIdx.x < NBH * NCHO) { const int it = blockIdx.x, pc = it % NCHO + PC0, bh = it / NCHO, h = bh % HGH, b = bh / HGH;
        const bf16_t* pr = p.P + (size_t)(hg_row0(b, pc) + t) * INC + h * 64 + cg * 8; zf = *(const u32x4*)(pr + OFF_); zb = *(const u32x4*)(pr + OFB); v8 = *(const u32x4*)(pr + OHI); q8 = *(const u32x4*)(pr + OHQ); g8 = *(const u32x4*)(pr + OHG_);
        HG_LOADSIN(bsin, bh, pc); }
    hg_stage_lb(tid, p, l);
    f32x4 hn0, hn1; { const float* nwp = p.hg_norm + l * 64 + cg * 8; hn0 = *(const f32x4*)nwp; hn1 = *(const f32x4*)(nwp + 4); }
    for (int it = blockIdx.x; it < NBH * NCHO; it += gridDim.x) {
        const int pc = it % NCHO + PC0, bh = it / NCHO, h = bh % HGH, b = bh / HGH, row0 = hg_row0(b, pc);
        { const int it2 = min(it + (int)gridDim.x, NBH * NCHO - 1); const int pc2 = it2 % NCHO + PC0, bh2 = it2 / NCHO, h2 = bh2 % HGH, b2 = bh2 / HGH;
            const bf16_t* pr = p.P + (size_t)(hg_row0(b2, pc2) + t) * INC + h2 * 64 + cg * 8; nzf = *(const u32x4*)(pr + OFF_); nzb = *(const u32x4*)(pr + OFB); nv8 = *(const u32x4*)(pr + OHI); nq8 = *(const u32x4*)(pr + OHQ); ng8 = *(const u32x4*)(pr + OHG_);
            HG_LOADSIN(nbsin, bh2, pc2); }
        hg_gates(tid, p, l, h, zf, zb, lds);
        {
            float w[6][8];
#pragma unroll
            for (int j = 0; j < 8; ++j) {
                const int k = cg * 8 + j;
                VT[TSW_E(k, t)] = (bf16_t)(j & 1 ? v8[j >> 1] >> 16 : v8[j >> 1] & 0xffffu);
                const float qv = bf8(q8, j) * 0.125f, af = AF[t * 65 + k], ab = AB[t * 65 + k], rf = AF[31 * 65 + k], rb = AB[32 * 65 + k];
                w[0][j] = qv * __expf(fminf(af - rf, 80.f)); w[1][j] = (1.f - FF[t * 65 + k]) * __expf(fminf(rf - af, 80.f)); w[2][j] = qv * __expf(af);
                w[3][j] = qv * __expf(fminf(ab - rb, 80.f)); w[4][j] = (1.f - FB[t * 65 + k]) * __expf(fminf(rb - ab, 80.f)); w[5][j] = qv * __expf(ab);
            }
#pragma unroll
            for (int a = 0; a < 6; ++a) { u32x4 o; o.x = cvt_pk_bf16(w[a][0], w[a][1]); o.y = cvt_pk_bf16(w[a][2], w[a][3]); o.z = cvt_pk_bf16(w[a][4], w[a][5]); o.w = cvt_pk_bf16(w[a][6], w[a][7]);
                *(LAS u32x4*)(lds + HG_T0 + a * HG_TS + t * 144 + cg * 16) = o; }
        }
        LDS_BAR();
        {
            const int dir = wave >> 2, tt = wave & 3;
            const LAS unsigned char* QT = lds + HG_T0 + (dir * 3 + 0) * HG_TS; const LAS unsigned char* KL = lds + HG_T0 + (dir * 3 + 1) * HG_TS; const LAS unsigned char* QH = lds + HG_T0 + (dir * 3 + 2) * HG_TS;
            bf16x8 bq[2], bh[2];
#pragma unroll
            for (int ks = 0; ks < 2; ++ks) { bq[ks] = *(const LAS bf16x8*)(QT + (tt * 16 + fr) * 144 + ks * 64 + fq * 16); bh[ks] = *(const LAS bf16x8*)(QH + (tt * 16 + fr) * 144 + ks * 64 + fq * 16); }
            f32x4 o[4];
#pragma unroll
            for (int vt = 0; vt < 4; ++vt) { o[vt] = (f32x4){0.f, 0.f, 0.f, 0.f};
#pragma unroll
                for (int ks = 0; ks < 2; ++ks) o[vt] = mfma16(bsin[vt][ks], bh[ks], o[vt]); }
            const int t_ = 16 * tt + fr;
#pragma unroll
            for (int kp = 0; kp < 2; ++kp) {
                f32x4 sc[2];
#pragma unroll
                for (int hf = 0; hf < 2; ++hf) { const int st = 2 * kp + hf;
                    sc[hf] = (f32x4){0.f, 0.f, 0.f, 0.f};
                    if (dir ? st >= tt : st <= tt) {
#pragma unroll
                        for (int ks = 0; ks < 2; ++ks) { const bf16x8 a = *(const LAS bf16x8*)(KL + (st * 16 + fr) * 144 + ks * 64 + fq * 16); sc[hf] = mfma16(a, bq[ks], sc[hf]); }
#pragma unroll
                        for (int r = 0; r < 4; ++r) { const int s_ = 16 * st + 4 * fq + r; const bool keep = dir ? (s_ >= t_) : (s_ <= t_); sc[hf][r] = keep ? sc[hf][r] : 0.f; }
                    } }
                if (dir ? (2 * kp + 1 >= tt) : (2 * kp <= tt)) {
                    u32x4 pw; pw.x = cvt_pk_bf16(sc[0][0], sc[0][1]); pw.y = cvt_pk_bf16(sc[0][2], sc[0][3]); pw.z = cvt_pk_bf16(sc[1][0], sc[1][1]); pw.w = cvt_pk_bf16(sc[1][2], sc[1][3]);
                    const bf16x8 pf = __builtin_bit_cast(bf16x8, pw);
                    const int s0 = 32 * kp + 4 * fq;
#pragma unroll
                    for (int vt = 0; vt < 4; ++vt) { const int v_ = 16 * vt + fr; const int sw = (v_ >> 3) & 7;
                        const LAS unsigned char* vr = lds + HG_VT + v_ * 144 + (s0 & 7) * 2;
                        const bf16x8 a = ld2x64(vr + (((s0 >> 3) ^ sw) << 4), vr + ((((s0 + 16) >> 3) ^ sw) << 4));
                        o[vt] = mfma16(a, pf, o[vt]); }
                }
            }
            LAS float* OOd = (LAS float*)(lds + (dir ? HG_FB : HG_FF));
#pragma unroll
            for (int vt = 0; vt < 4; ++vt)
#pragma unroll
                for (int r = 0; r < 4; ++r) OOd[t_ * 65 + 16 * vt + 4 * fq + r] = o[vt][r];
        }
        LDS_BAR();
        {
            float o[8]; float ss = 0.f;
#pragma unroll
            for (int j = 0; j < 8; ++j) { o[j] = FF[t * 65 + cg * 8 + j] + FB[t * 65 + cg * 8 + j]; ss += o[j] * o[j]; }
            ss = oct_sum(ss);
            const float rstd = 1.f / sqrtf(ss * (1.f / 64.f) + EPS);
            float y[8];
#pragma unroll
            for (int j = 0; j < 8; ++j) { const float g = bf8(g8, j); y[j] = o[j] * rstd * (j < 4 ? hn0[j & 3] : hn1[j & 3]) * g * __builtin_amdgcn_rcpf(1.f + __expf(-g)); }
            u32x4 ov; ov.x = cvt_pk_bf16(y[0], y[1]); ov.y = cvt_pk_bf16(y[2], y[3]); ov.z = cvt_pk_bf16(y[4], y[5]); ov.w = cvt_pk_bf16(y[6], y[7]);
            zf = nzf; zb = nzb; v8 = nv8; q8 = nq8; g8 = ng8;
#pragma unroll
            for (int vt = 0; vt < 4; ++vt) { bsin[vt][0] = nbsin[vt][0]; bsin[vt][1] = nbsin[vt][1]; }
            asm volatile("" ::: "memory");
            *(u32x4*)(p.MIX + (size_t)(row0 + t) * MIXD + 384 + h * 64 + cg * 8) = ov;
        }
        LDS_BAR();
    }
}


#undef HG_LOADSIN
constexpr int AT_KC = 0, AT_VCT = 36864, AT_KL = AT_VCT + 256 * 144, AT_VL = AT_KL + 3 * 9216, AT_RPB = AT_VL + 3 * 9216, AT_END = AT_RPB + 1920;
static_assert(AT_END <= RING_BYTES && CTX == 256, "attention LDS layout (built for 256 context tokens)");
constexpr float ATHR = 6.f;
template <bool LOCAL, int NKB>
__device__ __forceinline__ void attn_scores(const LAS unsigned char* Kb, const bf16x8 (&qb)[2], f32x4 (&sc)[2 * NKB], int fr, int fq, const LAS float* rpb_row, const int (&boff)[8]) {
#pragma unroll
    for (int mt = 0; mt < 2 * NKB; ++mt) { sc[mt] = (f32x4){0.f, 0.f, 0.f, 0.f};
#pragma unroll
        for (int ks = 0; ks < 2; ++ks) { const bf16x8 a = *(const LAS bf16x8*)(Kb + (16 * mt + fr) * 144 + ks * 64 + fq * 16); sc[mt] = mfma16(a, qb[ks], sc[mt]); } }
    if (LOCAL) {
#pragma unroll
        for (int mt = 0; mt < 2 * NKB; ++mt)
#pragma unroll
            for (int r = 0; r < 4; ++r) sc[mt][r] += *(const LAS float*)((const LAS unsigned char*)rpb_row + boff[(4 * mt + r) & 7]);
    }
}
template <bool LOCAL, int NKB>
__device__ __forceinline__ void attn_spv(const f32x4 (&sc)[2 * NKB], const LAS unsigned char* Vb, f32x4 (&o)[4], float& m, float& lsum, int lane, int vtr) {
    float mx = -INFINITY;
#pragma unroll
    for (int mt = 0; mt < 2 * NKB; ++mt)
#pragma unroll
        for (int r = 0; r < 4; ++r) mx = fmaxf(mx, sc[mt][r]);
    if (__builtin_amdgcn_ballot_w64(mx > m + ATHR) != 0ull) {
        mx = fmaxf(mx, __builtin_bit_cast(float, __builtin_amdgcn_ds_swizzle(__builtin_bit_cast(int, mx), (16 << 10) | 0x1f)));
        mx = fmaxf(mx, __builtin_bit_cast(float, __builtin_amdgcn_ds_bpermute((lane ^ 32) << 2, __builtin_bit_cast(int, mx))));
        const float mn = fmaxf(m, mx), corr = __builtin_amdgcn_exp2f(m - mn);
        m = mn; lsum *= corr;
#pragma unroll
        for (int dt = 0; dt < 4; ++dt) o[dt] = o[dt] * corr;
    }
    float ps = 0.f;
#pragma unroll
    for (int kb = 0; kb < NKB; ++kb) {
        float pv[8];
#pragma unroll
        for (int h2 = 0; h2 < 2; ++h2)
#pragma unroll
            for (int r = 0; r < 4; ++r) { const float e = __builtin_amdgcn_exp2f(sc[2 * kb + h2][r] - m); pv[4 * h2 + r] = e; ps += e; }
        u32x4 pw; pw.x = cvt_pk_bf16(pv[0], pv[1]); pw.y = cvt_pk_bf16(pv[2], pv[3]); pw.z = cvt_pk_bf16(pv[4], pv[5]); pw.w = cvt_pk_bf16(pv[6], pv[7]);
        const bf16x8 pf = __builtin_bit_cast(bf16x8, pw);
#pragma unroll
        for (int dt = 0; dt < 4; ++dt) {
            const LAS unsigned char* vr = Vb + vtr + kb * (32 * 144) + dt * 32;
            o[dt] = mfma16(ld2tr(vr, vr + 16 * 144), pf, o[dt]);
        }
    }
    lsum += ps;
}
__device__ __forceinline__ void phase_attn(const int tid, PRef p, int l, LAS unsigned char* lds) {
    const int wave = tid >> 6, lane = tid & 63, fr = lane & 15, fq = lane >> 4, skey = tid >> 3, sc8 = tid & 7;
    LAS float* RPB = (LAS float*)(lds + AT_RPB);
    constexpr int NPAIR = ROWS / 2; const int IPB = NPAIR + ((l + 1 < DEPTH) ? 2 : 0);
    const int G_ = gridDim.x, NIT = NB * NAH * IPB;
#ifndef AT_DEAL_A
#define AT_DEAL_A 9
#define AT_DEAL_B 2
#endif
    const bool deal = (G_ == 256 && NIT <= 160 * AT_DEAL_A + 96 * AT_DEAL_B);
    const int it_lo = deal ? ((int)blockIdx.x < 160 ? (int)blockIdx.x * AT_DEAL_A : 160 * AT_DEAL_A + ((int)blockIdx.x - 160) * AT_DEAL_B) : (int)blockIdx.x;
    const int it_n = deal ? ((int)blockIdx.x < 160 ? AT_DEAL_A : AT_DEAL_B) : (NIT - (int)blockIdx.x + G_ - 1) / G_;
    int last_bh = -1;
#define AT_QTOK(itx) (((itx) % IPB) < NPAIR ? (((itx) / IPB) / NAH) * SEQ + (2 * ((itx) % IPB) + (wave >> 2)) * GW + 16 * (wave & 3) + fr : NLAT + (((itx) / IPB) / NAH) * CTX + ((((itx) % IPB) - NPAIR) * 128 + 16 * wave) + fr)
#define AT_LOADQ(itx, dst) do { const bf16_t* qp_ = p.P + (size_t)AT_QTOK(itx) * INC + OQ + (((itx) / IPB) % NAH) * 64 + fq * 8; dst[0] = *(const bf16x8*)qp_; dst[1] = *(const bf16x8*)(qp_ + 32); } while (0)
    bf16x8 qnx[2] = {(bf16x8){0, 0, 0, 0, 0, 0, 0, 0}, (bf16x8){0, 0, 0, 0, 0, 0, 0, 0}};
    { const int it0 = it_lo; if (it_n > 0 && it0 < NIT) AT_LOADQ(it0, qnx); }
    for (int ii = 0; ii < it_n; ++ii) {
        const int it = deal ? it_lo + ii : it_lo + ii * G_;
        if (it >= NIT) break;
        const int sub = it % IPB, bh = it / IPB, head = bh % NAH, b = bh / NAH;
        const bool islat = sub < NPAIR;
        const int r0 = 2 * sub, qr = r0 + (wave >> 2), jb = wave & 3;
        LDS_BAR();
        if (bh != last_bh) {
            last_bh = bh;
            int sc8l = sc8; asm volatile("" : "+v"(sc8l));
            for (int rnd = 0; rnd < 4; ++rnd) {
                const int key = skey + 64 * rnd; const bf16_t* src = p.P + (size_t)(NLAT + b * CTX + key) * INC + head * 64 + sc8l * 8;
                const u32x4 kv = *(const u32x4*)(src + OK_), vv = *(const u32x4*)(src + OV);
                *(LAS u32x4*)(lds + AT_KC + key * 144 + sc8 * 16) = kv; *(LAS u32x4*)(lds + AT_VCT + key * 144 + sc8 * 16) = vv;
            }
            { int t2 = tid; asm volatile("" : "+v"(t2));
              if (t2 < 15 * 32) RPB[t2] = (t2 & 31) < 31 ? p.rpb[((size_t)l * NAH + head) * 465 + (t2 >> 5) * 31 + (t2 & 31)] * 1.44269504089f : -INFINITY; }
        }
        const int qtok = islat ? b * SEQ + qr * GW + 16 * jb + fr : NLAT + b * CTX + ((sub - NPAIR) * 128 + 16 * wave) + fr;
        bf16x8 qb[2]; qb[0] = qnx[0]; qb[1] = qnx[1];
        { const int itn = deal ? it + 1 : it + G_; if (ii + 1 < it_n && itn < NIT) { int fr = (tid & 15); asm volatile("" : "+v"(fr)); AT_LOADQ(itn, qnx); } }
        int krlo = 0, krhi = -1, rs = 0;
        if (islat) { int a = r0 - 4; a = a < 0 ? 0 : (a > ROWS - 8 ? ROWS - 8 : a); int c = r0 + 1 - 4; c = c < 0 ? 0 : (c > ROWS - 8 ? ROWS - 8 : c); krlo = a; krhi = c + 7;
            rs = qr - 4; rs = rs < 0 ? 0 : (rs > ROWS - 8 ? ROWS - 8 : rs); }
        u32x4 kA = (u32x4){0u, 0u, 0u, 0u}, vA = kA, kB = kA, vB = kA, kC = kA, vC = kA;
        int skl = skey; asm volatile("" : "+v"(skl));
#define AT_LOADROW(row, kd, vd) do { const bf16_t* src_ = p.P + (size_t)(b * SEQ + (row) * GW + skl) * INC + head * 64 + sc8 * 8; kd = *(const u32x4*)(src_ + OK_); vd = *(const u32x4*)(src_ + OV); } while (0)
#define AT_STAGEROW(bufi, kd, vd) do { *(LAS u32x4*)(lds + AT_KL + (bufi) * 9216 + skey * 144 + sc8 * 16) = kd; *(LAS u32x4*)(lds + AT_VL + (bufi) * 9216 + skey * 144 + sc8 * 16) = vd; } while (0)
        if (islat) { AT_LOADROW(krlo, kA, vA); AT_LOADROW(krlo + 1, kB, vB); AT_LOADROW(krlo + 2, kC, vC); }
        f32x4 o[4]; float m = -1e30f, lsum = 0.f;
#pragma unroll
        for (int dt = 0; dt < 4; ++dt) o[dt] = (f32x4){0.f, 0.f, 0.f, 0.f};
        LDS_BAR();
        const int bs = jb == 0 ? 0 : (jb == 1 ? 8 : (jb == 2 ? 24 : 32)), qc = 16 * jb + fr;
        int boff[8];
        { int ws = qc - 8; ws = ws < 0 ? 0 : (ws > 48 ? 48 : ws);
#pragma unroll
          for (int j_ = 0; j_ < 8; ++j_) { const int kc = bs + 16 * (j_ >> 2) + 4 * fq + (j_ & 3); const bool ok = kc >= ws && kc < ws + 16; boff[j_] = (ok ? kc - qc + 15 : 31) * 4; asm volatile("" : "+v"(boff[j_])); } }
        int vtr = (4 * fq + (fr >> 2)) * 144 + 8 * (fr & 3); asm volatile("" : "+v"(vtr));
        const int vtrl = vtr + bs * 144;
        {
            f32x4 sa[4], sb[4];
#define AT_CS(st, dst) attn_scores<false, 2>(lds + AT_KC + (st) * 64 * 144, qb, dst, fr, fq, RPB, boff)
#define AT_CP(st, src) attn_spv<false, 2>(src, lds + AT_VCT + (st) * 64 * 144, o, m, lsum, lane, vtr)
            AT_CS(0, sa); AT_CS(1, sb); AT_CP(0, sa); AT_CS(2, sa); AT_CP(1, sb); AT_CS(3, sb); AT_CP(2, sa); AT_CP(3, sb);
#undef AT_CS
#undef AT_CP
        }
        if (islat) { AT_STAGEROW(0, kA, vA); AT_LOADROW(krlo + 3, kA, vA); AT_STAGEROW(1, kB, vB); AT_LOADROW(krlo + 4, kB, vB); }
        LDS_BAR();
        if (islat) {
            const bool first0 = rs == krlo, last8 = !first0;
            const LAS float* rp = RPB + (krlo - qr + 7) * 32;
            f32x4 sa[2], sb[2];
#define AT_S(j, dst) attn_scores<true, 1>(lds + AT_KL + ((j) % 3) * 9216 + bs * 144, qb, dst, fr, fq, rp + 32 * (j), boff)
#define AT_P(j, src) attn_spv<true, 1>(src, lds + AT_VL + ((j) % 3) * 9216, o, m, lsum, lane, vtrl)
#define AT_MID(j, NK, NV, LOADROWX, SCUR, SNXT) { AT_STAGEROW(((j) + 2) % 3, NK, NV); if ((LOADROWX) >= 0) { AT_LOADROW(min(krlo + (LOADROWX), krhi), NK, NV); } \
            AT_S((j) + 1, SNXT); AT_P(j, SCUR); LDS_BAR(); }
            sa[0] = (f32x4){0.f, 0.f, 0.f, 0.f}; sa[1] = sa[0];
            if (first0) AT_S(0, sa);
            { AT_STAGEROW(2, kC, vC); AT_LOADROW(krlo + 5, kC, vC); AT_S(1, sb); if (first0) AT_P(0, sa); LDS_BAR(); }
            AT_MID(1, kA, vA, 6, sb, sa) AT_MID(2, kB, vB, 7, sa, sb) AT_MID(3, kC, vC, 8, sb, sa) AT_MID(4, kA, vA, -1, sa, sb) AT_MID(5, kB, vB, -1, sb, sa) AT_MID(6, kC, vC, -1, sa, sb)
            if (last8) { AT_S(8, sa); AT_P(7, sb); AT_P(8, sa); } else { AT_P(7, sb); }
#undef AT_S
#undef AT_P
#undef AT_MID
        }
#undef AT_LOADROW
#undef AT_STAGEROW
        lsum = x32_sum(x16_sum(lsum, lane), lane);
        const float inv = 1.f / lsum;
        bf16_t* orow = p.MIX + (size_t)qtok * MIXD + head * 64;
#pragma unroll
        for (int dt = 0; dt < 4; ++dt) { u32x2 w; w.x = cvt_pk_bf16(o[dt][0] * inv, o[dt][1] * inv); w.y = cvt_pk_bf16(o[dt][2] * inv, o[dt][3] * inv); *(u32x2*)(orow + 16 * dt + 4 * fq) = w; }
    }
}


#undef AT_QTOK
#undef AT_LOADQ
template <int MODE> __device__ __forceinline__ void mini_gemm(const int tid, PRef p, int l) {
    const int wave = tid >> 6, lane = tid & 63, fr = lane & 15, fq = lane >> 4;
    const int gw = blockIdx.x * NWAVES + wave, NGW = gridDim.x * NWAVES;
    constexpr int K = MODE == 3 ? ED : (MODE == 1 ? MIXD : D);
    constexpr int N = MODE == 0 ? INC : (MODE == 2 ? 2 * ED : D);
    constexpr int MROWS = MODE <= 1 ? NCTX : NSLOT_C;
    constexpr int NTC = MODE == 2 ? 2 : 1, TW = 16 * NTC;
    constexpr int NTN = N / TW, NT = (MROWS / 32) * NTN;
    for (int t = gw; t < NT; t += NGW) {
        const int rt = t / NTN, ct = t % NTN, c0 = ct * TW;
        const bf16_t* Bt; const bf16_t* arow[2];
        if (MODE == 0) { Bt = p.WIN_T + WBOFF(l); for (int mt = 0; mt < 2; ++mt) arow[mt] = p.H + (size_t)(NLAT + rt * 32 + 16 * mt + fr) * D; }
        else if (MODE == 1) { Bt = p.WOUT_T + WBOFF(l); for (int mt = 0; mt < 2; ++mt) arow[mt] = p.MIX + (size_t)(NLAT + rt * 32 + 16 * mt + fr) * MIXD; }
        else if (MODE == 2) { const int e = rt % NE; Bt = p.WGU_T + WBOFF(l) + (size_t)e * 2 * ED * D;
            for (int mt = 0; mt < 2; ++mt) { int row = p.STOK[NSLOT_L + rt * 32 + 16 * mt + fr]; row = row < 0 ? 0 : (row >= NTOK ? NTOK - 1 : row); arow[mt] = p.H + (size_t)row * D; } }
        else { const int e = rt % NE; Bt = p.WD_T + WBOFF(l) + (size_t)e * D * ED; for (int mt = 0; mt < 2; ++mt) arow[mt] = p.HID + (size_t)(NSLOT_L + rt * 32 + 16 * mt + fr) * ED; }
        const bf16_t* brow = Bt + (size_t)(c0 + fr) * K;
        f32x4 acc[2][NTC];
#pragma unroll
        for (int mt = 0; mt < 2; ++mt)
#pragma unroll
            for (int nt = 0; nt < NTC; ++nt) acc[mt][nt] = (f32x4){0.f, 0.f, 0.f, 0.f};
#pragma unroll 8
        for (int ks = 0; ks < K / 32; ++ks) {
            bf16x8 a[2], bfr[NTC];
#pragma unroll
            for (int mt = 0; mt < 2; ++mt) a[mt] = *(const bf16x8*)(arow[mt] + ks * 32 + fq * 8);
#pragma unroll
            for (int nt = 0; nt < NTC; ++nt) bfr[nt] = *(const bf16x8*)(brow + (size_t)(16 * nt) * K + ks * 32 + fq * 8);
#pragma unroll
            for (int mt = 0; mt < 2; ++mt)
#pragma unroll
                for (int nt = 0; nt < NTC; ++nt) acc[mt][nt] = mfma16(a[mt], bfr[nt], acc[mt][nt]);
        }
#pragma unroll
        for (int mt = 0; mt < 2; ++mt)
#pragma unroll
            for (int r = 0; r < 4; ++r) {
                const int lr = rt * 32 + 16 * mt + 4 * fq + r;
                if (MODE == 0) { bf16_t* o = p.P + (size_t)(NLAT + lr) * INC + c0 + fr;
#pragma unroll
                    for (int nt = 0; nt < NTC; ++nt) o[16 * nt] = f2bf(acc[mt][nt][r]); }
                else if (MODE == 1) { float* o = p.XC + (size_t)lr * D + c0 + fr; const float* g = p.MOD + ((size_t)l * 3 + 2) * NMOD + 2 * D + c0 + fr;
#pragma unroll
                    for (int nt = 0; nt < NTC; ++nt) o[16 * nt] += g[16 * nt] * acc[mt][nt][r]; }
                else if (MODE == 2) { bf16_t* o = p.HID + (size_t)(NSLOT_L + lr) * ED + c0 / 2 + fr;
#pragma unroll
                    for (int q = 0; q < NTC / 2; ++q) { const float g = acc[mt][2 * q][r], u = acc[mt][2 * q + 1][r]; o[16 * q] = f2bf(g / (1.f + __expf(-g)) * u); } }
                else { bf16_t* o = p.Y + (size_t)(NSLOT_L + lr) * D + c0 + fr; const float val = p.SVAL[NSLOT_L + lr];
#pragma unroll
                    for (int nt = 0; nt < NTC; ++nt) o[16 * nt] = f2bf(val * acc[mt][nt][r]); }
            }
    }
}


__device__ __forceinline__ void phase_conv(const int tid, PRef p, int l) {
    const float* w = p.conv_w + (size_t)l * 3 * CVD;
    constexpr int U = 2;
    const long nitem = (long)NTOK * (CVD / 8), gstr = (long)gridDim.x * NTHR;
    for (long g0 = (long)blockIdx.x * NTHR + tid; g0 < nitem; g0 += gstr * U) {
        u32x4 cc[U][3], uu[U][3], bg[U]; float vz[U][3]; int rr[U], c8v[U]; bool ok[U];
#pragma unroll
        for (int u = 0; u < U; ++u) {
            long gid = g0 + u * gstr; ok[u] = gid < nitem; if (!ok[u]) gid = g0;
            const int r = (int)(gid / (CVD / 8)), c8 = (int)(gid % (CVD / 8)) * 8; rr[u] = r; c8v[u] = c8;
            int t, T; if (r < NLAT) { t = r % SEQ; T = SEQ; } else { t = (r - NLAT) % CTX; T = CTX; }
            const bf16_t* pr = p.P + (size_t)r * INC + c8;
#pragma unroll
            for (int d = 0; d < 3; ++d) { const int tt = t + d - 1; const bool in = tt >= 0 && tt < T; vz[u][d] = in ? 1.f : 0.f;
                const bf16_t* q = pr + (in ? (long)(d - 1) * INC : 0L); cc[u][d] = *(const u32x4*)(q + OCC); uu[u][d] = *(const u32x4*)(q + OCU); }
            bg[u] = *(const u32x4*)(pr + OCB);
        }
        asm volatile("" ::: "memory");
#pragma unroll
        for (int u = 0; u < U; ++u) {
            float y[8];
#pragma unroll
            for (int j = 0; j < 8; ++j) y[j] = 0.f;
#pragma unroll
            for (int d = 0; d < 3; ++d) {
                const f32x4 w0 = *(const f32x4*)(w + d * CVD + c8v[u]) * vz[u][d], w1 = *(const f32x4*)(w + d * CVD + c8v[u] + 4) * vz[u][d];
#pragma unroll
                for (int j = 0; j < 8; ++j) y[j] += (j < 4 ? w0[j & 3] : w1[j & 3]) * bf8(cc[u][d], j) * bf8(uu[u][d], j);
            }
            u32x4 o; o.x = cvt_pk_bf16(bf8(bg[u], 0) * y[0], bf8(bg[u], 1) * y[1]); o.y = cvt_pk_bf16(bf8(bg[u], 2) * y[2], bf8(bg[u], 3) * y[3]);
            o.z = cvt_pk_bf16(bf8(bg[u], 4) * y[4], bf8(bg[u], 5) * y[5]); o.w = cvt_pk_bf16(bf8(bg[u], 6) * y[6], bf8(bg[u], 7) * y[7]);
            if (ok[u]) *(u32x4*)(p.MIX + (size_t)rr[u] * MIXD + 768 + c8v[u]) = o;
        }
    }
}
__device__ __forceinline__ void phase_qkprep(const int tid, PRef p, int l) {
    const int sub = tid & 7;
    constexpr int U = 4;
    const long ngroups = (long)NTOK * 12, gstride = ((long)gridDim.x * NTHR) >> 3;
    for (long g0 = ((long)blockIdx.x * NTHR + tid) >> 3; g0 < ngroups; g0 += gstride * U) {
        u32x4 raw[U]; bf16_t* ptr[U]; int rr[U]; int wh[U];
#pragma unroll
        for (int u = 0; u < U; ++u) { long g8 = g0 + u * gstride; const bool ok = g8 < ngroups; if (!ok) g8 = g0;
            rr[u] = ok ? (int)(g8 / 12) : -1; wh[u] = (int)(g8 % 12) / 6; const int head = (int)(g8 % 6);
            ptr[u] = p.P + (size_t)(g8 / 12) * INC + (wh[u] ? OK_ : OQ) + head * HD + sub * 8; raw[u] = *(const u32x4*)ptr[u]; }
#pragma unroll
        for (int u = 0; u < U; ++u) {
            const float* nw = (wh[u] ? p.k_norm : p.q_norm) + l * HD + sub * 8;
            float y[8]; float ss = 0.f;
#pragma unroll
            for (int j = 0; j < 8; ++j) { y[j] = bf8(raw[u], j); ss += y[j] * y[j]; }
            ss = oct_sum(ss);
            const float rstd = 1.f / sqrtf(ss * (1.f / HD) + EPS);
#pragma unroll
            for (int j = 0; j < 8; ++j) y[j] = y[j] * rstd * nw[j];
            const int r = rr[u];
            const bool lat = r >= 0 && r < NLAT;
            const int t = lat ? r % SEQ : 0; const float pos = (sub & 4) ? (float)(t % GW) : (float)(t / GW);
            const bool second = (sub & 2) != 0;
#pragma unroll
            for (int j = 0; j < 8; ++j) {
                const float other = __builtin_bit_cast(float, __builtin_amdgcn_ds_swizzle(__builtin_bit_cast(int, y[j]), (2 << 10) | 0x1f));
                const int fi = (sub & 1) * 8 + j;
                const float ang = pos * __builtin_amdgcn_exp2f(-(float)fi * (13.287712379549449f / 16.f));
                const float cs = FCOS(ang), sn = FSIN(ang);
                const float rot = second ? y[j] * cs + other * sn : y[j] * cs - other * sn;
                y[j] = lat ? rot : y[j];
            }
            if (r >= 0) { u32x4 o; o.x = cvt_pk_bf16(y[0], y[1]); o.y = cvt_pk_bf16(y[2], y[3]); o.z = cvt_pk_bf16(y[4], y[5]); o.w = cvt_pk_bf16(y[6], y[7]); *(u32x4*)ptr[u] = o; }
        }
    }
}

__device__ __forceinline__ f32x4 bf4(const u32x2 w) { return (f32x4){bfw(w.x, 0), bfw(w.x, 1), bfw(w.y, 0), bfw(w.y, 1)}; }
template <int MODE> __device__ __forceinline__ void phase_rows(const int tid, PRef p, int l, LAS unsigned char* lds) {
    static_assert(D == 1024, "wave-per-row kernels assume D = 1024");
    const int lane = tid & 63, wave = tid >> 6;
#define RC(j) (8 * lane + 512 * ((j) >> 1) + 4 * ((j) & 1))
    if (MODE == 1) {
        for (int k = tid; k < D; k += NTHR) { const f32x4* src = (const f32x4*)(p.w_router + ((size_t)l * D + k) * NE); LAS f32x4* dst = (LAS f32x4*)(lds + k * 64 + (k >> 3) * 16);
#pragma unroll
            for (int u = 0; u < 4; ++u) dst[u] = src[u]; }
        __syncthreads();
    }
    const int gw = blockIdx.x * NWAVES + wave, NGW = gridDim.x * NWAVES;
    const int rw = ((NTOK + NGW - 1) / NGW + 1) & ~1;
    const int r_lo = gw * rw, r_hi = min(NTOK, r_lo + rw);
    const bool doh = MODE != 2 || l + 1 < DEPTH;
    const int ln = (MODE == 2 && l + 1 < DEPTH) ? l + 1 : l;
    const float* nw = (MODE == 1 ? p.norm2_w : p.norm1_w) + (size_t)ln * D;
    int curset = -1; f32x4 Av[4], Sv[4], Gv[4];
#pragma unroll
    for (int j = 0; j < 4; ++j) { Av[j] = (f32x4){0.f, 0.f, 0.f, 0.f}; Sv[j] = Av[j]; Gv[j] = Av[j]; }
    constexpr int NVN = MODE == 0 ? 4 : 2;
    u32x4 vn[2][NVN]; int invn[2] = {-1, -1};
#define ROWS_LOADPAIR(rb) do { _Pragma("unroll") for (int i_ = 0; i_ < 2; ++i_) { const int rr_ = ((rb) + i_ < r_hi) ? (rb) + i_ : (rb); \
        if (MODE == 0) { const float* src_ = rr_ < NLAT ? p.x + (size_t)rr_ * D : p.ctx + (size_t)(rr_ - NLAT) * D; \
            _Pragma("unroll") for (int j_ = 0; j_ < NVN; ++j_) vn[i_][j_] = *(const u32x4*)(src_ + RC(j_)); } \
        else if (rr_ < NLAT) { const bf16_t* src_ = p.XB + (size_t)rr_ * D + 8 * lane; vn[i_][0] = *(const u32x4*)src_; vn[i_][1] = *(const u32x4*)(src_ + 512); } \
        if (MODE == 2) invn[i_] = lane < NE ? p.INV[(size_t)rr_ * NE + lane] : -1; } } while (0)
#pragma unroll
    for (int i = 0; i < 2; ++i)
#pragma unroll
        for (int j = 0; j < NVN; ++j) vn[i][j] = (u32x4){0u, 0u, 0u, 0u};
    if (r_lo < r_hi) ROWS_LOADPAIR(r_lo);
#pragma unroll 1
    for (int r = r_lo; r < r_hi; r += 2) {
        const bool two = r + 1 < r_hi;
        const bool lat = r < NLAT;
        const int set = modset(r);
        if (set != curset) { curset = set;
            const float* mod = p.MOD + ((size_t)ln * 3 + set) * NMOD; const float* shift = mod + (MODE == 1 ? 3 : 0) * D; const float* scale = mod + (MODE == 1 ? 4 : 1) * D;
            int lane2 = lane; asm volatile("" : "+v"(lane2));
#pragma unroll
            for (int j = 0; j < 4; ++j) { const int c = 8 * lane2 + 512 * (j >> 1) + 4 * (j & 1); const f32x4 w4 = *(const f32x4*)(nw + c), sc4 = *(const f32x4*)(scale + c); Av[j] = w4 * (sc4 + 1.f); Sv[j] = *(const f32x4*)(shift + c);
                if (MODE == 2) Gv[j] = *(const f32x4*)(p.MOD + ((size_t)l * 3 + set) * NMOD + 5 * D + c); } }
        f32x4 v[2][4]; int inv2[2];
#pragma unroll
        for (int i = 0; i < 2; ++i) { inv2[i] = invn[i];
            if (MODE == 0) {
#pragma unroll
                for (int j = 0; j < 4; ++j) v[i][j] = __builtin_bit_cast(f32x4, vn[i][j < NVN ? j : 0]);
            } else if (lat) {
#pragma unroll
                for (int jj = 0; jj < 2; ++jj) { const u32x4 w = vn[i][jj]; v[i][2 * jj] = (f32x4){bfw(w.x, 0), bfw(w.x, 1), bfw(w.y, 0), bfw(w.y, 1)}; v[i][2 * jj + 1] = (f32x4){bfw(w.z, 0), bfw(w.z, 1), bfw(w.w, 0), bfw(w.w, 1)}; }
            } else { const float* src = p.XC + (size_t)(r + ((i == 0 || two) ? i : 0) - NLAT) * D;
#pragma unroll
                for (int j = 0; j < 4; ++j) v[i][j] = *(const f32x4*)(src + RC(j));
            } }
        if (r + 2 < r_hi) ROWS_LOADPAIR(r + 2);
        if (MODE == 2) {
            unsigned long long mk[2]; int sl[2][2];
#pragma unroll
            for (int i = 0; i < 2; ++i) { const int myinv = inv2[i]; mk[i] = __ballot(myinv >= 0 && myinv < NSLOT);
#pragma unroll
                for (int c = 0; c < 2; ++c) { sl[i][c] = -1; if (mk[i]) { const int e = __builtin_ctzll(mk[i]); mk[i] &= mk[i] - 1; sl[i][c] = __builtin_amdgcn_readlane(myinv, e); } } }
            u32x4 y[2][2][2];
#pragma unroll
            for (int i = 0; i < 2; ++i)
#pragma unroll
                for (int c = 0; c < 2; ++c) { y[i][c][0] = (u32x4){0u, 0u, 0u, 0u}; y[i][c][1] = y[i][c][0];
                    if (sl[i][c] >= 0) { const bf16_t* yp = p.Y + (size_t)sl[i][c] * D + 8 * lane; y[i][c][0] = *(const u32x4*)yp; y[i][c][1] = *(const u32x4*)(yp + 512); } }
            asm volatile("" ::: "memory");
#pragma unroll
            for (int i = 0; i < 2; ++i) {
                f32x4 acc[4];
#pragma unroll
                for (int j = 0; j < 4; ++j) acc[j] = (f32x4){0.f, 0.f, 0.f, 0.f};
#pragma unroll
                for (int c = 0; c < 2; ++c)
#pragma unroll
                    for (int jj = 0; jj < 2; ++jj) { const u32x4 w = y[i][c][jj];
                        acc[2 * jj] = acc[2 * jj] + (f32x4){bfw(w.x, 0), bfw(w.x, 1), bfw(w.y, 0), bfw(w.y, 1)}; acc[2 * jj + 1] = acc[2 * jj + 1] + (f32x4){bfw(w.z, 0), bfw(w.z, 1), bfw(w.w, 0), bfw(w.w, 1)}; }
                const int myinv = inv2[i];
                while (mk[i]) {
                    const int e = __builtin_ctzll(mk[i]); mk[i] &= mk[i] - 1; const int s0 = __builtin_amdgcn_readlane(myinv, e);
                    const bf16_t* yp = p.Y + (size_t)s0 * D + 8 * lane; const u32x4 w0 = *(const u32x4*)yp, w1 = *(const u32x4*)(yp + 512);
                    acc[0] = acc[0] + (f32x4){bfw(w0.x, 0), bfw(w0.x, 1), bfw(w0.y, 0), bfw(w0.y, 1)}; acc[1] = acc[1] + (f32x4){bfw(w0.z, 0), bfw(w0.z, 1), bfw(w0.w, 0), bfw(w0.w, 1)};
                    acc[2] = acc[2] + (f32x4){bfw(w1.x, 0), bfw(w1.x, 1), bfw(w1.y, 0), bfw(w1.y, 1)}; acc[3] = acc[3] + (f32x4){bfw(w1.z, 0), bfw(w1.z, 1), bfw(w1.w, 0), bfw(w1.w, 1)};
                }
#pragma unroll
                for (int j = 0; j < 4; ++j) v[i][j] = v[i][j] + Gv[j] * acc[j];
            }
        }
        if (MODE == 0 || MODE == 2) {
            const bool fin = MODE == 2 && l + 1 == DEPTH;
#pragma unroll
            for (int i = 0; i < 2; ++i) if (i == 0 || two) {
                if (lat && !fin) {
#pragma unroll
                    for (int jj = 0; jj < 2; ++jj) { u32x4 o; o.x = cvt_pk_bf16(v[i][2 * jj][0], v[i][2 * jj][1]); o.y = cvt_pk_bf16(v[i][2 * jj][2], v[i][2 * jj][3]); o.z = cvt_pk_bf16(v[i][2 * jj + 1][0], v[i][2 * jj + 1][1]); o.w = cvt_pk_bf16(v[i][2 * jj + 1][2], v[i][2 * jj + 1][3]);
                        *(u32x4*)(p.XB + (size_t)(r + i) * D + 8 * lane + 512 * jj) = o; }
                } else if (lat || !fin) { float* dst = lat ? p.XL + (size_t)(r + i) * D : p.XC + (size_t)(r + i - NLAT) * D;
#pragma unroll
                    for (int j = 0; j < 4; ++j) *(f32x4*)(dst + RC(j)) = v[i][j]; }
            }
        }
        if (doh) {
            float ss[2];
#pragma unroll
            for (int i = 0; i < 2; ++i) { float a = 0.f;
#pragma unroll
                for (int j = 0; j < 4; ++j) a += (v[i][j][0] * v[i][j][0] + v[i][j][1] * v[i][j][1]) + (v[i][j][2] * v[i][j][2] + v[i][j][3] * v[i][j][3]);
                ss[i] = a; }
            ss[0] = wave_sum(ss[0], lane); ss[1] = wave_sum(ss[1], lane);
            const float rstd0 = 1.f / sqrtf(ss[0] * (1.f / D) + EPS), rstd1 = 1.f / sqrtf(ss[1] * (1.f / D) + EPS);
            f32x4 hh[2][4];
#pragma unroll
            for (int j = 0; j < 4; ++j) { hh[0][j] = v[0][j] * rstd0 * Av[j] + Sv[j]; hh[1][j] = v[1][j] * rstd1 * Av[j] + Sv[j]; }
#pragma unroll
            for (int i = 0; i < 2; ++i) if (i == 0 || two) {
#pragma unroll
                for (int jj = 0; jj < 2; ++jj) { u32x4 o; o.x = cvt_pk_bf16(hh[i][2 * jj][0], hh[i][2 * jj][1]); o.y = cvt_pk_bf16(hh[i][2 * jj][2], hh[i][2 * jj][3]); o.z = cvt_pk_bf16(hh[i][2 * jj + 1][0], hh[i][2 * jj + 1][1]); o.w = cvt_pk_bf16(hh[i][2 * jj + 1][2], hh[i][2 * jj + 1][3]);
                    *(u32x4*)(p.H + (size_t)(r + i) * D + 8 * lane + 512 * jj) = o; } }
            if (MODE == 1) {
                LAS float* red = (LAS float*)(lds + 70144 + wave * 4224);
                LAS float* red1 = (LAS float*)(wave < 6 ? lds + 103936 + wave * 4224 : lds + LDSCTL_OFF + 1024 + (wave - 6) * 4224);
                const LAS unsigned char* wb = lds + lane * 528;
#pragma unroll
                for (int u = 0; u < 4; ++u) {
                    f32x4 a0 = (f32x4){0.f, 0.f, 0.f, 0.f}, a1 = a0;
#pragma unroll
                    for (int j = 0; j < 4; ++j)
#pragma unroll
                        for (int q = 0; q < 4; ++q) { const f32x4 w = *(const LAS f32x4*)(wb + (j >> 1) * 33792 + (4 * (j & 1) + q) * 64 + u * 16); const float h0 = hh[0][j][q], h1 = hh[1][j][q];
                            a0 = __builtin_elementwise_fma(w, (f32x4){h0, h0, h0, h0}, a0); a1 = __builtin_elementwise_fma(w, (f32x4){h1, h1, h1, h1}, a1); }
#pragma unroll
                    for (int c = 0; c < 4; ++c) { red[(4 * u + c) * 65 + lane] = a0[c]; red1[(4 * u + c) * 65 + lane] = a1[c]; }
                    asm volatile("" ::: "memory");
                }
#pragma unroll
                for (int i = 0; i < 2; ++i) {
                    const LAS float* rd = i ? red1 : red;
                    const int e2 = lane & 15, part = lane >> 4;
                    float t = 0.f;
#pragma unroll
                    for (int x = 0; x < 16; ++x) t += rd[e2 * 65 + part * 16 + x];
                    asm volatile("" ::: "memory");
                    t = x32_sum(x16_sum(t, lane), lane);
#define SWZF(x, d) __builtin_bit_cast(float, __builtin_amdgcn_ds_swizzle(__builtin_bit_cast(int, (x)), ((d) << 10) | 0x1f))
                    float m = t;
                    m = row16_max(m);
                    const float ex = expf(t - m); float sm = ex;
                    sm = row16_sum(sm);
#undef SWZF
                    if (lane < NE && (i == 0 || two)) p.AFF[(size_t)(r + i) * NE + lane] = ex / sm;
                }
            }
        }
    }
#undef ROWS_LOADPAIR
#undef RC
    if (MODE == 1) __syncthreads();
}


__device__ __forceinline__ void phase_adaln(const int tid, PRef p, LAS unsigned char* lds) {
    static_assert(D == 1024 && NMOD % 256 == 0, "adaln layout");
    const int lane = tid & 63, wave = tid >> 6;
    LAS float* SC = (LAS float*)lds;
    LAS float* RED = (LAS float*)(lds + 16384);
    for (int i = tid; i < 3 * D; i += NTHR) { const int st = i / D, k = i % D; const float cv = st < 2 ? p.c[st * D + k] : p.c_ctx[k]; SC[i] = cv / (1.f + __expf(-cv)); }
    __syncthreads();
    constexpr int NCG = NMOD / 256;
    for (int item = blockIdx.x; item < DEPTH * NCG * 2; item += gridDim.x) {
        const int l = item / (NCG * 2), rem = item % (NCG * 2), cgp = rem >> 1, kh = rem & 1;
        const int kbase = kh * 512 + wave * 64;
        const float* wp = p.w_mod + ((size_t)l * D + kbase) * NMOD + cgp * 256 + 4 * lane;
        f32x4 acc[3];
#pragma unroll
        for (int st = 0; st < 3; ++st) acc[st] = (f32x4){0.f, 0.f, 0.f, 0.f};
#pragma unroll 16
        for (int kk = 0; kk < 64; ++kk) { const f32x4 w = *(const f32x4*)(wp + (size_t)kk * NMOD);
#pragma unroll
            for (int st = 0; st < 3; ++st) acc[st] = acc[st] + w * SC[st * D + kbase + kk]; }
#pragma unroll
        for (int st = 0; st < 3; ++st) *(LAS f32x4*)(RED + (wave * 3 + st) * 256 + 4 * lane) = acc[st];
        __syncthreads();
        for (int o = tid; o < 3 * 256; o += NTHR) { const int st = o >> 8, n = o & 255; float v = 0.f;
#pragma unroll
            for (int w8 = 0; w8 < 8; ++w8) v += RED[(w8 * 3 + st) * 256 + n];
            if (kh == 0) v += p.b_mod[(size_t)l * NMOD + cgp * 256 + n];
            atomicAdd(p.MOD + ((size_t)l * 3 + st) * NMOD + cgp * 256 + n, v); }
        __syncthreads();
    }
}

constexpr int NPL = 11, NPH = 1 + DEPTH * NPL;
struct Args { Params p; int ph_lo, ph_hi; };
__global__ void __launch_bounds__(NTHR, 2) mega_fwd(Args args) {
    LAS unsigned char* lds = (LAS unsigned char*)lds_raw;
    {
        const int tid0 = threadIdx.x;
        for (int u = tid0; u < (LDS_BYTES - LDSCTL_OFF) / 4; u += NTHR) ((LAS unsigned*)(lds + LDSCTL_OFF))[u] = 0u;
        __syncthreads();
    }
    int wslot = 0;
    { unsigned m_ = ~0u; asm volatile("" : "+s"(m_));
      const int simd = (int)(__builtin_amdgcn_s_getreg((1 << 11) | (4 << 6) | 4) & 3u);
      if (__builtin_amdgcn_mbcnt_hi(m_, __builtin_amdgcn_mbcnt_lo(m_, 0u)) == 0) wslot = simd + 4 * (int)__hip_atomic_fetch_add(((unsigned*)(lds_raw + MISC_OFF + 64)) + simd, 1u, __ATOMIC_RELAXED, __HIP_MEMORY_SCOPE_WORKGROUP); }
    wslot = __builtin_amdgcn_readfirstlane(wslot) & 7;
#define MY_TID(var) int var; { unsigned m_ = ~0u; asm volatile("" : "+s"(m_)); var = wslot * 64 + (int)__builtin_amdgcn_mbcnt_hi(m_, __builtin_amdgcn_mbcnt_lo(m_, 0u)); } asm volatile("" : "+v"(var))
    XcdBarrier bar; bar.bar = args.p.CTL; bar.x = 0;
    const bool multi = args.ph_hi - args.ph_lo > 1;
    if (multi) { MY_TID(t0); bar = xcd_barrier_post(args.p.CTL, t0 == 0); }
    const int G = gridDim.x;
    const int ph_lo = args.ph_lo, ph_hi = args.ph_hi;
#ifndef PHMASK
#define PHMASK 0xFFFF
#endif
#define PH_ON(k) ((k) == 0 ? (PHMASK & 1) : ((PHMASK >> (1 + ((k) - 1) % NPL)) & 1))
#ifndef REPMASK
#define REPMASK 0
#endif
#ifndef REP_LOCAL
#define REP_LOCAL 0
#define REP_CONV 0
#define REP_ATTN 0
#endif
#ifndef HG_STOP
#define HG_STOP 0
#endif
#ifndef REP_P0
#define REP_P0 0
#endif
#define REP_N(k) (((k) == 0 && REP_P0) ? 2 : (((k) > 0 && ((REPMASK >> (((k) - 1) % NPL)) & 1)) ? 2 : 1))
#define PH_BEGIN(k) if (PH_ON(k) && ph_lo <= (k) && (k) < ph_hi) { for (int rep_ = 0; rep_ < REP_N(k); ++rep_) { const AS4 Args* kp = (const AS4 Args*)__builtin_amdgcn_kernarg_segment_ptr(); asm volatile("" : "+s"(kp)); PRef p = kp->p; MY_TID(tid);
#define PH_END_IF(k, cond) } if ((cond) && (k) + 1 < ph_hi) { MY_TID(t1); xcd_barrier(bar, t1 == 0, XB_ST(lds_raw)); } }
#ifndef REP_CVT
#define REP_CVT 0
#endif
#ifndef REP_BAR
#define REP_BAR 0
#endif
#define PH_END(k) } if ((k) + 1 < ph_hi) { for (int rb_ = 0; rb_ < 1 + REP_BAR; ++rb_) { MY_TID(t1); xcd_barrier(bar, t1 == 0, XB_ST(lds_raw)); } } }
    PH_BEGIN(0)
        phase_adaln(tid, p, lds);
        run_items<b_lb>(tid, p, 0, 2L * 384, 0);
        phase_convert(tid, p, 0, lds, 1, 0);
    PH_END(0)
#define LAYER(l)                                                                                                                                     \
    PH_BEGIN(1 + (l) * NPL + 0) if ((l) == 0) { phase_rows<0>(tid, p, 0, lds); } PH_END_IF(1 + (l) * NPL + 0, (l) == 0)                                 \
    PH_BEGIN(1 + (l) * NPL + 1) {                                                                                                                    \
        pg8::Gemm g{p.H, p.WIN_T + WBOFF(l), NTOK, INC, D, nullptr, 0, 1, 0}; pg8::StaticOrder S; S.init(NTOK, INC, G, (int)blockIdx.x);                         \
        pg8::EpiP E{p.P, INC, p.q_norm + (l) * HD, p.k_norm + (l) * HD, rep_};                                                    \
        pg8::gemm_phase<pg8::EpiP, false>(tid, lds, g, S, E);                                                                                     \
        } PH_END(1 + (l) * NPL + 1)               \
    PH_BEGIN(1 + (l) * NPL + 2) if constexpr (!FUSE_QK) { phase_qkprep(tid, p, l); } if constexpr (FAST_HGRN && (HGRN_DIAG == 3 || HGRN_DIAG == 4)) { phase_hgrn_local(tid, p, l, lds); { MY_TID(t7); run_items<b_hgrn_local_slow>(t7, p, l, 2L * NBH * NCH * 64, 0); } } else if constexpr (FAST_HGRN && HGRN_DIAG >= 2) { run_items<b_hgrn_local_slow>(tid, p, l, 2L * NBH * NCH * 64, 0); } else if constexpr (FAST_HGRN) { for (int r2_ = 0; r2_ < 1 + REP_LOCAL; ++r2_) phase_hgrn_local(tid, p, l, lds); } else { run_items<b_gates>(tid, p, l, (long)NTOK * 768, 0); } phase_conv(tid, p, l); PH_END(1 + (l) * NPL + 2) \
    PH_BEGIN(1 + (l) * NPL + 3) if constexpr (FAST_HGRN && HGRN_DIAG) { run_items<b_hgrn_scan_slow>(tid, p, l, 2L * NBH * 4096, 0); } else if constexpr (FAST_HGRN) { phase_hgrn_scan(tid, p); } else { run_items<b_hgrn_seq2>(tid, p, l, 2L * NB * HGH * 64, 0); } if constexpr (FAST_ATTN) { for (int r4_ = 0; r4_ < 1 + REP_ATTN; ++r4_) { MY_TID(t6); phase_attn(t6, p, l, lds); } } else { run_items<b_attn>(tid, p, l, (long)NTOK * NAH, 0); } PH_END(1 + (l) * NPL + 3) \
    PH_BEGIN(1 + (l) * NPL + 4) if constexpr (FAST_HGRN && HGRN_DIAG) { run_items<b_hgrn_chunkseq>(tid, p, l, 2L * NBH * NCH * 64, 0); { MY_TID(t9); xcd_barrier(bar, t9 == 0, XB_ST(lds_raw)); } { MY_TID(t8); run_items<b_hgfin>(t8, p, l, (long)NTOK * HGH, 0); } } else if constexpr (FAST_HGRN) { phase_hgrn_out(tid, p, l, lds); } else { run_items<b_hgfin>(tid, p, l, (long)NTOK * HGH, 0); } PH_END(1 + (l) * NPL + 4)                                         \
    PH_BEGIN(1 + (l) * NPL + 5) {                                                                                                                    \
        pg8::Gemm g{p.MIX, p.WOUT_T + WBOFF(l), NLAT, D, MIXD, nullptr, 0, 1, 0}; pg8::StaticOrder S; S.init(NLAT, D, G, (int)blockIdx.x);                       \
        pg8::EpiRes E{p.XB, D, p.MOD + (size_t)(l) * 3 * NMOD + 2 * D, SEQ, (size_t)NMOD};                                                           \
        pg8::gemm_phase<pg8::EpiRes, false>(tid, lds, g, S, E);                                                                                      \
        if ((l) + 1 < DEPTH) { MY_TID(tid2); mini_gemm<1>(tid2, p, l); } } PH_END(1 + (l) * NPL + 5)                  \
    PH_BEGIN(1 + (l) * NPL + 6) phase_rows<1>(tid, p, l, lds); PH_END(1 + (l) * NPL + 6)                                                               \
    PH_BEGIN(1 + (l) * NPL + 7) if constexpr (FAST_TOPK) { phase_topk(tid, p, lds); if ((l) == 0 && gridDim.x > 2 * NB * NE + 32) { MY_TID(t4); phase_convert(t4, p, 0, lds, 2, 2 * NB * NE); } else if ((l) == 0) { MY_TID(t4); phase_convert(t4, p, 0, lds, 2, 0); } else if ((l) + 1 < DEPTH) { MY_TID(t4); phase_convert(t4, p, (l) + 1, lds, 0, gridDim.x > 2 * NB * NE + 32 ? 2 * NB * NE : 0); } } else { run_items<b_rank>(tid, p, l, (long)NTOK * NE, 0); } PH_END(1 + (l) * NPL + 7)                                          \
    PH_BEGIN(1 + (l) * NPL + 8) {                                                                                                                    \
        pg8::Gemm g{p.H, p.WGU_T + WBOFF(l), NSLOT_L, 2 * ED, D, p.STOK, CAPL / 256, NE, (size_t)2 * ED * D * 2}; pg8::StaticOrder S; S.init(NSLOT_L, 2 * ED, G, (int)blockIdx.x); \
        pg8::EpiHid E{p.HID, ED};                                                                                                                    \
        pg8::gemm_phase<pg8::EpiHid, true>(tid, lds, g, S, E);                                                                                       \
        if ((l) + 1 < DEPTH) { MY_TID(tid2); mini_gemm<2>(tid2, p, l); } } PH_END(1 + (l) * NPL + 8)              \
    PH_BEGIN(1 + (l) * NPL + 9) {                                                                                                                    \
        pg8::Gemm g{p.HID, p.WD_T + WBOFF(l), NSLOT_L, D, ED, nullptr, CAPL / 256, NE, (size_t)D * ED * 2}; pg8::StaticOrder S; S.init(NSLOT_L, D, G, (int)blockIdx.x); \
        pg8::EpiBf16 E{p.Y, D, p.SVAL, 0};                                                                                                              \
        pg8::gemm_phase<pg8::EpiBf16, false>(tid, lds, g, S, E);                                                                                     \
        if ((l) + 1 < DEPTH) { MY_TID(tid2); mini_gemm<3>(tid2, p, l); } } PH_END(1 + (l) * NPL + 9)                \
    PH_BEGIN(1 + (l) * NPL + 10) phase_rows<2>(tid, p, l, lds); if ((l) == 0) { for (int rc_ = 0; rc_ < 1 + REP_CVT; ++rc_) { MY_TID(t5); phase_convert(t5, p, (l) + 1, lds); } }        PH_END(1 + (l) * NPL + 10)
#ifndef NLAYERS_BUILD
#define NLAYERS_BUILD DEPTH
#endif
    LAYER(0)
    if constexpr (NLAYERS_BUILD > 1) { LAYER(1) }
    if constexpr (NLAYERS_BUILD > 2) { LAYER(2) }
    if constexpr (NLAYERS_BUILD > 3) { LAYER(3) }
}

#ifndef MK_SPLIT
#define MK_SPLIT 0
#endif
extern "C" void kernel_launch(void* const* d_in, const int* in_sizes, int n_in, void* d_out, int out_size, void* d_ws, size_t ws_size,
                              hipStream_t stream) {
    static int grid = 0;
    if (grid == 0) {
        if (n_in != 20 || out_size != NLAT * D || ws_size < WS_END) { fprintf(stderr, "kernel_launch: unexpected problem (n_in %d out %d ws %zu need %zu)\n", n_in, out_size, ws_size, (size_t)WS_END); grid = -1; return; }
        int dev = 0, cus = 0;
        if (hipGetDevice(&dev) != hipSuccess || hipDeviceGetAttribute(&cus, hipDeviceAttributeMultiprocessorCount, dev) != hipSuccess) { grid = -1; return; }
        if (hipFuncSetAttribute((const void*)mega_fwd, hipFuncAttributeMaxDynamicSharedMemorySize, LDS_BYTES) != hipSuccess) { fprintf(stderr, "kernel_launch: hipFuncSetAttribute failed\n"); grid = -1; return; }
        int per_cu = 0;
        if (hipOccupancyMaxActiveBlocksPerMultiprocessor(&per_cu, (const void*)mega_fwd, NTHR, LDS_BYTES) != hipSuccess || per_cu < 1) { fprintf(stderr, "kernel_launch: occupancy query says %d\n", per_cu); }
        (void)hipGetLastError();
        grid = cus;
    }
    if (grid < 0) return;
    (void)hipMemsetAsync((char*)d_ws + WS_CTL, 0, WS_LB - WS_CTL, stream);
    Args a{};
    a.p = make_params(d_in, d_out, d_ws);
#if MK_SPLIT
    for (int ph = 0; ph < NPH; ++ph) { a.ph_lo = ph; a.ph_hi = ph + 1; hipLaunchKernelGGL(mega_fwd, dim3(grid), dim3(NTHR), LDS_BYTES, stream, a); }
#else
    a.ph_lo = 0; a.ph_hi = NPH;
    hipLaunchKernelGGL(mega_fwd, dim3(grid), dim3(NTHR), LDS_BYTES, stream, a);
#endif
}
#endif
```

```cpp
#ifndef CPU_SIM
#include <hip/hip_runtime.h>
#define BODY __device__ __forceinline__
#define FSIN(x) __sinf(x)
#define FCOS(x) __cosf(x)
#else
#include <cmath>
#include <cstdio>
#include <cstdlib>
#include <cstring>
#define BODY static inline
#define FSIN(x) sinf(x)
#define FCOS(x) cosf(x)
#endif
#include <stdint.h>
#include <stddef.h>

#ifndef CFG_D
#define CFG_D 1024
#define CFG_SEQ 16384
#define CFG_CTX 256
#define CFG_EDIM 512
#define CFG_DEPTH 4
#endif

typedef unsigned short bf16_t;

constexpr int D = CFG_D, NB = 2, SEQ = CFG_SEQ, DEPTH = CFG_DEPTH, GW = 64, ROWS = SEQ / GW, CTX = CFG_CTX;
constexpr int HD = 64, NAH = 6, HGH = 6, CVD = 256, MIXD = 1024, INC = 3840, NMOD = 6 * D;
constexpr int NE = 16, ED = CFG_EDIM, CAPL = 2 * SEQ / NE, CAPC = 2 * CTX / NE;
constexpr int NLAT = NB * SEQ, NCTX = NB * CTX, NTOK = NLAT + NCTX;
constexpr int NSLOT_L = NB * NE * CAPL, NSLOT_C = NB * NE * CAPC, NSLOT = NSLOT_L + NSLOT_C;
constexpr int OQ = 0, OK_ = 384, OV = 768, OHQ = 1152, OFF_ = 1536, OFB = 1920, OHI = 2304, OHG_ = 2688, OCB = 3072, OCC = 3328, OCU = 3584;
constexpr float EPS = 1e-6f;
constexpr int NCH = (CTX + SEQ) / 64, NCHC = CTX / 64, NBH = NB * HGH;

struct Params {
    const float *x, *c, *ctx, *c_ctx, *w_mod, *b_mod, *norm1_w, *w_in, *q_norm, *k_norm, *rpb, *lb_logits, *hg_norm, *conv_w, *w_out,
        *norm2_w, *w_router, *w_gate, *w_up, *w_down;
    float *XL, *XC, *MOD, *LB, *AFF, *SVAL, *FG, *OHG;
    bf16_t *H, *P, *MIX, *HID, *Y;
    int *STOK, *INV;
    bf16_t *WIN_T, *WOUT_T, *WGU_T, *WD_T;
    unsigned* CTL;
    bf16_t* SLOC;
    float* GDEC;
    bf16_t* XB;
};

#ifndef CPU_SIM
#define AS4 __attribute__((address_space(4)))
typedef const AS4 Params& PRef;
#else
typedef const Params& PRef;
#endif
BODY float bf2f(bf16_t v) { return __builtin_bit_cast(float, (unsigned)v << 16); }
BODY bf16_t f2bf(float f) { unsigned u = __builtin_bit_cast(unsigned, f); u += 0x7fffu + ((u >> 16) & 1u); return (bf16_t)(u >> 16); }
BODY float silu_f(float x) { return x / (1.f + expf(-x)); }
BODY float sigmoid_f(float x) { return 1.f / (1.f + expf(-x)); }
BODY int modset(int r) { return r < NLAT ? r / SEQ : 2; }
BODY float* xrow(PRef p, int r) { return r < NLAT ? p.XL + (size_t)r * D : p.XC + (size_t)(r - NLAT) * D; }

BODY void b_adaln(long gid, PRef p, int) {
    const int n = (int)(gid % NMOD), s = (int)((gid / NMOD) % 3), l = (int)(gid / (3 * NMOD));
    const float* cv = s < 2 ? p.c + s * D : p.c_ctx;
    const float* w = p.w_mod + (size_t)l * D * NMOD + n;
    float acc = 0.f;
    for (int k = 0; k < D; ++k) acc += silu_f(cv[k]) * w[(size_t)k * NMOD];
    p.MOD[gid] = acc + p.b_mod[l * NMOD + n];
}
BODY void b_lb(long gid, PRef p, int) {
    const int dir = (int)(gid / 384), j = (int)(gid % 384);
    const float* lg = p.lb_logits + (size_t)dir * DEPTH * 384 + j;
    float m = -INFINITY;
    for (int l = 0; l < DEPTH; ++l) m = fmaxf(m, lg[l * 384]);
    float s = 0.f;
    for (int l = 0; l < DEPTH; ++l) s += expf(lg[l * 384] - m);
    float cum = 0.f;
    p.LB[(dir * DEPTH + 0) * 384 + j] = 0.f;
    for (int l = 1; l < DEPTH; ++l) { cum += expf(lg[l * 384] - m) / s; p.LB[(dir * DEPTH + l) * 384 + j] = cum; }
}
BODY void b_copyx(long gid, PRef p, int) {
    if (gid < (long)NLAT * D) p.XL[gid] = p.x[gid]; else p.XC[gid - (long)NLAT * D] = p.ctx[gid - (long)NLAT * D];
}
template <int WHICH> BODY void b_prenorm(long gid, PRef p, int l) {
    const int r = (int)gid;
    const float* xr = xrow(p, r);
    const float* nw = (WHICH ? p.norm2_w : p.norm1_w) + l * D;
    const float* mod = p.MOD + ((size_t)l * 3 + modset(r)) * NMOD;
    const float* shift = mod + (WHICH ? 3 : 0) * D;
    const float* scale = mod + (WHICH ? 4 : 1) * D;
    float ss = 0.f;
    for (int k = 0; k < D; ++k) ss += xr[k] * xr[k];
    const float rstd = 1.f / sqrtf(ss / D + EPS);
    float lg[NE];
#pragma unroll
    for (int e = 0; e < NE; ++e) lg[e] = 0.f;
    for (int k = 0; k < D; ++k) {
        const float h = xr[k] * rstd * nw[k] * (1.f + scale[k]) + shift[k];
        p.H[(size_t)r * D + k] = f2bf(h);
        if (WHICH) {
            const float* wr = p.w_router + ((size_t)l * D + k) * NE;
#pragma unroll
            for (int e = 0; e < NE; ++e) lg[e] += h * wr[e];
        }
    }
    if (WHICH) {
        float m = lg[0];
#pragma unroll
        for (int e = 1; e < NE; ++e) m = fmaxf(m, lg[e]);
        float s = 0.f;
#pragma unroll
        for (int e = 0; e < NE; ++e) { lg[e] = expf(lg[e] - m); s += lg[e]; }
#pragma unroll
        for (int e = 0; e < NE; ++e) p.AFF[(size_t)r * NE + e] = lg[e] / s;
    }
}
BODY void b_gemm_in(long gid, PRef p, int l) {
    const int r = (int)(gid / (INC / 4)), n = (int)(gid % (INC / 4)) * 4;
    const bf16_t* a = p.H + (size_t)r * D;
    const float* w = p.w_in + (size_t)l * D * INC + n;
    float a0 = 0.f, a1 = 0.f, a2 = 0.f, a3 = 0.f;
    for (int k = 0; k < D; ++k) { const float av = bf2f(a[k]); const float* wk = w + (size_t)k * INC; a0 += av * wk[0]; a1 += av * wk[1]; a2 += av * wk[2]; a3 += av * wk[3]; }
    bf16_t* o = p.P + (size_t)r * INC + n;
    o[0] = f2bf(a0); o[1] = f2bf(a1); o[2] = f2bf(a2); o[3] = f2bf(a3);
}
BODY void b_qkprep(long gid, PRef p, int l) {
    const int r = (int)(gid / 12), which = (int)(gid % 12) / 6, head = (int)(gid % 6);
    bf16_t* ptr = p.P + (size_t)r * INC + (which ? OK_ : OQ) + head * HD;
    const float* nw = (which ? p.k_norm : p.q_norm) + l * HD;
    float y[HD];
    float ss = 0.f;
#pragma unroll
    for (int d = 0; d < HD; ++d) { y[d] = bf2f(ptr[d]); ss += y[d] * y[d]; }
    const float rstd = 1.f / sqrtf(ss / HD + EPS);
#pragma unroll
    for (int d = 0; d < HD; ++d) y[d] = y[d] * rstd * nw[d];
    if (r < NLAT) {
        const int t = r % SEQ; const float row = (float)(t / GW), col = (float)(t % GW);
#pragma unroll
        for (int d = 0; d < 16; ++d) {
            const float inv = powf(10000.f, -(float)d / 16.f);
            const float ar = row * inv, ac = col * inv;
            const float cr = FCOS(ar), sr = FSIN(ar), cc = FCOS(ac), sc = FSIN(ac);
            const float x0 = y[d], x1 = y[d + 16], x2 = y[d + 32], x3 = y[d + 48];
            y[d] = x0 * cr - x1 * sr; y[d + 16] = x1 * cr + x0 * sr; y[d + 32] = x2 * cc - x3 * sc; y[d + 48] = x3 * cc + x2 * sc;
        }
    }
#pragma unroll
    for (int d = 0; d < HD; ++d) ptr[d] = f2bf(y[d]);
}
BODY void b_attn(long gid, PRef p, int l) {
    const int r = (int)(gid / NAH), head = (int)(gid % NAH);
    float q[HD], acc[HD];
    const bf16_t* qp = p.P + (size_t)r * INC + OQ + head * HD;
#pragma unroll
    for (int d = 0; d < HD; ++d) { q[d] = bf2f(qp[d]) * 0.125f; acc[d] = 0.f; }
    float m = -INFINITY, s = 0.f;
    const int b = r < NLAT ? r / SEQ : (r - NLAT) / CTX;
    const int nloc = r < NLAT ? 128 : 0;
    int row = 0, col = 0, rs = 0, ws = 0;
    if (r < NLAT) { const int t = r % SEQ; row = t / GW; col = t % GW; rs = row - 4; rs = rs < 0 ? 0 : (rs > ROWS - 8 ? ROWS - 8 : rs); ws = col - 8; ws = ws < 0 ? 0 : (ws > GW - 16 ? GW - 16 : ws); }
    for (int j = 0; j < nloc + CTX; ++j) {
        int kr; float bias = 0.f;
        if (j < nloc) { const int i = j / 16, jj = j % 16; kr = b * SEQ + (rs + i) * GW + ws + jj; bias = p.rpb[(((size_t)l * NAH + head) * 15 + (rs + i - row + 7)) * 31 + (ws + jj - col + 15)]; }
        else kr = NLAT + b * CTX + (j - nloc);
        const bf16_t* kp = p.P + (size_t)kr * INC + OK_ + head * HD;
        const bf16_t* vp = p.P + (size_t)kr * INC + OV + head * HD;
        float sc = 0.f;
#pragma unroll
        for (int d = 0; d < HD; ++d) sc += q[d] * bf2f(kp[d]);
        sc += bias;
        const float mn = fmaxf(m, sc), corr = expf(m - mn), pj = expf(sc - mn);
        s = s * corr + pj;
#pragma unroll
        for (int d = 0; d < HD; ++d) acc[d] = acc[d] * corr + pj * bf2f(vp[d]);
        m = mn;
    }
    const float inv = 1.f / s;
    bf16_t* o = p.MIX + (size_t)r * MIXD + head * HD;
#pragma unroll
    for (int d = 0; d < HD; ++d) o[d] = f2bf(acc[d] * inv);
}
BODY void b_gates(long gid, PRef p, int l) {
    const int j = (int)(gid % 384), dir = (int)((gid / 384) % 2), r = (int)(gid / 768);
    const float z = bf2f(p.P[(size_t)r * INC + (dir ? OFB : OFF_) + j]);
    const float lbv = p.LB[(dir * DEPTH + l) * 384 + j];
    p.FG[gid] = lbv + (1.f - lbv) * sigmoid_f(z);
}
template <int DIR> BODY void b_hgrn_seq(long gid, PRef p, int) {
    const int v = (int)(gid % 64), h = (int)((gid / 64) % HGH), b = (int)(gid / (64 * HGH));
    float S[64];
#pragma unroll
    for (int k = 0; k < 64; ++k) S[k] = 0.f;
    for (int step = 0; step < CTX + SEQ; ++step) {
        int r;
        if (step < CTX) r = NLAT + b * CTX + (DIR ? CTX - 1 - step : step);
        else r = b * SEQ + (DIR ? SEQ - 1 - (step - CTX) : (step - CTX));
        const float vv = bf2f(p.P[(size_t)r * INC + OHI + h * 64 + v]);
        const float* fr = p.FG + ((size_t)r * 2 + DIR) * 384 + h * 64;
        const bf16_t* qr = p.P + (size_t)r * INC + OHQ + h * 64;
        float o = 0.f;
#pragma unroll
        for (int k = 0; k < 64; ++k) { const float f = fr[k]; S[k] = f * S[k] + (1.f - f) * vv; o += S[k] * bf2f(qr[k]); }
        o *= 0.125f;
        p.OHG[((size_t)DIR * NTOK + r) * 384 + h * 64 + v] = o;
    }
}
BODY void b_hgfin(long gid, PRef p, int l) {
    const int r = (int)(gid / HGH), h = (int)(gid % HGH);
    const float* op = p.OHG + (size_t)r * 384 + h * 64;
    const float* op1 = op + (size_t)NTOK * 384;
    float o[64]; float ss = 0.f;
#pragma unroll
    for (int v = 0; v < 64; ++v) { o[v] = op[v] + op1[v]; ss += o[v] * o[v]; }
    const float rstd = 1.f / sqrtf(ss / 64.f + EPS);
    const bf16_t* g = p.P + (size_t)r * INC + OHG_ + h * 64;
    bf16_t* out = p.MIX + (size_t)r * MIXD + 384 + h * 64;
#pragma unroll
    for (int v = 0; v < 64; ++v) out[v] = f2bf(o[v] * rstd * p.hg_norm[l * 64 + v] * silu_f(bf2f(g[v])));
}
BODY void b_conv(long gid, PRef p, int l) {
    const int ch = (int)(gid % CVD), r = (int)(gid / CVD);
    int t, T;
    if (r < NLAT) { t = r % SEQ; T = SEQ; } else { t = (r - NLAT) % CTX; T = CTX; }
    const float* w = p.conv_w + (size_t)l * 3 * CVD + ch;
    float y = 0.f;
    for (int j = 0; j < 3; ++j) {
        const int tt = t + j - 1;
        if (tt < 0 || tt >= T) continue;
        const bf16_t* pr = p.P + (size_t)(r + j - 1) * INC;
        y += w[j * CVD] * bf2f(pr[OCC + ch]) * bf2f(pr[OCU + ch]);
    }
    p.MIX[(size_t)r * MIXD + 768 + ch] = f2bf(bf2f(p.P[(size_t)r * INC + OCB + ch]) * y);
}
BODY void b_gemm_out(long gid, PRef p, int l) {
    const int r = (int)(gid / (D / 4)), n = (int)(gid % (D / 4)) * 4;
    const bf16_t* a = p.MIX + (size_t)r * MIXD;
    const float* w = p.w_out + (size_t)l * MIXD * D + n;
    float a0 = 0.f, a1 = 0.f, a2 = 0.f, a3 = 0.f;
    for (int k = 0; k < MIXD; ++k) { const float av = bf2f(a[k]); const float* wk = w + (size_t)k * D; a0 += av * wk[0]; a1 += av * wk[1]; a2 += av * wk[2]; a3 += av * wk[3]; }
    const float* g = p.MOD + ((size_t)l * 3 + modset(r)) * NMOD + 2 * D + n;
    float* xr = xrow(p, r) + n;
    xr[0] += g[0] * a0; xr[1] += g[1] * a1; xr[2] += g[2] * a2; xr[3] += g[3] * a3;
}
BODY void b_rank(long gid, PRef p, int) {
    const int e = (int)(gid % NE), r = (int)(gid / NE);
    int t, T, row0, cap, base;
    if (r < NLAT) { const int b = r / SEQ; t = r % SEQ; T = SEQ; row0 = b * SEQ; cap = CAPL; base = (b * NE + e) * CAPL; }
    else { const int b = (r - NLAT) / CTX; t = (r - NLAT) % CTX; T = CTX; row0 = NLAT + b * CTX; cap = CAPC; base = NSLOT_L + (b * NE + e) * CAPC; }
    const float a = p.AFF[(size_t)r * NE + e];
    const float* col = p.AFF + (size_t)row0 * NE + e;
    int rank = 0;
    for (int tt = 0; tt < T; ++tt) { const float o = col[(size_t)tt * NE]; rank += (o > a || (o == a && tt < t)) ? 1 : 0; }
    if (rank < cap) { p.STOK[base + rank] = r; p.SVAL[base + rank] = a; p.INV[(size_t)r * NE + e] = base + rank; }
    else p.INV[(size_t)r * NE + e] = -1;
}
BODY int slot_expert(int s) { return s < NSLOT_L ? (s / CAPL) % NE : ((s - NSLOT_L) / CAPC) % NE; }
BODY void b_moe1(long gid, PRef p, int l) {
    const int s = (int)(gid / (ED / 4)), f = (int)(gid % (ED / 4)) * 4;
    const int e = slot_expert(s); int row = p.STOK[s]; row = row < 0 ? 0 : (row >= NTOK ? NTOK - 1 : row);
    const bf16_t* a = p.H + (size_t)row * D;
    const float* wg = p.w_gate + ((size_t)l * NE + e) * D * ED + f;
    const float* wu = p.w_up + ((size_t)l * NE + e) * D * ED + f;
    float g0 = 0.f, g1 = 0.f, g2 = 0.f, g3 = 0.f, u0 = 0.f, u1 = 0.f, u2 = 0.f, u3 = 0.f;
    for (int k = 0; k < D; ++k) {
        const float av = bf2f(a[k]); const float* gk = wg + (size_t)k * ED; const float* uk = wu + (size_t)k * ED;
        g0 += av * gk[0]; g1 += av * gk[1]; g2 += av * gk[2]; g3 += av * gk[3];
        u0 += av * uk[0]; u1 += av * uk[1]; u2 += av * uk[2]; u3 += av * uk[3];
    }
    bf16_t* o = p.HID + (size_t)s * ED + f;
    o[0] = f2bf(silu_f(g0) * u0); o[1] = f2bf(silu_f(g1) * u1); o[2] = f2bf(silu_f(g2) * u2); o[3] = f2bf(silu_f(g3) * u3);
}
BODY void b_moe2(long gid, PRef p, int l) {
    const int s = (int)(gid / (D / 4)), n = (int)(gid % (D / 4)) * 4;
    const int e = slot_expert(s);
    const bf16_t* a = p.HID + (size_t)s * ED;
    const float* w = p.w_down + ((size_t)l * NE + e) * ED * D + n;
    float a0 = 0.f, a1 = 0.f, a2 = 0.f, a3 = 0.f;
    for (int k = 0; k < ED; ++k) { const float av = bf2f(a[k]); const float* wk = w + (size_t)k * D; a0 += av * wk[0]; a1 += av * wk[1]; a2 += av * wk[2]; a3 += av * wk[3]; }
    const float val = p.SVAL[s];
    bf16_t* o = p.Y + (size_t)s * D + n;
    o[0] = f2bf(val * a0); o[1] = f2bf(val * a1); o[2] = f2bf(val * a2); o[3] = f2bf(val * a3);
}
BODY void b_combine(long gid, PRef p, int l) {
    const int r = (int)(gid / (D / 4)), n = (int)(gid % (D / 4)) * 4;
    float a0 = 0.f, a1 = 0.f, a2 = 0.f, a3 = 0.f;
    for (int e = 0; e < NE; ++e) {
        const int s = p.INV[(size_t)r * NE + e];
        if (s >= 0) { const bf16_t* y = p.Y + (size_t)s * D + n; a0 += bf2f(y[0]); a1 += bf2f(y[1]); a2 += bf2f(y[2]); a3 += bf2f(y[3]); }
    }
    const float* g = p.MOD + ((size_t)l * 3 + modset(r)) * NMOD + 5 * D + n;
    float* xr = xrow(p, r) + n;
    xr[0] += g[0] * a0; xr[1] += g[1] * a1; xr[2] += g[2] * a2; xr[3] += g[3] * a3;
}


#ifndef HGRN_DIAG
#define HGRN_DIAG 0
#endif
BODY void b_hgrn_chunkseq(long gid, PRef p, int l) {
    const int v = (int)(gid % 64), pc = (int)((gid / 64) % NCH), bh = (int)((gid / (64 * NCH)) % NBH), dir = (int)(gid / (64L * NCH * NBH));
    const int h = bh % HGH, b = bh / HGH, row0 = pc < NCHC ? NLAT + b * CTX + pc * 64 : b * SEQ + (pc - NCHC) * 64;
    const bf16_t* sin = p.SLOC + ((size_t)(dir * NBH + bh) * NCH + pc) * 4096 + v * 64;
    float S[64];
#pragma unroll
    for (int k = 0; k < 64; ++k) S[k] = bf2f(sin[k]);
    for (int i = 0; i < 64; ++i) {
        const int r = row0 + (dir ? 63 - i : i);
        const float vv = bf2f(p.P[(size_t)r * INC + OHI + h * 64 + v]);
        const bf16_t* zr = p.P + (size_t)r * INC + (dir ? OFB : OFF_) + h * 64;
        const bf16_t* qr = p.P + (size_t)r * INC + OHQ + h * 64;
        const float* lb = p.LB + (size_t)(dir * DEPTH + l) * 384 + h * 64;
        float o = 0.f;
#pragma unroll
        for (int k = 0; k < 64; ++k) { const float f = lb[k] + (1.f - lb[k]) * sigmoid_f(bf2f(zr[k])); S[k] = f * S[k] + (1.f - f) * vv; o += S[k] * bf2f(qr[k]); }
        p.OHG[((size_t)dir * NTOK + r) * 384 + h * 64 + v] = o * 0.125f;
    }
}

BODY void b_hgrn_scan_slow(long gid, PRef p, int) {
    const int e = (int)(gid % 4096), sq = (int)(gid / 4096), dir = sq / NBH, k = e & 63;
    bf16_t* S = p.SLOC + (size_t)sq * NCH * 4096 + e;
    const float* G = p.GDEC + (size_t)sq * NCH * 64 + k;
    float c = 0.f;
    for (int j = 0; j < NCH; ++j) {
        const int pc = dir ? (j < NCHC ? NCHC - 1 - j : NCH + NCHC - 1 - j) : j;
        const float x = bf2f(S[(size_t)pc * 4096]);
        S[(size_t)pc * 4096] = f2bf(c);
        c = G[(size_t)pc * 64] * c + x;
    }
}

BODY void b_hgrn_local_slow(long gid, PRef p, int l) {
    const int v = (int)(gid % 64), pc = (int)((gid / 64) % NCH), bh = (int)((gid / (64 * NCH)) % NBH), dir = (int)(gid / (64L * NCH * NBH));
    const int h = bh % HGH, b = bh / HGH, row0 = pc < NCHC ? NLAT + b * CTX + pc * 64 : b * SEQ + (pc - NCHC) * 64;
    float S[64], g[64];
#pragma unroll
    for (int k = 0; k < 64; ++k) { S[k] = 0.f; g[k] = 1.f; }
    for (int i = 0; i < 64; ++i) {
        const int r = row0 + (dir ? 63 - i : i);
        const float vv = bf2f(p.P[(size_t)r * INC + OHI + h * 64 + v]);
        const bf16_t* zr = p.P + (size_t)r * INC + (dir ? OFB : OFF_) + h * 64;
        const float* lb = p.LB + (size_t)(dir * DEPTH + l) * 384 + h * 64;
#pragma unroll
        for (int k = 0; k < 64; ++k) { const float f = lb[k] + (1.f - lb[k]) * sigmoid_f(bf2f(zr[k])); S[k] = f * S[k] + (1.f - f) * vv; g[k] *= f; }
    }
    bf16_t* dst = p.SLOC + ((size_t)(dir * NBH + bh) * NCH + pc) * 4096 + v * 64;
    if (HGRN_DIAG != 3 && HGRN_DIAG != 4) {
#pragma unroll
    for (int k = 0; k < 64; ++k) dst[k] = f2bf(S[k]);
    }
    if (v == 0) {
        float* gd = p.GDEC + ((size_t)(dir * NBH + bh) * NCH + pc) * 64;
#pragma unroll
        for (int k = 0; k < 64; ++k) gd[k] = g[k];
    }
}
#ifndef FAST_TOPK
#define FAST_TOPK 1
#endif
#ifndef FAST_HGRN
#define FAST_HGRN 1
#endif
#ifndef FAST_ATTN
#define FAST_ATTN 1
#endif
constexpr size_t al256(size_t x) { return (x + 255) & ~(size_t)255; }
constexpr size_t CTL_BYTES = 65536;
constexpr size_t WS_CTL = 0;
constexpr size_t WS_MOD = WS_CTL + CTL_BYTES;
constexpr size_t WS_LB = WS_MOD + al256((size_t)DEPTH * 3 * NMOD * 4);
constexpr size_t WS_XC = WS_LB + al256((size_t)2 * DEPTH * 384 * 4);
constexpr size_t WS_AFF = WS_XC + al256((size_t)NCTX * D * 4);
constexpr size_t WS_SVAL = WS_AFF + al256((size_t)NTOK * NE * 4);
constexpr size_t WS_STOK = WS_SVAL + al256((size_t)NSLOT * 4);
constexpr size_t WS_INV = WS_STOK + al256((size_t)NSLOT * 4);
constexpr size_t WS_H = WS_INV + al256((size_t)NTOK * NE * 4);
constexpr size_t WS_MIX = WS_H + al256((size_t)NTOK * D * 2);
constexpr size_t WS_P = WS_MIX + al256((size_t)NTOK * MIXD * 2);
constexpr size_t WS_HID = WS_P;
constexpr size_t WS_Y = WS_HID + al256((size_t)NSLOT * ED * 2);
constexpr size_t WS_P_END0 = WS_P + al256((size_t)NTOK * INC * 2);
constexpr size_t WS_P_END1 = WS_Y + al256((size_t)NSLOT * D * 2);
constexpr size_t WS_WB = WS_P_END0 > WS_P_END1 ? WS_P_END0 : WS_P_END1;
constexpr size_t WS_WIN_T = WS_WB;
constexpr size_t WS_WOUT_T = WS_WIN_T + al256((size_t)INC * D * 2);
constexpr size_t WS_WGU_T = WS_WOUT_T + al256((size_t)D * MIXD * 2);
constexpr size_t WS_WD_T = WS_WGU_T + al256((size_t)NE * 2 * ED * D * 2);
constexpr size_t WB_BYTES = WS_WD_T + al256((size_t)NE * D * ED * 2) - WS_WB;
constexpr size_t WS_T = WS_WB + 2 * WB_BYTES;
#if FAST_HGRN
constexpr size_t WS_SLOC = WS_T;
constexpr size_t WS_GDEC = WS_SLOC + al256((size_t)2 * NBH * NCH * 4096 * 2);
constexpr size_t WS_OHG = WS_GDEC + al256((size_t)2 * NBH * NCH * 64 * 4);
constexpr size_t WS_XB = WS_OHG + (HGRN_DIAG ? al256((size_t)2 * NTOK * 384 * 4) : 0);
constexpr size_t WS_END = WS_XB + al256((size_t)NLAT * D * 2);
constexpr size_t WS_FG = WS_T;
#else
constexpr size_t WS_FG = WS_T;
constexpr size_t WS_OHG = WS_FG + al256((size_t)NTOK * 768 * 4);
constexpr size_t WS_SLOC = WS_OHG + al256((size_t)2 * NTOK * 384 * 4);
constexpr size_t WS_GDEC = WS_SLOC;
constexpr size_t WS_XB = WS_SLOC;
constexpr size_t WS_END = WS_XB + al256((size_t)NLAT * D * 2);
#endif

static inline Params make_params(void* const* d_in, void* d_out, void* d_ws) {
    Params p{};
    const float** f = (const float**)&p;
    for (int i = 0; i < 20; ++i) f[i] = (const float*)d_in[i];
    char* ws = (char*)d_ws;
    p.XL = (float*)d_out; p.XC = (float*)(ws + WS_XC); p.MOD = (float*)(ws + WS_MOD); p.LB = (float*)(ws + WS_LB); p.AFF = (float*)(ws + WS_AFF);
    p.SVAL = (float*)(ws + WS_SVAL); p.FG = (float*)(ws + WS_FG); p.OHG = (float*)(ws + WS_OHG);
    p.H = (bf16_t*)(ws + WS_H); p.P = (bf16_t*)(ws + WS_P); p.MIX = (bf16_t*)(ws + WS_MIX); p.HID = (bf16_t*)(ws + WS_HID); p.Y = (bf16_t*)(ws + WS_Y);
    p.STOK = (int*)(ws + WS_STOK); p.INV = (int*)(ws + WS_INV);
    p.WIN_T = (bf16_t*)(ws + WS_WIN_T); p.WOUT_T = (bf16_t*)(ws + WS_WOUT_T); p.WGU_T = (bf16_t*)(ws + WS_WGU_T); p.WD_T = (bf16_t*)(ws + WS_WD_T);
    p.CTL = (unsigned*)(ws + WS_CTL); p.SLOC = (bf16_t*)(ws + WS_SLOC); p.GDEC = (float*)(ws + WS_GDEC); p.XB = (bf16_t*)(ws + WS_XB);
    return p;
}

#define FORWARD_STAGES(STAGE)                                                      \
    STAGE(b_adaln, (long)DEPTH * 3 * NMOD, 0)                                      \
    STAGE(b_lb, 2L * 384, 0)                                                       \
    STAGE(b_copyx, (long)NTOK * D, 0)                                              \
    for (int l = 0; l < DEPTH; ++l) {                                              \
        STAGE(b_prenorm<0>, (long)NTOK, l)                                         \
        STAGE(b_gemm_in, (long)NTOK * (INC / 4), l)                                \
        STAGE(b_qkprep, (long)NTOK * 12, l)                                        \
        STAGE(b_attn, (long)NTOK * NAH, l)                                         \
        STAGE(b_gates, (long)NTOK * 768, l)                                        \
        STAGE(b_hgrn_seq<0>, (long)NB * HGH * 64, l)                               \
        STAGE(b_hgrn_seq<1>, (long)NB * HGH * 64, l)                               \
        STAGE(b_hgfin, (long)NTOK * HGH, l)                                        \
        STAGE(b_conv, (long)NTOK * CVD, l)                                         \
        STAGE(b_gemm_out, (long)NTOK * (D / 4), l)                                 \
        STAGE(b_prenorm<1>, (long)NTOK, l)                                         \
        STAGE(b_rank, (long)NTOK * NE, l)                                          \
        STAGE(b_moe1, (long)NSLOT * (ED / 4), l)                                   \
        STAGE(b_moe2, (long)NSLOT * (D / 4), l)                                    \
        STAGE(b_combine, (long)NTOK * (D / 4), l)                                  \
    }

#ifndef CPU_SIM
#include <cstdio>
#define LAS __attribute__((address_space(3)))
#define GAS __attribute__((address_space(1)))
typedef short bf16x8 __attribute__((ext_vector_type(8)));
typedef float f32x4 __attribute__((ext_vector_type(4)));
typedef float f32x2 __attribute__((ext_vector_type(2)));
typedef unsigned u32x4 __attribute__((ext_vector_type(4)));
typedef unsigned u32x2 __attribute__((ext_vector_type(2)));
constexpr int NWAVES = 8, NTHR = 512;
constexpr int RING_BYTES = 131072, LDSCTL_OFF = RING_BYTES, MISC_OFF = LDSCTL_OFF + 320, TAB_OFF = LDSCTL_OFF + 1024  , LDS_BYTES = 147456;

typedef __bf16 bf16v2_t __attribute__((ext_vector_type(2)));
__device__ __forceinline__ unsigned cvt_pk_bf16_asm(float lo, float hi) { unsigned r; asm volatile("v_cvt_pk_bf16_f32 %0, %1, %2" : "=v"(r) : "v"(lo), "v"(hi)); return r; }
__device__ __forceinline__ unsigned cvt_pk_bf16(float lo, float hi) { bf16v2_t v = {(__bf16)lo, (__bf16)hi}; return __builtin_bit_cast(unsigned, v); }
#define DPPF(x, ctrl) __builtin_bit_cast(float, __builtin_amdgcn_update_dpp(0, __builtin_bit_cast(int, (x)), (ctrl), 0xF, 0xF, true))
#define DPP_X1 0xB1
#define DPP_X2 0x4E
#define DPP_HM 0x141
#define DPP_RM 0x140
__device__ __forceinline__ float x16_other(float x, int lane) { const unsigned u = __builtin_bit_cast(unsigned, x); const auto r = __builtin_amdgcn_permlane16_swap(u, u, false, false); return __builtin_bit_cast(float, (lane & 16) ? r[0] : r[1]); }
__device__ __forceinline__ float x32_other(float x, int lane) { const unsigned u = __builtin_bit_cast(unsigned, x); const auto r = __builtin_amdgcn_permlane32_swap(u, u, false, false); return __builtin_bit_cast(float, (lane & 32) ? r[0] : r[1]); }
__device__ __forceinline__ float x16_sum(float x, int lane) { return x + x16_other(x, lane); }
__device__ __forceinline__ float x32_sum(float x, int lane) { return x + x32_other(x, lane); }
__device__ __forceinline__ float x16_max(float x, int lane) { return fmaxf(x, x16_other(x, lane)); }
__device__ __forceinline__ float x32_max(float x, int lane) { return fmaxf(x, x32_other(x, lane)); }
__device__ __forceinline__ float row16_sum(float v) { v += DPPF(v, DPP_X1); v += DPPF(v, DPP_X2); v += DPPF(v, DPP_HM); v += DPPF(v, DPP_RM); return v; }
__device__ __forceinline__ float row16_max(float v) { v = fmaxf(v, DPPF(v, DPP_X1)); v = fmaxf(v, DPPF(v, DPP_X2)); v = fmaxf(v, DPPF(v, DPP_HM)); v = fmaxf(v, DPPF(v, DPP_RM)); return v; }
__device__ __forceinline__ float oct_sum(float v) { v += DPPF(v, DPP_X1); v += DPPF(v, DPP_X2); v += DPPF(v, DPP_HM); return v; }
__device__ __forceinline__ float wave_sum(float v, int lane) { return x32_sum(x16_sum(row16_sum(v), lane), lane); }

extern __shared__ __attribute__((aligned(16))) unsigned char lds_raw[];
#ifndef FUSE_QK
#define FUSE_QK 1
#endif
__device__ __forceinline__ float bfw(unsigned w, int hi) { return __builtin_bit_cast(float, hi ? (w & 0xffff0000u) : (w << 16)); }
__device__ __forceinline__ float bf8(const u32x4& v, int j) { return bfw(v[j >> 1], j & 1); }
namespace pg8 {
constexpr int BM = 256, BK = 64, HALF = 128, HTB = HALF * BK * 2, STAGE_BYTES = 8 * HTB, NXCD = 8, WGM = 8;
__device__ __forceinline__ int lds_byte(int r, int c) { const int st = (r >> 4) * 2 + (c >> 5), rr = r & 15, cc = c & 31, ob = rr * 64 + cc * 2; return st * 1024 + (ob ^ (((ob >> 9) & 1) << 5)); }
__device__ __forceinline__ void stage_rc(int b, int& R, int& C) { const int st = b / 1024, sb = b % 1024, swz = sb ^ (((sb >> 9) & 1) << 5); R = (st >> 1) * 16 + swz / 64; C = (st & 1) * 32 + (swz % 64) / 2; }
__device__ __forceinline__ int perm32(int rho) { const int n = rho >> 4, i = rho & 15; return 8 * (i >> 2) + 4 * n + (i & 3); }
struct Unit { int pm, pn; };
struct Gemm {
    const bf16_t* A; const bf16_t* Bt; int M, N, K;
    const int* gather;
    int gt, ng; size_t gstride;
};
struct StaticOrder {
    int nM, nN, nwg, G, c;
    __device__ void init(int M, int N, int G_, int c_) { nM = M / BM; nN = N / BM; nwg = nM * nN; G = G_; c = c_; }
    __device__ bool next(int i, Unit& u) const {
        const long L = (long)i * G + c; if (L >= nwg) return false;
        int wgid = (int)L; { const int q = nwg / NXCD, r = nwg % NXCD, xcd = wgid % NXCD, off = wgid / NXCD; wgid = (xcd < r ? xcd * (q + 1) : r * (q + 1) + (xcd - r) * q) + off; }
        const int nig = WGM * nN, gid = wgid / nig, fm = gid * WGM, gsz = (nM - fm) < WGM ? (nM - fm) : WGM;
        u.pm = fm + ((wgid % nig) % gsz); u.pn = (wgid % nig) / gsz; return true;
    }
};
struct EpiBf16 {
    static constexpr bool PERM = true;
    bf16_t* O; int ldc; const float* rowscale; int skip;
    __device__ __forceinline__ void operator()(const f32x4 (&acc)[2][2][4][2], const Unit& u, int wr, int wc, int fr, int fq) const {
        const int row0 = u.pm * BM + wr * 64 + fr, col0 = u.pn * BM + wc * 32 + 8 * fq;
        if (skip) { asm volatile("" :: "v"(acc[0][0][0][0]), "v"(acc[1][1][3][1])); return; }
        float scv[2][4];
#pragma unroll
        for (int ai = 0; ai < 2; ++ai)
#pragma unroll
            for (int m = 0; m < 4; ++m) scv[ai][m] = rowscale ? rowscale[row0 + ai * HALF + m * 16] : 1.f;
        asm volatile("" ::: "memory");
#pragma unroll
        for (int ai = 0; ai < 2; ++ai)
#pragma unroll
            for (int m = 0; m < 4; ++m) { const int row = row0 + ai * HALF + m * 16; bf16_t* rowp = O + (size_t)row * ldc + col0; const float sc = scv[ai][m];
#pragma unroll
                for (int bj = 0; bj < 2; ++bj) { const f32x4 v0 = acc[ai][bj][m][0] * sc, v1 = acc[ai][bj][m][1] * sc;
                    u32x4 w; w.x = cvt_pk_bf16_asm(v0[0], v0[1]); w.y = cvt_pk_bf16_asm(v0[2], v0[3]); w.z = cvt_pk_bf16_asm(v1[0], v1[1]); w.w = cvt_pk_bf16_asm(v1[2], v1[3]);
                    *(u32x4*)(rowp + bj * HALF) = w; } }
    }
};
struct EpiP {
    static constexpr bool PERM = true;
    bf16_t* O; int ldc; const float* qn; const float* kn; int skip;
    __device__ __forceinline__ void operator()(const f32x4 (&acc)[2][2][4][2], const Unit& u, int wr, int wc, int fr, int fq) const {
        const int row0 = u.pm * BM + wr * 64 + fr, col0 = u.pn * BM + wc * 32 + 8 * fq;
        if (skip) { asm volatile("" :: "v"(acc[0][0][0][0]), "v"(acc[1][1][3][1])); return; }
        if (u.pn >= 3 || !FUSE_QK) {
#pragma unroll
            for (int ai = 0; ai < 2; ++ai)
#pragma unroll
                for (int m = 0; m < 4; ++m) { bf16_t* rowp = O + (size_t)(row0 + ai * HALF + m * 16) * ldc + col0;
#pragma unroll
                    for (int bj = 0; bj < 2; ++bj) { const f32x4 v0 = acc[ai][bj][m][0], v1 = acc[ai][bj][m][1];
                        u32x4 w; w.x = cvt_pk_bf16_asm(v0[0], v0[1]); w.y = cvt_pk_bf16_asm(v0[2], v0[3]); w.z = cvt_pk_bf16_asm(v1[0], v1[1]); w.w = cvt_pk_bf16_asm(v1[2], v1[3]);
                        *(u32x4*)(rowp + bj * HALF) = w; } }
            return;
        }
        LAS float* PS = (LAS float*)((LAS unsigned char*)lds_raw + LDSCTL_OFF + 4096);
        const int half = wc & 1, hw = wc >> 1;
        unsigned lm_ = ~0u; asm volatile("" : "+s"(lm_)); const int lane = (int)__builtin_amdgcn_mbcnt_hi(lm_, __builtin_amdgcn_mbcnt_lo(lm_, 0u));
#pragma unroll
        for (int ai = 0; ai < 2; ++ai)
#pragma unroll
            for (int m = 0; m < 4; ++m)
#pragma unroll
                for (int bj = 0; bj < 2; ++bj) { const f32x4 v0 = acc[ai][bj][m][0], v1 = acc[ai][bj][m][1];
                    float s = (v0[0] * v0[0] + v0[1] * v0[1]) + (v0[2] * v0[2] + v0[3] * v0[3]) + (v1[0] * v1[0] + v1[1] * v1[1]) + (v1[2] * v1[2] + v1[3] * v1[3]);
                    s = x32_sum(x16_sum(s, lane), lane);
                    if (fq == 0) PS[((ai * HALF + wr * 64 + m * 16 + fr) * 4 + 2 * bj + hw) * 2 + half] = s; }
        asm volatile("s_waitcnt lgkmcnt(0)" ::: "memory"); __builtin_amdgcn_s_barrier(); asm volatile("" ::: "memory");
        float invf[8];
#pragma unroll
        for (int j = 0; j < 8; ++j) invf[j] = __builtin_amdgcn_exp2f(-(float)(8 * (fq & 1) + j) * (13.287712379549449f / 16.f));
        const bool second = (fq & 2) != 0;
        f32x4 nwv[2][2];
#pragma unroll
        for (int bj = 0; bj < 2; ++bj) { const bool isk = (u.pn * BM + bj * HALF + wc * 32) >= 384; const float* nw = (isk ? kn : qn) + 32 * half + 8 * fq; nwv[bj][0] = *(const f32x4*)nw; nwv[bj][1] = *(const f32x4*)(nw + 4); }
        asm volatile("" ::: "memory");
#pragma unroll
        for (int ai = 0; ai < 2; ++ai)
#pragma unroll
            for (int m = 0; m < 4; ++m) {
                const int grow = row0 + ai * HALF + m * 16; const bool lat = grow < NLAT; const int t = lat ? grow % SEQ : 0;
                int tp = half ? t % GW : t / GW; asm volatile("" : "+v"(tp));
                const float pos = (float)tp;
                float cs[8], sn[8];
#pragma unroll
                for (int j = 0; j < 8; ++j) { const float ang = pos * invf[j]; cs[j] = __cosf(ang); sn[j] = __sinf(ang); }
                bf16_t* rowp = O + (size_t)grow * ldc + col0;
#pragma unroll
                for (int bj = 0; bj < 2; ++bj) {
                    const int rl = ai * HALF + wr * 64 + m * 16 + fr, head = 2 * bj + hw;
                    const float ssq = PS[(rl * 4 + head) * 2] + PS[(rl * 4 + head) * 2 + 1];
                    const bool isk = (u.pn * BM + bj * HALF + wc * 32) >= 384;
                    const float rstd = (isk ? 1.f : 0.125f * 1.44269504089f) / sqrtf(ssq * (1.f / HD) + EPS);
                    const f32x4 n0 = nwv[bj][0], n1 = nwv[bj][1];
                    float y[8];
#pragma unroll
                    for (int j = 0; j < 4; ++j) { y[j] = acc[ai][bj][m][0][j] * rstd * n0[j]; y[4 + j] = acc[ai][bj][m][1][j] * rstd * n1[j]; }
#pragma unroll
                    for (int j = 0; j < 8; ++j) {
                        const unsigned yb = __builtin_bit_cast(unsigned, y[j]);
                        const auto sw = __builtin_amdgcn_permlane32_swap(yb, yb, false, false);
                        const float other = __builtin_bit_cast(float, lane < 32 ? sw[1] : sw[0]);
                        const float rot = second ? y[j] * cs[j] + other * sn[j] : y[j] * cs[j] - other * sn[j];
                        y[j] = lat ? rot : y[j];
                    }
                    u32x4 w; w.x = cvt_pk_bf16(y[0], y[1]); w.y = cvt_pk_bf16(y[2], y[3]); w.z = cvt_pk_bf16(y[4], y[5]); w.w = cvt_pk_bf16(y[6], y[7]);
                    *(u32x4*)(rowp + bj * HALF) = w;
                }
                asm volatile("" ::: "memory");
            }
    }
};
struct EpiRes {
    static constexpr bool PERM = true;
    bf16_t* X; int ldc; const float* gate0; int rows_per_set; size_t set_stride;
    __device__ __forceinline__ void operator()(const f32x4 (&acc)[2][2][4][2], const Unit& u, int wr, int wc, int fr, int fq) const {
        const int row0 = u.pm * BM + wr * 64 + fr, col0 = u.pn * BM + wc * 32 + 8 * fq;
        const float* gate = gate0 + (size_t)((u.pm * BM) / rows_per_set) * set_stride;
        f32x4 gv[2][2];
#pragma unroll
        for (int bj = 0; bj < 2; ++bj)
#pragma unroll
            for (int n = 0; n < 2; ++n) gv[bj][n] = *(const f32x4*)(gate + col0 + bj * HALF + n * 4);
        u32x4 rv[2][4][2];
#pragma unroll
        for (int ai = 0; ai < 2; ++ai)
#pragma unroll
            for (int m = 0; m < 4; ++m)
#pragma unroll
                for (int bj = 0; bj < 2; ++bj) rv[ai][m][bj] = *(const u32x4*)(X + (size_t)(row0 + ai * HALF + m * 16) * ldc + col0 + bj * HALF);
        asm volatile("" ::: "memory");
#pragma unroll
        for (int ai = 0; ai < 2; ++ai)
#pragma unroll
            for (int m = 0; m < 4; ++m) { bf16_t* rowp = X + (size_t)(row0 + ai * HALF + m * 16) * ldc + col0;
#pragma unroll
                for (int bj = 0; bj < 2; ++bj) { const u32x4 r = rv[ai][m][bj];
                    const f32x4 x0 = (f32x4){bfw(r.x, 0), bfw(r.x, 1), bfw(r.y, 0), bfw(r.y, 1)}, x1 = (f32x4){bfw(r.z, 0), bfw(r.z, 1), bfw(r.w, 0), bfw(r.w, 1)};
                    const f32x4 v0 = x0 + gv[bj][0] * acc[ai][bj][m][0], v1 = x1 + gv[bj][1] * acc[ai][bj][m][1];
                    u32x4 w; w.x = cvt_pk_bf16_asm(v0[0], v0[1]); w.y = cvt_pk_bf16_asm(v0[2], v0[3]); w.z = cvt_pk_bf16_asm(v1[0], v1[1]); w.w = cvt_pk_bf16_asm(v1[2], v1[3]);
                    *(u32x4*)(rowp + bj * HALF) = w; } }
    }
};
struct EpiHid {
    static constexpr bool PERM = false;
    bf16_t* O; int ldc;
    __device__ __forceinline__ void operator()(const f32x4 (&acc)[2][2][4][2], const Unit& u, int wr, int wc, int fr, int fq) const {
        const int row0 = u.pm * BM + wr * 64 + fr, col0 = (u.pn * BM + wc * 32) / 2 + 4 * fq;
#pragma unroll
        for (int ai = 0; ai < 2; ++ai)
#pragma unroll
            for (int m = 0; m < 4; ++m) { bf16_t* rowp = O + (size_t)(row0 + ai * HALF + m * 16) * ldc + col0;
#pragma unroll
                for (int bj = 0; bj < 2; ++bj) { const f32x4 g = acc[ai][bj][m][0], up = acc[ai][bj][m][1]; f32x4 h;
#pragma unroll
                    for (int j = 0; j < 4; ++j) h[j] = g[j] * __builtin_amdgcn_rcpf(1.f + __expf(-g[j])) * up[j];
                    u32x2 w; w.x = cvt_pk_bf16_asm(h[0], h[1]); w.y = cvt_pk_bf16_asm(h[2], h[3]);
                    *(u32x2*)(rowp + bj * (HALF / 2)) = w; } }
    }
};

template <class Epi, bool GATHER>
__device__ __forceinline__ void gemm_phase(const int tid, LAS unsigned char* lds, const Gemm g, const StaticOrder& S, const Epi& E) {
    const int wid = __builtin_amdgcn_readfirstlane(tid >> 6), lane = tid & 63, wr = wid >> 2, wc = wid & 3, fr = lane & 15, fq = lane >> 4;
    const int K = g.K, nt = K / BK;
    unsigned voffA[2], voffB[2];
#pragma unroll
    for (int i = 0; i < 2; ++i) { int R, C; stage_rc(tid * 16 + i * 8192, R, C); const int Rb = Epi::PERM ? ((R & ~31) + perm32(R & 31)) : R;
        voffB[i] = (unsigned)(Rb * K + C) * 2u; voffA[i] = GATHER ? (unsigned)(C * 2) : (Epi::PERM ? (unsigned)(R * K + C) * 2u : voffB[i]); }
    const size_t kstep = (size_t)(BK * 2);
    const size_t hstep = (size_t)HALF * K * 2;
    const size_t tstep = 2 * hstep;
    const unsigned ldsw = (unsigned)wid * 1024u;
    const int aoff = lds_byte(wr * 64 + fr, fq * 8), boff = lds_byte(wc * 32 + fr, fq * 8);
#define PG8_SA(b, h) (((b) * 2 + (h)) * HTB)
#define PG8_SB(b, h) ((4 + (b) * 2 + (h)) * HTB)
#define PG8_STAGE(bufoff, gbase, voff) do { const char* gb_ = (const char*)(gbase); asm volatile("" : "+s"(gb_)); _Pragma("unroll") for (int _i = 0; _i < 2; ++_i) \
        __builtin_amdgcn_global_load_lds((const unsigned*)(gb_ + (voff)[_i]), (LAS unsigned*)(lds + (bufoff) + ldsw + _i * 8192), 16, 0, 0); } while (0)
#define PG8_STAGE_A(bufoff, ubase, kt, h, tb) do { if constexpr (GATHER) { \
        if ((tb) < 0) { PG8_STAGE(bufoff, Ab + (size_t)(kt) * kstep, oAc[h]); } else { \
        unsigned m_ = ~0u; asm volatile("" : "+s"(m_)); const int tl_ = wid * 64 + (int)__builtin_amdgcn_mbcnt_hi(m_, __builtin_amdgcn_mbcnt_lo(m_, 0u)); \
        _Pragma("unroll") for (int _i = 0; _i < 2; ++_i) { int _R, _C; stage_rc(tl_ * 16 + _i * 8192, _R, _C); \
            const unsigned _o = min(*(const LAS unsigned*)(lds + TAB_OFF + (tb) * 1024 + ((h) * HALF + _R) * 4), (unsigned)(NTOK - 1)) * (unsigned)(K * 2) + (unsigned)(_C * 2); \
            __builtin_amdgcn_global_load_lds((const unsigned*)(Ab + (size_t)(kt) * kstep + _o), (LAS unsigned*)(lds + (bufoff) + ldsw + _i * 8192), 16, 0, 0); } } } \
        else { PG8_STAGE(bufoff, (ubase) + (size_t)(kt) * kstep + (size_t)(h) * hstep, voffA); } } while (0)
#define PG8_LOADOFFS(tb) do { if constexpr (GATHER) { unsigned m_ = ~0u; asm volatile("" : "+s"(m_)); const int tl_ = wid * 64 + (int)__builtin_amdgcn_mbcnt_hi(m_, __builtin_amdgcn_mbcnt_lo(m_, 0u)); \
        _Pragma("unroll") for (int _h = 0; _h < 2; ++_h) _Pragma("unroll") for (int _i = 0; _i < 2; ++_i) { int _R, _C; stage_rc(tl_ * 16 + _i * 8192, _R, _C); \
            oAc[_h][_i] = min(*(const LAS unsigned*)(lds + TAB_OFF + (tb) * 1024 + (_h * HALF + _R) * 4), (unsigned)(NTOK - 1)) * (unsigned)(K * 2) + (unsigned)(_C * 2); } } } while (0)
#define PG8_FILLTAB(u, tb) do { if constexpr (GATHER) { unsigned m_ = ~0u; asm volatile("" : "+s"(m_)); const int tl_ = wid * 64 + (int)__builtin_amdgcn_mbcnt_hi(m_, __builtin_amdgcn_mbcnt_lo(m_, 0u)); \
        if (tl_ < 256) *(LAS unsigned*)(lds + TAB_OFF + (tb) * 1024 + tl_ * 4) = (unsigned)g.gather[(u).pm * BM + tl_]; } } while (0)
#define PG8_LDA(dst, b, h) do { _Pragma("unroll") for (int m = 0; m < 4; ++m) _Pragma("unroll") for (int k = 0; k < 2; ++k) dst[m][k] = *(const LAS bf16x8*)(lds + PG8_SA(b, h) + aoff + m * 2048 + k * 1024); } while (0)
#define PG8_LDB(dst, b, h) do { _Pragma("unroll") for (int n = 0; n < 2; ++n) _Pragma("unroll") for (int k = 0; k < 2; ++k) dst[n][k] = *(const LAS bf16x8*)(lds + PG8_SB(b, h) + boff + n * 2048 + k * 1024); } while (0)
#define PG8_MMA(ai, bj, At, Bt) do { __builtin_amdgcn_s_setprio(1); _Pragma("unroll") for (int m = 0; m < 4; ++m) _Pragma("unroll") for (int n = 0; n < 2; ++n) _Pragma("unroll") for (int k = 0; k < 2; ++k) \
        acc[ai][bj][m][n] = __builtin_amdgcn_mfma_f32_16x16x32_bf16(Bt[n][k], At[m][k], acc[ai][bj][m][n], 0, 0, 0); __builtin_amdgcn_s_setprio(0); } while (0)
#define PG8_WAIT_V(n) asm volatile("s_waitcnt vmcnt(" #n ")" ::: "memory")
#define PG8_WAIT_L(n) asm volatile("s_waitcnt lgkmcnt(" #n ")" ::: "memory")
#define PG8_BAR __builtin_amdgcn_s_barrier()
#define PG8_SCHED __builtin_amdgcn_sched_barrier(0)
#define PG8_KTILE2(u1, k1, o1, u2, k2, o2, b2p) do { \
        PG8_LDB(B0, 0, 0); PG8_LDB(B1, 0, 1); PG8_SCHED; PG8_LDA(At, 0, 0); PG8_STAGE_A(PG8_SA(1, 1), u1, k1, 1, o1); \
        PG8_WAIT_V(8); PG8_WAIT_L(0); PG8_BAR; PG8_MMA(0, 0, At, B0); PG8_MMA(0, 1, At, B1); PG8_BAR; PG8_SCHED; \
        PG8_LDA(At, 0, 1); PG8_STAGE(PG8_SB(0, 0), b2p, voffB); PG8_STAGE(PG8_SB(0, 1), (b2p) + hstep, voffB); PG8_STAGE_A(PG8_SA(0, 0), u2, k2, 0, o2); \
        PG8_WAIT_V(8); PG8_WAIT_L(0); PG8_BAR; PG8_MMA(1, 0, At, B0); PG8_MMA(1, 1, At, B1); PG8_BAR; PG8_SCHED; \
        PG8_LDB(B0, 1, 0); PG8_LDB(B1, 1, 1); PG8_SCHED; PG8_LDA(At, 1, 0); PG8_STAGE_A(PG8_SA(0, 1), u2, k2, 1, o2); \
        PG8_WAIT_V(8); PG8_WAIT_L(0); PG8_BAR; PG8_MMA(0, 0, At, B0); PG8_MMA(0, 1, At, B1); PG8_BAR; PG8_SCHED; \
        PG8_LDA(At, 1, 1); PG8_STAGE(PG8_SB(1, 0), (b2p) + kstep, voffB); PG8_STAGE(PG8_SB(1, 1), (b2p) + kstep + hstep, voffB); PG8_STAGE_A(PG8_SA(1, 0), u2, (k2) + 1, 0, o2); \
        PG8_WAIT_V(8); PG8_WAIT_L(0); PG8_BAR; PG8_MMA(1, 0, At, B0); PG8_MMA(1, 1, At, B1); PG8_BAR; PG8_SCHED; } while (0)
#define PG8_BPTR(u) ((const char*)g.Bt + (g.gt ? (size_t)(((u).pm / g.gt) % g.ng) * g.gstride : (size_t)0) + (size_t)(u).pn * tstep)
    Unit cur, nxt; int ui = 0;
    if (!S.next(0, cur)) return;
#ifndef LATE_START
#define LATE_START 4
#endif
#ifndef GEMM_STAGGER
#define GEMM_STAGGER 0
#endif
    if (GEMM_STAGGER) { const int dg_ = ((int)blockIdx.x >> 3) & 3; for (int i_ = 0; i_ < dg_; ++i_) __builtin_amdgcn_s_sleep(GEMM_STAGGER); }
    if (S.nwg % S.G != 0 && S.c >= S.nwg % S.G) { for (int i_ = 0; i_ < LATE_START; ++i_) __builtin_amdgcn_s_sleep(127); }
    f32x4 acc[2][2][4][2];
#pragma unroll
    for (int a = 0; a < 2; ++a)
#pragma unroll
        for (int b = 0; b < 2; ++b)
#pragma unroll
            for (int m = 0; m < 4; ++m)
#pragma unroll
                for (int n = 0; n < 2; ++n) acc[a][b][m][n] = (f32x4){0.f, 0.f, 0.f, 0.f};
    bf16x8 At[4][2], B0[2][2], B1[2][2];
    unsigned oAc[2][2] = {{0u, 0u}, {0u, 0u}};
    const char* const Ab = (const char*)g.A;
    const char* cA = Ab + (size_t)cur.pm * tstep;
    const char* cB = PG8_BPTR(cur);
    PG8_FILLTAB(cur, 0);
    if constexpr (GATHER) { PG8_WAIT_L(0); PG8_BAR; PG8_LOADOFFS(0); }
    PG8_STAGE(PG8_SB(0, 0), cB, voffB); PG8_STAGE(PG8_SB(0, 1), cB + hstep, voffB); PG8_STAGE_A(PG8_SA(0, 0), cA, 0, 0, -1); PG8_STAGE_A(PG8_SA(0, 1), cA, 0, 1, -1);
    if (wr == 1) PG8_BAR;
    PG8_WAIT_V(2); PG8_BAR;
    PG8_STAGE(PG8_SB(1, 0), cB + kstep, voffB); PG8_STAGE_A(PG8_SA(1, 0), cA, 1, 0, -1); PG8_STAGE(PG8_SB(1, 1), cB + hstep + kstep, voffB);
    PG8_WAIT_V(6); PG8_BAR;
    for (;;) {
        const bool has_next = S.next(ui + 1, nxt);
        const char* nA = has_next ? Ab + (size_t)nxt.pm * tstep : cA; const char* nB = has_next ? PG8_BPTR(nxt) : cB;
        const int tbc = ui & 1, tbn = has_next ? ((ui + 1) & 1) : (ui & 1);
        if constexpr (GATHER) { if (has_next && wid < 4) { unsigned m_ = ~0u; asm volatile("" : "+s"(m_)); const int tl_ = wid * 64 + (int)__builtin_amdgcn_mbcnt_hi(m_, __builtin_amdgcn_mbcnt_lo(m_, 0u));
            __builtin_amdgcn_global_load_lds((const unsigned*)(g.gather + nxt.pm * BM + tl_), (LAS unsigned*)(lds + TAB_OFF + tbn * 1024 + wid * 256), 4, 0, 0); } }
        for (int t = 0; t < nt - 2; t += 2) { const char* b2 = cB + (size_t)(t + 2) * kstep; PG8_KTILE2(cA, t + 1, -1, cA, t + 2, -1, b2); }
        PG8_KTILE2(cA, nt - 1, -1, nA, 0, tbn, nB);
        if (wr == 0) PG8_BAR;
        { unsigned m_ = ~0u; asm volatile("" : "+s"(m_)); int l2 = (int)__builtin_amdgcn_mbcnt_hi(m_, __builtin_amdgcn_mbcnt_lo(m_, 0u)); asm volatile("" : "+v"(l2)); E(acc, cur, wr, wc, l2 & 15, l2 >> 4); }
        if (!has_next) break;
#pragma unroll
        for (int a = 0; a < 2; ++a)
#pragma unroll
            for (int b = 0; b < 2; ++b)
#pragma unroll
                for (int m = 0; m < 4; ++m)
#pragma unroll
                    for (int n = 0; n < 2; ++n) acc[a][b][m][n] = (f32x4){0.f, 0.f, 0.f, 0.f};
        cur = nxt; cA = nA; cB = nB; ++ui;
        PG8_LOADOFFS(ui & 1);
        if (wr == 1) PG8_BAR;
    }
    PG8_WAIT_V(0);
    PG8_BAR;
#undef PG8_STAGE_A
#undef PG8_FILLTAB
#undef PG8_LOADOFFS
#undef PG8_SA
#undef PG8_SB
#undef PG8_STAGE
#undef PG8_LDA
#undef PG8_LDB
#undef PG8_MMA
#undef PG8_WAIT_V
#undef PG8_WAIT_L
#undef PG8_BAR
#undef PG8_SCHED
#undef PG8_KTILE2
#undef PG8_BPTR
}
}

#define XB_TMO      128
#define XB_XCNT(j)  (256  + 64 * (j))
#define XB_XSUB(j)  (1280 + 64 * (j))
#define XB_XGEN(j)  (2304 + 64 * (j))
#define XB_TOP      3328
#define XB_TOPGEN   3392
#define XCD_BAR_WORDS 3456
#define XB_SPIN_CAP (1u << 20)
__device__ __forceinline__ unsigned xb_ld(unsigned* p)              { return __hip_atomic_load(p, __ATOMIC_RELAXED, __HIP_MEMORY_SCOPE_AGENT); }
__device__ __forceinline__ unsigned xb_add(unsigned* p, unsigned v) { return __hip_atomic_fetch_add(p, v, __ATOMIC_RELAXED, __HIP_MEMORY_SCOPE_AGENT); }
__device__ __forceinline__ unsigned xb_xcc_id() { return (unsigned)__builtin_amdgcn_s_getreg((3 << 11) | 20) & 0xFu; }
#define XB_SPIN(cond, bar) do { unsigned _sp = 0; while (cond) { __builtin_amdgcn_s_sleep(1); \
    if ((++_sp & 255u) == 0u) { if (xb_ld(&(bar)[XB_TMO])) break; if (_sp > XB_SPIN_CAP) { atomicAdd(&(bar)[XB_TMO], 1u); break; } } } } while (0)
struct XcdBarrier { unsigned* bar; unsigned x; };
#define XB_ST(ldsbase) ((volatile LAS unsigned*)((LAS unsigned char*)(ldsbase) + MISC_OFF + 32))
__device__ __forceinline__ XcdBarrier xcd_barrier_post(unsigned* bar, bool leader) {
    XcdBarrier b; b.bar = bar; b.x = xb_xcc_id();
    if (leader) (void)xb_add(&bar[XB_XCNT(b.x)], 1u);
    return b;
}
__device__ __forceinline__ void xcd_barrier_complete(unsigned* bar, unsigned x, unsigned& nloc, unsigned& nx) {
    const unsigned G = gridDim.x * gridDim.y * gridDim.z;
    unsigned sum, cnt, mine, sp = 0u;
    for (;;) {
        sum = 0u; cnt = 0u; mine = 0u;
#pragma unroll
        for (unsigned j = 0; j < 16; ++j) { const unsigned c = xb_ld(&bar[XB_XCNT(j)]); sum += c; cnt += (c > 0u) ? 1u : 0u; mine = (j == x) ? c : mine; }
        if (sum == G) break;
        __builtin_amdgcn_s_sleep(1);
        if ((++sp & 255u) == 0u) { if (xb_ld(&bar[XB_TMO])) break; if (sp > XB_SPIN_CAP) { atomicAdd(&bar[XB_TMO], 1u); break; } }
    }
    nloc = mine > 0u ? mine : 1u; nx = cnt > 0u ? cnt : 1u;
}
__device__ __forceinline__ void xcd_barrier(const XcdBarrier& b, bool leader, volatile LAS unsigned* st) {
    asm volatile("s_waitcnt vmcnt(0)" ::: "memory");
    __syncthreads();
    if (leader) {
        unsigned* bar = b.bar;
        __builtin_amdgcn_s_waitcnt(0);
        unsigned nloc = st[0], nx = st[1];
        if (nloc == 0u) { xcd_barrier_complete(bar, b.x, nloc, nx); st[0] = nloc; st[1] = nx; }
        const unsigned old = xb_add(&bar[XB_XSUB(b.x)], 1u);
        const unsigned gen = old / nloc;
        if (old + 1u == (gen + 1u) * nloc) {
            __builtin_amdgcn_fence(__ATOMIC_RELEASE, "agent");
            asm volatile("s_waitcnt vmcnt(0)" ::: "memory");
            const unsigned og = xb_add(&bar[XB_TOP], 1u);
            const unsigned tg = og / nx;
            if (og + 1u == (tg + 1u) * nx) xb_add(&bar[XB_TOPGEN], 1u);
            else XB_SPIN(xb_ld(&bar[XB_TOPGEN]) == tg, bar);
            __builtin_amdgcn_fence(__ATOMIC_ACQUIRE, "agent");
            xb_add(&bar[XB_XGEN(b.x)], 1u);
            asm volatile("s_waitcnt vmcnt(0)" ::: "memory");
        } else {
            XB_SPIN(xb_ld(&bar[XB_XGEN(b.x)]) == gen, bar);
            __builtin_amdgcn_fence(__ATOMIC_ACQUIRE, "agent");
            asm volatile("s_waitcnt vmcnt(0)" ::: "memory");
        }
    }
    __syncthreads();
}

template <void (*F)(long, PRef, int)> __device__ __forceinline__ void run_items(const int tid, PRef p, int l, long n, long off) {
    for (long gid = (long)blockIdx.x * NTHR + tid; gid < n; gid += (long)gridDim.x * NTHR) F(gid + off, p, l);
}
BODY void b_hgrn_seq2(long gid, PRef p, int l) { const long n1 = (long)NB * HGH * 64; if (gid < n1) b_hgrn_seq<0>(gid, p, l); else b_hgrn_seq<1>(gid - n1, p, l); }

template <int MAP> __device__ __forceinline__ void transpose_item(const float* W, int K, int N, bf16_t* WT, int row_off, LAS float* scr, int item, int lane) {
    const int nblk = N / 32, kb = item / nblk, nb = item % nblk, k0 = 64 * kb, n0 = 32 * nb;
#pragma unroll 8
    for (int i = 0; i < 32; ++i) { const int kk = 2 * i + (lane >> 5); scr[kk * 33 + (lane & 31)] = W[(size_t)(k0 + kk) * N + n0 + (lane & 31)]; }
    asm volatile("s_waitcnt lgkmcnt(0)" ::: "memory");
    const int c = lane & 7;
#pragma unroll
    for (int j = 0; j < 4; ++j) { const int n = (lane >> 3) + 8 * j; const LAS float* s = scr + (8 * c) * 33 + n;
        u32x4 o; o.x = cvt_pk_bf16(s[0 * 33], s[1 * 33]); o.y = cvt_pk_bf16(s[2 * 33], s[3 * 33]); o.z = cvt_pk_bf16(s[4 * 33], s[5 * 33]); o.w = cvt_pk_bf16(s[6 * 33], s[7 * 33]);
        const int nn = n0 + n; const int drow = MAP == 0 ? row_off + nn : (32 * (nn >> 4) + (nn & 15) + (MAP == 2 ? 16 : 0));
        *(u32x4*)(WT + (size_t)drow * K + k0 + 8 * c) = o; }
    asm volatile("s_waitcnt lgkmcnt(0)" ::: "memory");
}
#define WBOFF(l) ((size_t)((l) & 1) * (WB_BYTES / 2))
__device__ __forceinline__ void phase_convert(const int tid, PRef p, int l, LAS unsigned char* lds, int part = 0, int blk_lo = 0) {
    if ((int)blockIdx.x < blk_lo) return;
    const int lane = tid & 63, wave = tid >> 6;
    LAS float* scr = (LAS float*)(lds + wave * 16384);
    const int gw = ((int)blockIdx.x - blk_lo) * NWAVES + wave, NGW = ((int)gridDim.x - blk_lo) * NWAVES;
    constexpr int I_IN = (D / 64) * (INC / 32), I_OUT = (MIXD / 64) * (D / 32), I_G = (D / 64) * (ED / 32), I_D = (ED / 64) * (D / 32);
    constexpr int NITEMS = I_IN + I_OUT + NE * (2 * I_G + I_D);
    const int it_lo = part == 2 ? I_IN + I_OUT : 0, it_hi = part == 1 ? I_IN + I_OUT : NITEMS;
    for (int it = it_lo + gw; it < it_hi; it += NGW) {
        int r = it;
        if (r < I_IN) { transpose_item<0>(p.w_in + (size_t)l * D * INC, D, INC, p.WIN_T + WBOFF(l), 0, scr, r, lane); continue; } r -= I_IN;
        if (r < I_OUT) { transpose_item<0>(p.w_out + (size_t)l * MIXD * D, MIXD, D, p.WOUT_T + WBOFF(l), 0, scr, r, lane); continue; } r -= I_OUT;
        const int e = r / (2 * I_G + I_D); r -= e * (2 * I_G + I_D);
        if (r < I_G) { transpose_item<1>(p.w_gate + ((size_t)l * NE + e) * D * ED, D, ED, p.WGU_T + WBOFF(l) + (size_t)e * 2 * ED * D, 0, scr, r, lane); continue; } r -= I_G;
        if (r < I_G) { transpose_item<2>(p.w_up + ((size_t)l * NE + e) * D * ED, D, ED, p.WGU_T + WBOFF(l) + (size_t)e * 2 * ED * D, 0, scr, r, lane); continue; } r -= I_G;
        transpose_item<0>(p.w_down + ((size_t)l * NE + e) * ED * D, ED, D, p.WD_T + WBOFF(l) + (size_t)e * D * ED, 0, scr, r, lane);
    }
}
template <int WHICH> __device__ __forceinline__ void phase_prenorm(const int tid, PRef p, int l) {
    static_assert(D == 1024, "wave-per-row kernels assume D = 1024");
    const int lane = tid & 63, wave = tid >> 6;
    const int gw = blockIdx.x * NWAVES + wave, NGW = gridDim.x * NWAVES;
    const float* nw = (WHICH ? p.norm2_w : p.norm1_w) + l * D;
    for (int r = gw; r < NTOK; r += NGW) {
        const float* xr = xrow(p, r);
        const float* mod = p.MOD + ((size_t)l * 3 + modset(r)) * NMOD;
        const float* shift = mod + (WHICH ? 3 : 0) * D; const float* scale = mod + (WHICH ? 4 : 1) * D;
        f32x4 v[4]; float ss = 0.f;
#pragma unroll
        for (int j = 0; j < 4; ++j) { v[j] = *(const f32x4*)(xr + 4 * lane + 256 * j); ss += (v[j][0] * v[j][0] + v[j][1] * v[j][1]) + (v[j][2] * v[j][2] + v[j][3] * v[j][3]); }
        const float rstd = 1.f / sqrtf(wave_sum(ss, lane) * (1.f / D) + EPS);
        float lg[NE];
#pragma unroll
        for (int e = 0; e < NE; ++e) lg[e] = 0.f;
#pragma unroll
        for (int j = 0; j < 4; ++j) {
            const int c = 4 * lane + 256 * j;
            const f32x4 w4 = *(const f32x4*)(nw + c), sc4 = *(const f32x4*)(scale + c), sh4 = *(const f32x4*)(shift + c);
            f32x4 h;
#pragma unroll
            for (int i = 0; i < 4; ++i) h[i] = v[j][i] * rstd * w4[i] * (1.f + sc4[i]) + sh4[i];
            u32x2 o; o.x = cvt_pk_bf16(h[0], h[1]); o.y = cvt_pk_bf16(h[2], h[3]);
            *(u32x2*)(p.H + (size_t)r * D + c) = o;
            if (WHICH) {
#pragma unroll
                for (int i = 0; i < 4; ++i) { const f32x4* wr = (const f32x4*)(p.w_router + ((size_t)l * D + c + i) * NE);
#pragma unroll
                    for (int q = 0; q < 4; ++q) { const f32x4 w = wr[q]; lg[4 * q + 0] += h[i] * w[0]; lg[4 * q + 1] += h[i] * w[1]; lg[4 * q + 2] += h[i] * w[2]; lg[4 * q + 3] += h[i] * w[3]; } }
            }
        }
        if (WHICH) {
#pragma unroll
            for (int e = 0; e < NE; ++e) lg[e] = wave_sum(lg[e], lane);
            float m = lg[0];
#pragma unroll
            for (int e = 1; e < NE; ++e) m = fmaxf(m, lg[e]);
            float s = 0.f, mine = 0.f;
#pragma unroll
            for (int e = 0; e < NE; ++e) { const float ex = expf(lg[e] - m); s += ex; mine = (lane == e) ? ex : mine; }
            if (lane < NE) p.AFF[(size_t)r * NE + lane] = mine / s;
        }
    }
}
__device__ __forceinline__ void phase_combine(const int tid, PRef p, int l) {
    const int lane = tid & 63, wave = tid >> 6;
    const int gw = blockIdx.x * NWAVES + wave, NGW = gridDim.x * NWAVES;
    for (int r = gw; r < NTOK; r += NGW) {
        float* xr = xrow(p, r);
        const float* g = p.MOD + ((size_t)l * 3 + modset(r)) * NMOD + 5 * D;
        f32x4 acc[4];
#pragma unroll
        for (int j = 0; j < 4; ++j) acc[j] = (f32x4){0.f, 0.f, 0.f, 0.f};
        const int myinv = lane < NE ? p.INV[(size_t)r * NE + lane] : -1;
#pragma unroll
        for (int e = 0; e < NE; ++e) {
            const int s = __builtin_amdgcn_readlane(myinv, e);
            if (s >= 0 && s < NSLOT) {
                const bf16_t* y = p.Y + (size_t)s * D;
#pragma unroll
                for (int j = 0; j < 4; ++j) { const u32x2 w = *(const u32x2*)(y + 4 * lane + 256 * j);
                    acc[j][0] += __builtin_bit_cast(float, w.x << 16); acc[j][1] += __builtin_bit_cast(float, w.x & 0xffff0000u);
                    acc[j][2] += __builtin_bit_cast(float, w.y << 16); acc[j][3] += __builtin_bit_cast(float, w.y & 0xffff0000u); }
            }
        }
#pragma unroll
        for (int j = 0; j < 4; ++j) { const int c = 4 * lane + 256 * j; f32x4* q = (f32x4*)(xr + c); *q = *q + *(const f32x4*)(g + c) * acc[j]; }
    }
}


__device__ __forceinline__ unsigned wave_excl_scan(unsigned x, int lane) {
    unsigned inc = x;
#pragma unroll
    for (int d = 1; d < 64; d <<= 1) { const unsigned y = (unsigned)__builtin_amdgcn_ds_bpermute(((lane - d) & 63) << 2, (int)inc); if (lane >= d) inc += y; }
    return inc - x;
}
__device__ __forceinline__ void phase_topk(const int tid, PRef p, LAS unsigned char* lds) {
    LAS unsigned* keys = (LAS unsigned*)lds;
    LAS unsigned* hist = (LAS unsigned*)(lds + 70000);
    LAS unsigned* cgt = (LAS unsigned*)(lds + 76000);
    LAS unsigned* ceq = (LAS unsigned*)(lds + 80000);
    LAS unsigned* sh = (LAS unsigned*)(lds + 84000);
    static_assert(SEQ % 512 == 0 && SEQ + SEQ / 32 <= 17400, "topk LDS layout");
    constexpr int PER = SEQ / 512;
    for (int pr = blockIdx.x; pr < 2 * NB * NE; pr += gridDim.x) {
        const int e = pr % NE, b = (pr / NE) % NB, isctx = pr / (NE * NB);
        if (!isctx) {
            const int row0 = b * SEQ, base = (b * NE + e) * CAPL;
            for (int i = 0; i < PER; ++i) { const int t = i * 512 + tid; keys[t + (t >> 5)] = __builtin_bit_cast(unsigned, p.AFF[(size_t)(row0 + t) * NE + e]); }
            if (tid == 0) { sh[0] = 0u; sh[1] = (unsigned)CAPL; }
            __syncthreads();
            for (int pass = 0; pass < 3; ++pass) {
                const int shift = 20 - 10 * pass;
                for (int i = tid; i < 1024; i += 512) hist[i] = 0u;
                __syncthreads();
                const unsigned prefix = sh[0]; const unsigned himask = pass == 0 ? 0u : (0xFFFFFFFFu << (shift + 10));
                for (int i = 0; i < PER; ++i) { const int t = tid * PER + i; const unsigned k = keys[t + (t >> 5)]; if ((k & himask) == prefix) atomicAdd((unsigned*)&hist[(k >> shift) & 1023u], 1u); }
                __syncthreads();
                if (tid < 64) {
                    const unsigned need = sh[1];
                    unsigned c[16]; unsigned tot = 0u;
#pragma unroll
                    for (int q = 0; q < 16; ++q) { c[q] = hist[1023 - 16 * tid - q]; tot += c[q]; }
                    unsigned above = wave_excl_scan(tot, tid);
                    int fbin = -1; unsigned fabove = 0u;
#pragma unroll
                    for (int q = 0; q < 16; ++q) { if (fbin < 0 && above < need && above + c[q] >= need) { fbin = 1023 - 16 * tid - q; fabove = above; } above += c[q]; }
                    if (fbin >= 0) { sh[0] = prefix | ((unsigned)fbin << shift); sh[1] = need - fabove; }
                }
                __syncthreads();
            }
            const unsigned thr = sh[0], keq = sh[1];
            unsigned ng = 0u, nq = 0u;
            for (int i = 0; i < PER; ++i) { const int t = tid * PER + i; const unsigned k = keys[t + (t >> 5)]; ng += k > thr ? 1u : 0u; nq += k == thr ? 1u : 0u; }
            cgt[tid] = ng; ceq[tid] = nq;
            __syncthreads();
            if (tid < 64) {
                unsigned g[8], q[8], sg = 0u, sq = 0u;
#pragma unroll
                for (int i = 0; i < 8; ++i) { g[i] = cgt[8 * tid + i]; q[i] = ceq[8 * tid + i]; sg += g[i]; sq += q[i]; }
                unsigned ag = wave_excl_scan(sg, tid), aq = wave_excl_scan(sq, tid);
#pragma unroll
                for (int i = 0; i < 8; ++i) { cgt[8 * tid + i] = ag; ceq[8 * tid + i] = aq; ag += g[i]; aq += q[i]; }
            }
            __syncthreads();
            unsigned rg = cgt[tid], rq = ceq[tid];
            for (int i = 0; i < PER; ++i) {
                const int t = tid * PER + i; const unsigned k = keys[t + (t >> 5)];
                int slot = -1;
                if (k > thr) { slot = (int)(rg + (rq < keq ? rq : keq)); ++rg; }
                else if (k == thr) { if (rq < keq) slot = (int)(rg + rq); ++rq; }
                const int row = row0 + t;
                if (slot >= 0) { p.STOK[base + slot] = row; p.SVAL[base + slot] = __builtin_bit_cast(float, k); p.INV[(size_t)row * NE + e] = base + slot; }
                else p.INV[(size_t)row * NE + e] = -1;
            }
            __syncthreads();
        } else {
            const int row0 = NLAT + b * CTX, base = NSLOT_L + (b * NE + e) * CAPC;
            LAS float* vals = (LAS float*)lds;
            for (int t = tid; t < CTX; t += 512) vals[t] = p.AFF[(size_t)(row0 + t) * NE + e];
            __syncthreads();
            for (int t = tid; t < CTX; t += 512) {
                const float a = vals[t]; int rank = 0;
                for (int tt = 0; tt < CTX; ++tt) { const float o = vals[tt]; rank += (o > a || (o == a && tt < t)) ? 1 : 0; }
                const int row = row0 + t;
                if (rank < CAPC) { p.STOK[base + rank] = row; p.SVAL[base + rank] = a; p.INV[(size_t)row * NE + e] = base + rank; }
                else p.INV[(size_t)row * NE + e] = -1;
            }
            __syncthreads();
        }
    }
}

#define LDS_BAR() do { asm volatile("s_waitcnt lgkmcnt(0)" ::: "memory"); __builtin_amdgcn_s_barrier(); asm volatile("" ::: "memory"); } while (0)
__device__ __forceinline__ int hg_row0(int b, int pc) { return pc < NCHC ? NLAT + b * CTX + pc * 64 : b * SEQ + (pc - NCHC) * 64; }
constexpr int HG_FF = 0, HG_FB = 16384, HG_AF = 32768, HG_AB = 49152, HG_T0 = 65536, HG_TS = 9216, HG_VT = HG_T0 + 6 * HG_TS;
#define HGI(t, k) ((t) * 64 + ((k) ^ (((((t) >> 4) & 1) << 4) | (((t) & 3) << 2))))
#define HGLD8(dst, arr, t, k0) do { const f32x4 lo_ = *(const LAS f32x4*)((arr) + HGI(t, k0)), hi_ = *(const LAS f32x4*)((arr) + HGI(t, (k0) + 4)); \
        dst[0] = lo_[0]; dst[1] = lo_[1]; dst[2] = lo_[2]; dst[3] = lo_[3]; dst[4] = hi_[0]; dst[5] = hi_[1]; dst[6] = hi_[2]; dst[7] = hi_[3]; } while (0)
static_assert(HG_VT + HG_TS <= RING_BYTES, "hgrn LDS layout");
#define TSW_E(k, t) ((k) * 72 + ((((t) >> 3) ^ (((k) >> 3) & 7)) << 3) + ((t) & 7))
#define TSW_B(k, c) ((k) * 144 + (((c) ^ (((k) >> 3) & 7)) << 4))
constexpr int HG_LBOFF = LDSCTL_OFF + 4096;
__device__ __forceinline__ void hg_stage_lb(const int tid, PRef p, int l) {
    LAS float* dst = (LAS float*)((LAS unsigned char*)lds_raw + HG_LBOFF);
    for (int i = tid; i < 768; i += NTHR) dst[i] = p.LB[(size_t)((i / 384) * DEPTH + l) * 384 + (i % 384)];
    LDS_BAR();
}
__device__ __forceinline__ void hg_gates(const int tid, PRef p, int l, int h, const u32x4 zf, const u32x4 zb, LAS unsigned char* lds) {
    LAS float* FF = (LAS float*)(lds + HG_FF); LAS float* FB = (LAS float*)(lds + HG_FB); LAS float* AF = (LAS float*)(lds + HG_AF); LAS float* AB = (LAS float*)(lds + HG_AB);
    const int t = tid >> 3, cg = tid & 7;
    const LAS float* lbf = (const LAS float*)((LAS unsigned char*)lds_raw + HG_LBOFF) + h * 64 + cg * 8; const LAS float* lbb = lbf + 384;
    float ffv[8], fbv[8];
#pragma unroll
    for (int j = 0; j < 8; ++j) {
        const float z0 = fminf(fmaxf(bf8(zf, j), -60.f), 60.f), z1 = fminf(fmaxf(bf8(zb, j), -60.f), 60.f);
        const float l0 = lbf[j], l1 = lbb[j];
        ffv[j] = l0 + (1.f - l0) * __builtin_amdgcn_rcpf(1.f + __expf(-z0));
        fbv[j] = l1 + (1.f - l1) * __builtin_amdgcn_rcpf(1.f + __expf(-z1));
    }
    *(LAS f32x4*)(FF + HGI(t, cg * 8)) = (f32x4){ffv[0], ffv[1], ffv[2], ffv[3]}; *(LAS f32x4*)(FF + HGI(t, cg * 8 + 4)) = (f32x4){ffv[4], ffv[5], ffv[6], ffv[7]};
    *(LAS f32x4*)(FB + HGI(t, cg * 8)) = (f32x4){fbv[0], fbv[1], fbv[2], fbv[3]}; *(LAS f32x4*)(FB + HGI(t, cg * 8 + 4)) = (f32x4){fbv[4], fbv[5], fbv[6], fbv[7]};
    LDS_BAR();
    {
        const int wave = tid >> 6, lane = tid & 63, cl = lane & 15, seg = lane >> 4, dir = wave >> 2, col = 16 * (wave & 3) + cl;
        const LAS float* F = dir ? FB : FF; LAS float* A = dir ? AB : AF;
        float pre[16]; float run = 0.f;
#pragma unroll
        for (int i = 0; i < 16; ++i) { const int tt = dir ? 16 * seg + 15 - i : 16 * seg + i; run += __logf(F[HGI(tt, col)]); pre[i] = run; }
        const float T0 = __builtin_bit_cast(float, __builtin_amdgcn_ds_bpermute((cl + 0) << 2, __builtin_bit_cast(int, run)));
        const float T1 = __builtin_bit_cast(float, __builtin_amdgcn_ds_bpermute((cl + 16) << 2, __builtin_bit_cast(int, run)));
        const float T2 = __builtin_bit_cast(float, __builtin_amdgcn_ds_bpermute((cl + 32) << 2, __builtin_bit_cast(int, run)));
        const float T3 = __builtin_bit_cast(float, __builtin_amdgcn_ds_bpermute((cl + 48) << 2, __builtin_bit_cast(int, run)));
        const float off = dir ? ((seg < 1 ? T1 : 0.f) + (seg < 2 ? T2 : 0.f) + (seg < 3 ? T3 : 0.f)) : ((seg > 0 ? T0 : 0.f) + (seg > 1 ? T1 : 0.f) + (seg > 2 ? T2 : 0.f));
#pragma unroll
        for (int i = 0; i < 16; ++i) { const int tt = dir ? 16 * seg + 15 - i : 16 * seg + i; A[HGI(tt, col)] = off + pre[i]; }
    }
    LDS_BAR();
}
__device__ __forceinline__ bf16x8 ld2x64(const LAS unsigned char* p0, const LAS unsigned char* p1) {
    const u32x2 a = *(const LAS u32x2*)p0, b = *(const LAS u32x2*)p1; u32x4 r; r.x = a.x; r.y = a.y; r.z = b.x; r.w = b.y; return __builtin_bit_cast(bf16x8, r);
}
typedef short s16x4 __attribute__((ext_vector_type(4)));
__device__ __forceinline__ bf16x8 ld2tr(const LAS unsigned char* p0, const LAS unsigned char* p1) {
    const s16x4 a = __builtin_amdgcn_ds_read_tr16_b64_v4i16((LAS s16x4*)p0), b = __builtin_amdgcn_ds_read_tr16_b64_v4i16((LAS s16x4*)p1);
    return __builtin_shufflevector(a, b, 0, 1, 2, 3, 4, 5, 6, 7);
}
__device__ __forceinline__ f32x4 mfma16(bf16x8 a, bf16x8 b, f32x4 c) { return __builtin_amdgcn_mfma_f32_16x16x32_bf16(a, b, c, 0, 0, 0); }
__device__ __forceinline__ void phase_hgrn_local(const int tid, PRef p, int l, LAS unsigned char* lds) {
    LAS float* FF = (LAS float*)(lds + HG_FF); LAS float* FB = (LAS float*)(lds + HG_FB); LAS float* AF = (LAS float*)(lds + HG_AF); LAS float* AB = (LAS float*)(lds + HG_AB);
    LAS bf16_t* KTf = (LAS bf16_t*)(lds + HG_T0); LAS bf16_t* KTb = (LAS bf16_t*)(lds + HG_T0 + HG_TS); LAS bf16_t* VT = (LAS bf16_t*)(lds + HG_VT);
    const int t = tid >> 3, cg = tid & 7, wave = tid >> 6, lane = tid & 63, fr = lane & 15, fq = lane >> 4;
    u32x4 zf = (u32x4){0u, 0u, 0u, 0u}, zb = zf, v8 = zf, nzf = zf, nzb = zf, nv8 = zf;
    if ((int)blockIdx.x < NBH * NCH) { const int it = blockIdx.x, pc = it % NCH, bh = it / NCH, h = bh % HGH, b = bh / HGH;
        const bf16_t* pr = p.P + (size_t)(hg_row0(b, pc) + t) * INC + h * 64 + cg * 8; zf = *(const u32x4*)(pr + OFF_); zb = *(const u32x4*)(pr + OFB); v8 = *(const u32x4*)(pr + OHI); }
    hg_stage_lb(tid, p, l);
    for (int it = blockIdx.x; it < NBH * NCH; it += gridDim.x) {
        const int pc = it % NCH, bh = it / NCH, h = bh % HGH, b = bh / HGH, row0 = hg_row0(b, pc);
        { const int it2 = min(it + (int)gridDim.x, NBH * NCH - 1); const int pc2 = it2 % NCH, bh2 = it2 / NCH, h2 = bh2 % HGH, b2 = bh2 / HGH;
            const bf16_t* pr = p.P + (size_t)(hg_row0(b2, pc2) + t) * INC + h2 * 64 + cg * 8; nzf = *(const u32x4*)(pr + OFF_); nzb = *(const u32x4*)(pr + OFB); nv8 = *(const u32x4*)(pr + OHI); }
        hg_gates(tid, p, l, h, zf, zb, lds);
        {
            float f8[8], a8[8], e8[8], g8[8], b8[8], h8[8];
            HGLD8(f8, FF, t, cg * 8); HGLD8(a8, AF, t, cg * 8); HGLD8(e8, AF, 63, cg * 8); HGLD8(g8, FB, t, cg * 8); HGLD8(b8, AB, t, cg * 8); HGLD8(h8, AB, 0, cg * 8);
            float kf[8], kb[8];
#pragma unroll
            for (int j = 0; j < 8; ++j) { kf[j] = (1.f - f8[j]) * __expf(e8[j] - a8[j]); kb[j] = (1.f - g8[j]) * __expf(h8[j] - b8[j]); }
            u32x4 wf, wb; wf.x = cvt_pk_bf16(kf[0], kf[1]); wf.y = cvt_pk_bf16(kf[2], kf[3]); wf.z = cvt_pk_bf16(kf[4], kf[5]); wf.w = cvt_pk_bf16(kf[6], kf[7]);
            wb.x = cvt_pk_bf16(kb[0], kb[1]); wb.y = cvt_pk_bf16(kb[2], kb[3]); wb.z = cvt_pk_bf16(kb[4], kb[5]); wb.w = cvt_pk_bf16(kb[6], kb[7]);
            *(LAS u32x4*)(lds + HG_VT + t * 144 + cg * 16) = v8; *(LAS u32x4*)(lds + HG_T0 + t * 144 + cg * 16) = wf; *(LAS u32x4*)(lds + HG_T0 + HG_TS + t * 144 + cg * 16) = wb;
        }
        if (tid < 64) p.GDEC[((size_t)(0 * NBH + bh) * NCH + pc) * 64 + tid] = __expf(AF[HGI(63, tid)]);
        else if (tid < 128) p.GDEC[((size_t)(1 * NBH + bh) * NCH + pc) * 64 + (tid - 64)] = __expf(AB[HGI(0, tid - 64)]);
        LDS_BAR();
#if HGRN_DIAG == 4
        {
            const int v = tid >> 3, kg = tid & 7;
            for (int dir = 0; dir < 2; ++dir) {
                const LAS bf16_t* KT = (const LAS bf16_t*)(lds + HG_T0 + dir * HG_TS);
                float acc[8];
#pragma unroll
                for (int j = 0; j < 8; ++j) acc[j] = 0.f;
                for (int s_ = 0; s_ < 64; ++s_) { const float vv = bf2f(VT[v * 72 + s_]);
#pragma unroll
                    for (int j = 0; j < 8; ++j) acc[j] += bf2f(KT[(kg * 8 + j) * 72 + s_]) * vv; }
                bf16_t* dst = p.SLOC + ((size_t)(dir * NBH + bh) * NCH + pc) * 4096 + v * 64 + kg * 8;
#pragma unroll
                for (int j = 0; j < 8; ++j) dst[j] = f2bf(acc[j]);
            }
        }
#else
        {
            const int dir = wave >> 2, mt = wave & 3;
            const LAS unsigned char* KT = lds + HG_T0 + dir * HG_TS;
            const int trb = (8 * fq + (fr >> 2)) * 144 + 8 * (fr & 3);
            bf16x8 a[2];
#pragma unroll
            for (int ks = 0; ks < 2; ++ks) { const LAS unsigned char* ar = KT + trb + ks * (32 * 144) + mt * 32; a[ks] = ld2tr(ar, ar + 4 * 144); }
            bf16_t* dst = p.SLOC + ((size_t)(dir * NBH + bh) * NCH + pc) * 4096;
            u32x2 w[4];
#pragma unroll
            for (int nt = 0; nt < 4; ++nt) {
                f32x4 acc = (f32x4){0.f, 0.f, 0.f, 0.f};
#pragma unroll
                for (int ks = 0; ks < 2; ++ks) { const LAS unsigned char* br = lds + HG_VT + trb + ks * (32 * 144) + nt * 32; acc = mfma16(a[ks], ld2tr(br, br + 4 * 144), acc); }
                w[nt].x = cvt_pk_bf16(acc[0], acc[1]); w[nt].y = cvt_pk_bf16(acc[2], acc[3]);
            }
            zf = nzf; zb = nzb; v8 = nv8;
            asm volatile("" ::: "memory");
#pragma unroll
            for (int nt = 0; nt < 4; ++nt) *(u32x2*)(dst + (nt * 16 + fr) * 64 + mt * 16 + 4 * fq) = w[nt];
        }
#endif
        LDS_BAR();
    }
}
__device__ __forceinline__ void phase_hgrn_scan(const int tid, PRef p) {
    static_assert(NCH % 20 == 0, "scan group size");
    constexpr int GS = 20;
    for (int blk = (int)gridDim.x - 1 - (int)blockIdx.x; blk < 2 * NBH * 4; blk += gridDim.x) {
        const int sq = blk >> 2, part = blk & 3, dir = sq / NBH, e0 = part * 1024 + tid * 2, k = e0 & 63;
        unsigned* S = (unsigned*)(p.SLOC + (size_t)sq * NCH * 4096 + e0);
        const float* G = p.GDEC + (size_t)sq * NCH * 64 + k;
        float c0 = 0.f, c1 = 0.f;
        unsigned nx[GS]; f32x2 gn[GS];
#define HG_PC(j) (dir ? ((j) < NCHC ? NCHC - 1 - (j) : NCH + NCHC - 1 - (j)) : (j))
#pragma unroll
        for (int u = 0; u < GS; ++u) { const int pc = HG_PC(u); nx[u] = S[(size_t)pc * 2048]; gn[u] = *(const f32x2*)(G + (size_t)pc * 64); }
        for (int j0 = 0; j0 < NCH; j0 += GS) {
            unsigned cu[GS]; f32x2 gc[GS];
#pragma unroll
            for (int u = 0; u < GS; ++u) { cu[u] = nx[u]; gc[u] = gn[u]; }
            if (j0 + GS < NCH) {
#pragma unroll
                for (int u = 0; u < GS; ++u) { const int pc = HG_PC(j0 + GS + u); nx[u] = S[(size_t)pc * 2048]; gn[u] = *(const f32x2*)(G + (size_t)pc * 64); }
            }
#pragma unroll
            for (int u = 0; u < GS; ++u) {
                const int pc = HG_PC(j0 + u);
                S[(size_t)pc * 2048] = cvt_pk_bf16(c0, c1);
                c0 = gc[u][0] * c0 + bfw(cu[u], 0); c1 = gc[u][1] * c1 + bfw(cu[u], 1);
            }
        }
#undef HG_PC
    }
}
__device__ __forceinline__ void phase_hgrn_out(const int tid, PRef p, int l, LAS unsigned char* lds) {
    const int NCHO = (l + 1 < DEPTH) ? NCH : NCH - NCHC, PC0 = NCH - NCHO;
    LAS float* FF = (LAS float*)(lds + HG_FF); LAS float* FB = (LAS float*)(lds + HG_FB); LAS float* AF = (LAS float*)(lds + HG_AF); LAS float* AB = (LAS float*)(lds + HG_AB);
    LAS bf16_t* VT = (LAS bf16_t*)(lds + HG_VT);
    LAS float* OO = (LAS float*)(lds + HG_AF);
    const int t = tid >> 3, cg = tid & 7, wave = tid >> 6, lane = tid & 63, fr = lane & 15, fq = lane >> 4;
    u32x4 zf = (u32x4){0u, 0u, 0u, 0u}, zb = zf, v8 = zf, q8 = zf, g8 = zf, nzf = zf, nzb = zf, nv8 = zf, nq8 = zf, ng8 = zf;
    bf16x8 bsin[4][2], nbsin[4][2];
#define HG_LOADSIN(dst, bhx, pcx) do { const bf16_t* SIN_ = p.SLOC + ((size_t)((wave >> 2) * NBH + (bhx)) * NCH + (pcx)) * 4096; \
        _Pragma("unroll") for (int vt = 0; vt < 4; ++vt) _Pragma("unroll") for (int ks = 0; ks < 2; ++ks) dst[vt][ks] = *(const bf16x8*)(SIN_ + (vt * 16 + fr) * 64 + ks * 32 + fq * 8); } while (0)
#pragma unroll
    for (int vt = 0; vt < 4; ++vt) { bsin[vt][0] = (bf16x8){0, 0, 0, 0, 0, 0, 0, 0}; bsin[vt][1] = bsin[vt][0]; nbsin[vt][0] = bsin[vt][0]; nbsin[vt][1] = bsin[vt][0]; }
    if ((int)blockIdx.x < NBH * NCHO) { const int it = blockIdx.x, pc = it % NCHO + PC0, bh = it / NCHO, h = bh % HGH, b = bh / HGH;
        const bf16_t* pr = p.P + (size_t)(hg_row0(b, pc) + t) * INC + h * 64 + cg * 8; zf = *(const u32x4*)(pr + OFF_); zb = *(const u32x4*)(pr + OFB); v8 = *(const u32x4*)(pr + OHI); q8 = *(const u32x4*)(pr + OHQ); g8 = *(const u32x4*)(pr + OHG_);
        HG_LOADSIN(bsin, bh, pc); }
    hg_stage_lb(tid, p, l);
    f32x4 hn0, hn1; { const float* nwp = p.hg_norm + l * 64 + cg * 8; hn0 = *(const f32x4*)nwp; hn1 = *(const f32x4*)(nwp + 4); }
    for (int it = blockIdx.x; it < NBH * NCHO; it += gridDim.x) {
        const int pc = it % NCHO + PC0, bh = it / NCHO, h = bh % HGH, b = bh / HGH, row0 = hg_row0(b, pc);
        { const int it2 = min(it + (int)gridDim.x, NBH * NCHO - 1); const int pc2 = it2 % NCHO + PC0, bh2 = it2 / NCHO, h2 = bh2 % HGH, b2 = bh2 / HGH;
            const bf16_t* pr = p.P + (size_t)(hg_row0(b2, pc2) + t) * INC + h2 * 64 + cg * 8; nzf = *(const u32x4*)(pr + OFF_); nzb = *(const u32x4*)(pr + OFB); nv8 = *(const u32x4*)(pr + OHI); nq8 = *(const u32x4*)(pr + OHQ); ng8 = *(const u32x4*)(pr + OHG_);
            HG_LOADSIN(nbsin, bh2, pc2); }
        hg_gates(tid, p, l, h, zf, zb, lds);
        {
            float w[6][8];
            float af8[8], ab8[8], rf8[8], rb8[8], ff8[8], fb8[8];
            HGLD8(af8, AF, t, cg * 8); HGLD8(ab8, AB, t, cg * 8); HGLD8(rf8, AF, 31, cg * 8); HGLD8(rb8, AB, 32, cg * 8); HGLD8(ff8, FF, t, cg * 8); HGLD8(fb8, FB, t, cg * 8);
#pragma unroll
            for (int j = 0; j < 8; ++j) {
                const int k = cg * 8 + j;
                const float qv = bf8(q8, j) * 0.125f, af = af8[j], ab = ab8[j], rf = rf8[j], rb = rb8[j];
                w[0][j] = qv * __expf(fminf(af - rf, 80.f)); w[1][j] = (1.f - ff8[j]) * __expf(fminf(rf - af, 80.f)); w[2][j] = qv * __expf(af);
                w[3][j] = qv * __expf(fminf(ab - rb, 80.f)); w[4][j] = (1.f - fb8[j]) * __expf(fminf(rb - ab, 80.f)); w[5][j] = qv * __expf(ab);
            }
            *(LAS u32x4*)(lds + HG_VT + t * 144 + cg * 16) = v8;
#pragma unroll
            for (int a = 0; a < 6; ++a) { u32x4 o; o.x = cvt_pk_bf16(w[a][0], w[a][1]); o.y = cvt_pk_bf16(w[a][2], w[a][3]); o.z = cvt_pk_bf16(w[a][4], w[a][5]); o.w = cvt_pk_bf16(w[a][6], w[a][7]);
                *(LAS u32x4*)(lds + HG_T0 + a * HG_TS + t * 144 + cg * 16) = o; }
        }
        LDS_BAR();
        {
            const int dir = wave >> 2, tt = wave & 3;
            const LAS unsigned char* QT = lds + HG_T0 + (dir * 3 + 0) * HG_TS; const LAS unsigned char* KL = lds + HG_T0 + (dir * 3 + 1) * HG_TS; const LAS unsigned char* QH = lds + HG_T0 + (dir * 3 + 2) * HG_TS;
            bf16x8 bq[2], bh[2];
#pragma unroll
            for (int ks = 0; ks < 2; ++ks) { bq[ks] = *(const LAS bf16x8*)(QT + (tt * 16 + fr) * 144 + ks * 64 + fq * 16); bh[ks] = *(const LAS bf16x8*)(QH + (tt * 16 + fr) * 144 + ks * 64 + fq * 16); }
            f32x4 o[4];
#pragma unroll
            for (int vt = 0; vt < 4; ++vt) { o[vt] = (f32x4){0.f, 0.f, 0.f, 0.f};
#pragma unroll
                for (int ks = 0; ks < 2; ++ks) o[vt] = mfma16(bsin[vt][ks], bh[ks], o[vt]); }
            const int t_ = 16 * tt + fr;
#pragma unroll
            for (int kp = 0; kp < 2; ++kp) {
                f32x4 sc[2];
#pragma unroll
                for (int hf = 0; hf < 2; ++hf) { const int st = 2 * kp + hf;
                    sc[hf] = (f32x4){0.f, 0.f, 0.f, 0.f};
                    if (dir ? st >= tt : st <= tt) {
#pragma unroll
                        for (int ks = 0; ks < 2; ++ks) { const bf16x8 a = *(const LAS bf16x8*)(KL + (st * 16 + fr) * 144 + ks * 64 + fq * 16); sc[hf] = mfma16(a, bq[ks], sc[hf]); }
#pragma unroll
                        for (int r = 0; r < 4; ++r) { const int s_ = 16 * st + 4 * fq + r; const bool keep = dir ? (s_ >= t_) : (s_ <= t_); sc[hf][r] = keep ? sc[hf][r] : 0.f; }
                    } }
                if (dir ? (2 * kp + 1 >= tt) : (2 * kp <= tt)) {
                    u32x4 pw; pw.x = cvt_pk_bf16(sc[0][0], sc[0][1]); pw.y = cvt_pk_bf16(sc[0][2], sc[0][3]); pw.z = cvt_pk_bf16(sc[1][0], sc[1][1]); pw.w = cvt_pk_bf16(sc[1][2], sc[1][3]);
                    const bf16x8 pf = __builtin_bit_cast(bf16x8, pw);
                    const int s0 = 32 * kp + 4 * fq;
#pragma unroll
                    for (int vt = 0; vt < 4; ++vt) { const LAS unsigned char* vr = lds + HG_VT + (32 * kp + 4 * fq + (fr >> 2)) * 144 + 8 * (fr & 3) + vt * 32;
                        o[vt] = mfma16(ld2tr(vr, vr + 16 * 144), pf, o[vt]); }
                }
            }
            LAS float* OOd = (LAS float*)(lds + (dir ? HG_FB : HG_FF));
#pragma unroll
            for (int vt = 0; vt < 4; ++vt) *(LAS f32x4*)(OOd + HGI(t_, 16 * vt + 4 * fq)) = o[vt];
        }
        LDS_BAR();
        {
            float o[8]; float ss = 0.f;
            float of8[8], ob8[8]; HGLD8(of8, FF, t, cg * 8); HGLD8(ob8, FB, t, cg * 8);
#pragma unroll
            for (int j = 0; j < 8; ++j) { o[j] = of8[j] + ob8[j]; ss += o[j] * o[j]; }
            ss = oct_sum(ss);
            const float rstd = 1.f / sqrtf(ss * (1.f / 64.f) + EPS);
            float y[8];
#pragma unroll
            for (int j = 0; j < 8; ++j) { const float g = bf8(g8, j); y[j] = o[j] * rstd * (j < 4 ? hn0[j & 3] : hn1[j & 3]) * g * __builtin_amdgcn_rcpf(1.f + __expf(-g)); }
            u32x4 ov; ov.x = cvt_pk_bf16(y[0], y[1]); ov.y = cvt_pk_bf16(y[2], y[3]); ov.z = cvt_pk_bf16(y[4], y[5]); ov.w = cvt_pk_bf16(y[6], y[7]);
            zf = nzf; zb = nzb; v8 = nv8; q8 = nq8; g8 = ng8;
#pragma unroll
            for (int vt = 0; vt < 4; ++vt) { bsin[vt][0] = nbsin[vt][0]; bsin[vt][1] = nbsin[vt][1]; }
            asm volatile("" ::: "memory");
            *(u32x4*)(p.MIX + (size_t)(row0 + t) * MIXD + 384 + h * 64 + cg * 8) = ov;
        }
        LDS_BAR();
    }
}


#undef HG_LOADSIN
constexpr int AT_KC = 0, AT_VCT = 36864, AT_KL = AT_VCT + 256 * 144, AT_VL = AT_KL + 3 * 9216, AT_RPB = AT_VL + 3 * 9216, AT_END = AT_RPB + 1920;
static_assert(AT_END <= RING_BYTES && CTX == 256, "attention LDS layout (built for 256 context tokens)");
constexpr float ATHR = 6.f;
template <bool LOCAL, int NKB>
__device__ __forceinline__ void attn_scores(const LAS unsigned char* Kb, const bf16x8 (&qb)[2], f32x4 (&sc)[2 * NKB], int fr, int fq, const LAS float* rpb_row, const int (&boff)[8]) {
#pragma unroll
    for (int mt = 0; mt < 2 * NKB; ++mt) { sc[mt] = (f32x4){0.f, 0.f, 0.f, 0.f};
#pragma unroll
        for (int ks = 0; ks < 2; ++ks) { const bf16x8 a = *(const LAS bf16x8*)(Kb + (16 * mt + fr) * 144 + ks * 64 + fq * 16); sc[mt] = mfma16(a, qb[ks], sc[mt]); } }
    if (LOCAL) {
#pragma unroll
        for (int mt = 0; mt < 2 * NKB; ++mt)
#pragma unroll
            for (int r = 0; r < 4; ++r) sc[mt][r] += *(const LAS float*)((const LAS unsigned char*)rpb_row + boff[(4 * mt + r) & 7]);
    }
}
template <bool LOCAL, int NKB>
__device__ __forceinline__ void attn_spv(const f32x4 (&sc)[2 * NKB], const LAS unsigned char* Vb, f32x4 (&o)[4], float& m, float& lsum, int lane, int vtr) {
    float mx = -INFINITY;
#pragma unroll
    for (int mt = 0; mt < 2 * NKB; ++mt)
#pragma unroll
        for (int r = 0; r < 4; ++r) mx = fmaxf(mx, sc[mt][r]);
    if (__builtin_amdgcn_ballot_w64(mx > m + ATHR) != 0ull) {
        mx = fmaxf(mx, __builtin_bit_cast(float, __builtin_amdgcn_ds_swizzle(__builtin_bit_cast(int, mx), (16 << 10) | 0x1f)));
        mx = fmaxf(mx, __builtin_bit_cast(float, __builtin_amdgcn_ds_bpermute((lane ^ 32) << 2, __builtin_bit_cast(int, mx))));
        const float mn = fmaxf(m, mx), corr = __builtin_amdgcn_exp2f(m - mn);
        m = mn; lsum *= corr;
#pragma unroll
        for (int dt = 0; dt < 4; ++dt) o[dt] = o[dt] * corr;
    }
    float ps = 0.f;
#pragma unroll
    for (int kb = 0; kb < NKB; ++kb) {
        float pv[8];
#pragma unroll
        for (int h2 = 0; h2 < 2; ++h2)
#pragma unroll
            for (int r = 0; r < 4; ++r) { const float e = __builtin_amdgcn_exp2f(sc[2 * kb + h2][r] - m); pv[4 * h2 + r] = e; ps += e; }
        u32x4 pw; pw.x = cvt_pk_bf16(pv[0], pv[1]); pw.y = cvt_pk_bf16(pv[2], pv[3]); pw.z = cvt_pk_bf16(pv[4], pv[5]); pw.w = cvt_pk_bf16(pv[6], pv[7]);
        const bf16x8 pf = __builtin_bit_cast(bf16x8, pw);
#pragma unroll
        for (int dt = 0; dt < 4; ++dt) {
            const LAS unsigned char* vr = Vb + vtr + kb * (32 * 144) + dt * 32;
            o[dt] = mfma16(ld2tr(vr, vr + 16 * 144), pf, o[dt]);
        }
    }
    lsum += ps;
}
__device__ __forceinline__ void phase_attn(const int tid, PRef p, int l, LAS unsigned char* lds) {
    const int wave = tid >> 6, lane = tid & 63, fr = lane & 15, fq = lane >> 4, skey = tid >> 3, sc8 = tid & 7;
    LAS float* RPB = (LAS float*)(lds + AT_RPB);
    constexpr int NPAIR = ROWS / 2; const int IPB = NPAIR + ((l + 1 < DEPTH) ? 2 : 0);
    const int G_ = gridDim.x, NIT = NB * NAH * IPB;
#ifndef AT_DEAL_A
#define AT_DEAL_A 9
#define AT_DEAL_B 2
#endif
    const bool deal = (G_ == 256 && NIT <= 160 * AT_DEAL_A + 96 * AT_DEAL_B);
    const int it_lo = deal ? ((int)blockIdx.x < 160 ? (int)blockIdx.x * AT_DEAL_A : 160 * AT_DEAL_A + ((int)blockIdx.x - 160) * AT_DEAL_B) : (int)blockIdx.x;
    const int it_n = deal ? ((int)blockIdx.x < 160 ? AT_DEAL_A : AT_DEAL_B) : (NIT - (int)blockIdx.x + G_ - 1) / G_;
    int last_bh = -1;
#define AT_QTOK(itx) (((itx) % IPB) < NPAIR ? (((itx) / IPB) / NAH) * SEQ + (2 * ((itx) % IPB) + (wave >> 2)) * GW + 16 * (wave & 3) + fr : NLAT + (((itx) / IPB) / NAH) * CTX + ((((itx) % IPB) - NPAIR) * 128 + 16 * wave) + fr)
#define AT_LOADQ(itx, dst) do { const bf16_t* qp_ = p.P + (size_t)AT_QTOK(itx) * INC + OQ + (((itx) / IPB) % NAH) * 64 + fq * 8; dst[0] = *(const bf16x8*)qp_; dst[1] = *(const bf16x8*)(qp_ + 32); } while (0)
    bf16x8 qnx[2] = {(bf16x8){0, 0, 0, 0, 0, 0, 0, 0}, (bf16x8){0, 0, 0, 0, 0, 0, 0, 0}};
    { const int it0 = it_lo; if (it_n > 0 && it0 < NIT) AT_LOADQ(it0, qnx); }
    for (int ii = 0; ii < it_n; ++ii) {
        const int it = deal ? it_lo + ii : it_lo + ii * G_;
        if (it >= NIT) break;
        const int sub = it % IPB, bh = it / IPB, head = bh % NAH, b = bh / NAH;
        const bool islat = sub < NPAIR;
        const int r0 = 2 * sub, qr = r0 + (wave >> 2), jb = wave & 3;
        LDS_BAR();
        if (bh != last_bh) {
            last_bh = bh;
            int sc8l = sc8; asm volatile("" : "+v"(sc8l));
            for (int rnd = 0; rnd < 4; ++rnd) {
                const int key = skey + 64 * rnd; const bf16_t* src = p.P + (size_t)(NLAT + b * CTX + key) * INC + head * 64 + sc8l * 8;
                const u32x4 kv = *(const u32x4*)(src + OK_), vv = *(const u32x4*)(src + OV);
                *(LAS u32x4*)(lds + AT_KC + key * 144 + sc8 * 16) = kv; *(LAS u32x4*)(lds + AT_VCT + key * 144 + sc8 * 16) = vv;
            }
            { int t2 = tid; asm volatile("" : "+v"(t2));
              if (t2 < 15 * 32) RPB[t2] = (t2 & 31) < 31 ? p.rpb[((size_t)l * NAH + head) * 465 + (t2 >> 5) * 31 + (t2 & 31)] * 1.44269504089f : -INFINITY; }
        }
        const int qtok = islat ? b * SEQ + qr * GW + 16 * jb + fr : NLAT + b * CTX + ((sub - NPAIR) * 128 + 16 * wave) + fr;
        bf16x8 qb[2]; qb[0] = qnx[0]; qb[1] = qnx[1];
        { const int itn = deal ? it + 1 : it + G_; if (ii + 1 < it_n && itn < NIT) { int fr = (tid & 15); asm volatile("" : "+v"(fr)); AT_LOADQ(itn, qnx); } }
        int krlo = 0, krhi = -1, rs = 0;
        if (islat) { int a = r0 - 4; a = a < 0 ? 0 : (a > ROWS - 8 ? ROWS - 8 : a); int c = r0 + 1 - 4; c = c < 0 ? 0 : (c > ROWS - 8 ? ROWS - 8 : c); krlo = a; krhi = c + 7;
            rs = qr - 4; rs = rs < 0 ? 0 : (rs > ROWS - 8 ? ROWS - 8 : rs); }
        u32x4 kA = (u32x4){0u, 0u, 0u, 0u}, vA = kA, kB = kA, vB = kA, kC = kA, vC = kA;
        int skl = skey; asm volatile("" : "+v"(skl));
#define AT_LOADROW(row, kd, vd) do { const bf16_t* src_ = p.P + (size_t)(b * SEQ + (row) * GW + skl) * INC + head * 64 + sc8 * 8; kd = *(const u32x4*)(src_ + OK_); vd = *(const u32x4*)(src_ + OV); } while (0)
#define AT_STAGEROW(bufi, kd, vd) do { *(LAS u32x4*)(lds + AT_KL + (bufi) * 9216 + skey * 144 + sc8 * 16) = kd; *(LAS u32x4*)(lds + AT_VL + (bufi) * 9216 + skey * 144 + sc8 * 16) = vd; } while (0)
        if (islat) { AT_LOADROW(krlo, kA, vA); AT_LOADROW(krlo + 1, kB, vB); AT_LOADROW(krlo + 2, kC, vC); }
        f32x4 o[4]; float m = -1e30f, lsum = 0.f;
#pragma unroll
        for (int dt = 0; dt < 4; ++dt) o[dt] = (f32x4){0.f, 0.f, 0.f, 0.f};
        LDS_BAR();
        const int bs = jb == 0 ? 0 : (jb == 1 ? 8 : (jb == 2 ? 24 : 32)), qc = 16 * jb + fr;
        int boff[8];
        { int ws = qc - 8; ws = ws < 0 ? 0 : (ws > 48 ? 48 : ws);
#pragma unroll
          for (int j_ = 0; j_ < 8; ++j_) { const int kc = bs + 16 * (j_ >> 2) + 4 * fq + (j_ & 3); const bool ok = kc >= ws && kc < ws + 16; boff[j_] = (ok ? kc - qc + 15 : 31) * 4; asm volatile("" : "+v"(boff[j_])); } }
        int vtr = (4 * fq + (fr >> 2)) * 144 + 8 * (fr & 3); asm volatile("" : "+v"(vtr));
        const int vtrl = vtr + bs * 144;
        {
            f32x4 sa[4], sb[4];
#define AT_CS(st, dst) attn_scores<false, 2>(lds + AT_KC + (st) * 64 * 144, qb, dst, fr, fq, RPB, boff)
#define AT_CP(st, src) attn_spv<false, 2>(src, lds + AT_VCT + (st) * 64 * 144, o, m, lsum, lane, vtr)
            AT_CS(0, sa); AT_CS(1, sb); AT_CP(0, sa); AT_CS(2, sa); AT_CP(1, sb); AT_CS(3, sb); AT_CP(2, sa); AT_CP(3, sb);
#undef AT_CS
#undef AT_CP
        }
        if (islat) { AT_STAGEROW(0, kA, vA); AT_LOADROW(krlo + 3, kA, vA); AT_STAGEROW(1, kB, vB); AT_LOADROW(krlo + 4, kB, vB); }
        LDS_BAR();
        if (islat) {
            const bool first0 = rs == krlo, last8 = !first0;
            const LAS float* rp = RPB + (krlo - qr + 7) * 32;
            f32x4 sa[2], sb[2];
#define AT_S(j, dst) attn_scores<true, 1>(lds + AT_KL + ((j) % 3) * 9216 + bs * 144, qb, dst, fr, fq, rp + 32 * (j), boff)
#define AT_P(j, src) attn_spv<true, 1>(src, lds + AT_VL + ((j) % 3) * 9216, o, m, lsum, lane, vtrl)
#define AT_MID(j, NK, NV, LOADROWX, SCUR, SNXT) { AT_STAGEROW(((j) + 2) % 3, NK, NV); if ((LOADROWX) >= 0) { AT_LOADROW(min(krlo + (LOADROWX), krhi), NK, NV); } \
            AT_S((j) + 1, SNXT); AT_P(j, SCUR); LDS_BAR(); }
            sa[0] = (f32x4){0.f, 0.f, 0.f, 0.f}; sa[1] = sa[0];
            if (first0) AT_S(0, sa);
            { AT_STAGEROW(2, kC, vC); AT_LOADROW(krlo + 5, kC, vC); AT_S(1, sb); if (first0) AT_P(0, sa); LDS_BAR(); }
            AT_MID(1, kA, vA, 6, sb, sa) AT_MID(2, kB, vB, 7, sa, sb) AT_MID(3, kC, vC, 8, sb, sa) AT_MID(4, kA, vA, -1, sa, sb) AT_MID(5, kB, vB, -1, sb, sa) AT_MID(6, kC, vC, -1, sa, sb)
            if (last8) { AT_S(8, sa); AT_P(7, sb); AT_P(8, sa); } else { AT_P(7, sb); }
#undef AT_S
#undef AT_P
#undef AT_MID
        }
#undef AT_LOADROW
#undef AT_STAGEROW
        lsum = x32_sum(x16_sum(lsum, lane), lane);
        const float inv = 1.f / lsum;
        bf16_t* orow = p.MIX + (size_t)qtok * MIXD + head * 64;
#pragma unroll
        for (int dt = 0; dt < 4; ++dt) { u32x2 w; w.x = cvt_pk_bf16(o[dt][0] * inv, o[dt][1] * inv); w.y = cvt_pk_bf16(o[dt][2] * inv, o[dt][3] * inv); *(u32x2*)(orow + 16 * dt + 4 * fq) = w; }
    }
}


#undef AT_QTOK
#undef AT_LOADQ
template <int MODE> __device__ __forceinline__ void mini_gemm(const int tid, PRef p, int l) {
    const int wave = tid >> 6, lane = tid & 63, fr = lane & 15, fq = lane >> 4;
    const int gw = blockIdx.x * NWAVES + wave, NGW = gridDim.x * NWAVES;
    constexpr int K = MODE == 3 ? ED : (MODE == 1 ? MIXD : D);
    constexpr int N = MODE == 0 ? INC : (MODE == 2 ? 2 * ED : D);
    constexpr int MROWS = MODE <= 1 ? NCTX : NSLOT_C;
    constexpr int NTC = MODE == 2 ? 2 : 1, TW = 16 * NTC;
    constexpr int NTN = N / TW, NT = (MROWS / 32) * NTN;
    for (int t = gw; t < NT; t += NGW) {
        const int rt = t / NTN, ct = t % NTN, c0 = ct * TW;
        const bf16_t* Bt; const bf16_t* arow[2];
        if (MODE == 0) { Bt = p.WIN_T + WBOFF(l); for (int mt = 0; mt < 2; ++mt) arow[mt] = p.H + (size_t)(NLAT + rt * 32 + 16 * mt + fr) * D; }
        else if (MODE == 1) { Bt = p.WOUT_T + WBOFF(l); for (int mt = 0; mt < 2; ++mt) arow[mt] = p.MIX + (size_t)(NLAT + rt * 32 + 16 * mt + fr) * MIXD; }
        else if (MODE == 2) { const int e = rt % NE; Bt = p.WGU_T + WBOFF(l) + (size_t)e * 2 * ED * D;
            for (int mt = 0; mt < 2; ++mt) { int row = p.STOK[NSLOT_L + rt * 32 + 16 * mt + fr]; row = row < 0 ? 0 : (row >= NTOK ? NTOK - 1 : row); arow[mt] = p.H + (size_t)row * D; } }
        else { const int e = rt % NE; Bt = p.WD_T + WBOFF(l) + (size_t)e * D * ED; for (int mt = 0; mt < 2; ++mt) arow[mt] = p.HID + (size_t)(NSLOT_L + rt * 32 + 16 * mt + fr) * ED; }
        const bf16_t* brow = Bt + (size_t)(c0 + fr) * K;
        f32x4 acc[2][NTC];
#pragma unroll
        for (int mt = 0; mt < 2; ++mt)
#pragma unroll
            for (int nt = 0; nt < NTC; ++nt) acc[mt][nt] = (f32x4){0.f, 0.f, 0.f, 0.f};
#pragma unroll 8
        for (int ks = 0; ks < K / 32; ++ks) {
            bf16x8 a[2], bfr[NTC];
#pragma unroll
            for (int mt = 0; mt < 2; ++mt) a[mt] = *(const bf16x8*)(arow[mt] + ks * 32 + fq * 8);
#pragma unroll
            for (int nt = 0; nt < NTC; ++nt) bfr[nt] = *(const bf16x8*)(brow + (size_t)(16 * nt) * K + ks * 32 + fq * 8);
#pragma unroll
            for (int mt = 0; mt < 2; ++mt)
#pragma unroll
                for (int nt = 0; nt < NTC; ++nt) acc[mt][nt] = mfma16(a[mt], bfr[nt], acc[mt][nt]);
        }
#pragma unroll
        for (int mt = 0; mt < 2; ++mt)
#pragma unroll
            for (int r = 0; r < 4; ++r) {
                const int lr = rt * 32 + 16 * mt + 4 * fq + r;
                if (MODE == 0) { bf16_t* o = p.P + (size_t)(NLAT + lr) * INC + c0 + fr;
#pragma unroll
                    for (int nt = 0; nt < NTC; ++nt) o[16 * nt] = f2bf(acc[mt][nt][r]); }
                else if (MODE == 1) { float* o = p.XC + (size_t)lr * D + c0 + fr; const float* g = p.MOD + ((size_t)l * 3 + 2) * NMOD + 2 * D + c0 + fr;
#pragma unroll
                    for (int nt = 0; nt < NTC; ++nt) o[16 * nt] += g[16 * nt] * acc[mt][nt][r]; }
                else if (MODE == 2) { bf16_t* o = p.HID + (size_t)(NSLOT_L + lr) * ED + c0 / 2 + fr;
#pragma unroll
                    for (int q = 0; q < NTC / 2; ++q) { const float g = acc[mt][2 * q][r], u = acc[mt][2 * q + 1][r]; o[16 * q] = f2bf(g / (1.f + __expf(-g)) * u); } }
                else { bf16_t* o = p.Y + (size_t)(NSLOT_L + lr) * D + c0 + fr; const float val = p.SVAL[NSLOT_L + lr];
#pragma unroll
                    for (int nt = 0; nt < NTC; ++nt) o[16 * nt] = f2bf(val * acc[mt][nt][r]); }
            }
    }
}


__device__ __forceinline__ void phase_conv(const int tid, PRef p, int l) {
    const float* w = p.conv_w + (size_t)l * 3 * CVD;
    constexpr int U = 2;
    const long nitem = (long)NTOK * (CVD / 8), gstr = (long)gridDim.x * NTHR;
    for (long g0 = (long)blockIdx.x * NTHR + tid; g0 < nitem; g0 += gstr * U) {
        u32x4 cc[U][3], uu[U][3], bg[U]; float vz[U][3]; int rr[U], c8v[U]; bool ok[U];
#pragma unroll
        for (int u = 0; u < U; ++u) {
            long gid = g0 + u * gstr; ok[u] = gid < nitem; if (!ok[u]) gid = g0;
            const int r = (int)(gid / (CVD / 8)), c8 = (int)(gid % (CVD / 8)) * 8; rr[u] = r; c8v[u] = c8;
            int t, T; if (r < NLAT) { t = r % SEQ; T = SEQ; } else { t = (r - NLAT) % CTX; T = CTX; }
            const bf16_t* pr = p.P + (size_t)r * INC + c8;
#pragma unroll
            for (int d = 0; d < 3; ++d) { const int tt = t + d - 1; const bool in = tt >= 0 && tt < T; vz[u][d] = in ? 1.f : 0.f;
                const bf16_t* q = pr + (in ? (long)(d - 1) * INC : 0L); cc[u][d] = *(const u32x4*)(q + OCC); uu[u][d] = *(const u32x4*)(q + OCU); }
            bg[u] = *(const u32x4*)(pr + OCB);
        }
        asm volatile("" ::: "memory");
#pragma unroll
        for (int u = 0; u < U; ++u) {
            float y[8];
#pragma unroll
            for (int j = 0; j < 8; ++j) y[j] = 0.f;
#pragma unroll
            for (int d = 0; d < 3; ++d) {
                const f32x4 w0 = *(const f32x4*)(w + d * CVD + c8v[u]) * vz[u][d], w1 = *(const f32x4*)(w + d * CVD + c8v[u] + 4) * vz[u][d];
#pragma unroll
                for (int j = 0; j < 8; ++j) y[j] += (j < 4 ? w0[j & 3] : w1[j & 3]) * bf8(cc[u][d], j) * bf8(uu[u][d], j);
            }
            u32x4 o; o.x = cvt_pk_bf16(bf8(bg[u], 0) * y[0], bf8(bg[u], 1) * y[1]); o.y = cvt_pk_bf16(bf8(bg[u], 2) * y[2], bf8(bg[u], 3) * y[3]);
            o.z = cvt_pk_bf16(bf8(bg[u], 4) * y[4], bf8(bg[u], 5) * y[5]); o.w = cvt_pk_bf16(bf8(bg[u], 6) * y[6], bf8(bg[u], 7) * y[7]);
            if (ok[u]) *(u32x4*)(p.MIX + (size_t)rr[u] * MIXD + 768 + c8v[u]) = o;
        }
    }
}
__device__ __forceinline__ void phase_qkprep(const int tid, PRef p, int l) {
    const int sub = tid & 7;
    constexpr int U = 4;
    const long ngroups = (long)NTOK * 12, gstride = ((long)gridDim.x * NTHR) >> 3;
    for (long g0 = ((long)blockIdx.x * NTHR + tid) >> 3; g0 < ngroups; g0 += gstride * U) {
        u32x4 raw[U]; bf16_t* ptr[U]; int rr[U]; int wh[U];
#pragma unroll
        for (int u = 0; u < U; ++u) { long g8 = g0 + u * gstride; const bool ok = g8 < ngroups; if (!ok) g8 = g0;
            rr[u] = ok ? (int)(g8 / 12) : -1; wh[u] = (int)(g8 % 12) / 6; const int head = (int)(g8 % 6);
            ptr[u] = p.P + (size_t)(g8 / 12) * INC + (wh[u] ? OK_ : OQ) + head * HD + sub * 8; raw[u] = *(const u32x4*)ptr[u]; }
#pragma unroll
        for (int u = 0; u < U; ++u) {
            const float* nw = (wh[u] ? p.k_norm : p.q_norm) + l * HD + sub * 8;
            float y[8]; float ss = 0.f;
#pragma unroll
            for (int j = 0; j < 8; ++j) { y[j] = bf8(raw[u], j); ss += y[j] * y[j]; }
            ss = oct_sum(ss);
            const float rstd = 1.f / sqrtf(ss * (1.f / HD) + EPS);
#pragma unroll
            for (int j = 0; j < 8; ++j) y[j] = y[j] * rstd * nw[j];
            const int r = rr[u];
            const bool lat = r >= 0 && r < NLAT;
            const int t = lat ? r % SEQ : 0; const float pos = (sub & 4) ? (float)(t % GW) : (float)(t / GW);
            const bool second = (sub & 2) != 0;
#pragma unroll
            for (int j = 0; j < 8; ++j) {
                const float other = __builtin_bit_cast(float, __builtin_amdgcn_ds_swizzle(__builtin_bit_cast(int, y[j]), (2 << 10) | 0x1f));
                const int fi = (sub & 1) * 8 + j;
                const float ang = pos * __builtin_amdgcn_exp2f(-(float)fi * (13.287712379549449f / 16.f));
                const float cs = FCOS(ang), sn = FSIN(ang);
                const float rot = second ? y[j] * cs + other * sn : y[j] * cs - other * sn;
                y[j] = lat ? rot : y[j];
            }
            if (r >= 0) { u32x4 o; o.x = cvt_pk_bf16(y[0], y[1]); o.y = cvt_pk_bf16(y[2], y[3]); o.z = cvt_pk_bf16(y[4], y[5]); o.w = cvt_pk_bf16(y[6], y[7]); *(u32x4*)ptr[u] = o; }
        }
    }
}

__device__ __forceinline__ f32x4 bf4(const u32x2 w) { return (f32x4){bfw(w.x, 0), bfw(w.x, 1), bfw(w.y, 0), bfw(w.y, 1)}; }
template <int MODE> __device__ __forceinline__ void phase_rows(const int tid, PRef p, int l, LAS unsigned char* lds) {
    static_assert(D == 1024, "wave-per-row kernels assume D = 1024");
    const int lane = tid & 63, wave = tid >> 6;
#define RC(j) (8 * lane + 512 * ((j) >> 1) + 4 * ((j) & 1))
    if (MODE == 1) {
        for (int k = tid; k < D; k += NTHR) { const f32x4* src = (const f32x4*)(p.w_router + ((size_t)l * D + k) * NE); LAS f32x4* dst = (LAS f32x4*)(lds + k * 64 + (k >> 3) * 16);
#pragma unroll
            for (int u = 0; u < 4; ++u) dst[u] = src[u]; }
        __syncthreads();
    }
    const int gw = blockIdx.x * NWAVES + wave, NGW = gridDim.x * NWAVES;
    const int rw = ((NTOK + NGW - 1) / NGW + 1) & ~1;
    const int r_lo = gw * rw, r_hi = min(NTOK, r_lo + rw);
    const bool doh = MODE != 2 || l + 1 < DEPTH;
    const int ln = (MODE == 2 && l + 1 < DEPTH) ? l + 1 : l;
    const float* nw = (MODE == 1 ? p.norm2_w : p.norm1_w) + (size_t)ln * D;
    int curset = -1; f32x4 Av[4], Sv[4], Gv[4];
#pragma unroll
    for (int j = 0; j < 4; ++j) { Av[j] = (f32x4){0.f, 0.f, 0.f, 0.f}; Sv[j] = Av[j]; Gv[j] = Av[j]; }
    constexpr int NVN = MODE == 0 ? 4 : 2;
    u32x4 vn[2][NVN]; int invn[2] = {-1, -1};
#define ROWS_LOADPAIR(rb) do { _Pragma("unroll") for (int i_ = 0; i_ < 2; ++i_) { const int rr_ = ((rb) + i_ < r_hi) ? (rb) + i_ : (rb); \
        if (MODE == 0) { const float* src_ = rr_ < NLAT ? p.x + (size_t)rr_ * D : p.ctx + (size_t)(rr_ - NLAT) * D; \
            _Pragma("unroll") for (int j_ = 0; j_ < NVN; ++j_) vn[i_][j_] = *(const u32x4*)(src_ + RC(j_)); } \
        else if (rr_ < NLAT) { const bf16_t* src_ = p.XB + (size_t)rr_ * D + 8 * lane; vn[i_][0] = *(const u32x4*)src_; vn[i_][1] = *(const u32x4*)(src_ + 512); } \
        if (MODE == 2) invn[i_] = lane < NE ? p.INV[(size_t)rr_ * NE + lane] : -1; } } while (0)
#pragma unroll
    for (int i = 0; i < 2; ++i)
#pragma unroll
        for (int j = 0; j < NVN; ++j) vn[i][j] = (u32x4){0u, 0u, 0u, 0u};
    if (r_lo < r_hi) ROWS_LOADPAIR(r_lo);
#pragma unroll 1
    for (int r = r_lo; r < r_hi; r += 2) {
        const bool two = r + 1 < r_hi;
        const bool lat = r < NLAT;
        const int set = modset(r);
        if (set != curset) { curset = set;
            const float* mod = p.MOD + ((size_t)ln * 3 + set) * NMOD; const float* shift = mod + (MODE == 1 ? 3 : 0) * D; const float* scale = mod + (MODE == 1 ? 4 : 1) * D;
            int lane2 = lane; asm volatile("" : "+v"(lane2));
#pragma unroll
            for (int j = 0; j < 4; ++j) { const int c = 8 * lane2 + 512 * (j >> 1) + 4 * (j & 1); const f32x4 w4 = *(const f32x4*)(nw + c), sc4 = *(const f32x4*)(scale + c); Av[j] = w4 * (sc4 + 1.f); Sv[j] = *(const f32x4*)(shift + c);
                if (MODE == 2) Gv[j] = *(const f32x4*)(p.MOD + ((size_t)l * 3 + set) * NMOD + 5 * D + c); } }
        f32x4 v[2][4]; int inv2[2];
#pragma unroll
        for (int i = 0; i < 2; ++i) { inv2[i] = invn[i];
            if (MODE == 0) {
#pragma unroll
                for (int j = 0; j < 4; ++j) v[i][j] = __builtin_bit_cast(f32x4, vn[i][j < NVN ? j : 0]);
            } else if (lat) {
#pragma unroll
                for (int jj = 0; jj < 2; ++jj) { const u32x4 w = vn[i][jj]; v[i][2 * jj] = (f32x4){bfw(w.x, 0), bfw(w.x, 1), bfw(w.y, 0), bfw(w.y, 1)}; v[i][2 * jj + 1] = (f32x4){bfw(w.z, 0), bfw(w.z, 1), bfw(w.w, 0), bfw(w.w, 1)}; }
            } else { const float* src = p.XC + (size_t)(r + ((i == 0 || two) ? i : 0) - NLAT) * D;
#pragma unroll
                for (int j = 0; j < 4; ++j) v[i][j] = *(const f32x4*)(src + RC(j));
            } }
        if (r + 2 < r_hi) ROWS_LOADPAIR(r + 2);
        if (MODE == 2) {
            unsigned long long mk[2]; int sl[2][2];
#pragma unroll
            for (int i = 0; i < 2; ++i) { const int myinv = inv2[i]; mk[i] = __ballot(myinv >= 0 && myinv < NSLOT);
#pragma unroll
                for (int c = 0; c < 2; ++c) { sl[i][c] = -1; if (mk[i]) { const int e = __builtin_ctzll(mk[i]); mk[i] &= mk[i] - 1; sl[i][c] = __builtin_amdgcn_readlane(myinv, e); } } }
            u32x4 y[2][2][2];
#pragma unroll
            for (int i = 0; i < 2; ++i)
#pragma unroll
                for (int c = 0; c < 2; ++c) { y[i][c][0] = (u32x4){0u, 0u, 0u, 0u}; y[i][c][1] = y[i][c][0];
                    if (sl[i][c] >= 0) { const bf16_t* yp = p.Y + (size_t)sl[i][c] * D + 8 * lane; y[i][c][0] = *(const u32x4*)yp; y[i][c][1] = *(const u32x4*)(yp + 512); } }
            asm volatile("" ::: "memory");
#pragma unroll
            for (int i = 0; i < 2; ++i) {
                f32x4 acc[4];
#pragma unroll
                for (int j = 0; j < 4; ++j) acc[j] = (f32x4){0.f, 0.f, 0.f, 0.f};
#pragma unroll
                for (int c = 0; c < 2; ++c)
#pragma unroll
                    for (int jj = 0; jj < 2; ++jj) { const u32x4 w = y[i][c][jj];
                        acc[2 * jj] = acc[2 * jj] + (f32x4){bfw(w.x, 0), bfw(w.x, 1), bfw(w.y, 0), bfw(w.y, 1)}; acc[2 * jj + 1] = acc[2 * jj + 1] + (f32x4){bfw(w.z, 0), bfw(w.z, 1), bfw(w.w, 0), bfw(w.w, 1)}; }
                const int myinv = inv2[i];
                while (mk[i]) {
                    const int e = __builtin_ctzll(mk[i]); mk[i] &= mk[i] - 1; const int s0 = __builtin_amdgcn_readlane(myinv, e);
                    const bf16_t* yp = p.Y + (size_t)s0 * D + 8 * lane; const u32x4 w0 = *(const u32x4*)yp, w1 = *(const u32x4*)(yp + 512);
                    acc[0] = acc[0] + (f32x4){bfw(w0.x, 0), bfw(w0.x, 1), bfw(w0.y, 0), bfw(w0.y, 1)}; acc[1] = acc[1] + (f32x4){bfw(w0.z, 0), bfw(w0.z, 1), bfw(w0.w, 0), bfw(w0.w, 1)};
                    acc[2] = acc[2] + (f32x4){bfw(w1.x, 0), bfw(w1.x, 1), bfw(w1.y, 0), bfw(w1.y, 1)}; acc[3] = acc[3] + (f32x4){bfw(w1.z, 0), bfw(w1.z, 1), bfw(w1.w, 0), bfw(w1.w, 1)};
                }
#pragma unroll
                for (int j = 0; j < 4; ++j) v[i][j] = v[i][j] + Gv[j] * acc[j];
            }
        }
        if (MODE == 0 || MODE == 2) {
            const bool fin = MODE == 2 && l + 1 == DEPTH;
#pragma unroll
            for (int i = 0; i < 2; ++i) if (i == 0 || two) {
                if (lat && !fin) {
#pragma unroll
                    for (int jj = 0; jj < 2; ++jj) { u32x4 o; o.x = cvt_pk_bf16(v[i][2 * jj][0], v[i][2 * jj][1]); o.y = cvt_pk_bf16(v[i][2 * jj][2], v[i][2 * jj][3]); o.z = cvt_pk_bf16(v[i][2 * jj + 1][0], v[i][2 * jj + 1][1]); o.w = cvt_pk_bf16(v[i][2 * jj + 1][2], v[i][2 * jj + 1][3]);
                        *(u32x4*)(p.XB + (size_t)(r + i) * D + 8 * lane + 512 * jj) = o; }
                } else if (lat || !fin) { float* dst = lat ? p.XL + (size_t)(r + i) * D : p.XC + (size_t)(r + i - NLAT) * D;
#pragma unroll
                    for (int j = 0; j < 4; ++j) *(f32x4*)(dst + RC(j)) = v[i][j]; }
            }
        }
        if (doh) {
            float ss[2];
#pragma unroll
            for (int i = 0; i < 2; ++i) { float a = 0.f;
#pragma unroll
                for (int j = 0; j < 4; ++j) a += (v[i][j][0] * v[i][j][0] + v[i][j][1] * v[i][j][1]) + (v[i][j][2] * v[i][j][2] + v[i][j][3] * v[i][j][3]);
                ss[i] = a; }
            ss[0] = wave_sum(ss[0], lane); ss[1] = wave_sum(ss[1], lane);
            const float rstd0 = 1.f / sqrtf(ss[0] * (1.f / D) + EPS), rstd1 = 1.f / sqrtf(ss[1] * (1.f / D) + EPS);
            f32x4 hh[2][4];
#pragma unroll
            for (int j = 0; j < 4; ++j) { hh[0][j] = v[0][j] * rstd0 * Av[j] + Sv[j]; hh[1][j] = v[1][j] * rstd1 * Av[j] + Sv[j]; }
#pragma unroll
            for (int i = 0; i < 2; ++i) if (i == 0 || two) {
#pragma unroll
                for (int jj = 0; jj < 2; ++jj) { u32x4 o; o.x = cvt_pk_bf16(hh[i][2 * jj][0], hh[i][2 * jj][1]); o.y = cvt_pk_bf16(hh[i][2 * jj][2], hh[i][2 * jj][3]); o.z = cvt_pk_bf16(hh[i][2 * jj + 1][0], hh[i][2 * jj + 1][1]); o.w = cvt_pk_bf16(hh[i][2 * jj + 1][2], hh[i][2 * jj + 1][3]);
                    *(u32x4*)(p.H + (size_t)(r + i) * D + 8 * lane + 512 * jj) = o; } }
            if (MODE == 1) {
                LAS float* red = (LAS float*)(lds + 70144 + wave * 4224);
                LAS float* red1 = (LAS float*)(wave < 6 ? lds + 103936 + wave * 4224 : lds + LDSCTL_OFF + 1024 + (wave - 6) * 4224);
                const LAS unsigned char* wb = lds + lane * 528;
#pragma unroll
                for (int u = 0; u < 4; ++u) {
                    f32x4 a0 = (f32x4){0.f, 0.f, 0.f, 0.f}, a1 = a0;
#pragma unroll
                    for (int j = 0; j < 4; ++j)
#pragma unroll
                        for (int q = 0; q < 4; ++q) { const f32x4 w = *(const LAS f32x4*)(wb + (j >> 1) * 33792 + (4 * (j & 1) + q) * 64 + u * 16); const float h0 = hh[0][j][q], h1 = hh[1][j][q];
                            a0 = __builtin_elementwise_fma(w, (f32x4){h0, h0, h0, h0}, a0); a1 = __builtin_elementwise_fma(w, (f32x4){h1, h1, h1, h1}, a1); }
#pragma unroll
                    for (int c = 0; c < 4; ++c) { red[(4 * u + c) * 65 + lane] = a0[c]; red1[(4 * u + c) * 65 + lane] = a1[c]; }
                    asm volatile("" ::: "memory");
                }
#pragma unroll
                for (int i = 0; i < 2; ++i) {
                    const LAS float* rd = i ? red1 : red;
                    const int e2 = lane & 15, part = lane >> 4;
                    float t = 0.f;
#pragma unroll
                    for (int x = 0; x < 16; ++x) t += rd[e2 * 65 + part * 16 + x];
                    asm volatile("" ::: "memory");
                    t = x32_sum(x16_sum(t, lane), lane);
#define SWZF(x, d) __builtin_bit_cast(float, __builtin_amdgcn_ds_swizzle(__builtin_bit_cast(int, (x)), ((d) << 10) | 0x1f))
                    float m = t;
                    m = row16_max(m);
                    const float ex = expf(t - m); float sm = ex;
                    sm = row16_sum(sm);
#undef SWZF
                    if (lane < NE && (i == 0 || two)) p.AFF[(size_t)(r + i) * NE + lane] = ex / sm;
                }
            }
        }
    }
#undef ROWS_LOADPAIR
#undef RC
    if (MODE == 1) __syncthreads();
}


__device__ __forceinline__ void phase_adaln(const int tid, PRef p, LAS unsigned char* lds) {
    static_assert(D == 1024 && NMOD % 256 == 0, "adaln layout");
    const int lane = tid & 63, wave = tid >> 6;
    LAS float* SC = (LAS float*)lds;
    LAS float* RED = (LAS float*)(lds + 16384);
    for (int i = tid; i < 3 * D; i += NTHR) { const int st = i / D, k = i % D; const float cv = st < 2 ? p.c[st * D + k] : p.c_ctx[k]; SC[i] = cv / (1.f + __expf(-cv)); }
    __syncthreads();
    constexpr int NCG = NMOD / 256;
    for (int item = blockIdx.x; item < DEPTH * NCG * 2; item += gridDim.x) {
        const int l = item / (NCG * 2), rem = item % (NCG * 2), cgp = rem >> 1, kh = rem & 1;
        const int kbase = kh * 512 + wave * 64;
        const float* wp = p.w_mod + ((size_t)l * D + kbase) * NMOD + cgp * 256 + 4 * lane;
        f32x4 acc[3];
#pragma unroll
        for (int st = 0; st < 3; ++st) acc[st] = (f32x4){0.f, 0.f, 0.f, 0.f};
#pragma unroll 16
        for (int kk = 0; kk < 64; ++kk) { const f32x4 w = *(const f32x4*)(wp + (size_t)kk * NMOD);
#pragma unroll
            for (int st = 0; st < 3; ++st) acc[st] = acc[st] + w * SC[st * D + kbase + kk]; }
#pragma unroll
        for (int st = 0; st < 3; ++st) *(LAS f32x4*)(RED + (wave * 3 + st) * 256 + 4 * lane) = acc[st];
        __syncthreads();
        for (int o = tid; o < 3 * 256; o += NTHR) { const int st = o >> 8, n = o & 255; float v = 0.f;
#pragma unroll
            for (int w8 = 0; w8 < 8; ++w8) v += RED[(w8 * 3 + st) * 256 + n];
            if (kh == 0) v += p.b_mod[(size_t)l * NMOD + cgp * 256 + n];
            atomicAdd(p.MOD + ((size_t)l * 3 + st) * NMOD + cgp * 256 + n, v); }
        __syncthreads();
    }
}

constexpr int NPL = 11, NPH = 1 + DEPTH * NPL;
struct Args { Params p; int ph_lo, ph_hi; };
__global__ void __launch_bounds__(NTHR, 2) mega_fwd(Args args) {
    LAS unsigned char* lds = (LAS unsigned char*)lds_raw;
    {
        const int tid0 = threadIdx.x;
        for (int u = tid0; u < (LDS_BYTES - LDSCTL_OFF) / 4; u += NTHR) ((LAS unsigned*)(lds + LDSCTL_OFF))[u] = 0u;
        __syncthreads();
    }
    int wslot = 0;
    { unsigned m_ = ~0u; asm volatile("" : "+s"(m_));
      const int simd = (int)(__builtin_amdgcn_s_getreg((1 << 11) | (4 << 6) | 4) & 3u);
      if (__builtin_amdgcn_mbcnt_hi(m_, __builtin_amdgcn_mbcnt_lo(m_, 0u)) == 0) wslot = simd + 4 * (int)__hip_atomic_fetch_add(((unsigned*)(lds_raw + MISC_OFF + 64)) + simd, 1u, __ATOMIC_RELAXED, __HIP_MEMORY_SCOPE_WORKGROUP); }
    wslot = __builtin_amdgcn_readfirstlane(wslot) & 7;
#define MY_TID(var) int var; { unsigned m_ = ~0u; asm volatile("" : "+s"(m_)); var = wslot * 64 + (int)__builtin_amdgcn_mbcnt_hi(m_, __builtin_amdgcn_mbcnt_lo(m_, 0u)); } asm volatile("" : "+v"(var))
    XcdBarrier bar; bar.bar = args.p.CTL; bar.x = 0;
    const bool multi = args.ph_hi - args.ph_lo > 1;
    if (multi) { MY_TID(t0); bar = xcd_barrier_post(args.p.CTL, t0 == 0); }
    const int G = gridDim.x;
    const int ph_lo = args.ph_lo, ph_hi = args.ph_hi;
#ifndef PHMASK
#define PHMASK 0xFFFF
#endif
#define PH_ON(k) ((k) == 0 ? (PHMASK & 1) : ((PHMASK >> (1 + ((k) - 1) % NPL)) & 1))
#ifndef REPMASK
#define REPMASK 0
#endif
#ifndef REP_LOCAL
#define REP_LOCAL 0
#define REP_CONV 0
#define REP_ATTN 0
#endif
#ifndef HG_STOP
#define HG_STOP 0
#endif
#ifndef REP_P0
#define REP_P0 0
#endif
#define REP_N(k) (((k) == 0 && REP_P0) ? 2 : (((k) > 0 && ((REPMASK >> (((k) - 1) % NPL)) & 1)) ? 2 : 1))
#define PH_BEGIN(k) if (PH_ON(k) && ph_lo <= (k) && (k) < ph_hi) { for (int rep_ = 0; rep_ < REP_N(k); ++rep_) { const AS4 Args* kp = (const AS4 Args*)__builtin_amdgcn_kernarg_segment_ptr(); asm volatile("" : "+s"(kp)); PRef p = kp->p; MY_TID(tid);
#define PH_END_IF(k, cond) } if ((cond) && (k) + 1 < ph_hi) { MY_TID(t1); xcd_barrier(bar, t1 == 0, XB_ST(lds_raw)); } }
#ifndef REP_CVT
#define REP_CVT 0
#endif
#ifndef REP_BAR
#define REP_BAR 0
#endif
#define PH_END(k) } if ((k) + 1 < ph_hi) { for (int rb_ = 0; rb_ < 1 + REP_BAR; ++rb_) { MY_TID(t1); xcd_barrier(bar, t1 == 0, XB_ST(lds_raw)); } } }
    PH_BEGIN(0)
        phase_adaln(tid, p, lds);
        run_items<b_lb>(tid, p, 0, 2L * 384, 0);
        phase_convert(tid, p, 0, lds, 1, 0);
    PH_END(0)
#define LAYER(l)                                                                                                                                     \
    PH_BEGIN(1 + (l) * NPL + 0) if ((l) == 0) { phase_rows<0>(tid, p, 0, lds); } PH_END_IF(1 + (l) * NPL + 0, (l) == 0)                                 \
    PH_BEGIN(1 + (l) * NPL + 1) {                                                                                                                    \
        pg8::Gemm g{p.H, p.WIN_T + WBOFF(l), NTOK, INC, D, nullptr, 0, 1, 0}; pg8::StaticOrder S; S.init(NTOK, INC, G, (int)blockIdx.x);                         \
        pg8::EpiP E{p.P, INC, p.q_norm + (l) * HD, p.k_norm + (l) * HD, rep_};                                                    \
        pg8::gemm_phase<pg8::EpiP, false>(tid, lds, g, S, E);                                                                                     \
        } PH_END(1 + (l) * NPL + 1)               \
    PH_BEGIN(1 + (l) * NPL + 2) if constexpr (!FUSE_QK) { phase_qkprep(tid, p, l); } if constexpr (FAST_HGRN && (HGRN_DIAG == 3 || HGRN_DIAG == 4)) { phase_hgrn_local(tid, p, l, lds); { MY_TID(t7); run_items<b_hgrn_local_slow>(t7, p, l, 2L * NBH * NCH * 64, 0); } } else if constexpr (FAST_HGRN && HGRN_DIAG >= 2) { run_items<b_hgrn_local_slow>(tid, p, l, 2L * NBH * NCH * 64, 0); } else if constexpr (FAST_HGRN) { for (int r2_ = 0; r2_ < 1 + REP_LOCAL; ++r2_) phase_hgrn_local(tid, p, l, lds); } else { run_items<b_gates>(tid, p, l, (long)NTOK * 768, 0); } phase_conv(tid, p, l); PH_END(1 + (l) * NPL + 2) \
    PH_BEGIN(1 + (l) * NPL + 3) if constexpr (FAST_HGRN && HGRN_DIAG) { run_items<b_hgrn_scan_slow>(tid, p, l, 2L * NBH * 4096, 0); } else if constexpr (FAST_HGRN) { phase_hgrn_scan(tid, p); } else { run_items<b_hgrn_seq2>(tid, p, l, 2L * NB * HGH * 64, 0); } if constexpr (FAST_ATTN) { for (int r4_ = 0; r4_ < 1 + REP_ATTN; ++r4_) { MY_TID(t6); phase_attn(t6, p, l, lds); } } else { run_items<b_attn>(tid, p, l, (long)NTOK * NAH, 0); } PH_END(1 + (l) * NPL + 3) \
    PH_BEGIN(1 + (l) * NPL + 4) if constexpr (FAST_HGRN && HGRN_DIAG) { run_items<b_hgrn_chunkseq>(tid, p, l, 2L * NBH * NCH * 64, 0); { MY_TID(t9); xcd_barrier(bar, t9 == 0, XB_ST(lds_raw)); } { MY_TID(t8); run_items<b_hgfin>(t8, p, l, (long)NTOK * HGH, 0); } } else if constexpr (FAST_HGRN) { phase_hgrn_out(tid, p, l, lds); } else { run_items<b_hgfin>(tid, p, l, (long)NTOK * HGH, 0); } PH_END(1 + (l) * NPL + 4)                                         \
    PH_BEGIN(1 + (l) * NPL + 5) {                                                                                                                    \
        pg8::Gemm g{p.MIX, p.WOUT_T + WBOFF(l), NLAT, D, MIXD, nullptr, 0, 1, 0}; pg8::StaticOrder S; S.init(NLAT, D, G, (int)blockIdx.x);                       \
        pg8::EpiRes E{p.XB, D, p.MOD + (size_t)(l) * 3 * NMOD + 2 * D, SEQ, (size_t)NMOD};                                                           \
        pg8::gemm_phase<pg8::EpiRes, false>(tid, lds, g, S, E);                                                                                      \
        if ((l) + 1 < DEPTH) { MY_TID(tid2); mini_gemm<1>(tid2, p, l); } } PH_END(1 + (l) * NPL + 5)                  \
    PH_BEGIN(1 + (l) * NPL + 6) phase_rows<1>(tid, p, l, lds); PH_END(1 + (l) * NPL + 6)                                                               \
    PH_BEGIN(1 + (l) * NPL + 7) if constexpr (FAST_TOPK) { phase_topk(tid, p, lds); if ((l) == 0 && gridDim.x > 2 * NB * NE + 32) { MY_TID(t4); phase_convert(t4, p, 0, lds, 2, 2 * NB * NE); } else if ((l) == 0) { MY_TID(t4); phase_convert(t4, p, 0, lds, 2, 0); } else if ((l) + 1 < DEPTH) { MY_TID(t4); phase_convert(t4, p, (l) + 1, lds, 0, gridDim.x > 2 * NB * NE + 32 ? 2 * NB * NE : 0); } } else { run_items<b_rank>(tid, p, l, (long)NTOK * NE, 0); } PH_END(1 + (l) * NPL + 7)                                          \
    PH_BEGIN(1 + (l) * NPL + 8) {                                                                                                                    \
        pg8::Gemm g{p.H, p.WGU_T + WBOFF(l), NSLOT_L, 2 * ED, D, p.STOK, CAPL / 256, NE, (size_t)2 * ED * D * 2}; pg8::StaticOrder S; S.init(NSLOT_L, 2 * ED, G, (int)blockIdx.x); \
        pg8::EpiHid E{p.HID, ED};                                                                                                                    \
        pg8::gemm_phase<pg8::EpiHid, true>(tid, lds, g, S, E);                                                                                       \
        if ((l) + 1 < DEPTH) { MY_TID(tid2); mini_gemm<2>(tid2, p, l); } } PH_END(1 + (l) * NPL + 8)              \
    PH_BEGIN(1 + (l) * NPL + 9) {                                                                                                                    \
        pg8::Gemm g{p.HID, p.WD_T + WBOFF(l), NSLOT_L, D, ED, nullptr, CAPL / 256, NE, (size_t)D * ED * 2}; pg8::StaticOrder S; S.init(NSLOT_L, D, G, (int)blockIdx.x); \
        pg8::EpiBf16 E{p.Y, D, p.SVAL, 0};                                                                                                              \
        pg8::gemm_phase<pg8::EpiBf16, false>(tid, lds, g, S, E);                                                                                     \
        if ((l) + 1 < DEPTH) { MY_TID(tid2); mini_gemm<3>(tid2, p, l); } } PH_END(1 + (l) * NPL + 9)                \
    PH_BEGIN(1 + (l) * NPL + 10) phase_rows<2>(tid, p, l, lds); if ((l) == 0) { for (int rc_ = 0; rc_ < 1 + REP_CVT; ++rc_) { MY_TID(t5); phase_convert(t5, p, (l) + 1, lds); } }        PH_END(1 + (l) * NPL + 10)
#ifndef NLAYERS_BUILD
#define NLAYERS_BUILD DEPTH
#endif
    LAYER(0)
    if constexpr (NLAYERS_BUILD > 1) { LAYER(1) }
    if constexpr (NLAYERS_BUILD > 2) { LAYER(2) }
    if constexpr (NLAYERS_BUILD > 3) { LAYER(3) }
}

#ifndef MK_SPLIT
#define MK_SPLIT 0
#endif
extern "C" void kernel_launch(void* const* d_in, const int* in_sizes, int n_in, void* d_out, int out_size, void* d_ws, size_t ws_size,
                              hipStream_t stream) {
    static int grid = 0;
    if (grid == 0) {
        if (n_in != 20 || out_size != NLAT * D || ws_size < WS_END) { fprintf(stderr, "kernel_launch: unexpected problem (n_in %d out %d ws %zu need %zu)\n", n_in, out_size, ws_size, (size_t)WS_END); grid = -1; return; }
        int dev = 0, cus = 0;
        if (hipGetDevice(&dev) != hipSuccess || hipDeviceGetAttribute(&cus, hipDeviceAttributeMultiprocessorCount, dev) != hipSuccess) { grid = -1; return; }
        if (hipFuncSetAttribute((const void*)mega_fwd, hipFuncAttributeMaxDynamicSharedMemorySize, LDS_BYTES) != hipSuccess) { fprintf(stderr, "kernel_launch: hipFuncSetAttribute failed\n"); grid = -1; return; }
        int per_cu = 0;
        if (hipOccupancyMaxActiveBlocksPerMultiprocessor(&per_cu, (const void*)mega_fwd, NTHR, LDS_BYTES) != hipSuccess || per_cu < 1) { fprintf(stderr, "kernel_launch: occupancy query says %d\n", per_cu); }
        (void)hipGetLastError();
        grid = cus;
    }
    if (grid < 0) return;
    (void)hipMemsetAsync((char*)d_ws + WS_CTL, 0, WS_LB - WS_CTL, stream);
    Args a{};
    a.p = make_params(d_in, d_out, d_ws);
#if MK_SPLIT
    for (int ph = 0; ph < NPH; ++ph) { a.ph_lo = ph; a.ph_hi = ph + 1; hipLaunchKernelGGL(mega_fwd, dim3(grid), dim3(NTHR), LDS_BYTES, stream, a); }
#else
    a.ph_lo = 0; a.ph_hi = NPH;
    hipLaunchKernelGGL(mega_fwd, dim3(grid), dim3(NTHR), LDS_BYTES, stream, a);
#endif
}
#endif
```

```cpp
#ifndef CPU_SIM
#include <hip/hip_runtime.h>
#define BODY __device__ __forceinline__
#define FSIN(x) __sinf(x)
#define FCOS(x) __cosf(x)
#else
#include <cmath>
#include <cstdio>
#include <cstdlib>
#include <cstring>
#define BODY static inline
#define FSIN(x) sinf(x)
#define FCOS(x) cosf(x)
#endif
#include <stdint.h>
#include <stddef.h>

#ifndef CFG_D
#define CFG_D 1024
#define CFG_SEQ 16384
#define CFG_CTX 256
#define CFG_EDIM 512
#define CFG_DEPTH 4
#endif

typedef unsigned short bf16_t;

constexpr int D = CFG_D, NB = 2, SEQ = CFG_SEQ, DEPTH = CFG_DEPTH, GW = 64, ROWS = SEQ / GW, CTX = CFG_CTX;
constexpr int HD = 64, NAH = 6, HGH = 6, CVD = 256, MIXD = 1024, INC = 3840, NMOD = 6 * D;
constexpr int NE = 16, ED = CFG_EDIM, CAPL = 2 * SEQ / NE, CAPC = 2 * CTX / NE;
constexpr int NLAT = NB * SEQ, NCTX = NB * CTX, NTOK = NLAT + NCTX;
constexpr int NSLOT_L = NB * NE * CAPL, NSLOT_C = NB * NE * CAPC, NSLOT = NSLOT_L + NSLOT_C;
constexpr int OQ = 0, OK_ = 384, OV = 768, OHQ = 1152, OFF_ = 1536, OFB = 1920, OHI = 2304, OHG_ = 2688, OCB = 3072, OCC = 3328, OCU = 3584;
constexpr float EPS = 1e-6f;
constexpr int NCH = (CTX + SEQ) / 64, NCHC = CTX / 64, NBH = NB * HGH;

struct Params {
    const float *x, *c, *ctx, *c_ctx, *w_mod, *b_mod, *norm1_w, *w_in, *q_norm, *k_norm, *rpb, *lb_logits, *hg_norm, *conv_w, *w_out,
        *norm2_w, *w_router, *w_gate, *w_up, *w_down;
    float *XL, *XC, *MOD, *LB, *AFF, *SVAL, *FG, *OHG;
    bf16_t *H, *P, *MIX, *HID, *Y;
    int *STOK, *INV;
    bf16_t *WIN_T, *WOUT_T, *WGU_T, *WD_T;
    unsigned* CTL;
    bf16_t* SLOC;
    float* GDEC;
    bf16_t* XB;
};

#ifndef CPU_SIM
#define AS4 __attribute__((address_space(4)))
typedef const AS4 Params& PRef;
#else
typedef const Params& PRef;
#endif
BODY float bf2f(bf16_t v) { return __builtin_bit_cast(float, (unsigned)v << 16); }
BODY bf16_t f2bf(float f) { unsigned u = __builtin_bit_cast(unsigned, f); u += 0x7fffu + ((u >> 16) & 1u); return (bf16_t)(u >> 16); }
BODY float silu_f(float x) { return x / (1.f + expf(-x)); }
BODY float sigmoid_f(float x) { return 1.f / (1.f + expf(-x)); }
BODY int modset(int r) { return r < NLAT ? r / SEQ : 2; }
BODY float* xrow(PRef p, int r) { return r < NLAT ? p.XL + (size_t)r * D : p.XC + (size_t)(r - NLAT) * D; }

BODY void b_adaln(long gid, PRef p, int) {
    const int n = (int)(gid % NMOD), s = (int)((gid / NMOD) % 3), l = (int)(gid / (3 * NMOD));
    const float* cv = s < 2 ? p.c + s * D : p.c_ctx;
    const float* w = p.w_mod + (size_t)l * D * NMOD + n;
    float acc = 0.f;
    for (int k = 0; k < D; ++k) acc += silu_f(cv[k]) * w[(size_t)k * NMOD];
    p.MOD[gid] = acc + p.b_mod[l * NMOD + n];
}
BODY void b_lb(long gid, PRef p, int) {
    const int dir = (int)(gid / 384), j = (int)(gid % 384);
    const float* lg = p.lb_logits + (size_t)dir * DEPTH * 384 + j;
    float m = -INFINITY;
    for (int l = 0; l < DEPTH; ++l) m = fmaxf(m, lg[l * 384]);
    float s = 0.f;
    for (int l = 0; l < DEPTH; ++l) s += expf(lg[l * 384] - m);
    float cum = 0.f;
    p.LB[(dir * DEPTH + 0) * 384 + j] = 0.f;
    for (int l = 1; l < DEPTH; ++l) { cum += expf(lg[l * 384] - m) / s; p.LB[(dir * DEPTH + l) * 384 + j] = cum; }
}
BODY void b_copyx(long gid, PRef p, int) {
    if (gid < (long)NLAT * D) p.XL[gid] = p.x[gid]; else p.XC[gid - (long)NLAT * D] = p.ctx[gid - (long)NLAT * D];
}
template <int WHICH> BODY void b_prenorm(long gid, PRef p, int l) {
    const int r = (int)gid;
    const float* xr = xrow(p, r);
    const float* nw = (WHICH ? p.norm2_w : p.norm1_w) + l * D;
    const float* mod = p.MOD + ((size_t)l * 3 + modset(r)) * NMOD;
    const float* shift = mod + (WHICH ? 3 : 0) * D;
    const float* scale = mod + (WHICH ? 4 : 1) * D;
    float ss = 0.f;
    for (int k = 0; k < D; ++k) ss += xr[k] * xr[k];
    const float rstd = 1.f / sqrtf(ss / D + EPS);
    float lg[NE];
#pragma unroll
    for (int e = 0; e < NE; ++e) lg[e] = 0.f;
    for (int k = 0; k < D; ++k) {
        const float h = xr[k] * rstd * nw[k] * (1.f + scale[k]) + shift[k];
        p.H[(size_t)r * D + k] = f2bf(h);
        if (WHICH) {
            const float* wr = p.w_router + ((size_t)l * D + k) * NE;
#pragma unroll
            for (int e = 0; e < NE; ++e) lg[e] += h * wr[e];
        }
    }
    if (WHICH) {
        float m = lg[0];
#pragma unroll
        for (int e = 1; e < NE; ++e) m = fmaxf(m, lg[e]);
        float s = 0.f;
#pragma unroll
        for (int e = 0; e < NE; ++e) { lg[e] = expf(lg[e] - m); s += lg[e]; }
#pragma unroll
        for (int e = 0; e < NE; ++e) p.AFF[(size_t)r * NE + e] = lg[e] / s;
    }
}
BODY void b_gemm_in(long gid, PRef p, int l) {
    const int r = (int)(gid / (INC / 4)), n = (int)(gid % (INC / 4)) * 4;
    const bf16_t* a = p.H + (size_t)r * D;
    const float* w = p.w_in + (size_t)l * D * INC + n;
    float a0 = 0.f, a1 = 0.f, a2 = 0.f, a3 = 0.f;
    for (int k = 0; k < D; ++k) { const float av = bf2f(a[k]); const float* wk = w + (size_t)k * INC; a0 += av * wk[0]; a1 += av * wk[1]; a2 += av * wk[2]; a3 += av * wk[3]; }
    bf16_t* o = p.P + (size_t)r * INC + n;
    o[0] = f2bf(a0); o[1] = f2bf(a1); o[2] = f2bf(a2); o[3] = f2bf(a3);
}
BODY void b_qkprep(long gid, PRef p, int l) {
    const int r = (int)(gid / 12), which = (int)(gid % 12) / 6, head = (int)(gid % 6);
    bf16_t* ptr = p.P + (size_t)r * INC + (which ? OK_ : OQ) + head * HD;
    const float* nw = (which ? p.k_norm : p.q_norm) + l * HD;
    float y[HD];
    float ss = 0.f;
#pragma unroll
    for (int d = 0; d < HD; ++d) { y[d] = bf2f(ptr[d]); ss += y[d] * y[d]; }
    const float rstd = 1.f / sqrtf(ss / HD + EPS);
#pragma unroll
    for (int d = 0; d < HD; ++d) y[d] = y[d] * rstd * nw[d];
    if (r < NLAT) {
        const int t = r % SEQ; const float row = (float)(t / GW), col = (float)(t % GW);
#pragma unroll
        for (int d = 0; d < 16; ++d) {
            const float inv = powf(10000.f, -(float)d / 16.f);
            const float ar = row * inv, ac = col * inv;
            const float cr = FCOS(ar), sr = FSIN(ar), cc = FCOS(ac), sc = FSIN(ac);
            const float x0 = y[d], x1 = y[d + 16], x2 = y[d + 32], x3 = y[d + 48];
            y[d] = x0 * cr - x1 * sr; y[d + 16] = x1 * cr + x0 * sr; y[d + 32] = x2 * cc - x3 * sc; y[d + 48] = x3 * cc + x2 * sc;
        }
    }
#pragma unroll
    for (int d = 0; d < HD; ++d) ptr[d] = f2bf(y[d]);
}
BODY void b_attn(long gid, PRef p, int l) {
    const int r = (int)(gid / NAH), head = (int)(gid % NAH);
    float q[HD], acc[HD];
    const bf16_t* qp = p.P + (size_t)r * INC + OQ + head * HD;
#pragma unroll
    for (int d = 0; d < HD; ++d) { q[d] = bf2f(qp[d]) * 0.125f; acc[d] = 0.f; }
    float m = -INFINITY, s = 0.f;
    const int b = r < NLAT ? r / SEQ : (r - NLAT) / CTX;
    const int nloc = r < NLAT ? 128 : 0;
    int row = 0, col = 0, rs = 0, ws = 0;
    if (r < NLAT) { const int t = r % SEQ; row = t / GW; col = t % GW; rs = row - 4; rs = rs < 0 ? 0 : (rs > ROWS - 8 ? ROWS - 8 : rs); ws = col - 8; ws = ws < 0 ? 0 : (ws > GW - 16 ? GW - 16 : ws); }
    for (int j = 0; j < nloc + CTX; ++j) {
        int kr; float bias = 0.f;
        if (j < nloc) { const int i = j / 16, jj = j % 16; kr = b * SEQ + (rs + i) * GW + ws + jj; bias = p.rpb[(((size_t)l * NAH + head) * 15 + (rs + i - row + 7)) * 31 + (ws + jj - col + 15)]; }
        else kr = NLAT + b * CTX + (j - nloc);
        const bf16_t* kp = p.P + (size_t)kr * INC + OK_ + head * HD;
        const bf16_t* vp = p.P + (size_t)kr * INC + OV + head * HD;
        float sc = 0.f;
#pragma unroll
        for (int d = 0; d < HD; ++d) sc += q[d] * bf2f(kp[d]);
        sc += bias;
        const float mn = fmaxf(m, sc), corr = expf(m - mn), pj = expf(sc - mn);
        s = s * corr + pj;
#pragma unroll
        for (int d = 0; d < HD; ++d) acc[d] = acc[d] * corr + pj * bf2f(vp[d]);
        m = mn;
    }
    const float inv = 1.f / s;
    bf16_t* o = p.MIX + (size_t)r * MIXD + head * HD;
#pragma unroll
    for (int d = 0; d < HD; ++d) o[d] = f2bf(acc[d] * inv);
}
BODY void b_gates(long gid, PRef p, int l) {
    const int j = (int)(gid % 384), dir = (int)((gid / 384) % 2), r = (int)(gid / 768);
    const float z = bf2f(p.P[(size_t)r * INC + (dir ? OFB : OFF_) + j]);
    const float lbv = p.LB[(dir * DEPTH + l) * 384 + j];
    p.FG[gid] = lbv + (1.f - lbv) * sigmoid_f(z);
}
template <int DIR> BODY void b_hgrn_seq(long gid, PRef p, int) {
    const int v = (int)(gid % 64), h = (int)((gid / 64) % HGH), b = (int)(gid / (64 * HGH));
    float S[64];
#pragma unroll
    for (int k = 0; k < 64; ++k) S[k] = 0.f;
    for (int step = 0; step < CTX + SEQ; ++step) {
        int r;
        if (step < CTX) r = NLAT + b * CTX + (DIR ? CTX - 1 - step : step);
        else r = b * SEQ + (DIR ? SEQ - 1 - (step - CTX) : (step - CTX));
        const float vv = bf2f(p.P[(size_t)r * INC + OHI + h * 64 + v]);
        const float* fr = p.FG + ((size_t)r * 2 + DIR) * 384 + h * 64;
        const bf16_t* qr = p.P + (size_t)r * INC + OHQ + h * 64;
        float o = 0.f;
#pragma unroll
        for (int k = 0; k < 64; ++k) { const float f = fr[k]; S[k] = f * S[k] + (1.f - f) * vv; o += S[k] * bf2f(qr[k]); }
        o *= 0.125f;
        p.OHG[((size_t)DIR * NTOK + r) * 384 + h * 64 + v] = o;
    }
}
BODY void b_hgfin(long gid, PRef p, int l) {
    const int r = (int)(gid / HGH), h = (int)(gid % HGH);
    const float* op = p.OHG + (size_t)r * 384 + h * 64;
    const float* op1 = op + (size_t)NTOK * 384;
    float o[64]; float ss = 0.f;
#pragma unroll
    for (int v = 0; v < 64; ++v) { o[v] = op[v] + op1[v]; ss += o[v] * o[v]; }
    const float rstd = 1.f / sqrtf(ss / 64.f + EPS);
    const bf16_t* g = p.P + (size_t)r * INC + OHG_ + h * 64;
    bf16_t* out = p.MIX + (size_t)r * MIXD + 384 + h * 64;
#pragma unroll
    for (int v = 0; v < 64; ++v) out[v] = f2bf(o[v] * rstd * p.hg_norm[l * 64 + v] * silu_f(bf2f(g[v])));
}
BODY void b_conv(long gid, PRef p, int l) {
    const int ch = (int)(gid % CVD), r = (int)(gid / CVD);
    int t, T;
    if (r < NLAT) { t = r % SEQ; T = SEQ; } else { t = (r - NLAT) % CTX; T = CTX; }
    const float* w = p.conv_w + (size_t)l * 3 * CVD + ch;
    float y = 0.f;
    for (int j = 0; j < 3; ++j) {
        const int tt = t + j - 1;
        if (tt < 0 || tt >= T) continue;
        const bf16_t* pr = p.P + (size_t)(r + j - 1) * INC;
        y += w[j * CVD] * bf2f(pr[OCC + ch]) * bf2f(pr[OCU + ch]);
    }
    p.MIX[(size_t)r * MIXD + 768 + ch] = f2bf(bf2f(p.P[(size_t)r * INC + OCB + ch]) * y);
}
BODY void b_gemm_out(long gid, PRef p, int l) {
    const int r = (int)(gid / (D / 4)), n = (int)(gid % (D / 4)) * 4;
    const bf16_t* a = p.MIX + (size_t)r * MIXD;
    const float* w = p.w_out + (size_t)l * MIXD * D + n;
    float a0 = 0.f, a1 = 0.f, a2 = 0.f, a3 = 0.f;
    for (int k = 0; k < MIXD; ++k) { const float av = bf2f(a[k]); const float* wk = w + (size_t)k * D; a0 += av * wk[0]; a1 += av * wk[1]; a2 += av * wk[2]; a3 += av * wk[3]; }
    const float* g = p.MOD + ((size_t)l * 3 + modset(r)) * NMOD + 2 * D + n;
    float* xr = xrow(p, r) + n;
    xr[0] += g[0] * a0; xr[1] += g[1] * a1; xr[2] += g[2] * a2; xr[3] += g[3] * a3;
}
BODY void b_rank(long gid, PRef p, int) {
    const int e = (int)(gid % NE), r = (int)(gid / NE);
    int t, T, row0, cap, base;
    if (r < NLAT) { const int b = r / SEQ; t = r % SEQ; T = SEQ; row0 = b * SEQ; cap = CAPL; base = (b * NE + e) * CAPL; }
    else { const int b = (r - NLAT) / CTX; t = (r - NLAT) % CTX; T = CTX; row0 = NLAT + b * CTX; cap = CAPC; base = NSLOT_L + (b * NE + e) * CAPC; }
    const float a = p.AFF[(size_t)r * NE + e];
    const float* col = p.AFF + (size_t)row0 * NE + e;
    int rank = 0;
    for (int tt = 0; tt < T; ++tt) { const float o = col[(size_t)tt * NE]; rank += (o > a || (o == a && tt < t)) ? 1 : 0; }
    if (rank < cap) { p.STOK[base + rank] = r; p.SVAL[base + rank] = a; p.INV[(size_t)r * NE + e] = base + rank; }
    else p.INV[(size_t)r * NE + e] = -1;
}
BODY int slot_expert(int s) { return s < NSLOT_L ? (s / CAPL) % NE : ((s - NSLOT_L) / CAPC) % NE; }
BODY void b_moe1(long gid, PRef p, int l) {
    const int s = (int)(gid / (ED / 4)), f = (int)(gid % (ED / 4)) * 4;
    const int e = slot_expert(s); int row = p.STOK[s]; row = row < 0 ? 0 : (row >= NTOK ? NTOK - 1 : row);
    const bf16_t* a = p.H + (size_t)row * D;
    const float* wg = p.w_gate + ((size_t)l * NE + e) * D * ED + f;
    const float* wu = p.w_up + ((size_t)l * NE + e) * D * ED + f;
    float g0 = 0.f, g1 = 0.f, g2 = 0.f, g3 = 0.f, u0 = 0.f, u1 = 0.f, u2 = 0.f, u3 = 0.f;
    for (int k = 0; k < D; ++k) {
        const float av = bf2f(a[k]); const float* gk = wg + (size_t)k * ED; const float* uk = wu + (size_t)k * ED;
        g0 += av * gk[0]; g1 += av * gk[1]; g2 += av * gk[2]; g3 += av * gk[3];
        u0 += av * uk[0]; u1 += av * uk[1]; u2 += av * uk[2]; u3 += av * uk[3];
    }
    bf16_t* o = p.HID + (size_t)s * ED + f;
    o[0] = f2bf(silu_f(g0) * u0); o[1] = f2bf(silu_f(g1) * u1); o[2] = f2bf(silu_f(g2) * u2); o[3] = f2bf(silu_f(g3) * u3);
}
BODY void b_moe2(long gid, PRef p, int l) {
    const int s = (int)(gid / (D / 4)), n = (int)(gid % (D / 4)) * 4;
    const int e = slot_expert(s);
    const bf16_t* a = p.HID + (size_t)s * ED;
    const float* w = p.w_down + ((size_t)l * NE + e) * ED * D + n;
    float a0 = 0.f, a1 = 0.f, a2 = 0.f, a3 = 0.f;
    for (int k = 0; k < ED; ++k) { const float av = bf2f(a[k]); const float* wk = w + (size_t)k * D; a0 += av * wk[0]; a1 += av * wk[1]; a2 += av * wk[2]; a3 += av * wk[3]; }
    const float val = p.SVAL[s];
    bf16_t* o = p.Y + (size_t)s * D + n;
    o[0] = f2bf(val * a0); o[1] = f2bf(val * a1); o[2] = f2bf(val * a2); o[3] = f2bf(val * a3);
}
BODY void b_combine(long gid, PRef p, int l) {
    const int r = (int)(gid / (D / 4)), n = (int)(gid % (D / 4)) * 4;
    float a0 = 0.f, a1 = 0.f, a2 = 0.f, a3 = 0.f;
    for (int e = 0; e < NE; ++e) {
        const int s = p.INV[(size_t)r * NE + e];
        if (s >= 0) { const bf16_t* y = p.Y + (size_t)s * D + n; a0 += bf2f(y[0]); a1 += bf2f(y[1]); a2 += bf2f(y[2]); a3 += bf2f(y[3]); }
    }
    const float* g = p.MOD + ((size_t)l * 3 + modset(r)) * NMOD + 5 * D + n;
    float* xr = xrow(p, r) + n;
    xr[0] += g[0] * a0; xr[1] += g[1] * a1; xr[2] += g[2] * a2; xr[3] += g[3] * a3;
}


#ifndef HGRN_DIAG
#define HGRN_DIAG 0
#endif
BODY void b_hgrn_chunkseq(long gid, PRef p, int l) {
    const int v = (int)(gid % 64), pc = (int)((gid / 64) % NCH), bh = (int)((gid / (64 * NCH)) % NBH), dir = (int)(gid / (64L * NCH * NBH));
    const int h = bh % HGH, b = bh / HGH, row0 = pc < NCHC ? NLAT + b * CTX + pc * 64 : b * SEQ + (pc - NCHC) * 64;
    const bf16_t* sin = p.SLOC + ((size_t)(dir * NBH + bh) * NCH + pc) * 4096 + v * 64;
    float S[64];
#pragma unroll
    for (int k = 0; k < 64; ++k) S[k] = bf2f(sin[k]);
    for (int i = 0; i < 64; ++i) {
        const int r = row0 + (dir ? 63 - i : i);
        const float vv = bf2f(p.P[(size_t)r * INC + OHI + h * 64 + v]);
        const bf16_t* zr = p.P + (size_t)r * INC + (dir ? OFB : OFF_) + h * 64;
        const bf16_t* qr = p.P + (size_t)r * INC + OHQ + h * 64;
        const float* lb = p.LB + (size_t)(dir * DEPTH + l) * 384 + h * 64;
        float o = 0.f;
#pragma unroll
        for (int k = 0; k < 64; ++k) { const float f = lb[k] + (1.f - lb[k]) * sigmoid_f(bf2f(zr[k])); S[k] = f * S[k] + (1.f - f) * vv; o += S[k] * bf2f(qr[k]); }
        p.OHG[((size_t)dir * NTOK + r) * 384 + h * 64 + v] = o * 0.125f;
    }
}

BODY void b_hgrn_scan_slow(long gid, PRef p, int) {
    const int e = (int)(gid % 4096), sq = (int)(gid / 4096), dir = sq / NBH, k = e & 63;
    bf16_t* S = p.SLOC + (size_t)sq * NCH * 4096 + e;
    const float* G = p.GDEC + (size_t)sq * NCH * 64 + k;
    float c = 0.f;
    for (int j = 0; j < NCH; ++j) {
        const int pc = dir ? (j < NCHC ? NCHC - 1 - j : NCH + NCHC - 1 - j) : j;
        const float x = bf2f(S[(size_t)pc * 4096]);
        S[(size_t)pc * 4096] = f2bf(c);
        c = G[(size_t)pc * 64] * c + x;
    }
}

BODY void b_hgrn_local_slow(long gid, PRef p, int l) {
    const int v = (int)(gid % 64), pc = (int)((gid / 64) % NCH), bh = (int)((gid / (64 * NCH)) % NBH), dir = (int)(gid / (64L * NCH * NBH));
    const int h = bh % HGH, b = bh / HGH, row0 = pc < NCHC ? NLAT + b * CTX + pc * 64 : b * SEQ + (pc - NCHC) * 64;
    float S[64], g[64];
#pragma unroll
    for (int k = 0; k < 64; ++k) { S[k] = 0.f; g[k] = 1.f; }
    for (int i = 0; i < 64; ++i) {
        const int r = row0 + (dir ? 63 - i : i);
        const float vv = bf2f(p.P[(size_t)r * INC + OHI + h * 64 + v]);
        const bf16_t* zr = p.P + (size_t)r * INC + (dir ? OFB : OFF_) + h * 64;
        const float* lb = p.LB + (size_t)(dir * DEPTH + l) * 384 + h * 64;
#pragma unroll
        for (int k = 0; k < 64; ++k) { const float f = lb[k] + (1.f - lb[k]) * sigmoid_f(bf2f(zr[k])); S[k] = f * S[k] + (1.f - f) * vv; g[k] *= f; }
    }
    bf16_t* dst = p.SLOC + ((size_t)(dir * NBH + bh) * NCH + pc) * 4096 + v * 64;
    if (HGRN_DIAG != 3 && HGRN_DIAG != 4) {
#pragma unroll
    for (int k = 0; k < 64; ++k) dst[k] = f2bf(S[k]);
    }
    if (v == 0) {
        float* gd = p.GDEC + ((size_t)(dir * NBH + bh) * NCH + pc) * 64;
#pragma unroll
        for (int k = 0; k < 64; ++k) gd[k] = g[k];
    }
}
#ifndef FAST_TOPK
#define FAST_TOPK 1
#endif
#ifndef FAST_HGRN
#define FAST_HGRN 1
#endif
#ifndef FAST_ATTN
#define FAST_ATTN 1
#endif
constexpr size_t al256(size_t x) { return (x + 255) & ~(size_t)255; }
constexpr size_t CTL_BYTES = 65536;
constexpr size_t WS_CTL = 0;
constexpr size_t WS_MOD = WS_CTL + CTL_BYTES;
constexpr size_t WS_LB = WS_MOD + al256((size_t)DEPTH * 3 * NMOD * 4);
constexpr size_t WS_XC = WS_LB + al256((size_t)2 * DEPTH * 384 * 4);
constexpr size_t WS_AFF = WS_XC + al256((size_t)NCTX * D * 4);
constexpr size_t WS_SVAL = WS_AFF + al256((size_t)NTOK * NE * 4);
constexpr size_t WS_STOK = WS_SVAL + al256((size_t)NSLOT * 4);
constexpr size_t WS_INV = WS_STOK + al256((size_t)NSLOT * 4);
constexpr size_t WS_H = WS_INV + al256((size_t)NTOK * NE * 4);
constexpr size_t WS_MIX = WS_H + al256((size_t)NTOK * D * 2);
constexpr size_t WS_P = WS_MIX + al256((size_t)NTOK * MIXD * 2);
constexpr size_t WS_HID = WS_P;
constexpr size_t WS_Y = WS_HID + al256((size_t)NSLOT * ED * 2);
constexpr size_t WS_P_END0 = WS_P + al256((size_t)NTOK * INC * 2);
constexpr size_t WS_P_END1 = WS_Y + al256((size_t)NSLOT * D * 2);
constexpr size_t WS_WB = WS_P_END0 > WS_P_END1 ? WS_P_END0 : WS_P_END1;
constexpr size_t WS_WIN_T = WS_WB;
constexpr size_t WS_WOUT_T = WS_WIN_T + al256((size_t)INC * D * 2);
constexpr size_t WS_WGU_T = WS_WOUT_T + al256((size_t)D * MIXD * 2);
constexpr size_t WS_WD_T = WS_WGU_T + al256((size_t)NE * 2 * ED * D * 2);
constexpr size_t WB_BYTES = WS_WD_T + al256((size_t)NE * D * ED * 2) - WS_WB;
constexpr size_t WS_T = WS_WB + 2 * WB_BYTES;
#if FAST_HGRN
constexpr size_t WS_SLOC = WS_T;
constexpr size_t WS_GDEC = WS_SLOC + al256((size_t)2 * NBH * NCH * 4096 * 2);
constexpr size_t WS_OHG = WS_GDEC + al256((size_t)2 * NBH * NCH * 64 * 4);
constexpr size_t WS_XB = WS_OHG + (HGRN_DIAG ? al256((size_t)2 * NTOK * 384 * 4) : 0);
constexpr size_t WS_END = WS_XB + al256((size_t)NLAT * D * 2);
constexpr size_t WS_FG = WS_T;
#else
constexpr size_t WS_FG = WS_T;
constexpr size_t WS_OHG = WS_FG + al256((size_t)NTOK * 768 * 4);
constexpr size_t WS_SLOC = WS_OHG + al256((size_t)2 * NTOK * 384 * 4);
constexpr size_t WS_GDEC = WS_SLOC;
constexpr size_t WS_XB = WS_SLOC;
constexpr size_t WS_END = WS_XB + al256((size_t)NLAT * D * 2);
#endif

static inline Params make_params(void* const* d_in, void* d_out, void* d_ws) {
    Params p{};
    const float** f = (const float**)&p;
    for (int i = 0; i < 20; ++i) f[i] = (const float*)d_in[i];
    char* ws = (char*)d_ws;
    p.XL = (float*)d_out; p.XC = (float*)(ws + WS_XC); p.MOD = (float*)(ws + WS_MOD); p.LB = (float*)(ws + WS_LB); p.AFF = (float*)(ws + WS_AFF);
    p.SVAL = (float*)(ws + WS_SVAL); p.FG = (float*)(ws + WS_FG); p.OHG = (float*)(ws + WS_OHG);
    p.H = (bf16_t*)(ws + WS_H); p.P = (bf16_t*)(ws + WS_P); p.MIX = (bf16_t*)(ws + WS_MIX); p.HID = (bf16_t*)(ws + WS_HID); p.Y = (bf16_t*)(ws + WS_Y);
    p.STOK = (int*)(ws + WS_STOK); p.INV = (int*)(ws + WS_INV);
    p.WIN_T = (bf16_t*)(ws + WS_WIN_T); p.WOUT_T = (bf16_t*)(ws + WS_WOUT_T); p.WGU_T = (bf16_t*)(ws + WS_WGU_T); p.WD_T = (bf16_t*)(ws + WS_WD_T);
    p.CTL = (unsigned*)(ws + WS_CTL); p.SLOC = (bf16_t*)(ws + WS_SLOC); p.GDEC = (float*)(ws + WS_GDEC); p.XB = (bf16_t*)(ws + WS_XB);
    return p;
}

#define FORWARD_STAGES(STAGE)                                                      \
    STAGE(b_adaln, (long)DEPTH * 3 * NMOD, 0)                                      \
    STAGE(b_lb, 2L * 384, 0)                                                       \
    STAGE(b_copyx, (long)NTOK * D, 0)                                              \
    for (int l = 0; l < DEPTH; ++l) {                                              \
        STAGE(b_prenorm<0>, (long)NTOK, l)                                         \
        STAGE(b_gemm_in, (long)NTOK * (INC / 4), l)                                \
        STAGE(b_qkprep, (long)NTOK * 12, l)                                        \
        STAGE(b_attn, (long)NTOK * NAH, l)                                         \
        STAGE(b_gates, (long)NTOK * 768, l)                                        \
        STAGE(b_hgrn_seq<0>, (long)NB * HGH * 64, l)                               \
        STAGE(b_hgrn_seq<1>, (long)NB * HGH * 64, l)                               \
        STAGE(b_hgfin, (long)NTOK * HGH, l)                                        \
        STAGE(b_conv, (long)NTOK * CVD, l)                                         \
        STAGE(b_gemm_out, (long)NTOK * (D / 4), l)                                 \
        STAGE(b_prenorm<1>, (long)NTOK, l)                                         \
        STAGE(b_rank, (long)NTOK * NE, l)                                          \
        STAGE(b_moe1, (long)NSLOT * (ED / 4), l)                                   \
        STAGE(b_moe2, (long)NSLOT * (D / 4), l)                                    \
        STAGE(b_combine, (long)NTOK * (D / 4), l)                                  \
    }

#ifndef CPU_SIM
#include <cstdio>
#define LAS __attribute__((address_space(3)))
#define GAS __attribute__((address_space(1)))
typedef short bf16x8 __attribute__((ext_vector_type(8)));
typedef float f32x4 __attribute__((ext_vector_type(4)));
typedef float f32x2 __attribute__((ext_vector_type(2)));
typedef unsigned u32x4 __attribute__((ext_vector_type(4)));
typedef unsigned u32x2 __attribute__((ext_vector_type(2)));
constexpr int NWAVES = 8, NTHR = 512;
constexpr int RING_BYTES = 131072, LDSCTL_OFF = RING_BYTES, MISC_OFF = LDSCTL_OFF + 320, TAB_OFF = LDSCTL_OFF + 1024  , LDS_BYTES = 147456;

typedef __bf16 bf16v2_t __attribute__((ext_vector_type(2)));
__device__ __forceinline__ unsigned cvt_pk_bf16_asm(float lo, float hi) { unsigned r; asm volatile("v_cvt_pk_bf16_f32 %0, %1, %2" : "=v"(r) : "v"(lo), "v"(hi)); return r; }
__device__ __forceinline__ unsigned cvt_pk_bf16(float lo, float hi) { bf16v2_t v = {(__bf16)lo, (__bf16)hi}; return __builtin_bit_cast(unsigned, v); }
#define DPPF(x, ctrl) __builtin_bit_cast(float, __builtin_amdgcn_update_dpp(0, __builtin_bit_cast(int, (x)), (ctrl), 0xF, 0xF, true))
#define DPP_X1 0xB1
#define DPP_X2 0x4E
#define DPP_HM 0x141
#define DPP_RM 0x140
__device__ __forceinline__ float x16_other(float x, int lane) { const unsigned u = __builtin_bit_cast(unsigned, x); const auto r = __builtin_amdgcn_permlane16_swap(u, u, false, false); return __builtin_bit_cast(float, (lane & 16) ? r[0] : r[1]); }
__device__ __forceinline__ float x32_other(float x, int lane) { const unsigned u = __builtin_bit_cast(unsigned, x); const auto r = __builtin_amdgcn_permlane32_swap(u, u, false, false); return __builtin_bit_cast(float, (lane & 32) ? r[0] : r[1]); }
__device__ __forceinline__ float x16_sum(float x, int lane) { return x + x16_other(x, lane); }
__device__ __forceinline__ float x32_sum(float x, int lane) { return x + x32_other(x, lane); }
__device__ __forceinline__ float x16_max(float x, int lane) { return fmaxf(x, x16_other(x, lane)); }
__device__ __forceinline__ float x32_max(float x, int lane) { return fmaxf(x, x32_other(x, lane)); }
__device__ __forceinline__ float row16_sum(float v) { v += DPPF(v, DPP_X1); v += DPPF(v, DPP_X2); v += DPPF(v, DPP_HM); v += DPPF(v, DPP_RM); return v; }
__device__ __forceinline__ float row16_max(float v) { v = fmaxf(v, DPPF(v, DPP_X1)); v = fmaxf(v, DPPF(v, DPP_X2)); v = fmaxf(v, DPPF(v, DPP_HM)); v = fmaxf(v, DPPF(v, DPP_RM)); return v; }
__device__ __forceinline__ float oct_sum(float v) { v += DPPF(v, DPP_X1); v += DPPF(v, DPP_X2); v += DPPF(v, DPP_HM); return v; }
__device__ __forceinline__ float wave_sum(float v, int lane) { return x32_sum(x16_sum(row16_sum(v), lane), lane); }

extern __shared__ __attribute__((aligned(16))) unsigned char lds_raw[];
#ifndef FUSE_QK
#define FUSE_QK 1
#endif
__device__ __forceinline__ float bfw(unsigned w, int hi) { return __builtin_bit_cast(float, hi ? (w & 0xffff0000u) : (w << 16)); }
__device__ __forceinline__ float bf8(const u32x4& v, int j) { return bfw(v[j >> 1], j & 1); }
namespace pg8 {
constexpr int BM = 256, BK = 64, HALF = 128, HTB = HALF * BK * 2, STAGE_BYTES = 8 * HTB, NXCD = 8, WGM = 8;
__device__ __forceinline__ int lds_byte(int r, int c) { const int st = (r >> 4) * 2 + (c >> 5), rr = r & 15, cc = c & 31, ob = rr * 64 + cc * 2; return st * 1024 + (ob ^ (((ob >> 9) & 1) << 5)); }
__device__ __forceinline__ void stage_rc(int b, int& R, int& C) { const int st = b / 1024, sb = b % 1024, swz = sb ^ (((sb >> 9) & 1) << 5); R = (st >> 1) * 16 + swz / 64; C = (st & 1) * 32 + (swz % 64) / 2; }
__device__ __forceinline__ int perm32(int rho) { const int n = rho >> 4, i = rho & 15; return 8 * (i >> 2) + 4 * n + (i & 3); }
struct Unit { int pm, pn; };
struct Gemm {
    const bf16_t* A; const bf16_t* Bt; int M, N, K;
    const int* gather;
    int gt, ng; size_t gstride;
};
struct StaticOrder {
    int nM, nN, nwg, G, c;
    __device__ void init(int M, int N, int G_, int c_) { nM = M / BM; nN = N / BM; nwg = nM * nN; G = G_; c = c_; }
    __device__ bool next(int i, Unit& u) const {
        const long L = (long)i * G + c; if (L >= nwg) return false;
        int wgid = (int)L; { const int q = nwg / NXCD, r = nwg % NXCD, xcd = wgid % NXCD, off = wgid / NXCD; wgid = (xcd < r ? xcd * (q + 1) : r * (q + 1) + (xcd - r) * q) + off; }
        const int nig = WGM * nN, gid = wgid / nig, fm = gid * WGM, gsz = (nM - fm) < WGM ? (nM - fm) : WGM;
        u.pm = fm + ((wgid % nig) % gsz); u.pn = (wgid % nig) / gsz; return true;
    }
};
struct EpiBf16 {
    static constexpr bool PERM = true;
    bf16_t* O; int ldc; const float* rowscale; int skip;
    __device__ __forceinline__ void operator()(const f32x4 (&acc)[2][2][4][2], const Unit& u, int wr, int wc, int fr, int fq) const {
        const int row0 = u.pm * BM + wr * 64 + fr, col0 = u.pn * BM + wc * 32 + 8 * fq;
        if (skip) { asm volatile("" :: "v"(acc[0][0][0][0]), "v"(acc[1][1][3][1])); return; }
        float scv[2][4];
#pragma unroll
        for (int ai = 0; ai < 2; ++ai)
#pragma unroll
            for (int m = 0; m < 4; ++m) scv[ai][m] = rowscale ? rowscale[row0 + ai * HALF + m * 16] : 1.f;
        asm volatile("" ::: "memory");
#pragma unroll
        for (int ai = 0; ai < 2; ++ai)
#pragma unroll
            for (int m = 0; m < 4; ++m) { const int row = row0 + ai * HALF + m * 16; bf16_t* rowp = O + (size_t)row * ldc + col0; const float sc = scv[ai][m];
#pragma unroll
                for (int bj = 0; bj < 2; ++bj) { const f32x4 v0 = acc[ai][bj][m][0] * sc, v1 = acc[ai][bj][m][1] * sc;
                    u32x4 w; w.x = cvt_pk_bf16_asm(v0[0], v0[1]); w.y = cvt_pk_bf16_asm(v0[2], v0[3]); w.z = cvt_pk_bf16_asm(v1[0], v1[1]); w.w = cvt_pk_bf16_asm(v1[2], v1[3]);
                    *(u32x4*)(rowp + bj * HALF) = w; } }
    }
};
struct EpiP {
    static constexpr bool PERM = true;
    bf16_t* O; int ldc; const float* qn; const float* kn; int skip;
    __device__ __forceinline__ void operator()(const f32x4 (&acc)[2][2][4][2], const Unit& u, int wr, int wc, int fr, int fq) const {
        const int row0 = u.pm * BM + wr * 64 + fr, col0 = u.pn * BM + wc * 32 + 8 * fq;
        if (skip) { asm volatile("" :: "v"(acc[0][0][0][0]), "v"(acc[1][1][3][1])); return; }
        if (u.pn >= 3 || !FUSE_QK) {
#pragma unroll
            for (int ai = 0; ai < 2; ++ai)
#pragma unroll
                for (int m = 0; m < 4; ++m) { bf16_t* rowp = O + (size_t)(row0 + ai * HALF + m * 16) * ldc + col0;
#pragma unroll
                    for (int bj = 0; bj < 2; ++bj) { const f32x4 v0 = acc[ai][bj][m][0], v1 = acc[ai][bj][m][1];
                        u32x4 w; w.x = cvt_pk_bf16_asm(v0[0], v0[1]); w.y = cvt_pk_bf16_asm(v0[2], v0[3]); w.z = cvt_pk_bf16_asm(v1[0], v1[1]); w.w = cvt_pk_bf16_asm(v1[2], v1[3]);
                        *(u32x4*)(rowp + bj * HALF) = w; } }
            return;
        }
        LAS float* PS = (LAS float*)((LAS unsigned char*)lds_raw + LDSCTL_OFF + 4096);
        const int half = wc & 1, hw = wc >> 1;
        unsigned lm_ = ~0u; asm volatile("" : "+s"(lm_)); const int lane = (int)__builtin_amdgcn_mbcnt_hi(lm_, __builtin_amdgcn_mbcnt_lo(lm_, 0u));
#pragma unroll
        for (int ai = 0; ai < 2; ++ai)
#pragma unroll
            for (int m = 0; m < 4; ++m)
#pragma unroll
                for (int bj = 0; bj < 2; ++bj) { const f32x4 v0 = acc[ai][bj][m][0], v1 = acc[ai][bj][m][1];
                    float s = (v0[0] * v0[0] + v0[1] * v0[1]) + (v0[2] * v0[2] + v0[3] * v0[3]) + (v1[0] * v1[0] + v1[1] * v1[1]) + (v1[2] * v1[2] + v1[3] * v1[3]);
                    s = x32_sum(x16_sum(s, lane), lane);
                    if (fq == 0) PS[((ai * HALF + wr * 64 + m * 16 + fr) * 4 + 2 * bj + hw) * 2 + half] = s; }
        asm volatile("s_waitcnt lgkmcnt(0)" ::: "memory"); __builtin_amdgcn_s_barrier(); asm volatile("" ::: "memory");
        float invf[8];
#pragma unroll
        for (int j = 0; j < 8; ++j) invf[j] = __builtin_amdgcn_exp2f(-(float)(8 * (fq & 1) + j) * (13.287712379549449f / 16.f));
        const bool second = (fq & 2) != 0;
        f32x4 nwv[2][2];
#pragma unroll
        for (int bj = 0; bj < 2; ++bj) { const bool isk = (u.pn * BM + bj * HALF + wc * 32) >= 384; const float* nw = (isk ? kn : qn) + 32 * half + 8 * fq; nwv[bj][0] = *(const f32x4*)nw; nwv[bj][1] = *(const f32x4*)(nw + 4); }
        asm volatile("" ::: "memory");
#pragma unroll
        for (int ai = 0; ai < 2; ++ai)
#pragma unroll
            for (int m = 0; m < 4; ++m) {
                const int grow = row0 + ai * HALF + m * 16; const bool lat = grow < NLAT; const int t = lat ? grow % SEQ : 0;
                int tp = half ? t % GW : t / GW; asm volatile("" : "+v"(tp));
                const float pos = (float)tp;
                float cs[8], sn[8];
#pragma unroll
                for (int j = 0; j < 8; ++j) { const float ang = pos * invf[j]; cs[j] = __cosf(ang); sn[j] = __sinf(ang); }
                bf16_t* rowp = O + (size_t)grow * ldc + col0;
#pragma unroll
                for (int bj = 0; bj < 2; ++bj) {
                    const int rl = ai * HALF + wr * 64 + m * 16 + fr, head = 2 * bj + hw;
                    const float ssq = PS[(rl * 4 + head) * 2] + PS[(rl * 4 + head) * 2 + 1];
                    const bool isk = (u.pn * BM + bj * HALF + wc * 32) >= 384;
                    const float rstd = (isk ? 1.f : 0.125f * 1.44269504089f) / sqrtf(ssq * (1.f / HD) + EPS);
                    const f32x4 n0 = nwv[bj][0], n1 = nwv[bj][1];
                    float y[8];
#pragma unroll
                    for (int j = 0; j < 4; ++j) { y[j] = acc[ai][bj][m][0][j] * rstd * n0[j]; y[4 + j] = acc[ai][bj][m][1][j] * rstd * n1[j]; }
#pragma unroll
                    for (int j = 0; j < 8; ++j) {
                        const unsigned yb = __builtin_bit_cast(unsigned, y[j]);
                        const auto sw = __builtin_amdgcn_permlane32_swap(yb, yb, false, false);
                        const float other = __builtin_bit_cast(float, lane < 32 ? sw[1] : sw[0]);
                        const float rot = second ? y[j] * cs[j] + other * sn[j] : y[j] * cs[j] - other * sn[j];
                        y[j] = lat ? rot : y[j];
                    }
                    u32x4 w; w.x = cvt_pk_bf16(y[0], y[1]); w.y = cvt_pk_bf16(y[2], y[3]); w.z = cvt_pk_bf16(y[4], y[5]); w.w = cvt_pk_bf16(y[6], y[7]);
                    *(u32x4*)(rowp + bj * HALF) = w;
                }
                asm volatile("" ::: "memory");
            }
    }
};
struct EpiRes {
    static constexpr bool PERM = true;
    bf16_t* X; int ldc; const float* gate0; int rows_per_set; size_t set_stride;
    __device__ __forceinline__ void operator()(const f32x4 (&acc)[2][2][4][2], const Unit& u, int wr, int wc, int fr, int fq) const {
        const int row0 = u.pm * BM + wr * 64 + fr, col0 = u.pn * BM + wc * 32 + 8 * fq;
        const float* gate = gate0 + (size_t)((u.pm * BM) / rows_per_set) * set_stride;
        f32x4 gv[2][2];
#pragma unroll
        for (int bj = 0; bj < 2; ++bj)
#pragma unroll
            for (int n = 0; n < 2; ++n) gv[bj][n] = *(const f32x4*)(gate + col0 + bj * HALF + n * 4);
        u32x4 rv[2][4][2];
#pragma unroll
        for (int ai = 0; ai < 2; ++ai)
#pragma unroll
            for (int m = 0; m < 4; ++m)
#pragma unroll
                for (int bj = 0; bj < 2; ++bj) rv[ai][m][bj] = *(const u32x4*)(X + (size_t)(row0 + ai * HALF + m * 16) * ldc + col0 + bj * HALF);
        asm volatile("" ::: "memory");
#pragma unroll
        for (int ai = 0; ai < 2; ++ai)
#pragma unroll
            for (int m = 0; m < 4; ++m) { bf16_t* rowp = X + (size_t)(row0 + ai * HALF + m * 16) * ldc + col0;
#pragma unroll
                for (int bj = 0; bj < 2; ++bj) { const u32x4 r = rv[ai][m][bj];
                    const f32x4 x0 = (f32x4){bfw(r.x, 0), bfw(r.x, 1), bfw(r.y, 0), bfw(r.y, 1)}, x1 = (f32x4){bfw(r.z, 0), bfw(r.z, 1), bfw(r.w, 0), bfw(r.w, 1)};
                    const f32x4 v0 = x0 + gv[bj][0] * acc[ai][bj][m][0], v1 = x1 + gv[bj][1] * acc[ai][bj][m][1];
                    u32x4 w; w.x = cvt_pk_bf16_asm(v0[0], v0[1]); w.y = cvt_pk_bf16_asm(v0[2], v0[3]); w.z = cvt_pk_bf16_asm(v1[0], v1[1]); w.w = cvt_pk_bf16_asm(v1[2], v1[3]);
                    *(u32x4*)(rowp + bj * HALF) = w; } }
    }
};
struct EpiHid {
    static constexpr bool PERM = false;
    bf16_t* O; int ldc;
    __device__ __forceinline__ void operator()(const f32x4 (&acc)[2][2][4][2], const Unit& u, int wr, int wc, int fr, int fq) const {
        const int row0 = u.pm * BM + wr * 64 + fr, col0 = (u.pn * BM + wc * 32) / 2 + 4 * fq;
#pragma unroll
        for (int ai = 0; ai < 2; ++ai)
#pragma unroll
            for (int m = 0; m < 4; ++m) { bf16_t* rowp = O + (size_t)(row0 + ai * HALF + m * 16) * ldc + col0;
#pragma unroll
                for (int bj = 0; bj < 2; ++bj) { const f32x4 g = acc[ai][bj][m][0], up = acc[ai][bj][m][1]; f32x4 h;
#pragma unroll
                    for (int j = 0; j < 4; ++j) h[j] = g[j] * __builtin_amdgcn_rcpf(1.f + __expf(-g[j])) * up[j];
                    u32x2 w; w.x = cvt_pk_bf16_asm(h[0], h[1]); w.y = cvt_pk_bf16_asm(h[2], h[3]);
                    *(u32x2*)(rowp + bj * (HALF / 2)) = w; } }
    }
};

template <class Epi, bool GATHER>
__device__ __forceinline__ void gemm_phase(const int tid, LAS unsigned char* lds, const Gemm g, const StaticOrder& S, const Epi& E) {
    const int wid = __builtin_amdgcn_readfirstlane(tid >> 6), lane = tid & 63, wr = wid >> 2, wc = wid & 3, fr = lane & 15, fq = lane >> 4;
    const int K = g.K, nt = K / BK;
    unsigned voffA[2], voffB[2];
#pragma unroll
    for (int i = 0; i < 2; ++i) { int R, C; stage_rc(tid * 16 + i * 8192, R, C); const int Rb = Epi::PERM ? ((R & ~31) + perm32(R & 31)) : R;
        voffB[i] = (unsigned)(Rb * K + C) * 2u; voffA[i] = GATHER ? (unsigned)(C * 2) : (Epi::PERM ? (unsigned)(R * K + C) * 2u : voffB[i]); }
    const size_t kstep = (size_t)(BK * 2);
    const size_t hstep = (size_t)HALF * K * 2;
    const size_t tstep = 2 * hstep;
    const unsigned ldsw = (unsigned)wid * 1024u;
    const int aoff = lds_byte(wr * 64 + fr, fq * 8), boff = lds_byte(wc * 32 + fr, fq * 8);
#define PG8_SA(b, h) (((b) * 2 + (h)) * HTB)
#define PG8_SB(b, h) ((4 + (b) * 2 + (h)) * HTB)
#define PG8_STAGE(bufoff, gbase, voff) do { const char* gb_ = (const char*)(gbase); asm volatile("" : "+s"(gb_)); _Pragma("unroll") for (int _i = 0; _i < 2; ++_i) \
        __builtin_amdgcn_global_load_lds((const unsigned*)(gb_ + (voff)[_i]), (LAS unsigned*)(lds + (bufoff) + ldsw + _i * 8192), 16, 0, 0); } while (0)
#define PG8_STAGE_A(bufoff, ubase, kt, h, tb) do { if constexpr (GATHER) { \
        if ((tb) < 0) { PG8_STAGE(bufoff, Ab + (size_t)(kt) * kstep, oAc[h]); } else { \
        unsigned m_ = ~0u; asm volatile("" : "+s"(m_)); const int tl_ = wid * 64 + (int)__builtin_amdgcn_mbcnt_hi(m_, __builtin_amdgcn_mbcnt_lo(m_, 0u)); \
        _Pragma("unroll") for (int _i = 0; _i < 2; ++_i) { int _R, _C; stage_rc(tl_ * 16 + _i * 8192, _R, _C); \
            const unsigned _o = min(*(const LAS unsigned*)(lds + TAB_OFF + (tb) * 1024 + ((h) * HALF + _R) * 4), (unsigned)(NTOK - 1)) * (unsigned)(K * 2) + (unsigned)(_C * 2); \
            __builtin_amdgcn_global_load_lds((const unsigned*)(Ab + (size_t)(kt) * kstep + _o), (LAS unsigned*)(lds + (bufoff) + ldsw + _i * 8192), 16, 0, 0); } } } \
        else { PG8_STAGE(bufoff, (ubase) + (size_t)(kt) * kstep + (size_t)(h) * hstep, voffA); } } while (0)
#define PG8_LOADOFFS(tb) do { if constexpr (GATHER) { unsigned m_ = ~0u; asm volatile("" : "+s"(m_)); const int tl_ = wid * 64 + (int)__builtin_amdgcn_mbcnt_hi(m_, __builtin_amdgcn_mbcnt_lo(m_, 0u)); \
        _Pragma("unroll") for (int _h = 0; _h < 2; ++_h) _Pragma("unroll") for (int _i = 0; _i < 2; ++_i) { int _R, _C; stage_rc(tl_ * 16 + _i * 8192, _R, _C); \
            oAc[_h][_i] = min(*(const LAS unsigned*)(lds + TAB_OFF + (tb) * 1024 + (_h * HALF + _R) * 4), (unsigned)(NTOK - 1)) * (unsigned)(K * 2) + (unsigned)(_C * 2); } } } while (0)
#define PG8_FILLTAB(u, tb) do { if constexpr (GATHER) { unsigned m_ = ~0u; asm volatile("" : "+s"(m_)); const int tl_ = wid * 64 + (int)__builtin_amdgcn_mbcnt_hi(m_, __builtin_amdgcn_mbcnt_lo(m_, 0u)); \
        if (tl_ < 256) *(LAS unsigned*)(lds + TAB_OFF + (tb) * 1024 + tl_ * 4) = (unsigned)g.gather[(u).pm * BM + tl_]; } } while (0)
#define PG8_LDA(dst, b, h) do { _Pragma("unroll") for (int m = 0; m < 4; ++m) _Pragma("unroll") for (int k = 0; k < 2; ++k) dst[m][k] = *(const LAS bf16x8*)(lds + PG8_SA(b, h) + aoff + m * 2048 + k * 1024); } while (0)
#define PG8_LDB(dst, b, h) do { _Pragma("unroll") for (int n = 0; n < 2; ++n) _Pragma("unroll") for (int k = 0; k < 2; ++k) dst[n][k] = *(const LAS bf16x8*)(lds + PG8_SB(b, h) + boff + n * 2048 + k * 1024); } while (0)
#define PG8_MMA(ai, bj, At, Bt) do { __builtin_amdgcn_s_setprio(1); _Pragma("unroll") for (int m = 0; m < 4; ++m) _Pragma("unroll") for (int n = 0; n < 2; ++n) _Pragma("unroll") for (int k = 0; k < 2; ++k) \
        acc[ai][bj][m][n] = __builtin_amdgcn_mfma_f32_16x16x32_bf16(Bt[n][k], At[m][k], acc[ai][bj][m][n], 0, 0, 0); __builtin_amdgcn_s_setprio(0); } while (0)
#define PG8_WAIT_V(n) asm volatile("s_waitcnt vmcnt(" #n ")" ::: "memory")
#define PG8_WAIT_L(n) asm volatile("s_waitcnt lgkmcnt(" #n ")" ::: "memory")
#define PG8_BAR __builtin_amdgcn_s_barrier()
#define PG8_SCHED __builtin_amdgcn_sched_barrier(0)
#define PG8_KTILE2(u1, k1, o1, u2, k2, o2, b2p) do { \
        PG8_LDB(B0, 0, 0); PG8_LDB(B1, 0, 1); PG8_SCHED; PG8_LDA(At, 0, 0); PG8_STAGE_A(PG8_SA(1, 1), u1, k1, 1, o1); \
        PG8_WAIT_V(8); PG8_WAIT_L(0); PG8_BAR; PG8_MMA(0, 0, At, B0); PG8_MMA(0, 1, At, B1); PG8_BAR; PG8_SCHED; \
        PG8_LDA(At, 0, 1); PG8_STAGE(PG8_SB(0, 0), b2p, voffB); PG8_STAGE(PG8_SB(0, 1), (b2p) + hstep, voffB); PG8_STAGE_A(PG8_SA(0, 0), u2, k2, 0, o2); \
        PG8_WAIT_V(8); PG8_WAIT_L(0); PG8_BAR; PG8_MMA(1, 0, At, B0); PG8_MMA(1, 1, At, B1); PG8_BAR; PG8_SCHED; \
        PG8_LDB(B0, 1, 0); PG8_LDB(B1, 1, 1); PG8_SCHED; PG8_LDA(At, 1, 0); PG8_STAGE_A(PG8_SA(0, 1), u2, k2, 1, o2); \
        PG8_WAIT_V(8); PG8_WAIT_L(0); PG8_BAR; PG8_MMA(0, 0, At, B0); PG8_MMA(0, 1, At, B1); PG8_BAR; PG8_SCHED; \
        PG8_LDA(At, 1, 1); PG8_STAGE(PG8_SB(1, 0), (b2p) + kstep, voffB); PG8_STAGE(PG8_SB(1, 1), (b2p) + kstep + hstep, voffB); PG8_STAGE_A(PG8_SA(1, 0), u2, (k2) + 1, 0, o2); \
        PG8_WAIT_V(8); PG8_WAIT_L(0); PG8_BAR; PG8_MMA(1, 0, At, B0); PG8_MMA(1, 1, At, B1); PG8_BAR; PG8_SCHED; } while (0)
#define PG8_BPTR(u) ((const char*)g.Bt + (g.gt ? (size_t)(((u).pm / g.gt) % g.ng) * g.gstride : (size_t)0) + (size_t)(u).pn * tstep)
    Unit cur, nxt; int ui = 0;
    if (!S.next(0, cur)) return;
#ifndef LATE_START
#define LATE_START 4
#endif
#ifndef GEMM_STAGGER
#define GEMM_STAGGER 0
#endif
    if (GEMM_STAGGER) { const int dg_ = ((int)blockIdx.x >> 3) & 3; for (int i_ = 0; i_ < dg_; ++i_) __builtin_amdgcn_s_sleep(GEMM_STAGGER); }
    if (S.nwg % S.G != 0 && S.c >= S.nwg % S.G) { for (int i_ = 0; i_ < LATE_START; ++i_) __builtin_amdgcn_s_sleep(127); }
    f32x4 acc[2][2][4][2];
#pragma unroll
    for (int a = 0; a < 2; ++a)
#pragma unroll
        for (int b = 0; b < 2; ++b)
#pragma unroll
            for (int m = 0; m < 4; ++m)
#pragma unroll
                for (int n = 0; n < 2; ++n) acc[a][b][m][n] = (f32x4){0.f, 0.f, 0.f, 0.f};
    bf16x8 At[4][2], B0[2][2], B1[2][2];
    unsigned oAc[2][2] = {{0u, 0u}, {0u, 0u}};
    const char* const Ab = (const char*)g.A;
    const char* cA = Ab + (size_t)cur.pm * tstep;
    const char* cB = PG8_BPTR(cur);
    PG8_FILLTAB(cur, 0);
    if constexpr (GATHER) { PG8_WAIT_L(0); PG8_BAR; PG8_LOADOFFS(0); }
    PG8_STAGE(PG8_SB(0, 0), cB, voffB); PG8_STAGE(PG8_SB(0, 1), cB + hstep, voffB); PG8_STAGE_A(PG8_SA(0, 0), cA, 0, 0, -1); PG8_STAGE_A(PG8_SA(0, 1), cA, 0, 1, -1);
    if (wr == 1) PG8_BAR;
    PG8_WAIT_V(2); PG8_BAR;
    PG8_STAGE(PG8_SB(1, 0), cB + kstep, voffB); PG8_STAGE_A(PG8_SA(1, 0), cA, 1, 0, -1); PG8_STAGE(PG8_SB(1, 1), cB + hstep + kstep, voffB);
    PG8_WAIT_V(6); PG8_BAR;
    for (;;) {
        const bool has_next = S.next(ui + 1, nxt);
        const char* nA = has_next ? Ab + (size_t)nxt.pm * tstep : cA; const char* nB = has_next ? PG8_BPTR(nxt) : cB;
        const int tbc = ui & 1, tbn = has_next ? ((ui + 1) & 1) : (ui & 1);
        if constexpr (GATHER) { if (has_next && wid < 4) { unsigned m_ = ~0u; asm volatile("" : "+s"(m_)); const int tl_ = wid * 64 + (int)__builtin_amdgcn_mbcnt_hi(m_, __builtin_amdgcn_mbcnt_lo(m_, 0u));
            __builtin_amdgcn_global_load_lds((const unsigned*)(g.gather + nxt.pm * BM + tl_), (LAS unsigned*)(lds + TAB_OFF + tbn * 1024 + wid * 256), 4, 0, 0); } }
        for (int t = 0; t < nt - 2; t += 2) { const char* b2 = cB + (size_t)(t + 2) * kstep; PG8_KTILE2(cA, t + 1, -1, cA, t + 2, -1, b2); }
        PG8_KTILE2(cA, nt - 1, -1, nA, 0, tbn, nB);
        if (wr == 0) PG8_BAR;
        { unsigned m_ = ~0u; asm volatile("" : "+s"(m_)); int l2 = (int)__builtin_amdgcn_mbcnt_hi(m_, __builtin_amdgcn_mbcnt_lo(m_, 0u)); asm volatile("" : "+v"(l2)); E(acc, cur, wr, wc, l2 & 15, l2 >> 4); }
        if (!has_next) break;
#pragma unroll
        for (int a = 0; a < 2; ++a)
#pragma unroll
            for (int b = 0; b < 2; ++b)
#pragma unroll
                for (int m = 0; m < 4; ++m)
#pragma unroll
                    for (int n = 0; n < 2; ++n) acc[a][b][m][n] = (f32x4){0.f, 0.f, 0.f, 0.f};
        cur = nxt; cA = nA; cB = nB; ++ui;
        PG8_LOADOFFS(ui & 1);
        if (wr == 1) PG8_BAR;
    }
    PG8_WAIT_V(0);
    PG8_BAR;
#undef PG8_STAGE_A
#undef PG8_FILLTAB
#undef PG8_LOADOFFS
#undef PG8_SA
#undef PG8_SB
#undef PG8_STAGE
#undef PG8_LDA
#undef PG8_LDB
#undef PG8_MMA
#undef PG8_WAIT_V
#undef PG8_WAIT_L
#undef PG8_BAR
#undef PG8_SCHED
#undef PG8_KTILE2
#undef PG8_BPTR
}
}

#define XB_TMO      128
#define XB_XCNT(j)  (256  + 64 * (j))
#define XB_XSUB(j)  (1280 + 64 * (j))
#define XB_XGEN(j)  (2304 + 64 * (j))
#define XB_TOP      3328
#define XB_TOPGEN   3392
#define XCD_BAR_WORDS 3456
#define XB_SPIN_CAP (1u << 20)
__device__ __forceinline__ unsigned xb_ld(unsigned* p)              { return __hip_atomic_load(p, __ATOMIC_RELAXED, __HIP_MEMORY_SCOPE_AGENT); }
__device__ __forceinline__ unsigned xb_add(unsigned* p, unsigned v) { return __hip_atomic_fetch_add(p, v, __ATOMIC_RELAXED, __HIP_MEMORY_SCOPE_AGENT); }
__device__ __forceinline__ unsigned xb_xcc_id() { return (unsigned)__builtin_amdgcn_s_getreg((3 << 11) | 20) & 0xFu; }
#define XB_SPIN(cond, bar) do { unsigned _sp = 0; while (cond) { __builtin_amdgcn_s_sleep(1); \
    if ((++_sp & 255u) == 0u) { if (xb_ld(&(bar)[XB_TMO])) break; if (_sp > XB_SPIN_CAP) { atomicAdd(&(bar)[XB_TMO], 1u); break; } } } } while (0)
struct XcdBarrier { unsigned* bar; unsigned x; };
#define XB_ST(ldsbase) ((volatile LAS unsigned*)((LAS unsigned char*)(ldsbase) + MISC_OFF + 32))
__device__ __forceinline__ XcdBarrier xcd_barrier_post(unsigned* bar, bool leader) {
    XcdBarrier b; b.bar = bar; b.x = xb_xcc_id();
    if (leader) (void)xb_add(&bar[XB_XCNT(b.x)], 1u);
    return b;
}
__device__ __forceinline__ void xcd_barrier_complete(unsigned* bar, unsigned x, unsigned& nloc, unsigned& nx) {
    const unsigned G = gridDim.x * gridDim.y * gridDim.z;
    unsigned sum, cnt, mine, sp = 0u;
    for (;;) {
        sum = 0u; cnt = 0u; mine = 0u;
#pragma unroll
        for (unsigned j = 0; j < 16; ++j) { const unsigned c = xb_ld(&bar[XB_XCNT(j)]); sum += c; cnt += (c > 0u) ? 1u : 0u; mine = (j == x) ? c : mine; }
        if (sum == G) break;
        __builtin_amdgcn_s_sleep(1);
        if ((++sp & 255u) == 0u) { if (xb_ld(&bar[XB_TMO])) break; if (sp > XB_SPIN_CAP) { atomicAdd(&bar[XB_TMO], 1u); break; } }
    }
    nloc = mine > 0u ? mine : 1u; nx = cnt > 0u ? cnt : 1u;
}
__device__ __forceinline__ void xcd_barrier(const XcdBarrier& b, bool leader, volatile LAS unsigned* st) {
    asm volatile("s_waitcnt vmcnt(0)" ::: "memory");
    __syncthreads();
    if (leader) {
        unsigned* bar = b.bar;
        __builtin_amdgcn_s_waitcnt(0);
        unsigned nloc = st[0], nx = st[1];
        if (nloc == 0u) { xcd_barrier_complete(bar, b.x, nloc, nx); st[0] = nloc; st[1] = nx; }
        const unsigned old = xb_add(&bar[XB_XSUB(b.x)], 1u);
        const unsigned gen = old / nloc;
        if (old + 1u == (gen + 1u) * nloc) {
            __builtin_amdgcn_fence(__ATOMIC_RELEASE, "agent");
            asm volatile("s_waitcnt vmcnt(0)" ::: "memory");
            const unsigned og = xb_add(&bar[XB_TOP], 1u);
            const unsigned tg = og / nx;
            if (og + 1u == (tg + 1u) * nx) xb_add(&bar[XB_TOPGEN], 1u);
            else XB_SPIN(xb_ld(&bar[XB_TOPGEN]) == tg, bar);
            __builtin_amdgcn_fence(__ATOMIC_ACQUIRE, "agent");
            xb_add(&bar[XB_XGEN(b.x)], 1u);
            asm volatile("s_waitcnt vmcnt(0)" ::: "memory");
        } else {
            XB_SPIN(xb_ld(&bar[XB_XGEN(b.x)]) == gen, bar);
            __builtin_amdgcn_fence(__ATOMIC_ACQUIRE, "agent");
            asm volatile("s_waitcnt vmcnt(0)" ::: "memory");
        }
    }
    __syncthreads();
}

template <void (*F)(long, PRef, int)> __device__ __forceinline__ void run_items(const int tid, PRef p, int l, long n, long off) {
    for (long gid = (long)blockIdx.x * NTHR + tid; gid < n; gid += (long)gridDim.x * NTHR) F(gid + off, p, l);
}
BODY void b_hgrn_seq2(long gid, PRef p, int l) { const long n1 = (long)NB * HGH * 64; if (gid < n1) b_hgrn_seq<0>(gid, p, l); else b_hgrn_seq<1>(gid - n1, p, l); }

template <int MAP> __device__ __forceinline__ void transpose_item(const float* W, int K, int N, bf16_t* WT, int row_off, LAS float* scr, int item, int lane) {
    const int nblk = N / 32, kb = item / nblk, nb = item % nblk, k0 = 64 * kb, n0 = 32 * nb;
#pragma unroll 8
    for (int i = 0; i < 32; ++i) { const int kk = 2 * i + (lane >> 5); scr[kk * 33 + (lane & 31)] = W[(size_t)(k0 + kk) * N + n0 + (lane & 31)]; }
    asm volatile("s_waitcnt lgkmcnt(0)" ::: "memory");
    const int c = lane & 7;
#pragma unroll
    for (int j = 0; j < 4; ++j) { const int n = (lane >> 3) + 8 * j; const LAS float* s = scr + (8 * c) * 33 + n;
        u32x4 o; o.x = cvt_pk_bf16(s[0 * 33], s[1 * 33]); o.y = cvt_pk_bf16(s[2 * 33], s[3 * 33]); o.z = cvt_pk_bf16(s[4 * 33], s[5 * 33]); o.w = cvt_pk_bf16(s[6 * 33], s[7 * 33]);
        const int nn = n0 + n; const int drow = MAP == 0 ? row_off + nn : (32 * (nn >> 4) + (nn & 15) + (MAP == 2 ? 16 : 0));
        *(u32x4*)(WT + (size_t)drow * K + k0 + 8 * c) = o; }
    asm volatile("s_waitcnt lgkmcnt(0)" ::: "memory");
}
#define WBOFF(l) ((size_t)((l) & 1) * (WB_BYTES / 2))
__device__ __forceinline__ void phase_convert(const int tid, PRef p, int l, LAS unsigned char* lds, int part = 0, int blk_lo = 0) {
    if ((int)blockIdx.x < blk_lo) return;
    const int lane = tid & 63, wave = tid >> 6;
    LAS float* scr = (LAS float*)(lds + wave * 16384);
    const int gw = ((int)blockIdx.x - blk_lo) * NWAVES + wave, NGW = ((int)gridDim.x - blk_lo) * NWAVES;
    constexpr int I_IN = (D / 64) * (INC / 32), I_OUT = (MIXD / 64) * (D / 32), I_G = (D / 64) * (ED / 32), I_D = (ED / 64) * (D / 32);
    constexpr int NITEMS = I_IN + I_OUT + NE * (2 * I_G + I_D);
    const int it_lo = part == 2 ? I_IN + I_OUT : 0, it_hi = part == 1 ? I_IN + I_OUT : NITEMS;
    for (int it = it_lo + gw; it < it_hi; it += NGW) {
        int r = it;
        if (r < I_IN) { transpose_item<0>(p.w_in + (size_t)l * D * INC, D, INC, p.WIN_T + WBOFF(l), 0, scr, r, lane); continue; } r -= I_IN;
        if (r < I_OUT) { transpose_item<0>(p.w_out + (size_t)l * MIXD * D, MIXD, D, p.WOUT_T + WBOFF(l), 0, scr, r, lane); continue; } r -= I_OUT;
        const int e = r / (2 * I_G + I_D); r -= e * (2 * I_G + I_D);
        if (r < I_G) { transpose_item<1>(p.w_gate + ((size_t)l * NE + e) * D * ED, D, ED, p.WGU_T + WBOFF(l) + (size_t)e * 2 * ED * D, 0, scr, r, lane); continue; } r -= I_G;
        if (r < I_G) { transpose_item<2>(p.w_up + ((size_t)l * NE + e) * D * ED, D, ED, p.WGU_T + WBOFF(l) + (size_t)e * 2 * ED * D, 0, scr, r, lane); continue; } r -= I_G;
        transpose_item<0>(p.w_down + ((size_t)l * NE + e) * ED * D, ED, D, p.WD_T + WBOFF(l) + (size_t)e * D * ED, 0, scr, r, lane);
    }
}
template <int WHICH> __device__ __forceinline__ void phase_prenorm(const int tid, PRef p, int l) {
    static_assert(D == 1024, "wave-per-row kernels assume D = 1024");
    const int lane = tid & 63, wave = tid >> 6;
    const int gw = blockIdx.x * NWAVES + wave, NGW = gridDim.x * NWAVES;
    const float* nw = (WHICH ? p.norm2_w : p.norm1_w) + l * D;
    for (int r = gw; r < NTOK; r += NGW) {
        const float* xr = xrow(p, r);
        const float* mod = p.MOD + ((size_t)l * 3 + modset(r)) * NMOD;
        const float* shift = mod + (WHICH ? 3 : 0) * D; const float* scale = mod + (WHICH ? 4 : 1) * D;
        f32x4 v[4]; float ss = 0.f;
#pragma unroll
        for (int j = 0; j < 4; ++j) { v[j] = *(const f32x4*)(xr + 4 * lane + 256 * j); ss += (v[j][0] * v[j][0] + v[j][1] * v[j][1]) + (v[j][2] * v[j][2] + v[j][3] * v[j][3]); }
        const float rstd = 1.f / sqrtf(wave_sum(ss, lane) * (1.f / D) + EPS);
        float lg[NE];
#pragma unroll
        for (int e = 0; e < NE; ++e) lg[e] = 0.f;
#pragma unroll
        for (int j = 0; j < 4; ++j) {
            const int c = 4 * lane + 256 * j;
            const f32x4 w4 = *(const f32x4*)(nw + c), sc4 = *(const f32x4*)(scale + c), sh4 = *(const f32x4*)(shift + c);
            f32x4 h;
#pragma unroll
            for (int i = 0; i < 4; ++i) h[i] = v[j][i] * rstd * w4[i] * (1.f + sc4[i]) + sh4[i];
            u32x2 o; o.x = cvt_pk_bf16(h[0], h[1]); o.y = cvt_pk_bf16(h[2], h[3]);
            *(u32x2*)(p.H + (size_t)r * D + c) = o;
            if (WHICH) {
#pragma unroll
                for (int i = 0; i < 4; ++i) { const f32x4* wr = (const f32x4*)(p.w_router + ((size_t)l * D + c + i) * NE);
#pragma unroll
                    for (int q = 0; q < 4; ++q) { const f32x4 w = wr[q]; lg[4 * q + 0] += h[i] * w[0]; lg[4 * q + 1] += h[i] * w[1]; lg[4 * q + 2] += h[i] * w[2]; lg[4 * q + 3] += h[i] * w[3]; } }
            }
        }
        if (WHICH) {
#pragma unroll
            for (int e = 0; e < NE; ++e) lg[e] = wave_sum(lg[e], lane);
            float m = lg[0];
#pragma unroll
            for (int e = 1; e < NE; ++e) m = fmaxf(m, lg[e]);
            float s = 0.f, mine = 0.f;
#pragma unroll
            for (int e = 0; e < NE; ++e) { const float ex = expf(lg[e] - m); s += ex; mine = (lane == e) ? ex : mine; }
            if (lane < NE) p.AFF[(size_t)r * NE + lane] = mine / s;
        }
    }
}
__device__ __forceinline__ void phase_combine(const int tid, PRef p, int l) {
    const int lane = tid & 63, wave = tid >> 6;
    const int gw = blockIdx.x * NWAVES + wave, NGW = gridDim.x * NWAVES;
    for (int r = gw; r < NTOK; r += NGW) {
        float* xr = xrow(p, r);
        const float* g = p.MOD + ((size_t)l * 3 + modset(r)) * NMOD + 5 * D;
        f32x4 acc[4];
#pragma unroll
        for (int j = 0; j < 4; ++j) acc[j] = (f32x4){0.f, 0.f, 0.f, 0.f};
        const int myinv = lane < NE ? p.INV[(size_t)r * NE + lane] : -1;
#pragma unroll
        for (int e = 0; e < NE; ++e) {
            const int s = __builtin_amdgcn_readlane(myinv, e);
            if (s >= 0 && s < NSLOT) {
                const bf16_t* y = p.Y + (size_t)s * D;
#pragma unroll
                for (int j = 0; j < 4; ++j) { const u32x2 w = *(const u32x2*)(y + 4 * lane + 256 * j);
                    acc[j][0] += __builtin_bit_cast(float, w.x << 16); acc[j][1] += __builtin_bit_cast(float, w.x & 0xffff0000u);
                    acc[j][2] += __builtin_bit_cast(float, w.y << 16); acc[j][3] += __builtin_bit_cast(float, w.y & 0xffff0000u); }
            }
        }
#pragma unroll
        for (int j = 0; j < 4; ++j) { const int c = 4 * lane + 256 * j; f32x4* q = (f32x4*)(xr + c); *q = *q + *(const f32x4*)(g + c) * acc[j]; }
    }
}


__device__ __forceinline__ unsigned wave_excl_scan(unsigned x, int lane) {
    unsigned inc = x;
#pragma unroll
    for (int d = 1; d < 64; d <<= 1) { const unsigned y = (unsigned)__builtin_amdgcn_ds_bpermute(((lane - d) & 63) << 2, (int)inc); if (lane >= d) inc += y; }
    return inc - x;
}
__device__ __forceinline__ void phase_topk(const int tid, PRef p, LAS unsigned char* lds) {
    LAS unsigned* keys = (LAS unsigned*)lds;
    LAS unsigned* hist = (LAS unsigned*)(lds + 70000);
    LAS unsigned* cgt = (LAS unsigned*)(lds + 76000);
    LAS unsigned* ceq = (LAS unsigned*)(lds + 80000);
    LAS unsigned* sh = (LAS unsigned*)(lds + 84000);
    static_assert(SEQ % 512 == 0 && SEQ + SEQ / 32 <= 17400, "topk LDS layout");
    constexpr int PER = SEQ / 512;
    for (int pr = blockIdx.x; pr < 2 * NB * NE; pr += gridDim.x) {
        const int e = pr % NE, b = (pr / NE) % NB, isctx = pr / (NE * NB);
        if (!isctx) {
            const int row0 = b * SEQ, base = (b * NE + e) * CAPL;
            for (int i = 0; i < PER; ++i) { const int t = i * 512 + tid; keys[t + (t >> 5)] = __builtin_bit_cast(unsigned, p.AFF[(size_t)(row0 + t) * NE + e]); }
            if (tid == 0) { sh[0] = 0u; sh[1] = (unsigned)CAPL; }
            __syncthreads();
            for (int pass = 0; pass < 3; ++pass) {
                const int shift = 20 - 10 * pass;
                for (int i = tid; i < 1024; i += 512) hist[i] = 0u;
                __syncthreads();
                const unsigned prefix = sh[0]; const unsigned himask = pass == 0 ? 0u : (0xFFFFFFFFu << (shift + 10));
                for (int i = 0; i < PER; ++i) { const int t = tid * PER + i; const unsigned k = keys[t + (t >> 5)]; if ((k & himask) == prefix) atomicAdd((unsigned*)&hist[(k >> shift) & 1023u], 1u); }
                __syncthreads();
                if (tid < 64) {
                    const unsigned need = sh[1];
                    unsigned c[16]; unsigned tot = 0u;
#pragma unroll
                    for (int q = 0; q < 16; ++q) { c[q] = hist[1023 - 16 * tid - q]; tot += c[q]; }
                    unsigned above = wave_excl_scan(tot, tid);
                    int fbin = -1; unsigned fabove = 0u;
#pragma unroll
                    for (int q = 0; q < 16; ++q) { if (fbin < 0 && above < need && above + c[q] >= need) { fbin = 1023 - 16 * tid - q; fabove = above; } above += c[q]; }
                    if (fbin >= 0) { sh[0] = prefix | ((unsigned)fbin << shift); sh[1] = need - fabove; }
                }
                __syncthreads();
            }
            const unsigned thr = sh[0], keq = sh[1];
            unsigned ng = 0u, nq = 0u;
            for (int i = 0; i < PER; ++i) { const int t = tid * PER + i; const unsigned k = keys[t + (t >> 5)]; ng += k > thr ? 1u : 0u; nq += k == thr ? 1u : 0u; }
            cgt[tid] = ng; ceq[tid] = nq;
            __syncthreads();
            if (tid < 64) {
                unsigned g[8], q[8], sg = 0u, sq = 0u;
#pragma unroll
                for (int i = 0; i < 8; ++i) { g[i] = cgt[8 * tid + i]; q[i] = ceq[8 * tid + i]; sg += g[i]; sq += q[i]; }
                unsigned ag = wave_excl_scan(sg, tid), aq = wave_excl_scan(sq, tid);
#pragma unroll
                for (int i = 0; i < 8; ++i) { cgt[8 * tid + i] = ag; ceq[8 * tid + i] = aq; ag += g[i]; aq += q[i]; }
            }
            __syncthreads();
            unsigned rg = cgt[tid], rq = ceq[tid];
            for (int i = 0; i < PER; ++i) {
                const int t = tid * PER + i; const unsigned k = keys[t + (t >> 5)];
                int slot = -1;
                if (k > thr) { slot = (int)(rg + (rq < keq ? rq : keq)); ++rg; }
                else if (k == thr) { if (rq < keq) slot = (int)(rg + rq); ++rq; }
                const int row = row0 + t;
                if (slot >= 0) { p.STOK[base + slot] = row; p.SVAL[base + slot] = __builtin_bit_cast(float, k); p.INV[(size_t)row * NE + e] = base + slot; }
                else p.INV[(size_t)row * NE + e] = -1;
            }
            __syncthreads();
        } else {
            const int row0 = NLAT + b * CTX, base = NSLOT_L + (b * NE + e) * CAPC;
            LAS float* vals = (LAS float*)lds;
            for (int t = tid; t < CTX; t += 512) vals[t] = p.AFF[(size_t)(row0 + t) * NE + e];
            __syncthreads();
            for (int t = tid; t < CTX; t += 512) {
                const float a = vals[t]; int rank = 0;
                for (int tt = 0; tt < CTX; ++tt) { const float o = vals[tt]; rank += (o > a || (o == a && tt < t)) ? 1 : 0; }
                const int row = row0 + t;
                if (rank < CAPC) { p.STOK[base + rank] = row; p.SVAL[base + rank] = a; p.INV[(size_t)row * NE + e] = base + rank; }
                else p.INV[(size_t)row * NE + e] = -1;
            }
            __syncthreads();
        }
    }
}

#define LDS_BAR() do { asm volatile("s_waitcnt lgkmcnt(0)" ::: "memory"); __builtin_amdgcn_s_barrier(); asm volatile("" ::: "memory"); } while (0)
__device__ __forceinline__ int hg_row0(int b, int pc) { return pc < NCHC ? NLAT + b * CTX + pc * 64 : b * SEQ + (pc - NCHC) * 64; }
constexpr int HG_FF = 0, HG_FB = 16384, HG_AF = 32768, HG_AB = 49152, HG_T0 = 65536, HG_TS = 9216, HG_VT = HG_T0 + 6 * HG_TS;
#define HGI(t, k) ((t) * 64 + ((k) ^ (((((t) >> 4) & 1) << 4) | (((t) & 3) << 2))))
#define HGLD8(dst, arr, t, k0) do { const f32x4 lo_ = *(const LAS f32x4*)((arr) + HGI(t, k0)), hi_ = *(const LAS f32x4*)((arr) + HGI(t, (k0) + 4)); \
        dst[0] = lo_[0]; dst[1] = lo_[1]; dst[2] = lo_[2]; dst[3] = lo_[3]; dst[4] = hi_[0]; dst[5] = hi_[1]; dst[6] = hi_[2]; dst[7] = hi_[3]; } while (0)
static_assert(HG_VT + HG_TS <= RING_BYTES, "hgrn LDS layout");
#define TSW_E(k, t) ((k) * 72 + ((((t) >> 3) ^ (((k) >> 3) & 7)) << 3) + ((t) & 7))
#define TSW_B(k, c) ((k) * 144 + (((c) ^ (((k) >> 3) & 7)) << 4))
constexpr int HG_LBOFF = LDSCTL_OFF + 4096;
__device__ __forceinline__ void hg_stage_lb(const int tid, PRef p, int l) {
    LAS float* dst = (LAS float*)((LAS unsigned char*)lds_raw + HG_LBOFF);
    for (int i = tid; i < 768; i += NTHR) dst[i] = p.LB[(size_t)((i / 384) * DEPTH + l) * 384 + (i % 384)];
    LDS_BAR();
}
__device__ __forceinline__ void hg_gates(const int tid, PRef p, int l, int h, const u32x4 zf, const u32x4 zb, LAS unsigned char* lds) {
    LAS float* FF = (LAS float*)(lds + HG_FF); LAS float* FB = (LAS float*)(lds + HG_FB); LAS float* AF = (LAS float*)(lds + HG_AF); LAS float* AB = (LAS float*)(lds + HG_AB);
    const int t = tid >> 3, cg = tid & 7;
    const LAS float* lbf = (const LAS float*)((LAS unsigned char*)lds_raw + HG_LBOFF) + h * 64 + cg * 8; const LAS float* lbb = lbf + 384;
    float ffv[8], fbv[8];
#pragma unroll
    for (int j = 0; j < 8; ++j) {
        const float z0 = fminf(fmaxf(bf8(zf, j), -60.f), 60.f), z1 = fminf(fmaxf(bf8(zb, j), -60.f), 60.f);
        const float l0 = lbf[j], l1 = lbb[j];
        ffv[j] = l0 + (1.f - l0) * __builtin_amdgcn_rcpf(1.f + __expf(-z0));
        fbv[j] = l1 + (1.f - l1) * __builtin_amdgcn_rcpf(1.f + __expf(-z1));
    }
    *(LAS f32x4*)(FF + HGI(t, cg * 8)) = (f32x4){ffv[0], ffv[1], ffv[2], ffv[3]}; *(LAS f32x4*)(FF + HGI(t, cg * 8 + 4)) = (f32x4){ffv[4], ffv[5], ffv[6], ffv[7]};
    *(LAS f32x4*)(FB + HGI(t, cg * 8)) = (f32x4){fbv[0], fbv[1], fbv[2], fbv[3]}; *(LAS f32x4*)(FB + HGI(t, cg * 8 + 4)) = (f32x4){fbv[4], fbv[5], fbv[6], fbv[7]};
    LDS_BAR();
    {
        const int wave = tid >> 6, lane = tid & 63, cl = lane & 15, seg = lane >> 4, dir = wave >> 2, col = 16 * (wave & 3) + cl;
        const LAS float* F = dir ? FB : FF; LAS float* A = dir ? AB : AF;
        float pre[16]; float run = 0.f;
#pragma unroll
        for (int i = 0; i < 16; ++i) { const int tt = dir ? 16 * seg + 15 - i : 16 * seg + i; run += __logf(F[HGI(tt, col)]); pre[i] = run; }
        const float T0 = __builtin_bit_cast(float, __builtin_amdgcn_ds_bpermute((cl + 0) << 2, __builtin_bit_cast(int, run)));
        const float T1 = __builtin_bit_cast(float, __builtin_amdgcn_ds_bpermute((cl + 16) << 2, __builtin_bit_cast(int, run)));
        const float T2 = __builtin_bit_cast(float, __builtin_amdgcn_ds_bpermute((cl + 32) << 2, __builtin_bit_cast(int, run)));
        const float T3 = __builtin_bit_cast(float, __builtin_amdgcn_ds_bpermute((cl + 48) << 2, __builtin_bit_cast(int, run)));
        const float off = dir ? ((seg < 1 ? T1 : 0.f) + (seg < 2 ? T2 : 0.f) + (seg < 3 ? T3 : 0.f)) : ((seg > 0 ? T0 : 0.f) + (seg > 1 ? T1 : 0.f) + (seg > 2 ? T2 : 0.f));
#pragma unroll
        for (int i = 0; i < 16; ++i) { const int tt = dir ? 16 * seg + 15 - i : 16 * seg + i; A[HGI(tt, col)] = off + pre[i]; }
    }
    LDS_BAR();
}
__device__ __forceinline__ bf16x8 ld2x64(const LAS unsigned char* p0, const LAS unsigned char* p1) {
    const u32x2 a = *(const LAS u32x2*)p0, b = *(const LAS u32x2*)p1; u32x4 r; r.x = a.x; r.y = a.y; r.z = b.x; r.w = b.y; return __builtin_bit_cast(bf16x8, r);
}
typedef short s16x4 __attribute__((ext_vector_type(4)));
__device__ __forceinline__ bf16x8 ld2tr(const LAS unsigned char* p0, const LAS unsigned char* p1) {
    const s16x4 a = __builtin_amdgcn_ds_read_tr16_b64_v4i16((LAS s16x4*)p0), b = __builtin_amdgcn_ds_read_tr16_b64_v4i16((LAS s16x4*)p1);
    return __builtin_shufflevector(a, b, 0, 1, 2, 3, 4, 5, 6, 7);
}
__device__ __forceinline__ f32x4 mfma16(bf16x8 a, bf16x8 b, f32x4 c) { return __builtin_amdgcn_mfma_f32_16x16x32_bf16(a, b, c, 0, 0, 0); }
__device__ __forceinline__ void phase_hgrn_local(const int tid, PRef p, int l, LAS unsigned char* lds) {
    LAS float* FF = (LAS float*)(lds + HG_FF); LAS float* FB = (LAS float*)(lds + HG_FB); LAS float* AF = (LAS float*)(lds + HG_AF); LAS float* AB = (LAS float*)(lds + HG_AB);
    LAS bf16_t* KTf = (LAS bf16_t*)(lds + HG_T0); LAS bf16_t* KTb = (LAS bf16_t*)(lds + HG_T0 + HG_TS); LAS bf16_t* VT = (LAS bf16_t*)(lds + HG_VT);
    const int t = tid >> 3, cg = tid & 7, wave = tid >> 6, lane = tid & 63, fr = lane & 15, fq = lane >> 4;
    u32x4 zf = (u32x4){0u, 0u, 0u, 0u}, zb = zf, v8 = zf, nzf = zf, nzb = zf, nv8 = zf;
    if ((int)blockIdx.x < NBH * NCH) { const int it = blockIdx.x, pc = it % NCH, bh = it / NCH, h = bh % HGH, b = bh / HGH;
        const bf16_t* pr = p.P + (size_t)(hg_row0(b, pc) + t) * INC + h * 64 + cg * 8; zf = *(const u32x4*)(pr + OFF_); zb = *(const u32x4*)(pr + OFB); v8 = *(const u32x4*)(pr + OHI); }
    hg_stage_lb(tid, p, l);
    for (int it = blockIdx.x; it < NBH * NCH; it += gridDim.x) {
        const int pc = it % NCH, bh = it / NCH, h = bh % HGH, b = bh / HGH, row0 = hg_row0(b, pc);
        { const int it2 = min(it + (int)gridDim.x, NBH * NCH - 1); const int pc2 = it2 % NCH, bh2 = it2 / NCH, h2 = bh2 % HGH, b2 = bh2 / HGH;
            const bf16_t* pr = p.P + (size_t)(hg_row0(b2, pc2) + t) * INC + h2 * 64 + cg * 8; nzf = *(const u32x4*)(pr + OFF_); nzb = *(const u32x4*)(pr + OFB); nv8 = *(const u32x4*)(pr + OHI); }
        hg_gates(tid, p, l, h, zf, zb, lds);
        {
            float f8[8], a8[8], e8[8], g8[8], b8[8], h8[8];
            HGLD8(f8, FF, t, cg * 8); HGLD8(a8, AF, t, cg * 8); HGLD8(e8, AF, 63, cg * 8); HGLD8(g8, FB, t, cg * 8); HGLD8(b8, AB, t, cg * 8); HGLD8(h8, AB, 0, cg * 8);
            float kf[8], kb[8];
#pragma unroll
            for (int j = 0; j < 8; ++j) { kf[j] = (1.f - f8[j]) * __expf(e8[j] - a8[j]); kb[j] = (1.f - g8[j]) * __expf(h8[j] - b8[j]); }
            u32x4 wf, wb; wf.x = cvt_pk_bf16(kf[0], kf[1]); wf.y = cvt_pk_bf16(kf[2], kf[3]); wf.z = cvt_pk_bf16(kf[4], kf[5]); wf.w = cvt_pk_bf16(kf[6], kf[7]);
            wb.x = cvt_pk_bf16(kb[0], kb[1]); wb.y = cvt_pk_bf16(kb[2], kb[3]); wb.z = cvt_pk_bf16(kb[4], kb[5]); wb.w = cvt_pk_bf16(kb[6], kb[7]);
            *(LAS u32x4*)(lds + HG_VT + t * 144 + cg * 16) = v8; *(LAS u32x4*)(lds + HG_T0 + t * 144 + cg * 16) = wf; *(LAS u32x4*)(lds + HG_T0 + HG_TS + t * 144 + cg * 16) = wb;
        }
        if (tid < 64) p.GDEC[((size_t)(0 * NBH + bh) * NCH + pc) * 64 + tid] = __expf(AF[HGI(63, tid)]);
        else if (tid < 128) p.GDEC[((size_t)(1 * NBH + bh) * NCH + pc) * 64 + (tid - 64)] = __expf(AB[HGI(0, tid - 64)]);
        LDS_BAR();
#if HGRN_DIAG == 4
        {
            const int v = tid >> 3, kg = tid & 7;
            for (int dir = 0; dir < 2; ++dir) {
                const LAS bf16_t* KT = (const LAS bf16_t*)(lds + HG_T0 + dir * HG_TS);
                float acc[8];
#pragma unroll
                for (int j = 0; j < 8; ++j) acc[j] = 0.f;
                for (int s_ = 0; s_ < 64; ++s_) { const float vv = bf2f(VT[v * 72 + s_]);
#pragma unroll
                    for (int j = 0; j < 8; ++j) acc[j] += bf2f(KT[(kg * 8 + j) * 72 + s_]) * vv; }
                bf16_t* dst = p.SLOC + ((size_t)(dir * NBH + bh) * NCH + pc) * 4096 + v * 64 + kg * 8;
#pragma unroll
                for (int j = 0; j < 8; ++j) dst[j] = f2bf(acc[j]);
            }
        }
#else
        {
            const int dir = wave >> 2, mt = wave & 3;
            const LAS unsigned char* KT = lds + HG_T0 + dir * HG_TS;
            const int trb = (8 * fq + (fr >> 2)) * 144 + 8 * (fr & 3);
            bf16x8 a[2];
#pragma unroll
            for (int ks = 0; ks < 2; ++ks) { const LAS unsigned char* ar = KT + trb + ks * (32 * 144) + mt * 32; a[ks] = ld2tr(ar, ar + 4 * 144); }
            bf16_t* dst = p.SLOC + ((size_t)(dir * NBH + bh) * NCH + pc) * 4096;
            u32x2 w[4];
#pragma unroll
            for (int nt = 0; nt < 4; ++nt) {
                f32x4 acc = (f32x4){0.f, 0.f, 0.f, 0.f};
#pragma unroll
                for (int ks = 0; ks < 2; ++ks) { const LAS unsigned char* br = lds + HG_VT + trb + ks * (32 * 144) + nt * 32; acc = mfma16(a[ks], ld2tr(br, br + 4 * 144), acc); }
                w[nt].x = cvt_pk_bf16(acc[0], acc[1]); w[nt].y = cvt_pk_bf16(acc[2], acc[3]);
            }
            zf = nzf; zb = nzb; v8 = nv8;
            asm volatile("" ::: "memory");
#pragma unroll
            for (int nt = 0; nt < 4; ++nt) *(u32x2*)(dst + (nt * 16 + fr) * 64 + mt * 16 + 4 * fq) = w[nt];
        }
#endif
        LDS_BAR();
    }
}
__device__ __forceinline__ void phase_hgrn_scan(const int tid, PRef p) {
    constexpr int GS = 20, NG = NCH / GS;
    static_assert(NCH % GS == 0 && NCHC < GS, "scan group size");
    for (int blk = (int)gridDim.x - 1 - (int)blockIdx.x; blk < 2 * NBH * 4; blk += gridDim.x) {
        const int sq = blk >> 2, part = blk & 3, dir = sq / NBH, e0 = part * 1024 + tid * 2, k = e0 & 63;
        unsigned* S = (unsigned*)(p.SLOC + (size_t)sq * NCH * 4096 + e0);
        const float* G = p.GDEC + (size_t)sq * NCH * 64 + k;
        float c0 = 0.f, c1 = 0.f;
        const long sstep = dir ? -2048L : 2048L, gstep = dir ? -64L : 64L;
        unsigned* Sl = S + (size_t)(dir ? NCHC - 1 : 0) * 2048; const float* Gl = G + (size_t)(dir ? NCHC - 1 : 0) * 64; unsigned* Sw = Sl;
        unsigned* S2 = S + (size_t)(dir ? NCH - 1 : NCHC) * 2048; const float* G2 = G + (size_t)(dir ? NCH - 1 : NCHC) * 64;
        unsigned nx[2][GS]; f32x2 gn[2][GS];
#define HG_LD(set, j, u) do { nx[set][u] = *Sl; gn[set][u] = *(const f32x2*)Gl; if ((j) + 1 == NCHC) { Sl = S2; Gl = G2; } else { Sl += sstep; Gl += gstep; } } while (0)
#pragma unroll
        for (int u = 0; u < GS; ++u) HG_LD(0, u, u);
#pragma unroll
        for (int g = 0; g < NG; ++g) {
            asm volatile("" : "+v"(Sl), "+v"(Gl), "+v"(Sw));
            if (g + 1 < NG) {
#pragma unroll
                for (int u = 0; u < GS; ++u) HG_LD((g + 1) & 1, (g + 1) * GS + u, u);
            }
            unsigned w[GS];
#pragma unroll
            for (int u = 0; u < GS; ++u) {
                w[u] = cvt_pk_bf16(c0, c1);
                c0 = gn[g & 1][u][0] * c0 + bfw(nx[g & 1][u], 0); c1 = gn[g & 1][u][1] * c1 + bfw(nx[g & 1][u], 1);
            }
#pragma unroll
            for (int u = 0; u < GS; ++u) { *Sw = w[u]; if (g * GS + u + 1 == NCHC) Sw = S2; else Sw += sstep; }
        }
#undef HG_LD
    }
}
__device__ __forceinline__ void phase_hgrn_out(const int tid, PRef p, int l, LAS unsigned char* lds) {
    const int NCHO = (l + 1 < DEPTH) ? NCH : NCH - NCHC, PC0 = NCH - NCHO;
    LAS float* FF = (LAS float*)(lds + HG_FF); LAS float* FB = (LAS float*)(lds + HG_FB); LAS float* AF = (LAS float*)(lds + HG_AF); LAS float* AB = (LAS float*)(lds + HG_AB);
    LAS bf16_t* VT = (LAS bf16_t*)(lds + HG_VT);
    LAS float* OO = (LAS float*)(lds + HG_AF);
    const int t = tid >> 3, cg = tid & 7, wave = tid >> 6, lane = tid & 63, fr = lane & 15, fq = lane >> 4;
    u32x4 zf = (u32x4){0u, 0u, 0u, 0u}, zb = zf, v8 = zf, q8 = zf, g8 = zf, nzf = zf, nzb = zf, nv8 = zf, nq8 = zf, ng8 = zf;
    bf16x8 bsin[4][2], nbsin[4][2];
#define HG_LOADSIN(dst, bhx, pcx) do { const bf16_t* SIN_ = p.SLOC + ((size_t)((wave >> 2) * NBH + (bhx)) * NCH + (pcx)) * 4096; \
        _Pragma("unroll") for (int vt = 0; vt < 4; ++vt) _Pragma("unroll") for (int ks = 0; ks < 2; ++ks) dst[vt][ks] = *(const bf16x8*)(SIN_ + (vt * 16 + fr) * 64 + ks * 32 + fq * 8); } while (0)
#pragma unroll
    for (int vt = 0; vt < 4; ++vt) { bsin[vt][0] = (bf16x8){0, 0, 0, 0, 0, 0, 0, 0}; bsin[vt][1] = bsin[vt][0]; nbsin[vt][0] = bsin[vt][0]; nbsin[vt][1] = bsin[vt][0]; }
    if ((int)blockIdx.x < NBH * NCHO) { const int it = blockIdx.x, pc = it % NCHO + PC0, bh = it / NCHO, h = bh % HGH, b = bh / HGH;
        const bf16_t* pr = p.P + (size_t)(hg_row0(b, pc) + t) * INC + h * 64 + cg * 8; zf = *(const u32x4*)(pr + OFF_); zb = *(const u32x4*)(pr + OFB); v8 = *(const u32x4*)(pr + OHI); q8 = *(const u32x4*)(pr + OHQ); g8 = *(const u32x4*)(pr + OHG_);
        HG_LOADSIN(bsin, bh, pc); }
    hg_stage_lb(tid, p, l);
    f32x4 hn0, hn1; { const float* nwp = p.hg_norm + l * 64 + cg * 8; hn0 = *(const f32x4*)nwp; hn1 = *(const f32x4*)(nwp + 4); }
    for (int it = blockIdx.x; it < NBH * NCHO; it += gridDim.x) {
        const int pc = it % NCHO + PC0, bh = it / NCHO, h = bh % HGH, b = bh / HGH, row0 = hg_row0(b, pc);
        { const int it2 = min(it + (int)gridDim.x, NBH * NCHO - 1); const int pc2 = it2 % NCHO + PC0, bh2 = it2 / NCHO, h2 = bh2 % HGH, b2 = bh2 / HGH;
            const bf16_t* pr = p.P + (size_t)(hg_row0(b2, pc2) + t) * INC + h2 * 64 + cg * 8; nzf = *(const u32x4*)(pr + OFF_); nzb = *(const u32x4*)(pr + OFB); nv8 = *(const u32x4*)(pr + OHI); nq8 = *(const u32x4*)(pr + OHQ); ng8 = *(const u32x4*)(pr + OHG_);
            HG_LOADSIN(nbsin, bh2, pc2); }
        hg_gates(tid, p, l, h, zf, zb, lds);
        {
            float w[6][8];
            float af8[8], ab8[8], rf8[8], rb8[8], ff8[8], fb8[8];
            HGLD8(af8, AF, t, cg * 8); HGLD8(ab8, AB, t, cg * 8); HGLD8(rf8, AF, 31, cg * 8); HGLD8(rb8, AB, 32, cg * 8); HGLD8(ff8, FF, t, cg * 8); HGLD8(fb8, FB, t, cg * 8);
#pragma unroll
            for (int j = 0; j < 8; ++j) {
                const int k = cg * 8 + j;
                const float qv = bf8(q8, j) * 0.125f, af = af8[j], ab = ab8[j], rf = rf8[j], rb = rb8[j];
                w[0][j] = qv * __expf(fminf(af - rf, 80.f)); w[1][j] = (1.f - ff8[j]) * __expf(fminf(rf - af, 80.f)); w[2][j] = qv * __expf(af);
                w[3][j] = qv * __expf(fminf(ab - rb, 80.f)); w[4][j] = (1.f - fb8[j]) * __expf(fminf(rb - ab, 80.f)); w[5][j] = qv * __expf(ab);
            }
            *(LAS u32x4*)(lds + HG_VT + t * 144 + cg * 16) = v8;
#pragma unroll
            for (int a = 0; a < 6; ++a) { u32x4 o; o.x = cvt_pk_bf16(w[a][0], w[a][1]); o.y = cvt_pk_bf16(w[a][2], w[a][3]); o.z = cvt_pk_bf16(w[a][4], w[a][5]); o.w = cvt_pk_bf16(w[a][6], w[a][7]);
                *(LAS u32x4*)(lds + HG_T0 + a * HG_TS + t * 144 + cg * 16) = o; }
        }
        LDS_BAR();
        {
            const int dir = wave >> 2, tt = wave & 3;
            const LAS unsigned char* QT = lds + HG_T0 + (dir * 3 + 0) * HG_TS; const LAS unsigned char* KL = lds + HG_T0 + (dir * 3 + 1) * HG_TS; const LAS unsigned char* QH = lds + HG_T0 + (dir * 3 + 2) * HG_TS;
            bf16x8 bq[2], bh[2];
#pragma unroll
            for (int ks = 0; ks < 2; ++ks) { bq[ks] = *(const LAS bf16x8*)(QT + (tt * 16 + fr) * 144 + ks * 64 + fq * 16); bh[ks] = *(const LAS bf16x8*)(QH + (tt * 16 + fr) * 144 + ks * 64 + fq * 16); }
            f32x4 o[4];
#pragma unroll
            for (int vt = 0; vt < 4; ++vt) { o[vt] = (f32x4){0.f, 0.f, 0.f, 0.f};
#pragma unroll
                for (int ks = 0; ks < 2; ++ks) o[vt] = mfma16(bsin[vt][ks], bh[ks], o[vt]); }
            const int t_ = 16 * tt + fr;
#pragma unroll
            for (int kp = 0; kp < 2; ++kp) {
                f32x4 sc[2];
#pragma unroll
                for (int hf = 0; hf < 2; ++hf) { const int st = 2 * kp + hf;
                    sc[hf] = (f32x4){0.f, 0.f, 0.f, 0.f};
                    if (dir ? st >= tt : st <= tt) {
#pragma unroll
                        for (int ks = 0; ks < 2; ++ks) { const bf16x8 a = *(const LAS bf16x8*)(KL + (st * 16 + fr) * 144 + ks * 64 + fq * 16); sc[hf] = mfma16(a, bq[ks], sc[hf]); }
#pragma unroll
                        for (int r = 0; r < 4; ++r) { const int s_ = 16 * st + 4 * fq + r; const bool keep = dir ? (s_ >= t_) : (s_ <= t_); sc[hf][r] = keep ? sc[hf][r] : 0.f; }
                    } }
                if (dir ? (2 * kp + 1 >= tt) : (2 * kp <= tt)) {
                    u32x4 pw; pw.x = cvt_pk_bf16(sc[0][0], sc[0][1]); pw.y = cvt_pk_bf16(sc[0][2], sc[0][3]); pw.z = cvt_pk_bf16(sc[1][0], sc[1][1]); pw.w = cvt_pk_bf16(sc[1][2], sc[1][3]);
                    const bf16x8 pf = __builtin_bit_cast(bf16x8, pw);
                    const int s0 = 32 * kp + 4 * fq;
#pragma unroll
                    for (int vt = 0; vt < 4; ++vt) { const LAS unsigned char* vr = lds + HG_VT + (32 * kp + 4 * fq + (fr >> 2)) * 144 + 8 * (fr & 3) + vt * 32;
                        o[vt] = mfma16(ld2tr(vr, vr + 16 * 144), pf, o[vt]); }
                }
            }
            LAS float* OOd = (LAS float*)(lds + (dir ? HG_FB : HG_FF));
#pragma unroll
            for (int vt = 0; vt < 4; ++vt) *(LAS f32x4*)(OOd + HGI(t_, 16 * vt + 4 * fq)) = o[vt];
        }
        LDS_BAR();
        {
            float o[8]; float ss = 0.f;
            float of8[8], ob8[8]; HGLD8(of8, FF, t, cg * 8); HGLD8(ob8, FB, t, cg * 8);
#pragma unroll
            for (int j = 0; j < 8; ++j) { o[j] = of8[j] + ob8[j]; ss += o[j] * o[j]; }
            ss = oct_sum(ss);
            const float rstd = 1.f / sqrtf(ss * (1.f / 64.f) + EPS);
            float y[8];
#pragma unroll
            for (int j = 0; j < 8; ++j) { const float g = bf8(g8, j); y[j] = o[j] * rstd * (j < 4 ? hn0[j & 3] : hn1[j & 3]) * g * __builtin_amdgcn_rcpf(1.f + __expf(-g)); }
            u32x4 ov; ov.x = cvt_pk_bf16(y[0], y[1]); ov.y = cvt_pk_bf16(y[2], y[3]); ov.z = cvt_pk_bf16(y[4], y[5]); ov.w = cvt_pk_bf16(y[6], y[7]);
            zf = nzf; zb = nzb; v8 = nv8; q8 = nq8; g8 = ng8;
#pragma unroll
            for (int vt = 0; vt < 4; ++vt) { bsin[vt][0] = nbsin[vt][0]; bsin[vt][1] = nbsin[vt][1]; }
            asm volatile("" ::: "memory");
            *(u32x4*)(p.MIX + (size_t)(row0 + t) * MIXD + 384 + h * 64 + cg * 8) = ov;
        }
        LDS_BAR();
    }
}


#undef HG_LOADSIN
constexpr int AT_KC = 0, AT_VCT = 36864, AT_KL = AT_VCT + 256 * 144, AT_VL = AT_KL + 3 * 9216, AT_RPB = AT_VL + 3 * 9216, AT_END = AT_RPB + 1920;
static_assert(AT_END <= RING_BYTES && CTX == 256, "attention LDS layout (built for 256 context tokens)");
constexpr float ATHR = 6.f;
template <bool LOCAL, int NKB>
__device__ __forceinline__ void attn_scores(const LAS unsigned char* Kb, const bf16x8 (&qb)[2], f32x4 (&sc)[2 * NKB], int fr, int fq, const LAS float* rpb_row, const int (&boff)[8]) {
#pragma unroll
    for (int mt = 0; mt < 2 * NKB; ++mt) { sc[mt] = (f32x4){0.f, 0.f, 0.f, 0.f};
#pragma unroll
        for (int ks = 0; ks < 2; ++ks) { const bf16x8 a = *(const LAS bf16x8*)(Kb + (16 * mt + fr) * 144 + ks * 64 + fq * 16); sc[mt] = mfma16(a, qb[ks], sc[mt]); } }
    if (LOCAL) {
#pragma unroll
        for (int mt = 0; mt < 2 * NKB; ++mt)
#pragma unroll
            for (int r = 0; r < 4; ++r) sc[mt][r] += *(const LAS float*)((const LAS unsigned char*)rpb_row + boff[(4 * mt + r) & 7]);
    }
}
template <bool LOCAL, int NKB>
__device__ __forceinline__ void attn_spv(const f32x4 (&sc)[2 * NKB], const LAS unsigned char* Vb, f32x4 (&o)[4], float& m, float& lsum, int lane, int vtr) {
    float mx = -INFINITY;
#pragma unroll
    for (int mt = 0; mt < 2 * NKB; ++mt)
#pragma unroll
        for (int r = 0; r < 4; ++r) mx = fmaxf(mx, sc[mt][r]);
    if (__builtin_amdgcn_ballot_w64(mx > m + ATHR) != 0ull) {
        mx = fmaxf(mx, __builtin_bit_cast(float, __builtin_amdgcn_ds_swizzle(__builtin_bit_cast(int, mx), (16 << 10) | 0x1f)));
        mx = fmaxf(mx, __builtin_bit_cast(float, __builtin_amdgcn_ds_bpermute((lane ^ 32) << 2, __builtin_bit_cast(int, mx))));
        const float mn = fmaxf(m, mx), corr = __builtin_amdgcn_exp2f(m - mn);
        m = mn; lsum *= corr;
#pragma unroll
        for (int dt = 0; dt < 4; ++dt) o[dt] = o[dt] * corr;
    }
    float ps = 0.f;
#pragma unroll
    for (int kb = 0; kb < NKB; ++kb) {
        float pv[8];
#pragma unroll
        for (int h2 = 0; h2 < 2; ++h2)
#pragma unroll
            for (int r = 0; r < 4; ++r) { const float e = __builtin_amdgcn_exp2f(sc[2 * kb + h2][r] - m); pv[4 * h2 + r] = e; ps += e; }
        u32x4 pw; pw.x = cvt_pk_bf16(pv[0], pv[1]); pw.y = cvt_pk_bf16(pv[2], pv[3]); pw.z = cvt_pk_bf16(pv[4], pv[5]); pw.w = cvt_pk_bf16(pv[6], pv[7]);
        const bf16x8 pf = __builtin_bit_cast(bf16x8, pw);
#pragma unroll
        for (int dt = 0; dt < 4; ++dt) {
            const LAS unsigned char* vr = Vb + vtr + kb * (32 * 144) + dt * 32;
            o[dt] = mfma16(ld2tr(vr, vr + 16 * 144), pf, o[dt]);
        }
    }
    lsum += ps;
}
__device__ __forceinline__ void phase_attn(const int tid, PRef p, int l, LAS unsigned char* lds) {
    const int wave = tid >> 6, lane = tid & 63, fr = lane & 15, fq = lane >> 4, skey = tid >> 3, sc8 = tid & 7;
    LAS float* RPB = (LAS float*)(lds + AT_RPB);
    constexpr int NPAIR = ROWS / 2; const int IPB = NPAIR + ((l + 1 < DEPTH) ? 2 : 0);
    const int G_ = gridDim.x, NIT = NB * NAH * IPB;
#ifndef AT_DEAL_A
#define AT_DEAL_A 8
#define AT_DEAL_B 3
#endif
    const bool deal = (G_ == 256 && NIT <= 160 * AT_DEAL_A + 96 * AT_DEAL_B);
    const int it_lo = deal ? ((int)blockIdx.x < 160 ? (int)blockIdx.x * AT_DEAL_A : 160 * AT_DEAL_A + ((int)blockIdx.x - 160) * AT_DEAL_B) : (int)blockIdx.x;
    const int it_n = deal ? ((int)blockIdx.x < 160 ? AT_DEAL_A : AT_DEAL_B) : (NIT - (int)blockIdx.x + G_ - 1) / G_;
    int last_bh = -1;
#define AT_QTOK(itx) (((itx) % IPB) < NPAIR ? (((itx) / IPB) / NAH) * SEQ + (2 * ((itx) % IPB) + (wave >> 2)) * GW + 16 * (wave & 3) + fr : NLAT + (((itx) / IPB) / NAH) * CTX + ((((itx) % IPB) - NPAIR) * 128 + 16 * wave) + fr)
#define AT_LOADQ(itx, dst) do { const bf16_t* qp_ = p.P + (size_t)AT_QTOK(itx) * INC + OQ + (((itx) / IPB) % NAH) * 64 + fq * 8; dst[0] = *(const bf16x8*)qp_; dst[1] = *(const bf16x8*)(qp_ + 32); } while (0)
    bf16x8 qnx[2] = {(bf16x8){0, 0, 0, 0, 0, 0, 0, 0}, (bf16x8){0, 0, 0, 0, 0, 0, 0, 0}};
    { const int it0 = it_lo; if (it_n > 0 && it0 < NIT) AT_LOADQ(it0, qnx); }
    for (int ii = 0; ii < it_n; ++ii) {
        const int it = deal ? it_lo + ii : it_lo + ii * G_;
        if (it >= NIT) break;
        const int sub = it % IPB, bh = it / IPB, head = bh % NAH, b = bh / NAH;
        const bool islat = sub < NPAIR;
        const int r0 = 2 * sub, qr = r0 + (wave >> 2), jb = wave & 3;
        LDS_BAR();
        if (bh != last_bh) {
            last_bh = bh;
            int sc8l = sc8; asm volatile("" : "+v"(sc8l));
            for (int rnd = 0; rnd < 4; ++rnd) {
                const int key = skey + 64 * rnd; const bf16_t* src = p.P + (size_t)(NLAT + b * CTX + key) * INC + head * 64 + sc8l * 8;
                const u32x4 kv = *(const u32x4*)(src + OK_), vv = *(const u32x4*)(src + OV);
                *(LAS u32x4*)(lds + AT_KC + key * 144 + sc8 * 16) = kv; *(LAS u32x4*)(lds + AT_VCT + key * 144 + sc8 * 16) = vv;
            }
            { int t2 = tid; asm volatile("" : "+v"(t2));
              if (t2 < 15 * 32) RPB[t2] = (t2 & 31) < 31 ? p.rpb[((size_t)l * NAH + head) * 465 + (t2 >> 5) * 31 + (t2 & 31)] * 1.44269504089f : -INFINITY; }
        }
        const int qtok = islat ? b * SEQ + qr * GW + 16 * jb + fr : NLAT + b * CTX + ((sub - NPAIR) * 128 + 16 * wave) + fr;
        bf16x8 qb[2]; qb[0] = qnx[0]; qb[1] = qnx[1];
        { const int itn = deal ? it + 1 : it + G_; if (ii + 1 < it_n && itn < NIT) { int fr = (tid & 15); asm volatile("" : "+v"(fr)); AT_LOADQ(itn, qnx); } }
        int krlo = 0, krhi = -1, rs = 0;
        if (islat) { int a = r0 - 4; a = a < 0 ? 0 : (a > ROWS - 8 ? ROWS - 8 : a); int c = r0 + 1 - 4; c = c < 0 ? 0 : (c > ROWS - 8 ? ROWS - 8 : c); krlo = a; krhi = c + 7;
            rs = qr - 4; rs = rs < 0 ? 0 : (rs > ROWS - 8 ? ROWS - 8 : rs); }
        u32x4 kA = (u32x4){0u, 0u, 0u, 0u}, vA = kA, kB = kA, vB = kA, kC = kA, vC = kA;
        int skl = skey; asm volatile("" : "+v"(skl));
#define AT_LOADROW(row, kd, vd) do { const bf16_t* src_ = p.P + (size_t)(b * SEQ + (row) * GW + skl) * INC + head * 64 + sc8 * 8; kd = *(const u32x4*)(src_ + OK_); vd = *(const u32x4*)(src_ + OV); } while (0)
#define AT_STAGEROW(bufi, kd, vd) do { *(LAS u32x4*)(lds + AT_KL + (bufi) * 9216 + skey * 144 + sc8 * 16) = kd; *(LAS u32x4*)(lds + AT_VL + (bufi) * 9216 + skey * 144 + sc8 * 16) = vd; } while (0)
        if (islat) { AT_LOADROW(krlo, kA, vA); AT_LOADROW(krlo + 1, kB, vB); AT_LOADROW(krlo + 2, kC, vC); }
        f32x4 o[4]; float m = -1e30f, lsum = 0.f;
#pragma unroll
        for (int dt = 0; dt < 4; ++dt) o[dt] = (f32x4){0.f, 0.f, 0.f, 0.f};
        LDS_BAR();
        const int bs = jb == 0 ? 0 : (jb == 1 ? 8 : (jb == 2 ? 24 : 32)), qc = 16 * jb + fr;
        int boff[8];
        { int ws = qc - 8; ws = ws < 0 ? 0 : (ws > 48 ? 48 : ws);
#pragma unroll
          for (int j_ = 0; j_ < 8; ++j_) { const int kc = bs + 16 * (j_ >> 2) + 4 * fq + (j_ & 3); const bool ok = kc >= ws && kc < ws + 16; boff[j_] = (ok ? kc - qc + 15 : 31) * 4; asm volatile("" : "+v"(boff[j_])); } }
        int vtr = (4 * fq + (fr >> 2)) * 144 + 8 * (fr & 3); asm volatile("" : "+v"(vtr));
        const int vtrl = vtr + bs * 144;
        {
            f32x4 sa[4], sb[4];
#define AT_CS(st, dst) attn_scores<false, 2>(lds + AT_KC + (st) * 64 * 144, qb, dst, fr, fq, RPB, boff)
#define AT_CP(st, src) attn_spv<false, 2>(src, lds + AT_VCT + (st) * 64 * 144, o, m, lsum, lane, vtr)
            AT_CS(0, sa); AT_CS(1, sb); AT_CP(0, sa); AT_CS(2, sa); AT_CP(1, sb); AT_CS(3, sb); AT_CP(2, sa); AT_CP(3, sb);
#undef AT_CS
#undef AT_CP
        }
        if (islat) { AT_STAGEROW(0, kA, vA); AT_LOADROW(krlo + 3, kA, vA); AT_STAGEROW(1, kB, vB); AT_LOADROW(krlo + 4, kB, vB); }
        LDS_BAR();
        if (islat) {
            const bool first0 = rs == krlo, last8 = !first0;
            const LAS float* rp = RPB + (krlo - qr + 7) * 32;
            f32x4 sa[2], sb[2];
#define AT_S(j, dst) attn_scores<true, 1>(lds + AT_KL + ((j) % 3) * 9216 + bs * 144, qb, dst, fr, fq, rp + 32 * (j), boff)
#define AT_P(j, src) attn_spv<true, 1>(src, lds + AT_VL + ((j) % 3) * 9216, o, m, lsum, lane, vtrl)
#define AT_MID(j, NK, NV, LOADROWX, SCUR, SNXT) { AT_STAGEROW(((j) + 2) % 3, NK, NV); if ((LOADROWX) >= 0) { AT_LOADROW(min(krlo + (LOADROWX), krhi), NK, NV); } \
            AT_S((j) + 1, SNXT); AT_P(j, SCUR); LDS_BAR(); }
            sa[0] = (f32x4){0.f, 0.f, 0.f, 0.f}; sa[1] = sa[0];
            if (first0) AT_S(0, sa);
            { AT_STAGEROW(2, kC, vC); AT_LOADROW(krlo + 5, kC, vC); AT_S(1, sb); if (first0) AT_P(0, sa); LDS_BAR(); }
            AT_MID(1, kA, vA, 6, sb, sa) AT_MID(2, kB, vB, 7, sa, sb) AT_MID(3, kC, vC, 8, sb, sa) AT_MID(4, kA, vA, -1, sa, sb) AT_MID(5, kB, vB, -1, sb, sa) AT_MID(6, kC, vC, -1, sa, sb)
            if (last8) { AT_S(8, sa); AT_P(7, sb); AT_P(8, sa); } else { AT_P(7, sb); }
#undef AT_S
#undef AT_P
#undef AT_MID
        }
#undef AT_LOADROW
#undef AT_STAGEROW
        lsum = x32_sum(x16_sum(lsum, lane), lane);
        const float inv = 1.f / lsum;
        bf16_t* orow = p.MIX + (size_t)qtok * MIXD + head * 64;
#pragma unroll
        for (int dt = 0; dt < 4; ++dt) { u32x2 w; w.x = cvt_pk_bf16(o[dt][0] * inv, o[dt][1] * inv); w.y = cvt_pk_bf16(o[dt][2] * inv, o[dt][3] * inv); *(u32x2*)(orow + 16 * dt + 4 * fq) = w; }
    }
}


#undef AT_QTOK
#undef AT_LOADQ
template <int MODE> __device__ __forceinline__ void mini_gemm(const int tid, PRef p, int l) {
    const int wave = tid >> 6, lane = tid & 63, fr = lane & 15, fq = lane >> 4;
    const int gw = blockIdx.x * NWAVES + wave, NGW = gridDim.x * NWAVES;
    constexpr int K = MODE == 3 ? ED : (MODE == 1 ? MIXD : D);
    constexpr int N = MODE == 0 ? INC : (MODE == 2 ? 2 * ED : D);
    constexpr int MROWS = MODE <= 1 ? NCTX : NSLOT_C;
    constexpr int NTC = MODE == 2 ? 2 : 1, TW = 16 * NTC;
    constexpr int NTN = N / TW, NT = (MROWS / 32) * NTN;
    for (int t = gw; t < NT; t += NGW) {
        const int rt = t / NTN, ct = t % NTN, c0 = ct * TW;
        const bf16_t* Bt; const bf16_t* arow[2];
        if (MODE == 0) { Bt = p.WIN_T + WBOFF(l); for (int mt = 0; mt < 2; ++mt) arow[mt] = p.H + (size_t)(NLAT + rt * 32 + 16 * mt + fr) * D; }
        else if (MODE == 1) { Bt = p.WOUT_T + WBOFF(l); for (int mt = 0; mt < 2; ++mt) arow[mt] = p.MIX + (size_t)(NLAT + rt * 32 + 16 * mt + fr) * MIXD; }
        else if (MODE == 2) { const int e = rt % NE; Bt = p.WGU_T + WBOFF(l) + (size_t)e * 2 * ED * D;
            for (int mt = 0; mt < 2; ++mt) { int row = p.STOK[NSLOT_L + rt * 32 + 16 * mt + fr]; row = row < 0 ? 0 : (row >= NTOK ? NTOK - 1 : row); arow[mt] = p.H + (size_t)row * D; } }
        else { const int e = rt % NE; Bt = p.WD_T + WBOFF(l) + (size_t)e * D * ED; for (int mt = 0; mt < 2; ++mt) arow[mt] = p.HID + (size_t)(NSLOT_L + rt * 32 + 16 * mt + fr) * ED; }
        const bf16_t* brow = Bt + (size_t)(c0 + fr) * K;
        f32x4 acc[2][NTC];
#pragma unroll
        for (int mt = 0; mt < 2; ++mt)
#pragma unroll
            for (int nt = 0; nt < NTC; ++nt) acc[mt][nt] = (f32x4){0.f, 0.f, 0.f, 0.f};
#pragma unroll 8
        for (int ks = 0; ks < K / 32; ++ks) {
            bf16x8 a[2], bfr[NTC];
#pragma unroll
            for (int mt = 0; mt < 2; ++mt) a[mt] = *(const bf16x8*)(arow[mt] + ks * 32 + fq * 8);
#pragma unroll
            for (int nt = 0; nt < NTC; ++nt) bfr[nt] = *(const bf16x8*)(brow + (size_t)(16 * nt) * K + ks * 32 + fq * 8);
#pragma unroll
            for (int mt = 0; mt < 2; ++mt)
#pragma unroll
                for (int nt = 0; nt < NTC; ++nt) acc[mt][nt] = mfma16(a[mt], bfr[nt], acc[mt][nt]);
        }
#pragma unroll
        for (int mt = 0; mt < 2; ++mt)
#pragma unroll
            for (int r = 0; r < 4; ++r) {
                const int lr = rt * 32 + 16 * mt + 4 * fq + r;
                if (MODE == 0) { bf16_t* o = p.P + (size_t)(NLAT + lr) * INC + c0 + fr;
#pragma unroll
                    for (int nt = 0; nt < NTC; ++nt) o[16 * nt] = f2bf(acc[mt][nt][r]); }
                else if (MODE == 1) { float* o = p.XC + (size_t)lr * D + c0 + fr; const float* g = p.MOD + ((size_t)l * 3 + 2) * NMOD + 2 * D + c0 + fr;
#pragma unroll
                    for (int nt = 0; nt < NTC; ++nt) o[16 * nt] += g[16 * nt] * acc[mt][nt][r]; }
                else if (MODE == 2) { bf16_t* o = p.HID + (size_t)(NSLOT_L + lr) * ED + c0 / 2 + fr;
#pragma unroll
                    for (int q = 0; q < NTC / 2; ++q) { const float g = acc[mt][2 * q][r], u = acc[mt][2 * q + 1][r]; o[16 * q] = f2bf(g / (1.f + __expf(-g)) * u); } }
                else { bf16_t* o = p.Y + (size_t)(NSLOT_L + lr) * D + c0 + fr; const float val = p.SVAL[NSLOT_L + lr];
#pragma unroll
                    for (int nt = 0; nt < NTC; ++nt) o[16 * nt] = f2bf(val * acc[mt][nt][r]); }
            }
    }
}


__device__ __forceinline__ void phase_conv(const int tid, PRef p, int l) {
    const float* w = p.conv_w + (size_t)l * 3 * CVD;
    constexpr int U = 2;
    const long nitem = (long)NTOK * (CVD / 8), gstr = (long)gridDim.x * NTHR;
    for (long g0 = (long)blockIdx.x * NTHR + tid; g0 < nitem; g0 += gstr * U) {
        u32x4 cc[U][3], uu[U][3], bg[U]; float vz[U][3]; int rr[U], c8v[U]; bool ok[U];
#pragma unroll
        for (int u = 0; u < U; ++u) {
            long gid = g0 + u * gstr; ok[u] = gid < nitem; if (!ok[u]) gid = g0;
            const int r = (int)(gid / (CVD / 8)), c8 = (int)(gid % (CVD / 8)) * 8; rr[u] = r; c8v[u] = c8;
            int t, T; if (r < NLAT) { t = r % SEQ; T = SEQ; } else { t = (r - NLAT) % CTX; T = CTX; }
            const bf16_t* pr = p.P + (size_t)r * INC + c8;
#pragma unroll
            for (int d = 0; d < 3; ++d) { const int tt = t + d - 1; const bool in = tt >= 0 && tt < T; vz[u][d] = in ? 1.f : 0.f;
                const bf16_t* q = pr + (in ? (long)(d - 1) * INC : 0L); cc[u][d] = *(const u32x4*)(q + OCC); uu[u][d] = *(const u32x4*)(q + OCU); }
            bg[u] = *(const u32x4*)(pr + OCB);
        }
        asm volatile("" ::: "memory");
#pragma unroll
        for (int u = 0; u < U; ++u) {
            float y[8];
#pragma unroll
            for (int j = 0; j < 8; ++j) y[j] = 0.f;
#pragma unroll
            for (int d = 0; d < 3; ++d) {
                const f32x4 w0 = *(const f32x4*)(w + d * CVD + c8v[u]) * vz[u][d], w1 = *(const f32x4*)(w + d * CVD + c8v[u] + 4) * vz[u][d];
#pragma unroll
                for (int j = 0; j < 8; ++j) y[j] += (j < 4 ? w0[j & 3] : w1[j & 3]) * bf8(cc[u][d], j) * bf8(uu[u][d], j);
            }
            u32x4 o; o.x = cvt_pk_bf16(bf8(bg[u], 0) * y[0], bf8(bg[u], 1) * y[1]); o.y = cvt_pk_bf16(bf8(bg[u], 2) * y[2], bf8(bg[u], 3) * y[3]);
            o.z = cvt_pk_bf16(bf8(bg[u], 4) * y[4], bf8(bg[u], 5) * y[5]); o.w = cvt_pk_bf16(bf8(bg[u], 6) * y[6], bf8(bg[u], 7) * y[7]);
            if (ok[u]) *(u32x4*)(p.MIX + (size_t)rr[u] * MIXD + 768 + c8v[u]) = o;
        }
    }
}
__device__ __forceinline__ void phase_qkprep(const int tid, PRef p, int l) {
    const int sub = tid & 7;
    constexpr int U = 4;
    const long ngroups = (long)NTOK * 12, gstride = ((long)gridDim.x * NTHR) >> 3;
    for (long g0 = ((long)blockIdx.x * NTHR + tid) >> 3; g0 < ngroups; g0 += gstride * U) {
        u32x4 raw[U]; bf16_t* ptr[U]; int rr[U]; int wh[U];
#pragma unroll
        for (int u = 0; u < U; ++u) { long g8 = g0 + u * gstride; const bool ok = g8 < ngroups; if (!ok) g8 = g0;
            rr[u] = ok ? (int)(g8 / 12) : -1; wh[u] = (int)(g8 % 12) / 6; const int head = (int)(g8 % 6);
            ptr[u] = p.P + (size_t)(g8 / 12) * INC + (wh[u] ? OK_ : OQ) + head * HD + sub * 8; raw[u] = *(const u32x4*)ptr[u]; }
#pragma unroll
        for (int u = 0; u < U; ++u) {
            const float* nw = (wh[u] ? p.k_norm : p.q_norm) + l * HD + sub * 8;
            float y[8]; float ss = 0.f;
#pragma unroll
            for (int j = 0; j < 8; ++j) { y[j] = bf8(raw[u], j); ss += y[j] * y[j]; }
            ss = oct_sum(ss);
            const float rstd = 1.f / sqrtf(ss * (1.f / HD) + EPS);
#pragma unroll
            for (int j = 0; j < 8; ++j) y[j] = y[j] * rstd * nw[j];
            const int r = rr[u];
            const bool lat = r >= 0 && r < NLAT;
            const int t = lat ? r % SEQ : 0; const float pos = (sub & 4) ? (float)(t % GW) : (float)(t / GW);
            const bool second = (sub & 2) != 0;
#pragma unroll
            for (int j = 0; j < 8; ++j) {
                const float other = __builtin_bit_cast(float, __builtin_amdgcn_ds_swizzle(__builtin_bit_cast(int, y[j]), (2 << 10) | 0x1f));
                const int fi = (sub & 1) * 8 + j;
                const float ang = pos * __builtin_amdgcn_exp2f(-(float)fi * (13.287712379549449f / 16.f));
                const float cs = FCOS(ang), sn = FSIN(ang);
                const float rot = second ? y[j] * cs + other * sn : y[j] * cs - other * sn;
                y[j] = lat ? rot : y[j];
            }
            if (r >= 0) { u32x4 o; o.x = cvt_pk_bf16(y[0], y[1]); o.y = cvt_pk_bf16(y[2], y[3]); o.z = cvt_pk_bf16(y[4], y[5]); o.w = cvt_pk_bf16(y[6], y[7]); *(u32x4*)ptr[u] = o; }
        }
    }
}

__device__ __forceinline__ f32x4 bf4(const u32x2 w) { return (f32x4){bfw(w.x, 0), bfw(w.x, 1), bfw(w.y, 0), bfw(w.y, 1)}; }
template <int MODE> __device__ __forceinline__ void phase_rows(const int tid, PRef p, int l, LAS unsigned char* lds) {
    static_assert(D == 1024, "wave-per-row kernels assume D = 1024");
    const int lane = tid & 63, wave = tid >> 6;
#define RC(j) (8 * lane + 512 * ((j) >> 1) + 4 * ((j) & 1))
    if (MODE == 1) {
        for (int k = tid; k < D; k += NTHR) { const f32x4* src = (const f32x4*)(p.w_router + ((size_t)l * D + k) * NE); LAS f32x4* dst = (LAS f32x4*)(lds + k * 64 + (k >> 3) * 16);
#pragma unroll
            for (int u = 0; u < 4; ++u) dst[u] = src[u]; }
        __syncthreads();
    }
    const int gw = blockIdx.x * NWAVES + wave, NGW = gridDim.x * NWAVES;
    const int rw = ((NTOK + NGW - 1) / NGW + 1) & ~1;
    const int r_lo = gw * rw, r_hi = min(NTOK, r_lo + rw);
    const bool doh = MODE != 2 || l + 1 < DEPTH;
    const int ln = (MODE == 2 && l + 1 < DEPTH) ? l + 1 : l;
    const float* nw = (MODE == 1 ? p.norm2_w : p.norm1_w) + (size_t)ln * D;
    int curset = -1; f32x4 Av[4], Sv[4], Gv[4];
#pragma unroll
    for (int j = 0; j < 4; ++j) { Av[j] = (f32x4){0.f, 0.f, 0.f, 0.f}; Sv[j] = Av[j]; Gv[j] = Av[j]; }
    constexpr int NVN = MODE == 0 ? 4 : 2;
    u32x4 vn[2][NVN]; int invn[2] = {-1, -1};
#define ROWS_LOADPAIR(rb) do { _Pragma("unroll") for (int i_ = 0; i_ < 2; ++i_) { const int rr_ = ((rb) + i_ < r_hi) ? (rb) + i_ : (rb); \
        if (MODE == 0) { const float* src_ = rr_ < NLAT ? p.x + (size_t)rr_ * D : p.ctx + (size_t)(rr_ - NLAT) * D; \
            _Pragma("unroll") for (int j_ = 0; j_ < NVN; ++j_) vn[i_][j_] = *(const u32x4*)(src_ + RC(j_)); } \
        else if (rr_ < NLAT) { const bf16_t* src_ = p.XB + (size_t)rr_ * D + 8 * lane; vn[i_][0] = *(const u32x4*)src_; vn[i_][1] = *(const u32x4*)(src_ + 512); } \
        if (MODE == 2) invn[i_] = lane < NE ? p.INV[(size_t)rr_ * NE + lane] : -1; } } while (0)
#pragma unroll
    for (int i = 0; i < 2; ++i)
#pragma unroll
        for (int j = 0; j < NVN; ++j) vn[i][j] = (u32x4){0u, 0u, 0u, 0u};
    if (r_lo < r_hi) ROWS_LOADPAIR(r_lo);
#pragma unroll 1
    for (int r = r_lo; r < r_hi; r += 2) {
        const bool two = r + 1 < r_hi;
        const bool lat = r < NLAT;
        const int set = modset(r);
        if (set != curset) { curset = set;
            const float* mod = p.MOD + ((size_t)ln * 3 + set) * NMOD; const float* shift = mod + (MODE == 1 ? 3 : 0) * D; const float* scale = mod + (MODE == 1 ? 4 : 1) * D;
            int lane2 = lane; asm volatile("" : "+v"(lane2));
#pragma unroll
            for (int j = 0; j < 4; ++j) { const int c = 8 * lane2 + 512 * (j >> 1) + 4 * (j & 1); const f32x4 w4 = *(const f32x4*)(nw + c), sc4 = *(const f32x4*)(scale + c); Av[j] = w4 * (sc4 + 1.f); Sv[j] = *(const f32x4*)(shift + c);
                if (MODE == 2) Gv[j] = *(const f32x4*)(p.MOD + ((size_t)l * 3 + set) * NMOD + 5 * D + c); } }
        f32x4 v[2][4]; int inv2[2];
#pragma unroll
        for (int i = 0; i < 2; ++i) { inv2[i] = invn[i];
            if (MODE == 0) {
#pragma unroll
                for (int j = 0; j < 4; ++j) v[i][j] = __builtin_bit_cast(f32x4, vn[i][j < NVN ? j : 0]);
            } else if (lat) {
#pragma unroll
                for (int jj = 0; jj < 2; ++jj) { const u32x4 w = vn[i][jj]; v[i][2 * jj] = (f32x4){bfw(w.x, 0), bfw(w.x, 1), bfw(w.y, 0), bfw(w.y, 1)}; v[i][2 * jj + 1] = (f32x4){bfw(w.z, 0), bfw(w.z, 1), bfw(w.w, 0), bfw(w.w, 1)}; }
            } else { const float* src = p.XC + (size_t)(r + ((i == 0 || two) ? i : 0) - NLAT) * D;
#pragma unroll
                for (int j = 0; j < 4; ++j) v[i][j] = *(const f32x4*)(src + RC(j));
            } }
        if (r + 2 < r_hi) ROWS_LOADPAIR(r + 2);
        if (MODE == 2) {
            unsigned long long mk[2]; int sl[2][2];
#pragma unroll
            for (int i = 0; i < 2; ++i) { const int myinv = inv2[i]; mk[i] = __ballot(myinv >= 0 && myinv < NSLOT);
#pragma unroll
                for (int c = 0; c < 2; ++c) { sl[i][c] = -1; if (mk[i]) { const int e = __builtin_ctzll(mk[i]); mk[i] &= mk[i] - 1; sl[i][c] = __builtin_amdgcn_readlane(myinv, e); } } }
            u32x4 y[2][2][2];
#pragma unroll
            for (int i = 0; i < 2; ++i)
#pragma unroll
                for (int c = 0; c < 2; ++c) { y[i][c][0] = (u32x4){0u, 0u, 0u, 0u}; y[i][c][1] = y[i][c][0];
                    if (sl[i][c] >= 0) { const bf16_t* yp = p.Y + (size_t)sl[i][c] * D + 8 * lane; y[i][c][0] = *(const u32x4*)yp; y[i][c][1] = *(const u32x4*)(yp + 512); } }
            asm volatile("" ::: "memory");
#pragma unroll
            for (int i = 0; i < 2; ++i) {
                f32x4 acc[4];
#pragma unroll
                for (int j = 0; j < 4; ++j) acc[j] = (f32x4){0.f, 0.f, 0.f, 0.f};
#pragma unroll
                for (int c = 0; c < 2; ++c)
#pragma unroll
                    for (int jj = 0; jj < 2; ++jj) { const u32x4 w = y[i][c][jj];
                        acc[2 * jj] = acc[2 * jj] + (f32x4){bfw(w.x, 0), bfw(w.x, 1), bfw(w.y, 0), bfw(w.y, 1)}; acc[2 * jj + 1] = acc[2 * jj + 1] + (f32x4){bfw(w.z, 0), bfw(w.z, 1), bfw(w.w, 0), bfw(w.w, 1)}; }
                const int myinv = inv2[i];
                while (mk[i]) {
                    const int e = __builtin_ctzll(mk[i]); mk[i] &= mk[i] - 1; const int s0 = __builtin_amdgcn_readlane(myinv, e);
                    const bf16_t* yp = p.Y + (size_t)s0 * D + 8 * lane; const u32x4 w0 = *(const u32x4*)yp, w1 = *(const u32x4*)(yp + 512);
                    acc[0] = acc[0] + (f32x4){bfw(w0.x, 0), bfw(w0.x, 1), bfw(w0.y, 0), bfw(w0.y, 1)}; acc[1] = acc[1] + (f32x4){bfw(w0.z, 0), bfw(w0.z, 1), bfw(w0.w, 0), bfw(w0.w, 1)};
                    acc[2] = acc[2] + (f32x4){bfw(w1.x, 0), bfw(w1.x, 1), bfw(w1.y, 0), bfw(w1.y, 1)}; acc[3] = acc[3] + (f32x4){bfw(w1.z, 0), bfw(w1.z, 1), bfw(w1.w, 0), bfw(w1.w, 1)};
                }
#pragma unroll
                for (int j = 0; j < 4; ++j) v[i][j] = v[i][j] + Gv[j] * acc[j];
            }
        }
        if (MODE == 0 || MODE == 2) {
            const bool fin = MODE == 2 && l + 1 == DEPTH;
#pragma unroll
            for (int i = 0; i < 2; ++i) if (i == 0 || two) {
                if (lat && !fin) {
#pragma unroll
                    for (int jj = 0; jj < 2; ++jj) { u32x4 o; o.x = cvt_pk_bf16(v[i][2 * jj][0], v[i][2 * jj][1]); o.y = cvt_pk_bf16(v[i][2 * jj][2], v[i][2 * jj][3]); o.z = cvt_pk_bf16(v[i][2 * jj + 1][0], v[i][2 * jj + 1][1]); o.w = cvt_pk_bf16(v[i][2 * jj + 1][2], v[i][2 * jj + 1][3]);
                        *(u32x4*)(p.XB + (size_t)(r + i) * D + 8 * lane + 512 * jj) = o; }
                } else if (lat || !fin) { float* dst = lat ? p.XL + (size_t)(r + i) * D : p.XC + (size_t)(r + i - NLAT) * D;
#pragma unroll
                    for (int j = 0; j < 4; ++j) *(f32x4*)(dst + RC(j)) = v[i][j]; }
            }
        }
        if (doh) {
            float ss[2];
#pragma unroll
            for (int i = 0; i < 2; ++i) { float a = 0.f;
#pragma unroll
                for (int j = 0; j < 4; ++j) a += (v[i][j][0] * v[i][j][0] + v[i][j][1] * v[i][j][1]) + (v[i][j][2] * v[i][j][2] + v[i][j][3] * v[i][j][3]);
                ss[i] = a; }
            ss[0] = wave_sum(ss[0], lane); ss[1] = wave_sum(ss[1], lane);
            const float rstd0 = 1.f / sqrtf(ss[0] * (1.f / D) + EPS), rstd1 = 1.f / sqrtf(ss[1] * (1.f / D) + EPS);
            f32x4 hh[2][4];
#pragma unroll
            for (int j = 0; j < 4; ++j) { hh[0][j] = v[0][j] * rstd0 * Av[j] + Sv[j]; hh[1][j] = v[1][j] * rstd1 * Av[j] + Sv[j]; }
#pragma unroll
            for (int i = 0; i < 2; ++i) if (i == 0 || two) {
#pragma unroll
                for (int jj = 0; jj < 2; ++jj) { u32x4 o; o.x = cvt_pk_bf16(hh[i][2 * jj][0], hh[i][2 * jj][1]); o.y = cvt_pk_bf16(hh[i][2 * jj][2], hh[i][2 * jj][3]); o.z = cvt_pk_bf16(hh[i][2 * jj + 1][0], hh[i][2 * jj + 1][1]); o.w = cvt_pk_bf16(hh[i][2 * jj + 1][2], hh[i][2 * jj + 1][3]);
                    *(u32x4*)(p.H + (size_t)(r + i) * D + 8 * lane + 512 * jj) = o; } }
            if (MODE == 1) {
                LAS float* red = (LAS float*)(lds + 70144 + wave * 4224);
                LAS float* red1 = (LAS float*)(wave < 6 ? lds + 103936 + wave * 4224 : lds + LDSCTL_OFF + 1024 + (wave - 6) * 4224);
                const LAS unsigned char* wb = lds + lane * 528;
#pragma unroll
                for (int u = 0; u < 4; ++u) {
                    f32x4 a0 = (f32x4){0.f, 0.f, 0.f, 0.f}, a1 = a0;
#pragma unroll
                    for (int j = 0; j < 4; ++j)
#pragma unroll
                        for (int q = 0; q < 4; ++q) { const f32x4 w = *(const LAS f32x4*)(wb + (j >> 1) * 33792 + (4 * (j & 1) + q) * 64 + u * 16); const float h0 = hh[0][j][q], h1 = hh[1][j][q];
                            a0 = __builtin_elementwise_fma(w, (f32x4){h0, h0, h0, h0}, a0); a1 = __builtin_elementwise_fma(w, (f32x4){h1, h1, h1, h1}, a1); }
#pragma unroll
                    for (int c = 0; c < 4; ++c) { red[(4 * u + c) * 65 + lane] = a0[c]; red1[(4 * u + c) * 65 + lane] = a1[c]; }
                    asm volatile("" ::: "memory");
                }
#pragma unroll
                for (int i = 0; i < 2; ++i) {
                    const LAS float* rd = i ? red1 : red;
                    const int e2 = lane & 15, part = lane >> 4;
                    float t = 0.f;
#pragma unroll
                    for (int x = 0; x < 16; ++x) t += rd[e2 * 65 + part * 16 + x];
                    asm volatile("" ::: "memory");
                    t = x32_sum(x16_sum(t, lane), lane);
#define SWZF(x, d) __builtin_bit_cast(float, __builtin_amdgcn_ds_swizzle(__builtin_bit_cast(int, (x)), ((d) << 10) | 0x1f))
                    float m = t;
                    m = row16_max(m);
                    const float ex = expf(t - m); float sm = ex;
                    sm = row16_sum(sm);
#undef SWZF
                    if (lane < NE && (i == 0 || two)) p.AFF[(size_t)(r + i) * NE + lane] = ex / sm;
                }
            }
        }
    }
#undef ROWS_LOADPAIR
#undef RC
    if (MODE == 1) __syncthreads();
}


__device__ __forceinline__ void phase_adaln(const int tid, PRef p, LAS unsigned char* lds) {
    static_assert(D == 1024 && NMOD % 256 == 0, "adaln layout");
    const int lane = tid & 63, wave = tid >> 6;
    LAS float* SC = (LAS float*)lds;
    LAS float* RED = (LAS float*)(lds + 16384);
    for (int i = tid; i < 3 * D; i += NTHR) { const int st = i / D, k = i % D; const float cv = st < 2 ? p.c[st * D + k] : p.c_ctx[k]; SC[i] = cv / (1.f + __expf(-cv)); }
    __syncthreads();
    constexpr int NCG = NMOD / 256;
    for (int item = blockIdx.x; item < DEPTH * NCG * 2; item += gridDim.x) {
        const int l = item / (NCG * 2), rem = item % (NCG * 2), cgp = rem >> 1, kh = rem & 1;
        const int kbase = kh * 512 + wave * 64;
        const float* wp = p.w_mod + ((size_t)l * D + kbase) * NMOD + cgp * 256 + 4 * lane;
        f32x4 acc[3];
#pragma unroll
        for (int st = 0; st < 3; ++st) acc[st] = (f32x4){0.f, 0.f, 0.f, 0.f};
#pragma unroll 16
        for (int kk = 0; kk < 64; ++kk) { const f32x4 w = *(const f32x4*)(wp + (size_t)kk * NMOD);
#pragma unroll
            for (int st = 0; st < 3; ++st) acc[st] = acc[st] + w * SC[st * D + kbase + kk]; }
#pragma unroll
        for (int st = 0; st < 3; ++st) *(LAS f32x4*)(RED + (wave * 3 + st) * 256 + 4 * lane) = acc[st];
        __syncthreads();
        for (int o = tid; o < 3 * 256; o += NTHR) { const int st = o >> 8, n = o & 255; float v = 0.f;
#pragma unroll
            for (int w8 = 0; w8 < 8; ++w8) v += RED[(w8 * 3 + st) * 256 + n];
            if (kh == 0) v += p.b_mod[(size_t)l * NMOD + cgp * 256 + n];
            atomicAdd(p.MOD + ((size_t)l * 3 + st) * NMOD + cgp * 256 + n, v); }
        __syncthreads();
    }
}

constexpr int NPL = 11, NPH = 1 + DEPTH * NPL;
struct Args { Params p; int ph_lo, ph_hi; };
__global__ void __launch_bounds__(NTHR, 2) mega_fwd(Args args) {
    LAS unsigned char* lds = (LAS unsigned char*)lds_raw;
    {
        const int tid0 = threadIdx.x;
        for (int u = tid0; u < (LDS_BYTES - LDSCTL_OFF) / 4; u += NTHR) ((LAS unsigned*)(lds + LDSCTL_OFF))[u] = 0u;
        __syncthreads();
    }
    int wslot = 0;
    { unsigned m_ = ~0u; asm volatile("" : "+s"(m_));
      const int simd = (int)(__builtin_amdgcn_s_getreg((1 << 11) | (4 << 6) | 4) & 3u);
      if (__builtin_amdgcn_mbcnt_hi(m_, __builtin_amdgcn_mbcnt_lo(m_, 0u)) == 0) wslot = simd + 4 * (int)__hip_atomic_fetch_add(((unsigned*)(lds_raw + MISC_OFF + 64)) + simd, 1u, __ATOMIC_RELAXED, __HIP_MEMORY_SCOPE_WORKGROUP); }
    wslot = __builtin_amdgcn_readfirstlane(wslot) & 7;
#define MY_TID(var) int var; { unsigned m_ = ~0u; asm volatile("" : "+s"(m_)); var = wslot * 64 + (int)__builtin_amdgcn_mbcnt_hi(m_, __builtin_amdgcn_mbcnt_lo(m_, 0u)); } asm volatile("" : "+v"(var))
    XcdBarrier bar; bar.bar = args.p.CTL; bar.x = 0;
    const bool multi = args.ph_hi - args.ph_lo > 1;
    if (multi) { MY_TID(t0); bar = xcd_barrier_post(args.p.CTL, t0 == 0); }
    const int G = gridDim.x;
    const int ph_lo = args.ph_lo, ph_hi = args.ph_hi;
#ifndef PHMASK
#define PHMASK 0xFFFF
#endif
#define PH_ON(k) ((k) == 0 ? (PHMASK & 1) : ((PHMASK >> (1 + ((k) - 1) % NPL)) & 1))
#ifndef REPMASK
#define REPMASK 0
#endif
#ifndef REP_LOCAL
#define REP_LOCAL 0
#define REP_CONV 0
#define REP_ATTN 0
#endif
#ifndef HG_STOP
#define HG_STOP 0
#endif
#ifndef REP_P0
#define REP_P0 0
#endif
#define REP_N(k) (((k) == 0 && REP_P0) ? 2 : (((k) > 0 && ((REPMASK >> (((k) - 1) % NPL)) & 1)) ? 2 : 1))
#define PH_BEGIN(k) if (PH_ON(k) && ph_lo <= (k) && (k) < ph_hi) { for (int rep_ = 0; rep_ < REP_N(k); ++rep_) { const AS4 Args* kp = (const AS4 Args*)__builtin_amdgcn_kernarg_segment_ptr(); asm volatile("" : "+s"(kp)); PRef p = kp->p; MY_TID(tid);
#define PH_END_IF(k, cond) } if ((cond) && (k) + 1 < ph_hi) { MY_TID(t1); xcd_barrier(bar, t1 == 0, XB_ST(lds_raw)); } }
#ifndef REP_CVT
#define REP_CVT 0
#endif
#ifndef REP_BAR
#define REP_BAR 0
#endif
#define PH_END(k) } if ((k) + 1 < ph_hi) { for (int rb_ = 0; rb_ < 1 + REP_BAR; ++rb_) { MY_TID(t1); xcd_barrier(bar, t1 == 0, XB_ST(lds_raw)); } } }
    PH_BEGIN(0)
        phase_adaln(tid, p, lds);
        run_items<b_lb>(tid, p, 0, 2L * 384, 0);
        phase_convert(tid, p, 0, lds, 1, 0);
    PH_END(0)
#define LAYER(l)                                                                                                                                     \
    PH_BEGIN(1 + (l) * NPL + 0) if ((l) == 0) { phase_rows<0>(tid, p, 0, lds); } PH_END_IF(1 + (l) * NPL + 0, (l) == 0)                                 \
    PH_BEGIN(1 + (l) * NPL + 1) {                                                                                                                    \
        pg8::Gemm g{p.H, p.WIN_T + WBOFF(l), NTOK, INC, D, nullptr, 0, 1, 0}; pg8::StaticOrder S; S.init(NTOK, INC, G, (int)blockIdx.x);                         \
        pg8::EpiP E{p.P, INC, p.q_norm + (l) * HD, p.k_norm + (l) * HD, rep_};                                                    \
        pg8::gemm_phase<pg8::EpiP, false>(tid, lds, g, S, E);                                                                                     \
        } PH_END(1 + (l) * NPL + 1)               \
    PH_BEGIN(1 + (l) * NPL + 2) if constexpr (!FUSE_QK) { phase_qkprep(tid, p, l); } if constexpr (FAST_HGRN && (HGRN_DIAG == 3 || HGRN_DIAG == 4)) { phase_hgrn_local(tid, p, l, lds); { MY_TID(t7); run_items<b_hgrn_local_slow>(t7, p, l, 2L * NBH * NCH * 64, 0); } } else if constexpr (FAST_HGRN && HGRN_DIAG >= 2) { run_items<b_hgrn_local_slow>(tid, p, l, 2L * NBH * NCH * 64, 0); } else if constexpr (FAST_HGRN) { for (int r2_ = 0; r2_ < 1 + REP_LOCAL; ++r2_) phase_hgrn_local(tid, p, l, lds); } else { run_items<b_gates>(tid, p, l, (long)NTOK * 768, 0); } phase_conv(tid, p, l); PH_END(1 + (l) * NPL + 2) \
    PH_BEGIN(1 + (l) * NPL + 3) if constexpr (FAST_HGRN && HGRN_DIAG) { run_items<b_hgrn_scan_slow>(tid, p, l, 2L * NBH * 4096, 0); } else if constexpr (FAST_HGRN) { phase_hgrn_scan(tid, p); } else { run_items<b_hgrn_seq2>(tid, p, l, 2L * NB * HGH * 64, 0); } if constexpr (FAST_ATTN) { for (int r4_ = 0; r4_ < 1 + REP_ATTN; ++r4_) { MY_TID(t6); phase_attn(t6, p, l, lds); } } else { run_items<b_attn>(tid, p, l, (long)NTOK * NAH, 0); } PH_END(1 + (l) * NPL + 3) \
    PH_BEGIN(1 + (l) * NPL + 4) if constexpr (FAST_HGRN && HGRN_DIAG) { run_items<b_hgrn_chunkseq>(tid, p, l, 2L * NBH * NCH * 64, 0); { MY_TID(t9); xcd_barrier(bar, t9 == 0, XB_ST(lds_raw)); } { MY_TID(t8); run_items<b_hgfin>(t8, p, l, (long)NTOK * HGH, 0); } } else if constexpr (FAST_HGRN) { phase_hgrn_out(tid, p, l, lds); } else { run_items<b_hgfin>(tid, p, l, (long)NTOK * HGH, 0); } PH_END(1 + (l) * NPL + 4)                                         \
    PH_BEGIN(1 + (l) * NPL + 5) {                                                                                                                    \
        pg8::Gemm g{p.MIX, p.WOUT_T + WBOFF(l), NLAT, D, MIXD, nullptr, 0, 1, 0}; pg8::StaticOrder S; S.init(NLAT, D, G, (int)blockIdx.x);                       \
        pg8::EpiRes E{p.XB, D, p.MOD + (size_t)(l) * 3 * NMOD + 2 * D, SEQ, (size_t)NMOD};                                                           \
        pg8::gemm_phase<pg8::EpiRes, false>(tid, lds, g, S, E);                                                                                      \
        if ((l) + 1 < DEPTH) { MY_TID(tid2); mini_gemm<1>(tid2, p, l); } } PH_END(1 + (l) * NPL + 5)                  \
    PH_BEGIN(1 + (l) * NPL + 6) phase_rows<1>(tid, p, l, lds); PH_END(1 + (l) * NPL + 6)                                                               \
    PH_BEGIN(1 + (l) * NPL + 7) if constexpr (FAST_TOPK) { phase_topk(tid, p, lds); if ((l) == 0 && gridDim.x > 2 * NB * NE + 32) { MY_TID(t4); phase_convert(t4, p, 0, lds, 2, 2 * NB * NE); } else if ((l) == 0) { MY_TID(t4); phase_convert(t4, p, 0, lds, 2, 0); } else if ((l) + 1 < DEPTH) { MY_TID(t4); phase_convert(t4, p, (l) + 1, lds, 0, gridDim.x > 2 * NB * NE + 32 ? 2 * NB * NE : 0); } } else { run_items<b_rank>(tid, p, l, (long)NTOK * NE, 0); } PH_END(1 + (l) * NPL + 7)                                          \
    PH_BEGIN(1 + (l) * NPL + 8) {                                                                                                                    \
        pg8::Gemm g{p.H, p.WGU_T + WBOFF(l), NSLOT_L, 2 * ED, D, p.STOK, CAPL / 256, NE, (size_t)2 * ED * D * 2}; pg8::StaticOrder S; S.init(NSLOT_L, 2 * ED, G, (int)blockIdx.x); \
        pg8::EpiHid E{p.HID, ED};                                                                                                                    \
        pg8::gemm_phase<pg8::EpiHid, true>(tid, lds, g, S, E);                                                                                       \
        if ((l) + 1 < DEPTH) { MY_TID(tid2); mini_gemm<2>(tid2, p, l); } } PH_END(1 + (l) * NPL + 8)              \
    PH_BEGIN(1 + (l) * NPL + 9) {                                                                                                                    \
        pg8::Gemm g{p.HID, p.WD_T + WBOFF(l), NSLOT_L, D, ED, nullptr, CAPL / 256, NE, (size_t)D * ED * 2}; pg8::StaticOrder S; S.init(NSLOT_L, D, G, (int)blockIdx.x); \
        pg8::EpiBf16 E{p.Y, D, p.SVAL, 0};                                                                                                              \
        pg8::gemm_phase<pg8::EpiBf16, false>(tid, lds, g, S, E);                                                                                     \
        if ((l) + 1 < DEPTH) { MY_TID(tid2); mini_gemm<3>(tid2, p, l); } } PH_END(1 + (l) * NPL + 9)                \
    PH_BEGIN(1 + (l) * NPL + 10) phase_rows<2>(tid, p, l, lds); if ((l) == 0) { for (int rc_ = 0; rc_ < 1 + REP_CVT; ++rc_) { MY_TID(t5); phase_convert(t5, p, (l) + 1, lds); } }        PH_END(1 + (l) * NPL + 10)
#ifndef NLAYERS_BUILD
#define NLAYERS_BUILD DEPTH
#endif
    LAYER(0)
    if constexpr (NLAYERS_BUILD > 1) { LAYER(1) }
    if constexpr (NLAYERS_BUILD > 2) { LAYER(2) }
    if constexpr (NLAYERS_BUILD > 3) { LAYER(3) }
}

#ifndef MK_SPLIT
#define MK_SPLIT 0
#endif
extern "C" void kernel_launch(void* const* d_in, const int* in_sizes, int n_in, void* d_out, int out_size, void* d_ws, size_t ws_size,
                              hipStream_t stream) {
    static int grid = 0;
    if (grid == 0) {
        if (n_in != 20 || out_size != NLAT * D || ws_size < WS_END) { fprintf(stderr, "kernel_launch: unexpected problem (n_in %d out %d ws %zu need %zu)\n", n_in, out_size, ws_size, (size_t)WS_END); grid = -1; return; }
        int dev = 0, cus = 0;
        if (hipGetDevice(&dev) != hipSuccess || hipDeviceGetAttribute(&cus, hipDeviceAttributeMultiprocessorCount, dev) != hipSuccess) { grid = -1; return; }
        if (hipFuncSetAttribute((const void*)mega_fwd, hipFuncAttributeMaxDynamicSharedMemorySize, LDS_BYTES) != hipSuccess) { fprintf(stderr, "kernel_launch: hipFuncSetAttribute failed\n"); grid = -1; return; }
        int per_cu = 0;
        if (hipOccupancyMaxActiveBlocksPerMultiprocessor(&per_cu, (const void*)mega_fwd, NTHR, LDS_BYTES) != hipSuccess || per_cu < 1) { fprintf(stderr, "kernel_launch: occupancy query says %d\n", per_cu); }
        (void)hipGetLastError();
        grid = cus;
    }
    if (grid < 0) return;
    (void)hipMemsetAsync((char*)d_ws + WS_CTL, 0, WS_LB - WS_CTL, stream);
    Args a{};
    a.p = make_params(d_in, d_out, d_ws);
#if MK_SPLIT
    for (int ph = 0; ph < NPH; ++ph) { a.ph_lo = ph; a.ph_hi = ph + 1; hipLaunchKernelGGL(mega_fwd, dim3(grid), dim3(NTHR), LDS_BYTES, stream, a); }
#else
    a.ph_lo = 0; a.ph_hi = NPH;
    hipLaunchKernelGGL(mega_fwd, dim3(grid), dim3(NTHR), LDS_BYTES, stream, a);
#endif
}
#endif
```

```cpp
#ifndef CPU_SIM
#include <hip/hip_runtime.h>
#define BODY __device__ __forceinline__
#define FSIN(x) __sinf(x)
#define FCOS(x) __cosf(x)
#else
#include <cmath>
#include <cstdio>
#include <cstdlib>
#include <cstring>
#define BODY static inline
#define FSIN(x) sinf(x)
#define FCOS(x) cosf(x)
#endif
#include <stdint.h>
#include <stddef.h>

#ifndef CFG_D
#define CFG_D 1024
#define CFG_SEQ 16384
#define CFG_CTX 256
#define CFG_EDIM 512
#define CFG_DEPTH 4
#endif

typedef unsigned short bf16_t;

constexpr int D = CFG_D, NB = 2, SEQ = CFG_SEQ, DEPTH = CFG_DEPTH, GW = 64, ROWS = SEQ / GW, CTX = CFG_CTX;
constexpr int HD = 64, NAH = 6, HGH = 6, CVD = 256, MIXD = 1024, INC = 3840, NMOD = 6 * D;
constexpr int NE = 16, ED = CFG_EDIM, CAPL = 2 * SEQ / NE, CAPC = 2 * CTX / NE;
constexpr int NLAT = NB * SEQ, NCTX = NB * CTX, NTOK = NLAT + NCTX;
constexpr int NSLOT_L = NB * NE * CAPL, NSLOT_C = NB * NE * CAPC, NSLOT = NSLOT_L + NSLOT_C;
constexpr int OQ = 0, OK_ = 384, OV = 768, OHQ = 1152, OFF_ = 1536, OFB = 1920, OHI = 2304, OHG_ = 2688, OCB = 3072, OCC = 3328, OCU = 3584;
constexpr float EPS = 1e-6f;
constexpr int NCH = (CTX + SEQ) / 64, NCHC = CTX / 64, NBH = NB * HGH;

struct Params {
    const float *x, *c, *ctx, *c_ctx, *w_mod, *b_mod, *norm1_w, *w_in, *q_norm, *k_norm, *rpb, *lb_logits, *hg_norm, *conv_w, *w_out,
        *norm2_w, *w_router, *w_gate, *w_up, *w_down;
    float *XL, *XC, *MOD, *LB, *AFF, *SVAL, *FG, *OHG;
    bf16_t *H, *P, *MIX, *HID, *Y;
    int *STOK, *INV;
    bf16_t *WIN_T, *WOUT_T, *WGU_T, *WD_T;
    unsigned* CTL;
    bf16_t* SLOC;
    float* GDEC;
    bf16_t* XB;
};

#ifndef CPU_SIM
#define AS4 __attribute__((address_space(4)))
typedef const AS4 Params& PRef;
#else
typedef const Params& PRef;
#endif
BODY float bf2f(bf16_t v) { return __builtin_bit_cast(float, (unsigned)v << 16); }
BODY bf16_t f2bf(float f) { unsigned u = __builtin_bit_cast(unsigned, f); u += 0x7fffu + ((u >> 16) & 1u); return (bf16_t)(u >> 16); }
BODY float silu_f(float x) { return x / (1.f + expf(-x)); }
BODY float sigmoid_f(float x) { return 1.f / (1.f + expf(-x)); }
BODY int modset(int r) { return r < NLAT ? r / SEQ : 2; }
BODY float* xrow(PRef p, int r) { return r < NLAT ? p.XL + (size_t)r * D : p.XC + (size_t)(r - NLAT) * D; }

BODY void b_adaln(long gid, PRef p, int) {
    const int n = (int)(gid % NMOD), s = (int)((gid / NMOD) % 3), l = (int)(gid / (3 * NMOD));
    const float* cv = s < 2 ? p.c + s * D : p.c_ctx;
    const float* w = p.w_mod + (size_t)l * D * NMOD + n;
    float acc = 0.f;
    for (int k = 0; k < D; ++k) acc += silu_f(cv[k]) * w[(size_t)k * NMOD];
    p.MOD[gid] = acc + p.b_mod[l * NMOD + n];
}
BODY void b_lb(long gid, PRef p, int) {
    const int dir = (int)(gid / 384), j = (int)(gid % 384);
    const float* lg = p.lb_logits + (size_t)dir * DEPTH * 384 + j;
    float m = -INFINITY;
    for (int l = 0; l < DEPTH; ++l) m = fmaxf(m, lg[l * 384]);
    float s = 0.f;
    for (int l = 0; l < DEPTH; ++l) s += expf(lg[l * 384] - m);
    float cum = 0.f;
    p.LB[(dir * DEPTH + 0) * 384 + j] = 0.f;
    for (int l = 1; l < DEPTH; ++l) { cum += expf(lg[l * 384] - m) / s; p.LB[(dir * DEPTH + l) * 384 + j] = cum; }
}
BODY void b_copyx(long gid, PRef p, int) {
    if (gid < (long)NLAT * D) p.XL[gid] = p.x[gid]; else p.XC[gid - (long)NLAT * D] = p.ctx[gid - (long)NLAT * D];
}
template <int WHICH> BODY void b_prenorm(long gid, PRef p, int l) {
    const int r = (int)gid;
    const float* xr = xrow(p, r);
    const float* nw = (WHICH ? p.norm2_w : p.norm1_w) + l * D;
    const float* mod = p.MOD + ((size_t)l * 3 + modset(r)) * NMOD;
    const float* shift = mod + (WHICH ? 3 : 0) * D;
    const float* scale = mod + (WHICH ? 4 : 1) * D;
    float ss = 0.f;
    for (int k = 0; k < D; ++k) ss += xr[k] * xr[k];
    const float rstd = 1.f / sqrtf(ss / D + EPS);
    float lg[NE];
#pragma unroll
    for (int e = 0; e < NE; ++e) lg[e] = 0.f;
    for (int k = 0; k < D; ++k) {
        const float h = xr[k] * rstd * nw[k] * (1.f + scale[k]) + shift[k];
        p.H[(size_t)r * D + k] = f2bf(h);
        if (WHICH) {
            const float* wr = p.w_router + ((size_t)l * D + k) * NE;
#pragma unroll
            for (int e = 0; e < NE; ++e) lg[e] += h * wr[e];
        }
    }
    if (WHICH) {
        float m = lg[0];
#pragma unroll
        for (int e = 1; e < NE; ++e) m = fmaxf(m, lg[e]);
        float s = 0.f;
#pragma unroll
        for (int e = 0; e < NE; ++e) { lg[e] = expf(lg[e] - m); s += lg[e]; }
#pragma unroll
        for (int e = 0; e < NE; ++e) p.AFF[(size_t)r * NE + e] = lg[e] / s;
    }
}
BODY void b_gemm_in(long gid, PRef p, int l) {
    const int r = (int)(gid / (INC / 4)), n = (int)(gid % (INC / 4)) * 4;
    const bf16_t* a = p.H + (size_t)r * D;
    const float* w = p.w_in + (size_t)l * D * INC + n;
    float a0 = 0.f, a1 = 0.f, a2 = 0.f, a3 = 0.f;
    for (int k = 0; k < D; ++k) { const float av = bf2f(a[k]); const float* wk = w + (size_t)k * INC; a0 += av * wk[0]; a1 += av * wk[1]; a2 += av * wk[2]; a3 += av * wk[3]; }
    bf16_t* o = p.P + (size_t)r * INC + n;
    o[0] = f2bf(a0); o[1] = f2bf(a1); o[2] = f2bf(a2); o[3] = f2bf(a3);
}
BODY void b_qkprep(long gid, PRef p, int l) {
    const int r = (int)(gid / 12), which = (int)(gid % 12) / 6, head = (int)(gid % 6);
    bf16_t* ptr = p.P + (size_t)r * INC + (which ? OK_ : OQ) + head * HD;
    const float* nw = (which ? p.k_norm : p.q_norm) + l * HD;
    float y[HD];
    float ss = 0.f;
#pragma unroll
    for (int d = 0; d < HD; ++d) { y[d] = bf2f(ptr[d]); ss += y[d] * y[d]; }
    const float rstd = 1.f / sqrtf(ss / HD + EPS);
#pragma unroll
    for (int d = 0; d < HD; ++d) y[d] = y[d] * rstd * nw[d];
    if (r < NLAT) {
        const int t = r % SEQ; const float row = (float)(t / GW), col = (float)(t % GW);
#pragma unroll
        for (int d = 0; d < 16; ++d) {
            const float inv = powf(10000.f, -(float)d / 16.f);
            const float ar = row * inv, ac = col * inv;
            const float cr = FCOS(ar), sr = FSIN(ar), cc = FCOS(ac), sc = FSIN(ac);
            const float x0 = y[d], x1 = y[d + 16], x2 = y[d + 32], x3 = y[d + 48];
            y[d] = x0 * cr - x1 * sr; y[d + 16] = x1 * cr + x0 * sr; y[d + 32] = x2 * cc - x3 * sc; y[d + 48] = x3 * cc + x2 * sc;
        }
    }
#pragma unroll
    for (int d = 0; d < HD; ++d) ptr[d] = f2bf(y[d]);
}
BODY void b_attn(long gid, PRef p, int l) {
    const int r = (int)(gid / NAH), head = (int)(gid % NAH);
    float q[HD], acc[HD];
    const bf16_t* qp = p.P + (size_t)r * INC + OQ + head * HD;
#pragma unroll
    for (int d = 0; d < HD; ++d) { q[d] = bf2f(qp[d]) * 0.125f; acc[d] = 0.f; }
    float m = -INFINITY, s = 0.f;
    const int b = r < NLAT ? r / SEQ : (r - NLAT) / CTX;
    const int nloc = r < NLAT ? 128 : 0;
    int row = 0, col = 0, rs = 0, ws = 0;
    if (r < NLAT) { const int t = r % SEQ; row = t / GW; col = t % GW; rs = row - 4; rs = rs < 0 ? 0 : (rs > ROWS - 8 ? ROWS - 8 : rs); ws = col - 8; ws = ws < 0 ? 0 : (ws > GW - 16 ? GW - 16 : ws); }
    for (int j = 0; j < nloc + CTX; ++j) {
        int kr; float bias = 0.f;
        if (j < nloc) { const int i = j / 16, jj = j % 16; kr = b * SEQ + (rs + i) * GW + ws + jj; bias = p.rpb[(((size_t)l * NAH + head) * 15 + (rs + i - row + 7)) * 31 + (ws + jj - col + 15)]; }
        else kr = NLAT + b * CTX + (j - nloc);
        const bf16_t* kp = p.P + (size_t)kr * INC + OK_ + head * HD;
        const bf16_t* vp = p.P + (size_t)kr * INC + OV + head * HD;
        float sc = 0.f;
#pragma unroll
        for (int d = 0; d < HD; ++d) sc += q[d] * bf2f(kp[d]);
        sc += bias;
        const float mn = fmaxf(m, sc), corr = expf(m - mn), pj = expf(sc - mn);
        s = s * corr + pj;
#pragma unroll
        for (int d = 0; d < HD; ++d) acc[d] = acc[d] * corr + pj * bf2f(vp[d]);
        m = mn;
    }
    const float inv = 1.f / s;
    bf16_t* o = p.MIX + (size_t)r * MIXD + head * HD;
#pragma unroll
    for (int d = 0; d < HD; ++d) o[d] = f2bf(acc[d] * inv);
}
BODY void b_gates(long gid, PRef p, int l) {
    const int j = (int)(gid % 384), dir = (int)((gid / 384) % 2), r = (int)(gid / 768);
    const float z = bf2f(p.P[(size_t)r * INC + (dir ? OFB : OFF_) + j]);
    const float lbv = p.LB[(dir * DEPTH + l) * 384 + j];
    p.FG[gid] = lbv + (1.f - lbv) * sigmoid_f(z);
}
template <int DIR> BODY void b_hgrn_seq(long gid, PRef p, int) {
    const int v = (int)(gid % 64), h = (int)((gid / 64) % HGH), b = (int)(gid / (64 * HGH));
    float S[64];
#pragma unroll
    for (int k = 0; k < 64; ++k) S[k] = 0.f;
    for (int step = 0; step < CTX + SEQ; ++step) {
        int r;
        if (step < CTX) r = NLAT + b * CTX + (DIR ? CTX - 1 - step : step);
        else r = b * SEQ + (DIR ? SEQ - 1 - (step - CTX) : (step - CTX));
        const float vv = bf2f(p.P[(size_t)r * INC + OHI + h * 64 + v]);
        const float* fr = p.FG + ((size_t)r * 2 + DIR) * 384 + h * 64;
        const bf16_t* qr = p.P + (size_t)r * INC + OHQ + h * 64;
        float o = 0.f;
#pragma unroll
        for (int k = 0; k < 64; ++k) { const float f = fr[k]; S[k] = f * S[k] + (1.f - f) * vv; o += S[k] * bf2f(qr[k]); }
        o *= 0.125f;
        p.OHG[((size_t)DIR * NTOK + r) * 384 + h * 64 + v] = o;
    }
}
BODY void b_hgfin(long gid, PRef p, int l) {
    const int r = (int)(gid / HGH), h = (int)(gid % HGH);
    const float* op = p.OHG + (size_t)r * 384 + h * 64;
    const float* op1 = op + (size_t)NTOK * 384;
    float o[64]; float ss = 0.f;
#pragma unroll
    for (int v = 0; v < 64; ++v) { o[v] = op[v] + op1[v]; ss += o[v] * o[v]; }
    const float rstd = 1.f / sqrtf(ss / 64.f + EPS);
    const bf16_t* g = p.P + (size_t)r * INC + OHG_ + h * 64;
    bf16_t* out = p.MIX + (size_t)r * MIXD + 384 + h * 64;
#pragma unroll
    for (int v = 0; v < 64; ++v) out[v] = f2bf(o[v] * rstd * p.hg_norm[l * 64 + v] * silu_f(bf2f(g[v])));
}
BODY void b_conv(long gid, PRef p, int l) {
    const int ch = (int)(gid % CVD), r = (int)(gid / CVD);
    int t, T;
    if (r < NLAT) { t = r % SEQ; T = SEQ; } else { t = (r - NLAT) % CTX; T = CTX; }
    const float* w = p.conv_w + (size_t)l * 3 * CVD + ch;
    float y = 0.f;
    for (int j = 0; j < 3; ++j) {
        const int tt = t + j - 1;
        if (tt < 0 || tt >= T) continue;
        const bf16_t* pr = p.P + (size_t)(r + j - 1) * INC;
        y += w[j * CVD] * bf2f(pr[OCC + ch]) * bf2f(pr[OCU + ch]);
    }
    p.MIX[(size_t)r * MIXD + 768 + ch] = f2bf(bf2f(p.P[(size_t)r * INC + OCB + ch]) * y);
}
BODY void b_gemm_out(long gid, PRef p, int l) {
    const int r = (int)(gid / (D / 4)), n = (int)(gid % (D / 4)) * 4;
    const bf16_t* a = p.MIX + (size_t)r * MIXD;
    const float* w = p.w_out + (size_t)l * MIXD * D + n;
    float a0 = 0.f, a1 = 0.f, a2 = 0.f, a3 = 0.f;
    for (int k = 0; k < MIXD; ++k) { const float av = bf2f(a[k]); const float* wk = w + (size_t)k * D; a0 += av * wk[0]; a1 += av * wk[1]; a2 += av * wk[2]; a3 += av * wk[3]; }
    const float* g = p.MOD + ((size_t)l * 3 + modset(r)) * NMOD + 2 * D + n;
    float* xr = xrow(p, r) + n;
    xr[0] += g[0] * a0; xr[1] += g[1] * a1; xr[2] += g[2] * a2; xr[3] += g[3] * a3;
}
BODY void b_rank(long gid, PRef p, int) {
    const int e = (int)(gid % NE), r = (int)(gid / NE);
    int t, T, row0, cap, base;
    if (r < NLAT) { const int b = r / SEQ; t = r % SEQ; T = SEQ; row0 = b * SEQ; cap = CAPL; base = (b * NE + e) * CAPL; }
    else { const int b = (r - NLAT) / CTX; t = (r - NLAT) % CTX; T = CTX; row0 = NLAT + b * CTX; cap = CAPC; base = NSLOT_L + (b * NE + e) * CAPC; }
    const float a = p.AFF[(size_t)r * NE + e];
    const float* col = p.AFF + (size_t)row0 * NE + e;
    int rank = 0;
    for (int tt = 0; tt < T; ++tt) { const float o = col[(size_t)tt * NE]; rank += (o > a || (o == a && tt < t)) ? 1 : 0; }
    if (rank < cap) { p.STOK[base + rank] = r; p.SVAL[base + rank] = a; p.INV[(size_t)r * NE + e] = base + rank; }
    else p.INV[(size_t)r * NE + e] = -1;
}
BODY int slot_expert(int s) { return s < NSLOT_L ? (s / CAPL) % NE : ((s - NSLOT_L) / CAPC) % NE; }
BODY void b_moe1(long gid, PRef p, int l) {
    const int s = (int)(gid / (ED / 4)), f = (int)(gid % (ED / 4)) * 4;
    const int e = slot_expert(s); int row = p.STOK[s]; row = row < 0 ? 0 : (row >= NTOK ? NTOK - 1 : row);
    const bf16_t* a = p.H + (size_t)row * D;
    const float* wg = p.w_gate + ((size_t)l * NE + e) * D * ED + f;
    const float* wu = p.w_up + ((size_t)l * NE + e) * D * ED + f;
    float g0 = 0.f, g1 = 0.f, g2 = 0.f, g3 = 0.f, u0 = 0.f, u1 = 0.f, u2 = 0.f, u3 = 0.f;
    for (int k = 0; k < D; ++k) {
        const float av = bf2f(a[k]); const float* gk = wg + (size_t)k * ED; const float* uk = wu + (size_t)k * ED;
        g0 += av * gk[0]; g1 += av * gk[1]; g2 += av * gk[2]; g3 += av * gk[3];
        u0 += av * uk[0]; u1 += av * uk[1]; u2 += av * uk[2]; u3 += av * uk[3];
    }
    bf16_t* o = p.HID + (size_t)s * ED + f;
    o[0] = f2bf(silu_f(g0) * u0); o[1] = f2bf(silu_f(g1) * u1); o[2] = f2bf(silu_f(g2) * u2); o[3] = f2bf(silu_f(g3) * u3);
}
BODY void b_moe2(long gid, PRef p, int l) {
    const int s = (int)(gid / (D / 4)), n = (int)(gid % (D / 4)) * 4;
    const int e = slot_expert(s);
    const bf16_t* a = p.HID + (size_t)s * ED;
    const float* w = p.w_down + ((size_t)l * NE + e) * ED * D + n;
    float a0 = 0.f, a1 = 0.f, a2 = 0.f, a3 = 0.f;
    for (int k = 0; k < ED; ++k) { const float av = bf2f(a[k]); const float* wk = w + (size_t)k * D; a0 += av * wk[0]; a1 += av * wk[1]; a2 += av * wk[2]; a3 += av * wk[3]; }
    const float val = p.SVAL[s];
    bf16_t* o = p.Y + (size_t)s * D + n;
    o[0] = f2bf(val * a0); o[1] = f2bf(val * a1); o[2] = f2bf(val * a2); o[3] = f2bf(val * a3);
}
BODY void b_combine(long gid, PRef p, int l) {
    const int r = (int)(gid / (D / 4)), n = (int)(gid % (D / 4)) * 4;
    float a0 = 0.f, a1 = 0.f, a2 = 0.f, a3 = 0.f;
    for (int e = 0; e < NE; ++e) {
        const int s = p.INV[(size_t)r * NE + e];
        if (s >= 0) { const bf16_t* y = p.Y + (size_t)s * D + n; a0 += bf2f(y[0]); a1 += bf2f(y[1]); a2 += bf2f(y[2]); a3 += bf2f(y[3]); }
    }
    const float* g = p.MOD + ((size_t)l * 3 + modset(r)) * NMOD + 5 * D + n;
    float* xr = xrow(p, r) + n;
    xr[0] += g[0] * a0; xr[1] += g[1] * a1; xr[2] += g[2] * a2; xr[3] += g[3] * a3;
}


#ifndef HGRN_DIAG
#define HGRN_DIAG 0
#endif
BODY void b_hgrn_chunkseq(long gid, PRef p, int l) {
    const int v = (int)(gid % 64), pc = (int)((gid / 64) % NCH), bh = (int)((gid / (64 * NCH)) % NBH), dir = (int)(gid / (64L * NCH * NBH));
    const int h = bh % HGH, b = bh / HGH, row0 = pc < NCHC ? NLAT + b * CTX + pc * 64 : b * SEQ + (pc - NCHC) * 64;
    const bf16_t* sin = p.SLOC + ((size_t)(dir * NBH + bh) * NCH + pc) * 4096 + v * 64;
    float S[64];
#pragma unroll
    for (int k = 0; k < 64; ++k) S[k] = bf2f(sin[k]);
    for (int i = 0; i < 64; ++i) {
        const int r = row0 + (dir ? 63 - i : i);
        const float vv = bf2f(p.P[(size_t)r * INC + OHI + h * 64 + v]);
        const bf16_t* zr = p.P + (size_t)r * INC + (dir ? OFB : OFF_) + h * 64;
        const bf16_t* qr = p.P + (size_t)r * INC + OHQ + h * 64;
        const float* lb = p.LB + (size_t)(dir * DEPTH + l) * 384 + h * 64;
        float o = 0.f;
#pragma unroll
        for (int k = 0; k < 64; ++k) { const float f = lb[k] + (1.f - lb[k]) * sigmoid_f(bf2f(zr[k])); S[k] = f * S[k] + (1.f - f) * vv; o += S[k] * bf2f(qr[k]); }
        p.OHG[((size_t)dir * NTOK + r) * 384 + h * 64 + v] = o * 0.125f;
    }
}

BODY void b_hgrn_scan_slow(long gid, PRef p, int) {
    const int e = (int)(gid % 4096), sq = (int)(gid / 4096), dir = sq / NBH, k = e & 63;
    bf16_t* S = p.SLOC + (size_t)sq * NCH * 4096 + e;
    const float* G = p.GDEC + (size_t)sq * NCH * 64 + k;
    float c = 0.f;
    for (int j = 0; j < NCH; ++j) {
        const int pc = dir ? (j < NCHC ? NCHC - 1 - j : NCH + NCHC - 1 - j) : j;
        const float x = bf2f(S[(size_t)pc * 4096]);
        S[(size_t)pc * 4096] = f2bf(c);
        c = G[(size_t)pc * 64] * c + x;
    }
}

BODY void b_hgrn_local_slow(long gid, PRef p, int l) {
    const int v = (int)(gid % 64), pc = (int)((gid / 64) % NCH), bh = (int)((gid / (64 * NCH)) % NBH), dir = (int)(gid / (64L * NCH * NBH));
    const int h = bh % HGH, b = bh / HGH, row0 = pc < NCHC ? NLAT + b * CTX + pc * 64 : b * SEQ + (pc - NCHC) * 64;
    float S[64], g[64];
#pragma unroll
    for (int k = 0; k < 64; ++k) { S[k] = 0.f; g[k] = 1.f; }
    for (int i = 0; i < 64; ++i) {
        const int r = row0 + (dir ? 63 - i : i);
        const float vv = bf2f(p.P[(size_t)r * INC + OHI + h * 64 + v]);
        const bf16_t* zr = p.P + (size_t)r * INC + (dir ? OFB : OFF_) + h * 64;
        const float* lb = p.LB + (size_t)(dir * DEPTH + l) * 384 + h * 64;
#pragma unroll
        for (int k = 0; k < 64; ++k) { const float f = lb[k] + (1.f - lb[k]) * sigmoid_f(bf2f(zr[k])); S[k] = f * S[k] + (1.f - f) * vv; g[k] *= f; }
    }
    bf16_t* dst = p.SLOC + ((size_t)(dir * NBH + bh) * NCH + pc) * 4096 + v * 64;
    if (HGRN_DIAG != 3 && HGRN_DIAG != 4) {
#pragma unroll
    for (int k = 0; k < 64; ++k) dst[k] = f2bf(S[k]);
    }
    if (v == 0) {
        float* gd = p.GDEC + ((size_t)(dir * NBH + bh) * NCH + pc) * 64;
#pragma unroll
        for (int k = 0; k < 64; ++k) gd[k] = g[k];
    }
}
#ifndef FAST_TOPK
#define FAST_TOPK 1
#endif
#ifndef FAST_HGRN
#define FAST_HGRN 1
#endif
#ifndef FAST_ATTN
#define FAST_ATTN 1
#endif
constexpr size_t al256(size_t x) { return (x + 255) & ~(size_t)255; }
constexpr size_t CTL_BYTES = 65536;
constexpr size_t WS_CTL = 0;
constexpr size_t WS_MOD = WS_CTL + CTL_BYTES;
constexpr size_t WS_LB = WS_MOD + al256((size_t)DEPTH * 3 * NMOD * 4);
constexpr size_t WS_XC = WS_LB + al256((size_t)2 * DEPTH * 384 * 4);
constexpr size_t WS_AFF = WS_XC + al256((size_t)NCTX * D * 4);
constexpr size_t WS_SVAL = WS_AFF + al256((size_t)NTOK * NE * 4);
constexpr size_t WS_STOK = WS_SVAL + al256((size_t)NSLOT * 4);
constexpr size_t WS_INV = WS_STOK + al256((size_t)NSLOT * 4);
constexpr size_t WS_H = WS_INV + al256((size_t)NTOK * NE * 4);
constexpr size_t WS_MIX = WS_H + al256((size_t)NTOK * D * 2);
constexpr size_t WS_P = WS_MIX + al256((size_t)NTOK * MIXD * 2);
constexpr size_t WS_HID = WS_P;
constexpr size_t WS_Y = WS_HID + al256((size_t)NSLOT * ED * 2);
constexpr size_t WS_P_END0 = WS_P + al256((size_t)NTOK * INC * 2);
constexpr size_t WS_P_END1 = WS_Y + al256((size_t)NSLOT * D * 2);
constexpr size_t WS_WB = WS_P_END0 > WS_P_END1 ? WS_P_END0 : WS_P_END1;
constexpr size_t WS_WIN_T = WS_WB;
constexpr size_t WS_WOUT_T = WS_WIN_T + al256((size_t)INC * D * 2);
constexpr size_t WS_WGU_T = WS_WOUT_T + al256((size_t)D * MIXD * 2);
constexpr size_t WS_WD_T = WS_WGU_T + al256((size_t)NE * 2 * ED * D * 2);
constexpr size_t WB_BYTES = WS_WD_T + al256((size_t)NE * D * ED * 2) - WS_WB;
constexpr size_t WS_T = WS_WB + 2 * WB_BYTES;
#if FAST_HGRN
constexpr size_t WS_SLOC = WS_T;
constexpr size_t WS_GDEC = WS_SLOC + al256((size_t)2 * NBH * NCH * 4096 * 2);
constexpr size_t WS_OHG = WS_GDEC + al256((size_t)2 * NBH * NCH * 64 * 4);
constexpr size_t WS_XB = WS_OHG + (HGRN_DIAG ? al256((size_t)2 * NTOK * 384 * 4) : 0);
constexpr size_t WS_END = WS_XB + al256((size_t)NLAT * D * 2);
constexpr size_t WS_FG = WS_T;
#else
constexpr size_t WS_FG = WS_T;
constexpr size_t WS_OHG = WS_FG + al256((size_t)NTOK * 768 * 4);
constexpr size_t WS_SLOC = WS_OHG + al256((size_t)2 * NTOK * 384 * 4);
constexpr size_t WS_GDEC = WS_SLOC;
constexpr size_t WS_XB = WS_SLOC;
constexpr size_t WS_END = WS_XB + al256((size_t)NLAT * D * 2);
#endif

static inline Params make_params(void* const* d_in, void* d_out, void* d_ws) {
    Params p{};
    const float** f = (const float**)&p;
    for (int i = 0; i < 20; ++i) f[i] = (const float*)d_in[i];
    char* ws = (char*)d_ws;
    p.XL = (float*)d_out; p.XC = (float*)(ws + WS_XC); p.MOD = (float*)(ws + WS_MOD); p.LB = (float*)(ws + WS_LB); p.AFF = (float*)(ws + WS_AFF);
    p.SVAL = (float*)(ws + WS_SVAL); p.FG = (float*)(ws + WS_FG); p.OHG = (float*)(ws + WS_OHG);
    p.H = (bf16_t*)(ws + WS_H); p.P = (bf16_t*)(ws + WS_P); p.MIX = (bf16_t*)(ws + WS_MIX); p.HID = (bf16_t*)(ws + WS_HID); p.Y = (bf16_t*)(ws + WS_Y);
    p.STOK = (int*)(ws + WS_STOK); p.INV = (int*)(ws + WS_INV);
    p.WIN_T = (bf16_t*)(ws + WS_WIN_T); p.WOUT_T = (bf16_t*)(ws + WS_WOUT_T); p.WGU_T = (bf16_t*)(ws + WS_WGU_T); p.WD_T = (bf16_t*)(ws + WS_WD_T);
    p.CTL = (unsigned*)(ws + WS_CTL); p.SLOC = (bf16_t*)(ws + WS_SLOC); p.GDEC = (float*)(ws + WS_GDEC); p.XB = (bf16_t*)(ws + WS_XB);
    return p;
}

#define FORWARD_STAGES(STAGE)                                                      \
    STAGE(b_adaln, (long)DEPTH * 3 * NMOD, 0)                                      \
    STAGE(b_lb, 2L * 384, 0)                                                       \
    STAGE(b_copyx, (long)NTOK * D, 0)                                              \
    for (int l = 0; l < DEPTH; ++l) {                                              \
        STAGE(b_prenorm<0>, (long)NTOK, l)                                         \
        STAGE(b_gemm_in, (long)NTOK * (INC / 4), l)                                \
        STAGE(b_qkprep, (long)NTOK * 12, l)                                        \
        STAGE(b_attn, (long)NTOK * NAH, l)                                         \
        STAGE(b_gates, (long)NTOK * 768, l)                                        \
        STAGE(b_hgrn_seq<0>, (long)NB * HGH * 64, l)                               \
        STAGE(b_hgrn_seq<1>, (long)NB * HGH * 64, l)                               \
        STAGE(b_hgfin, (long)NTOK * HGH, l)                                        \
        STAGE(b_conv, (long)NTOK * CVD, l)                                         \
        STAGE(b_gemm_out, (long)NTOK * (D / 4), l)                                 \
        STAGE(b_prenorm<1>, (long)NTOK, l)                                         \
        STAGE(b_rank, (long)NTOK * NE, l)                                          \
        STAGE(b_moe1, (long)NSLOT * (ED / 4), l)                                   \
        STAGE(b_moe2, (long)NSLOT * (D / 4), l)                                    \
        STAGE(b_combine, (long)NTOK * (D / 4), l)                                  \
    }

#ifndef CPU_SIM
#include <cstdio>
#define LAS __attribute__((address_space(3)))
#define GAS __attribute__((address_space(1)))
typedef short bf16x8 __attribute__((ext_vector_type(8)));
typedef float f32x4 __attribute__((ext_vector_type(4)));
typedef float f32x2 __attribute__((ext_vector_type(2)));
typedef unsigned u32x4 __attribute__((ext_vector_type(4)));
typedef unsigned u32x2 __attribute__((ext_vector_type(2)));
constexpr int NWAVES = 8, NTHR = 512;
constexpr int RING_BYTES = 131072, LDSCTL_OFF = RING_BYTES, MISC_OFF = LDSCTL_OFF + 320, TAB_OFF = LDSCTL_OFF + 1024  , LDS_BYTES = 147456;

typedef __bf16 bf16v2_t __attribute__((ext_vector_type(2)));
__device__ __forceinline__ unsigned cvt_pk_bf16_asm(float lo, float hi) { unsigned r; asm volatile("v_cvt_pk_bf16_f32 %0, %1, %2" : "=v"(r) : "v"(lo), "v"(hi)); return r; }
__device__ __forceinline__ unsigned cvt_pk_bf16(float lo, float hi) { bf16v2_t v = {(__bf16)lo, (__bf16)hi}; return __builtin_bit_cast(unsigned, v); }
#define DPPF(x, ctrl) __builtin_bit_cast(float, __builtin_amdgcn_update_dpp(0, __builtin_bit_cast(int, (x)), (ctrl), 0xF, 0xF, true))
#define DPP_X1 0xB1
#define DPP_X2 0x4E
#define DPP_HM 0x141
#define DPP_RM 0x140
__device__ __forceinline__ float x16_other(float x, int lane) { const unsigned u = __builtin_bit_cast(unsigned, x); const auto r = __builtin_amdgcn_permlane16_swap(u, u, false, false); return __builtin_bit_cast(float, (lane & 16) ? r[0] : r[1]); }
__device__ __forceinline__ float x32_other(float x, int lane) { const unsigned u = __builtin_bit_cast(unsigned, x); const auto r = __builtin_amdgcn_permlane32_swap(u, u, false, false); return __builtin_bit_cast(float, (lane & 32) ? r[0] : r[1]); }
__device__ __forceinline__ float x16_sum(float x, int lane) { return x + x16_other(x, lane); }
__device__ __forceinline__ float x32_sum(float x, int lane) { return x + x32_other(x, lane); }
__device__ __forceinline__ float x16_max(float x, int lane) { return fmaxf(x, x16_other(x, lane)); }
__device__ __forceinline__ float x32_max(float x, int lane) { return fmaxf(x, x32_other(x, lane)); }
__device__ __forceinline__ float row16_sum(float v) { v += DPPF(v, DPP_X1); v += DPPF(v, DPP_X2); v += DPPF(v, DPP_HM); v += DPPF(v, DPP_RM); return v; }
__device__ __forceinline__ float row16_max(float v) { v = fmaxf(v, DPPF(v, DPP_X1)); v = fmaxf(v, DPPF(v, DPP_X2)); v = fmaxf(v, DPPF(v, DPP_HM)); v = fmaxf(v, DPPF(v, DPP_RM)); return v; }
__device__ __forceinline__ float oct_sum(float v) { v += DPPF(v, DPP_X1); v += DPPF(v, DPP_X2); v += DPPF(v, DPP_HM); return v; }
__device__ __forceinline__ float wave_sum(float v, int lane) { return x32_sum(x16_sum(row16_sum(v), lane), lane); }

extern __shared__ __attribute__((aligned(16))) unsigned char lds_raw[];
#ifndef FUSE_QK
#define FUSE_QK 1
#endif
__device__ __forceinline__ float bfw(unsigned w, int hi) { return __builtin_bit_cast(float, hi ? (w & 0xffff0000u) : (w << 16)); }
__device__ __forceinline__ float bf8(const u32x4& v, int j) { return bfw(v[j >> 1], j & 1); }
namespace pg8 {
constexpr int BM = 256, BK = 64, HALF = 128, HTB = HALF * BK * 2, STAGE_BYTES = 8 * HTB, NXCD = 8, WGM = 8;
__device__ __forceinline__ int lds_byte(int r, int c) { const int st = (r >> 4) * 2 + (c >> 5), rr = r & 15, cc = c & 31, ob = rr * 64 + cc * 2; return st * 1024 + (ob ^ (((ob >> 9) & 1) << 5)); }
__device__ __forceinline__ void stage_rc(int b, int& R, int& C) { const int st = b / 1024, sb = b % 1024, swz = sb ^ (((sb >> 9) & 1) << 5); R = (st >> 1) * 16 + swz / 64; C = (st & 1) * 32 + (swz % 64) / 2; }
__device__ __forceinline__ int perm32(int rho) { const int n = rho >> 4, i = rho & 15; return 8 * (i >> 2) + 4 * n + (i & 3); }
struct Unit { int pm, pn; };
struct Gemm {
    const bf16_t* A; const bf16_t* Bt; int M, N, K;
    const int* gather;
    int gt, ng; size_t gstride;
};
struct StaticOrder {
    int nM, nN, nwg, G, c;
    __device__ void init(int M, int N, int G_, int c_) { nM = M / BM; nN = N / BM; nwg = nM * nN; G = G_; c = c_; }
    __device__ bool next(int i, Unit& u) const {
        const long L = (long)i * G + c; if (L >= nwg) return false;
        int wgid = (int)L; { const int q = nwg / NXCD, r = nwg % NXCD, xcd = wgid % NXCD, off = wgid / NXCD; wgid = (xcd < r ? xcd * (q + 1) : r * (q + 1) + (xcd - r) * q) + off; }
        const int nig = WGM * nN, gid = wgid / nig, fm = gid * WGM, gsz = (nM - fm) < WGM ? (nM - fm) : WGM;
        u.pm = fm + ((wgid % nig) % gsz); u.pn = (wgid % nig) / gsz; return true;
    }
};
struct EpiBf16 {
    static constexpr bool PERM = true;
    bf16_t* O; int ldc; const float* rowscale; int skip;
    __device__ __forceinline__ void operator()(const f32x4 (&acc)[2][2][4][2], const Unit& u, int wr, int wc, int fr, int fq) const {
        const int row0 = u.pm * BM + wr * 64 + fr, col0 = u.pn * BM + wc * 32 + 8 * fq;
        if (skip) { asm volatile("" :: "v"(acc[0][0][0][0]), "v"(acc[1][1][3][1])); return; }
        float scv[2][4];
#pragma unroll
        for (int ai = 0; ai < 2; ++ai)
#pragma unroll
            for (int m = 0; m < 4; ++m) scv[ai][m] = rowscale ? rowscale[row0 + ai * HALF + m * 16] : 1.f;
        asm volatile("" ::: "memory");
#pragma unroll
        for (int ai = 0; ai < 2; ++ai)
#pragma unroll
            for (int m = 0; m < 4; ++m) { const int row = row0 + ai * HALF + m * 16; bf16_t* rowp = O + (size_t)row * ldc + col0; const float sc = scv[ai][m];
#pragma unroll
                for (int bj = 0; bj < 2; ++bj) { const f32x4 v0 = acc[ai][bj][m][0] * sc, v1 = acc[ai][bj][m][1] * sc;
                    u32x4 w; w.x = cvt_pk_bf16_asm(v0[0], v0[1]); w.y = cvt_pk_bf16_asm(v0[2], v0[3]); w.z = cvt_pk_bf16_asm(v1[0], v1[1]); w.w = cvt_pk_bf16_asm(v1[2], v1[3]);
                    *(u32x4*)(rowp + bj * HALF) = w; } }
    }
};
struct EpiP {
    static constexpr bool PERM = true;
    bf16_t* O; int ldc; const float* qn; const float* kn; int skip;
    __device__ __forceinline__ void operator()(const f32x4 (&acc)[2][2][4][2], const Unit& u, int wr, int wc, int fr, int fq) const {
        const int row0 = u.pm * BM + wr * 64 + fr, col0 = u.pn * BM + wc * 32 + 8 * fq;
        if (skip) { asm volatile("" :: "v"(acc[0][0][0][0]), "v"(acc[1][1][3][1])); return; }
        if (u.pn >= 3 || !FUSE_QK) {
#pragma unroll
            for (int ai = 0; ai < 2; ++ai)
#pragma unroll
                for (int m = 0; m < 4; ++m) { bf16_t* rowp = O + (size_t)(row0 + ai * HALF + m * 16) * ldc + col0;
#pragma unroll
                    for (int bj = 0; bj < 2; ++bj) { const f32x4 v0 = acc[ai][bj][m][0], v1 = acc[ai][bj][m][1];
                        u32x4 w; w.x = cvt_pk_bf16_asm(v0[0], v0[1]); w.y = cvt_pk_bf16_asm(v0[2], v0[3]); w.z = cvt_pk_bf16_asm(v1[0], v1[1]); w.w = cvt_pk_bf16_asm(v1[2], v1[3]);
                        *(u32x4*)(rowp + bj * HALF) = w; } }
            return;
        }
        LAS float* PS = (LAS float*)((LAS unsigned char*)lds_raw + LDSCTL_OFF + 4096);
        const int half = wc & 1, hw = wc >> 1;
        unsigned lm_ = ~0u; asm volatile("" : "+s"(lm_)); const int lane = (int)__builtin_amdgcn_mbcnt_hi(lm_, __builtin_amdgcn_mbcnt_lo(lm_, 0u));
#pragma unroll
        for (int ai = 0; ai < 2; ++ai)
#pragma unroll
            for (int m = 0; m < 4; ++m)
#pragma unroll
                for (int bj = 0; bj < 2; ++bj) { const f32x4 v0 = acc[ai][bj][m][0], v1 = acc[ai][bj][m][1];
                    float s = (v0[0] * v0[0] + v0[1] * v0[1]) + (v0[2] * v0[2] + v0[3] * v0[3]) + (v1[0] * v1[0] + v1[1] * v1[1]) + (v1[2] * v1[2] + v1[3] * v1[3]);
                    s = x32_sum(x16_sum(s, lane), lane);
                    if (fq == 0) PS[((ai * HALF + wr * 64 + m * 16 + fr) * 4 + 2 * bj + hw) * 2 + half] = s; }
        asm volatile("s_waitcnt lgkmcnt(0)" ::: "memory"); __builtin_amdgcn_s_barrier(); asm volatile("" ::: "memory");
        float invf[8];
#pragma unroll
        for (int j = 0; j < 8; ++j) invf[j] = __builtin_amdgcn_exp2f(-(float)(8 * (fq & 1) + j) * (13.287712379549449f / 16.f));
        const bool second = (fq & 2) != 0;
        f32x4 nwv[2][2];
#pragma unroll
        for (int bj = 0; bj < 2; ++bj) { const bool isk = (u.pn * BM + bj * HALF + wc * 32) >= 384; const float* nw = (isk ? kn : qn) + 32 * half + 8 * fq; nwv[bj][0] = *(const f32x4*)nw; nwv[bj][1] = *(const f32x4*)(nw + 4); }
        asm volatile("" ::: "memory");
#pragma unroll
        for (int ai = 0; ai < 2; ++ai)
#pragma unroll
            for (int m = 0; m < 4; ++m) {
                const int grow = row0 + ai * HALF + m * 16; const bool lat = grow < NLAT; const int t = lat ? grow % SEQ : 0;
                int tp = half ? t % GW : t / GW; asm volatile("" : "+v"(tp));
                const float pos = (float)tp;
                float cs[8], sn[8];
#pragma unroll
                for (int j = 0; j < 8; ++j) { const float ang = pos * invf[j]; cs[j] = __cosf(ang); sn[j] = __sinf(ang); }
                bf16_t* rowp = O + (size_t)grow * ldc + col0;
#pragma unroll
                for (int bj = 0; bj < 2; ++bj) {
                    const int rl = ai * HALF + wr * 64 + m * 16 + fr, head = 2 * bj + hw;
                    const float ssq = PS[(rl * 4 + head) * 2] + PS[(rl * 4 + head) * 2 + 1];
                    const bool isk = (u.pn * BM + bj * HALF + wc * 32) >= 384;
                    const float rstd = (isk ? 1.f : 0.125f * 1.44269504089f) / sqrtf(ssq * (1.f / HD) + EPS);
                    const f32x4 n0 = nwv[bj][0], n1 = nwv[bj][1];
                    float y[8];
#pragma unroll
                    for (int j = 0; j < 4; ++j) { y[j] = acc[ai][bj][m][0][j] * rstd * n0[j]; y[4 + j] = acc[ai][bj][m][1][j] * rstd * n1[j]; }
#pragma unroll
                    for (int j = 0; j < 8; ++j) {
                        const unsigned yb = __builtin_bit_cast(unsigned, y[j]);
                        const auto sw = __builtin_amdgcn_permlane32_swap(yb, yb, false, false);
                        const float other = __builtin_bit_cast(float, lane < 32 ? sw[1] : sw[0]);
                        const float rot = second ? y[j] * cs[j] + other * sn[j] : y[j] * cs[j] - other * sn[j];
                        y[j] = lat ? rot : y[j];
                    }
                    u32x4 w; w.x = cvt_pk_bf16(y[0], y[1]); w.y = cvt_pk_bf16(y[2], y[3]); w.z = cvt_pk_bf16(y[4], y[5]); w.w = cvt_pk_bf16(y[6], y[7]);
                    *(u32x4*)(rowp + bj * HALF) = w;
                }
                asm volatile("" ::: "memory");
            }
    }
};
struct EpiRes {
    static constexpr bool PERM = true;
    bf16_t* X; int ldc; const float* gate0; int rows_per_set; size_t set_stride;
    __device__ __forceinline__ void operator()(const f32x4 (&acc)[2][2][4][2], const Unit& u, int wr, int wc, int fr, int fq) const {
        const int row0 = u.pm * BM + wr * 64 + fr, col0 = u.pn * BM + wc * 32 + 8 * fq;
        const float* gate = gate0 + (size_t)((u.pm * BM) / rows_per_set) * set_stride;
        f32x4 gv[2][2];
#pragma unroll
        for (int bj = 0; bj < 2; ++bj)
#pragma unroll
            for (int n = 0; n < 2; ++n) gv[bj][n] = *(const f32x4*)(gate + col0 + bj * HALF + n * 4);
        u32x4 rv[2][4][2];
#pragma unroll
        for (int ai = 0; ai < 2; ++ai)
#pragma unroll
            for (int m = 0; m < 4; ++m)
#pragma unroll
                for (int bj = 0; bj < 2; ++bj) rv[ai][m][bj] = *(const u32x4*)(X + (size_t)(row0 + ai * HALF + m * 16) * ldc + col0 + bj * HALF);
        asm volatile("" ::: "memory");
#pragma unroll
        for (int ai = 0; ai < 2; ++ai)
#pragma unroll
            for (int m = 0; m < 4; ++m) { bf16_t* rowp = X + (size_t)(row0 + ai * HALF + m * 16) * ldc + col0;
#pragma unroll
                for (int bj = 0; bj < 2; ++bj) { const u32x4 r = rv[ai][m][bj];
                    const f32x4 x0 = (f32x4){bfw(r.x, 0), bfw(r.x, 1), bfw(r.y, 0), bfw(r.y, 1)}, x1 = (f32x4){bfw(r.z, 0), bfw(r.z, 1), bfw(r.w, 0), bfw(r.w, 1)};
                    const f32x4 v0 = x0 + gv[bj][0] * acc[ai][bj][m][0], v1 = x1 + gv[bj][1] * acc[ai][bj][m][1];
                    u32x4 w; w.x = cvt_pk_bf16_asm(v0[0], v0[1]); w.y = cvt_pk_bf16_asm(v0[2], v0[3]); w.z = cvt_pk_bf16_asm(v1[0], v1[1]); w.w = cvt_pk_bf16_asm(v1[2], v1[3]);
                    *(u32x4*)(rowp + bj * HALF) = w; } }
    }
};
struct EpiHid {
    static constexpr bool PERM = false;
    bf16_t* O; int ldc;
    __device__ __forceinline__ void operator()(const f32x4 (&acc)[2][2][4][2], const Unit& u, int wr, int wc, int fr, int fq) const {
        const int row0 = u.pm * BM + wr * 64 + fr, col0 = (u.pn * BM + wc * 32) / 2 + 4 * (fq & ~1) + ((fq & 1) ? HALF / 2 : 0);
#pragma unroll
        for (int ai = 0; ai < 2; ++ai)
#pragma unroll
            for (int m = 0; m < 4; ++m) { bf16_t* rowp = O + (size_t)(row0 + ai * HALF + m * 16) * ldc + col0;
                u32x2 w[2];
#pragma unroll
                for (int bj = 0; bj < 2; ++bj) { const f32x4 g = acc[ai][bj][m][0], up = acc[ai][bj][m][1]; f32x4 h;
#pragma unroll
                    for (int j = 0; j < 4; ++j) h[j] = g[j] * __builtin_amdgcn_rcpf(1.f + __expf(-g[j])) * up[j];
                    w[bj].x = cvt_pk_bf16(h[0], h[1]); w[bj].y = cvt_pk_bf16(h[2], h[3]); }
                const auto rx = __builtin_amdgcn_permlane16_swap(w[0].x, w[1].x, false, false), ry = __builtin_amdgcn_permlane16_swap(w[0].y, w[1].y, false, false);
                u32x4 o; o.x = rx[0]; o.y = ry[0]; o.z = rx[1]; o.w = ry[1];
                *(u32x4*)rowp = o; }
    }
};

template <class Epi, bool GATHER>
__device__ __forceinline__ void gemm_phase(const int tid, LAS unsigned char* lds, const Gemm g, const StaticOrder& S, const Epi& E) {
    const int wid = __builtin_amdgcn_readfirstlane(tid >> 6), lane = tid & 63, wr = wid >> 2, wc = wid & 3, fr = lane & 15, fq = lane >> 4;
    const int K = g.K, nt = K / BK;
    unsigned voffA[2], voffB[2];
#pragma unroll
    for (int i = 0; i < 2; ++i) { int R, C; stage_rc(tid * 16 + i * 8192, R, C); const int Rb = Epi::PERM ? ((R & ~31) + perm32(R & 31)) : R;
        voffB[i] = (unsigned)(Rb * K + C) * 2u; voffA[i] = GATHER ? (unsigned)(C * 2) : (Epi::PERM ? (unsigned)(R * K + C) * 2u : voffB[i]); }
    const size_t kstep = (size_t)(BK * 2);
    const size_t hstep = (size_t)HALF * K * 2;
    const size_t tstep = 2 * hstep;
    const unsigned ldsw = (unsigned)wid * 1024u;
    const int aoff = lds_byte(wr * 64 + fr, fq * 8), boff = lds_byte(wc * 32 + fr, fq * 8);
#define PG8_SA(b, h) (((b) * 2 + (h)) * HTB)
#define PG8_SB(b, h) ((4 + (b) * 2 + (h)) * HTB)
#define PG8_STAGE(bufoff, gbase, voff) do { const char* gb_ = (const char*)(gbase); asm volatile("" : "+s"(gb_)); _Pragma("unroll") for (int _i = 0; _i < 2; ++_i) \
        __builtin_amdgcn_global_load_lds((const unsigned*)(gb_ + (voff)[_i]), (LAS unsigned*)(lds + (bufoff) + ldsw + _i * 8192), 16, 0, 0); } while (0)
#define PG8_STAGE_A(bufoff, ubase, kt, h, tb) do { if constexpr (GATHER) { \
        if ((tb) < 0) { PG8_STAGE(bufoff, Ab + (size_t)(kt) * kstep, oAc[h]); } else { \
        unsigned m_ = ~0u; asm volatile("" : "+s"(m_)); const int tl_ = wid * 64 + (int)__builtin_amdgcn_mbcnt_hi(m_, __builtin_amdgcn_mbcnt_lo(m_, 0u)); \
        _Pragma("unroll") for (int _i = 0; _i < 2; ++_i) { int _R, _C; stage_rc(tl_ * 16 + _i * 8192, _R, _C); \
            const unsigned _o = min(*(const LAS unsigned*)(lds + TAB_OFF + (tb) * 1024 + ((h) * HALF + _R) * 4), (unsigned)(NTOK - 1)) * (unsigned)(K * 2) + (unsigned)(_C * 2); \
            __builtin_amdgcn_global_load_lds((const unsigned*)(Ab + (size_t)(kt) * kstep + _o), (LAS unsigned*)(lds + (bufoff) + ldsw + _i * 8192), 16, 0, 0); } } } \
        else { PG8_STAGE(bufoff, (ubase) + (size_t)(kt) * kstep + (size_t)(h) * hstep, voffA); } } while (0)
#define PG8_LOADOFFS(tb) do { if constexpr (GATHER) { unsigned m_ = ~0u; asm volatile("" : "+s"(m_)); const int tl_ = wid * 64 + (int)__builtin_amdgcn_mbcnt_hi(m_, __builtin_amdgcn_mbcnt_lo(m_, 0u)); \
        _Pragma("unroll") for (int _h = 0; _h < 2; ++_h) _Pragma("unroll") for (int _i = 0; _i < 2; ++_i) { int _R, _C; stage_rc(tl_ * 16 + _i * 8192, _R, _C); \
            oAc[_h][_i] = min(*(const LAS unsigned*)(lds + TAB_OFF + (tb) * 1024 + (_h * HALF + _R) * 4), (unsigned)(NTOK - 1)) * (unsigned)(K * 2) + (unsigned)(_C * 2); } } } while (0)
#define PG8_FILLTAB(u, tb) do { if constexpr (GATHER) { unsigned m_ = ~0u; asm volatile("" : "+s"(m_)); const int tl_ = wid * 64 + (int)__builtin_amdgcn_mbcnt_hi(m_, __builtin_amdgcn_mbcnt_lo(m_, 0u)); \
        if (tl_ < 256) *(LAS unsigned*)(lds + TAB_OFF + (tb) * 1024 + tl_ * 4) = (unsigned)g.gather[(u).pm * BM + tl_]; } } while (0)
#define PG8_LDA(dst, b, h) do { _Pragma("unroll") for (int m = 0; m < 4; ++m) _Pragma("unroll") for (int k = 0; k < 2; ++k) dst[m][k] = *(const LAS bf16x8*)(lds + PG8_SA(b, h) + aoff + m * 2048 + k * 1024); } while (0)
#define PG8_LDB(dst, b, h) do { _Pragma("unroll") for (int n = 0; n < 2; ++n) _Pragma("unroll") for (int k = 0; k < 2; ++k) dst[n][k] = *(const LAS bf16x8*)(lds + PG8_SB(b, h) + boff + n * 2048 + k * 1024); } while (0)
#define PG8_MMA(ai, bj, At, Bt) do { __builtin_amdgcn_s_setprio(1); _Pragma("unroll") for (int m = 0; m < 4; ++m) _Pragma("unroll") for (int n = 0; n < 2; ++n) _Pragma("unroll") for (int k = 0; k < 2; ++k) \
        acc[ai][bj][m][n] = __builtin_amdgcn_mfma_f32_16x16x32_bf16(Bt[n][k], At[m][k], acc[ai][bj][m][n], 0, 0, 0); __builtin_amdgcn_s_setprio(0); } while (0)
#define PG8_WAIT_V(n) asm volatile("s_waitcnt vmcnt(" #n ")" ::: "memory")
#define PG8_WAIT_L(n) asm volatile("s_waitcnt lgkmcnt(" #n ")" ::: "memory")
#define PG8_BAR __builtin_amdgcn_s_barrier()
#define PG8_SCHED __builtin_amdgcn_sched_barrier(0)
#define PG8_KTILE2(u1, k1, o1, u2, k2, o2, b2p) do { \
        PG8_LDB(B0, 0, 0); PG8_LDB(B1, 0, 1); PG8_SCHED; PG8_LDA(At, 0, 0); PG8_STAGE_A(PG8_SA(1, 1), u1, k1, 1, o1); \
        PG8_WAIT_V(8); PG8_WAIT_L(0); PG8_BAR; PG8_MMA(0, 0, At, B0); PG8_MMA(0, 1, At, B1); PG8_BAR; PG8_SCHED; \
        PG8_LDA(At, 0, 1); PG8_STAGE(PG8_SB(0, 0), b2p, voffB); PG8_STAGE(PG8_SB(0, 1), (b2p) + hstep, voffB); PG8_STAGE_A(PG8_SA(0, 0), u2, k2, 0, o2); \
        PG8_WAIT_V(8); PG8_WAIT_L(0); PG8_BAR; PG8_MMA(1, 0, At, B0); PG8_MMA(1, 1, At, B1); PG8_BAR; PG8_SCHED; \
        PG8_LDB(B0, 1, 0); PG8_LDB(B1, 1, 1); PG8_SCHED; PG8_LDA(At, 1, 0); PG8_STAGE_A(PG8_SA(0, 1), u2, k2, 1, o2); \
        PG8_WAIT_V(8); PG8_WAIT_L(0); PG8_BAR; PG8_MMA(0, 0, At, B0); PG8_MMA(0, 1, At, B1); PG8_BAR; PG8_SCHED; \
        PG8_LDA(At, 1, 1); PG8_STAGE(PG8_SB(1, 0), (b2p) + kstep, voffB); PG8_STAGE(PG8_SB(1, 1), (b2p) + kstep + hstep, voffB); PG8_STAGE_A(PG8_SA(1, 0), u2, (k2) + 1, 0, o2); \
        PG8_WAIT_V(8); PG8_WAIT_L(0); PG8_BAR; PG8_MMA(1, 0, At, B0); PG8_MMA(1, 1, At, B1); PG8_BAR; PG8_SCHED; } while (0)
#define PG8_BPTR(u) ((const char*)g.Bt + (g.gt ? (size_t)(((u).pm / g.gt) % g.ng) * g.gstride : (size_t)0) + (size_t)(u).pn * tstep)
    Unit cur, nxt; int ui = 0;
    if (!S.next(0, cur)) return;
#ifndef LATE_START
#define LATE_START 4
#endif
#ifndef GEMM_STAGGER
#define GEMM_STAGGER 0
#endif
    if (GEMM_STAGGER) { const int dg_ = ((int)blockIdx.x >> 3) & 3; for (int i_ = 0; i_ < dg_; ++i_) __builtin_amdgcn_s_sleep(GEMM_STAGGER); }
    if (S.nwg % S.G != 0 && S.c >= S.nwg % S.G) { for (int i_ = 0; i_ < LATE_START; ++i_) __builtin_amdgcn_s_sleep(127); }
    f32x4 acc[2][2][4][2];
#pragma unroll
    for (int a = 0; a < 2; ++a)
#pragma unroll
        for (int b = 0; b < 2; ++b)
#pragma unroll
            for (int m = 0; m < 4; ++m)
#pragma unroll
                for (int n = 0; n < 2; ++n) acc[a][b][m][n] = (f32x4){0.f, 0.f, 0.f, 0.f};
    bf16x8 At[4][2], B0[2][2], B1[2][2];
    unsigned oAc[2][2] = {{0u, 0u}, {0u, 0u}};
    const char* const Ab = (const char*)g.A;
    const char* cA = Ab + (size_t)cur.pm * tstep;
    const char* cB = PG8_BPTR(cur);
    PG8_FILLTAB(cur, 0);
    if constexpr (GATHER) { PG8_WAIT_L(0); PG8_BAR; PG8_LOADOFFS(0); }
    PG8_STAGE(PG8_SB(0, 0), cB, voffB); PG8_STAGE(PG8_SB(0, 1), cB + hstep, voffB); PG8_STAGE_A(PG8_SA(0, 0), cA, 0, 0, -1); PG8_STAGE_A(PG8_SA(0, 1), cA, 0, 1, -1);
    if (wr == 1) PG8_BAR;
    PG8_WAIT_V(2); PG8_BAR;
    PG8_STAGE(PG8_SB(1, 0), cB + kstep, voffB); PG8_STAGE_A(PG8_SA(1, 0), cA, 1, 0, -1); PG8_STAGE(PG8_SB(1, 1), cB + hstep + kstep, voffB);
    PG8_WAIT_V(6); PG8_BAR;
    for (;;) {
        const bool has_next = S.next(ui + 1, nxt);
        const char* nA = has_next ? Ab + (size_t)nxt.pm * tstep : cA; const char* nB = has_next ? PG8_BPTR(nxt) : cB;
        const int tbc = ui & 1, tbn = has_next ? ((ui + 1) & 1) : (ui & 1);
        if constexpr (GATHER) { if (has_next && wid < 4) { unsigned m_ = ~0u; asm volatile("" : "+s"(m_)); const int tl_ = wid * 64 + (int)__builtin_amdgcn_mbcnt_hi(m_, __builtin_amdgcn_mbcnt_lo(m_, 0u));
            __builtin_amdgcn_global_load_lds((const unsigned*)(g.gather + nxt.pm * BM + tl_), (LAS unsigned*)(lds + TAB_OFF + tbn * 1024 + wid * 256), 4, 0, 0); } }
        for (int t = 0; t < nt - 2; t += 2) { const char* b2 = cB + (size_t)(t + 2) * kstep; PG8_KTILE2(cA, t + 1, -1, cA, t + 2, -1, b2); }
        PG8_KTILE2(cA, nt - 1, -1, nA, 0, tbn, nB);
        if (wr == 0) PG8_BAR;
        { unsigned m_ = ~0u; asm volatile("" : "+s"(m_)); int l2 = (int)__builtin_amdgcn_mbcnt_hi(m_, __builtin_amdgcn_mbcnt_lo(m_, 0u)); asm volatile("" : "+v"(l2)); E(acc, cur, wr, wc, l2 & 15, l2 >> 4); }
        if (!has_next) break;
#pragma unroll
        for (int a = 0; a < 2; ++a)
#pragma unroll
            for (int b = 0; b < 2; ++b)
#pragma unroll
                for (int m = 0; m < 4; ++m)
#pragma unroll
                    for (int n = 0; n < 2; ++n) acc[a][b][m][n] = (f32x4){0.f, 0.f, 0.f, 0.f};
        cur = nxt; cA = nA; cB = nB; ++ui;
        PG8_LOADOFFS(ui & 1);
        if (wr == 1) PG8_BAR;
    }
    PG8_WAIT_V(0);
    PG8_BAR;
#undef PG8_STAGE_A
#undef PG8_FILLTAB
#undef PG8_LOADOFFS
#undef PG8_SA
#undef PG8_SB
#undef PG8_STAGE
#undef PG8_LDA
#undef PG8_LDB
#undef PG8_MMA
#undef PG8_WAIT_V
#undef PG8_WAIT_L
#undef PG8_BAR
#undef PG8_SCHED
#undef PG8_KTILE2
#undef PG8_BPTR
}
}

#define XB_TMO      128
#define XB_XCNT(j)  (256  + 64 * (j))
#define XB_XSUB(j)  (1280 + 64 * (j))
#define XB_XGEN(j)  (2304 + 64 * (j))
#define XB_TOP      3328
#define XB_TOPGEN   3392
#define XCD_BAR_WORDS 3456
#define XB_SPIN_CAP (1u << 20)
__device__ __forceinline__ unsigned xb_ld(unsigned* p)              { return __hip_atomic_load(p, __ATOMIC_RELAXED, __HIP_MEMORY_SCOPE_AGENT); }
__device__ __forceinline__ unsigned xb_add(unsigned* p, unsigned v) { return __hip_atomic_fetch_add(p, v, __ATOMIC_RELAXED, __HIP_MEMORY_SCOPE_AGENT); }
__device__ __forceinline__ unsigned xb_xcc_id() { return (unsigned)__builtin_amdgcn_s_getreg((3 << 11) | 20) & 0xFu; }
#define XB_SPIN(cond, bar) do { unsigned _sp = 0; while (cond) { __builtin_amdgcn_s_sleep(1); \
    if ((++_sp & 255u) == 0u) { if (xb_ld(&(bar)[XB_TMO])) break; if (_sp > XB_SPIN_CAP) { atomicAdd(&(bar)[XB_TMO], 1u); break; } } } } while (0)
struct XcdBarrier { unsigned* bar; unsigned x; };
#define XB_ST(ldsbase) ((volatile LAS unsigned*)((LAS unsigned char*)(ldsbase) + MISC_OFF + 32))
__device__ __forceinline__ XcdBarrier xcd_barrier_post(unsigned* bar, bool leader) {
    XcdBarrier b; b.bar = bar; b.x = xb_xcc_id();
    if (leader) (void)xb_add(&bar[XB_XCNT(b.x)], 1u);
    return b;
}
__device__ __forceinline__ void xcd_barrier_complete(unsigned* bar, unsigned x, unsigned& nloc, unsigned& nx) {
    const unsigned G = gridDim.x * gridDim.y * gridDim.z;
    unsigned sum, cnt, mine, sp = 0u;
    for (;;) {
        sum = 0u; cnt = 0u; mine = 0u;
#pragma unroll
        for (unsigned j = 0; j < 16; ++j) { const unsigned c = xb_ld(&bar[XB_XCNT(j)]); sum += c; cnt += (c > 0u) ? 1u : 0u; mine = (j == x) ? c : mine; }
        if (sum == G) break;
        __builtin_amdgcn_s_sleep(1);
        if ((++sp & 255u) == 0u) { if (xb_ld(&bar[XB_TMO])) break; if (sp > XB_SPIN_CAP) { atomicAdd(&bar[XB_TMO], 1u); break; } }
    }
    nloc = mine > 0u ? mine : 1u; nx = cnt > 0u ? cnt : 1u;
}
__device__ __forceinline__ void xcd_barrier(const XcdBarrier& b, bool leader, volatile LAS unsigned* st) {
    asm volatile("s_waitcnt vmcnt(0)" ::: "memory");
    __syncthreads();
    if (leader) {
        unsigned* bar = b.bar;
        __builtin_amdgcn_s_waitcnt(0);
        unsigned nloc = st[0], nx = st[1];
        if (nloc == 0u) { xcd_barrier_complete(bar, b.x, nloc, nx); st[0] = nloc; st[1] = nx; }
        const unsigned old = xb_add(&bar[XB_XSUB(b.x)], 1u);
        const unsigned gen = old / nloc;
        if (old + 1u == (gen + 1u) * nloc) {
            __builtin_amdgcn_fence(__ATOMIC_RELEASE, "agent");
            asm volatile("s_waitcnt vmcnt(0)" ::: "memory");
            const unsigned og = xb_add(&bar[XB_TOP], 1u);
            const unsigned tg = og / nx;
            if (og + 1u == (tg + 1u) * nx) xb_add(&bar[XB_TOPGEN], 1u);
            else XB_SPIN(xb_ld(&bar[XB_TOPGEN]) == tg, bar);
            __builtin_amdgcn_fence(__ATOMIC_ACQUIRE, "agent");
            xb_add(&bar[XB_XGEN(b.x)], 1u);
            asm volatile("s_waitcnt vmcnt(0)" ::: "memory");
        } else {
            XB_SPIN(xb_ld(&bar[XB_XGEN(b.x)]) == gen, bar);
            __builtin_amdgcn_fence(__ATOMIC_ACQUIRE, "agent");
            asm volatile("s_waitcnt vmcnt(0)" ::: "memory");
        }
    }
    __syncthreads();
}

template <void (*F)(long, PRef, int)> __device__ __forceinline__ void run_items(const int tid, PRef p, int l, long n, long off) {
    for (long gid = (long)blockIdx.x * NTHR + tid; gid < n; gid += (long)gridDim.x * NTHR) F(gid + off, p, l);
}
BODY void b_hgrn_seq2(long gid, PRef p, int l) { const long n1 = (long)NB * HGH * 64; if (gid < n1) b_hgrn_seq<0>(gid, p, l); else b_hgrn_seq<1>(gid - n1, p, l); }

template <int MAP> __device__ __forceinline__ void transpose_item(const float* W, int K, int N, bf16_t* WT, int row_off, LAS float* scr, int item, int lane) {
    const int nblk = N / 32, kb = item / nblk, nb = item % nblk, k0 = 64 * kb, n0 = 32 * nb;
#pragma unroll 8
    for (int i = 0; i < 32; ++i) { const int kk = 2 * i + (lane >> 5); scr[kk * 33 + (lane & 31)] = W[(size_t)(k0 + kk) * N + n0 + (lane & 31)]; }
    asm volatile("s_waitcnt lgkmcnt(0)" ::: "memory");
    const int c = lane & 7;
#pragma unroll
    for (int j = 0; j < 4; ++j) { const int n = (lane >> 3) + 8 * j; const LAS float* s = scr + (8 * c) * 33 + n;
        u32x4 o; o.x = cvt_pk_bf16(s[0 * 33], s[1 * 33]); o.y = cvt_pk_bf16(s[2 * 33], s[3 * 33]); o.z = cvt_pk_bf16(s[4 * 33], s[5 * 33]); o.w = cvt_pk_bf16(s[6 * 33], s[7 * 33]);
        const int nn = n0 + n; const int drow = MAP == 0 ? row_off + nn : (32 * (nn >> 4) + (nn & 15) + (MAP == 2 ? 16 : 0));
        *(u32x4*)(WT + (size_t)drow * K + k0 + 8 * c) = o; }
    asm volatile("s_waitcnt lgkmcnt(0)" ::: "memory");
}
#define WBOFF(l) ((size_t)((l) & 1) * (WB_BYTES / 2))
__device__ __forceinline__ void phase_convert(const int tid, PRef p, int l, LAS unsigned char* lds, int part = 0, int blk_lo = 0) {
    if ((int)blockIdx.x < blk_lo) return;
    const int lane = tid & 63, wave = tid >> 6;
    LAS float* scr = (LAS float*)(lds + wave * 16384);
    const int gw = ((int)blockIdx.x - blk_lo) * NWAVES + wave, NGW = ((int)gridDim.x - blk_lo) * NWAVES;
    constexpr int I_IN = (D / 64) * (INC / 32), I_OUT = (MIXD / 64) * (D / 32), I_G = (D / 64) * (ED / 32), I_D = (ED / 64) * (D / 32);
    constexpr int NITEMS = I_IN + I_OUT + NE * (2 * I_G + I_D);
    const int it_lo = part == 2 ? I_IN + I_OUT : 0, it_hi = part == 1 ? I_IN + I_OUT : NITEMS;
    for (int it = it_lo + gw; it < it_hi; it += NGW) {
        int r = it;
        if (r < I_IN) { transpose_item<0>(p.w_in + (size_t)l * D * INC, D, INC, p.WIN_T + WBOFF(l), 0, scr, r, lane); continue; } r -= I_IN;
        if (r < I_OUT) { transpose_item<0>(p.w_out + (size_t)l * MIXD * D, MIXD, D, p.WOUT_T + WBOFF(l), 0, scr, r, lane); continue; } r -= I_OUT;
        const int e = r / (2 * I_G + I_D); r -= e * (2 * I_G + I_D);
        if (r < I_G) { transpose_item<1>(p.w_gate + ((size_t)l * NE + e) * D * ED, D, ED, p.WGU_T + WBOFF(l) + (size_t)e * 2 * ED * D, 0, scr, r, lane); continue; } r -= I_G;
        if (r < I_G) { transpose_item<2>(p.w_up + ((size_t)l * NE + e) * D * ED, D, ED, p.WGU_T + WBOFF(l) + (size_t)e * 2 * ED * D, 0, scr, r, lane); continue; } r -= I_G;
        transpose_item<0>(p.w_down + ((size_t)l * NE + e) * ED * D, ED, D, p.WD_T + WBOFF(l) + (size_t)e * D * ED, 0, scr, r, lane);
    }
}
template <int WHICH> __device__ __forceinline__ void phase_prenorm(const int tid, PRef p, int l) {
    static_assert(D == 1024, "wave-per-row kernels assume D = 1024");
    const int lane = tid & 63, wave = tid >> 6;
    const int gw = blockIdx.x * NWAVES + wave, NGW = gridDim.x * NWAVES;
    const float* nw = (WHICH ? p.norm2_w : p.norm1_w) + l * D;
    for (int r = gw; r < NTOK; r += NGW) {
        const float* xr = xrow(p, r);
        const float* mod = p.MOD + ((size_t)l * 3 + modset(r)) * NMOD;
        const float* shift = mod + (WHICH ? 3 : 0) * D; const float* scale = mod + (WHICH ? 4 : 1) * D;
        f32x4 v[4]; float ss = 0.f;
#pragma unroll
        for (int j = 0; j < 4; ++j) { v[j] = *(const f32x4*)(xr + 4 * lane + 256 * j); ss += (v[j][0] * v[j][0] + v[j][1] * v[j][1]) + (v[j][2] * v[j][2] + v[j][3] * v[j][3]); }
        const float rstd = 1.f / sqrtf(wave_sum(ss, lane) * (1.f / D) + EPS);
        float lg[NE];
#pragma unroll
        for (int e = 0; e < NE; ++e) lg[e] = 0.f;
#pragma unroll
        for (int j = 0; j < 4; ++j) {
            const int c = 4 * lane + 256 * j;
            const f32x4 w4 = *(const f32x4*)(nw + c), sc4 = *(const f32x4*)(scale + c), sh4 = *(const f32x4*)(shift + c);
            f32x4 h;
#pragma unroll
            for (int i = 0; i < 4; ++i) h[i] = v[j][i] * rstd * w4[i] * (1.f + sc4[i]) + sh4[i];
            u32x2 o; o.x = cvt_pk_bf16(h[0], h[1]); o.y = cvt_pk_bf16(h[2], h[3]);
            *(u32x2*)(p.H + (size_t)r * D + c) = o;
            if (WHICH) {
#pragma unroll
                for (int i = 0; i < 4; ++i) { const f32x4* wr = (const f32x4*)(p.w_router + ((size_t)l * D + c + i) * NE);
#pragma unroll
                    for (int q = 0; q < 4; ++q) { const f32x4 w = wr[q]; lg[4 * q + 0] += h[i] * w[0]; lg[4 * q + 1] += h[i] * w[1]; lg[4 * q + 2] += h[i] * w[2]; lg[4 * q + 3] += h[i] * w[3]; } }
            }
        }
        if (WHICH) {
#pragma unroll
            for (int e = 0; e < NE; ++e) lg[e] = wave_sum(lg[e], lane);
            float m = lg[0];
#pragma unroll
            for (int e = 1; e < NE; ++e) m = fmaxf(m, lg[e]);
            float s = 0.f, mine = 0.f;
#pragma unroll
            for (int e = 0; e < NE; ++e) { const float ex = expf(lg[e] - m); s += ex; mine = (lane == e) ? ex : mine; }
            if (lane < NE) p.AFF[(size_t)r * NE + lane] = mine / s;
        }
    }
}
__device__ __forceinline__ void phase_combine(const int tid, PRef p, int l) {
    const int lane = tid & 63, wave = tid >> 6;
    const int gw = blockIdx.x * NWAVES + wave, NGW = gridDim.x * NWAVES;
    for (int r = gw; r < NTOK; r += NGW) {
        float* xr = xrow(p, r);
        const float* g = p.MOD + ((size_t)l * 3 + modset(r)) * NMOD + 5 * D;
        f32x4 acc[4];
#pragma unroll
        for (int j = 0; j < 4; ++j) acc[j] = (f32x4){0.f, 0.f, 0.f, 0.f};
        const int myinv = lane < NE ? p.INV[(size_t)r * NE + lane] : -1;
#pragma unroll
        for (int e = 0; e < NE; ++e) {
            const int s = __builtin_amdgcn_readlane(myinv, e);
            if (s >= 0 && s < NSLOT) {
                const bf16_t* y = p.Y + (size_t)s * D;
#pragma unroll
                for (int j = 0; j < 4; ++j) { const u32x2 w = *(const u32x2*)(y + 4 * lane + 256 * j);
                    acc[j][0] += __builtin_bit_cast(float, w.x << 16); acc[j][1] += __builtin_bit_cast(float, w.x & 0xffff0000u);
                    acc[j][2] += __builtin_bit_cast(float, w.y << 16); acc[j][3] += __builtin_bit_cast(float, w.y & 0xffff0000u); }
            }
        }
#pragma unroll
        for (int j = 0; j < 4; ++j) { const int c = 4 * lane + 256 * j; f32x4* q = (f32x4*)(xr + c); *q = *q + *(const f32x4*)(g + c) * acc[j]; }
    }
}


__device__ __forceinline__ unsigned wave_excl_scan(unsigned x, int lane) {
    unsigned inc = x;
#pragma unroll
    for (int d = 1; d < 64; d <<= 1) { const unsigned y = (unsigned)__builtin_amdgcn_ds_bpermute(((lane - d) & 63) << 2, (int)inc); if (lane >= d) inc += y; }
    return inc - x;
}
__device__ __forceinline__ void phase_topk(const int tid, PRef p, LAS unsigned char* lds) {
    LAS unsigned* keys = (LAS unsigned*)lds;
    LAS unsigned* hist = (LAS unsigned*)(lds + 70000);
    LAS unsigned* cgt = (LAS unsigned*)(lds + 76000);
    LAS unsigned* ceq = (LAS unsigned*)(lds + 80000);
    LAS unsigned* sh = (LAS unsigned*)(lds + 84000);
    static_assert(SEQ % 512 == 0 && SEQ + SEQ / 32 <= 17400, "topk LDS layout");
    constexpr int PER = SEQ / 512;
    for (int pr = blockIdx.x; pr < 2 * NB * NE; pr += gridDim.x) {
        const int e = pr % NE, b = (pr / NE) % NB, isctx = pr / (NE * NB);
        if (!isctx) {
            const int row0 = b * SEQ, base = (b * NE + e) * CAPL;
            for (int i = 0; i < PER; ++i) { const int t = i * 512 + tid; keys[t + (t >> 5)] = __builtin_bit_cast(unsigned, p.AFF[(size_t)(row0 + t) * NE + e]); }
            if (tid == 0) { sh[0] = 0u; sh[1] = (unsigned)CAPL; }
            __syncthreads();
            for (int pass = 0; pass < 3; ++pass) {
                const int shift = 20 - 10 * pass;
                for (int i = tid; i < 1024; i += 512) hist[i] = 0u;
                __syncthreads();
                const unsigned prefix = sh[0]; const unsigned himask = pass == 0 ? 0u : (0xFFFFFFFFu << (shift + 10));
                for (int i = 0; i < PER; ++i) { const int t = tid * PER + i; const unsigned k = keys[t + (t >> 5)]; if ((k & himask) == prefix) atomicAdd((unsigned*)&hist[(k >> shift) & 1023u], 1u); }
                __syncthreads();
                if (tid < 64) {
                    const unsigned need = sh[1];
                    unsigned c[16]; unsigned tot = 0u;
#pragma unroll
                    for (int q = 0; q < 16; ++q) { c[q] = hist[1023 - 16 * tid - q]; tot += c[q]; }
                    unsigned above = wave_excl_scan(tot, tid);
                    int fbin = -1; unsigned fabove = 0u;
#pragma unroll
                    for (int q = 0; q < 16; ++q) { if (fbin < 0 && above < need && above + c[q] >= need) { fbin = 1023 - 16 * tid - q; fabove = above; } above += c[q]; }
                    if (fbin >= 0) { sh[0] = prefix | ((unsigned)fbin << shift); sh[1] = need - fabove; }
                }
                __syncthreads();
            }
            const unsigned thr = sh[0], keq = sh[1];
            unsigned ng = 0u, nq = 0u;
            for (int i = 0; i < PER; ++i) { const int t = tid * PER + i; const unsigned k = keys[t + (t >> 5)]; ng += k > thr ? 1u : 0u; nq += k == thr ? 1u : 0u; }
            cgt[tid] = ng; ceq[tid] = nq;
            __syncthreads();
            if (tid < 64) {
                unsigned g[8], q[8], sg = 0u, sq = 0u;
#pragma unroll
                for (int i = 0; i < 8; ++i) { g[i] = cgt[8 * tid + i]; q[i] = ceq[8 * tid + i]; sg += g[i]; sq += q[i]; }
                unsigned ag = wave_excl_scan(sg, tid), aq = wave_excl_scan(sq, tid);
#pragma unroll
                for (int i = 0; i < 8; ++i) { cgt[8 * tid + i] = ag; ceq[8 * tid + i] = aq; ag += g[i]; aq += q[i]; }
            }
            __syncthreads();
            unsigned rg = cgt[tid], rq = ceq[tid];
            for (int i = 0; i < PER; ++i) {
                const int t = tid * PER + i; const unsigned k = keys[t + (t >> 5)];
                int slot = -1;
                if (k > thr) { slot = (int)(rg + (rq < keq ? rq : keq)); ++rg; }
                else if (k == thr) { if (rq < keq) slot = (int)(rg + rq); ++rq; }
                const int row = row0 + t;
                if (slot >= 0) { p.STOK[base + slot] = row; p.SVAL[base + slot] = __builtin_bit_cast(float, k); p.INV[(size_t)row * NE + e] = base + slot; }
                else p.INV[(size_t)row * NE + e] = -1;
            }
            __syncthreads();
        } else {
            const int row0 = NLAT + b * CTX, base = NSLOT_L + (b * NE + e) * CAPC;
            LAS float* vals = (LAS float*)lds;
            for (int t = tid; t < CTX; t += 512) vals[t] = p.AFF[(size_t)(row0 + t) * NE + e];
            __syncthreads();
            for (int t = tid; t < CTX; t += 512) {
                const float a = vals[t]; int rank = 0;
                for (int tt = 0; tt < CTX; ++tt) { const float o = vals[tt]; rank += (o > a || (o == a && tt < t)) ? 1 : 0; }
                const int row = row0 + t;
                if (rank < CAPC) { p.STOK[base + rank] = row; p.SVAL[base + rank] = a; p.INV[(size_t)row * NE + e] = base + rank; }
                else p.INV[(size_t)row * NE + e] = -1;
            }
            __syncthreads();
        }
    }
}

#define LDS_BAR() do { asm volatile("s_waitcnt lgkmcnt(0)" ::: "memory"); __builtin_amdgcn_s_barrier(); asm volatile("" ::: "memory"); } while (0)
__device__ __forceinline__ int hg_row0(int b, int pc) { return pc < NCHC ? NLAT + b * CTX + pc * 64 : b * SEQ + (pc - NCHC) * 64; }
constexpr int HG_FF = 0, HG_FB = 16384, HG_AF = 32768, HG_AB = 49152, HG_T0 = 65536, HG_TS = 9216, HG_VT = HG_T0 + 6 * HG_TS;
#define HGI(t, k) ((t) * 64 + ((k) ^ (((((t) >> 4) & 1) << 4) | (((t) & 3) << 2))))
#define HGLD8(dst, arr, t, k0) do { const f32x4 lo_ = *(const LAS f32x4*)((arr) + HGI(t, k0)), hi_ = *(const LAS f32x4*)((arr) + HGI(t, (k0) + 4)); \
        dst[0] = lo_[0]; dst[1] = lo_[1]; dst[2] = lo_[2]; dst[3] = lo_[3]; dst[4] = hi_[0]; dst[5] = hi_[1]; dst[6] = hi_[2]; dst[7] = hi_[3]; } while (0)
static_assert(HG_VT + HG_TS <= RING_BYTES, "hgrn LDS layout");
#define TSW_E(k, t) ((k) * 72 + ((((t) >> 3) ^ (((k) >> 3) & 7)) << 3) + ((t) & 7))
#define TSW_B(k, c) ((k) * 144 + (((c) ^ (((k) >> 3) & 7)) << 4))
constexpr int HG_LBOFF = LDSCTL_OFF + 4096;
__device__ __forceinline__ void hg_stage_lb(const int tid, PRef p, int l) {
    LAS float* dst = (LAS float*)((LAS unsigned char*)lds_raw + HG_LBOFF);
    for (int i = tid; i < 768; i += NTHR) dst[i] = p.LB[(size_t)((i / 384) * DEPTH + l) * 384 + (i % 384)];
    LDS_BAR();
}
__device__ __forceinline__ void hg_gates(const int tid, PRef p, int l, int h, const u32x4 zf, const u32x4 zb, LAS unsigned char* lds) {
    LAS float* FF = (LAS float*)(lds + HG_FF); LAS float* FB = (LAS float*)(lds + HG_FB); LAS float* AF = (LAS float*)(lds + HG_AF); LAS float* AB = (LAS float*)(lds + HG_AB);
    const int t = tid >> 3, cg = tid & 7;
    const LAS float* lbf = (const LAS float*)((LAS unsigned char*)lds_raw + HG_LBOFF) + h * 64 + cg * 8; const LAS float* lbb = lbf + 384;
    float ffv[8], fbv[8];
#pragma unroll
    for (int j = 0; j < 8; ++j) {
        const float z0 = fminf(fmaxf(bf8(zf, j), -60.f), 60.f), z1 = fminf(fmaxf(bf8(zb, j), -60.f), 60.f);
        const float l0 = lbf[j], l1 = lbb[j];
        ffv[j] = l0 + (1.f - l0) * __builtin_amdgcn_rcpf(1.f + __expf(-z0));
        fbv[j] = l1 + (1.f - l1) * __builtin_amdgcn_rcpf(1.f + __expf(-z1));
    }
    *(LAS f32x4*)(FF + HGI(t, cg * 8)) = (f32x4){ffv[0], ffv[1], ffv[2], ffv[3]}; *(LAS f32x4*)(FF + HGI(t, cg * 8 + 4)) = (f32x4){ffv[4], ffv[5], ffv[6], ffv[7]};
    *(LAS f32x4*)(FB + HGI(t, cg * 8)) = (f32x4){fbv[0], fbv[1], fbv[2], fbv[3]}; *(LAS f32x4*)(FB + HGI(t, cg * 8 + 4)) = (f32x4){fbv[4], fbv[5], fbv[6], fbv[7]};
    LDS_BAR();
    {
        const int wave = tid >> 6, lane = tid & 63, cl = lane & 15, seg = lane >> 4, dir = wave >> 2, col = 16 * (wave & 3) + cl;
        const LAS float* F = dir ? FB : FF; LAS float* A = dir ? AB : AF;
        float pre[16]; float run = 0.f;
#pragma unroll
        for (int i = 0; i < 16; ++i) { const int tt = dir ? 16 * seg + 15 - i : 16 * seg + i; run += __logf(F[HGI(tt, col)]); pre[i] = run; }
        const float T0 = __builtin_bit_cast(float, __builtin_amdgcn_ds_bpermute((cl + 0) << 2, __builtin_bit_cast(int, run)));
        const float T1 = __builtin_bit_cast(float, __builtin_amdgcn_ds_bpermute((cl + 16) << 2, __builtin_bit_cast(int, run)));
        const float T2 = __builtin_bit_cast(float, __builtin_amdgcn_ds_bpermute((cl + 32) << 2, __builtin_bit_cast(int, run)));
        const float T3 = __builtin_bit_cast(float, __builtin_amdgcn_ds_bpermute((cl + 48) << 2, __builtin_bit_cast(int, run)));
        const float off = dir ? ((seg < 1 ? T1 : 0.f) + (seg < 2 ? T2 : 0.f) + (seg < 3 ? T3 : 0.f)) : ((seg > 0 ? T0 : 0.f) + (seg > 1 ? T1 : 0.f) + (seg > 2 ? T2 : 0.f));
#pragma unroll
        for (int i = 0; i < 16; ++i) { const int tt = dir ? 16 * seg + 15 - i : 16 * seg + i; A[HGI(tt, col)] = off + pre[i]; }
    }
    LDS_BAR();
}
__device__ __forceinline__ bf16x8 ld2x64(const LAS unsigned char* p0, const LAS unsigned char* p1) {
    const u32x2 a = *(const LAS u32x2*)p0, b = *(const LAS u32x2*)p1; u32x4 r; r.x = a.x; r.y = a.y; r.z = b.x; r.w = b.y; return __builtin_bit_cast(bf16x8, r);
}
typedef short s16x4 __attribute__((ext_vector_type(4)));
__device__ __forceinline__ bf16x8 ld2tr(const LAS unsigned char* p0, const LAS unsigned char* p1) {
    const s16x4 a = __builtin_amdgcn_ds_read_tr16_b64_v4i16((LAS s16x4*)p0), b = __builtin_amdgcn_ds_read_tr16_b64_v4i16((LAS s16x4*)p1);
    return __builtin_shufflevector(a, b, 0, 1, 2, 3, 4, 5, 6, 7);
}
__device__ __forceinline__ f32x4 mfma16(bf16x8 a, bf16x8 b, f32x4 c) { return __builtin_amdgcn_mfma_f32_16x16x32_bf16(a, b, c, 0, 0, 0); }
__device__ __forceinline__ void phase_hgrn_local(const int tid, PRef p, int l, LAS unsigned char* lds) {
    LAS float* FF = (LAS float*)(lds + HG_FF); LAS float* FB = (LAS float*)(lds + HG_FB); LAS float* AF = (LAS float*)(lds + HG_AF); LAS float* AB = (LAS float*)(lds + HG_AB);
    LAS bf16_t* KTf = (LAS bf16_t*)(lds + HG_T0); LAS bf16_t* KTb = (LAS bf16_t*)(lds + HG_T0 + HG_TS); LAS bf16_t* VT = (LAS bf16_t*)(lds + HG_VT);
    const int t = tid >> 3, cg = tid & 7, wave = tid >> 6, lane = tid & 63, fr = lane & 15, fq = lane >> 4;
    u32x4 zf = (u32x4){0u, 0u, 0u, 0u}, zb = zf, v8 = zf, nzf = zf, nzb = zf, nv8 = zf;
    if ((int)blockIdx.x < NBH * NCH) { const int it = blockIdx.x, pc = it % NCH, bh = it / NCH, h = bh % HGH, b = bh / HGH;
        const bf16_t* pr = p.P + (size_t)(hg_row0(b, pc) + t) * INC + h * 64 + cg * 8; zf = *(const u32x4*)(pr + OFF_); zb = *(const u32x4*)(pr + OFB); v8 = *(const u32x4*)(pr + OHI); }
    hg_stage_lb(tid, p, l);
    for (int it = blockIdx.x; it < NBH * NCH; it += gridDim.x) {
        const int pc = it % NCH, bh = it / NCH, h = bh % HGH, b = bh / HGH, row0 = hg_row0(b, pc);
        { const int it2 = min(it + (int)gridDim.x, NBH * NCH - 1); const int pc2 = it2 % NCH, bh2 = it2 / NCH, h2 = bh2 % HGH, b2 = bh2 / HGH;
            const bf16_t* pr = p.P + (size_t)(hg_row0(b2, pc2) + t) * INC + h2 * 64 + cg * 8; nzf = *(const u32x4*)(pr + OFF_); nzb = *(const u32x4*)(pr + OFB); nv8 = *(const u32x4*)(pr + OHI); }
        hg_gates(tid, p, l, h, zf, zb, lds);
        {
            float f8[8], a8[8], e8[8], g8[8], b8[8], h8[8];
            HGLD8(f8, FF, t, cg * 8); HGLD8(a8, AF, t, cg * 8); HGLD8(e8, AF, 63, cg * 8); HGLD8(g8, FB, t, cg * 8); HGLD8(b8, AB, t, cg * 8); HGLD8(h8, AB, 0, cg * 8);
            float kf[8], kb[8];
#pragma unroll
            for (int j = 0; j < 8; ++j) { kf[j] = (1.f - f8[j]) * __expf(e8[j] - a8[j]); kb[j] = (1.f - g8[j]) * __expf(h8[j] - b8[j]); }
            u32x4 wf, wb; wf.x = cvt_pk_bf16(kf[0], kf[1]); wf.y = cvt_pk_bf16(kf[2], kf[3]); wf.z = cvt_pk_bf16(kf[4], kf[5]); wf.w = cvt_pk_bf16(kf[6], kf[7]);
            wb.x = cvt_pk_bf16(kb[0], kb[1]); wb.y = cvt_pk_bf16(kb[2], kb[3]); wb.z = cvt_pk_bf16(kb[4], kb[5]); wb.w = cvt_pk_bf16(kb[6], kb[7]);
            *(LAS u32x4*)(lds + HG_VT + t * 144 + cg * 16) = v8; *(LAS u32x4*)(lds + HG_T0 + t * 144 + cg * 16) = wf; *(LAS u32x4*)(lds + HG_T0 + HG_TS + t * 144 + cg * 16) = wb;
        }
        if (tid < 64) p.GDEC[((size_t)(0 * NBH + bh) * NCH + pc) * 64 + tid] = __expf(AF[HGI(63, tid)]);
        else if (tid < 128) p.GDEC[((size_t)(1 * NBH + bh) * NCH + pc) * 64 + (tid - 64)] = __expf(AB[HGI(0, tid - 64)]);
        LDS_BAR();
#if HGRN_DIAG == 4
        {
            const int v = tid >> 3, kg = tid & 7;
            for (int dir = 0; dir < 2; ++dir) {
                const LAS bf16_t* KT = (const LAS bf16_t*)(lds + HG_T0 + dir * HG_TS);
                float acc[8];
#pragma unroll
                for (int j = 0; j < 8; ++j) acc[j] = 0.f;
                for (int s_ = 0; s_ < 64; ++s_) { const float vv = bf2f(VT[v * 72 + s_]);
#pragma unroll
                    for (int j = 0; j < 8; ++j) acc[j] += bf2f(KT[(kg * 8 + j) * 72 + s_]) * vv; }
                bf16_t* dst = p.SLOC + ((size_t)(dir * NBH + bh) * NCH + pc) * 4096 + v * 64 + kg * 8;
#pragma unroll
                for (int j = 0; j < 8; ++j) dst[j] = f2bf(acc[j]);
            }
        }
#else
        {
            const int dir = wave >> 2, mt = wave & 3;
            const LAS unsigned char* KT = lds + HG_T0 + dir * HG_TS;
            const int trb = (8 * fq + (fr >> 2)) * 144 + 8 * (fr & 3);
            bf16x8 a[2];
#pragma unroll
            for (int ks = 0; ks < 2; ++ks) { const LAS unsigned char* ar = KT + trb + ks * (32 * 144) + mt * 32; a[ks] = ld2tr(ar, ar + 4 * 144); }
            bf16_t* dst = p.SLOC + ((size_t)(dir * NBH + bh) * NCH + pc) * 4096;
            u32x2 w[4];
#pragma unroll
            for (int nt = 0; nt < 4; ++nt) {
                f32x4 acc = (f32x4){0.f, 0.f, 0.f, 0.f};
#pragma unroll
                for (int ks = 0; ks < 2; ++ks) { const LAS unsigned char* br = lds + HG_VT + trb + ks * (32 * 144) + nt * 32; acc = mfma16(a[ks], ld2tr(br, br + 4 * 144), acc); }
                w[nt].x = cvt_pk_bf16(acc[0], acc[1]); w[nt].y = cvt_pk_bf16(acc[2], acc[3]);
            }
            zf = nzf; zb = nzb; v8 = nv8;
            asm volatile("" ::: "memory");
#pragma unroll
            for (int nt = 0; nt < 4; ++nt) *(u32x2*)(dst + (nt * 16 + fr) * 64 + mt * 16 + 4 * fq) = w[nt];
        }
#endif
        LDS_BAR();
    }
}
__device__ __forceinline__ void phase_hgrn_scan(const int tid, PRef p) {
    constexpr int GS = 20, NG = NCH / GS;
    static_assert(NCH % GS == 0 && NCHC < GS, "scan group size");
    for (int blk = (int)gridDim.x - 1 - (int)blockIdx.x; blk < 2 * NBH * 4; blk += gridDim.x) {
        const int sq = blk >> 2, part = blk & 3, dir = sq / NBH, e0 = part * 1024 + tid * 2, k = e0 & 63;
        unsigned* S = (unsigned*)(p.SLOC + (size_t)sq * NCH * 4096 + e0);
        const float* G = p.GDEC + (size_t)sq * NCH * 64 + k;
        float c0 = 0.f, c1 = 0.f;
        const long sstep = dir ? -2048L : 2048L, gstep = dir ? -64L : 64L;
        unsigned* Sl = S + (size_t)(dir ? NCHC - 1 : 0) * 2048; const float* Gl = G + (size_t)(dir ? NCHC - 1 : 0) * 64; unsigned* Sw = Sl;
        unsigned* S2 = S + (size_t)(dir ? NCH - 1 : NCHC) * 2048; const float* G2 = G + (size_t)(dir ? NCH - 1 : NCHC) * 64;
        unsigned nx[2][GS]; f32x2 gn[2][GS];
#define HG_LD(set, j, u) do { nx[set][u] = *Sl; gn[set][u] = *(const f32x2*)Gl; if ((j) + 1 == NCHC) { Sl = S2; Gl = G2; } else { Sl += sstep; Gl += gstep; } } while (0)
#pragma unroll
        for (int u = 0; u < GS; ++u) HG_LD(0, u, u);
#pragma unroll
        for (int g = 0; g < NG; ++g) {
            asm volatile("" : "+v"(Sl), "+v"(Gl), "+v"(Sw));
            if (g + 1 < NG) {
#pragma unroll
                for (int u = 0; u < GS; ++u) HG_LD((g + 1) & 1, (g + 1) * GS + u, u);
            }
            unsigned w[GS];
#pragma unroll
            for (int u = 0; u < GS; ++u) {
                w[u] = cvt_pk_bf16(c0, c1);
                c0 = gn[g & 1][u][0] * c0 + bfw(nx[g & 1][u], 0); c1 = gn[g & 1][u][1] * c1 + bfw(nx[g & 1][u], 1);
            }
#pragma unroll
            for (int u = 0; u < GS; ++u) { *Sw = w[u]; if (g * GS + u + 1 == NCHC) Sw = S2; else Sw += sstep; }
        }
#undef HG_LD
    }
}
__device__ __forceinline__ void phase_hgrn_out(const int tid, PRef p, int l, LAS unsigned char* lds) {
    const int NCHO = (l + 1 < DEPTH) ? NCH : NCH - NCHC, PC0 = NCH - NCHO;
    LAS float* FF = (LAS float*)(lds + HG_FF); LAS float* FB = (LAS float*)(lds + HG_FB); LAS float* AF = (LAS float*)(lds + HG_AF); LAS float* AB = (LAS float*)(lds + HG_AB);
    LAS bf16_t* VT = (LAS bf16_t*)(lds + HG_VT);
    LAS float* OO = (LAS float*)(lds + HG_AF);
    const int t = tid >> 3, cg = tid & 7, wave = tid >> 6, lane = tid & 63, fr = lane & 15, fq = lane >> 4;
    u32x4 zf = (u32x4){0u, 0u, 0u, 0u}, zb = zf, v8 = zf, q8 = zf, g8 = zf, nzf = zf, nzb = zf, nv8 = zf, nq8 = zf, ng8 = zf;
    bf16x8 bsin[4][2], nbsin[4][2];
#define HG_LOADSIN(dst, bhx, pcx) do { const bf16_t* SIN_ = p.SLOC + ((size_t)((wave >> 2) * NBH + (bhx)) * NCH + (pcx)) * 4096; \
        _Pragma("unroll") for (int vt = 0; vt < 4; ++vt) _Pragma("unroll") for (int ks = 0; ks < 2; ++ks) dst[vt][ks] = *(const bf16x8*)(SIN_ + (vt * 16 + fr) * 64 + ks * 32 + fq * 8); } while (0)
#pragma unroll
    for (int vt = 0; vt < 4; ++vt) { bsin[vt][0] = (bf16x8){0, 0, 0, 0, 0, 0, 0, 0}; bsin[vt][1] = bsin[vt][0]; nbsin[vt][0] = bsin[vt][0]; nbsin[vt][1] = bsin[vt][0]; }
    if ((int)blockIdx.x < NBH * NCHO) { const int it = blockIdx.x, pc = it % NCHO + PC0, bh = it / NCHO, h = bh % HGH, b = bh / HGH;
        const bf16_t* pr = p.P + (size_t)(hg_row0(b, pc) + t) * INC + h * 64 + cg * 8; zf = *(const u32x4*)(pr + OFF_); zb = *(const u32x4*)(pr + OFB); v8 = *(const u32x4*)(pr + OHI); q8 = *(const u32x4*)(pr + OHQ); g8 = *(const u32x4*)(pr + OHG_);
        HG_LOADSIN(bsin, bh, pc); }
    hg_stage_lb(tid, p, l);
    f32x4 hn0, hn1; { const float* nwp = p.hg_norm + l * 64 + cg * 8; hn0 = *(const f32x4*)nwp; hn1 = *(const f32x4*)(nwp + 4); }
    for (int it = blockIdx.x; it < NBH * NCHO; it += gridDim.x) {
        const int pc = it % NCHO + PC0, bh = it / NCHO, h = bh % HGH, b = bh / HGH, row0 = hg_row0(b, pc);
        { const int it2 = min(it + (int)gridDim.x, NBH * NCHO - 1); const int pc2 = it2 % NCHO + PC0, bh2 = it2 / NCHO, h2 = bh2 % HGH, b2 = bh2 / HGH;
            const bf16_t* pr = p.P + (size_t)(hg_row0(b2, pc2) + t) * INC + h2 * 64 + cg * 8; nzf = *(const u32x4*)(pr + OFF_); nzb = *(const u32x4*)(pr + OFB); nv8 = *(const u32x4*)(pr + OHI); nq8 = *(const u32x4*)(pr + OHQ); ng8 = *(const u32x4*)(pr + OHG_);
            HG_LOADSIN(nbsin, bh2, pc2); }
        hg_gates(tid, p, l, h, zf, zb, lds);
        {
            float w[6][8];
            float af8[8], ab8[8], rf8[8], rb8[8], ff8[8], fb8[8];
            HGLD8(af8, AF, t, cg * 8); HGLD8(ab8, AB, t, cg * 8); HGLD8(rf8, AF, 31, cg * 8); HGLD8(rb8, AB, 32, cg * 8); HGLD8(ff8, FF, t, cg * 8); HGLD8(fb8, FB, t, cg * 8);
#pragma unroll
            for (int j = 0; j < 8; ++j) {
                const int k = cg * 8 + j;
                const float qv = bf8(q8, j) * 0.125f, af = af8[j], ab = ab8[j], rf = rf8[j], rb = rb8[j];
                w[0][j] = qv * __expf(fminf(af - rf, 80.f)); w[1][j] = (1.f - ff8[j]) * __expf(fminf(rf - af, 80.f)); w[2][j] = qv * __expf(af);
                w[3][j] = qv * __expf(fminf(ab - rb, 80.f)); w[4][j] = (1.f - fb8[j]) * __expf(fminf(rb - ab, 80.f)); w[5][j] = qv * __expf(ab);
            }
            *(LAS u32x4*)(lds + HG_VT + t * 144 + cg * 16) = v8;
#pragma unroll
            for (int a = 0; a < 6; ++a) { u32x4 o; o.x = cvt_pk_bf16(w[a][0], w[a][1]); o.y = cvt_pk_bf16(w[a][2], w[a][3]); o.z = cvt_pk_bf16(w[a][4], w[a][5]); o.w = cvt_pk_bf16(w[a][6], w[a][7]);
                *(LAS u32x4*)(lds + HG_T0 + a * HG_TS + t * 144 + cg * 16) = o; }
        }
        LDS_BAR();
        {
            const int dir = wave >> 2, tt = wave & 3;
            const LAS unsigned char* QT = lds + HG_T0 + (dir * 3 + 0) * HG_TS; const LAS unsigned char* KL = lds + HG_T0 + (dir * 3 + 1) * HG_TS; const LAS unsigned char* QH = lds + HG_T0 + (dir * 3 + 2) * HG_TS;
            bf16x8 bq[2], bh[2];
#pragma unroll
            for (int ks = 0; ks < 2; ++ks) { bq[ks] = *(const LAS bf16x8*)(QT + (tt * 16 + fr) * 144 + ks * 64 + fq * 16); bh[ks] = *(const LAS bf16x8*)(QH + (tt * 16 + fr) * 144 + ks * 64 + fq * 16); }
            f32x4 o[4];
#pragma unroll
            for (int vt = 0; vt < 4; ++vt) { o[vt] = (f32x4){0.f, 0.f, 0.f, 0.f};
#pragma unroll
                for (int ks = 0; ks < 2; ++ks) o[vt] = mfma16(bsin[vt][ks], bh[ks], o[vt]); }
            const int t_ = 16 * tt + fr;
#pragma unroll
            for (int kp = 0; kp < 2; ++kp) {
                f32x4 sc[2];
#pragma unroll
                for (int hf = 0; hf < 2; ++hf) { const int st = 2 * kp + hf;
                    sc[hf] = (f32x4){0.f, 0.f, 0.f, 0.f};
                    if (dir ? st >= tt : st <= tt) {
#pragma unroll
                        for (int ks = 0; ks < 2; ++ks) { const bf16x8 a = *(const LAS bf16x8*)(KL + (st * 16 + fr) * 144 + ks * 64 + fq * 16); sc[hf] = mfma16(a, bq[ks], sc[hf]); }
#pragma unroll
                        for (int r = 0; r < 4; ++r) { const int s_ = 16 * st + 4 * fq + r; const bool keep = dir ? (s_ >= t_) : (s_ <= t_); sc[hf][r] = keep ? sc[hf][r] : 0.f; }
                    } }
                if (dir ? (2 * kp + 1 >= tt) : (2 * kp <= tt)) {
                    u32x4 pw; pw.x = cvt_pk_bf16(sc[0][0], sc[0][1]); pw.y = cvt_pk_bf16(sc[0][2], sc[0][3]); pw.z = cvt_pk_bf16(sc[1][0], sc[1][1]); pw.w = cvt_pk_bf16(sc[1][2], sc[1][3]);
                    const bf16x8 pf = __builtin_bit_cast(bf16x8, pw);
                    const int s0 = 32 * kp + 4 * fq;
#pragma unroll
                    for (int vt = 0; vt < 4; ++vt) { const LAS unsigned char* vr = lds + HG_VT + (32 * kp + 4 * fq + (fr >> 2)) * 144 + 8 * (fr & 3) + vt * 32;
                        o[vt] = mfma16(ld2tr(vr, vr + 16 * 144), pf, o[vt]); }
                }
            }
            LAS float* OOd = (LAS float*)(lds + (dir ? HG_FB : HG_FF));
#pragma unroll
            for (int vt = 0; vt < 4; ++vt) *(LAS f32x4*)(OOd + HGI(t_, 16 * vt + 4 * fq)) = o[vt];
        }
        LDS_BAR();
        {
            float o[8]; float ss = 0.f;
            float of8[8], ob8[8]; HGLD8(of8, FF, t, cg * 8); HGLD8(ob8, FB, t, cg * 8);
#pragma unroll
            for (int j = 0; j < 8; ++j) { o[j] = of8[j] + ob8[j]; ss += o[j] * o[j]; }
            ss = oct_sum(ss);
            const float rstd = 1.f / sqrtf(ss * (1.f / 64.f) + EPS);
            float y[8];
#pragma unroll
            for (int j = 0; j < 8; ++j) { const float g = bf8(g8, j); y[j] = o[j] * rstd * (j < 4 ? hn0[j & 3] : hn1[j & 3]) * g * __builtin_amdgcn_rcpf(1.f + __expf(-g)); }
            u32x4 ov; ov.x = cvt_pk_bf16(y[0], y[1]); ov.y = cvt_pk_bf16(y[2], y[3]); ov.z = cvt_pk_bf16(y[4], y[5]); ov.w = cvt_pk_bf16(y[6], y[7]);
            zf = nzf; zb = nzb; v8 = nv8; q8 = nq8; g8 = ng8;
#pragma unroll
            for (int vt = 0; vt < 4; ++vt) { bsin[vt][0] = nbsin[vt][0]; bsin[vt][1] = nbsin[vt][1]; }
            asm volatile("" ::: "memory");
            *(u32x4*)(p.MIX + (size_t)(row0 + t) * MIXD + 384 + h * 64 + cg * 8) = ov;
        }
        LDS_BAR();
    }
}


#undef HG_LOADSIN
constexpr int AT_KC = 0, AT_VCT = 36864, AT_KL = AT_VCT + 256 * 144, AT_VL = AT_KL + 3 * 9216, AT_RPB = AT_VL + 3 * 9216, AT_END = AT_RPB + 1920;
static_assert(AT_END <= RING_BYTES && CTX == 256, "attention LDS layout (built for 256 context tokens)");
constexpr float ATHR = 6.f;
template <bool LOCAL, int NKB>
__device__ __forceinline__ void attn_scores(const LAS unsigned char* Kb, const bf16x8 (&qb)[2], f32x4 (&sc)[2 * NKB], int fr, int fq, const LAS float* rpb_row, const int (&boff)[8]) {
#pragma unroll
    for (int mt = 0; mt < 2 * NKB; ++mt) { sc[mt] = (f32x4){0.f, 0.f, 0.f, 0.f};
#pragma unroll
        for (int ks = 0; ks < 2; ++ks) { const bf16x8 a = *(const LAS bf16x8*)(Kb + (16 * mt + fr) * 144 + ks * 64 + fq * 16); sc[mt] = mfma16(a, qb[ks], sc[mt]); } }
    if (LOCAL) {
#pragma unroll
        for (int mt = 0; mt < 2 * NKB; ++mt)
#pragma unroll
            for (int r = 0; r < 4; ++r) sc[mt][r] += *(const LAS float*)((const LAS unsigned char*)rpb_row + boff[(4 * mt + r) & 7]);
    }
}
template <bool LOCAL, int NKB>
__device__ __forceinline__ void attn_spv(const f32x4 (&sc)[2 * NKB], const LAS unsigned char* Vb, f32x4 (&o)[4], float& m, float& lsum, int lane, int vtr) {
    float mx = -INFINITY;
#pragma unroll
    for (int mt = 0; mt < 2 * NKB; ++mt)
#pragma unroll
        for (int r = 0; r < 4; ++r) mx = fmaxf(mx, sc[mt][r]);
    if (__builtin_amdgcn_ballot_w64(mx > m + ATHR) != 0ull) {
        mx = fmaxf(mx, __builtin_bit_cast(float, __builtin_amdgcn_ds_swizzle(__builtin_bit_cast(int, mx), (16 << 10) | 0x1f)));
        mx = fmaxf(mx, __builtin_bit_cast(float, __builtin_amdgcn_ds_bpermute((lane ^ 32) << 2, __builtin_bit_cast(int, mx))));
        const float mn = fmaxf(m, mx), corr = __builtin_amdgcn_exp2f(m - mn);
        m = mn; lsum *= corr;
#pragma unroll
        for (int dt = 0; dt < 4; ++dt) o[dt] = o[dt] * corr;
    }
    float ps = 0.f;
#pragma unroll
    for (int kb = 0; kb < NKB; ++kb) {
        float pv[8];
#pragma unroll
        for (int h2 = 0; h2 < 2; ++h2)
#pragma unroll
            for (int r = 0; r < 4; ++r) { const float e = __builtin_amdgcn_exp2f(sc[2 * kb + h2][r] - m); pv[4 * h2 + r] = e; ps += e; }
        u32x4 pw; pw.x = cvt_pk_bf16(pv[0], pv[1]); pw.y = cvt_pk_bf16(pv[2], pv[3]); pw.z = cvt_pk_bf16(pv[4], pv[5]); pw.w = cvt_pk_bf16(pv[6], pv[7]);
        const bf16x8 pf = __builtin_bit_cast(bf16x8, pw);
#pragma unroll
        for (int dt = 0; dt < 4; ++dt) {
            const LAS unsigned char* vr = Vb + vtr + kb * (32 * 144) + dt * 32;
            o[dt] = mfma16(ld2tr(vr, vr + 16 * 144), pf, o[dt]);
        }
    }
    lsum += ps;
}
__device__ __forceinline__ void phase_attn(const int tid, PRef p, int l, LAS unsigned char* lds) {
    const int wave = tid >> 6, lane = tid & 63, fr = lane & 15, fq = lane >> 4, skey = tid >> 3, sc8 = tid & 7;
    LAS float* RPB = (LAS float*)(lds + AT_RPB);
    constexpr int NPAIR = ROWS / 2; const int IPB = NPAIR + ((l + 1 < DEPTH) ? 2 : 0);
    const int G_ = gridDim.x, NIT = NB * NAH * IPB;
#ifndef AT_DEAL_A
#define AT_DEAL_A 8
#define AT_DEAL_B 3
#endif
    const bool deal = (G_ == 256 && NIT <= 160 * AT_DEAL_A + 96 * AT_DEAL_B);
    const int it_lo = deal ? ((int)blockIdx.x < 160 ? (int)blockIdx.x * AT_DEAL_A : 160 * AT_DEAL_A + ((int)blockIdx.x - 160) * AT_DEAL_B) : (int)blockIdx.x;
    const int it_n = deal ? ((int)blockIdx.x < 160 ? AT_DEAL_A : AT_DEAL_B) : (NIT - (int)blockIdx.x + G_ - 1) / G_;
    int last_bh = -1;
#define AT_QTOK(itx) (((itx) % IPB) < NPAIR ? (((itx) / IPB) / NAH) * SEQ + (2 * ((itx) % IPB) + (wave >> 2)) * GW + 16 * (wave & 3) + fr : NLAT + (((itx) / IPB) / NAH) * CTX + ((((itx) % IPB) - NPAIR) * 128 + 16 * wave) + fr)
#define AT_LOADQ(itx, dst) do { const bf16_t* qp_ = p.P + (size_t)AT_QTOK(itx) * INC + OQ + (((itx) / IPB) % NAH) * 64 + fq * 8; dst[0] = *(const bf16x8*)qp_; dst[1] = *(const bf16x8*)(qp_ + 32); } while (0)
    bf16x8 qnx[2] = {(bf16x8){0, 0, 0, 0, 0, 0, 0, 0}, (bf16x8){0, 0, 0, 0, 0, 0, 0, 0}};
    { const int it0 = it_lo; if (it_n > 0 && it0 < NIT) AT_LOADQ(it0, qnx); }
    for (int ii = 0; ii < it_n; ++ii) {
        const int it = deal ? it_lo + ii : it_lo + ii * G_;
        if (it >= NIT) break;
        const int sub = it % IPB, bh = it / IPB, head = bh % NAH, b = bh / NAH;
        const bool islat = sub < NPAIR;
        const int r0 = 2 * sub, qr = r0 + (wave >> 2), jb = wave & 3;
        LDS_BAR();
        if (bh != last_bh) {
            last_bh = bh;
            int sc8l = sc8; asm volatile("" : "+v"(sc8l));
            for (int rnd = 0; rnd < 4; ++rnd) {
                const int key = skey + 64 * rnd; const bf16_t* src = p.P + (size_t)(NLAT + b * CTX + key) * INC + head * 64 + sc8l * 8;
                const u32x4 kv = *(const u32x4*)(src + OK_), vv = *(const u32x4*)(src + OV);
                *(LAS u32x4*)(lds + AT_KC + key * 144 + sc8 * 16) = kv; *(LAS u32x4*)(lds + AT_VCT + key * 144 + sc8 * 16) = vv;
            }
            { int t2 = tid; asm volatile("" : "+v"(t2));
              if (t2 < 15 * 32) RPB[t2] = (t2 & 31) < 31 ? p.rpb[((size_t)l * NAH + head) * 465 + (t2 >> 5) * 31 + (t2 & 31)] * 1.44269504089f : -INFINITY; }
        }
        const int qtok = islat ? b * SEQ + qr * GW + 16 * jb + fr : NLAT + b * CTX + ((sub - NPAIR) * 128 + 16 * wave) + fr;
        bf16x8 qb[2]; qb[0] = qnx[0]; qb[1] = qnx[1];
        { const int itn = deal ? it + 1 : it + G_; if (ii + 1 < it_n && itn < NIT) { int fr = (tid & 15); asm volatile("" : "+v"(fr)); AT_LOADQ(itn, qnx); } }
        int krlo = 0, krhi = -1, rs = 0;
        if (islat) { int a = r0 - 4; a = a < 0 ? 0 : (a > ROWS - 8 ? ROWS - 8 : a); int c = r0 + 1 - 4; c = c < 0 ? 0 : (c > ROWS - 8 ? ROWS - 8 : c); krlo = a; krhi = c + 7;
            rs = qr - 4; rs = rs < 0 ? 0 : (rs > ROWS - 8 ? ROWS - 8 : rs); }
        u32x4 kA = (u32x4){0u, 0u, 0u, 0u}, vA = kA, kB = kA, vB = kA, kC = kA, vC = kA;
        int skl = skey; asm volatile("" : "+v"(skl));
#define AT_LOADROW(row, kd, vd) do { const bf16_t* src_ = p.P + (size_t)(b * SEQ + (row) * GW + skl) * INC + head * 64 + sc8 * 8; kd = *(const u32x4*)(src_ + OK_); vd = *(const u32x4*)(src_ + OV); } while (0)
#define AT_STAGEROW(bufi, kd, vd) do { *(LAS u32x4*)(lds + AT_KL + (bufi) * 9216 + skey * 144 + sc8 * 16) = kd; *(LAS u32x4*)(lds + AT_VL + (bufi) * 9216 + skey * 144 + sc8 * 16) = vd; } while (0)
        if (islat) { AT_LOADROW(krlo, kA, vA); AT_LOADROW(krlo + 1, kB, vB); AT_LOADROW(krlo + 2, kC, vC); }
        f32x4 o[4]; float m = -1e30f, lsum = 0.f;
#pragma unroll
        for (int dt = 0; dt < 4; ++dt) o[dt] = (f32x4){0.f, 0.f, 0.f, 0.f};
        LDS_BAR();
        const int bs = jb == 0 ? 0 : (jb == 1 ? 8 : (jb == 2 ? 24 : 32)), qc = 16 * jb + fr;
        int boff[8];
        { int ws = qc - 8; ws = ws < 0 ? 0 : (ws > 48 ? 48 : ws);
#pragma unroll
          for (int j_ = 0; j_ < 8; ++j_) { const int kc = bs + 16 * (j_ >> 2) + 4 * fq + (j_ & 3); const bool ok = kc >= ws && kc < ws + 16; boff[j_] = (ok ? kc - qc + 15 : 31) * 4; asm volatile("" : "+v"(boff[j_])); } }
        int vtr = (4 * fq + (fr >> 2)) * 144 + 8 * (fr & 3); asm volatile("" : "+v"(vtr));
        const int vtrl = vtr + bs * 144;
        {
            f32x4 sa[4], sb[4];
#define AT_CS(st, dst) attn_scores<false, 2>(lds + AT_KC + (st) * 64 * 144, qb, dst, fr, fq, RPB, boff)
#define AT_CP(st, src) attn_spv<false, 2>(src, lds + AT_VCT + (st) * 64 * 144, o, m, lsum, lane, vtr)
            AT_CS(0, sa); AT_CS(1, sb); AT_CP(0, sa); AT_CS(2, sa); AT_CP(1, sb); AT_CS(3, sb); AT_CP(2, sa); AT_CP(3, sb);
#undef AT_CS
#undef AT_CP
        }
        if (islat) { AT_STAGEROW(0, kA, vA); AT_LOADROW(krlo + 3, kA, vA); AT_STAGEROW(1, kB, vB); AT_LOADROW(krlo + 4, kB, vB); }
        LDS_BAR();
        if (islat) {
            const bool first0 = rs == krlo, last8 = !first0;
            const LAS float* rp = RPB + (krlo - qr + 7) * 32;
            f32x4 sa[2], sb[2];
#define AT_S(j, dst) attn_scores<true, 1>(lds + AT_KL + ((j) % 3) * 9216 + bs * 144, qb, dst, fr, fq, rp + 32 * (j), boff)
#define AT_P(j, src) attn_spv<true, 1>(src, lds + AT_VL + ((j) % 3) * 9216, o, m, lsum, lane, vtrl)
#define AT_MID(j, NK, NV, LOADROWX, SCUR, SNXT) { AT_STAGEROW(((j) + 2) % 3, NK, NV); if ((LOADROWX) >= 0) { AT_LOADROW(min(krlo + (LOADROWX), krhi), NK, NV); } \
            AT_S((j) + 1, SNXT); AT_P(j, SCUR); LDS_BAR(); }
            sa[0] = (f32x4){0.f, 0.f, 0.f, 0.f}; sa[1] = sa[0];
            if (first0) AT_S(0, sa);
            { AT_STAGEROW(2, kC, vC); AT_LOADROW(krlo + 5, kC, vC); AT_S(1, sb); if (first0) AT_P(0, sa); LDS_BAR(); }
            AT_MID(1, kA, vA, 6, sb, sa) AT_MID(2, kB, vB, 7, sa, sb) AT_MID(3, kC, vC, 8, sb, sa) AT_MID(4, kA, vA, -1, sa, sb) AT_MID(5, kB, vB, -1, sb, sa) AT_MID(6, kC, vC, -1, sa, sb)
            if (last8) { AT_S(8, sa); AT_P(7, sb); AT_P(8, sa); } else { AT_P(7, sb); }
#undef AT_S
#undef AT_P
#undef AT_MID
        }
#undef AT_LOADROW
#undef AT_STAGEROW
        lsum = x32_sum(x16_sum(lsum, lane), lane);
        const float inv = 1.f / lsum;
        bf16_t* orow = p.MIX + (size_t)qtok * MIXD + head * 64;
#pragma unroll
        for (int dt = 0; dt < 4; ++dt) { u32x2 w; w.x = cvt_pk_bf16(o[dt][0] * inv, o[dt][1] * inv); w.y = cvt_pk_bf16(o[dt][2] * inv, o[dt][3] * inv); *(u32x2*)(orow + 16 * dt + 4 * fq) = w; }
    }
}


#undef AT_QTOK
#undef AT_LOADQ
template <int MODE> __device__ __forceinline__ void mini_gemm(const int tid, PRef p, int l) {
    const int wave = tid >> 6, lane = tid & 63, fr = lane & 15, fq = lane >> 4;
    const int gw = blockIdx.x * NWAVES + wave, NGW = gridDim.x * NWAVES;
    constexpr int K = MODE == 3 ? ED : (MODE == 1 ? MIXD : D);
    constexpr int N = MODE == 0 ? INC : (MODE == 2 ? 2 * ED : D);
    constexpr int MROWS = MODE <= 1 ? NCTX : NSLOT_C;
    constexpr int NTC = MODE == 2 ? 2 : 1, TW = 16 * NTC;
    constexpr int NTN = N / TW, NT = (MROWS / 32) * NTN;
    for (int t = gw; t < NT; t += NGW) {
        const int rt = t / NTN, ct = t % NTN, c0 = ct * TW;
        const bf16_t* Bt; const bf16_t* arow[2];
        if (MODE == 0) { Bt = p.WIN_T + WBOFF(l); for (int mt = 0; mt < 2; ++mt) arow[mt] = p.H + (size_t)(NLAT + rt * 32 + 16 * mt + fr) * D; }
        else if (MODE == 1) { Bt = p.WOUT_T + WBOFF(l); for (int mt = 0; mt < 2; ++mt) arow[mt] = p.MIX + (size_t)(NLAT + rt * 32 + 16 * mt + fr) * MIXD; }
        else if (MODE == 2) { const int e = rt % NE; Bt = p.WGU_T + WBOFF(l) + (size_t)e * 2 * ED * D;
            for (int mt = 0; mt < 2; ++mt) { int row = p.STOK[NSLOT_L + rt * 32 + 16 * mt + fr]; row = row < 0 ? 0 : (row >= NTOK ? NTOK - 1 : row); arow[mt] = p.H + (size_t)row * D; } }
        else { const int e = rt % NE; Bt = p.WD_T + WBOFF(l) + (size_t)e * D * ED; for (int mt = 0; mt < 2; ++mt) arow[mt] = p.HID + (size_t)(NSLOT_L + rt * 32 + 16 * mt + fr) * ED; }
        const bf16_t* brow = Bt + (size_t)(c0 + fr) * K;
        f32x4 acc[2][NTC];
#pragma unroll
        for (int mt = 0; mt < 2; ++mt)
#pragma unroll
            for (int nt = 0; nt < NTC; ++nt) acc[mt][nt] = (f32x4){0.f, 0.f, 0.f, 0.f};
#pragma unroll 8
        for (int ks = 0; ks < K / 32; ++ks) {
            bf16x8 a[2], bfr[NTC];
#pragma unroll
            for (int mt = 0; mt < 2; ++mt) a[mt] = *(const bf16x8*)(arow[mt] + ks * 32 + fq * 8);
#pragma unroll
            for (int nt = 0; nt < NTC; ++nt) bfr[nt] = *(const bf16x8*)(brow + (size_t)(16 * nt) * K + ks * 32 + fq * 8);
#pragma unroll
            for (int mt = 0; mt < 2; ++mt)
#pragma unroll
                for (int nt = 0; nt < NTC; ++nt) acc[mt][nt] = mfma16(a[mt], bfr[nt], acc[mt][nt]);
        }
#pragma unroll
        for (int mt = 0; mt < 2; ++mt)
#pragma unroll
            for (int r = 0; r < 4; ++r) {
                const int lr = rt * 32 + 16 * mt + 4 * fq + r;
                if (MODE == 0) { bf16_t* o = p.P + (size_t)(NLAT + lr) * INC + c0 + fr;
#pragma unroll
                    for (int nt = 0; nt < NTC; ++nt) o[16 * nt] = f2bf(acc[mt][nt][r]); }
                else if (MODE == 1) { float* o = p.XC + (size_t)lr * D + c0 + fr; const float* g = p.MOD + ((size_t)l * 3 + 2) * NMOD + 2 * D + c0 + fr;
#pragma unroll
                    for (int nt = 0; nt < NTC; ++nt) o[16 * nt] += g[16 * nt] * acc[mt][nt][r]; }
                else if (MODE == 2) { bf16_t* o = p.HID + (size_t)(NSLOT_L + lr) * ED + c0 / 2 + fr;
#pragma unroll
                    for (int q = 0; q < NTC / 2; ++q) { const float g = acc[mt][2 * q][r], u = acc[mt][2 * q + 1][r]; o[16 * q] = f2bf(g / (1.f + __expf(-g)) * u); } }
                else { bf16_t* o = p.Y + (size_t)(NSLOT_L + lr) * D + c0 + fr; const float val = p.SVAL[NSLOT_L + lr];
#pragma unroll
                    for (int nt = 0; nt < NTC; ++nt) o[16 * nt] = f2bf(val * acc[mt][nt][r]); }
            }
    }
}


__device__ __forceinline__ void phase_conv(const int tid, PRef p, int l) {
    const float* w = p.conv_w + (size_t)l * 3 * CVD;
    constexpr int U = 2;
    const long nitem = (long)NTOK * (CVD / 8), gstr = (long)gridDim.x * NTHR;
    for (long g0 = (long)blockIdx.x * NTHR + tid; g0 < nitem; g0 += gstr * U) {
        u32x4 cc[U][3], uu[U][3], bg[U]; float vz[U][3]; int rr[U], c8v[U]; bool ok[U];
#pragma unroll
        for (int u = 0; u < U; ++u) {
            long gid = g0 + u * gstr; ok[u] = gid < nitem; if (!ok[u]) gid = g0;
            const int r = (int)(gid / (CVD / 8)), c8 = (int)(gid % (CVD / 8)) * 8; rr[u] = r; c8v[u] = c8;
            int t, T; if (r < NLAT) { t = r % SEQ; T = SEQ; } else { t = (r - NLAT) % CTX; T = CTX; }
            const bf16_t* pr = p.P + (size_t)r * INC + c8;
#pragma unroll
            for (int d = 0; d < 3; ++d) { const int tt = t + d - 1; const bool in = tt >= 0 && tt < T; vz[u][d] = in ? 1.f : 0.f;
                const bf16_t* q = pr + (in ? (long)(d - 1) * INC : 0L); cc[u][d] = *(const u32x4*)(q + OCC); uu[u][d] = *(const u32x4*)(q + OCU); }
            bg[u] = *(const u32x4*)(pr + OCB);
        }
        asm volatile("" ::: "memory");
#pragma unroll
        for (int u = 0; u < U; ++u) {
            float y[8];
#pragma unroll
            for (int j = 0; j < 8; ++j) y[j] = 0.f;
#pragma unroll
            for (int d = 0; d < 3; ++d) {
                const f32x4 w0 = *(const f32x4*)(w + d * CVD + c8v[u]) * vz[u][d], w1 = *(const f32x4*)(w + d * CVD + c8v[u] + 4) * vz[u][d];
#pragma unroll
                for (int j = 0; j < 8; ++j) y[j] += (j < 4 ? w0[j & 3] : w1[j & 3]) * bf8(cc[u][d], j) * bf8(uu[u][d], j);
            }
            u32x4 o; o.x = cvt_pk_bf16(bf8(bg[u], 0) * y[0], bf8(bg[u], 1) * y[1]); o.y = cvt_pk_bf16(bf8(bg[u], 2) * y[2], bf8(bg[u], 3) * y[3]);
            o.z = cvt_pk_bf16(bf8(bg[u], 4) * y[4], bf8(bg[u], 5) * y[5]); o.w = cvt_pk_bf16(bf8(bg[u], 6) * y[6], bf8(bg[u], 7) * y[7]);
            if (ok[u]) *(u32x4*)(p.MIX + (size_t)rr[u] * MIXD + 768 + c8v[u]) = o;
        }
    }
}
__device__ __forceinline__ void phase_qkprep(const int tid, PRef p, int l) {
    const int sub = tid & 7;
    constexpr int U = 4;
    const long ngroups = (long)NTOK * 12, gstride = ((long)gridDim.x * NTHR) >> 3;
    for (long g0 = ((long)blockIdx.x * NTHR + tid) >> 3; g0 < ngroups; g0 += gstride * U) {
        u32x4 raw[U]; bf16_t* ptr[U]; int rr[U]; int wh[U];
#pragma unroll
        for (int u = 0; u < U; ++u) { long g8 = g0 + u * gstride; const bool ok = g8 < ngroups; if (!ok) g8 = g0;
            rr[u] = ok ? (int)(g8 / 12) : -1; wh[u] = (int)(g8 % 12) / 6; const int head = (int)(g8 % 6);
            ptr[u] = p.P + (size_t)(g8 / 12) * INC + (wh[u] ? OK_ : OQ) + head * HD + sub * 8; raw[u] = *(const u32x4*)ptr[u]; }
#pragma unroll
        for (int u = 0; u < U; ++u) {
            const float* nw = (wh[u] ? p.k_norm : p.q_norm) + l * HD + sub * 8;
            float y[8]; float ss = 0.f;
#pragma unroll
            for (int j = 0; j < 8; ++j) { y[j] = bf8(raw[u], j); ss += y[j] * y[j]; }
            ss = oct_sum(ss);
            const float rstd = 1.f / sqrtf(ss * (1.f / HD) + EPS);
#pragma unroll
            for (int j = 0; j < 8; ++j) y[j] = y[j] * rstd * nw[j];
            const int r = rr[u];
            const bool lat = r >= 0 && r < NLAT;
            const int t = lat ? r % SEQ : 0; const float pos = (sub & 4) ? (float)(t % GW) : (float)(t / GW);
            const bool second = (sub & 2) != 0;
#pragma unroll
            for (int j = 0; j < 8; ++j) {
                const float other = __builtin_bit_cast(float, __builtin_amdgcn_ds_swizzle(__builtin_bit_cast(int, y[j]), (2 << 10) | 0x1f));
                const int fi = (sub & 1) * 8 + j;
                const float ang = pos * __builtin_amdgcn_exp2f(-(float)fi * (13.287712379549449f / 16.f));
                const float cs = FCOS(ang), sn = FSIN(ang);
                const float rot = second ? y[j] * cs + other * sn : y[j] * cs - other * sn;
                y[j] = lat ? rot : y[j];
            }
            if (r >= 0) { u32x4 o; o.x = cvt_pk_bf16(y[0], y[1]); o.y = cvt_pk_bf16(y[2], y[3]); o.z = cvt_pk_bf16(y[4], y[5]); o.w = cvt_pk_bf16(y[6], y[7]); *(u32x4*)ptr[u] = o; }
        }
    }
}

__device__ __forceinline__ f32x4 bf4(const u32x2 w) { return (f32x4){bfw(w.x, 0), bfw(w.x, 1), bfw(w.y, 0), bfw(w.y, 1)}; }
template <int MODE> __device__ __forceinline__ void phase_rows(const int tid, PRef p, int l, LAS unsigned char* lds) {
    static_assert(D == 1024, "wave-per-row kernels assume D = 1024");
    const int lane = tid & 63, wave = tid >> 6;
#define RC(j) (8 * lane + 512 * ((j) >> 1) + 4 * ((j) & 1))
    if (MODE == 1) {
        for (int k = tid; k < D; k += NTHR) { const f32x4* src = (const f32x4*)(p.w_router + ((size_t)l * D + k) * NE); LAS f32x4* dst = (LAS f32x4*)(lds + k * 64 + (k >> 3) * 16);
#pragma unroll
            for (int u = 0; u < 4; ++u) dst[u] = src[u]; }
        __syncthreads();
    }
    const int gw = blockIdx.x * NWAVES + wave, NGW = gridDim.x * NWAVES;
    const int rw = ((NTOK + NGW - 1) / NGW + 1) & ~1;
    const int r_lo = gw * rw, r_hi = min(NTOK, r_lo + rw);
    const bool doh = MODE != 2 || l + 1 < DEPTH;
    const int ln = (MODE == 2 && l + 1 < DEPTH) ? l + 1 : l;
    const float* nw = (MODE == 1 ? p.norm2_w : p.norm1_w) + (size_t)ln * D;
    int curset = -1; f32x4 Av[4], Sv[4], Gv[4];
#pragma unroll
    for (int j = 0; j < 4; ++j) { Av[j] = (f32x4){0.f, 0.f, 0.f, 0.f}; Sv[j] = Av[j]; Gv[j] = Av[j]; }
    constexpr int NVN = MODE == 0 ? 4 : 2;
    u32x4 vn[2][NVN]; int invn[2] = {-1, -1};
#define ROWS_LOADPAIR(rb) do { _Pragma("unroll") for (int i_ = 0; i_ < 2; ++i_) { const int rr_ = ((rb) + i_ < r_hi) ? (rb) + i_ : (rb); \
        if (MODE == 0) { const float* src_ = rr_ < NLAT ? p.x + (size_t)rr_ * D : p.ctx + (size_t)(rr_ - NLAT) * D; \
            _Pragma("unroll") for (int j_ = 0; j_ < NVN; ++j_) vn[i_][j_] = *(const u32x4*)(src_ + RC(j_)); } \
        else if (rr_ < NLAT) { const bf16_t* src_ = p.XB + (size_t)rr_ * D + 8 * lane; vn[i_][0] = *(const u32x4*)src_; vn[i_][1] = *(const u32x4*)(src_ + 512); } \
        if (MODE == 2) invn[i_] = lane < NE ? p.INV[(size_t)rr_ * NE + lane] : -1; } } while (0)
#pragma unroll
    for (int i = 0; i < 2; ++i)
#pragma unroll
        for (int j = 0; j < NVN; ++j) vn[i][j] = (u32x4){0u, 0u, 0u, 0u};
    if (r_lo < r_hi) ROWS_LOADPAIR(r_lo);
#pragma unroll 1
    for (int r = r_lo; r < r_hi; r += 2) {
        const bool two = r + 1 < r_hi;
        const bool lat = r < NLAT;
        const int set = modset(r);
        if (set != curset) { curset = set;
            const float* mod = p.MOD + ((size_t)ln * 3 + set) * NMOD; const float* shift = mod + (MODE == 1 ? 3 : 0) * D; const float* scale = mod + (MODE == 1 ? 4 : 1) * D;
            int lane2 = lane; asm volatile("" : "+v"(lane2));
#pragma unroll
            for (int j = 0; j < 4; ++j) { const int c = 8 * lane2 + 512 * (j >> 1) + 4 * (j & 1); const f32x4 w4 = *(const f32x4*)(nw + c), sc4 = *(const f32x4*)(scale + c); Av[j] = w4 * (sc4 + 1.f); Sv[j] = *(const f32x4*)(shift + c);
                if (MODE == 2) Gv[j] = *(const f32x4*)(p.MOD + ((size_t)l * 3 + set) * NMOD + 5 * D + c); } }
        f32x4 v[2][4]; int inv2[2];
#pragma unroll
        for (int i = 0; i < 2; ++i) { inv2[i] = invn[i];
            if (MODE == 0) {
#pragma unroll
                for (int j = 0; j < 4; ++j) v[i][j] = __builtin_bit_cast(f32x4, vn[i][j < NVN ? j : 0]);
            } else if (lat) {
#pragma unroll
                for (int jj = 0; jj < 2; ++jj) { const u32x4 w = vn[i][jj]; v[i][2 * jj] = (f32x4){bfw(w.x, 0), bfw(w.x, 1), bfw(w.y, 0), bfw(w.y, 1)}; v[i][2 * jj + 1] = (f32x4){bfw(w.z, 0), bfw(w.z, 1), bfw(w.w, 0), bfw(w.w, 1)}; }
            } else { const float* src = p.XC + (size_t)(r + ((i == 0 || two) ? i : 0) - NLAT) * D;
#pragma unroll
                for (int j = 0; j < 4; ++j) v[i][j] = *(const f32x4*)(src + RC(j));
            } }
        if (r + 2 < r_hi) ROWS_LOADPAIR(r + 2);
        if (MODE == 2) {
            unsigned long long mk[2]; int sl[2][2];
#pragma unroll
            for (int i = 0; i < 2; ++i) { const int myinv = inv2[i]; mk[i] = __ballot(myinv >= 0 && myinv < NSLOT);
#pragma unroll
                for (int c = 0; c < 2; ++c) { sl[i][c] = -1; if (mk[i]) { const int e = __builtin_ctzll(mk[i]); mk[i] &= mk[i] - 1; sl[i][c] = __builtin_amdgcn_readlane(myinv, e); } } }
            u32x4 y[2][2][2];
#pragma unroll
            for (int i = 0; i < 2; ++i)
#pragma unroll
                for (int c = 0; c < 2; ++c) { y[i][c][0] = (u32x4){0u, 0u, 0u, 0u}; y[i][c][1] = y[i][c][0];
                    if (sl[i][c] >= 0) { const bf16_t* yp = p.Y + (size_t)sl[i][c] * D + 8 * lane; y[i][c][0] = *(const u32x4*)yp; y[i][c][1] = *(const u32x4*)(yp + 512); } }
            asm volatile("" ::: "memory");
#pragma unroll
            for (int i = 0; i < 2; ++i) {
                f32x4 acc[4];
#pragma unroll
                for (int j = 0; j < 4; ++j) acc[j] = (f32x4){0.f, 0.f, 0.f, 0.f};
#pragma unroll
                for (int c = 0; c < 2; ++c)
#pragma unroll
                    for (int jj = 0; jj < 2; ++jj) { const u32x4 w = y[i][c][jj];
                        acc[2 * jj] = acc[2 * jj] + (f32x4){bfw(w.x, 0), bfw(w.x, 1), bfw(w.y, 0), bfw(w.y, 1)}; acc[2 * jj + 1] = acc[2 * jj + 1] + (f32x4){bfw(w.z, 0), bfw(w.z, 1), bfw(w.w, 0), bfw(w.w, 1)}; }
                const int myinv = inv2[i];
                while (mk[i]) {
                    const int e = __builtin_ctzll(mk[i]); mk[i] &= mk[i] - 1; const int s0 = __builtin_amdgcn_readlane(myinv, e);
                    const bf16_t* yp = p.Y + (size_t)s0 * D + 8 * lane; const u32x4 w0 = *(const u32x4*)yp, w1 = *(const u32x4*)(yp + 512);
                    acc[0] = acc[0] + (f32x4){bfw(w0.x, 0), bfw(w0.x, 1), bfw(w0.y, 0), bfw(w0.y, 1)}; acc[1] = acc[1] + (f32x4){bfw(w0.z, 0), bfw(w0.z, 1), bfw(w0.w, 0), bfw(w0.w, 1)};
                    acc[2] = acc[2] + (f32x4){bfw(w1.x, 0), bfw(w1.x, 1), bfw(w1.y, 0), bfw(w1.y, 1)}; acc[3] = acc[3] + (f32x4){bfw(w1.z, 0), bfw(w1.z, 1), bfw(w1.w, 0), bfw(w1.w, 1)};
                }
#pragma unroll
                for (int j = 0; j < 4; ++j) v[i][j] = v[i][j] + Gv[j] * acc[j];
            }
        }
        if (MODE == 0 || MODE == 2) {
            const bool fin = MODE == 2 && l + 1 == DEPTH;
#pragma unroll
            for (int i = 0; i < 2; ++i) if (i == 0 || two) {
                if (lat && !fin) {
#pragma unroll
                    for (int jj = 0; jj < 2; ++jj) { u32x4 o; o.x = cvt_pk_bf16(v[i][2 * jj][0], v[i][2 * jj][1]); o.y = cvt_pk_bf16(v[i][2 * jj][2], v[i][2 * jj][3]); o.z = cvt_pk_bf16(v[i][2 * jj + 1][0], v[i][2 * jj + 1][1]); o.w = cvt_pk_bf16(v[i][2 * jj + 1][2], v[i][2 * jj + 1][3]);
                        *(u32x4*)(p.XB + (size_t)(r + i) * D + 8 * lane + 512 * jj) = o; }
                } else if (lat || !fin) { float* dst = lat ? p.XL + (size_t)(r + i) * D : p.XC + (size_t)(r + i - NLAT) * D;
#pragma unroll
                    for (int j = 0; j < 4; ++j) *(f32x4*)(dst + RC(j)) = v[i][j]; }
            }
        }
        if (doh) {
            float ss[2];
#pragma unroll
            for (int i = 0; i < 2; ++i) { float a = 0.f;
#pragma unroll
                for (int j = 0; j < 4; ++j) a += (v[i][j][0] * v[i][j][0] + v[i][j][1] * v[i][j][1]) + (v[i][j][2] * v[i][j][2] + v[i][j][3] * v[i][j][3]);
                ss[i] = a; }
            ss[0] = wave_sum(ss[0], lane); ss[1] = wave_sum(ss[1], lane);
            const float rstd0 = 1.f / sqrtf(ss[0] * (1.f / D) + EPS), rstd1 = 1.f / sqrtf(ss[1] * (1.f / D) + EPS);
            f32x4 hh[2][4];
#pragma unroll
            for (int j = 0; j < 4; ++j) { hh[0][j] = v[0][j] * rstd0 * Av[j] + Sv[j]; hh[1][j] = v[1][j] * rstd1 * Av[j] + Sv[j]; }
#pragma unroll
            for (int i = 0; i < 2; ++i) if (i == 0 || two) {
#pragma unroll
                for (int jj = 0; jj < 2; ++jj) { u32x4 o; o.x = cvt_pk_bf16(hh[i][2 * jj][0], hh[i][2 * jj][1]); o.y = cvt_pk_bf16(hh[i][2 * jj][2], hh[i][2 * jj][3]); o.z = cvt_pk_bf16(hh[i][2 * jj + 1][0], hh[i][2 * jj + 1][1]); o.w = cvt_pk_bf16(hh[i][2 * jj + 1][2], hh[i][2 * jj + 1][3]);
                    *(u32x4*)(p.H + (size_t)(r + i) * D + 8 * lane + 512 * jj) = o; } }
            if (MODE == 1) {
                LAS float* red = (LAS float*)(lds + 70144 + wave * 4224);
                LAS float* red1 = (LAS float*)(wave < 6 ? lds + 103936 + wave * 4224 : lds + LDSCTL_OFF + 1024 + (wave - 6) * 4224);
                const LAS unsigned char* wb = lds + lane * 528;
#pragma unroll
                for (int u = 0; u < 4; ++u) {
                    f32x4 a0 = (f32x4){0.f, 0.f, 0.f, 0.f}, a1 = a0;
#pragma unroll
                    for (int j = 0; j < 4; ++j)
#pragma unroll
                        for (int q = 0; q < 4; ++q) { const f32x4 w = *(const LAS f32x4*)(wb + (j >> 1) * 33792 + (4 * (j & 1) + q) * 64 + u * 16); const float h0 = hh[0][j][q], h1 = hh[1][j][q];
                            a0 = __builtin_elementwise_fma(w, (f32x4){h0, h0, h0, h0}, a0); a1 = __builtin_elementwise_fma(w, (f32x4){h1, h1, h1, h1}, a1); }
#pragma unroll
                    for (int c = 0; c < 4; ++c) { red[(4 * u + c) * 65 + lane] = a0[c]; red1[(4 * u + c) * 65 + lane] = a1[c]; }
                    asm volatile("" ::: "memory");
                }
#pragma unroll
                for (int i = 0; i < 2; ++i) {
                    const LAS float* rd = i ? red1 : red;
                    const int e2 = lane & 15, part = lane >> 4;
                    float t = 0.f;
#pragma unroll
                    for (int x = 0; x < 16; ++x) t += rd[e2 * 65 + part * 16 + x];
                    asm volatile("" ::: "memory");
                    t = x32_sum(x16_sum(t, lane), lane);
#define SWZF(x, d) __builtin_bit_cast(float, __builtin_amdgcn_ds_swizzle(__builtin_bit_cast(int, (x)), ((d) << 10) | 0x1f))
                    float m = t;
                    m = row16_max(m);
                    const float ex = expf(t - m); float sm = ex;
                    sm = row16_sum(sm);
#undef SWZF
                    if (lane < NE && (i == 0 || two)) p.AFF[(size_t)(r + i) * NE + lane] = ex / sm;
                }
            }
        }
    }
#undef ROWS_LOADPAIR
#undef RC
    if (MODE == 1) __syncthreads();
}


__device__ __forceinline__ void phase_adaln(const int tid, PRef p, LAS unsigned char* lds) {
    static_assert(D == 1024 && NMOD % 256 == 0, "adaln layout");
    const int lane = tid & 63, wave = tid >> 6;
    LAS float* SC = (LAS float*)lds;
    LAS float* RED = (LAS float*)(lds + 16384);
    for (int i = tid; i < 3 * D; i += NTHR) { const int st = i / D, k = i % D; const float cv = st < 2 ? p.c[st * D + k] : p.c_ctx[k]; SC[i] = cv / (1.f + __expf(-cv)); }
    __syncthreads();
    constexpr int NCG = NMOD / 256;
    for (int item = blockIdx.x; item < DEPTH * NCG * 2; item += gridDim.x) {
        const int l = item / (NCG * 2), rem = item % (NCG * 2), cgp = rem >> 1, kh = rem & 1;
        const int kbase = kh * 512 + wave * 64;
        const float* wp = p.w_mod + ((size_t)l * D + kbase) * NMOD + cgp * 256 + 4 * lane;
        f32x4 acc[3];
#pragma unroll
        for (int st = 0; st < 3; ++st) acc[st] = (f32x4){0.f, 0.f, 0.f, 0.f};
#pragma unroll 16
        for (int kk = 0; kk < 64; ++kk) { const f32x4 w = *(const f32x4*)(wp + (size_t)kk * NMOD);
#pragma unroll
            for (int st = 0; st < 3; ++st) acc[st] = acc[st] + w * SC[st * D + kbase + kk]; }
#pragma unroll
        for (int st = 0; st < 3; ++st) *(LAS f32x4*)(RED + (wave * 3 + st) * 256 + 4 * lane) = acc[st];
        __syncthreads();
        for (int o = tid; o < 3 * 256; o += NTHR) { const int st = o >> 8, n = o & 255; float v = 0.f;
#pragma unroll
            for (int w8 = 0; w8 < 8; ++w8) v += RED[(w8 * 3 + st) * 256 + n];
            if (kh == 0) v += p.b_mod[(size_t)l * NMOD + cgp * 256 + n];
            atomicAdd(p.MOD + ((size_t)l * 3 + st) * NMOD + cgp * 256 + n, v); }
        __syncthreads();
    }
}

constexpr int NPL = 11, NPH = 1 + DEPTH * NPL;
struct Args { Params p; int ph_lo, ph_hi; };
__global__ void __launch_bounds__(NTHR, 2) mega_fwd(Args args) {
    LAS unsigned char* lds = (LAS unsigned char*)lds_raw;
    {
        const int tid0 = threadIdx.x;
        for (int u = tid0; u < (LDS_BYTES - LDSCTL_OFF) / 4; u += NTHR) ((LAS unsigned*)(lds + LDSCTL_OFF))[u] = 0u;
        __syncthreads();
    }
    int wslot = 0;
    { unsigned m_ = ~0u; asm volatile("" : "+s"(m_));
      const int simd = (int)(__builtin_amdgcn_s_getreg((1 << 11) | (4 << 6) | 4) & 3u);
      if (__builtin_amdgcn_mbcnt_hi(m_, __builtin_amdgcn_mbcnt_lo(m_, 0u)) == 0) wslot = simd + 4 * (int)__hip_atomic_fetch_add(((unsigned*)(lds_raw + MISC_OFF + 64)) + simd, 1u, __ATOMIC_RELAXED, __HIP_MEMORY_SCOPE_WORKGROUP); }
    wslot = __builtin_amdgcn_readfirstlane(wslot) & 7;
#define MY_TID(var) int var; { unsigned m_ = ~0u; asm volatile("" : "+s"(m_)); var = wslot * 64 + (int)__builtin_amdgcn_mbcnt_hi(m_, __builtin_amdgcn_mbcnt_lo(m_, 0u)); } asm volatile("" : "+v"(var))
    XcdBarrier bar; bar.bar = args.p.CTL; bar.x = 0;
    const bool multi = args.ph_hi - args.ph_lo > 1;
    if (multi) { MY_TID(t0); bar = xcd_barrier_post(args.p.CTL, t0 == 0); }
    const int G = gridDim.x;
    const int ph_lo = args.ph_lo, ph_hi = args.ph_hi;
#ifndef PHMASK
#define PHMASK 0xFFFF
#endif
#define PH_ON(k) ((k) == 0 ? (PHMASK & 1) : ((PHMASK >> (1 + ((k) - 1) % NPL)) & 1))
#ifndef REPMASK
#define REPMASK 0
#endif
#ifndef REP_LOCAL
#define REP_LOCAL 0
#define REP_CONV 0
#define REP_ATTN 0
#endif
#ifndef HG_STOP
#define HG_STOP 0
#endif
#ifndef REP_P0
#define REP_P0 0
#endif
#define REP_N(k) (((k) == 0 && REP_P0) ? 2 : (((k) > 0 && ((REPMASK >> (((k) - 1) % NPL)) & 1)) ? 2 : 1))
#define PH_BEGIN(k) if (PH_ON(k) && ph_lo <= (k) && (k) < ph_hi) { for (int rep_ = 0; rep_ < REP_N(k); ++rep_) { const AS4 Args* kp = (const AS4 Args*)__builtin_amdgcn_kernarg_segment_ptr(); asm volatile("" : "+s"(kp)); PRef p = kp->p; MY_TID(tid);
#define PH_END_IF(k, cond) } if ((cond) && (k) + 1 < ph_hi) { MY_TID(t1); xcd_barrier(bar, t1 == 0, XB_ST(lds_raw)); } }
#ifndef REP_CVT
#define REP_CVT 0
#endif
#ifndef REP_BAR
#define REP_BAR 0
#endif
#define PH_END(k) } if ((k) + 1 < ph_hi) { for (int rb_ = 0; rb_ < 1 + REP_BAR; ++rb_) { MY_TID(t1); xcd_barrier(bar, t1 == 0, XB_ST(lds_raw)); } } }
    PH_BEGIN(0)
        phase_adaln(tid, p, lds);
        run_items<b_lb>(tid, p, 0, 2L * 384, 0);
        phase_convert(tid, p, 0, lds, 1, 0);
    PH_END(0)
#define LAYER(l)                                                                                                                                     \
    PH_BEGIN(1 + (l) * NPL + 0) if ((l) == 0) { phase_rows<0>(tid, p, 0, lds); } PH_END_IF(1 + (l) * NPL + 0, (l) == 0)                                 \
    PH_BEGIN(1 + (l) * NPL + 1) {                                                                                                                    \
        pg8::Gemm g{p.H, p.WIN_T + WBOFF(l), NTOK, INC, D, nullptr, 0, 1, 0}; pg8::StaticOrder S; S.init(NTOK, INC, G, (int)blockIdx.x);                         \
        pg8::EpiP E{p.P, INC, p.q_norm + (l) * HD, p.k_norm + (l) * HD, rep_};                                                    \
        pg8::gemm_phase<pg8::EpiP, false>(tid, lds, g, S, E);                                                                                     \
        } PH_END(1 + (l) * NPL + 1)               \
    PH_BEGIN(1 + (l) * NPL + 2) if constexpr (!FUSE_QK) { phase_qkprep(tid, p, l); } if constexpr (FAST_HGRN && (HGRN_DIAG == 3 || HGRN_DIAG == 4)) { phase_hgrn_local(tid, p, l, lds); { MY_TID(t7); run_items<b_hgrn_local_slow>(t7, p, l, 2L * NBH * NCH * 64, 0); } } else if constexpr (FAST_HGRN && HGRN_DIAG >= 2) { run_items<b_hgrn_local_slow>(tid, p, l, 2L * NBH * NCH * 64, 0); } else if constexpr (FAST_HGRN) { for (int r2_ = 0; r2_ < 1 + REP_LOCAL; ++r2_) phase_hgrn_local(tid, p, l, lds); } else { run_items<b_gates>(tid, p, l, (long)NTOK * 768, 0); } phase_conv(tid, p, l); PH_END(1 + (l) * NPL + 2) \
    PH_BEGIN(1 + (l) * NPL + 3) if constexpr (FAST_HGRN && HGRN_DIAG) { run_items<b_hgrn_scan_slow>(tid, p, l, 2L * NBH * 4096, 0); } else if constexpr (FAST_HGRN) { phase_hgrn_scan(tid, p); } else { run_items<b_hgrn_seq2>(tid, p, l, 2L * NB * HGH * 64, 0); } if constexpr (FAST_ATTN) { for (int r4_ = 0; r4_ < 1 + REP_ATTN; ++r4_) { MY_TID(t6); phase_attn(t6, p, l, lds); } } else { run_items<b_attn>(tid, p, l, (long)NTOK * NAH, 0); } PH_END(1 + (l) * NPL + 3) \
    PH_BEGIN(1 + (l) * NPL + 4) if constexpr (FAST_HGRN && HGRN_DIAG) { run_items<b_hgrn_chunkseq>(tid, p, l, 2L * NBH * NCH * 64, 0); { MY_TID(t9); xcd_barrier(bar, t9 == 0, XB_ST(lds_raw)); } { MY_TID(t8); run_items<b_hgfin>(t8, p, l, (long)NTOK * HGH, 0); } } else if constexpr (FAST_HGRN) { phase_hgrn_out(tid, p, l, lds); } else { run_items<b_hgfin>(tid, p, l, (long)NTOK * HGH, 0); } PH_END(1 + (l) * NPL + 4)                                         \
    PH_BEGIN(1 + (l) * NPL + 5) {                                                                                                                    \
        pg8::Gemm g{p.MIX, p.WOUT_T + WBOFF(l), NLAT, D, MIXD, nullptr, 0, 1, 0}; pg8::StaticOrder S; S.init(NLAT, D, G, (int)blockIdx.x);                       \
        pg8::EpiRes E{p.XB, D, p.MOD + (size_t)(l) * 3 * NMOD + 2 * D, SEQ, (size_t)NMOD};                                                           \
        pg8::gemm_phase<pg8::EpiRes, false>(tid, lds, g, S, E);                                                                                      \
        if ((l) + 1 < DEPTH) { MY_TID(tid2); mini_gemm<1>(tid2, p, l); } } PH_END(1 + (l) * NPL + 5)                  \
    PH_BEGIN(1 + (l) * NPL + 6) phase_rows<1>(tid, p, l, lds); PH_END(1 + (l) * NPL + 6)                                                               \
    PH_BEGIN(1 + (l) * NPL + 7) if constexpr (FAST_TOPK) { phase_topk(tid, p, lds); if ((l) == 0 && gridDim.x > 2 * NB * NE + 32) { MY_TID(t4); phase_convert(t4, p, 0, lds, 2, 2 * NB * NE); } else if ((l) == 0) { MY_TID(t4); phase_convert(t4, p, 0, lds, 2, 0); } else if ((l) + 1 < DEPTH) { MY_TID(t4); phase_convert(t4, p, (l) + 1, lds, 0, gridDim.x > 2 * NB * NE + 32 ? 2 * NB * NE : 0); } } else { run_items<b_rank>(tid, p, l, (long)NTOK * NE, 0); } PH_END(1 + (l) * NPL + 7)                                          \
    PH_BEGIN(1 + (l) * NPL + 8) {                                                                                                                    \
        pg8::Gemm g{p.H, p.WGU_T + WBOFF(l), NSLOT_L, 2 * ED, D, p.STOK, CAPL / 256, NE, (size_t)2 * ED * D * 2}; pg8::StaticOrder S; S.init(NSLOT_L, 2 * ED, G, (int)blockIdx.x); \
        pg8::EpiHid E{p.HID, ED};                                                                                                                    \
        pg8::gemm_phase<pg8::EpiHid, true>(tid, lds, g, S, E);                                                                                       \
        if ((l) + 1 < DEPTH) { MY_TID(tid2); mini_gemm<2>(tid2, p, l); } } PH_END(1 + (l) * NPL + 8)              \
    PH_BEGIN(1 + (l) * NPL + 9) {                                                                                                                    \
        pg8::Gemm g{p.HID, p.WD_T + WBOFF(l), NSLOT_L, D, ED, nullptr, CAPL / 256, NE, (size_t)D * ED * 2}; pg8::StaticOrder S; S.init(NSLOT_L, D, G, (int)blockIdx.x); \
        pg8::EpiBf16 E{p.Y, D, p.SVAL, 0};                                                                                                              \
        pg8::gemm_phase<pg8::EpiBf16, false>(tid, lds, g, S, E);                                                                                     \
        if ((l) + 1 < DEPTH) { MY_TID(tid2); mini_gemm<3>(tid2, p, l); } } PH_END(1 + (l) * NPL + 9)                \
    PH_BEGIN(1 + (l) * NPL + 10) phase_rows<2>(tid, p, l, lds); if ((l) == 0) { for (int rc_ = 0; rc_ < 1 + REP_CVT; ++rc_) { MY_TID(t5); phase_convert(t5, p, (l) + 1, lds); } }        PH_END(1 + (l) * NPL + 10)
#ifndef NLAYERS_BUILD
#define NLAYERS_BUILD DEPTH
#endif
    LAYER(0)
    if constexpr (NLAYERS_BUILD > 1) { LAYER(1) }
    if constexpr (NLAYERS_BUILD > 2) { LAYER(2) }
    if constexpr (NLAYERS_BUILD > 3) { LAYER(3) }
}

#ifndef MK_SPLIT
#define MK_SPLIT 0
#endif
extern "C" void kernel_launch(void* const* d_in, const int* in_sizes, int n_in, void* d_out, int out_size, void* d_ws, size_t ws_size,
                              hipStream_t stream) {
    static int grid = 0;
    if (grid == 0) {
        if (n_in != 20 || out_size != NLAT * D || ws_size < WS_END) { fprintf(stderr, "kernel_launch: unexpected problem (n_in %d out %d ws %zu need %zu)\n", n_in, out_size, ws_size, (size_t)WS_END); grid = -1; return; }
        int dev = 0, cus = 0;
        if (hipGetDevice(&dev) != hipSuccess || hipDeviceGetAttribute(&cus, hipDeviceAttributeMultiprocessorCount, dev) != hipSuccess) { grid = -1; return; }
        if (hipFuncSetAttribute((const void*)mega_fwd, hipFuncAttributeMaxDynamicSharedMemorySize, LDS_BYTES) != hipSuccess) { fprintf(stderr, "kernel_launch: hipFuncSetAttribute failed\n"); grid = -1; return; }
        int per_cu = 0;
        if (hipOccupancyMaxActiveBlocksPerMultiprocessor(&per_cu, (const void*)mega_fwd, NTHR, LDS_BYTES) != hipSuccess || per_cu < 1) { fprintf(stderr, "kernel_launch: occupancy query says %d\n", per_cu); }
        (void)hipGetLastError();
        grid = cus;
    }
    if (grid < 0) return;
    (void)hipMemsetAsync((char*)d_ws + WS_CTL, 0, WS_LB - WS_CTL, stream);
    Args a{};
    a.p = make_params(d_in, d_out, d_ws);
#if MK_SPLIT
    for (int ph = 0; ph < NPH; ++ph) { a.ph_lo = ph; a.ph_hi = ph + 1; hipLaunchKernelGGL(mega_fwd, dim3(grid), dim3(NTHR), LDS_BYTES, stream, a); }
#else
    a.ph_lo = 0; a.ph_hi = NPH;
    hipLaunchKernelGGL(mega_fwd, dim3(grid), dim3(NTHR), LDS_BYTES, stream, a);
#endif
}
#endif
```

```cpp
#ifndef CPU_SIM
#include <hip/hip_runtime.h>
#define BODY __device__ __forceinline__
#define FSIN(x) __sinf(x)
#define FCOS(x) __cosf(x)
#else
#include <cmath>
#include <cstdio>
#include <cstdlib>
#include <cstring>
#define BODY static inline
#define FSIN(x) sinf(x)
#define FCOS(x) cosf(x)
#endif
#include <stdint.h>
#include <stddef.h>

#ifndef CFG_D
#define CFG_D 1024
#define CFG_SEQ 16384
#define CFG_CTX 256
#define CFG_EDIM 512
#define CFG_DEPTH 4
#endif

typedef unsigned short bf16_t;

constexpr int D = CFG_D, NB = 2, SEQ = CFG_SEQ, DEPTH = CFG_DEPTH, GW = 64, ROWS = SEQ / GW, CTX = CFG_CTX;
constexpr int HD = 64, NAH = 6, HGH = 6, CVD = 256, MIXD = 1024, INC = 3840, NMOD = 6 * D;
constexpr int NE = 16, ED = CFG_EDIM, CAPL = 2 * SEQ / NE, CAPC = 2 * CTX / NE;
constexpr int NLAT = NB * SEQ, NCTX = NB * CTX, NTOK = NLAT + NCTX;
constexpr int NSLOT_L = NB * NE * CAPL, NSLOT_C = NB * NE * CAPC, NSLOT = NSLOT_L + NSLOT_C;
constexpr int OQ = 0, OK_ = 384, OV = 768, OHQ = 1152, OFF_ = 1536, OFB = 1920, OHI = 2304, OHG_ = 2688, OCB = 3072, OCC = 3328, OCU = 3584;
constexpr float EPS = 1e-6f;
constexpr int NCH = (CTX + SEQ) / 64, NCHC = CTX / 64, NBH = NB * HGH;

struct Params {
    const float *x, *c, *ctx, *c_ctx, *w_mod, *b_mod, *norm1_w, *w_in, *q_norm, *k_norm, *rpb, *lb_logits, *hg_norm, *conv_w, *w_out,
        *norm2_w, *w_router, *w_gate, *w_up, *w_down;
    float *XL, *XC, *MOD, *LB, *AFF, *SVAL, *FG, *OHG;
    bf16_t *H, *P, *MIX, *HID, *Y;
    int *STOK, *INV;
    bf16_t *WIN_T, *WOUT_T, *WGU_T, *WD_T;
    unsigned* CTL;
    bf16_t* SLOC;
    float* GDEC;
    bf16_t* XB;
};

#ifndef CPU_SIM
#define AS4 __attribute__((address_space(4)))
typedef const AS4 Params& PRef;
#else
typedef const Params& PRef;
#endif
BODY float bf2f(bf16_t v) { return __builtin_bit_cast(float, (unsigned)v << 16); }
BODY bf16_t f2bf(float f) { unsigned u = __builtin_bit_cast(unsigned, f); u += 0x7fffu + ((u >> 16) & 1u); return (bf16_t)(u >> 16); }
BODY float silu_f(float x) { return x / (1.f + expf(-x)); }
BODY float sigmoid_f(float x) { return 1.f / (1.f + expf(-x)); }
BODY int modset(int r) { return r < NLAT ? r / SEQ : 2; }
BODY float* xrow(PRef p, int r) { return r < NLAT ? p.XL + (size_t)r * D : p.XC + (size_t)(r - NLAT) * D; }

BODY void b_adaln(long gid, PRef p, int) {
    const int n = (int)(gid % NMOD), s = (int)((gid / NMOD) % 3), l = (int)(gid / (3 * NMOD));
    const float* cv = s < 2 ? p.c + s * D : p.c_ctx;
    const float* w = p.w_mod + (size_t)l * D * NMOD + n;
    float acc = 0.f;
    for (int k = 0; k < D; ++k) acc += silu_f(cv[k]) * w[(size_t)k * NMOD];
    p.MOD[gid] = acc + p.b_mod[l * NMOD + n];
}
BODY void b_lb(long gid, PRef p, int) {
    const int dir = (int)(gid / 384), j = (int)(gid % 384);
    const float* lg = p.lb_logits + (size_t)dir * DEPTH * 384 + j;
    float m = -INFINITY;
    for (int l = 0; l < DEPTH; ++l) m = fmaxf(m, lg[l * 384]);
    float s = 0.f;
    for (int l = 0; l < DEPTH; ++l) s += expf(lg[l * 384] - m);
    float cum = 0.f;
    p.LB[(dir * DEPTH + 0) * 384 + j] = 0.f;
    for (int l = 1; l < DEPTH; ++l) { cum += expf(lg[l * 384] - m) / s; p.LB[(dir * DEPTH + l) * 384 + j] = cum; }
}
BODY void b_copyx(long gid, PRef p, int) {
    if (gid < (long)NLAT * D) p.XL[gid] = p.x[gid]; else p.XC[gid - (long)NLAT * D] = p.ctx[gid - (long)NLAT * D];
}
template <int WHICH> BODY void b_prenorm(long gid, PRef p, int l) {
    const int r = (int)gid;
    const float* xr = xrow(p, r);
    const float* nw = (WHICH ? p.norm2_w : p.norm1_w) + l * D;
    const float* mod = p.MOD + ((size_t)l * 3 + modset(r)) * NMOD;
    const float* shift = mod + (WHICH ? 3 : 0) * D;
    const float* scale = mod + (WHICH ? 4 : 1) * D;
    float ss = 0.f;
    for (int k = 0; k < D; ++k) ss += xr[k] * xr[k];
    const float rstd = 1.f / sqrtf(ss / D + EPS);
    float lg[NE];
#pragma unroll
    for (int e = 0; e < NE; ++e) lg[e] = 0.f;
    for (int k = 0; k < D; ++k) {
        const float h = xr[k] * rstd * nw[k] * (1.f + scale[k]) + shift[k];
        p.H[(size_t)r * D + k] = f2bf(h);
        if (WHICH) {
            const float* wr = p.w_router + ((size_t)l * D + k) * NE;
#pragma unroll
            for (int e = 0; e < NE; ++e) lg[e] += h * wr[e];
        }
    }
    if (WHICH) {
        float m = lg[0];
#pragma unroll
        for (int e = 1; e < NE; ++e) m = fmaxf(m, lg[e]);
        float s = 0.f;
#pragma unroll
        for (int e = 0; e < NE; ++e) { lg[e] = expf(lg[e] - m); s += lg[e]; }
#pragma unroll
        for (int e = 0; e < NE; ++e) p.AFF[(size_t)r * NE + e] = lg[e] / s;
    }
}
BODY void b_gemm_in(long gid, PRef p, int l) {
    const int r = (int)(gid / (INC / 4)), n = (int)(gid % (INC / 4)) * 4;
    const bf16_t* a = p.H + (size_t)r * D;
    const float* w = p.w_in + (size_t)l * D * INC + n;
    float a0 = 0.f, a1 = 0.f, a2 = 0.f, a3 = 0.f;
    for (int k = 0; k < D; ++k) { const float av = bf2f(a[k]); const float* wk = w + (size_t)k * INC; a0 += av * wk[0]; a1 += av * wk[1]; a2 += av * wk[2]; a3 += av * wk[3]; }
    bf16_t* o = p.P + (size_t)r * INC + n;
    o[0] = f2bf(a0); o[1] = f2bf(a1); o[2] = f2bf(a2); o[3] = f2bf(a3);
}
BODY void b_qkprep(long gid, PRef p, int l) {
    const int r = (int)(gid / 12), which = (int)(gid % 12) / 6, head = (int)(gid % 6);
    bf16_t* ptr = p.P + (size_t)r * INC + (which ? OK_ : OQ) + head * HD;
    const float* nw = (which ? p.k_norm : p.q_norm) + l * HD;
    float y[HD];
    float ss = 0.f;
#pragma unroll
    for (int d = 0; d < HD; ++d) { y[d] = bf2f(ptr[d]); ss += y[d] * y[d]; }
    const float rstd = 1.f / sqrtf(ss / HD + EPS);
#pragma unroll
    for (int d = 0; d < HD; ++d) y[d] = y[d] * rstd * nw[d];
    if (r < NLAT) {
        const int t = r % SEQ; const float row = (float)(t / GW), col = (float)(t % GW);
#pragma unroll
        for (int d = 0; d < 16; ++d) {
            const float inv = powf(10000.f, -(float)d / 16.f);
            const float ar = row * inv, ac = col * inv;
            const float cr = FCOS(ar), sr = FSIN(ar), cc = FCOS(ac), sc = FSIN(ac);
            const float x0 = y[d], x1 = y[d + 16], x2 = y[d + 32], x3 = y[d + 48];
            y[d] = x0 * cr - x1 * sr; y[d + 16] = x1 * cr + x0 * sr; y[d + 32] = x2 * cc - x3 * sc; y[d + 48] = x3 * cc + x2 * sc;
        }
    }
#pragma unroll
    for (int d = 0; d < HD; ++d) ptr[d] = f2bf(y[d]);
}
BODY void b_attn(long gid, PRef p, int l) {
    const int r = (int)(gid / NAH), head = (int)(gid % NAH);
    float q[HD], acc[HD];
    const bf16_t* qp = p.P + (size_t)r * INC + OQ + head * HD;
#pragma unroll
    for (int d = 0; d < HD; ++d) { q[d] = bf2f(qp[d]) * 0.125f; acc[d] = 0.f; }
    float m = -INFINITY, s = 0.f;
    const int b = r < NLAT ? r / SEQ : (r - NLAT) / CTX;
    const int nloc = r < NLAT ? 128 : 0;
    int row = 0, col = 0, rs = 0, ws = 0;
    if (r < NLAT) { const int t = r % SEQ; row = t / GW; col = t % GW; rs = row - 4; rs = rs < 0 ? 0 : (rs > ROWS - 8 ? ROWS - 8 : rs); ws = col - 8; ws = ws < 0 ? 0 : (ws > GW - 16 ? GW - 16 : ws); }
    for (int j = 0; j < nloc + CTX; ++j) {
        int kr; float bias = 0.f;
        if (j < nloc) { const int i = j / 16, jj = j % 16; kr = b * SEQ + (rs + i) * GW + ws + jj; bias = p.rpb[(((size_t)l * NAH + head) * 15 + (rs + i - row + 7)) * 31 + (ws + jj - col + 15)]; }
        else kr = NLAT + b * CTX + (j - nloc);
        const bf16_t* kp = p.P + (size_t)kr * INC + OK_ + head * HD;
        const bf16_t* vp = p.P + (size_t)kr * INC + OV + head * HD;
        float sc = 0.f;
#pragma unroll
        for (int d = 0; d < HD; ++d) sc += q[d] * bf2f(kp[d]);
        sc += bias;
        const float mn = fmaxf(m, sc), corr = expf(m - mn), pj = expf(sc - mn);
        s = s * corr + pj;
#pragma unroll
        for (int d = 0; d < HD; ++d) acc[d] = acc[d] * corr + pj * bf2f(vp[d]);
        m = mn;
    }
    const float inv = 1.f / s;
    bf16_t* o = p.MIX + (size_t)r * MIXD + head * HD;
#pragma unroll
    for (int d = 0; d < HD; ++d) o[d] = f2bf(acc[d] * inv);
}
BODY void b_gates(long gid, PRef p, int l) {
    const int j = (int)(gid % 384), dir = (int)((gid / 384) % 2), r = (int)(gid / 768);
    const float z = bf2f(p.P[(size_t)r * INC + (dir ? OFB : OFF_) + j]);
    const float lbv = p.LB[(dir * DEPTH + l) * 384 + j];
    p.FG[gid] = lbv + (1.f - lbv) * sigmoid_f(z);
}
template <int DIR> BODY void b_hgrn_seq(long gid, PRef p, int) {
    const int v = (int)(gid % 64), h = (int)((gid / 64) % HGH), b = (int)(gid / (64 * HGH));
    float S[64];
#pragma unroll
    for (int k = 0; k < 64; ++k) S[k] = 0.f;
    for (int step = 0; step < CTX + SEQ; ++step) {
        int r;
        if (step < CTX) r = NLAT + b * CTX + (DIR ? CTX - 1 - step : step);
        else r = b * SEQ + (DIR ? SEQ - 1 - (step - CTX) : (step - CTX));
        const float vv = bf2f(p.P[(size_t)r * INC + OHI + h * 64 + v]);
        const float* fr = p.FG + ((size_t)r * 2 + DIR) * 384 + h * 64;
        const bf16_t* qr = p.P + (size_t)r * INC + OHQ + h * 64;
        float o = 0.f;
#pragma unroll
        for (int k = 0; k < 64; ++k) { const float f = fr[k]; S[k] = f * S[k] + (1.f - f) * vv; o += S[k] * bf2f(qr[k]); }
        o *= 0.125f;
        p.OHG[((size_t)DIR * NTOK + r) * 384 + h * 64 + v] = o;
    }
}
BODY void b_hgfin(long gid, PRef p, int l) {
    const int r = (int)(gid / HGH), h = (int)(gid % HGH);
    const float* op = p.OHG + (size_t)r * 384 + h * 64;
    const float* op1 = op + (size_t)NTOK * 384;
    float o[64]; float ss = 0.f;
#pragma unroll
    for (int v = 0; v < 64; ++v) { o[v] = op[v] + op1[v]; ss += o[v] * o[v]; }
    const float rstd = 1.f / sqrtf(ss / 64.f + EPS);
    const bf16_t* g = p.P + (size_t)r * INC + OHG_ + h * 64;
    bf16_t* out = p.MIX + (size_t)r * MIXD + 384 + h * 64;
#pragma unroll
    for (int v = 0; v < 64; ++v) out[v] = f2bf(o[v] * rstd * p.hg_norm[l * 64 + v] * silu_f(bf2f(g[v])));
}
BODY void b_conv(long gid, PRef p, int l) {
    const int ch = (int)(gid % CVD), r = (int)(gid / CVD);
    int t, T;
    if (r < NLAT) { t = r % SEQ; T = SEQ; } else { t = (r - NLAT) % CTX; T = CTX; }
    const float* w = p.conv_w + (size_t)l * 3 * CVD + ch;
    float y = 0.f;
    for (int j = 0; j < 3; ++j) {
        const int tt = t + j - 1;
        if (tt < 0 || tt >= T) continue;
        const bf16_t* pr = p.P + (size_t)(r + j - 1) * INC;
        y += w[j * CVD] * bf2f(pr[OCC + ch]) * bf2f(pr[OCU + ch]);
    }
    p.MIX[(size_t)r * MIXD + 768 + ch] = f2bf(bf2f(p.P[(size_t)r * INC + OCB + ch]) * y);
}
BODY void b_gemm_out(long gid, PRef p, int l) {
    const int r = (int)(gid / (D / 4)), n = (int)(gid % (D / 4)) * 4;
    const bf16_t* a = p.MIX + (size_t)r * MIXD;
    const float* w = p.w_out + (size_t)l * MIXD * D + n;
    float a0 = 0.f, a1 = 0.f, a2 = 0.f, a3 = 0.f;
    for (int k = 0; k < MIXD; ++k) { const float av = bf2f(a[k]); const float* wk = w + (size_t)k * D; a0 += av * wk[0]; a1 += av * wk[1]; a2 += av * wk[2]; a3 += av * wk[3]; }
    const float* g = p.MOD + ((size_t)l * 3 + modset(r)) * NMOD + 2 * D + n;
    float* xr = xrow(p, r) + n;
    xr[0] += g[0] * a0; xr[1] += g[1] * a1; xr[2] += g[2] * a2; xr[3] += g[3] * a3;
}
BODY void b_rank(long gid, PRef p, int) {
    const int e = (int)(gid % NE), r = (int)(gid / NE);
    int t, T, row0, cap, base;
    if (r < NLAT) { const int b = r / SEQ; t = r % SEQ; T = SEQ; row0 = b * SEQ; cap = CAPL; base = (b * NE + e) * CAPL; }
    else { const int b = (r - NLAT) / CTX; t = (r - NLAT) % CTX; T = CTX; row0 = NLAT + b * CTX; cap = CAPC; base = NSLOT_L + (b * NE + e) * CAPC; }
    const float a = p.AFF[(size_t)r * NE + e];
    const float* col = p.AFF + (size_t)row0 * NE + e;
    int rank = 0;
    for (int tt = 0; tt < T; ++tt) { const float o = col[(size_t)tt * NE]; rank += (o > a || (o == a && tt < t)) ? 1 : 0; }
    if (rank < cap) { p.STOK[base + rank] = r; p.SVAL[base + rank] = a; p.INV[(size_t)r * NE + e] = base + rank; }
    else p.INV[(size_t)r * NE + e] = -1;
}
BODY int slot_expert(int s) { return s < NSLOT_L ? (s / CAPL) % NE : ((s - NSLOT_L) / CAPC) % NE; }
BODY void b_moe1(long gid, PRef p, int l) {
    const int s = (int)(gid / (ED / 4)), f = (int)(gid % (ED / 4)) * 4;
    const int e = slot_expert(s); int row = p.STOK[s]; row = row < 0 ? 0 : (row >= NTOK ? NTOK - 1 : row);
    const bf16_t* a = p.H + (size_t)row * D;
    const float* wg = p.w_gate + ((size_t)l * NE + e) * D * ED + f;
    const float* wu = p.w_up + ((size_t)l * NE + e) * D * ED + f;
    float g0 = 0.f, g1 = 0.f, g2 = 0.f, g3 = 0.f, u0 = 0.f, u1 = 0.f, u2 = 0.f, u3 = 0.f;
    for (int k = 0; k < D; ++k) {
        const float av = bf2f(a[k]); const float* gk = wg + (size_t)k * ED; const float* uk = wu + (size_t)k * ED;
        g0 += av * gk[0]; g1 += av * gk[1]; g2 += av * gk[2]; g3 += av * gk[3];
        u0 += av * uk[0]; u1 += av * uk[1]; u2 += av * uk[2]; u3 += av * uk[3];
    }
    bf16_t* o = p.HID + (size_t)s * ED + f;
    o[0] = f2bf(silu_f(g0) * u0); o[1] = f2bf(silu_f(g1) * u1); o[2] = f2bf(silu_f(g2) * u2); o[3] = f2bf(silu_f(g3) * u3);
}
BODY void b_moe2(long gid, PRef p, int l) {
    const int s = (int)(gid / (D / 4)), n = (int)(gid % (D / 4)) * 4;
    const int e = slot_expert(s);
    const bf16_t* a = p.HID + (size_t)s * ED;
    const float* w = p.w_down + ((size_t)l * NE + e) * ED * D + n;
    float a0 = 0.f, a1 = 0.f, a2 = 0.f, a3 = 0.f;
    for (int k = 0; k < ED; ++k) { const float av = bf2f(a[k]); const float* wk = w + (size_t)k * D; a0 += av * wk[0]; a1 += av * wk[1]; a2 += av * wk[2]; a3 += av * wk[3]; }
    const float val = p.SVAL[s];
    bf16_t* o = p.Y + (size_t)s * D + n;
    o[0] = f2bf(val * a0); o[1] = f2bf(val * a1); o[2] = f2bf(val * a2); o[3] = f2bf(val * a3);
}
BODY void b_combine(long gid, PRef p, int l) {
    const int r = (int)(gid / (D / 4)), n = (int)(gid % (D / 4)) * 4;
    float a0 = 0.f, a1 = 0.f, a2 = 0.f, a3 = 0.f;
    for (int e = 0; e < NE; ++e) {
        const int s = p.INV[(size_t)r * NE + e];
        if (s >= 0) { const bf16_t* y = p.Y + (size_t)s * D + n; a0 += bf2f(y[0]); a1 += bf2f(y[1]); a2 += bf2f(y[2]); a3 += bf2f(y[3]); }
    }
    const float* g = p.MOD + ((size_t)l * 3 + modset(r)) * NMOD + 5 * D + n;
    float* xr = xrow(p, r) + n;
    xr[0] += g[0] * a0; xr[1] += g[1] * a1; xr[2] += g[2] * a2; xr[3] += g[3] * a3;
}


#ifndef HGRN_DIAG
#define HGRN_DIAG 0
#endif
BODY void b_hgrn_chunkseq(long gid, PRef p, int l) {
    const int v = (int)(gid % 64), pc = (int)((gid / 64) % NCH), bh = (int)((gid / (64 * NCH)) % NBH), dir = (int)(gid / (64L * NCH * NBH));
    const int h = bh % HGH, b = bh / HGH, row0 = pc < NCHC ? NLAT + b * CTX + pc * 64 : b * SEQ + (pc - NCHC) * 64;
    const bf16_t* sin = p.SLOC + ((size_t)(dir * NBH + bh) * NCH + pc) * 4096 + v * 64;
    float S[64];
#pragma unroll
    for (int k = 0; k < 64; ++k) S[k] = bf2f(sin[k]);
    for (int i = 0; i < 64; ++i) {
        const int r = row0 + (dir ? 63 - i : i);
        const float vv = bf2f(p.P[(size_t)r * INC + OHI + h * 64 + v]);
        const bf16_t* zr = p.P + (size_t)r * INC + (dir ? OFB : OFF_) + h * 64;
        const bf16_t* qr = p.P + (size_t)r * INC + OHQ + h * 64;
        const float* lb = p.LB + (size_t)(dir * DEPTH + l) * 384 + h * 64;
        float o = 0.f;
#pragma unroll
        for (int k = 0; k < 64; ++k) { const float f = lb[k] + (1.f - lb[k]) * sigmoid_f(bf2f(zr[k])); S[k] = f * S[k] + (1.f - f) * vv; o += S[k] * bf2f(qr[k]); }
        p.OHG[((size_t)dir * NTOK + r) * 384 + h * 64 + v] = o * 0.125f;
    }
}

BODY void b_hgrn_scan_slow(long gid, PRef p, int) {
    const int e = (int)(gid % 4096), sq = (int)(gid / 4096), dir = sq / NBH, k = e & 63;
    bf16_t* S = p.SLOC + (size_t)sq * NCH * 4096 + e;
    const float* G = p.GDEC + (size_t)sq * NCH * 64 + k;
    float c = 0.f;
    for (int j = 0; j < NCH; ++j) {
        const int pc = dir ? (j < NCHC ? NCHC - 1 - j : NCH + NCHC - 1 - j) : j;
        const float x = bf2f(S[(size_t)pc * 4096]);
        S[(size_t)pc * 4096] = f2bf(c);
        c = G[(size_t)pc * 64] * c + x;
    }
}

BODY void b_hgrn_local_slow(long gid, PRef p, int l) {
    const int v = (int)(gid % 64), pc = (int)((gid / 64) % NCH), bh = (int)((gid / (64 * NCH)) % NBH), dir = (int)(gid / (64L * NCH * NBH));
    const int h = bh % HGH, b = bh / HGH, row0 = pc < NCHC ? NLAT + b * CTX + pc * 64 : b * SEQ + (pc - NCHC) * 64;
    float S[64], g[64];
#pragma unroll
    for (int k = 0; k < 64; ++k) { S[k] = 0.f; g[k] = 1.f; }
    for (int i = 0; i < 64; ++i) {
        const int r = row0 + (dir ? 63 - i : i);
        const float vv = bf2f(p.P[(size_t)r * INC + OHI + h * 64 + v]);
        const bf16_t* zr = p.P + (size_t)r * INC + (dir ? OFB : OFF_) + h * 64;
        const float* lb = p.LB + (size_t)(dir * DEPTH + l) * 384 + h * 64;
#pragma unroll
        for (int k = 0; k < 64; ++k) { const float f = lb[k] + (1.f - lb[k]) * sigmoid_f(bf2f(zr[k])); S[k] = f * S[k] + (1.f - f) * vv; g[k] *= f; }
    }
    bf16_t* dst = p.SLOC + ((size_t)(dir * NBH + bh) * NCH + pc) * 4096 + v * 64;
    if (HGRN_DIAG != 3 && HGRN_DIAG != 4) {
#pragma unroll
    for (int k = 0; k < 64; ++k) dst[k] = f2bf(S[k]);
    }
    if (v == 0) {
        float* gd = p.GDEC + ((size_t)(dir * NBH + bh) * NCH + pc) * 64;
#pragma unroll
        for (int k = 0; k < 64; ++k) gd[k] = g[k];
    }
}
#ifndef FAST_TOPK
#define FAST_TOPK 1
#endif
#ifndef FAST_HGRN
#define FAST_HGRN 1
#endif
#ifndef FAST_ATTN
#define FAST_ATTN 1
#endif
constexpr size_t al256(size_t x) { return (x + 255) & ~(size_t)255; }
constexpr size_t CTL_BYTES = 65536;
constexpr size_t WS_CTL = 0;
constexpr size_t WS_MOD = WS_CTL + CTL_BYTES;
constexpr size_t WS_LB = WS_MOD + al256((size_t)DEPTH * 3 * NMOD * 4);
constexpr size_t WS_XC = WS_LB + al256((size_t)2 * DEPTH * 384 * 4);
constexpr size_t WS_AFF = WS_XC + al256((size_t)NCTX * D * 4);
constexpr size_t WS_SVAL = WS_AFF + al256((size_t)NTOK * NE * 4);
constexpr size_t WS_STOK = WS_SVAL + al256((size_t)NSLOT * 4);
constexpr size_t WS_INV = WS_STOK + al256((size_t)NSLOT * 4);
constexpr size_t WS_H = WS_INV + al256((size_t)NTOK * NE * 4);
constexpr size_t WS_MIX = WS_H + al256((size_t)NTOK * D * 2);
constexpr size_t WS_P = WS_MIX + al256((size_t)NTOK * MIXD * 2);
constexpr size_t WS_HID = WS_P;
constexpr size_t WS_Y = WS_HID + al256((size_t)NSLOT * ED * 2);
constexpr size_t WS_P_END0 = WS_P + al256((size_t)NTOK * INC * 2);
constexpr size_t WS_P_END1 = WS_Y + al256((size_t)NSLOT * D * 2);
constexpr size_t WS_WB = WS_P_END0 > WS_P_END1 ? WS_P_END0 : WS_P_END1;
constexpr size_t WS_WIN_T = WS_WB;
constexpr size_t WS_WOUT_T = WS_WIN_T + al256((size_t)INC * D * 2);
constexpr size_t WS_WGU_T = WS_WOUT_T + al256((size_t)D * MIXD * 2);
constexpr size_t WS_WD_T = WS_WGU_T + al256((size_t)NE * 2 * ED * D * 2);
constexpr size_t WB_BYTES = WS_WD_T + al256((size_t)NE * D * ED * 2) - WS_WB;
constexpr size_t WS_T = WS_WB + 2 * WB_BYTES;
#if FAST_HGRN
constexpr size_t WS_SLOC = WS_T;
constexpr size_t WS_GDEC = WS_SLOC + al256((size_t)2 * NBH * NCH * 4096 * 2);
constexpr size_t WS_OHG = WS_GDEC + al256((size_t)2 * NBH * NCH * 64 * 4);
constexpr size_t WS_XB = WS_OHG + (HGRN_DIAG ? al256((size_t)2 * NTOK * 384 * 4) : 0);
constexpr size_t WS_END = WS_XB + al256((size_t)NLAT * D * 2);
constexpr size_t WS_FG = WS_T;
#else
constexpr size_t WS_FG = WS_T;
constexpr size_t WS_OHG = WS_FG + al256((size_t)NTOK * 768 * 4);
constexpr size_t WS_SLOC = WS_OHG + al256((size_t)2 * NTOK * 384 * 4);
constexpr size_t WS_GDEC = WS_SLOC;
constexpr size_t WS_XB = WS_SLOC;
constexpr size_t WS_END = WS_XB + al256((size_t)NLAT * D * 2);
#endif

static inline Params make_params(void* const* d_in, void* d_out, void* d_ws) {
    Params p{};
    const float** f = (const float**)&p;
    for (int i = 0; i < 20; ++i) f[i] = (const float*)d_in[i];
    char* ws = (char*)d_ws;
    p.XL = (float*)d_out; p.XC = (float*)(ws + WS_XC); p.MOD = (float*)(ws + WS_MOD); p.LB = (float*)(ws + WS_LB); p.AFF = (float*)(ws + WS_AFF);
    p.SVAL = (float*)(ws + WS_SVAL); p.FG = (float*)(ws + WS_FG); p.OHG = (float*)(ws + WS_OHG);
    p.H = (bf16_t*)(ws + WS_H); p.P = (bf16_t*)(ws + WS_P); p.MIX = (bf16_t*)(ws + WS_MIX); p.HID = (bf16_t*)(ws + WS_HID); p.Y = (bf16_t*)(ws + WS_Y);
    p.STOK = (int*)(ws + WS_STOK); p.INV = (int*)(ws + WS_INV);
    p.WIN_T = (bf16_t*)(ws + WS_WIN_T); p.WOUT_T = (bf16_t*)(ws + WS_WOUT_T); p.WGU_T = (bf16_t*)(ws + WS_WGU_T); p.WD_T = (bf16_t*)(ws + WS_WD_T);
    p.CTL = (unsigned*)(ws + WS_CTL); p.SLOC = (bf16_t*)(ws + WS_SLOC); p.GDEC = (float*)(ws + WS_GDEC); p.XB = (bf16_t*)(ws + WS_XB);
    return p;
}

#define FORWARD_STAGES(STAGE)                                                      \
    STAGE(b_adaln, (long)DEPTH * 3 * NMOD, 0)                                      \
    STAGE(b_lb, 2L * 384, 0)                                                       \
    STAGE(b_copyx, (long)NTOK * D, 0)                                              \
    for (int l = 0; l < DEPTH; ++l) {                                              \
        STAGE(b_prenorm<0>, (long)NTOK, l)                                         \
        STAGE(b_gemm_in, (long)NTOK * (INC / 4), l)                                \
        STAGE(b_qkprep, (long)NTOK * 12, l)                                        \
        STAGE(b_attn, (long)NTOK * NAH, l)                                         \
        STAGE(b_gates, (long)NTOK * 768, l)                                        \
        STAGE(b_hgrn_seq<0>, (long)NB * HGH * 64, l)                               \
        STAGE(b_hgrn_seq<1>, (long)NB * HGH * 64, l)                               \
        STAGE(b_hgfin, (long)NTOK * HGH, l)                                        \
        STAGE(b_conv, (long)NTOK * CVD, l)                                         \
        STAGE(b_gemm_out, (long)NTOK * (D / 4), l)                                 \
        STAGE(b_prenorm<1>, (long)NTOK, l)                                         \
        STAGE(b_rank, (long)NTOK * NE, l)                                          \
        STAGE(b_moe1, (long)NSLOT * (ED / 4), l)                                   \
        STAGE(b_moe2, (long)NSLOT * (D / 4), l)                                    \
        STAGE(b_combine, (long)NTOK * (D / 4), l)                                  \
    }

#ifndef CPU_SIM
#include <cstdio>
#define LAS __attribute__((address_space(3)))
#define GAS __attribute__((address_space(1)))
typedef short bf16x8 __attribute__((ext_vector_type(8)));
typedef float f32x4 __attribute__((ext_vector_type(4)));
typedef float f32x2 __attribute__((ext_vector_type(2)));
typedef unsigned u32x4 __attribute__((ext_vector_type(4)));
typedef unsigned u32x2 __attribute__((ext_vector_type(2)));
constexpr int NWAVES = 8, NTHR = 512;
constexpr int RING_BYTES = 131072, LDSCTL_OFF = RING_BYTES, MISC_OFF = LDSCTL_OFF + 320, TAB_OFF = LDSCTL_OFF + 1024  , LDS_BYTES = 147456;

typedef __bf16 bf16v2_t __attribute__((ext_vector_type(2)));
__device__ __forceinline__ unsigned cvt_pk_bf16_asm(float lo, float hi) { unsigned r; asm volatile("v_cvt_pk_bf16_f32 %0, %1, %2" : "=v"(r) : "v"(lo), "v"(hi)); return r; }
__device__ __forceinline__ unsigned cvt_pk_bf16(float lo, float hi) { bf16v2_t v = {(__bf16)lo, (__bf16)hi}; return __builtin_bit_cast(unsigned, v); }
#define DPPF(x, ctrl) __builtin_bit_cast(float, __builtin_amdgcn_update_dpp(0, __builtin_bit_cast(int, (x)), (ctrl), 0xF, 0xF, true))
#define DPP_X1 0xB1
#define DPP_X2 0x4E
#define DPP_HM 0x141
#define DPP_RM 0x140
__device__ __forceinline__ float x16_other(float x, int lane) { const unsigned u = __builtin_bit_cast(unsigned, x); const auto r = __builtin_amdgcn_permlane16_swap(u, u, false, false); return __builtin_bit_cast(float, (lane & 16) ? r[0] : r[1]); }
__device__ __forceinline__ float x32_other(float x, int lane) { const unsigned u = __builtin_bit_cast(unsigned, x); const auto r = __builtin_amdgcn_permlane32_swap(u, u, false, false); return __builtin_bit_cast(float, (lane & 32) ? r[0] : r[1]); }
__device__ __forceinline__ float x16_sum(float x, int lane) { return x + x16_other(x, lane); }
__device__ __forceinline__ float x32_sum(float x, int lane) { return x + x32_other(x, lane); }
__device__ __forceinline__ float x16_max(float x, int lane) { return fmaxf(x, x16_other(x, lane)); }
__device__ __forceinline__ float x32_max(float x, int lane) { return fmaxf(x, x32_other(x, lane)); }
__device__ __forceinline__ float row16_sum(float v) { v += DPPF(v, DPP_X1); v += DPPF(v, DPP_X2); v += DPPF(v, DPP_HM); v += DPPF(v, DPP_RM); return v; }
__device__ __forceinline__ float row16_max(float v) { v = fmaxf(v, DPPF(v, DPP_X1)); v = fmaxf(v, DPPF(v, DPP_X2)); v = fmaxf(v, DPPF(v, DPP_HM)); v = fmaxf(v, DPPF(v, DPP_RM)); return v; }
__device__ __forceinline__ float oct_sum(float v) { v += DPPF(v, DPP_X1); v += DPPF(v, DPP_X2); v += DPPF(v, DPP_HM); return v; }
__device__ __forceinline__ float wave_sum(float v, int lane) { return x32_sum(x16_sum(row16_sum(v), lane), lane); }

extern __shared__ __attribute__((aligned(16))) unsigned char lds_raw[];
#ifndef FUSE_QK
#define FUSE_QK 1
#endif
__device__ __forceinline__ float bfw(unsigned w, int hi) { return __builtin_bit_cast(float, hi ? (w & 0xffff0000u) : (w << 16)); }
__device__ __forceinline__ float bf8(const u32x4& v, int j) { return bfw(v[j >> 1], j & 1); }
namespace pg8 {
constexpr int BM = 256, BK = 64, HALF = 128, HTB = HALF * BK * 2, STAGE_BYTES = 8 * HTB, NXCD = 8, WGM = 8;
__device__ __forceinline__ int lds_byte(int r, int c) { const int st = (r >> 4) * 2 + (c >> 5), rr = r & 15, cc = c & 31, ob = rr * 64 + cc * 2; return st * 1024 + (ob ^ (((ob >> 9) & 1) << 5)); }
__device__ __forceinline__ void stage_rc(int b, int& R, int& C) { const int st = b / 1024, sb = b % 1024, swz = sb ^ (((sb >> 9) & 1) << 5); R = (st >> 1) * 16 + swz / 64; C = (st & 1) * 32 + (swz % 64) / 2; }
__device__ __forceinline__ int perm32(int rho) { const int n = rho >> 4, i = rho & 15; return 8 * (i >> 2) + 4 * n + (i & 3); }
struct Unit { int pm, pn; };
struct Gemm {
    const bf16_t* A; const bf16_t* Bt; int M, N, K;
    const int* gather;
    int gt, ng; size_t gstride;
};
struct StaticOrder {
    int nM, nN, nwg, G, c;
    __device__ void init(int M, int N, int G_, int c_) { nM = M / BM; nN = N / BM; nwg = nM * nN; G = G_; c = c_; }
    __device__ bool next(int i, Unit& u) const {
        const long L = (long)i * G + c; if (L >= nwg) return false;
        int wgid = (int)L; { const int q = nwg / NXCD, r = nwg % NXCD, xcd = wgid % NXCD, off = wgid / NXCD; wgid = (xcd < r ? xcd * (q + 1) : r * (q + 1) + (xcd - r) * q) + off; }
        const int nig = WGM * nN, gid = wgid / nig, fm = gid * WGM, gsz = (nM - fm) < WGM ? (nM - fm) : WGM;
        u.pm = fm + ((wgid % nig) % gsz); u.pn = (wgid % nig) / gsz; return true;
    }
};
struct EpiBf16 {
    static constexpr bool PERM = true;
    bf16_t* O; int ldc; const float* rowscale; int skip;
    __device__ __forceinline__ void operator()(const f32x4 (&acc)[2][2][4][2], const Unit& u, int wr, int wc, int fr, int fq) const {
        const int row0 = u.pm * BM + wr * 64 + fr, col0 = u.pn * BM + wc * 32 + 8 * fq;
        if (skip) { asm volatile("" :: "v"(acc[0][0][0][0]), "v"(acc[1][1][3][1])); return; }
        float scv[2][4];
#pragma unroll
        for (int ai = 0; ai < 2; ++ai)
#pragma unroll
            for (int m = 0; m < 4; ++m) scv[ai][m] = rowscale ? rowscale[row0 + ai * HALF + m * 16] : 1.f;
        asm volatile("" ::: "memory");
#pragma unroll
        for (int ai = 0; ai < 2; ++ai)
#pragma unroll
            for (int m = 0; m < 4; ++m) { const int row = row0 + ai * HALF + m * 16; bf16_t* rowp = O + (size_t)row * ldc + col0; const float sc = scv[ai][m];
#pragma unroll
                for (int bj = 0; bj < 2; ++bj) { const f32x4 v0 = acc[ai][bj][m][0] * sc, v1 = acc[ai][bj][m][1] * sc;
                    u32x4 w; w.x = cvt_pk_bf16_asm(v0[0], v0[1]); w.y = cvt_pk_bf16_asm(v0[2], v0[3]); w.z = cvt_pk_bf16_asm(v1[0], v1[1]); w.w = cvt_pk_bf16_asm(v1[2], v1[3]);
                    *(u32x4*)(rowp + bj * HALF) = w; } }
    }
};
struct EpiP {
    static constexpr bool PERM = true;
    bf16_t* O; int ldc; const float* qn; const float* kn; int skip;
    __device__ __forceinline__ void operator()(const f32x4 (&acc)[2][2][4][2], const Unit& u, int wr, int wc, int fr, int fq) const {
        const int row0 = u.pm * BM + wr * 64 + fr, col0 = u.pn * BM + wc * 32 + 8 * fq;
        if (skip) { asm volatile("" :: "v"(acc[0][0][0][0]), "v"(acc[1][1][3][1])); return; }
        if (u.pn >= 3 || !FUSE_QK) {
#pragma unroll
            for (int ai = 0; ai < 2; ++ai)
#pragma unroll
                for (int m = 0; m < 4; ++m) { bf16_t* rowp = O + (size_t)(row0 + ai * HALF + m * 16) * ldc + col0;
#pragma unroll
                    for (int bj = 0; bj < 2; ++bj) { const f32x4 v0 = acc[ai][bj][m][0], v1 = acc[ai][bj][m][1];
                        u32x4 w; w.x = cvt_pk_bf16_asm(v0[0], v0[1]); w.y = cvt_pk_bf16_asm(v0[2], v0[3]); w.z = cvt_pk_bf16_asm(v1[0], v1[1]); w.w = cvt_pk_bf16_asm(v1[2], v1[3]);
                        *(u32x4*)(rowp + bj * HALF) = w; } }
            return;
        }
        LAS float* PS = (LAS float*)((LAS unsigned char*)lds_raw + LDSCTL_OFF + 4096);
        const int half = wc & 1, hw = wc >> 1;
        unsigned lm_ = ~0u; asm volatile("" : "+s"(lm_)); const int lane = (int)__builtin_amdgcn_mbcnt_hi(lm_, __builtin_amdgcn_mbcnt_lo(lm_, 0u));
#pragma unroll
        for (int ai = 0; ai < 2; ++ai)
#pragma unroll
            for (int m = 0; m < 4; ++m)
#pragma unroll
                for (int bj = 0; bj < 2; ++bj) { const f32x4 v0 = acc[ai][bj][m][0], v1 = acc[ai][bj][m][1];
                    float s = (v0[0] * v0[0] + v0[1] * v0[1]) + (v0[2] * v0[2] + v0[3] * v0[3]) + (v1[0] * v1[0] + v1[1] * v1[1]) + (v1[2] * v1[2] + v1[3] * v1[3]);
                    s = x32_sum(x16_sum(s, lane), lane);
                    if (fq == 0) PS[((ai * HALF + wr * 64 + m * 16 + fr) * 4 + 2 * bj + hw) * 2 + half] = s; }
        asm volatile("s_waitcnt lgkmcnt(0)" ::: "memory"); __builtin_amdgcn_s_barrier(); asm volatile("" ::: "memory");
        float invf[8];
#pragma unroll
        for (int j = 0; j < 8; ++j) invf[j] = __builtin_amdgcn_exp2f(-(float)(8 * (fq & 1) + j) * (13.287712379549449f / 16.f));
        const bool second = (fq & 2) != 0;
        f32x4 nwv[2][2];
#pragma unroll
        for (int bj = 0; bj < 2; ++bj) { const bool isk = (u.pn * BM + bj * HALF + wc * 32) >= 384; const float* nw = (isk ? kn : qn) + 32 * half + 8 * fq; nwv[bj][0] = *(const f32x4*)nw; nwv[bj][1] = *(const f32x4*)(nw + 4); }
        asm volatile("" ::: "memory");
#pragma unroll
        for (int ai = 0; ai < 2; ++ai)
#pragma unroll
            for (int m = 0; m < 4; ++m) {
                const int grow = row0 + ai * HALF + m * 16; const bool lat = grow < NLAT; const int t = lat ? grow % SEQ : 0;
                int tp = half ? t % GW : t / GW; asm volatile("" : "+v"(tp));
                const float pos = (float)tp;
                float cs[8], sn[8];
#pragma unroll
                for (int j = 0; j < 8; ++j) { const float ang = pos * invf[j]; cs[j] = __cosf(ang); sn[j] = __sinf(ang); }
                bf16_t* rowp = O + (size_t)grow * ldc + col0;
#pragma unroll
                for (int bj = 0; bj < 2; ++bj) {
                    const int rl = ai * HALF + wr * 64 + m * 16 + fr, head = 2 * bj + hw;
                    const float ssq = PS[(rl * 4 + head) * 2] + PS[(rl * 4 + head) * 2 + 1];
                    const bool isk = (u.pn * BM + bj * HALF + wc * 32) >= 384;
                    const float rstd = (isk ? 1.f : 0.125f * 1.44269504089f) / sqrtf(ssq * (1.f / HD) + EPS);
                    const f32x4 n0 = nwv[bj][0], n1 = nwv[bj][1];
                    float y[8];
#pragma unroll
                    for (int j = 0; j < 4; ++j) { y[j] = acc[ai][bj][m][0][j] * rstd * n0[j]; y[4 + j] = acc[ai][bj][m][1][j] * rstd * n1[j]; }
#pragma unroll
                    for (int j = 0; j < 8; ++j) {
                        const unsigned yb = __builtin_bit_cast(unsigned, y[j]);
                        const auto sw = __builtin_amdgcn_permlane32_swap(yb, yb, false, false);
                        const float other = __builtin_bit_cast(float, lane < 32 ? sw[1] : sw[0]);
                        const float rot = second ? y[j] * cs[j] + other * sn[j] : y[j] * cs[j] - other * sn[j];
                        y[j] = lat ? rot : y[j];
                    }
                    u32x4 w; w.x = cvt_pk_bf16(y[0], y[1]); w.y = cvt_pk_bf16(y[2], y[3]); w.z = cvt_pk_bf16(y[4], y[5]); w.w = cvt_pk_bf16(y[6], y[7]);
                    *(u32x4*)(rowp + bj * HALF) = w;
                }
                asm volatile("" ::: "memory");
            }
    }
};
struct EpiRes {
    static constexpr bool PERM = true;
    bf16_t* X; int ldc; const float* gate0; int rows_per_set; size_t set_stride;
    __device__ __forceinline__ void operator()(const f32x4 (&acc)[2][2][4][2], const Unit& u, int wr, int wc, int fr, int fq) const {
        const int row0 = u.pm * BM + wr * 64 + fr, col0 = u.pn * BM + wc * 32 + 8 * fq;
        const float* gate = gate0 + (size_t)((u.pm * BM) / rows_per_set) * set_stride;
        f32x4 gv[2][2];
#pragma unroll
        for (int bj = 0; bj < 2; ++bj)
#pragma unroll
            for (int n = 0; n < 2; ++n) gv[bj][n] = *(const f32x4*)(gate + col0 + bj * HALF + n * 4);
        u32x4 rv[2][4][2];
#pragma unroll
        for (int ai = 0; ai < 2; ++ai)
#pragma unroll
            for (int m = 0; m < 4; ++m)
#pragma unroll
                for (int bj = 0; bj < 2; ++bj) rv[ai][m][bj] = *(const u32x4*)(X + (size_t)(row0 + ai * HALF + m * 16) * ldc + col0 + bj * HALF);
        asm volatile("" ::: "memory");
#pragma unroll
        for (int ai = 0; ai < 2; ++ai)
#pragma unroll
            for (int m = 0; m < 4; ++m) { bf16_t* rowp = X + (size_t)(row0 + ai * HALF + m * 16) * ldc + col0;
#pragma unroll
                for (int bj = 0; bj < 2; ++bj) { const u32x4 r = rv[ai][m][bj];
                    const f32x4 x0 = (f32x4){bfw(r.x, 0), bfw(r.x, 1), bfw(r.y, 0), bfw(r.y, 1)}, x1 = (f32x4){bfw(r.z, 0), bfw(r.z, 1), bfw(r.w, 0), bfw(r.w, 1)};
                    const f32x4 v0 = x0 + gv[bj][0] * acc[ai][bj][m][0], v1 = x1 + gv[bj][1] * acc[ai][bj][m][1];
                    u32x4 w; w.x = cvt_pk_bf16_asm(v0[0], v0[1]); w.y = cvt_pk_bf16_asm(v0[2], v0[3]); w.z = cvt_pk_bf16_asm(v1[0], v1[1]); w.w = cvt_pk_bf16_asm(v1[2], v1[3]);
                    *(u32x4*)(rowp + bj * HALF) = w; } }
    }
};
struct EpiHid {
    static constexpr bool PERM = false;
    bf16_t* O; int ldc;
    __device__ __forceinline__ void operator()(const f32x4 (&acc)[2][2][4][2], const Unit& u, int wr, int wc, int fr, int fq) const {
        const int row0 = u.pm * BM + wr * 64 + fr, col0 = (u.pn * BM + wc * 32) / 2 + 4 * (fq & ~1) + ((fq & 1) ? HALF / 2 : 0);
#pragma unroll
        for (int ai = 0; ai < 2; ++ai)
#pragma unroll
            for (int m = 0; m < 4; ++m) { bf16_t* rowp = O + (size_t)(row0 + ai * HALF + m * 16) * ldc + col0;
                u32x2 w[2];
#pragma unroll
                for (int bj = 0; bj < 2; ++bj) { const f32x4 g = acc[ai][bj][m][0], up = acc[ai][bj][m][1]; f32x4 h;
#pragma unroll
                    for (int j = 0; j < 4; ++j) h[j] = g[j] * __builtin_amdgcn_rcpf(1.f + __expf(-g[j])) * up[j];
                    w[bj].x = cvt_pk_bf16(h[0], h[1]); w[bj].y = cvt_pk_bf16(h[2], h[3]); }
                const auto rx = __builtin_amdgcn_permlane16_swap(w[0].x, w[1].x, false, false), ry = __builtin_amdgcn_permlane16_swap(w[0].y, w[1].y, false, false);
                u32x4 o; o.x = rx[0]; o.y = ry[0]; o.z = rx[1]; o.w = ry[1];
                *(u32x4*)rowp = o; }
    }
};

template <class Epi, bool GATHER>
__device__ __forceinline__ void gemm_phase(const int tid, LAS unsigned char* lds, const Gemm g, const StaticOrder& S, const Epi& E) {
    const int wid = __builtin_amdgcn_readfirstlane(tid >> 6), lane = tid & 63, wr = wid >> 2, wc = wid & 3, fr = lane & 15, fq = lane >> 4;
    const int K = g.K, nt = K / BK;
    unsigned voffA[2], voffB[2];
#pragma unroll
    for (int i = 0; i < 2; ++i) { int R, C; stage_rc(tid * 16 + i * 8192, R, C); const int Rb = Epi::PERM ? ((R & ~31) + perm32(R & 31)) : R;
        voffB[i] = (unsigned)(Rb * K + C) * 2u; voffA[i] = GATHER ? (unsigned)(C * 2) : (Epi::PERM ? (unsigned)(R * K + C) * 2u : voffB[i]); }
    const size_t kstep = (size_t)(BK * 2);
    const size_t hstep = (size_t)HALF * K * 2;
    const size_t tstep = 2 * hstep;
    const unsigned ldsw = (unsigned)wid * 1024u;
    const int aoff = lds_byte(wr * 64 + fr, fq * 8), boff = lds_byte(wc * 32 + fr, fq * 8);
#define PG8_SA(b, h) (((b) * 2 + (h)) * HTB)
#define PG8_SB(b, h) ((4 + (b) * 2 + (h)) * HTB)
#define PG8_STAGE(bufoff, gbase, voff) do { const char* gb_ = (const char*)(gbase); asm volatile("" : "+s"(gb_)); _Pragma("unroll") for (int _i = 0; _i < 2; ++_i) \
        __builtin_amdgcn_global_load_lds((const unsigned*)(gb_ + (voff)[_i]), (LAS unsigned*)(lds + (bufoff) + ldsw + _i * 8192), 16, 0, 0); } while (0)
#define PG8_STAGE_A(bufoff, ubase, kt, h, tb) do { if constexpr (GATHER) { \
        if ((tb) < 0) { PG8_STAGE(bufoff, Ab + (size_t)(kt) * kstep, oAc[h]); } else { \
        unsigned m_ = ~0u; asm volatile("" : "+s"(m_)); const int tl_ = wid * 64 + (int)__builtin_amdgcn_mbcnt_hi(m_, __builtin_amdgcn_mbcnt_lo(m_, 0u)); \
        _Pragma("unroll") for (int _i = 0; _i < 2; ++_i) { int _R, _C; stage_rc(tl_ * 16 + _i * 8192, _R, _C); \
            const unsigned _o = min(*(const LAS unsigned*)(lds + TAB_OFF + (tb) * 1024 + ((h) * HALF + _R) * 4), (unsigned)(NTOK - 1)) * (unsigned)(K * 2) + (unsigned)(_C * 2); \
            __builtin_amdgcn_global_load_lds((const unsigned*)(Ab + (size_t)(kt) * kstep + _o), (LAS unsigned*)(lds + (bufoff) + ldsw + _i * 8192), 16, 0, 0); } } } \
        else { PG8_STAGE(bufoff, (ubase) + (size_t)(kt) * kstep + (size_t)(h) * hstep, voffA); } } while (0)
#define PG8_LOADOFFS(tb) do { if constexpr (GATHER) { unsigned m_ = ~0u; asm volatile("" : "+s"(m_)); const int tl_ = wid * 64 + (int)__builtin_amdgcn_mbcnt_hi(m_, __builtin_amdgcn_mbcnt_lo(m_, 0u)); \
        _Pragma("unroll") for (int _h = 0; _h < 2; ++_h) _Pragma("unroll") for (int _i = 0; _i < 2; ++_i) { int _R, _C; stage_rc(tl_ * 16 + _i * 8192, _R, _C); \
            oAc[_h][_i] = min(*(const LAS unsigned*)(lds + TAB_OFF + (tb) * 1024 + (_h * HALF + _R) * 4), (unsigned)(NTOK - 1)) * (unsigned)(K * 2) + (unsigned)(_C * 2); } } } while (0)
#define PG8_FILLTAB(u, tb) do { if constexpr (GATHER) { unsigned m_ = ~0u; asm volatile("" : "+s"(m_)); const int tl_ = wid * 64 + (int)__builtin_amdgcn_mbcnt_hi(m_, __builtin_amdgcn_mbcnt_lo(m_, 0u)); \
        if (tl_ < 256) *(LAS unsigned*)(lds + TAB_OFF + (tb) * 1024 + tl_ * 4) = (unsigned)g.gather[(u).pm * BM + tl_]; } } while (0)
#define PG8_LDA(dst, b, h) do { _Pragma("unroll") for (int m = 0; m < 4; ++m) _Pragma("unroll") for (int k = 0; k < 2; ++k) dst[m][k] = *(const LAS bf16x8*)(lds + PG8_SA(b, h) + aoff + m * 2048 + k * 1024); } while (0)
#define PG8_LDB(dst, b, h) do { _Pragma("unroll") for (int n = 0; n < 2; ++n) _Pragma("unroll") for (int k = 0; k < 2; ++k) dst[n][k] = *(const LAS bf16x8*)(lds + PG8_SB(b, h) + boff + n * 2048 + k * 1024); } while (0)
#define PG8_MMA(ai, bj, At, Bt) do { __builtin_amdgcn_s_setprio(1); _Pragma("unroll") for (int m = 0; m < 4; ++m) _Pragma("unroll") for (int n = 0; n < 2; ++n) _Pragma("unroll") for (int k = 0; k < 2; ++k) \
        acc[ai][bj][m][n] = __builtin_amdgcn_mfma_f32_16x16x32_bf16(Bt[n][k], At[m][k], acc[ai][bj][m][n], 0, 0, 0); __builtin_amdgcn_s_setprio(0); } while (0)
#define PG8_WAIT_V(n) asm volatile("s_waitcnt vmcnt(" #n ")" ::: "memory")
#define PG8_WAIT_L(n) asm volatile("s_waitcnt lgkmcnt(" #n ")" ::: "memory")
#define PG8_BAR __builtin_amdgcn_s_barrier()
#define PG8_SCHED __builtin_amdgcn_sched_barrier(0)
#define PG8_KTILE2(u1, k1, o1, u2, k2, o2, b2p) do { \
        PG8_LDB(B0, 0, 0); PG8_LDB(B1, 0, 1); PG8_SCHED; PG8_LDA(At, 0, 0); PG8_STAGE_A(PG8_SA(1, 1), u1, k1, 1, o1); \
        PG8_WAIT_V(8); PG8_WAIT_L(0); PG8_BAR; PG8_MMA(0, 0, At, B0); PG8_MMA(0, 1, At, B1); PG8_BAR; PG8_SCHED; \
        PG8_LDA(At, 0, 1); PG8_STAGE(PG8_SB(0, 0), b2p, voffB); PG8_STAGE(PG8_SB(0, 1), (b2p) + hstep, voffB); PG8_STAGE_A(PG8_SA(0, 0), u2, k2, 0, o2); \
        PG8_WAIT_V(8); PG8_WAIT_L(0); PG8_BAR; PG8_MMA(1, 0, At, B0); PG8_MMA(1, 1, At, B1); PG8_BAR; PG8_SCHED; \
        PG8_LDB(B0, 1, 0); PG8_LDB(B1, 1, 1); PG8_SCHED; PG8_LDA(At, 1, 0); PG8_STAGE_A(PG8_SA(0, 1), u2, k2, 1, o2); \
        PG8_WAIT_V(8); PG8_WAIT_L(0); PG8_BAR; PG8_MMA(0, 0, At, B0); PG8_MMA(0, 1, At, B1); PG8_BAR; PG8_SCHED; \
        PG8_LDA(At, 1, 1); PG8_STAGE(PG8_SB(1, 0), (b2p) + kstep, voffB); PG8_STAGE(PG8_SB(1, 1), (b2p) + kstep + hstep, voffB); PG8_STAGE_A(PG8_SA(1, 0), u2, (k2) + 1, 0, o2); \
        PG8_WAIT_V(8); PG8_WAIT_L(0); PG8_BAR; PG8_MMA(1, 0, At, B0); PG8_MMA(1, 1, At, B1); PG8_BAR; PG8_SCHED; } while (0)
#define PG8_BPTR(u) ((const char*)g.Bt + (g.gt ? (size_t)(((u).pm / g.gt) % g.ng) * g.gstride : (size_t)0) + (size_t)(u).pn * tstep)
    Unit cur, nxt; int ui = 0;
    if (!S.next(0, cur)) return;
#ifndef LATE_START
#define LATE_START 4
#endif
#ifndef GEMM_STAGGER
#define GEMM_STAGGER 0
#endif
    if (GEMM_STAGGER) { const int dg_ = ((int)blockIdx.x >> 3) & 3; for (int i_ = 0; i_ < dg_; ++i_) __builtin_amdgcn_s_sleep(GEMM_STAGGER); }
    if (S.nwg % S.G != 0 && S.c >= S.nwg % S.G) { for (int i_ = 0; i_ < LATE_START; ++i_) __builtin_amdgcn_s_sleep(127); }
    f32x4 acc[2][2][4][2];
#pragma unroll
    for (int a = 0; a < 2; ++a)
#pragma unroll
        for (int b = 0; b < 2; ++b)
#pragma unroll
            for (int m = 0; m < 4; ++m)
#pragma unroll
                for (int n = 0; n < 2; ++n) acc[a][b][m][n] = (f32x4){0.f, 0.f, 0.f, 0.f};
    bf16x8 At[4][2], B0[2][2], B1[2][2];
    unsigned oAc[2][2] = {{0u, 0u}, {0u, 0u}};
    const char* const Ab = (const char*)g.A;
    const char* cA = Ab + (size_t)cur.pm * tstep;
    const char* cB = PG8_BPTR(cur);
    PG8_FILLTAB(cur, 0);
    if constexpr (GATHER) { PG8_WAIT_L(0); PG8_BAR; PG8_LOADOFFS(0); }
    PG8_STAGE(PG8_SB(0, 0), cB, voffB); PG8_STAGE(PG8_SB(0, 1), cB + hstep, voffB); PG8_STAGE_A(PG8_SA(0, 0), cA, 0, 0, -1); PG8_STAGE_A(PG8_SA(0, 1), cA, 0, 1, -1);
    if (wr == 1) PG8_BAR;
    PG8_WAIT_V(2); PG8_BAR;
    PG8_STAGE(PG8_SB(1, 0), cB + kstep, voffB); PG8_STAGE_A(PG8_SA(1, 0), cA, 1, 0, -1); PG8_STAGE(PG8_SB(1, 1), cB + hstep + kstep, voffB);
    PG8_WAIT_V(6); PG8_BAR;
    for (;;) {
        const bool has_next = S.next(ui + 1, nxt);
        const char* nA = has_next ? Ab + (size_t)nxt.pm * tstep : cA; const char* nB = has_next ? PG8_BPTR(nxt) : cB;
        const int tbc = ui & 1, tbn = has_next ? ((ui + 1) & 1) : (ui & 1);
        if constexpr (GATHER) { if (has_next && wid < 4) { unsigned m_ = ~0u; asm volatile("" : "+s"(m_)); const int tl_ = wid * 64 + (int)__builtin_amdgcn_mbcnt_hi(m_, __builtin_amdgcn_mbcnt_lo(m_, 0u));
            __builtin_amdgcn_global_load_lds((const unsigned*)(g.gather + nxt.pm * BM + tl_), (LAS unsigned*)(lds + TAB_OFF + tbn * 1024 + wid * 256), 4, 0, 0); } }
        for (int t = 0; t < nt - 2; t += 2) { const char* b2 = cB + (size_t)(t + 2) * kstep; PG8_KTILE2(cA, t + 1, -1, cA, t + 2, -1, b2); }
        PG8_KTILE2(cA, nt - 1, -1, nA, 0, tbn, nB);
        if (wr == 0) PG8_BAR;
        { unsigned m_ = ~0u; asm volatile("" : "+s"(m_)); int l2 = (int)__builtin_amdgcn_mbcnt_hi(m_, __builtin_amdgcn_mbcnt_lo(m_, 0u)); asm volatile("" : "+v"(l2)); E(acc, cur, wr, wc, l2 & 15, l2 >> 4); }
        if (!has_next) break;
#pragma unroll
        for (int a = 0; a < 2; ++a)
#pragma unroll
            for (int b = 0; b < 2; ++b)
#pragma unroll
                for (int m = 0; m < 4; ++m)
#pragma unroll
                    for (int n = 0; n < 2; ++n) acc[a][b][m][n] = (f32x4){0.f, 0.f, 0.f, 0.f};
        cur = nxt; cA = nA; cB = nB; ++ui;
        PG8_LOADOFFS(ui & 1);
        if (wr == 1) PG8_BAR;
    }
    PG8_WAIT_V(0);
    PG8_BAR;
#undef PG8_STAGE_A
#undef PG8_FILLTAB
#undef PG8_LOADOFFS
#undef PG8_SA
#undef PG8_SB
#undef PG8_STAGE
#undef PG8_LDA
#undef PG8_LDB
#undef PG8_MMA
#undef PG8_WAIT_V
#undef PG8_WAIT_L
#undef PG8_BAR
#undef PG8_SCHED
#undef PG8_KTILE2
#undef PG8_BPTR
}
}

#define XB_TMO      128
#define XB_XCNT(j)  (256  + 64 * (j))
#define XB_XSUB(j)  (1280 + 64 * (j))
#define XB_XGEN(j)  (2304 + 64 * (j))
#define XB_TOP      3328
#define XB_TOPGEN   3392
#define XCD_BAR_WORDS 3456
#define XB_SPIN_CAP (1u << 20)
__device__ __forceinline__ unsigned xb_ld(unsigned* p)              { return __hip_atomic_load(p, __ATOMIC_RELAXED, __HIP_MEMORY_SCOPE_AGENT); }
__device__ __forceinline__ unsigned xb_add(unsigned* p, unsigned v) { return __hip_atomic_fetch_add(p, v, __ATOMIC_RELAXED, __HIP_MEMORY_SCOPE_AGENT); }
__device__ __forceinline__ unsigned xb_xcc_id() { return (unsigned)__builtin_amdgcn_s_getreg((3 << 11) | 20) & 0xFu; }
#define XB_SPIN(cond, bar) do { unsigned _sp = 0; while (cond) { __builtin_amdgcn_s_sleep(1); \
    if ((++_sp & 255u) == 0u) { if (xb_ld(&(bar)[XB_TMO])) break; if (_sp > XB_SPIN_CAP) { atomicAdd(&(bar)[XB_TMO], 1u); break; } } } } while (0)
struct XcdBarrier { unsigned* bar; unsigned x; };
#define XB_ST(ldsbase) ((volatile LAS unsigned*)((LAS unsigned char*)(ldsbase) + MISC_OFF + 32))
__device__ __forceinline__ XcdBarrier xcd_barrier_post(unsigned* bar, bool leader) {
    XcdBarrier b; b.bar = bar; b.x = xb_xcc_id();
    if (leader) (void)xb_add(&bar[XB_XCNT(b.x)], 1u);
    return b;
}
__device__ __forceinline__ void xcd_barrier_complete(unsigned* bar, unsigned x, unsigned& nloc, unsigned& nx) {
    const unsigned G = gridDim.x * gridDim.y * gridDim.z;
    unsigned sum, cnt, mine, sp = 0u;
    for (;;) {
        sum = 0u; cnt = 0u; mine = 0u;
#pragma unroll
        for (unsigned j = 0; j < 16; ++j) { const unsigned c = xb_ld(&bar[XB_XCNT(j)]); sum += c; cnt += (c > 0u) ? 1u : 0u; mine = (j == x) ? c : mine; }
        if (sum == G) break;
        __builtin_amdgcn_s_sleep(1);
        if ((++sp & 255u) == 0u) { if (xb_ld(&bar[XB_TMO])) break; if (sp > XB_SPIN_CAP) { atomicAdd(&bar[XB_TMO], 1u); break; } }
    }
    nloc = mine > 0u ? mine : 1u; nx = cnt > 0u ? cnt : 1u;
}
__device__ __forceinline__ void xcd_barrier(const XcdBarrier& b, bool leader, volatile LAS unsigned* st) {
    asm volatile("s_waitcnt vmcnt(0)" ::: "memory");
    __syncthreads();
    if (leader) {
        unsigned* bar = b.bar;
        __builtin_amdgcn_s_waitcnt(0);
        unsigned nloc = st[0], nx = st[1];
        if (nloc == 0u) { xcd_barrier_complete(bar, b.x, nloc, nx); st[0] = nloc; st[1] = nx; }
        const unsigned old = xb_add(&bar[XB_XSUB(b.x)], 1u);
        const unsigned gen = old / nloc;
        if (old + 1u == (gen + 1u) * nloc) {
            __builtin_amdgcn_fence(__ATOMIC_RELEASE, "agent");
            asm volatile("s_waitcnt vmcnt(0)" ::: "memory");
            const unsigned og = xb_add(&bar[XB_TOP], 1u);
            const unsigned tg = og / nx;
            if (og + 1u == (tg + 1u) * nx) xb_add(&bar[XB_TOPGEN], 1u);
            else XB_SPIN(xb_ld(&bar[XB_TOPGEN]) == tg, bar);
            __builtin_amdgcn_fence(__ATOMIC_ACQUIRE, "agent");
            xb_add(&bar[XB_XGEN(b.x)], 1u);
            asm volatile("s_waitcnt vmcnt(0)" ::: "memory");
        } else {
            XB_SPIN(xb_ld(&bar[XB_XGEN(b.x)]) == gen, bar);
            __builtin_amdgcn_fence(__ATOMIC_ACQUIRE, "agent");
            asm volatile("s_waitcnt vmcnt(0)" ::: "memory");
        }
    }
    __syncthreads();
}

template <void (*F)(long, PRef, int)> __device__ __forceinline__ void run_items(const int tid, PRef p, int l, long n, long off) {
    for (long gid = (long)blockIdx.x * NTHR + tid; gid < n; gid += (long)gridDim.x * NTHR) F(gid + off, p, l);
}
BODY void b_hgrn_seq2(long gid, PRef p, int l) { const long n1 = (long)NB * HGH * 64; if (gid < n1) b_hgrn_seq<0>(gid, p, l); else b_hgrn_seq<1>(gid - n1, p, l); }

template <int MAP> __device__ __forceinline__ void transpose_item(const float* W, int K, int N, bf16_t* WT, int row_off, LAS float* scr, int item, int lane) {
    const int nblk = N / 32, kb = item / nblk, nb = item % nblk, k0 = 64 * kb, n0 = 32 * nb;
#pragma unroll 8
    for (int i = 0; i < 32; ++i) { const int kk = 2 * i + (lane >> 5); scr[kk * 33 + (lane & 31)] = W[(size_t)(k0 + kk) * N + n0 + (lane & 31)]; }
    asm volatile("s_waitcnt lgkmcnt(0)" ::: "memory");
    const int c = lane & 7;
#pragma unroll
    for (int j = 0; j < 4; ++j) { const int n = (lane >> 3) + 8 * j; const LAS float* s = scr + (8 * c) * 33 + n;
        u32x4 o; o.x = cvt_pk_bf16(s[0 * 33], s[1 * 33]); o.y = cvt_pk_bf16(s[2 * 33], s[3 * 33]); o.z = cvt_pk_bf16(s[4 * 33], s[5 * 33]); o.w = cvt_pk_bf16(s[6 * 33], s[7 * 33]);
        const int nn = n0 + n; const int drow = MAP == 0 ? row_off + nn : (32 * (nn >> 4) + (nn & 15) + (MAP == 2 ? 16 : 0));
        *(u32x4*)(WT + (size_t)drow * K + k0 + 8 * c) = o; }
    asm volatile("s_waitcnt lgkmcnt(0)" ::: "memory");
}
#define WBOFF(l) ((size_t)((l) & 1) * (WB_BYTES / 2))
__device__ __forceinline__ void phase_convert(const int tid, PRef p, int l, LAS unsigned char* lds, int part = 0, int blk_lo = 0) {
    if ((int)blockIdx.x < blk_lo) return;
    const int lane = tid & 63, wave = tid >> 6;
    LAS float* scr = (LAS float*)(lds + wave * 16384);
    const int gw = ((int)blockIdx.x - blk_lo) * NWAVES + wave, NGW = ((int)gridDim.x - blk_lo) * NWAVES;
    constexpr int I_IN = (D / 64) * (INC / 32), I_OUT = (MIXD / 64) * (D / 32), I_G = (D / 64) * (ED / 32), I_D = (ED / 64) * (D / 32);
    constexpr int NITEMS = I_IN + I_OUT + NE * (2 * I_G + I_D);
    const int it_lo = part == 2 ? I_IN + I_OUT : 0, it_hi = part == 1 ? I_IN + I_OUT : NITEMS;
    for (int it = it_lo + gw; it < it_hi; it += NGW) {
        int r = it;
        if (r < I_IN) { transpose_item<0>(p.w_in + (size_t)l * D * INC, D, INC, p.WIN_T + WBOFF(l), 0, scr, r, lane); continue; } r -= I_IN;
        if (r < I_OUT) { transpose_item<0>(p.w_out + (size_t)l * MIXD * D, MIXD, D, p.WOUT_T + WBOFF(l), 0, scr, r, lane); continue; } r -= I_OUT;
        const int e = r / (2 * I_G + I_D); r -= e * (2 * I_G + I_D);
        if (r < I_G) { transpose_item<1>(p.w_gate + ((size_t)l * NE + e) * D * ED, D, ED, p.WGU_T + WBOFF(l) + (size_t)e * 2 * ED * D, 0, scr, r, lane); continue; } r -= I_G;
        if (r < I_G) { transpose_item<2>(p.w_up + ((size_t)l * NE + e) * D * ED, D, ED, p.WGU_T + WBOFF(l) + (size_t)e * 2 * ED * D, 0, scr, r, lane); continue; } r -= I_G;
        transpose_item<0>(p.w_down + ((size_t)l * NE + e) * ED * D, ED, D, p.WD_T + WBOFF(l) + (size_t)e * D * ED, 0, scr, r, lane);
    }
}
template <int WHICH> __device__ __forceinline__ void phase_prenorm(const int tid, PRef p, int l) {
    static_assert(D == 1024, "wave-per-row kernels assume D = 1024");
    const int lane = tid & 63, wave = tid >> 6;
    const int gw = blockIdx.x * NWAVES + wave, NGW = gridDim.x * NWAVES;
    const float* nw = (WHICH ? p.norm2_w : p.norm1_w) + l * D;
    for (int r = gw; r < NTOK; r += NGW) {
        const float* xr = xrow(p, r);
        const float* mod = p.MOD + ((size_t)l * 3 + modset(r)) * NMOD;
        const float* shift = mod + (WHICH ? 3 : 0) * D; const float* scale = mod + (WHICH ? 4 : 1) * D;
        f32x4 v[4]; float ss = 0.f;
#pragma unroll
        for (int j = 0; j < 4; ++j) { v[j] = *(const f32x4*)(xr + 4 * lane + 256 * j); ss += (v[j][0] * v[j][0] + v[j][1] * v[j][1]) + (v[j][2] * v[j][2] + v[j][3] * v[j][3]); }
        const float rstd = 1.f / sqrtf(wave_sum(ss, lane) * (1.f / D) + EPS);
        float lg[NE];
#pragma unroll
        for (int e = 0; e < NE; ++e) lg[e] = 0.f;
#pragma unroll
        for (int j = 0; j < 4; ++j) {
            const int c = 4 * lane + 256 * j;
            const f32x4 w4 = *(const f32x4*)(nw + c), sc4 = *(const f32x4*)(scale + c), sh4 = *(const f32x4*)(shift + c);
            f32x4 h;
#pragma unroll
            for (int i = 0; i < 4; ++i) h[i] = v[j][i] * rstd * w4[i] * (1.f + sc4[i]) + sh4[i];
            u32x2 o; o.x = cvt_pk_bf16(h[0], h[1]); o.y = cvt_pk_bf16(h[2], h[3]);
            *(u32x2*)(p.H + (size_t)r * D + c) = o;
            if (WHICH) {
#pragma unroll
                for (int i = 0; i < 4; ++i) { const f32x4* wr = (const f32x4*)(p.w_router + ((size_t)l * D + c + i) * NE);
#pragma unroll
                    for (int q = 0; q < 4; ++q) { const f32x4 w = wr[q]; lg[4 * q + 0] += h[i] * w[0]; lg[4 * q + 1] += h[i] * w[1]; lg[4 * q + 2] += h[i] * w[2]; lg[4 * q + 3] += h[i] * w[3]; } }
            }
        }
        if (WHICH) {
#pragma unroll
            for (int e = 0; e < NE; ++e) lg[e] = wave_sum(lg[e], lane);
            float m = lg[0];
#pragma unroll
            for (int e = 1; e < NE; ++e) m = fmaxf(m, lg[e]);
            float s = 0.f, mine = 0.f;
#pragma unroll
            for (int e = 0; e < NE; ++e) { const float ex = expf(lg[e] - m); s += ex; mine = (lane == e) ? ex : mine; }
            if (lane < NE) p.AFF[(size_t)r * NE + lane] = mine / s;
        }
    }
}
__device__ __forceinline__ void phase_combine(const int tid, PRef p, int l) {
    const int lane = tid & 63, wave = tid >> 6;
    const int gw = blockIdx.x * NWAVES + wave, NGW = gridDim.x * NWAVES;
    for (int r = gw; r < NTOK; r += NGW) {
        float* xr = xrow(p, r);
        const float* g = p.MOD + ((size_t)l * 3 + modset(r)) * NMOD + 5 * D;
        f32x4 acc[4];
#pragma unroll
        for (int j = 0; j < 4; ++j) acc[j] = (f32x4){0.f, 0.f, 0.f, 0.f};
        const int myinv = lane < NE ? p.INV[(size_t)r * NE + lane] : -1;
#pragma unroll
        for (int e = 0; e < NE; ++e) {
            const int s = __builtin_amdgcn_readlane(myinv, e);
            if (s >= 0 && s < NSLOT) {
                const bf16_t* y = p.Y + (size_t)s * D;
#pragma unroll
                for (int j = 0; j < 4; ++j) { const u32x2 w = *(const u32x2*)(y + 4 * lane + 256 * j);
                    acc[j][0] += __builtin_bit_cast(float, w.x << 16); acc[j][1] += __builtin_bit_cast(float, w.x & 0xffff0000u);
                    acc[j][2] += __builtin_bit_cast(float, w.y << 16); acc[j][3] += __builtin_bit_cast(float, w.y & 0xffff0000u); }
            }
        }
#pragma unroll
        for (int j = 0; j < 4; ++j) { const int c = 4 * lane + 256 * j; f32x4* q = (f32x4*)(xr + c); *q = *q + *(const f32x4*)(g + c) * acc[j]; }
    }
}


__device__ __forceinline__ unsigned wave_excl_scan(unsigned x, int lane) {
    unsigned inc = x;
#pragma unroll
    for (int d = 1; d < 64; d <<= 1) { const unsigned y = (unsigned)__builtin_amdgcn_ds_bpermute(((lane - d) & 63) << 2, (int)inc); if (lane >= d) inc += y; }
    return inc - x;
}
__device__ __forceinline__ void phase_topk(const int tid, PRef p, LAS unsigned char* lds) {
    LAS unsigned* keys = (LAS unsigned*)lds;
    LAS unsigned* hist = (LAS unsigned*)(lds + 70000);
    LAS unsigned* cgt = (LAS unsigned*)(lds + 76000);
    LAS unsigned* ceq = (LAS unsigned*)(lds + 80000);
    LAS unsigned* sh = (LAS unsigned*)(lds + 84000);
    static_assert(SEQ % 512 == 0 && SEQ + SEQ / 32 <= 17400, "topk LDS layout");
    constexpr int PER = SEQ / 512;
    for (int pr = blockIdx.x; pr < 2 * NB * NE; pr += gridDim.x) {
        const int e = pr % NE, b = (pr / NE) % NB, isctx = pr / (NE * NB);
        if (!isctx) {
            const int row0 = b * SEQ, base = (b * NE + e) * CAPL;
            for (int i = 0; i < PER; ++i) { const int t = i * 512 + tid; keys[t + (t >> 5)] = __builtin_bit_cast(unsigned, p.AFF[(size_t)(row0 + t) * NE + e]); }
            if (tid == 0) { sh[0] = 0u; sh[1] = (unsigned)CAPL; }
            __syncthreads();
            for (int pass = 0; pass < 3; ++pass) {
                const int shift = 20 - 10 * pass;
                for (int i = tid; i < 1024; i += 512) hist[i] = 0u;
                __syncthreads();
                const unsigned prefix = sh[0]; const unsigned himask = pass == 0 ? 0u : (0xFFFFFFFFu << (shift + 10));
                for (int i = 0; i < PER; ++i) { const int t = tid * PER + i; const unsigned k = keys[t + (t >> 5)]; if ((k & himask) == prefix) atomicAdd((unsigned*)&hist[(k >> shift) & 1023u], 1u); }
                __syncthreads();
                if (tid < 64) {
                    const unsigned need = sh[1];
                    unsigned c[16]; unsigned tot = 0u;
#pragma unroll
                    for (int q = 0; q < 16; ++q) { c[q] = hist[1023 - 16 * tid - q]; tot += c[q]; }
                    unsigned above = wave_excl_scan(tot, tid);
                    int fbin = -1; unsigned fabove = 0u;
#pragma unroll
                    for (int q = 0; q < 16; ++q) { if (fbin < 0 && above < need && above + c[q] >= need) { fbin = 1023 - 16 * tid - q; fabove = above; } above += c[q]; }
                    if (fbin >= 0) { sh[0] = prefix | ((unsigned)fbin << shift); sh[1] = need - fabove; }
                }
                __syncthreads();
            }
            const unsigned thr = sh[0], keq = sh[1];
            unsigned ng = 0u, nq = 0u;
            for (int i = 0; i < PER; ++i) { const int t = tid * PER + i; const unsigned k = keys[t + (t >> 5)]; ng += k > thr ? 1u : 0u; nq += k == thr ? 1u : 0u; }
            cgt[tid] = ng; ceq[tid] = nq;
            __syncthreads();
            if (tid < 64) {
                unsigned g[8], q[8], sg = 0u, sq = 0u;
#pragma unroll
                for (int i = 0; i < 8; ++i) { g[i] = cgt[8 * tid + i]; q[i] = ceq[8 * tid + i]; sg += g[i]; sq += q[i]; }
                unsigned ag = wave_excl_scan(sg, tid), aq = wave_excl_scan(sq, tid);
#pragma unroll
                for (int i = 0; i < 8; ++i) { cgt[8 * tid + i] = ag; ceq[8 * tid + i] = aq; ag += g[i]; aq += q[i]; }
            }
            __syncthreads();
            unsigned rg = cgt[tid], rq = ceq[tid];
            for (int i = 0; i < PER; ++i) {
                const int t = tid * PER + i; const unsigned k = keys[t + (t >> 5)];
                int slot = -1;
                if (k > thr) { slot = (int)(rg + (rq < keq ? rq : keq)); ++rg; }
                else if (k == thr) { if (rq < keq) slot = (int)(rg + rq); ++rq; }
                const int row = row0 + t;
                if (slot >= 0) { p.STOK[base + slot] = row; p.SVAL[base + slot] = __builtin_bit_cast(float, k); p.INV[(size_t)row * NE + e] = base + slot; }
                else p.INV[(size_t)row * NE + e] = -1;
            }
            __syncthreads();
        } else {
            const int row0 = NLAT + b * CTX, base = NSLOT_L + (b * NE + e) * CAPC;
            LAS float* vals = (LAS float*)lds;
            for (int t = tid; t < CTX; t += 512) vals[t] = p.AFF[(size_t)(row0 + t) * NE + e];
            __syncthreads();
            for (int t = tid; t < CTX; t += 512) {
                const float a = vals[t]; int rank = 0;
                for (int tt = 0; tt < CTX; ++tt) { const float o = vals[tt]; rank += (o > a || (o == a && tt < t)) ? 1 : 0; }
                const int row = row0 + t;
                if (rank < CAPC) { p.STOK[base + rank] = row; p.SVAL[base + rank] = a; p.INV[(size_t)row * NE + e] = base + rank; }
                else p.INV[(size_t)row * NE + e] = -1;
            }
            __syncthreads();
        }
    }
}

#define LDS_BAR() do { asm volatile("s_waitcnt lgkmcnt(0)" ::: "memory"); __builtin_amdgcn_s_barrier(); asm volatile("" ::: "memory"); } while (0)
__device__ __forceinline__ int hg_row0(int b, int pc) { return pc < NCHC ? NLAT + b * CTX + pc * 64 : b * SEQ + (pc - NCHC) * 64; }
constexpr int HG_FF = 0, HG_FB = 16384, HG_AF = 32768, HG_AB = 49152, HG_T0 = 65536, HG_TS = 9216, HG_VT = HG_T0 + 6 * HG_TS;
#define HGI(t, k) ((t) * 64 + ((k) ^ (((((t) >> 4) & 1) << 4) | (((t) & 3) << 2))))
#define HGLD8(dst, arr, t, k0) do { const f32x4 lo_ = *(const LAS f32x4*)((arr) + HGI(t, k0)), hi_ = *(const LAS f32x4*)((arr) + HGI(t, (k0) + 4)); \
        dst[0] = lo_[0]; dst[1] = lo_[1]; dst[2] = lo_[2]; dst[3] = lo_[3]; dst[4] = hi_[0]; dst[5] = hi_[1]; dst[6] = hi_[2]; dst[7] = hi_[3]; } while (0)
static_assert(HG_VT + HG_TS <= RING_BYTES, "hgrn LDS layout");
#define TSW_E(k, t) ((k) * 72 + ((((t) >> 3) ^ (((k) >> 3) & 7)) << 3) + ((t) & 7))
#define TSW_B(k, c) ((k) * 144 + (((c) ^ (((k) >> 3) & 7)) << 4))
constexpr int HG_LBOFF = LDSCTL_OFF + 4096;
__device__ __forceinline__ void hg_stage_lb(const int tid, PRef p, int l) {
    LAS float* dst = (LAS float*)((LAS unsigned char*)lds_raw + HG_LBOFF);
    for (int i = tid; i < 768; i += NTHR) dst[i] = p.LB[(size_t)((i / 384) * DEPTH + l) * 384 + (i % 384)];
    LDS_BAR();
}
__device__ __forceinline__ void hg_gates(const int tid, PRef p, int l, int h, const u32x4 zf, const u32x4 zb, LAS unsigned char* lds) {
    LAS float* FF = (LAS float*)(lds + HG_FF); LAS float* FB = (LAS float*)(lds + HG_FB); LAS float* AF = (LAS float*)(lds + HG_AF); LAS float* AB = (LAS float*)(lds + HG_AB);
    const int t = tid >> 3, cg = tid & 7;
    const LAS float* lbf = (const LAS float*)((LAS unsigned char*)lds_raw + HG_LBOFF) + h * 64 + cg * 8; const LAS float* lbb = lbf + 384;
    float ffv[8], fbv[8];
#pragma unroll
    for (int j = 0; j < 8; ++j) {
        const float z0 = fminf(fmaxf(bf8(zf, j), -60.f), 60.f), z1 = fminf(fmaxf(bf8(zb, j), -60.f), 60.f);
        const float l0 = lbf[j], l1 = lbb[j];
        ffv[j] = l0 + (1.f - l0) * __builtin_amdgcn_rcpf(1.f + __expf(-z0));
        fbv[j] = l1 + (1.f - l1) * __builtin_amdgcn_rcpf(1.f + __expf(-z1));
    }
    *(LAS f32x4*)(FF + HGI(t, cg * 8)) = (f32x4){ffv[0], ffv[1], ffv[2], ffv[3]}; *(LAS f32x4*)(FF + HGI(t, cg * 8 + 4)) = (f32x4){ffv[4], ffv[5], ffv[6], ffv[7]};
    *(LAS f32x4*)(FB + HGI(t, cg * 8)) = (f32x4){fbv[0], fbv[1], fbv[2], fbv[3]}; *(LAS f32x4*)(FB + HGI(t, cg * 8 + 4)) = (f32x4){fbv[4], fbv[5], fbv[6], fbv[7]};
    LDS_BAR();
    {
        const int wave = tid >> 6, lane = tid & 63, cl = lane & 15, seg = lane >> 4, dir = wave >> 2, col = 16 * (wave & 3) + cl;
        const LAS float* F = dir ? FB : FF; LAS float* A = dir ? AB : AF;
        float pre[16]; float run = 0.f;
#pragma unroll
        for (int i = 0; i < 16; ++i) { const int tt = dir ? 16 * seg + 15 - i : 16 * seg + i; run += __logf(F[HGI(tt, col)]); pre[i] = run; }
        const float T0 = __builtin_bit_cast(float, __builtin_amdgcn_ds_bpermute((cl + 0) << 2, __builtin_bit_cast(int, run)));
        const float T1 = __builtin_bit_cast(float, __builtin_amdgcn_ds_bpermute((cl + 16) << 2, __builtin_bit_cast(int, run)));
        const float T2 = __builtin_bit_cast(float, __builtin_amdgcn_ds_bpermute((cl + 32) << 2, __builtin_bit_cast(int, run)));
        const float T3 = __builtin_bit_cast(float, __builtin_amdgcn_ds_bpermute((cl + 48) << 2, __builtin_bit_cast(int, run)));
        const float off = dir ? ((seg < 1 ? T1 : 0.f) + (seg < 2 ? T2 : 0.f) + (seg < 3 ? T3 : 0.f)) : ((seg > 0 ? T0 : 0.f) + (seg > 1 ? T1 : 0.f) + (seg > 2 ? T2 : 0.f));
#pragma unroll
        for (int i = 0; i < 16; ++i) { const int tt = dir ? 16 * seg + 15 - i : 16 * seg + i; A[HGI(tt, col)] = off + pre[i]; }
    }
    LDS_BAR();
}
__device__ __forceinline__ bf16x8 ld2x64(const LAS unsigned char* p0, const LAS unsigned char* p1) {
    const u32x2 a = *(const LAS u32x2*)p0, b = *(const LAS u32x2*)p1; u32x4 r; r.x = a.x; r.y = a.y; r.z = b.x; r.w = b.y; return __builtin_bit_cast(bf16x8, r);
}
typedef short s16x4 __attribute__((ext_vector_type(4)));
__device__ __forceinline__ bf16x8 ld2tr(const LAS unsigned char* p0, const LAS unsigned char* p1) {
    const s16x4 a = __builtin_amdgcn_ds_read_tr16_b64_v4i16((LAS s16x4*)p0), b = __builtin_amdgcn_ds_read_tr16_b64_v4i16((LAS s16x4*)p1);
    return __builtin_shufflevector(a, b, 0, 1, 2, 3, 4, 5, 6, 7);
}
__device__ __forceinline__ f32x4 mfma16(bf16x8 a, bf16x8 b, f32x4 c) { return __builtin_amdgcn_mfma_f32_16x16x32_bf16(a, b, c, 0, 0, 0); }
__device__ __forceinline__ void phase_hgrn_local(const int tid, PRef p, int l, LAS unsigned char* lds) {
    LAS float* FF = (LAS float*)(lds + HG_FF); LAS float* FB = (LAS float*)(lds + HG_FB); LAS float* AF = (LAS float*)(lds + HG_AF); LAS float* AB = (LAS float*)(lds + HG_AB);
    LAS bf16_t* KTf = (LAS bf16_t*)(lds + HG_T0); LAS bf16_t* KTb = (LAS bf16_t*)(lds + HG_T0 + HG_TS); LAS bf16_t* VT = (LAS bf16_t*)(lds + HG_VT);
    const int t = tid >> 3, cg = tid & 7, wave = tid >> 6, lane = tid & 63, fr = lane & 15, fq = lane >> 4;
    u32x4 zf = (u32x4){0u, 0u, 0u, 0u}, zb = zf, v8 = zf, nzf = zf, nzb = zf, nv8 = zf;
    if ((int)blockIdx.x < NBH * NCH) { const int it = blockIdx.x, pc = it % NCH, bh = it / NCH, h = bh % HGH, b = bh / HGH;
        const bf16_t* pr = p.P + (size_t)(hg_row0(b, pc) + t) * INC + h * 64 + cg * 8; zf = *(const u32x4*)(pr + OFF_); zb = *(const u32x4*)(pr + OFB); v8 = *(const u32x4*)(pr + OHI); }
    hg_stage_lb(tid, p, l);
    for (int it = blockIdx.x; it < NBH * NCH; it += gridDim.x) {
        const int pc = it % NCH, bh = it / NCH, h = bh % HGH, b = bh / HGH, row0 = hg_row0(b, pc);
        { const int it2 = min(it + (int)gridDim.x, NBH * NCH - 1); const int pc2 = it2 % NCH, bh2 = it2 / NCH, h2 = bh2 % HGH, b2 = bh2 / HGH;
            const bf16_t* pr = p.P + (size_t)(hg_row0(b2, pc2) + t) * INC + h2 * 64 + cg * 8; nzf = *(const u32x4*)(pr + OFF_); nzb = *(const u32x4*)(pr + OFB); nv8 = *(const u32x4*)(pr + OHI); }
        hg_gates(tid, p, l, h, zf, zb, lds);
        {
            float f8[8], a8[8], e8[8], g8[8], b8[8], h8[8];
            HGLD8(f8, FF, t, cg * 8); HGLD8(a8, AF, t, cg * 8); HGLD8(e8, AF, 63, cg * 8); HGLD8(g8, FB, t, cg * 8); HGLD8(b8, AB, t, cg * 8); HGLD8(h8, AB, 0, cg * 8);
            float kf[8], kb[8];
#pragma unroll
            for (int j = 0; j < 8; ++j) { kf[j] = (1.f - f8[j]) * __expf(e8[j] - a8[j]); kb[j] = (1.f - g8[j]) * __expf(h8[j] - b8[j]); }
            u32x4 wf, wb; wf.x = cvt_pk_bf16(kf[0], kf[1]); wf.y = cvt_pk_bf16(kf[2], kf[3]); wf.z = cvt_pk_bf16(kf[4], kf[5]); wf.w = cvt_pk_bf16(kf[6], kf[7]);
            wb.x = cvt_pk_bf16(kb[0], kb[1]); wb.y = cvt_pk_bf16(kb[2], kb[3]); wb.z = cvt_pk_bf16(kb[4], kb[5]); wb.w = cvt_pk_bf16(kb[6], kb[7]);
            *(LAS u32x4*)(lds + HG_VT + t * 144 + cg * 16) = v8; *(LAS u32x4*)(lds + HG_T0 + t * 144 + cg * 16) = wf; *(LAS u32x4*)(lds + HG_T0 + HG_TS + t * 144 + cg * 16) = wb;
        }
        if (tid < 64) p.GDEC[((size_t)(0 * NBH + bh) * NCH + pc) * 64 + tid] = __expf(AF[HGI(63, tid)]);
        else if (tid < 128) p.GDEC[((size_t)(1 * NBH + bh) * NCH + pc) * 64 + (tid - 64)] = __expf(AB[HGI(0, tid - 64)]);
        LDS_BAR();
#if HGRN_DIAG == 4
        {
            const int v = tid >> 3, kg = tid & 7;
            for (int dir = 0; dir < 2; ++dir) {
                const LAS bf16_t* KT = (const LAS bf16_t*)(lds + HG_T0 + dir * HG_TS);
                float acc[8];
#pragma unroll
                for (int j = 0; j < 8; ++j) acc[j] = 0.f;
                for (int s_ = 0; s_ < 64; ++s_) { const float vv = bf2f(VT[v * 72 + s_]);
#pragma unroll
                    for (int j = 0; j < 8; ++j) acc[j] += bf2f(KT[(kg * 8 + j) * 72 + s_]) * vv; }
                bf16_t* dst = p.SLOC + ((size_t)(dir * NBH + bh) * NCH + pc) * 4096 + v * 64 + kg * 8;
#pragma unroll
                for (int j = 0; j < 8; ++j) dst[j] = f2bf(acc[j]);
            }
        }
#else
        {
            const int dir = wave >> 2, mt = wave & 3;
            const LAS unsigned char* KT = lds + HG_T0 + dir * HG_TS;
            const int trb = (8 * fq + (fr >> 2)) * 144 + 8 * (fr & 3);
            bf16x8 a[2];
#pragma unroll
            for (int ks = 0; ks < 2; ++ks) { const LAS unsigned char* ar = KT + trb + ks * (32 * 144) + mt * 32; a[ks] = ld2tr(ar, ar + 4 * 144); }
            bf16_t* dst = p.SLOC + ((size_t)(dir * NBH + bh) * NCH + pc) * 4096;
            u32x2 w[4];
#pragma unroll
            for (int nt = 0; nt < 4; ++nt) {
                f32x4 acc = (f32x4){0.f, 0.f, 0.f, 0.f};
#pragma unroll
                for (int ks = 0; ks < 2; ++ks) { const LAS unsigned char* br = lds + HG_VT + trb + ks * (32 * 144) + nt * 32; acc = mfma16(a[ks], ld2tr(br, br + 4 * 144), acc); }
                w[nt].x = cvt_pk_bf16(acc[0], acc[1]); w[nt].y = cvt_pk_bf16(acc[2], acc[3]);
            }
            zf = nzf; zb = nzb; v8 = nv8;
            asm volatile("" ::: "memory");
#pragma unroll
            for (int np = 0; np < 2; ++np) {
                const auto rx = __builtin_amdgcn_permlane16_swap(w[2 * np].x, w[2 * np + 1].x, false, false), ry = __builtin_amdgcn_permlane16_swap(w[2 * np].y, w[2 * np + 1].y, false, false);
                u32x4 o; o.x = rx[0]; o.y = ry[0]; o.z = rx[1]; o.w = ry[1];
                *(u32x4*)(dst + ((2 * np + (fq & 1)) * 16 + fr) * 64 + mt * 16 + 4 * (fq & ~1)) = o; }
        }
#endif
        LDS_BAR();
    }
}
__device__ __forceinline__ void phase_hgrn_scan(const int tid, PRef p) {
    constexpr int GS = 20, NG = NCH / GS;
    static_assert(NCH % GS == 0 && NCHC < GS, "scan group size");
    for (int blk = (int)gridDim.x - 1 - (int)blockIdx.x; blk < 2 * NBH * 4; blk += gridDim.x) {
        const int sq = blk >> 2, part = blk & 3, dir = sq / NBH, e0 = part * 1024 + tid * 2, k = e0 & 63;
        unsigned* S = (unsigned*)(p.SLOC + (size_t)sq * NCH * 4096 + e0);
        const float* G = p.GDEC + (size_t)sq * NCH * 64 + k;
        float c0 = 0.f, c1 = 0.f;
        const long sstep = dir ? -2048L : 2048L, gstep = dir ? -64L : 64L;
        unsigned* Sl = S + (size_t)(dir ? NCHC - 1 : 0) * 2048; const float* Gl = G + (size_t)(dir ? NCHC - 1 : 0) * 64; unsigned* Sw = Sl;
        unsigned* S2 = S + (size_t)(dir ? NCH - 1 : NCHC) * 2048; const float* G2 = G + (size_t)(dir ? NCH - 1 : NCHC) * 64;
        unsigned nx[2][GS]; f32x2 gn[2][GS];
#define HG_LD(set, j, u) do { nx[set][u] = *Sl; gn[set][u] = *(const f32x2*)Gl; if ((j) + 1 == NCHC) { Sl = S2; Gl = G2; } else { Sl += sstep; Gl += gstep; } } while (0)
#pragma unroll
        for (int u = 0; u < GS; ++u) HG_LD(0, u, u);
#pragma unroll
        for (int g = 0; g < NG; ++g) {
            asm volatile("" : "+v"(Sl), "+v"(Gl), "+v"(Sw));
            if (g + 1 < NG) {
#pragma unroll
                for (int u = 0; u < GS; ++u) HG_LD((g + 1) & 1, (g + 1) * GS + u, u);
            }
            unsigned w[GS];
#pragma unroll
            for (int u = 0; u < GS; ++u) {
                w[u] = cvt_pk_bf16(c0, c1);
                c0 = gn[g & 1][u][0] * c0 + bfw(nx[g & 1][u], 0); c1 = gn[g & 1][u][1] * c1 + bfw(nx[g & 1][u], 1);
            }
#pragma unroll
            for (int u = 0; u < GS; ++u) { *Sw = w[u]; if (g * GS + u + 1 == NCHC) Sw = S2; else Sw += sstep; }
        }
#undef HG_LD
    }
}
__device__ __forceinline__ void phase_hgrn_out(const int tid, PRef p, int l, LAS unsigned char* lds) {
    const int NCHO = (l + 1 < DEPTH) ? NCH : NCH - NCHC, PC0 = NCH - NCHO;
    LAS float* FF = (LAS float*)(lds + HG_FF); LAS float* FB = (LAS float*)(lds + HG_FB); LAS float* AF = (LAS float*)(lds + HG_AF); LAS float* AB = (LAS float*)(lds + HG_AB);
    LAS bf16_t* VT = (LAS bf16_t*)(lds + HG_VT);
    LAS float* OO = (LAS float*)(lds + HG_AF);
    const int t = tid >> 3, cg = tid & 7, wave = tid >> 6, lane = tid & 63, fr = lane & 15, fq = lane >> 4;
    u32x4 zf = (u32x4){0u, 0u, 0u, 0u}, zb = zf, v8 = zf, q8 = zf, g8 = zf, nzf = zf, nzb = zf, nv8 = zf, nq8 = zf, ng8 = zf;
    bf16x8 bsin[4][2], nbsin[4][2];
#define HG_LOADSIN(dst, bhx, pcx) do { const bf16_t* SIN_ = p.SLOC + ((size_t)((wave >> 2) * NBH + (bhx)) * NCH + (pcx)) * 4096; \
        _Pragma("unroll") for (int vt = 0; vt < 4; ++vt) _Pragma("unroll") for (int ks = 0; ks < 2; ++ks) dst[vt][ks] = *(const bf16x8*)(SIN_ + (vt * 16 + fr) * 64 + ks * 32 + fq * 8); } while (0)
#pragma unroll
    for (int vt = 0; vt < 4; ++vt) { bsin[vt][0] = (bf16x8){0, 0, 0, 0, 0, 0, 0, 0}; bsin[vt][1] = bsin[vt][0]; nbsin[vt][0] = bsin[vt][0]; nbsin[vt][1] = bsin[vt][0]; }
    if ((int)blockIdx.x < NBH * NCHO) { const int it = blockIdx.x, pc = it % NCHO + PC0, bh = it / NCHO, h = bh % HGH, b = bh / HGH;
        const bf16_t* pr = p.P + (size_t)(hg_row0(b, pc) + t) * INC + h * 64 + cg * 8; zf = *(const u32x4*)(pr + OFF_); zb = *(const u32x4*)(pr + OFB); v8 = *(const u32x4*)(pr + OHI); q8 = *(const u32x4*)(pr + OHQ); g8 = *(const u32x4*)(pr + OHG_);
        HG_LOADSIN(bsin, bh, pc); }
    hg_stage_lb(tid, p, l);
    f32x4 hn0, hn1; { const float* nwp = p.hg_norm + l * 64 + cg * 8; hn0 = *(const f32x4*)nwp; hn1 = *(const f32x4*)(nwp + 4); }
    for (int it = blockIdx.x; it < NBH * NCHO; it += gridDim.x) {
        const int pc = it % NCHO + PC0, bh = it / NCHO, h = bh % HGH, b = bh / HGH, row0 = hg_row0(b, pc);
        { const int it2 = min(it + (int)gridDim.x, NBH * NCHO - 1); const int pc2 = it2 % NCHO + PC0, bh2 = it2 / NCHO, h2 = bh2 % HGH, b2 = bh2 / HGH;
            const bf16_t* pr = p.P + (size_t)(hg_row0(b2, pc2) + t) * INC + h2 * 64 + cg * 8; nzf = *(const u32x4*)(pr + OFF_); nzb = *(const u32x4*)(pr + OFB); nv8 = *(const u32x4*)(pr + OHI); nq8 = *(const u32x4*)(pr + OHQ); ng8 = *(const u32x4*)(pr + OHG_);
            HG_LOADSIN(nbsin, bh2, pc2); }
        hg_gates(tid, p, l, h, zf, zb, lds);
        {
            float w[6][8];
            float af8[8], ab8[8], rf8[8], rb8[8], ff8[8], fb8[8];
            HGLD8(af8, AF, t, cg * 8); HGLD8(ab8, AB, t, cg * 8); HGLD8(rf8, AF, 31, cg * 8); HGLD8(rb8, AB, 32, cg * 8); HGLD8(ff8, FF, t, cg * 8); HGLD8(fb8, FB, t, cg * 8);
#pragma unroll
            for (int j = 0; j < 8; ++j) {
                const int k = cg * 8 + j;
                const float qv = bf8(q8, j) * 0.125f, af = af8[j], ab = ab8[j], rf = rf8[j], rb = rb8[j];
                w[0][j] = qv * __expf(fminf(af - rf, 80.f)); w[1][j] = (1.f - ff8[j]) * __expf(fminf(rf - af, 80.f)); w[2][j] = qv * __expf(af);
                w[3][j] = qv * __expf(fminf(ab - rb, 80.f)); w[4][j] = (1.f - fb8[j]) * __expf(fminf(rb - ab, 80.f)); w[5][j] = qv * __expf(ab);
            }
            *(LAS u32x4*)(lds + HG_VT + t * 144 + cg * 16) = v8;
#pragma unroll
            for (int a = 0; a < 6; ++a) { u32x4 o; o.x = cvt_pk_bf16(w[a][0], w[a][1]); o.y = cvt_pk_bf16(w[a][2], w[a][3]); o.z = cvt_pk_bf16(w[a][4], w[a][5]); o.w = cvt_pk_bf16(w[a][6], w[a][7]);
                *(LAS u32x4*)(lds + HG_T0 + a * HG_TS + t * 144 + cg * 16) = o; }
        }
        LDS_BAR();
        {
            const int dir = wave >> 2, tt = wave & 3;
            const LAS unsigned char* QT = lds + HG_T0 + (dir * 3 + 0) * HG_TS; const LAS unsigned char* KL = lds + HG_T0 + (dir * 3 + 1) * HG_TS; const LAS unsigned char* QH = lds + HG_T0 + (dir * 3 + 2) * HG_TS;
            bf16x8 bq[2], bh[2];
#pragma unroll
            for (int ks = 0; ks < 2; ++ks) { bq[ks] = *(const LAS bf16x8*)(QT + (tt * 16 + fr) * 144 + ks * 64 + fq * 16); bh[ks] = *(const LAS bf16x8*)(QH + (tt * 16 + fr) * 144 + ks * 64 + fq * 16); }
            f32x4 o[4];
#pragma unroll
            for (int vt = 0; vt < 4; ++vt) { o[vt] = (f32x4){0.f, 0.f, 0.f, 0.f};
#pragma unroll
                for (int ks = 0; ks < 2; ++ks) o[vt] = mfma16(bsin[vt][ks], bh[ks], o[vt]); }
            const int t_ = 16 * tt + fr;
#pragma unroll
            for (int kp = 0; kp < 2; ++kp) {
                f32x4 sc[2];
#pragma unroll
                for (int hf = 0; hf < 2; ++hf) { const int st = 2 * kp + hf;
                    sc[hf] = (f32x4){0.f, 0.f, 0.f, 0.f};
                    if (dir ? st >= tt : st <= tt) {
#pragma unroll
                        for (int ks = 0; ks < 2; ++ks) { const bf16x8 a = *(const LAS bf16x8*)(KL + (st * 16 + fr) * 144 + ks * 64 + fq * 16); sc[hf] = mfma16(a, bq[ks], sc[hf]); }
#pragma unroll
                        for (int r = 0; r < 4; ++r) { const int s_ = 16 * st + 4 * fq + r; const bool keep = dir ? (s_ >= t_) : (s_ <= t_); sc[hf][r] = keep ? sc[hf][r] : 0.f; }
                    } }
                if (dir ? (2 * kp + 1 >= tt) : (2 * kp <= tt)) {
                    u32x4 pw; pw.x = cvt_pk_bf16(sc[0][0], sc[0][1]); pw.y = cvt_pk_bf16(sc[0][2], sc[0][3]); pw.z = cvt_pk_bf16(sc[1][0], sc[1][1]); pw.w = cvt_pk_bf16(sc[1][2], sc[1][3]);
                    const bf16x8 pf = __builtin_bit_cast(bf16x8, pw);
                    const int s0 = 32 * kp + 4 * fq;
#pragma unroll
                    for (int vt = 0; vt < 4; ++vt) { const LAS unsigned char* vr = lds + HG_VT + (32 * kp + 4 * fq + (fr >> 2)) * 144 + 8 * (fr & 3) + vt * 32;
                        o[vt] = mfma16(ld2tr(vr, vr + 16 * 144), pf, o[vt]); }
                }
            }
            LAS float* OOd = (LAS float*)(lds + (dir ? HG_FB : HG_FF));
#pragma unroll
            for (int vt = 0; vt < 4; ++vt) *(LAS f32x4*)(OOd + HGI(t_, 16 * vt + 4 * fq)) = o[vt];
        }
        LDS_BAR();
        {
            float o[8]; float ss = 0.f;
            float of8[8], ob8[8]; HGLD8(of8, FF, t, cg * 8); HGLD8(ob8, FB, t, cg * 8);
#pragma unroll
            for (int j = 0; j < 8; ++j) { o[j] = of8[j] + ob8[j]; ss += o[j] * o[j]; }
            ss = oct_sum(ss);
            const float rstd = 1.f / sqrtf(ss * (1.f / 64.f) + EPS);
            float y[8];
#pragma unroll
            for (int j = 0; j < 8; ++j) { const float g = bf8(g8, j); y[j] = o[j] * rstd * (j < 4 ? hn0[j & 3] : hn1[j & 3]) * g * __builtin_amdgcn_rcpf(1.f + __expf(-g)); }
            u32x4 ov; ov.x = cvt_pk_bf16(y[0], y[1]); ov.y = cvt_pk_bf16(y[2], y[3]); ov.z = cvt_pk_bf16(y[4], y[5]); ov.w = cvt_pk_bf16(y[6], y[7]);
            zf = nzf; zb = nzb; v8 = nv8; q8 = nq8; g8 = ng8;
#pragma unroll
            for (int vt = 0; vt < 4; ++vt) { bsin[vt][0] = nbsin[vt][0]; bsin[vt][1] = nbsin[vt][1]; }
            asm volatile("" ::: "memory");
            *(u32x4*)(p.MIX + (size_t)(row0 + t) * MIXD + 384 + h * 64 + cg * 8) = ov;
        }
        LDS_BAR();
    }
}


#undef HG_LOADSIN
constexpr int AT_KC = 0, AT_VCT = 36864, AT_KL = AT_VCT + 256 * 144, AT_VL = AT_KL + 3 * 9216, AT_RPB = AT_VL + 3 * 9216, AT_END = AT_RPB + 1920;
static_assert(AT_END <= RING_BYTES && CTX == 256, "attention LDS layout (built for 256 context tokens)");
constexpr float ATHR = 6.f;
template <bool LOCAL, int NKB>
__device__ __forceinline__ void attn_scores(const LAS unsigned char* Kb, const bf16x8 (&qb)[2], f32x4 (&sc)[2 * NKB], int fr, int fq, const LAS float* rpb_row, const int (&boff)[8]) {
#pragma unroll
    for (int mt = 0; mt < 2 * NKB; ++mt) { sc[mt] = (f32x4){0.f, 0.f, 0.f, 0.f};
#pragma unroll
        for (int ks = 0; ks < 2; ++ks) { const bf16x8 a = *(const LAS bf16x8*)(Kb + (16 * mt + fr) * 144 + ks * 64 + fq * 16); sc[mt] = mfma16(a, qb[ks], sc[mt]); } }
    if (LOCAL) {
#pragma unroll
        for (int mt = 0; mt < 2 * NKB; ++mt)
#pragma unroll
            for (int r = 0; r < 4; ++r) sc[mt][r] += *(const LAS float*)((const LAS unsigned char*)rpb_row + boff[(4 * mt + r) & 7]);
    }
}
template <bool LOCAL, int NKB>
__device__ __forceinline__ void attn_spv(const f32x4 (&sc)[2 * NKB], const LAS unsigned char* Vb, f32x4 (&o)[4], float& m, float& lsum, int lane, int vtr) {
    float mx = -INFINITY;
#pragma unroll
    for (int mt = 0; mt < 2 * NKB; ++mt)
#pragma unroll
        for (int r = 0; r < 4; ++r) mx = fmaxf(mx, sc[mt][r]);
    if (__builtin_amdgcn_ballot_w64(mx > m + ATHR) != 0ull) {
        mx = fmaxf(mx, __builtin_bit_cast(float, __builtin_amdgcn_ds_swizzle(__builtin_bit_cast(int, mx), (16 << 10) | 0x1f)));
        mx = fmaxf(mx, __builtin_bit_cast(float, __builtin_amdgcn_ds_bpermute((lane ^ 32) << 2, __builtin_bit_cast(int, mx))));
        const float mn = fmaxf(m, mx), corr = __builtin_amdgcn_exp2f(m - mn);
        m = mn; lsum *= corr;
#pragma unroll
        for (int dt = 0; dt < 4; ++dt) o[dt] = o[dt] * corr;
    }
    float ps = 0.f;
#pragma unroll
    for (int kb = 0; kb < NKB; ++kb) {
        float pv[8];
#pragma unroll
        for (int h2 = 0; h2 < 2; ++h2)
#pragma unroll
            for (int r = 0; r < 4; ++r) { const float e = __builtin_amdgcn_exp2f(sc[2 * kb + h2][r] - m); pv[4 * h2 + r] = e; ps += e; }
        u32x4 pw; pw.x = cvt_pk_bf16(pv[0], pv[1]); pw.y = cvt_pk_bf16(pv[2], pv[3]); pw.z = cvt_pk_bf16(pv[4], pv[5]); pw.w = cvt_pk_bf16(pv[6], pv[7]);
        const bf16x8 pf = __builtin_bit_cast(bf16x8, pw);
#pragma unroll
        for (int dt = 0; dt < 4; ++dt) {
            const LAS unsigned char* vr = Vb + vtr + kb * (32 * 144) + dt * 32;
            o[dt] = mfma16(ld2tr(vr, vr + 16 * 144), pf, o[dt]);
        }
    }
    lsum += ps;
}
__device__ __forceinline__ void phase_attn(const int tid, PRef p, int l, LAS unsigned char* lds) {
    const int wave = tid >> 6, lane = tid & 63, fr = lane & 15, fq = lane >> 4, skey = tid >> 3, sc8 = tid & 7;
    LAS float* RPB = (LAS float*)(lds + AT_RPB);
    constexpr int NPAIR = ROWS / 2; const int IPB = NPAIR + ((l + 1 < DEPTH) ? 2 : 0);
    const int G_ = gridDim.x, NIT = NB * NAH * IPB;
#ifndef AT_DEAL_A
#define AT_DEAL_A 8
#define AT_DEAL_B 3
#endif
    const bool deal = (G_ == 256 && NIT <= 160 * AT_DEAL_A + 96 * AT_DEAL_B);
    const int it_lo = deal ? ((int)blockIdx.x < 160 ? (int)blockIdx.x * AT_DEAL_A : 160 * AT_DEAL_A + ((int)blockIdx.x - 160) * AT_DEAL_B) : (int)blockIdx.x;
    const int it_n = deal ? ((int)blockIdx.x < 160 ? AT_DEAL_A : AT_DEAL_B) : (NIT - (int)blockIdx.x + G_ - 1) / G_;
    int last_bh = -1;
#define AT_QTOK(itx) (((itx) % IPB) < NPAIR ? (((itx) / IPB) / NAH) * SEQ + (2 * ((itx) % IPB) + (wave >> 2)) * GW + 16 * (wave & 3) + fr : NLAT + (((itx) / IPB) / NAH) * CTX + ((((itx) % IPB) - NPAIR) * 128 + 16 * wave) + fr)
#define AT_LOADQ(itx, dst) do { const bf16_t* qp_ = p.P + (size_t)AT_QTOK(itx) * INC + OQ + (((itx) / IPB) % NAH) * 64 + fq * 8; dst[0] = *(const bf16x8*)qp_; dst[1] = *(const bf16x8*)(qp_ + 32); } while (0)
    bf16x8 qnx[2] = {(bf16x8){0, 0, 0, 0, 0, 0, 0, 0}, (bf16x8){0, 0, 0, 0, 0, 0, 0, 0}};
    { const int it0 = it_lo; if (it_n > 0 && it0 < NIT) AT_LOADQ(it0, qnx); }
    for (int ii = 0; ii < it_n; ++ii) {
        const int it = deal ? it_lo + ii : it_lo + ii * G_;
        if (it >= NIT) break;
        const int sub = it % IPB, bh = it / IPB, head = bh % NAH, b = bh / NAH;
        const bool islat = sub < NPAIR;
        const int r0 = 2 * sub, qr = r0 + (wave >> 2), jb = wave & 3;
        LDS_BAR();
        if (bh != last_bh) {
            last_bh = bh;
            int sc8l = sc8; asm volatile("" : "+v"(sc8l));
            for (int rnd = 0; rnd < 4; ++rnd) {
                const int key = skey + 64 * rnd; const bf16_t* src = p.P + (size_t)(NLAT + b * CTX + key) * INC + head * 64 + sc8l * 8;
                const u32x4 kv = *(const u32x4*)(src + OK_), vv = *(const u32x4*)(src + OV);
                *(LAS u32x4*)(lds + AT_KC + key * 144 + sc8 * 16) = kv; *(LAS u32x4*)(lds + AT_VCT + key * 144 + sc8 * 16) = vv;
            }
            { int t2 = tid; asm volatile("" : "+v"(t2));
              if (t2 < 15 * 32) RPB[t2] = (t2 & 31) < 31 ? p.rpb[((size_t)l * NAH + head) * 465 + (t2 >> 5) * 31 + (t2 & 31)] * 1.44269504089f : -INFINITY; }
        }
        const int qtok = islat ? b * SEQ + qr * GW + 16 * jb + fr : NLAT + b * CTX + ((sub - NPAIR) * 128 + 16 * wave) + fr;
        bf16x8 qb[2]; qb[0] = qnx[0]; qb[1] = qnx[1];
        { const int itn = deal ? it + 1 : it + G_; if (ii + 1 < it_n && itn < NIT) { int fr = (tid & 15); asm volatile("" : "+v"(fr)); AT_LOADQ(itn, qnx); } }
        int krlo = 0, krhi = -1, rs = 0;
        if (islat) { int a = r0 - 4; a = a < 0 ? 0 : (a > ROWS - 8 ? ROWS - 8 : a); int c = r0 + 1 - 4; c = c < 0 ? 0 : (c > ROWS - 8 ? ROWS - 8 : c); krlo = a; krhi = c + 7;
            rs = qr - 4; rs = rs < 0 ? 0 : (rs > ROWS - 8 ? ROWS - 8 : rs); }
        u32x4 kA = (u32x4){0u, 0u, 0u, 0u}, vA = kA, kB = kA, vB = kA, kC = kA, vC = kA;
        int skl = skey; asm volatile("" : "+v"(skl));
#define AT_LOADROW(row, kd, vd) do { const bf16_t* src_ = p.P + (size_t)(b * SEQ + (row) * GW + skl) * INC + head * 64 + sc8 * 8; kd = *(const u32x4*)(src_ + OK_); vd = *(const u32x4*)(src_ + OV); } while (0)
#define AT_STAGEROW(bufi, kd, vd) do { *(LAS u32x4*)(lds + AT_KL + (bufi) * 9216 + skey * 144 + sc8 * 16) = kd; *(LAS u32x4*)(lds + AT_VL + (bufi) * 9216 + skey * 144 + sc8 * 16) = vd; } while (0)
        if (islat) { AT_LOADROW(krlo, kA, vA); AT_LOADROW(krlo + 1, kB, vB); AT_LOADROW(krlo + 2, kC, vC); }
        f32x4 o[4]; float m = -1e30f, lsum = 0.f;
#pragma unroll
        for (int dt = 0; dt < 4; ++dt) o[dt] = (f32x4){0.f, 0.f, 0.f, 0.f};
        LDS_BAR();
        const int bs = jb == 0 ? 0 : (jb == 1 ? 8 : (jb == 2 ? 24 : 32)), qc = 16 * jb + fr;
        int boff[8];
        { int ws = qc - 8; ws = ws < 0 ? 0 : (ws > 48 ? 48 : ws);
#pragma unroll
          for (int j_ = 0; j_ < 8; ++j_) { const int kc = bs + 16 * (j_ >> 2) + 4 * fq + (j_ & 3); const bool ok = kc >= ws && kc < ws + 16; boff[j_] = (ok ? kc - qc + 15 : 31) * 4; asm volatile("" : "+v"(boff[j_])); } }
        int vtr = (4 * fq + (fr >> 2)) * 144 + 8 * (fr & 3); asm volatile("" : "+v"(vtr));
        const int vtrl = vtr + bs * 144;
        {
            f32x4 sa[4], sb[4];
#define AT_CS(st, dst) attn_scores<false, 2>(lds + AT_KC + (st) * 64 * 144, qb, dst, fr, fq, RPB, boff)
#define AT_CP(st, src) attn_spv<false, 2>(src, lds + AT_VCT + (st) * 64 * 144, o, m, lsum, lane, vtr)
            AT_CS(0, sa); AT_CS(1, sb); AT_CP(0, sa); AT_CS(2, sa); AT_CP(1, sb); AT_CS(3, sb); AT_CP(2, sa); AT_CP(3, sb);
#undef AT_CS
#undef AT_CP
        }
        if (islat) { AT_STAGEROW(0, kA, vA); AT_LOADROW(krlo + 3, kA, vA); AT_STAGEROW(1, kB, vB); AT_LOADROW(krlo + 4, kB, vB); }
        LDS_BAR();
        if (islat) {
            const bool first0 = rs == krlo, last8 = !first0;
            const LAS float* rp = RPB + (krlo - qr + 7) * 32;
            f32x4 sa[2], sb[2];
#define AT_S(j, dst) attn_scores<true, 1>(lds + AT_KL + ((j) % 3) * 9216 + bs * 144, qb, dst, fr, fq, rp + 32 * (j), boff)
#define AT_P(j, src) attn_spv<true, 1>(src, lds + AT_VL + ((j) % 3) * 9216, o, m, lsum, lane, vtrl)
#define AT_MID(j, NK, NV, LOADROWX, SCUR, SNXT) { AT_STAGEROW(((j) + 2) % 3, NK, NV); if ((LOADROWX) >= 0) { AT_LOADROW(min(krlo + (LOADROWX), krhi), NK, NV); } \
            AT_S((j) + 1, SNXT); AT_P(j, SCUR); LDS_BAR(); }
            sa[0] = (f32x4){0.f, 0.f, 0.f, 0.f}; sa[1] = sa[0];
            if (first0) AT_S(0, sa);
            { AT_STAGEROW(2, kC, vC); AT_LOADROW(krlo + 5, kC, vC); AT_S(1, sb); if (first0) AT_P(0, sa); LDS_BAR(); }
            AT_MID(1, kA, vA, 6, sb, sa) AT_MID(2, kB, vB, 7, sa, sb) AT_MID(3, kC, vC, 8, sb, sa) AT_MID(4, kA, vA, -1, sa, sb) AT_MID(5, kB, vB, -1, sb, sa) AT_MID(6, kC, vC, -1, sa, sb)
            if (last8) { AT_S(8, sa); AT_P(7, sb); AT_P(8, sa); } else { AT_P(7, sb); }
#undef AT_S
#undef AT_P
#undef AT_MID
        }
#undef AT_LOADROW
#undef AT_STAGEROW
        lsum = x32_sum(x16_sum(lsum, lane), lane);
        const float inv = 1.f / lsum;
        bf16_t* orow = p.MIX + (size_t)qtok * MIXD + head * 64;
#pragma unroll
        for (int dp = 0; dp < 2; ++dp) {
            u32x2 w[2];
#pragma unroll
            for (int c = 0; c < 2; ++c) { const int dt = 2 * dp + c; w[c].x = cvt_pk_bf16(o[dt][0] * inv, o[dt][1] * inv); w[c].y = cvt_pk_bf16(o[dt][2] * inv, o[dt][3] * inv); }
            const auto rx = __builtin_amdgcn_permlane16_swap(w[0].x, w[1].x, false, false), ry = __builtin_amdgcn_permlane16_swap(w[0].y, w[1].y, false, false);
            u32x4 ov; ov.x = rx[0]; ov.y = ry[0]; ov.z = rx[1]; ov.w = ry[1];
            *(u32x4*)(orow + 16 * (2 * dp + (fq & 1)) + 4 * (fq & ~1)) = ov; }
    }
}


#undef AT_QTOK
#undef AT_LOADQ
template <int MODE> __device__ __forceinline__ void mini_gemm(const int tid, PRef p, int l) {
    const int wave = tid >> 6, lane = tid & 63, fr = lane & 15, fq = lane >> 4;
    const int gw = blockIdx.x * NWAVES + wave, NGW = gridDim.x * NWAVES;
    constexpr int K = MODE == 3 ? ED : (MODE == 1 ? MIXD : D);
    constexpr int N = MODE == 0 ? INC : (MODE == 2 ? 2 * ED : D);
    constexpr int MROWS = MODE <= 1 ? NCTX : NSLOT_C;
    constexpr int NTC = MODE == 2 ? 2 : 1, TW = 16 * NTC;
    constexpr int NTN = N / TW, NT = (MROWS / 32) * NTN;
    for (int t = gw; t < NT; t += NGW) {
        const int rt = t / NTN, ct = t % NTN, c0 = ct * TW;
        const bf16_t* Bt; const bf16_t* arow[2];
        if (MODE == 0) { Bt = p.WIN_T + WBOFF(l); for (int mt = 0; mt < 2; ++mt) arow[mt] = p.H + (size_t)(NLAT + rt * 32 + 16 * mt + fr) * D; }
        else if (MODE == 1) { Bt = p.WOUT_T + WBOFF(l); for (int mt = 0; mt < 2; ++mt) arow[mt] = p.MIX + (size_t)(NLAT + rt * 32 + 16 * mt + fr) * MIXD; }
        else if (MODE == 2) { const int e = rt % NE; Bt = p.WGU_T + WBOFF(l) + (size_t)e * 2 * ED * D;
            for (int mt = 0; mt < 2; ++mt) { int row = p.STOK[NSLOT_L + rt * 32 + 16 * mt + fr]; row = row < 0 ? 0 : (row >= NTOK ? NTOK - 1 : row); arow[mt] = p.H + (size_t)row * D; } }
        else { const int e = rt % NE; Bt = p.WD_T + WBOFF(l) + (size_t)e * D * ED; for (int mt = 0; mt < 2; ++mt) arow[mt] = p.HID + (size_t)(NSLOT_L + rt * 32 + 16 * mt + fr) * ED; }
        const bf16_t* brow = Bt + (size_t)(c0 + fr) * K;
        f32x4 acc[2][NTC];
#pragma unroll
        for (int mt = 0; mt < 2; ++mt)
#pragma unroll
            for (int nt = 0; nt < NTC; ++nt) acc[mt][nt] = (f32x4){0.f, 0.f, 0.f, 0.f};
#pragma unroll 8
        for (int ks = 0; ks < K / 32; ++ks) {
            bf16x8 a[2], bfr[NTC];
#pragma unroll
            for (int mt = 0; mt < 2; ++mt) a[mt] = *(const bf16x8*)(arow[mt] + ks * 32 + fq * 8);
#pragma unroll
            for (int nt = 0; nt < NTC; ++nt) bfr[nt] = *(const bf16x8*)(brow + (size_t)(16 * nt) * K + ks * 32 + fq * 8);
#pragma unroll
            for (int mt = 0; mt < 2; ++mt)
#pragma unroll
                for (int nt = 0; nt < NTC; ++nt) acc[mt][nt] = mfma16(a[mt], bfr[nt], acc[mt][nt]);
        }
#pragma unroll
        for (int mt = 0; mt < 2; ++mt)
#pragma unroll
            for (int r = 0; r < 4; ++r) {
                const int lr = rt * 32 + 16 * mt + 4 * fq + r;
                if (MODE == 0) { bf16_t* o = p.P + (size_t)(NLAT + lr) * INC + c0 + fr;
#pragma unroll
                    for (int nt = 0; nt < NTC; ++nt) o[16 * nt] = f2bf(acc[mt][nt][r]); }
                else if (MODE == 1) { float* o = p.XC + (size_t)lr * D + c0 + fr; const float* g = p.MOD + ((size_t)l * 3 + 2) * NMOD + 2 * D + c0 + fr;
#pragma unroll
                    for (int nt = 0; nt < NTC; ++nt) o[16 * nt] += g[16 * nt] * acc[mt][nt][r]; }
                else if (MODE == 2) { bf16_t* o = p.HID + (size_t)(NSLOT_L + lr) * ED + c0 / 2 + fr;
#pragma unroll
                    for (int q = 0; q < NTC / 2; ++q) { const float g = acc[mt][2 * q][r], u = acc[mt][2 * q + 1][r]; o[16 * q] = f2bf(g / (1.f + __expf(-g)) * u); } }
                else { bf16_t* o = p.Y + (size_t)(NSLOT_L + lr) * D + c0 + fr; const float val = p.SVAL[NSLOT_L + lr];
#pragma unroll
                    for (int nt = 0; nt < NTC; ++nt) o[16 * nt] = f2bf(val * acc[mt][nt][r]); }
            }
    }
}


__device__ __forceinline__ void phase_conv(const int tid, PRef p, int l) {
    const float* w = p.conv_w + (size_t)l * 3 * CVD;
    constexpr int U = 2;
    const long nitem = (long)NTOK * (CVD / 8), gstr = (long)gridDim.x * NTHR;
    for (long g0 = (long)blockIdx.x * NTHR + tid; g0 < nitem; g0 += gstr * U) {
        u32x4 cc[U][3], uu[U][3], bg[U]; float vz[U][3]; int rr[U], c8v[U]; bool ok[U];
#pragma unroll
        for (int u = 0; u < U; ++u) {
            long gid = g0 + u * gstr; ok[u] = gid < nitem; if (!ok[u]) gid = g0;
            const int r = (int)(gid / (CVD / 8)), c8 = (int)(gid % (CVD / 8)) * 8; rr[u] = r; c8v[u] = c8;
            int t, T; if (r < NLAT) { t = r % SEQ; T = SEQ; } else { t = (r - NLAT) % CTX; T = CTX; }
            const bf16_t* pr = p.P + (size_t)r * INC + c8;
#pragma unroll
            for (int d = 0; d < 3; ++d) { const int tt = t + d - 1; const bool in = tt >= 0 && tt < T; vz[u][d] = in ? 1.f : 0.f;
                const bf16_t* q = pr + (in ? (long)(d - 1) * INC : 0L); cc[u][d] = *(const u32x4*)(q + OCC); uu[u][d] = *(const u32x4*)(q + OCU); }
            bg[u] = *(const u32x4*)(pr + OCB);
        }
        asm volatile("" ::: "memory");
#pragma unroll
        for (int u = 0; u < U; ++u) {
            float y[8];
#pragma unroll
            for (int j = 0; j < 8; ++j) y[j] = 0.f;
#pragma unroll
            for (int d = 0; d < 3; ++d) {
                const f32x4 w0 = *(const f32x4*)(w + d * CVD + c8v[u]) * vz[u][d], w1 = *(const f32x4*)(w + d * CVD + c8v[u] + 4) * vz[u][d];
#pragma unroll
                for (int j = 0; j < 8; ++j) y[j] += (j < 4 ? w0[j & 3] : w1[j & 3]) * bf8(cc[u][d], j) * bf8(uu[u][d], j);
            }
            u32x4 o; o.x = cvt_pk_bf16(bf8(bg[u], 0) * y[0], bf8(bg[u], 1) * y[1]); o.y = cvt_pk_bf16(bf8(bg[u], 2) * y[2], bf8(bg[u], 3) * y[3]);
            o.z = cvt_pk_bf16(bf8(bg[u], 4) * y[4], bf8(bg[u], 5) * y[5]); o.w = cvt_pk_bf16(bf8(bg[u], 6) * y[6], bf8(bg[u], 7) * y[7]);
            if (ok[u]) *(u32x4*)(p.MIX + (size_t)rr[u] * MIXD + 768 + c8v[u]) = o;
        }
    }
}
__device__ __forceinline__ void phase_qkprep(const int tid, PRef p, int l) {
    const int sub = tid & 7;
    constexpr int U = 4;
    const long ngroups = (long)NTOK * 12, gstride = ((long)gridDim.x * NTHR) >> 3;
    for (long g0 = ((long)blockIdx.x * NTHR + tid) >> 3; g0 < ngroups; g0 += gstride * U) {
        u32x4 raw[U]; bf16_t* ptr[U]; int rr[U]; int wh[U];
#pragma unroll
        for (int u = 0; u < U; ++u) { long g8 = g0 + u * gstride; const bool ok = g8 < ngroups; if (!ok) g8 = g0;
            rr[u] = ok ? (int)(g8 / 12) : -1; wh[u] = (int)(g8 % 12) / 6; const int head = (int)(g8 % 6);
            ptr[u] = p.P + (size_t)(g8 / 12) * INC + (wh[u] ? OK_ : OQ) + head * HD + sub * 8; raw[u] = *(const u32x4*)ptr[u]; }
#pragma unroll
        for (int u = 0; u < U; ++u) {
            const float* nw = (wh[u] ? p.k_norm : p.q_norm) + l * HD + sub * 8;
            float y[8]; float ss = 0.f;
#pragma unroll
            for (int j = 0; j < 8; ++j) { y[j] = bf8(raw[u], j); ss += y[j] * y[j]; }
            ss = oct_sum(ss);
            const float rstd = 1.f / sqrtf(ss * (1.f / HD) + EPS);
#pragma unroll
            for (int j = 0; j < 8; ++j) y[j] = y[j] * rstd * nw[j];
            const int r = rr[u];
            const bool lat = r >= 0 && r < NLAT;
            const int t = lat ? r % SEQ : 0; const float pos = (sub & 4) ? (float)(t % GW) : (float)(t / GW);
            const bool second = (sub & 2) != 0;
#pragma unroll
            for (int j = 0; j < 8; ++j) {
                const float other = __builtin_bit_cast(float, __builtin_amdgcn_ds_swizzle(__builtin_bit_cast(int, y[j]), (2 << 10) | 0x1f));
                const int fi = (sub & 1) * 8 + j;
                const float ang = pos * __builtin_amdgcn_exp2f(-(float)fi * (13.287712379549449f / 16.f));
                const float cs = FCOS(ang), sn = FSIN(ang);
                const float rot = second ? y[j] * cs + other * sn : y[j] * cs - other * sn;
                y[j] = lat ? rot : y[j];
            }
            if (r >= 0) { u32x4 o; o.x = cvt_pk_bf16(y[0], y[1]); o.y = cvt_pk_bf16(y[2], y[3]); o.z = cvt_pk_bf16(y[4], y[5]); o.w = cvt_pk_bf16(y[6], y[7]); *(u32x4*)ptr[u] = o; }
        }
    }
}

__device__ __forceinline__ f32x4 bf4(const u32x2 w) { return (f32x4){bfw(w.x, 0), bfw(w.x, 1), bfw(w.y, 0), bfw(w.y, 1)}; }
template <int MODE> __device__ __forceinline__ void phase_rows(const int tid, PRef p, int l, LAS unsigned char* lds) {
    static_assert(D == 1024, "wave-per-row kernels assume D = 1024");
    const int lane = tid & 63, wave = tid >> 6;
#define RC(j) (8 * lane + 512 * ((j) >> 1) + 4 * ((j) & 1))
    if (MODE == 1) {
        for (int k = tid; k < D; k += NTHR) { const f32x4* src = (const f32x4*)(p.w_router + ((size_t)l * D + k) * NE); LAS f32x4* dst = (LAS f32x4*)(lds + k * 64 + (k >> 3) * 16);
#pragma unroll
            for (int u = 0; u < 4; ++u) dst[u] = src[u]; }
        __syncthreads();
    }
    const int gw = blockIdx.x * NWAVES + wave, NGW = gridDim.x * NWAVES;
    const int rw = ((NTOK + NGW - 1) / NGW + 1) & ~1;
    const int r_lo = gw * rw, r_hi = min(NTOK, r_lo + rw);
    const bool doh = MODE != 2 || l + 1 < DEPTH;
    const int ln = (MODE == 2 && l + 1 < DEPTH) ? l + 1 : l;
    const float* nw = (MODE == 1 ? p.norm2_w : p.norm1_w) + (size_t)ln * D;
    int curset = -1; f32x4 Av[4], Sv[4], Gv[4];
#pragma unroll
    for (int j = 0; j < 4; ++j) { Av[j] = (f32x4){0.f, 0.f, 0.f, 0.f}; Sv[j] = Av[j]; Gv[j] = Av[j]; }
    constexpr int NVN = MODE == 0 ? 4 : 2;
    u32x4 vn[2][NVN]; int invn[2] = {-1, -1};
#define ROWS_LOADPAIR(rb) do { _Pragma("unroll") for (int i_ = 0; i_ < 2; ++i_) { const int rr_ = ((rb) + i_ < r_hi) ? (rb) + i_ : (rb); \
        if (MODE == 0) { const float* src_ = rr_ < NLAT ? p.x + (size_t)rr_ * D : p.ctx + (size_t)(rr_ - NLAT) * D; \
            _Pragma("unroll") for (int j_ = 0; j_ < NVN; ++j_) vn[i_][j_] = *(const u32x4*)(src_ + RC(j_)); } \
        else if (rr_ < NLAT) { const bf16_t* src_ = p.XB + (size_t)rr_ * D + 8 * lane; vn[i_][0] = *(const u32x4*)src_; vn[i_][1] = *(const u32x4*)(src_ + 512); } \
        if (MODE == 2) invn[i_] = lane < NE ? p.INV[(size_t)rr_ * NE + lane] : -1; } } while (0)
#pragma unroll
    for (int i = 0; i < 2; ++i)
#pragma unroll
        for (int j = 0; j < NVN; ++j) vn[i][j] = (u32x4){0u, 0u, 0u, 0u};
    if (r_lo < r_hi) ROWS_LOADPAIR(r_lo);
#pragma unroll 1
    for (int r = r_lo; r < r_hi; r += 2) {
        const bool two = r + 1 < r_hi;
        const bool lat = r < NLAT;
        const int set = modset(r);
        if (set != curset) { curset = set;
            const float* mod = p.MOD + ((size_t)ln * 3 + set) * NMOD; const float* shift = mod + (MODE == 1 ? 3 : 0) * D; const float* scale = mod + (MODE == 1 ? 4 : 1) * D;
            int lane2 = lane; asm volatile("" : "+v"(lane2));
#pragma unroll
            for (int j = 0; j < 4; ++j) { const int c = 8 * lane2 + 512 * (j >> 1) + 4 * (j & 1); const f32x4 w4 = *(const f32x4*)(nw + c), sc4 = *(const f32x4*)(scale + c); Av[j] = w4 * (sc4 + 1.f); Sv[j] = *(const f32x4*)(shift + c);
                if (MODE == 2) Gv[j] = *(const f32x4*)(p.MOD + ((size_t)l * 3 + set) * NMOD + 5 * D + c); } }
        f32x4 v[2][4]; int inv2[2];
#pragma unroll
        for (int i = 0; i < 2; ++i) { inv2[i] = invn[i];
            if (MODE == 0) {
#pragma unroll
                for (int j = 0; j < 4; ++j) v[i][j] = __builtin_bit_cast(f32x4, vn[i][j < NVN ? j : 0]);
            } else if (lat) {
#pragma unroll
                for (int jj = 0; jj < 2; ++jj) { const u32x4 w = vn[i][jj]; v[i][2 * jj] = (f32x4){bfw(w.x, 0), bfw(w.x, 1), bfw(w.y, 0), bfw(w.y, 1)}; v[i][2 * jj + 1] = (f32x4){bfw(w.z, 0), bfw(w.z, 1), bfw(w.w, 0), bfw(w.w, 1)}; }
            } else { const float* src = p.XC + (size_t)(r + ((i == 0 || two) ? i : 0) - NLAT) * D;
#pragma unroll
                for (int j = 0; j < 4; ++j) v[i][j] = *(const f32x4*)(src + RC(j));
            } }
        if (r + 2 < r_hi) ROWS_LOADPAIR(r + 2);
        if (MODE == 2) {
            unsigned long long mk[2]; int sl[2][2];
#pragma unroll
            for (int i = 0; i < 2; ++i) { const int myinv = inv2[i]; mk[i] = __ballot(myinv >= 0 && myinv < NSLOT);
#pragma unroll
                for (int c = 0; c < 2; ++c) { sl[i][c] = -1; if (mk[i]) { const int e = __builtin_ctzll(mk[i]); mk[i] &= mk[i] - 1; sl[i][c] = __builtin_amdgcn_readlane(myinv, e); } } }
            u32x4 y[2][2][2];
#pragma unroll
            for (int i = 0; i < 2; ++i)
#pragma unroll
                for (int c = 0; c < 2; ++c) { y[i][c][0] = (u32x4){0u, 0u, 0u, 0u}; y[i][c][1] = y[i][c][0];
                    if (sl[i][c] >= 0) { const bf16_t* yp = p.Y + (size_t)sl[i][c] * D + 8 * lane; y[i][c][0] = *(const u32x4*)yp; y[i][c][1] = *(const u32x4*)(yp + 512); } }
            asm volatile("" ::: "memory");
#pragma unroll
            for (int i = 0; i < 2; ++i) {
                f32x4 acc[4];
#pragma unroll
                for (int j = 0; j < 4; ++j) acc[j] = (f32x4){0.f, 0.f, 0.f, 0.f};
#pragma unroll
                for (int c = 0; c < 2; ++c)
#pragma unroll
                    for (int jj = 0; jj < 2; ++jj) { const u32x4 w = y[i][c][jj];
                        acc[2 * jj] = acc[2 * jj] + (f32x4){bfw(w.x, 0), bfw(w.x, 1), bfw(w.y, 0), bfw(w.y, 1)}; acc[2 * jj + 1] = acc[2 * jj + 1] + (f32x4){bfw(w.z, 0), bfw(w.z, 1), bfw(w.w, 0), bfw(w.w, 1)}; }
                const int myinv = inv2[i];
                while (mk[i]) {
                    const int e = __builtin_ctzll(mk[i]); mk[i] &= mk[i] - 1; const int s0 = __builtin_amdgcn_readlane(myinv, e);
                    const bf16_t* yp = p.Y + (size_t)s0 * D + 8 * lane; const u32x4 w0 = *(const u32x4*)yp, w1 = *(const u32x4*)(yp + 512);
                    acc[0] = acc[0] + (f32x4){bfw(w0.x, 0), bfw(w0.x, 1), bfw(w0.y, 0), bfw(w0.y, 1)}; acc[1] = acc[1] + (f32x4){bfw(w0.z, 0), bfw(w0.z, 1), bfw(w0.w, 0), bfw(w0.w, 1)};
                    acc[2] = acc[2] + (f32x4){bfw(w1.x, 0), bfw(w1.x, 1), bfw(w1.y, 0), bfw(w1.y, 1)}; acc[3] = acc[3] + (f32x4){bfw(w1.z, 0), bfw(w1.z, 1), bfw(w1.w, 0), bfw(w1.w, 1)};
                }
#pragma unroll
                for (int j = 0; j < 4; ++j) v[i][j] = v[i][j] + Gv[j] * acc[j];
            }
        }
        if (MODE == 0 || MODE == 2) {
            const bool fin = MODE == 2 && l + 1 == DEPTH;
#pragma unroll
            for (int i = 0; i < 2; ++i) if (i == 0 || two) {
                if (lat && !fin) {
#pragma unroll
                    for (int jj = 0; jj < 2; ++jj) { u32x4 o; o.x = cvt_pk_bf16(v[i][2 * jj][0], v[i][2 * jj][1]); o.y = cvt_pk_bf16(v[i][2 * jj][2], v[i][2 * jj][3]); o.z = cvt_pk_bf16(v[i][2 * jj + 1][0], v[i][2 * jj + 1][1]); o.w = cvt_pk_bf16(v[i][2 * jj + 1][2], v[i][2 * jj + 1][3]);
                        *(u32x4*)(p.XB + (size_t)(r + i) * D + 8 * lane + 512 * jj) = o; }
                } else if (lat || !fin) { float* dst = lat ? p.XL + (size_t)(r + i) * D : p.XC + (size_t)(r + i - NLAT) * D;
#pragma unroll
                    for (int j = 0; j < 4; ++j) *(f32x4*)(dst + RC(j)) = v[i][j]; }
            }
        }
        if (doh) {
            float ss[2];
#pragma unroll
            for (int i = 0; i < 2; ++i) { float a = 0.f;
#pragma unroll
                for (int j = 0; j < 4; ++j) a += (v[i][j][0] * v[i][j][0] + v[i][j][1] * v[i][j][1]) + (v[i][j][2] * v[i][j][2] + v[i][j][3] * v[i][j][3]);
                ss[i] = a; }
            ss[0] = wave_sum(ss[0], lane); ss[1] = wave_sum(ss[1], lane);
            const float rstd0 = 1.f / sqrtf(ss[0] * (1.f / D) + EPS), rstd1 = 1.f / sqrtf(ss[1] * (1.f / D) + EPS);
            f32x4 hh[2][4];
#pragma unroll
            for (int j = 0; j < 4; ++j) { hh[0][j] = v[0][j] * rstd0 * Av[j] + Sv[j]; hh[1][j] = v[1][j] * rstd1 * Av[j] + Sv[j]; }
#pragma unroll
            for (int i = 0; i < 2; ++i) if (i == 0 || two) {
#pragma unroll
                for (int jj = 0; jj < 2; ++jj) { u32x4 o; o.x = cvt_pk_bf16(hh[i][2 * jj][0], hh[i][2 * jj][1]); o.y = cvt_pk_bf16(hh[i][2 * jj][2], hh[i][2 * jj][3]); o.z = cvt_pk_bf16(hh[i][2 * jj + 1][0], hh[i][2 * jj + 1][1]); o.w = cvt_pk_bf16(hh[i][2 * jj + 1][2], hh[i][2 * jj + 1][3]);
                    *(u32x4*)(p.H + (size_t)(r + i) * D + 8 * lane + 512 * jj) = o; } }
            if (MODE == 1) {
                LAS float* red = (LAS float*)(lds + 70144 + wave * 4224);
                LAS float* red1 = (LAS float*)(wave < 6 ? lds + 103936 + wave * 4224 : lds + LDSCTL_OFF + 1024 + (wave - 6) * 4224);
                const LAS unsigned char* wb = lds + lane * 528;
#pragma unroll
                for (int u = 0; u < 4; ++u) {
                    f32x4 a0 = (f32x4){0.f, 0.f, 0.f, 0.f}, a1 = a0;
#pragma unroll
                    for (int j = 0; j < 4; ++j)
#pragma unroll
                        for (int q = 0; q < 4; ++q) { const f32x4 w = *(const LAS f32x4*)(wb + (j >> 1) * 33792 + (4 * (j & 1) + q) * 64 + u * 16); const float h0 = hh[0][j][q], h1 = hh[1][j][q];
                            a0 = __builtin_elementwise_fma(w, (f32x4){h0, h0, h0, h0}, a0); a1 = __builtin_elementwise_fma(w, (f32x4){h1, h1, h1, h1}, a1); }
#pragma unroll
                    for (int c = 0; c < 4; ++c) { red[(4 * u + c) * 65 + lane] = a0[c]; red1[(4 * u + c) * 65 + lane] = a1[c]; }
                    asm volatile("" ::: "memory");
                }
#pragma unroll
                for (int i = 0; i < 2; ++i) {
                    const LAS float* rd = i ? red1 : red;
                    const int e2 = lane & 15, part = lane >> 4;
                    float t = 0.f;
#pragma unroll
                    for (int x = 0; x < 16; ++x) t += rd[e2 * 65 + part * 16 + x];
                    asm volatile("" ::: "memory");
                    t = x32_sum(x16_sum(t, lane), lane);
#define SWZF(x, d) __builtin_bit_cast(float, __builtin_amdgcn_ds_swizzle(__builtin_bit_cast(int, (x)), ((d) << 10) | 0x1f))
                    float m = t;
                    m = row16_max(m);
                    const float ex = expf(t - m); float sm = ex;
                    sm = row16_sum(sm);
#undef SWZF
                    if (lane < NE && (i == 0 || two)) p.AFF[(size_t)(r + i) * NE + lane] = ex / sm;
                }
            }
        }
    }
#undef ROWS_LOADPAIR
#undef RC
    if (MODE == 1) __syncthreads();
}


__device__ __forceinline__ void phase_adaln(const int tid, PRef p, LAS unsigned char* lds) {
    static_assert(D == 1024 && NMOD % 256 == 0, "adaln layout");
    const int lane = tid & 63, wave = tid >> 6;
    LAS float* SC = (LAS float*)lds;
    LAS float* RED = (LAS float*)(lds + 16384);
    for (int i = tid; i < 3 * D; i += NTHR) { const int st = i / D, k = i % D; const float cv = st < 2 ? p.c[st * D + k] : p.c_ctx[k]; SC[i] = cv / (1.f + __expf(-cv)); }
    __syncthreads();
    constexpr int NCG = NMOD / 256;
    for (int item = blockIdx.x; item < DEPTH * NCG * 2; item += gridDim.x) {
        const int l = item / (NCG * 2), rem = item % (NCG * 2), cgp = rem >> 1, kh = rem & 1;
        const int kbase = kh * 512 + wave * 64;
        const float* wp = p.w_mod + ((size_t)l * D + kbase) * NMOD + cgp * 256 + 4 * lane;
        f32x4 acc[3];
#pragma unroll
        for (int st = 0; st < 3; ++st) acc[st] = (f32x4){0.f, 0.f, 0.f, 0.f};
#pragma unroll 16
        for (int kk = 0; kk < 64; ++kk) { const f32x4 w = *(const f32x4*)(wp + (size_t)kk * NMOD);
#pragma unroll
            for (int st = 0; st < 3; ++st) acc[st] = acc[st] + w * SC[st * D + kbase + kk]; }
#pragma unroll
        for (int st = 0; st < 3; ++st) *(LAS f32x4*)(RED + (wave * 3 + st) * 256 + 4 * lane) = acc[st];
        __syncthreads();
        for (int o = tid; o < 3 * 256; o += NTHR) { const int st = o >> 8, n = o & 255; float v = 0.f;
#pragma unroll
            for (int w8 = 0; w8 < 8; ++w8) v += RED[(w8 * 3 + st) * 256 + n];
            if (kh == 0) v += p.b_mod[(size_t)l * NMOD + cgp * 256 + n];
            atomicAdd(p.MOD + ((size_t)l * 3 + st) * NMOD + cgp * 256 + n, v); }
        __syncthreads();
    }
}

constexpr int NPL = 11, NPH = 1 + DEPTH * NPL;
struct Args { Params p; int ph_lo, ph_hi; };
__global__ void __launch_bounds__(NTHR, 2) mega_fwd(Args args) {
    LAS unsigned char* lds = (LAS unsigned char*)lds_raw;
    {
        const int tid0 = threadIdx.x;
        for (int u = tid0; u < (LDS_BYTES - LDSCTL_OFF) / 4; u += NTHR) ((LAS unsigned*)(lds + LDSCTL_OFF))[u] = 0u;
        __syncthreads();
    }
    int wslot = 0;
    { unsigned m_ = ~0u; asm volatile("" : "+s"(m_));
      const int simd = (int)(__builtin_amdgcn_s_getreg((1 << 11) | (4 << 6) | 4) & 3u);
      if (__builtin_amdgcn_mbcnt_hi(m_, __builtin_amdgcn_mbcnt_lo(m_, 0u)) == 0) wslot = simd + 4 * (int)__hip_atomic_fetch_add(((unsigned*)(lds_raw + MISC_OFF + 64)) + simd, 1u, __ATOMIC_RELAXED, __HIP_MEMORY_SCOPE_WORKGROUP); }
    wslot = __builtin_amdgcn_readfirstlane(wslot) & 7;
#define MY_TID(var) int var; { unsigned m_ = ~0u; asm volatile("" : "+s"(m_)); var = wslot * 64 + (int)__builtin_amdgcn_mbcnt_hi(m_, __builtin_amdgcn_mbcnt_lo(m_, 0u)); } asm volatile("" : "+v"(var))
    XcdBarrier bar; bar.bar = args.p.CTL; bar.x = 0;
    const bool multi = args.ph_hi - args.ph_lo > 1;
    if (multi) { MY_TID(t0); bar = xcd_barrier_post(args.p.CTL, t0 == 0); }
    const int G = gridDim.x;
    const int ph_lo = args.ph_lo, ph_hi = args.ph_hi;
#ifndef PHMASK
#define PHMASK 0xFFFF
#endif
#define PH_ON(k) ((k) == 0 ? (PHMASK & 1) : ((PHMASK >> (1 + ((k) - 1) % NPL)) & 1))
#ifndef REPMASK
#define REPMASK 0
#endif
#ifndef REP_LOCAL
#define REP_LOCAL 0
#define REP_CONV 0
#define REP_ATTN 0
#endif
#ifndef HG_STOP
#define HG_STOP 0
#endif
#ifndef REP_P0
#define REP_P0 0
#endif
#define REP_N(k) (((k) == 0 && REP_P0) ? 2 : (((k) > 0 && ((REPMASK >> (((k) - 1) % NPL)) & 1)) ? 2 : 1))
#define PH_BEGIN(k) if (PH_ON(k) && ph_lo <= (k) && (k) < ph_hi) { for (int rep_ = 0; rep_ < REP_N(k); ++rep_) { const AS4 Args* kp = (const AS4 Args*)__builtin_amdgcn_kernarg_segment_ptr(); asm volatile("" : "+s"(kp)); PRef p = kp->p; MY_TID(tid);
#define PH_END_IF(k, cond) } if ((cond) && (k) + 1 < ph_hi) { MY_TID(t1); xcd_barrier(bar, t1 == 0, XB_ST(lds_raw)); } }
#ifndef REP_CVT
#define REP_CVT 0
#endif
#ifndef REP_BAR
#define REP_BAR 0
#endif
#define PH_END(k) } if ((k) + 1 < ph_hi) { for (int rb_ = 0; rb_ < 1 + REP_BAR; ++rb_) { MY_TID(t1); xcd_barrier(bar, t1 == 0, XB_ST(lds_raw)); } } }
    PH_BEGIN(0)
        phase_adaln(tid, p, lds);
        run_items<b_lb>(tid, p, 0, 2L * 384, 0);
        phase_convert(tid, p, 0, lds, 1, 0);
    PH_END(0)
#define LAYER(l)                                                                                                                                     \
    PH_BEGIN(1 + (l) * NPL + 0) if ((l) == 0) { phase_rows<0>(tid, p, 0, lds); } PH_END_IF(1 + (l) * NPL + 0, (l) == 0)                                 \
    PH_BEGIN(1 + (l) * NPL + 1) {                                                                                                                    \
        pg8::Gemm g{p.H, p.WIN_T + WBOFF(l), NTOK, INC, D, nullptr, 0, 1, 0}; pg8::StaticOrder S; S.init(NTOK, INC, G, (int)blockIdx.x);                         \
        pg8::EpiP E{p.P, INC, p.q_norm + (l) * HD, p.k_norm + (l) * HD, rep_};                                                    \
        pg8::gemm_phase<pg8::EpiP, false>(tid, lds, g, S, E);                                                                                     \
        } PH_END(1 + (l) * NPL + 1)               \
    PH_BEGIN(1 + (l) * NPL + 2) if constexpr (!FUSE_QK) { phase_qkprep(tid, p, l); } if constexpr (FAST_HGRN && (HGRN_DIAG == 3 || HGRN_DIAG == 4)) { phase_hgrn_local(tid, p, l, lds); { MY_TID(t7); run_items<b_hgrn_local_slow>(t7, p, l, 2L * NBH * NCH * 64, 0); } } else if constexpr (FAST_HGRN && HGRN_DIAG >= 2) { run_items<b_hgrn_local_slow>(tid, p, l, 2L * NBH * NCH * 64, 0); } else if constexpr (FAST_HGRN) { for (int r2_ = 0; r2_ < 1 + REP_LOCAL; ++r2_) phase_hgrn_local(tid, p, l, lds); } else { run_items<b_gates>(tid, p, l, (long)NTOK * 768, 0); } phase_conv(tid, p, l); PH_END(1 + (l) * NPL + 2) \
    PH_BEGIN(1 + (l) * NPL + 3) if constexpr (FAST_HGRN && HGRN_DIAG) { run_items<b_hgrn_scan_slow>(tid, p, l, 2L * NBH * 4096, 0); } else if constexpr (FAST_HGRN) { phase_hgrn_scan(tid, p); } else { run_items<b_hgrn_seq2>(tid, p, l, 2L * NB * HGH * 64, 0); } if constexpr (FAST_ATTN) { for (int r4_ = 0; r4_ < 1 + REP_ATTN; ++r4_) { MY_TID(t6); phase_attn(t6, p, l, lds); } } else { run_items<b_attn>(tid, p, l, (long)NTOK * NAH, 0); } PH_END(1 + (l) * NPL + 3) \
    PH_BEGIN(1 + (l) * NPL + 4) if constexpr (FAST_HGRN && HGRN_DIAG) { run_items<b_hgrn_chunkseq>(tid, p, l, 2L * NBH * NCH * 64, 0); { MY_TID(t9); xcd_barrier(bar, t9 == 0, XB_ST(lds_raw)); } { MY_TID(t8); run_items<b_hgfin>(t8, p, l, (long)NTOK * HGH, 0); } } else if constexpr (FAST_HGRN) { phase_hgrn_out(tid, p, l, lds); } else { run_items<b_hgfin>(tid, p, l, (long)NTOK * HGH, 0); } PH_END(1 + (l) * NPL + 4)                                         \
    PH_BEGIN(1 + (l) * NPL + 5) {                                                                                                                    \
        pg8::Gemm g{p.MIX, p.WOUT_T + WBOFF(l), NLAT, D, MIXD, nullptr, 0, 1, 0}; pg8::StaticOrder S; S.init(NLAT, D, G, (int)blockIdx.x);                       \
        pg8::EpiRes E{p.XB, D, p.MOD + (size_t)(l) * 3 * NMOD + 2 * D, SEQ, (size_t)NMOD};                                                           \
        pg8::gemm_phase<pg8::EpiRes, false>(tid, lds, g, S, E);                                                                                      \
        if ((l) + 1 < DEPTH) { MY_TID(tid2); mini_gemm<1>(tid2, p, l); } } PH_END(1 + (l) * NPL + 5)                  \
    PH_BEGIN(1 + (l) * NPL + 6) phase_rows<1>(tid, p, l, lds); PH_END(1 + (l) * NPL + 6)                                                               \
    PH_BEGIN(1 + (l) * NPL + 7) if constexpr (FAST_TOPK) { phase_topk(tid, p, lds); if ((l) == 0 && gridDim.x > 2 * NB * NE + 32) { MY_TID(t4); phase_convert(t4, p, 0, lds, 2, 2 * NB * NE); } else if ((l) == 0) { MY_TID(t4); phase_convert(t4, p, 0, lds, 2, 0); } else if ((l) + 1 < DEPTH) { MY_TID(t4); phase_convert(t4, p, (l) + 1, lds, 0, gridDim.x > 2 * NB * NE + 32 ? 2 * NB * NE : 0); } } else { run_items<b_rank>(tid, p, l, (long)NTOK * NE, 0); } PH_END(1 + (l) * NPL + 7)                                          \
    PH_BEGIN(1 + (l) * NPL + 8) {                                                                                                                    \
        pg8::Gemm g{p.H, p.WGU_T + WBOFF(l), NSLOT_L, 2 * ED, D, p.STOK, CAPL / 256, NE, (size_t)2 * ED * D * 2}; pg8::StaticOrder S; S.init(NSLOT_L, 2 * ED, G, (int)blockIdx.x); \
        pg8::EpiHid E{p.HID, ED};                                                                                                                    \
        pg8::gemm_phase<pg8::EpiHid, true>(tid, lds, g, S, E);                                                                                       \
        if ((l) + 1 < DEPTH) { MY_TID(tid2); mini_gemm<2>(tid2, p, l); } } PH_END(1 + (l) * NPL + 8)              \
    PH_BEGIN(1 + (l) * NPL + 9) {                                                                                                                    \
        pg8::Gemm g{p.HID, p.WD_T + WBOFF(l), NSLOT_L, D, ED, nullptr, CAPL / 256, NE, (size_t)D * ED * 2}; pg8::StaticOrder S; S.init(NSLOT_L, D, G, (int)blockIdx.x); \
        pg8::EpiBf16 E{p.Y, D, p.SVAL, 0};                                                                                                              \
        pg8::gemm_phase<pg8::EpiBf16, false>(tid, lds, g, S, E);                                                                                     \
        if ((l) + 1 < DEPTH) { MY_TID(tid2); mini_gemm<3>(tid2, p, l); } } PH_END(1 + (l) * NPL + 9)                \
    PH_BEGIN(1 + (l) * NPL + 10) phase_rows<2>(tid, p, l, lds); if ((l) == 0) { for (int rc_ = 0; rc_ < 1 + REP_CVT; ++rc_) { MY_TID(t5); phase_convert(t5, p, (l) + 1, lds); } }        PH_END(1 + (l) * NPL + 10)
#ifndef NLAYERS_BUILD
#define NLAYERS_BUILD DEPTH
#endif
    LAYER(0)
    if constexpr (NLAYERS_BUILD > 1) { LAYER(1) }
    if constexpr (NLAYERS_BUILD > 2) { LAYER(2) }
    if constexpr (NLAYERS_BUILD > 3) { LAYER(3) }
}

#ifndef MK_SPLIT
#define MK_SPLIT 0
#endif
extern "C" void kernel_launch(void* const* d_in, const int* in_sizes, int n_in, void* d_out, int out_size, void* d_ws, size_t ws_size,
                              hipStream_t stream) {
    static int grid = 0;
    if (grid == 0) {
        if (n_in != 20 || out_size != NLAT * D || ws_size < WS_END) { fprintf(stderr, "kernel_launch: unexpected problem (n_in %d out %d ws %zu need %zu)\n", n_in, out_size, ws_size, (size_t)WS_END); grid = -1; return; }
        int dev = 0, cus = 0;
        if (hipGetDevice(&dev) != hipSuccess || hipDeviceGetAttribute(&cus, hipDeviceAttributeMultiprocessorCount, dev) != hipSuccess) { grid = -1; return; }
        if (hipFuncSetAttribute((const void*)mega_fwd, hipFuncAttributeMaxDynamicSharedMemorySize, LDS_BYTES) != hipSuccess) { fprintf(stderr, "kernel_launch: hipFuncSetAttribute failed\n"); grid = -1; return; }
        int per_cu = 0;
        if (hipOccupancyMaxActiveBlocksPerMultiprocessor(&per_cu, (const void*)mega_fwd, NTHR, LDS_BYTES) != hipSuccess || per_cu < 1) { fprintf(stderr, "kernel_launch: occupancy query says %d\n", per_cu); }
        (void)hipGetLastError();
        grid = cus;
    }
    if (grid < 0) return;
    (void)hipMemsetAsync((char*)d_ws + WS_CTL, 0, WS_LB - WS_CTL, stream);
    Args a{};
    a.p = make_params(d_in, d_out, d_ws);
#if MK_SPLIT
    for (int ph = 0; ph < NPH; ++ph) { a.ph_lo = ph; a.ph_hi = ph + 1; hipLaunchKernelGGL(mega_fwd, dim3(grid), dim3(NTHR), LDS_BYTES, stream, a); }
#else
    a.ph_lo = 0; a.ph_hi = NPH;
    hipLaunchKernelGGL(mega_fwd, dim3(grid), dim3(NTHR), LDS_BYTES, stream, a);
#endif
}
#endif
```
